# Optimizing an MI355X kernel written in HIP

```python
import math
import jax
import jax.numpy as jnp
from jax import lax
import numpy as np

D_MODEL = 2048
BATCH = 4
SEQ = 4096
DEPTH = 1

CHUNK = 64
Q_BLOCK = 128
DIFF_HEADS = 8
DIFF_HEAD_DIM = 64
DIFF_V_DIM = 2 * DIFF_HEAD_DIM
DSA_HEADS = 8
DSA_HEAD_DIM = 128
DSA_LATENT = 512
IDX_HEADS = 16
IDX_DIM = 64
DSA_TOPK_MAX = 256
MEM_TOKENS = 256
MEM_HEADS = 4
MEM_HEAD_DIM = 128
D_FF = 11 * D_MODEL // 4
BRANCH_A_WIDTH = DIFF_HEADS * DIFF_V_DIM
BRANCH_B_WIDTH = DSA_HEADS * DSA_HEAD_DIM
IN_WIDTHS = (DIFF_HEADS * 2 * DIFF_HEAD_DIM, DIFF_HEADS * 2 * DIFF_HEAD_DIM, DIFF_HEADS * DIFF_V_DIM,
             DSA_HEADS * DSA_HEAD_DIM, DSA_LATENT, IDX_HEADS * IDX_DIM, IDX_DIM, IDX_HEADS)
IN_TOTAL = sum(IN_WIDTHS)
ALPHA = (2.0 * DEPTH) ** 0.25
BETA = (8.0 * DEPTH) ** -0.25
LN_EPS = 1e-5

kernel_name = 'hybrid_diff_dsa_macaron_deepnorm_layer'


def _layer_norm(x, g, b):
    xf = x.astype(jnp.float32)
    mu = jnp.mean(xf, axis=-1, keepdims=True)
    var = jnp.mean(jnp.square(xf - mu), axis=-1, keepdims=True)
    return ((xf - mu) * lax.rsqrt(var + LN_EPS) * g.astype(jnp.float32) + b.astype(jnp.float32)).astype(x.dtype)


def _rms_norm(x, g):
    xf = x.astype(jnp.float32)
    return (xf * lax.rsqrt(jnp.mean(jnp.square(xf), axis=-1, keepdims=True) + LN_EPS) * g.astype(jnp.float32)).astype(x.dtype)


def _alibi_slopes(n):
    return 2.0 ** (-8.0 * jnp.arange(1, n + 1, dtype=jnp.float32) / n)


def _swiglu(x, w_gate, w_up, w_down):
    return (jax.nn.silu(x @ w_gate) * (x @ w_up)) @ w_down


def _chunk_admissible(q_pos, k_pos):
    return (k_pos // CHUNK)[None, :] <= (q_pos // CHUNK)[:, None]


def _diff_attention(q, k, v, lam, sub_g, lambda_init):
    seq = q.shape[1]
    slopes = _alibi_slopes(DIFF_HEADS)
    scale = DIFF_HEAD_DIM ** -0.5
    pos = jnp.arange(seq, dtype=jnp.int32)
    outs = []
    for start in range(0, seq, Q_BLOCK):
        end = start + Q_BLOCK
        q_pos, k_pos = pos[start:end], pos[:end]
        logits = jnp.einsum('bthcd,bshcd->bhcts', q[:, start:end], k[:, :end]).astype(jnp.float32) * scale
        dist = jnp.abs(q_pos[:, None] - k_pos[None, :]).astype(jnp.float32)
        logits = logits - (slopes[:, None, None] * dist)[None, :, None]
        logits = jnp.where(_chunk_admissible(q_pos, k_pos), logits, -jnp.inf)
        p = jax.nn.softmax(logits, axis=-1)
        attn = p[:, :, 0] - lam * p[:, :, 1]
        outs.append(jnp.einsum('bhts,bshe->bthe', attn.astype(v.dtype), v[:, :end]))
    o = jnp.concatenate(outs, axis=1)
    o = _rms_norm(o, sub_g) * (1.0 - lambda_init)
    return o.reshape(o.shape[0], seq, BRANCH_A_WIDTH)


def _dsa_attention(q, c, iq, ik, iw, w_uk, w_uv, kv_g):
    batch, seq = q.shape[0], q.shape[1]
    top_k = min(DSA_TOPK_MAX, seq // 4)
    slopes = _alibi_slopes(DSA_HEADS)
    scale = DSA_HEAD_DIM ** -0.5
    idx_scale = (IDX_HEADS * IDX_DIM) ** -0.5
    c = _rms_norm(c, kv_g)
    q_lat = jnp.einsum('bthd,hcd->bthc', q, w_uk)
    k_pos = jnp.arange(seq, dtype=jnp.int32)
    gather = jax.vmap(lambda cb, ib: cb[ib])

    def one_block(start):
        q_pos = start + jnp.arange(Q_BLOCK, dtype=jnp.int32)
        iq_b = lax.dynamic_slice_in_dim(iq, start, Q_BLOCK, axis=1)
        iw_b = lax.dynamic_slice_in_dim(iw, start, Q_BLOCK, axis=1)
        ql_b = lax.dynamic_slice_in_dim(q_lat, start, Q_BLOCK, axis=1)
        head_scores = jax.nn.relu(jnp.einsum('bthd,bsd->bths', iq_b, ik))
        score = jnp.einsum('bths,bth->bts', head_scores, iw_b).astype(jnp.float32) * idx_scale
        score = jnp.where(_chunk_admissible(q_pos, k_pos)[None], score, -jnp.inf)
        _, sel = lax.top_k(score, top_k)
        c_sel = gather(c, sel)
        valid = (sel // CHUNK) <= (q_pos // CHUNK)[None, :, None]
        dist = jnp.abs(q_pos[None, :, None] - sel).astype(jnp.float32)
        logits = jnp.einsum('bthc,btkc->bthk', ql_b, c_sel).astype(jnp.float32) * scale
        logits = logits - slopes[None, None, :, None] * dist[:, :, None, :]
        logits = jnp.where(valid[:, :, None, :], logits, -jnp.inf)
        p = jax.nn.softmax(logits, axis=-1).astype(c.dtype)
        o_lat = jnp.einsum('bthk,btkc->bthc', p, c_sel)
        return jnp.einsum('bthc,hcd->bthd', o_lat, w_uv)

    starts = jnp.arange(0, seq, Q_BLOCK, dtype=jnp.int32)
    o = lax.map(one_block, starts)
    return jnp.moveaxis(o, 0, 1).reshape(batch, seq, BRANCH_B_WIDTH)


def _hybrid_mixer(x, w_in, diff_lambda, diff_subln_g, lambda_init, dsa_kv_g, dsa_w_uk, dsa_w_uv,
                  w_gate, b_gate, w_branch_a, w_branch_b, w_mix_out):
    b, s = x.shape[0], x.shape[1]
    h = x @ w_in
    aq, ak, av, bq, bc, iq, ik, iw = jnp.split(h, np.cumsum(IN_WIDTHS)[:-1].tolist(), axis=-1)
    lf = diff_lambda.astype(jnp.float32)
    lam = jnp.exp(jnp.sum(lf[0] * lf[1])) - jnp.exp(jnp.sum(lf[2] * lf[3])) + lambda_init
    y_a = _diff_attention(aq.reshape(b, s, DIFF_HEADS, 2, DIFF_HEAD_DIM),
                          ak.reshape(b, s, DIFF_HEADS, 2, DIFF_HEAD_DIM),
                          av.reshape(b, s, DIFF_HEADS, DIFF_V_DIM), lam, diff_subln_g, lambda_init)
    y_b = _dsa_attention(bq.reshape(b, s, DSA_HEADS, DSA_HEAD_DIM), bc,
                         iq.reshape(b, s, IDX_HEADS, IDX_DIM), ik, iw, dsa_w_uk, dsa_w_uv, dsa_kv_g)
    gates = jax.nn.sigmoid(jnp.einsum('bsd,gde->gbse', x, w_gate) + b_gate[:, None, None, :])
    merged = gates[0] * (y_a @ w_branch_a) + gates[1] * (y_b @ w_branch_b)
    return merged @ w_mix_out


def _memory_attention(x, mem, w_q, w_kv, w_o):
    b, s = x.shape[0], x.shape[1]
    q = (x @ w_q).reshape(b, s, MEM_HEADS, MEM_HEAD_DIM)
    kv = (mem @ w_kv).reshape(b, mem.shape[1], 2, MEM_HEADS, MEM_HEAD_DIM)
    logits = jnp.einsum('bthd,bmhd->bhtm', q, kv[:, :, 0]).astype(jnp.float32) * MEM_HEAD_DIM ** -0.5
    p = jax.nn.softmax(logits, axis=-1).astype(x.dtype)
    o = jnp.einsum('bhtm,bmhd->bthd', p, kv[:, :, 1])
    return o.reshape(b, s, MEM_HEADS * MEM_HEAD_DIM) @ w_o


def setup_inputs(seed: int = 0) -> dict:
    key = jax.random.key(seed)
    ks = iter(jax.random.split(key, 32))
    f32 = jnp.float32
    L = DEPTH

    def w(shape, fan_in, gain=1.0):
        return jax.random.normal(next(ks), shape, f32) * (gain * fan_in ** -0.5)

    def noise(shape, s):
        return jax.random.normal(next(ks), shape, f32) * s

    return {
        'x': jax.random.normal(next(ks), (BATCH, SEQ, D_MODEL), f32),
        'mem': jax.random.normal(next(ks), (BATCH, MEM_TOKENS, D_MODEL), f32),
        'ffn1_w_gate': w((L, D_MODEL, D_FF), D_MODEL),
        'ffn1_w_up': w((L, D_MODEL, D_FF), D_MODEL),
        'ffn1_w_down': w((L, D_FF, D_MODEL), D_FF, BETA),
        'w_in': w((L, D_MODEL, IN_TOTAL), D_MODEL),
        'diff_lambda': noise((L, 4, DIFF_HEAD_DIM), 0.1),
        'diff_subln_g': 1.0 + noise((L, DIFF_V_DIM), 0.02),
        'dsa_kv_g': 1.0 + noise((L, DSA_LATENT), 0.02),
        'dsa_w_uk': w((L, DSA_HEADS, DSA_LATENT, DSA_HEAD_DIM), DSA_LATENT),
        'dsa_w_uv': w((L, DSA_HEADS, DSA_LATENT, DSA_HEAD_DIM), DSA_LATENT),
        'w_gate': w((L, 2, D_MODEL, D_MODEL), D_MODEL),
        'b_gate': noise((L, 2, D_MODEL), 0.02),
        'w_branch_a': w((L, BRANCH_A_WIDTH, D_MODEL), BRANCH_A_WIDTH),
        'w_branch_b': w((L, BRANCH_B_WIDTH, D_MODEL), BRANCH_B_WIDTH),
        'w_mix_out': w((L, D_MODEL, D_MODEL), D_MODEL, BETA),
        'mem_w_q': w((L, D_MODEL, MEM_HEADS * MEM_HEAD_DIM), D_MODEL),
        'mem_w_kv': w((L, D_MODEL, 2 * MEM_HEADS * MEM_HEAD_DIM), D_MODEL),
        'mem_w_o': w((L, MEM_HEADS * MEM_HEAD_DIM, D_MODEL), MEM_HEADS * MEM_HEAD_DIM, BETA),
        'ffn2_w_gate': w((L, D_MODEL, D_FF), D_MODEL),
        'ffn2_w_up': w((L, D_MODEL, D_FF), D_MODEL),
        'ffn2_w_down': w((L, D_FF, D_MODEL), D_FF, BETA),
        'ln_g': 1.0 + noise((L, 4, D_MODEL), 0.02),
        'ln_b': noise((L, 4, D_MODEL), 0.02),
    }


def reference(x, mem, ffn1_w_gate, ffn1_w_up, ffn1_w_down, w_in, diff_lambda, diff_subln_g,
              dsa_kv_g, dsa_w_uk, dsa_w_uv, w_gate, b_gate, w_branch_a, w_branch_b, w_mix_out,
              mem_w_q, mem_w_kv, mem_w_o, ffn2_w_gate, ffn2_w_up, ffn2_w_down, ln_g, ln_b):
    for l in range(DEPTH):
        lambda_init = 0.8 - 0.6 * math.exp(-0.3 * l)
        x = _layer_norm(ALPHA * x + 0.5 * _swiglu(x, ffn1_w_gate[l], ffn1_w_up[l], ffn1_w_down[l]),
                        ln_g[l, 0], ln_b[l, 0])
        x = _layer_norm(ALPHA * x + _hybrid_mixer(x, w_in[l], diff_lambda[l], diff_subln_g[l], lambda_init,
                                                  dsa_kv_g[l], dsa_w_uk[l], dsa_w_uv[l], w_gate[l], b_gate[l],
                                                  w_branch_a[l], w_branch_b[l], w_mix_out[l]),
                        ln_g[l, 1], ln_b[l, 1])
        x = _layer_norm(ALPHA * x + _memory_attention(x, mem, mem_w_q[l], mem_w_kv[l], mem_w_o[l]),
                        ln_g[l, 2], ln_b[l, 2])
        x = _layer_norm(ALPHA * x + 0.5 * _swiglu(x, ffn2_w_gate[l], ffn2_w_up[l], ffn2_w_down[l]),
                        ln_g[l, 3], ln_b[l, 3])
    return x
```

```cpp
#include <hip/hip_runtime.h>
#include <cstdio>
#include <cstdint>

#ifndef MK_ONE_LAUNCH
#define MK_ONE_LAUNCH 0
#endif

namespace pg8 {
#define PG8_LAS __attribute__((address_space(3)))
typedef unsigned short bf16_t;
typedef short bf16x8 __attribute__((ext_vector_type(8)));
typedef float f32x4 __attribute__((ext_vector_type(4)));
typedef unsigned u32x4 __attribute__((ext_vector_type(4)));
constexpr int BM = 256, BK = 64, HALF = 128, HTB = HALF * BK * 2  , STAGE_BYTES = 8 * HTB, NXCD = 8, WGM = 8;

__host__ __device__ __forceinline__ int lds_byte(int r, int c) { const int st = (r >> 4) * 2 + (c >> 5), rr = r & 15, cc = c & 31, ob = rr * 64 + cc * 2; return st * 1024 + (ob ^ (((ob >> 9) & 1) << 5)); }
__host__ __device__ __forceinline__ void stage_rc(int b, int& R, int& C) { const int st = b / 1024, sb = b % 1024, swz = sb ^ (((sb >> 9) & 1) << 5); R = (st >> 1) * 16 + swz / 64; C = (st & 1) * 32 + (swz % 64) / 2; }
__host__ __device__ __forceinline__ int perm32(int rho) { const int n = rho >> 4, i = rho & 15; return 8 * (i >> 2) + 4 * n + (i & 3); }

struct Unit { int pm, pn; };
struct Gemm { const bf16_t* A; const bf16_t* Bt; int lda, ldb, K, a_shift, a_mul; };

struct StaticOrder {
    int nM, nN, nwg, G, c;
    __host__ __device__ void init(int M, int N, int G_, int c_) { nM = M / BM; nN = N / BM; nwg = nM * nN; G = G_; c = c_; }
    __host__ __device__ bool next(int i, Unit& u) const {
        const long L = (long)i * G + c; if (L >= nwg) return false;
        int wgid = (int)L; { const int q = nwg / NXCD, r = nwg % NXCD, xcd = wgid % NXCD, off = wgid / NXCD; wgid = (xcd < r ? xcd * (q + 1) : r * (q + 1) + (xcd - r) * q) + off; }
        const int nig = WGM * nN, gid = wgid / nig, fm = gid * WGM, gsz = (nM - fm) < WGM ? (nM - fm) : WGM;
        u.pm = fm + ((wgid % nig) % gsz); u.pn = (wgid % nig) / gsz; return true;
    }
    __device__ __forceinline__ void a_ready(const Unit&) const {}
    __device__ __forceinline__ void done(const Unit&) const {}
};

__device__ __forceinline__ unsigned cvt_pk_bf16(float lo, float hi) { unsigned r; asm volatile("v_cvt_pk_bf16_f32 %0, %1, %2" : "=v"(r) : "v"(lo), "v"(hi)); return r; }
__device__ __forceinline__ float bflo(unsigned w) { return __uint_as_float(w << 16); }
__device__ __forceinline__ float bfhi(unsigned w) { return __uint_as_float(w & 0xffff0000u); }
__device__ __forceinline__ float sigmoidf_fast(float x) { return __builtin_amdgcn_rcpf(1.0f + __builtin_amdgcn_exp2f(-1.4426950408889634f * x)); }

struct EpiBf16 {
    static constexpr bool PERM = true, AFTER_DRAIN = false;
    bf16_t* O; int ldc;
    __device__ __forceinline__ void operator()(const f32x4 (&acc)[2][2][4][2], const Unit& u, int wr, int wc, int fr, int fq) const {
        const int row0 = u.pm * BM + wr * 64 + fr, col0 = u.pn * BM + wc * 32 + 8 * fq;
#pragma unroll
        for (int ai = 0; ai < 2; ++ai)
#pragma unroll
            for (int m = 0; m < 4; ++m) { bf16_t* rowp = O + (size_t)(row0 + ai * HALF + m * 16) * ldc + col0;
#pragma unroll
                for (int bj = 0; bj < 2; ++bj) { const f32x4 v0 = acc[ai][bj][m][0], v1 = acc[ai][bj][m][1];
                    u32x4 w; w.x = cvt_pk_bf16(v0[0], v0[1]); w.y = cvt_pk_bf16(v0[2], v0[3]); w.z = cvt_pk_bf16(v1[0], v1[1]); w.w = cvt_pk_bf16(v1[2], v1[3]);
                    *(u32x4*)(rowp + bj * HALF) = w; } }
    }
};
struct EpiInProj {
    static constexpr bool PERM = true, AFTER_DRAIN = false;
    bf16_t *aq, *ak, *av, *bq, *bc, *iq, *ikw;
    __device__ __forceinline__ void operator()(const f32x4 (&acc)[2][2][4][2], const Unit& u, int wr, int wc, int fr, int fq) const {
        bf16_t* base; int ldc, colt; const int pn = u.pn;
        if (pn < 4) { base = aq; ldc = 1024; colt = pn * 256; }
        else if (pn < 8) { base = ak; ldc = 1024; colt = (pn - 4) * 256; }
        else if (pn < 12) { base = av; ldc = 1024; colt = (pn - 8) * 256; }
        else if (pn < 16) { base = bq; ldc = 1024; colt = (pn - 12) * 256; }
        else if (pn < 18) { base = bc; ldc = 512; colt = (pn - 16) * 256; }
        else if (pn < 22) { base = iq; ldc = 1024; colt = (pn - 18) * 256; }
        else { base = ikw; ldc = 256; colt = 0; }
        const int row0 = u.pm * BM + wr * 64 + fr, col0 = colt + wc * 32 + 8 * fq;
#pragma unroll
        for (int ai = 0; ai < 2; ++ai)
#pragma unroll
            for (int m = 0; m < 4; ++m) { bf16_t* rowp = base + (size_t)(row0 + ai * HALF + m * 16) * ldc + col0;
#pragma unroll
                for (int bj = 0; bj < 2; ++bj) { const f32x4 v0 = acc[ai][bj][m][0], v1 = acc[ai][bj][m][1];
                    u32x4 w; w.x = cvt_pk_bf16(v0[0], v0[1]); w.y = cvt_pk_bf16(v0[2], v0[3]); w.z = cvt_pk_bf16(v1[0], v1[1]); w.w = cvt_pk_bf16(v1[2], v1[3]);
                    *(u32x4*)(rowp + bj * HALF) = w; } }
    }
};
struct EpiSwiGLU {
    static constexpr bool PERM = true, AFTER_DRAIN = false;
    bf16_t* O; int ldc;
    __device__ __forceinline__ void operator()(const f32x4 (&acc)[2][2][4][2], const Unit& u, int wr, int wc, int fr, int fq) const {
        const int row0 = u.pm * BM + wr * 64 + fr, col0 = u.pn * HALF + wc * 32 + 8 * fq;
#pragma unroll
        for (int ai = 0; ai < 2; ++ai)
#pragma unroll
            for (int m = 0; m < 4; ++m) { bf16_t* rowp = O + (size_t)(row0 + ai * HALF + m * 16) * ldc + col0;
                float h[8];
#pragma unroll
                for (int n = 0; n < 2; ++n)
#pragma unroll
                    for (int j = 0; j < 4; ++j) { const float g = acc[ai][0][m][n][j], up = acc[ai][1][m][n][j]; h[4 * n + j] = g * sigmoidf_fast(g) * up; }
                u32x4 w; w.x = cvt_pk_bf16(h[0], h[1]); w.y = cvt_pk_bf16(h[2], h[3]); w.z = cvt_pk_bf16(h[4], h[5]); w.w = cvt_pk_bf16(h[6], h[7]);
                *(u32x4*)rowp = w; }
    }
};
struct EpiGateMerge {
    static constexpr bool PERM = true, AFTER_DRAIN = false;
    const bf16_t* ta; const bf16_t* tb; bf16_t* O; int ldc; const float* b0; const float* b1;
    __device__ __forceinline__ void operator()(const f32x4 (&acc)[2][2][4][2], const Unit& u, int wr, int wc, int fr, int fq) const {
        const int row0 = u.pm * BM + wr * 64 + fr, col0 = u.pn * HALF + wc * 32 + 8 * fq;
        float bb0[8], bb1[8];
#pragma unroll
        for (int j = 0; j < 8; ++j) { bb0[j] = b0[col0 + j]; bb1[j] = b1[col0 + j]; }
#pragma unroll
        for (int ai = 0; ai < 2; ++ai)
#pragma unroll
            for (int m = 0; m < 4; ++m) { const size_t off = (size_t)(row0 + ai * HALF + m * 16) * ldc + col0;
                const u32x4 a = *(const u32x4*)(ta + off), b = *(const u32x4*)(tb + off);
                const float av[8] = {bflo(a.x), bfhi(a.x), bflo(a.y), bfhi(a.y), bflo(a.z), bfhi(a.z), bflo(a.w), bfhi(a.w)};
                const float bv[8] = {bflo(b.x), bfhi(b.x), bflo(b.y), bfhi(b.y), bflo(b.z), bfhi(b.z), bflo(b.w), bfhi(b.w)};
                float h[8];
#pragma unroll
                for (int n = 0; n < 2; ++n)
#pragma unroll
                    for (int j = 0; j < 4; ++j) { const int e = 4 * n + j; h[e] = sigmoidf_fast(acc[ai][0][m][n][j] + bb0[e]) * av[e] + sigmoidf_fast(acc[ai][1][m][n][j] + bb1[e]) * bv[e]; }
                u32x4 w; w.x = cvt_pk_bf16(h[0], h[1]); w.y = cvt_pk_bf16(h[2], h[3]); w.z = cvt_pk_bf16(h[4], h[5]); w.w = cvt_pk_bf16(h[6], h[7]);
                *(u32x4*)(O + off) = w; }
    }
};
struct EpiRes {
    static constexpr bool PERM = false, AFTER_DRAIN = false;
    const float* res; float* out; int ldc; float alpha, s;
    __device__ __forceinline__ void operator()(const f32x4 (&acc)[2][2][4][2], const Unit& u, int wr, int wc, int fr, int fq) const {
        const int col0 = u.pn * BM + wc * 32 + 4 * fq;
#pragma unroll
        for (int ai = 0; ai < 2; ++ai)
#pragma unroll
            for (int m = 0; m < 4; ++m) { const size_t off = (size_t)(u.pm * BM + ai * HALF + wr * 64 + m * 16 + fr) * ldc + col0;
#pragma unroll
                for (int bj = 0; bj < 2; ++bj)
#pragma unroll
                    for (int n = 0; n < 2; ++n) { const f32x4 r = *(const f32x4*)(res + off + bj * HALF + n * 16); *(f32x4*)(out + off + bj * HALF + n * 16) = r * alpha + acc[ai][bj][m][n] * s; }
                if (m & 1) asm volatile("" ::: "memory"); }
    }
};

template <class Epi, class Sched, bool ALIGN_EPI>
__device__ __forceinline__ void gemm_phase(PG8_LAS unsigned char* lds, const Gemm g, const Sched& S, const Epi& E) {
    const int tid = threadIdx.x, wid = __builtin_amdgcn_readfirstlane(tid >> 6), lane = tid & 63, wr = wid >> 2, wc = wid & 3, fr = lane & 15, fq = lane >> 4;
    const int K = g.K, nt = K / BK;
    unsigned voffA[2], voffB[2];
#pragma unroll
    for (int i = 0; i < 2; ++i) { int R, C; stage_rc(tid * 16 + i * 8192, R, C); const int Rb = Epi::PERM ? ((R & ~31) + perm32(R & 31)) : R;
        voffA[i] = (unsigned)(R * g.lda + C) * 2u; voffB[i] = (unsigned)(Rb * g.ldb + C) * 2u; }
    const size_t kstep = (size_t)(BK * 2);
    const size_t hstepA = (size_t)HALF * g.lda * 2, hstepB = (size_t)HALF * g.ldb * 2;
    const size_t tstepA = 2 * hstepA, tstepB = 2 * hstepB;
    const unsigned ldsw = (unsigned)wid * 1024u;
    const int aoff = lds_byte(wr * 64 + fr, fq * 8), boff = lds_byte(wc * 32 + fr, fq * 8);
#define PG8_UA(u) ((const char*)g.A + (size_t)(u).pm * tstepA + (size_t)(((u).pn >> g.a_shift) * g.a_mul) * 2)
#define PG8_UB(u) ((const char*)g.Bt + (size_t)(u).pn * tstepB)
#define PG8_SA(b, h) (((b) * 2 + (h)) * HTB)
#define PG8_SB(b, h) ((4 + (b) * 2 + (h)) * HTB)
#define PG8_STAGE(bufoff, gbase, voff) do { _Pragma("unroll") for (int _i = 0; _i < 2; ++_i) \
        __builtin_amdgcn_global_load_lds((const unsigned*)((const char*)(gbase) + (voff)[_i]), (PG8_LAS unsigned*)(lds + (bufoff) + ldsw + _i * 8192), 16, 0, 0); } while (0)
#define PG8_LDA(dst, b, h) do { _Pragma("unroll") for (int m = 0; m < 4; ++m) _Pragma("unroll") for (int k = 0; k < 2; ++k) dst[m][k] = *(const PG8_LAS bf16x8*)(lds + PG8_SA(b, h) + aoff + m * 2048 + k * 1024); } while (0)
#define PG8_LDB(dst, b, h) do { _Pragma("unroll") for (int n = 0; n < 2; ++n) _Pragma("unroll") for (int k = 0; k < 2; ++k) dst[n][k] = *(const PG8_LAS bf16x8*)(lds + PG8_SB(b, h) + boff + n * 2048 + k * 1024); } while (0)
#define PG8_MMA(ai, bj, At, Bt) do { __builtin_amdgcn_s_setprio(1); _Pragma("unroll") for (int m = 0; m < 4; ++m) _Pragma("unroll") for (int n = 0; n < 2; ++n) _Pragma("unroll") for (int k = 0; k < 2; ++k) \
        acc[ai][bj][m][n] = __builtin_amdgcn_mfma_f32_16x16x32_bf16(Bt[n][k], At[m][k], acc[ai][bj][m][n], 0, 0, 0); __builtin_amdgcn_s_setprio(0); } while (0)
#define PG8_WAIT_V(n) asm volatile("s_waitcnt vmcnt(" #n ")" ::: "memory")
#define PG8_WAIT_L(n) asm volatile("s_waitcnt lgkmcnt(" #n ")" ::: "memory")
#define PG8_BAR __builtin_amdgcn_s_barrier()
#define PG8_SCHED __builtin_amdgcn_sched_barrier(0)
    Unit cur, nxt; int ui = 0;
    if (!S.next(0, cur)) return;
    f32x4 acc[2][2][4][2];
#pragma unroll
    for (int a = 0; a < 2; ++a)
#pragma unroll
        for (int b = 0; b < 2; ++b)
#pragma unroll
            for (int m = 0; m < 4; ++m)
#pragma unroll
                for (int n = 0; n < 2; ++n) acc[a][b][m][n] = (f32x4){0.f, 0.f, 0.f, 0.f};
    bf16x8 At[4][2], B0[2][2], B1[2][2];
    const char* cA = PG8_UA(cur); const char* cB = PG8_UB(cur);
    S.a_ready(cur);
    PG8_STAGE(PG8_SB(0, 0), cB, voffB); PG8_STAGE(PG8_SB(0, 1), cB + hstepB, voffB); PG8_STAGE(PG8_SA(0, 0), cA, voffA); PG8_STAGE(PG8_SA(0, 1), cA + hstepA, voffA);
    if (wr == 1) PG8_BAR;
    PG8_WAIT_V(2); PG8_BAR;
    PG8_STAGE(PG8_SB(1, 0), cB + kstep, voffB); PG8_STAGE(PG8_SA(1, 0), cA + kstep, voffA); PG8_STAGE(PG8_SB(1, 1), cB + hstepB + kstep, voffB);
    PG8_WAIT_V(6); PG8_BAR;
    for (;;) {
        const bool has_next = S.next(ui + 1, nxt);
        const char* nA = has_next ? PG8_UA(nxt) : cA; const char* nB = has_next ? PG8_UB(nxt) : cB;
        for (int t = 0; t < nt; t += 2) {
            const bool last = (t == nt - 2);
            const char* a1 = cA + (size_t)(t + 1) * kstep;
            const char* a2 = last ? nA : cA + (size_t)(t + 2) * kstep; const char* b2 = last ? nB : cB + (size_t)(t + 2) * kstep;
            const char* a3 = a2 + kstep; const char* b3 = b2 + kstep;
            if (last && has_next) S.a_ready(nxt);
            PG8_LDB(B0, 0, 0); PG8_LDB(B1, 0, 1); PG8_SCHED; PG8_LDA(At, 0, 0); PG8_STAGE(PG8_SA(1, 1), a1 + hstepA, voffA);
            PG8_WAIT_V(8); PG8_WAIT_L(0); PG8_BAR; PG8_MMA(0, 0, At, B0); PG8_MMA(0, 1, At, B1); PG8_BAR; PG8_SCHED;
            PG8_LDA(At, 0, 1); PG8_STAGE(PG8_SB(0, 0), b2, voffB); PG8_STAGE(PG8_SB(0, 1), b2 + hstepB, voffB); PG8_STAGE(PG8_SA(0, 0), a2, voffA);
            PG8_WAIT_V(8); PG8_WAIT_L(0); PG8_BAR; PG8_MMA(1, 0, At, B0); PG8_MMA(1, 1, At, B1); PG8_BAR; PG8_SCHED;
            PG8_LDB(B0, 1, 0); PG8_LDB(B1, 1, 1); PG8_SCHED; PG8_LDA(At, 1, 0); PG8_STAGE(PG8_SA(0, 1), a2 + hstepA, voffA);
            PG8_WAIT_V(8); PG8_WAIT_L(0); PG8_BAR; PG8_MMA(0, 0, At, B0); PG8_MMA(0, 1, At, B1); PG8_BAR; PG8_SCHED;
            PG8_LDA(At, 1, 1); PG8_STAGE(PG8_SB(1, 0), b3, voffB); PG8_STAGE(PG8_SB(1, 1), b3 + hstepB, voffB); PG8_STAGE(PG8_SA(1, 0), a3, voffA);
            PG8_WAIT_V(8); PG8_WAIT_L(0); PG8_BAR; PG8_MMA(1, 0, At, B0); PG8_MMA(1, 1, At, B1); PG8_BAR; PG8_SCHED;
        }
        if constexpr (ALIGN_EPI) { if (wr == 0) PG8_BAR; }
        E(acc, cur, wr, wc, fr, fq); S.done(cur);
        if (!has_next) break;
#pragma unroll
        for (int a = 0; a < 2; ++a)
#pragma unroll
            for (int b = 0; b < 2; ++b)
#pragma unroll
                for (int m = 0; m < 4; ++m)
#pragma unroll
                    for (int n = 0; n < 2; ++n) acc[a][b][m][n] = (f32x4){0.f, 0.f, 0.f, 0.f};
        cur = nxt; cA = nA; cB = nB; ++ui;
        if constexpr (ALIGN_EPI) { if (wr == 1) PG8_BAR; }
    }
    PG8_WAIT_V(0);
    if constexpr (!ALIGN_EPI) { if (wr == 0) PG8_BAR; }
    PG8_BAR;
#undef PG8_UA
#undef PG8_UB
#undef PG8_SA
#undef PG8_SB
#undef PG8_STAGE
#undef PG8_LDA
#undef PG8_LDB
#undef PG8_MMA
#undef PG8_WAIT_V
#undef PG8_WAIT_L
#undef PG8_BAR
#undef PG8_SCHED
}
}

constexpr int NWAVES = 8;
constexpr int BATCH = 4, SEQ = 4096, D = 2048, FF = 5632, M = BATCH * SEQ;
constexpr int N_IN = 5888;
constexpr int MEMT = 256;
constexpr float LN_EPS = 1e-5f;
constexpr float ALPHA = 1.189207115002721f;
constexpr float LAMBDA_INIT = 0.2f;

constexpr size_t MiB = 1u << 20;
constexpr size_t WS_CTL = 0, CTL_ZERO_BYTES = 1 * MiB;
constexpr size_t WS_W_IN = 2 * MiB;
constexpr size_t WS_W_G = 25 * MiB;
constexpr size_t WS_W_UK = 41 * MiB;
constexpr size_t WS_W_UVP = 42 * MiB;
constexpr size_t WS_W_A = 44 * MiB;
constexpr size_t WS_W_B = 48 * MiB;
constexpr size_t WS_W_MO = 52 * MiB;
constexpr size_t WS_W_MQ = 60 * MiB;
constexpr size_t WS_W_MKV = 62 * MiB;
constexpr size_t WS_W_MOUT = 66 * MiB;
constexpr size_t WS_MEM16 = 68 * MiB;
constexpr size_t WS_KVMEM = 72 * MiB;
constexpr size_t WS_W_GU2 = 74 * MiB;
constexpr size_t WS_W_D2 = 118 * MiB;
constexpr size_t WS_X16 = 140 * MiB;
constexpr size_t WS_MIX = 204 * MiB;
constexpr size_t WS_W_GU1 = 204 * MiB;
constexpr size_t WS_W_D1 = 248 * MiB;
constexpr size_t WS_H = 270 * MiB;
constexpr size_t WS_AQ = WS_MIX + 0 * MiB, WS_AK = WS_MIX + 32 * MiB, WS_AV = WS_MIX + 64 * MiB, WS_BQ = WS_MIX + 96 * MiB;
constexpr size_t WS_BC = WS_MIX + 128 * MiB;
constexpr size_t WS_IQ = WS_MIX + 144 * MiB;
constexpr size_t WS_IKW = WS_MIX + 176 * MiB;
constexpr size_t WS_QLAT = WS_MIX + 184 * MiB;
constexpr size_t WS_IDX = WS_AK;
constexpr size_t WS_NCNT = WS_AK + 8 * MiB;
constexpr size_t WS_YB = WS_BQ;
constexpr size_t WS_TA = WS_QLAT, WS_TB = WS_QLAT + 64 * MiB;
constexpr size_t WS_QM = WS_AQ, WS_OM = WS_AQ + 16 * MiB;
constexpr size_t WS_END = WS_MIX + 312 * MiB;
static_assert(WS_H + (size_t)M * FF * 2 <= WS_END && WS_QLAT + (size_t)M * 4096 * 2 <= WS_END, "d_ws map");
constexpr int CW_BAR = 4096;

constexpr int RING_OFF = 0, RING_BYTES = 131072;
constexpr int LDSCTL_OFF = RING_BYTES, MISC_OFF = LDSCTL_OFF + 320;
constexpr int LDS_BYTES = 147456;
static_assert(MISC_OFF + 128 <= LDS_BYTES, "LDS map");

#define GAS __attribute__((address_space(1)))
#define LAS __attribute__((address_space(3)))
typedef unsigned short bf16;
typedef unsigned v4u __attribute__((ext_vector_type(4)));
typedef unsigned v2u __attribute__((ext_vector_type(2)));
typedef float f32x4 __attribute__((ext_vector_type(4)));
typedef float f32x16 __attribute__((ext_vector_type(16)));
typedef short bf16x8 __attribute__((ext_vector_type(8)));
typedef GAS unsigned gu32;
#define RLX_AGENT __ATOMIC_RELAXED, __HIP_MEMORY_SCOPE_AGENT
#define LDS_WAIT() asm volatile("s_waitcnt lgkmcnt(0)" ::: "memory")
#define VM_WAIT() asm volatile("s_waitcnt vmcnt(0)" ::: "memory")
__device__ __forceinline__ unsigned f2bf(float f) { unsigned u = __builtin_bit_cast(unsigned, f); return (u + 0x7fffu + ((u >> 16) & 1u)) >> 16; }
__device__ __forceinline__ unsigned pk2(float lo, float hi) { return f2bf(lo) | (f2bf(hi) << 16); }
__device__ __forceinline__ float bf2f(unsigned short v) { return __uint_as_float((unsigned)v << 16); }
__device__ __forceinline__ float blo(unsigned w) { return __uint_as_float(w << 16); }
__device__ __forceinline__ float bhi(unsigned w) { return __uint_as_float(w & 0xffff0000u); }
__device__ __forceinline__ float wave_sum(float v) {
#pragma unroll
    for (int o = 1; o < 64; o <<= 1) v += __shfl_xor(v, o);
    return v;
}

#define XB_TMO      128
#define XB_XCNT(j)  (256  + 64 * (j))
#define XB_XSUB(j)  (1280 + 64 * (j))
#define XB_XGEN(j)  (2304 + 64 * (j))
#define XB_TOP      3328
#define XB_TOPGEN   3392
#define XCD_BAR_WORDS 3456
#define XB_SPIN_CAP (1u << 18)

__device__ __forceinline__ unsigned xb_ld(unsigned* p)              { return __hip_atomic_load(p, __ATOMIC_RELAXED, __HIP_MEMORY_SCOPE_AGENT); }
__device__ __forceinline__ unsigned xb_add(unsigned* p, unsigned v) { return __hip_atomic_fetch_add(p, v, __ATOMIC_RELAXED, __HIP_MEMORY_SCOPE_AGENT); }
__device__ __forceinline__ unsigned xb_xcc_id() { return (unsigned)__builtin_amdgcn_s_getreg((3 << 11) | 20) & 0xFu; }
#define XB_SPIN(cond, bar) do { unsigned _sp = 0; while (cond) { __builtin_amdgcn_s_sleep(1); \
    if ((++_sp & 255u) == 0u) { if (xb_ld(&(bar)[XB_TMO])) break; if (_sp > XB_SPIN_CAP) { atomicAdd(&(bar)[XB_TMO], 1u); break; } } } } while (0)

struct XcdBarrier {
    unsigned* bar; unsigned x;
    volatile LAS unsigned* st;
};

__device__ __forceinline__ XcdBarrier xcd_barrier_post(unsigned* bar, volatile LAS unsigned* st) {
    XcdBarrier b; b.bar = bar; b.x = xb_xcc_id(); b.st = st;
    if (threadIdx.x == 0) (void)xb_add(&bar[XB_XCNT(b.x)], 1u);
    return b;
}
__device__ __forceinline__ void xcd_barrier_complete(unsigned* bar, unsigned x, unsigned& nloc, unsigned& nx) {
    const unsigned G = gridDim.x * gridDim.y * gridDim.z;
    unsigned sum, cnt, mine, sp = 0u;
    for (;;) {
        sum = 0u; cnt = 0u; mine = 0u;
#pragma unroll
        for (unsigned j = 0; j < 16; ++j) { const unsigned c = xb_ld(&bar[XB_XCNT(j)]); sum += c; cnt += (c > 0u) ? 1u : 0u; mine = (j == x) ? c : mine; }
        if (sum == G) break;
        __builtin_amdgcn_s_sleep(1);
        if ((++sp & 255u) == 0u) { if (xb_ld(&bar[XB_TMO])) break; if (sp > XB_SPIN_CAP) { atomicAdd(&bar[XB_TMO], 1u); break; } }
    }
    nloc = mine > 0u ? mine : 1u; nx = cnt > 0u ? cnt : 1u;
}

__device__ __forceinline__ void xcd_barrier(const XcdBarrier& b) {
    asm volatile("s_waitcnt vmcnt(0)" ::: "memory");
    __syncthreads();
    if (threadIdx.x == 0) {
        unsigned* bar = b.bar;
        __builtin_amdgcn_s_waitcnt(0);
        unsigned nloc = b.st[0], nx = b.st[1];
        if (nloc == 0u) { xcd_barrier_complete(bar, b.x, nloc, nx); b.st[0] = nloc; b.st[1] = nx; }
        const unsigned old = xb_add(&bar[XB_XSUB(b.x)], 1u);
        const unsigned gen = old / nloc;
        if (old + 1u == (gen + 1u) * nloc) {
            __builtin_amdgcn_fence(__ATOMIC_RELEASE, "agent");
            asm volatile("s_waitcnt vmcnt(0)" ::: "memory");
            const unsigned og = xb_add(&bar[XB_TOP], 1u);
            const unsigned tg = og / nx;
            if (og + 1u == (tg + 1u) * nx) xb_add(&bar[XB_TOPGEN], 1u);
            else XB_SPIN(xb_ld(&bar[XB_TOPGEN]) == tg, bar);
            __builtin_amdgcn_fence(__ATOMIC_ACQUIRE, "agent");
            xb_add(&bar[XB_XGEN(b.x)], 1u);
            asm volatile("s_waitcnt vmcnt(0)" ::: "memory");
        } else {
            XB_SPIN(xb_ld(&bar[XB_XGEN(b.x)]) == gen, bar);
            __builtin_amdgcn_fence(__ATOMIC_ACQUIRE, "agent");
            asm volatile("s_waitcnt vmcnt(0)" ::: "memory");
        }
    }
    __syncthreads();
}

__device__ __forceinline__ void tr_item(const float* W, int ldw, int nvalid, bf16* WT, int ldt, int k0, int n0, int drow0, int dcol0, LAS float* scr, int lane) {
    const int n = n0 + (lane & 31); const bool ok = n < nvalid;
#pragma unroll 8
    for (int i = 0; i < 32; ++i) { const int kk = 2 * i + (lane >> 5); scr[kk * 33 + (lane & 31)] = ok ? W[(size_t)(k0 + kk) * ldw + n] : 0.f; }
    LDS_WAIT(); asm volatile("" ::: "memory");
    const int c = lane & 7;
#pragma unroll
    for (int j = 0; j < 4; ++j) { const int nn = (lane >> 3) + 8 * j; const LAS float* s = scr + (8 * c) * 33 + nn;
        v4u o; o.x = pk2(s[0 * 33], s[1 * 33]); o.y = pk2(s[2 * 33], s[3 * 33]); o.z = pk2(s[4 * 33], s[5 * 33]); o.w = pk2(s[6 * 33], s[7 * 33]);
        *(GAS v4u*)(WT + (size_t)(drow0 + nn) * ldt + dcol0 + k0 + 8 * c) = o; }
    LDS_WAIT(); asm volatile("" ::: "memory");
}
__device__ __forceinline__ void cvt_item(const float* src, bf16* dst, int item, int lane) {
    const GAS f32x4* s = (const GAS f32x4*)(src + (size_t)item * 512) + 2 * lane; const f32x4 a = s[0], b = s[1];
    v4u o; o.x = pk2(a.x, a.y); o.y = pk2(a.z, a.w); o.z = pk2(b.x, b.y); o.w = pk2(b.z, b.w);
    *((GAS v4u*)(dst + (size_t)item * 512) + lane) = o;
}
__device__ __forceinline__ void p0_prologue(const float* const (&in)[24], unsigned char* ws, LAS unsigned char* lds, int gw, int NGW, int wave, int lane) {
    LAS float* scr = (LAS float*)(lds + RING_OFF + wave * 16384);
#define TRM(SRC, Kk, LDW, NVALID, NPAD, DST, LDT, ROWMAP, DCOL) { constexpr int nblk = (NPAD) / 32; constexpr int cnt = ((Kk) / 64) * nblk; \
        if (r < cnt) { const int kb = r / nblk, nb = r % nblk, n0 = 32 * nb; tr_item(SRC, LDW, NVALID, (bf16*)(ws + (DST)), LDT, 64 * kb, n0, (ROWMAP), (DCOL), scr, lane); continue; } r -= cnt; }
    constexpr int N_TR = 2 * (32 * 176) + 88 * 64 + 32 * 184 + 2 * (32 * 64) + 256 + 2 * (16 * 64) + 32 * 64 + 32 * 16 + 32 * 32 + 8 * 64 + 2 * (32 * 176) + 88 * 64;
    for (int it = gw; it < N_TR; it += NGW) {
        int r = it;
        TRM(in[2], 2048, 5632, 5632, 5632, WS_W_GU1, 2048, 256 * (n0 >> 7) + (n0 & 127), 0)
        TRM(in[3], 2048, 5632, 5632, 5632, WS_W_GU1, 2048, 256 * (n0 >> 7) + 128 + (n0 & 127), 0)
        TRM(in[4], 5632, 2048, 2048, 2048, WS_W_D1, 5632, n0, 0)
        TRM(in[5], 2048, 5712, 5712, 5888, WS_W_IN, 2048, n0, 0)
        TRM(in[11], 2048, 2048, 2048, 2048, WS_W_G, 2048, 256 * (n0 >> 7) + (n0 & 127), 0)
        TRM(in[11] + (size_t)2048 * 2048, 2048, 2048, 2048, 2048, WS_W_G, 2048, 256 * (n0 >> 7) + 128 + (n0 & 127), 0)
        if (r < 256) { const int h = r >> 5, rr = r & 31, kb = rr >> 2, nb = rr & 3;
            tr_item(in[10] + (size_t)h * 512 * 128, 128, 128, (bf16*)(ws + WS_W_UVP), 1024, 64 * kb, 32 * nb, (h >> 1) * 256 + (h & 1) * 128 + 32 * nb, (h & 1) * 512, scr, lane); continue; } r -= 256;
        TRM(in[13], 1024, 2048, 2048, 2048, WS_W_A, 1024, n0, 0)
        TRM(in[14], 1024, 2048, 2048, 2048, WS_W_B, 1024, n0, 0)
        TRM(in[15], 2048, 2048, 2048, 2048, WS_W_MO, 2048, n0, 0)
        TRM(in[16], 2048, 512, 512, 512, WS_W_MQ, 2048, n0, 0)
        TRM(in[17], 2048, 1024, 1024, 1024, WS_W_MKV, 2048, n0, 0)
        TRM(in[18], 512, 2048, 2048, 2048, WS_W_MOUT, 512, n0, 0)
        TRM(in[19], 2048, 5632, 5632, 5632, WS_W_GU2, 2048, 256 * (n0 >> 7) + (n0 & 127), 0)
        TRM(in[20], 2048, 5632, 5632, 5632, WS_W_GU2, 2048, 256 * (n0 >> 7) + 128 + (n0 & 127), 0)
        TRM(in[21], 5632, 2048, 2048, 2048, WS_W_D2, 5632, n0, 0)
    }
#undef TRM
    for (int rw = gw; rw < 1024; rw += NGW) { const int e = (rw >> 7) & 1; *((GAS v4u*)((bf16*)(ws + WS_W_UVP) + (size_t)rw * 1024 + (1 - e) * 512) + lane) = (v4u){0u, 0u, 0u, 0u}; }
    for (int it = gw; it < (M * D) / 512; it += NGW) cvt_item(in[0], (bf16*)(ws + WS_X16), it, lane);
    for (int it = gw; it < (BATCH * MEMT * D) / 512; it += NGW) cvt_item(in[1], (bf16*)(ws + WS_MEM16), it, lane);
    for (int it = gw; it < (8 * 512 * 128) / 512; it += NGW) cvt_item(in[9], (bf16*)(ws + WS_W_UK), it, lane);
}

__device__ __forceinline__ void ln_phase(float* zx, bf16* x16, const float* g, const float* b, int gw, int NGW, int lane) {
    f32x4 gv[8], bv[8];
#pragma unroll
    for (int j = 0; j < 8; ++j) { gv[j] = *((const GAS f32x4*)g + lane + 64 * j); bv[j] = *((const GAS f32x4*)b + lane + 64 * j); }
    for (int m = gw; m < M; m += NGW) {
        GAS f32x4* xr = (GAS f32x4*)(zx + (size_t)m * D) + lane;
        f32x4 v[8]; float s = 0.f;
#pragma unroll
        for (int j = 0; j < 8; ++j) { v[j] = xr[64 * j]; s += (v[j].x + v[j].y) + (v[j].z + v[j].w); }
        const float mean = wave_sum(s) * (1.f / D); float s2 = 0.f;
#pragma unroll
        for (int j = 0; j < 8; ++j) { v[j] = v[j] - mean; s2 += (v[j].x * v[j].x + v[j].y * v[j].y) + (v[j].z * v[j].z + v[j].w * v[j].w); }
        const float rstd = 1.f / sqrtf(wave_sum(s2) * (1.f / D) + LN_EPS);
#pragma unroll
        for (int j = 0; j < 8; ++j) { v[j] = v[j] * rstd * gv[j] + bv[j]; xr[64 * j] = v[j]; }
        if (x16) { GAS v2u* o8 = (GAS v2u*)(x16 + (size_t)m * D) + lane;
#pragma unroll
            for (int j = 0; j < 8; ++j) o8[64 * j] = (v2u){pk2(v[j].x, v[j].y), pk2(v[j].z, v[j].w)}; }
    }
}
__device__ __forceinline__ void crms_phase(bf16* bc, const float* kvg, int gw, int NGW, int lane) {
    float gg[8];
#pragma unroll
    for (int j = 0; j < 8; ++j) gg[j] = kvg[8 * lane + j];
    for (int m = gw; m < M; m += NGW) {
        GAS v4u* p = (GAS v4u*)(bc + (size_t)m * 512) + lane; const v4u w = *p;
        float x[8] = {blo(w.x), bhi(w.x), blo(w.y), bhi(w.y), blo(w.z), bhi(w.z), blo(w.w), bhi(w.w)}; float s = 0.f;
#pragma unroll
        for (int j = 0; j < 8; ++j) s += x[j] * x[j];
        const float r = 1.f / sqrtf(wave_sum(s) * (1.f / 512.f) + LN_EPS);
#pragma unroll
        for (int j = 0; j < 8; ++j) x[j] = x[j] * r * gg[j];
        *p = (v4u){pk2(x[0], x[1]), pk2(x[2], x[3]), pk2(x[4], x[5]), pk2(x[6], x[7])};
    }
}

__device__ __forceinline__ void diff_attn_simple(LAS unsigned char* lds, const bf16* AQ, const bf16* AK, const bf16* AV, bf16* YA, const float* dlam, const float* subg, int vcu, int G) {
    const int tid = threadIdx.x, lane = tid & 63, wave = __builtin_amdgcn_readfirstlane(tid >> 6);
    LAS bf16* Qs = (LAS bf16*)(lds);
    LAS bf16* Ks = (LAS bf16*)(lds + 16384);
    LAS bf16* Vs = (LAS bf16*)(lds + 32768);
    LAS float* Sx = (LAS float*)(lds + 49152);
    LAS float* Mx = (LAS float*)(lds + 49152 + 33280);
    LAS float* Lx = Mx + 128; LAS float* Fx = Lx + 128; LAS float* Lam = Fx + 128;
    if (wave == 0) { float a = dlam[lane] * dlam[64 + lane], b = dlam[128 + lane] * dlam[192 + lane]; a = wave_sum(a); b = wave_sum(b); if (lane == 0) Lam[0] = __expf(a) - __expf(b) + LAMBDA_INIT; }
    __syncthreads();
    const float lam = Lam[0];
    const int srow = tid >> 3, schunk = tid & 7;
    const int comp = wave >> 2, kg = wave & 3, sq = lane;
    const int pq = tid >> 3, eg = tid & 7;
    for (int j = vcu; j < 2048; j += G) {
        const int w = j & 255, i = j >> 8, bh = w >> 3, s = w & 7;
        const int qc = (i & 1) ? 16 * (i >> 1) + 15 - s : 16 * (i >> 1) + s;
        const int b = bh >> 3, h = bh & 7;
        const float slope = 1.0f / (float)(2 << h);
        const size_t rowbase = (size_t)b * SEQ; const int q0 = qc * 64;
        { const GAS v4u* src = (const GAS v4u*)(AQ + (rowbase + q0 + srow) * 1024 + h * 128 + schunk * 16); LAS v4u* dst = (LAS v4u*)(Qs + srow * 128 + schunk * 16); dst[0] = src[0]; dst[1] = src[1]; }
        if (tid < 128) { Mx[tid] = -INFINITY; Lx[tid] = 0.f; }
        __syncthreads();
        float qf[64];
#pragma unroll
        for (int d = 0; d < 64; d += 2) { const unsigned wv = *(const LAS unsigned*)(Qs + sq * 128 + comp * 64 + d); qf[d] = blo(wv) * 0.125f; qf[d + 1] = bhi(wv) * 0.125f; }
        float o0[16], o1[16];
#pragma unroll
        for (int e = 0; e < 16; ++e) { o0[e] = 0.f; o1[e] = 0.f; }
        for (int kt = 0; kt <= qc; ++kt) {
            { const GAS v4u* ksrc = (const GAS v4u*)(AK + (rowbase + kt * 64 + srow) * 1024 + h * 128 + schunk * 16); LAS v4u* kd = (LAS v4u*)(Ks + srow * 128 + schunk * 16); kd[0] = ksrc[0]; kd[1] = ksrc[1];
              const GAS v4u* vsrc = (const GAS v4u*)(AV + (rowbase + kt * 64 + srow) * 1024 + h * 128 + schunk * 16); LAS v4u* vd = (LAS v4u*)(Vs + srow * 128 + schunk * 16); vd[0] = vsrc[0]; vd[1] = vsrc[1]; }
            __syncthreads();
            for (int kk = 0; kk < 16; ++kk) {
                const int k = kg * 16 + kk; const LAS v4u* kr = (const LAS v4u*)(Ks + k * 128 + comp * 64); float dot = 0.f;
#pragma unroll
                for (int c = 0; c < 8; ++c) { const v4u wv = kr[c];
                    dot += qf[8 * c + 0] * blo(wv.x) + qf[8 * c + 1] * bhi(wv.x) + qf[8 * c + 2] * blo(wv.y) + qf[8 * c + 3] * bhi(wv.y)
                         + qf[8 * c + 4] * blo(wv.z) + qf[8 * c + 5] * bhi(wv.z) + qf[8 * c + 6] * blo(wv.w) + qf[8 * c + 7] * bhi(wv.w); }
                const int dist = (q0 + sq) - (kt * 64 + k);
                Sx[(comp * 64 + sq) * 65 + k] = dot - slope * (float)(dist < 0 ? -dist : dist);
            }
            __syncthreads();
            if (tid < 128) {
                LAS float* row = Sx + tid * 65; const float mo = Mx[tid]; float mx = mo;
                for (int k = 0; k < 64; ++k) mx = fmaxf(mx, row[k]);
                const float f = __expf(mo - mx); float sum = 0.f;
                for (int k = 0; k < 64; ++k) { const float p = __expf(row[k] - mx); row[k] = p; sum += p; }
                Lx[tid] = Lx[tid] * f + sum; Mx[tid] = mx; Fx[tid] = f;
            }
            __syncthreads();
            { const float f0 = Fx[pq], f1 = Fx[64 + pq];
#pragma unroll
              for (int e = 0; e < 16; ++e) { o0[e] *= f0; o1[e] *= f1; }
              for (int k = 0; k < 64; ++k) {
                  const float p0 = Sx[pq * 65 + k], p1 = Sx[(64 + pq) * 65 + k];
                  const LAS v4u* vr = (const LAS v4u*)(Vs + k * 128 + eg * 16); const v4u a = vr[0], c = vr[1];
                  const float v[16] = {blo(a.x), bhi(a.x), blo(a.y), bhi(a.y), blo(a.z), bhi(a.z), blo(a.w), bhi(a.w), blo(c.x), bhi(c.x), blo(c.y), bhi(c.y), blo(c.z), bhi(c.z), blo(c.w), bhi(c.w)};
#pragma unroll
                  for (int e = 0; e < 16; ++e) { o0[e] += p0 * v[e]; o1[e] += p1 * v[e]; }
              } }
            __syncthreads();
        }
        { const float il0 = 1.f / Lx[pq], il1 = lam / Lx[64 + pq]; float a[16]; float ss = 0.f;
#pragma unroll
          for (int e = 0; e < 16; ++e) { a[e] = o0[e] * il0 - o1[e] * il1; ss += a[e] * a[e]; }
          ss += __shfl_xor(ss, 1); ss += __shfl_xor(ss, 2); ss += __shfl_xor(ss, 4);
          const float r = (1.0f - LAMBDA_INIT) / sqrtf(ss * (1.f / 128.f) + LN_EPS);
#pragma unroll
          for (int e = 0; e < 16; ++e) a[e] = a[e] * r * subg[eg * 16 + e];
          GAS v4u* dst = (GAS v4u*)(YA + (rowbase + q0 + pq) * 1024 + h * 128 + eg * 16);
          dst[0] = (v4u){pk2(a[0], a[1]), pk2(a[2], a[3]), pk2(a[4], a[5]), pk2(a[6], a[7])}; dst[1] = (v4u){pk2(a[8], a[9]), pk2(a[10], a[11]), pk2(a[12], a[13]), pk2(a[14], a[15])}; }
        __syncthreads();
    }
}

__device__ __forceinline__ unsigned okey(float f) { const unsigned u = __float_as_uint(f); return (u & 0x80000000u) ? ~u : (u | 0x80000000u); }
__device__ __forceinline__ void indexer_topk(const bf16* IQ, const bf16* IKW, unsigned short* IDX, int* NCNT, int gw, int NGW, int lane) {
    const int r32 = lane & 31, hi = lane >> 5;
    for (int p = gw; p < M / 2; p += NGW) {
        const int c64 = p & 63, b = p >> 11, pic = (p >> 6) & 31;
        const int chunk = (b & 1) ? 63 - c64 : c64;
        const int t0 = b * SEQ + chunk * 64 + 2 * pic;
        const int ngroups = 2 * (chunk + 1);
        bf16x8 a[4];
#pragma unroll
        for (int ks = 0; ks < 4; ++ks) a[ks] = *(const GAS bf16x8*)(IQ + (size_t)(t0 + (r32 >> 4)) * 1024 + (r32 & 15) * 64 + ks * 16 + 8 * hi);
        float wv[16];
#pragma unroll
        for (int r = 0; r < 16; ++r) { const int row = (r & 3) + 8 * (r >> 2) + 4 * hi; wv[r] = bf2f(IKW[(size_t)(t0 + (row >> 4)) * 256 + 64 + (row & 15)]); }
        unsigned key[128];
#pragma unroll
        for (int g = 0; g < 128; ++g) {
            if (g < ngroups) {
                const bf16* kp = IKW + (size_t)(b * SEQ + 32 * g + r32) * 256 + 8 * hi;
                bf16x8 bk[4];
#pragma unroll
                for (int ks = 0; ks < 4; ++ks) bk[ks] = *(const GAS bf16x8*)(kp + ks * 16);
                f32x16 acc = {0.f, 0.f, 0.f, 0.f, 0.f, 0.f, 0.f, 0.f, 0.f, 0.f, 0.f, 0.f, 0.f, 0.f, 0.f, 0.f};
#pragma unroll
                for (int ks = 0; ks < 4; ++ks) acc = __builtin_amdgcn_mfma_f32_32x32x16_bf16(a[ks], bk[ks], acc, 0, 0, 0);
                float s0 = 0.f, s1 = 0.f;
#pragma unroll
                for (int r = 0; r < 8; ++r) { s0 += wv[r] * fmaxf(acc[r], 0.f); s1 += wv[8 + r] * fmaxf(acc[8 + r], 0.f); }
                s0 += __shfl_xor(s0, 32); s1 += __shfl_xor(s1, 32);
                key[g] = okey(hi ? s1 : s0);
            } else key[g] = 0u;
        }
        unsigned T = 0u;
        if (chunk >= 4) {
            bool done = false;
#pragma nounroll
            for (int bit = 31; bit >= 0; --bit) {
                if (__all(done ? 1 : 0)) break;
                const unsigned trial = T | (1u << bit);
                int cnt = 0;
#pragma unroll
                for (int g = 0; g < 128; ++g) cnt += (key[g] >= trial) ? 1 : 0;
                cnt += __shfl_xor(cnt, 1); cnt += __shfl_xor(cnt, 2); cnt += __shfl_xor(cnt, 4); cnt += __shfl_xor(cnt, 8); cnt += __shfl_xor(cnt, 16);
                if (!done && cnt >= 256) { T = trial; if (cnt == 256) done = true; }
            }
        }
        int base = 0;
        unsigned short* ip = IDX + (size_t)(t0 + hi) * 256;
#pragma unroll
        for (int g = 0; g < 128; ++g) {
            if (g < ngroups) {
                const bool sel = key[g] >= T;
                const unsigned long long mk = __ballot(sel ? 1 : 0);
                const unsigned mh = hi ? (unsigned)(mk >> 32) : (unsigned)mk;
                const int pos = base + __popc(mh & ((1u << r32) - 1u));
                if (sel && pos < 256) ip[pos] = (unsigned short)(32 * g + r32);
                base += __popc(mh);
            }
        }
        if (r32 == 0) NCNT[t0 + hi] = base < 256 ? base : 256;
    }
}

__device__ __forceinline__ void dsa_simple(LAS unsigned char* lds, bf16* QL, const bf16* C, const unsigned short* IDX, const int* NCNT, int gw, int NGW, int wave, int lane) {
    LAS float* Ls = (LAS float*)(lds + wave * 8192);
    const float scale = 0.08838834764831845f;
    for (int t = gw; t < M; t += NGW) {
        const int b = t >> 12, tpos = t & (SEQ - 1); const int n = NCNT[t];
        float q[8][8];
#pragma unroll
        for (int h = 0; h < 8; ++h) { const v4u w = *((const GAS v4u*)(QL + (size_t)t * 4096 + h * 512) + lane);
            q[h][0] = blo(w.x); q[h][1] = bhi(w.x); q[h][2] = blo(w.y); q[h][3] = bhi(w.y); q[h][4] = blo(w.z); q[h][5] = bhi(w.z); q[h][6] = blo(w.w); q[h][7] = bhi(w.w); }
        const unsigned short* ip = IDX + (size_t)t * 256;
        for (int k = 0; k < n; ++k) {
            const int s = ip[k];
            const v4u w = *((const GAS v4u*)(C + ((size_t)b * SEQ + s) * 512) + lane);
            const float cv[8] = {blo(w.x), bhi(w.x), blo(w.y), bhi(w.y), blo(w.z), bhi(w.z), blo(w.w), bhi(w.w)};
            float part[8];
#pragma unroll
            for (int h = 0; h < 8; ++h) { float d = 0.f;
#pragma unroll
                for (int j = 0; j < 8; ++j) d += q[h][j] * cv[j];
                part[h] = wave_sum(d); }
            const int dist = tpos - s; const float ad = (float)(dist < 0 ? -dist : dist);
            float mine = part[0];
#pragma unroll
            for (int h = 1; h < 8; ++h) mine = (lane == h) ? part[h] : mine;
            if (lane < 8) Ls[k * 8 + lane] = mine * scale - ad / (float)(2 << lane);
        }
        LDS_WAIT(); asm volatile("" ::: "memory");
        { const int h = lane >> 3, sub = lane & 7; float mx = -INFINITY;
          for (int k = sub; k < n; k += 8) mx = fmaxf(mx, Ls[k * 8 + h]);
          mx = fmaxf(mx, __shfl_xor(mx, 1)); mx = fmaxf(mx, __shfl_xor(mx, 2)); mx = fmaxf(mx, __shfl_xor(mx, 4));
          float sum = 0.f;
          for (int k = sub; k < n; k += 8) { const float pz = __expf(Ls[k * 8 + h] - mx); Ls[k * 8 + h] = pz; sum += pz; }
          sum += __shfl_xor(sum, 1); sum += __shfl_xor(sum, 2); sum += __shfl_xor(sum, 4);
          LDS_WAIT(); asm volatile("" ::: "memory");
          float acc[8][8];
#pragma unroll
          for (int hh = 0; hh < 8; ++hh)
#pragma unroll
              for (int j = 0; j < 8; ++j) acc[hh][j] = 0.f;
          for (int k = 0; k < n; ++k) {
              const int s = ip[k];
              const v4u w = *((const GAS v4u*)(C + ((size_t)b * SEQ + s) * 512) + lane);
              const float cv[8] = {blo(w.x), bhi(w.x), blo(w.y), bhi(w.y), blo(w.z), bhi(w.z), blo(w.w), bhi(w.w)};
              const f32x4 pa = *(const LAS f32x4*)(Ls + k * 8), pb = *(const LAS f32x4*)(Ls + k * 8 + 4);
              const float pp[8] = {pa.x, pa.y, pa.z, pa.w, pb.x, pb.y, pb.z, pb.w};
#pragma unroll
              for (int hh = 0; hh < 8; ++hh)
#pragma unroll
                  for (int j = 0; j < 8; ++j) acc[hh][j] += pp[hh] * cv[j];
          }
          const float inv = 1.f / sum;
#pragma unroll
          for (int hh = 0; hh < 8; ++hh) { const float ih = __shfl(inv, hh * 8);
              *((GAS v4u*)(QL + (size_t)t * 4096 + hh * 512) + lane) = (v4u){pk2(acc[hh][0] * ih, acc[hh][1] * ih), pk2(acc[hh][2] * ih, acc[hh][3] * ih), pk2(acc[hh][4] * ih, acc[hh][5] * ih), pk2(acc[hh][6] * ih, acc[hh][7] * ih)}; }
        }
        LDS_WAIT(); asm volatile("" ::: "memory");
    }
}

__device__ __forceinline__ void memattn_simple(LAS unsigned char* lds, const bf16* QM, const bf16* KV, bf16* OM, int gw, int NGW, int wave, int lane) {
    LAS float* Ls = (LAS float*)(lds + wave * 4096);
    const float scale = 0.08838834764831845f;
    const int h = lane >> 4, sub = lane & 15;
    for (int t = gw; t < M; t += NGW) {
        const int b = t >> 12;
        const v4u wq = *((const GAS v4u*)(QM + (size_t)t * 512) + lane);
        const float q[8] = {blo(wq.x), bhi(wq.x), blo(wq.y), bhi(wq.y), blo(wq.z), bhi(wq.z), blo(wq.w), bhi(wq.w)};
        const bf16* kvb = KV + (size_t)b * MEMT * 1024;
        for (int m = 0; m < MEMT; ++m) {
            const v4u w = *((const GAS v4u*)(kvb + (size_t)m * 1024) + lane);
            float d = q[0] * blo(w.x) + q[1] * bhi(w.x) + q[2] * blo(w.y) + q[3] * bhi(w.y) + q[4] * blo(w.z) + q[5] * bhi(w.z) + q[6] * blo(w.w) + q[7] * bhi(w.w);
            d += __shfl_xor(d, 1); d += __shfl_xor(d, 2); d += __shfl_xor(d, 4); d += __shfl_xor(d, 8);
            if (sub == 0) Ls[h * 256 + m] = d * scale;
        }
        LDS_WAIT(); asm volatile("" ::: "memory");
        float mx = -INFINITY;
        for (int m = sub; m < MEMT; m += 16) mx = fmaxf(mx, Ls[h * 256 + m]);
        mx = fmaxf(mx, __shfl_xor(mx, 1)); mx = fmaxf(mx, __shfl_xor(mx, 2)); mx = fmaxf(mx, __shfl_xor(mx, 4)); mx = fmaxf(mx, __shfl_xor(mx, 8));
        float sum = 0.f;
        for (int m = sub; m < MEMT; m += 16) { const float pz = __expf(Ls[h * 256 + m] - mx); Ls[h * 256 + m] = pz; sum += pz; }
        sum += __shfl_xor(sum, 1); sum += __shfl_xor(sum, 2); sum += __shfl_xor(sum, 4); sum += __shfl_xor(sum, 8);
        LDS_WAIT(); asm volatile("" ::: "memory");
        float acc[8] = {0.f, 0.f, 0.f, 0.f, 0.f, 0.f, 0.f, 0.f};
        for (int m = 0; m < MEMT; ++m) {
            const float pz = Ls[h * 256 + m];
            const v4u w = *((const GAS v4u*)(kvb + (size_t)m * 1024 + 512) + lane);
            acc[0] += pz * blo(w.x); acc[1] += pz * bhi(w.x); acc[2] += pz * blo(w.y); acc[3] += pz * bhi(w.y); acc[4] += pz * blo(w.z); acc[5] += pz * bhi(w.z); acc[6] += pz * blo(w.w); acc[7] += pz * bhi(w.w);
        }
        const float inv = 1.f / sum;
        *((GAS v4u*)(OM + (size_t)t * 512) + lane) = (v4u){pk2(acc[0] * inv, acc[1] * inv), pk2(acc[2] * inv, acc[3] * inv), pk2(acc[4] * inv, acc[5] * inv), pk2(acc[6] * inv, acc[7] * inv)};
        LDS_WAIT(); asm volatile("" ::: "memory");
    }
}

constexpr int N_PHASES = 21;
struct Args { const float* in[24]; float* out; unsigned char* ws; int ph_lo, ph_hi; };
__global__ void __launch_bounds__(NWAVES * 64, 2) mk_fwd(Args args) {
    extern __shared__ __attribute__((aligned(16))) unsigned char lds_raw[];
    LAS unsigned char* lds = (LAS unsigned char*)lds_raw;
    volatile LAS unsigned* MISC = (volatile LAS unsigned*)(lds + MISC_OFF);
    const int tid = threadIdx.x, lane = tid & 63, wave = __builtin_amdgcn_readfirstlane(tid >> 6);
    const int G = gridDim.x, bx = blockIdx.x;
    const int vcu = (G % 8 == 0) ? (bx % 8) * (G / 8) + bx / 8 : bx;
    const int gw = vcu * NWAVES + wave, NGW = G * NWAVES;
    unsigned char* ws = args.ws;
    gu32* ctl = (gu32*)(ws + WS_CTL);
    for (int u = tid; u < (LDS_BYTES - LDSCTL_OFF) / 4; u += NWAVES * 64) ((LAS unsigned*)(lds + LDSCTL_OFF))[u] = 0u;
    __syncthreads();
    const bool one = (args.ph_hi - args.ph_lo) > 1;
    XcdBarrier bar; bar.bar = (unsigned*)(ctl + CW_BAR); bar.x = 0; bar.st = nullptr;
    if (one) bar = xcd_barrier_post((unsigned*)(ctl + CW_BAR), MISC + 8);
    const int lo = args.ph_lo, hi = args.ph_hi;
#define IN(k) (lo <= (k) && (k) < hi)
#define SEAM(k) do { if (IN(k) && IN((k) + 1)) xcd_barrier(bar); } while (0)
    bf16* const X16 = (bf16*)(ws + WS_X16); bf16* const HB = (bf16*)(ws + WS_H);
    float* const out = args.out;
    const float* const ln_g = args.in[22]; const float* const ln_b = args.in[23];
    using namespace pg8;

    if (IN(0)) { p0_prologue(args.in, ws, lds, gw, NGW, wave, lane); }
    SEAM(0);
    if (IN(1)) { Gemm g{X16, (const bf16*)(ws + WS_W_GU1), D, D, D, 0, 0}; StaticOrder S; S.init(M, 2 * FF, G, bx); EpiSwiGLU E{HB, FF}; gemm_phase<EpiSwiGLU, StaticOrder, true>(lds + RING_OFF, g, S, E); }
    SEAM(1);
    if (IN(2)) { Gemm g{HB, (const bf16*)(ws + WS_W_D1), FF, FF, FF, 0, 0}; StaticOrder S; S.init(M, D, G, bx); EpiRes E{args.in[0], out, D, ALPHA, 0.5f}; gemm_phase<EpiRes, StaticOrder, true>(lds + RING_OFF, g, S, E); }
    SEAM(2);
    if (IN(3)) ln_phase(out, X16, ln_g, ln_b, gw, NGW, lane);
    SEAM(3);
    if (IN(4)) {
        { Gemm g{X16, (const bf16*)(ws + WS_W_IN), D, D, D, 0, 0}; StaticOrder S; S.init(M, N_IN, G, bx);
          EpiInProj E{(bf16*)(ws + WS_AQ), (bf16*)(ws + WS_AK), (bf16*)(ws + WS_AV), (bf16*)(ws + WS_BQ), (bf16*)(ws + WS_BC), (bf16*)(ws + WS_IQ), (bf16*)(ws + WS_IKW)};
          gemm_phase<EpiInProj, StaticOrder, true>(lds + RING_OFF, g, S, E); }
        { Gemm g{(const bf16*)(ws + WS_MEM16), (const bf16*)(ws + WS_W_MKV), D, D, D, 0, 0}; StaticOrder S; S.init(BATCH * MEMT, 1024, G, bx); EpiBf16 E{(bf16*)(ws + WS_KVMEM), 1024};
          gemm_phase<EpiBf16, StaticOrder, true>(lds + RING_OFF, g, S, E); }
    }
    SEAM(4);
    if (IN(5)) {
        { Gemm g{(const bf16*)(ws + WS_BQ), (const bf16*)(ws + WS_W_UK), 1024, 128, 128, 1, 128}; StaticOrder S; S.init(M, 4096, G, bx); EpiBf16 E{(bf16*)(ws + WS_QLAT), 4096};
          gemm_phase<EpiBf16, StaticOrder, true>(lds + RING_OFF, g, S, E); }
        crms_phase((bf16*)(ws + WS_BC), args.in[8], gw, NGW, lane);
    }
    SEAM(5);
    if (IN(6)) diff_attn_simple(lds, (const bf16*)(ws + WS_AQ), (const bf16*)(ws + WS_AK), (const bf16*)(ws + WS_AV), (bf16*)(ws + WS_AQ), args.in[6], args.in[7], vcu, G);
    SEAM(6);
    if (IN(7)) indexer_topk((const bf16*)(ws + WS_IQ), (const bf16*)(ws + WS_IKW), (unsigned short*)(ws + WS_IDX), (int*)(ws + WS_NCNT), gw, NGW, lane);
    SEAM(7);
    if (IN(8)) dsa_simple(lds, (bf16*)(ws + WS_QLAT), (const bf16*)(ws + WS_BC), (const unsigned short*)(ws + WS_IDX), (const int*)(ws + WS_NCNT), gw, NGW, wave, lane);
    SEAM(8);
    if (IN(9)) { Gemm g{(const bf16*)(ws + WS_QLAT), (const bf16*)(ws + WS_W_UVP), 4096, 1024, 1024, 0, 1024}; StaticOrder S; S.init(M, 1024, G, bx); EpiBf16 E{(bf16*)(ws + WS_YB), 1024};
        gemm_phase<EpiBf16, StaticOrder, true>(lds + RING_OFF, g, S, E); }
    SEAM(9);
    if (IN(10)) {
        { Gemm g{(const bf16*)(ws + WS_AQ), (const bf16*)(ws + WS_W_A), 1024, 1024, 1024, 0, 0}; StaticOrder S; S.init(M, D, G, bx); EpiBf16 E{(bf16*)(ws + WS_TA), D}; gemm_phase<EpiBf16, StaticOrder, true>(lds + RING_OFF, g, S, E); }
        { Gemm g{(const bf16*)(ws + WS_YB), (const bf16*)(ws + WS_W_B), 1024, 1024, 1024, 0, 0}; StaticOrder S; S.init(M, D, G, bx); EpiBf16 E{(bf16*)(ws + WS_TB), D}; gemm_phase<EpiBf16, StaticOrder, true>(lds + RING_OFF, g, S, E); }
    }
    SEAM(10);
    if (IN(11)) { Gemm g{X16, (const bf16*)(ws + WS_W_G), D, D, D, 0, 0}; StaticOrder S; S.init(M, 2 * D, G, bx);
        EpiGateMerge E{(const bf16*)(ws + WS_TA), (const bf16*)(ws + WS_TB), (bf16*)(ws + WS_TA), D, args.in[12], args.in[12] + D};
        gemm_phase<EpiGateMerge, StaticOrder, true>(lds + RING_OFF, g, S, E); }
    SEAM(11);
    if (IN(12)) { Gemm g{(const bf16*)(ws + WS_TA), (const bf16*)(ws + WS_W_MO), D, D, D, 0, 0}; StaticOrder S; S.init(M, D, G, bx); EpiRes E{out, out, D, ALPHA, 1.0f}; gemm_phase<EpiRes, StaticOrder, true>(lds + RING_OFF, g, S, E); }
    SEAM(12);
    if (IN(13)) ln_phase(out, X16, ln_g + D, ln_b + D, gw, NGW, lane);
    SEAM(13);
    if (IN(14)) { Gemm g{X16, (const bf16*)(ws + WS_W_MQ), D, D, D, 0, 0}; StaticOrder S; S.init(M, 512, G, bx); EpiBf16 E{(bf16*)(ws + WS_QM), 512}; gemm_phase<EpiBf16, StaticOrder, true>(lds + RING_OFF, g, S, E); }
    SEAM(14);
    if (IN(15)) memattn_simple(lds, (const bf16*)(ws + WS_QM), (const bf16*)(ws + WS_KVMEM), (bf16*)(ws + WS_OM), gw, NGW, wave, lane);
    SEAM(15);
    if (IN(16)) { Gemm g{(const bf16*)(ws + WS_OM), (const bf16*)(ws + WS_W_MOUT), 512, 512, 512, 0, 0}; StaticOrder S; S.init(M, D, G, bx); EpiRes E{out, out, D, ALPHA, 1.0f}; gemm_phase<EpiRes, StaticOrder, true>(lds + RING_OFF, g, S, E); }
    SEAM(16);
    if (IN(17)) ln_phase(out, X16, ln_g + 2 * D, ln_b + 2 * D, gw, NGW, lane);
    SEAM(17);
    if (IN(18)) { Gemm g{X16, (const bf16*)(ws + WS_W_GU2), D, D, D, 0, 0}; StaticOrder S; S.init(M, 2 * FF, G, bx); EpiSwiGLU E{HB, FF}; gemm_phase<EpiSwiGLU, StaticOrder, true>(lds + RING_OFF, g, S, E); }
    SEAM(18);
    if (IN(19)) { Gemm g{HB, (const bf16*)(ws + WS_W_D2), FF, FF, FF, 0, 0}; StaticOrder S; S.init(M, D, G, bx); EpiRes E{out, out, D, ALPHA, 0.5f}; gemm_phase<EpiRes, StaticOrder, true>(lds + RING_OFF, g, S, E); }
    SEAM(19);
    if (IN(20)) ln_phase(out, nullptr, ln_g + 3 * D, ln_b + 3 * D, gw, NGW, lane);
#undef IN
#undef SEAM
}

extern "C" void kernel_launch(void* const* d_in, const int* in_sizes, int n_in, void* d_out, int out_size, void* d_ws, size_t ws_size, hipStream_t stream) {
    static int grid = 0;
    if (grid == 0) {
        if (n_in != 24 || in_sizes[0] != M * D || out_size != M * D || ws_size < WS_END) { fprintf(stderr, "kernel_launch: unexpected shapes (n_in %d, in0 %d, out %d, ws %zu); nothing launched\n", n_in, n_in > 0 ? in_sizes[0] : -1, out_size, ws_size); grid = -1; return; }
        int dev = 0, cus = 0, per_cu = 0;
        if (hipGetDevice(&dev) != hipSuccess || hipDeviceGetAttribute(&cus, hipDeviceAttributeMultiprocessorCount, dev) != hipSuccess) { grid = -1; return; }
        if (hipFuncSetAttribute((const void*)mk_fwd, hipFuncAttributeMaxDynamicSharedMemorySize, LDS_BYTES) != hipSuccess) { fprintf(stderr, "kernel_launch: hipFuncSetAttribute failed\n"); grid = -1; return; }
        if (hipOccupancyMaxActiveBlocksPerMultiprocessor(&per_cu, (const void*)mk_fwd, NWAVES * 64, LDS_BYTES) != hipSuccess || per_cu < 1)
            fprintf(stderr, "kernel_launch: note: the occupancy query reports %d workgroups per CU\n", per_cu);
        (void)hipGetLastError();
        grid = cus;
    }
    if (grid < 0) return;
    if (hipMemsetAsync((char*)d_ws + WS_CTL, 0, CTL_ZERO_BYTES, stream) != hipSuccess) return;
    Args a{};
    for (int i = 0; i < 24; ++i) a.in[i] = (const float*)d_in[i];
    a.out = (float*)d_out; a.ws = (unsigned char*)d_ws;
#if MK_ONE_LAUNCH
    a.ph_lo = 0; a.ph_hi = N_PHASES;
    hipLaunchKernelGGL(mk_fwd, dim3(grid), dim3(NWAVES * 64), LDS_BYTES, stream, a);
#else
    for (int p = 0; p < N_PHASES; ++p) { a.ph_lo = p; a.ph_hi = p + 1; hipLaunchKernelGGL(mk_fwd, dim3(grid), dim3(NWAVES * 64), LDS_BYTES, stream, a); }
#endif
}
```

```cpp
#include <hip/hip_runtime.h>
#include <cstdio>
#include <cstdint>

#ifndef MK_ONE_LAUNCH
#define MK_ONE_LAUNCH 1
#endif

namespace pg8 {
#define PG8_LAS __attribute__((address_space(3)))
typedef unsigned short bf16_t;
typedef short bf16x8 __attribute__((ext_vector_type(8)));
typedef float f32x4 __attribute__((ext_vector_type(4)));
typedef unsigned u32x4 __attribute__((ext_vector_type(4)));
constexpr int BM = 256, BK = 64, HALF = 128, HTB = HALF * BK * 2  , STAGE_BYTES = 8 * HTB, NXCD = 8, WGM = 8;

__host__ __device__ __forceinline__ int lds_byte(int r, int c) { const int st = (r >> 4) * 2 + (c >> 5), rr = r & 15, cc = c & 31, ob = rr * 64 + cc * 2; return st * 1024 + (ob ^ (((ob >> 9) & 1) << 5)); }
__host__ __device__ __forceinline__ void stage_rc(int b, int& R, int& C) { const int st = b / 1024, sb = b % 1024, swz = sb ^ (((sb >> 9) & 1) << 5); R = (st >> 1) * 16 + swz / 64; C = (st & 1) * 32 + (swz % 64) / 2; }
__host__ __device__ __forceinline__ int perm32(int rho) { const int n = rho >> 4, i = rho & 15; return 8 * (i >> 2) + 4 * n + (i & 3); }

struct Unit { int pm, pn; };
struct Gemm { const bf16_t* A; const bf16_t* Bt; int lda, ldb, K, a_shift, a_mul; };

struct StaticOrder {
    int nM, nN, nwg, G, c;
    __host__ __device__ void init(int M, int N, int G_, int c_) { nM = M / BM; nN = N / BM; nwg = nM * nN; G = G_; c = c_; }
    __host__ __device__ bool next(int i, Unit& u) const {
        const long L = (long)i * G + c; if (L >= nwg) return false;
        int wgid = (int)L; { const int q = nwg / NXCD, r = nwg % NXCD, xcd = wgid % NXCD, off = wgid / NXCD; wgid = (xcd < r ? xcd * (q + 1) : r * (q + 1) + (xcd - r) * q) + off; }
        const int nig = WGM * nN, gid = wgid / nig, fm = gid * WGM, gsz = (nM - fm) < WGM ? (nM - fm) : WGM;
        u.pm = fm + ((wgid % nig) % gsz); u.pn = (wgid % nig) / gsz; return true;
    }
    __device__ __forceinline__ void a_ready(const Unit&) const {}
    __device__ __forceinline__ void done(const Unit&) const {}
};

__device__ __forceinline__ unsigned cvt_pk_bf16(float lo, float hi) { unsigned r; asm volatile("v_cvt_pk_bf16_f32 %0, %1, %2" : "=v"(r) : "v"(lo), "v"(hi)); return r; }
__device__ __forceinline__ float bflo(unsigned w) { return __uint_as_float(w << 16); }
__device__ __forceinline__ float bfhi(unsigned w) { return __uint_as_float(w & 0xffff0000u); }
__device__ __forceinline__ float sigmoidf_fast(float x) { return __builtin_amdgcn_rcpf(1.0f + __builtin_amdgcn_exp2f(-1.4426950408889634f * x)); }

struct EpiBf16 {
    static constexpr bool PERM = true, AFTER_DRAIN = false;
    bf16_t* O; int ldc;
    __device__ __forceinline__ void operator()(const f32x4 (&acc)[2][2][4][2], const Unit& u, int wr, int wc, int fr, int fq) const {
        const int row0 = u.pm * BM + wr * 64 + fr, col0 = u.pn * BM + wc * 32 + 8 * fq;
#pragma unroll
        for (int ai = 0; ai < 2; ++ai)
#pragma unroll
            for (int m = 0; m < 4; ++m) { bf16_t* rowp = O + (size_t)(row0 + ai * HALF + m * 16) * ldc + col0;
#pragma unroll
                for (int bj = 0; bj < 2; ++bj) { const f32x4 v0 = acc[ai][bj][m][0], v1 = acc[ai][bj][m][1];
                    u32x4 w; w.x = cvt_pk_bf16(v0[0], v0[1]); w.y = cvt_pk_bf16(v0[2], v0[3]); w.z = cvt_pk_bf16(v1[0], v1[1]); w.w = cvt_pk_bf16(v1[2], v1[3]);
                    *(u32x4*)(rowp + bj * HALF) = w; } }
    }
};
struct EpiInProj {
    static constexpr bool PERM = true, AFTER_DRAIN = false;
    bf16_t *aq, *ak, *av, *bq, *bc, *iq, *ikw;
    __device__ __forceinline__ void operator()(const f32x4 (&acc)[2][2][4][2], const Unit& u, int wr, int wc, int fr, int fq) const {
        bf16_t* base; int ldc, colt; const int pn = u.pn;
        if (pn < 4) { base = aq; ldc = 1024; colt = pn * 256; }
        else if (pn < 8) { base = ak; ldc = 1024; colt = (pn - 4) * 256; }
        else if (pn < 12) { base = av; ldc = 1024; colt = (pn - 8) * 256; }
        else if (pn < 16) { base = bq; ldc = 1024; colt = (pn - 12) * 256; }
        else if (pn < 18) { base = bc; ldc = 512; colt = (pn - 16) * 256; }
        else if (pn < 22) { base = iq; ldc = 1024; colt = (pn - 18) * 256; }
        else { base = ikw; ldc = 256; colt = 0; }
        const int row0 = u.pm * BM + wr * 64 + fr, col0 = colt + wc * 32 + 8 * fq;
#pragma unroll
        for (int ai = 0; ai < 2; ++ai)
#pragma unroll
            for (int m = 0; m < 4; ++m) { bf16_t* rowp = base + (size_t)(row0 + ai * HALF + m * 16) * ldc + col0;
#pragma unroll
                for (int bj = 0; bj < 2; ++bj) { const f32x4 v0 = acc[ai][bj][m][0], v1 = acc[ai][bj][m][1];
                    u32x4 w; w.x = cvt_pk_bf16(v0[0], v0[1]); w.y = cvt_pk_bf16(v0[2], v0[3]); w.z = cvt_pk_bf16(v1[0], v1[1]); w.w = cvt_pk_bf16(v1[2], v1[3]);
                    *(u32x4*)(rowp + bj * HALF) = w; } }
    }
};
struct EpiSwiGLU {
    static constexpr bool PERM = true, AFTER_DRAIN = false;
    bf16_t* O; int ldc;
    __device__ __forceinline__ void operator()(const f32x4 (&acc)[2][2][4][2], const Unit& u, int wr, int wc, int fr, int fq) const {
        const int row0 = u.pm * BM + wr * 64 + fr, col0 = u.pn * HALF + wc * 32 + 8 * fq;
#pragma unroll
        for (int ai = 0; ai < 2; ++ai)
#pragma unroll
            for (int m = 0; m < 4; ++m) { bf16_t* rowp = O + (size_t)(row0 + ai * HALF + m * 16) * ldc + col0;
                float h[8];
#pragma unroll
                for (int n = 0; n < 2; ++n)
#pragma unroll
                    for (int j = 0; j < 4; ++j) { const float g = acc[ai][0][m][n][j], up = acc[ai][1][m][n][j]; h[4 * n + j] = g * sigmoidf_fast(g) * up; }
                u32x4 w; w.x = cvt_pk_bf16(h[0], h[1]); w.y = cvt_pk_bf16(h[2], h[3]); w.z = cvt_pk_bf16(h[4], h[5]); w.w = cvt_pk_bf16(h[6], h[7]);
                *(u32x4*)rowp = w; }
    }
};
struct EpiGateMerge {
    static constexpr bool PERM = true, AFTER_DRAIN = false;
    const bf16_t* ta; const bf16_t* tb; bf16_t* O; int ldc; const float* b0; const float* b1;
    __device__ __forceinline__ void operator()(const f32x4 (&acc)[2][2][4][2], const Unit& u, int wr, int wc, int fr, int fq) const {
        const int row0 = u.pm * BM + wr * 64 + fr, col0 = u.pn * HALF + wc * 32 + 8 * fq;
        float bb0[8], bb1[8];
#pragma unroll
        for (int j = 0; j < 8; ++j) { bb0[j] = b0[col0 + j]; bb1[j] = b1[col0 + j]; }
#pragma unroll
        for (int ai = 0; ai < 2; ++ai)
#pragma unroll
            for (int m = 0; m < 4; ++m) { const size_t off = (size_t)(row0 + ai * HALF + m * 16) * ldc + col0;
                const u32x4 a = *(const u32x4*)(ta + off), b = *(const u32x4*)(tb + off);
                const float av[8] = {bflo(a.x), bfhi(a.x), bflo(a.y), bfhi(a.y), bflo(a.z), bfhi(a.z), bflo(a.w), bfhi(a.w)};
                const float bv[8] = {bflo(b.x), bfhi(b.x), bflo(b.y), bfhi(b.y), bflo(b.z), bfhi(b.z), bflo(b.w), bfhi(b.w)};
                float h[8];
#pragma unroll
                for (int n = 0; n < 2; ++n)
#pragma unroll
                    for (int j = 0; j < 4; ++j) { const int e = 4 * n + j; h[e] = sigmoidf_fast(acc[ai][0][m][n][j] + bb0[e]) * av[e] + sigmoidf_fast(acc[ai][1][m][n][j] + bb1[e]) * bv[e]; }
                u32x4 w; w.x = cvt_pk_bf16(h[0], h[1]); w.y = cvt_pk_bf16(h[2], h[3]); w.z = cvt_pk_bf16(h[4], h[5]); w.w = cvt_pk_bf16(h[6], h[7]);
                *(u32x4*)(O + off) = w; }
    }
};
struct EpiRes {
    static constexpr bool PERM = false, AFTER_DRAIN = false;
    const float* res; float* out; int ldc; float alpha, s;
    __device__ __forceinline__ void operator()(const f32x4 (&acc)[2][2][4][2], const Unit& u, int wr, int wc, int fr, int fq) const {
        const int col0 = u.pn * BM + wc * 32 + 4 * fq;
#pragma unroll
        for (int ai = 0; ai < 2; ++ai)
#pragma unroll
            for (int m = 0; m < 4; ++m) { const size_t off = (size_t)(u.pm * BM + ai * HALF + wr * 64 + m * 16 + fr) * ldc + col0;
#pragma unroll
                for (int bj = 0; bj < 2; ++bj)
#pragma unroll
                    for (int n = 0; n < 2; ++n) { const f32x4 r = *(const f32x4*)(res + off + bj * HALF + n * 16); *(f32x4*)(out + off + bj * HALF + n * 16) = r * alpha + acc[ai][bj][m][n] * s; }
                if (m & 1) asm volatile("" ::: "memory"); }
    }
};

template <class Epi, class Sched, bool ALIGN_EPI>
__device__ __forceinline__ void gemm_phase(PG8_LAS unsigned char* lds, const Gemm g, const Sched& S, const Epi& E) {
    const int tid = threadIdx.x, wid = __builtin_amdgcn_readfirstlane(tid >> 6), lane = tid & 63, wr = wid >> 2, wc = wid & 3, fr = lane & 15, fq = lane >> 4;
    const int K = g.K, nt = K / BK;
    unsigned voffA[2], voffB[2];
#pragma unroll
    for (int i = 0; i < 2; ++i) { int R, C; stage_rc(tid * 16 + i * 8192, R, C); const int Rb = Epi::PERM ? ((R & ~31) + perm32(R & 31)) : R;
        voffA[i] = (unsigned)(R * g.lda + C) * 2u; voffB[i] = (unsigned)(Rb * g.ldb + C) * 2u; }
    const size_t kstep = (size_t)(BK * 2);
    const size_t hstepA = (size_t)HALF * g.lda * 2, hstepB = (size_t)HALF * g.ldb * 2;
    const size_t tstepA = 2 * hstepA, tstepB = 2 * hstepB;
    const unsigned ldsw = (unsigned)wid * 1024u;
    const int aoff = lds_byte(wr * 64 + fr, fq * 8), boff = lds_byte(wc * 32 + fr, fq * 8);
#define PG8_UA(u) ((const char*)g.A + (size_t)(u).pm * tstepA + (size_t)(((u).pn >> g.a_shift) * g.a_mul) * 2)
#define PG8_UB(u) ((const char*)g.Bt + (size_t)(u).pn * tstepB)
#define PG8_SA(b, h) (((b) * 2 + (h)) * HTB)
#define PG8_SB(b, h) ((4 + (b) * 2 + (h)) * HTB)
#define PG8_STAGE(bufoff, gbase, voff) do { _Pragma("unroll") for (int _i = 0; _i < 2; ++_i) \
        __builtin_amdgcn_global_load_lds((const unsigned*)((const char*)(gbase) + (voff)[_i]), (PG8_LAS unsigned*)(lds + (bufoff) + ldsw + _i * 8192), 16, 0, 0); } while (0)
#define PG8_LDA(dst, b, h) do { _Pragma("unroll") for (int m = 0; m < 4; ++m) _Pragma("unroll") for (int k = 0; k < 2; ++k) dst[m][k] = *(const PG8_LAS bf16x8*)(lds + PG8_SA(b, h) + aoff + m * 2048 + k * 1024); } while (0)
#define PG8_LDB(dst, b, h) do { _Pragma("unroll") for (int n = 0; n < 2; ++n) _Pragma("unroll") for (int k = 0; k < 2; ++k) dst[n][k] = *(const PG8_LAS bf16x8*)(lds + PG8_SB(b, h) + boff + n * 2048 + k * 1024); } while (0)
#define PG8_MMA(ai, bj, At, Bt) do { __builtin_amdgcn_s_setprio(1); _Pragma("unroll") for (int m = 0; m < 4; ++m) _Pragma("unroll") for (int n = 0; n < 2; ++n) _Pragma("unroll") for (int k = 0; k < 2; ++k) \
        acc[ai][bj][m][n] = __builtin_amdgcn_mfma_f32_16x16x32_bf16(Bt[n][k], At[m][k], acc[ai][bj][m][n], 0, 0, 0); __builtin_amdgcn_s_setprio(0); } while (0)
#define PG8_WAIT_V(n) asm volatile("s_waitcnt vmcnt(" #n ")" ::: "memory")
#define PG8_WAIT_L(n) asm volatile("s_waitcnt lgkmcnt(" #n ")" ::: "memory")
#define PG8_BAR __builtin_amdgcn_s_barrier()
#define PG8_SCHED __builtin_amdgcn_sched_barrier(0)
    Unit cur, nxt; int ui = 0;
    if (!S.next(0, cur)) return;
    f32x4 acc[2][2][4][2];
#pragma unroll
    for (int a = 0; a < 2; ++a)
#pragma unroll
        for (int b = 0; b < 2; ++b)
#pragma unroll
            for (int m = 0; m < 4; ++m)
#pragma unroll
                for (int n = 0; n < 2; ++n) acc[a][b][m][n] = (f32x4){0.f, 0.f, 0.f, 0.f};
    bf16x8 At[4][2], B0[2][2], B1[2][2];
    const char* cA = PG8_UA(cur); const char* cB = PG8_UB(cur);
    S.a_ready(cur);
    PG8_STAGE(PG8_SB(0, 0), cB, voffB); PG8_STAGE(PG8_SB(0, 1), cB + hstepB, voffB); PG8_STAGE(PG8_SA(0, 0), cA, voffA); PG8_STAGE(PG8_SA(0, 1), cA + hstepA, voffA);
    if (wr == 1) PG8_BAR;
    PG8_WAIT_V(2); PG8_BAR;
    PG8_STAGE(PG8_SB(1, 0), cB + kstep, voffB); PG8_STAGE(PG8_SA(1, 0), cA + kstep, voffA); PG8_STAGE(PG8_SB(1, 1), cB + hstepB + kstep, voffB);
    PG8_WAIT_V(6); PG8_BAR;
    for (;;) {
        const bool has_next = S.next(ui + 1, nxt);
        const char* nA = has_next ? PG8_UA(nxt) : cA; const char* nB = has_next ? PG8_UB(nxt) : cB;
        for (int t = 0; t < nt; t += 2) {
            const bool last = (t == nt - 2);
            const char* a1 = cA + (size_t)(t + 1) * kstep;
            const char* a2 = last ? nA : cA + (size_t)(t + 2) * kstep; const char* b2 = last ? nB : cB + (size_t)(t + 2) * kstep;
            const char* a3 = a2 + kstep; const char* b3 = b2 + kstep;
            if (last && has_next) S.a_ready(nxt);
            PG8_LDB(B0, 0, 0); PG8_LDB(B1, 0, 1); PG8_SCHED; PG8_LDA(At, 0, 0); PG8_STAGE(PG8_SA(1, 1), a1 + hstepA, voffA);
            PG8_WAIT_V(8); PG8_WAIT_L(0); PG8_BAR; PG8_MMA(0, 0, At, B0); PG8_MMA(0, 1, At, B1); PG8_BAR; PG8_SCHED;
            PG8_LDA(At, 0, 1); PG8_STAGE(PG8_SB(0, 0), b2, voffB); PG8_STAGE(PG8_SB(0, 1), b2 + hstepB, voffB); PG8_STAGE(PG8_SA(0, 0), a2, voffA);
            PG8_WAIT_V(8); PG8_WAIT_L(0); PG8_BAR; PG8_MMA(1, 0, At, B0); PG8_MMA(1, 1, At, B1); PG8_BAR; PG8_SCHED;
            PG8_LDB(B0, 1, 0); PG8_LDB(B1, 1, 1); PG8_SCHED; PG8_LDA(At, 1, 0); PG8_STAGE(PG8_SA(0, 1), a2 + hstepA, voffA);
            PG8_WAIT_V(8); PG8_WAIT_L(0); PG8_BAR; PG8_MMA(0, 0, At, B0); PG8_MMA(0, 1, At, B1); PG8_BAR; PG8_SCHED;
            PG8_LDA(At, 1, 1); PG8_STAGE(PG8_SB(1, 0), b3, voffB); PG8_STAGE(PG8_SB(1, 1), b3 + hstepB, voffB); PG8_STAGE(PG8_SA(1, 0), a3, voffA);
            PG8_WAIT_V(8); PG8_WAIT_L(0); PG8_BAR; PG8_MMA(1, 0, At, B0); PG8_MMA(1, 1, At, B1); PG8_BAR; PG8_SCHED;
        }
        if constexpr (ALIGN_EPI) { if (wr == 0) PG8_BAR; }
        E(acc, cur, wr, wc, fr, fq); S.done(cur);
        if (!has_next) break;
#pragma unroll
        for (int a = 0; a < 2; ++a)
#pragma unroll
            for (int b = 0; b < 2; ++b)
#pragma unroll
                for (int m = 0; m < 4; ++m)
#pragma unroll
                    for (int n = 0; n < 2; ++n) acc[a][b][m][n] = (f32x4){0.f, 0.f, 0.f, 0.f};
        cur = nxt; cA = nA; cB = nB; ++ui;
        if constexpr (ALIGN_EPI) { if (wr == 1) PG8_BAR; }
    }
    PG8_WAIT_V(0);
    if constexpr (!ALIGN_EPI) { if (wr == 0) PG8_BAR; }
    PG8_BAR;
#undef PG8_UA
#undef PG8_UB
#undef PG8_SA
#undef PG8_SB
#undef PG8_STAGE
#undef PG8_LDA
#undef PG8_LDB
#undef PG8_MMA
#undef PG8_WAIT_V
#undef PG8_WAIT_L
#undef PG8_BAR
#undef PG8_SCHED
}
}

constexpr int NWAVES = 8;
constexpr int BATCH = 4, SEQ = 4096, D = 2048, FF = 5632, M = BATCH * SEQ;
constexpr int N_IN = 5888;
constexpr int MEMT = 256;
constexpr float LN_EPS = 1e-5f;
constexpr float ALPHA = 1.189207115002721f;
constexpr float LAMBDA_INIT = 0.2f;

constexpr size_t MiB = 1u << 20;
constexpr size_t WS_CTL = 0, CTL_ZERO_BYTES = 1 * MiB;
constexpr size_t WS_W_IN = 2 * MiB;
constexpr size_t WS_W_G = 25 * MiB;
constexpr size_t WS_W_UK = 41 * MiB;
constexpr size_t WS_W_UVP = 42 * MiB;
constexpr size_t WS_W_A = 44 * MiB;
constexpr size_t WS_W_B = 48 * MiB;
constexpr size_t WS_W_MO = 52 * MiB;
constexpr size_t WS_W_MQ = 60 * MiB;
constexpr size_t WS_W_MKV = 62 * MiB;
constexpr size_t WS_W_MOUT = 66 * MiB;
constexpr size_t WS_MEM16 = 68 * MiB;
constexpr size_t WS_KVMEM = 72 * MiB;
constexpr size_t WS_W_GU2 = 74 * MiB;
constexpr size_t WS_W_D2 = 118 * MiB;
constexpr size_t WS_X16 = 140 * MiB;
constexpr size_t WS_MIX = 204 * MiB;
constexpr size_t WS_W_GU1 = 204 * MiB;
constexpr size_t WS_W_D1 = 248 * MiB;
constexpr size_t WS_H = 270 * MiB;
constexpr size_t WS_AQ = WS_MIX + 0 * MiB, WS_AK = WS_MIX + 32 * MiB, WS_AV = WS_MIX + 64 * MiB, WS_BQ = WS_MIX + 96 * MiB;
constexpr size_t WS_BC = WS_MIX + 128 * MiB;
constexpr size_t WS_IQ = WS_MIX + 144 * MiB;
constexpr size_t WS_IKW = WS_MIX + 176 * MiB;
constexpr size_t WS_QLAT = WS_MIX + 184 * MiB;
constexpr size_t WS_IDX = WS_AK;
constexpr size_t WS_NCNT = WS_AK + 8 * MiB;
constexpr size_t WS_YB = WS_BQ;
constexpr size_t WS_TA = WS_QLAT, WS_TB = WS_QLAT + 64 * MiB;
constexpr size_t WS_QM = WS_AQ, WS_OM = WS_AQ + 16 * MiB;
constexpr size_t WS_END = WS_MIX + 312 * MiB;
static_assert(WS_H + (size_t)M * FF * 2 <= WS_END && WS_QLAT + (size_t)M * 4096 * 2 <= WS_END, "d_ws map");
constexpr int CW_BAR = 4096;

constexpr int RING_OFF = 0, RING_BYTES = 131072;
constexpr int LDSCTL_OFF = RING_BYTES, MISC_OFF = LDSCTL_OFF + 320;
constexpr int LDS_BYTES = 147456;
static_assert(MISC_OFF + 128 <= LDS_BYTES, "LDS map");

#define GAS __attribute__((address_space(1)))
#define LAS __attribute__((address_space(3)))
typedef unsigned short bf16;
typedef unsigned v4u __attribute__((ext_vector_type(4)));
typedef unsigned v2u __attribute__((ext_vector_type(2)));
typedef float f32x4 __attribute__((ext_vector_type(4)));
typedef float f32x16 __attribute__((ext_vector_type(16)));
typedef short bf16x8 __attribute__((ext_vector_type(8)));
typedef GAS unsigned gu32;
#define RLX_AGENT __ATOMIC_RELAXED, __HIP_MEMORY_SCOPE_AGENT
#define LDS_WAIT() asm volatile("s_waitcnt lgkmcnt(0)" ::: "memory")
#define VM_WAIT() asm volatile("s_waitcnt vmcnt(0)" ::: "memory")
__device__ __forceinline__ unsigned f2bf(float f) { unsigned u = __builtin_bit_cast(unsigned, f); return (u + 0x7fffu + ((u >> 16) & 1u)) >> 16; }
__device__ __forceinline__ unsigned pk2(float lo, float hi) { return f2bf(lo) | (f2bf(hi) << 16); }
__device__ __forceinline__ float bf2f(unsigned short v) { return __uint_as_float((unsigned)v << 16); }
__device__ __forceinline__ float blo(unsigned w) { return __uint_as_float(w << 16); }
__device__ __forceinline__ float bhi(unsigned w) { return __uint_as_float(w & 0xffff0000u); }
__device__ __forceinline__ float wave_sum(float v) {
#pragma unroll
    for (int o = 1; o < 64; o <<= 1) v += __shfl_xor(v, o);
    return v;
}

#define XB_TMO      128
#define XB_XCNT(j)  (256  + 64 * (j))
#define XB_XSUB(j)  (1280 + 64 * (j))
#define XB_XGEN(j)  (2304 + 64 * (j))
#define XB_TOP      3328
#define XB_TOPGEN   3392
#define XCD_BAR_WORDS 3456
#define XB_SPIN_CAP (1u << 18)

__device__ __forceinline__ unsigned xb_ld(unsigned* p)              { return __hip_atomic_load(p, __ATOMIC_RELAXED, __HIP_MEMORY_SCOPE_AGENT); }
__device__ __forceinline__ unsigned xb_add(unsigned* p, unsigned v) { return __hip_atomic_fetch_add(p, v, __ATOMIC_RELAXED, __HIP_MEMORY_SCOPE_AGENT); }
__device__ __forceinline__ unsigned xb_xcc_id() { return (unsigned)__builtin_amdgcn_s_getreg((3 << 11) | 20) & 0xFu; }
#define XB_SPIN(cond, bar) do { unsigned _sp = 0; while (cond) { __builtin_amdgcn_s_sleep(1); \
    if ((++_sp & 255u) == 0u) { if (xb_ld(&(bar)[XB_TMO])) break; if (_sp > XB_SPIN_CAP) { atomicAdd(&(bar)[XB_TMO], 1u); break; } } } } while (0)

struct XcdBarrier {
    unsigned* bar; unsigned x;
    volatile LAS unsigned* st;
};

__device__ __forceinline__ XcdBarrier xcd_barrier_post(unsigned* bar, volatile LAS unsigned* st) {
    XcdBarrier b; b.bar = bar; b.x = xb_xcc_id(); b.st = st;
    if (threadIdx.x == 0) (void)xb_add(&bar[XB_XCNT(b.x)], 1u);
    return b;
}
__device__ __forceinline__ void xcd_barrier_complete(unsigned* bar, unsigned x, unsigned& nloc, unsigned& nx) {
    const unsigned G = gridDim.x * gridDim.y * gridDim.z;
    unsigned sum, cnt, mine, sp = 0u;
    for (;;) {
        sum = 0u; cnt = 0u; mine = 0u;
#pragma unroll
        for (unsigned j = 0; j < 16; ++j) { const unsigned c = xb_ld(&bar[XB_XCNT(j)]); sum += c; cnt += (c > 0u) ? 1u : 0u; mine = (j == x) ? c : mine; }
        if (sum == G) break;
        __builtin_amdgcn_s_sleep(1);
        if ((++sp & 255u) == 0u) { if (xb_ld(&bar[XB_TMO])) break; if (sp > XB_SPIN_CAP) { atomicAdd(&bar[XB_TMO], 1u); break; } }
    }
    nloc = mine > 0u ? mine : 1u; nx = cnt > 0u ? cnt : 1u;
}

__device__ __forceinline__ void xcd_barrier(const XcdBarrier& b) {
    asm volatile("s_waitcnt vmcnt(0)" ::: "memory");
    __syncthreads();
    if (threadIdx.x == 0) {
        unsigned* bar = b.bar;
        __builtin_amdgcn_s_waitcnt(0);
        unsigned nloc = b.st[0], nx = b.st[1];
        if (nloc == 0u) { xcd_barrier_complete(bar, b.x, nloc, nx); b.st[0] = nloc; b.st[1] = nx; }
        const unsigned old = xb_add(&bar[XB_XSUB(b.x)], 1u);
        const unsigned gen = old / nloc;
        if (old + 1u == (gen + 1u) * nloc) {
            __builtin_amdgcn_fence(__ATOMIC_RELEASE, "agent");
            asm volatile("s_waitcnt vmcnt(0)" ::: "memory");
            const unsigned og = xb_add(&bar[XB_TOP], 1u);
            const unsigned tg = og / nx;
            if (og + 1u == (tg + 1u) * nx) xb_add(&bar[XB_TOPGEN], 1u);
            else XB_SPIN(xb_ld(&bar[XB_TOPGEN]) == tg, bar);
            __builtin_amdgcn_fence(__ATOMIC_ACQUIRE, "agent");
            xb_add(&bar[XB_XGEN(b.x)], 1u);
            asm volatile("s_waitcnt vmcnt(0)" ::: "memory");
        } else {
            XB_SPIN(xb_ld(&bar[XB_XGEN(b.x)]) == gen, bar);
            __builtin_amdgcn_fence(__ATOMIC_ACQUIRE, "agent");
            asm volatile("s_waitcnt vmcnt(0)" ::: "memory");
        }
    }
    __syncthreads();
}

__device__ __forceinline__ void tr_item(const float* W, int ldw, int nvalid, bf16* WT, int ldt, int k0, int n0, int drow0, int dcol0, LAS float* scr, int lane) {
    const int n = n0 + (lane & 31); const bool ok = n < nvalid;
#pragma unroll 8
    for (int i = 0; i < 32; ++i) { const int kk = 2 * i + (lane >> 5); scr[kk * 33 + (lane & 31)] = ok ? W[(size_t)(k0 + kk) * ldw + n] : 0.f; }
    LDS_WAIT(); asm volatile("" ::: "memory");
    const int c = lane & 7;
#pragma unroll
    for (int j = 0; j < 4; ++j) { const int nn = (lane >> 3) + 8 * j; const LAS float* s = scr + (8 * c) * 33 + nn;
        v4u o; o.x = pk2(s[0 * 33], s[1 * 33]); o.y = pk2(s[2 * 33], s[3 * 33]); o.z = pk2(s[4 * 33], s[5 * 33]); o.w = pk2(s[6 * 33], s[7 * 33]);
        *(GAS v4u*)(WT + (size_t)(drow0 + nn) * ldt + dcol0 + k0 + 8 * c) = o; }
    LDS_WAIT(); asm volatile("" ::: "memory");
}
__device__ __forceinline__ void cvt_item(const float* src, bf16* dst, int item, int lane) {
    const GAS f32x4* s = (const GAS f32x4*)(src + (size_t)item * 512) + 2 * lane; const f32x4 a = s[0], b = s[1];
    v4u o; o.x = pk2(a.x, a.y); o.y = pk2(a.z, a.w); o.z = pk2(b.x, b.y); o.w = pk2(b.z, b.w);
    *((GAS v4u*)(dst + (size_t)item * 512) + lane) = o;
}
__device__ __forceinline__ void p0_prologue(const float* const (&in)[24], unsigned char* ws, LAS unsigned char* lds, int gw, int NGW, int wave, int lane) {
    LAS float* scr = (LAS float*)(lds + RING_OFF + wave * 16384);
#define TRM(SRC, Kk, LDW, NVALID, NPAD, DST, LDT, ROWMAP, DCOL) { constexpr int nblk = (NPAD) / 32; constexpr int cnt = ((Kk) / 64) * nblk; \
        if (r < cnt) { const int kb = r / nblk, nb = r % nblk, n0 = 32 * nb; tr_item(SRC, LDW, NVALID, (bf16*)(ws + (DST)), LDT, 64 * kb, n0, (ROWMAP), (DCOL), scr, lane); continue; } r -= cnt; }
    constexpr int N_TR = 2 * (32 * 176) + 88 * 64 + 32 * 184 + 2 * (32 * 64) + 256 + 2 * (16 * 64) + 32 * 64 + 32 * 16 + 32 * 32 + 8 * 64 + 2 * (32 * 176) + 88 * 64;
    for (int it = gw; it < N_TR; it += NGW) {
        int r = it;
        TRM(in[2], 2048, 5632, 5632, 5632, WS_W_GU1, 2048, 256 * (n0 >> 7) + (n0 & 127), 0)
        TRM(in[3], 2048, 5632, 5632, 5632, WS_W_GU1, 2048, 256 * (n0 >> 7) + 128 + (n0 & 127), 0)
        TRM(in[4], 5632, 2048, 2048, 2048, WS_W_D1, 5632, n0, 0)
        TRM(in[5], 2048, 5712, 5712, 5888, WS_W_IN, 2048, n0, 0)
        TRM(in[11], 2048, 2048, 2048, 2048, WS_W_G, 2048, 256 * (n0 >> 7) + (n0 & 127), 0)
        TRM(in[11] + (size_t)2048 * 2048, 2048, 2048, 2048, 2048, WS_W_G, 2048, 256 * (n0 >> 7) + 128 + (n0 & 127), 0)
        if (r < 256) { const int h = r >> 5, rr = r & 31, kb = rr >> 2, nb = rr & 3;
            tr_item(in[10] + (size_t)h * 512 * 128, 128, 128, (bf16*)(ws + WS_W_UVP), 1024, 64 * kb, 32 * nb, (h >> 1) * 256 + (h & 1) * 128 + 32 * nb, (h & 1) * 512, scr, lane); continue; } r -= 256;
        TRM(in[13], 1024, 2048, 2048, 2048, WS_W_A, 1024, n0, 0)
        TRM(in[14], 1024, 2048, 2048, 2048, WS_W_B, 1024, n0, 0)
        TRM(in[15], 2048, 2048, 2048, 2048, WS_W_MO, 2048, n0, 0)
        TRM(in[16], 2048, 512, 512, 512, WS_W_MQ, 2048, n0, 0)
        TRM(in[17], 2048, 1024, 1024, 1024, WS_W_MKV, 2048, n0, 0)
        TRM(in[18], 512, 2048, 2048, 2048, WS_W_MOUT, 512, n0, 0)
        TRM(in[19], 2048, 5632, 5632, 5632, WS_W_GU2, 2048, 256 * (n0 >> 7) + (n0 & 127), 0)
        TRM(in[20], 2048, 5632, 5632, 5632, WS_W_GU2, 2048, 256 * (n0 >> 7) + 128 + (n0 & 127), 0)
        TRM(in[21], 5632, 2048, 2048, 2048, WS_W_D2, 5632, n0, 0)
    }
#undef TRM
    for (int rw = gw; rw < 1024; rw += NGW) { const int e = (rw >> 7) & 1; *((GAS v4u*)((bf16*)(ws + WS_W_UVP) + (size_t)rw * 1024 + (1 - e) * 512) + lane) = (v4u){0u, 0u, 0u, 0u}; }
    for (int it = gw; it < (M * D) / 512; it += NGW) cvt_item(in[0], (bf16*)(ws + WS_X16), it, lane);
    for (int it = gw; it < (BATCH * MEMT * D) / 512; it += NGW) cvt_item(in[1], (bf16*)(ws + WS_MEM16), it, lane);
    for (int it = gw; it < (8 * 512 * 128) / 512; it += NGW) cvt_item(in[9], (bf16*)(ws + WS_W_UK), it, lane);
}

__device__ __forceinline__ void ln_phase(float* zx, bf16* x16, const float* g, const float* b, int gw, int NGW, int lane) {
    f32x4 gv[8], bv[8];
#pragma unroll
    for (int j = 0; j < 8; ++j) { gv[j] = *((const GAS f32x4*)g + lane + 64 * j); bv[j] = *((const GAS f32x4*)b + lane + 64 * j); }
    for (int m = gw; m < M; m += NGW) {
        GAS f32x4* xr = (GAS f32x4*)(zx + (size_t)m * D) + lane;
        f32x4 v[8]; float s = 0.f;
#pragma unroll
        for (int j = 0; j < 8; ++j) { v[j] = xr[64 * j]; s += (v[j].x + v[j].y) + (v[j].z + v[j].w); }
        const float mean = wave_sum(s) * (1.f / D); float s2 = 0.f;
#pragma unroll
        for (int j = 0; j < 8; ++j) { v[j] = v[j] - mean; s2 += (v[j].x * v[j].x + v[j].y * v[j].y) + (v[j].z * v[j].z + v[j].w * v[j].w); }
        const float rstd = 1.f / sqrtf(wave_sum(s2) * (1.f / D) + LN_EPS);
#pragma unroll
        for (int j = 0; j < 8; ++j) { v[j] = v[j] * rstd * gv[j] + bv[j]; xr[64 * j] = v[j]; }
        if (x16) { GAS v2u* o8 = (GAS v2u*)(x16 + (size_t)m * D) + lane;
#pragma unroll
            for (int j = 0; j < 8; ++j) o8[64 * j] = (v2u){pk2(v[j].x, v[j].y), pk2(v[j].z, v[j].w)}; }
    }
}
__device__ __forceinline__ void crms_phase(bf16* bc, const float* kvg, int gw, int NGW, int lane) {
    float gg[8];
#pragma unroll
    for (int j = 0; j < 8; ++j) gg[j] = kvg[8 * lane + j];
    for (int m = gw; m < M; m += NGW) {
        GAS v4u* p = (GAS v4u*)(bc + (size_t)m * 512) + lane; const v4u w = *p;
        float x[8] = {blo(w.x), bhi(w.x), blo(w.y), bhi(w.y), blo(w.z), bhi(w.z), blo(w.w), bhi(w.w)}; float s = 0.f;
#pragma unroll
        for (int j = 0; j < 8; ++j) s += x[j] * x[j];
        const float r = 1.f / sqrtf(wave_sum(s) * (1.f / 512.f) + LN_EPS);
#pragma unroll
        for (int j = 0; j < 8; ++j) x[j] = x[j] * r * gg[j];
        *p = (v4u){pk2(x[0], x[1]), pk2(x[2], x[3]), pk2(x[4], x[5]), pk2(x[6], x[7])};
    }
}

__device__ __forceinline__ void diff_attn_simple(LAS unsigned char* lds, const bf16* AQ, const bf16* AK, const bf16* AV, bf16* YA, const float* dlam, const float* subg, int vcu, int G) {
    const int tid = threadIdx.x, lane = tid & 63, wave = __builtin_amdgcn_readfirstlane(tid >> 6);
    LAS bf16* Qs = (LAS bf16*)(lds);
    LAS bf16* Ks = (LAS bf16*)(lds + 16384);
    LAS bf16* Vs = (LAS bf16*)(lds + 32768);
    LAS float* Sx = (LAS float*)(lds + 49152);
    LAS float* Mx = (LAS float*)(lds + 49152 + 33280);
    LAS float* Lx = Mx + 128; LAS float* Fx = Lx + 128; LAS float* Lam = Fx + 128;
    if (wave == 0) { float a = dlam[lane] * dlam[64 + lane], b = dlam[128 + lane] * dlam[192 + lane]; a = wave_sum(a); b = wave_sum(b); if (lane == 0) Lam[0] = __expf(a) - __expf(b) + LAMBDA_INIT; }
    __syncthreads();
    const float lam = Lam[0];
    const int srow = tid >> 3, schunk = tid & 7;
    const int comp = wave >> 2, kg = wave & 3, sq = lane;
    const int pq = tid >> 3, eg = tid & 7;
    for (int j = vcu; j < 2048; j += G) {
        const int w = j & 255, i = j >> 8, bh = w >> 3, s = w & 7;
        const int qc = (i & 1) ? 16 * (i >> 1) + 15 - s : 16 * (i >> 1) + s;
        const int b = bh >> 3, h = bh & 7;
        const float slope = 1.0f / (float)(2 << h);
        const size_t rowbase = (size_t)b * SEQ; const int q0 = qc * 64;
        { const GAS v4u* src = (const GAS v4u*)(AQ + (rowbase + q0 + srow) * 1024 + h * 128 + schunk * 16); LAS v4u* dst = (LAS v4u*)(Qs + srow * 128 + schunk * 16); dst[0] = src[0]; dst[1] = src[1]; }
        if (tid < 128) { Mx[tid] = -INFINITY; Lx[tid] = 0.f; }
        __syncthreads();
        float qf[64];
#pragma unroll
        for (int d = 0; d < 64; d += 2) { const unsigned wv = *(const LAS unsigned*)(Qs + sq * 128 + comp * 64 + d); qf[d] = blo(wv) * 0.125f; qf[d + 1] = bhi(wv) * 0.125f; }
        float o0[16], o1[16];
#pragma unroll
        for (int e = 0; e < 16; ++e) { o0[e] = 0.f; o1[e] = 0.f; }
        for (int kt = 0; kt <= qc; ++kt) {
            { const GAS v4u* ksrc = (const GAS v4u*)(AK + (rowbase + kt * 64 + srow) * 1024 + h * 128 + schunk * 16); LAS v4u* kd = (LAS v4u*)(Ks + srow * 128 + schunk * 16); kd[0] = ksrc[0]; kd[1] = ksrc[1];
              const GAS v4u* vsrc = (const GAS v4u*)(AV + (rowbase + kt * 64 + srow) * 1024 + h * 128 + schunk * 16); LAS v4u* vd = (LAS v4u*)(Vs + srow * 128 + schunk * 16); vd[0] = vsrc[0]; vd[1] = vsrc[1]; }
            __syncthreads();
            for (int kk = 0; kk < 16; ++kk) {
                const int k = kg * 16 + kk; const LAS v4u* kr = (const LAS v4u*)(Ks + k * 128 + comp * 64); float dot = 0.f;
#pragma unroll
                for (int c = 0; c < 8; ++c) { const v4u wv = kr[c];
                    dot += qf[8 * c + 0] * blo(wv.x) + qf[8 * c + 1] * bhi(wv.x) + qf[8 * c + 2] * blo(wv.y) + qf[8 * c + 3] * bhi(wv.y)
                         + qf[8 * c + 4] * blo(wv.z) + qf[8 * c + 5] * bhi(wv.z) + qf[8 * c + 6] * blo(wv.w) + qf[8 * c + 7] * bhi(wv.w); }
                const int dist = (q0 + sq) - (kt * 64 + k);
                Sx[(comp * 64 + sq) * 65 + k] = dot - slope * (float)(dist < 0 ? -dist : dist);
            }
            __syncthreads();
            if (tid < 128) {
                LAS float* row = Sx + tid * 65; const float mo = Mx[tid]; float mx = mo;
                for (int k = 0; k < 64; ++k) mx = fmaxf(mx, row[k]);
                const float f = __expf(mo - mx); float sum = 0.f;
                for (int k = 0; k < 64; ++k) { const float p = __expf(row[k] - mx); row[k] = p; sum += p; }
                Lx[tid] = Lx[tid] * f + sum; Mx[tid] = mx; Fx[tid] = f;
            }
            __syncthreads();
            { const float f0 = Fx[pq], f1 = Fx[64 + pq];
#pragma unroll
              for (int e = 0; e < 16; ++e) { o0[e] *= f0; o1[e] *= f1; }
              for (int k = 0; k < 64; ++k) {
                  const float p0 = Sx[pq * 65 + k], p1 = Sx[(64 + pq) * 65 + k];
                  const LAS v4u* vr = (const LAS v4u*)(Vs + k * 128 + eg * 16); const v4u a = vr[0], c = vr[1];
                  const float v[16] = {blo(a.x), bhi(a.x), blo(a.y), bhi(a.y), blo(a.z), bhi(a.z), blo(a.w), bhi(a.w), blo(c.x), bhi(c.x), blo(c.y), bhi(c.y), blo(c.z), bhi(c.z), blo(c.w), bhi(c.w)};
#pragma unroll
                  for (int e = 0; e < 16; ++e) { o0[e] += p0 * v[e]; o1[e] += p1 * v[e]; }
              } }
            __syncthreads();
        }
        { const float il0 = 1.f / Lx[pq], il1 = lam / Lx[64 + pq]; float a[16]; float ss = 0.f;
#pragma unroll
          for (int e = 0; e < 16; ++e) { a[e] = o0[e] * il0 - o1[e] * il1; ss += a[e] * a[e]; }
          ss += __shfl_xor(ss, 1); ss += __shfl_xor(ss, 2); ss += __shfl_xor(ss, 4);
          const float r = (1.0f - LAMBDA_INIT) / sqrtf(ss * (1.f / 128.f) + LN_EPS);
#pragma unroll
          for (int e = 0; e < 16; ++e) a[e] = a[e] * r * subg[eg * 16 + e];
          GAS v4u* dst = (GAS v4u*)(YA + (rowbase + q0 + pq) * 1024 + h * 128 + eg * 16);
          dst[0] = (v4u){pk2(a[0], a[1]), pk2(a[2], a[3]), pk2(a[4], a[5]), pk2(a[6], a[7])}; dst[1] = (v4u){pk2(a[8], a[9]), pk2(a[10], a[11]), pk2(a[12], a[13]), pk2(a[14], a[15])}; }
        __syncthreads();
    }
}

__device__ __forceinline__ unsigned okey(float f) { const unsigned u = __float_as_uint(f); return (u & 0x80000000u) ? ~u : (u | 0x80000000u); }
__device__ __forceinline__ void indexer_topk(const bf16* IQ, const bf16* IKW, unsigned short* IDX, int* NCNT, int gw, int NGW, int lane) {
    const int r32 = lane & 31, hi = lane >> 5;
    for (int p = gw; p < M / 2; p += NGW) {
        const int c64 = p & 63, b = p >> 11, pic = (p >> 6) & 31;
        const int chunk = (b & 1) ? 63 - c64 : c64;
        const int t0 = b * SEQ + chunk * 64 + 2 * pic;
        const int ngroups = 2 * (chunk + 1);
        bf16x8 a[4];
#pragma unroll
        for (int ks = 0; ks < 4; ++ks) a[ks] = *(const GAS bf16x8*)(IQ + (size_t)(t0 + (r32 >> 4)) * 1024 + (r32 & 15) * 64 + ks * 16 + 8 * hi);
        float wv[16];
#pragma unroll
        for (int r = 0; r < 16; ++r) { const int row = (r & 3) + 8 * (r >> 2) + 4 * hi; wv[r] = bf2f(IKW[(size_t)(t0 + (row >> 4)) * 256 + 64 + (row & 15)]); }
        unsigned key[128];
#pragma unroll
        for (int g = 0; g < 128; ++g) {
            if (g < ngroups) {
                const bf16* kp = IKW + (size_t)(b * SEQ + 32 * g + r32) * 256 + 8 * hi;
                bf16x8 bk[4];
#pragma unroll
                for (int ks = 0; ks < 4; ++ks) bk[ks] = *(const GAS bf16x8*)(kp + ks * 16);
                f32x16 acc = {0.f, 0.f, 0.f, 0.f, 0.f, 0.f, 0.f, 0.f, 0.f, 0.f, 0.f, 0.f, 0.f, 0.f, 0.f, 0.f};
#pragma unroll
                for (int ks = 0; ks < 4; ++ks) acc = __builtin_amdgcn_mfma_f32_32x32x16_bf16(a[ks], bk[ks], acc, 0, 0, 0);
                float s0 = 0.f, s1 = 0.f;
#pragma unroll
                for (int r = 0; r < 8; ++r) { s0 += wv[r] * fmaxf(acc[r], 0.f); s1 += wv[8 + r] * fmaxf(acc[8 + r], 0.f); }
                s0 += __shfl_xor(s0, 32); s1 += __shfl_xor(s1, 32);
                key[g] = okey(hi ? s1 : s0);
            } else key[g] = 0u;
        }
        unsigned T = 0u;
        if (chunk >= 4) {
            bool done = false;
#pragma nounroll
            for (int bit = 31; bit >= 0; --bit) {
                if (__all(done ? 1 : 0)) break;
                const unsigned trial = T | (1u << bit);
                int cnt = 0;
#pragma unroll
                for (int g = 0; g < 128; ++g) cnt += (key[g] >= trial) ? 1 : 0;
                cnt += __shfl_xor(cnt, 1); cnt += __shfl_xor(cnt, 2); cnt += __shfl_xor(cnt, 4); cnt += __shfl_xor(cnt, 8); cnt += __shfl_xor(cnt, 16);
                if (!done && cnt >= 256) { T = trial; if (cnt == 256) done = true; }
            }
        }
        int base = 0;
        unsigned short* ip = IDX + (size_t)(t0 + hi) * 256;
#pragma unroll
        for (int g = 0; g < 128; ++g) {
            if (g < ngroups) {
                const bool sel = key[g] >= T;
                const unsigned long long mk = __ballot(sel ? 1 : 0);
                const unsigned mh = hi ? (unsigned)(mk >> 32) : (unsigned)mk;
                const int pos = base + __popc(mh & ((1u << r32) - 1u));
                if (sel && pos < 256) ip[pos] = (unsigned short)(32 * g + r32);
                base += __popc(mh);
            }
        }
        if (r32 == 0) NCNT[t0 + hi] = base < 256 ? base : 256;
    }
}

__device__ __forceinline__ void dsa_simple(LAS unsigned char* lds, bf16* QL, const bf16* C, const unsigned short* IDX, const int* NCNT, int gw, int NGW, int wave, int lane) {
    LAS float* Ls = (LAS float*)(lds + wave * 8192);
    const float scale = 0.08838834764831845f;
    for (int t = gw; t < M; t += NGW) {
        const int b = t >> 12, tpos = t & (SEQ - 1); const int n = NCNT[t];
        float q[8][8];
#pragma unroll
        for (int h = 0; h < 8; ++h) { const v4u w = *((const GAS v4u*)(QL + (size_t)t * 4096 + h * 512) + lane);
            q[h][0] = blo(w.x); q[h][1] = bhi(w.x); q[h][2] = blo(w.y); q[h][3] = bhi(w.y); q[h][4] = blo(w.z); q[h][5] = bhi(w.z); q[h][6] = blo(w.w); q[h][7] = bhi(w.w); }
        const unsigned short* ip = IDX + (size_t)t * 256;
        for (int k = 0; k < n; ++k) {
            const int s = ip[k];
            const v4u w = *((const GAS v4u*)(C + ((size_t)b * SEQ + s) * 512) + lane);
            const float cv[8] = {blo(w.x), bhi(w.x), blo(w.y), bhi(w.y), blo(w.z), bhi(w.z), blo(w.w), bhi(w.w)};
            float part[8];
#pragma unroll
            for (int h = 0; h < 8; ++h) { float d = 0.f;
#pragma unroll
                for (int j = 0; j < 8; ++j) d += q[h][j] * cv[j];
                part[h] = wave_sum(d); }
            const int dist = tpos - s; const float ad = (float)(dist < 0 ? -dist : dist);
            float mine = part[0];
#pragma unroll
            for (int h = 1; h < 8; ++h) mine = (lane == h) ? part[h] : mine;
            if (lane < 8) Ls[k * 8 + lane] = mine * scale - ad / (float)(2 << lane);
        }
        LDS_WAIT(); asm volatile("" ::: "memory");
        { const int h = lane >> 3, sub = lane & 7; float mx = -INFINITY;
          for (int k = sub; k < n; k += 8) mx = fmaxf(mx, Ls[k * 8 + h]);
          mx = fmaxf(mx, __shfl_xor(mx, 1)); mx = fmaxf(mx, __shfl_xor(mx, 2)); mx = fmaxf(mx, __shfl_xor(mx, 4));
          float sum = 0.f;
          for (int k = sub; k < n; k += 8) { const float pz = __expf(Ls[k * 8 + h] - mx); Ls[k * 8 + h] = pz; sum += pz; }
          sum += __shfl_xor(sum, 1); sum += __shfl_xor(sum, 2); sum += __shfl_xor(sum, 4);
          LDS_WAIT(); asm volatile("" ::: "memory");
          float acc[8][8];
#pragma unroll
          for (int hh = 0; hh < 8; ++hh)
#pragma unroll
              for (int j = 0; j < 8; ++j) acc[hh][j] = 0.f;
          for (int k = 0; k < n; ++k) {
              const int s = ip[k];
              const v4u w = *((const GAS v4u*)(C + ((size_t)b * SEQ + s) * 512) + lane);
              const float cv[8] = {blo(w.x), bhi(w.x), blo(w.y), bhi(w.y), blo(w.z), bhi(w.z), blo(w.w), bhi(w.w)};
              const f32x4 pa = *(const LAS f32x4*)(Ls + k * 8), pb = *(const LAS f32x4*)(Ls + k * 8 + 4);
              const float pp[8] = {pa.x, pa.y, pa.z, pa.w, pb.x, pb.y, pb.z, pb.w};
#pragma unroll
              for (int hh = 0; hh < 8; ++hh)
#pragma unroll
                  for (int j = 0; j < 8; ++j) acc[hh][j] += pp[hh] * cv[j];
          }
          const float inv = 1.f / sum;
#pragma unroll
          for (int hh = 0; hh < 8; ++hh) { const float ih = __shfl(inv, hh * 8);
              *((GAS v4u*)(QL + (size_t)t * 4096 + hh * 512) + lane) = (v4u){pk2(acc[hh][0] * ih, acc[hh][1] * ih), pk2(acc[hh][2] * ih, acc[hh][3] * ih), pk2(acc[hh][4] * ih, acc[hh][5] * ih), pk2(acc[hh][6] * ih, acc[hh][7] * ih)}; }
        }
        LDS_WAIT(); asm volatile("" ::: "memory");
    }
}

__device__ __forceinline__ void memattn_simple(LAS unsigned char* lds, const bf16* QM, const bf16* KV, bf16* OM, int gw, int NGW, int wave, int lane) {
    LAS float* Ls = (LAS float*)(lds + wave * 4096);
    const float scale = 0.08838834764831845f;
    const int h = lane >> 4, sub = lane & 15;
    for (int t = gw; t < M; t += NGW) {
        const int b = t >> 12;
        const v4u wq = *((const GAS v4u*)(QM + (size_t)t * 512) + lane);
        const float q[8] = {blo(wq.x), bhi(wq.x), blo(wq.y), bhi(wq.y), blo(wq.z), bhi(wq.z), blo(wq.w), bhi(wq.w)};
        const bf16* kvb = KV + (size_t)b * MEMT * 1024;
        for (int m = 0; m < MEMT; ++m) {
            const v4u w = *((const GAS v4u*)(kvb + (size_t)m * 1024) + lane);
            float d = q[0] * blo(w.x) + q[1] * bhi(w.x) + q[2] * blo(w.y) + q[3] * bhi(w.y) + q[4] * blo(w.z) + q[5] * bhi(w.z) + q[6] * blo(w.w) + q[7] * bhi(w.w);
            d += __shfl_xor(d, 1); d += __shfl_xor(d, 2); d += __shfl_xor(d, 4); d += __shfl_xor(d, 8);
            if (sub == 0) Ls[h * 256 + m] = d * scale;
        }
        LDS_WAIT(); asm volatile("" ::: "memory");
        float mx = -INFINITY;
        for (int m = sub; m < MEMT; m += 16) mx = fmaxf(mx, Ls[h * 256 + m]);
        mx = fmaxf(mx, __shfl_xor(mx, 1)); mx = fmaxf(mx, __shfl_xor(mx, 2)); mx = fmaxf(mx, __shfl_xor(mx, 4)); mx = fmaxf(mx, __shfl_xor(mx, 8));
        float sum = 0.f;
        for (int m = sub; m < MEMT; m += 16) { const float pz = __expf(Ls[h * 256 + m] - mx); Ls[h * 256 + m] = pz; sum += pz; }
        sum += __shfl_xor(sum, 1); sum += __shfl_xor(sum, 2); sum += __shfl_xor(sum, 4); sum += __shfl_xor(sum, 8);
        LDS_WAIT(); asm volatile("" ::: "memory");
        float acc[8] = {0.f, 0.f, 0.f, 0.f, 0.f, 0.f, 0.f, 0.f};
        for (int m = 0; m < MEMT; ++m) {
            const float pz = Ls[h * 256 + m];
            const v4u w = *((const GAS v4u*)(kvb + (size_t)m * 1024 + 512) + lane);
            acc[0] += pz * blo(w.x); acc[1] += pz * bhi(w.x); acc[2] += pz * blo(w.y); acc[3] += pz * bhi(w.y); acc[4] += pz * blo(w.z); acc[5] += pz * bhi(w.z); acc[6] += pz * blo(w.w); acc[7] += pz * bhi(w.w);
        }
        const float inv = 1.f / sum;
        *((GAS v4u*)(OM + (size_t)t * 512) + lane) = (v4u){pk2(acc[0] * inv, acc[1] * inv), pk2(acc[2] * inv, acc[3] * inv), pk2(acc[4] * inv, acc[5] * inv), pk2(acc[6] * inv, acc[7] * inv)};
        LDS_WAIT(); asm volatile("" ::: "memory");
    }
}

constexpr int N_PHASES = 21;
struct Args { const float* in[24]; float* out; unsigned char* ws; int ph_lo, ph_hi; };
__global__ void __launch_bounds__(NWAVES * 64, 2) mk_fwd(Args args) {
    extern __shared__ __attribute__((aligned(16))) unsigned char lds_raw[];
    LAS unsigned char* lds = (LAS unsigned char*)lds_raw;
    volatile LAS unsigned* MISC = (volatile LAS unsigned*)(lds + MISC_OFF);
    const int tid = threadIdx.x, lane = tid & 63, wave = __builtin_amdgcn_readfirstlane(tid >> 6);
    const int G = gridDim.x, bx = blockIdx.x;
    const int vcu = (G % 8 == 0) ? (bx % 8) * (G / 8) + bx / 8 : bx;
    const int gw = vcu * NWAVES + wave, NGW = G * NWAVES;
    unsigned char* ws = args.ws;
    gu32* ctl = (gu32*)(ws + WS_CTL);
    for (int u = tid; u < (LDS_BYTES - LDSCTL_OFF) / 4; u += NWAVES * 64) ((LAS unsigned*)(lds + LDSCTL_OFF))[u] = 0u;
    __syncthreads();
    const bool one = (args.ph_hi - args.ph_lo) > 1;
    XcdBarrier bar; bar.bar = (unsigned*)(ctl + CW_BAR); bar.x = 0; bar.st = nullptr;
    if (one) bar = xcd_barrier_post((unsigned*)(ctl + CW_BAR), MISC + 8);
    const int lo = args.ph_lo, hi = args.ph_hi;
#define IN(k) (lo <= (k) && (k) < hi)
#define SEAM(k) do { if (IN(k) && IN((k) + 1)) xcd_barrier(bar); } while (0)
    bf16* const X16 = (bf16*)(ws + WS_X16); bf16* const HB = (bf16*)(ws + WS_H);
    float* const out = args.out;
    const float* const ln_g = args.in[22]; const float* const ln_b = args.in[23];
    using namespace pg8;

    if (IN(0)) { p0_prologue(args.in, ws, lds, gw, NGW, wave, lane); }
    SEAM(0);
    if (IN(1)) { Gemm g{X16, (const bf16*)(ws + WS_W_GU1), D, D, D, 0, 0}; StaticOrder S; S.init(M, 2 * FF, G, bx); EpiSwiGLU E{HB, FF}; gemm_phase<EpiSwiGLU, StaticOrder, true>(lds + RING_OFF, g, S, E); }
    SEAM(1);
    if (IN(2)) { Gemm g{HB, (const bf16*)(ws + WS_W_D1), FF, FF, FF, 0, 0}; StaticOrder S; S.init(M, D, G, bx); EpiRes E{args.in[0], out, D, ALPHA, 0.5f}; gemm_phase<EpiRes, StaticOrder, true>(lds + RING_OFF, g, S, E); }
    SEAM(2);
    if (IN(3)) ln_phase(out, X16, ln_g, ln_b, gw, NGW, lane);
    SEAM(3);
    if (IN(4)) {
        { Gemm g{X16, (const bf16*)(ws + WS_W_IN), D, D, D, 0, 0}; StaticOrder S; S.init(M, N_IN, G, bx);
          EpiInProj E{(bf16*)(ws + WS_AQ), (bf16*)(ws + WS_AK), (bf16*)(ws + WS_AV), (bf16*)(ws + WS_BQ), (bf16*)(ws + WS_BC), (bf16*)(ws + WS_IQ), (bf16*)(ws + WS_IKW)};
          gemm_phase<EpiInProj, StaticOrder, true>(lds + RING_OFF, g, S, E); }
        { Gemm g{(const bf16*)(ws + WS_MEM16), (const bf16*)(ws + WS_W_MKV), D, D, D, 0, 0}; StaticOrder S; S.init(BATCH * MEMT, 1024, G, bx); EpiBf16 E{(bf16*)(ws + WS_KVMEM), 1024};
          gemm_phase<EpiBf16, StaticOrder, true>(lds + RING_OFF, g, S, E); }
    }
    SEAM(4);
    if (IN(5)) {
        { Gemm g{(const bf16*)(ws + WS_BQ), (const bf16*)(ws + WS_W_UK), 1024, 128, 128, 1, 128}; StaticOrder S; S.init(M, 4096, G, bx); EpiBf16 E{(bf16*)(ws + WS_QLAT), 4096};
          gemm_phase<EpiBf16, StaticOrder, true>(lds + RING_OFF, g, S, E); }
        crms_phase((bf16*)(ws + WS_BC), args.in[8], gw, NGW, lane);
    }
    SEAM(5);
    if (IN(6)) diff_attn_simple(lds, (const bf16*)(ws + WS_AQ), (const bf16*)(ws + WS_AK), (const bf16*)(ws + WS_AV), (bf16*)(ws + WS_AQ), args.in[6], args.in[7], vcu, G);
    SEAM(6);
    if (IN(7)) indexer_topk((const bf16*)(ws + WS_IQ), (const bf16*)(ws + WS_IKW), (unsigned short*)(ws + WS_IDX), (int*)(ws + WS_NCNT), gw, NGW, lane);
    SEAM(7);
    if (IN(8)) dsa_simple(lds, (bf16*)(ws + WS_QLAT), (const bf16*)(ws + WS_BC), (const unsigned short*)(ws + WS_IDX), (const int*)(ws + WS_NCNT), gw, NGW, wave, lane);
    SEAM(8);
    if (IN(9)) { Gemm g{(const bf16*)(ws + WS_QLAT), (const bf16*)(ws + WS_W_UVP), 4096, 1024, 1024, 0, 1024}; StaticOrder S; S.init(M, 1024, G, bx); EpiBf16 E{(bf16*)(ws + WS_YB), 1024};
        gemm_phase<EpiBf16, StaticOrder, true>(lds + RING_OFF, g, S, E); }
    SEAM(9);
    if (IN(10)) {
        { Gemm g{(const bf16*)(ws + WS_AQ), (const bf16*)(ws + WS_W_A), 1024, 1024, 1024, 0, 0}; StaticOrder S; S.init(M, D, G, bx); EpiBf16 E{(bf16*)(ws + WS_TA), D}; gemm_phase<EpiBf16, StaticOrder, true>(lds + RING_OFF, g, S, E); }
        { Gemm g{(const bf16*)(ws + WS_YB), (const bf16*)(ws + WS_W_B), 1024, 1024, 1024, 0, 0}; StaticOrder S; S.init(M, D, G, bx); EpiBf16 E{(bf16*)(ws + WS_TB), D}; gemm_phase<EpiBf16, StaticOrder, true>(lds + RING_OFF, g, S, E); }
    }
    SEAM(10);
    if (IN(11)) { Gemm g{X16, (const bf16*)(ws + WS_W_G), D, D, D, 0, 0}; StaticOrder S; S.init(M, 2 * D, G, bx);
        EpiGateMerge E{(const bf16*)(ws + WS_TA), (const bf16*)(ws + WS_TB), (bf16*)(ws + WS_TA), D, args.in[12], args.in[12] + D};
        gemm_phase<EpiGateMerge, StaticOrder, true>(lds + RING_OFF, g, S, E); }
    SEAM(11);
    if (IN(12)) { Gemm g{(const bf16*)(ws + WS_TA), (const bf16*)(ws + WS_W_MO), D, D, D, 0, 0}; StaticOrder S; S.init(M, D, G, bx); EpiRes E{out, out, D, ALPHA, 1.0f}; gemm_phase<EpiRes, StaticOrder, true>(lds + RING_OFF, g, S, E); }
    SEAM(12);
    if (IN(13)) ln_phase(out, X16, ln_g + D, ln_b + D, gw, NGW, lane);
    SEAM(13);
    if (IN(14)) { Gemm g{X16, (const bf16*)(ws + WS_W_MQ), D, D, D, 0, 0}; StaticOrder S; S.init(M, 512, G, bx); EpiBf16 E{(bf16*)(ws + WS_QM), 512}; gemm_phase<EpiBf16, StaticOrder, true>(lds + RING_OFF, g, S, E); }
    SEAM(14);
    if (IN(15)) memattn_simple(lds, (const bf16*)(ws + WS_QM), (const bf16*)(ws + WS_KVMEM), (bf16*)(ws + WS_OM), gw, NGW, wave, lane);
    SEAM(15);
    if (IN(16)) { Gemm g{(const bf16*)(ws + WS_OM), (const bf16*)(ws + WS_W_MOUT), 512, 512, 512, 0, 0}; StaticOrder S; S.init(M, D, G, bx); EpiRes E{out, out, D, ALPHA, 1.0f}; gemm_phase<EpiRes, StaticOrder, true>(lds + RING_OFF, g, S, E); }
    SEAM(16);
    if (IN(17)) ln_phase(out, X16, ln_g + 2 * D, ln_b + 2 * D, gw, NGW, lane);
    SEAM(17);
    if (IN(18)) { Gemm g{X16, (const bf16*)(ws + WS_W_GU2), D, D, D, 0, 0}; StaticOrder S; S.init(M, 2 * FF, G, bx); EpiSwiGLU E{HB, FF}; gemm_phase<EpiSwiGLU, StaticOrder, true>(lds + RING_OFF, g, S, E); }
    SEAM(18);
    if (IN(19)) { Gemm g{HB, (const bf16*)(ws + WS_W_D2), FF, FF, FF, 0, 0}; StaticOrder S; S.init(M, D, G, bx); EpiRes E{out, out, D, ALPHA, 0.5f}; gemm_phase<EpiRes, StaticOrder, true>(lds + RING_OFF, g, S, E); }
    SEAM(19);
    if (IN(20)) ln_phase(out, nullptr, ln_g + 3 * D, ln_b + 3 * D, gw, NGW, lane);
#undef IN
#undef SEAM
}

extern "C" void kernel_launch(void* const* d_in, const int* in_sizes, int n_in, void* d_out, int out_size, void* d_ws, size_t ws_size, hipStream_t stream) {
    static int grid = 0;
    if (grid == 0) {
        if (n_in != 24 || in_sizes[0] != M * D || out_size != M * D || ws_size < WS_END) { fprintf(stderr, "kernel_launch: unexpected shapes (n_in %d, in0 %d, out %d, ws %zu); nothing launched\n", n_in, n_in > 0 ? in_sizes[0] : -1, out_size, ws_size); grid = -1; return; }
        int dev = 0, cus = 0, per_cu = 0;
        if (hipGetDevice(&dev) != hipSuccess || hipDeviceGetAttribute(&cus, hipDeviceAttributeMultiprocessorCount, dev) != hipSuccess) { grid = -1; return; }
        if (hipFuncSetAttribute((const void*)mk_fwd, hipFuncAttributeMaxDynamicSharedMemorySize, LDS_BYTES) != hipSuccess) { fprintf(stderr, "kernel_launch: hipFuncSetAttribute failed\n"); grid = -1; return; }
        if (hipOccupancyMaxActiveBlocksPerMultiprocessor(&per_cu, (const void*)mk_fwd, NWAVES * 64, LDS_BYTES) != hipSuccess || per_cu < 1)
            fprintf(stderr, "kernel_launch: note: the occupancy query reports %d workgroups per CU\n", per_cu);
        (void)hipGetLastError();
        grid = cus;
    }
    if (grid < 0) return;
    if (hipMemsetAsync((char*)d_ws + WS_CTL, 0, CTL_ZERO_BYTES, stream) != hipSuccess) return;
    Args a{};
    for (int i = 0; i < 24; ++i) a.in[i] = (const float*)d_in[i];
    a.out = (float*)d_out; a.ws = (unsigned char*)d_ws;
#if MK_ONE_LAUNCH
    a.ph_lo = 0; a.ph_hi = N_PHASES;
    hipLaunchKernelGGL(mk_fwd, dim3(grid), dim3(NWAVES * 64), LDS_BYTES, stream, a);
#else
    for (int p = 0; p < N_PHASES; ++p) { a.ph_lo = p; a.ph_hi = p + 1; hipLaunchKernelGGL(mk_fwd, dim3(grid), dim3(NWAVES * 64), LDS_BYTES, stream, a); }
#endif
}
```

```cpp
#include <hip/hip_runtime.h>
#include <cstdio>
#include <cstdint>

#ifndef MK_ONE_LAUNCH
#define MK_ONE_LAUNCH 1
#endif

__device__ __forceinline__ int lane_fresh() { int l = (int)__builtin_amdgcn_mbcnt_hi(~0u, __builtin_amdgcn_mbcnt_lo(~0u, 0u)); asm volatile("" : "+v"(l)); return l; }
namespace pg8 {
#define PG8_LAS __attribute__((address_space(3)))
typedef unsigned short bf16_t;
typedef short bf16x8 __attribute__((ext_vector_type(8)));
typedef float f32x4 __attribute__((ext_vector_type(4)));
typedef unsigned u32x4 __attribute__((ext_vector_type(4)));
constexpr int BM = 256, BK = 64, HALF = 128, HTB = HALF * BK * 2  , STAGE_BYTES = 8 * HTB, NXCD = 8, WGM = 8;

__host__ __device__ __forceinline__ int lds_byte(int r, int c) { const int st = (r >> 4) * 2 + (c >> 5), rr = r & 15, cc = c & 31, ob = rr * 64 + cc * 2; return st * 1024 + (ob ^ (((ob >> 9) & 1) << 5)); }
__host__ __device__ __forceinline__ void stage_rc(int b, int& R, int& C) { const int st = b / 1024, sb = b % 1024, swz = sb ^ (((sb >> 9) & 1) << 5); R = (st >> 1) * 16 + swz / 64; C = (st & 1) * 32 + (swz % 64) / 2; }
__host__ __device__ __forceinline__ int perm32(int rho) { const int n = rho >> 4, i = rho & 15; return 8 * (i >> 2) + 4 * n + (i & 3); }

struct Unit { int pm, pn; };
struct Gemm { const bf16_t* A; const bf16_t* Bt; int lda, ldb, K, a_shift, a_mul; };

struct StaticOrder {
    int nM, nN, nwg, G, c;
    __host__ __device__ void init(int M, int N, int G_, int c_) { nM = M / BM; nN = N / BM; nwg = nM * nN; G = G_; c = c_; }
    __host__ __device__ bool next(int i, Unit& u) const {
        const long L = (long)i * G + c; if (L >= nwg) return false;
        int wgid = (int)L; { const int q = nwg / NXCD, r = nwg % NXCD, xcd = wgid % NXCD, off = wgid / NXCD; wgid = (xcd < r ? xcd * (q + 1) : r * (q + 1) + (xcd - r) * q) + off; }
        const int nig = WGM * nN, gid = wgid / nig, fm = gid * WGM, gsz = (nM - fm) < WGM ? (nM - fm) : WGM;
        u.pm = fm + ((wgid % nig) % gsz); u.pn = (wgid % nig) / gsz; return true;
    }
    __device__ __forceinline__ void a_ready(const Unit&) const {}
    __device__ __forceinline__ void done(const Unit&) const {}
};

__device__ __forceinline__ unsigned cvt_pk_bf16(float lo, float hi) { unsigned r; asm volatile("v_cvt_pk_bf16_f32 %0, %1, %2" : "=v"(r) : "v"(lo), "v"(hi)); return r; }
__device__ __forceinline__ float bflo(unsigned w) { return __uint_as_float(w << 16); }
__device__ __forceinline__ float bfhi(unsigned w) { return __uint_as_float(w & 0xffff0000u); }
__device__ __forceinline__ float sigmoidf_fast(float x) { return __builtin_amdgcn_rcpf(1.0f + __builtin_amdgcn_exp2f(-1.4426950408889634f * x)); }

struct EpiBf16 {
    static constexpr bool PERM = true, AFTER_DRAIN = false;
    bf16_t* O; int ldc;
    __device__ __forceinline__ void operator()(const f32x4 (&acc)[2][2][4][2], const Unit& u, int wr, int wc, int fr, int fq) const {
        const int row0 = u.pm * BM + wr * 64 + fr, col0 = u.pn * BM + wc * 32 + 8 * fq;
#pragma unroll
        for (int ai = 0; ai < 2; ++ai)
#pragma unroll
            for (int m = 0; m < 4; ++m) { bf16_t* rowp = O + (size_t)(row0 + ai * HALF + m * 16) * ldc + col0;
#pragma unroll
                for (int bj = 0; bj < 2; ++bj) { const f32x4 v0 = acc[ai][bj][m][0], v1 = acc[ai][bj][m][1];
                    u32x4 w; w.x = cvt_pk_bf16(v0[0], v0[1]); w.y = cvt_pk_bf16(v0[2], v0[3]); w.z = cvt_pk_bf16(v1[0], v1[1]); w.w = cvt_pk_bf16(v1[2], v1[3]);
                    *(u32x4*)(rowp + bj * HALF) = w; } }
    }
};
struct EpiInProj {
    static constexpr bool PERM = true, AFTER_DRAIN = false;
    bf16_t *aq, *ak, *av, *bq, *bc, *iq, *ikw; float qscale;
    __device__ __forceinline__ void operator()(const f32x4 (&acc)[2][2][4][2], const Unit& u, int wr, int wc, int fr, int fq) const {
        bf16_t* base; int ldc, colt; const int pn = u.pn;
        if (pn < 4) { base = aq; ldc = 1024; colt = pn * 256; }
        else if (pn < 8) { base = ak; ldc = 1024; colt = (pn - 4) * 256; }
        else if (pn < 12) { base = av; ldc = 1024; colt = (pn - 8) * 256; }
        else if (pn < 16) { base = bq; ldc = 1024; colt = (pn - 12) * 256; }
        else if (pn < 18) { base = bc; ldc = 512; colt = (pn - 16) * 256; }
        else if (pn < 22) { base = iq; ldc = 1024; colt = (pn - 18) * 256; }
        else { base = ikw; ldc = 256; colt = 0; }
        const float sc = (pn < 4) ? qscale : 1.0f;
        const int row0 = u.pm * BM + wr * 64 + fr, col0 = colt + wc * 32 + 8 * fq;
#pragma unroll
        for (int ai = 0; ai < 2; ++ai)
#pragma unroll
            for (int m = 0; m < 4; ++m) { bf16_t* rowp = base + (size_t)(row0 + ai * HALF + m * 16) * ldc + col0;
#pragma unroll
                for (int bj = 0; bj < 2; ++bj) { const f32x4 v0 = acc[ai][bj][m][0] * sc, v1 = acc[ai][bj][m][1] * sc;
                    u32x4 w; w.x = cvt_pk_bf16(v0[0], v0[1]); w.y = cvt_pk_bf16(v0[2], v0[3]); w.z = cvt_pk_bf16(v1[0], v1[1]); w.w = cvt_pk_bf16(v1[2], v1[3]);
                    *(u32x4*)(rowp + bj * HALF) = w; } }
    }
};
struct EpiSwiGLU {
    static constexpr bool PERM = true, AFTER_DRAIN = false;
    bf16_t* O; int ldc;
    __device__ __forceinline__ void operator()(const f32x4 (&acc)[2][2][4][2], const Unit& u, int wr, int wc, int fr, int fq) const {
        const int row0 = u.pm * BM + wr * 64 + fr, col0 = u.pn * HALF + wc * 32 + 8 * fq;
#pragma unroll
        for (int ai = 0; ai < 2; ++ai)
#pragma unroll
            for (int m = 0; m < 4; ++m) { bf16_t* rowp = O + (size_t)(row0 + ai * HALF + m * 16) * ldc + col0;
                float h[8];
#pragma unroll
                for (int n = 0; n < 2; ++n)
#pragma unroll
                    for (int j = 0; j < 4; ++j) { const float g = acc[ai][0][m][n][j], up = acc[ai][1][m][n][j]; h[4 * n + j] = g * sigmoidf_fast(g) * up; }
                u32x4 w; w.x = cvt_pk_bf16(h[0], h[1]); w.y = cvt_pk_bf16(h[2], h[3]); w.z = cvt_pk_bf16(h[4], h[5]); w.w = cvt_pk_bf16(h[6], h[7]);
                *(u32x4*)rowp = w; }
    }
};
struct EpiGateMerge {
    static constexpr bool PERM = true, AFTER_DRAIN = false;
    const bf16_t* ta; const bf16_t* tb; bf16_t* O; int ldc; const float* b0; const float* b1;
    __device__ __forceinline__ void operator()(const f32x4 (&acc)[2][2][4][2], const Unit& u, int wr, int wc, int fr, int fq) const {
        const int row0 = u.pm * BM + wr * 64 + fr, col0 = u.pn * HALF + wc * 32 + 8 * fq;
        float bb0[8], bb1[8];
#pragma unroll
        for (int j = 0; j < 8; ++j) { bb0[j] = b0[col0 + j]; bb1[j] = b1[col0 + j]; }
#pragma unroll
        for (int ai = 0; ai < 2; ++ai)
#pragma unroll
            for (int m = 0; m < 4; ++m) { const size_t off = (size_t)(row0 + ai * HALF + m * 16) * ldc + col0;
                const u32x4 a = *(const u32x4*)(ta + off), b = *(const u32x4*)(tb + off);
                const float av[8] = {bflo(a.x), bfhi(a.x), bflo(a.y), bfhi(a.y), bflo(a.z), bfhi(a.z), bflo(a.w), bfhi(a.w)};
                const float bv[8] = {bflo(b.x), bfhi(b.x), bflo(b.y), bfhi(b.y), bflo(b.z), bfhi(b.z), bflo(b.w), bfhi(b.w)};
                float h[8];
#pragma unroll
                for (int n = 0; n < 2; ++n)
#pragma unroll
                    for (int j = 0; j < 4; ++j) { const int e = 4 * n + j; h[e] = sigmoidf_fast(acc[ai][0][m][n][j] + bb0[e]) * av[e] + sigmoidf_fast(acc[ai][1][m][n][j] + bb1[e]) * bv[e]; }
                u32x4 w; w.x = cvt_pk_bf16(h[0], h[1]); w.y = cvt_pk_bf16(h[2], h[3]); w.z = cvt_pk_bf16(h[4], h[5]); w.w = cvt_pk_bf16(h[6], h[7]);
                *(u32x4*)(O + off) = w; }
    }
};
struct EpiRes {
    static constexpr bool PERM = false, AFTER_DRAIN = false;
    const float* res; float* out; int ldc; float alpha, s;
    __device__ __forceinline__ void operator()(const f32x4 (&acc)[2][2][4][2], const Unit& u, int wr, int wc, int fr, int fq) const {
        const int col0 = u.pn * BM + wc * 32 + 4 * fq;
#pragma unroll
        for (int ai = 0; ai < 2; ++ai)
#pragma unroll
            for (int m = 0; m < 4; ++m) { const size_t off = (size_t)(u.pm * BM + ai * HALF + wr * 64 + m * 16 + fr) * ldc + col0;
#pragma unroll
                for (int bj = 0; bj < 2; ++bj)
#pragma unroll
                    for (int n = 0; n < 2; ++n) { const f32x4 r = *(const f32x4*)(res + off + bj * HALF + n * 16); *(f32x4*)(out + off + bj * HALF + n * 16) = r * alpha + acc[ai][bj][m][n] * s; }
                if (m & 1) asm volatile("" ::: "memory"); }
    }
};

template <class Epi, class Sched, bool ALIGN_EPI>
__device__ __forceinline__ void gemm_phase(PG8_LAS unsigned char* lds, const Gemm g, const Sched& S, const Epi& E, const int wid) {
    const int lane = lane_fresh(), tid = wid * 64 + lane, wr = wid >> 2, wc = wid & 3, fr = lane & 15, fq = lane >> 4;
    const int K = g.K, nt = K / BK;
    unsigned voffA[2], voffB[2];
#pragma unroll
    for (int i = 0; i < 2; ++i) { int R, C; stage_rc(tid * 16 + i * 8192, R, C); const int Rb = Epi::PERM ? ((R & ~31) + perm32(R & 31)) : R;
        voffA[i] = (unsigned)(R * g.lda + C) * 2u; voffB[i] = (unsigned)(Rb * g.ldb + C) * 2u; }
    const size_t kstep = (size_t)(BK * 2);
    const size_t hstepA = (size_t)HALF * g.lda * 2, hstepB = (size_t)HALF * g.ldb * 2;
    const size_t tstepA = 2 * hstepA, tstepB = 2 * hstepB;
    const unsigned ldsw = (unsigned)wid * 1024u;
    const int aoff = lds_byte(wr * 64 + fr, fq * 8), boff = lds_byte(wc * 32 + fr, fq * 8);
#define PG8_UA(u) ((const char*)g.A + (size_t)(u).pm * tstepA + (size_t)(((u).pn >> g.a_shift) * g.a_mul) * 2)
#define PG8_UB(u) ((const char*)g.Bt + (size_t)(u).pn * tstepB)
#define PG8_SA(b, h) (((b) * 2 + (h)) * HTB)
#define PG8_SB(b, h) ((4 + (b) * 2 + (h)) * HTB)
#define PG8_STAGE(bufoff, gbase, voff) do { _Pragma("unroll") for (int _i = 0; _i < 2; ++_i) \
        __builtin_amdgcn_global_load_lds((const unsigned*)((const char*)(gbase) + (voff)[_i]), (PG8_LAS unsigned*)(lds + (bufoff) + ldsw + _i * 8192), 16, 0, 0); } while (0)
#define PG8_LDA(dst, b, h) do { _Pragma("unroll") for (int m = 0; m < 4; ++m) _Pragma("unroll") for (int k = 0; k < 2; ++k) dst[m][k] = *(const PG8_LAS bf16x8*)(lds + PG8_SA(b, h) + aoff + m * 2048 + k * 1024); } while (0)
#define PG8_LDB(dst, b, h) do { _Pragma("unroll") for (int n = 0; n < 2; ++n) _Pragma("unroll") for (int k = 0; k < 2; ++k) dst[n][k] = *(const PG8_LAS bf16x8*)(lds + PG8_SB(b, h) + boff + n * 2048 + k * 1024); } while (0)
#define PG8_MMA(ai, bj, At, Bt) do { __builtin_amdgcn_s_setprio(1); _Pragma("unroll") for (int m = 0; m < 4; ++m) _Pragma("unroll") for (int n = 0; n < 2; ++n) _Pragma("unroll") for (int k = 0; k < 2; ++k) \
        acc[ai][bj][m][n] = __builtin_amdgcn_mfma_f32_16x16x32_bf16(Bt[n][k], At[m][k], acc[ai][bj][m][n], 0, 0, 0); __builtin_amdgcn_s_setprio(0); } while (0)
#define PG8_WAIT_V(n) asm volatile("s_waitcnt vmcnt(" #n ")" ::: "memory")
#define PG8_WAIT_L(n) asm volatile("s_waitcnt lgkmcnt(" #n ")" ::: "memory")
#define PG8_BAR __builtin_amdgcn_s_barrier()
#define PG8_SCHED __builtin_amdgcn_sched_barrier(0)
    Unit cur, nxt; int ui = 0;
    if (!S.next(0, cur)) return;
    f32x4 acc[2][2][4][2];
#pragma unroll
    for (int a = 0; a < 2; ++a)
#pragma unroll
        for (int b = 0; b < 2; ++b)
#pragma unroll
            for (int m = 0; m < 4; ++m)
#pragma unroll
                for (int n = 0; n < 2; ++n) acc[a][b][m][n] = (f32x4){0.f, 0.f, 0.f, 0.f};
    bf16x8 At[4][2], B0[2][2], B1[2][2];
    const char* cA = PG8_UA(cur); const char* cB = PG8_UB(cur);
    S.a_ready(cur);
    PG8_STAGE(PG8_SB(0, 0), cB, voffB); PG8_STAGE(PG8_SB(0, 1), cB + hstepB, voffB); PG8_STAGE(PG8_SA(0, 0), cA, voffA); PG8_STAGE(PG8_SA(0, 1), cA + hstepA, voffA);
    if (wr == 1) PG8_BAR;
    PG8_WAIT_V(2); PG8_BAR;
    PG8_STAGE(PG8_SB(1, 0), cB + kstep, voffB); PG8_STAGE(PG8_SA(1, 0), cA + kstep, voffA); PG8_STAGE(PG8_SB(1, 1), cB + hstepB + kstep, voffB);
    PG8_WAIT_V(6); PG8_BAR;
    for (;;) {
        const bool has_next = S.next(ui + 1, nxt);
        const char* nA = has_next ? PG8_UA(nxt) : cA; const char* nB = has_next ? PG8_UB(nxt) : cB;
        for (int t = 0; t < nt; t += 2) {
            const bool last = (t == nt - 2);
            const char* a1 = cA + (size_t)(t + 1) * kstep;
            const char* a2 = last ? nA : cA + (size_t)(t + 2) * kstep; const char* b2 = last ? nB : cB + (size_t)(t + 2) * kstep;
            const char* a3 = a2 + kstep; const char* b3 = b2 + kstep;
            if (last && has_next) S.a_ready(nxt);
            PG8_LDB(B0, 0, 0); PG8_LDB(B1, 0, 1); PG8_SCHED; PG8_LDA(At, 0, 0); PG8_STAGE(PG8_SA(1, 1), a1 + hstepA, voffA);
            PG8_WAIT_V(8); PG8_WAIT_L(0); PG8_BAR; PG8_MMA(0, 0, At, B0); PG8_MMA(0, 1, At, B1); PG8_BAR; PG8_SCHED;
            PG8_LDA(At, 0, 1); PG8_STAGE(PG8_SB(0, 0), b2, voffB); PG8_STAGE(PG8_SB(0, 1), b2 + hstepB, voffB); PG8_STAGE(PG8_SA(0, 0), a2, voffA);
            PG8_WAIT_V(8); PG8_WAIT_L(0); PG8_BAR; PG8_MMA(1, 0, At, B0); PG8_MMA(1, 1, At, B1); PG8_BAR; PG8_SCHED;
            PG8_LDB(B0, 1, 0); PG8_LDB(B1, 1, 1); PG8_SCHED; PG8_LDA(At, 1, 0); PG8_STAGE(PG8_SA(0, 1), a2 + hstepA, voffA);
            PG8_WAIT_V(8); PG8_WAIT_L(0); PG8_BAR; PG8_MMA(0, 0, At, B0); PG8_MMA(0, 1, At, B1); PG8_BAR; PG8_SCHED;
            PG8_LDA(At, 1, 1); PG8_STAGE(PG8_SB(1, 0), b3, voffB); PG8_STAGE(PG8_SB(1, 1), b3 + hstepB, voffB); PG8_STAGE(PG8_SA(1, 0), a3, voffA);
            PG8_WAIT_V(8); PG8_WAIT_L(0); PG8_BAR; PG8_MMA(1, 0, At, B0); PG8_MMA(1, 1, At, B1); PG8_BAR; PG8_SCHED;
        }
        if constexpr (ALIGN_EPI) { if (wr == 0) PG8_BAR; }
        E(acc, cur, wr, wc, fr, fq); S.done(cur);
        if (!has_next) break;
#pragma unroll
        for (int a = 0; a < 2; ++a)
#pragma unroll
            for (int b = 0; b < 2; ++b)
#pragma unroll
                for (int m = 0; m < 4; ++m)
#pragma unroll
                    for (int n = 0; n < 2; ++n) acc[a][b][m][n] = (f32x4){0.f, 0.f, 0.f, 0.f};
        cur = nxt; cA = nA; cB = nB; ++ui;
        if constexpr (ALIGN_EPI) { if (wr == 1) PG8_BAR; }
    }
    PG8_WAIT_V(0);
    if constexpr (!ALIGN_EPI) { if (wr == 0) PG8_BAR; }
    PG8_BAR;
#undef PG8_UA
#undef PG8_UB
#undef PG8_SA
#undef PG8_SB
#undef PG8_STAGE
#undef PG8_LDA
#undef PG8_LDB
#undef PG8_MMA
#undef PG8_WAIT_V
#undef PG8_WAIT_L
#undef PG8_BAR
#undef PG8_SCHED
}
}

constexpr int NWAVES = 8;
constexpr int BATCH = 4, SEQ = 4096, D = 2048, FF = 5632, M = BATCH * SEQ;
constexpr int N_IN = 5888;
constexpr int MEMT = 256;
constexpr float LN_EPS = 1e-5f;
constexpr float ALPHA = 1.189207115002721f;
constexpr float LAMBDA_INIT = 0.2f;

constexpr size_t MiB = 1u << 20;
constexpr size_t WS_CTL = 0, CTL_ZERO_BYTES = 1 * MiB;
constexpr size_t WS_W_IN = 2 * MiB;
constexpr size_t WS_W_G = 25 * MiB;
constexpr size_t WS_W_UK = 41 * MiB;
constexpr size_t WS_W_UVP = 42 * MiB;
constexpr size_t WS_W_A = 44 * MiB;
constexpr size_t WS_W_B = 48 * MiB;
constexpr size_t WS_W_MO = 52 * MiB;
constexpr size_t WS_W_MQ = 60 * MiB;
constexpr size_t WS_W_MKV = 62 * MiB;
constexpr size_t WS_W_MOUT = 66 * MiB;
constexpr size_t WS_MEM16 = 68 * MiB;
constexpr size_t WS_KVMEM = 72 * MiB;
constexpr size_t WS_W_GU2 = 74 * MiB;
constexpr size_t WS_W_D2 = 118 * MiB;
constexpr size_t WS_X16 = 140 * MiB;
constexpr size_t WS_MIX = 204 * MiB;
constexpr size_t WS_W_GU1 = 204 * MiB;
constexpr size_t WS_W_D1 = 248 * MiB;
constexpr size_t WS_H = 270 * MiB;
constexpr size_t WS_AQ = WS_MIX + 0 * MiB, WS_AK = WS_MIX + 32 * MiB, WS_AV = WS_MIX + 64 * MiB, WS_BQ = WS_MIX + 96 * MiB;
constexpr size_t WS_BC = WS_MIX + 128 * MiB;
constexpr size_t WS_IQ = WS_MIX + 144 * MiB;
constexpr size_t WS_IKW = WS_MIX + 176 * MiB;
constexpr size_t WS_QLAT = WS_MIX + 184 * MiB;
constexpr size_t WS_IDX = WS_AK;
constexpr size_t WS_NCNT = WS_AK + 8 * MiB;
constexpr size_t WS_YB = WS_BQ;
constexpr size_t WS_TA = WS_QLAT, WS_TB = WS_QLAT + 64 * MiB;
constexpr size_t WS_QM = WS_AQ, WS_OM = WS_AQ + 16 * MiB;
constexpr size_t WS_END = WS_MIX + 312 * MiB;
static_assert(WS_H + (size_t)M * FF * 2 <= WS_END && WS_QLAT + (size_t)M * 4096 * 2 <= WS_END, "d_ws map");
constexpr int CW_BAR = 4096;

constexpr int RING_OFF = 0, RING_BYTES = 143360;
constexpr int LDSCTL_OFF = RING_BYTES, MISC_OFF = LDSCTL_OFF + 320;
constexpr int LDS_BYTES = 144384;
static_assert(MISC_OFF + 128 <= LDS_BYTES, "LDS map");

#define GAS __attribute__((address_space(1)))
#define LAS __attribute__((address_space(3)))
typedef unsigned short bf16;
typedef unsigned v4u __attribute__((ext_vector_type(4)));
typedef unsigned v2u __attribute__((ext_vector_type(2)));
typedef float f32x4 __attribute__((ext_vector_type(4)));
typedef float f32x16 __attribute__((ext_vector_type(16)));
typedef short bf16x8 __attribute__((ext_vector_type(8)));
typedef GAS unsigned gu32;
#define RLX_AGENT __ATOMIC_RELAXED, __HIP_MEMORY_SCOPE_AGENT
#define LDS_WAIT() asm volatile("s_waitcnt lgkmcnt(0)" ::: "memory")
#define VM_WAIT() asm volatile("s_waitcnt vmcnt(0)" ::: "memory")
__device__ __forceinline__ unsigned f2bf(float f) { unsigned u = __builtin_bit_cast(unsigned, f); return (u + 0x7fffu + ((u >> 16) & 1u)) >> 16; }
__device__ __forceinline__ unsigned pk2(float lo, float hi) { return f2bf(lo) | (f2bf(hi) << 16); }
__device__ __forceinline__ float bf2f(unsigned short v) { return __uint_as_float((unsigned)v << 16); }
__device__ __forceinline__ float blo(unsigned w) { return __uint_as_float(w << 16); }
__device__ __forceinline__ float bhi(unsigned w) { return __uint_as_float(w & 0xffff0000u); }
__device__ __forceinline__ float wave_sum(float v) {
#pragma unroll
    for (int o = 1; o < 64; o <<= 1) v += __shfl_xor(v, o);
    return v;
}

#define XB_TMO      128
#define XB_XCNT(j)  (256  + 64 * (j))
#define XB_XSUB(j)  (1280 + 64 * (j))
#define XB_XGEN(j)  (2304 + 64 * (j))
#define XB_TOP      3328
#define XB_TOPGEN   3392
#define XCD_BAR_WORDS 3456
#define XB_SPIN_CAP (1u << 18)

__device__ __forceinline__ unsigned xb_ld(unsigned* p)              { return __hip_atomic_load(p, __ATOMIC_RELAXED, __HIP_MEMORY_SCOPE_AGENT); }
__device__ __forceinline__ unsigned xb_add(unsigned* p, unsigned v) { return __hip_atomic_fetch_add(p, v, __ATOMIC_RELAXED, __HIP_MEMORY_SCOPE_AGENT); }
__device__ __forceinline__ unsigned xb_xcc_id() { return (unsigned)__builtin_amdgcn_s_getreg((3 << 11) | 20) & 0xFu; }
#define XB_SPIN(cond, bar) do { unsigned _sp = 0; while (cond) { __builtin_amdgcn_s_sleep(1); \
    if ((++_sp & 255u) == 0u) { if (xb_ld(&(bar)[XB_TMO])) break; if (_sp > XB_SPIN_CAP) { atomicAdd(&(bar)[XB_TMO], 1u); break; } } } } while (0)

struct XcdBarrier {
    unsigned* bar; unsigned x;
    volatile LAS unsigned* st;
};

__device__ __forceinline__ XcdBarrier xcd_barrier_post(unsigned* bar, volatile LAS unsigned* st, bool t0) {
    XcdBarrier b; b.bar = bar; b.x = xb_xcc_id(); b.st = st;
    if (t0) (void)xb_add(&bar[XB_XCNT(b.x)], 1u);
    return b;
}
__device__ __forceinline__ void xcd_barrier_complete(unsigned* bar, unsigned x, unsigned& nloc, unsigned& nx) {
    const unsigned G = gridDim.x * gridDim.y * gridDim.z;
    unsigned sum, cnt, mine, sp = 0u;
    for (;;) {
        sum = 0u; cnt = 0u; mine = 0u;
#pragma unroll
        for (unsigned j = 0; j < 16; ++j) { const unsigned c = xb_ld(&bar[XB_XCNT(j)]); sum += c; cnt += (c > 0u) ? 1u : 0u; mine = (j == x) ? c : mine; }
        if (sum == G) break;
        __builtin_amdgcn_s_sleep(1);
        if ((++sp & 255u) == 0u) { if (xb_ld(&bar[XB_TMO])) break; if (sp > XB_SPIN_CAP) { atomicAdd(&bar[XB_TMO], 1u); break; } }
    }
    nloc = mine > 0u ? mine : 1u; nx = cnt > 0u ? cnt : 1u;
}

__device__ __forceinline__ void xcd_barrier(const XcdBarrier& b, const int wave) {
    asm volatile("s_waitcnt vmcnt(0)" ::: "memory");
    __syncthreads();
    if (wave == 0 && lane_fresh() == 0) {
        unsigned* bar = b.bar;
        __builtin_amdgcn_s_waitcnt(0);
        unsigned nloc = b.st[0], nx = b.st[1];
        if (nloc == 0u) { xcd_barrier_complete(bar, b.x, nloc, nx); b.st[0] = nloc; b.st[1] = nx; }
        const unsigned old = xb_add(&bar[XB_XSUB(b.x)], 1u);
        const unsigned gen = old / nloc;
        if (old + 1u == (gen + 1u) * nloc) {
            __builtin_amdgcn_fence(__ATOMIC_RELEASE, "agent");
            asm volatile("s_waitcnt vmcnt(0)" ::: "memory");
            const unsigned og = xb_add(&bar[XB_TOP], 1u);
            const unsigned tg = og / nx;
            if (og + 1u == (tg + 1u) * nx) xb_add(&bar[XB_TOPGEN], 1u);
            else XB_SPIN(xb_ld(&bar[XB_TOPGEN]) == tg, bar);
            __builtin_amdgcn_fence(__ATOMIC_ACQUIRE, "agent");
            xb_add(&bar[XB_XGEN(b.x)], 1u);
            asm volatile("s_waitcnt vmcnt(0)" ::: "memory");
        } else {
            XB_SPIN(xb_ld(&bar[XB_XGEN(b.x)]) == gen, bar);
            __builtin_amdgcn_fence(__ATOMIC_ACQUIRE, "agent");
            asm volatile("s_waitcnt vmcnt(0)" ::: "memory");
        }
    }
    __syncthreads();
}

__device__ __forceinline__ void tr_item(const float* W, int ldw, int nvalid, bf16* WT, int ldt, int k0, int n0, int drow0, int dcol0, LAS float* scr, int lane) {
    const int n = n0 + (lane & 31); const bool ok = n < nvalid;
#pragma unroll 8
    for (int i = 0; i < 32; ++i) { const int kk = 2 * i + (lane >> 5); scr[kk * 33 + (lane & 31)] = ok ? W[(size_t)(k0 + kk) * ldw + n] : 0.f; }
    LDS_WAIT(); asm volatile("" ::: "memory");
    const int c = lane & 7;
#pragma unroll
    for (int j = 0; j < 4; ++j) { const int nn = (lane >> 3) + 8 * j; const LAS float* s = scr + (8 * c) * 33 + nn;
        v4u o; o.x = pk2(s[0 * 33], s[1 * 33]); o.y = pk2(s[2 * 33], s[3 * 33]); o.z = pk2(s[4 * 33], s[5 * 33]); o.w = pk2(s[6 * 33], s[7 * 33]);
        *(GAS v4u*)(WT + (size_t)(drow0 + nn) * ldt + dcol0 + k0 + 8 * c) = o; }
    LDS_WAIT(); asm volatile("" ::: "memory");
}
__device__ __forceinline__ void cvt_item(const float* src, bf16* dst, int item, int lane) {
    const GAS f32x4* s = (const GAS f32x4*)(src + (size_t)item * 512) + 2 * lane; const f32x4 a = s[0], b = s[1];
    v4u o; o.x = pk2(a.x, a.y); o.y = pk2(a.z, a.w); o.z = pk2(b.x, b.y); o.w = pk2(b.z, b.w);
    *((GAS v4u*)(dst + (size_t)item * 512) + lane) = o;
}
__device__ __forceinline__ void p0_prologue(const float* const (&in)[24], unsigned char* ws, LAS unsigned char* lds, int gw, int NGW, int wave, int lane) {
    LAS float* scr = (LAS float*)(lds + RING_OFF + wave * 16384);
#define TRM(SRC, Kk, LDW, NVALID, NPAD, DST, LDT, ROWMAP, DCOL) { constexpr int nblk = (NPAD) / 32; constexpr int cnt = ((Kk) / 64) * nblk; \
        if (r < cnt) { const int kb = r / nblk, nb = r % nblk, n0 = 32 * nb; tr_item(SRC, LDW, NVALID, (bf16*)(ws + (DST)), LDT, 64 * kb, n0, (ROWMAP), (DCOL), scr, lane); continue; } r -= cnt; }
    constexpr int N_TR = 2 * (32 * 176) + 88 * 64 + 32 * 184 + 2 * (32 * 64) + 256 + 2 * (16 * 64) + 32 * 64 + 32 * 16 + 32 * 32 + 8 * 64 + 2 * (32 * 176) + 88 * 64;
    for (int it = gw; it < N_TR; it += NGW) {
        int r = it;
        TRM(in[2], 2048, 5632, 5632, 5632, WS_W_GU1, 2048, 256 * (n0 >> 7) + (n0 & 127), 0)
        TRM(in[3], 2048, 5632, 5632, 5632, WS_W_GU1, 2048, 256 * (n0 >> 7) + 128 + (n0 & 127), 0)
        TRM(in[4], 5632, 2048, 2048, 2048, WS_W_D1, 5632, n0, 0)
        TRM(in[5], 2048, 5712, 5712, 5888, WS_W_IN, 2048, n0, 0)
        TRM(in[11], 2048, 2048, 2048, 2048, WS_W_G, 2048, 256 * (n0 >> 7) + (n0 & 127), 0)
        TRM(in[11] + (size_t)2048 * 2048, 2048, 2048, 2048, 2048, WS_W_G, 2048, 256 * (n0 >> 7) + 128 + (n0 & 127), 0)
        if (r < 256) { const int h = r >> 5, rr = r & 31, kb = rr >> 2, nb = rr & 3;
            tr_item(in[10] + (size_t)h * 512 * 128, 128, 128, (bf16*)(ws + WS_W_UVP), 1024, 64 * kb, 32 * nb, (h >> 1) * 256 + (h & 1) * 128 + 32 * nb, (h & 1) * 512, scr, lane); continue; } r -= 256;
        TRM(in[13], 1024, 2048, 2048, 2048, WS_W_A, 1024, n0, 0)
        TRM(in[14], 1024, 2048, 2048, 2048, WS_W_B, 1024, n0, 0)
        TRM(in[15], 2048, 2048, 2048, 2048, WS_W_MO, 2048, n0, 0)
        TRM(in[16], 2048, 512, 512, 512, WS_W_MQ, 2048, n0, 0)
        TRM(in[17], 2048, 1024, 1024, 1024, WS_W_MKV, 2048, n0, 0)
        TRM(in[18], 512, 2048, 2048, 2048, WS_W_MOUT, 512, n0, 0)
        TRM(in[19], 2048, 5632, 5632, 5632, WS_W_GU2, 2048, 256 * (n0 >> 7) + (n0 & 127), 0)
        TRM(in[20], 2048, 5632, 5632, 5632, WS_W_GU2, 2048, 256 * (n0 >> 7) + 128 + (n0 & 127), 0)
        TRM(in[21], 5632, 2048, 2048, 2048, WS_W_D2, 5632, n0, 0)
    }
#undef TRM
    for (int rw = gw; rw < 1024; rw += NGW) { const int e = (rw >> 7) & 1; *((GAS v4u*)((bf16*)(ws + WS_W_UVP) + (size_t)rw * 1024 + (1 - e) * 512) + lane) = (v4u){0u, 0u, 0u, 0u}; }
    for (int it = gw; it < (M * D) / 512; it += NGW) cvt_item(in[0], (bf16*)(ws + WS_X16), it, lane);
    for (int it = gw; it < (BATCH * MEMT * D) / 512; it += NGW) cvt_item(in[1], (bf16*)(ws + WS_MEM16), it, lane);
    for (int it = gw; it < (8 * 512 * 128) / 512; it += NGW) cvt_item(in[9], (bf16*)(ws + WS_W_UK), it, lane);
}

__device__ __forceinline__ void ln_phase(float* zx, bf16* x16, const float* g, const float* b, int gw, int NGW, int lane) {
    f32x4 gv[8], bv[8];
#pragma unroll
    for (int j = 0; j < 8; ++j) { gv[j] = *((const GAS f32x4*)g + lane + 64 * j); bv[j] = *((const GAS f32x4*)b + lane + 64 * j); }
    for (int m = gw; m < M; m += NGW) {
        GAS f32x4* xr = (GAS f32x4*)(zx + (size_t)m * D) + lane;
        f32x4 v[8]; float s = 0.f;
#pragma unroll
        for (int j = 0; j < 8; ++j) { v[j] = xr[64 * j]; s += (v[j].x + v[j].y) + (v[j].z + v[j].w); }
        const float mean = wave_sum(s) * (1.f / D); float s2 = 0.f;
#pragma unroll
        for (int j = 0; j < 8; ++j) { v[j] = v[j] - mean; s2 += (v[j].x * v[j].x + v[j].y * v[j].y) + (v[j].z * v[j].z + v[j].w * v[j].w); }
        const float rstd = 1.f / sqrtf(wave_sum(s2) * (1.f / D) + LN_EPS);
#pragma unroll
        for (int j = 0; j < 8; ++j) { v[j] = v[j] * rstd * gv[j] + bv[j]; xr[64 * j] = v[j]; }
        if (x16) { GAS v2u* o8 = (GAS v2u*)(x16 + (size_t)m * D) + lane;
#pragma unroll
            for (int j = 0; j < 8; ++j) o8[64 * j] = (v2u){pk2(v[j].x, v[j].y), pk2(v[j].z, v[j].w)}; }
    }
}
__device__ __forceinline__ void crms_phase(bf16* bc, const float* kvg, int gw, int NGW, int lane) {
    float gg[8];
#pragma unroll
    for (int j = 0; j < 8; ++j) gg[j] = kvg[8 * lane + j];
    for (int m = gw; m < M; m += NGW) {
        GAS v4u* p = (GAS v4u*)(bc + (size_t)m * 512) + lane; const v4u w = *p;
        float x[8] = {blo(w.x), bhi(w.x), blo(w.y), bhi(w.y), blo(w.z), bhi(w.z), blo(w.w), bhi(w.w)}; float s = 0.f;
#pragma unroll
        for (int j = 0; j < 8; ++j) s += x[j] * x[j];
        const float r = 1.f / sqrtf(wave_sum(s) * (1.f / 512.f) + LN_EPS);
#pragma unroll
        for (int j = 0; j < 8; ++j) x[j] = x[j] * r * gg[j];
        *p = (v4u){pk2(x[0], x[1]), pk2(x[2], x[3]), pk2(x[4], x[5]), pk2(x[6], x[7])};
    }
}

typedef short v4i16_t __attribute__((ext_vector_type(4)));
__device__ __forceinline__ v4i16_t lds_tr16(const LAS unsigned char* p) { return __builtin_amdgcn_ds_read_tr16_b64_v4i16((LAS v4i16_t*)p); }
__device__ __forceinline__ unsigned cvtpk(float lo, float hi) { typedef float f2 __attribute__((ext_vector_type(2))); typedef __bf16 b2 __attribute__((ext_vector_type(2))); f2 v = {lo, hi}; b2 b = __builtin_convertvector(v, b2); return __builtin_bit_cast(unsigned, b); }
__device__ __forceinline__ float xhalf_f(float v) { return __shfl_xor(v, 32); }
constexpr float LOG2E = 1.4426950408889634f;
constexpr float QSCALE = 0.125f * LOG2E;

__device__ __forceinline__ void diff_attn_mfma(LAS unsigned char* lds, const bf16* AQ, const bf16* AK, const bf16* AV, bf16* YA, const float* dlam, const float* subg, int vcu, int G, const int wave) {
    const int lane = lane_fresh(), r32 = lane & 31, hi = lane >> 5;
    const int comp = wave >> 2, wq = wave & 3;
    const unsigned ksrc = (unsigned)(lane * 1024 + (2 * wave) * 8);
    const unsigned vsrc0 = (unsigned)((16 * ((2 * wave) & 3) + (lane >> 2)) * 1024 + ((2 * wave) >> 2) * 32 + (lane & 3) * 8);
    const unsigned vsrc1 = (unsigned)((16 * ((2 * wave + 1) & 3) + (lane >> 2)) * 1024 + ((2 * wave + 1) >> 2) * 32 + (lane & 3) * 8);
    const unsigned kdst = (unsigned)(2 * wave) * 1024u, vdst0 = 16384u + (unsigned)(((2 * wave) >> 2) * 4096 + ((2 * wave) & 3) * 1024), vdst1 = 16384u + (unsigned)(((2 * wave + 1) >> 2) * 4096 + ((2 * wave + 1) & 3) * 1024);
#define DA_STAGE(bo, to) do { \
        __builtin_amdgcn_global_load_lds((const unsigned*)(Kg + (to) + ksrc), (LAS unsigned*)(lds + (bo) + kdst), 16, 0, 0); \
        __builtin_amdgcn_global_load_lds((const unsigned*)(Kg + (to) + ksrc + 8), (LAS unsigned*)(lds + (bo) + kdst + 1024), 16, 0, 0); \
        __builtin_amdgcn_global_load_lds((const unsigned*)(Vg + (to) + vsrc0), (LAS unsigned*)(lds + (bo) + vdst0), 16, 0, 0); \
        __builtin_amdgcn_global_load_lds((const unsigned*)(Vg + (to) + vsrc1), (LAS unsigned*)(lds + (bo) + vdst1), 16, 0, 0); } while (0)
    const unsigned koff = (unsigned)(((comp * 8 + hi) * 64 + r32) * 16);
    const unsigned voff = (unsigned)(16384 + (4 * hi + ((lane & 15) >> 2)) * 64 + ((lane >> 4) & 1) * 32 + (lane & 3) * 8);
    for (int j = vcu; j < 1024; j += G) {
        const int w = j & 255, i = j >> 8, bh = w >> 3, s8 = w & 7;
        const int ub = (i == 0) ? s8 : (i == 1) ? 15 - s8 : (i == 2) ? 16 + s8 : 31 - s8;
        const int b = bh >> 3, h = bh & 7;
        const float sl2 = LOG2E / (float)(2 << h);
        const size_t rowbase = (size_t)b * SEQ; const int q0 = ub * 128;
        const int qpos = q0 + wq * 32 + r32;
        const int nt = 2 * ub + 2;
        const int myt = 2 * ub + 1 + (wq >> 1);
        const bf16* Kg = AK + rowbase * 1024 + h * 128; const bf16* Vg = AV + rowbase * 1024 + h * 128;
        bf16x8 qr[4];
#pragma unroll
        for (int s = 0; s < 4; ++s) qr[s] = *(const GAS bf16x8*)(AQ + (rowbase + qpos) * 1024 + h * 128 + comp * 64 + s * 16 + hi * 8);
        f32x16 o[4];
#pragma unroll
        for (int blk = 0; blk < 4; ++blk)
#pragma unroll
            for (int r = 0; r < 16; ++r) o[blk][r] = 0.f;
        float mrun = -INFINITY, lrun = 0.f;
        DA_STAGE(0u, (size_t)0);
        __syncthreads();
        for (int kt = 0; kt < nt; ++kt) {
            const unsigned bufo = (unsigned)(kt & 1) * 32768u;
            if (kt + 1 < nt) DA_STAGE(32768u - bufo, (size_t)(kt + 1) * 64 * 1024);
            if (kt < myt) {
                const LAS unsigned char* Kb = lds + bufo + koff;
                f32x16 p0, p1;
#pragma unroll
                for (int r = 0; r < 16; ++r) { p0[r] = 0.f; p1[r] = 0.f; }
                { bf16x8 kf[4];
#pragma unroll
                  for (int s = 0; s < 4; ++s) kf[s] = *(const LAS bf16x8*)(Kb + s * 2048);
#pragma unroll
                  for (int s = 0; s < 4; ++s) p0 = __builtin_amdgcn_mfma_f32_32x32x16_bf16(kf[s], qr[s], p0, 0, 0, 0); }
                { bf16x8 kf[4];
#pragma unroll
                  for (int s = 0; s < 4; ++s) kf[s] = *(const LAS bf16x8*)(Kb + s * 2048 + 512);
#pragma unroll
                  for (int s = 0; s < 4; ++s) p1 = __builtin_amdgcn_mfma_f32_32x32x16_bf16(kf[s], qr[s], p1, 0, 0, 0); }
                const float qth = (float)(qpos - kt * 64 - 4 * hi);
                float rm = -INFINITY;
#pragma unroll
                for (int r = 0; r < 16; ++r) { const float kr = (float)((r & 3) + 8 * (r >> 2)); const float v0 = qth - kr, v1 = qth - (kr + 32.f);
                    p0[r] = p0[r] - sl2 * fabsf(v0); p1[r] = p1[r] - sl2 * fabsf(v1); rm = fmaxf(rm, fmaxf(p0[r], p1[r])); }
                rm = fmaxf(rm, xhalf_f(rm));
                if (__any(rm > mrun)) { const float mn = fmaxf(mrun, rm), f = __builtin_amdgcn_exp2f(mrun - mn); mrun = mn; lrun *= f;
#pragma unroll
                    for (int blk = 0; blk < 4; ++blk)
#pragma unroll
                        for (int r = 0; r < 16; ++r) o[blk][r] *= f; }
                float ls = 0.f;
#pragma unroll
                for (int r = 0; r < 16; ++r) { p0[r] = __builtin_amdgcn_exp2f(p0[r] - mrun); p1[r] = __builtin_amdgcn_exp2f(p1[r] - mrun); ls += p0[r] + p1[r]; }
                lrun += ls;
                bf16x8 pw[4];
#pragma unroll
                for (int s = 0; s < 2; ++s) {
                    v4u a = {cvtpk(p0[8 * s + 0], p0[8 * s + 1]), cvtpk(p0[8 * s + 2], p0[8 * s + 3]), cvtpk(p0[8 * s + 4], p0[8 * s + 5]), cvtpk(p0[8 * s + 6], p0[8 * s + 7])};
                    v4u c = {cvtpk(p1[8 * s + 0], p1[8 * s + 1]), cvtpk(p1[8 * s + 2], p1[8 * s + 3]), cvtpk(p1[8 * s + 4], p1[8 * s + 5]), cvtpk(p1[8 * s + 6], p1[8 * s + 7])};
                    pw[s] = __builtin_bit_cast(bf16x8, a); pw[2 + s] = __builtin_bit_cast(bf16x8, c); }
                const LAS unsigned char* Vb = lds + bufo + voff;
#pragma unroll
                for (int blk = 0; blk < 4; ++blk) {
#pragma unroll
                    for (int s = 0; s < 4; ++s) {
                        const v4i16_t lo = lds_tr16(Vb + blk * 4096 + s * 1024), hh = lds_tr16(Vb + blk * 4096 + s * 1024 + 512);
                        const bf16x8 vf = {lo[0], lo[1], lo[2], lo[3], hh[0], hh[1], hh[2], hh[3]};
                        o[blk] = __builtin_amdgcn_mfma_f32_32x32x16_bf16(vf, pw[s], o[blk], 0, 0, 0);
                    }
                }
            }
            __syncthreads();
        }
        lrun += xhalf_f(lrun);
        const float inv = 1.f / lrun;
        LAS float* Y1 = (LAS float*)(lds) + wq * 4096;
        if (comp == 1) {
            float lam; { float a = dlam[lane] * dlam[64 + lane], bq_ = dlam[128 + lane] * dlam[192 + lane]; a = wave_sum(a); bq_ = wave_sum(bq_); lam = __expf(a) - __expf(bq_) + LAMBDA_INIT; }
            const float sc = inv * lam;
#pragma unroll
            for (int blk = 0; blk < 4; ++blk)
#pragma unroll
                for (int r = 0; r < 16; ++r) Y1[(32 * blk + (r & 3) + 8 * (r >> 2) + 4 * hi) * 32 + r32] = o[blk][r] * sc; }
        __syncthreads();
        if (comp == 0) {
            float ss = 0.f;
#pragma unroll
            for (int blk = 0; blk < 4; ++blk)
#pragma unroll
                for (int r = 0; r < 16; ++r) { const float a = o[blk][r] * inv - Y1[(32 * blk + (r & 3) + 8 * (r >> 2) + 4 * hi) * 32 + r32]; o[blk][r] = a; ss += a * a; }
            ss += xhalf_f(ss);
            const float rr = (1.0f - LAMBDA_INIT) / sqrtf(ss * (1.f / 128.f) + LN_EPS);
            LAS unsigned* stg = (LAS unsigned*)(lds + 65536) + wq * (32 * 65);
#pragma unroll
            for (int blk = 0; blk < 4; ++blk) {
#pragma unroll
                for (int r = 0; r < 16; r += 2) { const int e = 32 * blk + (r & 3) + 8 * (r >> 2) + 4 * hi;
                    stg[r32 * 65 + (e >> 1)] = cvtpk(o[blk][r] * rr * subg[e], o[blk][r + 1] * rr * subg[e + 1]); }
                asm volatile("" ::: "memory"); }
            LDS_WAIT(); asm volatile("" ::: "memory");
            bf16* orow = YA + (rowbase + q0 + wq * 32) * 1024 + h * 128;
#pragma unroll 4
            for (int row = 0; row < 32; ++row) *((GAS unsigned*)(orow + (size_t)row * 1024) + lane) = stg[row * 65 + lane];
        }
        __syncthreads();
    }
#undef DA_STAGE
}

__device__ __forceinline__ unsigned okey(float f) { const unsigned u = __float_as_uint(f); return (u & 0x80000000u) ? ~u : (u | 0x80000000u); }
__device__ __forceinline__ void indexer_topk(const bf16* IQ, const bf16* IKW, unsigned short* IDX, int* NCNT, int gw, int NGW, int lane) {
    const int r32 = lane & 31, hi = lane >> 5;
    for (int p = gw; p < M / 2; p += NGW) {
        const int c64 = p & 63, b = p >> 11, pic = (p >> 6) & 31;
        const int chunk = (b & 1) ? 63 - c64 : c64;
        const int t0 = b * SEQ + chunk * 64 + 2 * pic;
        const int ngroups = 2 * (chunk + 1);
        bf16x8 a[4];
#pragma unroll
        for (int ks = 0; ks < 4; ++ks) a[ks] = *(const GAS bf16x8*)(IQ + (size_t)(t0 + (r32 >> 4)) * 1024 + (r32 & 15) * 64 + ks * 16 + 8 * hi);
        float wv[16];
#pragma unroll
        for (int r = 0; r < 16; ++r) { const int row = (r & 3) + 8 * (r >> 2) + 4 * hi; wv[r] = bf2f(IKW[(size_t)(t0 + (row >> 4)) * 256 + 64 + (row & 15)]); }
        unsigned key[128];
#pragma unroll
        for (int g = 0; g < 128; ++g) {
            if (g < ngroups) {
                const bf16* kp = IKW + (size_t)(b * SEQ + 32 * g + r32) * 256 + 8 * hi;
                bf16x8 bk[4];
#pragma unroll
                for (int ks = 0; ks < 4; ++ks) bk[ks] = *(const GAS bf16x8*)(kp + ks * 16);
                f32x16 acc = {0.f, 0.f, 0.f, 0.f, 0.f, 0.f, 0.f, 0.f, 0.f, 0.f, 0.f, 0.f, 0.f, 0.f, 0.f, 0.f};
#pragma unroll
                for (int ks = 0; ks < 4; ++ks) acc = __builtin_amdgcn_mfma_f32_32x32x16_bf16(a[ks], bk[ks], acc, 0, 0, 0);
                float s0 = 0.f, s1 = 0.f;
#pragma unroll
                for (int r = 0; r < 8; ++r) { s0 += wv[r] * fmaxf(acc[r], 0.f); s1 += wv[8 + r] * fmaxf(acc[8 + r], 0.f); }
                s0 += __shfl_xor(s0, 32); s1 += __shfl_xor(s1, 32);
                key[g] = okey(hi ? s1 : s0);
            } else key[g] = 0u;
        }
        unsigned T = 0u;
        if (chunk >= 4) {
            bool done = false;
#pragma nounroll
            for (int bit = 31; bit >= 0; --bit) {
                if (__all(done ? 1 : 0)) break;
                const unsigned trial = T | (1u << bit);
                int cnt = 0;
#pragma unroll
                for (int g = 0; g < 128; ++g) cnt += (key[g] >= trial) ? 1 : 0;
                cnt += __shfl_xor(cnt, 1); cnt += __shfl_xor(cnt, 2); cnt += __shfl_xor(cnt, 4); cnt += __shfl_xor(cnt, 8); cnt += __shfl_xor(cnt, 16);
                if (!done && cnt >= 256) { T = trial; if (cnt == 256) done = true; }
            }
        }
        int base = 0;
        unsigned short* ip = IDX + (size_t)(t0 + hi) * 256;
#pragma unroll
        for (int g = 0; g < 128; ++g) {
            if (g < ngroups) {
                const bool sel = key[g] >= T;
                const unsigned long long mk = __ballot(sel ? 1 : 0);
                const unsigned mh = hi ? (unsigned)(mk >> 32) : (unsigned)mk;
                const int pos = base + __popc(mh & ((1u << r32) - 1u));
                if (sel && pos < 256) ip[pos] = (unsigned short)(32 * g + r32);
                base += __popc(mh);
            }
        }
        if (r32 == 0) NCNT[t0 + hi] = base < 256 ? base : 256;
    }
}

constexpr int DSA_ROWB = 1040;
constexpr int DSA_BUF = 64 * DSA_ROWB;
constexpr int DSA_PART = 2 * DSA_BUF;
constexpr int DSA_IDX = DSA_PART + 2 * 16 * 68 * 4;
constexpr int DSA_LDS_END = DSA_IDX + 2 * 512;
__device__ __forceinline__ void dsa_mfma(LAS unsigned char* lds, bf16* QL, const bf16* C, const unsigned short* IDX, const int* NCNT, int vcu, int G, const int wave) {
    const int lane = lane_fresh(), h16 = lane & 15, g = lane >> 4;
    const int kb = wave & 3, kh = wave >> 2;
    const float sc2 = 0.08838834764831845f * LOG2E;
    const float sl2 = (h16 < 8) ? LOG2E / (float)(2 << (h16 & 7)) : 0.f;
    const int ntok = (G == 256) ? 64 : (M - vcu + G - 1) / G;
#define DSA_TOK(i) ((G == 256) ? ((vcu >> 6) * SEQ + (vcu & 63) + 64 * (i)) : (vcu + G * (i)))
    const unsigned qk_off = (unsigned)((16 * kb + h16) * DSA_ROWB + (256 * kh + 8 * g) * 2);
    const unsigned pv_off = (unsigned)((8 * g + (h16 >> 2)) * DSA_ROWB + (64 * wave + 4 * (lane & 3)) * 2);
    const unsigned part_w = (unsigned)(DSA_PART + ((kh * 16 + h16) * 68 + 16 * kb + 4 * g) * 4);
    const unsigned part_r = (unsigned)(DSA_PART + (h16 * 68 + 8 * g) * 4);
    LAS unsigned short* idxs = (LAS unsigned short*)(lds + DSA_IDX);
    bf16x8 qf[8];
    { const int t = DSA_TOK(0);
#pragma unroll
      for (int i = 0; i < 8; ++i) { qf[i] = (bf16x8){0, 0, 0, 0, 0, 0, 0, 0}; if (h16 < 8) qf[i] = *(const GAS bf16x8*)(QL + (size_t)t * 4096 + h16 * 512 + 256 * kh + 32 * i + 8 * g); }
      if (wave == 7 && lane < 32) *(LAS v4u*)(lds + DSA_IDX + lane * 16) = *((const GAS v4u*)(IDX + (size_t)t * 256) + lane); }
    __syncthreads();
    for (int it = 0; it < ntok; ++it) {
        const int t = DSA_TOK(it); const int b = t >> 12, tpos = t & (SEQ - 1);
        const int n = __builtin_amdgcn_readfirstlane(__hip_atomic_load(NCNT + t, __ATOMIC_RELAXED, __HIP_MEMORY_SCOPE_AGENT)); const int nst = (n + 63) >> 6;
        LAS unsigned short* idc = idxs + (it & 1) * 256;
        const bf16* Cb = C + (size_t)b * SEQ * 512;
        bf16x8 qn[8]; v4u idn = {0u, 0u, 0u, 0u}; const bool more = (it + 1 < ntok);
        if (more) { const int tn = DSA_TOK(it + 1);
#pragma unroll
            for (int i = 0; i < 8; ++i) { qn[i] = (bf16x8){0, 0, 0, 0, 0, 0, 0, 0}; if (h16 < 8) qn[i] = *(const GAS bf16x8*)(QL + (size_t)tn * 4096 + h16 * 512 + 256 * kh + 32 * i + 8 * g); }
            if (wave == 7 && lane < 32) idn = *((const GAS v4u*)(IDX + (size_t)tn * 256) + lane); }
        f32x4 o[4];
#pragma unroll
        for (int blk = 0; blk < 4; ++blk) o[blk] = (f32x4){0.f, 0.f, 0.f, 0.f};
        float mrun = -INFINITY, lrun = 0.f;
#define DSA_GATHER(st, bo) do { _Pragma("unroll") for (int i_ = 0; i_ < 8; ++i_) { const int k_ = (st) * 64 + wave * 8 + i_; \
            const int s_ = __builtin_amdgcn_readfirstlane((int)idc[k_ < n ? k_ : 0]); \
            __builtin_amdgcn_global_load_lds((const unsigned*)(Cb + (size_t)s_ * 512 + lane * 8), (LAS unsigned*)(lds + (bo) + (wave * 8 + i_) * DSA_ROWB), 16, 0, 0); } } while (0)
        DSA_GATHER(0, 0);
        for (int st = 0; st < nst; ++st) {
            const unsigned bufo = (unsigned)(st & 1) * DSA_BUF;
            if (st + 1 < nst) { DSA_GATHER(st + 1, DSA_BUF - bufo); asm volatile("s_waitcnt vmcnt(8)\n\ts_barrier" ::: "memory"); }
            else { asm volatile("s_waitcnt vmcnt(0)\n\ts_barrier" ::: "memory"); }
            { f32x4 acc = {0.f, 0.f, 0.f, 0.f};
#pragma unroll
              for (int i = 0; i < 8; ++i) { const bf16x8 a = *(const LAS bf16x8*)(lds + bufo + qk_off + 64 * i); acc = __builtin_amdgcn_mfma_f32_16x16x32_bf16(a, qf[i], acc, 0, 0, 0); }
              *(LAS f32x4*)(lds + part_w) = acc; }
            asm volatile("s_waitcnt lgkmcnt(0)\n\ts_barrier" ::: "memory");
            float lg[16];
#pragma unroll
            for (int ks = 0; ks < 2; ++ks) {
                const f32x4 a0 = *(const LAS f32x4*)(lds + part_r + ks * 128), a1 = *(const LAS f32x4*)(lds + part_r + ks * 128 + 16);
                const f32x4 b0 = *(const LAS f32x4*)(lds + part_r + 16 * 68 * 4 + ks * 128), b1 = *(const LAS f32x4*)(lds + part_r + 16 * 68 * 4 + ks * 128 + 16);
                const v4u iw = *(const LAS v4u*)(idc + st * 64 + 32 * ks + 8 * g);
                const int sidx[8] = {(int)(iw.x & 0xffffu), (int)(iw.x >> 16), (int)(iw.y & 0xffffu), (int)(iw.y >> 16), (int)(iw.z & 0xffffu), (int)(iw.z >> 16), (int)(iw.w & 0xffffu), (int)(iw.w >> 16)};
                const float sv[8] = {a0.x + b0.x, a0.y + b0.y, a0.z + b0.z, a0.w + b0.w, a1.x + b1.x, a1.y + b1.y, a1.z + b1.z, a1.w + b1.w};
#pragma unroll
                for (int jj = 0; jj < 8; ++jj) { const int kk = st * 64 + 32 * ks + 8 * g + jj; const int d = tpos - sidx[jj];
                    lg[8 * ks + jj] = (kk < n) ? sv[jj] * sc2 - sl2 * (float)(d < 0 ? -d : d) : -INFINITY; }
            }
            float rm = lg[0];
#pragma unroll
            for (int e = 1; e < 16; ++e) rm = fmaxf(rm, lg[e]);
            rm = fmaxf(rm, __shfl_xor(rm, 16)); rm = fmaxf(rm, __shfl_xor(rm, 32));
            { const float mn = fmaxf(mrun, rm), f = __builtin_amdgcn_exp2f(mrun - mn); mrun = mn; lrun *= f;
#pragma unroll
              for (int blk = 0; blk < 4; ++blk) o[blk] = o[blk] * f; }
            float ps = 0.f;
#pragma unroll
            for (int e = 0; e < 16; ++e) { lg[e] = __builtin_amdgcn_exp2f(lg[e] - mrun); ps += lg[e]; }
            lrun += ps;
            bf16x8 pw[2];
#pragma unroll
            for (int ks = 0; ks < 2; ++ks) { v4u a = {cvtpk(lg[8 * ks + 0], lg[8 * ks + 1]), cvtpk(lg[8 * ks + 2], lg[8 * ks + 3]), cvtpk(lg[8 * ks + 4], lg[8 * ks + 5]), cvtpk(lg[8 * ks + 6], lg[8 * ks + 7])}; pw[ks] = __builtin_bit_cast(bf16x8, a); }
#pragma unroll
            for (int blk = 0; blk < 4; ++blk)
#pragma unroll
                for (int ks = 0; ks < 2; ++ks) {
                    const LAS unsigned char* ap = lds + bufo + pv_off + ks * 32 * DSA_ROWB + blk * 32;
                    const v4i16_t lo = lds_tr16(ap), hh = lds_tr16(ap + 4 * DSA_ROWB);
                    const bf16x8 af = {lo[0], lo[1], lo[2], lo[3], hh[0], hh[1], hh[2], hh[3]};
                    o[blk] = __builtin_amdgcn_mfma_f32_16x16x32_bf16(af, pw[ks], o[blk], 0, 0, 0);
                }
            asm volatile("s_waitcnt lgkmcnt(0)\n\ts_barrier" ::: "memory");
        }
        lrun += __shfl_xor(lrun, 16); lrun += __shfl_xor(lrun, 32);
        const float inv = 1.f / lrun;
        if (h16 < 8) {
#pragma unroll
            for (int blk = 0; blk < 4; ++blk) { const f32x4 v = o[blk] * inv;
                *(GAS v2u*)(QL + (size_t)t * 4096 + h16 * 512 + 64 * wave + 16 * blk + 4 * g) = (v2u){cvtpk(v.x, v.y), cvtpk(v.z, v.w)}; } }
        if (more) {
#pragma unroll
            for (int i = 0; i < 8; ++i) qf[i] = qn[i];
            if (wave == 7 && lane < 32) *(LAS v4u*)(lds + DSA_IDX + ((it + 1) & 1) * 512 + lane * 16) = idn;
        }
        __syncthreads();
    }
#undef DSA_GATHER
#undef DSA_TOK
}
static_assert(DSA_LDS_END <= RING_BYTES, "DSA LDS map");

__device__ __forceinline__ void memattn_simple(LAS unsigned char* lds, const bf16* QM, const bf16* KV, bf16* OM, int gw, int NGW, int wave, int lane) {
    LAS float* Ls = (LAS float*)(lds + wave * 4096);
    const float scale = 0.08838834764831845f;
    const int h = lane >> 4, sub = lane & 15;
    for (int t = gw; t < M; t += NGW) {
        const int b = t >> 12;
        const v4u wq = *((const GAS v4u*)(QM + (size_t)t * 512) + lane);
        const float q[8] = {blo(wq.x), bhi(wq.x), blo(wq.y), bhi(wq.y), blo(wq.z), bhi(wq.z), blo(wq.w), bhi(wq.w)};
        const bf16* kvb = KV + (size_t)b * MEMT * 1024;
        for (int m = 0; m < MEMT; ++m) {
            const v4u w = *((const GAS v4u*)(kvb + (size_t)m * 1024) + lane);
            float d = q[0] * blo(w.x) + q[1] * bhi(w.x) + q[2] * blo(w.y) + q[3] * bhi(w.y) + q[4] * blo(w.z) + q[5] * bhi(w.z) + q[6] * blo(w.w) + q[7] * bhi(w.w);
            d += __shfl_xor(d, 1); d += __shfl_xor(d, 2); d += __shfl_xor(d, 4); d += __shfl_xor(d, 8);
            if (sub == 0) Ls[h * 256 + m] = d * scale;
        }
        LDS_WAIT(); asm volatile("" ::: "memory");
        float mx = -INFINITY;
        for (int m = sub; m < MEMT; m += 16) mx = fmaxf(mx, Ls[h * 256 + m]);
        mx = fmaxf(mx, __shfl_xor(mx, 1)); mx = fmaxf(mx, __shfl_xor(mx, 2)); mx = fmaxf(mx, __shfl_xor(mx, 4)); mx = fmaxf(mx, __shfl_xor(mx, 8));
        float sum = 0.f;
        for (int m = sub; m < MEMT; m += 16) { const float pz = __expf(Ls[h * 256 + m] - mx); Ls[h * 256 + m] = pz; sum += pz; }
        sum += __shfl_xor(sum, 1); sum += __shfl_xor(sum, 2); sum += __shfl_xor(sum, 4); sum += __shfl_xor(sum, 8);
        LDS_WAIT(); asm volatile("" ::: "memory");
        float acc[8] = {0.f, 0.f, 0.f, 0.f, 0.f, 0.f, 0.f, 0.f};
        for (int m = 0; m < MEMT; ++m) {
            const float pz = Ls[h * 256 + m];
            const v4u w = *((const GAS v4u*)(kvb + (size_t)m * 1024 + 512) + lane);
            acc[0] += pz * blo(w.x); acc[1] += pz * bhi(w.x); acc[2] += pz * blo(w.y); acc[3] += pz * bhi(w.y); acc[4] += pz * blo(w.z); acc[5] += pz * bhi(w.z); acc[6] += pz * blo(w.w); acc[7] += pz * bhi(w.w);
        }
        const float inv = 1.f / sum;
        *((GAS v4u*)(OM + (size_t)t * 512) + lane) = (v4u){pk2(acc[0] * inv, acc[1] * inv), pk2(acc[2] * inv, acc[3] * inv), pk2(acc[4] * inv, acc[5] * inv), pk2(acc[6] * inv, acc[7] * inv)};
        LDS_WAIT(); asm volatile("" ::: "memory");
    }
}

constexpr int N_PHASES = 21;
struct Args { const float* in[24]; float* out; unsigned char* ws; int ph_lo, ph_hi; };
__global__ void __launch_bounds__(NWAVES * 64, 2) mk_fwd(Args args) {
    extern __shared__ __attribute__((aligned(16))) unsigned char lds_raw[];
    LAS unsigned char* lds = (LAS unsigned char*)lds_raw;
    volatile LAS unsigned* MISC = (volatile LAS unsigned*)(lds + MISC_OFF);
    const int tid = threadIdx.x, wave = __builtin_amdgcn_readfirstlane(tid >> 6);
#define lane lane_fresh()
    const int G = gridDim.x, bx = blockIdx.x;
    const int vcu = (G % 8 == 0) ? (bx % 8) * (G / 8) + bx / 8 : bx;
    const int gw = vcu * NWAVES + wave, NGW = G * NWAVES;
    unsigned char* ws = args.ws;
    gu32* ctl = (gu32*)(ws + WS_CTL);
    for (int u = tid; u < (LDS_BYTES - LDSCTL_OFF) / 4; u += NWAVES * 64) ((LAS unsigned*)(lds + LDSCTL_OFF))[u] = 0u;
    __syncthreads();
    const bool one = (args.ph_hi - args.ph_lo) > 1;
    XcdBarrier bar; bar.bar = (unsigned*)(ctl + CW_BAR); bar.x = 0; bar.st = nullptr;
    if (one) bar = xcd_barrier_post((unsigned*)(ctl + CW_BAR), MISC + 8, tid == 0);
    const int lo = args.ph_lo, hi = args.ph_hi;
#ifndef PH_MASK
#define PH_MASK 0xFFFFFFFFu
#endif
#define IN(k) ((((PH_MASK) >> (k)) & 1u) && lo <= (k) && (k) < hi)
#define SEAM(k) do { if (IN(k) && IN((k) + 1)) xcd_barrier(bar, wave); } while (0)
    bf16* const X16 = (bf16*)(ws + WS_X16); bf16* const HB = (bf16*)(ws + WS_H);
    float* const out = args.out;
    const float* const ln_g = args.in[22]; const float* const ln_b = args.in[23];
    using namespace pg8;

    if (IN(0)) { p0_prologue(args.in, ws, lds, gw, NGW, wave, lane); }
    SEAM(0);
    if (IN(1)) { Gemm g{X16, (const bf16*)(ws + WS_W_GU1), D, D, D, 0, 0}; StaticOrder S; S.init(M, 2 * FF, G, bx); EpiSwiGLU E{HB, FF}; gemm_phase<EpiSwiGLU, StaticOrder, true>(lds + RING_OFF, g, S, E, wave); }
    SEAM(1);
    if (IN(2)) { Gemm g{HB, (const bf16*)(ws + WS_W_D1), FF, FF, FF, 0, 0}; StaticOrder S; S.init(M, D, G, bx); EpiRes E{args.in[0], out, D, ALPHA, 0.5f}; gemm_phase<EpiRes, StaticOrder, true>(lds + RING_OFF, g, S, E, wave); }
    SEAM(2);
    if (IN(3)) ln_phase(out, X16, ln_g, ln_b, gw, NGW, lane);
    SEAM(3);
    if (IN(4)) {
        { Gemm g{X16, (const bf16*)(ws + WS_W_IN), D, D, D, 0, 0}; StaticOrder S; S.init(M, N_IN, G, bx);
          EpiInProj E{(bf16*)(ws + WS_AQ), (bf16*)(ws + WS_AK), (bf16*)(ws + WS_AV), (bf16*)(ws + WS_BQ), (bf16*)(ws + WS_BC), (bf16*)(ws + WS_IQ), (bf16*)(ws + WS_IKW), QSCALE};
          gemm_phase<EpiInProj, StaticOrder, true>(lds + RING_OFF, g, S, E, wave); }
        { Gemm g{(const bf16*)(ws + WS_MEM16), (const bf16*)(ws + WS_W_MKV), D, D, D, 0, 0}; StaticOrder S; S.init(BATCH * MEMT, 1024, G, bx); EpiBf16 E{(bf16*)(ws + WS_KVMEM), 1024};
          gemm_phase<EpiBf16, StaticOrder, true>(lds + RING_OFF, g, S, E, wave); }
    }
    SEAM(4);
    if (IN(5)) {
        { Gemm g{(const bf16*)(ws + WS_BQ), (const bf16*)(ws + WS_W_UK), 1024, 128, 128, 1, 128}; StaticOrder S; S.init(M, 4096, G, bx); EpiBf16 E{(bf16*)(ws + WS_QLAT), 4096};
          gemm_phase<EpiBf16, StaticOrder, true>(lds + RING_OFF, g, S, E, wave); }
        crms_phase((bf16*)(ws + WS_BC), args.in[8], gw, NGW, lane);
    }
    SEAM(5);
    if (IN(6)) diff_attn_mfma(lds, (const bf16*)(ws + WS_AQ), (const bf16*)(ws + WS_AK), (const bf16*)(ws + WS_AV), (bf16*)(ws + WS_AQ), args.in[6], args.in[7], vcu, G, wave);
    SEAM(6);
    if (IN(7)) indexer_topk((const bf16*)(ws + WS_IQ), (const bf16*)(ws + WS_IKW), (unsigned short*)(ws + WS_IDX), (int*)(ws + WS_NCNT), gw, NGW, lane);
    SEAM(7);
    if (IN(8)) dsa_mfma(lds, (bf16*)(ws + WS_QLAT), (const bf16*)(ws + WS_BC), (const unsigned short*)(ws + WS_IDX), (const int*)(ws + WS_NCNT), vcu, G, wave);
    SEAM(8);
    if (IN(9)) { Gemm g{(const bf16*)(ws + WS_QLAT), (const bf16*)(ws + WS_W_UVP), 4096, 1024, 1024, 0, 1024}; StaticOrder S; S.init(M, 1024, G, bx); EpiBf16 E{(bf16*)(ws + WS_YB), 1024};
        gemm_phase<EpiBf16, StaticOrder, true>(lds + RING_OFF, g, S, E, wave); }
    SEAM(9);
    if (IN(10)) {
        { Gemm g{(const bf16*)(ws + WS_AQ), (const bf16*)(ws + WS_W_A), 1024, 1024, 1024, 0, 0}; StaticOrder S; S.init(M, D, G, bx); EpiBf16 E{(bf16*)(ws + WS_TA), D}; gemm_phase<EpiBf16, StaticOrder, true>(lds + RING_OFF, g, S, E, wave); }
        { Gemm g{(const bf16*)(ws + WS_YB), (const bf16*)(ws + WS_W_B), 1024, 1024, 1024, 0, 0}; StaticOrder S; S.init(M, D, G, bx); EpiBf16 E{(bf16*)(ws + WS_TB), D}; gemm_phase<EpiBf16, StaticOrder, true>(lds + RING_OFF, g, S, E, wave); }
    }
    SEAM(10);
    if (IN(11)) { Gemm g{X16, (const bf16*)(ws + WS_W_G), D, D, D, 0, 0}; StaticOrder S; S.init(M, 2 * D, G, bx);
        EpiGateMerge E{(const bf16*)(ws + WS_TA), (const bf16*)(ws + WS_TB), (bf16*)(ws + WS_TA), D, args.in[12], args.in[12] + D};
        gemm_phase<EpiGateMerge, StaticOrder, true>(lds + RING_OFF, g, S, E, wave); }
    SEAM(11);
    if (IN(12)) { Gemm g{(const bf16*)(ws + WS_TA), (const bf16*)(ws + WS_W_MO), D, D, D, 0, 0}; StaticOrder S; S.init(M, D, G, bx); EpiRes E{out, out, D, ALPHA, 1.0f}; gemm_phase<EpiRes, StaticOrder, true>(lds + RING_OFF, g, S, E, wave); }
    SEAM(12);
    if (IN(13)) ln_phase(out, X16, ln_g + D, ln_b + D, gw, NGW, lane);
    SEAM(13);
    if (IN(14)) { Gemm g{X16, (const bf16*)(ws + WS_W_MQ), D, D, D, 0, 0}; StaticOrder S; S.init(M, 512, G, bx); EpiBf16 E{(bf16*)(ws + WS_QM), 512}; gemm_phase<EpiBf16, StaticOrder, true>(lds + RING_OFF, g, S, E, wave); }
    SEAM(14);
    if (IN(15)) memattn_simple(lds, (const bf16*)(ws + WS_QM), (const bf16*)(ws + WS_KVMEM), (bf16*)(ws + WS_OM), gw, NGW, wave, lane);
    SEAM(15);
    if (IN(16)) { Gemm g{(const bf16*)(ws + WS_OM), (const bf16*)(ws + WS_W_MOUT), 512, 512, 512, 0, 0}; StaticOrder S; S.init(M, D, G, bx); EpiRes E{out, out, D, ALPHA, 1.0f}; gemm_phase<EpiRes, StaticOrder, true>(lds + RING_OFF, g, S, E, wave); }
    SEAM(16);
    if (IN(17)) ln_phase(out, X16, ln_g + 2 * D, ln_b + 2 * D, gw, NGW, lane);
    SEAM(17);
    if (IN(18)) { Gemm g{X16, (const bf16*)(ws + WS_W_GU2), D, D, D, 0, 0}; StaticOrder S; S.init(M, 2 * FF, G, bx); EpiSwiGLU E{HB, FF}; gemm_phase<EpiSwiGLU, StaticOrder, true>(lds + RING_OFF, g, S, E, wave); }
    SEAM(18);
    if (IN(19)) { Gemm g{HB, (const bf16*)(ws + WS_W_D2), FF, FF, FF, 0, 0}; StaticOrder S; S.init(M, D, G, bx); EpiRes E{out, out, D, ALPHA, 0.5f}; gemm_phase<EpiRes, StaticOrder, true>(lds + RING_OFF, g, S, E, wave); }
    SEAM(19);
    if (IN(20)) ln_phase(out, nullptr, ln_g + 3 * D, ln_b + 3 * D, gw, NGW, lane);
#undef IN
#undef SEAM
#undef lane
}

extern "C" void kernel_launch(void* const* d_in, const int* in_sizes, int n_in, void* d_out, int out_size, void* d_ws, size_t ws_size, hipStream_t stream) {
    static int grid = 0;
    if (grid == 0) {
        if (n_in != 24 || in_sizes[0] != M * D || out_size != M * D || ws_size < WS_END) { fprintf(stderr, "kernel_launch: unexpected shapes (n_in %d, in0 %d, out %d, ws %zu); nothing launched\n", n_in, n_in > 0 ? in_sizes[0] : -1, out_size, ws_size); grid = -1; return; }
        int dev = 0, cus = 0, per_cu = 0;
        if (hipGetDevice(&dev) != hipSuccess || hipDeviceGetAttribute(&cus, hipDeviceAttributeMultiprocessorCount, dev) != hipSuccess) { grid = -1; return; }
        if (hipFuncSetAttribute((const void*)mk_fwd, hipFuncAttributeMaxDynamicSharedMemorySize, LDS_BYTES) != hipSuccess) { fprintf(stderr, "kernel_launch: hipFuncSetAttribute failed\n"); grid = -1; return; }
        if (hipOccupancyMaxActiveBlocksPerMultiprocessor(&per_cu, (const void*)mk_fwd, NWAVES * 64, LDS_BYTES) != hipSuccess || per_cu < 1)
            fprintf(stderr, "kernel_launch: note: the occupancy query reports %d workgroups per CU\n", per_cu);
        (void)hipGetLastError();
        grid = cus;
    }
    if (grid < 0) return;
    if (hipMemsetAsync((char*)d_ws + WS_CTL, 0, CTL_ZERO_BYTES, stream) != hipSuccess) return;
    Args a{};
    for (int i = 0; i < 24; ++i) a.in[i] = (const float*)d_in[i];
    a.out = (float*)d_out; a.ws = (unsigned char*)d_ws;
#if MK_ONE_LAUNCH
    a.ph_lo = 0; a.ph_hi = N_PHASES;
    hipLaunchKernelGGL(mk_fwd, dim3(grid), dim3(NWAVES * 64), LDS_BYTES, stream, a);
#else
    for (int p = 0; p < N_PHASES; ++p) { a.ph_lo = p; a.ph_hi = p + 1; hipLaunchKernelGGL(mk_fwd, dim3(grid), dim3(NWAVES * 64), LDS_BYTES, stream, a); }
#endif
}
```

```cpp
#include <hip/hip_runtime.h>
#include <cstdio>
#include <cstdint>

#ifndef MK_ONE_LAUNCH
#define MK_ONE_LAUNCH 1
#endif

__device__ __forceinline__ int lane_fresh() { int l = (int)__builtin_amdgcn_mbcnt_hi(~0u, __builtin_amdgcn_mbcnt_lo(~0u, 0u)); asm volatile("" : "+v"(l)); return l; }
__device__ __forceinline__ void glds16(const void* gsrc, unsigned lds_dst) { unsigned keep;
    asm volatile("s_mov_b32 %0, m0\n\ts_mov_b32 m0, %2\n\ts_nop 0\n\tglobal_load_lds_dwordx4 %1, off\n\ts_mov_b32 m0, %0" : "=&s"(keep) : "v"(gsrc), "s"(lds_dst) : "memory"); }
namespace pg8 {
#define PG8_LAS __attribute__((address_space(3)))
typedef unsigned short bf16_t;
typedef short bf16x8 __attribute__((ext_vector_type(8)));
typedef float f32x4 __attribute__((ext_vector_type(4)));
typedef unsigned u32x4 __attribute__((ext_vector_type(4)));
constexpr int BM = 256, BK = 64, HALF = 128, HTB = HALF * BK * 2  , STAGE_BYTES = 8 * HTB, NXCD = 8, WGM = 8;

__host__ __device__ __forceinline__ int lds_byte(int r, int c) { const int st = (r >> 4) * 2 + (c >> 5), rr = r & 15, cc = c & 31, ob = rr * 64 + cc * 2; return st * 1024 + (ob ^ (((ob >> 9) & 1) << 5)); }
__host__ __device__ __forceinline__ void stage_rc(int b, int& R, int& C) { const int st = b / 1024, sb = b % 1024, swz = sb ^ (((sb >> 9) & 1) << 5); R = (st >> 1) * 16 + swz / 64; C = (st & 1) * 32 + (swz % 64) / 2; }
__host__ __device__ __forceinline__ int perm32(int rho) { const int n = rho >> 4, i = rho & 15; return 8 * (i >> 2) + 4 * n + (i & 3); }

struct Unit { int pm, pn; };
struct Gemm { const bf16_t* A; const bf16_t* Bt; int lda, ldb, K, a_shift, a_mul; };

struct StaticOrder {
    int nM, nN, nwg, G, c;
    __host__ __device__ void init(int M, int N, int G_, int c_) { nM = M / BM; nN = N / BM; nwg = nM * nN; G = G_; c = c_; }
    __host__ __device__ bool next(int i, Unit& u) const {
        const long L = (long)i * G + c; if (L >= nwg) return false;
        int wgid = (int)L; { const int q = nwg / NXCD, r = nwg % NXCD, xcd = wgid % NXCD, off = wgid / NXCD; wgid = (xcd < r ? xcd * (q + 1) : r * (q + 1) + (xcd - r) * q) + off; }
        const int nig = WGM * nN, gid = wgid / nig, fm = gid * WGM, gsz = (nM - fm) < WGM ? (nM - fm) : WGM;
        u.pm = fm + ((wgid % nig) % gsz); u.pn = (wgid % nig) / gsz; return true;
    }
    __device__ __forceinline__ void a_ready(const Unit&) const {}
    __device__ __forceinline__ void done(const Unit&) const {}
};

__device__ __forceinline__ unsigned cvt_pk_bf16(float lo, float hi) { unsigned r; asm volatile("v_cvt_pk_bf16_f32 %0, %1, %2" : "=v"(r) : "v"(lo), "v"(hi)); return r; }
__device__ __forceinline__ float bflo(unsigned w) { return __uint_as_float(w << 16); }
__device__ __forceinline__ float bfhi(unsigned w) { return __uint_as_float(w & 0xffff0000u); }
__device__ __forceinline__ float sigmoidf_fast(float x) { return __builtin_amdgcn_rcpf(1.0f + __builtin_amdgcn_exp2f(-1.4426950408889634f * x)); }

struct EpiBf16 {
    static constexpr bool PERM = true, AFTER_DRAIN = false;
    bf16_t* O; int ldc; float sc = 1.0f;
    __device__ __forceinline__ void operator()(const f32x4 (&acc)[2][2][4][2], const Unit& u, int wr, int wc, int fr, int fq) const {
        const int row0 = u.pm * BM + wr * 64 + fr, col0 = u.pn * BM + wc * 32 + 8 * fq;
#pragma unroll
        for (int ai = 0; ai < 2; ++ai)
#pragma unroll
            for (int m = 0; m < 4; ++m) { bf16_t* rowp = O + (size_t)(row0 + ai * HALF + m * 16) * ldc + col0;
#pragma unroll
                for (int bj = 0; bj < 2; ++bj) { const f32x4 v0 = acc[ai][bj][m][0] * sc, v1 = acc[ai][bj][m][1] * sc;
                    u32x4 w; w.x = cvt_pk_bf16(v0[0], v0[1]); w.y = cvt_pk_bf16(v0[2], v0[3]); w.z = cvt_pk_bf16(v1[0], v1[1]); w.w = cvt_pk_bf16(v1[2], v1[3]);
                    *(u32x4*)(rowp + bj * HALF) = w; } }
    }
};
struct EpiInProj {
    static constexpr bool PERM = true, AFTER_DRAIN = false;
    bf16_t *aq, *ak, *av, *bq, *bc, *iq, *ikw; float qscale;
    __device__ __forceinline__ void operator()(const f32x4 (&acc)[2][2][4][2], const Unit& u, int wr, int wc, int fr, int fq) const {
        bf16_t* base; int ldc, colt; const int pn = u.pn;
        if (pn < 4) { base = aq; ldc = 1024; colt = pn * 256; }
        else if (pn < 8) { base = ak; ldc = 1024; colt = (pn - 4) * 256; }
        else if (pn < 12) { base = av; ldc = 1024; colt = (pn - 8) * 256; }
        else if (pn < 16) { base = bq; ldc = 1024; colt = (pn - 12) * 256; }
        else if (pn < 18) { base = bc; ldc = 512; colt = (pn - 16) * 256; }
        else if (pn < 22) { base = iq; ldc = 1024; colt = (pn - 18) * 256; }
        else { base = ikw; ldc = 256; colt = 0; }
        const float sc = (pn < 4) ? qscale : 1.0f;
        const int row0 = u.pm * BM + wr * 64 + fr, col0 = colt + wc * 32 + 8 * fq;
#pragma unroll
        for (int ai = 0; ai < 2; ++ai)
#pragma unroll
            for (int m = 0; m < 4; ++m) { bf16_t* rowp = base + (size_t)(row0 + ai * HALF + m * 16) * ldc + col0;
#pragma unroll
                for (int bj = 0; bj < 2; ++bj) { const f32x4 v0 = acc[ai][bj][m][0] * sc, v1 = acc[ai][bj][m][1] * sc;
                    u32x4 w; w.x = cvt_pk_bf16(v0[0], v0[1]); w.y = cvt_pk_bf16(v0[2], v0[3]); w.z = cvt_pk_bf16(v1[0], v1[1]); w.w = cvt_pk_bf16(v1[2], v1[3]);
                    *(u32x4*)(rowp + bj * HALF) = w; } }
    }
};
struct EpiSwiGLU {
    static constexpr bool PERM = true, AFTER_DRAIN = false;
    bf16_t* O; int ldc;
    __device__ __forceinline__ void operator()(const f32x4 (&acc)[2][2][4][2], const Unit& u, int wr, int wc, int fr, int fq) const {
        const int row0 = u.pm * BM + wr * 64 + fr, col0 = u.pn * HALF + wc * 32 + 8 * fq;
#pragma unroll
        for (int ai = 0; ai < 2; ++ai)
#pragma unroll
            for (int m = 0; m < 4; ++m) { bf16_t* rowp = O + (size_t)(row0 + ai * HALF + m * 16) * ldc + col0;
                float h[8];
#pragma unroll
                for (int n = 0; n < 2; ++n)
#pragma unroll
                    for (int j = 0; j < 4; ++j) { const float g = acc[ai][0][m][n][j], up = acc[ai][1][m][n][j]; h[4 * n + j] = g * sigmoidf_fast(g) * up; }
                u32x4 w; w.x = cvt_pk_bf16(h[0], h[1]); w.y = cvt_pk_bf16(h[2], h[3]); w.z = cvt_pk_bf16(h[4], h[5]); w.w = cvt_pk_bf16(h[6], h[7]);
                *(u32x4*)rowp = w; }
    }
};
struct EpiGateMerge {
    static constexpr bool PERM = true, AFTER_DRAIN = false;
    const bf16_t* ta; const bf16_t* tb; bf16_t* O; int ldc; const float* b0; const float* b1;
    __device__ __forceinline__ void operator()(const f32x4 (&acc)[2][2][4][2], const Unit& u, int wr, int wc, int fr, int fq) const {
        const int row0 = u.pm * BM + wr * 64 + fr, col0 = u.pn * HALF + wc * 32 + 8 * fq;
        float bb0[8], bb1[8];
#pragma unroll
        for (int j = 0; j < 8; ++j) { bb0[j] = b0[col0 + j]; bb1[j] = b1[col0 + j]; }
#pragma unroll
        for (int ai = 0; ai < 2; ++ai)
#pragma unroll
            for (int m = 0; m < 4; ++m) { const size_t off = (size_t)(row0 + ai * HALF + m * 16) * ldc + col0;
                const u32x4 a = *(const u32x4*)(ta + off), b = *(const u32x4*)(tb + off);
                const float av[8] = {bflo(a.x), bfhi(a.x), bflo(a.y), bfhi(a.y), bflo(a.z), bfhi(a.z), bflo(a.w), bfhi(a.w)};
                const float bv[8] = {bflo(b.x), bfhi(b.x), bflo(b.y), bfhi(b.y), bflo(b.z), bfhi(b.z), bflo(b.w), bfhi(b.w)};
                float h[8];
#pragma unroll
                for (int n = 0; n < 2; ++n)
#pragma unroll
                    for (int j = 0; j < 4; ++j) { const int e = 4 * n + j; h[e] = sigmoidf_fast(acc[ai][0][m][n][j] + bb0[e]) * av[e] + sigmoidf_fast(acc[ai][1][m][n][j] + bb1[e]) * bv[e]; }
                u32x4 w; w.x = cvt_pk_bf16(h[0], h[1]); w.y = cvt_pk_bf16(h[2], h[3]); w.z = cvt_pk_bf16(h[4], h[5]); w.w = cvt_pk_bf16(h[6], h[7]);
                *(u32x4*)(O + off) = w; }
    }
};
struct EpiRes {
    static constexpr bool PERM = false, AFTER_DRAIN = false;
    const float* res; float* out; int ldc; float alpha, s;
    __device__ __forceinline__ void operator()(const f32x4 (&acc)[2][2][4][2], const Unit& u, int wr, int wc, int fr, int fq) const {
        const int col0 = u.pn * BM + wc * 32 + 4 * fq;
#pragma unroll
        for (int ai = 0; ai < 2; ++ai)
#pragma unroll
            for (int m = 0; m < 4; ++m) { const size_t off = (size_t)(u.pm * BM + ai * HALF + wr * 64 + m * 16 + fr) * ldc + col0;
#pragma unroll
                for (int bj = 0; bj < 2; ++bj)
#pragma unroll
                    for (int n = 0; n < 2; ++n) { const f32x4 r = *(const f32x4*)(res + off + bj * HALF + n * 16); *(f32x4*)(out + off + bj * HALF + n * 16) = r * alpha + acc[ai][bj][m][n] * s; }
                if (m & 1) asm volatile("" ::: "memory"); }
    }
};

template <class Epi, class Sched, bool ALIGN_EPI>
__device__ __forceinline__ void gemm_phase(PG8_LAS unsigned char* lds, const Gemm g, const Sched& S, const Epi& E, const int wid) {
    const int lane = lane_fresh(), tid = wid * 64 + lane, wr = wid >> 2, wc = wid & 3, fr = lane & 15, fq = lane >> 4;
    const int K = g.K, nt = K / BK;
    unsigned voffA[2], voffB[2];
#pragma unroll
    for (int i = 0; i < 2; ++i) { int R, C; stage_rc(tid * 16 + i * 8192, R, C); const int Rb = Epi::PERM ? ((R & ~31) + perm32(R & 31)) : R;
        voffA[i] = (unsigned)(R * g.lda + C) * 2u; voffB[i] = (unsigned)(Rb * g.ldb + C) * 2u; }
    const size_t kstep = (size_t)(BK * 2);
    const size_t hstepA = (size_t)HALF * g.lda * 2, hstepB = (size_t)HALF * g.ldb * 2;
    const size_t tstepA = 2 * hstepA, tstepB = 2 * hstepB;
    const unsigned ldsw = (unsigned)wid * 1024u;
    const int aoff = lds_byte(wr * 64 + fr, fq * 8), boff = lds_byte(wc * 32 + fr, fq * 8);
#define PG8_UA(u) ((const char*)g.A + (size_t)(u).pm * tstepA + (size_t)(((u).pn >> g.a_shift) * g.a_mul) * 2)
#define PG8_UB(u) ((const char*)g.Bt + (size_t)(u).pn * tstepB)
#define PG8_SA(b, h) (((b) * 2 + (h)) * HTB)
#define PG8_SB(b, h) ((4 + (b) * 2 + (h)) * HTB)
#define PG8_STAGE(bufoff, gbase, voff) do { _Pragma("unroll") for (int _i = 0; _i < 2; ++_i) \
        __builtin_amdgcn_global_load_lds((const unsigned*)((const char*)(gbase) + (voff)[_i]), (PG8_LAS unsigned*)(lds + (bufoff) + ldsw + _i * 8192), 16, 0, 0); } while (0)
#define PG8_LDA(dst, b, h) do { _Pragma("unroll") for (int m = 0; m < 4; ++m) _Pragma("unroll") for (int k = 0; k < 2; ++k) dst[m][k] = *(const PG8_LAS bf16x8*)(lds + PG8_SA(b, h) + aoff + m * 2048 + k * 1024); } while (0)
#define PG8_LDB(dst, b, h) do { _Pragma("unroll") for (int n = 0; n < 2; ++n) _Pragma("unroll") for (int k = 0; k < 2; ++k) dst[n][k] = *(const PG8_LAS bf16x8*)(lds + PG8_SB(b, h) + boff + n * 2048 + k * 1024); } while (0)
#define PG8_MMA(ai, bj, At, Bt) do { __builtin_amdgcn_s_setprio(1); _Pragma("unroll") for (int m = 0; m < 4; ++m) _Pragma("unroll") for (int n = 0; n < 2; ++n) _Pragma("unroll") for (int k = 0; k < 2; ++k) \
        acc[ai][bj][m][n] = __builtin_amdgcn_mfma_f32_16x16x32_bf16(Bt[n][k], At[m][k], acc[ai][bj][m][n], 0, 0, 0); __builtin_amdgcn_s_setprio(0); } while (0)
#define PG8_WAIT_V(n) asm volatile("s_waitcnt vmcnt(" #n ")" ::: "memory")
#define PG8_WAIT_L(n) asm volatile("s_waitcnt lgkmcnt(" #n ")" ::: "memory")
#define PG8_BAR __builtin_amdgcn_s_barrier()
#define PG8_SCHED __builtin_amdgcn_sched_barrier(0)
    Unit cur, nxt; int ui = 0;
    if (!S.next(0, cur)) return;
    f32x4 acc[2][2][4][2];
#pragma unroll
    for (int a = 0; a < 2; ++a)
#pragma unroll
        for (int b = 0; b < 2; ++b)
#pragma unroll
            for (int m = 0; m < 4; ++m)
#pragma unroll
                for (int n = 0; n < 2; ++n) acc[a][b][m][n] = (f32x4){0.f, 0.f, 0.f, 0.f};
    bf16x8 At[4][2], B0[2][2], B1[2][2];
    const char* cA = PG8_UA(cur); const char* cB = PG8_UB(cur);
    S.a_ready(cur);
    PG8_STAGE(PG8_SB(0, 0), cB, voffB); PG8_STAGE(PG8_SB(0, 1), cB + hstepB, voffB); PG8_STAGE(PG8_SA(0, 0), cA, voffA); PG8_STAGE(PG8_SA(0, 1), cA + hstepA, voffA);
    if (wr == 1) PG8_BAR;
    PG8_WAIT_V(2); PG8_BAR;
    PG8_STAGE(PG8_SB(1, 0), cB + kstep, voffB); PG8_STAGE(PG8_SA(1, 0), cA + kstep, voffA); PG8_STAGE(PG8_SB(1, 1), cB + hstepB + kstep, voffB);
    PG8_WAIT_V(6); PG8_BAR;
    for (;;) {
        const bool has_next = S.next(ui + 1, nxt);
        const char* nA = has_next ? PG8_UA(nxt) : cA; const char* nB = has_next ? PG8_UB(nxt) : cB;
        for (int t = 0; t < nt; t += 2) {
            const bool last = (t == nt - 2);
            const char* a1 = cA + (size_t)(t + 1) * kstep;
            const char* a2 = last ? nA : cA + (size_t)(t + 2) * kstep; const char* b2 = last ? nB : cB + (size_t)(t + 2) * kstep;
            const char* a3 = a2 + kstep; const char* b3 = b2 + kstep;
            if (last && has_next) S.a_ready(nxt);
            PG8_LDB(B0, 0, 0); PG8_LDB(B1, 0, 1); PG8_SCHED; PG8_LDA(At, 0, 0); PG8_STAGE(PG8_SA(1, 1), a1 + hstepA, voffA);
            PG8_WAIT_V(8); PG8_WAIT_L(0); PG8_BAR; PG8_MMA(0, 0, At, B0); PG8_MMA(0, 1, At, B1); PG8_BAR; PG8_SCHED;
            PG8_LDA(At, 0, 1); PG8_STAGE(PG8_SB(0, 0), b2, voffB); PG8_STAGE(PG8_SB(0, 1), b2 + hstepB, voffB); PG8_STAGE(PG8_SA(0, 0), a2, voffA);
            PG8_WAIT_V(8); PG8_WAIT_L(0); PG8_BAR; PG8_MMA(1, 0, At, B0); PG8_MMA(1, 1, At, B1); PG8_BAR; PG8_SCHED;
            PG8_LDB(B0, 1, 0); PG8_LDB(B1, 1, 1); PG8_SCHED; PG8_LDA(At, 1, 0); PG8_STAGE(PG8_SA(0, 1), a2 + hstepA, voffA);
            PG8_WAIT_V(8); PG8_WAIT_L(0); PG8_BAR; PG8_MMA(0, 0, At, B0); PG8_MMA(0, 1, At, B1); PG8_BAR; PG8_SCHED;
            PG8_LDA(At, 1, 1); PG8_STAGE(PG8_SB(1, 0), b3, voffB); PG8_STAGE(PG8_SB(1, 1), b3 + hstepB, voffB); PG8_STAGE(PG8_SA(1, 0), a3, voffA);
            PG8_WAIT_V(8); PG8_WAIT_L(0); PG8_BAR; PG8_MMA(1, 0, At, B0); PG8_MMA(1, 1, At, B1); PG8_BAR; PG8_SCHED;
        }
        if constexpr (ALIGN_EPI) { if (wr == 0) PG8_BAR; }
        E(acc, cur, wr, wc, fr, fq); S.done(cur);
        if (!has_next) break;
#pragma unroll
        for (int a = 0; a < 2; ++a)
#pragma unroll
            for (int b = 0; b < 2; ++b)
#pragma unroll
                for (int m = 0; m < 4; ++m)
#pragma unroll
                    for (int n = 0; n < 2; ++n) acc[a][b][m][n] = (f32x4){0.f, 0.f, 0.f, 0.f};
        cur = nxt; cA = nA; cB = nB; ++ui;
        if constexpr (ALIGN_EPI) { if (wr == 1) PG8_BAR; }
    }
    PG8_WAIT_V(0);
    if constexpr (!ALIGN_EPI) { if (wr == 0) PG8_BAR; }
    PG8_BAR;
#undef PG8_UA
#undef PG8_UB
#undef PG8_SA
#undef PG8_SB
#undef PG8_STAGE
#undef PG8_LDA
#undef PG8_LDB
#undef PG8_MMA
#undef PG8_WAIT_V
#undef PG8_WAIT_L
#undef PG8_BAR
#undef PG8_SCHED
}
}

constexpr int NWAVES = 8;
constexpr int BATCH = 4, SEQ = 4096, D = 2048, FF = 5632, M = BATCH * SEQ;
constexpr int N_IN = 5888;
constexpr int MEMT = 256;
constexpr float LN_EPS = 1e-5f;
constexpr float ALPHA = 1.189207115002721f;
constexpr float LAMBDA_INIT = 0.2f;

constexpr size_t MiB = 1u << 20;
constexpr size_t WS_CTL = 0, CTL_ZERO_BYTES = 1 * MiB;
constexpr size_t WS_W_IN = 2 * MiB;
constexpr size_t WS_W_G = 25 * MiB;
constexpr size_t WS_W_UK = 41 * MiB;
constexpr size_t WS_W_UVP = 42 * MiB;
constexpr size_t WS_W_A = 44 * MiB;
constexpr size_t WS_W_B = 48 * MiB;
constexpr size_t WS_W_MO = 52 * MiB;
constexpr size_t WS_W_MQ = 60 * MiB;
constexpr size_t WS_W_MKV = 62 * MiB;
constexpr size_t WS_W_MOUT = 66 * MiB;
constexpr size_t WS_MEM16 = 68 * MiB;
constexpr size_t WS_KVMEM = 72 * MiB;
constexpr size_t WS_W_GU2 = 74 * MiB;
constexpr size_t WS_W_D2 = 118 * MiB;
constexpr size_t WS_X16 = 140 * MiB;
constexpr size_t WS_MIX = 204 * MiB;
constexpr size_t WS_W_GU1 = 204 * MiB;
constexpr size_t WS_W_D1 = 248 * MiB;
constexpr size_t WS_H = 270 * MiB;
constexpr size_t WS_AQ = WS_MIX + 0 * MiB, WS_AK = WS_MIX + 32 * MiB, WS_AV = WS_MIX + 64 * MiB, WS_BQ = WS_MIX + 96 * MiB;
constexpr size_t WS_BC = WS_MIX + 128 * MiB;
constexpr size_t WS_IQ = WS_MIX + 144 * MiB;
constexpr size_t WS_IKW = WS_MIX + 176 * MiB;
constexpr size_t WS_QLAT = WS_MIX + 184 * MiB;
constexpr size_t WS_IDX = WS_AK;
constexpr size_t WS_NCNT = WS_AK + 8 * MiB;
constexpr size_t WS_YB = WS_BQ;
constexpr size_t WS_TA = WS_QLAT, WS_TB = WS_QLAT + 64 * MiB;
constexpr size_t WS_QM = WS_AQ, WS_OM = WS_AQ + 16 * MiB;
constexpr size_t WS_END = WS_MIX + 312 * MiB;
static_assert(WS_H + (size_t)M * FF * 2 <= WS_END && WS_QLAT + (size_t)M * 4096 * 2 <= WS_END, "d_ws map");
constexpr int CW_BAR = 4096;

constexpr int RING_OFF = 0, RING_BYTES = 153600;
constexpr int LDSCTL_OFF = RING_BYTES, MISC_OFF = LDSCTL_OFF + 320;
constexpr int LDS_BYTES = 154624;
static_assert(MISC_OFF + 128 <= LDS_BYTES, "LDS map");

#define GAS __attribute__((address_space(1)))
#define LAS __attribute__((address_space(3)))
typedef unsigned short bf16;
typedef unsigned v4u __attribute__((ext_vector_type(4)));
typedef unsigned v2u __attribute__((ext_vector_type(2)));
typedef float f32x4 __attribute__((ext_vector_type(4)));
typedef float f32x16 __attribute__((ext_vector_type(16)));
typedef short bf16x8 __attribute__((ext_vector_type(8)));
typedef GAS unsigned gu32;
#define RLX_AGENT __ATOMIC_RELAXED, __HIP_MEMORY_SCOPE_AGENT
#define LDS_WAIT() asm volatile("s_waitcnt lgkmcnt(0)" ::: "memory")
#define VM_WAIT() asm volatile("s_waitcnt vmcnt(0)" ::: "memory")
__device__ __forceinline__ unsigned f2bf(float f) { unsigned u = __builtin_bit_cast(unsigned, f); return (u + 0x7fffu + ((u >> 16) & 1u)) >> 16; }
__device__ __forceinline__ unsigned pk2(float lo, float hi) { return f2bf(lo) | (f2bf(hi) << 16); }
__device__ __forceinline__ float bf2f(unsigned short v) { return __uint_as_float((unsigned)v << 16); }
__device__ __forceinline__ float blo(unsigned w) { return __uint_as_float(w << 16); }
__device__ __forceinline__ float bhi(unsigned w) { return __uint_as_float(w & 0xffff0000u); }
__device__ __forceinline__ float wave_sum(float v) {
#pragma unroll
    for (int o = 1; o < 64; o <<= 1) v += __shfl_xor(v, o);
    return v;
}

#define XB_TMO      128
#define XB_XCNT(j)  (256  + 64 * (j))
#define XB_XSUB(j)  (1280 + 64 * (j))
#define XB_XGEN(j)  (2304 + 64 * (j))
#define XB_TOP      3328
#define XB_TOPGEN   3392
#define XCD_BAR_WORDS 3456
#define XB_SPIN_CAP (1u << 18)

__device__ __forceinline__ unsigned xb_ld(unsigned* p)              { return __hip_atomic_load(p, __ATOMIC_RELAXED, __HIP_MEMORY_SCOPE_AGENT); }
__device__ __forceinline__ unsigned xb_add(unsigned* p, unsigned v) { return __hip_atomic_fetch_add(p, v, __ATOMIC_RELAXED, __HIP_MEMORY_SCOPE_AGENT); }
__device__ __forceinline__ unsigned xb_xcc_id() { return (unsigned)__builtin_amdgcn_s_getreg((3 << 11) | 20) & 0xFu; }
#define XB_SPIN(cond, bar) do { unsigned _sp = 0; while (cond) { __builtin_amdgcn_s_sleep(1); \
    if ((++_sp & 255u) == 0u) { if (xb_ld(&(bar)[XB_TMO])) break; if (_sp > XB_SPIN_CAP) { atomicAdd(&(bar)[XB_TMO], 1u); break; } } } } while (0)

struct XcdBarrier {
    unsigned* bar; unsigned x;
    volatile LAS unsigned* st;
};

__device__ __forceinline__ XcdBarrier xcd_barrier_post(unsigned* bar, volatile LAS unsigned* st, bool t0) {
    XcdBarrier b; b.bar = bar; b.x = xb_xcc_id(); b.st = st;
    if (t0) (void)xb_add(&bar[XB_XCNT(b.x)], 1u);
    return b;
}
__device__ __forceinline__ void xcd_barrier_complete(unsigned* bar, unsigned x, unsigned& nloc, unsigned& nx) {
    const unsigned G = gridDim.x * gridDim.y * gridDim.z;
    unsigned sum, cnt, mine, sp = 0u;
    for (;;) {
        sum = 0u; cnt = 0u; mine = 0u;
#pragma unroll
        for (unsigned j = 0; j < 16; ++j) { const unsigned c = xb_ld(&bar[XB_XCNT(j)]); sum += c; cnt += (c > 0u) ? 1u : 0u; mine = (j == x) ? c : mine; }
        if (sum == G) break;
        __builtin_amdgcn_s_sleep(1);
        if ((++sp & 255u) == 0u) { if (xb_ld(&bar[XB_TMO])) break; if (sp > XB_SPIN_CAP) { atomicAdd(&bar[XB_TMO], 1u); break; } }
    }
    nloc = mine > 0u ? mine : 1u; nx = cnt > 0u ? cnt : 1u;
}

__device__ __forceinline__ void xcd_barrier(const XcdBarrier& b, const int wave) {
    asm volatile("s_waitcnt vmcnt(0)" ::: "memory");
    __syncthreads();
    if (wave == 0 && lane_fresh() == 0) {
        unsigned* bar = b.bar;
        __builtin_amdgcn_s_waitcnt(0);
        unsigned nloc = b.st[0], nx = b.st[1];
        if (nloc == 0u) { xcd_barrier_complete(bar, b.x, nloc, nx); b.st[0] = nloc; b.st[1] = nx; }
        const unsigned old = xb_add(&bar[XB_XSUB(b.x)], 1u);
        const unsigned gen = old / nloc;
        if (old + 1u == (gen + 1u) * nloc) {
            __builtin_amdgcn_fence(__ATOMIC_RELEASE, "agent");
            asm volatile("s_waitcnt vmcnt(0)" ::: "memory");
            const unsigned og = xb_add(&bar[XB_TOP], 1u);
            const unsigned tg = og / nx;
            if (og + 1u == (tg + 1u) * nx) xb_add(&bar[XB_TOPGEN], 1u);
            else XB_SPIN(xb_ld(&bar[XB_TOPGEN]) == tg, bar);
            __builtin_amdgcn_fence(__ATOMIC_ACQUIRE, "agent");
            xb_add(&bar[XB_XGEN(b.x)], 1u);
            asm volatile("s_waitcnt vmcnt(0)" ::: "memory");
        } else {
            XB_SPIN(xb_ld(&bar[XB_XGEN(b.x)]) == gen, bar);
            __builtin_amdgcn_fence(__ATOMIC_ACQUIRE, "agent");
            asm volatile("s_waitcnt vmcnt(0)" ::: "memory");
        }
    }
    __syncthreads();
}

__device__ __forceinline__ void tr_item(const float* W, int ldw, int nvalid, bf16* WT, int ldt, int k0, int n0, int drow0, int dcol0, LAS float* scr, int lane) {
    const int n = n0 + (lane & 31); const bool ok = n < nvalid;
#pragma unroll 8
    for (int i = 0; i < 32; ++i) { const int kk = 2 * i + (lane >> 5); scr[kk * 33 + (lane & 31)] = ok ? W[(size_t)(k0 + kk) * ldw + n] : 0.f; }
    LDS_WAIT(); asm volatile("" ::: "memory");
    const int c = lane & 7;
#pragma unroll
    for (int j = 0; j < 4; ++j) { const int nn = (lane >> 3) + 8 * j; const LAS float* s = scr + (8 * c) * 33 + nn;
        v4u o; o.x = pk2(s[0 * 33], s[1 * 33]); o.y = pk2(s[2 * 33], s[3 * 33]); o.z = pk2(s[4 * 33], s[5 * 33]); o.w = pk2(s[6 * 33], s[7 * 33]);
        *(GAS v4u*)(WT + (size_t)(drow0 + nn) * ldt + dcol0 + k0 + 8 * c) = o; }
    LDS_WAIT(); asm volatile("" ::: "memory");
}
__device__ __forceinline__ void cvt_item(const float* src, bf16* dst, int item, int lane) {
    const GAS f32x4* s = (const GAS f32x4*)(src + (size_t)item * 512) + 2 * lane; const f32x4 a = s[0], b = s[1];
    v4u o; o.x = pk2(a.x, a.y); o.y = pk2(a.z, a.w); o.z = pk2(b.x, b.y); o.w = pk2(b.z, b.w);
    *((GAS v4u*)(dst + (size_t)item * 512) + lane) = o;
}
__device__ __forceinline__ void p0_prologue(const float* const (&in)[24], unsigned char* ws, LAS unsigned char* lds, int gw, int NGW, int wave, int lane) {
    LAS float* scr = (LAS float*)(lds + RING_OFF + wave * 16384);
#define TRM(SRC, Kk, LDW, NVALID, NPAD, DST, LDT, ROWMAP, DCOL) { constexpr int nblk = (NPAD) / 32; constexpr int cnt = ((Kk) / 64) * nblk; \
        if (r < cnt) { const int kb = r / nblk, nb = r % nblk, n0 = 32 * nb; tr_item(SRC, LDW, NVALID, (bf16*)(ws + (DST)), LDT, 64 * kb, n0, (ROWMAP), (DCOL), scr, lane); continue; } r -= cnt; }
    constexpr int N_TR = 2 * (32 * 176) + 88 * 64 + 32 * 184 + 2 * (32 * 64) + 256 + 2 * (16 * 64) + 32 * 64 + 32 * 16 + 32 * 32 + 8 * 64 + 2 * (32 * 176) + 88 * 64;
    for (int it = gw; it < N_TR; it += NGW) {
        int r = it;
        TRM(in[2], 2048, 5632, 5632, 5632, WS_W_GU1, 2048, 256 * (n0 >> 7) + (n0 & 127), 0)
        TRM(in[3], 2048, 5632, 5632, 5632, WS_W_GU1, 2048, 256 * (n0 >> 7) + 128 + (n0 & 127), 0)
        TRM(in[4], 5632, 2048, 2048, 2048, WS_W_D1, 5632, n0, 0)
        TRM(in[5], 2048, 5712, 5712, 5888, WS_W_IN, 2048, n0, 0)
        TRM(in[11], 2048, 2048, 2048, 2048, WS_W_G, 2048, 256 * (n0 >> 7) + (n0 & 127), 0)
        TRM(in[11] + (size_t)2048 * 2048, 2048, 2048, 2048, 2048, WS_W_G, 2048, 256 * (n0 >> 7) + 128 + (n0 & 127), 0)
        if (r < 256) { const int h = r >> 5, rr = r & 31, kb = rr >> 2, nb = rr & 3;
            tr_item(in[10] + (size_t)h * 512 * 128, 128, 128, (bf16*)(ws + WS_W_UVP), 1024, 64 * kb, 32 * nb, (h >> 1) * 256 + (h & 1) * 128 + 32 * nb, (h & 1) * 512, scr, lane); continue; } r -= 256;
        TRM(in[13], 1024, 2048, 2048, 2048, WS_W_A, 1024, n0, 0)
        TRM(in[14], 1024, 2048, 2048, 2048, WS_W_B, 1024, n0, 0)
        TRM(in[15], 2048, 2048, 2048, 2048, WS_W_MO, 2048, n0, 0)
        TRM(in[16], 2048, 512, 512, 512, WS_W_MQ, 2048, n0, 0)
        TRM(in[17], 2048, 1024, 1024, 1024, WS_W_MKV, 2048, n0, 0)
        TRM(in[18], 512, 2048, 2048, 2048, WS_W_MOUT, 512, n0, 0)
        TRM(in[19], 2048, 5632, 5632, 5632, WS_W_GU2, 2048, 256 * (n0 >> 7) + (n0 & 127), 0)
        TRM(in[20], 2048, 5632, 5632, 5632, WS_W_GU2, 2048, 256 * (n0 >> 7) + 128 + (n0 & 127), 0)
        TRM(in[21], 5632, 2048, 2048, 2048, WS_W_D2, 5632, n0, 0)
    }
#undef TRM
    for (int rw = gw; rw < 1024; rw += NGW) { const int e = (rw >> 7) & 1; *((GAS v4u*)((bf16*)(ws + WS_W_UVP) + (size_t)rw * 1024 + (1 - e) * 512) + lane) = (v4u){0u, 0u, 0u, 0u}; }
    for (int it = gw; it < (M * D) / 512; it += NGW) cvt_item(in[0], (bf16*)(ws + WS_X16), it, lane);
    for (int it = gw; it < (BATCH * MEMT * D) / 512; it += NGW) cvt_item(in[1], (bf16*)(ws + WS_MEM16), it, lane);
    for (int it = gw; it < (8 * 512 * 128) / 512; it += NGW) cvt_item(in[9], (bf16*)(ws + WS_W_UK), it, lane);
}

__device__ __forceinline__ void ln_phase(float* zx, bf16* x16, const float* g, const float* b, int gw, int NGW, int lane) {
    f32x4 gv[8], bv[8];
#pragma unroll
    for (int j = 0; j < 8; ++j) { gv[j] = *((const GAS f32x4*)g + lane + 64 * j); bv[j] = *((const GAS f32x4*)b + lane + 64 * j); }
    for (int m = gw; m < M; m += NGW) {
        GAS f32x4* xr = (GAS f32x4*)(zx + (size_t)m * D) + lane;
        f32x4 v[8]; float s = 0.f;
#pragma unroll
        for (int j = 0; j < 8; ++j) { v[j] = xr[64 * j]; s += (v[j].x + v[j].y) + (v[j].z + v[j].w); }
        const float mean = wave_sum(s) * (1.f / D); float s2 = 0.f;
#pragma unroll
        for (int j = 0; j < 8; ++j) { v[j] = v[j] - mean; s2 += (v[j].x * v[j].x + v[j].y * v[j].y) + (v[j].z * v[j].z + v[j].w * v[j].w); }
        const float rstd = 1.f / sqrtf(wave_sum(s2) * (1.f / D) + LN_EPS);
#pragma unroll
        for (int j = 0; j < 8; ++j) { v[j] = v[j] * rstd * gv[j] + bv[j]; xr[64 * j] = v[j]; }
        if (x16) { GAS v2u* o8 = (GAS v2u*)(x16 + (size_t)m * D) + lane;
#pragma unroll
            for (int j = 0; j < 8; ++j) o8[64 * j] = (v2u){pk2(v[j].x, v[j].y), pk2(v[j].z, v[j].w)}; }
    }
}
__device__ __forceinline__ void crms_phase(bf16* bc, const float* kvg, int gw, int NGW, int lane) {
    float gg[8];
#pragma unroll
    for (int j = 0; j < 8; ++j) gg[j] = kvg[8 * lane + j];
    for (int m = gw; m < M; m += NGW) {
        GAS v4u* p = (GAS v4u*)(bc + (size_t)m * 512) + lane; const v4u w = *p;
        float x[8] = {blo(w.x), bhi(w.x), blo(w.y), bhi(w.y), blo(w.z), bhi(w.z), blo(w.w), bhi(w.w)}; float s = 0.f;
#pragma unroll
        for (int j = 0; j < 8; ++j) s += x[j] * x[j];
        const float r = 1.f / sqrtf(wave_sum(s) * (1.f / 512.f) + LN_EPS);
#pragma unroll
        for (int j = 0; j < 8; ++j) x[j] = x[j] * r * gg[j];
        *p = (v4u){pk2(x[0], x[1]), pk2(x[2], x[3]), pk2(x[4], x[5]), pk2(x[6], x[7])};
    }
}

typedef short v4i16_t __attribute__((ext_vector_type(4)));
__device__ __forceinline__ v4i16_t lds_tr16(const LAS unsigned char* p) { return __builtin_amdgcn_ds_read_tr16_b64_v4i16((LAS v4i16_t*)p); }
__device__ __forceinline__ unsigned cvtpk(float lo, float hi) { typedef float f2 __attribute__((ext_vector_type(2))); typedef __bf16 b2 __attribute__((ext_vector_type(2))); f2 v = {lo, hi}; b2 b = __builtin_convertvector(v, b2); return __builtin_bit_cast(unsigned, b); }
__device__ __forceinline__ float xhalf_f(float v) { return __shfl_xor(v, 32); }
constexpr float LOG2E = 1.4426950408889634f;
constexpr float QSCALE = 0.125f * LOG2E;

__device__ __forceinline__ void diff_attn_mfma(LAS unsigned char* lds, const bf16* AQ, const bf16* AK, const bf16* AV, bf16* YA, const float* dlam, const float* subg, int vcu, int G, const int wave) {
    const int lane = lane_fresh(), r32 = lane & 31, hi = lane >> 5;
    const int comp = wave >> 2, wq = wave & 3;
    const unsigned ksrc = (unsigned)(lane * 1024 + (2 * wave) * 8);
    const unsigned vsrc0 = (unsigned)((16 * ((2 * wave) & 3) + (lane >> 2)) * 1024 + ((2 * wave) >> 2) * 32 + (lane & 3) * 8);
    const unsigned vsrc1 = (unsigned)((16 * ((2 * wave + 1) & 3) + (lane >> 2)) * 1024 + ((2 * wave + 1) >> 2) * 32 + (lane & 3) * 8);
    const unsigned kdst = (unsigned)(2 * wave) * 1024u, vdst0 = 16384u + (unsigned)(((2 * wave) >> 2) * 4096 + ((2 * wave) & 3) * 1024), vdst1 = 16384u + (unsigned)(((2 * wave + 1) >> 2) * 4096 + ((2 * wave + 1) & 3) * 1024);
    const unsigned lds0 = (unsigned)(uintptr_t)lds;
#define DA_STAGE(bo, to) do { \
        glds16(Kg + (to) + ksrc, (unsigned)__builtin_amdgcn_readfirstlane((int)(lds0 + (bo) + kdst))); \
        glds16(Kg + (to) + ksrc + 8, (unsigned)__builtin_amdgcn_readfirstlane((int)(lds0 + (bo) + kdst + 1024))); \
        glds16(Vg + (to) + vsrc0, (unsigned)__builtin_amdgcn_readfirstlane((int)(lds0 + (bo) + vdst0))); \
        glds16(Vg + (to) + vsrc1, (unsigned)__builtin_amdgcn_readfirstlane((int)(lds0 + (bo) + vdst1))); } while (0)
#define DA_WAITBAR() asm volatile("s_waitcnt vmcnt(0) lgkmcnt(0)\n\ts_barrier" ::: "memory")
    const unsigned koff = (unsigned)(((comp * 8 + hi) * 64 + r32) * 16);
    const unsigned voff = (unsigned)(16384 + (4 * hi + ((lane & 15) >> 2)) * 64 + ((lane >> 4) & 1) * 32 + (lane & 3) * 8);
    for (int j = vcu; j < 1024; j += G) {
        const int w = j & 255, i = j >> 8, bh = w >> 3, s8 = w & 7;
        const int ub = (i == 0) ? s8 : (i == 1) ? 15 - s8 : (i == 2) ? 16 + s8 : 31 - s8;
        const int b = bh >> 3, h = bh & 7;
        const float sl2 = LOG2E / (float)(2 << h);
        const size_t rowbase = (size_t)b * SEQ; const int q0 = ub * 128;
        const int qpos = q0 + wq * 32 + r32;
        const int nt = 2 * ub + 2;
        const int myt = 2 * ub + 1 + (wq >> 1);
        const bf16* Kg = AK + rowbase * 1024 + h * 128; const bf16* Vg = AV + rowbase * 1024 + h * 128;
        bf16x8 qr[4];
#pragma unroll
        for (int s = 0; s < 4; ++s) qr[s] = *(const GAS bf16x8*)(AQ + (rowbase + qpos) * 1024 + h * 128 + comp * 64 + s * 16 + hi * 8);
        f32x16 o[4];
#pragma unroll
        for (int blk = 0; blk < 4; ++blk)
#pragma unroll
            for (int r = 0; r < 16; ++r) o[blk][r] = 0.f;
        float mrun = -INFINITY, lrun = 0.f;
        DA_STAGE(0u, (size_t)0);
        DA_WAITBAR();
        for (int kt = 0; kt < nt; ++kt) {
            const unsigned bufo = (unsigned)(kt & 1) * 32768u;
            if (kt + 1 < nt) DA_STAGE(32768u - bufo, (size_t)(kt + 1) * 64 * 1024);
            if (kt < myt) {
                const LAS unsigned char* Kb = lds + bufo + koff;
                f32x16 p0, p1;
#pragma unroll
                for (int r = 0; r < 16; ++r) { p0[r] = 0.f; p1[r] = 0.f; }
                { bf16x8 kf[4];
#pragma unroll
                  for (int s = 0; s < 4; ++s) kf[s] = *(const LAS bf16x8*)(Kb + s * 2048);
#pragma unroll
                  for (int s = 0; s < 4; ++s) p0 = __builtin_amdgcn_mfma_f32_32x32x16_bf16(kf[s], qr[s], p0, 0, 0, 0); }
                { bf16x8 kf[4];
#pragma unroll
                  for (int s = 0; s < 4; ++s) kf[s] = *(const LAS bf16x8*)(Kb + s * 2048 + 512);
#pragma unroll
                  for (int s = 0; s < 4; ++s) p1 = __builtin_amdgcn_mfma_f32_32x32x16_bf16(kf[s], qr[s], p1, 0, 0, 0); }
                const float qth = (float)(qpos - kt * 64 - 4 * hi);
                float rm = -INFINITY;
#pragma unroll
                for (int r = 0; r < 16; ++r) { const float kr = (float)((r & 3) + 8 * (r >> 2)); const float v0 = qth - kr, v1 = qth - (kr + 32.f);
                    p0[r] = p0[r] - sl2 * fabsf(v0); p1[r] = p1[r] - sl2 * fabsf(v1); rm = fmaxf(rm, fmaxf(p0[r], p1[r])); }
                rm = fmaxf(rm, xhalf_f(rm));
                if (__any(rm > mrun)) { const float mn = fmaxf(mrun, rm), f = __builtin_amdgcn_exp2f(mrun - mn); mrun = mn; lrun *= f;
#pragma unroll
                    for (int blk = 0; blk < 4; ++blk)
#pragma unroll
                        for (int r = 0; r < 16; ++r) o[blk][r] *= f; }
                float ls = 0.f;
#pragma unroll
                for (int r = 0; r < 16; ++r) { p0[r] = __builtin_amdgcn_exp2f(p0[r] - mrun); p1[r] = __builtin_amdgcn_exp2f(p1[r] - mrun); ls += p0[r] + p1[r]; }
                lrun += ls;
                bf16x8 pw[4];
#pragma unroll
                for (int s = 0; s < 2; ++s) {
                    v4u a = {cvtpk(p0[8 * s + 0], p0[8 * s + 1]), cvtpk(p0[8 * s + 2], p0[8 * s + 3]), cvtpk(p0[8 * s + 4], p0[8 * s + 5]), cvtpk(p0[8 * s + 6], p0[8 * s + 7])};
                    v4u c = {cvtpk(p1[8 * s + 0], p1[8 * s + 1]), cvtpk(p1[8 * s + 2], p1[8 * s + 3]), cvtpk(p1[8 * s + 4], p1[8 * s + 5]), cvtpk(p1[8 * s + 6], p1[8 * s + 7])};
                    pw[s] = __builtin_bit_cast(bf16x8, a); pw[2 + s] = __builtin_bit_cast(bf16x8, c); }
                const LAS unsigned char* Vb = lds + bufo + voff;
#pragma unroll
                for (int blk = 0; blk < 4; ++blk) {
#pragma unroll
                    for (int s = 0; s < 4; ++s) {
                        const v4i16_t lo = lds_tr16(Vb + blk * 4096 + s * 1024), hh = lds_tr16(Vb + blk * 4096 + s * 1024 + 512);
                        const bf16x8 vf = {lo[0], lo[1], lo[2], lo[3], hh[0], hh[1], hh[2], hh[3]};
                        o[blk] = __builtin_amdgcn_mfma_f32_32x32x16_bf16(vf, pw[s], o[blk], 0, 0, 0);
                    }
                }
            }
            DA_WAITBAR();
        }
        lrun += xhalf_f(lrun);
        const float inv = 1.f / lrun;
        LAS float* Y1 = (LAS float*)(lds) + wq * 4096;
        if (comp == 1) {
            float lam; { float a = dlam[lane] * dlam[64 + lane], bq_ = dlam[128 + lane] * dlam[192 + lane]; a = wave_sum(a); bq_ = wave_sum(bq_); lam = __expf(a) - __expf(bq_) + LAMBDA_INIT; }
            const float sc = inv * lam;
#pragma unroll
            for (int blk = 0; blk < 4; ++blk)
#pragma unroll
                for (int r = 0; r < 16; ++r) Y1[(32 * blk + (r & 3) + 8 * (r >> 2) + 4 * hi) * 32 + r32] = o[blk][r] * sc; }
        __syncthreads();
        if (comp == 0) {
            float ss = 0.f;
#pragma unroll
            for (int blk = 0; blk < 4; ++blk)
#pragma unroll
                for (int r = 0; r < 16; ++r) { const float a = o[blk][r] * inv - Y1[(32 * blk + (r & 3) + 8 * (r >> 2) + 4 * hi) * 32 + r32]; o[blk][r] = a; ss += a * a; }
            ss += xhalf_f(ss);
            const float rr = (1.0f - LAMBDA_INIT) / sqrtf(ss * (1.f / 128.f) + LN_EPS);
            LAS unsigned* stg = (LAS unsigned*)(lds + 65536) + wq * (32 * 65);
#pragma unroll
            for (int blk = 0; blk < 4; ++blk) {
#pragma unroll
                for (int r = 0; r < 16; r += 2) { const int e = 32 * blk + (r & 3) + 8 * (r >> 2) + 4 * hi;
                    stg[r32 * 65 + (e >> 1)] = cvtpk(o[blk][r] * rr * subg[e], o[blk][r + 1] * rr * subg[e + 1]); }
                asm volatile("" ::: "memory"); }
            LDS_WAIT(); asm volatile("" ::: "memory");
            bf16* orow = YA + (rowbase + q0 + wq * 32) * 1024 + h * 128;
#pragma unroll 4
            for (int row = 0; row < 32; ++row) *((GAS unsigned*)(orow + (size_t)row * 1024) + lane) = stg[row * 65 + lane];
        }
        __syncthreads();
    }
#undef DA_STAGE
#undef DA_WAITBAR
}

__device__ __forceinline__ unsigned okey(float f) { const unsigned u = __float_as_uint(f); return (u & 0x80000000u) ? ~u : (u | 0x80000000u); }
__device__ __forceinline__ void indexer_topk(const bf16* IQ, const bf16* IKW, unsigned short* IDX, int* NCNT, int gw, int NGW, int lane) {
    const int r32 = lane & 31, hi = lane >> 5;
    for (int p = gw; p < M / 2; p += NGW) {
        const int c64 = p & 63, b = p >> 11, pic = (p >> 6) & 31;
        const int chunk = (b & 1) ? 63 - c64 : c64;
        const int t0 = b * SEQ + chunk * 64 + 2 * pic;
        const int ngroups = 2 * (chunk + 1);
        bf16x8 a[4];
#pragma unroll
        for (int ks = 0; ks < 4; ++ks) a[ks] = *(const GAS bf16x8*)(IQ + (size_t)(t0 + (r32 >> 4)) * 1024 + (r32 & 15) * 64 + ks * 16 + 8 * hi);
        float wv[16];
#pragma unroll
        for (int r = 0; r < 16; ++r) { const int row = (r & 3) + 8 * (r >> 2) + 4 * hi; wv[r] = bf2f(IKW[(size_t)(t0 + (row >> 4)) * 256 + 64 + (row & 15)]); }
        unsigned key[128];
#pragma unroll
        for (int g = 0; g < 128; ++g) {
            if (g < ngroups) {
                const bf16* kp = IKW + (size_t)(b * SEQ + 32 * g + r32) * 256 + 8 * hi;
                bf16x8 bk[4];
#pragma unroll
                for (int ks = 0; ks < 4; ++ks) bk[ks] = *(const GAS bf16x8*)(kp + ks * 16);
                f32x16 acc = {0.f, 0.f, 0.f, 0.f, 0.f, 0.f, 0.f, 0.f, 0.f, 0.f, 0.f, 0.f, 0.f, 0.f, 0.f, 0.f};
#pragma unroll
                for (int ks = 0; ks < 4; ++ks) acc = __builtin_amdgcn_mfma_f32_32x32x16_bf16(a[ks], bk[ks], acc, 0, 0, 0);
                float s0 = 0.f, s1 = 0.f;
#pragma unroll
                for (int r = 0; r < 8; ++r) { s0 += wv[r] * fmaxf(acc[r], 0.f); s1 += wv[8 + r] * fmaxf(acc[8 + r], 0.f); }
                s0 += __shfl_xor(s0, 32); s1 += __shfl_xor(s1, 32);
                key[g] = okey(hi ? s1 : s0);
            } else key[g] = 0u;
        }
        unsigned T = 0u;
        if (chunk >= 4) {
            bool done = false;
#pragma nounroll
            for (int bit = 31; bit >= 0; --bit) {
                if (__all(done ? 1 : 0)) break;
                const unsigned trial = T | (1u << bit);
                int cnt = 0;
#pragma unroll
                for (int g = 0; g < 128; ++g) cnt += (key[g] >= trial) ? 1 : 0;
                cnt += __shfl_xor(cnt, 1); cnt += __shfl_xor(cnt, 2); cnt += __shfl_xor(cnt, 4); cnt += __shfl_xor(cnt, 8); cnt += __shfl_xor(cnt, 16);
                if (!done && cnt >= 256) { T = trial; if (cnt == 256) done = true; }
            }
        }
        int base = 0;
        unsigned short* ip = IDX + (size_t)(t0 + hi) * 256;
#pragma unroll
        for (int g = 0; g < 128; ++g) {
            if (g < ngroups) {
                const bool sel = key[g] >= T;
                const unsigned long long mk = __ballot(sel ? 1 : 0);
                const unsigned mh = hi ? (unsigned)(mk >> 32) : (unsigned)mk;
                const int pos = base + __popc(mh & ((1u << r32) - 1u));
                if (sel && pos < 256) ip[pos] = (unsigned short)(32 * g + r32);
                base += __popc(mh);
            }
        }
        if (r32 == 0) NCNT[t0 + hi] = base < 256 ? base : 256;
    }
}

__device__ __forceinline__ bf16x8 dpp_shl8(bf16x8 v) {
    v4u u = __builtin_bit_cast(v4u, v);
    u.x = (unsigned)__builtin_amdgcn_update_dpp(0, (int)u.x, 0x108, 0xf, 0xf, true); u.y = (unsigned)__builtin_amdgcn_update_dpp(0, (int)u.y, 0x108, 0xf, 0xf, true);
    u.z = (unsigned)__builtin_amdgcn_update_dpp(0, (int)u.z, 0x108, 0xf, 0xf, true); u.w = (unsigned)__builtin_amdgcn_update_dpp(0, (int)u.w, 0x108, 0xf, 0xf, true);
    return __builtin_bit_cast(bf16x8, u); }
constexpr int DSA_ROWB = 1040;
constexpr int DSA_WAVEB = 16 * DSA_ROWB + 512;
constexpr int DSA_LDS_END = 8 * DSA_WAVEB;
__device__ __forceinline__ void dsa_mfma(LAS unsigned char* lds, const bf16* QL, bf16* OL, const int omask, const bf16* C, const unsigned short* IDX, int vcu, int G, const int wave) {
    const int lane = lane_fresh(), h16 = lane & 15, g = lane >> 4;
    LAS unsigned char* wl = lds + wave * DSA_WAVEB;
    const unsigned wl0 = (unsigned)(uintptr_t)wl;
    LAS unsigned short* idxs = (LAS unsigned short*)(wl + 16 * DSA_ROWB);
    const float sc2 = 0.08838834764831845f * LOG2E;
    const float sl2 = (h16 < 8) ? LOG2E / (float)(2 << (h16 & 7)) : 0.f;
    const int ntok = (G == 256) ? 8 : (M - (vcu * 8 + wave) + G * 8 - 1) / (G * 8);
#define DSA_TOK(i) ((G == 256) ? ((vcu >> 6) * SEQ + (vcu & 63) + 64 * (wave + 8 * (i))) : (vcu * 8 + wave + G * 8 * (i)))
    const unsigned qk_off = (unsigned)(h16 * DSA_ROWB + 16 * g);
    const unsigned pv_off = (unsigned)((4 * g + (h16 >> 2)) * DSA_ROWB + 8 * (lane & 3));
    for (int it = 0; it < ntok; ++it) {
        const int t = DSA_TOK(it); const int tpos = t & (SEQ - 1);
        const int n = (tpos >> 6) >= 3 ? 256 : 64 * ((tpos >> 6) + 1); const int nst = n >> 4;
        const bf16* Cb = C + (size_t)(t >> 12) * SEQ * 512;
        { const v2u iv = *((const GAS v2u*)(IDX + (size_t)t * 256) + lane); *((LAS v2u*)idxs + lane) = iv; }
        bf16x8 qf[8];
#pragma unroll
        for (int s = 0; s < 8; ++s) qf[s] = *(const GAS bf16x8*)(QL + (size_t)t * 4096 + (h16 & 7) * 512 + 32 * (s + 8 * (h16 >> 3)) + 8 * g);
        f32x4 o[32];
#pragma unroll
        for (int blk = 0; blk < 32; ++blk) o[blk] = (f32x4){0.f, 0.f, 0.f, 0.f};
        float mrun = -INFINITY, lrun = 0.f;
        asm volatile("s_waitcnt vmcnt(0) lgkmcnt(0)" ::: "memory");
        for (int st = 0; st < nst; ++st) {
            { const v4u i0 = *(const LAS v4u*)(idxs + st * 16), i1 = *(const LAS v4u*)(idxs + st * 16 + 8);
              const unsigned iw[8] = {i0.x, i0.y, i0.z, i0.w, i1.x, i1.y, i1.z, i1.w};
#pragma unroll
              for (int i = 0; i < 16; ++i) { const int s_ = __builtin_amdgcn_readfirstlane((int)((iw[i >> 1] >> ((i & 1) * 16)) & 0xffffu));
                  glds16(Cb + (size_t)s_ * 512 + lane * 8, (unsigned)__builtin_amdgcn_readfirstlane((int)(wl0 + i * DSA_ROWB))); } }
            asm volatile("s_waitcnt vmcnt(0)" ::: "memory");
            f32x4 acc = {0.f, 0.f, 0.f, 0.f};
#pragma unroll
            for (int s = 0; s < 8; ++s) { const bf16x8 a = *(const LAS bf16x8*)(wl + qk_off + 64 * s); acc = __builtin_amdgcn_mfma_f32_16x16x32_bf16(a, qf[s], acc, 0, 0, 0); }
#pragma unroll
            for (int s = 0; s < 8; ++s) { const bf16x8 a = *(const LAS bf16x8*)(wl + qk_off + 64 * (s + 8)); acc = __builtin_amdgcn_mfma_f32_16x16x32_bf16(a, dpp_shl8(qf[s]), acc, 0, 0, 0); }
            const v2u iq = *(const LAS v2u*)(idxs + st * 16 + 4 * g);
            const int sidx[4] = {(int)(iq.x & 0xffffu), (int)(iq.x >> 16), (int)(iq.y & 0xffffu), (int)(iq.y >> 16)};
            float lg[4];
#pragma unroll
            for (int r = 0; r < 4; ++r) { const int d = tpos - sidx[r]; lg[r] = acc[r] * sc2 - sl2 * (float)(d < 0 ? -d : d); }
            float rm = fmaxf(fmaxf(lg[0], lg[1]), fmaxf(lg[2], lg[3]));
            rm = fmaxf(rm, __shfl_xor(rm, 16)); rm = fmaxf(rm, __shfl_xor(rm, 32));
            const float mn = fmaxf(mrun, rm), f = __builtin_amdgcn_exp2f(mrun - mn); mrun = mn;
#pragma unroll
            for (int r = 0; r < 4; ++r) lg[r] = __builtin_amdgcn_exp2f(lg[r] - mn);
            lrun = lrun * f + ((lg[0] + lg[1]) + (lg[2] + lg[3]));
            const v4u pwu = {cvtpk(lg[0], lg[1]), cvtpk(lg[2], lg[3]), 0u, 0u};
            const bf16x8 pw = __builtin_bit_cast(bf16x8, pwu);
#pragma unroll
            for (int blk = 0; blk < 32; ++blk) {
                const v4i16_t lo = lds_tr16(wl + pv_off + 32 * blk);
                const bf16x8 af = {lo[0], lo[1], lo[2], lo[3], lo[0], lo[1], lo[2], lo[3]};
                o[blk] = __builtin_amdgcn_mfma_f32_16x16x32_bf16(af, pw, o[blk] * f, 0, 0, 0);
                if ((blk & 3) == 3) __builtin_amdgcn_sched_barrier(0);
            }
        }
        float lt = lrun; lt += __shfl_xor(lt, 16); lt += __shfl_xor(lt, 32);
        const float inv = 1.f / lt;
        if (h16 < 8) {
#pragma unroll
            for (int blk = 0; blk < 32; ++blk) { const f32x4 v = o[blk] * inv;
                *(GAS v2u*)(OL + (size_t)(t & omask) * 4096 + h16 * 512 + 16 * blk + 4 * g) = (v2u){cvtpk(v.x, v.y), cvtpk(v.z, v.w)}; } }
    }
    asm volatile("s_waitcnt vmcnt(0) lgkmcnt(0)" ::: "memory");
    __syncthreads();
#undef DSA_TOK
}
static_assert(DSA_LDS_END <= RING_BYTES, "DSA LDS map");

__device__ __forceinline__ void memattn_mfma(LAS unsigned char* lds, const bf16* QM, const bf16* KV, bf16* OM, int vcu, int G, const int wave) {
    const int lane = lane_fresh(), r32 = lane & 31, hi = lane >> 5;
    const unsigned voff = (unsigned)(65536 + (4 * hi + ((lane & 15) >> 2)) * 64 + ((lane >> 4) & 1) * 32 + (lane & 3) * 8);
    for (int j = vcu; j < 256; j += G) {
        const int bh = j >> 4, qb = j & 15, b = bh >> 2, h = bh & 3;
        const bf16* Kg = KV + (size_t)b * MEMT * 1024 + h * 128; const bf16* Vg = Kg + 512;
#pragma unroll
        for (int i = 0; i < 8; ++i) { const int q = 8 * wave + i;
            glds16(Kg + (size_t)(64 * (q & 3) + lane) * 1024 + (q >> 2) * 8, (unsigned)__builtin_amdgcn_readfirstlane((int)((unsigned)(uintptr_t)lds + ((q >> 2) * 256 + 64 * (q & 3)) * 16)));
            glds16(Vg + (size_t)(16 * (q & 15) + (lane >> 2)) * 1024 + (q >> 4) * 32 + (lane & 3) * 8, (unsigned)__builtin_amdgcn_readfirstlane((int)((unsigned)(uintptr_t)lds + 65536 + (q >> 4) * 16384 + (q & 15) * 1024))); }
        const size_t qrow = (size_t)b * SEQ + qb * 256 + wave * 32 + r32;
        bf16x8 qr[8];
#pragma unroll
        for (int s = 0; s < 8; ++s) qr[s] = *(const GAS bf16x8*)(QM + qrow * 512 + h * 128 + s * 16 + hi * 8);
        f32x16 o[4];
#pragma unroll
        for (int blk = 0; blk < 4; ++blk)
#pragma unroll
            for (int r = 0; r < 16; ++r) o[blk][r] = 0.f;
        float mrun = -INFINITY, lrun = 0.f;
        asm volatile("s_waitcnt vmcnt(0) lgkmcnt(0)\n\ts_barrier" ::: "memory");
        for (int kt = 0; kt < 4; ++kt) {
            const LAS unsigned char* Kb = lds + (unsigned)((hi * 256 + 64 * kt + r32) * 16);
            f32x16 p0, p1;
#pragma unroll
            for (int r = 0; r < 16; ++r) { p0[r] = 0.f; p1[r] = 0.f; }
#pragma unroll
            for (int s = 0; s < 8; ++s) { const bf16x8 k0 = *(const LAS bf16x8*)(Kb + s * 8192), k1 = *(const LAS bf16x8*)(Kb + s * 8192 + 512);
                p0 = __builtin_amdgcn_mfma_f32_32x32x16_bf16(k0, qr[s], p0, 0, 0, 0); p1 = __builtin_amdgcn_mfma_f32_32x32x16_bf16(k1, qr[s], p1, 0, 0, 0); }
            float rm = -INFINITY;
#pragma unroll
            for (int r = 0; r < 16; ++r) rm = fmaxf(rm, fmaxf(p0[r], p1[r]));
            rm = fmaxf(rm, xhalf_f(rm));
            if (__any(rm > mrun)) { const float mn = fmaxf(mrun, rm), f = __builtin_amdgcn_exp2f(mrun - mn); mrun = mn; lrun *= f;
#pragma unroll
                for (int blk = 0; blk < 4; ++blk)
#pragma unroll
                    for (int r = 0; r < 16; ++r) o[blk][r] *= f; }
            float ls = 0.f;
#pragma unroll
            for (int r = 0; r < 16; ++r) { p0[r] = __builtin_amdgcn_exp2f(p0[r] - mrun); p1[r] = __builtin_amdgcn_exp2f(p1[r] - mrun); ls += p0[r] + p1[r]; }
            lrun += ls;
            bf16x8 pw[4];
#pragma unroll
            for (int s = 0; s < 2; ++s) {
                v4u a = {cvtpk(p0[8 * s + 0], p0[8 * s + 1]), cvtpk(p0[8 * s + 2], p0[8 * s + 3]), cvtpk(p0[8 * s + 4], p0[8 * s + 5]), cvtpk(p0[8 * s + 6], p0[8 * s + 7])};
                v4u c = {cvtpk(p1[8 * s + 0], p1[8 * s + 1]), cvtpk(p1[8 * s + 2], p1[8 * s + 3]), cvtpk(p1[8 * s + 4], p1[8 * s + 5]), cvtpk(p1[8 * s + 6], p1[8 * s + 7])};
                pw[s] = __builtin_bit_cast(bf16x8, a); pw[2 + s] = __builtin_bit_cast(bf16x8, c); }
            const LAS unsigned char* Vb = lds + voff + kt * 4096;
#pragma unroll
            for (int blk = 0; blk < 4; ++blk) {
#pragma unroll
                for (int s = 0; s < 4; ++s) {
                    const v4i16_t lo = lds_tr16(Vb + blk * 16384 + s * 1024), hh = lds_tr16(Vb + blk * 16384 + s * 1024 + 512);
                    const bf16x8 vf = {lo[0], lo[1], lo[2], lo[3], hh[0], hh[1], hh[2], hh[3]};
                    o[blk] = __builtin_amdgcn_mfma_f32_32x32x16_bf16(vf, pw[s], o[blk], 0, 0, 0);
                }
            }
        }
        __syncthreads();
        lrun += xhalf_f(lrun);
        const float inv = 1.f / lrun;
        LAS unsigned* stg = (LAS unsigned*)(lds) + wave * (32 * 65);
#pragma unroll
        for (int blk = 0; blk < 4; ++blk)
#pragma unroll
            for (int r = 0; r < 16; r += 2) { const int e = 32 * blk + (r & 3) + 8 * (r >> 2) + 4 * hi;
                stg[r32 * 65 + (e >> 1)] = cvtpk(o[blk][r] * inv, o[blk][r + 1] * inv); }
        LDS_WAIT(); asm volatile("" ::: "memory");
        bf16* orow = OM + ((size_t)b * SEQ + qb * 256 + wave * 32) * 512 + h * 128;
#pragma unroll 4
        for (int row = 0; row < 32; ++row) *((GAS unsigned*)(orow + (size_t)row * 512) + lane) = stg[row * 65 + lane];
        __syncthreads();
    }
}

constexpr int N_PHASES = 21;
struct Args { const float* in[24]; float* out; unsigned char* ws; int ph_lo, ph_hi; };
__global__ void __launch_bounds__(NWAVES * 64, 2) mk_fwd(Args args) {
    extern __shared__ __attribute__((aligned(16))) unsigned char lds_raw[];
    LAS unsigned char* lds = (LAS unsigned char*)lds_raw;
    volatile LAS unsigned* MISC = (volatile LAS unsigned*)(lds + MISC_OFF);
    const int tid = threadIdx.x, wave = __builtin_amdgcn_readfirstlane(tid >> 6);
#define lane lane_fresh()
    const int G = gridDim.x, bx = blockIdx.x;
    const int vcu = (G % 8 == 0) ? (bx % 8) * (G / 8) + bx / 8 : bx;
    const int gw = vcu * NWAVES + wave, NGW = G * NWAVES;
    unsigned char* ws = args.ws;
    gu32* ctl = (gu32*)(ws + WS_CTL);
    for (int u = tid; u < (LDS_BYTES - LDSCTL_OFF) / 4; u += NWAVES * 64) ((LAS unsigned*)(lds + LDSCTL_OFF))[u] = 0u;
    __syncthreads();
    const bool one = (args.ph_hi - args.ph_lo) > 1;
    XcdBarrier bar; bar.bar = (unsigned*)(ctl + CW_BAR); bar.x = 0; bar.st = nullptr;
    if (one) bar = xcd_barrier_post((unsigned*)(ctl + CW_BAR), MISC + 8, tid == 0);
    const int lo = args.ph_lo, hi = args.ph_hi;
#ifndef PH_MASK
#define PH_MASK 0xFFFFFFFFu
#endif
#define IN(k) ((((PH_MASK) >> (k)) & 1u) && lo <= (k) && (k) < hi)
#define SEAM(k) do { if (IN(k) && IN((k) + 1)) xcd_barrier(bar, wave); } while (0)
    bf16* const X16 = (bf16*)(ws + WS_X16); bf16* const HB = (bf16*)(ws + WS_H);
    float* const out = args.out;
    const float* const ln_g = args.in[22]; const float* const ln_b = args.in[23];
    using namespace pg8;

#ifdef PROBE_P0
    if (IN(0)) { p0_prologue(args.in, ws, lds, gw, NGW, wave, lane); }
#endif
    if (IN(0)) { p0_prologue(args.in, ws, lds, gw, NGW, wave, lane); }
    SEAM(0);
    if (IN(1)) { Gemm g{X16, (const bf16*)(ws + WS_W_GU1), D, D, D, 0, 0}; StaticOrder S; S.init(M, 2 * FF, G, bx); EpiSwiGLU E{HB, FF}; gemm_phase<EpiSwiGLU, StaticOrder, true>(lds + RING_OFF, g, S, E, wave); }
    SEAM(1);
    if (IN(2)) { Gemm g{HB, (const bf16*)(ws + WS_W_D1), FF, FF, FF, 0, 0}; StaticOrder S; S.init(M, D, G, bx); EpiRes E{args.in[0], out, D, ALPHA, 0.5f}; gemm_phase<EpiRes, StaticOrder, true>(lds + RING_OFF, g, S, E, wave); }
    SEAM(2);
    if (IN(3)) ln_phase(out, X16, ln_g, ln_b, gw, NGW, lane);
    SEAM(3);
    if (IN(4)) {
        { Gemm g{X16, (const bf16*)(ws + WS_W_IN), D, D, D, 0, 0}; StaticOrder S; S.init(M, N_IN, G, bx);
          EpiInProj E{(bf16*)(ws + WS_AQ), (bf16*)(ws + WS_AK), (bf16*)(ws + WS_AV), (bf16*)(ws + WS_BQ), (bf16*)(ws + WS_BC), (bf16*)(ws + WS_IQ), (bf16*)(ws + WS_IKW), QSCALE};
          gemm_phase<EpiInProj, StaticOrder, true>(lds + RING_OFF, g, S, E, wave); }
        { Gemm g{(const bf16*)(ws + WS_MEM16), (const bf16*)(ws + WS_W_MKV), D, D, D, 0, 0}; StaticOrder S; S.init(BATCH * MEMT, 1024, G, bx); EpiBf16 E{(bf16*)(ws + WS_KVMEM), 1024};
          gemm_phase<EpiBf16, StaticOrder, true>(lds + RING_OFF, g, S, E, wave); }
    }
    SEAM(4);
    if (IN(5)) {
        { Gemm g{(const bf16*)(ws + WS_BQ), (const bf16*)(ws + WS_W_UK), 1024, 128, 128, 1, 128}; StaticOrder S; S.init(M, 4096, G, bx); EpiBf16 E{(bf16*)(ws + WS_QLAT), 4096};
          gemm_phase<EpiBf16, StaticOrder, true>(lds + RING_OFF, g, S, E, wave); }
        crms_phase((bf16*)(ws + WS_BC), args.in[8], gw, NGW, lane);
    }
    SEAM(5);
#ifdef PROBE_P6
    if (IN(6)) diff_attn_mfma(lds, (const bf16*)(ws + WS_AQ), (const bf16*)(ws + WS_AK), (const bf16*)(ws + WS_AV), (bf16*)(ws + WS_BQ), args.in[6], args.in[7], vcu, G, wave);
#endif
    if (IN(6)) diff_attn_mfma(lds, (const bf16*)(ws + WS_AQ), (const bf16*)(ws + WS_AK), (const bf16*)(ws + WS_AV), (bf16*)(ws + WS_AQ), args.in[6], args.in[7], vcu, G, wave);
    SEAM(6);
#ifdef PROBE_P7
    if (IN(7)) indexer_topk((const bf16*)(ws + WS_IQ), (const bf16*)(ws + WS_IKW), (unsigned short*)(ws + WS_IDX), (int*)(ws + WS_NCNT), gw, NGW, lane);
#endif
    if (IN(7)) indexer_topk((const bf16*)(ws + WS_IQ), (const bf16*)(ws + WS_IKW), (unsigned short*)(ws + WS_IDX), (int*)(ws + WS_NCNT), gw, NGW, lane);
    SEAM(7);
#ifdef PROBE_P8
    if (IN(8)) dsa_mfma(lds, (const bf16*)(ws + WS_QLAT), (bf16*)(ws + WS_AV), 1023, (const bf16*)(ws + WS_BC), (const unsigned short*)(ws + WS_IDX), vcu, G, wave);
#endif
    if (IN(8)) dsa_mfma(lds, (const bf16*)(ws + WS_QLAT), (bf16*)(ws + WS_QLAT), 0x7fffffff, (const bf16*)(ws + WS_BC), (const unsigned short*)(ws + WS_IDX), vcu, G, wave);
    SEAM(8);
    if (IN(9)) { Gemm g{(const bf16*)(ws + WS_QLAT), (const bf16*)(ws + WS_W_UVP), 4096, 1024, 1024, 0, 1024}; StaticOrder S; S.init(M, 1024, G, bx); EpiBf16 E{(bf16*)(ws + WS_YB), 1024};
        gemm_phase<EpiBf16, StaticOrder, true>(lds + RING_OFF, g, S, E, wave); }
    SEAM(9);
    if (IN(10)) {
        { Gemm g{(const bf16*)(ws + WS_AQ), (const bf16*)(ws + WS_W_A), 1024, 1024, 1024, 0, 0}; StaticOrder S; S.init(M, D, G, bx); EpiBf16 E{(bf16*)(ws + WS_TA), D}; gemm_phase<EpiBf16, StaticOrder, true>(lds + RING_OFF, g, S, E, wave); }
        { Gemm g{(const bf16*)(ws + WS_YB), (const bf16*)(ws + WS_W_B), 1024, 1024, 1024, 0, 0}; StaticOrder S; S.init(M, D, G, bx); EpiBf16 E{(bf16*)(ws + WS_TB), D}; gemm_phase<EpiBf16, StaticOrder, true>(lds + RING_OFF, g, S, E, wave); }
    }
    SEAM(10);
    if (IN(11)) { Gemm g{X16, (const bf16*)(ws + WS_W_G), D, D, D, 0, 0}; StaticOrder S; S.init(M, 2 * D, G, bx);
        EpiGateMerge E{(const bf16*)(ws + WS_TA), (const bf16*)(ws + WS_TB), (bf16*)(ws + WS_TA), D, args.in[12], args.in[12] + D};
        gemm_phase<EpiGateMerge, StaticOrder, true>(lds + RING_OFF, g, S, E, wave); }
    SEAM(11);
    if (IN(12)) { Gemm g{(const bf16*)(ws + WS_TA), (const bf16*)(ws + WS_W_MO), D, D, D, 0, 0}; StaticOrder S; S.init(M, D, G, bx); EpiRes E{out, out, D, ALPHA, 1.0f}; gemm_phase<EpiRes, StaticOrder, true>(lds + RING_OFF, g, S, E, wave); }
    SEAM(12);
    if (IN(13)) ln_phase(out, X16, ln_g + D, ln_b + D, gw, NGW, lane);
    SEAM(13);
    if (IN(14)) { Gemm g{X16, (const bf16*)(ws + WS_W_MQ), D, D, D, 0, 0}; StaticOrder S; S.init(M, 512, G, bx); EpiBf16 E{(bf16*)(ws + WS_QM), 512, 0.08838834764831845f * LOG2E}; gemm_phase<EpiBf16, StaticOrder, true>(lds + RING_OFF, g, S, E, wave); }
    SEAM(14);
    if (IN(15)) memattn_mfma(lds, (const bf16*)(ws + WS_QM), (const bf16*)(ws + WS_KVMEM), (bf16*)(ws + WS_OM), vcu, G, wave);
    SEAM(15);
    if (IN(16)) { Gemm g{(const bf16*)(ws + WS_OM), (const bf16*)(ws + WS_W_MOUT), 512, 512, 512, 0, 0}; StaticOrder S; S.init(M, D, G, bx); EpiRes E{out, out, D, ALPHA, 1.0f}; gemm_phase<EpiRes, StaticOrder, true>(lds + RING_OFF, g, S, E, wave); }
    SEAM(16);
    if (IN(17)) ln_phase(out, X16, ln_g + 2 * D, ln_b + 2 * D, gw, NGW, lane);
    SEAM(17);
    if (IN(18)) { Gemm g{X16, (const bf16*)(ws + WS_W_GU2), D, D, D, 0, 0}; StaticOrder S; S.init(M, 2 * FF, G, bx); EpiSwiGLU E{HB, FF}; gemm_phase<EpiSwiGLU, StaticOrder, true>(lds + RING_OFF, g, S, E, wave); }
    SEAM(18);
    if (IN(19)) { Gemm g{HB, (const bf16*)(ws + WS_W_D2), FF, FF, FF, 0, 0}; StaticOrder S; S.init(M, D, G, bx); EpiRes E{out, out, D, ALPHA, 0.5f}; gemm_phase<EpiRes, StaticOrder, true>(lds + RING_OFF, g, S, E, wave); }
    SEAM(19);
    if (IN(20)) ln_phase(out, nullptr, ln_g + 3 * D, ln_b + 3 * D, gw, NGW, lane);
#undef IN
#undef SEAM
#undef lane
}

extern "C" void kernel_launch(void* const* d_in, const int* in_sizes, int n_in, void* d_out, int out_size, void* d_ws, size_t ws_size, hipStream_t stream) {
    static int grid = 0;
    if (grid == 0) {
        if (n_in != 24 || in_sizes[0] != M * D || out_size != M * D || ws_size < WS_END) { fprintf(stderr, "kernel_launch: unexpected shapes (n_in %d, in0 %d, out %d, ws %zu); nothing launched\n", n_in, n_in > 0 ? in_sizes[0] : -1, out_size, ws_size); grid = -1; return; }
        int dev = 0, cus = 0, per_cu = 0;
        if (hipGetDevice(&dev) != hipSuccess || hipDeviceGetAttribute(&cus, hipDeviceAttributeMultiprocessorCount, dev) != hipSuccess) { grid = -1; return; }
        if (hipFuncSetAttribute((const void*)mk_fwd, hipFuncAttributeMaxDynamicSharedMemorySize, LDS_BYTES) != hipSuccess) { fprintf(stderr, "kernel_launch: hipFuncSetAttribute failed\n"); grid = -1; return; }
        if (hipOccupancyMaxActiveBlocksPerMultiprocessor(&per_cu, (const void*)mk_fwd, NWAVES * 64, LDS_BYTES) != hipSuccess || per_cu < 1)
            fprintf(stderr, "kernel_launch: note: the occupancy query reports %d workgroups per CU\n", per_cu);
        (void)hipGetLastError();
        grid = cus;
    }
    if (grid < 0) return;
    if (hipMemsetAsync((char*)d_ws + WS_CTL, 0, CTL_ZERO_BYTES, stream) != hipSuccess) return;
    Args a{};
    for (int i = 0; i < 24; ++i) a.in[i] = (const float*)d_in[i];
    a.out = (float*)d_out; a.ws = (unsigned char*)d_ws;
#if MK_ONE_LAUNCH
    a.ph_lo = 0; a.ph_hi = N_PHASES;
    hipLaunchKernelGGL(mk_fwd, dim3(grid), dim3(NWAVES * 64), LDS_BYTES, stream, a);
#else
    for (int p = 0; p < N_PHASES; ++p) { a.ph_lo = p; a.ph_hi = p + 1; hipLaunchKernelGGL(mk_fwd, dim3(grid), dim3(NWAVES * 64), LDS_BYTES, stream, a); }
#endif
}
```

```cpp
#include <hip/hip_runtime.h>
#include <cstdio>
#include <cstdint>

#ifndef MK_ONE_LAUNCH
#define MK_ONE_LAUNCH 1
#endif

__device__ __forceinline__ int lane_fresh() { int l = (int)__builtin_amdgcn_mbcnt_hi(~0u, __builtin_amdgcn_mbcnt_lo(~0u, 0u)); asm volatile("" : "+v"(l)); return l; }
__device__ __forceinline__ void glds16(const void* gsrc, unsigned lds_dst) { unsigned keep;
    asm volatile("s_mov_b32 %0, m0\n\ts_mov_b32 m0, %2\n\ts_nop 0\n\tglobal_load_lds_dwordx4 %1, off\n\ts_mov_b32 m0, %0" : "=&s"(keep) : "v"(gsrc), "s"(lds_dst) : "memory"); }
namespace pg8 {
#define PG8_LAS __attribute__((address_space(3)))
typedef unsigned short bf16_t;
typedef short bf16x8 __attribute__((ext_vector_type(8)));
typedef float f32x4 __attribute__((ext_vector_type(4)));
typedef unsigned u32x4 __attribute__((ext_vector_type(4)));
constexpr int BM = 256, BK = 64, HALF = 128, HTB = HALF * BK * 2  , STAGE_BYTES = 8 * HTB, NXCD = 8, WGM = 8;

__host__ __device__ __forceinline__ int lds_byte(int r, int c) { const int st = (r >> 4) * 2 + (c >> 5), rr = r & 15, cc = c & 31, ob = rr * 64 + cc * 2; return st * 1024 + (ob ^ (((ob >> 9) & 1) << 5)); }
__host__ __device__ __forceinline__ void stage_rc(int b, int& R, int& C) { const int st = b / 1024, sb = b % 1024, swz = sb ^ (((sb >> 9) & 1) << 5); R = (st >> 1) * 16 + swz / 64; C = (st & 1) * 32 + (swz % 64) / 2; }
__host__ __device__ __forceinline__ int perm32(int rho) { const int n = rho >> 4, i = rho & 15; return 8 * (i >> 2) + 4 * n + (i & 3); }

struct Unit { int pm, pn; };
struct Gemm { const bf16_t* A; const bf16_t* Bt; int lda, ldb, K, a_shift, a_mul; };

struct StaticOrder {
    int nM, nN, nwg, G, c;
    __host__ __device__ void init(int M, int N, int G_, int c_) { nM = M / BM; nN = N / BM; nwg = nM * nN; G = G_; c = c_; }
    __host__ __device__ bool next(int i, Unit& u) const {
        const long L = (long)i * G + c; if (L >= nwg) return false;
        int wgid = (int)L; { const int q = nwg / NXCD, r = nwg % NXCD, xcd = wgid % NXCD, off = wgid / NXCD; wgid = (xcd < r ? xcd * (q + 1) : r * (q + 1) + (xcd - r) * q) + off; }
        const int nig = WGM * nN, gid = wgid / nig, fm = gid * WGM, gsz = (nM - fm) < WGM ? (nM - fm) : WGM;
        u.pm = fm + ((wgid % nig) % gsz); u.pn = (wgid % nig) / gsz; return true;
    }
    __device__ __forceinline__ void a_ready(const Unit&) const {}
    __device__ __forceinline__ void done(const Unit&) const {}
};

__device__ __forceinline__ unsigned cvt_pk_bf16(float lo, float hi) { unsigned r; asm volatile("v_cvt_pk_bf16_f32 %0, %1, %2" : "=v"(r) : "v"(lo), "v"(hi)); return r; }
__device__ __forceinline__ float bflo(unsigned w) { return __uint_as_float(w << 16); }
__device__ __forceinline__ float bfhi(unsigned w) { return __uint_as_float(w & 0xffff0000u); }
__device__ __forceinline__ float sigmoidf_fast(float x) { return __builtin_amdgcn_rcpf(1.0f + __builtin_amdgcn_exp2f(-1.4426950408889634f * x)); }

struct EpiBf16 {
    static constexpr bool PERM = true, AFTER_DRAIN = false;
    bf16_t* O; int ldc; float sc = 1.0f;
    __device__ __forceinline__ void operator()(const f32x4 (&acc)[2][2][4][2], const Unit& u, int wr, int wc, int fr, int fq) const {
        const int row0 = u.pm * BM + wr * 64 + fr, col0 = u.pn * BM + wc * 32 + 8 * fq;
#pragma unroll
        for (int ai = 0; ai < 2; ++ai)
#pragma unroll
            for (int m = 0; m < 4; ++m) { bf16_t* rowp = O + (size_t)(row0 + ai * HALF + m * 16) * ldc + col0;
#pragma unroll
                for (int bj = 0; bj < 2; ++bj) { const f32x4 v0 = acc[ai][bj][m][0] * sc, v1 = acc[ai][bj][m][1] * sc;
                    u32x4 w; w.x = cvt_pk_bf16(v0[0], v0[1]); w.y = cvt_pk_bf16(v0[2], v0[3]); w.z = cvt_pk_bf16(v1[0], v1[1]); w.w = cvt_pk_bf16(v1[2], v1[3]);
                    *(u32x4*)(rowp + bj * HALF) = w; } }
    }
};
struct EpiInProj {
    static constexpr bool PERM = true, AFTER_DRAIN = false;
    bf16_t *aq, *ak, *av, *bq, *bc, *iq, *ikw; float qscale;
    __device__ __forceinline__ void operator()(const f32x4 (&acc)[2][2][4][2], const Unit& u, int wr, int wc, int fr, int fq) const {
        bf16_t* base; int ldc, colt; const int pn = u.pn;
        if (pn < 4) { base = aq; ldc = 1024; colt = pn * 256; }
        else if (pn < 8) { base = ak; ldc = 1024; colt = (pn - 4) * 256; }
        else if (pn < 12) { base = av; ldc = 1024; colt = (pn - 8) * 256; }
        else if (pn < 16) { base = bq; ldc = 1024; colt = (pn - 12) * 256; }
        else if (pn < 18) { base = bc; ldc = 512; colt = (pn - 16) * 256; }
        else if (pn < 22) { base = iq; ldc = 1024; colt = (pn - 18) * 256; }
        else { base = ikw; ldc = 256; colt = 0; }
        const float sc = (pn < 4) ? qscale : 1.0f;
        const int row0 = u.pm * BM + wr * 64 + fr, col0 = colt + wc * 32 + 8 * fq;
#pragma unroll
        for (int ai = 0; ai < 2; ++ai)
#pragma unroll
            for (int m = 0; m < 4; ++m) { bf16_t* rowp = base + (size_t)(row0 + ai * HALF + m * 16) * ldc + col0;
#pragma unroll
                for (int bj = 0; bj < 2; ++bj) { const f32x4 v0 = acc[ai][bj][m][0] * sc, v1 = acc[ai][bj][m][1] * sc;
                    u32x4 w; w.x = cvt_pk_bf16(v0[0], v0[1]); w.y = cvt_pk_bf16(v0[2], v0[3]); w.z = cvt_pk_bf16(v1[0], v1[1]); w.w = cvt_pk_bf16(v1[2], v1[3]);
                    *(u32x4*)(rowp + bj * HALF) = w; } }
    }
};
struct EpiSwiGLU {
    static constexpr bool PERM = true, AFTER_DRAIN = false;
    bf16_t* O; int ldc;
    __device__ __forceinline__ void operator()(const f32x4 (&acc)[2][2][4][2], const Unit& u, int wr, int wc, int fr, int fq) const {
        const int row0 = u.pm * BM + wr * 64 + fr, col0 = u.pn * HALF + wc * 32 + 8 * fq;
#pragma unroll
        for (int ai = 0; ai < 2; ++ai)
#pragma unroll
            for (int m = 0; m < 4; ++m) { bf16_t* rowp = O + (size_t)(row0 + ai * HALF + m * 16) * ldc + col0;
                float h[8];
#pragma unroll
                for (int n = 0; n < 2; ++n)
#pragma unroll
                    for (int j = 0; j < 4; ++j) { const float g = acc[ai][0][m][n][j], up = acc[ai][1][m][n][j]; h[4 * n + j] = g * sigmoidf_fast(g) * up; }
                u32x4 w; w.x = cvt_pk_bf16(h[0], h[1]); w.y = cvt_pk_bf16(h[2], h[3]); w.z = cvt_pk_bf16(h[4], h[5]); w.w = cvt_pk_bf16(h[6], h[7]);
                *(u32x4*)rowp = w; }
    }
};
__device__ __forceinline__ unsigned pk4_fp8(float a, float b, float c, float d) { int w = 0; w = __builtin_amdgcn_cvt_pk_fp8_f32(a, b, w, false); w = __builtin_amdgcn_cvt_pk_fp8_f32(c, d, w, true); return (unsigned)w; }
struct EpiSwiGLU8 {
    static constexpr bool PERM = true, AFTER_DRAIN = false;
    unsigned char* O; int ldc; float ascale, hs;
    __device__ __forceinline__ void operator()(const f32x4 (&acc)[2][2][4][2], const Unit& u, int wr, int wc, int fr, int fq) const {
        const int row0 = u.pm * BM + wr * 64 + fr, col0 = u.pn * HALF + wc * 32 + 8 * fq;
        typedef unsigned u32x2 __attribute__((ext_vector_type(2)));
#pragma unroll
        for (int ai = 0; ai < 2; ++ai)
#pragma unroll
            for (int m = 0; m < 4; ++m) { unsigned char* rowp = O + (size_t)(row0 + ai * HALF + m * 16) * ldc + col0;
                float h[8];
#pragma unroll
                for (int n = 0; n < 2; ++n)
#pragma unroll
                    for (int j = 0; j < 4; ++j) { const float g = acc[ai][0][m][n][j] * ascale, up = acc[ai][1][m][n][j] * ascale; h[4 * n + j] = fminf(fmaxf(g * sigmoidf_fast(g) * up * hs, -448.f), 448.f); }
                *(u32x2*)rowp = (u32x2){pk4_fp8(h[0], h[1], h[2], h[3]), pk4_fp8(h[4], h[5], h[6], h[7])}; }
    }
};
struct EpiGateMerge {
    static constexpr bool PERM = true, AFTER_DRAIN = false;
    const bf16_t* ta; const bf16_t* tb; bf16_t* O; int ldc; const float* b0; const float* b1;
    __device__ __forceinline__ void operator()(const f32x4 (&acc)[2][2][4][2], const Unit& u, int wr, int wc, int fr, int fq) const {
        const int row0 = u.pm * BM + wr * 64 + fr, col0 = u.pn * HALF + wc * 32 + 8 * fq;
        float bb0[8], bb1[8];
#pragma unroll
        for (int j = 0; j < 8; ++j) { bb0[j] = b0[col0 + j]; bb1[j] = b1[col0 + j]; }
#pragma unroll
        for (int ai = 0; ai < 2; ++ai)
#pragma unroll
            for (int m = 0; m < 4; ++m) { const size_t off = (size_t)(row0 + ai * HALF + m * 16) * ldc + col0;
                const u32x4 a = *(const u32x4*)(ta + off), b = *(const u32x4*)(tb + off);
                const float av[8] = {bflo(a.x), bfhi(a.x), bflo(a.y), bfhi(a.y), bflo(a.z), bfhi(a.z), bflo(a.w), bfhi(a.w)};
                const float bv[8] = {bflo(b.x), bfhi(b.x), bflo(b.y), bfhi(b.y), bflo(b.z), bfhi(b.z), bflo(b.w), bfhi(b.w)};
                float h[8];
#pragma unroll
                for (int n = 0; n < 2; ++n)
#pragma unroll
                    for (int j = 0; j < 4; ++j) { const int e = 4 * n + j; h[e] = sigmoidf_fast(acc[ai][0][m][n][j] + bb0[e]) * av[e] + sigmoidf_fast(acc[ai][1][m][n][j] + bb1[e]) * bv[e]; }
                u32x4 w; w.x = cvt_pk_bf16(h[0], h[1]); w.y = cvt_pk_bf16(h[2], h[3]); w.z = cvt_pk_bf16(h[4], h[5]); w.w = cvt_pk_bf16(h[6], h[7]);
                *(u32x4*)(O + off) = w; }
    }
};
struct EpiRes {
    static constexpr bool PERM = false, AFTER_DRAIN = false;
    const float* res; float* out; int ldc; float alpha, s;
    __device__ __forceinline__ void operator()(const f32x4 (&acc)[2][2][4][2], const Unit& u, int wr, int wc, int fr, int fq) const {
        const int col0 = u.pn * BM + wc * 32 + 4 * fq;
#pragma unroll
        for (int ai = 0; ai < 2; ++ai)
#pragma unroll
            for (int m = 0; m < 4; ++m) { const size_t off = (size_t)(u.pm * BM + ai * HALF + wr * 64 + m * 16 + fr) * ldc + col0;
#pragma unroll
                for (int bj = 0; bj < 2; ++bj)
#pragma unroll
                    for (int n = 0; n < 2; ++n) { const f32x4 r = *(const f32x4*)(res + off + bj * HALF + n * 16); *(f32x4*)(out + off + bj * HALF + n * 16) = r * alpha + acc[ai][bj][m][n] * s; }
                if (m & 1) asm volatile("" ::: "memory"); }
    }
};

typedef int v8i_t __attribute__((ext_vector_type(8)));
typedef int v4i_t __attribute__((ext_vector_type(4)));
template <class Epi, class Sched, bool ALIGN_EPI, bool FP8 = false>
__device__ __forceinline__ void gemm_phase(PG8_LAS unsigned char* lds, const Gemm g, const Sched& S, const Epi& E, const int wid) {
    const int lane = lane_fresh(), tid = wid * 64 + lane, wr = wid >> 2, wc = wid & 3, fr = lane & 15, fq = lane >> 4;
    const int K = g.K, nt = K / BK;
    unsigned voffA[2], voffB[2];
#pragma unroll
    for (int i = 0; i < 2; ++i) { int R, C; stage_rc(tid * 16 + i * 8192, R, C); const int Rb = Epi::PERM ? ((R & ~31) + perm32(R & 31)) : R;
        voffA[i] = (unsigned)(R * g.lda + C) * 2u; voffB[i] = (unsigned)(Rb * g.ldb + C) * 2u; }
    const size_t kstep = (size_t)(BK * 2);
    const size_t hstepA = (size_t)HALF * g.lda * 2, hstepB = (size_t)HALF * g.ldb * 2;
    const size_t tstepA = 2 * hstepA, tstepB = 2 * hstepB;
    const unsigned ldsw = (unsigned)wid * 1024u;
    const int aoff = lds_byte(wr * 64 + fr, fq * 8), boff = lds_byte(wc * 32 + fr, fq * 8);
#define PG8_UA(u) ((const char*)g.A + (size_t)(u).pm * tstepA + (size_t)(((u).pn >> g.a_shift) * g.a_mul) * 2)
#define PG8_UB(u) ((const char*)g.Bt + (size_t)(u).pn * tstepB)
#define PG8_SA(b, h) (((b) * 2 + (h)) * HTB)
#define PG8_SB(b, h) ((4 + (b) * 2 + (h)) * HTB)
#define PG8_STAGE(bufoff, gbase, voff) do { _Pragma("unroll") for (int _i = 0; _i < 2; ++_i) \
        __builtin_amdgcn_global_load_lds((const unsigned*)((const char*)(gbase) + (voff)[_i]), (PG8_LAS unsigned*)(lds + (bufoff) + ldsw + _i * 8192), 16, 0, 0); } while (0)
#define PG8_LD8(p_) __builtin_shufflevector(*(const PG8_LAS v4i_t*)(p_), *(const PG8_LAS v4i_t*)((p_) + 1024), 0, 1, 2, 3, 4, 5, 6, 7)
#define PG8_LDA(dst, b, h) do { _Pragma("unroll") for (int m = 0; m < 4; ++m) { if constexpr (FP8) dst##8[m] = PG8_LD8(lds + PG8_SA(b, h) + aoff + m * 2048); else { _Pragma("unroll") for (int k = 0; k < 2; ++k) dst[m][k] = *(const PG8_LAS bf16x8*)(lds + PG8_SA(b, h) + aoff + m * 2048 + k * 1024); } } } while (0)
#define PG8_LDB(dst, b, h) do { _Pragma("unroll") for (int n = 0; n < 2; ++n) { if constexpr (FP8) dst##8[n] = PG8_LD8(lds + PG8_SB(b, h) + boff + n * 2048); else { _Pragma("unroll") for (int k = 0; k < 2; ++k) dst[n][k] = *(const PG8_LAS bf16x8*)(lds + PG8_SB(b, h) + boff + n * 2048 + k * 1024); } } } while (0)
#define PG8_MMA(ai, bj, At, Bt) do { __builtin_amdgcn_s_setprio(1); _Pragma("unroll") for (int m = 0; m < 4; ++m) _Pragma("unroll") for (int n = 0; n < 2; ++n) { \
        if constexpr (FP8) asm volatile("v_mfma_scale_f32_16x16x128_f8f6f4 %0, %1, %2, %0, %3, %3 op_sel_hi:[0,0,0]" : "+v"(acc[ai][bj][m][n]) : "v"(Bt##8[n]), "v"(At##8[m]), "v"(one_scale)); \
        else { _Pragma("unroll") for (int k = 0; k < 2; ++k) acc[ai][bj][m][n] = __builtin_amdgcn_mfma_f32_16x16x32_bf16(Bt[n][k], At[m][k], acc[ai][bj][m][n], 0, 0, 0); } } \
        __builtin_amdgcn_s_setprio(0); } while (0)
#define PG8_WAIT_V(n) asm volatile("s_waitcnt vmcnt(" #n ")" ::: "memory")
#define PG8_WAIT_L(n) asm volatile("s_waitcnt lgkmcnt(" #n ")" ::: "memory")
#define PG8_BAR __builtin_amdgcn_s_barrier()
#define PG8_SCHED __builtin_amdgcn_sched_barrier(0)
    Unit cur, nxt; int ui = 0;
    if (!S.next(0, cur)) return;
    f32x4 acc[2][2][4][2];
#pragma unroll
    for (int a = 0; a < 2; ++a)
#pragma unroll
        for (int b = 0; b < 2; ++b)
#pragma unroll
            for (int m = 0; m < 4; ++m)
#pragma unroll
                for (int n = 0; n < 2; ++n) acc[a][b][m][n] = (f32x4){0.f, 0.f, 0.f, 0.f};
    bf16x8 At[4][2], B0[2][2], B1[2][2]; v8i_t At8[4], B08[2], B18[2];
    int one_scale = 0x7f7f7f7f; asm volatile("" : "+v"(one_scale));
    const char* cA = PG8_UA(cur); const char* cB = PG8_UB(cur);
    S.a_ready(cur);
    PG8_STAGE(PG8_SB(0, 0), cB, voffB); PG8_STAGE(PG8_SB(0, 1), cB + hstepB, voffB); PG8_STAGE(PG8_SA(0, 0), cA, voffA); PG8_STAGE(PG8_SA(0, 1), cA + hstepA, voffA);
    if (wr == 1) PG8_BAR;
    PG8_WAIT_V(2); PG8_BAR;
    PG8_STAGE(PG8_SB(1, 0), cB + kstep, voffB); PG8_STAGE(PG8_SA(1, 0), cA + kstep, voffA); PG8_STAGE(PG8_SB(1, 1), cB + hstepB + kstep, voffB);
    PG8_WAIT_V(6); PG8_BAR;
    for (;;) {
        const bool has_next = S.next(ui + 1, nxt);
        const char* nA = has_next ? PG8_UA(nxt) : cA; const char* nB = has_next ? PG8_UB(nxt) : cB;
        for (int t = 0; t < nt; t += 2) {
            const bool last = (t == nt - 2);
            const char* a1 = cA + (size_t)(t + 1) * kstep;
            const char* a2 = last ? nA : cA + (size_t)(t + 2) * kstep; const char* b2 = last ? nB : cB + (size_t)(t + 2) * kstep;
            const char* a3 = a2 + kstep; const char* b3 = b2 + kstep;
            if (last && has_next) S.a_ready(nxt);
            PG8_LDB(B0, 0, 0); PG8_LDB(B1, 0, 1); PG8_SCHED; PG8_LDA(At, 0, 0); PG8_STAGE(PG8_SA(1, 1), a1 + hstepA, voffA);
            PG8_WAIT_V(8); PG8_WAIT_L(0); PG8_BAR; PG8_MMA(0, 0, At, B0); PG8_MMA(0, 1, At, B1); PG8_BAR; PG8_SCHED;
            PG8_LDA(At, 0, 1); PG8_STAGE(PG8_SB(0, 0), b2, voffB); PG8_STAGE(PG8_SB(0, 1), b2 + hstepB, voffB); PG8_STAGE(PG8_SA(0, 0), a2, voffA);
            PG8_WAIT_V(8); PG8_WAIT_L(0); PG8_BAR; PG8_MMA(1, 0, At, B0); PG8_MMA(1, 1, At, B1); PG8_BAR; PG8_SCHED;
            PG8_LDB(B0, 1, 0); PG8_LDB(B1, 1, 1); PG8_SCHED; PG8_LDA(At, 1, 0); PG8_STAGE(PG8_SA(0, 1), a2 + hstepA, voffA);
            PG8_WAIT_V(8); PG8_WAIT_L(0); PG8_BAR; PG8_MMA(0, 0, At, B0); PG8_MMA(0, 1, At, B1); PG8_BAR; PG8_SCHED;
            PG8_LDA(At, 1, 1); PG8_STAGE(PG8_SB(1, 0), b3, voffB); PG8_STAGE(PG8_SB(1, 1), b3 + hstepB, voffB); PG8_STAGE(PG8_SA(1, 0), a3, voffA);
            PG8_WAIT_V(8); PG8_WAIT_L(0); PG8_BAR; PG8_MMA(1, 0, At, B0); PG8_MMA(1, 1, At, B1); PG8_BAR; PG8_SCHED;
        }
        if constexpr (ALIGN_EPI) { if (wr == 0) PG8_BAR; }
        if constexpr (FP8) asm volatile("s_nop 15\n\ts_nop 7" ::: "memory");
        E(acc, cur, wr, wc, fr, fq); S.done(cur);
        if (!has_next) break;
#pragma unroll
        for (int a = 0; a < 2; ++a)
#pragma unroll
            for (int b = 0; b < 2; ++b)
#pragma unroll
                for (int m = 0; m < 4; ++m)
#pragma unroll
                    for (int n = 0; n < 2; ++n) acc[a][b][m][n] = (f32x4){0.f, 0.f, 0.f, 0.f};
        cur = nxt; cA = nA; cB = nB; ++ui;
        if constexpr (ALIGN_EPI) { if (wr == 1) PG8_BAR; }
    }
    PG8_WAIT_V(0);
    if constexpr (!ALIGN_EPI) { if (wr == 0) PG8_BAR; }
    PG8_BAR;
#undef PG8_UA
#undef PG8_UB
#undef PG8_SA
#undef PG8_SB
#undef PG8_STAGE
#undef PG8_LDA
#undef PG8_LDB
#undef PG8_MMA
#undef PG8_LD8
#undef PG8_WAIT_V
#undef PG8_WAIT_L
#undef PG8_BAR
#undef PG8_SCHED
}
}

constexpr int NWAVES = 8;
constexpr int BATCH = 4, SEQ = 4096, D = 2048, FF = 5632, M = BATCH * SEQ;
constexpr int N_IN = 5888;
constexpr int MEMT = 256;
constexpr float LN_EPS = 1e-5f;
constexpr float ALPHA = 1.189207115002721f;
constexpr float LAMBDA_INIT = 0.2f;

constexpr size_t MiB = 1u << 20;
constexpr size_t WS_CTL = 0, CTL_ZERO_BYTES = 1 * MiB;
constexpr size_t WS_W_IN = 2 * MiB;
constexpr size_t WS_W_G = 25 * MiB;
constexpr size_t WS_W_UK = 41 * MiB;
constexpr size_t WS_W_UVP = 42 * MiB;
constexpr size_t WS_W_A = 44 * MiB;
constexpr size_t WS_W_B = 48 * MiB;
constexpr size_t WS_W_MO = 52 * MiB;
constexpr size_t WS_W_MQ = 60 * MiB;
constexpr size_t WS_W_MKV = 62 * MiB;
constexpr size_t WS_W_MOUT = 66 * MiB;
constexpr size_t WS_MEM16 = 68 * MiB;
constexpr size_t WS_KVMEM = 72 * MiB;
constexpr size_t WS_W_GU2 = 74 * MiB;
constexpr size_t WS_W_D2 = 118 * MiB;
constexpr size_t WS_X16 = 140 * MiB;
constexpr size_t WS_MIX = 204 * MiB;
constexpr size_t WS_W_GU1 = 204 * MiB;
constexpr size_t WS_W_D1 = 248 * MiB;
constexpr size_t WS_H = 270 * MiB;
constexpr size_t WS_AQ = WS_MIX + 0 * MiB, WS_AK = WS_MIX + 32 * MiB, WS_AV = WS_MIX + 64 * MiB, WS_BQ = WS_MIX + 96 * MiB;
constexpr size_t WS_BC = WS_MIX + 128 * MiB;
constexpr size_t WS_IQ = WS_MIX + 144 * MiB;
constexpr size_t WS_IKW = WS_MIX + 176 * MiB;
constexpr size_t WS_QLAT = WS_MIX + 184 * MiB;
constexpr size_t WS_IDX = WS_AK;
constexpr size_t WS_NCNT = WS_AK + 8 * MiB;
constexpr size_t WS_YB = WS_BQ;
constexpr size_t WS_TA = WS_QLAT, WS_TB = WS_QLAT + 64 * MiB;
constexpr size_t WS_QM = WS_AQ, WS_OM = WS_AQ + 16 * MiB;
constexpr size_t WS_X8 = WS_H + 96 * MiB;
constexpr float FP8_XS = 32.f, FP8_WGUS = 1024.f, FP8_HS = 8.f, FP8_WDS = 4096.f;
constexpr size_t WS_END = WS_MIX + 312 * MiB;
static_assert(WS_H + (size_t)M * FF * 2 <= WS_END && WS_QLAT + (size_t)M * 4096 * 2 <= WS_END, "d_ws map");
constexpr int CW_BAR = 4096;

constexpr int RING_OFF = 0, RING_BYTES = 153600;
constexpr int LDSCTL_OFF = RING_BYTES, MISC_OFF = LDSCTL_OFF + 320;
constexpr int LDS_BYTES = 154624;
static_assert(MISC_OFF + 128 <= LDS_BYTES, "LDS map");

#define GAS __attribute__((address_space(1)))
#define LAS __attribute__((address_space(3)))
typedef unsigned short bf16;
typedef unsigned v4u __attribute__((ext_vector_type(4)));
typedef unsigned v2u __attribute__((ext_vector_type(2)));
typedef float f32x4 __attribute__((ext_vector_type(4)));
typedef float f32x16 __attribute__((ext_vector_type(16)));
typedef short bf16x8 __attribute__((ext_vector_type(8)));
typedef GAS unsigned gu32;
#define RLX_AGENT __ATOMIC_RELAXED, __HIP_MEMORY_SCOPE_AGENT
#define LDS_WAIT() asm volatile("s_waitcnt lgkmcnt(0)" ::: "memory")
#define VM_WAIT() asm volatile("s_waitcnt vmcnt(0)" ::: "memory")
__device__ __forceinline__ unsigned f2bf(float f) { unsigned u = __builtin_bit_cast(unsigned, f); return (u + 0x7fffu + ((u >> 16) & 1u)) >> 16; }
__device__ __forceinline__ unsigned pk2(float lo, float hi) { return f2bf(lo) | (f2bf(hi) << 16); }
__device__ __forceinline__ float bf2f(unsigned short v) { return __uint_as_float((unsigned)v << 16); }
__device__ __forceinline__ float blo(unsigned w) { return __uint_as_float(w << 16); }
__device__ __forceinline__ float bhi(unsigned w) { return __uint_as_float(w & 0xffff0000u); }
__device__ __forceinline__ float wave_sum(float v) {
#pragma unroll
    for (int o = 1; o < 64; o <<= 1) v += __shfl_xor(v, o);
    return v;
}

#define XB_TMO      128
#define XB_XCNT(j)  (256  + 64 * (j))
#define XB_XSUB(j)  (1280 + 64 * (j))
#define XB_XGEN(j)  (2304 + 64 * (j))
#define XB_TOP      3328
#define XB_TOPGEN   3392
#define XCD_BAR_WORDS 3456
#define XB_SPIN_CAP (1u << 18)

__device__ __forceinline__ unsigned xb_ld(unsigned* p)              { return __hip_atomic_load(p, __ATOMIC_RELAXED, __HIP_MEMORY_SCOPE_AGENT); }
__device__ __forceinline__ unsigned xb_add(unsigned* p, unsigned v) { return __hip_atomic_fetch_add(p, v, __ATOMIC_RELAXED, __HIP_MEMORY_SCOPE_AGENT); }
__device__ __forceinline__ unsigned xb_xcc_id() { return (unsigned)__builtin_amdgcn_s_getreg((3 << 11) | 20) & 0xFu; }
#define XB_SPIN(cond, bar) do { unsigned _sp = 0; while (cond) { __builtin_amdgcn_s_sleep(1); \
    if ((++_sp & 255u) == 0u) { if (xb_ld(&(bar)[XB_TMO])) break; if (_sp > XB_SPIN_CAP) { atomicAdd(&(bar)[XB_TMO], 1u); break; } } } } while (0)

struct XcdBarrier {
    unsigned* bar; unsigned x;
    volatile LAS unsigned* st;
};

__device__ __forceinline__ XcdBarrier xcd_barrier_post(unsigned* bar, volatile LAS unsigned* st, bool t0) {
    XcdBarrier b; b.bar = bar; b.x = xb_xcc_id(); b.st = st;
    if (t0) (void)xb_add(&bar[XB_XCNT(b.x)], 1u);
    return b;
}
__device__ __forceinline__ void xcd_barrier_complete(unsigned* bar, unsigned x, unsigned& nloc, unsigned& nx) {
    const unsigned G = gridDim.x * gridDim.y * gridDim.z;
    unsigned sum, cnt, mine, sp = 0u;
    for (;;) {
        sum = 0u; cnt = 0u; mine = 0u;
#pragma unroll
        for (unsigned j = 0; j < 16; ++j) { const unsigned c = xb_ld(&bar[XB_XCNT(j)]); sum += c; cnt += (c > 0u) ? 1u : 0u; mine = (j == x) ? c : mine; }
        if (sum == G) break;
        __builtin_amdgcn_s_sleep(1);
        if ((++sp & 255u) == 0u) { if (xb_ld(&bar[XB_TMO])) break; if (sp > XB_SPIN_CAP) { atomicAdd(&bar[XB_TMO], 1u); break; } }
    }
    nloc = mine > 0u ? mine : 1u; nx = cnt > 0u ? cnt : 1u;
}

__device__ __forceinline__ void xcd_barrier(const XcdBarrier& b, const int wave) {
    asm volatile("s_waitcnt vmcnt(0)" ::: "memory");
    __syncthreads();
    if (wave == 0 && lane_fresh() == 0) {
        unsigned* bar = b.bar;
        __builtin_amdgcn_s_waitcnt(0);
        unsigned nloc = b.st[0], nx = b.st[1];
        if (nloc == 0u) { xcd_barrier_complete(bar, b.x, nloc, nx); b.st[0] = nloc; b.st[1] = nx; }
        const unsigned old = xb_add(&bar[XB_XSUB(b.x)], 1u);
        const unsigned gen = old / nloc;
        if (old + 1u == (gen + 1u) * nloc) {
            __builtin_amdgcn_fence(__ATOMIC_RELEASE, "agent");
            asm volatile("s_waitcnt vmcnt(0)" ::: "memory");
            const unsigned og = xb_add(&bar[XB_TOP], 1u);
            const unsigned tg = og / nx;
            if (og + 1u == (tg + 1u) * nx) xb_add(&bar[XB_TOPGEN], 1u);
            else XB_SPIN(xb_ld(&bar[XB_TOPGEN]) == tg, bar);
            __builtin_amdgcn_fence(__ATOMIC_ACQUIRE, "agent");
            xb_add(&bar[XB_XGEN(b.x)], 1u);
            asm volatile("s_waitcnt vmcnt(0)" ::: "memory");
        } else {
            XB_SPIN(xb_ld(&bar[XB_XGEN(b.x)]) == gen, bar);
            __builtin_amdgcn_fence(__ATOMIC_ACQUIRE, "agent");
            asm volatile("s_waitcnt vmcnt(0)" ::: "memory");
        }
    }
    __syncthreads();
}

__device__ __forceinline__ void tr_item(const float* W, int ldw, int nvalid, bf16* WT, int ldt, int k0, int n0, int drow0, int dcol0, LAS float* scr, int lane) {
    const int n = n0 + (lane & 31); const bool ok = n < nvalid;
#pragma unroll 8
    for (int i = 0; i < 32; ++i) { const int kk = 2 * i + (lane >> 5); scr[kk * 33 + (lane & 31)] = ok ? W[(size_t)(k0 + kk) * ldw + n] : 0.f; }
    LDS_WAIT(); asm volatile("" ::: "memory");
    const int c = lane & 7;
#pragma unroll
    for (int j = 0; j < 4; ++j) { const int nn = (lane >> 3) + 8 * j; const LAS float* s = scr + (8 * c) * 33 + nn;
        v4u o; o.x = pk2(s[0 * 33], s[1 * 33]); o.y = pk2(s[2 * 33], s[3 * 33]); o.z = pk2(s[4 * 33], s[5 * 33]); o.w = pk2(s[6 * 33], s[7 * 33]);
        *(GAS v4u*)(WT + (size_t)(drow0 + nn) * ldt + dcol0 + k0 + 8 * c) = o; }
    LDS_WAIT(); asm volatile("" ::: "memory");
}
__device__ __forceinline__ void tr_item8(const float* W, int ldw, unsigned char* WT, int ldt, int k0, int n0, int drow0, float sc, LAS float* scr, int lane) {
    const int n = n0 + (lane & 31);
#pragma unroll 8
    for (int i = 0; i < 32; ++i) { const int kk = 2 * i + (lane >> 5); scr[kk * 33 + (lane & 31)] = W[(size_t)(k0 + kk) * ldw + n]; }
    LDS_WAIT(); asm volatile("" ::: "memory");
    const int nn = lane >> 1, hf = lane & 1; const LAS float* sp = scr + (32 * hf) * 33 + nn;
    unsigned o[8];
#pragma unroll
    for (int q = 0; q < 8; ++q) { const float a = fminf(fmaxf(sp[(4 * q + 0) * 33] * sc, -448.f), 448.f), b = fminf(fmaxf(sp[(4 * q + 1) * 33] * sc, -448.f), 448.f), c = fminf(fmaxf(sp[(4 * q + 2) * 33] * sc, -448.f), 448.f), d = fminf(fmaxf(sp[(4 * q + 3) * 33] * sc, -448.f), 448.f);
        int w = 0; w = __builtin_amdgcn_cvt_pk_fp8_f32(a, b, w, false); w = __builtin_amdgcn_cvt_pk_fp8_f32(c, d, w, true); o[q] = (unsigned)w; }
    GAS v4u* dst = (GAS v4u*)(WT + (size_t)(drow0 + nn) * ldt + k0 + 32 * hf);
    dst[0] = (v4u){o[0], o[1], o[2], o[3]}; dst[1] = (v4u){o[4], o[5], o[6], o[7]};
    LDS_WAIT(); asm volatile("" ::: "memory");
}
__device__ __forceinline__ void cvt_item8(const float* src, unsigned char* dst, int item, int lane, float sc) {
    const GAS f32x4* sp = (const GAS f32x4*)(src + (size_t)item * 512) + 2 * lane; f32x4 a = sp[0] * sc, b = sp[1] * sc;
    int w0 = 0, w1 = 0; w0 = __builtin_amdgcn_cvt_pk_fp8_f32(fminf(fmaxf(a.x, -448.f), 448.f), fminf(fmaxf(a.y, -448.f), 448.f), w0, false); w0 = __builtin_amdgcn_cvt_pk_fp8_f32(fminf(fmaxf(a.z, -448.f), 448.f), fminf(fmaxf(a.w, -448.f), 448.f), w0, true);
    w1 = __builtin_amdgcn_cvt_pk_fp8_f32(fminf(fmaxf(b.x, -448.f), 448.f), fminf(fmaxf(b.y, -448.f), 448.f), w1, false); w1 = __builtin_amdgcn_cvt_pk_fp8_f32(fminf(fmaxf(b.z, -448.f), 448.f), fminf(fmaxf(b.w, -448.f), 448.f), w1, true);
    *((GAS v2u*)(dst + (size_t)item * 512) + lane) = (v2u){(unsigned)w0, (unsigned)w1};
}
__device__ __forceinline__ void cvt_item(const float* src, bf16* dst, int item, int lane) {
    const GAS f32x4* s = (const GAS f32x4*)(src + (size_t)item * 512) + 2 * lane; const f32x4 a = s[0], b = s[1];
    v4u o; o.x = pk2(a.x, a.y); o.y = pk2(a.z, a.w); o.z = pk2(b.x, b.y); o.w = pk2(b.z, b.w);
    *((GAS v4u*)(dst + (size_t)item * 512) + lane) = o;
}
__device__ __forceinline__ void p0_prologue(const float* const (&in)[24], unsigned char* ws, LAS unsigned char* lds, int gw, int NGW, int wave, int lane) {
    LAS float* scr = (LAS float*)(lds + RING_OFF + wave * 16384);
#define TRM(SRC, Kk, LDW, NVALID, NPAD, DST, LDT, ROWMAP, DCOL) { constexpr int nblk = (NPAD) / 32; constexpr int cnt = ((Kk) / 64) * nblk; \
        if (r < cnt) { const int kb = r / nblk, nb = r % nblk, n0 = 32 * nb; tr_item(SRC, LDW, NVALID, (bf16*)(ws + (DST)), LDT, 64 * kb, n0, (ROWMAP), (DCOL), scr, lane); continue; } r -= cnt; }
#define TRM8(SRC, Kk, LDW, NN, DST, LDT, ROWMAP, SC) { constexpr int nblk = (NN) / 32; constexpr int cnt = ((Kk) / 64) * nblk; \
        if (r < cnt) { const int kb = r / nblk, nb = r % nblk, n0 = 32 * nb; tr_item8(SRC, LDW, (unsigned char*)(ws + (DST)), LDT, 64 * kb, n0, (ROWMAP), SC, scr, lane); continue; } r -= cnt; }
    constexpr int N_TR = 2 * (32 * 176) + 88 * 64 + 32 * 184 + 2 * (32 * 64) + 256 + 2 * (16 * 64) + 32 * 64 + 32 * 16 + 32 * 32 + 8 * 64 + 2 * (32 * 176) + 88 * 64;
    for (int it = gw; it < N_TR; it += NGW) {
        int r = it;
        TRM8(in[2], 2048, 5632, 5632, WS_W_GU1, 2048, 256 * (n0 >> 7) + (n0 & 127), FP8_WGUS)
        TRM8(in[3], 2048, 5632, 5632, WS_W_GU1, 2048, 256 * (n0 >> 7) + 128 + (n0 & 127), FP8_WGUS)
        TRM8(in[4], 5632, 2048, 2048, WS_W_D1, 5632, n0, FP8_WDS)
        TRM(in[5], 2048, 5712, 5712, 5888, WS_W_IN, 2048, n0, 0)
        TRM(in[11], 2048, 2048, 2048, 2048, WS_W_G, 2048, 256 * (n0 >> 7) + (n0 & 127), 0)
        TRM(in[11] + (size_t)2048 * 2048, 2048, 2048, 2048, 2048, WS_W_G, 2048, 256 * (n0 >> 7) + 128 + (n0 & 127), 0)
        if (r < 256) { const int h = r >> 5, rr = r & 31, kb = rr >> 2, nb = rr & 3;
            tr_item(in[10] + (size_t)h * 512 * 128, 128, 128, (bf16*)(ws + WS_W_UVP), 1024, 64 * kb, 32 * nb, (h >> 1) * 256 + (h & 1) * 128 + 32 * nb, (h & 1) * 512, scr, lane); continue; } r -= 256;
        TRM(in[13], 1024, 2048, 2048, 2048, WS_W_A, 1024, n0, 0)
        TRM(in[14], 1024, 2048, 2048, 2048, WS_W_B, 1024, n0, 0)
        TRM(in[15], 2048, 2048, 2048, 2048, WS_W_MO, 2048, n0, 0)
        TRM(in[16], 2048, 512, 512, 512, WS_W_MQ, 2048, n0, 0)
        TRM(in[17], 2048, 1024, 1024, 1024, WS_W_MKV, 2048, n0, 0)
        TRM(in[18], 512, 2048, 2048, 2048, WS_W_MOUT, 512, n0, 0)
        TRM8(in[19], 2048, 5632, 5632, WS_W_GU2, 2048, 256 * (n0 >> 7) + (n0 & 127), FP8_WGUS)
        TRM8(in[20], 2048, 5632, 5632, WS_W_GU2, 2048, 256 * (n0 >> 7) + 128 + (n0 & 127), FP8_WGUS)
        TRM8(in[21], 5632, 2048, 2048, WS_W_D2, 5632, n0, FP8_WDS)
    }
#undef TRM
#undef TRM8
    for (int rw = gw; rw < 1024; rw += NGW) { const int e = (rw >> 7) & 1; *((GAS v4u*)((bf16*)(ws + WS_W_UVP) + (size_t)rw * 1024 + (1 - e) * 512) + lane) = (v4u){0u, 0u, 0u, 0u}; }
    for (int it = gw; it < (M * D) / 512; it += NGW) cvt_item8(in[0], (unsigned char*)(ws + WS_X8), it, lane, FP8_XS);
    for (int it = gw; it < (BATCH * MEMT * D) / 512; it += NGW) cvt_item(in[1], (bf16*)(ws + WS_MEM16), it, lane);
    for (int it = gw; it < (8 * 512 * 128) / 512; it += NGW) cvt_item(in[9], (bf16*)(ws + WS_W_UK), it, lane);
}

__device__ __forceinline__ void ln_phase(float* zx, bf16* x16, unsigned char* x8, const float* g, const float* b, int gw, int NGW, int lane) {
    f32x4 gv[8], bv[8];
#pragma unroll
    for (int j = 0; j < 8; ++j) { gv[j] = *((const GAS f32x4*)g + lane + 64 * j); bv[j] = *((const GAS f32x4*)b + lane + 64 * j); }
    for (int m = gw; m < M; m += NGW) {
        GAS f32x4* xr = (GAS f32x4*)(zx + (size_t)m * D) + lane;
        f32x4 v[8]; float s = 0.f;
#pragma unroll
        for (int j = 0; j < 8; ++j) { v[j] = xr[64 * j]; s += (v[j].x + v[j].y) + (v[j].z + v[j].w); }
        const float mean = wave_sum(s) * (1.f / D); float s2 = 0.f;
#pragma unroll
        for (int j = 0; j < 8; ++j) { v[j] = v[j] - mean; s2 += (v[j].x * v[j].x + v[j].y * v[j].y) + (v[j].z * v[j].z + v[j].w * v[j].w); }
        const float rstd = 1.f / sqrtf(wave_sum(s2) * (1.f / D) + LN_EPS);
#pragma unroll
        for (int j = 0; j < 8; ++j) { v[j] = v[j] * rstd * gv[j] + bv[j]; xr[64 * j] = v[j]; }
        if (x16) { GAS v2u* o8 = (GAS v2u*)(x16 + (size_t)m * D) + lane;
#pragma unroll
            for (int j = 0; j < 8; ++j) o8[64 * j] = (v2u){pk2(v[j].x, v[j].y), pk2(v[j].z, v[j].w)}; }
        if (x8) { GAS unsigned* o4 = (GAS unsigned*)(x8 + (size_t)m * D) + lane;
#pragma unroll
            for (int j = 0; j < 8; ++j) { const f32x4 q = v[j] * FP8_XS; int w = 0; w = __builtin_amdgcn_cvt_pk_fp8_f32(fminf(fmaxf(q.x, -448.f), 448.f), fminf(fmaxf(q.y, -448.f), 448.f), w, false);
                w = __builtin_amdgcn_cvt_pk_fp8_f32(fminf(fmaxf(q.z, -448.f), 448.f), fminf(fmaxf(q.w, -448.f), 448.f), w, true); o4[64 * j] = (unsigned)w; } }
    }
}
__device__ __forceinline__ void crms_phase(bf16* bc, const float* kvg, int gw, int NGW, int lane) {
    float gg[8];
#pragma unroll
    for (int j = 0; j < 8; ++j) gg[j] = kvg[8 * lane + j];
    for (int m = gw; m < M; m += NGW) {
        GAS v4u* p = (GAS v4u*)(bc + (size_t)m * 512) + lane; const v4u w = *p;
        float x[8] = {blo(w.x), bhi(w.x), blo(w.y), bhi(w.y), blo(w.z), bhi(w.z), blo(w.w), bhi(w.w)}; float s = 0.f;
#pragma unroll
        for (int j = 0; j < 8; ++j) s += x[j] * x[j];
        const float r = 1.f / sqrtf(wave_sum(s) * (1.f / 512.f) + LN_EPS);
#pragma unroll
        for (int j = 0; j < 8; ++j) x[j] = x[j] * r * gg[j];
        *p = (v4u){pk2(x[0], x[1]), pk2(x[2], x[3]), pk2(x[4], x[5]), pk2(x[6], x[7])};
    }
}

typedef short v4i16_t __attribute__((ext_vector_type(4)));
__device__ __forceinline__ v4i16_t lds_tr16(const LAS unsigned char* p) { return __builtin_amdgcn_ds_read_tr16_b64_v4i16((LAS v4i16_t*)p); }
__device__ __forceinline__ unsigned cvtpk(float lo, float hi) { typedef float f2 __attribute__((ext_vector_type(2))); typedef __bf16 b2 __attribute__((ext_vector_type(2))); f2 v = {lo, hi}; b2 b = __builtin_convertvector(v, b2); return __builtin_bit_cast(unsigned, b); }
__device__ __forceinline__ float xhalf_f(float v) { return __shfl_xor(v, 32); }
constexpr float LOG2E = 1.4426950408889634f;
constexpr float QSCALE = 0.125f * LOG2E;

__device__ __forceinline__ void diff_attn_mfma(LAS unsigned char* lds, const bf16* AQ, const bf16* AK, const bf16* AV, bf16* YA, const float* dlam, const float* subg, int vcu, int G, const int wave) {
    const int lane = lane_fresh(), r32 = lane & 31, hi = lane >> 5;
    const int comp = wave >> 2, wq = wave & 3;
    const unsigned ksrc = (unsigned)(lane * 1024 + (2 * wave) * 8);
    const unsigned vsrc0 = (unsigned)((16 * ((2 * wave) & 3) + (lane >> 2)) * 1024 + ((2 * wave) >> 2) * 32 + (lane & 3) * 8);
    const unsigned vsrc1 = (unsigned)((16 * ((2 * wave + 1) & 3) + (lane >> 2)) * 1024 + ((2 * wave + 1) >> 2) * 32 + (lane & 3) * 8);
    const unsigned kdst = (unsigned)(2 * wave) * 1024u, vdst0 = 16384u + (unsigned)(((2 * wave) >> 2) * 4096 + ((2 * wave) & 3) * 1024), vdst1 = 16384u + (unsigned)(((2 * wave + 1) >> 2) * 4096 + ((2 * wave + 1) & 3) * 1024);
    const unsigned lds0 = (unsigned)(uintptr_t)lds;
#define DA_STAGE(bo, to) do { \
        glds16(Kg + (to) + ksrc, (unsigned)__builtin_amdgcn_readfirstlane((int)(lds0 + (bo) + kdst))); \
        glds16(Kg + (to) + ksrc + 8, (unsigned)__builtin_amdgcn_readfirstlane((int)(lds0 + (bo) + kdst + 1024))); \
        glds16(Vg + (to) + vsrc0, (unsigned)__builtin_amdgcn_readfirstlane((int)(lds0 + (bo) + vdst0))); \
        glds16(Vg + (to) + vsrc1, (unsigned)__builtin_amdgcn_readfirstlane((int)(lds0 + (bo) + vdst1))); } while (0)
#define DA_WAITBAR() asm volatile("s_waitcnt vmcnt(0) lgkmcnt(0)\n\ts_barrier" ::: "memory")
    const unsigned koff = (unsigned)(((comp * 8 + hi) * 64 + r32) * 16);
    const unsigned voff = (unsigned)(16384 + (4 * hi + ((lane & 15) >> 2)) * 64 + ((lane >> 4) & 1) * 32 + (lane & 3) * 8);
    for (int j = vcu; j < 1024; j += G) {
        const int w = j & 255, i = j >> 8, bh = w >> 3, s8 = w & 7;
        const int ub = (i == 0) ? s8 : (i == 1) ? 15 - s8 : (i == 2) ? 16 + s8 : 31 - s8;
        const int b = bh >> 3, h = bh & 7;
        const float sl2 = LOG2E / (float)(2 << h);
        const size_t rowbase = (size_t)b * SEQ; const int q0 = ub * 128;
        const int qpos = q0 + wq * 32 + r32;
        const int nt = 2 * ub + 2;
        const int myt = 2 * ub + 1 + (wq >> 1);
        const bf16* Kg = AK + rowbase * 1024 + h * 128; const bf16* Vg = AV + rowbase * 1024 + h * 128;
        bf16x8 qr[4];
#pragma unroll
        for (int s = 0; s < 4; ++s) qr[s] = *(const GAS bf16x8*)(AQ + (rowbase + qpos) * 1024 + h * 128 + comp * 64 + s * 16 + hi * 8);
        f32x16 o[4];
#pragma unroll
        for (int blk = 0; blk < 4; ++blk)
#pragma unroll
            for (int r = 0; r < 16; ++r) o[blk][r] = 0.f;
        float mrun = -INFINITY, lrun = 0.f;
        DA_STAGE(0u, (size_t)0);
        DA_WAITBAR();
        for (int kt = 0; kt < nt; ++kt) {
            const unsigned bufo = (unsigned)(kt & 1) * 32768u;
            if (kt + 1 < nt) DA_STAGE(32768u - bufo, (size_t)(kt + 1) * 64 * 1024);
            if (kt < myt) {
                const LAS unsigned char* Kb = lds + bufo + koff;
                f32x16 p0, p1;
#pragma unroll
                for (int r = 0; r < 16; ++r) { p0[r] = 0.f; p1[r] = 0.f; }
                { bf16x8 kf[4];
#pragma unroll
                  for (int s = 0; s < 4; ++s) kf[s] = *(const LAS bf16x8*)(Kb + s * 2048);
#pragma unroll
                  for (int s = 0; s < 4; ++s) p0 = __builtin_amdgcn_mfma_f32_32x32x16_bf16(kf[s], qr[s], p0, 0, 0, 0); }
                { bf16x8 kf[4];
#pragma unroll
                  for (int s = 0; s < 4; ++s) kf[s] = *(const LAS bf16x8*)(Kb + s * 2048 + 512);
#pragma unroll
                  for (int s = 0; s < 4; ++s) p1 = __builtin_amdgcn_mfma_f32_32x32x16_bf16(kf[s], qr[s], p1, 0, 0, 0); }
                const float qth = (float)(qpos - kt * 64 - 4 * hi);
                float rm = -INFINITY;
#pragma unroll
                for (int r = 0; r < 16; ++r) { const float kr = (float)((r & 3) + 8 * (r >> 2)); const float v0 = qth - kr, v1 = qth - (kr + 32.f);
                    p0[r] = p0[r] - sl2 * fabsf(v0); p1[r] = p1[r] - sl2 * fabsf(v1); rm = fmaxf(rm, fmaxf(p0[r], p1[r])); }
                rm = fmaxf(rm, xhalf_f(rm));
                if (__any(rm > mrun)) { const float mn = fmaxf(mrun, rm), f = __builtin_amdgcn_exp2f(mrun - mn); mrun = mn; lrun *= f;
#pragma unroll
                    for (int blk = 0; blk < 4; ++blk)
#pragma unroll
                        for (int r = 0; r < 16; ++r) o[blk][r] *= f; }
                float ls = 0.f;
#pragma unroll
                for (int r = 0; r < 16; ++r) { p0[r] = __builtin_amdgcn_exp2f(p0[r] - mrun); p1[r] = __builtin_amdgcn_exp2f(p1[r] - mrun); ls += p0[r] + p1[r]; }
                lrun += ls;
                bf16x8 pw[4];
#pragma unroll
                for (int s = 0; s < 2; ++s) {
                    v4u a = {cvtpk(p0[8 * s + 0], p0[8 * s + 1]), cvtpk(p0[8 * s + 2], p0[8 * s + 3]), cvtpk(p0[8 * s + 4], p0[8 * s + 5]), cvtpk(p0[8 * s + 6], p0[8 * s + 7])};
                    v4u c = {cvtpk(p1[8 * s + 0], p1[8 * s + 1]), cvtpk(p1[8 * s + 2], p1[8 * s + 3]), cvtpk(p1[8 * s + 4], p1[8 * s + 5]), cvtpk(p1[8 * s + 6], p1[8 * s + 7])};
                    pw[s] = __builtin_bit_cast(bf16x8, a); pw[2 + s] = __builtin_bit_cast(bf16x8, c); }
                const LAS unsigned char* Vb = lds + bufo + voff;
#pragma unroll
                for (int blk = 0; blk < 4; ++blk) {
#pragma unroll
                    for (int s = 0; s < 4; ++s) {
                        const v4i16_t lo = lds_tr16(Vb + blk * 4096 + s * 1024), hh = lds_tr16(Vb + blk * 4096 + s * 1024 + 512);
                        const bf16x8 vf = {lo[0], lo[1], lo[2], lo[3], hh[0], hh[1], hh[2], hh[3]};
                        o[blk] = __builtin_amdgcn_mfma_f32_32x32x16_bf16(vf, pw[s], o[blk], 0, 0, 0);
                    }
                }
            }
            DA_WAITBAR();
        }
        lrun += xhalf_f(lrun);
        const float inv = 1.f / lrun;
        LAS float* Y1 = (LAS float*)(lds) + wq * 4096;
        if (comp == 1) {
            float lam; { float a = dlam[lane] * dlam[64 + lane], bq_ = dlam[128 + lane] * dlam[192 + lane]; a = wave_sum(a); bq_ = wave_sum(bq_); lam = __expf(a) - __expf(bq_) + LAMBDA_INIT; }
            const float sc = inv * lam;
#pragma unroll
            for (int blk = 0; blk < 4; ++blk)
#pragma unroll
                for (int r = 0; r < 16; ++r) Y1[(32 * blk + (r & 3) + 8 * (r >> 2) + 4 * hi) * 32 + r32] = o[blk][r] * sc; }
        __syncthreads();
        if (comp == 0) {
            float ss = 0.f;
#pragma unroll
            for (int blk = 0; blk < 4; ++blk)
#pragma unroll
                for (int r = 0; r < 16; ++r) { const float a = o[blk][r] * inv - Y1[(32 * blk + (r & 3) + 8 * (r >> 2) + 4 * hi) * 32 + r32]; o[blk][r] = a; ss += a * a; }
            ss += xhalf_f(ss);
            const float rr = (1.0f - LAMBDA_INIT) / sqrtf(ss * (1.f / 128.f) + LN_EPS);
            LAS unsigned* stg = (LAS unsigned*)(lds + 65536) + wq * (32 * 65);
#pragma unroll
            for (int blk = 0; blk < 4; ++blk) {
#pragma unroll
                for (int r = 0; r < 16; r += 2) { const int e = 32 * blk + (r & 3) + 8 * (r >> 2) + 4 * hi;
                    stg[r32 * 65 + (e >> 1)] = cvtpk(o[blk][r] * rr * subg[e], o[blk][r + 1] * rr * subg[e + 1]); }
                asm volatile("" ::: "memory"); }
            LDS_WAIT(); asm volatile("" ::: "memory");
            bf16* orow = YA + (rowbase + q0 + wq * 32) * 1024 + h * 128;
#pragma unroll 4
            for (int row = 0; row < 32; ++row) *((GAS unsigned*)(orow + (size_t)row * 1024) + lane) = stg[row * 65 + lane];
        }
        __syncthreads();
    }
#undef DA_STAGE
#undef DA_WAITBAR
}

__device__ __forceinline__ unsigned okey(float f) { const unsigned u = __float_as_uint(f); return (u & 0x80000000u) ? ~u : (u | 0x80000000u); }
__device__ __forceinline__ void indexer_topk(const bf16* IQ, const bf16* IKW, unsigned short* IDX, int* NCNT, int gw, int NGW, int lane) {
    const int r32 = lane & 31, hi = lane >> 5;
    for (int p = gw; p < M / 2; p += NGW) {
        const int c64 = p & 63, b = p >> 11, pic = (p >> 6) & 31;
        const int chunk = (b & 1) ? 63 - c64 : c64;
        const int t0 = b * SEQ + chunk * 64 + 2 * pic;
        const int ngroups = 2 * (chunk + 1);
        bf16x8 a[4];
#pragma unroll
        for (int ks = 0; ks < 4; ++ks) a[ks] = *(const GAS bf16x8*)(IQ + (size_t)(t0 + (r32 >> 4)) * 1024 + (r32 & 15) * 64 + ks * 16 + 8 * hi);
        float wv[16];
#pragma unroll
        for (int r = 0; r < 16; ++r) { const int row = (r & 3) + 8 * (r >> 2) + 4 * hi; wv[r] = bf2f(IKW[(size_t)(t0 + (row >> 4)) * 256 + 64 + (row & 15)]); }
        unsigned key[128];
#pragma unroll
        for (int g = 0; g < 128; ++g) {
            if (g < ngroups) {
                const bf16* kp = IKW + (size_t)(b * SEQ + 32 * g + r32) * 256 + 8 * hi;
                bf16x8 bk[4];
#pragma unroll
                for (int ks = 0; ks < 4; ++ks) bk[ks] = *(const GAS bf16x8*)(kp + ks * 16);
                f32x16 acc = {0.f, 0.f, 0.f, 0.f, 0.f, 0.f, 0.f, 0.f, 0.f, 0.f, 0.f, 0.f, 0.f, 0.f, 0.f, 0.f};
#pragma unroll
                for (int ks = 0; ks < 4; ++ks) acc = __builtin_amdgcn_mfma_f32_32x32x16_bf16(a[ks], bk[ks], acc, 0, 0, 0);
                float s0 = 0.f, s1 = 0.f;
#pragma unroll
                for (int r = 0; r < 8; ++r) { s0 += wv[r] * fmaxf(acc[r], 0.f); s1 += wv[8 + r] * fmaxf(acc[8 + r], 0.f); }
                s0 += __shfl_xor(s0, 32); s1 += __shfl_xor(s1, 32);
                key[g] = okey(hi ? s1 : s0);
            } else key[g] = 0u;
        }
        unsigned T = 0u;
        if (chunk >= 4) {
            bool done = false;
#pragma nounroll
            for (int bit = 31; bit >= 0; --bit) {
                if (__all(done ? 1 : 0)) break;
                const unsigned trial = T | (1u << bit);
                int cnt = 0;
#pragma unroll
                for (int g = 0; g < 128; ++g) cnt += (key[g] >= trial) ? 1 : 0;
                cnt += __shfl_xor(cnt, 1); cnt += __shfl_xor(cnt, 2); cnt += __shfl_xor(cnt, 4); cnt += __shfl_xor(cnt, 8); cnt += __shfl_xor(cnt, 16);
                if (!done && cnt >= 256) { T = trial; if (cnt == 256) done = true; }
            }
        }
        int base = 0;
        unsigned short* ip = IDX + (size_t)(t0 + hi) * 256;
#pragma unroll
        for (int g = 0; g < 128; ++g) {
            if (g < ngroups) {
                const bool sel = key[g] >= T;
                const unsigned long long mk = __ballot(sel ? 1 : 0);
                const unsigned mh = hi ? (unsigned)(mk >> 32) : (unsigned)mk;
                const int pos = base + __popc(mh & ((1u << r32) - 1u));
                if (sel && pos < 256) ip[pos] = (unsigned short)(32 * g + r32);
                base += __popc(mh);
            }
        }
        if (r32 == 0) NCNT[t0 + hi] = base < 256 ? base : 256;
    }
}

__device__ __forceinline__ bf16x8 dpp_shl8(bf16x8 v) {
    v4u u = __builtin_bit_cast(v4u, v);
    u.x = (unsigned)__builtin_amdgcn_update_dpp(0, (int)u.x, 0x108, 0xf, 0xf, true); u.y = (unsigned)__builtin_amdgcn_update_dpp(0, (int)u.y, 0x108, 0xf, 0xf, true);
    u.z = (unsigned)__builtin_amdgcn_update_dpp(0, (int)u.z, 0x108, 0xf, 0xf, true); u.w = (unsigned)__builtin_amdgcn_update_dpp(0, (int)u.w, 0x108, 0xf, 0xf, true);
    return __builtin_bit_cast(bf16x8, u); }
constexpr int DSA_ROWB = 1040;
constexpr int DSA_WAVEB = 16 * DSA_ROWB + 512;
constexpr int DSA_LDS_END = 8 * DSA_WAVEB;
__device__ __forceinline__ void dsa_mfma(LAS unsigned char* lds, const bf16* QL, bf16* OL, const int omask, const bf16* C, const unsigned short* IDX, int vcu, int G, const int wave) {
    const int lane = lane_fresh(), h16 = lane & 15, g = lane >> 4;
    LAS unsigned char* wl = lds + wave * DSA_WAVEB;
    const unsigned wl0 = (unsigned)(uintptr_t)wl;
    LAS unsigned short* idxs = (LAS unsigned short*)(wl + 16 * DSA_ROWB);
    const float sc2 = 0.08838834764831845f * LOG2E;
    const float sl2 = (h16 < 8) ? LOG2E / (float)(2 << (h16 & 7)) : 0.f;
    const int ntok = (G == 256) ? 8 : (M - (vcu * 8 + wave) + G * 8 - 1) / (G * 8);
#define DSA_TOK(i) ((G == 256) ? ((vcu >> 6) * SEQ + (vcu & 63) + 64 * (wave + 8 * (i))) : (vcu * 8 + wave + G * 8 * (i)))
    const unsigned qk_off = (unsigned)(h16 * DSA_ROWB + 16 * g);
    const unsigned pv_off = (unsigned)((4 * g + (h16 >> 2)) * DSA_ROWB + 8 * (lane & 3));
    for (int it = 0; it < ntok; ++it) {
        const int t = DSA_TOK(it); const int tpos = t & (SEQ - 1);
        const int n = (tpos >> 6) >= 3 ? 256 : 64 * ((tpos >> 6) + 1); const int nst = n >> 4;
        const bf16* Cb = C + (size_t)(t >> 12) * SEQ * 512;
        { const v2u iv = *((const GAS v2u*)(IDX + (size_t)t * 256) + lane); *((LAS v2u*)idxs + lane) = iv; }
        bf16x8 qf[8];
#pragma unroll
        for (int s = 0; s < 8; ++s) qf[s] = *(const GAS bf16x8*)(QL + (size_t)t * 4096 + (h16 & 7) * 512 + 32 * (s + 8 * (h16 >> 3)) + 8 * g);
        f32x4 o[32];
#pragma unroll
        for (int blk = 0; blk < 32; ++blk) o[blk] = (f32x4){0.f, 0.f, 0.f, 0.f};
        float mrun = -INFINITY, lrun = 0.f;
        asm volatile("s_waitcnt vmcnt(0) lgkmcnt(0)" ::: "memory");
        for (int st = 0; st < nst; ++st) {
            { const v4u i0 = *(const LAS v4u*)(idxs + st * 16), i1 = *(const LAS v4u*)(idxs + st * 16 + 8);
              const unsigned iw[8] = {i0.x, i0.y, i0.z, i0.w, i1.x, i1.y, i1.z, i1.w};
#pragma unroll
              for (int i = 0; i < 16; ++i) { const int s_ = __builtin_amdgcn_readfirstlane((int)((iw[i >> 1] >> ((i & 1) * 16)) & 0xffffu));
                  glds16(Cb + (size_t)s_ * 512 + lane * 8, (unsigned)__builtin_amdgcn_readfirstlane((int)(wl0 + i * DSA_ROWB))); } }
            asm volatile("s_waitcnt vmcnt(0)" ::: "memory");
            f32x4 acc = {0.f, 0.f, 0.f, 0.f};
#pragma unroll
            for (int s = 0; s < 8; ++s) { const bf16x8 a = *(const LAS bf16x8*)(wl + qk_off + 64 * s); acc = __builtin_amdgcn_mfma_f32_16x16x32_bf16(a, qf[s], acc, 0, 0, 0); }
#pragma unroll
            for (int s = 0; s < 8; ++s) { const bf16x8 a = *(const LAS bf16x8*)(wl + qk_off + 64 * (s + 8)); acc = __builtin_amdgcn_mfma_f32_16x16x32_bf16(a, dpp_shl8(qf[s]), acc, 0, 0, 0); }
            const v2u iq = *(const LAS v2u*)(idxs + st * 16 + 4 * g);
            const int sidx[4] = {(int)(iq.x & 0xffffu), (int)(iq.x >> 16), (int)(iq.y & 0xffffu), (int)(iq.y >> 16)};
            float lg[4];
#pragma unroll
            for (int r = 0; r < 4; ++r) { const int d = tpos - sidx[r]; lg[r] = acc[r] * sc2 - sl2 * (float)(d < 0 ? -d : d); }
            float rm = fmaxf(fmaxf(lg[0], lg[1]), fmaxf(lg[2], lg[3]));
            rm = fmaxf(rm, __shfl_xor(rm, 16)); rm = fmaxf(rm, __shfl_xor(rm, 32));
            const float mn = fmaxf(mrun, rm), f = __builtin_amdgcn_exp2f(mrun - mn); mrun = mn;
#pragma unroll
            for (int r = 0; r < 4; ++r) lg[r] = __builtin_amdgcn_exp2f(lg[r] - mn);
            lrun = lrun * f + ((lg[0] + lg[1]) + (lg[2] + lg[3]));
            const v4u pwu = {cvtpk(lg[0], lg[1]), cvtpk(lg[2], lg[3]), 0u, 0u};
            const bf16x8 pw = __builtin_bit_cast(bf16x8, pwu);
#pragma unroll
            for (int blk = 0; blk < 32; ++blk) {
                const v4i16_t lo = lds_tr16(wl + pv_off + 32 * blk);
                const bf16x8 af = {lo[0], lo[1], lo[2], lo[3], lo[0], lo[1], lo[2], lo[3]};
                o[blk] = __builtin_amdgcn_mfma_f32_16x16x32_bf16(af, pw, o[blk] * f, 0, 0, 0);
                if ((blk & 3) == 3) __builtin_amdgcn_sched_barrier(0);
            }
        }
        float lt = lrun; lt += __shfl_xor(lt, 16); lt += __shfl_xor(lt, 32);
        const float inv = 1.f / lt;
        if (h16 < 8) {
#pragma unroll
            for (int blk = 0; blk < 32; ++blk) { const f32x4 v = o[blk] * inv;
                *(GAS v2u*)(OL + (size_t)(t & omask) * 4096 + h16 * 512 + 16 * blk + 4 * g) = (v2u){cvtpk(v.x, v.y), cvtpk(v.z, v.w)}; } }
    }
    asm volatile("s_waitcnt vmcnt(0) lgkmcnt(0)" ::: "memory");
    __syncthreads();
#undef DSA_TOK
}
static_assert(DSA_LDS_END <= RING_BYTES, "DSA LDS map");

__device__ __forceinline__ void memattn_mfma(LAS unsigned char* lds, const bf16* QM, const bf16* KV, bf16* OM, int vcu, int G, const int wave) {
    const int lane = lane_fresh(), r32 = lane & 31, hi = lane >> 5;
    const unsigned voff = (unsigned)(65536 + (4 * hi + ((lane & 15) >> 2)) * 64 + ((lane >> 4) & 1) * 32 + (lane & 3) * 8);
    for (int j = vcu; j < 256; j += G) {
        const int bh = j >> 4, qb = j & 15, b = bh >> 2, h = bh & 3;
        const bf16* Kg = KV + (size_t)b * MEMT * 1024 + h * 128; const bf16* Vg = Kg + 512;
#pragma unroll
        for (int i = 0; i < 8; ++i) { const int q = 8 * wave + i;
            glds16(Kg + (size_t)(64 * (q & 3) + lane) * 1024 + (q >> 2) * 8, (unsigned)__builtin_amdgcn_readfirstlane((int)((unsigned)(uintptr_t)lds + ((q >> 2) * 256 + 64 * (q & 3)) * 16)));
            glds16(Vg + (size_t)(16 * (q & 15) + (lane >> 2)) * 1024 + (q >> 4) * 32 + (lane & 3) * 8, (unsigned)__builtin_amdgcn_readfirstlane((int)((unsigned)(uintptr_t)lds + 65536 + (q >> 4) * 16384 + (q & 15) * 1024))); }
        const size_t qrow = (size_t)b * SEQ + qb * 256 + wave * 32 + r32;
        bf16x8 qr[8];
#pragma unroll
        for (int s = 0; s < 8; ++s) qr[s] = *(const GAS bf16x8*)(QM + qrow * 512 + h * 128 + s * 16 + hi * 8);
        f32x16 o[4];
#pragma unroll
        for (int blk = 0; blk < 4; ++blk)
#pragma unroll
            for (int r = 0; r < 16; ++r) o[blk][r] = 0.f;
        float mrun = -INFINITY, lrun = 0.f;
        asm volatile("s_waitcnt vmcnt(0) lgkmcnt(0)\n\ts_barrier" ::: "memory");
        for (int kt = 0; kt < 4; ++kt) {
            const LAS unsigned char* Kb = lds + (unsigned)((hi * 256 + 64 * kt + r32) * 16);
            f32x16 p0, p1;
#pragma unroll
            for (int r = 0; r < 16; ++r) { p0[r] = 0.f; p1[r] = 0.f; }
#pragma unroll
            for (int s = 0; s < 8; ++s) { const bf16x8 k0 = *(const LAS bf16x8*)(Kb + s * 8192), k1 = *(const LAS bf16x8*)(Kb + s * 8192 + 512);
                p0 = __builtin_amdgcn_mfma_f32_32x32x16_bf16(k0, qr[s], p0, 0, 0, 0); p1 = __builtin_amdgcn_mfma_f32_32x32x16_bf16(k1, qr[s], p1, 0, 0, 0); }
            float rm = -INFINITY;
#pragma unroll
            for (int r = 0; r < 16; ++r) rm = fmaxf(rm, fmaxf(p0[r], p1[r]));
            rm = fmaxf(rm, xhalf_f(rm));
            if (__any(rm > mrun)) { const float mn = fmaxf(mrun, rm), f = __builtin_amdgcn_exp2f(mrun - mn); mrun = mn; lrun *= f;
#pragma unroll
                for (int blk = 0; blk < 4; ++blk)
#pragma unroll
                    for (int r = 0; r < 16; ++r) o[blk][r] *= f; }
            float ls = 0.f;
#pragma unroll
            for (int r = 0; r < 16; ++r) { p0[r] = __builtin_amdgcn_exp2f(p0[r] - mrun); p1[r] = __builtin_amdgcn_exp2f(p1[r] - mrun); ls += p0[r] + p1[r]; }
            lrun += ls;
            bf16x8 pw[4];
#pragma unroll
            for (int s = 0; s < 2; ++s) {
                v4u a = {cvtpk(p0[8 * s + 0], p0[8 * s + 1]), cvtpk(p0[8 * s + 2], p0[8 * s + 3]), cvtpk(p0[8 * s + 4], p0[8 * s + 5]), cvtpk(p0[8 * s + 6], p0[8 * s + 7])};
                v4u c = {cvtpk(p1[8 * s + 0], p1[8 * s + 1]), cvtpk(p1[8 * s + 2], p1[8 * s + 3]), cvtpk(p1[8 * s + 4], p1[8 * s + 5]), cvtpk(p1[8 * s + 6], p1[8 * s + 7])};
                pw[s] = __builtin_bit_cast(bf16x8, a); pw[2 + s] = __builtin_bit_cast(bf16x8, c); }
            const LAS unsigned char* Vb = lds + voff + kt * 4096;
#pragma unroll
            for (int blk = 0; blk < 4; ++blk) {
#pragma unroll
                for (int s = 0; s < 4; ++s) {
                    const v4i16_t lo = lds_tr16(Vb + blk * 16384 + s * 1024), hh = lds_tr16(Vb + blk * 16384 + s * 1024 + 512);
                    const bf16x8 vf = {lo[0], lo[1], lo[2], lo[3], hh[0], hh[1], hh[2], hh[3]};
                    o[blk] = __builtin_amdgcn_mfma_f32_32x32x16_bf16(vf, pw[s], o[blk], 0, 0, 0);
                }
            }
        }
        __syncthreads();
        lrun += xhalf_f(lrun);
        const float inv = 1.f / lrun;
        LAS unsigned* stg = (LAS unsigned*)(lds) + wave * (32 * 65);
#pragma unroll
        for (int blk = 0; blk < 4; ++blk)
#pragma unroll
            for (int r = 0; r < 16; r += 2) { const int e = 32 * blk + (r & 3) + 8 * (r >> 2) + 4 * hi;
                stg[r32 * 65 + (e >> 1)] = cvtpk(o[blk][r] * inv, o[blk][r + 1] * inv); }
        LDS_WAIT(); asm volatile("" ::: "memory");
        bf16* orow = OM + ((size_t)b * SEQ + qb * 256 + wave * 32) * 512 + h * 128;
#pragma unroll 4
        for (int row = 0; row < 32; ++row) *((GAS unsigned*)(orow + (size_t)row * 512) + lane) = stg[row * 65 + lane];
        __syncthreads();
    }
}

constexpr int N_PHASES = 21;
struct Args { const float* in[24]; float* out; unsigned char* ws; int ph_lo, ph_hi; };
__global__ void __launch_bounds__(NWAVES * 64, 2) mk_fwd(Args args) {
    extern __shared__ __attribute__((aligned(16))) unsigned char lds_raw[];
    LAS unsigned char* lds = (LAS unsigned char*)lds_raw;
    volatile LAS unsigned* MISC = (volatile LAS unsigned*)(lds + MISC_OFF);
    const int tid = threadIdx.x, wave = __builtin_amdgcn_readfirstlane(tid >> 6);
#define lane lane_fresh()
    const int G = gridDim.x, bx = blockIdx.x;
    const int vcu = (G % 8 == 0) ? (bx % 8) * (G / 8) + bx / 8 : bx;
    const int gw = vcu * NWAVES + wave, NGW = G * NWAVES;
    unsigned char* ws = args.ws;
    gu32* ctl = (gu32*)(ws + WS_CTL);
    for (int u = tid; u < (LDS_BYTES - LDSCTL_OFF) / 4; u += NWAVES * 64) ((LAS unsigned*)(lds + LDSCTL_OFF))[u] = 0u;
    __syncthreads();
    const bool one = (args.ph_hi - args.ph_lo) > 1;
    XcdBarrier bar; bar.bar = (unsigned*)(ctl + CW_BAR); bar.x = 0; bar.st = nullptr;
    if (one) bar = xcd_barrier_post((unsigned*)(ctl + CW_BAR), MISC + 8, tid == 0);
    const int lo = args.ph_lo, hi = args.ph_hi;
#ifndef PH_MASK
#define PH_MASK 0xFFFFFFFFu
#endif
#define IN(k) ((((PH_MASK) >> (k)) & 1u) && lo <= (k) && (k) < hi)
#define SEAM(k) do { if (IN(k) && IN((k) + 1)) xcd_barrier(bar, wave); } while (0)
    bf16* const X16 = (bf16*)(ws + WS_X16); bf16* const HB = (bf16*)(ws + WS_H);
    float* const out = args.out;
    const float* const ln_g = args.in[22]; const float* const ln_b = args.in[23];
    using namespace pg8;

#ifdef PROBE_P0
    if (IN(0)) { p0_prologue(args.in, ws, lds, gw, NGW, wave, lane); }
#endif
    if (IN(0)) { p0_prologue(args.in, ws, lds, gw, NGW, wave, lane); }
    SEAM(0);
    if (IN(1)) { Gemm g{(const bf16*)(ws + WS_X8), (const bf16*)(ws + WS_W_GU1), D / 2, D / 2, D / 2, 0, 0}; StaticOrder S; S.init(M, 2 * FF, G, bx); EpiSwiGLU8 E{(unsigned char*)HB, FF, 1.0f / (FP8_XS * FP8_WGUS), FP8_HS};
        gemm_phase<EpiSwiGLU8, StaticOrder, true, true>(lds + RING_OFF, g, S, E, wave); }
    SEAM(1);
    if (IN(2)) { Gemm g{HB, (const bf16*)(ws + WS_W_D1), FF / 2, FF / 2, FF / 2, 0, 0}; StaticOrder S; S.init(M, D, G, bx); EpiRes E{args.in[0], out, D, ALPHA, 0.5f / (FP8_HS * FP8_WDS)}; gemm_phase<EpiRes, StaticOrder, true, true>(lds + RING_OFF, g, S, E, wave); }
    SEAM(2);
    if (IN(3)) ln_phase(out, X16, nullptr, ln_g, ln_b, gw, NGW, lane);
    SEAM(3);
    if (IN(4)) {
        { Gemm g{X16, (const bf16*)(ws + WS_W_IN), D, D, D, 0, 0}; StaticOrder S; S.init(M, N_IN, G, bx);
          EpiInProj E{(bf16*)(ws + WS_AQ), (bf16*)(ws + WS_AK), (bf16*)(ws + WS_AV), (bf16*)(ws + WS_BQ), (bf16*)(ws + WS_BC), (bf16*)(ws + WS_IQ), (bf16*)(ws + WS_IKW), QSCALE};
          gemm_phase<EpiInProj, StaticOrder, true>(lds + RING_OFF, g, S, E, wave); }
        { Gemm g{(const bf16*)(ws + WS_MEM16), (const bf16*)(ws + WS_W_MKV), D, D, D, 0, 0}; StaticOrder S; S.init(BATCH * MEMT, 1024, G, bx); EpiBf16 E{(bf16*)(ws + WS_KVMEM), 1024};
          gemm_phase<EpiBf16, StaticOrder, true>(lds + RING_OFF, g, S, E, wave); }
    }
    SEAM(4);
    if (IN(5)) {
        { Gemm g{(const bf16*)(ws + WS_BQ), (const bf16*)(ws + WS_W_UK), 1024, 128, 128, 1, 128}; StaticOrder S; S.init(M, 4096, G, bx); EpiBf16 E{(bf16*)(ws + WS_QLAT), 4096};
          gemm_phase<EpiBf16, StaticOrder, true>(lds + RING_OFF, g, S, E, wave); }
        crms_phase((bf16*)(ws + WS_BC), args.in[8], gw, NGW, lane);
    }
    SEAM(5);
#ifdef PROBE_P6
    if (IN(6)) diff_attn_mfma(lds, (const bf16*)(ws + WS_AQ), (const bf16*)(ws + WS_AK), (const bf16*)(ws + WS_AV), (bf16*)(ws + WS_BQ), args.in[6], args.in[7], vcu, G, wave);
#endif
    if (IN(6)) diff_attn_mfma(lds, (const bf16*)(ws + WS_AQ), (const bf16*)(ws + WS_AK), (const bf16*)(ws + WS_AV), (bf16*)(ws + WS_AQ), args.in[6], args.in[7], vcu, G, wave);
    SEAM(6);
#ifdef PROBE_P7
    if (IN(7)) indexer_topk((const bf16*)(ws + WS_IQ), (const bf16*)(ws + WS_IKW), (unsigned short*)(ws + WS_IDX), (int*)(ws + WS_NCNT), gw, NGW, lane);
#endif
    if (IN(7)) indexer_topk((const bf16*)(ws + WS_IQ), (const bf16*)(ws + WS_IKW), (unsigned short*)(ws + WS_IDX), (int*)(ws + WS_NCNT), gw, NGW, lane);
    SEAM(7);
#ifdef PROBE_P8
    if (IN(8)) dsa_mfma(lds, (const bf16*)(ws + WS_QLAT), (bf16*)(ws + WS_AV), 1023, (const bf16*)(ws + WS_BC), (const unsigned short*)(ws + WS_IDX), vcu, G, wave);
#endif
    if (IN(8)) dsa_mfma(lds, (const bf16*)(ws + WS_QLAT), (bf16*)(ws + WS_QLAT), 0x7fffffff, (const bf16*)(ws + WS_BC), (const unsigned short*)(ws + WS_IDX), vcu, G, wave);
    SEAM(8);
    if (IN(9)) { Gemm g{(const bf16*)(ws + WS_QLAT), (const bf16*)(ws + WS_W_UVP), 4096, 1024, 1024, 0, 1024}; StaticOrder S; S.init(M, 1024, G, bx); EpiBf16 E{(bf16*)(ws + WS_YB), 1024};
        gemm_phase<EpiBf16, StaticOrder, true>(lds + RING_OFF, g, S, E, wave); }
    SEAM(9);
    if (IN(10)) {
        { Gemm g{(const bf16*)(ws + WS_AQ), (const bf16*)(ws + WS_W_A), 1024, 1024, 1024, 0, 0}; StaticOrder S; S.init(M, D, G, bx); EpiBf16 E{(bf16*)(ws + WS_TA), D}; gemm_phase<EpiBf16, StaticOrder, true>(lds + RING_OFF, g, S, E, wave); }
        { Gemm g{(const bf16*)(ws + WS_YB), (const bf16*)(ws + WS_W_B), 1024, 1024, 1024, 0, 0}; StaticOrder S; S.init(M, D, G, bx); EpiBf16 E{(bf16*)(ws + WS_TB), D}; gemm_phase<EpiBf16, StaticOrder, true>(lds + RING_OFF, g, S, E, wave); }
    }
    SEAM(10);
    if (IN(11)) { Gemm g{X16, (const bf16*)(ws + WS_W_G), D, D, D, 0, 0}; StaticOrder S; S.init(M, 2 * D, G, bx);
        EpiGateMerge E{(const bf16*)(ws + WS_TA), (const bf16*)(ws + WS_TB), (bf16*)(ws + WS_TA), D, args.in[12], args.in[12] + D};
        gemm_phase<EpiGateMerge, StaticOrder, true>(lds + RING_OFF, g, S, E, wave); }
    SEAM(11);
    if (IN(12)) { Gemm g{(const bf16*)(ws + WS_TA), (const bf16*)(ws + WS_W_MO), D, D, D, 0, 0}; StaticOrder S; S.init(M, D, G, bx); EpiRes E{out, out, D, ALPHA, 1.0f}; gemm_phase<EpiRes, StaticOrder, true>(lds + RING_OFF, g, S, E, wave); }
    SEAM(12);
    if (IN(13)) ln_phase(out, X16, nullptr, ln_g + D, ln_b + D, gw, NGW, lane);
    SEAM(13);
    if (IN(14)) { Gemm g{X16, (const bf16*)(ws + WS_W_MQ), D, D, D, 0, 0}; StaticOrder S; S.init(M, 512, G, bx); EpiBf16 E{(bf16*)(ws + WS_QM), 512, 0.08838834764831845f * LOG2E}; gemm_phase<EpiBf16, StaticOrder, true>(lds + RING_OFF, g, S, E, wave); }
    SEAM(14);
    if (IN(15)) memattn_mfma(lds, (const bf16*)(ws + WS_QM), (const bf16*)(ws + WS_KVMEM), (bf16*)(ws + WS_OM), vcu, G, wave);
    SEAM(15);
    if (IN(16)) { Gemm g{(const bf16*)(ws + WS_OM), (const bf16*)(ws + WS_W_MOUT), 512, 512, 512, 0, 0}; StaticOrder S; S.init(M, D, G, bx); EpiRes E{out, out, D, ALPHA, 1.0f}; gemm_phase<EpiRes, StaticOrder, true>(lds + RING_OFF, g, S, E, wave); }
    SEAM(16);
    if (IN(17)) ln_phase(out, nullptr, (unsigned char*)(ws + WS_X8), ln_g + 2 * D, ln_b + 2 * D, gw, NGW, lane);
    SEAM(17);
    if (IN(18)) { Gemm g{(const bf16*)(ws + WS_X8), (const bf16*)(ws + WS_W_GU2), D / 2, D / 2, D / 2, 0, 0}; StaticOrder S; S.init(M, 2 * FF, G, bx); EpiSwiGLU8 E{(unsigned char*)HB, FF, 1.0f / (FP8_XS * FP8_WGUS), FP8_HS};
        gemm_phase<EpiSwiGLU8, StaticOrder, true, true>(lds + RING_OFF, g, S, E, wave); }
    SEAM(18);
    if (IN(19)) { Gemm g{HB, (const bf16*)(ws + WS_W_D2), FF / 2, FF / 2, FF / 2, 0, 0}; StaticOrder S; S.init(M, D, G, bx); EpiRes E{out, out, D, ALPHA, 0.5f / (FP8_HS * FP8_WDS)}; gemm_phase<EpiRes, StaticOrder, true, true>(lds + RING_OFF, g, S, E, wave); }
    SEAM(19);
    if (IN(20)) ln_phase(out, nullptr, nullptr, ln_g + 3 * D, ln_b + 3 * D, gw, NGW, lane);
#undef IN
#undef SEAM
#undef lane
}

extern "C" void kernel_launch(void* const* d_in, const int* in_sizes, int n_in, void* d_out, int out_size, void* d_ws, size_t ws_size, hipStream_t stream) {
    static int grid = 0;
    if (grid == 0) {
        if (n_in != 24 || in_sizes[0] != M * D || out_size != M * D || ws_size < WS_END) { fprintf(stderr, "kernel_launch: unexpected shapes (n_in %d, in0 %d, out %d, ws %zu); nothing launched\n", n_in, n_in > 0 ? in_sizes[0] : -1, out_size, ws_size); grid = -1; return; }
        int dev = 0, cus = 0, per_cu = 0;
        if (hipGetDevice(&dev) != hipSuccess || hipDeviceGetAttribute(&cus, hipDeviceAttributeMultiprocessorCount, dev) != hipSuccess) { grid = -1; return; }
        if (hipFuncSetAttribute((const void*)mk_fwd, hipFuncAttributeMaxDynamicSharedMemorySize, LDS_BYTES) != hipSuccess) { fprintf(stderr, "kernel_launch: hipFuncSetAttribute failed\n"); grid = -1; return; }
        if (hipOccupancyMaxActiveBlocksPerMultiprocessor(&per_cu, (const void*)mk_fwd, NWAVES * 64, LDS_BYTES) != hipSuccess || per_cu < 1)
            fprintf(stderr, "kernel_launch: note: the occupancy query reports %d workgroups per CU\n", per_cu);
        (void)hipGetLastError();
        grid = cus;
    }
    if (grid < 0) return;
    if (hipMemsetAsync((char*)d_ws + WS_CTL, 0, CTL_ZERO_BYTES, stream) != hipSuccess) return;
    Args a{};
    for (int i = 0; i < 24; ++i) a.in[i] = (const float*)d_in[i];
    a.out = (float*)d_out; a.ws = (unsigned char*)d_ws;
#if MK_ONE_LAUNCH
    a.ph_lo = 0; a.ph_hi = N_PHASES;
    hipLaunchKernelGGL(mk_fwd, dim3(grid), dim3(NWAVES * 64), LDS_BYTES, stream, a);
#else
    for (int p = 0; p < N_PHASES; ++p) { a.ph_lo = p; a.ph_hi = p + 1; hipLaunchKernelGGL(mk_fwd, dim3(grid), dim3(NWAVES * 64), LDS_BYTES, stream, a); }
#endif
}
```

```cpp
#include <hip/hip_runtime.h>
#include <cstdio>
#include <cstdint>

#ifndef MK_ONE_LAUNCH
#define MK_ONE_LAUNCH 1
#endif

__device__ __forceinline__ int lane_fresh() { int l = (int)__builtin_amdgcn_mbcnt_hi(~0u, __builtin_amdgcn_mbcnt_lo(~0u, 0u)); asm volatile("" : "+v"(l)); return l; }
__device__ __forceinline__ void glds16(const void* gsrc, unsigned lds_dst) { unsigned keep;
    asm volatile("s_mov_b32 %0, m0\n\ts_mov_b32 m0, %2\n\ts_nop 0\n\tglobal_load_lds_dwordx4 %1, off\n\ts_mov_b32 m0, %0" : "=&s"(keep) : "v"(gsrc), "s"(lds_dst) : "memory"); }
__device__ __forceinline__ void glds16s(const void* sbase, unsigned voff, unsigned lds_dst) { unsigned keep;
    asm volatile("s_mov_b32 %0, m0\n\ts_mov_b32 m0, %3\n\ts_nop 0\n\tglobal_load_lds_dwordx4 %1, %2\n\ts_mov_b32 m0, %0" : "=&s"(keep) : "v"(voff), "s"(sbase), "s"(lds_dst) : "memory"); }
namespace pg8 {
#define PG8_LAS __attribute__((address_space(3)))
typedef unsigned short bf16_t;
typedef short bf16x8 __attribute__((ext_vector_type(8)));
typedef float f32x4 __attribute__((ext_vector_type(4)));
typedef unsigned u32x4 __attribute__((ext_vector_type(4)));
constexpr int BM = 256, BK = 64, HALF = 128, HTB = HALF * BK * 2  , STAGE_BYTES = 8 * HTB, NXCD = 8, WGM = 8;

__host__ __device__ __forceinline__ int lds_byte(int r, int c) { const int st = (r >> 4) * 2 + (c >> 5), rr = r & 15, cc = c & 31, ob = rr * 64 + cc * 2; return st * 1024 + (ob ^ (((ob >> 9) & 1) << 5)); }
__host__ __device__ __forceinline__ void stage_rc(int b, int& R, int& C) { const int st = b / 1024, sb = b % 1024, swz = sb ^ (((sb >> 9) & 1) << 5); R = (st >> 1) * 16 + swz / 64; C = (st & 1) * 32 + (swz % 64) / 2; }
__host__ __device__ __forceinline__ int perm32(int rho) { const int n = rho >> 4, i = rho & 15; return 8 * (i >> 2) + 4 * n + (i & 3); }

struct Unit { int pm, pn; };
struct Gemm { const bf16_t* A; const bf16_t* Bt; int lda, ldb, K, a_shift, a_mul; };

struct StaticOrder {
    int nM, nN, nwg, G, c;
    __host__ __device__ void init(int M, int N, int G_, int c_) { nM = M / BM; nN = N / BM; nwg = nM * nN; G = G_; c = c_; }
    __host__ __device__ bool next(int i, Unit& u) const {
        const long L = (long)i * G + c; if (L >= nwg) return false;
        int wgid = (int)L; { const int q = nwg / NXCD, r = nwg % NXCD, xcd = wgid % NXCD, off = wgid / NXCD; wgid = (xcd < r ? xcd * (q + 1) : r * (q + 1) + (xcd - r) * q) + off; }
        const int nig = WGM * nN, gid = wgid / nig, fm = gid * WGM, gsz = (nM - fm) < WGM ? (nM - fm) : WGM;
        u.pm = fm + ((wgid % nig) % gsz); u.pn = (wgid % nig) / gsz; return true;
    }
    __device__ __forceinline__ void a_ready(const Unit&) const {}
    __device__ __forceinline__ void done(const Unit&) const {}
};

__device__ __forceinline__ unsigned cvt_pk_bf16(float lo, float hi) { unsigned r; asm volatile("v_cvt_pk_bf16_f32 %0, %1, %2" : "=v"(r) : "v"(lo), "v"(hi)); return r; }
__device__ __forceinline__ float bflo(unsigned w) { return __uint_as_float(w << 16); }
__device__ __forceinline__ float bfhi(unsigned w) { return __uint_as_float(w & 0xffff0000u); }
__device__ __forceinline__ float sigmoidf_fast(float x) { return __builtin_amdgcn_rcpf(1.0f + __builtin_amdgcn_exp2f(-1.4426950408889634f * x)); }

struct EpiBf16 {
    static constexpr bool PERM = true, AFTER_DRAIN = false;
    bf16_t* O; int ldc; float sc = 1.0f;
    __device__ __forceinline__ void operator()(const f32x4 (&acc)[2][2][4][2], const Unit& u, int wr, int wc, int fr, int fq) const {
        const int row0 = u.pm * BM + wr * 64 + fr, col0 = u.pn * BM + wc * 32 + 8 * fq;
#pragma unroll
        for (int ai = 0; ai < 2; ++ai)
#pragma unroll
            for (int m = 0; m < 4; ++m) { bf16_t* rowp = O + (size_t)(row0 + ai * HALF + m * 16) * ldc + col0;
#pragma unroll
                for (int bj = 0; bj < 2; ++bj) { const f32x4 v0 = acc[ai][bj][m][0] * sc, v1 = acc[ai][bj][m][1] * sc;
                    u32x4 w; w.x = cvt_pk_bf16(v0[0], v0[1]); w.y = cvt_pk_bf16(v0[2], v0[3]); w.z = cvt_pk_bf16(v1[0], v1[1]); w.w = cvt_pk_bf16(v1[2], v1[3]);
                    *(u32x4*)(rowp + bj * HALF) = w; } }
    }
};
struct EpiInProj {
    static constexpr bool PERM = true, AFTER_DRAIN = false;
    bf16_t *aq, *ak, *av, *bq, *bc, *iq, *ikw; float qscale;
    __device__ __forceinline__ void operator()(const f32x4 (&acc)[2][2][4][2], const Unit& u, int wr, int wc, int fr, int fq) const {
        bf16_t* base; int ldc, colt; const int pn = u.pn;
        if (pn < 4) { base = aq; ldc = 1024; colt = pn * 256; }
        else if (pn < 8) { base = ak; ldc = 1024; colt = (pn - 4) * 256; }
        else if (pn < 12) { base = av; ldc = 1024; colt = (pn - 8) * 256; }
        else if (pn < 16) { base = bq; ldc = 1024; colt = (pn - 12) * 256; }
        else if (pn < 18) { base = bc; ldc = 512; colt = (pn - 16) * 256; }
        else if (pn < 22) { base = iq; ldc = 1024; colt = (pn - 18) * 256; }
        else { base = ikw; ldc = 256; colt = 0; }
        const float sc = (pn < 4) ? qscale : 1.0f;
        const int row0 = u.pm * BM + wr * 64 + fr, col0 = colt + wc * 32 + 8 * fq;
#pragma unroll
        for (int ai = 0; ai < 2; ++ai)
#pragma unroll
            for (int m = 0; m < 4; ++m) { bf16_t* rowp = base + (size_t)(row0 + ai * HALF + m * 16) * ldc + col0;
#pragma unroll
                for (int bj = 0; bj < 2; ++bj) { const f32x4 v0 = acc[ai][bj][m][0] * sc, v1 = acc[ai][bj][m][1] * sc;
                    u32x4 w; w.x = cvt_pk_bf16(v0[0], v0[1]); w.y = cvt_pk_bf16(v0[2], v0[3]); w.z = cvt_pk_bf16(v1[0], v1[1]); w.w = cvt_pk_bf16(v1[2], v1[3]);
                    *(u32x4*)(rowp + bj * HALF) = w; } }
    }
};
struct EpiSwiGLU {
    static constexpr bool PERM = true, AFTER_DRAIN = false;
    bf16_t* O; int ldc;
    __device__ __forceinline__ void operator()(const f32x4 (&acc)[2][2][4][2], const Unit& u, int wr, int wc, int fr, int fq) const {
        const int row0 = u.pm * BM + wr * 64 + fr, col0 = u.pn * HALF + wc * 32 + 8 * fq;
#pragma unroll
        for (int ai = 0; ai < 2; ++ai)
#pragma unroll
            for (int m = 0; m < 4; ++m) { bf16_t* rowp = O + (size_t)(row0 + ai * HALF + m * 16) * ldc + col0;
                float h[8];
#pragma unroll
                for (int n = 0; n < 2; ++n)
#pragma unroll
                    for (int j = 0; j < 4; ++j) { const float g = acc[ai][0][m][n][j], up = acc[ai][1][m][n][j]; h[4 * n + j] = g * sigmoidf_fast(g) * up; }
                u32x4 w; w.x = cvt_pk_bf16(h[0], h[1]); w.y = cvt_pk_bf16(h[2], h[3]); w.z = cvt_pk_bf16(h[4], h[5]); w.w = cvt_pk_bf16(h[6], h[7]);
                *(u32x4*)rowp = w; }
    }
};
__device__ __forceinline__ unsigned pk4_fp8(float a, float b, float c, float d) { int w = 0; w = __builtin_amdgcn_cvt_pk_fp8_f32(a, b, w, false); w = __builtin_amdgcn_cvt_pk_fp8_f32(c, d, w, true); return (unsigned)w; }
struct EpiSwiGLU8 {
    static constexpr bool PERM = true, AFTER_DRAIN = false;
    unsigned char* O; int ldc; float ascale, hs;
    __device__ __forceinline__ void operator()(const f32x4 (&acc)[2][2][4][2], const Unit& u, int wr, int wc, int fr, int fq) const {
        const int row0 = u.pm * BM + wr * 64 + fr, col0 = u.pn * HALF + wc * 32 + 8 * fq;
        typedef unsigned u32x2 __attribute__((ext_vector_type(2)));
#pragma unroll
        for (int ai = 0; ai < 2; ++ai)
#pragma unroll
            for (int m = 0; m < 4; ++m) { unsigned char* rowp = O + (size_t)(row0 + ai * HALF + m * 16) * ldc + col0;
                float h[8];
#pragma unroll
                for (int n = 0; n < 2; ++n)
#pragma unroll
                    for (int j = 0; j < 4; ++j) { const float g = acc[ai][0][m][n][j] * ascale, up = acc[ai][1][m][n][j] * ascale; h[4 * n + j] = fminf(fmaxf(g * sigmoidf_fast(g) * up * hs, -448.f), 448.f); }
                *(u32x2*)rowp = (u32x2){pk4_fp8(h[0], h[1], h[2], h[3]), pk4_fp8(h[4], h[5], h[6], h[7])}; }
    }
};
struct EpiGateMerge {
    static constexpr bool PERM = true, AFTER_DRAIN = false;
    const bf16_t* ta; const bf16_t* tb; bf16_t* O; int ldc; const float* b0; const float* b1;
    __device__ __forceinline__ void operator()(const f32x4 (&acc)[2][2][4][2], const Unit& u, int wr, int wc, int fr, int fq) const {
        const int row0 = u.pm * BM + wr * 64 + fr, col0 = u.pn * HALF + wc * 32 + 8 * fq;
        float bb0[8], bb1[8];
#pragma unroll
        for (int j = 0; j < 8; ++j) { bb0[j] = b0[col0 + j]; bb1[j] = b1[col0 + j]; }
#pragma unroll
        for (int ai = 0; ai < 2; ++ai)
#pragma unroll
            for (int m = 0; m < 4; ++m) { const size_t off = (size_t)(row0 + ai * HALF + m * 16) * ldc + col0;
                const u32x4 a = *(const u32x4*)(ta + off), b = *(const u32x4*)(tb + off);
                const float av[8] = {bflo(a.x), bfhi(a.x), bflo(a.y), bfhi(a.y), bflo(a.z), bfhi(a.z), bflo(a.w), bfhi(a.w)};
                const float bv[8] = {bflo(b.x), bfhi(b.x), bflo(b.y), bfhi(b.y), bflo(b.z), bfhi(b.z), bflo(b.w), bfhi(b.w)};
                float h[8];
#pragma unroll
                for (int n = 0; n < 2; ++n)
#pragma unroll
                    for (int j = 0; j < 4; ++j) { const int e = 4 * n + j; h[e] = sigmoidf_fast(acc[ai][0][m][n][j] + bb0[e]) * av[e] + sigmoidf_fast(acc[ai][1][m][n][j] + bb1[e]) * bv[e]; }
                u32x4 w; w.x = cvt_pk_bf16(h[0], h[1]); w.y = cvt_pk_bf16(h[2], h[3]); w.z = cvt_pk_bf16(h[4], h[5]); w.w = cvt_pk_bf16(h[6], h[7]);
                *(u32x4*)(O + off) = w; }
    }
};
struct EpiGateMerge8 {
    static constexpr bool PERM = true, AFTER_DRAIN = false;
    const bf16_t* ta; const bf16_t* tb; unsigned char* O; int ldc; const float* b0; const float* b1; float ascale, ms;
    __device__ __forceinline__ void operator()(const f32x4 (&acc)[2][2][4][2], const Unit& u, int wr, int wc, int fr, int fq) const {
        const int row0 = u.pm * BM + wr * 64 + fr, col0 = u.pn * HALF + wc * 32 + 8 * fq;
        typedef unsigned u32x2 __attribute__((ext_vector_type(2)));
        float bb0[8], bb1[8];
#pragma unroll
        for (int j = 0; j < 8; ++j) { bb0[j] = b0[col0 + j]; bb1[j] = b1[col0 + j]; }
#pragma unroll
        for (int ai = 0; ai < 2; ++ai)
#pragma unroll
            for (int m = 0; m < 4; ++m) { const size_t off = (size_t)(row0 + ai * HALF + m * 16) * ldc + col0;
                const u32x4 a = *(const u32x4*)(ta + off), b = *(const u32x4*)(tb + off);
                const float av[8] = {bflo(a.x), bfhi(a.x), bflo(a.y), bfhi(a.y), bflo(a.z), bfhi(a.z), bflo(a.w), bfhi(a.w)};
                const float bv[8] = {bflo(b.x), bfhi(b.x), bflo(b.y), bfhi(b.y), bflo(b.z), bfhi(b.z), bflo(b.w), bfhi(b.w)};
                float h[8];
#pragma unroll
                for (int n = 0; n < 2; ++n)
#pragma unroll
                    for (int j = 0; j < 4; ++j) { const int e = 4 * n + j; const float v = sigmoidf_fast(acc[ai][0][m][n][j] * ascale + bb0[e]) * av[e] + sigmoidf_fast(acc[ai][1][m][n][j] * ascale + bb1[e]) * bv[e];
                        h[e] = fminf(fmaxf(v * ms, -448.f), 448.f); }
                *(u32x2*)(O + off) = (u32x2){pk4_fp8(h[0], h[1], h[2], h[3]), pk4_fp8(h[4], h[5], h[6], h[7])}; }
    }
};
struct EpiRes {
    static constexpr bool PERM = false, AFTER_DRAIN = false;
    const float* res; float* out; int ldc; float alpha, s;
    __device__ __forceinline__ void operator()(const f32x4 (&acc)[2][2][4][2], const Unit& u, int wr, int wc, int fr, int fq) const {
        const int col0 = u.pn * BM + wc * 32 + 4 * fq;
#pragma unroll
        for (int ai = 0; ai < 2; ++ai)
#pragma unroll
            for (int m = 0; m < 4; ++m) { const size_t off = (size_t)(u.pm * BM + ai * HALF + wr * 64 + m * 16 + fr) * ldc + col0;
#pragma unroll
                for (int bj = 0; bj < 2; ++bj)
#pragma unroll
                    for (int n = 0; n < 2; ++n) { const f32x4 r = *(const f32x4*)(res + off + bj * HALF + n * 16); *(f32x4*)(out + off + bj * HALF + n * 16) = r * alpha + acc[ai][bj][m][n] * s; }
                if (m & 1) asm volatile("" ::: "memory"); }
    }
};

typedef int v8i_t __attribute__((ext_vector_type(8)));
typedef int v4i_t __attribute__((ext_vector_type(4)));
template <class Epi, class Sched, bool ALIGN_EPI, bool FP8 = false>
__device__ __forceinline__ void gemm_phase(PG8_LAS unsigned char* lds, const Gemm g, const Sched& S, const Epi& E, const int wid) {
    const int lane = lane_fresh(), tid = wid * 64 + lane, wr = wid >> 2, wc = wid & 3, fr = lane & 15, fq = lane >> 4;
    const int K = g.K, nt = K / BK;
    unsigned voffA[2], voffB[2];
#pragma unroll
    for (int i = 0; i < 2; ++i) { int R, C; stage_rc(tid * 16 + i * 8192, R, C); const int Rb = Epi::PERM ? ((R & ~31) + perm32(R & 31)) : R;
        voffA[i] = (unsigned)(R * g.lda + C) * 2u; voffB[i] = (unsigned)(Rb * g.ldb + C) * 2u; }
    const size_t kstep = (size_t)(BK * 2);
    const size_t hstepA = (size_t)HALF * g.lda * 2, hstepB = (size_t)HALF * g.ldb * 2;
    const size_t tstepA = 2 * hstepA, tstepB = 2 * hstepB;
    const unsigned ldsw = (unsigned)wid * 1024u;
    const int aoff = lds_byte(wr * 64 + fr, fq * 8), boff = lds_byte(wc * 32 + fr, fq * 8);
#define PG8_UA(u) ((const char*)g.A + (size_t)(u).pm * tstepA + (size_t)(((u).pn >> g.a_shift) * g.a_mul) * 2)
#define PG8_UB(u) ((const char*)g.Bt + (size_t)(u).pn * tstepB)
#define PG8_SA(b, h) (((b) * 2 + (h)) * HTB)
#define PG8_SB(b, h) ((4 + (b) * 2 + (h)) * HTB)
#define PG8_STAGE(bufoff, gbase, voff) do { _Pragma("unroll") for (int _i = 0; _i < 2; ++_i) \
        __builtin_amdgcn_global_load_lds((const unsigned*)((const char*)(gbase) + (voff)[_i]), (PG8_LAS unsigned*)(lds + (bufoff) + ldsw + _i * 8192), 16, 0, 0); } while (0)
#define PG8_LD8(p_) __builtin_shufflevector(*(const PG8_LAS v4i_t*)(p_), *(const PG8_LAS v4i_t*)((p_) + 1024), 0, 1, 2, 3, 4, 5, 6, 7)
#define PG8_LDA(dst, b, h) do { _Pragma("unroll") for (int m = 0; m < 4; ++m) { if constexpr (FP8) dst##8[m] = PG8_LD8(lds + PG8_SA(b, h) + aoff + m * 2048); else { _Pragma("unroll") for (int k = 0; k < 2; ++k) dst[m][k] = *(const PG8_LAS bf16x8*)(lds + PG8_SA(b, h) + aoff + m * 2048 + k * 1024); } } } while (0)
#define PG8_LDB(dst, b, h) do { _Pragma("unroll") for (int n = 0; n < 2; ++n) { if constexpr (FP8) dst##8[n] = PG8_LD8(lds + PG8_SB(b, h) + boff + n * 2048); else { _Pragma("unroll") for (int k = 0; k < 2; ++k) dst[n][k] = *(const PG8_LAS bf16x8*)(lds + PG8_SB(b, h) + boff + n * 2048 + k * 1024); } } } while (0)
#define PG8_MMA(ai, bj, At, Bt) do { __builtin_amdgcn_s_setprio(1); _Pragma("unroll") for (int m = 0; m < 4; ++m) _Pragma("unroll") for (int n = 0; n < 2; ++n) { \
        if constexpr (FP8) asm volatile("v_mfma_scale_f32_16x16x128_f8f6f4 %0, %1, %2, %0, %3, %3 op_sel_hi:[0,0,0]" : "+v"(acc[ai][bj][m][n]) : "v"(Bt##8[n]), "v"(At##8[m]), "v"(one_scale)); \
        else { _Pragma("unroll") for (int k = 0; k < 2; ++k) acc[ai][bj][m][n] = __builtin_amdgcn_mfma_f32_16x16x32_bf16(Bt[n][k], At[m][k], acc[ai][bj][m][n], 0, 0, 0); } } \
        __builtin_amdgcn_s_setprio(0); } while (0)
#define PG8_WAIT_V(n) asm volatile("s_waitcnt vmcnt(" #n ")" ::: "memory")
#define PG8_WAIT_L(n) asm volatile("s_waitcnt lgkmcnt(" #n ")" ::: "memory")
#define PG8_BAR __builtin_amdgcn_s_barrier()
#define PG8_SCHED __builtin_amdgcn_sched_barrier(0)
    Unit cur, nxt; int ui = 0;
    if (!S.next(0, cur)) return;
    f32x4 acc[2][2][4][2];
#pragma unroll
    for (int a = 0; a < 2; ++a)
#pragma unroll
        for (int b = 0; b < 2; ++b)
#pragma unroll
            for (int m = 0; m < 4; ++m)
#pragma unroll
                for (int n = 0; n < 2; ++n) acc[a][b][m][n] = (f32x4){0.f, 0.f, 0.f, 0.f};
    bf16x8 At[4][2], B0[2][2], B1[2][2]; v8i_t At8[4], B08[2], B18[2];
    int one_scale = 0x7f7f7f7f; asm volatile("" : "+v"(one_scale));
    const char* cA = PG8_UA(cur); const char* cB = PG8_UB(cur);
    S.a_ready(cur);
    PG8_STAGE(PG8_SB(0, 0), cB, voffB); PG8_STAGE(PG8_SB(0, 1), cB + hstepB, voffB); PG8_STAGE(PG8_SA(0, 0), cA, voffA); PG8_STAGE(PG8_SA(0, 1), cA + hstepA, voffA);
    if (wr == 1) PG8_BAR;
    PG8_WAIT_V(2); PG8_BAR;
    PG8_STAGE(PG8_SB(1, 0), cB + kstep, voffB); PG8_STAGE(PG8_SA(1, 0), cA + kstep, voffA); PG8_STAGE(PG8_SB(1, 1), cB + hstepB + kstep, voffB);
    PG8_WAIT_V(6); PG8_BAR;
    for (;;) {
        const bool has_next = S.next(ui + 1, nxt);
        const char* nA = has_next ? PG8_UA(nxt) : cA; const char* nB = has_next ? PG8_UB(nxt) : cB;
        for (int t = 0; t < nt; t += 2) {
            const bool last = (t == nt - 2);
            const char* a1 = cA + (size_t)(t + 1) * kstep;
            const char* a2 = last ? nA : cA + (size_t)(t + 2) * kstep; const char* b2 = last ? nB : cB + (size_t)(t + 2) * kstep;
            const char* a3 = a2 + kstep; const char* b3 = b2 + kstep;
            if (last && has_next) S.a_ready(nxt);
            PG8_LDB(B0, 0, 0); PG8_LDB(B1, 0, 1); PG8_SCHED; PG8_LDA(At, 0, 0); PG8_STAGE(PG8_SA(1, 1), a1 + hstepA, voffA);
            PG8_WAIT_V(8); PG8_WAIT_L(0); PG8_BAR; PG8_MMA(0, 0, At, B0); PG8_MMA(0, 1, At, B1); PG8_BAR; PG8_SCHED;
            PG8_LDA(At, 0, 1); PG8_STAGE(PG8_SB(0, 0), b2, voffB); PG8_STAGE(PG8_SB(0, 1), b2 + hstepB, voffB); PG8_STAGE(PG8_SA(0, 0), a2, voffA);
            PG8_WAIT_V(8); PG8_WAIT_L(0); PG8_BAR; PG8_MMA(1, 0, At, B0); PG8_MMA(1, 1, At, B1); PG8_BAR; PG8_SCHED;
            PG8_LDB(B0, 1, 0); PG8_LDB(B1, 1, 1); PG8_SCHED; PG8_LDA(At, 1, 0); PG8_STAGE(PG8_SA(0, 1), a2 + hstepA, voffA);
            PG8_WAIT_V(8); PG8_WAIT_L(0); PG8_BAR; PG8_MMA(0, 0, At, B0); PG8_MMA(0, 1, At, B1); PG8_BAR; PG8_SCHED;
            PG8_LDA(At, 1, 1); PG8_STAGE(PG8_SB(1, 0), b3, voffB); PG8_STAGE(PG8_SB(1, 1), b3 + hstepB, voffB); PG8_STAGE(PG8_SA(1, 0), a3, voffA);
            PG8_WAIT_V(8); PG8_WAIT_L(0); PG8_BAR; PG8_MMA(1, 0, At, B0); PG8_MMA(1, 1, At, B1); PG8_BAR; PG8_SCHED;
        }
        if constexpr (ALIGN_EPI) { if (wr == 0) PG8_BAR; }
        if constexpr (FP8) asm volatile("s_nop 15\n\ts_nop 7" ::: "memory");
        E(acc, cur, wr, wc, fr, fq); S.done(cur);
        if (!has_next) break;
#pragma unroll
        for (int a = 0; a < 2; ++a)
#pragma unroll
            for (int b = 0; b < 2; ++b)
#pragma unroll
                for (int m = 0; m < 4; ++m)
#pragma unroll
                    for (int n = 0; n < 2; ++n) acc[a][b][m][n] = (f32x4){0.f, 0.f, 0.f, 0.f};
        cur = nxt; cA = nA; cB = nB; ++ui;
        if constexpr (ALIGN_EPI) { if (wr == 1) PG8_BAR; }
    }
    PG8_WAIT_V(0);
    if constexpr (!ALIGN_EPI) { if (wr == 0) PG8_BAR; }
    PG8_BAR;
#undef PG8_UA
#undef PG8_UB
#undef PG8_SA
#undef PG8_SB
#undef PG8_STAGE
#undef PG8_LDA
#undef PG8_LDB
#undef PG8_MMA
#undef PG8_LD8
#undef PG8_WAIT_V
#undef PG8_WAIT_L
#undef PG8_BAR
#undef PG8_SCHED
}
}

constexpr int NWAVES = 8;
constexpr int BATCH = 4, SEQ = 4096, D = 2048, FF = 5632, M = BATCH * SEQ;
constexpr int N_IN = 5888;
constexpr int MEMT = 256;
constexpr float LN_EPS = 1e-5f;
constexpr float ALPHA = 1.189207115002721f;
constexpr float LAMBDA_INIT = 0.2f;

constexpr size_t MiB = 1u << 20;
constexpr size_t WS_CTL = 0, CTL_ZERO_BYTES = 1 * MiB;
constexpr size_t WS_W_IN = 2 * MiB;
constexpr size_t WS_W_G = 25 * MiB;
constexpr size_t WS_W_UK = 41 * MiB;
constexpr size_t WS_W_UVP = 42 * MiB;
constexpr size_t WS_W_A = 44 * MiB;
constexpr size_t WS_W_B = 48 * MiB;
constexpr size_t WS_W_MO = 52 * MiB;
constexpr size_t WS_W_MQ = 60 * MiB;
constexpr size_t WS_W_MKV = 62 * MiB;
constexpr size_t WS_W_MOUT = 66 * MiB;
constexpr size_t WS_MEM16 = 68 * MiB;
constexpr size_t WS_KVMEM = 72 * MiB;
constexpr size_t WS_W_GU2 = 74 * MiB;
constexpr size_t WS_W_D2 = 96 * MiB;
constexpr size_t WS_X8M = 107 * MiB;
constexpr size_t WS_X16 = 140 * MiB;
constexpr size_t WS_MIX = 204 * MiB;
constexpr size_t WS_W_GU1 = 204 * MiB;
constexpr size_t WS_W_D1 = 248 * MiB;
constexpr size_t WS_H = 270 * MiB;
constexpr size_t WS_AQ = WS_MIX + 0 * MiB, WS_AK = WS_MIX + 32 * MiB, WS_AV = WS_MIX + 64 * MiB, WS_BQ = WS_MIX + 96 * MiB;
constexpr size_t WS_BC = WS_MIX + 128 * MiB;
constexpr size_t WS_IQ = WS_MIX + 144 * MiB;
constexpr size_t WS_IKW = WS_MIX + 176 * MiB;
constexpr size_t WS_QLAT = WS_MIX + 184 * MiB;
constexpr size_t WS_IDX = WS_MIX + 312 * MiB;
constexpr size_t WS_YB = WS_BQ;
constexpr size_t WS_TA = WS_QLAT, WS_TB = WS_QLAT + 64 * MiB;
constexpr size_t WS_QM = WS_AQ, WS_OM = WS_AQ + 16 * MiB;
constexpr size_t WS_X8 = WS_H + 96 * MiB;
constexpr size_t WS_MRG8 = WS_AV;
constexpr float FP8_WGS = 1024.f, FP8_MS = 32.f, FP8_WMOS = 2048.f;
constexpr float FP8_XS = 32.f, FP8_WGUS = 1024.f, FP8_HS = 8.f, FP8_WDS = 4096.f;
constexpr size_t WS_END = WS_MIX + 320 * MiB;
static_assert(WS_H + (size_t)M * FF * 2 <= WS_END && WS_QLAT + (size_t)M * 4096 * 2 <= WS_END, "d_ws map");
constexpr int CW_BAR = 4096;

constexpr int RING_OFF = 0, RING_BYTES = 153600;
constexpr int LDSCTL_OFF = RING_BYTES, MISC_OFF = LDSCTL_OFF + 320;
constexpr int LDS_BYTES = 154624;
static_assert(MISC_OFF + 128 <= LDS_BYTES, "LDS map");

#define GAS __attribute__((address_space(1)))
#define LAS __attribute__((address_space(3)))
typedef unsigned short bf16;
typedef unsigned v4u __attribute__((ext_vector_type(4)));
typedef unsigned v2u __attribute__((ext_vector_type(2)));
typedef float f32x4 __attribute__((ext_vector_type(4)));
typedef float f32x16 __attribute__((ext_vector_type(16)));
typedef short bf16x8 __attribute__((ext_vector_type(8)));
typedef GAS unsigned gu32;
#define RLX_AGENT __ATOMIC_RELAXED, __HIP_MEMORY_SCOPE_AGENT
#define LDS_WAIT() asm volatile("s_waitcnt lgkmcnt(0)" ::: "memory")
#define VM_WAIT() asm volatile("s_waitcnt vmcnt(0)" ::: "memory")
__device__ __forceinline__ unsigned f2bf(float f) { unsigned u = __builtin_bit_cast(unsigned, f); return (u + 0x7fffu + ((u >> 16) & 1u)) >> 16; }
__device__ __forceinline__ unsigned pk2(float lo, float hi) { return f2bf(lo) | (f2bf(hi) << 16); }
__device__ __forceinline__ float bf2f(unsigned short v) { return __uint_as_float((unsigned)v << 16); }
__device__ __forceinline__ float blo(unsigned w) { return __uint_as_float(w << 16); }
__device__ __forceinline__ float bhi(unsigned w) { return __uint_as_float(w & 0xffff0000u); }
__device__ __forceinline__ float wave_sum(float v) {
#pragma unroll
    for (int o = 1; o < 64; o <<= 1) v += __shfl_xor(v, o);
    return v;
}

#define XB_TMO      128
#define XB_XCNT(j)  (256  + 64 * (j))
#define XB_XSUB(j)  (1280 + 64 * (j))
#define XB_XGEN(j)  (2304 + 64 * (j))
#define XB_TOP      3328
#define XB_TOPGEN   3392
#define XCD_BAR_WORDS 3456
#define XB_SPIN_CAP (1u << 18)

__device__ __forceinline__ unsigned xb_ld(unsigned* p)              { return __hip_atomic_load(p, __ATOMIC_RELAXED, __HIP_MEMORY_SCOPE_AGENT); }
__device__ __forceinline__ unsigned xb_add(unsigned* p, unsigned v) { return __hip_atomic_fetch_add(p, v, __ATOMIC_RELAXED, __HIP_MEMORY_SCOPE_AGENT); }
__device__ __forceinline__ unsigned xb_xcc_id() { return (unsigned)__builtin_amdgcn_s_getreg((3 << 11) | 20) & 0xFu; }
#define XB_SPIN(cond, bar) do { unsigned _sp = 0; while (cond) { __builtin_amdgcn_s_sleep(1); \
    if ((++_sp & 255u) == 0u) { if (xb_ld(&(bar)[XB_TMO])) break; if (_sp > XB_SPIN_CAP) { atomicAdd(&(bar)[XB_TMO], 1u); break; } } } } while (0)

struct XcdBarrier {
    unsigned* bar; unsigned x;
    volatile LAS unsigned* st;
};

__device__ __forceinline__ XcdBarrier xcd_barrier_post(unsigned* bar, volatile LAS unsigned* st, bool t0) {
    XcdBarrier b; b.bar = bar; b.x = xb_xcc_id(); b.st = st;
    if (t0) (void)xb_add(&bar[XB_XCNT(b.x)], 1u);
    return b;
}
__device__ __forceinline__ void xcd_barrier_complete(unsigned* bar, unsigned x, unsigned& nloc, unsigned& nx) {
    const unsigned G = gridDim.x * gridDim.y * gridDim.z;
    unsigned sum, cnt, mine, sp = 0u;
    for (;;) {
        sum = 0u; cnt = 0u; mine = 0u;
#pragma unroll
        for (unsigned j = 0; j < 16; ++j) { const unsigned c = xb_ld(&bar[XB_XCNT(j)]); sum += c; cnt += (c > 0u) ? 1u : 0u; mine = (j == x) ? c : mine; }
        if (sum == G) break;
        __builtin_amdgcn_s_sleep(1);
        if ((++sp & 255u) == 0u) { if (xb_ld(&bar[XB_TMO])) break; if (sp > XB_SPIN_CAP) { atomicAdd(&bar[XB_TMO], 1u); break; } }
    }
    nloc = mine > 0u ? mine : 1u; nx = cnt > 0u ? cnt : 1u;
}

__device__ __forceinline__ void xcd_barrier(const XcdBarrier& b, const int wave) {
    asm volatile("s_waitcnt vmcnt(0)" ::: "memory");
    __syncthreads();
    if (wave == 0 && lane_fresh() == 0) {
        unsigned* bar = b.bar;
        __builtin_amdgcn_s_waitcnt(0);
        unsigned nloc = b.st[0], nx = b.st[1];
        if (nloc == 0u) { xcd_barrier_complete(bar, b.x, nloc, nx); b.st[0] = nloc; b.st[1] = nx; }
        const unsigned old = xb_add(&bar[XB_XSUB(b.x)], 1u);
        const unsigned gen = old / nloc;
        if (old + 1u == (gen + 1u) * nloc) {
            __builtin_amdgcn_fence(__ATOMIC_RELEASE, "agent");
            asm volatile("s_waitcnt vmcnt(0)" ::: "memory");
            const unsigned og = xb_add(&bar[XB_TOP], 1u);
            const unsigned tg = og / nx;
            if (og + 1u == (tg + 1u) * nx) xb_add(&bar[XB_TOPGEN], 1u);
            else XB_SPIN(xb_ld(&bar[XB_TOPGEN]) == tg, bar);
            __builtin_amdgcn_fence(__ATOMIC_ACQUIRE, "agent");
            xb_add(&bar[XB_XGEN(b.x)], 1u);
            asm volatile("s_waitcnt vmcnt(0)" ::: "memory");
        } else {
            XB_SPIN(xb_ld(&bar[XB_XGEN(b.x)]) == gen, bar);
            __builtin_amdgcn_fence(__ATOMIC_ACQUIRE, "agent");
            asm volatile("s_waitcnt vmcnt(0)" ::: "memory");
        }
    }
    __syncthreads();
}

__device__ __forceinline__ void tr_item(const float* W, int ldw, int nvalid, bf16* WT, int ldt, int k0, int n0, int drow0, int dcol0, LAS float* scr, int lane) {
    const int n = n0 + (lane & 31); const bool ok = n < nvalid;
#pragma unroll 8
    for (int i = 0; i < 32; ++i) { const int kk = 2 * i + (lane >> 5); scr[kk * 33 + (lane & 31)] = ok ? W[(size_t)(k0 + kk) * ldw + n] : 0.f; }
    LDS_WAIT(); asm volatile("" ::: "memory");
    const int c = lane & 7;
#pragma unroll
    for (int j = 0; j < 4; ++j) { const int nn = (lane >> 3) + 8 * j; const LAS float* s = scr + (8 * c) * 33 + nn;
        v4u o; o.x = pk2(s[0 * 33], s[1 * 33]); o.y = pk2(s[2 * 33], s[3 * 33]); o.z = pk2(s[4 * 33], s[5 * 33]); o.w = pk2(s[6 * 33], s[7 * 33]);
        *(GAS v4u*)(WT + (size_t)(drow0 + nn) * ldt + dcol0 + k0 + 8 * c) = o; }
    LDS_WAIT(); asm volatile("" ::: "memory");
}
__device__ __forceinline__ void tr_item8(const float* W, int ldw, unsigned char* WT, int ldt, int k0, int n0, int drow0, float sc, LAS float* scr, int lane) {
    const int n = n0 + (lane & 31);
#pragma unroll 8
    for (int i = 0; i < 32; ++i) { const int kk = 2 * i + (lane >> 5); scr[kk * 33 + (lane & 31)] = W[(size_t)(k0 + kk) * ldw + n]; }
    LDS_WAIT(); asm volatile("" ::: "memory");
    const int nn = lane >> 1, hf = lane & 1; const LAS float* sp = scr + (32 * hf) * 33 + nn;
    unsigned o[8];
#pragma unroll
    for (int q = 0; q < 8; ++q) { const float a = fminf(fmaxf(sp[(4 * q + 0) * 33] * sc, -448.f), 448.f), b = fminf(fmaxf(sp[(4 * q + 1) * 33] * sc, -448.f), 448.f), c = fminf(fmaxf(sp[(4 * q + 2) * 33] * sc, -448.f), 448.f), d = fminf(fmaxf(sp[(4 * q + 3) * 33] * sc, -448.f), 448.f);
        int w = 0; w = __builtin_amdgcn_cvt_pk_fp8_f32(a, b, w, false); w = __builtin_amdgcn_cvt_pk_fp8_f32(c, d, w, true); o[q] = (unsigned)w; }
    GAS v4u* dst = (GAS v4u*)(WT + (size_t)(drow0 + nn) * ldt + k0 + 32 * hf);
    dst[0] = (v4u){o[0], o[1], o[2], o[3]}; dst[1] = (v4u){o[4], o[5], o[6], o[7]};
    LDS_WAIT(); asm volatile("" ::: "memory");
}
__device__ __forceinline__ void cvt_item8(const float* src, unsigned char* dst, int item, int lane, float sc) {
    const GAS f32x4* sp = (const GAS f32x4*)(src + (size_t)item * 512) + 2 * lane; f32x4 a = sp[0] * sc, b = sp[1] * sc;
    int w0 = 0, w1 = 0; w0 = __builtin_amdgcn_cvt_pk_fp8_f32(fminf(fmaxf(a.x, -448.f), 448.f), fminf(fmaxf(a.y, -448.f), 448.f), w0, false); w0 = __builtin_amdgcn_cvt_pk_fp8_f32(fminf(fmaxf(a.z, -448.f), 448.f), fminf(fmaxf(a.w, -448.f), 448.f), w0, true);
    w1 = __builtin_amdgcn_cvt_pk_fp8_f32(fminf(fmaxf(b.x, -448.f), 448.f), fminf(fmaxf(b.y, -448.f), 448.f), w1, false); w1 = __builtin_amdgcn_cvt_pk_fp8_f32(fminf(fmaxf(b.z, -448.f), 448.f), fminf(fmaxf(b.w, -448.f), 448.f), w1, true);
    *((GAS v2u*)(dst + (size_t)item * 512) + lane) = (v2u){(unsigned)w0, (unsigned)w1};
}
__device__ __forceinline__ void cvt_item(const float* src, bf16* dst, int item, int lane) {
    const GAS f32x4* s = (const GAS f32x4*)(src + (size_t)item * 512) + 2 * lane; const f32x4 a = s[0], b = s[1];
    v4u o; o.x = pk2(a.x, a.y); o.y = pk2(a.z, a.w); o.z = pk2(b.x, b.y); o.w = pk2(b.z, b.w);
    *((GAS v4u*)(dst + (size_t)item * 512) + lane) = o;
}
__device__ __forceinline__ void p0_prologue(const float* const (&in)[24], unsigned char* ws, LAS unsigned char* lds, int gw, int NGW, int wave, int lane) {
    LAS float* scr = (LAS float*)(lds + RING_OFF + wave * 16384);
#define TRM(SRC, Kk, LDW, NVALID, NPAD, DST, LDT, ROWMAP, DCOL) { constexpr int nblk = (NPAD) / 32; constexpr int cnt = ((Kk) / 64) * nblk; \
        if (r < cnt) { const int kb = r / nblk, nb = r % nblk, n0 = 32 * nb; tr_item(SRC, LDW, NVALID, (bf16*)(ws + (DST)), LDT, 64 * kb, n0, (ROWMAP), (DCOL), scr, lane); continue; } r -= cnt; }
#define TRM8(SRC, Kk, LDW, NN, DST, LDT, ROWMAP, SC) { constexpr int nblk = (NN) / 32; constexpr int cnt = ((Kk) / 64) * nblk; \
        if (r < cnt) { const int kb = r / nblk, nb = r % nblk, n0 = 32 * nb; tr_item8(SRC, LDW, (unsigned char*)(ws + (DST)), LDT, 64 * kb, n0, (ROWMAP), SC, scr, lane); continue; } r -= cnt; }
    constexpr int N_TR = 2 * (32 * 176) + 88 * 64 + 32 * 184 + 2 * (32 * 64) + 256 + 2 * (16 * 64) + 32 * 64 + 32 * 16 + 32 * 32 + 8 * 64 + 2 * (32 * 176) + 88 * 64;
    for (int it = gw; it < N_TR; it += NGW) {
        int r = it;
        TRM8(in[2], 2048, 5632, 5632, WS_W_GU1, 2048, 256 * (n0 >> 7) + (n0 & 127), FP8_WGUS)
        TRM8(in[3], 2048, 5632, 5632, WS_W_GU1, 2048, 256 * (n0 >> 7) + 128 + (n0 & 127), FP8_WGUS)
        TRM8(in[4], 5632, 2048, 2048, WS_W_D1, 5632, n0, FP8_WDS)
        TRM(in[5], 2048, 5712, 5712, 5888, WS_W_IN, 2048, n0, 0)
        TRM8(in[11], 2048, 2048, 2048, WS_W_G, 2048, 256 * (n0 >> 7) + (n0 & 127), FP8_WGS)
        TRM8(in[11] + (size_t)2048 * 2048, 2048, 2048, 2048, WS_W_G, 2048, 256 * (n0 >> 7) + 128 + (n0 & 127), FP8_WGS)
        if (r < 256) { const int h = r >> 5, rr = r & 31, kb = rr >> 2, nb = rr & 3;
            tr_item(in[10] + (size_t)h * 512 * 128, 128, 128, (bf16*)(ws + WS_W_UVP), 1024, 64 * kb, 32 * nb, (h >> 1) * 256 + (h & 1) * 128 + 32 * nb, (h & 1) * 512, scr, lane); continue; } r -= 256;
        TRM(in[13], 1024, 2048, 2048, 2048, WS_W_A, 1024, n0, 0)
        TRM(in[14], 1024, 2048, 2048, 2048, WS_W_B, 1024, n0, 0)
        TRM8(in[15], 2048, 2048, 2048, WS_W_MO, 2048, n0, FP8_WMOS)
        TRM(in[16], 2048, 512, 512, 512, WS_W_MQ, 2048, n0, 0)
        TRM(in[17], 2048, 1024, 1024, 1024, WS_W_MKV, 2048, n0, 0)
        TRM(in[18], 512, 2048, 2048, 2048, WS_W_MOUT, 512, n0, 0)
        TRM8(in[19], 2048, 5632, 5632, WS_W_GU2, 2048, 256 * (n0 >> 7) + (n0 & 127), FP8_WGUS)
        TRM8(in[20], 2048, 5632, 5632, WS_W_GU2, 2048, 256 * (n0 >> 7) + 128 + (n0 & 127), FP8_WGUS)
        TRM8(in[21], 5632, 2048, 2048, WS_W_D2, 5632, n0, FP8_WDS)
    }
#undef TRM
#undef TRM8
    for (int rw = gw; rw < 1024; rw += NGW) { const int e = (rw >> 7) & 1; *((GAS v4u*)((bf16*)(ws + WS_W_UVP) + (size_t)rw * 1024 + (1 - e) * 512) + lane) = (v4u){0u, 0u, 0u, 0u}; }
    for (int it = gw; it < (M * D) / 512; it += NGW) cvt_item8(in[0], (unsigned char*)(ws + WS_X8), it, lane, FP8_XS);
    for (int it = gw; it < (BATCH * MEMT * D) / 512; it += NGW) cvt_item(in[1], (bf16*)(ws + WS_MEM16), it, lane);
    for (int it = gw; it < (8 * 512 * 128) / 512; it += NGW) cvt_item(in[9], (bf16*)(ws + WS_W_UK), it, lane);
}

__device__ __forceinline__ void ln_phase(float* zx, bf16* x16, unsigned char* x8, const float* g, const float* b, int gw, int NGW, int lane) {
    f32x4 gv[8], bv[8];
#pragma unroll
    for (int j = 0; j < 8; ++j) { gv[j] = *((const GAS f32x4*)g + lane + 64 * j); bv[j] = *((const GAS f32x4*)b + lane + 64 * j); }
    for (int m = gw; m < M; m += NGW) {
        GAS f32x4* xr = (GAS f32x4*)(zx + (size_t)m * D) + lane;
        f32x4 v[8]; float s = 0.f;
#pragma unroll
        for (int j = 0; j < 8; ++j) { v[j] = xr[64 * j]; s += (v[j].x + v[j].y) + (v[j].z + v[j].w); }
        const float mean = wave_sum(s) * (1.f / D); float s2 = 0.f;
#pragma unroll
        for (int j = 0; j < 8; ++j) { v[j] = v[j] - mean; s2 += (v[j].x * v[j].x + v[j].y * v[j].y) + (v[j].z * v[j].z + v[j].w * v[j].w); }
        const float rstd = 1.f / sqrtf(wave_sum(s2) * (1.f / D) + LN_EPS);
#pragma unroll
        for (int j = 0; j < 8; ++j) { v[j] = v[j] * rstd * gv[j] + bv[j]; xr[64 * j] = v[j]; }
        if (x16) { GAS v2u* o8 = (GAS v2u*)(x16 + (size_t)m * D) + lane;
#pragma unroll
            for (int j = 0; j < 8; ++j) o8[64 * j] = (v2u){pk2(v[j].x, v[j].y), pk2(v[j].z, v[j].w)}; }
        if (x8) { GAS unsigned* o4 = (GAS unsigned*)(x8 + (size_t)m * D) + lane;
#pragma unroll
            for (int j = 0; j < 8; ++j) { const f32x4 q = v[j] * FP8_XS; int w = 0; w = __builtin_amdgcn_cvt_pk_fp8_f32(fminf(fmaxf(q.x, -448.f), 448.f), fminf(fmaxf(q.y, -448.f), 448.f), w, false);
                w = __builtin_amdgcn_cvt_pk_fp8_f32(fminf(fmaxf(q.z, -448.f), 448.f), fminf(fmaxf(q.w, -448.f), 448.f), w, true); o4[64 * j] = (unsigned)w; } }
    }
}
__device__ __forceinline__ void crms_phase(bf16* bc, const float* kvg, int gw, int NGW, int lane) {
    float gg[8];
#pragma unroll
    for (int j = 0; j < 8; ++j) gg[j] = kvg[8 * lane + j];
    for (int m = gw; m < M; m += NGW) {
        GAS v4u* p = (GAS v4u*)(bc + (size_t)m * 512) + lane; const v4u w = *p;
        float x[8] = {blo(w.x), bhi(w.x), blo(w.y), bhi(w.y), blo(w.z), bhi(w.z), blo(w.w), bhi(w.w)}; float s = 0.f;
#pragma unroll
        for (int j = 0; j < 8; ++j) s += x[j] * x[j];
        const float r = 1.f / sqrtf(wave_sum(s) * (1.f / 512.f) + LN_EPS);
#pragma unroll
        for (int j = 0; j < 8; ++j) x[j] = x[j] * r * gg[j];
        *p = (v4u){pk2(x[0], x[1]), pk2(x[2], x[3]), pk2(x[4], x[5]), pk2(x[6], x[7])};
    }
}

typedef short v4i16_t __attribute__((ext_vector_type(4)));
__device__ __forceinline__ v4i16_t lds_tr16(const LAS unsigned char* p) { return __builtin_amdgcn_ds_read_tr16_b64_v4i16((LAS v4i16_t*)p); }
__device__ __forceinline__ unsigned cvtpk(float lo, float hi) { typedef float f2 __attribute__((ext_vector_type(2))); typedef __bf16 b2 __attribute__((ext_vector_type(2))); f2 v = {lo, hi}; b2 b = __builtin_convertvector(v, b2); return __builtin_bit_cast(unsigned, b); }
__device__ __forceinline__ float xhalf_f(float v) { return __shfl_xor(v, 32); }
constexpr float LOG2E = 1.4426950408889634f;
constexpr float QSCALE = 0.125f * LOG2E;

__device__ __forceinline__ void diff_attn_mfma(LAS unsigned char* lds, const bf16* AQ, const bf16* AK, const bf16* AV, bf16* YA, const float* dlam, const float* subg, int vcu, int G, const int wave) {
    const int lane = lane_fresh(), r32 = lane & 31, hi = lane >> 5;
    const int comp = wave >> 2, wq = wave & 3;
    const unsigned ksrc = (unsigned)(lane * 1024 + (2 * wave) * 8);
    const unsigned vsrc0 = (unsigned)((16 * ((2 * wave) & 3) + (lane >> 2)) * 1024 + ((2 * wave) >> 2) * 32 + (lane & 3) * 8);
    const unsigned vsrc1 = (unsigned)((16 * ((2 * wave + 1) & 3) + (lane >> 2)) * 1024 + ((2 * wave + 1) >> 2) * 32 + (lane & 3) * 8);
    const unsigned kdst = (unsigned)(2 * wave) * 1024u, vdst0 = 16384u + (unsigned)(((2 * wave) >> 2) * 4096 + ((2 * wave) & 3) * 1024), vdst1 = 16384u + (unsigned)(((2 * wave + 1) >> 2) * 4096 + ((2 * wave + 1) & 3) * 1024);
    const unsigned lds0 = (unsigned)(uintptr_t)lds;
#define DA_STAGE(bo, to) do { \
        glds16(Kg + (to) + ksrc, (unsigned)__builtin_amdgcn_readfirstlane((int)(lds0 + (bo) + kdst))); \
        glds16(Kg + (to) + ksrc + 8, (unsigned)__builtin_amdgcn_readfirstlane((int)(lds0 + (bo) + kdst + 1024))); \
        glds16(Vg + (to) + vsrc0, (unsigned)__builtin_amdgcn_readfirstlane((int)(lds0 + (bo) + vdst0))); \
        glds16(Vg + (to) + vsrc1, (unsigned)__builtin_amdgcn_readfirstlane((int)(lds0 + (bo) + vdst1))); } while (0)
#define DA_WAITBAR() asm volatile("s_waitcnt vmcnt(0) lgkmcnt(0)\n\ts_barrier" ::: "memory")
    const unsigned koff = (unsigned)(((comp * 8 + hi) * 64 + r32) * 16);
    const unsigned voff = (unsigned)(16384 + (4 * hi + ((lane & 15) >> 2)) * 64 + ((lane >> 4) & 1) * 32 + (lane & 3) * 8);
    for (int j = vcu; j < 1024; j += G) {
        const int w = j & 255, i = j >> 8, bh = w >> 3, s8 = w & 7;
        const int ub = (i == 0) ? s8 : (i == 1) ? 15 - s8 : (i == 2) ? 16 + s8 : 31 - s8;
        const int b = bh >> 3, h = bh & 7;
        const float sl2 = LOG2E / (float)(2 << h);
        const size_t rowbase = (size_t)b * SEQ; const int q0 = ub * 128;
        const int qpos = q0 + wq * 32 + r32;
        const int nt = 2 * ub + 2;
        const int myt = 2 * ub + 1 + (wq >> 1);
        const bf16* Kg = AK + rowbase * 1024 + h * 128; const bf16* Vg = AV + rowbase * 1024 + h * 128;
        bf16x8 qr[4];
#pragma unroll
        for (int s = 0; s < 4; ++s) qr[s] = *(const GAS bf16x8*)(AQ + (rowbase + qpos) * 1024 + h * 128 + comp * 64 + s * 16 + hi * 8);
        f32x16 o[4];
#pragma unroll
        for (int blk = 0; blk < 4; ++blk)
#pragma unroll
            for (int r = 0; r < 16; ++r) o[blk][r] = 0.f;
        float mrun = -INFINITY, lrun = 0.f;
        DA_STAGE(0u, (size_t)0);
        DA_WAITBAR();
        for (int kt = 0; kt < nt; ++kt) {
            const unsigned bufo = (unsigned)(kt & 1) * 32768u;
            if (kt + 1 < nt) DA_STAGE(32768u - bufo, (size_t)(kt + 1) * 64 * 1024);
            if (kt < myt) {
                const LAS unsigned char* Kb = lds + bufo + koff;
                f32x16 p0, p1;
#pragma unroll
                for (int r = 0; r < 16; ++r) { p0[r] = 0.f; p1[r] = 0.f; }
                { bf16x8 kf[4];
#pragma unroll
                  for (int s = 0; s < 4; ++s) kf[s] = *(const LAS bf16x8*)(Kb + s * 2048);
#pragma unroll
                  for (int s = 0; s < 4; ++s) p0 = __builtin_amdgcn_mfma_f32_32x32x16_bf16(kf[s], qr[s], p0, 0, 0, 0); }
                { bf16x8 kf[4];
#pragma unroll
                  for (int s = 0; s < 4; ++s) kf[s] = *(const LAS bf16x8*)(Kb + s * 2048 + 512);
#pragma unroll
                  for (int s = 0; s < 4; ++s) p1 = __builtin_amdgcn_mfma_f32_32x32x16_bf16(kf[s], qr[s], p1, 0, 0, 0); }
                const float qth = (float)(qpos - kt * 64 - 4 * hi);
                float rm = -INFINITY;
#pragma unroll
                for (int r = 0; r < 16; ++r) { const float kr = (float)((r & 3) + 8 * (r >> 2)); const float v0 = qth - kr, v1 = qth - (kr + 32.f);
                    p0[r] = p0[r] - sl2 * fabsf(v0); p1[r] = p1[r] - sl2 * fabsf(v1); rm = fmaxf(rm, fmaxf(p0[r], p1[r])); }
                rm = fmaxf(rm, xhalf_f(rm));
                if (__any(rm > mrun)) { const float mn = fmaxf(mrun, rm), f = __builtin_amdgcn_exp2f(mrun - mn); mrun = mn; lrun *= f;
#pragma unroll
                    for (int blk = 0; blk < 4; ++blk)
#pragma unroll
                        for (int r = 0; r < 16; ++r) o[blk][r] *= f; }
                float ls = 0.f;
#pragma unroll
                for (int r = 0; r < 16; ++r) { p0[r] = __builtin_amdgcn_exp2f(p0[r] - mrun); p1[r] = __builtin_amdgcn_exp2f(p1[r] - mrun); ls += p0[r] + p1[r]; }
                lrun += ls;
                bf16x8 pw[4];
#pragma unroll
                for (int s = 0; s < 2; ++s) {
                    v4u a = {cvtpk(p0[8 * s + 0], p0[8 * s + 1]), cvtpk(p0[8 * s + 2], p0[8 * s + 3]), cvtpk(p0[8 * s + 4], p0[8 * s + 5]), cvtpk(p0[8 * s + 6], p0[8 * s + 7])};
                    v4u c = {cvtpk(p1[8 * s + 0], p1[8 * s + 1]), cvtpk(p1[8 * s + 2], p1[8 * s + 3]), cvtpk(p1[8 * s + 4], p1[8 * s + 5]), cvtpk(p1[8 * s + 6], p1[8 * s + 7])};
                    pw[s] = __builtin_bit_cast(bf16x8, a); pw[2 + s] = __builtin_bit_cast(bf16x8, c); }
                const LAS unsigned char* Vb = lds + bufo + voff;
#pragma unroll
                for (int blk = 0; blk < 4; ++blk) {
#pragma unroll
                    for (int s = 0; s < 4; ++s) {
                        const v4i16_t lo = lds_tr16(Vb + blk * 4096 + s * 1024), hh = lds_tr16(Vb + blk * 4096 + s * 1024 + 512);
                        const bf16x8 vf = {lo[0], lo[1], lo[2], lo[3], hh[0], hh[1], hh[2], hh[3]};
                        o[blk] = __builtin_amdgcn_mfma_f32_32x32x16_bf16(vf, pw[s], o[blk], 0, 0, 0);
                    }
                }
            }
            DA_WAITBAR();
        }
        lrun += xhalf_f(lrun);
        const float inv = 1.f / lrun;
        LAS float* Y1 = (LAS float*)(lds) + wq * 4096;
        if (comp == 1) {
            float lam; { float a = dlam[lane] * dlam[64 + lane], bq_ = dlam[128 + lane] * dlam[192 + lane]; a = wave_sum(a); bq_ = wave_sum(bq_); lam = __expf(a) - __expf(bq_) + LAMBDA_INIT; }
            const float sc = inv * lam;
#pragma unroll
            for (int blk = 0; blk < 4; ++blk)
#pragma unroll
                for (int r = 0; r < 16; ++r) Y1[(32 * blk + (r & 3) + 8 * (r >> 2) + 4 * hi) * 32 + r32] = o[blk][r] * sc; }
        __syncthreads();
        if (comp == 0) {
            float ss = 0.f;
#pragma unroll
            for (int blk = 0; blk < 4; ++blk)
#pragma unroll
                for (int r = 0; r < 16; ++r) { const float a = o[blk][r] * inv - Y1[(32 * blk + (r & 3) + 8 * (r >> 2) + 4 * hi) * 32 + r32]; o[blk][r] = a; ss += a * a; }
            ss += xhalf_f(ss);
            const float rr = (1.0f - LAMBDA_INIT) / sqrtf(ss * (1.f / 128.f) + LN_EPS);
            LAS unsigned* stg = (LAS unsigned*)(lds + 65536) + wq * (32 * 65);
#pragma unroll
            for (int blk = 0; blk < 4; ++blk) {
#pragma unroll
                for (int r = 0; r < 16; r += 2) { const int e = 32 * blk + (r & 3) + 8 * (r >> 2) + 4 * hi;
                    stg[r32 * 65 + (e >> 1)] = cvtpk(o[blk][r] * rr * subg[e], o[blk][r + 1] * rr * subg[e + 1]); }
                asm volatile("" ::: "memory"); }
            LDS_WAIT(); asm volatile("" ::: "memory");
            bf16* orow = YA + (rowbase + q0 + wq * 32) * 1024 + h * 128;
#pragma unroll 4
            for (int row = 0; row < 32; ++row) *((GAS unsigned*)(orow + (size_t)row * 1024) + lane) = stg[row * 65 + lane];
        }
        __syncthreads();
    }
#undef DA_STAGE
#undef DA_WAITBAR
}

__device__ __forceinline__ unsigned okey(float f) { const unsigned u = __float_as_uint(f); return (u & 0x80000000u) ? ~u : (u | 0x80000000u); }
__device__ __forceinline__ void indexer_topk(LAS unsigned char* lds, const bf16* IQ, const bf16* IKW, unsigned short* IDX, int vcu, int G, const int wave) {
    const int lane = lane_fresh(), r32 = lane & 31, hi = lane >> 5;
    const unsigned lds0 = (unsigned)(uintptr_t)lds;
    const unsigned boff = (unsigned)((hi * 256 + r32) * 16);
    for (int j = vcu; j < 1024; j += G) {
        const int w = j & 255, i = j >> 8, bq = w >> 4, s16 = w & 15;
        const int chunk = (i == 0) ? s16 : (i == 1) ? 31 - s16 : (i == 2) ? 32 + s16 : 63 - s16;
        const int b = bq >> 2, gq = bq & 3;
        const int t0 = b * SEQ + chunk * 64 + gq * 16 + 2 * wave;
        const int ngroups = 2 * (chunk + 1);
        const int ntiles = (ngroups + 7) >> 3;
        const bf16* Kg = IKW + (size_t)b * SEQ * 256;
#define IX_STAGE(tile, bo) do { int tl_ = (tile); asm volatile("" : "+s"(tl_)); _Pragma("unroll") for (int i_ = 0; i_ < 4; ++i_) { const int q_ = 4 * wave + i_; \
            glds16s(Kg + (size_t)(tl_ * 256 + 64 * (q_ & 3)) * 256 + (q_ >> 2) * 8, (unsigned)lane * 512u, (unsigned)__builtin_amdgcn_readfirstlane((int)(lds0 + (bo) + ((q_ >> 2) * 256 + 64 * (q_ & 3)) * 16))); } } while (0)
        asm volatile("s_barrier" ::: "memory");
        IX_STAGE(0, 0u);
        bf16x8 a[4];
#pragma unroll
        for (int ks = 0; ks < 4; ++ks) a[ks] = *(const GAS bf16x8*)(IQ + (size_t)(t0 + (r32 >> 4)) * 1024 + (r32 & 15) * 64 + ks * 16 + 8 * hi);
        float wv[16];
        { const bf16* iwp = IKW + (size_t)t0 * 256 + 64 + 4 * hi;
          const v2u w00 = *(const GAS v2u*)(iwp), w01 = *(const GAS v2u*)(iwp + 8), w10 = *(const GAS v2u*)(iwp + 256), w11 = *(const GAS v2u*)(iwp + 256 + 8);
          wv[0] = blo(w00.x); wv[1] = bhi(w00.x); wv[2] = blo(w00.y); wv[3] = bhi(w00.y); wv[4] = blo(w01.x); wv[5] = bhi(w01.x); wv[6] = blo(w01.y); wv[7] = bhi(w01.y);
          wv[8] = blo(w10.x); wv[9] = bhi(w10.x); wv[10] = blo(w10.y); wv[11] = bhi(w10.y); wv[12] = blo(w11.x); wv[13] = bhi(w11.x); wv[14] = blo(w11.y); wv[15] = bhi(w11.y); }
        unsigned key[128];
#pragma unroll 128
        for (int g = 0; g < 128; ++g) {
            if (g < ngroups) {
                const unsigned bufo = (unsigned)((g >> 3) & 1) * 32768u;
                if ((g & 7) == 0) {
                    asm volatile("s_waitcnt vmcnt(0)\n\ts_barrier" ::: "memory");
                    if ((g >> 3) + 1 < ntiles) IX_STAGE((g >> 3) + 1, 32768u - bufo);
                }
                bf16x8 bk[4];
#pragma unroll
                for (int ks = 0; ks < 4; ++ks) bk[ks] = *(const LAS bf16x8*)(lds + bufo + boff + (g & 7) * 512 + ks * 8192);
                f32x16 acc = {0.f, 0.f, 0.f, 0.f, 0.f, 0.f, 0.f, 0.f, 0.f, 0.f, 0.f, 0.f, 0.f, 0.f, 0.f, 0.f};
#pragma unroll
                for (int ks = 0; ks < 4; ++ks) acc = __builtin_amdgcn_mfma_f32_32x32x16_bf16(a[ks], bk[ks], acc, 0, 0, 0);
                float s0 = 0.f, s1 = 0.f;
#pragma unroll
                for (int r = 0; r < 8; ++r) { s0 += wv[r] * fmaxf(acc[r], 0.f); s1 += wv[8 + r] * fmaxf(acc[8 + r], 0.f); }
                s0 += __shfl_xor(s0, 32); s1 += __shfl_xor(s1, 32);
                key[g] = okey(hi ? s1 : s0);
            } else key[g] = 0u;
        }
        unsigned T = 0u;
        if (chunk >= 4) {
            bool done = false;
#pragma nounroll
            for (int bit = 31; bit >= 0; --bit) {
                if (__all(done ? 1 : 0)) break;
                const unsigned trial = T | (1u << bit);
                int cnt = 0;
#pragma unroll
                for (int g = 0; g < 128; ++g) cnt += (key[g] >= trial) ? 1 : 0;
                cnt += __shfl_xor(cnt, 1); cnt += __shfl_xor(cnt, 2); cnt += __shfl_xor(cnt, 4); cnt += __shfl_xor(cnt, 8); cnt += __shfl_xor(cnt, 16);
                if (!done && cnt >= 256) { T = trial; if (cnt == 256) done = true; }
            }
        }
        int base = 0;
        unsigned short* ip = IDX + (size_t)(t0 + hi) * 256;
#pragma unroll
        for (int g = 0; g < 128; ++g) {
            if (g < ngroups) {
                const bool sel = key[g] >= T;
                const unsigned long long mk = __ballot(sel ? 1 : 0);
                const unsigned mh = hi ? (unsigned)(mk >> 32) : (unsigned)mk;
                const int pos = base + __popc(mh & ((1u << r32) - 1u));
                if (sel && pos < 256) ip[pos] = (unsigned short)(32 * g + r32);
                base += __popc(mh);
            }
        }
    }
#undef IX_STAGE
    asm volatile("s_waitcnt vmcnt(0) lgkmcnt(0)\n\ts_barrier" ::: "memory");
}

__device__ __forceinline__ bf16x8 dpp_shl8(bf16x8 v) {
    v4u u = __builtin_bit_cast(v4u, v);
    u.x = (unsigned)__builtin_amdgcn_update_dpp(0, (int)u.x, 0x108, 0xf, 0xf, true); u.y = (unsigned)__builtin_amdgcn_update_dpp(0, (int)u.y, 0x108, 0xf, 0xf, true);
    u.z = (unsigned)__builtin_amdgcn_update_dpp(0, (int)u.z, 0x108, 0xf, 0xf, true); u.w = (unsigned)__builtin_amdgcn_update_dpp(0, (int)u.w, 0x108, 0xf, 0xf, true);
    return __builtin_bit_cast(bf16x8, u); }
constexpr int DSA_ROWB = 1040;
constexpr int DSA_WAVEB = 16 * DSA_ROWB + 512;
constexpr int DSA_LDS_END = 8 * DSA_WAVEB;
__device__ __forceinline__ void dsa_mfma(LAS unsigned char* lds, const bf16* QL, bf16* OL, const int omask, const bf16* C, const unsigned short* IDX, int vcu, int G, const int wave) {
    const int lane = lane_fresh(), h16 = lane & 15, g = lane >> 4;
    LAS unsigned char* wl = lds + wave * DSA_WAVEB;
    const unsigned wl0 = (unsigned)(uintptr_t)wl;
    LAS unsigned short* idxs = (LAS unsigned short*)(wl + 16 * DSA_ROWB);
    const float sc2 = 0.08838834764831845f * LOG2E;
    const float sl2 = (h16 < 8) ? LOG2E / (float)(2 << (h16 & 7)) : 0.f;
    const int ntok = (G == 256) ? 8 : (M - (vcu * 8 + wave) + G * 8 - 1) / (G * 8);
#define DSA_TOK(i) ((G == 256) ? ((vcu >> 6) * SEQ + (vcu & 63) + 64 * (wave + 8 * (i))) : (vcu * 8 + wave + G * 8 * (i)))
    const unsigned qk_off = (unsigned)(h16 * DSA_ROWB + 16 * g);
    const unsigned pv_off = (unsigned)((4 * g + (h16 >> 2)) * DSA_ROWB + 8 * (lane & 3));
    for (int it = 0; it < ntok; ++it) {
        const int t = DSA_TOK(it); const int tpos = t & (SEQ - 1);
        const int n = (tpos >> 6) >= 3 ? 256 : 64 * ((tpos >> 6) + 1); const int nst = n >> 4;
        const bf16* Cb = C + (size_t)(t >> 12) * SEQ * 512;
        int ln = lane; asm volatile("" : "+v"(ln));
        const int h16b = ln & 15, gb = ln >> 4;
        { const v2u iv = __builtin_nontemporal_load((const GAS v2u*)(IDX + (size_t)t * 256) + ln); *((LAS v2u*)idxs + ln) = iv; }
        bf16x8 qf[8];
#pragma unroll
        for (int s = 0; s < 8; ++s) qf[s] = __builtin_nontemporal_load((const GAS bf16x8*)(QL + (size_t)t * 4096 + (h16b & 7) * 512 + 32 * (s + 8 * (h16b >> 3)) + 8 * gb));
        f32x4 o[32];
#pragma unroll
        for (int blk = 0; blk < 32; ++blk) o[blk] = (f32x4){0.f, 0.f, 0.f, 0.f};
        float mrun = -INFINITY, lrun = 0.f;
        asm volatile("s_waitcnt vmcnt(0) lgkmcnt(0)" ::: "memory");
        for (int st = 0; st < nst; ++st) {
            { const v4u i0 = *(const LAS v4u*)(idxs + st * 16), i1 = *(const LAS v4u*)(idxs + st * 16 + 8);
              const unsigned iw[8] = {i0.x, i0.y, i0.z, i0.w, i1.x, i1.y, i1.z, i1.w};
#pragma unroll
              for (int i = 0; i < 16; ++i) { const int s_ = __builtin_amdgcn_readfirstlane((int)((iw[i >> 1] >> ((i & 1) * 16)) & 0xffffu));
                  glds16s(Cb + (size_t)s_ * 512, (unsigned)lane * 16u, (unsigned)__builtin_amdgcn_readfirstlane((int)(wl0 + i * DSA_ROWB))); } }
            asm volatile("s_waitcnt vmcnt(0)" ::: "memory");
            f32x4 acc = {0.f, 0.f, 0.f, 0.f};
#pragma unroll
            for (int s = 0; s < 8; ++s) { const bf16x8 a = *(const LAS bf16x8*)(wl + qk_off + 64 * s); acc = __builtin_amdgcn_mfma_f32_16x16x32_bf16(a, qf[s], acc, 0, 0, 0); }
#pragma unroll
            for (int s = 0; s < 8; ++s) { const bf16x8 a = *(const LAS bf16x8*)(wl + qk_off + 64 * (s + 8)); acc = __builtin_amdgcn_mfma_f32_16x16x32_bf16(a, dpp_shl8(qf[s]), acc, 0, 0, 0); }
            const v2u iq = *(const LAS v2u*)(idxs + st * 16 + 4 * g);
            const int sidx[4] = {(int)(iq.x & 0xffffu), (int)(iq.x >> 16), (int)(iq.y & 0xffffu), (int)(iq.y >> 16)};
            float lg[4];
#pragma unroll
            for (int r = 0; r < 4; ++r) { const int d = tpos - sidx[r]; lg[r] = acc[r] * sc2 - sl2 * (float)(d < 0 ? -d : d); }
            float rm = fmaxf(fmaxf(lg[0], lg[1]), fmaxf(lg[2], lg[3]));
            rm = fmaxf(rm, __shfl_xor(rm, 16)); rm = fmaxf(rm, __shfl_xor(rm, 32));
            const float mn = fmaxf(mrun, rm), f = __builtin_amdgcn_exp2f(mrun - mn); mrun = mn;
#pragma unroll
            for (int r = 0; r < 4; ++r) lg[r] = __builtin_amdgcn_exp2f(lg[r] - mn);
            lrun = lrun * f + ((lg[0] + lg[1]) + (lg[2] + lg[3]));
            const v4u pwu = {cvtpk(lg[0], lg[1]), cvtpk(lg[2], lg[3]), 0u, 0u};
            const bf16x8 pw = __builtin_bit_cast(bf16x8, pwu);
#pragma unroll
            for (int blk = 0; blk < 32; ++blk) {
                const v4i16_t lo = lds_tr16(wl + pv_off + 32 * blk);
                const bf16x8 af = {lo[0], lo[1], lo[2], lo[3], lo[0], lo[1], lo[2], lo[3]};
                o[blk] = __builtin_amdgcn_mfma_f32_16x16x32_bf16(af, pw, o[blk] * f, 0, 0, 0);
                if ((blk & 3) == 3) __builtin_amdgcn_sched_barrier(0);
            }
        }
        float lt = lrun; lt += __shfl_xor(lt, 16); lt += __shfl_xor(lt, 32);
        const float inv = 1.f / lt;
        if (h16 < 8) {
#pragma unroll
            for (int blk = 0; blk < 32; ++blk) { const f32x4 v = o[blk] * inv;
                __builtin_nontemporal_store((v2u){cvtpk(v.x, v.y), cvtpk(v.z, v.w)}, (GAS v2u*)(OL + (size_t)(t & omask) * 4096 + h16b * 512 + 16 * blk + 4 * gb)); } }
    }
    asm volatile("s_waitcnt vmcnt(0) lgkmcnt(0)" ::: "memory");
    __syncthreads();
#undef DSA_TOK
}
static_assert(DSA_LDS_END <= RING_BYTES, "DSA LDS map");

__device__ __forceinline__ void memattn_mfma(LAS unsigned char* lds, const bf16* QM, const bf16* KV, bf16* OM, int vcu, int G, const int wave) {
    const int lane = lane_fresh(), r32 = lane & 31, hi = lane >> 5;
    const unsigned voff = (unsigned)(65536 + (4 * hi + ((lane & 15) >> 2)) * 64 + ((lane >> 4) & 1) * 32 + (lane & 3) * 8);
    for (int j = vcu; j < 256; j += G) {
        const int bh = j >> 4, qb = j & 15, b = bh >> 2, h = bh & 3;
        const bf16* Kg = KV + (size_t)b * MEMT * 1024 + h * 128; const bf16* Vg = Kg + 512;
#pragma unroll
        for (int i = 0; i < 8; ++i) { const int q = 8 * wave + i;
            glds16(Kg + (size_t)(64 * (q & 3) + lane) * 1024 + (q >> 2) * 8, (unsigned)__builtin_amdgcn_readfirstlane((int)((unsigned)(uintptr_t)lds + ((q >> 2) * 256 + 64 * (q & 3)) * 16)));
            glds16(Vg + (size_t)(16 * (q & 15) + (lane >> 2)) * 1024 + (q >> 4) * 32 + (lane & 3) * 8, (unsigned)__builtin_amdgcn_readfirstlane((int)((unsigned)(uintptr_t)lds + 65536 + (q >> 4) * 16384 + (q & 15) * 1024))); }
        const size_t qrow = (size_t)b * SEQ + qb * 256 + wave * 32 + r32;
        bf16x8 qr[8];
#pragma unroll
        for (int s = 0; s < 8; ++s) qr[s] = *(const GAS bf16x8*)(QM + qrow * 512 + h * 128 + s * 16 + hi * 8);
        f32x16 o[4];
#pragma unroll
        for (int blk = 0; blk < 4; ++blk)
#pragma unroll
            for (int r = 0; r < 16; ++r) o[blk][r] = 0.f;
        float mrun = -INFINITY, lrun = 0.f;
        asm volatile("s_waitcnt vmcnt(0) lgkmcnt(0)\n\ts_barrier" ::: "memory");
        for (int kt = 0; kt < 4; ++kt) {
            const LAS unsigned char* Kb = lds + (unsigned)((hi * 256 + 64 * kt + r32) * 16);
            f32x16 p0, p1;
#pragma unroll
            for (int r = 0; r < 16; ++r) { p0[r] = 0.f; p1[r] = 0.f; }
#pragma unroll
            for (int s = 0; s < 8; ++s) { const bf16x8 k0 = *(const LAS bf16x8*)(Kb + s * 8192), k1 = *(const LAS bf16x8*)(Kb + s * 8192 + 512);
                p0 = __builtin_amdgcn_mfma_f32_32x32x16_bf16(k0, qr[s], p0, 0, 0, 0); p1 = __builtin_amdgcn_mfma_f32_32x32x16_bf16(k1, qr[s], p1, 0, 0, 0); }
            float rm = -INFINITY;
#pragma unroll
            for (int r = 0; r < 16; ++r) rm = fmaxf(rm, fmaxf(p0[r], p1[r]));
            rm = fmaxf(rm, xhalf_f(rm));
            if (__any(rm > mrun)) { const float mn = fmaxf(mrun, rm), f = __builtin_amdgcn_exp2f(mrun - mn); mrun = mn; lrun *= f;
#pragma unroll
                for (int blk = 0; blk < 4; ++blk)
#pragma unroll
                    for (int r = 0; r < 16; ++r) o[blk][r] *= f; }
            float ls = 0.f;
#pragma unroll
            for (int r = 0; r < 16; ++r) { p0[r] = __builtin_amdgcn_exp2f(p0[r] - mrun); p1[r] = __builtin_amdgcn_exp2f(p1[r] - mrun); ls += p0[r] + p1[r]; }
            lrun += ls;
            bf16x8 pw[4];
#pragma unroll
            for (int s = 0; s < 2; ++s) {
                v4u a = {cvtpk(p0[8 * s + 0], p0[8 * s + 1]), cvtpk(p0[8 * s + 2], p0[8 * s + 3]), cvtpk(p0[8 * s + 4], p0[8 * s + 5]), cvtpk(p0[8 * s + 6], p0[8 * s + 7])};
                v4u c = {cvtpk(p1[8 * s + 0], p1[8 * s + 1]), cvtpk(p1[8 * s + 2], p1[8 * s + 3]), cvtpk(p1[8 * s + 4], p1[8 * s + 5]), cvtpk(p1[8 * s + 6], p1[8 * s + 7])};
                pw[s] = __builtin_bit_cast(bf16x8, a); pw[2 + s] = __builtin_bit_cast(bf16x8, c); }
            const LAS unsigned char* Vb = lds + voff + kt * 4096;
#pragma unroll
            for (int blk = 0; blk < 4; ++blk) {
#pragma unroll
                for (int s = 0; s < 4; ++s) {
                    const v4i16_t lo = lds_tr16(Vb + blk * 16384 + s * 1024), hh = lds_tr16(Vb + blk * 16384 + s * 1024 + 512);
                    const bf16x8 vf = {lo[0], lo[1], lo[2], lo[3], hh[0], hh[1], hh[2], hh[3]};
                    o[blk] = __builtin_amdgcn_mfma_f32_32x32x16_bf16(vf, pw[s], o[blk], 0, 0, 0);
                }
            }
        }
        __syncthreads();
        lrun += xhalf_f(lrun);
        const float inv = 1.f / lrun;
        LAS unsigned* stg = (LAS unsigned*)(lds) + wave * (32 * 65);
#pragma unroll
        for (int blk = 0; blk < 4; ++blk)
#pragma unroll
            for (int r = 0; r < 16; r += 2) { const int e = 32 * blk + (r & 3) + 8 * (r >> 2) + 4 * hi;
                stg[r32 * 65 + (e >> 1)] = cvtpk(o[blk][r] * inv, o[blk][r + 1] * inv); }
        LDS_WAIT(); asm volatile("" ::: "memory");
        bf16* orow = OM + ((size_t)b * SEQ + qb * 256 + wave * 32) * 512 + h * 128;
#pragma unroll 4
        for (int row = 0; row < 32; ++row) *((GAS unsigned*)(orow + (size_t)row * 512) + lane) = stg[row * 65 + lane];
        __syncthreads();
    }
}

constexpr int N_PHASES = 21;
struct Args { const float* in[24]; float* out; unsigned char* ws; int ph_lo, ph_hi; };
__global__ void __launch_bounds__(NWAVES * 64, 2) mk_fwd(Args args) {
    extern __shared__ __attribute__((aligned(16))) unsigned char lds_raw[];
    LAS unsigned char* lds = (LAS unsigned char*)lds_raw;
    volatile LAS unsigned* MISC = (volatile LAS unsigned*)(lds + MISC_OFF);
    const int tid = threadIdx.x, wave = __builtin_amdgcn_readfirstlane(tid >> 6);
#define lane lane_fresh()
    const int G = gridDim.x, bx = blockIdx.x;
    const int vcu = (G % 8 == 0) ? (bx % 8) * (G / 8) + bx / 8 : bx;
    const int gw = vcu * NWAVES + wave, NGW = G * NWAVES;
    unsigned char* ws = args.ws;
    gu32* ctl = (gu32*)(ws + WS_CTL);
    for (int u = tid; u < (LDS_BYTES - LDSCTL_OFF) / 4; u += NWAVES * 64) ((LAS unsigned*)(lds + LDSCTL_OFF))[u] = 0u;
    __syncthreads();
    const bool one = (args.ph_hi - args.ph_lo) > 1;
    XcdBarrier bar; bar.bar = (unsigned*)(ctl + CW_BAR); bar.x = 0; bar.st = nullptr;
    if (one) bar = xcd_barrier_post((unsigned*)(ctl + CW_BAR), MISC + 8, tid == 0);
    const int lo = args.ph_lo, hi = args.ph_hi;
#ifndef PH_MASK
#define PH_MASK 0xFFFFFFFFu
#endif
#define IN(k) ((((PH_MASK) >> (k)) & 1u) && lo <= (k) && (k) < hi)
#define SEAM(k) do { if (IN(k) && IN((k) + 1)) xcd_barrier(bar, wave); } while (0)
    bf16* const X16 = (bf16*)(ws + WS_X16); bf16* const HB = (bf16*)(ws + WS_H);
    float* const out = args.out;
    const float* const ln_g = args.in[22]; const float* const ln_b = args.in[23];
    using namespace pg8;

#ifdef PROBE_P0
    if (IN(0)) { p0_prologue(args.in, ws, lds, gw, NGW, wave, lane); }
#endif
    if (IN(0)) { p0_prologue(args.in, ws, lds, gw, NGW, wave, lane); }
    SEAM(0);
    if (IN(1)) { Gemm g{(const bf16*)(ws + WS_X8), (const bf16*)(ws + WS_W_GU1), D / 2, D / 2, D / 2, 0, 0}; StaticOrder S; S.init(M, 2 * FF, G, bx); EpiSwiGLU8 E{(unsigned char*)HB, FF, 1.0f / (FP8_XS * FP8_WGUS), FP8_HS};
        gemm_phase<EpiSwiGLU8, StaticOrder, true, true>(lds + RING_OFF, g, S, E, wave); }
    SEAM(1);
    if (IN(2)) { Gemm g{HB, (const bf16*)(ws + WS_W_D1), FF / 2, FF / 2, FF / 2, 0, 0}; StaticOrder S; S.init(M, D, G, bx); EpiRes E{args.in[0], out, D, ALPHA, 0.5f / (FP8_HS * FP8_WDS)}; gemm_phase<EpiRes, StaticOrder, true, true>(lds + RING_OFF, g, S, E, wave); }
    SEAM(2);
    if (IN(3)) ln_phase(out, X16, (unsigned char*)(ws + WS_X8M), ln_g, ln_b, gw, NGW, lane);
    SEAM(3);
    if (IN(4)) {
        { Gemm g{X16, (const bf16*)(ws + WS_W_IN), D, D, D, 0, 0}; StaticOrder S; S.init(M, N_IN, G, bx);
          EpiInProj E{(bf16*)(ws + WS_AQ), (bf16*)(ws + WS_AK), (bf16*)(ws + WS_AV), (bf16*)(ws + WS_BQ), (bf16*)(ws + WS_BC), (bf16*)(ws + WS_IQ), (bf16*)(ws + WS_IKW), QSCALE};
          gemm_phase<EpiInProj, StaticOrder, true>(lds + RING_OFF, g, S, E, wave); }
        { Gemm g{(const bf16*)(ws + WS_MEM16), (const bf16*)(ws + WS_W_MKV), D, D, D, 0, 0}; StaticOrder S; S.init(BATCH * MEMT, 1024, G, bx >= G - 16 ? bx - (G - 16) : (1 << 20)); EpiBf16 E{(bf16*)(ws + WS_KVMEM), 1024};
          gemm_phase<EpiBf16, StaticOrder, true>(lds + RING_OFF, g, S, E, wave); }
    }
    SEAM(4);
    if (IN(5)) {
        { Gemm g{(const bf16*)(ws + WS_BQ), (const bf16*)(ws + WS_W_UK), 1024, 128, 128, 1, 128}; StaticOrder S; S.init(M, 4096, G, bx); EpiBf16 E{(bf16*)(ws + WS_QLAT), 4096};
          gemm_phase<EpiBf16, StaticOrder, true>(lds + RING_OFF, g, S, E, wave); }
        crms_phase((bf16*)(ws + WS_BC), args.in[8], gw, NGW, lane);
    }
#ifdef PROBE_P6
    if (IN(6)) diff_attn_mfma(lds, (const bf16*)(ws + WS_AQ), (const bf16*)(ws + WS_AK), (const bf16*)(ws + WS_AV), (bf16*)(ws + WS_BQ), args.in[6], args.in[7], vcu, G, wave);
#endif
    if (IN(6)) diff_attn_mfma(lds, (const bf16*)(ws + WS_AQ), (const bf16*)(ws + WS_AK), (const bf16*)(ws + WS_AV), (bf16*)(ws + WS_AQ), args.in[6], args.in[7], vcu, G, wave);
    if (IN(7)) indexer_topk(lds, (const bf16*)(ws + WS_IQ), (const bf16*)(ws + WS_IKW), (unsigned short*)(ws + WS_IDX), vcu, G, wave);
    SEAM(7);
#ifdef PROBE_P8
    if (IN(8)) dsa_mfma(lds, (const bf16*)(ws + WS_QLAT), (bf16*)(ws + WS_AV), 1023, (const bf16*)(ws + WS_BC), (const unsigned short*)(ws + WS_IDX), vcu, G, wave);
#endif
    if (IN(8)) dsa_mfma(lds, (const bf16*)(ws + WS_QLAT), (bf16*)(ws + WS_QLAT), 0x7fffffff, (const bf16*)(ws + WS_BC), (const unsigned short*)(ws + WS_IDX), vcu, G, wave);
    SEAM(8);
    if (IN(9)) { Gemm g{(const bf16*)(ws + WS_QLAT), (const bf16*)(ws + WS_W_UVP), 4096, 1024, 1024, 0, 1024}; StaticOrder S; S.init(M, 1024, G, bx); EpiBf16 E{(bf16*)(ws + WS_YB), 1024};
        gemm_phase<EpiBf16, StaticOrder, true>(lds + RING_OFF, g, S, E, wave); }
    SEAM(9);
    if (IN(10)) {
        { Gemm g{(const bf16*)(ws + WS_AQ), (const bf16*)(ws + WS_W_A), 1024, 1024, 1024, 0, 0}; StaticOrder S; S.init(M, D, G, bx); EpiBf16 E{(bf16*)(ws + WS_TA), D}; gemm_phase<EpiBf16, StaticOrder, true>(lds + RING_OFF, g, S, E, wave); }
        { Gemm g{(const bf16*)(ws + WS_YB), (const bf16*)(ws + WS_W_B), 1024, 1024, 1024, 0, 0}; StaticOrder S; S.init(M, D, G, bx); EpiBf16 E{(bf16*)(ws + WS_TB), D}; gemm_phase<EpiBf16, StaticOrder, true>(lds + RING_OFF, g, S, E, wave); }
    }
    SEAM(10);
    if (IN(11)) { Gemm g{(const bf16*)(ws + WS_X8M), (const bf16*)(ws + WS_W_G), D / 2, D / 2, D / 2, 0, 0}; StaticOrder S; S.init(M, 2 * D, G, bx);
        EpiGateMerge8 E{(const bf16*)(ws + WS_TA), (const bf16*)(ws + WS_TB), (unsigned char*)(ws + WS_MRG8), D, args.in[12], args.in[12] + D, 1.0f / (FP8_XS * FP8_WGS), FP8_MS};
        gemm_phase<EpiGateMerge8, StaticOrder, true, true>(lds + RING_OFF, g, S, E, wave); }
    SEAM(11);
    if (IN(12)) { Gemm g{(const bf16*)(ws + WS_MRG8), (const bf16*)(ws + WS_W_MO), D / 2, D / 2, D / 2, 0, 0}; StaticOrder S; S.init(M, D, G, bx); EpiRes E{out, out, D, ALPHA, 1.0f / (FP8_MS * FP8_WMOS)}; gemm_phase<EpiRes, StaticOrder, true, true>(lds + RING_OFF, g, S, E, wave); }
    SEAM(12);
    if (IN(13)) ln_phase(out, X16, nullptr, ln_g + D, ln_b + D, gw, NGW, lane);
    SEAM(13);
    if (IN(14)) { Gemm g{X16, (const bf16*)(ws + WS_W_MQ), D, D, D, 0, 0}; StaticOrder S; S.init(M, 512, G, bx); EpiBf16 E{(bf16*)(ws + WS_QM), 512, 0.08838834764831845f * LOG2E}; gemm_phase<EpiBf16, StaticOrder, true>(lds + RING_OFF, g, S, E, wave); }
    SEAM(14);
    if (IN(15)) memattn_mfma(lds, (const bf16*)(ws + WS_QM), (const bf16*)(ws + WS_KVMEM), (bf16*)(ws + WS_OM), vcu, G, wave);
    SEAM(15);
    if (IN(16)) { Gemm g{(const bf16*)(ws + WS_OM), (const bf16*)(ws + WS_W_MOUT), 512, 512, 512, 0, 0}; StaticOrder S; S.init(M, D, G, bx); EpiRes E{out, out, D, ALPHA, 1.0f}; gemm_phase<EpiRes, StaticOrder, true>(lds + RING_OFF, g, S, E, wave); }
    SEAM(16);
    if (IN(17)) ln_phase(out, nullptr, (unsigned char*)(ws + WS_X8), ln_g + 2 * D, ln_b + 2 * D, gw, NGW, lane);
    SEAM(17);
    if (IN(18)) { Gemm g{(const bf16*)(ws + WS_X8), (const bf16*)(ws + WS_W_GU2), D / 2, D / 2, D / 2, 0, 0}; StaticOrder S; S.init(M, 2 * FF, G, bx); EpiSwiGLU8 E{(unsigned char*)HB, FF, 1.0f / (FP8_XS * FP8_WGUS), FP8_HS};
        gemm_phase<EpiSwiGLU8, StaticOrder, true, true>(lds + RING_OFF, g, S, E, wave); }
    SEAM(18);
    if (IN(19)) { Gemm g{HB, (const bf16*)(ws + WS_W_D2), FF / 2, FF / 2, FF / 2, 0, 0}; StaticOrder S; S.init(M, D, G, bx); EpiRes E{out, out, D, ALPHA, 0.5f / (FP8_HS * FP8_WDS)}; gemm_phase<EpiRes, StaticOrder, true, true>(lds + RING_OFF, g, S, E, wave); }
    SEAM(19);
    if (IN(20)) ln_phase(out, nullptr, nullptr, ln_g + 3 * D, ln_b + 3 * D, gw, NGW, lane);
#undef IN
#undef SEAM
#undef lane
}

extern "C" void kernel_launch(void* const* d_in, const int* in_sizes, int n_in, void* d_out, int out_size, void* d_ws, size_t ws_size, hipStream_t stream) {
    static int grid = 0;
    if (grid == 0) {
        if (n_in != 24 || in_sizes[0] != M * D || out_size != M * D || ws_size < WS_END) { fprintf(stderr, "kernel_launch: unexpected shapes (n_in %d, in0 %d, out %d, ws %zu); nothing launched\n", n_in, n_in > 0 ? in_sizes[0] : -1, out_size, ws_size); grid = -1; return; }
        int dev = 0, cus = 0, per_cu = 0;
        if (hipGetDevice(&dev) != hipSuccess || hipDeviceGetAttribute(&cus, hipDeviceAttributeMultiprocessorCount, dev) != hipSuccess) { grid = -1; return; }
        if (hipFuncSetAttribute((const void*)mk_fwd, hipFuncAttributeMaxDynamicSharedMemorySize, LDS_BYTES) != hipSuccess) { fprintf(stderr, "kernel_launch: hipFuncSetAttribute failed\n"); grid = -1; return; }
        if (hipOccupancyMaxActiveBlocksPerMultiprocessor(&per_cu, (const void*)mk_fwd, NWAVES * 64, LDS_BYTES) != hipSuccess || per_cu < 1)
            fprintf(stderr, "kernel_launch: note: the occupancy query reports %d workgroups per CU\n", per_cu);
        (void)hipGetLastError();
        grid = cus;
    }
    if (grid < 0) return;
    if (hipMemsetAsync((char*)d_ws + WS_CTL, 0, CTL_ZERO_BYTES, stream) != hipSuccess) return;
    Args a{};
    for (int i = 0; i < 24; ++i) a.in[i] = (const float*)d_in[i];
    a.out = (float*)d_out; a.ws = (unsigned char*)d_ws;
#if MK_ONE_LAUNCH
    a.ph_lo = 0; a.ph_hi = N_PHASES;
    hipLaunchKernelGGL(mk_fwd, dim3(grid), dim3(NWAVES * 64), LDS_BYTES, stream, a);
#else
    for (int p = 0; p < N_PHASES; ++p) { a.ph_lo = p; a.ph_hi = p + 1; hipLaunchKernelGGL(mk_fwd, dim3(grid), dim3(NWAVES * 64), LDS_BYTES, stream, a); }
#endif
}
```

```cpp
#include <hip/hip_runtime.h>
#include <cstdio>
#include <cstdint>

#ifndef MK_ONE_LAUNCH
#define MK_ONE_LAUNCH 1
#endif

__device__ __forceinline__ int lane_fresh() { int l = (int)__builtin_amdgcn_mbcnt_hi(~0u, __builtin_amdgcn_mbcnt_lo(~0u, 0u)); asm volatile("" : "+v"(l)); return l; }
__device__ __forceinline__ void glds16(const void* gsrc, unsigned lds_dst) { unsigned keep;
    asm volatile("s_mov_b32 %0, m0\n\ts_mov_b32 m0, %2\n\ts_nop 0\n\tglobal_load_lds_dwordx4 %1, off\n\ts_mov_b32 m0, %0" : "=&s"(keep) : "v"(gsrc), "s"(lds_dst) : "memory"); }
__device__ __forceinline__ void glds16s(const void* sbase, unsigned voff, unsigned lds_dst) { unsigned keep;
    asm volatile("s_mov_b32 %0, m0\n\ts_mov_b32 m0, %3\n\ts_nop 0\n\tglobal_load_lds_dwordx4 %1, %2\n\ts_mov_b32 m0, %0" : "=&s"(keep) : "v"(voff), "s"(sbase), "s"(lds_dst) : "memory"); }
namespace pg8 {
#define PG8_LAS __attribute__((address_space(3)))
typedef unsigned short bf16_t;
typedef short bf16x8 __attribute__((ext_vector_type(8)));
typedef float f32x4 __attribute__((ext_vector_type(4)));
typedef unsigned u32x4 __attribute__((ext_vector_type(4)));
constexpr int BM = 256, BK = 64, HALF = 128, HTB = HALF * BK * 2  , STAGE_BYTES = 8 * HTB, NXCD = 8, WGM = 8;

__host__ __device__ __forceinline__ int lds_byte(int r, int c) { const int st = (r >> 4) * 2 + (c >> 5), rr = r & 15, cc = c & 31, ob = rr * 64 + cc * 2; return st * 1024 + (ob ^ (((ob >> 9) & 1) << 5)); }
__host__ __device__ __forceinline__ void stage_rc(int b, int& R, int& C) { const int st = b / 1024, sb = b % 1024, swz = sb ^ (((sb >> 9) & 1) << 5); R = (st >> 1) * 16 + swz / 64; C = (st & 1) * 32 + (swz % 64) / 2; }
__host__ __device__ __forceinline__ int perm32(int rho) { const int n = rho >> 4, i = rho & 15; return 8 * (i >> 2) + 4 * n + (i & 3); }

struct Unit { int pm, pn; };
struct Gemm { const bf16_t* A; const bf16_t* Bt; int lda, ldb, K, a_shift, a_mul; };

struct StaticOrder {
    int nM, nN, nwg, G, c;
    __host__ __device__ void init(int M, int N, int G_, int c_) { nM = M / BM; nN = N / BM; nwg = nM * nN; G = G_; c = c_; }
    __host__ __device__ bool next(int i, Unit& u) const {
        const long L = (long)i * G + c; if (L >= nwg) return false;
        int wgid = (int)L; { const int q = nwg / NXCD, r = nwg % NXCD, xcd = wgid % NXCD, off = wgid / NXCD; wgid = (xcd < r ? xcd * (q + 1) : r * (q + 1) + (xcd - r) * q) + off; }
        const int nig = WGM * nN, gid = wgid / nig, fm = gid * WGM, gsz = (nM - fm) < WGM ? (nM - fm) : WGM;
        u.pm = fm + ((wgid % nig) % gsz); u.pn = (wgid % nig) / gsz; return true;
    }
    __device__ __forceinline__ void a_ready(const Unit&) const {}
    __device__ __forceinline__ void done(const Unit&) const {}
};

__device__ __forceinline__ unsigned cvt_pk_bf16(float lo, float hi) { unsigned r; asm volatile("v_cvt_pk_bf16_f32 %0, %1, %2" : "=v"(r) : "v"(lo), "v"(hi)); return r; }
__device__ __forceinline__ float bflo(unsigned w) { return __uint_as_float(w << 16); }
__device__ __forceinline__ float bfhi(unsigned w) { return __uint_as_float(w & 0xffff0000u); }
__device__ __forceinline__ float sigmoidf_fast(float x) { return __builtin_amdgcn_rcpf(1.0f + __builtin_amdgcn_exp2f(-1.4426950408889634f * x)); }

struct LnFold {
    const long long* stats; const float* gW; const float* bW;
    __device__ __forceinline__ void row(int r, float& mean, float& rstd) const { const long long s0 = stats[2 * (size_t)r], s1 = stats[2 * (size_t)r + 1];
        mean = (float)s0 * (1.0f / (1048576.f * 2048.0f)); rstd = __builtin_amdgcn_rsqf((float)s1 * (1.0f / (65536.f * 2048.0f)) - mean * mean + 1e-5f); }
    __device__ __forceinline__ f32x4 vec4(const float* v, int i) const { return *(const f32x4*)(v + i); }
};
struct EpiBf16 {
    static constexpr bool PERM = true, AFTER_DRAIN = false;
    bf16_t* O; int ldc; float sc = 1.0f; LnFold lf = {nullptr, nullptr, nullptr};
    __device__ __forceinline__ void operator()(const f32x4 (&acc)[2][2][4][2], const Unit& u, int wr, int wc, int fr, int fq) const {
        const int row0 = u.pm * BM + wr * 64 + fr, col0 = u.pn * BM + wc * 32 + 8 * fq;
        f32x4 gw[2][2], bw[2][2];
#pragma unroll
        for (int bj = 0; bj < 2; ++bj)
#pragma unroll
            for (int n = 0; n < 2; ++n) { gw[bj][n] = (f32x4){0.f, 0.f, 0.f, 0.f}; bw[bj][n] = (f32x4){0.f, 0.f, 0.f, 0.f}; if (lf.stats) { gw[bj][n] = lf.vec4(lf.gW, col0 + bj * HALF + 4 * n); bw[bj][n] = lf.vec4(lf.bW, col0 + bj * HALF + 4 * n); } }
#pragma unroll
        for (int ai = 0; ai < 2; ++ai)
#pragma unroll
            for (int m = 0; m < 4; ++m) { bf16_t* rowp = O + (size_t)(row0 + ai * HALF + m * 16) * ldc + col0;
                float mean = 0.f, rstd = 1.f; if (lf.stats) lf.row(row0 + ai * HALF + m * 16, mean, rstd);
#pragma unroll
                for (int bj = 0; bj < 2; ++bj) { const f32x4 v0 = ((acc[ai][bj][m][0] - gw[bj][0] * mean) * rstd + bw[bj][0]) * sc, v1 = ((acc[ai][bj][m][1] - gw[bj][1] * mean) * rstd + bw[bj][1]) * sc;
                    u32x4 w; w.x = cvt_pk_bf16(v0[0], v0[1]); w.y = cvt_pk_bf16(v0[2], v0[3]); w.z = cvt_pk_bf16(v1[0], v1[1]); w.w = cvt_pk_bf16(v1[2], v1[3]);
                    *(u32x4*)(rowp + bj * HALF) = w; } }
    }
};
struct EpiInProj {
    static constexpr bool PERM = true, AFTER_DRAIN = false;
    bf16_t *aq, *ak, *av, *bq, *bc, *iq, *ikw; float qscale; LnFold lf;
    __device__ __forceinline__ void operator()(const f32x4 (&acc)[2][2][4][2], const Unit& u, int wr, int wc, int fr, int fq) const {
        bf16_t* base; int ldc, colt; const int pn = u.pn;
        if (pn < 4) { base = aq; ldc = 1024; colt = pn * 256; }
        else if (pn < 8) { base = ak; ldc = 1024; colt = (pn - 4) * 256; }
        else if (pn < 12) { base = av; ldc = 1024; colt = (pn - 8) * 256; }
        else if (pn < 16) { base = bq; ldc = 1024; colt = (pn - 12) * 256; }
        else if (pn < 18) { base = bc; ldc = 512; colt = (pn - 16) * 256; }
        else if (pn < 22) { base = iq; ldc = 1024; colt = (pn - 18) * 256; }
        else { base = ikw; ldc = 256; colt = 0; }
        const float sc = (pn < 4) ? qscale : 1.0f;
        const int row0 = u.pm * BM + wr * 64 + fr, col0 = colt + wc * 32 + 8 * fq, cidx = pn * BM + wc * 32 + 8 * fq;
        f32x4 gw[2][2], bw[2][2];
#pragma unroll
        for (int bj = 0; bj < 2; ++bj)
#pragma unroll
            for (int n = 0; n < 2; ++n) { gw[bj][n] = lf.vec4(lf.gW, cidx + bj * HALF + 4 * n); bw[bj][n] = lf.vec4(lf.bW, cidx + bj * HALF + 4 * n); }
#pragma unroll
        for (int ai = 0; ai < 2; ++ai)
#pragma unroll
            for (int m = 0; m < 4; ++m) { bf16_t* rowp = base + (size_t)(row0 + ai * HALF + m * 16) * ldc + col0;
                float mean, rstd; lf.row(row0 + ai * HALF + m * 16, mean, rstd);
#pragma unroll
                for (int bj = 0; bj < 2; ++bj) { const f32x4 v0 = ((acc[ai][bj][m][0] - gw[bj][0] * mean) * rstd + bw[bj][0]) * sc, v1 = ((acc[ai][bj][m][1] - gw[bj][1] * mean) * rstd + bw[bj][1]) * sc;
                    u32x4 w; w.x = cvt_pk_bf16(v0[0], v0[1]); w.y = cvt_pk_bf16(v0[2], v0[3]); w.z = cvt_pk_bf16(v1[0], v1[1]); w.w = cvt_pk_bf16(v1[2], v1[3]);
                    *(u32x4*)(rowp + bj * HALF) = w; } }
    }
};
struct EpiSwiGLU {
    static constexpr bool PERM = true, AFTER_DRAIN = false;
    bf16_t* O; int ldc;
    __device__ __forceinline__ void operator()(const f32x4 (&acc)[2][2][4][2], const Unit& u, int wr, int wc, int fr, int fq) const {
        const int row0 = u.pm * BM + wr * 64 + fr, col0 = u.pn * HALF + wc * 32 + 8 * fq;
#pragma unroll
        for (int ai = 0; ai < 2; ++ai)
#pragma unroll
            for (int m = 0; m < 4; ++m) { bf16_t* rowp = O + (size_t)(row0 + ai * HALF + m * 16) * ldc + col0;
                float h[8];
#pragma unroll
                for (int n = 0; n < 2; ++n)
#pragma unroll
                    for (int j = 0; j < 4; ++j) { const float g = acc[ai][0][m][n][j], up = acc[ai][1][m][n][j]; h[4 * n + j] = g * sigmoidf_fast(g) * up; }
                u32x4 w; w.x = cvt_pk_bf16(h[0], h[1]); w.y = cvt_pk_bf16(h[2], h[3]); w.z = cvt_pk_bf16(h[4], h[5]); w.w = cvt_pk_bf16(h[6], h[7]);
                *(u32x4*)rowp = w; }
    }
};
__device__ __forceinline__ unsigned pk4_fp8(float a, float b, float c, float d) { int w = 0; w = __builtin_amdgcn_cvt_pk_fp8_f32(a, b, w, false); w = __builtin_amdgcn_cvt_pk_fp8_f32(c, d, w, true); return (unsigned)w; }
struct EpiSwiGLU8 {
    static constexpr bool PERM = true, AFTER_DRAIN = false;
    unsigned char* O; int ldc; float ascale, hs; LnFold lf;
    __device__ __forceinline__ void operator()(const f32x4 (&acc)[2][2][4][2], const Unit& u, int wr, int wc, int fr, int fq) const {
        const int row0 = u.pm * BM + wr * 64 + fr, col0 = u.pn * HALF + wc * 32 + 8 * fq, cidx = u.pn * BM + wc * 32 + 8 * fq;
        typedef unsigned u32x2 __attribute__((ext_vector_type(2)));
        f32x4 gw[2][2], bw[2][2];
#pragma unroll
        for (int bj = 0; bj < 2; ++bj)
#pragma unroll
            for (int n = 0; n < 2; ++n) { gw[bj][n] = (f32x4){0.f, 0.f, 0.f, 0.f}; bw[bj][n] = (f32x4){0.f, 0.f, 0.f, 0.f}; if (lf.stats) { gw[bj][n] = lf.vec4(lf.gW, cidx + bj * HALF + 4 * n); bw[bj][n] = lf.vec4(lf.bW, cidx + bj * HALF + 4 * n); } }
#pragma unroll
        for (int ai = 0; ai < 2; ++ai)
#pragma unroll
            for (int m = 0; m < 4; ++m) { unsigned char* rowp = O + (size_t)(row0 + ai * HALF + m * 16) * ldc + col0;
                float h[8]; float mean = 0.f, rstd = 1.f; if (lf.stats) lf.row(row0 + ai * HALF + m * 16, mean, rstd);
#pragma unroll
                for (int n = 0; n < 2; ++n)
#pragma unroll
                    for (int j = 0; j < 4; ++j) { const float g = (acc[ai][0][m][n][j] * ascale - gw[0][n][j] * mean) * rstd + bw[0][n][j], up = (acc[ai][1][m][n][j] * ascale - gw[1][n][j] * mean) * rstd + bw[1][n][j];
                        h[4 * n + j] = fminf(fmaxf(g * sigmoidf_fast(g) * up * hs, -448.f), 448.f); }
                *(u32x2*)rowp = (u32x2){pk4_fp8(h[0], h[1], h[2], h[3]), pk4_fp8(h[4], h[5], h[6], h[7])}; }
    }
};
struct EpiGateMerge {
    static constexpr bool PERM = true, AFTER_DRAIN = false;
    const bf16_t* ta; const bf16_t* tb; bf16_t* O; int ldc; const float* b0; const float* b1;
    __device__ __forceinline__ void operator()(const f32x4 (&acc)[2][2][4][2], const Unit& u, int wr, int wc, int fr, int fq) const {
        const int row0 = u.pm * BM + wr * 64 + fr, col0 = u.pn * HALF + wc * 32 + 8 * fq;
        float bb0[8], bb1[8];
#pragma unroll
        for (int j = 0; j < 8; ++j) { bb0[j] = b0[col0 + j]; bb1[j] = b1[col0 + j]; }
#pragma unroll
        for (int ai = 0; ai < 2; ++ai)
#pragma unroll
            for (int m = 0; m < 4; ++m) { const size_t off = (size_t)(row0 + ai * HALF + m * 16) * ldc + col0;
                const u32x4 a = *(const u32x4*)(ta + off), b = *(const u32x4*)(tb + off);
                const float av[8] = {bflo(a.x), bfhi(a.x), bflo(a.y), bfhi(a.y), bflo(a.z), bfhi(a.z), bflo(a.w), bfhi(a.w)};
                const float bv[8] = {bflo(b.x), bfhi(b.x), bflo(b.y), bfhi(b.y), bflo(b.z), bfhi(b.z), bflo(b.w), bfhi(b.w)};
                float h[8];
#pragma unroll
                for (int n = 0; n < 2; ++n)
#pragma unroll
                    for (int j = 0; j < 4; ++j) { const int e = 4 * n + j; h[e] = sigmoidf_fast(acc[ai][0][m][n][j] + bb0[e]) * av[e] + sigmoidf_fast(acc[ai][1][m][n][j] + bb1[e]) * bv[e]; }
                u32x4 w; w.x = cvt_pk_bf16(h[0], h[1]); w.y = cvt_pk_bf16(h[2], h[3]); w.z = cvt_pk_bf16(h[4], h[5]); w.w = cvt_pk_bf16(h[6], h[7]);
                *(u32x4*)(O + off) = w; }
    }
};
struct EpiGateMerge8 {
    static constexpr bool PERM = true, AFTER_DRAIN = false;
    const bf16_t* ta; const bf16_t* tb; unsigned char* O; int ldc; const float* b0; const float* b1; float ascale, ms; LnFold lf;
    __device__ __forceinline__ void operator()(const f32x4 (&acc)[2][2][4][2], const Unit& u, int wr, int wc, int fr, int fq) const {
        const int row0 = u.pm * BM + wr * 64 + fr, col0 = u.pn * HALF + wc * 32 + 8 * fq, cidx = u.pn * BM + wc * 32 + 8 * fq;
        typedef unsigned u32x2 __attribute__((ext_vector_type(2)));
        float bb0[8], bb1[8], gw0[8], gw1[8];
#pragma unroll
        for (int j = 0; j < 8; ++j) { bb0[j] = b0[col0 + j] + lf.bW[cidx + j]; bb1[j] = b1[col0 + j] + lf.bW[cidx + HALF + j]; gw0[j] = lf.gW[cidx + j]; gw1[j] = lf.gW[cidx + HALF + j]; }
#pragma unroll
        for (int ai = 0; ai < 2; ++ai)
#pragma unroll
            for (int m = 0; m < 4; ++m) { const size_t off = (size_t)(row0 + ai * HALF + m * 16) * ldc + col0;
                const u32x4 a = *(const u32x4*)(ta + off), b = *(const u32x4*)(tb + off);
                const float av[8] = {bflo(a.x), bfhi(a.x), bflo(a.y), bfhi(a.y), bflo(a.z), bfhi(a.z), bflo(a.w), bfhi(a.w)};
                const float bv[8] = {bflo(b.x), bfhi(b.x), bflo(b.y), bfhi(b.y), bflo(b.z), bfhi(b.z), bflo(b.w), bfhi(b.w)};
                float h[8]; float mean, rstd; lf.row(row0 + ai * HALF + m * 16, mean, rstd);
#pragma unroll
                for (int n = 0; n < 2; ++n)
#pragma unroll
                    for (int j = 0; j < 4; ++j) { const int e = 4 * n + j; const float v = sigmoidf_fast((acc[ai][0][m][n][j] * ascale - gw0[e] * mean) * rstd + bb0[e]) * av[e] + sigmoidf_fast((acc[ai][1][m][n][j] * ascale - gw1[e] * mean) * rstd + bb1[e]) * bv[e];
                        h[e] = fminf(fmaxf(v * ms, -448.f), 448.f); }
                *(u32x2*)(O + off) = (u32x2){pk4_fp8(h[0], h[1], h[2], h[3]), pk4_fp8(h[4], h[5], h[6], h[7])}; }
    }
};
struct EpiRes {
    static constexpr bool PERM = true, AFTER_DRAIN = false;
    const float* res32; const bf16_t* res16; int ldc; float alpha, s;
    const long long* rstats; const float* rg; const float* rb; long long* ostats; bf16_t* o16; unsigned char* o8; float o8s;
    __device__ __forceinline__ void operator()(const f32x4 (&acc)[2][2][4][2], const Unit& u, int wr, int wc, int fr, int fq) const {
        const int col0 = u.pn * BM + wc * 32 + 8 * fq;
        typedef unsigned u32x2 __attribute__((ext_vector_type(2)));
        float al = alpha, sa = s; asm volatile("" : "+v"(al), "+v"(sa));
        f32x4 gv[2][2], bv[2][2];
#pragma unroll
        for (int bj = 0; bj < 2; ++bj)
#pragma unroll
            for (int n = 0; n < 2; ++n) { gv[bj][n] = (f32x4){1.f, 1.f, 1.f, 1.f}; bv[bj][n] = (f32x4){0.f, 0.f, 0.f, 0.f};
                if (rstats) { gv[bj][n] = *(const f32x4*)(rg + col0 + bj * HALF + 4 * n); bv[bj][n] = *(const f32x4*)(rb + col0 + bj * HALF + 4 * n); }
                gv[bj][n] = gv[bj][n] * al; bv[bj][n] = bv[bj][n] * al; }
#pragma unroll
        for (int ai = 0; ai < 2; ++ai)
#pragma unroll
            for (int m = 0; m < 4; ++m) { const int row = u.pm * BM + ai * HALF + wr * 64 + m * 16 + fr; const size_t off = (size_t)row * ldc + col0;
                float mean = 0.f, rstd = 1.f;
                if (rstats) { const long long s0 = rstats[2 * (size_t)row], s1 = rstats[2 * (size_t)row + 1]; mean = (float)s0 * (1.0f / (1048576.f * 2048.0f)); rstd = __builtin_amdgcn_rsqf((float)s1 * (1.0f / (65536.f * 2048.0f)) - mean * mean + 1e-5f); }
                float ps = 0.f, pq = 0.f;
#pragma unroll
                for (int bj = 0; bj < 2; ++bj) {
                    f32x4 r0, r1;
                    if (res32) { r0 = *(const f32x4*)(res32 + off + bj * HALF); r1 = *(const f32x4*)(res32 + off + bj * HALF + 4); }
                    else { const u32x4 w = *(const u32x4*)(res16 + off + bj * HALF); r0 = (f32x4){bflo(w.x), bfhi(w.x), bflo(w.y), bfhi(w.y)}; r1 = (f32x4){bflo(w.z), bfhi(w.z), bflo(w.w), bfhi(w.w)}; }
                    const f32x4 z0 = (r0 - mean) * rstd * gv[bj][0] + bv[bj][0] + acc[ai][bj][m][0] * sa, z1 = (r1 - mean) * rstd * gv[bj][1] + bv[bj][1] + acc[ai][bj][m][1] * sa;
                    u32x4 w16; w16.x = cvt_pk_bf16(z0[0], z0[1]); w16.y = cvt_pk_bf16(z0[2], z0[3]); w16.z = cvt_pk_bf16(z1[0], z1[1]); w16.w = cvt_pk_bf16(z1[2], z1[3]);
                    *(u32x4*)(o16 + off + bj * HALF) = w16;
                    const float q0 = bflo(w16.x), q1 = bfhi(w16.x), q2 = bflo(w16.y), q3 = bfhi(w16.y), q4 = bflo(w16.z), q5 = bfhi(w16.z), q6 = bflo(w16.w), q7 = bfhi(w16.w);
                    ps += ((q0 + q1) + (q2 + q3)) + ((q4 + q5) + (q6 + q7)); pq += ((q0 * q0 + q1 * q1) + (q2 * q2 + q3 * q3)) + ((q4 * q4 + q5 * q5) + (q6 * q6 + q7 * q7));
                    if (o8) *(u32x2*)(o8 + off + bj * HALF) = (u32x2){pk4_fp8(fminf(fmaxf(q0 * o8s, -448.f), 448.f), fminf(fmaxf(q1 * o8s, -448.f), 448.f), fminf(fmaxf(q2 * o8s, -448.f), 448.f), fminf(fmaxf(q3 * o8s, -448.f), 448.f)),
                                                                      pk4_fp8(fminf(fmaxf(q4 * o8s, -448.f), 448.f), fminf(fmaxf(q5 * o8s, -448.f), 448.f), fminf(fmaxf(q6 * o8s, -448.f), 448.f), fminf(fmaxf(q7 * o8s, -448.f), 448.f))}; }
                if (ostats) { ps += __shfl_xor(ps, 16); ps += __shfl_xor(ps, 32); pq += __shfl_xor(pq, 16); pq += __shfl_xor(pq, 32);
                    if (fq == 0) { (void)__hip_atomic_fetch_add(ostats + 2 * (size_t)row, (long long)__builtin_rintf(ps * 1048576.f), __ATOMIC_RELAXED, __HIP_MEMORY_SCOPE_AGENT); (void)__hip_atomic_fetch_add(ostats + 2 * (size_t)row + 1, (long long)__builtin_rintf(pq * 65536.f), __ATOMIC_RELAXED, __HIP_MEMORY_SCOPE_AGENT); } }
                if (m & 1) asm volatile("" ::: "memory"); }
    }
};

typedef int v8i_t __attribute__((ext_vector_type(8)));
typedef int v4i_t __attribute__((ext_vector_type(4)));
template <class Epi, class Sched, bool ALIGN_EPI, bool FP8 = false>
__device__ __forceinline__ void gemm_phase(PG8_LAS unsigned char* lds, const Gemm g, const Sched& S, const Epi& E, const int wid) {
    const int lane = lane_fresh(), tid = wid * 64 + lane, wr = wid >> 2, wc = wid & 3, fr = lane & 15, fq = lane >> 4;
    const int K = g.K, nt = K / BK;
    unsigned voffA[2], voffB[2];
#pragma unroll
    for (int i = 0; i < 2; ++i) { int R, C; stage_rc(tid * 16 + i * 8192, R, C); const int Rb = Epi::PERM ? ((R & ~31) + perm32(R & 31)) : R;
        voffA[i] = (unsigned)(R * g.lda + C) * 2u; voffB[i] = (unsigned)(Rb * g.ldb + C) * 2u; }
    const size_t kstep = (size_t)(BK * 2);
    const size_t hstepA = (size_t)HALF * g.lda * 2, hstepB = (size_t)HALF * g.ldb * 2;
    const size_t tstepA = 2 * hstepA, tstepB = 2 * hstepB;
    const unsigned ldsw = (unsigned)wid * 1024u;
    const int aoff = lds_byte(wr * 64 + fr, fq * 8), boff = lds_byte(wc * 32 + fr, fq * 8);
#define PG8_UA(u) ((const char*)g.A + (size_t)(u).pm * tstepA + (size_t)(((u).pn >> g.a_shift) * g.a_mul) * 2)
#define PG8_UB(u) ((const char*)g.Bt + (size_t)(u).pn * tstepB)
#define PG8_SA(b, h) (((b) * 2 + (h)) * HTB)
#define PG8_SB(b, h) ((4 + (b) * 2 + (h)) * HTB)
#define PG8_STAGE(bufoff, gbase, voff) do { _Pragma("unroll") for (int _i = 0; _i < 2; ++_i) \
        __builtin_amdgcn_global_load_lds((const unsigned*)((const char*)(gbase) + (voff)[_i]), (PG8_LAS unsigned*)(lds + (bufoff) + ldsw + _i * 8192), 16, 0, 0); } while (0)
#define PG8_LD8(p_) __builtin_shufflevector(*(const PG8_LAS v4i_t*)(p_), *(const PG8_LAS v4i_t*)((p_) + 1024), 0, 1, 2, 3, 4, 5, 6, 7)
#define PG8_LDA(dst, b, h) do { _Pragma("unroll") for (int m = 0; m < 4; ++m) { if constexpr (FP8) dst##8[m] = PG8_LD8(lds + PG8_SA(b, h) + aoff + m * 2048); else { _Pragma("unroll") for (int k = 0; k < 2; ++k) dst[m][k] = *(const PG8_LAS bf16x8*)(lds + PG8_SA(b, h) + aoff + m * 2048 + k * 1024); } } } while (0)
#define PG8_LDB(dst, b, h) do { _Pragma("unroll") for (int n = 0; n < 2; ++n) { if constexpr (FP8) dst##8[n] = PG8_LD8(lds + PG8_SB(b, h) + boff + n * 2048); else { _Pragma("unroll") for (int k = 0; k < 2; ++k) dst[n][k] = *(const PG8_LAS bf16x8*)(lds + PG8_SB(b, h) + boff + n * 2048 + k * 1024); } } } while (0)
#define PG8_MMA(ai, bj, At, Bt) do { __builtin_amdgcn_s_setprio(1); _Pragma("unroll") for (int m = 0; m < 4; ++m) _Pragma("unroll") for (int n = 0; n < 2; ++n) { \
        if constexpr (FP8) asm volatile("v_mfma_scale_f32_16x16x128_f8f6f4 %0, %1, %2, %0, %3, %3 op_sel_hi:[0,0,0]" : "+v"(acc[ai][bj][m][n]) : "v"(Bt##8[n]), "v"(At##8[m]), "v"(one_scale)); \
        else { _Pragma("unroll") for (int k = 0; k < 2; ++k) acc[ai][bj][m][n] = __builtin_amdgcn_mfma_f32_16x16x32_bf16(Bt[n][k], At[m][k], acc[ai][bj][m][n], 0, 0, 0); } } \
        __builtin_amdgcn_s_setprio(0); } while (0)
#define PG8_WAIT_V(n) asm volatile("s_waitcnt vmcnt(" #n ")" ::: "memory")
#define PG8_WAIT_L(n) asm volatile("s_waitcnt lgkmcnt(" #n ")" ::: "memory")
#define PG8_BAR __builtin_amdgcn_s_barrier()
#define PG8_SCHED __builtin_amdgcn_sched_barrier(0)
    Unit cur, nxt; int ui = 0;
    if (!S.next(0, cur)) return;
    f32x4 acc[2][2][4][2];
#pragma unroll
    for (int a = 0; a < 2; ++a)
#pragma unroll
        for (int b = 0; b < 2; ++b)
#pragma unroll
            for (int m = 0; m < 4; ++m)
#pragma unroll
                for (int n = 0; n < 2; ++n) acc[a][b][m][n] = (f32x4){0.f, 0.f, 0.f, 0.f};
    bf16x8 At[4][2], B0[2][2], B1[2][2]; v8i_t At8[4], B08[2], B18[2];
    int one_scale = 0x7f7f7f7f; asm volatile("" : "+v"(one_scale));
    const char* cA = PG8_UA(cur); const char* cB = PG8_UB(cur);
    S.a_ready(cur);
    PG8_STAGE(PG8_SB(0, 0), cB, voffB); PG8_STAGE(PG8_SB(0, 1), cB + hstepB, voffB); PG8_STAGE(PG8_SA(0, 0), cA, voffA); PG8_STAGE(PG8_SA(0, 1), cA + hstepA, voffA);
    if (wr == 1) PG8_BAR;
    PG8_WAIT_V(2); PG8_BAR;
    PG8_STAGE(PG8_SB(1, 0), cB + kstep, voffB); PG8_STAGE(PG8_SA(1, 0), cA + kstep, voffA); PG8_STAGE(PG8_SB(1, 1), cB + hstepB + kstep, voffB);
    PG8_WAIT_V(6); PG8_BAR;
    for (;;) {
        const bool has_next = S.next(ui + 1, nxt);
        const char* nA = has_next ? PG8_UA(nxt) : cA; const char* nB = has_next ? PG8_UB(nxt) : cB;
        for (int t = 0; t < nt; t += 2) {
            const bool last = (t == nt - 2);
            const char* a1 = cA + (size_t)(t + 1) * kstep;
            const char* a2 = last ? nA : cA + (size_t)(t + 2) * kstep; const char* b2 = last ? nB : cB + (size_t)(t + 2) * kstep;
            const char* a3 = a2 + kstep; const char* b3 = b2 + kstep;
            if (last && has_next) S.a_ready(nxt);
            PG8_LDB(B0, 0, 0); PG8_LDB(B1, 0, 1); PG8_SCHED; PG8_LDA(At, 0, 0); PG8_STAGE(PG8_SA(1, 1), a1 + hstepA, voffA);
            PG8_WAIT_V(8); PG8_WAIT_L(0); PG8_BAR; PG8_MMA(0, 0, At, B0); PG8_MMA(0, 1, At, B1); PG8_BAR; PG8_SCHED;
            PG8_LDA(At, 0, 1); PG8_STAGE(PG8_SB(0, 0), b2, voffB); PG8_STAGE(PG8_SB(0, 1), b2 + hstepB, voffB); PG8_STAGE(PG8_SA(0, 0), a2, voffA);
            PG8_WAIT_V(8); PG8_WAIT_L(0); PG8_BAR; PG8_MMA(1, 0, At, B0); PG8_MMA(1, 1, At, B1); PG8_BAR; PG8_SCHED;
            PG8_LDB(B0, 1, 0); PG8_LDB(B1, 1, 1); PG8_SCHED; PG8_LDA(At, 1, 0); PG8_STAGE(PG8_SA(0, 1), a2 + hstepA, voffA);
            PG8_WAIT_V(8); PG8_WAIT_L(0); PG8_BAR; PG8_MMA(0, 0, At, B0); PG8_MMA(0, 1, At, B1); PG8_BAR; PG8_SCHED;
            PG8_LDA(At, 1, 1); PG8_STAGE(PG8_SB(1, 0), b3, voffB); PG8_STAGE(PG8_SB(1, 1), b3 + hstepB, voffB); PG8_STAGE(PG8_SA(1, 0), a3, voffA);
            PG8_WAIT_V(8); PG8_WAIT_L(0); PG8_BAR; PG8_MMA(1, 0, At, B0); PG8_MMA(1, 1, At, B1); PG8_BAR; PG8_SCHED;
        }
        if constexpr (ALIGN_EPI) { if (wr == 0) PG8_BAR; }
        if constexpr (FP8) asm volatile("s_nop 15\n\ts_nop 7" ::: "memory");
        E(acc, cur, wr, wc, fr, fq); S.done(cur);
        if (!has_next) break;
#pragma unroll
        for (int a = 0; a < 2; ++a)
#pragma unroll
            for (int b = 0; b < 2; ++b)
#pragma unroll
                for (int m = 0; m < 4; ++m)
#pragma unroll
                    for (int n = 0; n < 2; ++n) acc[a][b][m][n] = (f32x4){0.f, 0.f, 0.f, 0.f};
        cur = nxt; cA = nA; cB = nB; ++ui;
        if constexpr (ALIGN_EPI) { if (wr == 1) PG8_BAR; }
    }
    PG8_WAIT_V(0);
    if constexpr (!ALIGN_EPI) { if (wr == 0) PG8_BAR; }
    PG8_BAR;
#undef PG8_UA
#undef PG8_UB
#undef PG8_SA
#undef PG8_SB
#undef PG8_STAGE
#undef PG8_LDA
#undef PG8_LDB
#undef PG8_MMA
#undef PG8_LD8
#undef PG8_WAIT_V
#undef PG8_WAIT_L
#undef PG8_BAR
#undef PG8_SCHED
}
}

constexpr int NWAVES = 8;
constexpr int BATCH = 4, SEQ = 4096, D = 2048, FF = 5632, M = BATCH * SEQ;
constexpr int N_IN = 5888;
constexpr int MEMT = 256;
constexpr float LN_EPS = 1e-5f;
constexpr float ALPHA = 1.189207115002721f;
constexpr float LAMBDA_INIT = 0.2f;

constexpr size_t MiB = 1u << 20;
constexpr size_t WS_CTL = 0, CTL_ZERO_BYTES = 2 * MiB;
constexpr size_t WS_W_IN = 2 * MiB;
constexpr size_t WS_W_G = 25 * MiB;
constexpr size_t WS_W_UK = 41 * MiB;
constexpr size_t WS_W_UVP = 42 * MiB;
constexpr size_t WS_W_A = 44 * MiB;
constexpr size_t WS_W_B = 48 * MiB;
constexpr size_t WS_W_MO = 52 * MiB;
constexpr size_t WS_W_MQ = 60 * MiB;
constexpr size_t WS_W_MKV = 62 * MiB;
constexpr size_t WS_W_MOUT = 66 * MiB;
constexpr size_t WS_MEM16 = 68 * MiB;
constexpr size_t WS_KVMEM = 72 * MiB;
constexpr size_t WS_W_GU2 = 74 * MiB;
constexpr size_t WS_W_D2 = 96 * MiB;
constexpr size_t WS_X8M = 107 * MiB;
constexpr size_t WS_X16 = 140 * MiB;
constexpr size_t WS_MIX = 204 * MiB;
constexpr size_t WS_W_GU1 = 204 * MiB;
constexpr size_t WS_W_D1 = 248 * MiB;
constexpr size_t WS_H = 270 * MiB;
constexpr size_t WS_AQ = WS_MIX + 0 * MiB, WS_AK = WS_MIX + 32 * MiB, WS_AV = WS_MIX + 64 * MiB, WS_BQ = WS_MIX + 96 * MiB;
constexpr size_t WS_BC = WS_MIX + 128 * MiB;
constexpr size_t WS_IQ = WS_MIX + 144 * MiB;
constexpr size_t WS_IKW = WS_MIX + 176 * MiB;
constexpr size_t WS_QLAT = WS_MIX + 184 * MiB;
constexpr size_t WS_IDX = WS_MIX + 312 * MiB;
constexpr size_t WS_YB = WS_BQ;
constexpr size_t WS_TA = WS_QLAT, WS_TB = WS_QLAT + 64 * MiB;
constexpr size_t WS_QM = WS_AQ, WS_OM = WS_AQ + 16 * MiB;
constexpr size_t WS_X8 = WS_H + 96 * MiB;
constexpr size_t WS_MRG8 = WS_AV;
constexpr float FP8_WGS = 1024.f, FP8_MS = 32.f, FP8_WMOS = 2048.f;
constexpr float FP8_XS = 32.f, FP8_WGUS = 1024.f, FP8_HS = 8.f, FP8_WDS = 4096.f;
constexpr size_t WS_END = WS_MIX + 320 * MiB;
static_assert(WS_H + (size_t)M * FF * 2 <= WS_END && WS_QLAT + (size_t)M * 4096 * 2 <= WS_END, "d_ws map");
constexpr int CW_BAR = 4096;
constexpr size_t CTL_STATS = 65536, CTL_STATS_STRIDE = (size_t)M * 2 * 8;
constexpr size_t CTL_VEC = CTL_STATS + 3 * CTL_STATS_STRIDE;
constexpr int V_GW_IN = 0, V_BW_IN = 5888, V_GW_G = 11776, V_BW_G = 15872, V_GW_MQ = 19968, V_BW_MQ = 20480, V_GW_GU2 = 20992, V_BW_GU2 = 32256, V_END = 43520;
constexpr size_t CTL_VECF = CTL_VEC + (size_t)V_END * 8;
static_assert(CTL_VECF + (size_t)V_END * 4 <= CTL_ZERO_BYTES, "control region");
constexpr float FX_S = 1048576.f, FX_Q = 65536.f, FX_V = 16777216.f;

constexpr int RING_OFF = 0, RING_BYTES = 153600;
constexpr int LDSCTL_OFF = RING_BYTES, MISC_OFF = LDSCTL_OFF + 320;
constexpr int LDS_BYTES = 154624;
static_assert(MISC_OFF + 128 <= LDS_BYTES, "LDS map");

#define GAS __attribute__((address_space(1)))
#define LAS __attribute__((address_space(3)))
typedef unsigned short bf16;
typedef unsigned v4u __attribute__((ext_vector_type(4)));
typedef unsigned v2u __attribute__((ext_vector_type(2)));
typedef float f32x4 __attribute__((ext_vector_type(4)));
typedef float f32x16 __attribute__((ext_vector_type(16)));
typedef short bf16x8 __attribute__((ext_vector_type(8)));
typedef GAS unsigned gu32;
#define RLX_AGENT __ATOMIC_RELAXED, __HIP_MEMORY_SCOPE_AGENT
#define LDS_WAIT() asm volatile("s_waitcnt lgkmcnt(0)" ::: "memory")
#define VM_WAIT() asm volatile("s_waitcnt vmcnt(0)" ::: "memory")
__device__ __forceinline__ unsigned f2bf(float f) { unsigned u = __builtin_bit_cast(unsigned, f); return (u + 0x7fffu + ((u >> 16) & 1u)) >> 16; }
__device__ __forceinline__ unsigned pk2(float lo, float hi) { return f2bf(lo) | (f2bf(hi) << 16); }
__device__ __forceinline__ float bf2f(unsigned short v) { return __uint_as_float((unsigned)v << 16); }
__device__ __forceinline__ float blo(unsigned w) { return __uint_as_float(w << 16); }
__device__ __forceinline__ float bhi(unsigned w) { return __uint_as_float(w & 0xffff0000u); }
__device__ __forceinline__ float wave_sum(float v) {
#pragma unroll
    for (int o = 1; o < 64; o <<= 1) v += __shfl_xor(v, o);
    return v;
}

#define XB_TMO      128
#define XB_XCNT(j)  (256  + 64 * (j))
#define XB_XSUB(j)  (1280 + 64 * (j))
#define XB_XGEN(j)  (2304 + 64 * (j))
#define XB_TOP      3328
#define XB_TOPGEN   3392
#define XCD_BAR_WORDS 3456
#define XB_SPIN_CAP (1u << 18)

__device__ __forceinline__ unsigned xb_ld(unsigned* p)              { return __hip_atomic_load(p, __ATOMIC_RELAXED, __HIP_MEMORY_SCOPE_AGENT); }
__device__ __forceinline__ unsigned xb_add(unsigned* p, unsigned v) { return __hip_atomic_fetch_add(p, v, __ATOMIC_RELAXED, __HIP_MEMORY_SCOPE_AGENT); }
__device__ __forceinline__ unsigned xb_xcc_id() { return (unsigned)__builtin_amdgcn_s_getreg((3 << 11) | 20) & 0xFu; }
#define XB_SPIN(cond, bar) do { unsigned _sp = 0; while (cond) { __builtin_amdgcn_s_sleep(1); \
    if ((++_sp & 255u) == 0u) { if (xb_ld(&(bar)[XB_TMO])) break; if (_sp > XB_SPIN_CAP) { atomicAdd(&(bar)[XB_TMO], 1u); break; } } } } while (0)

struct XcdBarrier {
    unsigned* bar; unsigned x;
    volatile LAS unsigned* st;
};

__device__ __forceinline__ XcdBarrier xcd_barrier_post(unsigned* bar, volatile LAS unsigned* st, bool t0) {
    XcdBarrier b; b.bar = bar; b.x = xb_xcc_id(); b.st = st;
    if (t0) (void)xb_add(&bar[XB_XCNT(b.x)], 1u);
    return b;
}
__device__ __forceinline__ void xcd_barrier_complete(unsigned* bar, unsigned x, unsigned& nloc, unsigned& nx) {
    const unsigned G = gridDim.x * gridDim.y * gridDim.z;
    unsigned sum, cnt, mine, sp = 0u;
    for (;;) {
        sum = 0u; cnt = 0u; mine = 0u;
#pragma unroll
        for (unsigned j = 0; j < 16; ++j) { const unsigned c = xb_ld(&bar[XB_XCNT(j)]); sum += c; cnt += (c > 0u) ? 1u : 0u; mine = (j == x) ? c : mine; }
        if (sum == G) break;
        __builtin_amdgcn_s_sleep(1);
        if ((++sp & 255u) == 0u) { if (xb_ld(&bar[XB_TMO])) break; if (sp > XB_SPIN_CAP) { atomicAdd(&bar[XB_TMO], 1u); break; } }
    }
    nloc = mine > 0u ? mine : 1u; nx = cnt > 0u ? cnt : 1u;
}

__device__ __forceinline__ void xcd_barrier(const XcdBarrier& b, const int wave) {
    asm volatile("s_waitcnt vmcnt(0)" ::: "memory");
    __syncthreads();
    if (wave == 0 && lane_fresh() == 0) {
        unsigned* bar = b.bar;
        __builtin_amdgcn_s_waitcnt(0);
        unsigned nloc = b.st[0], nx = b.st[1];
        if (nloc == 0u) { xcd_barrier_complete(bar, b.x, nloc, nx); b.st[0] = nloc; b.st[1] = nx; }
        const unsigned old = xb_add(&bar[XB_XSUB(b.x)], 1u);
        const unsigned gen = old / nloc;
        if (old + 1u == (gen + 1u) * nloc) {
            __builtin_amdgcn_fence(__ATOMIC_RELEASE, "agent");
            asm volatile("s_waitcnt vmcnt(0)" ::: "memory");
            const unsigned og = xb_add(&bar[XB_TOP], 1u);
            const unsigned tg = og / nx;
            if (og + 1u == (tg + 1u) * nx) xb_add(&bar[XB_TOPGEN], 1u);
            else XB_SPIN(xb_ld(&bar[XB_TOPGEN]) == tg, bar);
            __builtin_amdgcn_fence(__ATOMIC_ACQUIRE, "agent");
            xb_add(&bar[XB_XGEN(b.x)], 1u);
            asm volatile("s_waitcnt vmcnt(0)" ::: "memory");
        } else {
            XB_SPIN(xb_ld(&bar[XB_XGEN(b.x)]) == gen, bar);
            __builtin_amdgcn_fence(__ATOMIC_ACQUIRE, "agent");
            asm volatile("s_waitcnt vmcnt(0)" ::: "memory");
        }
    }
    __syncthreads();
}

__device__ __forceinline__ void tr_item(const float* W, int ldw, int nvalid, bf16* WT, int ldt, int k0, int n0, int drow0, int dcol0, LAS float* scr, int lane) {
    const int n = n0 + (lane & 31); const bool ok = n < nvalid;
#pragma unroll 8
    for (int i = 0; i < 32; ++i) { const int kk = 2 * i + (lane >> 5); scr[kk * 33 + (lane & 31)] = ok ? W[(size_t)(k0 + kk) * ldw + n] : 0.f; }
    LDS_WAIT(); asm volatile("" ::: "memory");
    const int c = lane & 7;
#pragma unroll
    for (int j = 0; j < 4; ++j) { const int nn = (lane >> 3) + 8 * j; const LAS float* s = scr + (8 * c) * 33 + nn;
        v4u o; o.x = pk2(s[0 * 33], s[1 * 33]); o.y = pk2(s[2 * 33], s[3 * 33]); o.z = pk2(s[4 * 33], s[5 * 33]); o.w = pk2(s[6 * 33], s[7 * 33]);
        *(GAS v4u*)(WT + (size_t)(drow0 + nn) * ldt + dcol0 + k0 + 8 * c) = o; }
    LDS_WAIT(); asm volatile("" ::: "memory");
}
__device__ __forceinline__ void tr_item8(const float* W, int ldw, unsigned char* WT, int ldt, int k0, int n0, int drow0, float sc, LAS float* scr, int lane) {
    const int n = n0 + (lane & 31);
#pragma unroll 8
    for (int i = 0; i < 32; ++i) { const int kk = 2 * i + (lane >> 5); scr[kk * 33 + (lane & 31)] = W[(size_t)(k0 + kk) * ldw + n]; }
    LDS_WAIT(); asm volatile("" ::: "memory");
    const int nn = lane >> 1, hf = lane & 1; const LAS float* sp = scr + (32 * hf) * 33 + nn;
    unsigned o[8];
#pragma unroll
    for (int q = 0; q < 8; ++q) { const float a = fminf(fmaxf(sp[(4 * q + 0) * 33] * sc, -448.f), 448.f), b = fminf(fmaxf(sp[(4 * q + 1) * 33] * sc, -448.f), 448.f), c = fminf(fmaxf(sp[(4 * q + 2) * 33] * sc, -448.f), 448.f), d = fminf(fmaxf(sp[(4 * q + 3) * 33] * sc, -448.f), 448.f);
        int w = 0; w = __builtin_amdgcn_cvt_pk_fp8_f32(a, b, w, false); w = __builtin_amdgcn_cvt_pk_fp8_f32(c, d, w, true); o[q] = (unsigned)w; }
    GAS v4u* dst = (GAS v4u*)(WT + (size_t)(drow0 + nn) * ldt + k0 + 32 * hf);
    dst[0] = (v4u){o[0], o[1], o[2], o[3]}; dst[1] = (v4u){o[4], o[5], o[6], o[7]};
    LDS_WAIT(); asm volatile("" ::: "memory");
}
__device__ __forceinline__ void tr_item_ln(const float* W, int ldw, int nvalid, bf16* WT, int ldt, int k0, int n0, int drow0, const float* gain, const float* bvec, long long* gW, long long* bW, LAS float* scr, int lane) {
    const int n = n0 + (lane & 31); const bool ok = n < nvalid;
#pragma unroll 8
    for (int i = 0; i < 32; ++i) { const int kk = 2 * i + (lane >> 5); scr[kk * 33 + (lane & 31)] = ok ? W[(size_t)(k0 + kk) * ldw + n] : 0.f; }
    LDS_WAIT(); asm volatile("" ::: "memory");
    const int c = lane & 7;
    const f32x4 g0 = *(const GAS f32x4*)(gain + k0 + 8 * c), g1 = *(const GAS f32x4*)(gain + k0 + 8 * c + 4), b0 = *(const GAS f32x4*)(bvec + k0 + 8 * c), b1 = *(const GAS f32x4*)(bvec + k0 + 8 * c + 4);
    const float gk[8] = {g0.x, g0.y, g0.z, g0.w, g1.x, g1.y, g1.z, g1.w}, bk[8] = {b0.x, b0.y, b0.z, b0.w, b1.x, b1.y, b1.z, b1.w};
#pragma unroll
    for (int j = 0; j < 4; ++j) { const int nn = (lane >> 3) + 8 * j; const LAS float* sp = scr + (8 * c) * 33 + nn;
        float v[8], bs = 0.f;
#pragma unroll
        for (int i = 0; i < 8; ++i) { const float raw = sp[i * 33]; v[i] = raw * gk[i]; bs += raw * bk[i]; }
        v4u o; o.x = pk2(v[0], v[1]); o.y = pk2(v[2], v[3]); o.z = pk2(v[4], v[5]); o.w = pk2(v[6], v[7]);
        float gs = ((blo(o.x) + bhi(o.x)) + (blo(o.y) + bhi(o.y))) + ((blo(o.z) + bhi(o.z)) + (blo(o.w) + bhi(o.w)));
        *(GAS v4u*)(WT + (size_t)(drow0 + nn) * ldt + k0 + 8 * c) = o;
        gs += __shfl_xor(gs, 1); gs += __shfl_xor(gs, 2); gs += __shfl_xor(gs, 4); bs += __shfl_xor(bs, 1); bs += __shfl_xor(bs, 2); bs += __shfl_xor(bs, 4);
        if (c == 0) { (void)__hip_atomic_fetch_add(gW + drow0 + nn, (long long)__builtin_rintf(gs * FX_V), __ATOMIC_RELAXED, __HIP_MEMORY_SCOPE_AGENT); (void)__hip_atomic_fetch_add(bW + drow0 + nn, (long long)__builtin_rintf(bs * FX_V), __ATOMIC_RELAXED, __HIP_MEMORY_SCOPE_AGENT); } }
    LDS_WAIT(); asm volatile("" ::: "memory");
}
__device__ __forceinline__ void tr_item8_ln(const float* W, int ldw, unsigned char* WT, int ldt, int k0, int n0, int drow0, float sc, const float* gain, const float* bvec, long long* gW, long long* bW, LAS float* scr, int lane) {
    const int n = n0 + (lane & 31);
#pragma unroll 8
    for (int i = 0; i < 32; ++i) { const int kk = 2 * i + (lane >> 5); scr[kk * 33 + (lane & 31)] = W[(size_t)(k0 + kk) * ldw + n]; }
    LDS_WAIT(); asm volatile("" ::: "memory");
    const int nn = lane >> 1, hf = lane & 1; const LAS float* sp = scr + (32 * hf) * 33 + nn;
    unsigned o[8]; float gs = 0.f, bs = 0.f;
#pragma unroll
    for (int q = 0; q < 8; ++q) { const f32x4 g4 = *(const GAS f32x4*)(gain + k0 + 32 * hf + 4 * q), b4 = *(const GAS f32x4*)(bvec + k0 + 32 * hf + 4 * q);
        const float r0 = sp[(4 * q + 0) * 33], r1 = sp[(4 * q + 1) * 33], r2 = sp[(4 * q + 2) * 33], r3 = sp[(4 * q + 3) * 33];
        bs += (r0 * b4.x + r1 * b4.y) + (r2 * b4.z + r3 * b4.w);
        const float a = fminf(fmaxf(r0 * g4.x * sc, -448.f), 448.f), b = fminf(fmaxf(r1 * g4.y * sc, -448.f), 448.f), c = fminf(fmaxf(r2 * g4.z * sc, -448.f), 448.f), d = fminf(fmaxf(r3 * g4.w * sc, -448.f), 448.f);
        int w = 0; w = __builtin_amdgcn_cvt_pk_fp8_f32(a, b, w, false); w = __builtin_amdgcn_cvt_pk_fp8_f32(c, d, w, true); o[q] = (unsigned)w;
        gs += (__builtin_amdgcn_cvt_f32_fp8(w, 0) + __builtin_amdgcn_cvt_f32_fp8(w, 1)) + (__builtin_amdgcn_cvt_f32_fp8(w, 2) + __builtin_amdgcn_cvt_f32_fp8(w, 3)); }
    GAS v4u* dst = (GAS v4u*)(WT + (size_t)(drow0 + nn) * ldt + k0 + 32 * hf);
    dst[0] = (v4u){o[0], o[1], o[2], o[3]}; dst[1] = (v4u){o[4], o[5], o[6], o[7]};
    gs += __shfl_xor(gs, 1); bs += __shfl_xor(bs, 1);
    if (hf == 0) { (void)__hip_atomic_fetch_add(gW + drow0 + nn, (long long)__builtin_rintf(gs / sc * FX_V), __ATOMIC_RELAXED, __HIP_MEMORY_SCOPE_AGENT); (void)__hip_atomic_fetch_add(bW + drow0 + nn, (long long)__builtin_rintf(bs * FX_V), __ATOMIC_RELAXED, __HIP_MEMORY_SCOPE_AGENT); }
    LDS_WAIT(); asm volatile("" ::: "memory");
}
__device__ __forceinline__ void cvt_item8(const float* src, unsigned char* dst, int item, int lane, float sc) {
    const GAS f32x4* sp = (const GAS f32x4*)(src + (size_t)item * 512) + 2 * lane; f32x4 a = sp[0] * sc, b = sp[1] * sc;
    int w0 = 0, w1 = 0; w0 = __builtin_amdgcn_cvt_pk_fp8_f32(fminf(fmaxf(a.x, -448.f), 448.f), fminf(fmaxf(a.y, -448.f), 448.f), w0, false); w0 = __builtin_amdgcn_cvt_pk_fp8_f32(fminf(fmaxf(a.z, -448.f), 448.f), fminf(fmaxf(a.w, -448.f), 448.f), w0, true);
    w1 = __builtin_amdgcn_cvt_pk_fp8_f32(fminf(fmaxf(b.x, -448.f), 448.f), fminf(fmaxf(b.y, -448.f), 448.f), w1, false); w1 = __builtin_amdgcn_cvt_pk_fp8_f32(fminf(fmaxf(b.z, -448.f), 448.f), fminf(fmaxf(b.w, -448.f), 448.f), w1, true);
    *((GAS v2u*)(dst + (size_t)item * 512) + lane) = (v2u){(unsigned)w0, (unsigned)w1};
}
__device__ __forceinline__ void cvt_item(const float* src, bf16* dst, int item, int lane) {
    const GAS f32x4* s = (const GAS f32x4*)(src + (size_t)item * 512) + 2 * lane; const f32x4 a = s[0], b = s[1];
    v4u o; o.x = pk2(a.x, a.y); o.y = pk2(a.z, a.w); o.z = pk2(b.x, b.y); o.w = pk2(b.z, b.w);
    *((GAS v4u*)(dst + (size_t)item * 512) + lane) = o;
}
__device__ __forceinline__ void p0_prologue(const float* const (&in)[24], unsigned char* ws, LAS unsigned char* lds, int gw, int NGW, int wave, int lane) {
    LAS float* scr = (LAS float*)(lds + RING_OFF + wave * 16384);
#define TRM(SRC, Kk, LDW, NVALID, NPAD, DST, LDT, ROWMAP, DCOL) { constexpr int nblk = (NPAD) / 32; constexpr int cnt = ((Kk) / 64) * nblk; \
        if (r < cnt) { const int kb = r / nblk, nb = r % nblk, n0 = 32 * nb; tr_item(SRC, LDW, NVALID, (bf16*)(ws + (DST)), LDT, 64 * kb, n0, (ROWMAP), (DCOL), scr, lane); continue; } r -= cnt; }
#define TRM8(SRC, Kk, LDW, NN, DST, LDT, ROWMAP, SC) { constexpr int nblk = (NN) / 32; constexpr int cnt = ((Kk) / 64) * nblk; \
        if (r < cnt) { const int kb = r / nblk, nb = r % nblk, n0 = 32 * nb; tr_item8(SRC, LDW, (unsigned char*)(ws + (DST)), LDT, 64 * kb, n0, (ROWMAP), SC, scr, lane); continue; } r -= cnt; }
    long long* const vec = (long long*)(ws + WS_CTL + CTL_VEC);
#define TRML(SRC, Kk, LDW, NVALID, NPAD, DST, LDT, ROWMAP, GAIN, BVEC, VG, VB) { constexpr int nblk = (NPAD) / 32; constexpr int cnt = ((Kk) / 64) * nblk; \
        if (r < cnt) { const int kb = r / nblk, nb = r % nblk, n0 = 32 * nb; tr_item_ln(SRC, LDW, NVALID, (bf16*)(ws + (DST)), LDT, 64 * kb, n0, (ROWMAP), GAIN, BVEC, vec + (VG), vec + (VB), scr, lane); continue; } r -= cnt; }
#define TRML8(SRC, Kk, LDW, NN, DST, LDT, ROWMAP, SC, GAIN, BVEC, VG, VB) { constexpr int nblk = (NN) / 32; constexpr int cnt = ((Kk) / 64) * nblk; \
        if (r < cnt) { const int kb = r / nblk, nb = r % nblk, n0 = 32 * nb; tr_item8_ln(SRC, LDW, (unsigned char*)(ws + (DST)), LDT, 64 * kb, n0, (ROWMAP), SC, GAIN, BVEC, vec + (VG), vec + (VB), scr, lane); continue; } r -= cnt; }
    constexpr int N_TR = 2 * (32 * 176) + 88 * 64 + 32 * 184 + 2 * (32 * 64) + 256 + 2 * (16 * 64) + 32 * 64 + 32 * 16 + 32 * 32 + 8 * 64 + 2 * (32 * 176) + 88 * 64;
    for (int it = gw; it < N_TR; it += NGW) {
        int r = it;
        TRM8(in[2], 2048, 5632, 5632, WS_W_GU1, 2048, 256 * (n0 >> 7) + (n0 & 127), FP8_WGUS)
        TRM8(in[3], 2048, 5632, 5632, WS_W_GU1, 2048, 256 * (n0 >> 7) + 128 + (n0 & 127), FP8_WGUS)
        TRM8(in[4], 5632, 2048, 2048, WS_W_D1, 5632, n0, FP8_WDS)
        TRML(in[5], 2048, 5712, 5712, 5888, WS_W_IN, 2048, n0, in[22], in[23], V_GW_IN, V_BW_IN)
        TRML8(in[11], 2048, 2048, 2048, WS_W_G, 2048, 256 * (n0 >> 7) + (n0 & 127), FP8_WGS, in[22], in[23], V_GW_G, V_BW_G)
        TRML8(in[11] + (size_t)2048 * 2048, 2048, 2048, 2048, WS_W_G, 2048, 256 * (n0 >> 7) + 128 + (n0 & 127), FP8_WGS, in[22], in[23], V_GW_G, V_BW_G)
        if (r < 256) { const int h = r >> 5, rr = r & 31, kb = rr >> 2, nb = rr & 3;
            tr_item(in[10] + (size_t)h * 512 * 128, 128, 128, (bf16*)(ws + WS_W_UVP), 1024, 64 * kb, 32 * nb, (h >> 1) * 256 + (h & 1) * 128 + 32 * nb, (h & 1) * 512, scr, lane); continue; } r -= 256;
        TRM(in[13], 1024, 2048, 2048, 2048, WS_W_A, 1024, n0, 0)
        TRM(in[14], 1024, 2048, 2048, 2048, WS_W_B, 1024, n0, 0)
        TRM8(in[15], 2048, 2048, 2048, WS_W_MO, 2048, n0, FP8_WMOS)
        TRML(in[16], 2048, 512, 512, 512, WS_W_MQ, 2048, n0, in[22] + D, in[23] + D, V_GW_MQ, V_BW_MQ)
        TRM(in[17], 2048, 1024, 1024, 1024, WS_W_MKV, 2048, n0, 0)
        TRM(in[18], 512, 2048, 2048, 2048, WS_W_MOUT, 512, n0, 0)
        TRML8(in[19], 2048, 5632, 5632, WS_W_GU2, 2048, 256 * (n0 >> 7) + (n0 & 127), FP8_WGUS, in[22] + 2 * D, in[23] + 2 * D, V_GW_GU2, V_BW_GU2)
        TRML8(in[20], 2048, 5632, 5632, WS_W_GU2, 2048, 256 * (n0 >> 7) + 128 + (n0 & 127), FP8_WGUS, in[22] + 2 * D, in[23] + 2 * D, V_GW_GU2, V_BW_GU2)
        TRM8(in[21], 5632, 2048, 2048, WS_W_D2, 5632, n0, FP8_WDS)
    }
#undef TRM
#undef TRM8
#undef TRML
#undef TRML8
    for (int rw = gw; rw < 1024; rw += NGW) { const int e = (rw >> 7) & 1; *((GAS v4u*)((bf16*)(ws + WS_W_UVP) + (size_t)rw * 1024 + (1 - e) * 512) + lane) = (v4u){0u, 0u, 0u, 0u}; }
    for (int it = gw; it < (M * D) / 512; it += NGW) cvt_item8(in[0], (unsigned char*)(ws + WS_X8), it, lane, FP8_XS);
    for (int it = gw; it < (BATCH * MEMT * D) / 512; it += NGW) cvt_item(in[1], (bf16*)(ws + WS_MEM16), it, lane);
    for (int it = gw; it < (8 * 512 * 128) / 512; it += NGW) cvt_item(in[9], (bf16*)(ws + WS_W_UK), it, lane);
}

__device__ __forceinline__ void ln_phase(float* zx, bf16* x16, unsigned char* x8, const float* g, const float* b, int gw, int NGW, int lane) {
    f32x4 gv[8], bv[8];
#pragma unroll
    for (int j = 0; j < 8; ++j) { gv[j] = *((const GAS f32x4*)g + lane + 64 * j); bv[j] = *((const GAS f32x4*)b + lane + 64 * j); }
    for (int m = gw; m < M; m += NGW) {
        GAS f32x4* xr = (GAS f32x4*)(zx + (size_t)m * D) + lane;
        f32x4 v[8]; float s = 0.f;
#pragma unroll
        for (int j = 0; j < 8; ++j) { v[j] = xr[64 * j]; s += (v[j].x + v[j].y) + (v[j].z + v[j].w); }
        const float mean = wave_sum(s) * (1.f / D); float s2 = 0.f;
#pragma unroll
        for (int j = 0; j < 8; ++j) { v[j] = v[j] - mean; s2 += (v[j].x * v[j].x + v[j].y * v[j].y) + (v[j].z * v[j].z + v[j].w * v[j].w); }
        const float rstd = 1.f / sqrtf(wave_sum(s2) * (1.f / D) + LN_EPS);
#pragma unroll
        for (int j = 0; j < 8; ++j) { v[j] = v[j] * rstd * gv[j] + bv[j]; xr[64 * j] = v[j]; }
        if (x16) { GAS v2u* o8 = (GAS v2u*)(x16 + (size_t)m * D) + lane;
#pragma unroll
            for (int j = 0; j < 8; ++j) o8[64 * j] = (v2u){pk2(v[j].x, v[j].y), pk2(v[j].z, v[j].w)}; }
        if (x8) { GAS unsigned* o4 = (GAS unsigned*)(x8 + (size_t)m * D) + lane;
#pragma unroll
            for (int j = 0; j < 8; ++j) { const f32x4 q = v[j] * FP8_XS; int w = 0; w = __builtin_amdgcn_cvt_pk_fp8_f32(fminf(fmaxf(q.x, -448.f), 448.f), fminf(fmaxf(q.y, -448.f), 448.f), w, false);
                w = __builtin_amdgcn_cvt_pk_fp8_f32(fminf(fmaxf(q.z, -448.f), 448.f), fminf(fmaxf(q.w, -448.f), 448.f), w, true); o4[64 * j] = (unsigned)w; } }
    }
}
__device__ __forceinline__ void ln_final_phase(const bf16* z16, float* outp, const float* g, const float* b, int gw, int NGW, int lane) {
    for (int m = gw; m < M; m += NGW) {
        const GAS v4u* zr = (const GAS v4u*)(z16 + (size_t)m * D) + lane;
        float v[32]; float s = 0.f;
#pragma unroll
        for (int j = 0; j < 4; ++j) { const v4u w = zr[64 * j]; v[8 * j + 0] = blo(w.x); v[8 * j + 1] = bhi(w.x); v[8 * j + 2] = blo(w.y); v[8 * j + 3] = bhi(w.y); v[8 * j + 4] = blo(w.z); v[8 * j + 5] = bhi(w.z); v[8 * j + 6] = blo(w.w); v[8 * j + 7] = bhi(w.w); }
#pragma unroll
        for (int e = 0; e < 32; ++e) s += v[e];
        const float mean = wave_sum(s) * (1.f / D); float s2 = 0.f;
#pragma unroll
        for (int e = 0; e < 32; ++e) { v[e] -= mean; s2 += v[e] * v[e]; }
        const float rstd = 1.f / sqrtf(wave_sum(s2) * (1.f / D) + LN_EPS);
#pragma unroll
        for (int j = 0; j < 4; ++j) { const int c0 = 512 * j + 8 * lane;
            const f32x4 g0 = *(const GAS f32x4*)(g + c0), g1 = *(const GAS f32x4*)(g + c0 + 4), b0 = *(const GAS f32x4*)(b + c0), b1 = *(const GAS f32x4*)(b + c0 + 4);
            GAS f32x4* o = (GAS f32x4*)(outp + (size_t)m * D + c0);
            o[0] = (f32x4){v[8 * j + 0], v[8 * j + 1], v[8 * j + 2], v[8 * j + 3]} * rstd * g0 + b0; o[1] = (f32x4){v[8 * j + 4], v[8 * j + 5], v[8 * j + 6], v[8 * j + 7]} * rstd * g1 + b1; }
    }
}
__device__ __forceinline__ void crms_phase(bf16* bc, const float* kvg, int gw, int NGW, int lane) {
    float gg[8];
#pragma unroll
    for (int j = 0; j < 8; ++j) gg[j] = kvg[8 * lane + j];
    for (int m = gw; m < M; m += NGW) {
        GAS v4u* p = (GAS v4u*)(bc + (size_t)m * 512) + lane; const v4u w = *p;
        float x[8] = {blo(w.x), bhi(w.x), blo(w.y), bhi(w.y), blo(w.z), bhi(w.z), blo(w.w), bhi(w.w)}; float s = 0.f;
#pragma unroll
        for (int j = 0; j < 8; ++j) s += x[j] * x[j];
        const float r = 1.f / sqrtf(wave_sum(s) * (1.f / 512.f) + LN_EPS);
#pragma unroll
        for (int j = 0; j < 8; ++j) x[j] = x[j] * r * gg[j];
        *p = (v4u){pk2(x[0], x[1]), pk2(x[2], x[3]), pk2(x[4], x[5]), pk2(x[6], x[7])};
    }
}

typedef short v4i16_t __attribute__((ext_vector_type(4)));
__device__ __forceinline__ v4i16_t lds_tr16(const LAS unsigned char* p) { return __builtin_amdgcn_ds_read_tr16_b64_v4i16((LAS v4i16_t*)p); }
__device__ __forceinline__ unsigned cvtpk(float lo, float hi) { typedef float f2 __attribute__((ext_vector_type(2))); typedef __bf16 b2 __attribute__((ext_vector_type(2))); f2 v = {lo, hi}; b2 b = __builtin_convertvector(v, b2); return __builtin_bit_cast(unsigned, b); }
__device__ __forceinline__ float xhalf_f(float v) { return __shfl_xor(v, 32); }
constexpr float LOG2E = 1.4426950408889634f;
constexpr float QSCALE = 0.125f * LOG2E;

__device__ __forceinline__ void diff_attn_mfma(LAS unsigned char* lds, const bf16* AQ, const bf16* AK, const bf16* AV, bf16* YA, const float* dlam, const float* subg, int vcu, int G, const int wave) {
    const int lane = lane_fresh(), r32 = lane & 31, hi = lane >> 5;
    const int comp = wave >> 2, wq = wave & 3;
    const unsigned ksrc = (unsigned)(lane * 1024 + (2 * wave) * 8);
    const unsigned vsrc0 = (unsigned)((16 * ((2 * wave) & 3) + (lane >> 2)) * 1024 + ((2 * wave) >> 2) * 32 + (lane & 3) * 8);
    const unsigned vsrc1 = (unsigned)((16 * ((2 * wave + 1) & 3) + (lane >> 2)) * 1024 + ((2 * wave + 1) >> 2) * 32 + (lane & 3) * 8);
    const unsigned kdst = (unsigned)(2 * wave) * 1024u, vdst0 = 16384u + (unsigned)(((2 * wave) >> 2) * 4096 + ((2 * wave) & 3) * 1024), vdst1 = 16384u + (unsigned)(((2 * wave + 1) >> 2) * 4096 + ((2 * wave + 1) & 3) * 1024);
    const unsigned lds0 = (unsigned)(uintptr_t)lds;
#define DA_STAGE(bo, to) do { \
        glds16(Kg + (to) + ksrc, (unsigned)__builtin_amdgcn_readfirstlane((int)(lds0 + (bo) + kdst))); \
        glds16(Kg + (to) + ksrc + 8, (unsigned)__builtin_amdgcn_readfirstlane((int)(lds0 + (bo) + kdst + 1024))); \
        glds16(Vg + (to) + vsrc0, (unsigned)__builtin_amdgcn_readfirstlane((int)(lds0 + (bo) + vdst0))); \
        glds16(Vg + (to) + vsrc1, (unsigned)__builtin_amdgcn_readfirstlane((int)(lds0 + (bo) + vdst1))); } while (0)
#define DA_WAITBAR() asm volatile("s_waitcnt vmcnt(0) lgkmcnt(0)\n\ts_barrier" ::: "memory")
    const unsigned koff = (unsigned)(((comp * 8 + hi) * 64 + r32) * 16);
    const unsigned voff = (unsigned)(16384 + (4 * hi + ((lane & 15) >> 2)) * 64 + ((lane >> 4) & 1) * 32 + (lane & 3) * 8);
    for (int j = vcu; j < 1024; j += G) {
        const int w = j & 255, i = j >> 8, bh = w >> 3, s8 = w & 7;
        const int ub = (i == 0) ? s8 : (i == 1) ? 15 - s8 : (i == 2) ? 16 + s8 : 31 - s8;
        const int b = bh >> 3, h = bh & 7;
        const float sl2 = LOG2E / (float)(2 << h);
        const size_t rowbase = (size_t)b * SEQ; const int q0 = ub * 128;
        const int qpos = q0 + wq * 32 + r32;
        const int nt = 2 * ub + 2;
        const int myt = 2 * ub + 1 + (wq >> 1);
        const bf16* Kg = AK + rowbase * 1024 + h * 128; const bf16* Vg = AV + rowbase * 1024 + h * 128;
        bf16x8 qr[4];
#pragma unroll
        for (int s = 0; s < 4; ++s) qr[s] = *(const GAS bf16x8*)(AQ + (rowbase + qpos) * 1024 + h * 128 + comp * 64 + s * 16 + hi * 8);
        f32x16 o[4];
#pragma unroll
        for (int blk = 0; blk < 4; ++blk)
#pragma unroll
            for (int r = 0; r < 16; ++r) o[blk][r] = 0.f;
        float mrun = -INFINITY, lrun = 0.f;
        DA_STAGE(0u, (size_t)(nt - 1) * 64 * 1024);
        DA_WAITBAR();
        for (int st = 0; st < nt; ++st) {
            const int kt = nt - 1 - st;
            const unsigned bufo = (unsigned)(st & 1) * 32768u;
            if (kt > 0) DA_STAGE(32768u - bufo, (size_t)(kt - 1) * 64 * 1024);
            if (kt < myt) {
                const LAS unsigned char* Kb = lds + bufo + koff;
                f32x16 p0, p1;
#pragma unroll
                for (int r = 0; r < 16; ++r) { p0[r] = 0.f; p1[r] = 0.f; }
                { bf16x8 kf[4];
#pragma unroll
                  for (int s = 0; s < 4; ++s) kf[s] = *(const LAS bf16x8*)(Kb + s * 2048);
#pragma unroll
                  for (int s = 0; s < 4; ++s) p0 = __builtin_amdgcn_mfma_f32_32x32x16_bf16(kf[s], qr[s], p0, 0, 0, 0); }
                { bf16x8 kf[4];
#pragma unroll
                  for (int s = 0; s < 4; ++s) kf[s] = *(const LAS bf16x8*)(Kb + s * 2048 + 512);
#pragma unroll
                  for (int s = 0; s < 4; ++s) p1 = __builtin_amdgcn_mfma_f32_32x32x16_bf16(kf[s], qr[s], p1, 0, 0, 0); }
                const float qth = (float)(qpos - kt * 64 - 4 * hi);
                float rm = -INFINITY;
#pragma unroll
                for (int r = 0; r < 16; ++r) { const float kr = (float)((r & 3) + 8 * (r >> 2)); const float v0 = qth - kr, v1 = qth - (kr + 32.f);
                    p0[r] = p0[r] - sl2 * fabsf(v0); p1[r] = p1[r] - sl2 * fabsf(v1); rm = fmaxf(rm, fmaxf(p0[r], p1[r])); }
                rm = fmaxf(rm, xhalf_f(rm));
                if (__any(rm > mrun)) { const float mn = fmaxf(mrun, rm), f = __builtin_amdgcn_exp2f(mrun - mn); mrun = mn; lrun *= f;
#pragma unroll
                    for (int blk = 0; blk < 4; ++blk)
#pragma unroll
                        for (int r = 0; r < 16; ++r) o[blk][r] *= f; }
                float ls = 0.f;
#pragma unroll
                for (int r = 0; r < 16; ++r) { p0[r] = __builtin_amdgcn_exp2f(p0[r] - mrun); p1[r] = __builtin_amdgcn_exp2f(p1[r] - mrun); ls += p0[r] + p1[r]; }
                lrun += ls;
                bf16x8 pw[4];
#pragma unroll
                for (int s = 0; s < 2; ++s) {
                    v4u a = {cvtpk(p0[8 * s + 0], p0[8 * s + 1]), cvtpk(p0[8 * s + 2], p0[8 * s + 3]), cvtpk(p0[8 * s + 4], p0[8 * s + 5]), cvtpk(p0[8 * s + 6], p0[8 * s + 7])};
                    v4u c = {cvtpk(p1[8 * s + 0], p1[8 * s + 1]), cvtpk(p1[8 * s + 2], p1[8 * s + 3]), cvtpk(p1[8 * s + 4], p1[8 * s + 5]), cvtpk(p1[8 * s + 6], p1[8 * s + 7])};
                    pw[s] = __builtin_bit_cast(bf16x8, a); pw[2 + s] = __builtin_bit_cast(bf16x8, c); }
                const LAS unsigned char* Vb = lds + bufo + voff;
#pragma unroll
                for (int blk = 0; blk < 4; ++blk) {
#pragma unroll
                    for (int s = 0; s < 4; ++s) {
                        const v4i16_t lo = lds_tr16(Vb + blk * 4096 + s * 1024), hh = lds_tr16(Vb + blk * 4096 + s * 1024 + 512);
                        const bf16x8 vf = {lo[0], lo[1], lo[2], lo[3], hh[0], hh[1], hh[2], hh[3]};
                        o[blk] = __builtin_amdgcn_mfma_f32_32x32x16_bf16(vf, pw[s], o[blk], 0, 0, 0);
                    }
                }
            }
            DA_WAITBAR();
        }
        lrun += xhalf_f(lrun);
        const float inv = 1.f / lrun;
        LAS float* Y1 = (LAS float*)(lds) + wq * 4096;
        if (comp == 1) {
            float lam; { float a = dlam[lane] * dlam[64 + lane], bq_ = dlam[128 + lane] * dlam[192 + lane]; a = wave_sum(a); bq_ = wave_sum(bq_); lam = __expf(a) - __expf(bq_) + LAMBDA_INIT; }
            const float sc = inv * lam;
#pragma unroll
            for (int blk = 0; blk < 4; ++blk)
#pragma unroll
                for (int r = 0; r < 16; ++r) Y1[(32 * blk + (r & 3) + 8 * (r >> 2) + 4 * hi) * 32 + r32] = o[blk][r] * sc; }
        __syncthreads();
        if (comp == 0) {
            float ss = 0.f;
#pragma unroll
            for (int blk = 0; blk < 4; ++blk)
#pragma unroll
                for (int r = 0; r < 16; ++r) { const float a = o[blk][r] * inv - Y1[(32 * blk + (r & 3) + 8 * (r >> 2) + 4 * hi) * 32 + r32]; o[blk][r] = a; ss += a * a; }
            ss += xhalf_f(ss);
            const float rr = (1.0f - LAMBDA_INIT) / sqrtf(ss * (1.f / 128.f) + LN_EPS);
            LAS unsigned* stg = (LAS unsigned*)(lds + 65536) + wq * (32 * 65);
#pragma unroll
            for (int blk = 0; blk < 4; ++blk) {
#pragma unroll
                for (int r = 0; r < 16; r += 2) { const int e = 32 * blk + (r & 3) + 8 * (r >> 2) + 4 * hi;
                    stg[r32 * 65 + (e >> 1)] = cvtpk(o[blk][r] * rr * subg[e], o[blk][r + 1] * rr * subg[e + 1]); }
                asm volatile("" ::: "memory"); }
            LDS_WAIT(); asm volatile("" ::: "memory");
            bf16* orow = YA + (rowbase + q0 + wq * 32) * 1024 + h * 128;
#pragma unroll 4
            for (int row = 0; row < 32; ++row) *((GAS unsigned*)(orow + (size_t)row * 1024) + lane) = stg[row * 65 + lane];
        }
        __syncthreads();
    }
#undef DA_STAGE
#undef DA_WAITBAR
}

__device__ __forceinline__ unsigned okey(float f) { const unsigned u = __float_as_uint(f); return (u & 0x80000000u) ? ~u : (u | 0x80000000u); }
__device__ __forceinline__ void indexer_topk(LAS unsigned char* lds, const bf16* IQ, const bf16* IKW, unsigned short* IDX, int vcu, int G, const int wave) {
    const int lane = lane_fresh(), r32 = lane & 31, hi = lane >> 5;
    const unsigned lds0 = (unsigned)(uintptr_t)lds;
    const unsigned boff = (unsigned)((hi * 256 + r32) * 16);
    for (int j = vcu; j < 1024; j += G) {
        const int w = j & 255, i = j >> 8, bq = w >> 4, s16 = w & 15;
        const int chunk = (i == 0) ? s16 : (i == 1) ? 31 - s16 : (i == 2) ? 32 + s16 : 63 - s16;
        const int b = bq >> 2, gq = bq & 3;
        const int t0 = b * SEQ + chunk * 64 + gq * 16 + 2 * wave;
        const int ngroups = 2 * (chunk + 1);
        const int ntiles = (ngroups + 7) >> 3;
        const bf16* Kg = IKW + (size_t)b * SEQ * 256;
#define IX_STAGE(tile, bo) do { int tl_ = (tile); asm volatile("" : "+s"(tl_)); _Pragma("unroll") for (int i_ = 0; i_ < 4; ++i_) { const int q_ = 4 * wave + i_; \
            glds16s(Kg + (size_t)(tl_ * 256 + 64 * (q_ & 3)) * 256 + (q_ >> 2) * 8, (unsigned)lane * 512u, (unsigned)__builtin_amdgcn_readfirstlane((int)(lds0 + (bo) + ((q_ >> 2) * 256 + 64 * (q_ & 3)) * 16))); } } while (0)
        asm volatile("s_barrier" ::: "memory");
        IX_STAGE(0, 0u);
        bf16x8 a[4];
#pragma unroll
        for (int ks = 0; ks < 4; ++ks) a[ks] = *(const GAS bf16x8*)(IQ + (size_t)(t0 + (r32 >> 4)) * 1024 + (r32 & 15) * 64 + ks * 16 + 8 * hi);
        float wv[16];
        { const bf16* iwp = IKW + (size_t)t0 * 256 + 64 + 4 * hi;
          const v2u w00 = *(const GAS v2u*)(iwp), w01 = *(const GAS v2u*)(iwp + 8), w10 = *(const GAS v2u*)(iwp + 256), w11 = *(const GAS v2u*)(iwp + 256 + 8);
          wv[0] = blo(w00.x); wv[1] = bhi(w00.x); wv[2] = blo(w00.y); wv[3] = bhi(w00.y); wv[4] = blo(w01.x); wv[5] = bhi(w01.x); wv[6] = blo(w01.y); wv[7] = bhi(w01.y);
          wv[8] = blo(w10.x); wv[9] = bhi(w10.x); wv[10] = blo(w10.y); wv[11] = bhi(w10.y); wv[12] = blo(w11.x); wv[13] = bhi(w11.x); wv[14] = blo(w11.y); wv[15] = bhi(w11.y); }
        unsigned key[128];
#pragma unroll 128
        for (int g = 0; g < 128; ++g) {
            if (g < ngroups) {
                const unsigned bufo = (unsigned)((g >> 3) & 1) * 32768u;
                if ((g & 7) == 0) {
                    asm volatile("s_waitcnt vmcnt(0)\n\ts_barrier" ::: "memory");
                    if ((g >> 3) + 1 < ntiles) IX_STAGE((g >> 3) + 1, 32768u - bufo);
                }
                bf16x8 bk[4];
#pragma unroll
                for (int ks = 0; ks < 4; ++ks) bk[ks] = *(const LAS bf16x8*)(lds + bufo + boff + (g & 7) * 512 + ks * 8192);
                f32x16 acc = {0.f, 0.f, 0.f, 0.f, 0.f, 0.f, 0.f, 0.f, 0.f, 0.f, 0.f, 0.f, 0.f, 0.f, 0.f, 0.f};
#pragma unroll
                for (int ks = 0; ks < 4; ++ks) acc = __builtin_amdgcn_mfma_f32_32x32x16_bf16(a[ks], bk[ks], acc, 0, 0, 0);
                float s0 = 0.f, s1 = 0.f;
#pragma unroll
                for (int r = 0; r < 8; ++r) { s0 += wv[r] * fmaxf(acc[r], 0.f); s1 += wv[8 + r] * fmaxf(acc[8 + r], 0.f); }
                s0 += __shfl_xor(s0, 32); s1 += __shfl_xor(s1, 32);
                key[g] = okey(hi ? s1 : s0);
            } else key[g] = 0u;
        }
        unsigned T = 0u;
        if (chunk >= 4) {
            bool done = false;
#pragma nounroll
            for (int bit = 31; bit >= 0; --bit) {
                if (__all(done ? 1 : 0)) break;
                const unsigned trial = T | (1u << bit);
                int cnt = 0;
#pragma unroll
                for (int g = 0; g < 128; ++g) cnt += (key[g] >= trial) ? 1 : 0;
                cnt += __shfl_xor(cnt, 1); cnt += __shfl_xor(cnt, 2); cnt += __shfl_xor(cnt, 4); cnt += __shfl_xor(cnt, 8); cnt += __shfl_xor(cnt, 16);
                if (!done && cnt >= 256) { T = trial; if (cnt == 256) done = true; }
            }
        }
        int base = 0;
        unsigned short* ip = IDX + (size_t)(t0 + hi) * 256;
#pragma unroll
        for (int g = 0; g < 128; ++g) {
            if (g < ngroups) {
                const bool sel = key[g] >= T;
                const unsigned long long mk = __ballot(sel ? 1 : 0);
                const unsigned mh = hi ? (unsigned)(mk >> 32) : (unsigned)mk;
                const int pos = base + __popc(mh & ((1u << r32) - 1u));
                if (sel && pos < 256) ip[pos] = (unsigned short)(32 * g + r32);
                base += __popc(mh);
            }
        }
    }
#undef IX_STAGE
    asm volatile("s_waitcnt vmcnt(0) lgkmcnt(0)\n\ts_barrier" ::: "memory");
}

__device__ __forceinline__ bf16x8 dpp_shl8(bf16x8 v) {
    v4u u = __builtin_bit_cast(v4u, v);
    u.x = (unsigned)__builtin_amdgcn_update_dpp(0, (int)u.x, 0x108, 0xf, 0xf, true); u.y = (unsigned)__builtin_amdgcn_update_dpp(0, (int)u.y, 0x108, 0xf, 0xf, true);
    u.z = (unsigned)__builtin_amdgcn_update_dpp(0, (int)u.z, 0x108, 0xf, 0xf, true); u.w = (unsigned)__builtin_amdgcn_update_dpp(0, (int)u.w, 0x108, 0xf, 0xf, true);
    return __builtin_bit_cast(bf16x8, u); }
constexpr int DSA_ROWB = 1040;
constexpr int DSA_WAVEB = 16 * DSA_ROWB + 512;
constexpr int DSA_LDS_END = 8 * DSA_WAVEB;
__device__ __forceinline__ void dsa_mfma(LAS unsigned char* lds, const bf16* QL, bf16* OL, const int omask, const bf16* C, const unsigned short* IDX, int vcu, int G, const int wave) {
    const int lane = lane_fresh(), h16 = lane & 15, g = lane >> 4;
    LAS unsigned char* wl = lds + wave * DSA_WAVEB;
    const unsigned wl0 = (unsigned)(uintptr_t)wl;
    LAS unsigned short* idxs = (LAS unsigned short*)(wl + 16 * DSA_ROWB);
    const float sc2 = 0.08838834764831845f * LOG2E;
    const float sl2 = (h16 < 8) ? LOG2E / (float)(2 << (h16 & 7)) : 0.f;
    const int ntok = (G == 256) ? 8 : (M - (vcu * 8 + wave) + G * 8 - 1) / (G * 8);
#define DSA_TOK(i) ((G == 256) ? ((vcu >> 6) * SEQ + (vcu & 63) + 64 * (wave + 8 * (i))) : (vcu * 8 + wave + G * 8 * (i)))
    const unsigned qk_off = (unsigned)(h16 * DSA_ROWB + 16 * g);
    const unsigned pv_off = (unsigned)((4 * g + (h16 >> 2)) * DSA_ROWB + 8 * (lane & 3));
    for (int it = 0; it < ntok; ++it) {
        const int t = DSA_TOK(it); const int tpos = t & (SEQ - 1);
        const int n = (tpos >> 6) >= 3 ? 256 : 64 * ((tpos >> 6) + 1); const int nst = n >> 4;
        const bf16* Cb = C + (size_t)(t >> 12) * SEQ * 512;
        int ln = lane; asm volatile("" : "+v"(ln));
        const int h16b = ln & 15, gb = ln >> 4;
        { const v2u iv = __builtin_nontemporal_load((const GAS v2u*)(IDX + (size_t)t * 256) + ln); *((LAS v2u*)idxs + ln) = iv; }
        bf16x8 qf[8];
#pragma unroll
        for (int s = 0; s < 8; ++s) qf[s] = __builtin_nontemporal_load((const GAS bf16x8*)(QL + (size_t)t * 4096 + (h16b & 7) * 512 + 32 * (s + 8 * (h16b >> 3)) + 8 * gb));
        f32x4 o[32];
#pragma unroll
        for (int blk = 0; blk < 32; ++blk) o[blk] = (f32x4){0.f, 0.f, 0.f, 0.f};
        float mrun = -INFINITY, lrun = 0.f;
        asm volatile("s_waitcnt vmcnt(0) lgkmcnt(0)" ::: "memory");
        for (int st = 0; st < nst; ++st) {
            { const v4u i0 = *(const LAS v4u*)(idxs + st * 16), i1 = *(const LAS v4u*)(idxs + st * 16 + 8);
              const unsigned iw[8] = {i0.x, i0.y, i0.z, i0.w, i1.x, i1.y, i1.z, i1.w};
#pragma unroll
              for (int i = 0; i < 16; ++i) { const int s_ = __builtin_amdgcn_readfirstlane((int)((iw[i >> 1] >> ((i & 1) * 16)) & 0xffffu));
                  glds16s(Cb + (size_t)s_ * 512, (unsigned)lane * 16u, (unsigned)__builtin_amdgcn_readfirstlane((int)(wl0 + i * DSA_ROWB))); } }
            asm volatile("s_waitcnt vmcnt(0)" ::: "memory");
            f32x4 acc = {0.f, 0.f, 0.f, 0.f};
#pragma unroll
            for (int s = 0; s < 8; ++s) { const bf16x8 a = *(const LAS bf16x8*)(wl + qk_off + 64 * s); acc = __builtin_amdgcn_mfma_f32_16x16x32_bf16(a, qf[s], acc, 0, 0, 0); }
#pragma unroll
            for (int s = 0; s < 8; ++s) { const bf16x8 a = *(const LAS bf16x8*)(wl + qk_off + 64 * (s + 8)); acc = __builtin_amdgcn_mfma_f32_16x16x32_bf16(a, dpp_shl8(qf[s]), acc, 0, 0, 0); }
            const v2u iq = *(const LAS v2u*)(idxs + st * 16 + 4 * g);
            const int sidx[4] = {(int)(iq.x & 0xffffu), (int)(iq.x >> 16), (int)(iq.y & 0xffffu), (int)(iq.y >> 16)};
            float lg[4];
#pragma unroll
            for (int r = 0; r < 4; ++r) { const int d = tpos - sidx[r]; lg[r] = acc[r] * sc2 - sl2 * (float)(d < 0 ? -d : d); }
            float rm = fmaxf(fmaxf(lg[0], lg[1]), fmaxf(lg[2], lg[3]));
            rm = fmaxf(rm, __shfl_xor(rm, 16)); rm = fmaxf(rm, __shfl_xor(rm, 32));
            const float mn = fmaxf(mrun, rm), f = __builtin_amdgcn_exp2f(mrun - mn); mrun = mn;
#pragma unroll
            for (int r = 0; r < 4; ++r) lg[r] = __builtin_amdgcn_exp2f(lg[r] - mn);
            lrun = lrun * f + ((lg[0] + lg[1]) + (lg[2] + lg[3]));
            const v4u pwu = {cvtpk(lg[0], lg[1]), cvtpk(lg[2], lg[3]), 0u, 0u};
            const bf16x8 pw = __builtin_bit_cast(bf16x8, pwu);
#pragma unroll
            for (int blk = 0; blk < 32; ++blk) {
                const v4i16_t lo = lds_tr16(wl + pv_off + 32 * blk);
                const bf16x8 af = {lo[0], lo[1], lo[2], lo[3], lo[0], lo[1], lo[2], lo[3]};
                o[blk] = __builtin_amdgcn_mfma_f32_16x16x32_bf16(af, pw, o[blk] * f, 0, 0, 0);
                if ((blk & 3) == 3) __builtin_amdgcn_sched_barrier(0);
            }
        }
        float lt = lrun; lt += __shfl_xor(lt, 16); lt += __shfl_xor(lt, 32);
        const float inv = 1.f / lt;
        if (h16 < 8) {
#pragma unroll
            for (int blk = 0; blk < 32; ++blk) { const f32x4 v = o[blk] * inv;
                __builtin_nontemporal_store((v2u){cvtpk(v.x, v.y), cvtpk(v.z, v.w)}, (GAS v2u*)(OL + (size_t)(t & omask) * 4096 + h16b * 512 + 16 * blk + 4 * gb)); } }
    }
    asm volatile("s_waitcnt vmcnt(0) lgkmcnt(0)" ::: "memory");
    __syncthreads();
#undef DSA_TOK
}
static_assert(DSA_LDS_END <= RING_BYTES, "DSA LDS map");

__device__ __forceinline__ void memattn_mfma(LAS unsigned char* lds, const bf16* QM, const bf16* KV, bf16* OM, int vcu, int G, const int wave) {
    const int lane = lane_fresh(), r32 = lane & 31, hi = lane >> 5;
    const unsigned voff = (unsigned)(65536 + (4 * hi + ((lane & 15) >> 2)) * 64 + ((lane >> 4) & 1) * 32 + (lane & 3) * 8);
    for (int j = vcu; j < 256; j += G) {
        const int bh = j >> 4, qb = j & 15, b = bh >> 2, h = bh & 3;
        const bf16* Kg = KV + (size_t)b * MEMT * 1024 + h * 128; const bf16* Vg = Kg + 512;
#pragma unroll
        for (int i = 0; i < 8; ++i) { const int q = 8 * wave + i;
            glds16(Kg + (size_t)(64 * (q & 3) + lane) * 1024 + (q >> 2) * 8, (unsigned)__builtin_amdgcn_readfirstlane((int)((unsigned)(uintptr_t)lds + ((q >> 2) * 256 + 64 * (q & 3)) * 16)));
            glds16(Vg + (size_t)(16 * (q & 15) + (lane >> 2)) * 1024 + (q >> 4) * 32 + (lane & 3) * 8, (unsigned)__builtin_amdgcn_readfirstlane((int)((unsigned)(uintptr_t)lds + 65536 + (q >> 4) * 16384 + (q & 15) * 1024))); }
        const size_t qrow = (size_t)b * SEQ + qb * 256 + wave * 32 + r32;
        bf16x8 qr[8];
#pragma unroll
        for (int s = 0; s < 8; ++s) qr[s] = *(const GAS bf16x8*)(QM + qrow * 512 + h * 128 + s * 16 + hi * 8);
        f32x16 o[4];
#pragma unroll
        for (int blk = 0; blk < 4; ++blk)
#pragma unroll
            for (int r = 0; r < 16; ++r) o[blk][r] = 0.f;
        float mrun = -INFINITY, lrun = 0.f;
        asm volatile("s_waitcnt vmcnt(0) lgkmcnt(0)\n\ts_barrier" ::: "memory");
        for (int kt = 0; kt < 4; ++kt) {
            const LAS unsigned char* Kb = lds + (unsigned)((hi * 256 + 64 * kt + r32) * 16);
            f32x16 p0, p1;
#pragma unroll
            for (int r = 0; r < 16; ++r) { p0[r] = 0.f; p1[r] = 0.f; }
#pragma unroll
            for (int s = 0; s < 8; ++s) { const bf16x8 k0 = *(const LAS bf16x8*)(Kb + s * 8192), k1 = *(const LAS bf16x8*)(Kb + s * 8192 + 512);
                p0 = __builtin_amdgcn_mfma_f32_32x32x16_bf16(k0, qr[s], p0, 0, 0, 0); p1 = __builtin_amdgcn_mfma_f32_32x32x16_bf16(k1, qr[s], p1, 0, 0, 0); }
            float rm = -INFINITY;
#pragma unroll
            for (int r = 0; r < 16; ++r) rm = fmaxf(rm, fmaxf(p0[r], p1[r]));
            rm = fmaxf(rm, xhalf_f(rm));
            if (__any(rm > mrun)) { const float mn = fmaxf(mrun, rm), f = __builtin_amdgcn_exp2f(mrun - mn); mrun = mn; lrun *= f;
#pragma unroll
                for (int blk = 0; blk < 4; ++blk)
#pragma unroll
                    for (int r = 0; r < 16; ++r) o[blk][r] *= f; }
            float ls = 0.f;
#pragma unroll
            for (int r = 0; r < 16; ++r) { p0[r] = __builtin_amdgcn_exp2f(p0[r] - mrun); p1[r] = __builtin_amdgcn_exp2f(p1[r] - mrun); ls += p0[r] + p1[r]; }
            lrun += ls;
            bf16x8 pw[4];
#pragma unroll
            for (int s = 0; s < 2; ++s) {
                v4u a = {cvtpk(p0[8 * s + 0], p0[8 * s + 1]), cvtpk(p0[8 * s + 2], p0[8 * s + 3]), cvtpk(p0[8 * s + 4], p0[8 * s + 5]), cvtpk(p0[8 * s + 6], p0[8 * s + 7])};
                v4u c = {cvtpk(p1[8 * s + 0], p1[8 * s + 1]), cvtpk(p1[8 * s + 2], p1[8 * s + 3]), cvtpk(p1[8 * s + 4], p1[8 * s + 5]), cvtpk(p1[8 * s + 6], p1[8 * s + 7])};
                pw[s] = __builtin_bit_cast(bf16x8, a); pw[2 + s] = __builtin_bit_cast(bf16x8, c); }
            const LAS unsigned char* Vb = lds + voff + kt * 4096;
#pragma unroll
            for (int blk = 0; blk < 4; ++blk) {
#pragma unroll
                for (int s = 0; s < 4; ++s) {
                    const v4i16_t lo = lds_tr16(Vb + blk * 16384 + s * 1024), hh = lds_tr16(Vb + blk * 16384 + s * 1024 + 512);
                    const bf16x8 vf = {lo[0], lo[1], lo[2], lo[3], hh[0], hh[1], hh[2], hh[3]};
                    o[blk] = __builtin_amdgcn_mfma_f32_32x32x16_bf16(vf, pw[s], o[blk], 0, 0, 0);
                }
            }
        }
        __syncthreads();
        lrun += xhalf_f(lrun);
        const float inv = 1.f / lrun;
        LAS unsigned* stg = (LAS unsigned*)(lds) + wave * (32 * 65);
#pragma unroll
        for (int blk = 0; blk < 4; ++blk)
#pragma unroll
            for (int r = 0; r < 16; r += 2) { const int e = 32 * blk + (r & 3) + 8 * (r >> 2) + 4 * hi;
                stg[r32 * 65 + (e >> 1)] = cvtpk(o[blk][r] * inv, o[blk][r + 1] * inv); }
        LDS_WAIT(); asm volatile("" ::: "memory");
        bf16* orow = OM + ((size_t)b * SEQ + qb * 256 + wave * 32) * 512 + h * 128;
#pragma unroll 4
        for (int row = 0; row < 32; ++row) *((GAS unsigned*)(orow + (size_t)row * 512) + lane) = stg[row * 65 + lane];
        __syncthreads();
    }
}

constexpr int N_PHASES = 21;
struct Args { const float* in[24]; float* out; unsigned char* ws; int ph_lo, ph_hi; };
__global__ void __launch_bounds__(NWAVES * 64, 2) mk_fwd(Args args) {
    extern __shared__ __attribute__((aligned(16))) unsigned char lds_raw[];
    LAS unsigned char* lds = (LAS unsigned char*)lds_raw;
    volatile LAS unsigned* MISC = (volatile LAS unsigned*)(lds + MISC_OFF);
    const int tid = threadIdx.x, wave = __builtin_amdgcn_readfirstlane(tid >> 6);
#define lane lane_fresh()
    const int G = gridDim.x, bx = blockIdx.x;
    const int vcu = (G % 8 == 0) ? (bx % 8) * (G / 8) + bx / 8 : bx;
    const int gw = vcu * NWAVES + wave, NGW = G * NWAVES;
    unsigned char* ws = args.ws;
    gu32* ctl = (gu32*)(ws + WS_CTL);
    for (int u = tid; u < (LDS_BYTES - LDSCTL_OFF) / 4; u += NWAVES * 64) ((LAS unsigned*)(lds + LDSCTL_OFF))[u] = 0u;
    __syncthreads();
    const bool one = (args.ph_hi - args.ph_lo) > 1;
    XcdBarrier bar; bar.bar = (unsigned*)(ctl + CW_BAR); bar.x = 0; bar.st = nullptr;
    if (one) bar = xcd_barrier_post((unsigned*)(ctl + CW_BAR), MISC + 8, tid == 0);
    const int lo = args.ph_lo, hi = args.ph_hi;
#ifndef PH_MASK
#define PH_MASK 0xFFFFFFFFu
#endif
#define IN(k) ((((PH_MASK) >> (k)) & 1u) && lo <= (k) && (k) < hi)
#define SEAM(k) do { if (IN(k) && IN((k) + 1)) xcd_barrier(bar, wave); } while (0)
    bf16* const X16 = (bf16*)(ws + WS_X16); bf16* const HB = (bf16*)(ws + WS_H);
    long long* const ST0 = (long long*)(ws + WS_CTL + CTL_STATS); long long* const ST1 = (long long*)(ws + WS_CTL + CTL_STATS + CTL_STATS_STRIDE); long long* const ST2 = (long long*)(ws + WS_CTL + CTL_STATS + 2 * CTL_STATS_STRIDE);
    const float* const VEC = (const float*)(ws + WS_CTL + CTL_VECF);
    float* const out = args.out;
    const float* const ln_g = args.in[22]; const float* const ln_b = args.in[23];
    using namespace pg8;

#ifdef PROBE_P0
    if (IN(0)) { p0_prologue(args.in, ws, lds, gw, NGW, wave, lane); }
#endif
    if (IN(0)) { p0_prologue(args.in, ws, lds, gw, NGW, wave, lane); }
    SEAM(0);
    if (IN(1)) { { const long long* vi = (const long long*)(ws + WS_CTL + CTL_VEC); float* vf = (float*)(ws + WS_CTL + CTL_VECF); for (int i = gw * 64 + lane; i < V_END; i += NGW * 64) vf[i] = (float)vi[i] * (1.0f / 16777216.f); }
        Gemm g{(const bf16*)(ws + WS_X8), (const bf16*)(ws + WS_W_GU1), D / 2, D / 2, D / 2, 0, 0}; StaticOrder S; S.init(M, 2 * FF, G, bx); EpiSwiGLU8 E{(unsigned char*)HB, FF, 1.0f / (FP8_XS * FP8_WGUS), FP8_HS, LnFold{nullptr, nullptr, nullptr}};
        gemm_phase<EpiSwiGLU8, StaticOrder, true, true>(lds + RING_OFF, g, S, E, wave); }
    SEAM(1);
    if (IN(2)) { Gemm g{HB, (const bf16*)(ws + WS_W_D1), FF / 2, FF / 2, FF / 2, 0, 0}; StaticOrder S; S.init(M, D, G, bx); EpiRes E{args.in[0], nullptr, D, ALPHA, 0.5f / (FP8_HS * FP8_WDS), nullptr, nullptr, nullptr, ST0, X16, (unsigned char*)(ws + WS_X8M), FP8_XS};
        gemm_phase<EpiRes, StaticOrder, true, true>(lds + RING_OFF, g, S, E, wave); }
    SEAM(2);
    if (IN(4)) {
        { Gemm g{X16, (const bf16*)(ws + WS_W_IN), D, D, D, 0, 0}; StaticOrder S; S.init(M, N_IN, G, bx);
          EpiInProj E{(bf16*)(ws + WS_AQ), (bf16*)(ws + WS_AK), (bf16*)(ws + WS_AV), (bf16*)(ws + WS_BQ), (bf16*)(ws + WS_BC), (bf16*)(ws + WS_IQ), (bf16*)(ws + WS_IKW), QSCALE, LnFold{ST0, VEC + V_GW_IN, VEC + V_BW_IN}};
          gemm_phase<EpiInProj, StaticOrder, true>(lds + RING_OFF, g, S, E, wave); }
        { Gemm g{(const bf16*)(ws + WS_MEM16), (const bf16*)(ws + WS_W_MKV), D, D, D, 0, 0}; StaticOrder S; S.init(BATCH * MEMT, 1024, G, bx >= G - 16 ? bx - (G - 16) : (1 << 20)); EpiBf16 E{(bf16*)(ws + WS_KVMEM), 1024};
          gemm_phase<EpiBf16, StaticOrder, true>(lds + RING_OFF, g, S, E, wave); }
    }
    SEAM(4);
    if (IN(5)) {
        { Gemm g{(const bf16*)(ws + WS_BQ), (const bf16*)(ws + WS_W_UK), 1024, 128, 128, 1, 128}; StaticOrder S; S.init(M, 4096, G, bx); EpiBf16 E{(bf16*)(ws + WS_QLAT), 4096};
          gemm_phase<EpiBf16, StaticOrder, true>(lds + RING_OFF, g, S, E, wave); }
        crms_phase((bf16*)(ws + WS_BC), args.in[8], gw, NGW, lane);
    }
#ifdef PROBE_P6
    if (IN(6)) diff_attn_mfma(lds, (const bf16*)(ws + WS_AQ), (const bf16*)(ws + WS_AK), (const bf16*)(ws + WS_AV), (bf16*)(ws + WS_BQ), args.in[6], args.in[7], vcu, G, wave);
#endif
    if (IN(6)) diff_attn_mfma(lds, (const bf16*)(ws + WS_AQ), (const bf16*)(ws + WS_AK), (const bf16*)(ws + WS_AV), (bf16*)(ws + WS_AQ), args.in[6], args.in[7], vcu, G, wave);
    if (IN(7)) indexer_topk(lds, (const bf16*)(ws + WS_IQ), (const bf16*)(ws + WS_IKW), (unsigned short*)(ws + WS_IDX), vcu, G, wave);
    SEAM(7);
#ifdef PROBE_P8
    if (IN(8)) dsa_mfma(lds, (const bf16*)(ws + WS_QLAT), (bf16*)(ws + WS_AV), 1023, (const bf16*)(ws + WS_BC), (const unsigned short*)(ws + WS_IDX), vcu, G, wave);
#endif
    if (IN(8)) dsa_mfma(lds, (const bf16*)(ws + WS_QLAT), (bf16*)(ws + WS_QLAT), 0x7fffffff, (const bf16*)(ws + WS_BC), (const unsigned short*)(ws + WS_IDX), vcu, G, wave);
    SEAM(8);
    if (IN(9)) { Gemm g{(const bf16*)(ws + WS_QLAT), (const bf16*)(ws + WS_W_UVP), 4096, 1024, 1024, 0, 1024}; StaticOrder S; S.init(M, 1024, G, bx); EpiBf16 E{(bf16*)(ws + WS_YB), 1024};
        gemm_phase<EpiBf16, StaticOrder, true>(lds + RING_OFF, g, S, E, wave); }
    SEAM(9);
    if (IN(10)) {
        { Gemm g{(const bf16*)(ws + WS_AQ), (const bf16*)(ws + WS_W_A), 1024, 1024, 1024, 0, 0}; StaticOrder S; S.init(M, D, G, bx); EpiBf16 E{(bf16*)(ws + WS_TA), D}; gemm_phase<EpiBf16, StaticOrder, true>(lds + RING_OFF, g, S, E, wave); }
        { Gemm g{(const bf16*)(ws + WS_YB), (const bf16*)(ws + WS_W_B), 1024, 1024, 1024, 0, 0}; StaticOrder S; S.init(M, D, G, bx); EpiBf16 E{(bf16*)(ws + WS_TB), D}; gemm_phase<EpiBf16, StaticOrder, true>(lds + RING_OFF, g, S, E, wave); }
    }
    SEAM(10);
    if (IN(11)) { Gemm g{(const bf16*)(ws + WS_X8M), (const bf16*)(ws + WS_W_G), D / 2, D / 2, D / 2, 0, 0}; StaticOrder S; S.init(M, 2 * D, G, bx);
        EpiGateMerge8 E{(const bf16*)(ws + WS_TA), (const bf16*)(ws + WS_TB), (unsigned char*)(ws + WS_MRG8), D, args.in[12], args.in[12] + D, 1.0f / (FP8_XS * FP8_WGS), FP8_MS, LnFold{ST0, VEC + V_GW_G, VEC + V_BW_G}};
        gemm_phase<EpiGateMerge8, StaticOrder, true, true>(lds + RING_OFF, g, S, E, wave); }
    SEAM(11);
    if (IN(12)) { Gemm g{(const bf16*)(ws + WS_MRG8), (const bf16*)(ws + WS_W_MO), D / 2, D / 2, D / 2, 0, 0}; StaticOrder S; S.init(M, D, G, bx); EpiRes E{nullptr, X16, D, ALPHA, 1.0f / (FP8_MS * FP8_WMOS), ST0, ln_g, ln_b, ST1, X16, nullptr, 0.f};
        gemm_phase<EpiRes, StaticOrder, true, true>(lds + RING_OFF, g, S, E, wave); }
    SEAM(12);
    if (IN(14)) { Gemm g{X16, (const bf16*)(ws + WS_W_MQ), D, D, D, 0, 0}; StaticOrder S; S.init(M, 512, G, bx); EpiBf16 E{(bf16*)(ws + WS_QM), 512, 0.08838834764831845f * LOG2E, LnFold{ST1, VEC + V_GW_MQ, VEC + V_BW_MQ}}; gemm_phase<EpiBf16, StaticOrder, true>(lds + RING_OFF, g, S, E, wave); }
    SEAM(14);
    if (IN(15)) memattn_mfma(lds, (const bf16*)(ws + WS_QM), (const bf16*)(ws + WS_KVMEM), (bf16*)(ws + WS_OM), vcu, G, wave);
    SEAM(15);
    if (IN(16)) { Gemm g{(const bf16*)(ws + WS_OM), (const bf16*)(ws + WS_W_MOUT), 512, 512, 512, 0, 0}; StaticOrder S; S.init(M, D, G, bx); EpiRes E{nullptr, X16, D, ALPHA, 1.0f, ST1, ln_g + D, ln_b + D, ST2, X16, (unsigned char*)(ws + WS_X8), FP8_XS};
        gemm_phase<EpiRes, StaticOrder, true>(lds + RING_OFF, g, S, E, wave); }
    SEAM(16);
    if (IN(18)) { Gemm g{(const bf16*)(ws + WS_X8), (const bf16*)(ws + WS_W_GU2), D / 2, D / 2, D / 2, 0, 0}; StaticOrder S; S.init(M, 2 * FF, G, bx); EpiSwiGLU8 E{(unsigned char*)HB, FF, 1.0f / (FP8_XS * FP8_WGUS), FP8_HS, LnFold{ST2, VEC + V_GW_GU2, VEC + V_BW_GU2}};
        gemm_phase<EpiSwiGLU8, StaticOrder, true, true>(lds + RING_OFF, g, S, E, wave); }
    SEAM(18);
    if (IN(19)) { Gemm g{HB, (const bf16*)(ws + WS_W_D2), FF / 2, FF / 2, FF / 2, 0, 0}; StaticOrder S; S.init(M, D, G, bx); EpiRes E{nullptr, X16, D, ALPHA, 0.5f / (FP8_HS * FP8_WDS), ST2, ln_g + 2 * D, ln_b + 2 * D, nullptr, X16, nullptr, 0.f};
        gemm_phase<EpiRes, StaticOrder, true, true>(lds + RING_OFF, g, S, E, wave); }
    SEAM(19);
    if (IN(20)) ln_final_phase(X16, out, ln_g + 3 * D, ln_b + 3 * D, gw, NGW, lane);
#undef IN
#undef SEAM
#undef lane
}

extern "C" void kernel_launch(void* const* d_in, const int* in_sizes, int n_in, void* d_out, int out_size, void* d_ws, size_t ws_size, hipStream_t stream) {
    static int grid = 0;
    if (grid == 0) {
        if (n_in != 24 || in_sizes[0] != M * D || out_size != M * D || ws_size < WS_END) { fprintf(stderr, "kernel_launch: unexpected shapes (n_in %d, in0 %d, out %d, ws %zu); nothing launched\n", n_in, n_in > 0 ? in_sizes[0] : -1, out_size, ws_size); grid = -1; return; }
        int dev = 0, cus = 0, per_cu = 0;
        if (hipGetDevice(&dev) != hipSuccess || hipDeviceGetAttribute(&cus, hipDeviceAttributeMultiprocessorCount, dev) != hipSuccess) { grid = -1; return; }
        if (hipFuncSetAttribute((const void*)mk_fwd, hipFuncAttributeMaxDynamicSharedMemorySize, LDS_BYTES) != hipSuccess) { fprintf(stderr, "kernel_launch: hipFuncSetAttribute failed\n"); grid = -1; return; }
        if (hipOccupancyMaxActiveBlocksPerMultiprocessor(&per_cu, (const void*)mk_fwd, NWAVES * 64, LDS_BYTES) != hipSuccess || per_cu < 1)
            fprintf(stderr, "kernel_launch: note: the occupancy query reports %d workgroups per CU\n", per_cu);
        (void)hipGetLastError();
        grid = cus;
    }
    if (grid < 0) return;
    if (hipMemsetAsync((char*)d_ws + WS_CTL, 0, CTL_ZERO_BYTES, stream) != hipSuccess) return;
    Args a{};
    for (int i = 0; i < 24; ++i) a.in[i] = (const float*)d_in[i];
    a.out = (float*)d_out; a.ws = (unsigned char*)d_ws;
#if MK_ONE_LAUNCH
    a.ph_lo = 0; a.ph_hi = N_PHASES;
    hipLaunchKernelGGL(mk_fwd, dim3(grid), dim3(NWAVES * 64), LDS_BYTES, stream, a);
#else
    for (int p = 0; p < N_PHASES; ++p) { a.ph_lo = p; a.ph_hi = p + 1; hipLaunchKernelGGL(mk_fwd, dim3(grid), dim3(NWAVES * 64), LDS_BYTES, stream, a); }
#endif
}
```

```cpp
#include <hip/hip_runtime.h>
#include <cstdio>
#include <cstdint>

#ifndef MK_ONE_LAUNCH
#define MK_ONE_LAUNCH 1
#endif

__device__ __forceinline__ int lane_fresh() { int l = (int)__builtin_amdgcn_mbcnt_hi(~0u, __builtin_amdgcn_mbcnt_lo(~0u, 0u)); asm volatile("" : "+v"(l)); return l; }
__device__ __forceinline__ void glds16(const void* gsrc, unsigned lds_dst) { unsigned keep;
    asm volatile("s_mov_b32 %0, m0\n\ts_mov_b32 m0, %2\n\ts_nop 0\n\tglobal_load_lds_dwordx4 %1, off\n\ts_mov_b32 m0, %0" : "=&s"(keep) : "v"(gsrc), "s"(lds_dst) : "memory"); }
__device__ __forceinline__ void glds16s(const void* sbase, unsigned voff, unsigned lds_dst) { unsigned keep;
    asm volatile("s_mov_b32 %0, m0\n\ts_mov_b32 m0, %3\n\ts_nop 0\n\tglobal_load_lds_dwordx4 %1, %2\n\ts_mov_b32 m0, %0" : "=&s"(keep) : "v"(voff), "s"(sbase), "s"(lds_dst) : "memory"); }
namespace pg8 {
#define PG8_LAS __attribute__((address_space(3)))
typedef unsigned short bf16_t;
typedef short bf16x8 __attribute__((ext_vector_type(8)));
typedef float f32x4 __attribute__((ext_vector_type(4)));
typedef unsigned u32x4 __attribute__((ext_vector_type(4)));
constexpr int BM = 256, BK = 64, HALF = 128, HTB = HALF * BK * 2  , STAGE_BYTES = 8 * HTB, NXCD = 8, WGM = 8;

__host__ __device__ __forceinline__ int lds_byte(int r, int c) { const int st = (r >> 4) * 2 + (c >> 5), rr = r & 15, cc = c & 31, ob = rr * 64 + cc * 2; return st * 1024 + (ob ^ (((ob >> 9) & 1) << 5)); }
__host__ __device__ __forceinline__ void stage_rc(int b, int& R, int& C) { const int st = b / 1024, sb = b % 1024, swz = sb ^ (((sb >> 9) & 1) << 5); R = (st >> 1) * 16 + swz / 64; C = (st & 1) * 32 + (swz % 64) / 2; }
__host__ __device__ __forceinline__ int perm32(int rho) { const int n = rho >> 4, i = rho & 15; return 8 * (i >> 2) + 4 * n + (i & 3); }

struct Unit { int pm, pn; };
struct Gemm { const bf16_t* A; const bf16_t* Bt; int lda, ldb, K, a_shift, a_mul; };

struct StaticOrder {
    int nM, nN, nwg, G, c;
    __host__ __device__ void init(int M, int N, int G_, int c_) { nM = M / BM; nN = N / BM; nwg = nM * nN; G = G_; c = c_; }
    __host__ __device__ bool next(int i, Unit& u) const {
        const long L = (long)i * G + c; if (L >= nwg) return false;
        int wgid = (int)L; { const int q = nwg / NXCD, r = nwg % NXCD, xcd = wgid % NXCD, off = wgid / NXCD; wgid = (xcd < r ? xcd * (q + 1) : r * (q + 1) + (xcd - r) * q) + off; }
        const int nig = WGM * nN, gid = wgid / nig, fm = gid * WGM, gsz = (nM - fm) < WGM ? (nM - fm) : WGM;
        u.pm = fm + ((wgid % nig) % gsz); u.pn = (wgid % nig) / gsz; return true;
    }
    __device__ __forceinline__ void a_ready(const Unit&) const {}
    __device__ __forceinline__ void done(const Unit&) const {}
};

__device__ __forceinline__ unsigned cvt_pk_bf16(float lo, float hi) { unsigned r; asm volatile("v_cvt_pk_bf16_f32 %0, %1, %2" : "=v"(r) : "v"(lo), "v"(hi)); return r; }
__device__ __forceinline__ float bflo(unsigned w) { return __uint_as_float(w << 16); }
__device__ __forceinline__ float bfhi(unsigned w) { return __uint_as_float(w & 0xffff0000u); }
__device__ __forceinline__ float sigmoidf_fast(float x) { return __builtin_amdgcn_rcpf(1.0f + __builtin_amdgcn_exp2f(-1.4426950408889634f * x)); }

struct LnFold {
    const long long* stats; const float* gW; const float* bW;
    __device__ __forceinline__ void row(int r, float& mean, float& rstd) const { const long long s0 = stats[2 * (size_t)r], s1 = stats[2 * (size_t)r + 1];
        mean = (float)s0 * (1.0f / (1048576.f * 2048.0f)); rstd = __builtin_amdgcn_rsqf((float)s1 * (1.0f / (65536.f * 2048.0f)) - mean * mean + 1e-5f); }
    __device__ __forceinline__ f32x4 vec4(const float* v, int i) const { return *(const f32x4*)(v + i); }
};
struct EpiBf16 {
    static constexpr bool PERM = true, AFTER_DRAIN = false;
    bf16_t* O; int ldc; float sc = 1.0f; LnFold lf = {nullptr, nullptr, nullptr};
    __device__ __forceinline__ void operator()(const f32x4 (&acc)[2][2][4][2], const Unit& u, int wr, int wc, int fr, int fq) const {
        const int row0 = u.pm * BM + wr * 64 + fr, col0 = u.pn * BM + wc * 32 + 8 * fq;
        f32x4 gw[2][2], bw[2][2];
#pragma unroll
        for (int bj = 0; bj < 2; ++bj)
#pragma unroll
            for (int n = 0; n < 2; ++n) { gw[bj][n] = (f32x4){0.f, 0.f, 0.f, 0.f}; bw[bj][n] = (f32x4){0.f, 0.f, 0.f, 0.f}; if (lf.stats) { gw[bj][n] = lf.vec4(lf.gW, col0 + bj * HALF + 4 * n); bw[bj][n] = lf.vec4(lf.bW, col0 + bj * HALF + 4 * n); } }
#pragma unroll
        for (int ai = 0; ai < 2; ++ai)
#pragma unroll
            for (int m = 0; m < 4; ++m) { bf16_t* rowp = O + (size_t)(row0 + ai * HALF + m * 16) * ldc + col0;
                float mean = 0.f, rstd = 1.f; if (lf.stats) lf.row(row0 + ai * HALF + m * 16, mean, rstd);
#pragma unroll
                for (int bj = 0; bj < 2; ++bj) { const f32x4 v0 = ((acc[ai][bj][m][0] - gw[bj][0] * mean) * rstd + bw[bj][0]) * sc, v1 = ((acc[ai][bj][m][1] - gw[bj][1] * mean) * rstd + bw[bj][1]) * sc;
                    u32x4 w; w.x = cvt_pk_bf16(v0[0], v0[1]); w.y = cvt_pk_bf16(v0[2], v0[3]); w.z = cvt_pk_bf16(v1[0], v1[1]); w.w = cvt_pk_bf16(v1[2], v1[3]);
                    *(u32x4*)(rowp + bj * HALF) = w; } }
    }
};
struct EpiInProj {
    static constexpr bool PERM = true, AFTER_DRAIN = false;
    bf16_t *aq, *ak, *av, *bq, *bc, *iq, *ikw; float qscale; LnFold lf;
    __device__ __forceinline__ void operator()(const f32x4 (&acc)[2][2][4][2], const Unit& u, int wr, int wc, int fr, int fq) const {
        bf16_t* base; int ldc, colt; const int pn = u.pn;
        if (pn < 4) { base = aq; ldc = 1024; colt = pn * 256; }
        else if (pn < 8) { base = ak; ldc = 1024; colt = (pn - 4) * 256; }
        else if (pn < 12) { base = av; ldc = 1024; colt = (pn - 8) * 256; }
        else if (pn < 16) { base = bq; ldc = 1024; colt = (pn - 12) * 256; }
        else if (pn < 18) { base = bc; ldc = 512; colt = (pn - 16) * 256; }
        else if (pn < 22) { base = iq; ldc = 1024; colt = (pn - 18) * 256; }
        else { base = ikw; ldc = 256; colt = 0; }
        const float sc = (pn < 4) ? qscale : 1.0f;
        const int row0 = u.pm * BM + wr * 64 + fr, col0 = colt + wc * 32 + 8 * fq, cidx = pn * BM + wc * 32 + 8 * fq;
        f32x4 gw[2][2], bw[2][2];
#pragma unroll
        for (int bj = 0; bj < 2; ++bj)
#pragma unroll
            for (int n = 0; n < 2; ++n) { gw[bj][n] = lf.vec4(lf.gW, cidx + bj * HALF + 4 * n); bw[bj][n] = lf.vec4(lf.bW, cidx + bj * HALF + 4 * n); }
#pragma unroll
        for (int ai = 0; ai < 2; ++ai)
#pragma unroll
            for (int m = 0; m < 4; ++m) { bf16_t* rowp = base + (size_t)(row0 + ai * HALF + m * 16) * ldc + col0;
                float mean, rstd; lf.row(row0 + ai * HALF + m * 16, mean, rstd);
#pragma unroll
                for (int bj = 0; bj < 2; ++bj) { const f32x4 v0 = ((acc[ai][bj][m][0] - gw[bj][0] * mean) * rstd + bw[bj][0]) * sc, v1 = ((acc[ai][bj][m][1] - gw[bj][1] * mean) * rstd + bw[bj][1]) * sc;
                    u32x4 w; w.x = cvt_pk_bf16(v0[0], v0[1]); w.y = cvt_pk_bf16(v0[2], v0[3]); w.z = cvt_pk_bf16(v1[0], v1[1]); w.w = cvt_pk_bf16(v1[2], v1[3]);
                    *(u32x4*)(rowp + bj * HALF) = w; } }
    }
};
struct EpiSwiGLU {
    static constexpr bool PERM = true, AFTER_DRAIN = false;
    bf16_t* O; int ldc;
    __device__ __forceinline__ void operator()(const f32x4 (&acc)[2][2][4][2], const Unit& u, int wr, int wc, int fr, int fq) const {
        const int row0 = u.pm * BM + wr * 64 + fr, col0 = u.pn * HALF + wc * 32 + 8 * fq;
#pragma unroll
        for (int ai = 0; ai < 2; ++ai)
#pragma unroll
            for (int m = 0; m < 4; ++m) { bf16_t* rowp = O + (size_t)(row0 + ai * HALF + m * 16) * ldc + col0;
                float h[8];
#pragma unroll
                for (int n = 0; n < 2; ++n)
#pragma unroll
                    for (int j = 0; j < 4; ++j) { const float g = acc[ai][0][m][n][j], up = acc[ai][1][m][n][j]; h[4 * n + j] = g * sigmoidf_fast(g) * up; }
                u32x4 w; w.x = cvt_pk_bf16(h[0], h[1]); w.y = cvt_pk_bf16(h[2], h[3]); w.z = cvt_pk_bf16(h[4], h[5]); w.w = cvt_pk_bf16(h[6], h[7]);
                *(u32x4*)rowp = w; }
    }
};
__device__ __forceinline__ unsigned pk4_fp8(float a, float b, float c, float d) { int w = 0; w = __builtin_amdgcn_cvt_pk_fp8_f32(a, b, w, false); w = __builtin_amdgcn_cvt_pk_fp8_f32(c, d, w, true); return (unsigned)w; }
struct EpiSwiGLU8 {
    static constexpr bool PERM = true, AFTER_DRAIN = false;
    unsigned char* O; int ldc; float ascale, hs; LnFold lf;
    __device__ __forceinline__ void operator()(const f32x4 (&acc)[2][2][4][2], const Unit& u, int wr, int wc, int fr, int fq) const {
        const int row0 = u.pm * BM + wr * 64 + fr, col0 = u.pn * HALF + wc * 32 + 8 * fq, cidx = u.pn * BM + wc * 32 + 8 * fq;
        typedef unsigned u32x2 __attribute__((ext_vector_type(2)));
        f32x4 gw[2][2], bw[2][2];
#pragma unroll
        for (int bj = 0; bj < 2; ++bj)
#pragma unroll
            for (int n = 0; n < 2; ++n) { gw[bj][n] = (f32x4){0.f, 0.f, 0.f, 0.f}; bw[bj][n] = (f32x4){0.f, 0.f, 0.f, 0.f}; if (lf.stats) { gw[bj][n] = lf.vec4(lf.gW, cidx + bj * HALF + 4 * n); bw[bj][n] = lf.vec4(lf.bW, cidx + bj * HALF + 4 * n); } }
#pragma unroll
        for (int ai = 0; ai < 2; ++ai)
#pragma unroll
            for (int m = 0; m < 4; ++m) { unsigned char* rowp = O + (size_t)(row0 + ai * HALF + m * 16) * ldc + col0;
                float h[8]; float mean = 0.f, rstd = 1.f; if (lf.stats) lf.row(row0 + ai * HALF + m * 16, mean, rstd);
#pragma unroll
                for (int n = 0; n < 2; ++n)
#pragma unroll
                    for (int j = 0; j < 4; ++j) { const float g = (acc[ai][0][m][n][j] * ascale - gw[0][n][j] * mean) * rstd + bw[0][n][j], up = (acc[ai][1][m][n][j] * ascale - gw[1][n][j] * mean) * rstd + bw[1][n][j];
                        h[4 * n + j] = fminf(fmaxf(g * sigmoidf_fast(g) * up * hs, -448.f), 448.f); }
                *(u32x2*)rowp = (u32x2){pk4_fp8(h[0], h[1], h[2], h[3]), pk4_fp8(h[4], h[5], h[6], h[7])}; }
    }
};
struct EpiGateMerge {
    static constexpr bool PERM = true, AFTER_DRAIN = false;
    const bf16_t* ta; const bf16_t* tb; bf16_t* O; int ldc; const float* b0; const float* b1;
    __device__ __forceinline__ void operator()(const f32x4 (&acc)[2][2][4][2], const Unit& u, int wr, int wc, int fr, int fq) const {
        const int row0 = u.pm * BM + wr * 64 + fr, col0 = u.pn * HALF + wc * 32 + 8 * fq;
        float bb0[8], bb1[8];
#pragma unroll
        for (int j = 0; j < 8; ++j) { bb0[j] = b0[col0 + j]; bb1[j] = b1[col0 + j]; }
#pragma unroll
        for (int ai = 0; ai < 2; ++ai)
#pragma unroll
            for (int m = 0; m < 4; ++m) { const size_t off = (size_t)(row0 + ai * HALF + m * 16) * ldc + col0;
                const u32x4 a = *(const u32x4*)(ta + off), b = *(const u32x4*)(tb + off);
                const float av[8] = {bflo(a.x), bfhi(a.x), bflo(a.y), bfhi(a.y), bflo(a.z), bfhi(a.z), bflo(a.w), bfhi(a.w)};
                const float bv[8] = {bflo(b.x), bfhi(b.x), bflo(b.y), bfhi(b.y), bflo(b.z), bfhi(b.z), bflo(b.w), bfhi(b.w)};
                float h[8];
#pragma unroll
                for (int n = 0; n < 2; ++n)
#pragma unroll
                    for (int j = 0; j < 4; ++j) { const int e = 4 * n + j; h[e] = sigmoidf_fast(acc[ai][0][m][n][j] + bb0[e]) * av[e] + sigmoidf_fast(acc[ai][1][m][n][j] + bb1[e]) * bv[e]; }
                u32x4 w; w.x = cvt_pk_bf16(h[0], h[1]); w.y = cvt_pk_bf16(h[2], h[3]); w.z = cvt_pk_bf16(h[4], h[5]); w.w = cvt_pk_bf16(h[6], h[7]);
                *(u32x4*)(O + off) = w; }
    }
};
struct EpiGateMerge8 {
    static constexpr bool PERM = true, AFTER_DRAIN = false;
    const bf16_t* ta; const bf16_t* tb; unsigned char* O; int ldc; const float* b0; const float* b1; float ascale, ms; LnFold lf;
    __device__ __forceinline__ void operator()(const f32x4 (&acc)[2][2][4][2], const Unit& u, int wr, int wc, int fr, int fq) const {
        const int row0 = u.pm * BM + wr * 64 + fr, col0 = u.pn * HALF + wc * 32 + 8 * fq, cidx = u.pn * BM + wc * 32 + 8 * fq;
        typedef unsigned u32x2 __attribute__((ext_vector_type(2)));
        float bb0[8], bb1[8], gw0[8], gw1[8];
#pragma unroll
        for (int j = 0; j < 8; ++j) { bb0[j] = b0[col0 + j] + lf.bW[cidx + j]; bb1[j] = b1[col0 + j] + lf.bW[cidx + HALF + j]; gw0[j] = lf.gW[cidx + j]; gw1[j] = lf.gW[cidx + HALF + j]; }
#pragma unroll
        for (int ai = 0; ai < 2; ++ai)
#pragma unroll
            for (int m = 0; m < 4; ++m) { const size_t off = (size_t)(row0 + ai * HALF + m * 16) * ldc + col0;
                const u32x4 a = *(const u32x4*)(ta + off), b = *(const u32x4*)(tb + off);
                const float av[8] = {bflo(a.x), bfhi(a.x), bflo(a.y), bfhi(a.y), bflo(a.z), bfhi(a.z), bflo(a.w), bfhi(a.w)};
                const float bv[8] = {bflo(b.x), bfhi(b.x), bflo(b.y), bfhi(b.y), bflo(b.z), bfhi(b.z), bflo(b.w), bfhi(b.w)};
                float h[8]; float mean, rstd; lf.row(row0 + ai * HALF + m * 16, mean, rstd);
#pragma unroll
                for (int n = 0; n < 2; ++n)
#pragma unroll
                    for (int j = 0; j < 4; ++j) { const int e = 4 * n + j; const float v = sigmoidf_fast((acc[ai][0][m][n][j] * ascale - gw0[e] * mean) * rstd + bb0[e]) * av[e] + sigmoidf_fast((acc[ai][1][m][n][j] * ascale - gw1[e] * mean) * rstd + bb1[e]) * bv[e];
                        h[e] = fminf(fmaxf(v * ms, -448.f), 448.f); }
                *(u32x2*)(O + off) = (u32x2){pk4_fp8(h[0], h[1], h[2], h[3]), pk4_fp8(h[4], h[5], h[6], h[7])}; }
    }
};
struct EpiRes {
    static constexpr bool PERM = true, AFTER_DRAIN = false;
    const float* res32; const bf16_t* res16; int ldc; float alpha, s;
    const long long* rstats; const float* rg; const float* rb; long long* ostats; bf16_t* o16; unsigned char* o8; float o8s;
    __device__ __forceinline__ void operator()(const f32x4 (&acc)[2][2][4][2], const Unit& u, int wr, int wc, int fr, int fq) const {
        const int col0 = u.pn * BM + wc * 32 + 8 * fq;
        typedef unsigned u32x2 __attribute__((ext_vector_type(2)));
        float al = alpha, sa = s; asm volatile("" : "+v"(al), "+v"(sa));
        f32x4 gv[2][2], bv[2][2];
#pragma unroll
        for (int bj = 0; bj < 2; ++bj)
#pragma unroll
            for (int n = 0; n < 2; ++n) { gv[bj][n] = (f32x4){1.f, 1.f, 1.f, 1.f}; bv[bj][n] = (f32x4){0.f, 0.f, 0.f, 0.f};
                if (rstats) { gv[bj][n] = *(const f32x4*)(rg + col0 + bj * HALF + 4 * n); bv[bj][n] = *(const f32x4*)(rb + col0 + bj * HALF + 4 * n); }
                gv[bj][n] = gv[bj][n] * al; bv[bj][n] = bv[bj][n] * al; }
#pragma unroll
        for (int ai = 0; ai < 2; ++ai)
#pragma unroll
            for (int m = 0; m < 4; ++m) { const int row = u.pm * BM + ai * HALF + wr * 64 + m * 16 + fr; const size_t off = (size_t)row * ldc + col0;
                float mean = 0.f, rstd = 1.f;
                if (rstats) { const long long s0 = rstats[2 * (size_t)row], s1 = rstats[2 * (size_t)row + 1]; mean = (float)s0 * (1.0f / (1048576.f * 2048.0f)); rstd = __builtin_amdgcn_rsqf((float)s1 * (1.0f / (65536.f * 2048.0f)) - mean * mean + 1e-5f); }
                float ps = 0.f, pq = 0.f;
#pragma unroll
                for (int bj = 0; bj < 2; ++bj) {
                    f32x4 r0, r1;
                    if (res32) { r0 = *(const f32x4*)(res32 + off + bj * HALF); r1 = *(const f32x4*)(res32 + off + bj * HALF + 4); }
                    else { const u32x4 w = *(const u32x4*)(res16 + off + bj * HALF); r0 = (f32x4){bflo(w.x), bfhi(w.x), bflo(w.y), bfhi(w.y)}; r1 = (f32x4){bflo(w.z), bfhi(w.z), bflo(w.w), bfhi(w.w)}; }
                    const f32x4 z0 = (r0 - mean) * rstd * gv[bj][0] + bv[bj][0] + acc[ai][bj][m][0] * sa, z1 = (r1 - mean) * rstd * gv[bj][1] + bv[bj][1] + acc[ai][bj][m][1] * sa;
                    u32x4 w16; w16.x = cvt_pk_bf16(z0[0], z0[1]); w16.y = cvt_pk_bf16(z0[2], z0[3]); w16.z = cvt_pk_bf16(z1[0], z1[1]); w16.w = cvt_pk_bf16(z1[2], z1[3]);
                    *(u32x4*)(o16 + off + bj * HALF) = w16;
                    const float q0 = bflo(w16.x), q1 = bfhi(w16.x), q2 = bflo(w16.y), q3 = bfhi(w16.y), q4 = bflo(w16.z), q5 = bfhi(w16.z), q6 = bflo(w16.w), q7 = bfhi(w16.w);
                    ps += ((q0 + q1) + (q2 + q3)) + ((q4 + q5) + (q6 + q7)); pq += ((q0 * q0 + q1 * q1) + (q2 * q2 + q3 * q3)) + ((q4 * q4 + q5 * q5) + (q6 * q6 + q7 * q7));
                    if (o8) *(u32x2*)(o8 + off + bj * HALF) = (u32x2){pk4_fp8(fminf(fmaxf(q0 * o8s, -448.f), 448.f), fminf(fmaxf(q1 * o8s, -448.f), 448.f), fminf(fmaxf(q2 * o8s, -448.f), 448.f), fminf(fmaxf(q3 * o8s, -448.f), 448.f)),
                                                                      pk4_fp8(fminf(fmaxf(q4 * o8s, -448.f), 448.f), fminf(fmaxf(q5 * o8s, -448.f), 448.f), fminf(fmaxf(q6 * o8s, -448.f), 448.f), fminf(fmaxf(q7 * o8s, -448.f), 448.f))}; }
                if (ostats) { ps += __shfl_xor(ps, 16); ps += __shfl_xor(ps, 32); pq += __shfl_xor(pq, 16); pq += __shfl_xor(pq, 32);
                    if (fq == 0) { (void)__hip_atomic_fetch_add(ostats + 2 * (size_t)row, (long long)__builtin_rintf(ps * 1048576.f), __ATOMIC_RELAXED, __HIP_MEMORY_SCOPE_AGENT); (void)__hip_atomic_fetch_add(ostats + 2 * (size_t)row + 1, (long long)__builtin_rintf(pq * 65536.f), __ATOMIC_RELAXED, __HIP_MEMORY_SCOPE_AGENT); } }
                if (m & 1) asm volatile("" ::: "memory"); }
    }
};

typedef int v8i_t __attribute__((ext_vector_type(8)));
typedef int v4i_t __attribute__((ext_vector_type(4)));
template <class Epi, class Sched, bool ALIGN_EPI, bool FP8 = false>
__device__ __forceinline__ void gemm_phase(PG8_LAS unsigned char* lds, const Gemm g, const Sched& S, const Epi& E, const int wid) {
    const int lane = lane_fresh(), tid = wid * 64 + lane, wr = wid >> 2, wc = wid & 3, fr = lane & 15, fq = lane >> 4;
    const int K = g.K, nt = K / BK;
    unsigned voffA[2], voffB[2];
#pragma unroll
    for (int i = 0; i < 2; ++i) { int R, C; stage_rc(tid * 16 + i * 8192, R, C); const int Rb = Epi::PERM ? ((R & ~31) + perm32(R & 31)) : R;
        voffA[i] = (unsigned)(R * g.lda + C) * 2u; voffB[i] = (unsigned)(Rb * g.ldb + C) * 2u; }
    const size_t kstep = (size_t)(BK * 2);
    const size_t hstepA = (size_t)HALF * g.lda * 2, hstepB = (size_t)HALF * g.ldb * 2;
    const size_t tstepA = 2 * hstepA, tstepB = 2 * hstepB;
    const unsigned ldsw = (unsigned)wid * 1024u;
    const int aoff = lds_byte(wr * 64 + fr, fq * 8), boff = lds_byte(wc * 32 + fr, fq * 8);
#define PG8_UA(u) ((const char*)g.A + (size_t)(u).pm * tstepA + (size_t)(((u).pn >> g.a_shift) * g.a_mul) * 2)
#define PG8_UB(u) ((const char*)g.Bt + (size_t)(u).pn * tstepB)
#define PG8_SA(b, h) (((b) * 2 + (h)) * HTB)
#define PG8_SB(b, h) ((4 + (b) * 2 + (h)) * HTB)
#define PG8_STAGE(bufoff, gbase, voff) do { _Pragma("unroll") for (int _i = 0; _i < 2; ++_i) \
        __builtin_amdgcn_global_load_lds((const unsigned*)((const char*)(gbase) + (voff)[_i]), (PG8_LAS unsigned*)(lds + (bufoff) + ldsw + _i * 8192), 16, 0, 0); } while (0)
#define PG8_LD8(p_) __builtin_shufflevector(*(const PG8_LAS v4i_t*)(p_), *(const PG8_LAS v4i_t*)((p_) + 1024), 0, 1, 2, 3, 4, 5, 6, 7)
#define PG8_LDA(dst, b, h) do { _Pragma("unroll") for (int m = 0; m < 4; ++m) { if constexpr (FP8) dst##8[m] = PG8_LD8(lds + PG8_SA(b, h) + aoff + m * 2048); else { _Pragma("unroll") for (int k = 0; k < 2; ++k) dst[m][k] = *(const PG8_LAS bf16x8*)(lds + PG8_SA(b, h) + aoff + m * 2048 + k * 1024); } } } while (0)
#define PG8_LDB(dst, b, h) do { _Pragma("unroll") for (int n = 0; n < 2; ++n) { if constexpr (FP8) dst##8[n] = PG8_LD8(lds + PG8_SB(b, h) + boff + n * 2048); else { _Pragma("unroll") for (int k = 0; k < 2; ++k) dst[n][k] = *(const PG8_LAS bf16x8*)(lds + PG8_SB(b, h) + boff + n * 2048 + k * 1024); } } } while (0)
#define PG8_MMA(ai, bj, At, Bt) do { __builtin_amdgcn_s_setprio(1); _Pragma("unroll") for (int m = 0; m < 4; ++m) _Pragma("unroll") for (int n = 0; n < 2; ++n) { \
        if constexpr (FP8) asm volatile("v_mfma_scale_f32_16x16x128_f8f6f4 %0, %1, %2, %0, %3, %3 op_sel_hi:[0,0,0]" : "+v"(acc[ai][bj][m][n]) : "v"(Bt##8[n]), "v"(At##8[m]), "v"(one_scale)); \
        else { _Pragma("unroll") for (int k = 0; k < 2; ++k) acc[ai][bj][m][n] = __builtin_amdgcn_mfma_f32_16x16x32_bf16(Bt[n][k], At[m][k], acc[ai][bj][m][n], 0, 0, 0); } } \
        __builtin_amdgcn_s_setprio(0); } while (0)
#define PG8_WAIT_V(n) asm volatile("s_waitcnt vmcnt(" #n ")" ::: "memory")
#define PG8_WAIT_L(n) asm volatile("s_waitcnt lgkmcnt(" #n ")" ::: "memory")
#define PG8_BAR __builtin_amdgcn_s_barrier()
#define PG8_SCHED __builtin_amdgcn_sched_barrier(0)
    Unit cur, nxt; int ui = 0;
    if (!S.next(0, cur)) return;
    f32x4 acc[2][2][4][2];
#pragma unroll
    for (int a = 0; a < 2; ++a)
#pragma unroll
        for (int b = 0; b < 2; ++b)
#pragma unroll
            for (int m = 0; m < 4; ++m)
#pragma unroll
                for (int n = 0; n < 2; ++n) acc[a][b][m][n] = (f32x4){0.f, 0.f, 0.f, 0.f};
    bf16x8 At[4][2], B0[2][2], B1[2][2]; v8i_t At8[4], B08[2], B18[2];
    int one_scale = 0x7f7f7f7f; asm volatile("" : "+v"(one_scale));
    const char* cA = PG8_UA(cur); const char* cB = PG8_UB(cur);
    S.a_ready(cur);
    PG8_STAGE(PG8_SB(0, 0), cB, voffB); PG8_STAGE(PG8_SB(0, 1), cB + hstepB, voffB); PG8_STAGE(PG8_SA(0, 0), cA, voffA); PG8_STAGE(PG8_SA(0, 1), cA + hstepA, voffA);
    if (wr == 1) PG8_BAR;
    PG8_WAIT_V(2); PG8_BAR;
    PG8_STAGE(PG8_SB(1, 0), cB + kstep, voffB); PG8_STAGE(PG8_SA(1, 0), cA + kstep, voffA); PG8_STAGE(PG8_SB(1, 1), cB + hstepB + kstep, voffB);
    PG8_WAIT_V(6); PG8_BAR;
    for (;;) {
        const bool has_next = S.next(ui + 1, nxt);
        const char* nA = has_next ? PG8_UA(nxt) : cA; const char* nB = has_next ? PG8_UB(nxt) : cB;
        for (int t = 0; t < nt; t += 2) {
            const bool last = (t == nt - 2);
            const char* a1 = cA + (size_t)(t + 1) * kstep;
            const char* a2 = last ? nA : cA + (size_t)(t + 2) * kstep; const char* b2 = last ? nB : cB + (size_t)(t + 2) * kstep;
            const char* a3 = a2 + kstep; const char* b3 = b2 + kstep;
            if (last && has_next) S.a_ready(nxt);
            PG8_LDB(B0, 0, 0); PG8_LDB(B1, 0, 1); PG8_SCHED; PG8_LDA(At, 0, 0); PG8_STAGE(PG8_SA(1, 1), a1 + hstepA, voffA);
            PG8_WAIT_V(8); PG8_WAIT_L(0); PG8_BAR; PG8_MMA(0, 0, At, B0); PG8_MMA(0, 1, At, B1); PG8_BAR; PG8_SCHED;
            PG8_LDA(At, 0, 1); PG8_STAGE(PG8_SB(0, 0), b2, voffB); PG8_STAGE(PG8_SB(0, 1), b2 + hstepB, voffB); PG8_STAGE(PG8_SA(0, 0), a2, voffA);
            PG8_WAIT_V(8); PG8_WAIT_L(0); PG8_BAR; PG8_MMA(1, 0, At, B0); PG8_MMA(1, 1, At, B1); PG8_BAR; PG8_SCHED;
            PG8_LDB(B0, 1, 0); PG8_LDB(B1, 1, 1); PG8_SCHED; PG8_LDA(At, 1, 0); PG8_STAGE(PG8_SA(0, 1), a2 + hstepA, voffA);
            PG8_WAIT_V(8); PG8_WAIT_L(0); PG8_BAR; PG8_MMA(0, 0, At, B0); PG8_MMA(0, 1, At, B1); PG8_BAR; PG8_SCHED;
            PG8_LDA(At, 1, 1); PG8_STAGE(PG8_SB(1, 0), b3, voffB); PG8_STAGE(PG8_SB(1, 1), b3 + hstepB, voffB); PG8_STAGE(PG8_SA(1, 0), a3, voffA);
            PG8_WAIT_V(8); PG8_WAIT_L(0); PG8_BAR; PG8_MMA(1, 0, At, B0); PG8_MMA(1, 1, At, B1); PG8_BAR; PG8_SCHED;
        }
        if constexpr (ALIGN_EPI) { if (wr == 0) PG8_BAR; }
        if constexpr (FP8) asm volatile("s_nop 15\n\ts_nop 7" ::: "memory");
        E(acc, cur, wr, wc, fr, fq); S.done(cur);
        if (!has_next) break;
#pragma unroll
        for (int a = 0; a < 2; ++a)
#pragma unroll
            for (int b = 0; b < 2; ++b)
#pragma unroll
                for (int m = 0; m < 4; ++m)
#pragma unroll
                    for (int n = 0; n < 2; ++n) acc[a][b][m][n] = (f32x4){0.f, 0.f, 0.f, 0.f};
        cur = nxt; cA = nA; cB = nB; ++ui;
        if constexpr (ALIGN_EPI) { if (wr == 1) PG8_BAR; }
    }
    PG8_WAIT_V(0);
    if constexpr (!ALIGN_EPI) { if (wr == 0) PG8_BAR; }
    PG8_BAR;
#undef PG8_UA
#undef PG8_UB
#undef PG8_SA
#undef PG8_SB
#undef PG8_STAGE
#undef PG8_LDA
#undef PG8_LDB
#undef PG8_MMA
#undef PG8_LD8
#undef PG8_WAIT_V
#undef PG8_WAIT_L
#undef PG8_BAR
#undef PG8_SCHED
}
}

constexpr int NWAVES = 8;
constexpr int BATCH = 4, SEQ = 4096, D = 2048, FF = 5632, M = BATCH * SEQ;
constexpr int N_IN = 5888;
constexpr int MEMT = 256;
constexpr float LN_EPS = 1e-5f;
constexpr float ALPHA = 1.189207115002721f;
constexpr float LAMBDA_INIT = 0.2f;

constexpr size_t MiB = 1u << 20;
constexpr size_t WS_CTL = 0, CTL_ZERO_BYTES = 2 * MiB;
constexpr size_t WS_W_IN = 2 * MiB;
constexpr size_t WS_W_G = 25 * MiB;
constexpr size_t WS_W_UK = 41 * MiB;
constexpr size_t WS_W_UVP = 42 * MiB;
constexpr size_t WS_W_A = 44 * MiB;
constexpr size_t WS_W_B = 48 * MiB;
constexpr size_t WS_W_MO = 52 * MiB;
constexpr size_t WS_W_MQ = 60 * MiB;
constexpr size_t WS_W_MKV = 62 * MiB;
constexpr size_t WS_W_MOUT = 66 * MiB;
constexpr size_t WS_MEM16 = 68 * MiB;
constexpr size_t WS_KVMEM = 72 * MiB;
constexpr size_t WS_W_GU2 = 74 * MiB;
constexpr size_t WS_W_D2 = 96 * MiB;
constexpr size_t WS_X8M = 107 * MiB;
constexpr size_t WS_X16 = 140 * MiB;
constexpr size_t WS_MIX = 204 * MiB;
constexpr size_t WS_W_GU1 = 204 * MiB;
constexpr size_t WS_W_D1 = 248 * MiB;
constexpr size_t WS_H = 270 * MiB;
constexpr size_t WS_AQ = WS_MIX + 0 * MiB, WS_AK = WS_MIX + 32 * MiB, WS_AV = WS_MIX + 64 * MiB, WS_BQ = WS_MIX + 96 * MiB;
constexpr size_t WS_BC = WS_MIX + 128 * MiB;
constexpr size_t WS_IQ = WS_MIX + 144 * MiB;
constexpr size_t WS_IKW = WS_MIX + 176 * MiB;
constexpr size_t WS_QLAT = WS_MIX + 184 * MiB;
constexpr size_t WS_IDX = WS_MIX + 312 * MiB;
constexpr size_t WS_YB = WS_BQ;
constexpr size_t WS_TA = WS_QLAT, WS_TB = WS_QLAT + 64 * MiB;
constexpr size_t WS_QM = WS_AQ, WS_OM = WS_AQ + 16 * MiB;
constexpr size_t WS_X8 = WS_H + 96 * MiB;
constexpr size_t WS_C8 = WS_W_IN;
constexpr size_t WS_MRG8 = WS_AV;
constexpr float FP8_WGS = 1024.f, FP8_MS = 32.f, FP8_WMOS = 2048.f;
constexpr float FP8_XS = 32.f, FP8_WGUS = 1024.f, FP8_HS = 8.f, FP8_WDS = 4096.f;
constexpr size_t WS_END = WS_MIX + 320 * MiB;
static_assert(WS_H + (size_t)M * FF * 2 <= WS_END && WS_QLAT + (size_t)M * 4096 * 2 <= WS_END, "d_ws map");
constexpr int CW_BAR = 4096;
constexpr size_t CTL_STATS = 65536, CTL_STATS_STRIDE = (size_t)M * 2 * 8;
constexpr size_t CTL_VEC = CTL_STATS + 3 * CTL_STATS_STRIDE;
constexpr int V_GW_IN = 0, V_BW_IN = 5888, V_GW_G = 11776, V_BW_G = 15872, V_GW_MQ = 19968, V_BW_MQ = 20480, V_GW_GU2 = 20992, V_BW_GU2 = 32256, V_END = 43520;
constexpr size_t CTL_VECF = CTL_VEC + (size_t)V_END * 8;
static_assert(CTL_VECF + (size_t)V_END * 4 <= CTL_ZERO_BYTES, "control region");
constexpr float FX_S = 1048576.f, FX_Q = 65536.f, FX_V = 16777216.f;

constexpr int RING_OFF = 0, RING_BYTES = 153600;
constexpr int LDSCTL_OFF = RING_BYTES, MISC_OFF = LDSCTL_OFF + 320;
constexpr int LDS_BYTES = 154624;
static_assert(MISC_OFF + 128 <= LDS_BYTES, "LDS map");

#define GAS __attribute__((address_space(1)))
#define LAS __attribute__((address_space(3)))
typedef unsigned short bf16;
typedef unsigned v4u __attribute__((ext_vector_type(4)));
typedef unsigned v2u __attribute__((ext_vector_type(2)));
typedef float f32x4 __attribute__((ext_vector_type(4)));
typedef float f32x16 __attribute__((ext_vector_type(16)));
typedef short bf16x8 __attribute__((ext_vector_type(8)));
typedef GAS unsigned gu32;
#define RLX_AGENT __ATOMIC_RELAXED, __HIP_MEMORY_SCOPE_AGENT
#define LDS_WAIT() asm volatile("s_waitcnt lgkmcnt(0)" ::: "memory")
#define VM_WAIT() asm volatile("s_waitcnt vmcnt(0)" ::: "memory")
__device__ __forceinline__ unsigned f2bf(float f) { unsigned u = __builtin_bit_cast(unsigned, f); return (u + 0x7fffu + ((u >> 16) & 1u)) >> 16; }
__device__ __forceinline__ unsigned pk2(float lo, float hi) { return f2bf(lo) | (f2bf(hi) << 16); }
__device__ __forceinline__ float bf2f(unsigned short v) { return __uint_as_float((unsigned)v << 16); }
__device__ __forceinline__ float blo(unsigned w) { return __uint_as_float(w << 16); }
__device__ __forceinline__ float bhi(unsigned w) { return __uint_as_float(w & 0xffff0000u); }
__device__ __forceinline__ float wave_sum(float v) {
#pragma unroll
    for (int o = 1; o < 64; o <<= 1) v += __shfl_xor(v, o);
    return v;
}

#define XB_TMO      128
#define XB_XCNT(j)  (256  + 64 * (j))
#define XB_XSUB(j)  (1280 + 64 * (j))
#define XB_XGEN(j)  (2304 + 64 * (j))
#define XB_TOP      3328
#define XB_TOPGEN   3392
#define XCD_BAR_WORDS 3456
#define XB_SPIN_CAP (1u << 18)

__device__ __forceinline__ unsigned xb_ld(unsigned* p)              { return __hip_atomic_load(p, __ATOMIC_RELAXED, __HIP_MEMORY_SCOPE_AGENT); }
__device__ __forceinline__ unsigned xb_add(unsigned* p, unsigned v) { return __hip_atomic_fetch_add(p, v, __ATOMIC_RELAXED, __HIP_MEMORY_SCOPE_AGENT); }
__device__ __forceinline__ unsigned xb_xcc_id() { return (unsigned)__builtin_amdgcn_s_getreg((3 << 11) | 20) & 0xFu; }
#define XB_SPIN(cond, bar) do { unsigned _sp = 0; while (cond) { __builtin_amdgcn_s_sleep(1); \
    if ((++_sp & 255u) == 0u) { if (xb_ld(&(bar)[XB_TMO])) break; if (_sp > XB_SPIN_CAP) { atomicAdd(&(bar)[XB_TMO], 1u); break; } } } } while (0)

struct XcdBarrier {
    unsigned* bar; unsigned x;
    volatile LAS unsigned* st;
};

__device__ __forceinline__ XcdBarrier xcd_barrier_post(unsigned* bar, volatile LAS unsigned* st, bool t0) {
    XcdBarrier b; b.bar = bar; b.x = xb_xcc_id(); b.st = st;
    if (t0) (void)xb_add(&bar[XB_XCNT(b.x)], 1u);
    return b;
}
__device__ __forceinline__ void xcd_barrier_complete(unsigned* bar, unsigned x, unsigned& nloc, unsigned& nx) {
    const unsigned G = gridDim.x * gridDim.y * gridDim.z;
    unsigned sum, cnt, mine, sp = 0u;
    for (;;) {
        sum = 0u; cnt = 0u; mine = 0u;
#pragma unroll
        for (unsigned j = 0; j < 16; ++j) { const unsigned c = xb_ld(&bar[XB_XCNT(j)]); sum += c; cnt += (c > 0u) ? 1u : 0u; mine = (j == x) ? c : mine; }
        if (sum == G) break;
        __builtin_amdgcn_s_sleep(1);
        if ((++sp & 255u) == 0u) { if (xb_ld(&bar[XB_TMO])) break; if (sp > XB_SPIN_CAP) { atomicAdd(&bar[XB_TMO], 1u); break; } }
    }
    nloc = mine > 0u ? mine : 1u; nx = cnt > 0u ? cnt : 1u;
}

__device__ __forceinline__ void xcd_barrier(const XcdBarrier& b, const int wave) {
    asm volatile("s_waitcnt vmcnt(0)" ::: "memory");
    __syncthreads();
    if (wave == 0 && lane_fresh() == 0) {
        unsigned* bar = b.bar;
        __builtin_amdgcn_s_waitcnt(0);
        unsigned nloc = b.st[0], nx = b.st[1];
        if (nloc == 0u) { xcd_barrier_complete(bar, b.x, nloc, nx); b.st[0] = nloc; b.st[1] = nx; }
        const unsigned old = xb_add(&bar[XB_XSUB(b.x)], 1u);
        const unsigned gen = old / nloc;
        if (old + 1u == (gen + 1u) * nloc) {
            __builtin_amdgcn_fence(__ATOMIC_RELEASE, "agent");
            asm volatile("s_waitcnt vmcnt(0)" ::: "memory");
            const unsigned og = xb_add(&bar[XB_TOP], 1u);
            const unsigned tg = og / nx;
            if (og + 1u == (tg + 1u) * nx) xb_add(&bar[XB_TOPGEN], 1u);
            else XB_SPIN(xb_ld(&bar[XB_TOPGEN]) == tg, bar);
            __builtin_amdgcn_fence(__ATOMIC_ACQUIRE, "agent");
            xb_add(&bar[XB_XGEN(b.x)], 1u);
            asm volatile("s_waitcnt vmcnt(0)" ::: "memory");
        } else {
            XB_SPIN(xb_ld(&bar[XB_XGEN(b.x)]) == gen, bar);
            __builtin_amdgcn_fence(__ATOMIC_ACQUIRE, "agent");
            asm volatile("s_waitcnt vmcnt(0)" ::: "memory");
        }
    }
    __syncthreads();
}

__device__ __forceinline__ void tr_item(const float* W, int ldw, int nvalid, bf16* WT, int ldt, int k0, int n0, int drow0, int dcol0, LAS float* scr, int lane) {
    const int n = n0 + (lane & 31); const bool ok = n < nvalid;
#pragma unroll 8
    for (int i = 0; i < 32; ++i) { const int kk = 2 * i + (lane >> 5); scr[kk * 33 + (lane & 31)] = ok ? W[(size_t)(k0 + kk) * ldw + n] : 0.f; }
    LDS_WAIT(); asm volatile("" ::: "memory");
    const int c = lane & 7;
#pragma unroll
    for (int j = 0; j < 4; ++j) { const int nn = (lane >> 3) + 8 * j; const LAS float* s = scr + (8 * c) * 33 + nn;
        v4u o; o.x = pk2(s[0 * 33], s[1 * 33]); o.y = pk2(s[2 * 33], s[3 * 33]); o.z = pk2(s[4 * 33], s[5 * 33]); o.w = pk2(s[6 * 33], s[7 * 33]);
        *(GAS v4u*)(WT + (size_t)(drow0 + nn) * ldt + dcol0 + k0 + 8 * c) = o; }
    LDS_WAIT(); asm volatile("" ::: "memory");
}
__device__ __forceinline__ void tr_item8(const float* W, int ldw, unsigned char* WT, int ldt, int k0, int n0, int drow0, float sc, LAS float* scr, int lane) {
    const int n = n0 + (lane & 31);
#pragma unroll 8
    for (int i = 0; i < 32; ++i) { const int kk = 2 * i + (lane >> 5); scr[kk * 33 + (lane & 31)] = W[(size_t)(k0 + kk) * ldw + n]; }
    LDS_WAIT(); asm volatile("" ::: "memory");
    const int nn = lane >> 1, hf = lane & 1; const LAS float* sp = scr + (32 * hf) * 33 + nn;
    unsigned o[8];
#pragma unroll
    for (int q = 0; q < 8; ++q) { const float a = fminf(fmaxf(sp[(4 * q + 0) * 33] * sc, -448.f), 448.f), b = fminf(fmaxf(sp[(4 * q + 1) * 33] * sc, -448.f), 448.f), c = fminf(fmaxf(sp[(4 * q + 2) * 33] * sc, -448.f), 448.f), d = fminf(fmaxf(sp[(4 * q + 3) * 33] * sc, -448.f), 448.f);
        int w = 0; w = __builtin_amdgcn_cvt_pk_fp8_f32(a, b, w, false); w = __builtin_amdgcn_cvt_pk_fp8_f32(c, d, w, true); o[q] = (unsigned)w; }
    GAS v4u* dst = (GAS v4u*)(WT + (size_t)(drow0 + nn) * ldt + k0 + 32 * hf);
    dst[0] = (v4u){o[0], o[1], o[2], o[3]}; dst[1] = (v4u){o[4], o[5], o[6], o[7]};
    LDS_WAIT(); asm volatile("" ::: "memory");
}
__device__ __forceinline__ void tr_item_ln(const float* W, int ldw, int nvalid, bf16* WT, int ldt, int k0, int n0, int drow0, const float* gain, const float* bvec, long long* gW, long long* bW, LAS float* scr, int lane) {
    const int n = n0 + (lane & 31); const bool ok = n < nvalid;
#pragma unroll 8
    for (int i = 0; i < 32; ++i) { const int kk = 2 * i + (lane >> 5); scr[kk * 33 + (lane & 31)] = ok ? W[(size_t)(k0 + kk) * ldw + n] : 0.f; }
    LDS_WAIT(); asm volatile("" ::: "memory");
    const int c = lane & 7;
    const f32x4 g0 = *(const GAS f32x4*)(gain + k0 + 8 * c), g1 = *(const GAS f32x4*)(gain + k0 + 8 * c + 4), b0 = *(const GAS f32x4*)(bvec + k0 + 8 * c), b1 = *(const GAS f32x4*)(bvec + k0 + 8 * c + 4);
    const float gk[8] = {g0.x, g0.y, g0.z, g0.w, g1.x, g1.y, g1.z, g1.w}, bk[8] = {b0.x, b0.y, b0.z, b0.w, b1.x, b1.y, b1.z, b1.w};
#pragma unroll
    for (int j = 0; j < 4; ++j) { const int nn = (lane >> 3) + 8 * j; const LAS float* sp = scr + (8 * c) * 33 + nn;
        float v[8], bs = 0.f;
#pragma unroll
        for (int i = 0; i < 8; ++i) { const float raw = sp[i * 33]; v[i] = raw * gk[i]; bs += raw * bk[i]; }
        v4u o; o.x = pk2(v[0], v[1]); o.y = pk2(v[2], v[3]); o.z = pk2(v[4], v[5]); o.w = pk2(v[6], v[7]);
        float gs = ((blo(o.x) + bhi(o.x)) + (blo(o.y) + bhi(o.y))) + ((blo(o.z) + bhi(o.z)) + (blo(o.w) + bhi(o.w)));
        *(GAS v4u*)(WT + (size_t)(drow0 + nn) * ldt + k0 + 8 * c) = o;
        gs += __shfl_xor(gs, 1); gs += __shfl_xor(gs, 2); gs += __shfl_xor(gs, 4); bs += __shfl_xor(bs, 1); bs += __shfl_xor(bs, 2); bs += __shfl_xor(bs, 4);
        if (c == 0) { (void)__hip_atomic_fetch_add(gW + drow0 + nn, (long long)__builtin_rintf(gs * FX_V), __ATOMIC_RELAXED, __HIP_MEMORY_SCOPE_AGENT); (void)__hip_atomic_fetch_add(bW + drow0 + nn, (long long)__builtin_rintf(bs * FX_V), __ATOMIC_RELAXED, __HIP_MEMORY_SCOPE_AGENT); } }
    LDS_WAIT(); asm volatile("" ::: "memory");
}
__device__ __forceinline__ void tr_item8_ln(const float* W, int ldw, unsigned char* WT, int ldt, int k0, int n0, int drow0, float sc, const float* gain, const float* bvec, long long* gW, long long* bW, LAS float* scr, int lane) {
    const int n = n0 + (lane & 31);
#pragma unroll 8
    for (int i = 0; i < 32; ++i) { const int kk = 2 * i + (lane >> 5); scr[kk * 33 + (lane & 31)] = W[(size_t)(k0 + kk) * ldw + n]; }
    LDS_WAIT(); asm volatile("" ::: "memory");
    const int nn = lane >> 1, hf = lane & 1; const LAS float* sp = scr + (32 * hf) * 33 + nn;
    unsigned o[8]; float gs = 0.f, bs = 0.f;
#pragma unroll
    for (int q = 0; q < 8; ++q) { const f32x4 g4 = *(const GAS f32x4*)(gain + k0 + 32 * hf + 4 * q), b4 = *(const GAS f32x4*)(bvec + k0 + 32 * hf + 4 * q);
        const float r0 = sp[(4 * q + 0) * 33], r1 = sp[(4 * q + 1) * 33], r2 = sp[(4 * q + 2) * 33], r3 = sp[(4 * q + 3) * 33];
        bs += (r0 * b4.x + r1 * b4.y) + (r2 * b4.z + r3 * b4.w);
        const float a = fminf(fmaxf(r0 * g4.x * sc, -448.f), 448.f), b = fminf(fmaxf(r1 * g4.y * sc, -448.f), 448.f), c = fminf(fmaxf(r2 * g4.z * sc, -448.f), 448.f), d = fminf(fmaxf(r3 * g4.w * sc, -448.f), 448.f);
        int w = 0; w = __builtin_amdgcn_cvt_pk_fp8_f32(a, b, w, false); w = __builtin_amdgcn_cvt_pk_fp8_f32(c, d, w, true); o[q] = (unsigned)w;
        gs += (__builtin_amdgcn_cvt_f32_fp8(w, 0) + __builtin_amdgcn_cvt_f32_fp8(w, 1)) + (__builtin_amdgcn_cvt_f32_fp8(w, 2) + __builtin_amdgcn_cvt_f32_fp8(w, 3)); }
    GAS v4u* dst = (GAS v4u*)(WT + (size_t)(drow0 + nn) * ldt + k0 + 32 * hf);
    dst[0] = (v4u){o[0], o[1], o[2], o[3]}; dst[1] = (v4u){o[4], o[5], o[6], o[7]};
    gs += __shfl_xor(gs, 1); bs += __shfl_xor(bs, 1);
    if (hf == 0) { (void)__hip_atomic_fetch_add(gW + drow0 + nn, (long long)__builtin_rintf(gs / sc * FX_V), __ATOMIC_RELAXED, __HIP_MEMORY_SCOPE_AGENT); (void)__hip_atomic_fetch_add(bW + drow0 + nn, (long long)__builtin_rintf(bs * FX_V), __ATOMIC_RELAXED, __HIP_MEMORY_SCOPE_AGENT); }
    LDS_WAIT(); asm volatile("" ::: "memory");
}
__device__ __forceinline__ void cvt_item8(const float* src, unsigned char* dst, int item, int lane, float sc) {
    const GAS f32x4* sp = (const GAS f32x4*)(src + (size_t)item * 512) + 2 * lane; f32x4 a = sp[0] * sc, b = sp[1] * sc;
    int w0 = 0, w1 = 0; w0 = __builtin_amdgcn_cvt_pk_fp8_f32(fminf(fmaxf(a.x, -448.f), 448.f), fminf(fmaxf(a.y, -448.f), 448.f), w0, false); w0 = __builtin_amdgcn_cvt_pk_fp8_f32(fminf(fmaxf(a.z, -448.f), 448.f), fminf(fmaxf(a.w, -448.f), 448.f), w0, true);
    w1 = __builtin_amdgcn_cvt_pk_fp8_f32(fminf(fmaxf(b.x, -448.f), 448.f), fminf(fmaxf(b.y, -448.f), 448.f), w1, false); w1 = __builtin_amdgcn_cvt_pk_fp8_f32(fminf(fmaxf(b.z, -448.f), 448.f), fminf(fmaxf(b.w, -448.f), 448.f), w1, true);
    *((GAS v2u*)(dst + (size_t)item * 512) + lane) = (v2u){(unsigned)w0, (unsigned)w1};
}
__device__ __forceinline__ void cvt_item(const float* src, bf16* dst, int item, int lane) {
    const GAS f32x4* s = (const GAS f32x4*)(src + (size_t)item * 512) + 2 * lane; const f32x4 a = s[0], b = s[1];
    v4u o; o.x = pk2(a.x, a.y); o.y = pk2(a.z, a.w); o.z = pk2(b.x, b.y); o.w = pk2(b.z, b.w);
    *((GAS v4u*)(dst + (size_t)item * 512) + lane) = o;
}
__device__ __forceinline__ void p0_prologue(const float* const (&in)[24], unsigned char* ws, LAS unsigned char* lds, int gw, int NGW, int wave, int lane) {
    LAS float* scr = (LAS float*)(lds + RING_OFF + wave * 16384);
#define TRM(SRC, Kk, LDW, NVALID, NPAD, DST, LDT, ROWMAP, DCOL) { constexpr int nblk = (NPAD) / 32; constexpr int cnt = ((Kk) / 64) * nblk; \
        if (r < cnt) { const int kb = r / nblk, nb = r % nblk, n0 = 32 * nb; tr_item(SRC, LDW, NVALID, (bf16*)(ws + (DST)), LDT, 64 * kb, n0, (ROWMAP), (DCOL), scr, lane); continue; } r -= cnt; }
#define TRM8(SRC, Kk, LDW, NN, DST, LDT, ROWMAP, SC) { constexpr int nblk = (NN) / 32; constexpr int cnt = ((Kk) / 64) * nblk; \
        if (r < cnt) { const int kb = r / nblk, nb = r % nblk, n0 = 32 * nb; tr_item8(SRC, LDW, (unsigned char*)(ws + (DST)), LDT, 64 * kb, n0, (ROWMAP), SC, scr, lane); continue; } r -= cnt; }
    long long* const vec = (long long*)(ws + WS_CTL + CTL_VEC);
#define TRML(SRC, Kk, LDW, NVALID, NPAD, DST, LDT, ROWMAP, GAIN, BVEC, VG, VB) { constexpr int nblk = (NPAD) / 32; constexpr int cnt = ((Kk) / 64) * nblk; \
        if (r < cnt) { const int kb = r / nblk, nb = r % nblk, n0 = 32 * nb; tr_item_ln(SRC, LDW, NVALID, (bf16*)(ws + (DST)), LDT, 64 * kb, n0, (ROWMAP), GAIN, BVEC, vec + (VG), vec + (VB), scr, lane); continue; } r -= cnt; }
#define TRML8(SRC, Kk, LDW, NN, DST, LDT, ROWMAP, SC, GAIN, BVEC, VG, VB) { constexpr int nblk = (NN) / 32; constexpr int cnt = ((Kk) / 64) * nblk; \
        if (r < cnt) { const int kb = r / nblk, nb = r % nblk, n0 = 32 * nb; tr_item8_ln(SRC, LDW, (unsigned char*)(ws + (DST)), LDT, 64 * kb, n0, (ROWMAP), SC, GAIN, BVEC, vec + (VG), vec + (VB), scr, lane); continue; } r -= cnt; }
    constexpr int N_TR = 2 * (32 * 176) + 88 * 64 + 32 * 184 + 2 * (32 * 64) + 256 + 2 * (16 * 64) + 32 * 64 + 32 * 16 + 32 * 32 + 8 * 64 + 2 * (32 * 176) + 88 * 64;
    for (int it = gw; it < N_TR; it += NGW) {
        int r = it;
        TRM8(in[2], 2048, 5632, 5632, WS_W_GU1, 2048, 256 * (n0 >> 7) + (n0 & 127), FP8_WGUS)
        TRM8(in[3], 2048, 5632, 5632, WS_W_GU1, 2048, 256 * (n0 >> 7) + 128 + (n0 & 127), FP8_WGUS)
        TRM8(in[4], 5632, 2048, 2048, WS_W_D1, 5632, n0, FP8_WDS)
        TRML(in[5], 2048, 5712, 5712, 5888, WS_W_IN, 2048, n0, in[22], in[23], V_GW_IN, V_BW_IN)
        TRML8(in[11], 2048, 2048, 2048, WS_W_G, 2048, 256 * (n0 >> 7) + (n0 & 127), FP8_WGS, in[22], in[23], V_GW_G, V_BW_G)
        TRML8(in[11] + (size_t)2048 * 2048, 2048, 2048, 2048, WS_W_G, 2048, 256 * (n0 >> 7) + 128 + (n0 & 127), FP8_WGS, in[22], in[23], V_GW_G, V_BW_G)
        if (r < 256) { const int h = r >> 5, rr = r & 31, kb = rr >> 2, nb = rr & 3;
            tr_item(in[10] + (size_t)h * 512 * 128, 128, 128, (bf16*)(ws + WS_W_UVP), 1024, 64 * kb, 32 * nb, (h >> 1) * 256 + (h & 1) * 128 + 32 * nb, (h & 1) * 512, scr, lane); continue; } r -= 256;
        TRM(in[13], 1024, 2048, 2048, 2048, WS_W_A, 1024, n0, 0)
        TRM(in[14], 1024, 2048, 2048, 2048, WS_W_B, 1024, n0, 0)
        TRM8(in[15], 2048, 2048, 2048, WS_W_MO, 2048, n0, FP8_WMOS)
        TRML(in[16], 2048, 512, 512, 512, WS_W_MQ, 2048, n0, in[22] + D, in[23] + D, V_GW_MQ, V_BW_MQ)
        TRM(in[17], 2048, 1024, 1024, 1024, WS_W_MKV, 2048, n0, 0)
        TRM(in[18], 512, 2048, 2048, 2048, WS_W_MOUT, 512, n0, 0)
        TRML8(in[19], 2048, 5632, 5632, WS_W_GU2, 2048, 256 * (n0 >> 7) + (n0 & 127), FP8_WGUS, in[22] + 2 * D, in[23] + 2 * D, V_GW_GU2, V_BW_GU2)
        TRML8(in[20], 2048, 5632, 5632, WS_W_GU2, 2048, 256 * (n0 >> 7) + 128 + (n0 & 127), FP8_WGUS, in[22] + 2 * D, in[23] + 2 * D, V_GW_GU2, V_BW_GU2)
        TRM8(in[21], 5632, 2048, 2048, WS_W_D2, 5632, n0, FP8_WDS)
    }
#undef TRM
#undef TRM8
#undef TRML
#undef TRML8
    for (int rw = gw; rw < 1024; rw += NGW) { const int e = (rw >> 7) & 1; *((GAS v4u*)((bf16*)(ws + WS_W_UVP) + (size_t)rw * 1024 + (1 - e) * 512) + lane) = (v4u){0u, 0u, 0u, 0u}; }
    for (int it = gw; it < (M * D) / 512; it += NGW) cvt_item8(in[0], (unsigned char*)(ws + WS_X8), it, lane, FP8_XS);
    for (int it = gw; it < (BATCH * MEMT * D) / 512; it += NGW) cvt_item(in[1], (bf16*)(ws + WS_MEM16), it, lane);
    for (int it = gw; it < (8 * 512 * 128) / 512; it += NGW) cvt_item(in[9], (bf16*)(ws + WS_W_UK), it, lane);
}

__device__ __forceinline__ void ln_phase(float* zx, bf16* x16, unsigned char* x8, const float* g, const float* b, int gw, int NGW, int lane) {
    f32x4 gv[8], bv[8];
#pragma unroll
    for (int j = 0; j < 8; ++j) { gv[j] = *((const GAS f32x4*)g + lane + 64 * j); bv[j] = *((const GAS f32x4*)b + lane + 64 * j); }
    for (int m = gw; m < M; m += NGW) {
        GAS f32x4* xr = (GAS f32x4*)(zx + (size_t)m * D) + lane;
        f32x4 v[8]; float s = 0.f;
#pragma unroll
        for (int j = 0; j < 8; ++j) { v[j] = xr[64 * j]; s += (v[j].x + v[j].y) + (v[j].z + v[j].w); }
        const float mean = wave_sum(s) * (1.f / D); float s2 = 0.f;
#pragma unroll
        for (int j = 0; j < 8; ++j) { v[j] = v[j] - mean; s2 += (v[j].x * v[j].x + v[j].y * v[j].y) + (v[j].z * v[j].z + v[j].w * v[j].w); }
        const float rstd = 1.f / sqrtf(wave_sum(s2) * (1.f / D) + LN_EPS);
#pragma unroll
        for (int j = 0; j < 8; ++j) { v[j] = v[j] * rstd * gv[j] + bv[j]; xr[64 * j] = v[j]; }
        if (x16) { GAS v2u* o8 = (GAS v2u*)(x16 + (size_t)m * D) + lane;
#pragma unroll
            for (int j = 0; j < 8; ++j) o8[64 * j] = (v2u){pk2(v[j].x, v[j].y), pk2(v[j].z, v[j].w)}; }
        if (x8) { GAS unsigned* o4 = (GAS unsigned*)(x8 + (size_t)m * D) + lane;
#pragma unroll
            for (int j = 0; j < 8; ++j) { const f32x4 q = v[j] * FP8_XS; int w = 0; w = __builtin_amdgcn_cvt_pk_fp8_f32(fminf(fmaxf(q.x, -448.f), 448.f), fminf(fmaxf(q.y, -448.f), 448.f), w, false);
                w = __builtin_amdgcn_cvt_pk_fp8_f32(fminf(fmaxf(q.z, -448.f), 448.f), fminf(fmaxf(q.w, -448.f), 448.f), w, true); o4[64 * j] = (unsigned)w; } }
    }
}
__device__ __forceinline__ void ln_final_phase(const bf16* z16, float* outp, const float* g, const float* b, int gw, int NGW, int lane) {
    for (int m = gw; m < M; m += NGW) {
        const GAS v4u* zr = (const GAS v4u*)(z16 + (size_t)m * D) + lane;
        float v[32]; float s = 0.f;
#pragma unroll
        for (int j = 0; j < 4; ++j) { const v4u w = zr[64 * j]; v[8 * j + 0] = blo(w.x); v[8 * j + 1] = bhi(w.x); v[8 * j + 2] = blo(w.y); v[8 * j + 3] = bhi(w.y); v[8 * j + 4] = blo(w.z); v[8 * j + 5] = bhi(w.z); v[8 * j + 6] = blo(w.w); v[8 * j + 7] = bhi(w.w); }
#pragma unroll
        for (int e = 0; e < 32; ++e) s += v[e];
        const float mean = wave_sum(s) * (1.f / D); float s2 = 0.f;
#pragma unroll
        for (int e = 0; e < 32; ++e) { v[e] -= mean; s2 += v[e] * v[e]; }
        const float rstd = 1.f / sqrtf(wave_sum(s2) * (1.f / D) + LN_EPS);
#pragma unroll
        for (int j = 0; j < 4; ++j) { const int c0 = 512 * j + 8 * lane;
            const f32x4 g0 = *(const GAS f32x4*)(g + c0), g1 = *(const GAS f32x4*)(g + c0 + 4), b0 = *(const GAS f32x4*)(b + c0), b1 = *(const GAS f32x4*)(b + c0 + 4);
            GAS f32x4* o = (GAS f32x4*)(outp + (size_t)m * D + c0);
            o[0] = (f32x4){v[8 * j + 0], v[8 * j + 1], v[8 * j + 2], v[8 * j + 3]} * rstd * g0 + b0; o[1] = (f32x4){v[8 * j + 4], v[8 * j + 5], v[8 * j + 6], v[8 * j + 7]} * rstd * g1 + b1; }
    }
}
__device__ __forceinline__ void crms_phase(const bf16* bc, unsigned char* c8, const float* kvg, float cs, int gw, int NGW, int lane) {
    float gg[8];
#pragma unroll
    for (int j = 0; j < 8; ++j) gg[j] = kvg[8 * lane + j] * cs;
    for (int m = gw; m < M; m += NGW) {
        const v4u w = *((const GAS v4u*)(bc + (size_t)m * 512) + lane);
        float x[8] = {blo(w.x), bhi(w.x), blo(w.y), bhi(w.y), blo(w.z), bhi(w.z), blo(w.w), bhi(w.w)}; float s = 0.f;
#pragma unroll
        for (int j = 0; j < 8; ++j) s += x[j] * x[j];
        const float r = 1.f / sqrtf(wave_sum(s) * (1.f / 512.f) + LN_EPS);
#pragma unroll
        for (int j = 0; j < 8; ++j) x[j] = fminf(fmaxf(x[j] * r * gg[j], -448.f), 448.f);
        *((GAS v2u*)(c8 + (size_t)m * 512) + lane) = (v2u){pg8::pk4_fp8(x[0], x[1], x[2], x[3]), pg8::pk4_fp8(x[4], x[5], x[6], x[7])};
    }
}
typedef short v4i16_t __attribute__((ext_vector_type(4)));
__device__ __forceinline__ v4i16_t lds_tr16(const LAS unsigned char* p) { return __builtin_amdgcn_ds_read_tr16_b64_v4i16((LAS v4i16_t*)p); }
__device__ __forceinline__ unsigned cvtpk(float lo, float hi) { typedef float f2 __attribute__((ext_vector_type(2))); typedef __bf16 b2 __attribute__((ext_vector_type(2))); f2 v = {lo, hi}; b2 b = __builtin_convertvector(v, b2); return __builtin_bit_cast(unsigned, b); }
__device__ __forceinline__ float xhalf_f(float v) { return __shfl_xor(v, 32); }
constexpr float LOG2E = 1.4426950408889634f;
constexpr float QSCALE = 0.125f * LOG2E;

__device__ __forceinline__ void diff_attn_mfma(LAS unsigned char* lds, const bf16* AQ, const bf16* AK, const bf16* AV, bf16* YA, const float* dlam, const float* subg, int vcu, int G, const int wave) {
    const int lane = lane_fresh(), r32 = lane & 31, hi = lane >> 5;
    const int comp = wave >> 2, wq = wave & 3;
    const unsigned ksrc = (unsigned)(lane * 1024 + (2 * wave) * 8);
    const unsigned vsrc0 = (unsigned)((16 * ((2 * wave) & 3) + (lane >> 2)) * 1024 + ((2 * wave) >> 2) * 32 + (lane & 3) * 8);
    const unsigned vsrc1 = (unsigned)((16 * ((2 * wave + 1) & 3) + (lane >> 2)) * 1024 + ((2 * wave + 1) >> 2) * 32 + (lane & 3) * 8);
    const unsigned kdst = (unsigned)(2 * wave) * 1024u, vdst0 = 16384u + (unsigned)(((2 * wave) >> 2) * 4096 + ((2 * wave) & 3) * 1024), vdst1 = 16384u + (unsigned)(((2 * wave + 1) >> 2) * 4096 + ((2 * wave + 1) & 3) * 1024);
    const unsigned lds0 = (unsigned)(uintptr_t)lds;
#define DA_STAGE(bo, to) do { \
        glds16(Kg + (to) + ksrc, (unsigned)__builtin_amdgcn_readfirstlane((int)(lds0 + (bo) + kdst))); \
        glds16(Kg + (to) + ksrc + 8, (unsigned)__builtin_amdgcn_readfirstlane((int)(lds0 + (bo) + kdst + 1024))); \
        glds16(Vg + (to) + vsrc0, (unsigned)__builtin_amdgcn_readfirstlane((int)(lds0 + (bo) + vdst0))); \
        glds16(Vg + (to) + vsrc1, (unsigned)__builtin_amdgcn_readfirstlane((int)(lds0 + (bo) + vdst1))); } while (0)
#define DA_WAITBAR() asm volatile("s_waitcnt vmcnt(0) lgkmcnt(0)\n\ts_barrier" ::: "memory")
    const unsigned koff = (unsigned)(((comp * 8 + hi) * 64 + r32) * 16);
    const unsigned voff = (unsigned)(16384 + (4 * hi + ((lane & 15) >> 2)) * 64 + ((lane >> 4) & 1) * 32 + (lane & 3) * 8);
    for (int j = vcu; j < 1024; j += G) {
        const int w = j & 255, i = j >> 8, bh = w >> 3, s8 = w & 7;
        const int ub = (i == 0) ? s8 : (i == 1) ? 15 - s8 : (i == 2) ? 16 + s8 : 31 - s8;
        const int b = bh >> 3, h = bh & 7;
        const float sl2 = LOG2E / (float)(2 << h);
        const size_t rowbase = (size_t)b * SEQ; const int q0 = ub * 128;
        const int qpos = q0 + wq * 32 + r32;
        const int nt = 2 * ub + 2;
        const int myt = 2 * ub + 1 + (wq >> 1);
        const bf16* Kg = AK + rowbase * 1024 + h * 128; const bf16* Vg = AV + rowbase * 1024 + h * 128;
        bf16x8 qr[4];
#pragma unroll
        for (int s = 0; s < 4; ++s) qr[s] = *(const GAS bf16x8*)(AQ + (rowbase + qpos) * 1024 + h * 128 + comp * 64 + s * 16 + hi * 8);
        f32x16 o[4];
#pragma unroll
        for (int blk = 0; blk < 4; ++blk)
#pragma unroll
            for (int r = 0; r < 16; ++r) o[blk][r] = 0.f;
        float mrun = -INFINITY, lrun = 0.f;
        DA_STAGE(0u, (size_t)(nt - 1) * 64 * 1024);
        DA_WAITBAR();
        for (int st = 0; st < nt; ++st) {
            const int kt = nt - 1 - st;
            const unsigned bufo = (unsigned)(st & 1) * 32768u;
            if (kt > 0) DA_STAGE(32768u - bufo, (size_t)(kt - 1) * 64 * 1024);
            if (kt < myt) {
                const LAS unsigned char* Kb = lds + bufo + koff;
                f32x16 p0, p1;
#pragma unroll
                for (int r = 0; r < 16; ++r) { p0[r] = 0.f; p1[r] = 0.f; }
                { bf16x8 kf[4];
#pragma unroll
                  for (int s = 0; s < 4; ++s) kf[s] = *(const LAS bf16x8*)(Kb + s * 2048);
#pragma unroll
                  for (int s = 0; s < 4; ++s) p0 = __builtin_amdgcn_mfma_f32_32x32x16_bf16(kf[s], qr[s], p0, 0, 0, 0); }
                { bf16x8 kf[4];
#pragma unroll
                  for (int s = 0; s < 4; ++s) kf[s] = *(const LAS bf16x8*)(Kb + s * 2048 + 512);
#pragma unroll
                  for (int s = 0; s < 4; ++s) p1 = __builtin_amdgcn_mfma_f32_32x32x16_bf16(kf[s], qr[s], p1, 0, 0, 0); }
                const float qth = (float)(qpos - kt * 64 - 4 * hi);
                float rm = -INFINITY;
#pragma unroll
                for (int r = 0; r < 16; ++r) { const float kr = (float)((r & 3) + 8 * (r >> 2)); const float v0 = qth - kr, v1 = qth - (kr + 32.f);
                    p0[r] = p0[r] - sl2 * fabsf(v0); p1[r] = p1[r] - sl2 * fabsf(v1); rm = fmaxf(rm, fmaxf(p0[r], p1[r])); }
                rm = fmaxf(rm, xhalf_f(rm));
                if (__any(rm > mrun)) { const float mn = fmaxf(mrun, rm), f = __builtin_amdgcn_exp2f(mrun - mn); mrun = mn; lrun *= f;
#pragma unroll
                    for (int blk = 0; blk < 4; ++blk)
#pragma unroll
                        for (int r = 0; r < 16; ++r) o[blk][r] *= f; }
                float ls = 0.f;
#pragma unroll
                for (int r = 0; r < 16; ++r) { p0[r] = __builtin_amdgcn_exp2f(p0[r] - mrun); p1[r] = __builtin_amdgcn_exp2f(p1[r] - mrun); ls += p0[r] + p1[r]; }
                lrun += ls;
                bf16x8 pw[4];
#pragma unroll
                for (int s = 0; s < 2; ++s) {
                    v4u a = {cvtpk(p0[8 * s + 0], p0[8 * s + 1]), cvtpk(p0[8 * s + 2], p0[8 * s + 3]), cvtpk(p0[8 * s + 4], p0[8 * s + 5]), cvtpk(p0[8 * s + 6], p0[8 * s + 7])};
                    v4u c = {cvtpk(p1[8 * s + 0], p1[8 * s + 1]), cvtpk(p1[8 * s + 2], p1[8 * s + 3]), cvtpk(p1[8 * s + 4], p1[8 * s + 5]), cvtpk(p1[8 * s + 6], p1[8 * s + 7])};
                    pw[s] = __builtin_bit_cast(bf16x8, a); pw[2 + s] = __builtin_bit_cast(bf16x8, c); }
                const LAS unsigned char* Vb = lds + bufo + voff;
#pragma unroll
                for (int blk = 0; blk < 4; ++blk) {
#pragma unroll
                    for (int s = 0; s < 4; ++s) {
                        const v4i16_t lo = lds_tr16(Vb + blk * 4096 + s * 1024), hh = lds_tr16(Vb + blk * 4096 + s * 1024 + 512);
                        const bf16x8 vf = {lo[0], lo[1], lo[2], lo[3], hh[0], hh[1], hh[2], hh[3]};
                        o[blk] = __builtin_amdgcn_mfma_f32_32x32x16_bf16(vf, pw[s], o[blk], 0, 0, 0);
                    }
                }
            }
            DA_WAITBAR();
        }
        lrun += xhalf_f(lrun);
        const float inv = 1.f / lrun;
        LAS float* Y1 = (LAS float*)(lds) + wq * 4096;
        if (comp == 1) {
            float lam; { float a = dlam[lane] * dlam[64 + lane], bq_ = dlam[128 + lane] * dlam[192 + lane]; a = wave_sum(a); bq_ = wave_sum(bq_); lam = __expf(a) - __expf(bq_) + LAMBDA_INIT; }
            const float sc = inv * lam;
#pragma unroll
            for (int blk = 0; blk < 4; ++blk)
#pragma unroll
                for (int r = 0; r < 16; ++r) Y1[(32 * blk + (r & 3) + 8 * (r >> 2) + 4 * hi) * 32 + r32] = o[blk][r] * sc; }
        __syncthreads();
        if (comp == 0) {
            float ss = 0.f;
#pragma unroll
            for (int blk = 0; blk < 4; ++blk)
#pragma unroll
                for (int r = 0; r < 16; ++r) { const float a = o[blk][r] * inv - Y1[(32 * blk + (r & 3) + 8 * (r >> 2) + 4 * hi) * 32 + r32]; o[blk][r] = a; ss += a * a; }
            ss += xhalf_f(ss);
            const float rr = (1.0f - LAMBDA_INIT) / sqrtf(ss * (1.f / 128.f) + LN_EPS);
            LAS unsigned* stg = (LAS unsigned*)(lds + 65536) + wq * (32 * 65);
#pragma unroll
            for (int blk = 0; blk < 4; ++blk) {
#pragma unroll
                for (int r = 0; r < 16; r += 2) { const int e = 32 * blk + (r & 3) + 8 * (r >> 2) + 4 * hi;
                    stg[r32 * 65 + (e >> 1)] = cvtpk(o[blk][r] * rr * subg[e], o[blk][r + 1] * rr * subg[e + 1]); }
                asm volatile("" ::: "memory"); }
            LDS_WAIT(); asm volatile("" ::: "memory");
            bf16* orow = YA + (rowbase + q0 + wq * 32) * 1024 + h * 128;
#pragma unroll 4
            for (int row = 0; row < 32; ++row) *((GAS unsigned*)(orow + (size_t)row * 1024) + lane) = stg[row * 65 + lane];
        }
        __syncthreads();
    }
#undef DA_STAGE
#undef DA_WAITBAR
}

__device__ __forceinline__ unsigned okey(float f) { const unsigned u = __float_as_uint(f); return (u & 0x80000000u) ? ~u : (u | 0x80000000u); }
__device__ __forceinline__ void indexer_topk(LAS unsigned char* lds, const bf16* IQ, const bf16* IKW, unsigned short* IDX, int vcu, int G, const int wave) {
    const int lane = lane_fresh(), r32 = lane & 31, hi = lane >> 5;
    const unsigned lds0 = (unsigned)(uintptr_t)lds;
    const unsigned boff = (unsigned)((hi * 256 + r32) * 16);
    for (int j = vcu; j < 1024; j += G) {
        const int w = j & 255, i = j >> 8, bq = w >> 4, s16 = w & 15;
        const int chunk = (i == 0) ? s16 : (i == 1) ? 31 - s16 : (i == 2) ? 32 + s16 : 63 - s16;
        const int b = bq >> 2, gq = bq & 3;
        const int t0 = b * SEQ + chunk * 64 + gq * 16 + 2 * wave;
        const int ngroups = 2 * (chunk + 1);
        const int ntiles = (ngroups + 7) >> 3;
        const bf16* Kg = IKW + (size_t)b * SEQ * 256;
#define IX_STAGE(tile, bo) do { int tl_ = (tile); asm volatile("" : "+s"(tl_)); _Pragma("unroll") for (int i_ = 0; i_ < 4; ++i_) { const int q_ = 4 * wave + i_; \
            glds16s(Kg + (size_t)(tl_ * 256 + 64 * (q_ & 3)) * 256 + (q_ >> 2) * 8, (unsigned)lane * 512u, (unsigned)__builtin_amdgcn_readfirstlane((int)(lds0 + (bo) + ((q_ >> 2) * 256 + 64 * (q_ & 3)) * 16))); } } while (0)
        asm volatile("s_barrier" ::: "memory");
        IX_STAGE(0, 0u);
        bf16x8 a[4];
#pragma unroll
        for (int ks = 0; ks < 4; ++ks) a[ks] = *(const GAS bf16x8*)(IQ + (size_t)(t0 + (r32 >> 4)) * 1024 + (r32 & 15) * 64 + ks * 16 + 8 * hi);
        float wv[16];
        { const bf16* iwp = IKW + (size_t)t0 * 256 + 64 + 4 * hi;
          const v2u w00 = *(const GAS v2u*)(iwp), w01 = *(const GAS v2u*)(iwp + 8), w10 = *(const GAS v2u*)(iwp + 256), w11 = *(const GAS v2u*)(iwp + 256 + 8);
          wv[0] = blo(w00.x); wv[1] = bhi(w00.x); wv[2] = blo(w00.y); wv[3] = bhi(w00.y); wv[4] = blo(w01.x); wv[5] = bhi(w01.x); wv[6] = blo(w01.y); wv[7] = bhi(w01.y);
          wv[8] = blo(w10.x); wv[9] = bhi(w10.x); wv[10] = blo(w10.y); wv[11] = bhi(w10.y); wv[12] = blo(w11.x); wv[13] = bhi(w11.x); wv[14] = blo(w11.y); wv[15] = bhi(w11.y); }
        unsigned key[128];
#pragma unroll 128
        for (int g = 0; g < 128; ++g) {
            if (g < ngroups) {
                const unsigned bufo = (unsigned)((g >> 3) & 1) * 32768u;
                if ((g & 7) == 0) {
                    asm volatile("s_waitcnt vmcnt(0)\n\ts_barrier" ::: "memory");
                    if ((g >> 3) + 1 < ntiles) IX_STAGE((g >> 3) + 1, 32768u - bufo);
                }
                bf16x8 bk[4];
#pragma unroll
                for (int ks = 0; ks < 4; ++ks) bk[ks] = *(const LAS bf16x8*)(lds + bufo + boff + (g & 7) * 512 + ks * 8192);
                f32x16 acc = {0.f, 0.f, 0.f, 0.f, 0.f, 0.f, 0.f, 0.f, 0.f, 0.f, 0.f, 0.f, 0.f, 0.f, 0.f, 0.f};
#pragma unroll
                for (int ks = 0; ks < 4; ++ks) acc = __builtin_amdgcn_mfma_f32_32x32x16_bf16(a[ks], bk[ks], acc, 0, 0, 0);
                float s0 = 0.f, s1 = 0.f;
#pragma unroll
                for (int r = 0; r < 8; ++r) { s0 += wv[r] * fmaxf(acc[r], 0.f); s1 += wv[8 + r] * fmaxf(acc[8 + r], 0.f); }
                s0 += __shfl_xor(s0, 32); s1 += __shfl_xor(s1, 32);
                key[g] = okey(hi ? s1 : s0);
            } else key[g] = 0u;
        }
        unsigned T = 0u;
        if (chunk >= 4) {
            bool done = false;
#pragma nounroll
            for (int bit = 31; bit >= 0; --bit) {
                if (__all(done ? 1 : 0)) break;
                const unsigned trial = T | (1u << bit);
                int cnt = 0;
#pragma unroll
                for (int g = 0; g < 128; ++g) cnt += (key[g] >= trial) ? 1 : 0;
                cnt += __shfl_xor(cnt, 1); cnt += __shfl_xor(cnt, 2); cnt += __shfl_xor(cnt, 4); cnt += __shfl_xor(cnt, 8); cnt += __shfl_xor(cnt, 16);
                if (!done && cnt >= 256) { T = trial; if (cnt == 256) done = true; }
            }
        }
        int base = 0;
        unsigned short* ip = IDX + (size_t)(t0 + hi) * 256;
#pragma unroll
        for (int g = 0; g < 128; ++g) {
            if (g < ngroups) {
                const bool sel = key[g] >= T;
                const unsigned long long mk = __ballot(sel ? 1 : 0);
                const unsigned mh = hi ? (unsigned)(mk >> 32) : (unsigned)mk;
                const int pos = base + __popc(mh & ((1u << r32) - 1u));
                if (sel && pos < 256) ip[pos] = (unsigned short)(32 * g + r32);
                base += __popc(mh);
            }
        }
    }
#undef IX_STAGE
    asm volatile("s_waitcnt vmcnt(0) lgkmcnt(0)\n\ts_barrier" ::: "memory");
}

constexpr int DSA_PAIRB = 1040;
constexpr int DSA_WAVEB = 16 * DSA_PAIRB + 512;
constexpr int DSA_LDS_END = 8 * DSA_WAVEB;
constexpr float DSA_CS = 64.f, DSA_QS = 64.f, DSA_PS = 256.f;
typedef int v2i_t __attribute__((ext_vector_type(2)));
__device__ __forceinline__ void dsa_mfma(LAS unsigned char* lds, const bf16* QL, bf16* OL, const int omask, const unsigned char* C8, const unsigned short* IDX, int vcu, int G, const int wave) {
    const int lane = lane_fresh(), h16 = lane & 15, g = lane >> 4;
    LAS unsigned char* wl = lds + wave * DSA_WAVEB;
    const unsigned wl0 = (unsigned)(uintptr_t)wl;
    LAS unsigned short* idxs = (LAS unsigned short*)(wl + 16 * DSA_PAIRB);
    const float sc2 = 0.08838834764831845f * LOG2E / (DSA_QS * DSA_CS);
    const float sl2 = (h16 < 8) ? LOG2E / (float)(2 << (h16 & 7)) : 0.f;
    const int ntok = (G == 256) ? 8 : (M - (vcu * 8 + wave) + G * 8 - 1) / (G * 8);
#define DSA_TOK(i) ((G == 256) ? ((vcu >> 6) * SEQ + (vcu & 63) + 64 * (wave + 8 * (i))) : (vcu * 8 + wave + G * 8 * (i)))
    const unsigned qk_off = (unsigned)((h16 >> 1) * DSA_PAIRB + (h16 & 1) * 512 + 32 * g);
    const int trow = (h16 >> 1) < 4 ? 4 * g + (h16 >> 1) : 16 + 4 * g + ((h16 >> 1) - 4);
    const unsigned pv_off = (unsigned)((trow >> 1) * DSA_PAIRB + (trow & 1) * 512 + 8 * (h16 & 1));
    for (int it = 0; it < ntok; ++it) {
        const int t = DSA_TOK(it); const int tpos = t & (SEQ - 1);
        const int n = (tpos >> 6) >= 3 ? 256 : 64 * ((tpos >> 6) + 1); const int nst = n >> 5;
        const unsigned char* Cb = C8 + (size_t)(t >> 12) * SEQ * 512;
        int ln = lane; asm volatile("" : "+v"(ln));
        const int h16b = ln & 15, gb = ln >> 4;
        { const v2u iv = __builtin_nontemporal_load((const GAS v2u*)(IDX + (size_t)t * 256) + ln); *((LAS v2u*)idxs + ln) = iv; }
        pg8::v8i_t qf[4];
        { const bf16* qp = QL + (size_t)t * 4096 + (h16b & 7) * 512 + 32 * gb;
#pragma unroll
          for (int s = 0; s < 4; ++s) { unsigned w8[8];
#pragma unroll
              for (int c = 0; c < 4; ++c) { const v4u w = __builtin_nontemporal_load((const GAS v4u*)(qp + 128 * s + 8 * c));
                  w8[2 * c] = pg8::pk4_fp8(fminf(fmaxf(blo(w.x) * DSA_QS, -448.f), 448.f), fminf(fmaxf(bhi(w.x) * DSA_QS, -448.f), 448.f), fminf(fmaxf(blo(w.y) * DSA_QS, -448.f), 448.f), fminf(fmaxf(bhi(w.y) * DSA_QS, -448.f), 448.f));
                  w8[2 * c + 1] = pg8::pk4_fp8(fminf(fmaxf(blo(w.z) * DSA_QS, -448.f), 448.f), fminf(fmaxf(bhi(w.z) * DSA_QS, -448.f), 448.f), fminf(fmaxf(blo(w.w) * DSA_QS, -448.f), 448.f), fminf(fmaxf(bhi(w.w) * DSA_QS, -448.f), 448.f)); }
              qf[s] = (pg8::v8i_t){(int)w8[0], (int)w8[1], (int)w8[2], (int)w8[3], (int)w8[4], (int)w8[5], (int)w8[6], (int)w8[7]}; } }
        f32x4 o[32];
#pragma unroll
        for (int blk = 0; blk < 32; ++blk) o[blk] = (f32x4){0.f, 0.f, 0.f, 0.f};
        float mrun = -INFINITY, lrun = 0.f;
        asm volatile("s_waitcnt vmcnt(0) lgkmcnt(0)" ::: "memory");
        for (int st = 0; st < nst; ++st) {
#pragma unroll
            for (int i = 0; i < 16; ++i) { const unsigned srow = idxs[st * 32 + 2 * i + (lane >> 5)];
                glds16s(Cb, srow * 512u + (unsigned)(lane & 31) * 16u, (unsigned)__builtin_amdgcn_readfirstlane((int)(wl0 + i * DSA_PAIRB))); }
            asm volatile("s_waitcnt vmcnt(0)" ::: "memory");
            f32x4 a0 = {0.f, 0.f, 0.f, 0.f}, a1 = {0.f, 0.f, 0.f, 0.f};
#pragma unroll
            for (int s = 0; s < 4; ++s) {
                const pg8::v4i_t x0 = *(const LAS pg8::v4i_t*)(wl + qk_off + 128 * s), x1 = *(const LAS pg8::v4i_t*)(wl + qk_off + 128 * s + 16);
                const pg8::v4i_t y0 = *(const LAS pg8::v4i_t*)(wl + qk_off + 8 * DSA_PAIRB + 128 * s), y1 = *(const LAS pg8::v4i_t*)(wl + qk_off + 8 * DSA_PAIRB + 128 * s + 16);
                a0 = __builtin_amdgcn_mfma_scale_f32_16x16x128_f8f6f4(__builtin_shufflevector(x0, x1, 0, 1, 2, 3, 4, 5, 6, 7), qf[s], a0, 0, 0, 0, 0x7f7f7f7f, 0, 0x7f7f7f7f);
                a1 = __builtin_amdgcn_mfma_scale_f32_16x16x128_f8f6f4(__builtin_shufflevector(y0, y1, 0, 1, 2, 3, 4, 5, 6, 7), qf[s], a1, 0, 0, 0, 0x7f7f7f7f, 0, 0x7f7f7f7f); }
            const v2u i0 = *(const LAS v2u*)(idxs + st * 32 + 4 * g), i1 = *(const LAS v2u*)(idxs + st * 32 + 16 + 4 * g);
            const int sidx[8] = {(int)(i0.x & 0xffffu), (int)(i0.x >> 16), (int)(i0.y & 0xffffu), (int)(i0.y >> 16), (int)(i1.x & 0xffffu), (int)(i1.x >> 16), (int)(i1.y & 0xffffu), (int)(i1.y >> 16)};
            float lg[8];
#pragma unroll
            for (int r = 0; r < 8; ++r) { const int d = tpos - sidx[r]; lg[r] = (r < 4 ? a0[r & 3] : a1[r & 3]) * sc2 - sl2 * (float)(d < 0 ? -d : d); }
            float rm = fmaxf(fmaxf(fmaxf(lg[0], lg[1]), fmaxf(lg[2], lg[3])), fmaxf(fmaxf(lg[4], lg[5]), fmaxf(lg[6], lg[7])));
            rm = fmaxf(rm, __shfl_xor(rm, 16)); rm = fmaxf(rm, __shfl_xor(rm, 32));
            const float mn = fmaxf(mrun, rm), f = __builtin_amdgcn_exp2f(mrun - mn); mrun = mn;
#pragma unroll
            for (int r = 0; r < 8; ++r) lg[r] = __builtin_amdgcn_exp2f(lg[r] - mn) * DSA_PS;
            const unsigned pw0 = pg8::pk4_fp8(lg[0], lg[1], lg[2], lg[3]), pw1 = pg8::pk4_fp8(lg[4], lg[5], lg[6], lg[7]);
            { const float ps = ((__builtin_amdgcn_cvt_f32_fp8((int)pw0, 0) + __builtin_amdgcn_cvt_f32_fp8((int)pw0, 1)) + (__builtin_amdgcn_cvt_f32_fp8((int)pw0, 2) + __builtin_amdgcn_cvt_f32_fp8((int)pw0, 3)))
                           + ((__builtin_amdgcn_cvt_f32_fp8((int)pw1, 0) + __builtin_amdgcn_cvt_f32_fp8((int)pw1, 1)) + (__builtin_amdgcn_cvt_f32_fp8((int)pw1, 2) + __builtin_amdgcn_cvt_f32_fp8((int)pw1, 3)));
              lrun = lrun * f + ps; }
            const long pw = (long)(((unsigned long)pw1 << 32) | (unsigned long)pw0);
#pragma unroll
            for (int blk = 0; blk < 32; ++blk) {
                const v2i_t av = __builtin_amdgcn_ds_read_tr8_b64_v2i32((LAS v2i_t*)(wl + pv_off + 16 * blk));
                const long al = (long)(((unsigned long)(unsigned)av.y << 32) | (unsigned long)(unsigned)av.x);
                o[blk] = __builtin_amdgcn_mfma_f32_16x16x32_fp8_fp8(al, pw, o[blk] * f, 0, 0, 0);
                if ((blk & 3) == 3) __builtin_amdgcn_sched_barrier(0);
            }
        }
        float lt = lrun; lt += __shfl_xor(lt, 16); lt += __shfl_xor(lt, 32);
        const float inv = 1.f / (lt * DSA_CS);
        if (h16 < 8) {
#pragma unroll
            for (int blk = 0; blk < 32; ++blk) { const f32x4 v = o[blk] * inv;
                __builtin_nontemporal_store((v2u){cvtpk(v.x, v.y), cvtpk(v.z, v.w)}, (GAS v2u*)(OL + (size_t)(t & omask) * 4096 + h16b * 512 + 16 * blk + 4 * gb)); } }
    }
    asm volatile("s_waitcnt vmcnt(0) lgkmcnt(0)" ::: "memory");
    __syncthreads();
#undef DSA_TOK
}
static_assert(DSA_LDS_END <= RING_BYTES, "DSA LDS map");

__device__ __forceinline__ void memattn_mfma(LAS unsigned char* lds, const bf16* QM, const bf16* KV, bf16* OM, int vcu, int G, const int wave) {
    const int lane = lane_fresh(), r32 = lane & 31, hi = lane >> 5;
    const unsigned voff = (unsigned)(65536 + (4 * hi + ((lane & 15) >> 2)) * 64 + ((lane >> 4) & 1) * 32 + (lane & 3) * 8);
    for (int j = vcu; j < 256; j += G) {
        const int bh = j >> 4, qb = j & 15, b = bh >> 2, h = bh & 3;
        const bf16* Kg = KV + (size_t)b * MEMT * 1024 + h * 128; const bf16* Vg = Kg + 512;
#pragma unroll
        for (int i = 0; i < 8; ++i) { const int q = 8 * wave + i;
            glds16(Kg + (size_t)(64 * (q & 3) + lane) * 1024 + (q >> 2) * 8, (unsigned)__builtin_amdgcn_readfirstlane((int)((unsigned)(uintptr_t)lds + ((q >> 2) * 256 + 64 * (q & 3)) * 16)));
            glds16(Vg + (size_t)(16 * (q & 15) + (lane >> 2)) * 1024 + (q >> 4) * 32 + (lane & 3) * 8, (unsigned)__builtin_amdgcn_readfirstlane((int)((unsigned)(uintptr_t)lds + 65536 + (q >> 4) * 16384 + (q & 15) * 1024))); }
        const size_t qrow = (size_t)b * SEQ + qb * 256 + wave * 32 + r32;
        bf16x8 qr[8];
#pragma unroll
        for (int s = 0; s < 8; ++s) qr[s] = *(const GAS bf16x8*)(QM + qrow * 512 + h * 128 + s * 16 + hi * 8);
        f32x16 o[4];
#pragma unroll
        for (int blk = 0; blk < 4; ++blk)
#pragma unroll
            for (int r = 0; r < 16; ++r) o[blk][r] = 0.f;
        float mrun = -INFINITY, lrun = 0.f;
        asm volatile("s_waitcnt vmcnt(0) lgkmcnt(0)\n\ts_barrier" ::: "memory");
        for (int kt = 0; kt < 4; ++kt) {
            const LAS unsigned char* Kb = lds + (unsigned)((hi * 256 + 64 * kt + r32) * 16);
            f32x16 p0, p1;
#pragma unroll
            for (int r = 0; r < 16; ++r) { p0[r] = 0.f; p1[r] = 0.f; }
#pragma unroll
            for (int s = 0; s < 8; ++s) { const bf16x8 k0 = *(const LAS bf16x8*)(Kb + s * 8192), k1 = *(const LAS bf16x8*)(Kb + s * 8192 + 512);
                p0 = __builtin_amdgcn_mfma_f32_32x32x16_bf16(k0, qr[s], p0, 0, 0, 0); p1 = __builtin_amdgcn_mfma_f32_32x32x16_bf16(k1, qr[s], p1, 0, 0, 0); }
            float rm = -INFINITY;
#pragma unroll
            for (int r = 0; r < 16; ++r) rm = fmaxf(rm, fmaxf(p0[r], p1[r]));
            rm = fmaxf(rm, xhalf_f(rm));
            if (__any(rm > mrun)) { const float mn = fmaxf(mrun, rm), f = __builtin_amdgcn_exp2f(mrun - mn); mrun = mn; lrun *= f;
#pragma unroll
                for (int blk = 0; blk < 4; ++blk)
#pragma unroll
                    for (int r = 0; r < 16; ++r) o[blk][r] *= f; }
            float ls = 0.f;
#pragma unroll
            for (int r = 0; r < 16; ++r) { p0[r] = __builtin_amdgcn_exp2f(p0[r] - mrun); p1[r] = __builtin_amdgcn_exp2f(p1[r] - mrun); ls += p0[r] + p1[r]; }
            lrun += ls;
            bf16x8 pw[4];
#pragma unroll
            for (int s = 0; s < 2; ++s) {
                v4u a = {cvtpk(p0[8 * s + 0], p0[8 * s + 1]), cvtpk(p0[8 * s + 2], p0[8 * s + 3]), cvtpk(p0[8 * s + 4], p0[8 * s + 5]), cvtpk(p0[8 * s + 6], p0[8 * s + 7])};
                v4u c = {cvtpk(p1[8 * s + 0], p1[8 * s + 1]), cvtpk(p1[8 * s + 2], p1[8 * s + 3]), cvtpk(p1[8 * s + 4], p1[8 * s + 5]), cvtpk(p1[8 * s + 6], p1[8 * s + 7])};
                pw[s] = __builtin_bit_cast(bf16x8, a); pw[2 + s] = __builtin_bit_cast(bf16x8, c); }
            const LAS unsigned char* Vb = lds + voff + kt * 4096;
#pragma unroll
            for (int blk = 0; blk < 4; ++blk) {
#pragma unroll
                for (int s = 0; s < 4; ++s) {
                    const v4i16_t lo = lds_tr16(Vb + blk * 16384 + s * 1024), hh = lds_tr16(Vb + blk * 16384 + s * 1024 + 512);
                    const bf16x8 vf = {lo[0], lo[1], lo[2], lo[3], hh[0], hh[1], hh[2], hh[3]};
                    o[blk] = __builtin_amdgcn_mfma_f32_32x32x16_bf16(vf, pw[s], o[blk], 0, 0, 0);
                }
            }
        }
        __syncthreads();
        lrun += xhalf_f(lrun);
        const float inv = 1.f / lrun;
        LAS unsigned* stg = (LAS unsigned*)(lds) + wave * (32 * 65);
#pragma unroll
        for (int blk = 0; blk < 4; ++blk)
#pragma unroll
            for (int r = 0; r < 16; r += 2) { const int e = 32 * blk + (r & 3) + 8 * (r >> 2) + 4 * hi;
                stg[r32 * 65 + (e >> 1)] = cvtpk(o[blk][r] * inv, o[blk][r + 1] * inv); }
        LDS_WAIT(); asm volatile("" ::: "memory");
        bf16* orow = OM + ((size_t)b * SEQ + qb * 256 + wave * 32) * 512 + h * 128;
#pragma unroll 4
        for (int row = 0; row < 32; ++row) *((GAS unsigned*)(orow + (size_t)row * 512) + lane) = stg[row * 65 + lane];
        __syncthreads();
    }
}

constexpr int N_PHASES = 21;
struct Args { const float* in[24]; float* out; unsigned char* ws; int ph_lo, ph_hi; };
__global__ void __launch_bounds__(NWAVES * 64, 2) mk_fwd(Args args) {
    extern __shared__ __attribute__((aligned(16))) unsigned char lds_raw[];
    LAS unsigned char* lds = (LAS unsigned char*)lds_raw;
    volatile LAS unsigned* MISC = (volatile LAS unsigned*)(lds + MISC_OFF);
    const int tid = threadIdx.x, wave = __builtin_amdgcn_readfirstlane(tid >> 6);
#define lane lane_fresh()
    const int G = gridDim.x, bx = blockIdx.x;
    const int vcu = (G % 8 == 0) ? (bx % 8) * (G / 8) + bx / 8 : bx;
    const int gw = vcu * NWAVES + wave, NGW = G * NWAVES;
    unsigned char* ws = args.ws;
    gu32* ctl = (gu32*)(ws + WS_CTL);
    for (int u = tid; u < (LDS_BYTES - LDSCTL_OFF) / 4; u += NWAVES * 64) ((LAS unsigned*)(lds + LDSCTL_OFF))[u] = 0u;
    __syncthreads();
    const bool one = (args.ph_hi - args.ph_lo) > 1;
    XcdBarrier bar; bar.bar = (unsigned*)(ctl + CW_BAR); bar.x = 0; bar.st = nullptr;
    if (one) bar = xcd_barrier_post((unsigned*)(ctl + CW_BAR), MISC + 8, tid == 0);
    const int lo = args.ph_lo, hi = args.ph_hi;
#ifndef PH_MASK
#define PH_MASK 0xFFFFFFFFu
#endif
#define IN(k) ((((PH_MASK) >> (k)) & 1u) && lo <= (k) && (k) < hi)
#define SEAM(k) do { if (IN(k) && IN((k) + 1)) xcd_barrier(bar, wave); } while (0)
    bf16* const X16 = (bf16*)(ws + WS_X16); bf16* const HB = (bf16*)(ws + WS_H);
    long long* const ST0 = (long long*)(ws + WS_CTL + CTL_STATS); long long* const ST1 = (long long*)(ws + WS_CTL + CTL_STATS + CTL_STATS_STRIDE); long long* const ST2 = (long long*)(ws + WS_CTL + CTL_STATS + 2 * CTL_STATS_STRIDE);
    const float* const VEC = (const float*)(ws + WS_CTL + CTL_VECF);
    float* const out = args.out;
    const float* const ln_g = args.in[22]; const float* const ln_b = args.in[23];
    using namespace pg8;

#ifdef PROBE_P0
    if (IN(0)) { p0_prologue(args.in, ws, lds, gw, NGW, wave, lane); }
#endif
    if (IN(0)) { p0_prologue(args.in, ws, lds, gw, NGW, wave, lane); }
    SEAM(0);
    if (IN(1)) { { const long long* vi = (const long long*)(ws + WS_CTL + CTL_VEC); float* vf = (float*)(ws + WS_CTL + CTL_VECF); for (int i = gw * 64 + lane; i < V_END; i += NGW * 64) vf[i] = (float)vi[i] * (1.0f / 16777216.f); }
        Gemm g{(const bf16*)(ws + WS_X8), (const bf16*)(ws + WS_W_GU1), D / 2, D / 2, D / 2, 0, 0}; StaticOrder S; S.init(M, 2 * FF, G, bx); EpiSwiGLU8 E{(unsigned char*)HB, FF, 1.0f / (FP8_XS * FP8_WGUS), FP8_HS, LnFold{nullptr, nullptr, nullptr}};
        gemm_phase<EpiSwiGLU8, StaticOrder, true, true>(lds + RING_OFF, g, S, E, wave); }
    SEAM(1);
    if (IN(2)) { Gemm g{HB, (const bf16*)(ws + WS_W_D1), FF / 2, FF / 2, FF / 2, 0, 0}; StaticOrder S; S.init(M, D, G, bx); EpiRes E{args.in[0], nullptr, D, ALPHA, 0.5f / (FP8_HS * FP8_WDS), nullptr, nullptr, nullptr, ST0, X16, (unsigned char*)(ws + WS_X8M), FP8_XS};
        gemm_phase<EpiRes, StaticOrder, true, true>(lds + RING_OFF, g, S, E, wave); }
    SEAM(2);
    if (IN(4)) {
        { Gemm g{X16, (const bf16*)(ws + WS_W_IN), D, D, D, 0, 0}; StaticOrder S; S.init(M, N_IN, G, bx);
          EpiInProj E{(bf16*)(ws + WS_AQ), (bf16*)(ws + WS_AK), (bf16*)(ws + WS_AV), (bf16*)(ws + WS_BQ), (bf16*)(ws + WS_BC), (bf16*)(ws + WS_IQ), (bf16*)(ws + WS_IKW), QSCALE, LnFold{ST0, VEC + V_GW_IN, VEC + V_BW_IN}};
          gemm_phase<EpiInProj, StaticOrder, true>(lds + RING_OFF, g, S, E, wave); }
        { Gemm g{(const bf16*)(ws + WS_MEM16), (const bf16*)(ws + WS_W_MKV), D, D, D, 0, 0}; StaticOrder S; S.init(BATCH * MEMT, 1024, G, bx >= G - 16 ? bx - (G - 16) : (1 << 20)); EpiBf16 E{(bf16*)(ws + WS_KVMEM), 1024};
          gemm_phase<EpiBf16, StaticOrder, true>(lds + RING_OFF, g, S, E, wave); }
    }
    SEAM(4);
    if (IN(5)) {
        { Gemm g{(const bf16*)(ws + WS_BQ), (const bf16*)(ws + WS_W_UK), 1024, 128, 128, 1, 128}; StaticOrder S; S.init(M, 4096, G, bx); EpiBf16 E{(bf16*)(ws + WS_QLAT), 4096};
          gemm_phase<EpiBf16, StaticOrder, true>(lds + RING_OFF, g, S, E, wave); }
        crms_phase((const bf16*)(ws + WS_BC), (unsigned char*)(ws + WS_C8), args.in[8], DSA_CS, gw, NGW, lane);
    }
#ifdef PROBE_P6
    if (IN(6)) diff_attn_mfma(lds, (const bf16*)(ws + WS_AQ), (const bf16*)(ws + WS_AK), (const bf16*)(ws + WS_AV), (bf16*)(ws + WS_BQ), args.in[6], args.in[7], vcu, G, wave);
#endif
    if (IN(6)) diff_attn_mfma(lds, (const bf16*)(ws + WS_AQ), (const bf16*)(ws + WS_AK), (const bf16*)(ws + WS_AV), (bf16*)(ws + WS_AQ), args.in[6], args.in[7], vcu, G, wave);
    if (IN(7)) indexer_topk(lds, (const bf16*)(ws + WS_IQ), (const bf16*)(ws + WS_IKW), (unsigned short*)(ws + WS_IDX), vcu, G, wave);
    SEAM(7);
    if (IN(8)) dsa_mfma(lds, (const bf16*)(ws + WS_QLAT), (bf16*)(ws + WS_QLAT), 0x7fffffff, (const unsigned char*)(ws + WS_C8), (const unsigned short*)(ws + WS_IDX), vcu, G, wave);
    SEAM(8);
    if (IN(9)) { Gemm g{(const bf16*)(ws + WS_QLAT), (const bf16*)(ws + WS_W_UVP), 4096, 1024, 1024, 0, 1024}; StaticOrder S; S.init(M, 1024, G, bx); EpiBf16 E{(bf16*)(ws + WS_YB), 1024};
        gemm_phase<EpiBf16, StaticOrder, true>(lds + RING_OFF, g, S, E, wave); }
    SEAM(9);
    if (IN(10)) {
        { Gemm g{(const bf16*)(ws + WS_AQ), (const bf16*)(ws + WS_W_A), 1024, 1024, 1024, 0, 0}; StaticOrder S; S.init(M, D, G, bx); EpiBf16 E{(bf16*)(ws + WS_TA), D}; gemm_phase<EpiBf16, StaticOrder, true>(lds + RING_OFF, g, S, E, wave); }
        { Gemm g{(const bf16*)(ws + WS_YB), (const bf16*)(ws + WS_W_B), 1024, 1024, 1024, 0, 0}; StaticOrder S; S.init(M, D, G, bx); EpiBf16 E{(bf16*)(ws + WS_TB), D}; gemm_phase<EpiBf16, StaticOrder, true>(lds + RING_OFF, g, S, E, wave); }
    }
    SEAM(10);
    if (IN(11)) { Gemm g{(const bf16*)(ws + WS_X8M), (const bf16*)(ws + WS_W_G), D / 2, D / 2, D / 2, 0, 0}; StaticOrder S; S.init(M, 2 * D, G, bx);
        EpiGateMerge8 E{(const bf16*)(ws + WS_TA), (const bf16*)(ws + WS_TB), (unsigned char*)(ws + WS_MRG8), D, args.in[12], args.in[12] + D, 1.0f / (FP8_XS * FP8_WGS), FP8_MS, LnFold{ST0, VEC + V_GW_G, VEC + V_BW_G}};
        gemm_phase<EpiGateMerge8, StaticOrder, true, true>(lds + RING_OFF, g, S, E, wave); }
    SEAM(11);
    if (IN(12)) { Gemm g{(const bf16*)(ws + WS_MRG8), (const bf16*)(ws + WS_W_MO), D / 2, D / 2, D / 2, 0, 0}; StaticOrder S; S.init(M, D, G, bx); EpiRes E{nullptr, X16, D, ALPHA, 1.0f / (FP8_MS * FP8_WMOS), ST0, ln_g, ln_b, ST1, X16, nullptr, 0.f};
        gemm_phase<EpiRes, StaticOrder, true, true>(lds + RING_OFF, g, S, E, wave); }
    SEAM(12);
    if (IN(14)) { Gemm g{X16, (const bf16*)(ws + WS_W_MQ), D, D, D, 0, 0}; StaticOrder S; S.init(M, 512, G, bx); EpiBf16 E{(bf16*)(ws + WS_QM), 512, 0.08838834764831845f * LOG2E, LnFold{ST1, VEC + V_GW_MQ, VEC + V_BW_MQ}}; gemm_phase<EpiBf16, StaticOrder, true>(lds + RING_OFF, g, S, E, wave); }
    SEAM(14);
    if (IN(15)) memattn_mfma(lds, (const bf16*)(ws + WS_QM), (const bf16*)(ws + WS_KVMEM), (bf16*)(ws + WS_OM), vcu, G, wave);
    SEAM(15);
    if (IN(16)) { Gemm g{(const bf16*)(ws + WS_OM), (const bf16*)(ws + WS_W_MOUT), 512, 512, 512, 0, 0}; StaticOrder S; S.init(M, D, G, bx); EpiRes E{nullptr, X16, D, ALPHA, 1.0f, ST1, ln_g + D, ln_b + D, ST2, X16, (unsigned char*)(ws + WS_X8), FP8_XS};
        gemm_phase<EpiRes, StaticOrder, true>(lds + RING_OFF, g, S, E, wave); }
    SEAM(16);
    if (IN(18)) { Gemm g{(const bf16*)(ws + WS_X8), (const bf16*)(ws + WS_W_GU2), D / 2, D / 2, D / 2, 0, 0}; StaticOrder S; S.init(M, 2 * FF, G, bx); EpiSwiGLU8 E{(unsigned char*)HB, FF, 1.0f / (FP8_XS * FP8_WGUS), FP8_HS, LnFold{ST2, VEC + V_GW_GU2, VEC + V_BW_GU2}};
        gemm_phase<EpiSwiGLU8, StaticOrder, true, true>(lds + RING_OFF, g, S, E, wave); }
    SEAM(18);
    if (IN(19)) { Gemm g{HB, (const bf16*)(ws + WS_W_D2), FF / 2, FF / 2, FF / 2, 0, 0}; StaticOrder S; S.init(M, D, G, bx); EpiRes E{nullptr, X16, D, ALPHA, 0.5f / (FP8_HS * FP8_WDS), ST2, ln_g + 2 * D, ln_b + 2 * D, nullptr, X16, nullptr, 0.f};
        gemm_phase<EpiRes, StaticOrder, true, true>(lds + RING_OFF, g, S, E, wave); }
    SEAM(19);
    if (IN(20)) ln_final_phase(X16, out, ln_g + 3 * D, ln_b + 3 * D, gw, NGW, lane);
#undef IN
#undef SEAM
#undef lane
}

extern "C" void kernel_launch(void* const* d_in, const int* in_sizes, int n_in, void* d_out, int out_size, void* d_ws, size_t ws_size, hipStream_t stream) {
    static int grid = 0;
    if (grid == 0) {
        if (n_in != 24 || in_sizes[0] != M * D || out_size != M * D || ws_size < WS_END) { fprintf(stderr, "kernel_launch: unexpected shapes (n_in %d, in0 %d, out %d, ws %zu); nothing launched\n", n_in, n_in > 0 ? in_sizes[0] : -1, out_size, ws_size); grid = -1; return; }
        int dev = 0, cus = 0, per_cu = 0;
        if (hipGetDevice(&dev) != hipSuccess || hipDeviceGetAttribute(&cus, hipDeviceAttributeMultiprocessorCount, dev) != hipSuccess) { grid = -1; return; }
        if (hipFuncSetAttribute((const void*)mk_fwd, hipFuncAttributeMaxDynamicSharedMemorySize, LDS_BYTES) != hipSuccess) { fprintf(stderr, "kernel_launch: hipFuncSetAttribute failed\n"); grid = -1; return; }
        if (hipOccupancyMaxActiveBlocksPerMultiprocessor(&per_cu, (const void*)mk_fwd, NWAVES * 64, LDS_BYTES) != hipSuccess || per_cu < 1)
            fprintf(stderr, "kernel_launch: note: the occupancy query reports %d workgroups per CU\n", per_cu);
        (void)hipGetLastError();
        grid = cus;
    }
    if (grid < 0) return;
    if (hipMemsetAsync((char*)d_ws + WS_CTL, 0, CTL_ZERO_BYTES, stream) != hipSuccess) return;
    Args a{};
    for (int i = 0; i < 24; ++i) a.in[i] = (const float*)d_in[i];
    a.out = (float*)d_out; a.ws = (unsigned char*)d_ws;
#if MK_ONE_LAUNCH
    a.ph_lo = 0; a.ph_hi = N_PHASES;
    hipLaunchKernelGGL(mk_fwd, dim3(grid), dim3(NWAVES * 64), LDS_BYTES, stream, a);
#else
    for (int p = 0; p < N_PHASES; ++p) { a.ph_lo = p; a.ph_hi = p + 1; hipLaunchKernelGGL(mk_fwd, dim3(grid), dim3(NWAVES * 64), LDS_BYTES, stream, a); }
#endif
}
```

```cpp
#include <hip/hip_runtime.h>
#include <cstdio>
#include <cstdint>

#ifndef MK_ONE_LAUNCH
#define MK_ONE_LAUNCH 1
#endif

__device__ __forceinline__ int lane_fresh() { int l = (int)__builtin_amdgcn_mbcnt_hi(~0u, __builtin_amdgcn_mbcnt_lo(~0u, 0u)); asm volatile("" : "+v"(l)); return l; }
__device__ __forceinline__ void glds16(const void* gsrc, unsigned lds_dst) { unsigned keep;
    asm volatile("s_mov_b32 %0, m0\n\ts_mov_b32 m0, %2\n\ts_nop 0\n\tglobal_load_lds_dwordx4 %1, off\n\ts_mov_b32 m0, %0" : "=&s"(keep) : "v"(gsrc), "s"(lds_dst) : "memory"); }
__device__ __forceinline__ void glds16s(const void* sbase, unsigned voff, unsigned lds_dst) { unsigned keep;
    asm volatile("s_mov_b32 %0, m0\n\ts_mov_b32 m0, %3\n\ts_nop 0\n\tglobal_load_lds_dwordx4 %1, %2\n\ts_mov_b32 m0, %0" : "=&s"(keep) : "v"(voff), "s"(sbase), "s"(lds_dst) : "memory"); }
namespace pg8 {
#define PG8_LAS __attribute__((address_space(3)))
typedef unsigned short bf16_t;
typedef short bf16x8 __attribute__((ext_vector_type(8)));
typedef float f32x4 __attribute__((ext_vector_type(4)));
typedef unsigned u32x4 __attribute__((ext_vector_type(4)));
constexpr int BM = 256, BK = 64, HALF = 128, HTB = HALF * BK * 2  , STAGE_BYTES = 8 * HTB, NXCD = 8, WGM = 8;

__host__ __device__ __forceinline__ int lds_byte(int r, int c) { const int st = (r >> 4) * 2 + (c >> 5), rr = r & 15, cc = c & 31, ob = rr * 64 + cc * 2; return st * 1024 + (ob ^ (((ob >> 9) & 1) << 5)); }
__host__ __device__ __forceinline__ void stage_rc(int b, int& R, int& C) { const int st = b / 1024, sb = b % 1024, swz = sb ^ (((sb >> 9) & 1) << 5); R = (st >> 1) * 16 + swz / 64; C = (st & 1) * 32 + (swz % 64) / 2; }
__host__ __device__ __forceinline__ int perm32(int rho) { const int n = rho >> 4, i = rho & 15; return 8 * (i >> 2) + 4 * n + (i & 3); }

struct Unit { int pm, pn; };
struct Gemm { const bf16_t* A; const bf16_t* Bt; int lda, ldb, K, a_shift, a_mul; };

struct StaticOrder {
    int nM, nN, nwg, G, c;
    __host__ __device__ void init(int M, int N, int G_, int c_) { nM = M / BM; nN = N / BM; nwg = nM * nN; G = G_; c = c_; }
    __host__ __device__ bool next(int i, Unit& u) const {
        const long L = (long)i * G + c; if (L >= nwg) return false;
        int wgid = (int)L; { const int q = nwg / NXCD, r = nwg % NXCD, xcd = wgid % NXCD, off = wgid / NXCD; wgid = (xcd < r ? xcd * (q + 1) : r * (q + 1) + (xcd - r) * q) + off; }
        const int nig = WGM * nN, gid = wgid / nig, fm = gid * WGM, gsz = (nM - fm) < WGM ? (nM - fm) : WGM;
        u.pm = fm + ((wgid % nig) % gsz); u.pn = (wgid % nig) / gsz; return true;
    }
    __device__ __forceinline__ void a_ready(const Unit&) const {}
    __device__ __forceinline__ void done(const Unit&) const {}
};

__device__ __forceinline__ unsigned cvt_pk_bf16(float lo, float hi) { unsigned r; asm volatile("v_cvt_pk_bf16_f32 %0, %1, %2" : "=v"(r) : "v"(lo), "v"(hi)); return r; }
__device__ __forceinline__ float bflo(unsigned w) { return __uint_as_float(w << 16); }
__device__ __forceinline__ float bfhi(unsigned w) { return __uint_as_float(w & 0xffff0000u); }
__device__ __forceinline__ float sigmoidf_fast(float x) { return __builtin_amdgcn_rcpf(1.0f + __builtin_amdgcn_exp2f(-1.4426950408889634f * x)); }

struct LnFold {
    const long long* stats; const float* gW; const float* bW;
    __device__ __forceinline__ void row(int r, float& mean, float& rstd) const { const long long s0 = stats[2 * (size_t)r], s1 = stats[2 * (size_t)r + 1];
        mean = (float)s0 * (1.0f / (1048576.f * 2048.0f)); rstd = __builtin_amdgcn_rsqf((float)s1 * (1.0f / (65536.f * 2048.0f)) - mean * mean + 1e-5f); }
    __device__ __forceinline__ f32x4 vec4(const float* v, int i) const { return *(const f32x4*)(v + i); }
};
struct EpiBf16 {
    static constexpr bool PERM = true, AFTER_DRAIN = false;
    bf16_t* O; int ldc; float sc = 1.0f; LnFold lf = {nullptr, nullptr, nullptr};
    __device__ __forceinline__ void operator()(const f32x4 (&acc)[2][2][4][2], const Unit& u, int wr, int wc, int fr, int fq) const {
        const int row0 = u.pm * BM + wr * 64 + fr, col0 = u.pn * BM + wc * 32 + 8 * fq;
        f32x4 gw[2][2], bw[2][2];
#pragma unroll
        for (int bj = 0; bj < 2; ++bj)
#pragma unroll
            for (int n = 0; n < 2; ++n) { gw[bj][n] = (f32x4){0.f, 0.f, 0.f, 0.f}; bw[bj][n] = (f32x4){0.f, 0.f, 0.f, 0.f}; if (lf.stats) { gw[bj][n] = lf.vec4(lf.gW, col0 + bj * HALF + 4 * n); bw[bj][n] = lf.vec4(lf.bW, col0 + bj * HALF + 4 * n); } }
#pragma unroll
        for (int ai = 0; ai < 2; ++ai)
#pragma unroll
            for (int m = 0; m < 4; ++m) { bf16_t* rowp = O + (size_t)(row0 + ai * HALF + m * 16) * ldc + col0;
                float mean = 0.f, rstd = 1.f; if (lf.stats) lf.row(row0 + ai * HALF + m * 16, mean, rstd);
#pragma unroll
                for (int bj = 0; bj < 2; ++bj) { const f32x4 v0 = ((acc[ai][bj][m][0] - gw[bj][0] * mean) * rstd + bw[bj][0]) * sc, v1 = ((acc[ai][bj][m][1] - gw[bj][1] * mean) * rstd + bw[bj][1]) * sc;
                    u32x4 w; w.x = cvt_pk_bf16(v0[0], v0[1]); w.y = cvt_pk_bf16(v0[2], v0[3]); w.z = cvt_pk_bf16(v1[0], v1[1]); w.w = cvt_pk_bf16(v1[2], v1[3]);
                    *(u32x4*)(rowp + bj * HALF) = w; } }
    }
};
struct EpiInProj {
    static constexpr bool PERM = true, AFTER_DRAIN = false;
    bf16_t *aq, *ak, *av, *bq, *bc, *iq, *ikw; float qscale; LnFold lf; unsigned* kmax;
    __device__ __forceinline__ void operator()(const f32x4 (&acc)[2][2][4][2], const Unit& u, int wr, int wc, int fr, int fq) const {
        bf16_t* base; int ldc, colt; const int pn = u.pn;
        if (pn < 4) { base = aq; ldc = 1024; colt = pn * 256; }
        else if (pn < 8) { base = ak; ldc = 1024; colt = (pn - 4) * 256; }
        else if (pn < 12) { base = av; ldc = 1024; colt = (pn - 8) * 256; }
        else if (pn < 16) { base = bq; ldc = 1024; colt = (pn - 12) * 256; }
        else if (pn < 18) { base = bc; ldc = 512; colt = (pn - 16) * 256; }
        else if (pn < 22) { base = iq; ldc = 1024; colt = (pn - 18) * 256; }
        else { base = ikw; ldc = 256; colt = 0; }
        const float sc = (pn < 4) ? qscale : 1.0f; float kam[2] = {0.f, 0.f};
        const int row0 = u.pm * BM + wr * 64 + fr, col0 = colt + wc * 32 + 8 * fq, cidx = pn * BM + wc * 32 + 8 * fq;
        f32x4 gw[2][2], bw[2][2];
#pragma unroll
        for (int bj = 0; bj < 2; ++bj)
#pragma unroll
            for (int n = 0; n < 2; ++n) { gw[bj][n] = lf.vec4(lf.gW, cidx + bj * HALF + 4 * n); bw[bj][n] = lf.vec4(lf.bW, cidx + bj * HALF + 4 * n); }
#pragma unroll
        for (int ai = 0; ai < 2; ++ai)
#pragma unroll
            for (int m = 0; m < 4; ++m) { bf16_t* rowp = base + (size_t)(row0 + ai * HALF + m * 16) * ldc + col0;
                float mean, rstd; lf.row(row0 + ai * HALF + m * 16, mean, rstd);
#pragma unroll
                for (int bj = 0; bj < 2; ++bj) { const f32x4 v0 = ((acc[ai][bj][m][0] - gw[bj][0] * mean) * rstd + bw[bj][0]) * sc, v1 = ((acc[ai][bj][m][1] - gw[bj][1] * mean) * rstd + bw[bj][1]) * sc;
                    kam[bj] = fmaxf(kam[bj], fmaxf(fmaxf(fmaxf(fabsf(v0[0]), fabsf(v0[1])), fmaxf(fabsf(v0[2]), fabsf(v0[3]))), fmaxf(fmaxf(fabsf(v1[0]), fabsf(v1[1])), fmaxf(fabsf(v1[2]), fabsf(v1[3])))));
                    u32x4 w; w.x = cvt_pk_bf16(v0[0], v0[1]); w.y = cvt_pk_bf16(v0[2], v0[3]); w.z = cvt_pk_bf16(v1[0], v1[1]); w.w = cvt_pk_bf16(v1[2], v1[3]);
                    *(u32x4*)(rowp + bj * HALF) = w; } }
        if (pn >= 4 && pn < 8) {
#pragma unroll
            for (int bj = 0; bj < 2; ++bj) { float v = kam[bj];
#pragma unroll
                for (int o = 1; o < 64; o <<= 1) v = fmaxf(v, __shfl_xor(v, o));
                if ((fr | fq) == 0) (void)__hip_atomic_fetch_max(kmax + ((u.pm >> 4) * 8 + 2 * (pn - 4) + bj) * 2 + (wc >> 1), __float_as_uint(v), __ATOMIC_RELAXED, __HIP_MEMORY_SCOPE_AGENT); } }
    }
};
struct EpiSwiGLU {
    static constexpr bool PERM = true, AFTER_DRAIN = false;
    bf16_t* O; int ldc;
    __device__ __forceinline__ void operator()(const f32x4 (&acc)[2][2][4][2], const Unit& u, int wr, int wc, int fr, int fq) const {
        const int row0 = u.pm * BM + wr * 64 + fr, col0 = u.pn * HALF + wc * 32 + 8 * fq;
#pragma unroll
        for (int ai = 0; ai < 2; ++ai)
#pragma unroll
            for (int m = 0; m < 4; ++m) { bf16_t* rowp = O + (size_t)(row0 + ai * HALF + m * 16) * ldc + col0;
                float h[8];
#pragma unroll
                for (int n = 0; n < 2; ++n)
#pragma unroll
                    for (int j = 0; j < 4; ++j) { const float g = acc[ai][0][m][n][j], up = acc[ai][1][m][n][j]; h[4 * n + j] = g * sigmoidf_fast(g) * up; }
                u32x4 w; w.x = cvt_pk_bf16(h[0], h[1]); w.y = cvt_pk_bf16(h[2], h[3]); w.z = cvt_pk_bf16(h[4], h[5]); w.w = cvt_pk_bf16(h[6], h[7]);
                *(u32x4*)rowp = w; }
    }
};
__device__ __forceinline__ unsigned pk4_fp8(float a, float b, float c, float d) { int w = 0; w = __builtin_amdgcn_cvt_pk_fp8_f32(a, b, w, false); w = __builtin_amdgcn_cvt_pk_fp8_f32(c, d, w, true); return (unsigned)w; }
struct EpiSwiGLU8 {
    static constexpr bool PERM = true, AFTER_DRAIN = false;
    unsigned char* O; int ldc; float ascale, hs; LnFold lf;
    __device__ __forceinline__ void operator()(const f32x4 (&acc)[2][2][4][2], const Unit& u, int wr, int wc, int fr, int fq) const {
        const int row0 = u.pm * BM + wr * 64 + fr, col0 = u.pn * HALF + wc * 32 + 8 * fq, cidx = u.pn * BM + wc * 32 + 8 * fq;
        typedef unsigned u32x2 __attribute__((ext_vector_type(2)));
        f32x4 gw[2][2], bw[2][2];
#pragma unroll
        for (int bj = 0; bj < 2; ++bj)
#pragma unroll
            for (int n = 0; n < 2; ++n) { gw[bj][n] = (f32x4){0.f, 0.f, 0.f, 0.f}; bw[bj][n] = (f32x4){0.f, 0.f, 0.f, 0.f}; if (lf.stats) { gw[bj][n] = lf.vec4(lf.gW, cidx + bj * HALF + 4 * n); bw[bj][n] = lf.vec4(lf.bW, cidx + bj * HALF + 4 * n); } }
#pragma unroll
        for (int ai = 0; ai < 2; ++ai)
#pragma unroll
            for (int m = 0; m < 4; ++m) { unsigned char* rowp = O + (size_t)(row0 + ai * HALF + m * 16) * ldc + col0;
                float h[8]; float mean = 0.f, rstd = 1.f; if (lf.stats) lf.row(row0 + ai * HALF + m * 16, mean, rstd);
#pragma unroll
                for (int n = 0; n < 2; ++n)
#pragma unroll
                    for (int j = 0; j < 4; ++j) { const float g = (acc[ai][0][m][n][j] * ascale - gw[0][n][j] * mean) * rstd + bw[0][n][j], up = (acc[ai][1][m][n][j] * ascale - gw[1][n][j] * mean) * rstd + bw[1][n][j];
                        h[4 * n + j] = fminf(fmaxf(g * sigmoidf_fast(g) * up * hs, -448.f), 448.f); }
                *(u32x2*)rowp = (u32x2){pk4_fp8(h[0], h[1], h[2], h[3]), pk4_fp8(h[4], h[5], h[6], h[7])}; }
    }
};
struct EpiGateMerge {
    static constexpr bool PERM = true, AFTER_DRAIN = false;
    const bf16_t* ta; const bf16_t* tb; bf16_t* O; int ldc; const float* b0; const float* b1;
    __device__ __forceinline__ void operator()(const f32x4 (&acc)[2][2][4][2], const Unit& u, int wr, int wc, int fr, int fq) const {
        const int row0 = u.pm * BM + wr * 64 + fr, col0 = u.pn * HALF + wc * 32 + 8 * fq;
        float bb0[8], bb1[8];
#pragma unroll
        for (int j = 0; j < 8; ++j) { bb0[j] = b0[col0 + j]; bb1[j] = b1[col0 + j]; }
#pragma unroll
        for (int ai = 0; ai < 2; ++ai)
#pragma unroll
            for (int m = 0; m < 4; ++m) { const size_t off = (size_t)(row0 + ai * HALF + m * 16) * ldc + col0;
                const u32x4 a = *(const u32x4*)(ta + off), b = *(const u32x4*)(tb + off);
                const float av[8] = {bflo(a.x), bfhi(a.x), bflo(a.y), bfhi(a.y), bflo(a.z), bfhi(a.z), bflo(a.w), bfhi(a.w)};
                const float bv[8] = {bflo(b.x), bfhi(b.x), bflo(b.y), bfhi(b.y), bflo(b.z), bfhi(b.z), bflo(b.w), bfhi(b.w)};
                float h[8];
#pragma unroll
                for (int n = 0; n < 2; ++n)
#pragma unroll
                    for (int j = 0; j < 4; ++j) { const int e = 4 * n + j; h[e] = sigmoidf_fast(acc[ai][0][m][n][j] + bb0[e]) * av[e] + sigmoidf_fast(acc[ai][1][m][n][j] + bb1[e]) * bv[e]; }
                u32x4 w; w.x = cvt_pk_bf16(h[0], h[1]); w.y = cvt_pk_bf16(h[2], h[3]); w.z = cvt_pk_bf16(h[4], h[5]); w.w = cvt_pk_bf16(h[6], h[7]);
                *(u32x4*)(O + off) = w; }
    }
};
struct EpiGateMerge8 {
    static constexpr bool PERM = true, AFTER_DRAIN = false;
    const bf16_t* ta; const bf16_t* tb; unsigned char* O; int ldc; const float* b0; const float* b1; float ascale, ms; LnFold lf;
    __device__ __forceinline__ void operator()(const f32x4 (&acc)[2][2][4][2], const Unit& u, int wr, int wc, int fr, int fq) const {
        const int row0 = u.pm * BM + wr * 64 + fr, col0 = u.pn * HALF + wc * 32 + 8 * fq, cidx = u.pn * BM + wc * 32 + 8 * fq;
        typedef unsigned u32x2 __attribute__((ext_vector_type(2)));
        float bb0[8], bb1[8], gw0[8], gw1[8];
#pragma unroll
        for (int j = 0; j < 8; ++j) { bb0[j] = b0[col0 + j] + lf.bW[cidx + j]; bb1[j] = b1[col0 + j] + lf.bW[cidx + HALF + j]; gw0[j] = lf.gW[cidx + j]; gw1[j] = lf.gW[cidx + HALF + j]; }
#pragma unroll
        for (int ai = 0; ai < 2; ++ai)
#pragma unroll
            for (int m = 0; m < 4; ++m) { const size_t off = (size_t)(row0 + ai * HALF + m * 16) * ldc + col0;
                const u32x4 a = *(const u32x4*)(ta + off), b = *(const u32x4*)(tb + off);
                const float av[8] = {bflo(a.x), bfhi(a.x), bflo(a.y), bfhi(a.y), bflo(a.z), bfhi(a.z), bflo(a.w), bfhi(a.w)};
                const float bv[8] = {bflo(b.x), bfhi(b.x), bflo(b.y), bfhi(b.y), bflo(b.z), bfhi(b.z), bflo(b.w), bfhi(b.w)};
                float h[8]; float mean, rstd; lf.row(row0 + ai * HALF + m * 16, mean, rstd);
#pragma unroll
                for (int n = 0; n < 2; ++n)
#pragma unroll
                    for (int j = 0; j < 4; ++j) { const int e = 4 * n + j; const float v = sigmoidf_fast((acc[ai][0][m][n][j] * ascale - gw0[e] * mean) * rstd + bb0[e]) * av[e] + sigmoidf_fast((acc[ai][1][m][n][j] * ascale - gw1[e] * mean) * rstd + bb1[e]) * bv[e];
                        h[e] = fminf(fmaxf(v * ms, -448.f), 448.f); }
                *(u32x2*)(O + off) = (u32x2){pk4_fp8(h[0], h[1], h[2], h[3]), pk4_fp8(h[4], h[5], h[6], h[7])}; }
    }
};
struct EpiRes {
    static constexpr bool PERM = true, AFTER_DRAIN = false;
    const float* res32; const bf16_t* res16; int ldc; float alpha, s;
    const long long* rstats; const float* rg; const float* rb; long long* ostats; bf16_t* o16; unsigned char* o8; float o8s;
    __device__ __forceinline__ void operator()(const f32x4 (&acc)[2][2][4][2], const Unit& u, int wr, int wc, int fr, int fq) const {
        const int col0 = u.pn * BM + wc * 32 + 8 * fq;
        typedef unsigned u32x2 __attribute__((ext_vector_type(2)));
        float al = alpha, sa = s; asm volatile("" : "+v"(al), "+v"(sa));
        f32x4 gv[2][2], bv[2][2];
#pragma unroll
        for (int bj = 0; bj < 2; ++bj)
#pragma unroll
            for (int n = 0; n < 2; ++n) { gv[bj][n] = (f32x4){1.f, 1.f, 1.f, 1.f}; bv[bj][n] = (f32x4){0.f, 0.f, 0.f, 0.f};
                if (rstats) { gv[bj][n] = *(const f32x4*)(rg + col0 + bj * HALF + 4 * n); bv[bj][n] = *(const f32x4*)(rb + col0 + bj * HALF + 4 * n); }
                gv[bj][n] = gv[bj][n] * al; bv[bj][n] = bv[bj][n] * al; }
#pragma unroll
        for (int ai = 0; ai < 2; ++ai)
#pragma unroll
            for (int m = 0; m < 4; ++m) { const int row = u.pm * BM + ai * HALF + wr * 64 + m * 16 + fr; const size_t off = (size_t)row * ldc + col0;
                float mean = 0.f, rstd = 1.f;
                if (rstats) { const long long s0 = rstats[2 * (size_t)row], s1 = rstats[2 * (size_t)row + 1]; mean = (float)s0 * (1.0f / (1048576.f * 2048.0f)); rstd = __builtin_amdgcn_rsqf((float)s1 * (1.0f / (65536.f * 2048.0f)) - mean * mean + 1e-5f); }
                float ps = 0.f, pq = 0.f;
#pragma unroll
                for (int bj = 0; bj < 2; ++bj) {
                    f32x4 r0, r1;
                    if (res32) { r0 = *(const f32x4*)(res32 + off + bj * HALF); r1 = *(const f32x4*)(res32 + off + bj * HALF + 4); }
                    else { const u32x4 w = *(const u32x4*)(res16 + off + bj * HALF); r0 = (f32x4){bflo(w.x), bfhi(w.x), bflo(w.y), bfhi(w.y)}; r1 = (f32x4){bflo(w.z), bfhi(w.z), bflo(w.w), bfhi(w.w)}; }
                    const f32x4 z0 = (r0 - mean) * rstd * gv[bj][0] + bv[bj][0] + acc[ai][bj][m][0] * sa, z1 = (r1 - mean) * rstd * gv[bj][1] + bv[bj][1] + acc[ai][bj][m][1] * sa;
                    u32x4 w16; w16.x = cvt_pk_bf16(z0[0], z0[1]); w16.y = cvt_pk_bf16(z0[2], z0[3]); w16.z = cvt_pk_bf16(z1[0], z1[1]); w16.w = cvt_pk_bf16(z1[2], z1[3]);
                    *(u32x4*)(o16 + off + bj * HALF) = w16;
                    const float q0 = bflo(w16.x), q1 = bfhi(w16.x), q2 = bflo(w16.y), q3 = bfhi(w16.y), q4 = bflo(w16.z), q5 = bfhi(w16.z), q6 = bflo(w16.w), q7 = bfhi(w16.w);
                    ps += ((q0 + q1) + (q2 + q3)) + ((q4 + q5) + (q6 + q7)); pq += ((q0 * q0 + q1 * q1) + (q2 * q2 + q3 * q3)) + ((q4 * q4 + q5 * q5) + (q6 * q6 + q7 * q7));
                    if (o8) *(u32x2*)(o8 + off + bj * HALF) = (u32x2){pk4_fp8(fminf(fmaxf(q0 * o8s, -448.f), 448.f), fminf(fmaxf(q1 * o8s, -448.f), 448.f), fminf(fmaxf(q2 * o8s, -448.f), 448.f), fminf(fmaxf(q3 * o8s, -448.f), 448.f)),
                                                                      pk4_fp8(fminf(fmaxf(q4 * o8s, -448.f), 448.f), fminf(fmaxf(q5 * o8s, -448.f), 448.f), fminf(fmaxf(q6 * o8s, -448.f), 448.f), fminf(fmaxf(q7 * o8s, -448.f), 448.f))}; }
                if (ostats) { ps += __shfl_xor(ps, 16); ps += __shfl_xor(ps, 32); pq += __shfl_xor(pq, 16); pq += __shfl_xor(pq, 32);
                    if (fq == 0) { (void)__hip_atomic_fetch_add(ostats + 2 * (size_t)row, (long long)__builtin_rintf(ps * 1048576.f), __ATOMIC_RELAXED, __HIP_MEMORY_SCOPE_AGENT); (void)__hip_atomic_fetch_add(ostats + 2 * (size_t)row + 1, (long long)__builtin_rintf(pq * 65536.f), __ATOMIC_RELAXED, __HIP_MEMORY_SCOPE_AGENT); } }
                if (m & 1) asm volatile("" ::: "memory"); }
    }
};

typedef int v8i_t __attribute__((ext_vector_type(8)));
typedef int v4i_t __attribute__((ext_vector_type(4)));
template <class Epi, class Sched, bool ALIGN_EPI, bool FP8 = false>
__device__ __forceinline__ void gemm_phase(PG8_LAS unsigned char* lds, const Gemm g, const Sched& S, const Epi& E, const int wid) {
    const int lane = lane_fresh(), tid = wid * 64 + lane, wr = wid >> 2, wc = wid & 3, fr = lane & 15, fq = lane >> 4;
    const int K = g.K, nt = K / BK;
    unsigned voffA[2], voffB[2];
#pragma unroll
    for (int i = 0; i < 2; ++i) { int R, C; stage_rc(tid * 16 + i * 8192, R, C); const int Rb = Epi::PERM ? ((R & ~31) + perm32(R & 31)) : R;
        voffA[i] = (unsigned)(R * g.lda + C) * 2u; voffB[i] = (unsigned)(Rb * g.ldb + C) * 2u; }
    const size_t kstep = (size_t)(BK * 2);
    const size_t hstepA = (size_t)HALF * g.lda * 2, hstepB = (size_t)HALF * g.ldb * 2;
    const size_t tstepA = 2 * hstepA, tstepB = 2 * hstepB;
    const unsigned ldsw = (unsigned)wid * 1024u;
    const int aoff = lds_byte(wr * 64 + fr, fq * 8), boff = lds_byte(wc * 32 + fr, fq * 8);
#define PG8_UA(u) ((const char*)g.A + (size_t)(u).pm * tstepA + (size_t)(((u).pn >> g.a_shift) * g.a_mul) * 2)
#define PG8_UB(u) ((const char*)g.Bt + (size_t)(u).pn * tstepB)
#define PG8_SA(b, h) (((b) * 2 + (h)) * HTB)
#define PG8_SB(b, h) ((4 + (b) * 2 + (h)) * HTB)
#define PG8_STAGE(bufoff, gbase, voff) do { _Pragma("unroll") for (int _i = 0; _i < 2; ++_i) \
        __builtin_amdgcn_global_load_lds((const unsigned*)((const char*)(gbase) + (voff)[_i]), (PG8_LAS unsigned*)(lds + (bufoff) + ldsw + _i * 8192), 16, 0, 0); } while (0)
#define PG8_LD8(p_) __builtin_shufflevector(*(const PG8_LAS v4i_t*)(p_), *(const PG8_LAS v4i_t*)((p_) + 1024), 0, 1, 2, 3, 4, 5, 6, 7)
#define PG8_LDA(dst, b, h) do { _Pragma("unroll") for (int m = 0; m < 4; ++m) { if constexpr (FP8) dst##8[m] = PG8_LD8(lds + PG8_SA(b, h) + aoff + m * 2048); else { _Pragma("unroll") for (int k = 0; k < 2; ++k) dst[m][k] = *(const PG8_LAS bf16x8*)(lds + PG8_SA(b, h) + aoff + m * 2048 + k * 1024); } } } while (0)
#define PG8_LDB(dst, b, h) do { _Pragma("unroll") for (int n = 0; n < 2; ++n) { if constexpr (FP8) dst##8[n] = PG8_LD8(lds + PG8_SB(b, h) + boff + n * 2048); else { _Pragma("unroll") for (int k = 0; k < 2; ++k) dst[n][k] = *(const PG8_LAS bf16x8*)(lds + PG8_SB(b, h) + boff + n * 2048 + k * 1024); } } } while (0)
#define PG8_MMA(ai, bj, At, Bt) do { __builtin_amdgcn_s_setprio(1); _Pragma("unroll") for (int m = 0; m < 4; ++m) _Pragma("unroll") for (int n = 0; n < 2; ++n) { \
        if constexpr (FP8) asm volatile("v_mfma_scale_f32_16x16x128_f8f6f4 %0, %1, %2, %0, %3, %3 op_sel_hi:[0,0,0]" : "+v"(acc[ai][bj][m][n]) : "v"(Bt##8[n]), "v"(At##8[m]), "v"(one_scale)); \
        else { _Pragma("unroll") for (int k = 0; k < 2; ++k) acc[ai][bj][m][n] = __builtin_amdgcn_mfma_f32_16x16x32_bf16(Bt[n][k], At[m][k], acc[ai][bj][m][n], 0, 0, 0); } } \
        __builtin_amdgcn_s_setprio(0); } while (0)
#define PG8_WAIT_V(n) asm volatile("s_waitcnt vmcnt(" #n ")" ::: "memory")
#define PG8_WAIT_L(n) asm volatile("s_waitcnt lgkmcnt(" #n ")" ::: "memory")
#define PG8_BAR __builtin_amdgcn_s_barrier()
#define PG8_SCHED __builtin_amdgcn_sched_barrier(0)
    Unit cur, nxt; int ui = 0;
    if (!S.next(0, cur)) return;
    f32x4 acc[2][2][4][2];
#pragma unroll
    for (int a = 0; a < 2; ++a)
#pragma unroll
        for (int b = 0; b < 2; ++b)
#pragma unroll
            for (int m = 0; m < 4; ++m)
#pragma unroll
                for (int n = 0; n < 2; ++n) acc[a][b][m][n] = (f32x4){0.f, 0.f, 0.f, 0.f};
    bf16x8 At[4][2], B0[2][2], B1[2][2]; v8i_t At8[4], B08[2], B18[2];
    int one_scale = 0x7f7f7f7f; asm volatile("" : "+v"(one_scale));
    const char* cA = PG8_UA(cur); const char* cB = PG8_UB(cur);
    S.a_ready(cur);
    PG8_STAGE(PG8_SB(0, 0), cB, voffB); PG8_STAGE(PG8_SB(0, 1), cB + hstepB, voffB); PG8_STAGE(PG8_SA(0, 0), cA, voffA); PG8_STAGE(PG8_SA(0, 1), cA + hstepA, voffA);
    if (wr == 1) PG8_BAR;
    PG8_WAIT_V(2); PG8_BAR;
    PG8_STAGE(PG8_SB(1, 0), cB + kstep, voffB); PG8_STAGE(PG8_SA(1, 0), cA + kstep, voffA); PG8_STAGE(PG8_SB(1, 1), cB + hstepB + kstep, voffB);
    PG8_WAIT_V(6); PG8_BAR;
    for (;;) {
        const bool has_next = S.next(ui + 1, nxt);
        const char* nA = has_next ? PG8_UA(nxt) : cA; const char* nB = has_next ? PG8_UB(nxt) : cB;
        for (int t = 0; t < nt; t += 2) {
            const bool last = (t == nt - 2);
            const char* a1 = cA + (size_t)(t + 1) * kstep;
            const char* a2 = last ? nA : cA + (size_t)(t + 2) * kstep; const char* b2 = last ? nB : cB + (size_t)(t + 2) * kstep;
            const char* a3 = a2 + kstep; const char* b3 = b2 + kstep;
            if (last && has_next) S.a_ready(nxt);
            PG8_LDB(B0, 0, 0); PG8_LDB(B1, 0, 1); PG8_SCHED; PG8_LDA(At, 0, 0); PG8_STAGE(PG8_SA(1, 1), a1 + hstepA, voffA);
            PG8_WAIT_V(8); PG8_WAIT_L(0); PG8_BAR; PG8_MMA(0, 0, At, B0); PG8_MMA(0, 1, At, B1); PG8_BAR; PG8_SCHED;
            PG8_LDA(At, 0, 1); PG8_STAGE(PG8_SB(0, 0), b2, voffB); PG8_STAGE(PG8_SB(0, 1), b2 + hstepB, voffB); PG8_STAGE(PG8_SA(0, 0), a2, voffA);
            PG8_WAIT_V(8); PG8_WAIT_L(0); PG8_BAR; PG8_MMA(1, 0, At, B0); PG8_MMA(1, 1, At, B1); PG8_BAR; PG8_SCHED;
            PG8_LDB(B0, 1, 0); PG8_LDB(B1, 1, 1); PG8_SCHED; PG8_LDA(At, 1, 0); PG8_STAGE(PG8_SA(0, 1), a2 + hstepA, voffA);
            PG8_WAIT_V(8); PG8_WAIT_L(0); PG8_BAR; PG8_MMA(0, 0, At, B0); PG8_MMA(0, 1, At, B1); PG8_BAR; PG8_SCHED;
            PG8_LDA(At, 1, 1); PG8_STAGE(PG8_SB(1, 0), b3, voffB); PG8_STAGE(PG8_SB(1, 1), b3 + hstepB, voffB); PG8_STAGE(PG8_SA(1, 0), a3, voffA);
            PG8_WAIT_V(8); PG8_WAIT_L(0); PG8_BAR; PG8_MMA(1, 0, At, B0); PG8_MMA(1, 1, At, B1); PG8_BAR; PG8_SCHED;
        }
        if constexpr (ALIGN_EPI) { if (wr == 0) PG8_BAR; }
        if constexpr (FP8) asm volatile("s_nop 15\n\ts_nop 7" ::: "memory");
        E(acc, cur, wr, wc, fr, fq); S.done(cur);
        if (!has_next) break;
#pragma unroll
        for (int a = 0; a < 2; ++a)
#pragma unroll
            for (int b = 0; b < 2; ++b)
#pragma unroll
                for (int m = 0; m < 4; ++m)
#pragma unroll
                    for (int n = 0; n < 2; ++n) acc[a][b][m][n] = (f32x4){0.f, 0.f, 0.f, 0.f};
        cur = nxt; cA = nA; cB = nB; ++ui;
        if constexpr (ALIGN_EPI) { if (wr == 1) PG8_BAR; }
    }
    PG8_WAIT_V(0);
    if constexpr (!ALIGN_EPI) { if (wr == 0) PG8_BAR; }
    PG8_BAR;
#undef PG8_UA
#undef PG8_UB
#undef PG8_SA
#undef PG8_SB
#undef PG8_STAGE
#undef PG8_LDA
#undef PG8_LDB
#undef PG8_MMA
#undef PG8_LD8
#undef PG8_WAIT_V
#undef PG8_WAIT_L
#undef PG8_BAR
#undef PG8_SCHED
}
}

constexpr int NWAVES = 8;
constexpr int BATCH = 4, SEQ = 4096, D = 2048, FF = 5632, M = BATCH * SEQ;
constexpr int N_IN = 5888;
constexpr int MEMT = 256;
constexpr float LN_EPS = 1e-5f;
constexpr float ALPHA = 1.189207115002721f;
constexpr float LAMBDA_INIT = 0.2f;

constexpr size_t MiB = 1u << 20;
constexpr size_t WS_CTL = 0, CTL_ZERO_BYTES = 2 * MiB;
constexpr size_t WS_W_IN = 2 * MiB;
constexpr size_t WS_W_G = 25 * MiB;
constexpr size_t WS_W_UK = 41 * MiB;
constexpr size_t WS_W_UVP = 42 * MiB;
constexpr size_t WS_W_A = 44 * MiB;
constexpr size_t WS_W_B = 48 * MiB;
constexpr size_t WS_W_MO = 52 * MiB;
constexpr size_t WS_W_MQ = 60 * MiB;
constexpr size_t WS_W_MKV = 62 * MiB;
constexpr size_t WS_W_MOUT = 66 * MiB;
constexpr size_t WS_MEM16 = 68 * MiB;
constexpr size_t WS_KVMEM = 72 * MiB;
constexpr size_t WS_W_GU2 = 74 * MiB;
constexpr size_t WS_W_D2 = 96 * MiB;
constexpr size_t WS_X8M = 107 * MiB;
constexpr size_t WS_X16 = 140 * MiB;
constexpr size_t WS_MIX = 204 * MiB;
constexpr size_t WS_W_GU1 = 204 * MiB;
constexpr size_t WS_W_D1 = 248 * MiB;
constexpr size_t WS_H = 270 * MiB;
constexpr size_t WS_AQ = WS_MIX + 0 * MiB, WS_AK = WS_MIX + 32 * MiB, WS_AV = WS_MIX + 64 * MiB, WS_BQ = WS_MIX + 96 * MiB;
constexpr size_t WS_BC = WS_MIX + 128 * MiB;
constexpr size_t WS_IQ = WS_MIX + 144 * MiB;
constexpr size_t WS_IKW = WS_MIX + 176 * MiB;
constexpr size_t WS_QLAT = WS_MIX + 184 * MiB;
constexpr size_t WS_IDX = WS_MIX + 312 * MiB;
constexpr size_t WS_YB = WS_BQ;
constexpr size_t WS_TA = WS_QLAT, WS_TB = WS_QLAT + 64 * MiB;
constexpr size_t WS_QM = WS_AQ, WS_OM = WS_AQ + 16 * MiB;
constexpr size_t WS_X8 = WS_H + 96 * MiB;
constexpr size_t WS_C8 = WS_W_IN;
constexpr size_t WS_MRG8 = WS_AV;
constexpr float FP8_WGS = 1024.f, FP8_MS = 32.f, FP8_WMOS = 2048.f;
constexpr float FP8_XS = 32.f, FP8_WGUS = 1024.f, FP8_HS = 8.f, FP8_WDS = 4096.f;
constexpr size_t WS_END = WS_MIX + 320 * MiB;
static_assert(WS_H + (size_t)M * FF * 2 <= WS_END && WS_QLAT + (size_t)M * 4096 * 2 <= WS_END, "d_ws map");
constexpr int CW_BAR = 4096;
constexpr int CW_DQ = 8192;
constexpr int CW_KMAX = 8256;
constexpr size_t CTL_STATS = 65536, CTL_STATS_STRIDE = (size_t)M * 2 * 8;
constexpr size_t CTL_VEC = CTL_STATS + 3 * CTL_STATS_STRIDE;
constexpr int V_GW_IN = 0, V_BW_IN = 5888, V_GW_G = 11776, V_BW_G = 15872, V_GW_MQ = 19968, V_BW_MQ = 20480, V_GW_GU2 = 20992, V_BW_GU2 = 32256, V_END = 43520;
constexpr size_t CTL_VECF = CTL_VEC + (size_t)V_END * 8;
static_assert(CTL_VECF + (size_t)V_END * 4 <= CTL_ZERO_BYTES, "control region");
constexpr float FX_S = 1048576.f, FX_Q = 65536.f, FX_V = 16777216.f;

constexpr int RING_OFF = 0, RING_BYTES = 153600;
constexpr int LDSCTL_OFF = RING_BYTES, MISC_OFF = LDSCTL_OFF + 320;
constexpr int LDS_BYTES = 154624;
static_assert(MISC_OFF + 128 <= LDS_BYTES, "LDS map");

#define GAS __attribute__((address_space(1)))
#define LAS __attribute__((address_space(3)))
typedef unsigned short bf16;
typedef unsigned v4u __attribute__((ext_vector_type(4)));
typedef unsigned v2u __attribute__((ext_vector_type(2)));
typedef float f32x4 __attribute__((ext_vector_type(4)));
typedef float f32x16 __attribute__((ext_vector_type(16)));
typedef short bf16x8 __attribute__((ext_vector_type(8)));
typedef GAS unsigned gu32;
#define RLX_AGENT __ATOMIC_RELAXED, __HIP_MEMORY_SCOPE_AGENT
#define LDS_WAIT() asm volatile("s_waitcnt lgkmcnt(0)" ::: "memory")
#define VM_WAIT() asm volatile("s_waitcnt vmcnt(0)" ::: "memory")
__device__ __forceinline__ unsigned f2bf(float f) { unsigned u = __builtin_bit_cast(unsigned, f); return (u + 0x7fffu + ((u >> 16) & 1u)) >> 16; }
__device__ __forceinline__ unsigned pk2(float lo, float hi) { return f2bf(lo) | (f2bf(hi) << 16); }
__device__ __forceinline__ float bf2f(unsigned short v) { return __uint_as_float((unsigned)v << 16); }
__device__ __forceinline__ float blo(unsigned w) { return __uint_as_float(w << 16); }
__device__ __forceinline__ float bhi(unsigned w) { return __uint_as_float(w & 0xffff0000u); }
__device__ __forceinline__ float wave_sum(float v) {
#pragma unroll
    for (int o = 1; o < 64; o <<= 1) v += __shfl_xor(v, o);
    return v;
}

#define XB_TMO      128
#define XB_XCNT(j)  (256  + 64 * (j))
#define XB_XSUB(j)  (1280 + 64 * (j))
#define XB_XGEN(j)  (2304 + 64 * (j))
#define XB_TOP      3328
#define XB_TOPGEN   3392
#define XCD_BAR_WORDS 3456
#define XB_SPIN_CAP (1u << 18)

__device__ __forceinline__ unsigned xb_ld(unsigned* p)              { return __hip_atomic_load(p, __ATOMIC_RELAXED, __HIP_MEMORY_SCOPE_AGENT); }
__device__ __forceinline__ unsigned xb_add(unsigned* p, unsigned v) { return __hip_atomic_fetch_add(p, v, __ATOMIC_RELAXED, __HIP_MEMORY_SCOPE_AGENT); }
__device__ __forceinline__ unsigned xb_xcc_id() { return (unsigned)__builtin_amdgcn_s_getreg((3 << 11) | 20) & 0xFu; }
#define XB_SPIN(cond, bar) do { unsigned _sp = 0; while (cond) { __builtin_amdgcn_s_sleep(1); \
    if ((++_sp & 255u) == 0u) { if (xb_ld(&(bar)[XB_TMO])) break; if (_sp > XB_SPIN_CAP) { atomicAdd(&(bar)[XB_TMO], 1u); break; } } } } while (0)

struct XcdBarrier {
    unsigned* bar; unsigned x;
    volatile LAS unsigned* st;
};

__device__ __forceinline__ XcdBarrier xcd_barrier_post(unsigned* bar, volatile LAS unsigned* st, bool t0) {
    XcdBarrier b; b.bar = bar; b.x = xb_xcc_id(); b.st = st;
    if (t0) (void)xb_add(&bar[XB_XCNT(b.x)], 1u);
    return b;
}
__device__ __forceinline__ void xcd_barrier_complete(unsigned* bar, unsigned x, unsigned& nloc, unsigned& nx) {
    const unsigned G = gridDim.x * gridDim.y * gridDim.z;
    unsigned sum, cnt, mine, sp = 0u;
    for (;;) {
        sum = 0u; cnt = 0u; mine = 0u;
#pragma unroll
        for (unsigned j = 0; j < 16; ++j) { const unsigned c = xb_ld(&bar[XB_XCNT(j)]); sum += c; cnt += (c > 0u) ? 1u : 0u; mine = (j == x) ? c : mine; }
        if (sum == G) break;
        __builtin_amdgcn_s_sleep(1);
        if ((++sp & 255u) == 0u) { if (xb_ld(&bar[XB_TMO])) break; if (sp > XB_SPIN_CAP) { atomicAdd(&bar[XB_TMO], 1u); break; } }
    }
    nloc = mine > 0u ? mine : 1u; nx = cnt > 0u ? cnt : 1u;
}

__device__ __forceinline__ void xcd_barrier(const XcdBarrier& b, const int wave) {
    asm volatile("s_waitcnt vmcnt(0)" ::: "memory");
    __syncthreads();
    if (wave == 0 && lane_fresh() == 0) {
        unsigned* bar = b.bar;
        __builtin_amdgcn_s_waitcnt(0);
        unsigned nloc = b.st[0], nx = b.st[1];
        if (nloc == 0u) { xcd_barrier_complete(bar, b.x, nloc, nx); b.st[0] = nloc; b.st[1] = nx; }
        const unsigned old = xb_add(&bar[XB_XSUB(b.x)], 1u);
        const unsigned gen = old / nloc;
        if (old + 1u == (gen + 1u) * nloc) {
            __builtin_amdgcn_fence(__ATOMIC_RELEASE, "agent");
            asm volatile("s_waitcnt vmcnt(0)" ::: "memory");
            const unsigned og = xb_add(&bar[XB_TOP], 1u);
            const unsigned tg = og / nx;
            if (og + 1u == (tg + 1u) * nx) xb_add(&bar[XB_TOPGEN], 1u);
            else XB_SPIN(xb_ld(&bar[XB_TOPGEN]) == tg, bar);
            __builtin_amdgcn_fence(__ATOMIC_ACQUIRE, "agent");
            xb_add(&bar[XB_XGEN(b.x)], 1u);
            asm volatile("s_waitcnt vmcnt(0)" ::: "memory");
        } else {
            XB_SPIN(xb_ld(&bar[XB_XGEN(b.x)]) == gen, bar);
            __builtin_amdgcn_fence(__ATOMIC_ACQUIRE, "agent");
            asm volatile("s_waitcnt vmcnt(0)" ::: "memory");
        }
    }
    __syncthreads();
}

__device__ __forceinline__ void tr_item(const float* W, int ldw, int nvalid, bf16* WT, int ldt, int k0, int n0, int drow0, int dcol0, LAS float* scr, int lane) {
    const int n = n0 + (lane & 31); const bool ok = n < nvalid;
#pragma unroll 8
    for (int i = 0; i < 32; ++i) { const int kk = 2 * i + (lane >> 5); scr[kk * 33 + (lane & 31)] = ok ? W[(size_t)(k0 + kk) * ldw + n] : 0.f; }
    LDS_WAIT(); asm volatile("" ::: "memory");
    const int c = lane & 7;
#pragma unroll
    for (int j = 0; j < 4; ++j) { const int nn = (lane >> 3) + 8 * j; const LAS float* s = scr + (8 * c) * 33 + nn;
        v4u o; o.x = pk2(s[0 * 33], s[1 * 33]); o.y = pk2(s[2 * 33], s[3 * 33]); o.z = pk2(s[4 * 33], s[5 * 33]); o.w = pk2(s[6 * 33], s[7 * 33]);
        *(GAS v4u*)(WT + (size_t)(drow0 + nn) * ldt + dcol0 + k0 + 8 * c) = o; }
    LDS_WAIT(); asm volatile("" ::: "memory");
}
__device__ __forceinline__ void tr_item8(const float* W, int ldw, unsigned char* WT, int ldt, int k0, int n0, int drow0, float sc, LAS float* scr, int lane) {
    const int n = n0 + (lane & 31);
#pragma unroll 8
    for (int i = 0; i < 32; ++i) { const int kk = 2 * i + (lane >> 5); scr[kk * 33 + (lane & 31)] = W[(size_t)(k0 + kk) * ldw + n]; }
    LDS_WAIT(); asm volatile("" ::: "memory");
    const int nn = lane >> 1, hf = lane & 1; const LAS float* sp = scr + (32 * hf) * 33 + nn;
    unsigned o[8];
#pragma unroll
    for (int q = 0; q < 8; ++q) { const float a = fminf(fmaxf(sp[(4 * q + 0) * 33] * sc, -448.f), 448.f), b = fminf(fmaxf(sp[(4 * q + 1) * 33] * sc, -448.f), 448.f), c = fminf(fmaxf(sp[(4 * q + 2) * 33] * sc, -448.f), 448.f), d = fminf(fmaxf(sp[(4 * q + 3) * 33] * sc, -448.f), 448.f);
        int w = 0; w = __builtin_amdgcn_cvt_pk_fp8_f32(a, b, w, false); w = __builtin_amdgcn_cvt_pk_fp8_f32(c, d, w, true); o[q] = (unsigned)w; }
    GAS v4u* dst = (GAS v4u*)(WT + (size_t)(drow0 + nn) * ldt + k0 + 32 * hf);
    dst[0] = (v4u){o[0], o[1], o[2], o[3]}; dst[1] = (v4u){o[4], o[5], o[6], o[7]};
    LDS_WAIT(); asm volatile("" ::: "memory");
}
__device__ __forceinline__ void tr_item_ln(const float* W, int ldw, int nvalid, bf16* WT, int ldt, int k0, int n0, int drow0, const float* gain, const float* bvec, long long* gW, long long* bW, LAS float* scr, int lane) {
    const int n = n0 + (lane & 31); const bool ok = n < nvalid;
#pragma unroll 8
    for (int i = 0; i < 32; ++i) { const int kk = 2 * i + (lane >> 5); scr[kk * 33 + (lane & 31)] = ok ? W[(size_t)(k0 + kk) * ldw + n] : 0.f; }
    LDS_WAIT(); asm volatile("" ::: "memory");
    const int c = lane & 7;
    const f32x4 g0 = *(const GAS f32x4*)(gain + k0 + 8 * c), g1 = *(const GAS f32x4*)(gain + k0 + 8 * c + 4), b0 = *(const GAS f32x4*)(bvec + k0 + 8 * c), b1 = *(const GAS f32x4*)(bvec + k0 + 8 * c + 4);
    const float gk[8] = {g0.x, g0.y, g0.z, g0.w, g1.x, g1.y, g1.z, g1.w}, bk[8] = {b0.x, b0.y, b0.z, b0.w, b1.x, b1.y, b1.z, b1.w};
#pragma unroll
    for (int j = 0; j < 4; ++j) { const int nn = (lane >> 3) + 8 * j; const LAS float* sp = scr + (8 * c) * 33 + nn;
        float v[8], bs = 0.f;
#pragma unroll
        for (int i = 0; i < 8; ++i) { const float raw = sp[i * 33]; v[i] = raw * gk[i]; bs += raw * bk[i]; }
        v4u o; o.x = pk2(v[0], v[1]); o.y = pk2(v[2], v[3]); o.z = pk2(v[4], v[5]); o.w = pk2(v[6], v[7]);
        float gs = ((blo(o.x) + bhi(o.x)) + (blo(o.y) + bhi(o.y))) + ((blo(o.z) + bhi(o.z)) + (blo(o.w) + bhi(o.w)));
        *(GAS v4u*)(WT + (size_t)(drow0 + nn) * ldt + k0 + 8 * c) = o;
        gs += __shfl_xor(gs, 1); gs += __shfl_xor(gs, 2); gs += __shfl_xor(gs, 4); bs += __shfl_xor(bs, 1); bs += __shfl_xor(bs, 2); bs += __shfl_xor(bs, 4);
        if (c == 0) { (void)__hip_atomic_fetch_add(gW + drow0 + nn, (long long)__builtin_rintf(gs * FX_V), __ATOMIC_RELAXED, __HIP_MEMORY_SCOPE_AGENT); (void)__hip_atomic_fetch_add(bW + drow0 + nn, (long long)__builtin_rintf(bs * FX_V), __ATOMIC_RELAXED, __HIP_MEMORY_SCOPE_AGENT); } }
    LDS_WAIT(); asm volatile("" ::: "memory");
}
__device__ __forceinline__ void tr_item8_ln(const float* W, int ldw, unsigned char* WT, int ldt, int k0, int n0, int drow0, float sc, const float* gain, const float* bvec, long long* gW, long long* bW, LAS float* scr, int lane) {
    const int n = n0 + (lane & 31);
#pragma unroll 8
    for (int i = 0; i < 32; ++i) { const int kk = 2 * i + (lane >> 5); scr[kk * 33 + (lane & 31)] = W[(size_t)(k0 + kk) * ldw + n]; }
    LDS_WAIT(); asm volatile("" ::: "memory");
    const int nn = lane >> 1, hf = lane & 1; const LAS float* sp = scr + (32 * hf) * 33 + nn;
    unsigned o[8]; float gs = 0.f, bs = 0.f;
#pragma unroll
    for (int q = 0; q < 8; ++q) { const f32x4 g4 = *(const GAS f32x4*)(gain + k0 + 32 * hf + 4 * q), b4 = *(const GAS f32x4*)(bvec + k0 + 32 * hf + 4 * q);
        const float r0 = sp[(4 * q + 0) * 33], r1 = sp[(4 * q + 1) * 33], r2 = sp[(4 * q + 2) * 33], r3 = sp[(4 * q + 3) * 33];
        bs += (r0 * b4.x + r1 * b4.y) + (r2 * b4.z + r3 * b4.w);
        const float a = fminf(fmaxf(r0 * g4.x * sc, -448.f), 448.f), b = fminf(fmaxf(r1 * g4.y * sc, -448.f), 448.f), c = fminf(fmaxf(r2 * g4.z * sc, -448.f), 448.f), d = fminf(fmaxf(r3 * g4.w * sc, -448.f), 448.f);
        int w = 0; w = __builtin_amdgcn_cvt_pk_fp8_f32(a, b, w, false); w = __builtin_amdgcn_cvt_pk_fp8_f32(c, d, w, true); o[q] = (unsigned)w;
        gs += (__builtin_amdgcn_cvt_f32_fp8(w, 0) + __builtin_amdgcn_cvt_f32_fp8(w, 1)) + (__builtin_amdgcn_cvt_f32_fp8(w, 2) + __builtin_amdgcn_cvt_f32_fp8(w, 3)); }
    GAS v4u* dst = (GAS v4u*)(WT + (size_t)(drow0 + nn) * ldt + k0 + 32 * hf);
    dst[0] = (v4u){o[0], o[1], o[2], o[3]}; dst[1] = (v4u){o[4], o[5], o[6], o[7]};
    gs += __shfl_xor(gs, 1); bs += __shfl_xor(bs, 1);
    if (hf == 0) { (void)__hip_atomic_fetch_add(gW + drow0 + nn, (long long)__builtin_rintf(gs / sc * FX_V), __ATOMIC_RELAXED, __HIP_MEMORY_SCOPE_AGENT); (void)__hip_atomic_fetch_add(bW + drow0 + nn, (long long)__builtin_rintf(bs * FX_V), __ATOMIC_RELAXED, __HIP_MEMORY_SCOPE_AGENT); }
    LDS_WAIT(); asm volatile("" ::: "memory");
}
__device__ __forceinline__ void cvt_item8(const float* src, unsigned char* dst, int item, int lane, float sc) {
    const GAS f32x4* sp = (const GAS f32x4*)(src + (size_t)item * 512) + 2 * lane; f32x4 a = sp[0] * sc, b = sp[1] * sc;
    int w0 = 0, w1 = 0; w0 = __builtin_amdgcn_cvt_pk_fp8_f32(fminf(fmaxf(a.x, -448.f), 448.f), fminf(fmaxf(a.y, -448.f), 448.f), w0, false); w0 = __builtin_amdgcn_cvt_pk_fp8_f32(fminf(fmaxf(a.z, -448.f), 448.f), fminf(fmaxf(a.w, -448.f), 448.f), w0, true);
    w1 = __builtin_amdgcn_cvt_pk_fp8_f32(fminf(fmaxf(b.x, -448.f), 448.f), fminf(fmaxf(b.y, -448.f), 448.f), w1, false); w1 = __builtin_amdgcn_cvt_pk_fp8_f32(fminf(fmaxf(b.z, -448.f), 448.f), fminf(fmaxf(b.w, -448.f), 448.f), w1, true);
    *((GAS v2u*)(dst + (size_t)item * 512) + lane) = (v2u){(unsigned)w0, (unsigned)w1};
}
__device__ __forceinline__ void cvt_item(const float* src, bf16* dst, int item, int lane) {
    const GAS f32x4* s = (const GAS f32x4*)(src + (size_t)item * 512) + 2 * lane; const f32x4 a = s[0], b = s[1];
    v4u o; o.x = pk2(a.x, a.y); o.y = pk2(a.z, a.w); o.z = pk2(b.x, b.y); o.w = pk2(b.z, b.w);
    *((GAS v4u*)(dst + (size_t)item * 512) + lane) = o;
}
__device__ __forceinline__ void p0_prologue(const float* const (&in)[24], unsigned char* ws, LAS unsigned char* lds, int gw, int NGW, int wave, int lane) {
    LAS float* scr = (LAS float*)(lds + RING_OFF + wave * 16384);
#define TRM(SRC, Kk, LDW, NVALID, NPAD, DST, LDT, ROWMAP, DCOL) { constexpr int nblk = (NPAD) / 32; constexpr int cnt = ((Kk) / 64) * nblk; \
        if (r < cnt) { const int kb = r / nblk, nb = r % nblk, n0 = 32 * nb; tr_item(SRC, LDW, NVALID, (bf16*)(ws + (DST)), LDT, 64 * kb, n0, (ROWMAP), (DCOL), scr, lane); continue; } r -= cnt; }
#define TRM8(SRC, Kk, LDW, NN, DST, LDT, ROWMAP, SC) { constexpr int nblk = (NN) / 32; constexpr int cnt = ((Kk) / 64) * nblk; \
        if (r < cnt) { const int kb = r / nblk, nb = r % nblk, n0 = 32 * nb; tr_item8(SRC, LDW, (unsigned char*)(ws + (DST)), LDT, 64 * kb, n0, (ROWMAP), SC, scr, lane); continue; } r -= cnt; }
    long long* const vec = (long long*)(ws + WS_CTL + CTL_VEC);
#define TRML(SRC, Kk, LDW, NVALID, NPAD, DST, LDT, ROWMAP, GAIN, BVEC, VG, VB) { constexpr int nblk = (NPAD) / 32; constexpr int cnt = ((Kk) / 64) * nblk; \
        if (r < cnt) { const int kb = r / nblk, nb = r % nblk, n0 = 32 * nb; tr_item_ln(SRC, LDW, NVALID, (bf16*)(ws + (DST)), LDT, 64 * kb, n0, (ROWMAP), GAIN, BVEC, vec + (VG), vec + (VB), scr, lane); continue; } r -= cnt; }
#define TRML8(SRC, Kk, LDW, NN, DST, LDT, ROWMAP, SC, GAIN, BVEC, VG, VB) { constexpr int nblk = (NN) / 32; constexpr int cnt = ((Kk) / 64) * nblk; \
        if (r < cnt) { const int kb = r / nblk, nb = r % nblk, n0 = 32 * nb; tr_item8_ln(SRC, LDW, (unsigned char*)(ws + (DST)), LDT, 64 * kb, n0, (ROWMAP), SC, GAIN, BVEC, vec + (VG), vec + (VB), scr, lane); continue; } r -= cnt; }
    constexpr int N_TR = 2 * (32 * 176) + 88 * 64 + 32 * 184 + 2 * (32 * 64) + 256 + 2 * (16 * 64) + 32 * 64 + 32 * 16 + 32 * 32 + 8 * 64 + 2 * (32 * 176) + 88 * 64;
    for (int it = gw; it < N_TR; it += NGW) {
        int r = it;
        TRM8(in[2], 2048, 5632, 5632, WS_W_GU1, 2048, 256 * (n0 >> 7) + (n0 & 127), FP8_WGUS)
        TRM8(in[3], 2048, 5632, 5632, WS_W_GU1, 2048, 256 * (n0 >> 7) + 128 + (n0 & 127), FP8_WGUS)
        TRM8(in[4], 5632, 2048, 2048, WS_W_D1, 5632, n0, FP8_WDS)
        TRML(in[5], 2048, 5712, 5712, 5888, WS_W_IN, 2048, n0, in[22], in[23], V_GW_IN, V_BW_IN)
        TRML8(in[11], 2048, 2048, 2048, WS_W_G, 2048, 256 * (n0 >> 7) + (n0 & 127), FP8_WGS, in[22], in[23], V_GW_G, V_BW_G)
        TRML8(in[11] + (size_t)2048 * 2048, 2048, 2048, 2048, WS_W_G, 2048, 256 * (n0 >> 7) + 128 + (n0 & 127), FP8_WGS, in[22], in[23], V_GW_G, V_BW_G)
        if (r < 256) { const int h = r >> 5, rr = r & 31, kb = rr >> 2, nb = rr & 3;
            tr_item(in[10] + (size_t)h * 512 * 128, 128, 128, (bf16*)(ws + WS_W_UVP), 1024, 64 * kb, 32 * nb, (h >> 1) * 256 + (h & 1) * 128 + 32 * nb, (h & 1) * 512, scr, lane); continue; } r -= 256;
        TRM(in[13], 1024, 2048, 2048, 2048, WS_W_A, 1024, n0, 0)
        TRM(in[14], 1024, 2048, 2048, 2048, WS_W_B, 1024, n0, 0)
        TRM8(in[15], 2048, 2048, 2048, WS_W_MO, 2048, n0, FP8_WMOS)
        TRML(in[16], 2048, 512, 512, 512, WS_W_MQ, 2048, n0, in[22] + D, in[23] + D, V_GW_MQ, V_BW_MQ)
        TRM(in[17], 2048, 1024, 1024, 1024, WS_W_MKV, 2048, n0, 0)
        TRM(in[18], 512, 2048, 2048, 2048, WS_W_MOUT, 512, n0, 0)
        TRML8(in[19], 2048, 5632, 5632, WS_W_GU2, 2048, 256 * (n0 >> 7) + (n0 & 127), FP8_WGUS, in[22] + 2 * D, in[23] + 2 * D, V_GW_GU2, V_BW_GU2)
        TRML8(in[20], 2048, 5632, 5632, WS_W_GU2, 2048, 256 * (n0 >> 7) + 128 + (n0 & 127), FP8_WGUS, in[22] + 2 * D, in[23] + 2 * D, V_GW_GU2, V_BW_GU2)
        TRM8(in[21], 5632, 2048, 2048, WS_W_D2, 5632, n0, FP8_WDS)
    }
#undef TRM
#undef TRM8
#undef TRML
#undef TRML8
    for (int rw = gw; rw < 1024; rw += NGW) { const int e = (rw >> 7) & 1; *((GAS v4u*)((bf16*)(ws + WS_W_UVP) + (size_t)rw * 1024 + (1 - e) * 512) + lane) = (v4u){0u, 0u, 0u, 0u}; }
    for (int it = gw; it < (M * D) / 512; it += NGW) cvt_item8(in[0], (unsigned char*)(ws + WS_X8), it, lane, FP8_XS);
    for (int it = gw; it < (BATCH * MEMT * D) / 512; it += NGW) cvt_item(in[1], (bf16*)(ws + WS_MEM16), it, lane);
    for (int it = gw; it < (8 * 512 * 128) / 512; it += NGW) cvt_item(in[9], (bf16*)(ws + WS_W_UK), it, lane);
}

__device__ __forceinline__ void ln_phase(float* zx, bf16* x16, unsigned char* x8, const float* g, const float* b, int gw, int NGW, int lane) {
    f32x4 gv[8], bv[8];
#pragma unroll
    for (int j = 0; j < 8; ++j) { gv[j] = *((const GAS f32x4*)g + lane + 64 * j); bv[j] = *((const GAS f32x4*)b + lane + 64 * j); }
    for (int m = gw; m < M; m += NGW) {
        GAS f32x4* xr = (GAS f32x4*)(zx + (size_t)m * D) + lane;
        f32x4 v[8]; float s = 0.f;
#pragma unroll
        for (int j = 0; j < 8; ++j) { v[j] = xr[64 * j]; s += (v[j].x + v[j].y) + (v[j].z + v[j].w); }
        const float mean = wave_sum(s) * (1.f / D); float s2 = 0.f;
#pragma unroll
        for (int j = 0; j < 8; ++j) { v[j] = v[j] - mean; s2 += (v[j].x * v[j].x + v[j].y * v[j].y) + (v[j].z * v[j].z + v[j].w * v[j].w); }
        const float rstd = 1.f / sqrtf(wave_sum(s2) * (1.f / D) + LN_EPS);
#pragma unroll
        for (int j = 0; j < 8; ++j) { v[j] = v[j] * rstd * gv[j] + bv[j]; xr[64 * j] = v[j]; }
        if (x16) { GAS v2u* o8 = (GAS v2u*)(x16 + (size_t)m * D) + lane;
#pragma unroll
            for (int j = 0; j < 8; ++j) o8[64 * j] = (v2u){pk2(v[j].x, v[j].y), pk2(v[j].z, v[j].w)}; }
        if (x8) { GAS unsigned* o4 = (GAS unsigned*)(x8 + (size_t)m * D) + lane;
#pragma unroll
            for (int j = 0; j < 8; ++j) { const f32x4 q = v[j] * FP8_XS; int w = 0; w = __builtin_amdgcn_cvt_pk_fp8_f32(fminf(fmaxf(q.x, -448.f), 448.f), fminf(fmaxf(q.y, -448.f), 448.f), w, false);
                w = __builtin_amdgcn_cvt_pk_fp8_f32(fminf(fmaxf(q.z, -448.f), 448.f), fminf(fmaxf(q.w, -448.f), 448.f), w, true); o4[64 * j] = (unsigned)w; } }
    }
}
__device__ __forceinline__ void ln_final_phase(const bf16* z16, float* outp, const float* g, const float* b, int gw, int NGW, int lane) {
    for (int m = gw; m < M; m += NGW) {
        const GAS v4u* zr = (const GAS v4u*)(z16 + (size_t)m * D) + lane;
        float v[32]; float s = 0.f;
#pragma unroll
        for (int j = 0; j < 4; ++j) { const v4u w = zr[64 * j]; v[8 * j + 0] = blo(w.x); v[8 * j + 1] = bhi(w.x); v[8 * j + 2] = blo(w.y); v[8 * j + 3] = bhi(w.y); v[8 * j + 4] = blo(w.z); v[8 * j + 5] = bhi(w.z); v[8 * j + 6] = blo(w.w); v[8 * j + 7] = bhi(w.w); }
#pragma unroll
        for (int e = 0; e < 32; ++e) s += v[e];
        const float mean = wave_sum(s) * (1.f / D); float s2 = 0.f;
#pragma unroll
        for (int e = 0; e < 32; ++e) { v[e] -= mean; s2 += v[e] * v[e]; }
        const float rstd = 1.f / sqrtf(wave_sum(s2) * (1.f / D) + LN_EPS);
#pragma unroll
        for (int j = 0; j < 4; ++j) { const int c0 = 512 * j + 8 * lane;
            const f32x4 g0 = *(const GAS f32x4*)(g + c0), g1 = *(const GAS f32x4*)(g + c0 + 4), b0 = *(const GAS f32x4*)(b + c0), b1 = *(const GAS f32x4*)(b + c0 + 4);
            GAS f32x4* o = (GAS f32x4*)(outp + (size_t)m * D + c0);
            o[0] = (f32x4){v[8 * j + 0], v[8 * j + 1], v[8 * j + 2], v[8 * j + 3]} * rstd * g0 + b0; o[1] = (f32x4){v[8 * j + 4], v[8 * j + 5], v[8 * j + 6], v[8 * j + 7]} * rstd * g1 + b1; }
    }
}
__device__ __forceinline__ void crms_phase(const bf16* bc, unsigned char* c8, const float* kvg, float cs, int gw, int NGW, int lane) {
    float gg[8];
#pragma unroll
    for (int j = 0; j < 8; ++j) gg[j] = kvg[8 * lane + j] * cs;
    for (int m = gw; m < M; m += NGW) {
        const v4u w = *((const GAS v4u*)(bc + (size_t)m * 512) + lane);
        float x[8] = {blo(w.x), bhi(w.x), blo(w.y), bhi(w.y), blo(w.z), bhi(w.z), blo(w.w), bhi(w.w)}; float s = 0.f;
#pragma unroll
        for (int j = 0; j < 8; ++j) s += x[j] * x[j];
        const float r = 1.f / sqrtf(wave_sum(s) * (1.f / 512.f) + LN_EPS);
#pragma unroll
        for (int j = 0; j < 8; ++j) x[j] = fminf(fmaxf(x[j] * r * gg[j], -448.f), 448.f);
        *((GAS v2u*)(c8 + (size_t)m * 512) + lane) = (v2u){pg8::pk4_fp8(x[0], x[1], x[2], x[3]), pg8::pk4_fp8(x[4], x[5], x[6], x[7])};
    }
}
typedef short v4i16_t __attribute__((ext_vector_type(4)));
__device__ __forceinline__ v4i16_t lds_tr16(const LAS unsigned char* p) { return __builtin_amdgcn_ds_read_tr16_b64_v4i16((LAS v4i16_t*)p); }
__device__ __forceinline__ unsigned cvtpk(float lo, float hi) { typedef float f2 __attribute__((ext_vector_type(2))); typedef __bf16 b2 __attribute__((ext_vector_type(2))); f2 v = {lo, hi}; b2 b = __builtin_convertvector(v, b2); return __builtin_bit_cast(unsigned, b); }
__device__ __forceinline__ float xhalf_f(float v) { return __shfl_xor(v, 32); }
constexpr float LOG2E = 1.4426950408889634f;
constexpr float QSCALE = 0.125f * LOG2E;

__device__ __forceinline__ void diff_attn_mfma(LAS unsigned char* lds, const bf16* AQ, const bf16* AK, const bf16* AV, bf16* YA, const float* dlam, const float* subg, unsigned* dq, const unsigned* kmax, const int wave) {
    const int lane = lane_fresh(), r32 = lane & 31, hi = lane >> 5;
    const int comp = wave >> 2, wq = wave & 3;
    const unsigned ksrc = (unsigned)(lane * 1024 + (2 * wave) * 8);
    const unsigned vsrc0 = (unsigned)((16 * ((2 * wave) & 3) + (lane >> 2)) * 1024 + ((2 * wave) >> 2) * 32 + (lane & 3) * 8);
    const unsigned vsrc1 = (unsigned)((16 * ((2 * wave + 1) & 3) + (lane >> 2)) * 1024 + ((2 * wave + 1) >> 2) * 32 + (lane & 3) * 8);
    const unsigned kdst = (unsigned)(2 * wave) * 1024u, vdst0 = 16384u + (unsigned)(((2 * wave) >> 2) * 4096 + ((2 * wave) & 3) * 1024), vdst1 = 16384u + (unsigned)(((2 * wave + 1) >> 2) * 4096 + ((2 * wave + 1) & 3) * 1024);
    const unsigned lds0 = (unsigned)(uintptr_t)lds;
#define DA_STAGE(bo, to) do { \
        glds16(Kg + (to) + ksrc, (unsigned)__builtin_amdgcn_readfirstlane((int)(lds0 + (bo) + kdst))); \
        glds16(Kg + (to) + ksrc + 8, (unsigned)__builtin_amdgcn_readfirstlane((int)(lds0 + (bo) + kdst + 1024))); \
        glds16(Vg + (to) + vsrc0, (unsigned)__builtin_amdgcn_readfirstlane((int)(lds0 + (bo) + vdst0))); \
        glds16(Vg + (to) + vsrc1, (unsigned)__builtin_amdgcn_readfirstlane((int)(lds0 + (bo) + vdst1))); } while (0)
#define DA_WAITBAR() asm volatile("s_waitcnt vmcnt(0) lgkmcnt(0)\n\ts_barrier" ::: "memory")
    const unsigned koff = (unsigned)(((comp * 8 + hi) * 64 + r32) * 16);
    const unsigned voff = (unsigned)(16384 + (4 * hi + ((lane & 15) >> 2)) * 64 + ((lane >> 4) & 1) * 32 + (lane & 3) * 8);
    LAS unsigned* xq = (LAS unsigned*)(lds + 100352);
    for (;;) {
        if (wave == 0 && lane == 0) xq[0] = __hip_atomic_fetch_add(dq, 1u, __ATOMIC_RELAXED, __HIP_MEMORY_SCOPE_AGENT);
        asm volatile("s_waitcnt vmcnt(0) lgkmcnt(0)\n\ts_barrier" ::: "memory");
        const int j = (int)xq[0];
        if (j >= 1024) break;
        const int ub = 31 - (j >> 5), bh = j & 31;
        const int b = bh >> 3, h = 7 - (bh & 7);
        const float sl2 = LOG2E / (float)(2 << h);
        const size_t rowbase = (size_t)b * SEQ; const int q0 = ub * 128;
        const int qpos = q0 + wq * 32 + r32;
        const int nt = 2 * ub + 2;
        const int myt = 2 * ub + 1 + (wq >> 1);
        const bf16* Kg = AK + rowbase * 1024 + h * 128; const bf16* Vg = AV + rowbase * 1024 + h * 128;
        bf16x8 qr[4];
#pragma unroll
        for (int s = 0; s < 4; ++s) qr[s] = *(const GAS bf16x8*)(AQ + (rowbase + qpos) * 1024 + h * 128 + comp * 64 + s * 16 + hi * 8);
        f32x16 o[4];
#pragma unroll
        for (int blk = 0; blk < 4; ++blk)
#pragma unroll
            for (int r = 0; r < 16; ++r) o[blk][r] = 0.f;
        float mrun = -INFINITY, lrun = 0.f;
        { float qn2 = 0.f;
#pragma unroll
          for (int s = 0; s < 4; ++s) { const v4u w = __builtin_bit_cast(v4u, qr[s]); const float e0 = blo(w.x), e1 = bhi(w.x), e2 = blo(w.y), e3 = bhi(w.y), e4 = blo(w.z), e5 = bhi(w.z), e6 = blo(w.w), e7 = bhi(w.w);
              qn2 += ((e0 * e0 + e1 * e1) + (e2 * e2 + e3 * e3)) + ((e4 * e4 + e5 * e5) + (e6 * e6 + e7 * e7)); }
          qn2 += xhalf_f(qn2);
#pragma unroll
          for (int o_ = 1; o_ < 32; o_ <<= 1) qn2 = fmaxf(qn2, __shfl_xor(qn2, o_));
          const float kb = __uint_as_float(__hip_atomic_load(kmax + (b * 8 + h) * 2 + comp, __ATOMIC_RELAXED, __HIP_MEMORY_SCOPE_AGENT));
          if (lane == 0) xq[8 + wave] = __float_as_uint(sqrtf(qn2) * kb * 8.1f); }
        DA_STAGE(0u, (size_t)(nt - 1) * 64 * 1024);
        DA_WAITBAR();
        int kt_lo = 0;
        { float sb = 0.f;
#pragma unroll
          for (int w_ = 0; w_ < 8; ++w_) sb = fmaxf(sb, __uint_as_float(xq[8 + w_]));
          const float xcut = (float)(q0 - 63) - (40.f + 2.f * sb) / sl2;
          kt_lo = xcut > 0.f ? (int)__builtin_ceilf(xcut * (1.f / 64.f)) : 0; kt_lo = __builtin_amdgcn_readfirstlane(kt_lo); }
        for (int st = 0; st < nt - kt_lo; ++st) {
            const int kt = nt - 1 - st;
            const unsigned bufo = (unsigned)(st & 1) * 32768u;
            if (kt > kt_lo) DA_STAGE(32768u - bufo, (size_t)(kt - 1) * 64 * 1024);
            if (kt < myt) {
                const LAS unsigned char* Kb = lds + bufo + koff;
                f32x16 p0, p1;
#pragma unroll
                for (int r = 0; r < 16; ++r) { p0[r] = 0.f; p1[r] = 0.f; }
                { bf16x8 kf[4];
#pragma unroll
                  for (int s = 0; s < 4; ++s) kf[s] = *(const LAS bf16x8*)(Kb + s * 2048);
#pragma unroll
                  for (int s = 0; s < 4; ++s) p0 = __builtin_amdgcn_mfma_f32_32x32x16_bf16(kf[s], qr[s], p0, 0, 0, 0); }
                { bf16x8 kf[4];
#pragma unroll
                  for (int s = 0; s < 4; ++s) kf[s] = *(const LAS bf16x8*)(Kb + s * 2048 + 512);
#pragma unroll
                  for (int s = 0; s < 4; ++s) p1 = __builtin_amdgcn_mfma_f32_32x32x16_bf16(kf[s], qr[s], p1, 0, 0, 0); }
                const float qth = (float)(qpos - kt * 64 - 4 * hi);
                float rm = -INFINITY;
#pragma unroll
                for (int r = 0; r < 16; ++r) { const float kr = (float)((r & 3) + 8 * (r >> 2)); const float v0 = qth - kr, v1 = qth - (kr + 32.f);
                    p0[r] = p0[r] - sl2 * fabsf(v0); p1[r] = p1[r] - sl2 * fabsf(v1); rm = fmaxf(rm, fmaxf(p0[r], p1[r])); }
                rm = fmaxf(rm, xhalf_f(rm));
                if (__any(rm > mrun)) { const float mn = fmaxf(mrun, rm), f = __builtin_amdgcn_exp2f(mrun - mn); mrun = mn; lrun *= f;
#pragma unroll
                    for (int blk = 0; blk < 4; ++blk)
#pragma unroll
                        for (int r = 0; r < 16; ++r) o[blk][r] *= f; }
                float ls = 0.f;
#pragma unroll
                for (int r = 0; r < 16; ++r) { p0[r] = __builtin_amdgcn_exp2f(p0[r] - mrun); p1[r] = __builtin_amdgcn_exp2f(p1[r] - mrun); ls += p0[r] + p1[r]; }
                lrun += ls;
                bf16x8 pw[4];
#pragma unroll
                for (int s = 0; s < 2; ++s) {
                    v4u a = {cvtpk(p0[8 * s + 0], p0[8 * s + 1]), cvtpk(p0[8 * s + 2], p0[8 * s + 3]), cvtpk(p0[8 * s + 4], p0[8 * s + 5]), cvtpk(p0[8 * s + 6], p0[8 * s + 7])};
                    v4u c = {cvtpk(p1[8 * s + 0], p1[8 * s + 1]), cvtpk(p1[8 * s + 2], p1[8 * s + 3]), cvtpk(p1[8 * s + 4], p1[8 * s + 5]), cvtpk(p1[8 * s + 6], p1[8 * s + 7])};
                    pw[s] = __builtin_bit_cast(bf16x8, a); pw[2 + s] = __builtin_bit_cast(bf16x8, c); }
                const LAS unsigned char* Vb = lds + bufo + voff;
#pragma unroll
                for (int blk = 0; blk < 4; ++blk) {
#pragma unroll
                    for (int s = 0; s < 4; ++s) {
                        const v4i16_t lo = lds_tr16(Vb + blk * 4096 + s * 1024), hh = lds_tr16(Vb + blk * 4096 + s * 1024 + 512);
                        const bf16x8 vf = {lo[0], lo[1], lo[2], lo[3], hh[0], hh[1], hh[2], hh[3]};
                        o[blk] = __builtin_amdgcn_mfma_f32_32x32x16_bf16(vf, pw[s], o[blk], 0, 0, 0);
                    }
                }
            }
            DA_WAITBAR();
        }
        lrun += xhalf_f(lrun);
        const float inv = 1.f / lrun;
        LAS float* Y1 = (LAS float*)(lds) + wq * 4096;
        if (comp == 1) {
            float lam; { float a = dlam[lane] * dlam[64 + lane], bq_ = dlam[128 + lane] * dlam[192 + lane]; a = wave_sum(a); bq_ = wave_sum(bq_); lam = __expf(a) - __expf(bq_) + LAMBDA_INIT; }
            const float sc = inv * lam;
#pragma unroll
            for (int blk = 0; blk < 4; ++blk)
#pragma unroll
                for (int r = 0; r < 16; ++r) Y1[(32 * blk + (r & 3) + 8 * (r >> 2) + 4 * hi) * 32 + r32] = o[blk][r] * sc; }
        __syncthreads();
        if (comp == 0) {
            float ss = 0.f;
#pragma unroll
            for (int blk = 0; blk < 4; ++blk)
#pragma unroll
                for (int r = 0; r < 16; ++r) { const float a = o[blk][r] * inv - Y1[(32 * blk + (r & 3) + 8 * (r >> 2) + 4 * hi) * 32 + r32]; o[blk][r] = a; ss += a * a; }
            ss += xhalf_f(ss);
            const float rr = (1.0f - LAMBDA_INIT) / sqrtf(ss * (1.f / 128.f) + LN_EPS);
            LAS unsigned* stg = (LAS unsigned*)(lds + 65536) + wq * (32 * 65);
#pragma unroll
            for (int blk = 0; blk < 4; ++blk) {
#pragma unroll
                for (int r = 0; r < 16; r += 2) { const int e = 32 * blk + (r & 3) + 8 * (r >> 2) + 4 * hi;
                    stg[r32 * 65 + (e >> 1)] = cvtpk(o[blk][r] * rr * subg[e], o[blk][r + 1] * rr * subg[e + 1]); }
                asm volatile("" ::: "memory"); }
            LDS_WAIT(); asm volatile("" ::: "memory");
            bf16* orow = YA + (rowbase + q0 + wq * 32) * 1024 + h * 128;
#pragma unroll 4
            for (int row = 0; row < 32; ++row) *((GAS unsigned*)(orow + (size_t)row * 1024) + lane) = stg[row * 65 + lane];
        }
        __syncthreads();
    }
#undef DA_STAGE
#undef DA_WAITBAR
}

__device__ __forceinline__ unsigned okey(float f) { const unsigned u = __float_as_uint(f); return (u & 0x80000000u) ? ~u : (u | 0x80000000u); }
__device__ __forceinline__ void indexer_topk(LAS unsigned char* lds, const bf16* IQ, const bf16* IKW, unsigned short* IDX, int vcu, int G, const int wave) {
    const int lane = lane_fresh(), r32 = lane & 31, hi = lane >> 5;
    const unsigned lds0 = (unsigned)(uintptr_t)lds;
    const unsigned boff = (unsigned)((hi * 256 + r32) * 16);
    for (int j = vcu; j < 1024; j += G) {
        const int w = j & 255, i = j >> 8, bq = w >> 4, s16 = w & 15;
        const int chunk = (i == 0) ? s16 : (i == 1) ? 31 - s16 : (i == 2) ? 32 + s16 : 63 - s16;
        const int b = bq >> 2, gq = bq & 3;
        const int t0 = b * SEQ + chunk * 64 + gq * 16 + 2 * wave;
        const int ngroups = 2 * (chunk + 1);
        const int ntiles = (ngroups + 7) >> 3;
        const bf16* Kg = IKW + (size_t)b * SEQ * 256;
#define IX_STAGE(tile, bo) do { int tl_ = (tile); asm volatile("" : "+s"(tl_)); _Pragma("unroll") for (int i_ = 0; i_ < 4; ++i_) { const int q_ = 4 * wave + i_; \
            glds16s(Kg + (size_t)(tl_ * 256 + 64 * (q_ & 3)) * 256 + (q_ >> 2) * 8, (unsigned)lane * 512u, (unsigned)__builtin_amdgcn_readfirstlane((int)(lds0 + (bo) + ((q_ >> 2) * 256 + 64 * (q_ & 3)) * 16))); } } while (0)
        asm volatile("s_barrier" ::: "memory");
        IX_STAGE(0, 0u);
        bf16x8 a[4];
#pragma unroll
        for (int ks = 0; ks < 4; ++ks) a[ks] = *(const GAS bf16x8*)(IQ + (size_t)(t0 + (r32 >> 4)) * 1024 + (r32 & 15) * 64 + ks * 16 + 8 * hi);
        float wv[16];
        { const bf16* iwp = IKW + (size_t)t0 * 256 + 64 + 4 * hi;
          const v2u w00 = *(const GAS v2u*)(iwp), w01 = *(const GAS v2u*)(iwp + 8), w10 = *(const GAS v2u*)(iwp + 256), w11 = *(const GAS v2u*)(iwp + 256 + 8);
          wv[0] = blo(w00.x); wv[1] = bhi(w00.x); wv[2] = blo(w00.y); wv[3] = bhi(w00.y); wv[4] = blo(w01.x); wv[5] = bhi(w01.x); wv[6] = blo(w01.y); wv[7] = bhi(w01.y);
          wv[8] = blo(w10.x); wv[9] = bhi(w10.x); wv[10] = blo(w10.y); wv[11] = bhi(w10.y); wv[12] = blo(w11.x); wv[13] = bhi(w11.x); wv[14] = blo(w11.y); wv[15] = bhi(w11.y); }
        unsigned key[128];
#pragma unroll 128
        for (int g = 0; g < 128; ++g) {
            if (g < ngroups) {
                const unsigned bufo = (unsigned)((g >> 3) & 1) * 32768u;
                if ((g & 7) == 0) {
                    asm volatile("s_waitcnt vmcnt(0)\n\ts_barrier" ::: "memory");
                    if ((g >> 3) + 1 < ntiles) IX_STAGE((g >> 3) + 1, 32768u - bufo);
                }
                bf16x8 bk[4];
#pragma unroll
                for (int ks = 0; ks < 4; ++ks) bk[ks] = *(const LAS bf16x8*)(lds + bufo + boff + (g & 7) * 512 + ks * 8192);
                f32x16 acc = {0.f, 0.f, 0.f, 0.f, 0.f, 0.f, 0.f, 0.f, 0.f, 0.f, 0.f, 0.f, 0.f, 0.f, 0.f, 0.f};
#pragma unroll
                for (int ks = 0; ks < 4; ++ks) acc = __builtin_amdgcn_mfma_f32_32x32x16_bf16(a[ks], bk[ks], acc, 0, 0, 0);
                float s0 = 0.f, s1 = 0.f;
#pragma unroll
                for (int r = 0; r < 8; ++r) { s0 += wv[r] * fmaxf(acc[r], 0.f); s1 += wv[8 + r] * fmaxf(acc[8 + r], 0.f); }
                s0 += __shfl_xor(s0, 32); s1 += __shfl_xor(s1, 32);
                key[g] = okey(hi ? s1 : s0);
            } else key[g] = 0u;
        }
        unsigned T = 0u;
        if (chunk >= 4) {
            bool done = false;
#pragma nounroll
            for (int bit = 31; bit >= 0; --bit) {
                if (__all(done ? 1 : 0)) break;
                const unsigned trial = T | (1u << bit);
                int cnt = 0;
#pragma unroll
                for (int g = 0; g < 128; ++g) cnt += (key[g] >= trial) ? 1 : 0;
                cnt += __shfl_xor(cnt, 1); cnt += __shfl_xor(cnt, 2); cnt += __shfl_xor(cnt, 4); cnt += __shfl_xor(cnt, 8); cnt += __shfl_xor(cnt, 16);
                if (!done && cnt >= 256) { T = trial; if (cnt == 256) done = true; }
            }
        }
        int base = 0;
        unsigned short* ip = IDX + (size_t)(t0 + hi) * 256;
#pragma unroll
        for (int g = 0; g < 128; ++g) {
            if (g < ngroups) {
                const bool sel = key[g] >= T;
                const unsigned long long mk = __ballot(sel ? 1 : 0);
                const unsigned mh = hi ? (unsigned)(mk >> 32) : (unsigned)mk;
                const int pos = base + __popc(mh & ((1u << r32) - 1u));
                if (sel && pos < 256) ip[pos] = (unsigned short)(32 * g + r32);
                base += __popc(mh);
            }
        }
    }
#undef IX_STAGE
    asm volatile("s_waitcnt vmcnt(0) lgkmcnt(0)\n\ts_barrier" ::: "memory");
}

constexpr int DSA_PAIRB = 1040;
constexpr int DSA_WAVEB = 16 * DSA_PAIRB + 512;
constexpr int DSA_LDS_END = 8 * DSA_WAVEB;
constexpr float DSA_CS = 64.f, DSA_QS = 64.f, DSA_PS = 256.f;
typedef int v2i_t __attribute__((ext_vector_type(2)));
__device__ __forceinline__ void dsa_mfma(LAS unsigned char* lds, const bf16* QL, bf16* OL, const int omask, const unsigned char* C8, const unsigned short* IDX, int vcu, int G, const int wave) {
    const int lane = lane_fresh(), h16 = lane & 15, g = lane >> 4;
    LAS unsigned char* wl = lds + wave * DSA_WAVEB;
    const unsigned wl0 = (unsigned)(uintptr_t)wl;
    LAS unsigned short* idxs = (LAS unsigned short*)(wl + 16 * DSA_PAIRB);
    const float sc2 = 0.08838834764831845f * LOG2E / (DSA_QS * DSA_CS);
    const float sl2 = (h16 < 8) ? LOG2E / (float)(2 << (h16 & 7)) : 0.f;
    const int ntok = (G == 256) ? 8 : (M - (vcu * 8 + wave) + G * 8 - 1) / (G * 8);
#define DSA_TOK(i) ((G == 256) ? ((vcu >> 6) * SEQ + (vcu & 63) + 64 * (wave + 8 * (i))) : (vcu * 8 + wave + G * 8 * (i)))
    const unsigned qk_off = (unsigned)((h16 >> 1) * DSA_PAIRB + (h16 & 1) * 512 + 32 * g);
    const int trow = (h16 >> 1) < 4 ? 4 * g + (h16 >> 1) : 16 + 4 * g + ((h16 >> 1) - 4);
    const unsigned pv_off = (unsigned)((trow >> 1) * DSA_PAIRB + (trow & 1) * 512 + 8 * (h16 & 1));
    for (int it = 0; it < ntok; ++it) {
        const int t = DSA_TOK(it); const int tpos = t & (SEQ - 1);
        const int n = (tpos >> 6) >= 3 ? 256 : 64 * ((tpos >> 6) + 1); const int nst = n >> 5;
        const unsigned char* Cb = C8 + (size_t)(t >> 12) * SEQ * 512;
        int ln = lane; asm volatile("" : "+v"(ln));
        const int h16b = ln & 15, gb = ln >> 4;
        { const v2u iv = __builtin_nontemporal_load((const GAS v2u*)(IDX + (size_t)t * 256) + ln); *((LAS v2u*)idxs + ln) = iv; }
        pg8::v8i_t qf[4];
        { const bf16* qp = QL + (size_t)t * 4096 + (h16b & 7) * 512 + 32 * gb;
#pragma unroll
          for (int s = 0; s < 4; ++s) { unsigned w8[8];
#pragma unroll
              for (int c = 0; c < 4; ++c) { const v4u w = __builtin_nontemporal_load((const GAS v4u*)(qp + 128 * s + 8 * c));
                  w8[2 * c] = pg8::pk4_fp8(fminf(fmaxf(blo(w.x) * DSA_QS, -448.f), 448.f), fminf(fmaxf(bhi(w.x) * DSA_QS, -448.f), 448.f), fminf(fmaxf(blo(w.y) * DSA_QS, -448.f), 448.f), fminf(fmaxf(bhi(w.y) * DSA_QS, -448.f), 448.f));
                  w8[2 * c + 1] = pg8::pk4_fp8(fminf(fmaxf(blo(w.z) * DSA_QS, -448.f), 448.f), fminf(fmaxf(bhi(w.z) * DSA_QS, -448.f), 448.f), fminf(fmaxf(blo(w.w) * DSA_QS, -448.f), 448.f), fminf(fmaxf(bhi(w.w) * DSA_QS, -448.f), 448.f)); }
              qf[s] = (pg8::v8i_t){(int)w8[0], (int)w8[1], (int)w8[2], (int)w8[3], (int)w8[4], (int)w8[5], (int)w8[6], (int)w8[7]}; } }
        f32x4 o[32];
#pragma unroll
        for (int blk = 0; blk < 32; ++blk) o[blk] = (f32x4){0.f, 0.f, 0.f, 0.f};
        float mrun = -INFINITY, lrun = 0.f;
        asm volatile("s_waitcnt vmcnt(0) lgkmcnt(0)" ::: "memory");
        for (int st = 0; st < nst; ++st) {
#pragma unroll
            for (int i = 0; i < 16; ++i) { const unsigned srow = idxs[st * 32 + 2 * i + (lane >> 5)];
                glds16s(Cb, srow * 512u + (unsigned)(lane & 31) * 16u, (unsigned)__builtin_amdgcn_readfirstlane((int)(wl0 + i * DSA_PAIRB))); }
            asm volatile("s_waitcnt vmcnt(0)" ::: "memory");
            f32x4 a0 = {0.f, 0.f, 0.f, 0.f}, a1 = {0.f, 0.f, 0.f, 0.f};
#pragma unroll
            for (int s = 0; s < 4; ++s) {
                const pg8::v4i_t x0 = *(const LAS pg8::v4i_t*)(wl + qk_off + 128 * s), x1 = *(const LAS pg8::v4i_t*)(wl + qk_off + 128 * s + 16);
                const pg8::v4i_t y0 = *(const LAS pg8::v4i_t*)(wl + qk_off + 8 * DSA_PAIRB + 128 * s), y1 = *(const LAS pg8::v4i_t*)(wl + qk_off + 8 * DSA_PAIRB + 128 * s + 16);
                a0 = __builtin_amdgcn_mfma_scale_f32_16x16x128_f8f6f4(__builtin_shufflevector(x0, x1, 0, 1, 2, 3, 4, 5, 6, 7), qf[s], a0, 0, 0, 0, 0x7f7f7f7f, 0, 0x7f7f7f7f);
                a1 = __builtin_amdgcn_mfma_scale_f32_16x16x128_f8f6f4(__builtin_shufflevector(y0, y1, 0, 1, 2, 3, 4, 5, 6, 7), qf[s], a1, 0, 0, 0, 0x7f7f7f7f, 0, 0x7f7f7f7f); }
            const v2u i0 = *(const LAS v2u*)(idxs + st * 32 + 4 * g), i1 = *(const LAS v2u*)(idxs + st * 32 + 16 + 4 * g);
            const int sidx[8] = {(int)(i0.x & 0xffffu), (int)(i0.x >> 16), (int)(i0.y & 0xffffu), (int)(i0.y >> 16), (int)(i1.x & 0xffffu), (int)(i1.x >> 16), (int)(i1.y & 0xffffu), (int)(i1.y >> 16)};
            float lg[8];
#pragma unroll
            for (int r = 0; r < 8; ++r) { const int d = tpos - sidx[r]; lg[r] = (r < 4 ? a0[r & 3] : a1[r & 3]) * sc2 - sl2 * (float)(d < 0 ? -d : d); }
            float rm = fmaxf(fmaxf(fmaxf(lg[0], lg[1]), fmaxf(lg[2], lg[3])), fmaxf(fmaxf(lg[4], lg[5]), fmaxf(lg[6], lg[7])));
            rm = fmaxf(rm, __shfl_xor(rm, 16)); rm = fmaxf(rm, __shfl_xor(rm, 32));
            const float mn = fmaxf(mrun, rm), f = __builtin_amdgcn_exp2f(mrun - mn); mrun = mn;
#pragma unroll
            for (int r = 0; r < 8; ++r) lg[r] = __builtin_amdgcn_exp2f(lg[r] - mn) * DSA_PS;
            const unsigned pw0 = pg8::pk4_fp8(lg[0], lg[1], lg[2], lg[3]), pw1 = pg8::pk4_fp8(lg[4], lg[5], lg[6], lg[7]);
            { const float ps = ((__builtin_amdgcn_cvt_f32_fp8((int)pw0, 0) + __builtin_amdgcn_cvt_f32_fp8((int)pw0, 1)) + (__builtin_amdgcn_cvt_f32_fp8((int)pw0, 2) + __builtin_amdgcn_cvt_f32_fp8((int)pw0, 3)))
                           + ((__builtin_amdgcn_cvt_f32_fp8((int)pw1, 0) + __builtin_amdgcn_cvt_f32_fp8((int)pw1, 1)) + (__builtin_amdgcn_cvt_f32_fp8((int)pw1, 2) + __builtin_amdgcn_cvt_f32_fp8((int)pw1, 3)));
              lrun = lrun * f + ps; }
            const long pw = (long)(((unsigned long)pw1 << 32) | (unsigned long)pw0);
#pragma unroll
            for (int blk = 0; blk < 32; ++blk) {
                const v2i_t av = __builtin_amdgcn_ds_read_tr8_b64_v2i32((LAS v2i_t*)(wl + pv_off + 16 * blk));
                const long al = (long)(((unsigned long)(unsigned)av.y << 32) | (unsigned long)(unsigned)av.x);
                o[blk] = __builtin_amdgcn_mfma_f32_16x16x32_fp8_fp8(al, pw, o[blk] * f, 0, 0, 0);
                if ((blk & 3) == 3) __builtin_amdgcn_sched_barrier(0);
            }
        }
        float lt = lrun; lt += __shfl_xor(lt, 16); lt += __shfl_xor(lt, 32);
        const float inv = 1.f / (lt * DSA_CS);
        if (h16 < 8) {
#pragma unroll
            for (int blk = 0; blk < 32; ++blk) { const f32x4 v = o[blk] * inv;
                __builtin_nontemporal_store((v2u){cvtpk(v.x, v.y), cvtpk(v.z, v.w)}, (GAS v2u*)(OL + (size_t)(t & omask) * 4096 + h16b * 512 + 16 * blk + 4 * gb)); } }
    }
    asm volatile("s_waitcnt vmcnt(0) lgkmcnt(0)" ::: "memory");
    __syncthreads();
#undef DSA_TOK
}
static_assert(DSA_LDS_END <= RING_BYTES, "DSA LDS map");

__device__ __forceinline__ void memattn_mfma(LAS unsigned char* lds, const bf16* QM, const bf16* KV, bf16* OM, int vcu, int G, const int wave) {
    const int lane = lane_fresh(), r32 = lane & 31, hi = lane >> 5;
    const unsigned voff = (unsigned)(65536 + (4 * hi + ((lane & 15) >> 2)) * 64 + ((lane >> 4) & 1) * 32 + (lane & 3) * 8);
    for (int j = vcu; j < 256; j += G) {
        const int bh = j >> 4, qb = j & 15, b = bh >> 2, h = bh & 3;
        const bf16* Kg = KV + (size_t)b * MEMT * 1024 + h * 128; const bf16* Vg = Kg + 512;
#pragma unroll
        for (int i = 0; i < 8; ++i) { const int q = 8 * wave + i;
            glds16(Kg + (size_t)(64 * (q & 3) + lane) * 1024 + (q >> 2) * 8, (unsigned)__builtin_amdgcn_readfirstlane((int)((unsigned)(uintptr_t)lds + ((q >> 2) * 256 + 64 * (q & 3)) * 16)));
            glds16(Vg + (size_t)(16 * (q & 15) + (lane >> 2)) * 1024 + (q >> 4) * 32 + (lane & 3) * 8, (unsigned)__builtin_amdgcn_readfirstlane((int)((unsigned)(uintptr_t)lds + 65536 + (q >> 4) * 16384 + (q & 15) * 1024))); }
        const size_t qrow = (size_t)b * SEQ + qb * 256 + wave * 32 + r32;
        bf16x8 qr[8];
#pragma unroll
        for (int s = 0; s < 8; ++s) qr[s] = *(const GAS bf16x8*)(QM + qrow * 512 + h * 128 + s * 16 + hi * 8);
        f32x16 o[4];
#pragma unroll
        for (int blk = 0; blk < 4; ++blk)
#pragma unroll
            for (int r = 0; r < 16; ++r) o[blk][r] = 0.f;
        float mrun = -INFINITY, lrun = 0.f;
        asm volatile("s_waitcnt vmcnt(0) lgkmcnt(0)\n\ts_barrier" ::: "memory");
        for (int kt = 0; kt < 4; ++kt) {
            const LAS unsigned char* Kb = lds + (unsigned)((hi * 256 + 64 * kt + r32) * 16);
            f32x16 p0, p1;
#pragma unroll
            for (int r = 0; r < 16; ++r) { p0[r] = 0.f; p1[r] = 0.f; }
#pragma unroll
            for (int s = 0; s < 8; ++s) { const bf16x8 k0 = *(const LAS bf16x8*)(Kb + s * 8192), k1 = *(const LAS bf16x8*)(Kb + s * 8192 + 512);
                p0 = __builtin_amdgcn_mfma_f32_32x32x16_bf16(k0, qr[s], p0, 0, 0, 0); p1 = __builtin_amdgcn_mfma_f32_32x32x16_bf16(k1, qr[s], p1, 0, 0, 0); }
            float rm = -INFINITY;
#pragma unroll
            for (int r = 0; r < 16; ++r) rm = fmaxf(rm, fmaxf(p0[r], p1[r]));
            rm = fmaxf(rm, xhalf_f(rm));
            if (__any(rm > mrun)) { const float mn = fmaxf(mrun, rm), f = __builtin_amdgcn_exp2f(mrun - mn); mrun = mn; lrun *= f;
#pragma unroll
                for (int blk = 0; blk < 4; ++blk)
#pragma unroll
                    for (int r = 0; r < 16; ++r) o[blk][r] *= f; }
            float ls = 0.f;
#pragma unroll
            for (int r = 0; r < 16; ++r) { p0[r] = __builtin_amdgcn_exp2f(p0[r] - mrun); p1[r] = __builtin_amdgcn_exp2f(p1[r] - mrun); ls += p0[r] + p1[r]; }
            lrun += ls;
            bf16x8 pw[4];
#pragma unroll
            for (int s = 0; s < 2; ++s) {
                v4u a = {cvtpk(p0[8 * s + 0], p0[8 * s + 1]), cvtpk(p0[8 * s + 2], p0[8 * s + 3]), cvtpk(p0[8 * s + 4], p0[8 * s + 5]), cvtpk(p0[8 * s + 6], p0[8 * s + 7])};
                v4u c = {cvtpk(p1[8 * s + 0], p1[8 * s + 1]), cvtpk(p1[8 * s + 2], p1[8 * s + 3]), cvtpk(p1[8 * s + 4], p1[8 * s + 5]), cvtpk(p1[8 * s + 6], p1[8 * s + 7])};
                pw[s] = __builtin_bit_cast(bf16x8, a); pw[2 + s] = __builtin_bit_cast(bf16x8, c); }
            const LAS unsigned char* Vb = lds + voff + kt * 4096;
#pragma unroll
            for (int blk = 0; blk < 4; ++blk) {
#pragma unroll
                for (int s = 0; s < 4; ++s) {
                    const v4i16_t lo = lds_tr16(Vb + blk * 16384 + s * 1024), hh = lds_tr16(Vb + blk * 16384 + s * 1024 + 512);
                    const bf16x8 vf = {lo[0], lo[1], lo[2], lo[3], hh[0], hh[1], hh[2], hh[3]};
                    o[blk] = __builtin_amdgcn_mfma_f32_32x32x16_bf16(vf, pw[s], o[blk], 0, 0, 0);
                }
            }
        }
        __syncthreads();
        lrun += xhalf_f(lrun);
        const float inv = 1.f / lrun;
        LAS unsigned* stg = (LAS unsigned*)(lds) + wave * (32 * 65);
#pragma unroll
        for (int blk = 0; blk < 4; ++blk)
#pragma unroll
            for (int r = 0; r < 16; r += 2) { const int e = 32 * blk + (r & 3) + 8 * (r >> 2) + 4 * hi;
                stg[r32 * 65 + (e >> 1)] = cvtpk(o[blk][r] * inv, o[blk][r + 1] * inv); }
        LDS_WAIT(); asm volatile("" ::: "memory");
        bf16* orow = OM + ((size_t)b * SEQ + qb * 256 + wave * 32) * 512 + h * 128;
#pragma unroll 4
        for (int row = 0; row < 32; ++row) *((GAS unsigned*)(orow + (size_t)row * 512) + lane) = stg[row * 65 + lane];
        __syncthreads();
    }
}

constexpr int N_PHASES = 21;
struct Args { const float* in[24]; float* out; unsigned char* ws; int ph_lo, ph_hi; };
__global__ void __launch_bounds__(NWAVES * 64, 2) mk_fwd(Args args) {
    extern __shared__ __attribute__((aligned(16))) unsigned char lds_raw[];
    LAS unsigned char* lds = (LAS unsigned char*)lds_raw;
    volatile LAS unsigned* MISC = (volatile LAS unsigned*)(lds + MISC_OFF);
    const int tid = threadIdx.x, wave = __builtin_amdgcn_readfirstlane(tid >> 6);
#define lane lane_fresh()
    const int G = gridDim.x, bx = blockIdx.x;
    const int vcu = (G % 8 == 0) ? (bx % 8) * (G / 8) + bx / 8 : bx;
    const int gw = vcu * NWAVES + wave, NGW = G * NWAVES;
    unsigned char* ws = args.ws;
    gu32* ctl = (gu32*)(ws + WS_CTL);
    for (int u = tid; u < (LDS_BYTES - LDSCTL_OFF) / 4; u += NWAVES * 64) ((LAS unsigned*)(lds + LDSCTL_OFF))[u] = 0u;
    __syncthreads();
    const bool one = (args.ph_hi - args.ph_lo) > 1;
    XcdBarrier bar; bar.bar = (unsigned*)(ctl + CW_BAR); bar.x = 0; bar.st = nullptr;
    if (one) bar = xcd_barrier_post((unsigned*)(ctl + CW_BAR), MISC + 8, tid == 0);
    const int lo = args.ph_lo, hi = args.ph_hi;
#ifndef PH_MASK
#define PH_MASK 0xFFFFFFFFu
#endif
#define IN(k) ((((PH_MASK) >> (k)) & 1u) && lo <= (k) && (k) < hi)
#define SEAM(k) do { if (IN(k) && IN((k) + 1)) xcd_barrier(bar, wave); } while (0)
    bf16* const X16 = (bf16*)(ws + WS_X16); bf16* const HB = (bf16*)(ws + WS_H);
    long long* const ST0 = (long long*)(ws + WS_CTL + CTL_STATS); long long* const ST1 = (long long*)(ws + WS_CTL + CTL_STATS + CTL_STATS_STRIDE); long long* const ST2 = (long long*)(ws + WS_CTL + CTL_STATS + 2 * CTL_STATS_STRIDE);
    const float* const VEC = (const float*)(ws + WS_CTL + CTL_VECF);
    float* const out = args.out;
    const float* const ln_g = args.in[22]; const float* const ln_b = args.in[23];
    using namespace pg8;

#ifdef PROBE_P0
    if (IN(0)) { p0_prologue(args.in, ws, lds, gw, NGW, wave, lane); }
#endif
    if (IN(0)) { p0_prologue(args.in, ws, lds, gw, NGW, wave, lane); }
    SEAM(0);
    if (IN(1)) { { const long long* vi = (const long long*)(ws + WS_CTL + CTL_VEC); float* vf = (float*)(ws + WS_CTL + CTL_VECF); for (int i = gw * 64 + lane; i < V_END; i += NGW * 64) vf[i] = (float)vi[i] * (1.0f / 16777216.f); }
        Gemm g{(const bf16*)(ws + WS_X8), (const bf16*)(ws + WS_W_GU1), D / 2, D / 2, D / 2, 0, 0}; StaticOrder S; S.init(M, 2 * FF, G, bx); EpiSwiGLU8 E{(unsigned char*)HB, FF, 1.0f / (FP8_XS * FP8_WGUS), FP8_HS, LnFold{nullptr, nullptr, nullptr}};
        gemm_phase<EpiSwiGLU8, StaticOrder, true, true>(lds + RING_OFF, g, S, E, wave); }
    SEAM(1);
    if (IN(2)) { Gemm g{HB, (const bf16*)(ws + WS_W_D1), FF / 2, FF / 2, FF / 2, 0, 0}; StaticOrder S; S.init(M, D, G, bx); EpiRes E{args.in[0], nullptr, D, ALPHA, 0.5f / (FP8_HS * FP8_WDS), nullptr, nullptr, nullptr, ST0, X16, (unsigned char*)(ws + WS_X8M), FP8_XS};
        gemm_phase<EpiRes, StaticOrder, true, true>(lds + RING_OFF, g, S, E, wave); }
    SEAM(2);
    if (IN(4)) {
        { Gemm g{X16, (const bf16*)(ws + WS_W_IN), D, D, D, 0, 0}; StaticOrder S; S.init(M, N_IN, G, bx);
          EpiInProj E{(bf16*)(ws + WS_AQ), (bf16*)(ws + WS_AK), (bf16*)(ws + WS_AV), (bf16*)(ws + WS_BQ), (bf16*)(ws + WS_BC), (bf16*)(ws + WS_IQ), (bf16*)(ws + WS_IKW), QSCALE, LnFold{ST0, VEC + V_GW_IN, VEC + V_BW_IN}, (unsigned*)(ctl + CW_KMAX)};
          gemm_phase<EpiInProj, StaticOrder, true>(lds + RING_OFF, g, S, E, wave); }
        { Gemm g{(const bf16*)(ws + WS_MEM16), (const bf16*)(ws + WS_W_MKV), D, D, D, 0, 0}; StaticOrder S; S.init(BATCH * MEMT, 1024, G, bx >= G - 16 ? bx - (G - 16) : (1 << 20)); EpiBf16 E{(bf16*)(ws + WS_KVMEM), 1024};
          gemm_phase<EpiBf16, StaticOrder, true>(lds + RING_OFF, g, S, E, wave); }
    }
    SEAM(4);
    if (IN(5)) {
        { Gemm g{(const bf16*)(ws + WS_BQ), (const bf16*)(ws + WS_W_UK), 1024, 128, 128, 1, 128}; StaticOrder S; S.init(M, 4096, G, bx); EpiBf16 E{(bf16*)(ws + WS_QLAT), 4096};
          gemm_phase<EpiBf16, StaticOrder, true>(lds + RING_OFF, g, S, E, wave); }
        crms_phase((const bf16*)(ws + WS_BC), (unsigned char*)(ws + WS_C8), args.in[8], DSA_CS, gw, NGW, lane);
    }
    if (IN(7)) indexer_topk(lds, (const bf16*)(ws + WS_IQ), (const bf16*)(ws + WS_IKW), (unsigned short*)(ws + WS_IDX), vcu, G, wave);
    if (IN(7)) diff_attn_mfma(lds, (const bf16*)(ws + WS_AQ), (const bf16*)(ws + WS_AK), (const bf16*)(ws + WS_AV), (bf16*)(ws + WS_AQ), args.in[6], args.in[7], (unsigned*)(ctl + CW_DQ), (const unsigned*)(ctl + CW_KMAX), wave);
    SEAM(7);
    if (IN(8)) dsa_mfma(lds, (const bf16*)(ws + WS_QLAT), (bf16*)(ws + WS_QLAT), 0x7fffffff, (const unsigned char*)(ws + WS_C8), (const unsigned short*)(ws + WS_IDX), vcu, G, wave);
    SEAM(8);
    if (IN(9)) { Gemm g{(const bf16*)(ws + WS_QLAT), (const bf16*)(ws + WS_W_UVP), 4096, 1024, 1024, 0, 1024}; StaticOrder S; S.init(M, 1024, G, bx); EpiBf16 E{(bf16*)(ws + WS_YB), 1024};
        gemm_phase<EpiBf16, StaticOrder, true>(lds + RING_OFF, g, S, E, wave); }
    SEAM(9);
    if (IN(10)) {
        { Gemm g{(const bf16*)(ws + WS_AQ), (const bf16*)(ws + WS_W_A), 1024, 1024, 1024, 0, 0}; StaticOrder S; S.init(M, D, G, bx); EpiBf16 E{(bf16*)(ws + WS_TA), D}; gemm_phase<EpiBf16, StaticOrder, true>(lds + RING_OFF, g, S, E, wave); }
        { Gemm g{(const bf16*)(ws + WS_YB), (const bf16*)(ws + WS_W_B), 1024, 1024, 1024, 0, 0}; StaticOrder S; S.init(M, D, G, bx); EpiBf16 E{(bf16*)(ws + WS_TB), D}; gemm_phase<EpiBf16, StaticOrder, true>(lds + RING_OFF, g, S, E, wave); }
    }
    SEAM(10);
    if (IN(11)) { Gemm g{(const bf16*)(ws + WS_X8M), (const bf16*)(ws + WS_W_G), D / 2, D / 2, D / 2, 0, 0}; StaticOrder S; S.init(M, 2 * D, G, bx);
        EpiGateMerge8 E{(const bf16*)(ws + WS_TA), (const bf16*)(ws + WS_TB), (unsigned char*)(ws + WS_MRG8), D, args.in[12], args.in[12] + D, 1.0f / (FP8_XS * FP8_WGS), FP8_MS, LnFold{ST0, VEC + V_GW_G, VEC + V_BW_G}};
        gemm_phase<EpiGateMerge8, StaticOrder, true, true>(lds + RING_OFF, g, S, E, wave); }
    SEAM(11);
    if (IN(12)) { Gemm g{(const bf16*)(ws + WS_MRG8), (const bf16*)(ws + WS_W_MO), D / 2, D / 2, D / 2, 0, 0}; StaticOrder S; S.init(M, D, G, bx); EpiRes E{nullptr, X16, D, ALPHA, 1.0f / (FP8_MS * FP8_WMOS), ST0, ln_g, ln_b, ST1, X16, nullptr, 0.f};
        gemm_phase<EpiRes, StaticOrder, true, true>(lds + RING_OFF, g, S, E, wave); }
    SEAM(12);
    if (IN(14)) { Gemm g{X16, (const bf16*)(ws + WS_W_MQ), D, D, D, 0, 0}; StaticOrder S; S.init(M, 512, G, bx); EpiBf16 E{(bf16*)(ws + WS_QM), 512, 0.08838834764831845f * LOG2E, LnFold{ST1, VEC + V_GW_MQ, VEC + V_BW_MQ}}; gemm_phase<EpiBf16, StaticOrder, true>(lds + RING_OFF, g, S, E, wave); }
    SEAM(14);
    if (IN(15)) memattn_mfma(lds, (const bf16*)(ws + WS_QM), (const bf16*)(ws + WS_KVMEM), (bf16*)(ws + WS_OM), vcu, G, wave);
    SEAM(15);
    if (IN(16)) { Gemm g{(const bf16*)(ws + WS_OM), (const bf16*)(ws + WS_W_MOUT), 512, 512, 512, 0, 0}; StaticOrder S; S.init(M, D, G, bx); EpiRes E{nullptr, X16, D, ALPHA, 1.0f, ST1, ln_g + D, ln_b + D, ST2, X16, (unsigned char*)(ws + WS_X8), FP8_XS};
        gemm_phase<EpiRes, StaticOrder, true>(lds + RING_OFF, g, S, E, wave); }
    SEAM(16);
    if (IN(18)) { Gemm g{(const bf16*)(ws + WS_X8), (const bf16*)(ws + WS_W_GU2), D / 2, D / 2, D / 2, 0, 0}; StaticOrder S; S.init(M, 2 * FF, G, bx); EpiSwiGLU8 E{(unsigned char*)HB, FF, 1.0f / (FP8_XS * FP8_WGUS), FP8_HS, LnFold{ST2, VEC + V_GW_GU2, VEC + V_BW_GU2}};
        gemm_phase<EpiSwiGLU8, StaticOrder, true, true>(lds + RING_OFF, g, S, E, wave); }
    SEAM(18);
    if (IN(19)) { Gemm g{HB, (const bf16*)(ws + WS_W_D2), FF / 2, FF / 2, FF / 2, 0, 0}; StaticOrder S; S.init(M, D, G, bx); EpiRes E{nullptr, X16, D, ALPHA, 0.5f / (FP8_HS * FP8_WDS), ST2, ln_g + 2 * D, ln_b + 2 * D, nullptr, X16, nullptr, 0.f};
        gemm_phase<EpiRes, StaticOrder, true, true>(lds + RING_OFF, g, S, E, wave); }
    SEAM(19);
    if (IN(20)) ln_final_phase(X16, out, ln_g + 3 * D, ln_b + 3 * D, gw, NGW, lane);
#undef IN
#undef SEAM
#undef lane
}

extern "C" void kernel_launch(void* const* d_in, const int* in_sizes, int n_in, void* d_out, int out_size, void* d_ws, size_t ws_size, hipStream_t stream) {
    static int grid = 0;
    if (grid == 0) {
        if (n_in != 24 || in_sizes[0] != M * D || out_size != M * D || ws_size < WS_END) { fprintf(stderr, "kernel_launch: unexpected shapes (n_in %d, in0 %d, out %d, ws %zu); nothing launched\n", n_in, n_in > 0 ? in_sizes[0] : -1, out_size, ws_size); grid = -1; return; }
        int dev = 0, cus = 0, per_cu = 0;
        if (hipGetDevice(&dev) != hipSuccess || hipDeviceGetAttribute(&cus, hipDeviceAttributeMultiprocessorCount, dev) != hipSuccess) { grid = -1; return; }
        if (hipFuncSetAttribute((const void*)mk_fwd, hipFuncAttributeMaxDynamicSharedMemorySize, LDS_BYTES) != hipSuccess) { fprintf(stderr, "kernel_launch: hipFuncSetAttribute failed\n"); grid = -1; return; }
        if (hipOccupancyMaxActiveBlocksPerMultiprocessor(&per_cu, (const void*)mk_fwd, NWAVES * 64, LDS_BYTES) != hipSuccess || per_cu < 1)
            fprintf(stderr, "kernel_launch: note: the occupancy query reports %d workgroups per CU\n", per_cu);
        (void)hipGetLastError();
        grid = cus;
    }
    if (grid < 0) return;
    if (hipMemsetAsync((char*)d_ws + WS_CTL, 0, CTL_ZERO_BYTES, stream) != hipSuccess) return;
    Args a{};
    for (int i = 0; i < 24; ++i) a.in[i] = (const float*)d_in[i];
    a.out = (float*)d_out; a.ws = (unsigned char*)d_ws;
#if MK_ONE_LAUNCH
    a.ph_lo = 0; a.ph_hi = N_PHASES;
    hipLaunchKernelGGL(mk_fwd, dim3(grid), dim3(NWAVES * 64), LDS_BYTES, stream, a);
#else
    for (int p = 0; p < N_PHASES; ++p) { a.ph_lo = p; a.ph_hi = p + 1; hipLaunchKernelGGL(mk_fwd, dim3(grid), dim3(NWAVES * 64), LDS_BYTES, stream, a); }
#endif
}
```

```cpp
#include <hip/hip_runtime.h>
#include <cstdio>
#include <cstdint>

#ifndef MK_ONE_LAUNCH
#define MK_ONE_LAUNCH 1
#endif

__device__ __forceinline__ int lane_fresh() { int l = (int)__builtin_amdgcn_mbcnt_hi(~0u, __builtin_amdgcn_mbcnt_lo(~0u, 0u)); asm volatile("" : "+v"(l)); return l; }
__device__ __forceinline__ void glds16(const void* gsrc, unsigned lds_dst) { unsigned keep;
    asm volatile("s_mov_b32 %0, m0\n\ts_mov_b32 m0, %2\n\ts_nop 0\n\tglobal_load_lds_dwordx4 %1, off\n\ts_mov_b32 m0, %0" : "=&s"(keep) : "v"(gsrc), "s"(lds_dst) : "memory"); }
__device__ __forceinline__ void glds16s(const void* sbase, unsigned voff, unsigned lds_dst) { unsigned keep;
    asm volatile("s_mov_b32 %0, m0\n\ts_mov_b32 m0, %3\n\ts_nop 0\n\tglobal_load_lds_dwordx4 %1, %2\n\ts_mov_b32 m0, %0" : "=&s"(keep) : "v"(voff), "s"(sbase), "s"(lds_dst) : "memory"); }
namespace pg8 {
#define PG8_LAS __attribute__((address_space(3)))
typedef unsigned short bf16_t;
typedef short bf16x8 __attribute__((ext_vector_type(8)));
typedef float f32x4 __attribute__((ext_vector_type(4)));
typedef unsigned u32x4 __attribute__((ext_vector_type(4)));
constexpr int BM = 256, BK = 64, HALF = 128, HTB = HALF * BK * 2  , STAGE_BYTES = 8 * HTB, NXCD = 8, WGM = 8;

__host__ __device__ __forceinline__ int lds_byte(int r, int c) { const int st = (r >> 4) * 2 + (c >> 5), rr = r & 15, cc = c & 31, ob = rr * 64 + cc * 2; return st * 1024 + (ob ^ (((ob >> 9) & 1) << 5)); }
__host__ __device__ __forceinline__ void stage_rc(int b, int& R, int& C) { const int st = b / 1024, sb = b % 1024, swz = sb ^ (((sb >> 9) & 1) << 5); R = (st >> 1) * 16 + swz / 64; C = (st & 1) * 32 + (swz % 64) / 2; }
__host__ __device__ __forceinline__ int perm32(int rho) { const int n = rho >> 4, i = rho & 15; return 8 * (i >> 2) + 4 * n + (i & 3); }

struct Unit { int pm, pn; };
struct Gemm { const bf16_t* A; const bf16_t* Bt; int lda, ldb, K, a_shift, a_mul; };

struct StaticOrder {
    int nM, nN, nwg, G, c;
    __host__ __device__ void init(int M, int N, int G_, int c_) { nM = M / BM; nN = N / BM; nwg = nM * nN; G = G_; c = c_; }
    __host__ __device__ bool next(int i, Unit& u) const {
        const long L = (long)i * G + c; if (L >= nwg) return false;
        int wgid = (int)L; { const int q = nwg / NXCD, r = nwg % NXCD, xcd = wgid % NXCD, off = wgid / NXCD; wgid = (xcd < r ? xcd * (q + 1) : r * (q + 1) + (xcd - r) * q) + off; }
        const int nig = WGM * nN, gid = wgid / nig, fm = gid * WGM, gsz = (nM - fm) < WGM ? (nM - fm) : WGM;
        u.pm = fm + ((wgid % nig) % gsz); u.pn = (wgid % nig) / gsz; return true;
    }
    __device__ __forceinline__ void a_ready(const Unit&) const {}
    __device__ __forceinline__ void done(const Unit&) const {}
};

__device__ __forceinline__ unsigned cvt_pk_bf16(float lo, float hi) { unsigned r; asm volatile("v_cvt_pk_bf16_f32 %0, %1, %2" : "=v"(r) : "v"(lo), "v"(hi)); return r; }
__device__ __forceinline__ float bflo(unsigned w) { return __uint_as_float(w << 16); }
__device__ __forceinline__ float bfhi(unsigned w) { return __uint_as_float(w & 0xffff0000u); }
__device__ __forceinline__ float sigmoidf_fast(float x) { return __builtin_amdgcn_rcpf(1.0f + __builtin_amdgcn_exp2f(-1.4426950408889634f * x)); }

struct LnFold {
    const long long* stats; const float* gW; const float* bW;
    __device__ __forceinline__ void row(int r, float& mean, float& rstd) const { const long long s0 = stats[2 * (size_t)r], s1 = stats[2 * (size_t)r + 1];
        mean = (float)s0 * (1.0f / (1048576.f * 2048.0f)); rstd = __builtin_amdgcn_rsqf((float)s1 * (1.0f / (65536.f * 2048.0f)) - mean * mean + 1e-5f); }
    __device__ __forceinline__ f32x4 vec4(const float* v, int i) const { return *(const f32x4*)(v + i); }
};
struct EpiBf16 {
    static constexpr bool PERM = true, AFTER_DRAIN = false;
    bf16_t* O; int ldc; float sc = 1.0f; LnFold lf = {nullptr, nullptr, nullptr};
    __device__ __forceinline__ void operator()(const f32x4 (&acc)[2][2][4][2], const Unit& u, int wr, int wc, int fr, int fq) const {
        const int row0 = u.pm * BM + wr * 64 + fr, col0 = u.pn * BM + wc * 32 + 8 * fq;
        f32x4 gw[2][2], bw[2][2];
#pragma unroll
        for (int bj = 0; bj < 2; ++bj)
#pragma unroll
            for (int n = 0; n < 2; ++n) { gw[bj][n] = (f32x4){0.f, 0.f, 0.f, 0.f}; bw[bj][n] = (f32x4){0.f, 0.f, 0.f, 0.f}; if (lf.stats) { gw[bj][n] = lf.vec4(lf.gW, col0 + bj * HALF + 4 * n); bw[bj][n] = lf.vec4(lf.bW, col0 + bj * HALF + 4 * n); } }
#pragma unroll
        for (int ai = 0; ai < 2; ++ai)
#pragma unroll
            for (int m = 0; m < 4; ++m) { bf16_t* rowp = O + (size_t)(row0 + ai * HALF + m * 16) * ldc + col0;
                float mean = 0.f, rstd = 1.f; if (lf.stats) lf.row(row0 + ai * HALF + m * 16, mean, rstd);
#pragma unroll
                for (int bj = 0; bj < 2; ++bj) { const f32x4 v0 = ((acc[ai][bj][m][0] - gw[bj][0] * mean) * rstd + bw[bj][0]) * sc, v1 = ((acc[ai][bj][m][1] - gw[bj][1] * mean) * rstd + bw[bj][1]) * sc;
                    u32x4 w; w.x = cvt_pk_bf16(v0[0], v0[1]); w.y = cvt_pk_bf16(v0[2], v0[3]); w.z = cvt_pk_bf16(v1[0], v1[1]); w.w = cvt_pk_bf16(v1[2], v1[3]);
                    *(u32x4*)(rowp + bj * HALF) = w; } }
    }
};
struct EpiInProj {
    static constexpr bool PERM = true, AFTER_DRAIN = false;
    bf16_t *aq, *ak, *av, *bq, *bc, *iq, *ikw; float qscale; LnFold lf; unsigned* kmax;
    __device__ __forceinline__ void operator()(const f32x4 (&acc)[2][2][4][2], const Unit& u, int wr, int wc, int fr, int fq) const {
        bf16_t* base; int ldc, colt; const int pn = u.pn;
        if (pn < 4) { base = aq; ldc = 1024; colt = pn * 256; }
        else if (pn < 8) { base = ak; ldc = 1024; colt = (pn - 4) * 256; }
        else if (pn < 12) { base = av; ldc = 1024; colt = (pn - 8) * 256; }
        else if (pn < 16) { base = bq; ldc = 1024; colt = (pn - 12) * 256; }
        else if (pn < 18) { base = bc; ldc = 512; colt = (pn - 16) * 256; }
        else if (pn < 22) { base = iq; ldc = 1024; colt = (pn - 18) * 256; }
        else { base = ikw; ldc = 256; colt = 0; }
        const float sc = (pn < 4) ? qscale : 1.0f; float kam[2] = {0.f, 0.f};
        const int row0 = u.pm * BM + wr * 64 + fr, col0 = colt + wc * 32 + 8 * fq, cidx = pn * BM + wc * 32 + 8 * fq;
        f32x4 gw[2][2], bw[2][2];
#pragma unroll
        for (int bj = 0; bj < 2; ++bj)
#pragma unroll
            for (int n = 0; n < 2; ++n) { gw[bj][n] = lf.vec4(lf.gW, cidx + bj * HALF + 4 * n); bw[bj][n] = lf.vec4(lf.bW, cidx + bj * HALF + 4 * n); }
#pragma unroll
        for (int ai = 0; ai < 2; ++ai)
#pragma unroll
            for (int m = 0; m < 4; ++m) { bf16_t* rowp = base + (size_t)(row0 + ai * HALF + m * 16) * ldc + col0;
                float mean, rstd; lf.row(row0 + ai * HALF + m * 16, mean, rstd);
#pragma unroll
                for (int bj = 0; bj < 2; ++bj) { const f32x4 v0 = ((acc[ai][bj][m][0] - gw[bj][0] * mean) * rstd + bw[bj][0]) * sc, v1 = ((acc[ai][bj][m][1] - gw[bj][1] * mean) * rstd + bw[bj][1]) * sc;
                    kam[bj] = fmaxf(kam[bj], fmaxf(fmaxf(fmaxf(fabsf(v0[0]), fabsf(v0[1])), fmaxf(fabsf(v0[2]), fabsf(v0[3]))), fmaxf(fmaxf(fabsf(v1[0]), fabsf(v1[1])), fmaxf(fabsf(v1[2]), fabsf(v1[3])))));
                    u32x4 w; w.x = cvt_pk_bf16(v0[0], v0[1]); w.y = cvt_pk_bf16(v0[2], v0[3]); w.z = cvt_pk_bf16(v1[0], v1[1]); w.w = cvt_pk_bf16(v1[2], v1[3]);
                    *(u32x4*)(rowp + bj * HALF) = w; } }
        if (pn >= 4 && pn < 8) {
#pragma unroll
            for (int bj = 0; bj < 2; ++bj) { float v = kam[bj];
#pragma unroll
                for (int o = 1; o < 64; o <<= 1) v = fmaxf(v, __shfl_xor(v, o));
                if ((fr | fq) == 0) (void)__hip_atomic_fetch_max(kmax + ((u.pm >> 4) * 8 + 2 * (pn - 4) + bj) * 2 + (wc >> 1), __float_as_uint(v), __ATOMIC_RELAXED, __HIP_MEMORY_SCOPE_AGENT); } }
    }
};
struct EpiSwiGLU {
    static constexpr bool PERM = true, AFTER_DRAIN = false;
    bf16_t* O; int ldc;
    __device__ __forceinline__ void operator()(const f32x4 (&acc)[2][2][4][2], const Unit& u, int wr, int wc, int fr, int fq) const {
        const int row0 = u.pm * BM + wr * 64 + fr, col0 = u.pn * HALF + wc * 32 + 8 * fq;
#pragma unroll
        for (int ai = 0; ai < 2; ++ai)
#pragma unroll
            for (int m = 0; m < 4; ++m) { bf16_t* rowp = O + (size_t)(row0 + ai * HALF + m * 16) * ldc + col0;
                float h[8];
#pragma unroll
                for (int n = 0; n < 2; ++n)
#pragma unroll
                    for (int j = 0; j < 4; ++j) { const float g = acc[ai][0][m][n][j], up = acc[ai][1][m][n][j]; h[4 * n + j] = g * sigmoidf_fast(g) * up; }
                u32x4 w; w.x = cvt_pk_bf16(h[0], h[1]); w.y = cvt_pk_bf16(h[2], h[3]); w.z = cvt_pk_bf16(h[4], h[5]); w.w = cvt_pk_bf16(h[6], h[7]);
                *(u32x4*)rowp = w; }
    }
};
__device__ __forceinline__ unsigned pk4_fp8(float a, float b, float c, float d) { int w = 0; w = __builtin_amdgcn_cvt_pk_fp8_f32(a, b, w, false); w = __builtin_amdgcn_cvt_pk_fp8_f32(c, d, w, true); return (unsigned)w; }
struct EpiSwiGLU8 {
    static constexpr bool PERM = true, AFTER_DRAIN = false;
    unsigned char* O; int ldc; float ascale, hs; LnFold lf;
    __device__ __forceinline__ void operator()(const f32x4 (&acc)[2][2][4][2], const Unit& u, int wr, int wc, int fr, int fq) const {
        const int row0 = u.pm * BM + wr * 64 + fr, col0 = u.pn * HALF + wc * 32 + 8 * fq, cidx = u.pn * BM + wc * 32 + 8 * fq;
        typedef unsigned u32x2 __attribute__((ext_vector_type(2)));
        f32x4 gw[2][2], bw[2][2];
#pragma unroll
        for (int bj = 0; bj < 2; ++bj)
#pragma unroll
            for (int n = 0; n < 2; ++n) { gw[bj][n] = (f32x4){0.f, 0.f, 0.f, 0.f}; bw[bj][n] = (f32x4){0.f, 0.f, 0.f, 0.f}; if (lf.stats) { gw[bj][n] = lf.vec4(lf.gW, cidx + bj * HALF + 4 * n); bw[bj][n] = lf.vec4(lf.bW, cidx + bj * HALF + 4 * n); } }
#pragma unroll
        for (int ai = 0; ai < 2; ++ai)
#pragma unroll
            for (int m = 0; m < 4; ++m) { unsigned char* rowp = O + (size_t)(row0 + ai * HALF + m * 16) * ldc + col0;
                float h[8]; float mean = 0.f, rstd = 1.f; if (lf.stats) lf.row(row0 + ai * HALF + m * 16, mean, rstd);
#pragma unroll
                for (int n = 0; n < 2; ++n)
#pragma unroll
                    for (int j = 0; j < 4; ++j) { const float g = (acc[ai][0][m][n][j] * ascale - gw[0][n][j] * mean) * rstd + bw[0][n][j], up = (acc[ai][1][m][n][j] * ascale - gw[1][n][j] * mean) * rstd + bw[1][n][j];
                        h[4 * n + j] = fminf(fmaxf(g * sigmoidf_fast(g) * up * hs, -448.f), 448.f); }
                *(u32x2*)rowp = (u32x2){pk4_fp8(h[0], h[1], h[2], h[3]), pk4_fp8(h[4], h[5], h[6], h[7])}; }
    }
};
struct EpiGateMerge {
    static constexpr bool PERM = true, AFTER_DRAIN = false;
    const bf16_t* ta; const bf16_t* tb; bf16_t* O; int ldc; const float* b0; const float* b1;
    __device__ __forceinline__ void operator()(const f32x4 (&acc)[2][2][4][2], const Unit& u, int wr, int wc, int fr, int fq) const {
        const int row0 = u.pm * BM + wr * 64 + fr, col0 = u.pn * HALF + wc * 32 + 8 * fq;
        float bb0[8], bb1[8];
#pragma unroll
        for (int j = 0; j < 8; ++j) { bb0[j] = b0[col0 + j]; bb1[j] = b1[col0 + j]; }
#pragma unroll
        for (int ai = 0; ai < 2; ++ai)
#pragma unroll
            for (int m = 0; m < 4; ++m) { const size_t off = (size_t)(row0 + ai * HALF + m * 16) * ldc + col0;
                const u32x4 a = *(const u32x4*)(ta + off), b = *(const u32x4*)(tb + off);
                const float av[8] = {bflo(a.x), bfhi(a.x), bflo(a.y), bfhi(a.y), bflo(a.z), bfhi(a.z), bflo(a.w), bfhi(a.w)};
                const float bv[8] = {bflo(b.x), bfhi(b.x), bflo(b.y), bfhi(b.y), bflo(b.z), bfhi(b.z), bflo(b.w), bfhi(b.w)};
                float h[8];
#pragma unroll
                for (int n = 0; n < 2; ++n)
#pragma unroll
                    for (int j = 0; j < 4; ++j) { const int e = 4 * n + j; h[e] = sigmoidf_fast(acc[ai][0][m][n][j] + bb0[e]) * av[e] + sigmoidf_fast(acc[ai][1][m][n][j] + bb1[e]) * bv[e]; }
                u32x4 w; w.x = cvt_pk_bf16(h[0], h[1]); w.y = cvt_pk_bf16(h[2], h[3]); w.z = cvt_pk_bf16(h[4], h[5]); w.w = cvt_pk_bf16(h[6], h[7]);
                *(u32x4*)(O + off) = w; }
    }
};
struct EpiGateMerge8 {
    static constexpr bool PERM = true, AFTER_DRAIN = false;
    const bf16_t* ta; const bf16_t* tb; unsigned char* O; int ldc; const float* b0; const float* b1; float ascale, ms; LnFold lf;
    __device__ __forceinline__ void operator()(const f32x4 (&acc)[2][2][4][2], const Unit& u, int wr, int wc, int fr, int fq) const {
        const int row0 = u.pm * BM + wr * 64 + fr, col0 = u.pn * HALF + wc * 32 + 8 * fq, cidx = u.pn * BM + wc * 32 + 8 * fq;
        typedef unsigned u32x2 __attribute__((ext_vector_type(2)));
        float bb0[8], bb1[8], gw0[8], gw1[8];
#pragma unroll
        for (int j = 0; j < 8; ++j) { bb0[j] = b0[col0 + j] + lf.bW[cidx + j]; bb1[j] = b1[col0 + j] + lf.bW[cidx + HALF + j]; gw0[j] = lf.gW[cidx + j]; gw1[j] = lf.gW[cidx + HALF + j]; }
#pragma unroll
        for (int ai = 0; ai < 2; ++ai)
#pragma unroll
            for (int m = 0; m < 4; ++m) { const size_t off = (size_t)(row0 + ai * HALF + m * 16) * ldc + col0;
                const u32x4 a = *(const u32x4*)(ta + off), b = *(const u32x4*)(tb + off);
                const float av[8] = {bflo(a.x), bfhi(a.x), bflo(a.y), bfhi(a.y), bflo(a.z), bfhi(a.z), bflo(a.w), bfhi(a.w)};
                const float bv[8] = {bflo(b.x), bfhi(b.x), bflo(b.y), bfhi(b.y), bflo(b.z), bfhi(b.z), bflo(b.w), bfhi(b.w)};
                float h[8]; float mean, rstd; lf.row(row0 + ai * HALF + m * 16, mean, rstd);
#pragma unroll
                for (int n = 0; n < 2; ++n)
#pragma unroll
                    for (int j = 0; j < 4; ++j) { const int e = 4 * n + j; const float v = sigmoidf_fast((acc[ai][0][m][n][j] * ascale - gw0[e] * mean) * rstd + bb0[e]) * av[e] + sigmoidf_fast((acc[ai][1][m][n][j] * ascale - gw1[e] * mean) * rstd + bb1[e]) * bv[e];
                        h[e] = fminf(fmaxf(v * ms, -448.f), 448.f); }
                *(u32x2*)(O + off) = (u32x2){pk4_fp8(h[0], h[1], h[2], h[3]), pk4_fp8(h[4], h[5], h[6], h[7])}; }
    }
};
struct EpiRes {
    static constexpr bool PERM = true, AFTER_DRAIN = false;
    const float* res32; const bf16_t* res16; int ldc; float alpha, s;
    const long long* rstats; const float* rg; const float* rb; long long* ostats; bf16_t* o16; unsigned char* o8; float o8s;
    __device__ __forceinline__ void operator()(const f32x4 (&acc)[2][2][4][2], const Unit& u, int wr, int wc, int fr, int fq) const {
        const int col0 = u.pn * BM + wc * 32 + 8 * fq;
        typedef unsigned u32x2 __attribute__((ext_vector_type(2)));
        float al = alpha, sa = s; asm volatile("" : "+v"(al), "+v"(sa));
        f32x4 gv[2][2], bv[2][2];
#pragma unroll
        for (int bj = 0; bj < 2; ++bj)
#pragma unroll
            for (int n = 0; n < 2; ++n) { gv[bj][n] = (f32x4){1.f, 1.f, 1.f, 1.f}; bv[bj][n] = (f32x4){0.f, 0.f, 0.f, 0.f};
                if (rstats) { gv[bj][n] = *(const f32x4*)(rg + col0 + bj * HALF + 4 * n); bv[bj][n] = *(const f32x4*)(rb + col0 + bj * HALF + 4 * n); }
                gv[bj][n] = gv[bj][n] * al; bv[bj][n] = bv[bj][n] * al; }
#pragma unroll
        for (int ai = 0; ai < 2; ++ai)
#pragma unroll
            for (int m = 0; m < 4; ++m) { const int row = u.pm * BM + ai * HALF + wr * 64 + m * 16 + fr; const size_t off = (size_t)row * ldc + col0;
                float mean = 0.f, rstd = 1.f;
                if (rstats) { const long long s0 = rstats[2 * (size_t)row], s1 = rstats[2 * (size_t)row + 1]; mean = (float)s0 * (1.0f / (1048576.f * 2048.0f)); rstd = __builtin_amdgcn_rsqf((float)s1 * (1.0f / (65536.f * 2048.0f)) - mean * mean + 1e-5f); }
                float ps = 0.f, pq = 0.f;
#pragma unroll
                for (int bj = 0; bj < 2; ++bj) {
                    f32x4 r0, r1;
                    if (res32) { r0 = *(const f32x4*)(res32 + off + bj * HALF); r1 = *(const f32x4*)(res32 + off + bj * HALF + 4); }
                    else { const u32x4 w = *(const u32x4*)(res16 + off + bj * HALF); r0 = (f32x4){bflo(w.x), bfhi(w.x), bflo(w.y), bfhi(w.y)}; r1 = (f32x4){bflo(w.z), bfhi(w.z), bflo(w.w), bfhi(w.w)}; }
                    const f32x4 z0 = (r0 - mean) * rstd * gv[bj][0] + bv[bj][0] + acc[ai][bj][m][0] * sa, z1 = (r1 - mean) * rstd * gv[bj][1] + bv[bj][1] + acc[ai][bj][m][1] * sa;
                    u32x4 w16; w16.x = cvt_pk_bf16(z0[0], z0[1]); w16.y = cvt_pk_bf16(z0[2], z0[3]); w16.z = cvt_pk_bf16(z1[0], z1[1]); w16.w = cvt_pk_bf16(z1[2], z1[3]);
                    *(u32x4*)(o16 + off + bj * HALF) = w16;
                    const float q0 = bflo(w16.x), q1 = bfhi(w16.x), q2 = bflo(w16.y), q3 = bfhi(w16.y), q4 = bflo(w16.z), q5 = bfhi(w16.z), q6 = bflo(w16.w), q7 = bfhi(w16.w);
                    ps += ((q0 + q1) + (q2 + q3)) + ((q4 + q5) + (q6 + q7)); pq += ((q0 * q0 + q1 * q1) + (q2 * q2 + q3 * q3)) + ((q4 * q4 + q5 * q5) + (q6 * q6 + q7 * q7));
                    if (o8) *(u32x2*)(o8 + off + bj * HALF) = (u32x2){pk4_fp8(fminf(fmaxf(q0 * o8s, -448.f), 448.f), fminf(fmaxf(q1 * o8s, -448.f), 448.f), fminf(fmaxf(q2 * o8s, -448.f), 448.f), fminf(fmaxf(q3 * o8s, -448.f), 448.f)),
                                                                      pk4_fp8(fminf(fmaxf(q4 * o8s, -448.f), 448.f), fminf(fmaxf(q5 * o8s, -448.f), 448.f), fminf(fmaxf(q6 * o8s, -448.f), 448.f), fminf(fmaxf(q7 * o8s, -448.f), 448.f))}; }
                if (ostats) { ps += __shfl_xor(ps, 16); ps += __shfl_xor(ps, 32); pq += __shfl_xor(pq, 16); pq += __shfl_xor(pq, 32);
                    if (fq == 0) { (void)__hip_atomic_fetch_add(ostats + 2 * (size_t)row, (long long)__builtin_rintf(ps * 1048576.f), __ATOMIC_RELAXED, __HIP_MEMORY_SCOPE_AGENT); (void)__hip_atomic_fetch_add(ostats + 2 * (size_t)row + 1, (long long)__builtin_rintf(pq * 65536.f), __ATOMIC_RELAXED, __HIP_MEMORY_SCOPE_AGENT); } }
                if (m & 1) asm volatile("" ::: "memory"); }
    }
};

typedef int v8i_t __attribute__((ext_vector_type(8)));
typedef int v4i_t __attribute__((ext_vector_type(4)));
template <class Epi, class Sched, bool ALIGN_EPI, bool FP8 = false>
__device__ __forceinline__ void gemm_phase(PG8_LAS unsigned char* lds, const Gemm g, const Sched& S, const Epi& E, const int wid) {
    const int lane = lane_fresh(), tid = wid * 64 + lane, wr = wid >> 2, wc = wid & 3, fr = lane & 15, fq = lane >> 4;
    const int K = g.K, nt = K / BK;
    unsigned voffA[2], voffB[2];
#pragma unroll
    for (int i = 0; i < 2; ++i) { int R, C; stage_rc(tid * 16 + i * 8192, R, C); const int Rb = Epi::PERM ? ((R & ~31) + perm32(R & 31)) : R;
        voffA[i] = (unsigned)(R * g.lda + C) * 2u; voffB[i] = (unsigned)(Rb * g.ldb + C) * 2u; }
    const size_t kstep = (size_t)(BK * 2);
    const size_t hstepA = (size_t)HALF * g.lda * 2, hstepB = (size_t)HALF * g.ldb * 2;
    const size_t tstepA = 2 * hstepA, tstepB = 2 * hstepB;
    const unsigned ldsw = (unsigned)wid * 1024u;
    const int aoff = lds_byte(wr * 64 + fr, fq * 8), boff = lds_byte(wc * 32 + fr, fq * 8);
#define PG8_UA(u) ((const char*)g.A + (size_t)(u).pm * tstepA + (size_t)(((u).pn >> g.a_shift) * g.a_mul) * 2)
#define PG8_UB(u) ((const char*)g.Bt + (size_t)(u).pn * tstepB)
#define PG8_SA(b, h) (((b) * 2 + (h)) * HTB)
#define PG8_SB(b, h) ((4 + (b) * 2 + (h)) * HTB)
#define PG8_STAGE(bufoff, gbase, voff) do { _Pragma("unroll") for (int _i = 0; _i < 2; ++_i) \
        __builtin_amdgcn_global_load_lds((const unsigned*)((const char*)(gbase) + (voff)[_i]), (PG8_LAS unsigned*)(lds + (bufoff) + ldsw + _i * 8192), 16, 0, 0); } while (0)
#define PG8_LD8(p_) __builtin_shufflevector(*(const PG8_LAS v4i_t*)(p_), *(const PG8_LAS v4i_t*)((p_) + 1024), 0, 1, 2, 3, 4, 5, 6, 7)
#define PG8_LDA(dst, b, h) do { _Pragma("unroll") for (int m = 0; m < 4; ++m) { if constexpr (FP8) dst##8[m] = PG8_LD8(lds + PG8_SA(b, h) + aoff + m * 2048); else { _Pragma("unroll") for (int k = 0; k < 2; ++k) dst[m][k] = *(const PG8_LAS bf16x8*)(lds + PG8_SA(b, h) + aoff + m * 2048 + k * 1024); } } } while (0)
#define PG8_LDB(dst, b, h) do { _Pragma("unroll") for (int n = 0; n < 2; ++n) { if constexpr (FP8) dst##8[n] = PG8_LD8(lds + PG8_SB(b, h) + boff + n * 2048); else { _Pragma("unroll") for (int k = 0; k < 2; ++k) dst[n][k] = *(const PG8_LAS bf16x8*)(lds + PG8_SB(b, h) + boff + n * 2048 + k * 1024); } } } while (0)
#define PG8_MMA(ai, bj, At, Bt) do { __builtin_amdgcn_s_setprio(1); _Pragma("unroll") for (int m = 0; m < 4; ++m) _Pragma("unroll") for (int n = 0; n < 2; ++n) { \
        if constexpr (FP8) asm volatile("v_mfma_scale_f32_16x16x128_f8f6f4 %0, %1, %2, %0, %3, %3 op_sel_hi:[0,0,0]" : "+v"(acc[ai][bj][m][n]) : "v"(Bt##8[n]), "v"(At##8[m]), "v"(one_scale)); \
        else { _Pragma("unroll") for (int k = 0; k < 2; ++k) acc[ai][bj][m][n] = __builtin_amdgcn_mfma_f32_16x16x32_bf16(Bt[n][k], At[m][k], acc[ai][bj][m][n], 0, 0, 0); } } \
        __builtin_amdgcn_s_setprio(0); } while (0)
#define PG8_WAIT_V(n) asm volatile("s_waitcnt vmcnt(" #n ")" ::: "memory")
#define PG8_WAIT_L(n) asm volatile("s_waitcnt lgkmcnt(" #n ")" ::: "memory")
#define PG8_BAR __builtin_amdgcn_s_barrier()
#define PG8_SCHED __builtin_amdgcn_sched_barrier(0)
    Unit cur, nxt; int ui = 0;
    if (!S.next(0, cur)) return;
    f32x4 acc[2][2][4][2];
#pragma unroll
    for (int a = 0; a < 2; ++a)
#pragma unroll
        for (int b = 0; b < 2; ++b)
#pragma unroll
            for (int m = 0; m < 4; ++m)
#pragma unroll
                for (int n = 0; n < 2; ++n) acc[a][b][m][n] = (f32x4){0.f, 0.f, 0.f, 0.f};
    bf16x8 At[4][2], B0[2][2], B1[2][2]; v8i_t At8[4], B08[2], B18[2];
    int one_scale = 0x7f7f7f7f; asm volatile("" : "+v"(one_scale));
    const char* cA = PG8_UA(cur); const char* cB = PG8_UB(cur);
    S.a_ready(cur);
    PG8_STAGE(PG8_SB(0, 0), cB, voffB); PG8_STAGE(PG8_SB(0, 1), cB + hstepB, voffB); PG8_STAGE(PG8_SA(0, 0), cA, voffA); PG8_STAGE(PG8_SA(0, 1), cA + hstepA, voffA);
    if (wr == 1) PG8_BAR;
    PG8_WAIT_V(2); PG8_BAR;
    PG8_STAGE(PG8_SB(1, 0), cB + kstep, voffB); PG8_STAGE(PG8_SA(1, 0), cA + kstep, voffA); PG8_STAGE(PG8_SB(1, 1), cB + hstepB + kstep, voffB);
    PG8_WAIT_V(6); PG8_BAR;
    for (;;) {
        const bool has_next = S.next(ui + 1, nxt);
        const char* nA = has_next ? PG8_UA(nxt) : cA; const char* nB = has_next ? PG8_UB(nxt) : cB;
        for (int t = 0; t < nt; t += 2) {
            const bool last = (t == nt - 2);
            const char* a1 = cA + (size_t)(t + 1) * kstep;
            const char* a2 = last ? nA : cA + (size_t)(t + 2) * kstep; const char* b2 = last ? nB : cB + (size_t)(t + 2) * kstep;
            const char* a3 = a2 + kstep; const char* b3 = b2 + kstep;
            if (last && has_next) S.a_ready(nxt);
            PG8_LDB(B0, 0, 0); PG8_LDB(B1, 0, 1); PG8_SCHED; PG8_LDA(At, 0, 0); PG8_STAGE(PG8_SA(1, 1), a1 + hstepA, voffA);
            PG8_WAIT_V(8); PG8_WAIT_L(0); PG8_BAR; PG8_MMA(0, 0, At, B0); PG8_MMA(0, 1, At, B1); PG8_BAR; PG8_SCHED;
            PG8_LDA(At, 0, 1); PG8_STAGE(PG8_SB(0, 0), b2, voffB); PG8_STAGE(PG8_SB(0, 1), b2 + hstepB, voffB); PG8_STAGE(PG8_SA(0, 0), a2, voffA);
            PG8_WAIT_V(8); PG8_WAIT_L(0); PG8_BAR; PG8_MMA(1, 0, At, B0); PG8_MMA(1, 1, At, B1); PG8_BAR; PG8_SCHED;
            PG8_LDB(B0, 1, 0); PG8_LDB(B1, 1, 1); PG8_SCHED; PG8_LDA(At, 1, 0); PG8_STAGE(PG8_SA(0, 1), a2 + hstepA, voffA);
            PG8_WAIT_V(8); PG8_WAIT_L(0); PG8_BAR; PG8_MMA(0, 0, At, B0); PG8_MMA(0, 1, At, B1); PG8_BAR; PG8_SCHED;
            PG8_LDA(At, 1, 1); PG8_STAGE(PG8_SB(1, 0), b3, voffB); PG8_STAGE(PG8_SB(1, 1), b3 + hstepB, voffB); PG8_STAGE(PG8_SA(1, 0), a3, voffA);
            PG8_WAIT_V(8); PG8_WAIT_L(0); PG8_BAR; PG8_MMA(1, 0, At, B0); PG8_MMA(1, 1, At, B1); PG8_BAR; PG8_SCHED;
        }
        if constexpr (ALIGN_EPI) { if (wr == 0) PG8_BAR; }
        if constexpr (FP8) asm volatile("s_nop 15\n\ts_nop 7" ::: "memory");
        E(acc, cur, wr, wc, fr, fq); S.done(cur);
        if (!has_next) break;
#pragma unroll
        for (int a = 0; a < 2; ++a)
#pragma unroll
            for (int b = 0; b < 2; ++b)
#pragma unroll
                for (int m = 0; m < 4; ++m)
#pragma unroll
                    for (int n = 0; n < 2; ++n) acc[a][b][m][n] = (f32x4){0.f, 0.f, 0.f, 0.f};
        cur = nxt; cA = nA; cB = nB; ++ui;
        if constexpr (ALIGN_EPI) { if (wr == 1) PG8_BAR; }
    }
    PG8_WAIT_V(0);
    if constexpr (!ALIGN_EPI) { if (wr == 0) PG8_BAR; }
    PG8_BAR;
#undef PG8_UA
#undef PG8_UB
#undef PG8_SA
#undef PG8_SB
#undef PG8_STAGE
#undef PG8_LDA
#undef PG8_LDB
#undef PG8_MMA
#undef PG8_LD8
#undef PG8_WAIT_V
#undef PG8_WAIT_L
#undef PG8_BAR
#undef PG8_SCHED
}
}

constexpr int NWAVES = 8;
constexpr int BATCH = 4, SEQ = 4096, D = 2048, FF = 5632, M = BATCH * SEQ;
constexpr int N_IN = 5888;
constexpr int MEMT = 256;
constexpr float LN_EPS = 1e-5f;
constexpr float ALPHA = 1.189207115002721f;
constexpr float LAMBDA_INIT = 0.2f;

constexpr size_t MiB = 1u << 20;
constexpr size_t WS_CTL = 0, CTL_ZERO_BYTES = 2 * MiB;
constexpr size_t WS_W_IN = 2 * MiB;
constexpr size_t WS_W_G = 25 * MiB;
constexpr size_t WS_W_UK = 41 * MiB;
constexpr size_t WS_W_UVP = 42 * MiB;
constexpr size_t WS_W_A = 44 * MiB;
constexpr size_t WS_W_B = 48 * MiB;
constexpr size_t WS_W_MO = 52 * MiB;
constexpr size_t WS_W_MQ = 60 * MiB;
constexpr size_t WS_W_MKV = 62 * MiB;
constexpr size_t WS_W_MOUT = 66 * MiB;
constexpr size_t WS_MEM16 = 68 * MiB;
constexpr size_t WS_KVMEM = 72 * MiB;
constexpr size_t WS_W_GU2 = 74 * MiB;
constexpr size_t WS_W_D2 = 96 * MiB;
constexpr size_t WS_X8M = 107 * MiB;
constexpr size_t WS_X16 = 140 * MiB;
constexpr size_t WS_MIX = 204 * MiB;
constexpr size_t WS_W_GU1 = 204 * MiB;
constexpr size_t WS_W_D1 = 248 * MiB;
constexpr size_t WS_H = 270 * MiB;
constexpr size_t WS_AQ = WS_MIX + 0 * MiB, WS_AK = WS_MIX + 32 * MiB, WS_AV = WS_MIX + 64 * MiB, WS_BQ = WS_MIX + 96 * MiB;
constexpr size_t WS_BC = WS_MIX + 128 * MiB;
constexpr size_t WS_IQ = WS_MIX + 144 * MiB;
constexpr size_t WS_IKW = WS_MIX + 176 * MiB;
constexpr size_t WS_QLAT = WS_MIX + 184 * MiB;
constexpr size_t WS_IDX = WS_MIX + 312 * MiB;
constexpr size_t WS_YB = WS_BQ;
constexpr size_t WS_TA = WS_QLAT, WS_TB = WS_QLAT + 64 * MiB;
constexpr size_t WS_QM = WS_AQ, WS_OM = WS_AQ + 16 * MiB;
constexpr size_t WS_X8 = WS_H + 96 * MiB;
constexpr size_t WS_C8 = WS_W_IN;
constexpr size_t WS_MRG8 = WS_AV;
constexpr float FP8_WGS = 1024.f, FP8_MS = 32.f, FP8_WMOS = 2048.f;
constexpr float FP8_XS = 32.f, FP8_WGUS = 1024.f, FP8_HS = 8.f, FP8_WDS = 4096.f;
constexpr size_t WS_END = WS_MIX + 320 * MiB;
static_assert(WS_H + (size_t)M * FF * 2 <= WS_END && WS_QLAT + (size_t)M * 4096 * 2 <= WS_END, "d_ws map");
constexpr int CW_BAR = 4096;
constexpr int CW_DQ = 8192;
constexpr int CW_KMAX = 8256;
constexpr size_t CTL_STATS = 65536, CTL_STATS_STRIDE = (size_t)M * 2 * 8;
constexpr size_t CTL_VEC = CTL_STATS + 3 * CTL_STATS_STRIDE;
constexpr int V_GW_IN = 0, V_BW_IN = 5888, V_GW_G = 11776, V_BW_G = 15872, V_GW_MQ = 19968, V_BW_MQ = 20480, V_GW_GU2 = 20992, V_BW_GU2 = 32256, V_END = 43520;
constexpr size_t CTL_VECF = CTL_VEC + (size_t)V_END * 8;
static_assert(CTL_VECF + (size_t)V_END * 4 <= CTL_ZERO_BYTES, "control region");
constexpr float FX_S = 1048576.f, FX_Q = 65536.f, FX_V = 16777216.f;

constexpr int RING_OFF = 0, RING_BYTES = 153600;
constexpr int LDSCTL_OFF = RING_BYTES, MISC_OFF = LDSCTL_OFF + 320;
constexpr int LDS_BYTES = 154624;
static_assert(MISC_OFF + 128 <= LDS_BYTES, "LDS map");

#define GAS __attribute__((address_space(1)))
#define LAS __attribute__((address_space(3)))
typedef unsigned short bf16;
typedef unsigned v4u __attribute__((ext_vector_type(4)));
typedef unsigned v2u __attribute__((ext_vector_type(2)));
typedef float f32x4 __attribute__((ext_vector_type(4)));
typedef float f32x16 __attribute__((ext_vector_type(16)));
typedef short bf16x8 __attribute__((ext_vector_type(8)));
typedef GAS unsigned gu32;
#define RLX_AGENT __ATOMIC_RELAXED, __HIP_MEMORY_SCOPE_AGENT
#define LDS_WAIT() asm volatile("s_waitcnt lgkmcnt(0)" ::: "memory")
#define VM_WAIT() asm volatile("s_waitcnt vmcnt(0)" ::: "memory")
__device__ __forceinline__ unsigned f2bf(float f) { unsigned u = __builtin_bit_cast(unsigned, f); return (u + 0x7fffu + ((u >> 16) & 1u)) >> 16; }
__device__ __forceinline__ unsigned pk2(float lo, float hi) { return f2bf(lo) | (f2bf(hi) << 16); }
__device__ __forceinline__ float bf2f(unsigned short v) { return __uint_as_float((unsigned)v << 16); }
__device__ __forceinline__ float blo(unsigned w) { return __uint_as_float(w << 16); }
__device__ __forceinline__ float bhi(unsigned w) { return __uint_as_float(w & 0xffff0000u); }
__device__ __forceinline__ float wave_sum(float v) {
    v += __builtin_bit_cast(float, __builtin_amdgcn_update_dpp(0, __builtin_bit_cast(int, v), 0xB1, 0xf, 0xf, true));
    v += __builtin_bit_cast(float, __builtin_amdgcn_update_dpp(0, __builtin_bit_cast(int, v), 0x4E, 0xf, 0xf, true));
    v += __builtin_bit_cast(float, __builtin_amdgcn_update_dpp(0, __builtin_bit_cast(int, v), 0x141, 0xf, 0xf, true));
    v += __builtin_bit_cast(float, __builtin_amdgcn_update_dpp(0, __builtin_bit_cast(int, v), 0x140, 0xf, 0xf, true));
    { const auto rr = __builtin_amdgcn_permlane16_swap(__float_as_uint(v), __float_as_uint(v), false, false); v = __uint_as_float(rr[0]) + __uint_as_float(rr[1]); }
    { const auto rr = __builtin_amdgcn_permlane32_swap(__float_as_uint(v), __float_as_uint(v), false, false); v = __uint_as_float(rr[0]) + __uint_as_float(rr[1]); }
    return v;
}

__device__ __forceinline__ float xhalf_add(float a) { const auto rr = __builtin_amdgcn_permlane32_swap(__float_as_uint(a), __float_as_uint(a), false, false); return __uint_as_float(rr[0]) + __uint_as_float(rr[1]); }
__device__ __forceinline__ float xhalf_max(float a) { const auto rr = __builtin_amdgcn_permlane32_swap(__float_as_uint(a), __float_as_uint(a), false, false); return fmaxf(__uint_as_float(rr[0]), __uint_as_float(rr[1])); }
__device__ __forceinline__ int half_sum_i32(int v) {
    v += __builtin_amdgcn_update_dpp(0, v, 0xB1, 0xf, 0xf, true);
    v += __builtin_amdgcn_update_dpp(0, v, 0x4E, 0xf, 0xf, true);
    v += __builtin_amdgcn_update_dpp(0, v, 0x141, 0xf, 0xf, true);
    v += __builtin_amdgcn_update_dpp(0, v, 0x140, 0xf, 0xf, true);
    const auto rr = __builtin_amdgcn_permlane16_swap((unsigned)v, (unsigned)v, false, false); return (int)rr[0] + (int)rr[1];
}
#define XB_TMO      128
#define XB_XCNT(j)  (256  + 64 * (j))
#define XB_XSUB(j)  (1280 + 64 * (j))
#define XB_XGEN(j)  (2304 + 64 * (j))
#define XB_TOP      3328
#define XB_TOPGEN   3392
#define XCD_BAR_WORDS 3456
#define XB_SPIN_CAP (1u << 18)

__device__ __forceinline__ unsigned xb_ld(unsigned* p)              { return __hip_atomic_load(p, __ATOMIC_RELAXED, __HIP_MEMORY_SCOPE_AGENT); }
__device__ __forceinline__ unsigned xb_add(unsigned* p, unsigned v) { return __hip_atomic_fetch_add(p, v, __ATOMIC_RELAXED, __HIP_MEMORY_SCOPE_AGENT); }
__device__ __forceinline__ unsigned xb_xcc_id() { return (unsigned)__builtin_amdgcn_s_getreg((3 << 11) | 20) & 0xFu; }
#define XB_SPIN(cond, bar) do { unsigned _sp = 0; while (cond) { __builtin_amdgcn_s_sleep(1); \
    if ((++_sp & 255u) == 0u) { if (xb_ld(&(bar)[XB_TMO])) break; if (_sp > XB_SPIN_CAP) { atomicAdd(&(bar)[XB_TMO], 1u); break; } } } } while (0)

struct XcdBarrier {
    unsigned* bar; unsigned x;
    volatile LAS unsigned* st;
};

__device__ __forceinline__ XcdBarrier xcd_barrier_post(unsigned* bar, volatile LAS unsigned* st, bool t0) {
    XcdBarrier b; b.bar = bar; b.x = xb_xcc_id(); b.st = st;
    if (t0) (void)xb_add(&bar[XB_XCNT(b.x)], 1u);
    return b;
}
__device__ __forceinline__ void xcd_barrier_complete(unsigned* bar, unsigned x, unsigned& nloc, unsigned& nx) {
    const unsigned G = gridDim.x * gridDim.y * gridDim.z;
    unsigned sum, cnt, mine, sp = 0u;
    for (;;) {
        sum = 0u; cnt = 0u; mine = 0u;
#pragma unroll
        for (unsigned j = 0; j < 16; ++j) { const unsigned c = xb_ld(&bar[XB_XCNT(j)]); sum += c; cnt += (c > 0u) ? 1u : 0u; mine = (j == x) ? c : mine; }
        if (sum == G) break;
        __builtin_amdgcn_s_sleep(1);
        if ((++sp & 255u) == 0u) { if (xb_ld(&bar[XB_TMO])) break; if (sp > XB_SPIN_CAP) { atomicAdd(&bar[XB_TMO], 1u); break; } }
    }
    nloc = mine > 0u ? mine : 1u; nx = cnt > 0u ? cnt : 1u;
}

__device__ __forceinline__ void xcd_barrier(const XcdBarrier& b, const int wave) {
    asm volatile("s_waitcnt vmcnt(0)" ::: "memory");
    __syncthreads();
    if (wave == 0 && lane_fresh() == 0) {
        unsigned* bar = b.bar;
        __builtin_amdgcn_s_waitcnt(0);
        unsigned nloc = b.st[0], nx = b.st[1];
        if (nloc == 0u) { xcd_barrier_complete(bar, b.x, nloc, nx); b.st[0] = nloc; b.st[1] = nx; }
        const unsigned old = xb_add(&bar[XB_XSUB(b.x)], 1u);
        const unsigned gen = old / nloc;
        if (old + 1u == (gen + 1u) * nloc) {
            __builtin_amdgcn_fence(__ATOMIC_RELEASE, "agent");
            asm volatile("s_waitcnt vmcnt(0)" ::: "memory");
            const unsigned og = xb_add(&bar[XB_TOP], 1u);
            const unsigned tg = og / nx;
            if (og + 1u == (tg + 1u) * nx) xb_add(&bar[XB_TOPGEN], 1u);
            else XB_SPIN(xb_ld(&bar[XB_TOPGEN]) == tg, bar);
            __builtin_amdgcn_fence(__ATOMIC_ACQUIRE, "agent");
            xb_add(&bar[XB_XGEN(b.x)], 1u);
            asm volatile("s_waitcnt vmcnt(0)" ::: "memory");
        } else {
            XB_SPIN(xb_ld(&bar[XB_XGEN(b.x)]) == gen, bar);
            __builtin_amdgcn_fence(__ATOMIC_ACQUIRE, "agent");
            asm volatile("s_waitcnt vmcnt(0)" ::: "memory");
        }
    }
    __syncthreads();
}

__device__ __forceinline__ void tr_item(const float* W, int ldw, int nvalid, bf16* WT, int ldt, int k0, int n0, int drow0, int dcol0, LAS float* scr, int lane) {
    { const int n4 = 4 * (lane & 7), kr = lane >> 3; const bool ok = n0 + n4 < nvalid;
#pragma unroll
      for (int i = 0; i < 8; ++i) { const int kk = 8 * i + kr; const f32x4 v = ok ? *(const GAS f32x4*)(W + (size_t)(k0 + kk) * ldw + n0 + n4) : (f32x4){0.f, 0.f, 0.f, 0.f};
          LAS float* d = scr + kk * 33 + n4; d[0] = v.x; d[1] = v.y; d[2] = v.z; d[3] = v.w; } }
    LDS_WAIT(); asm volatile("" ::: "memory");
    const int c = lane & 7;
#pragma unroll
    for (int j = 0; j < 4; ++j) { const int nn = (lane >> 3) + 8 * j; const LAS float* s = scr + (8 * c) * 33 + nn;
        v4u o; o.x = pk2(s[0 * 33], s[1 * 33]); o.y = pk2(s[2 * 33], s[3 * 33]); o.z = pk2(s[4 * 33], s[5 * 33]); o.w = pk2(s[6 * 33], s[7 * 33]);
        *(GAS v4u*)(WT + (size_t)(drow0 + nn) * ldt + dcol0 + k0 + 8 * c) = o; }
    LDS_WAIT(); asm volatile("" ::: "memory");
}
__device__ __forceinline__ void tr_item8(const float* W, int ldw, unsigned char* WT, int ldt, int k0, int n0, int drow0, float sc, LAS float* scr, int lane) {
    { const int n4 = 4 * (lane & 7), kr = lane >> 3;
#pragma unroll
      for (int i = 0; i < 8; ++i) { const int kk = 8 * i + kr; const f32x4 v = *(const GAS f32x4*)(W + (size_t)(k0 + kk) * ldw + n0 + n4);
          LAS float* d = scr + kk * 33 + n4; d[0] = v.x; d[1] = v.y; d[2] = v.z; d[3] = v.w; } }
    LDS_WAIT(); asm volatile("" ::: "memory");
    const int nn = lane >> 1, hf = lane & 1; const LAS float* sp = scr + (32 * hf) * 33 + nn;
    unsigned o[8];
#pragma unroll
    for (int q = 0; q < 8; ++q) { const float a = fminf(fmaxf(sp[(4 * q + 0) * 33] * sc, -448.f), 448.f), b = fminf(fmaxf(sp[(4 * q + 1) * 33] * sc, -448.f), 448.f), c = fminf(fmaxf(sp[(4 * q + 2) * 33] * sc, -448.f), 448.f), d = fminf(fmaxf(sp[(4 * q + 3) * 33] * sc, -448.f), 448.f);
        int w = 0; w = __builtin_amdgcn_cvt_pk_fp8_f32(a, b, w, false); w = __builtin_amdgcn_cvt_pk_fp8_f32(c, d, w, true); o[q] = (unsigned)w; }
    GAS v4u* dst = (GAS v4u*)(WT + (size_t)(drow0 + nn) * ldt + k0 + 32 * hf);
    dst[0] = (v4u){o[0], o[1], o[2], o[3]}; dst[1] = (v4u){o[4], o[5], o[6], o[7]};
    LDS_WAIT(); asm volatile("" ::: "memory");
}
__device__ __forceinline__ void tr_item_ln(const float* W, int ldw, int nvalid, bf16* WT, int ldt, int k0, int n0, int drow0, const float* gain, const float* bvec, long long* gW, long long* bW, LAS float* scr, int lane) {
    { const int n4 = 4 * (lane & 7), kr = lane >> 3; const bool ok = n0 + n4 < nvalid;
#pragma unroll
      for (int i = 0; i < 8; ++i) { const int kk = 8 * i + kr; const f32x4 v = ok ? *(const GAS f32x4*)(W + (size_t)(k0 + kk) * ldw + n0 + n4) : (f32x4){0.f, 0.f, 0.f, 0.f};
          LAS float* d = scr + kk * 33 + n4; d[0] = v.x; d[1] = v.y; d[2] = v.z; d[3] = v.w; } }
    LDS_WAIT(); asm volatile("" ::: "memory");
    const int c = lane & 7;
    const f32x4 g0 = *(const GAS f32x4*)(gain + k0 + 8 * c), g1 = *(const GAS f32x4*)(gain + k0 + 8 * c + 4), b0 = *(const GAS f32x4*)(bvec + k0 + 8 * c), b1 = *(const GAS f32x4*)(bvec + k0 + 8 * c + 4);
    const float gk[8] = {g0.x, g0.y, g0.z, g0.w, g1.x, g1.y, g1.z, g1.w}, bk[8] = {b0.x, b0.y, b0.z, b0.w, b1.x, b1.y, b1.z, b1.w};
#pragma unroll
    for (int j = 0; j < 4; ++j) { const int nn = (lane >> 3) + 8 * j; const LAS float* sp = scr + (8 * c) * 33 + nn;
        float v[8], bs = 0.f;
#pragma unroll
        for (int i = 0; i < 8; ++i) { const float raw = sp[i * 33]; v[i] = raw * gk[i]; bs += raw * bk[i]; }
        v4u o; o.x = pk2(v[0], v[1]); o.y = pk2(v[2], v[3]); o.z = pk2(v[4], v[5]); o.w = pk2(v[6], v[7]);
        float gs = ((blo(o.x) + bhi(o.x)) + (blo(o.y) + bhi(o.y))) + ((blo(o.z) + bhi(o.z)) + (blo(o.w) + bhi(o.w)));
        *(GAS v4u*)(WT + (size_t)(drow0 + nn) * ldt + k0 + 8 * c) = o;
        gs += __shfl_xor(gs, 1); gs += __shfl_xor(gs, 2); gs += __shfl_xor(gs, 4); bs += __shfl_xor(bs, 1); bs += __shfl_xor(bs, 2); bs += __shfl_xor(bs, 4);
        if (c == 0) { (void)__hip_atomic_fetch_add(gW + drow0 + nn, (long long)__builtin_rintf(gs * FX_V), __ATOMIC_RELAXED, __HIP_MEMORY_SCOPE_AGENT); (void)__hip_atomic_fetch_add(bW + drow0 + nn, (long long)__builtin_rintf(bs * FX_V), __ATOMIC_RELAXED, __HIP_MEMORY_SCOPE_AGENT); } }
    LDS_WAIT(); asm volatile("" ::: "memory");
}
__device__ __forceinline__ void tr_item8_ln(const float* W, int ldw, unsigned char* WT, int ldt, int k0, int n0, int drow0, float sc, const float* gain, const float* bvec, long long* gW, long long* bW, LAS float* scr, int lane) {
    { const int n4 = 4 * (lane & 7), kr = lane >> 3;
#pragma unroll
      for (int i = 0; i < 8; ++i) { const int kk = 8 * i + kr; const f32x4 v = *(const GAS f32x4*)(W + (size_t)(k0 + kk) * ldw + n0 + n4);
          LAS float* d = scr + kk * 33 + n4; d[0] = v.x; d[1] = v.y; d[2] = v.z; d[3] = v.w; } }
    LDS_WAIT(); asm volatile("" ::: "memory");
    const int nn = lane >> 1, hf = lane & 1; const LAS float* sp = scr + (32 * hf) * 33 + nn;
    unsigned o[8]; float gs = 0.f, bs = 0.f;
#pragma unroll
    for (int q = 0; q < 8; ++q) { const f32x4 g4 = *(const GAS f32x4*)(gain + k0 + 32 * hf + 4 * q), b4 = *(const GAS f32x4*)(bvec + k0 + 32 * hf + 4 * q);
        const float r0 = sp[(4 * q + 0) * 33], r1 = sp[(4 * q + 1) * 33], r2 = sp[(4 * q + 2) * 33], r3 = sp[(4 * q + 3) * 33];
        bs += (r0 * b4.x + r1 * b4.y) + (r2 * b4.z + r3 * b4.w);
        const float a = fminf(fmaxf(r0 * g4.x * sc, -448.f), 448.f), b = fminf(fmaxf(r1 * g4.y * sc, -448.f), 448.f), c = fminf(fmaxf(r2 * g4.z * sc, -448.f), 448.f), d = fminf(fmaxf(r3 * g4.w * sc, -448.f), 448.f);
        int w = 0; w = __builtin_amdgcn_cvt_pk_fp8_f32(a, b, w, false); w = __builtin_amdgcn_cvt_pk_fp8_f32(c, d, w, true); o[q] = (unsigned)w;
        gs += (__builtin_amdgcn_cvt_f32_fp8(w, 0) + __builtin_amdgcn_cvt_f32_fp8(w, 1)) + (__builtin_amdgcn_cvt_f32_fp8(w, 2) + __builtin_amdgcn_cvt_f32_fp8(w, 3)); }
    GAS v4u* dst = (GAS v4u*)(WT + (size_t)(drow0 + nn) * ldt + k0 + 32 * hf);
    dst[0] = (v4u){o[0], o[1], o[2], o[3]}; dst[1] = (v4u){o[4], o[5], o[6], o[7]};
    gs += __shfl_xor(gs, 1); bs += __shfl_xor(bs, 1);
    if (hf == 0) { (void)__hip_atomic_fetch_add(gW + drow0 + nn, (long long)__builtin_rintf(gs / sc * FX_V), __ATOMIC_RELAXED, __HIP_MEMORY_SCOPE_AGENT); (void)__hip_atomic_fetch_add(bW + drow0 + nn, (long long)__builtin_rintf(bs * FX_V), __ATOMIC_RELAXED, __HIP_MEMORY_SCOPE_AGENT); }
    LDS_WAIT(); asm volatile("" ::: "memory");
}
__device__ __forceinline__ void cvt_item8(const float* src, unsigned char* dst, int item, int lane, float sc) {
    const GAS f32x4* sp = (const GAS f32x4*)(src + (size_t)item * 512) + 2 * lane; f32x4 a = sp[0] * sc, b = sp[1] * sc;
    int w0 = 0, w1 = 0; w0 = __builtin_amdgcn_cvt_pk_fp8_f32(fminf(fmaxf(a.x, -448.f), 448.f), fminf(fmaxf(a.y, -448.f), 448.f), w0, false); w0 = __builtin_amdgcn_cvt_pk_fp8_f32(fminf(fmaxf(a.z, -448.f), 448.f), fminf(fmaxf(a.w, -448.f), 448.f), w0, true);
    w1 = __builtin_amdgcn_cvt_pk_fp8_f32(fminf(fmaxf(b.x, -448.f), 448.f), fminf(fmaxf(b.y, -448.f), 448.f), w1, false); w1 = __builtin_amdgcn_cvt_pk_fp8_f32(fminf(fmaxf(b.z, -448.f), 448.f), fminf(fmaxf(b.w, -448.f), 448.f), w1, true);
    *((GAS v2u*)(dst + (size_t)item * 512) + lane) = (v2u){(unsigned)w0, (unsigned)w1};
}
__device__ __forceinline__ void cvt_item(const float* src, bf16* dst, int item, int lane) {
    const GAS f32x4* s = (const GAS f32x4*)(src + (size_t)item * 512) + 2 * lane; const f32x4 a = s[0], b = s[1];
    v4u o; o.x = pk2(a.x, a.y); o.y = pk2(a.z, a.w); o.z = pk2(b.x, b.y); o.w = pk2(b.z, b.w);
    *((GAS v4u*)(dst + (size_t)item * 512) + lane) = o;
}
__device__ __forceinline__ void p0_prologue(const float* const (&in)[24], unsigned char* ws, LAS unsigned char* lds, int gw, int NGW, int wave, int lane) {
    LAS float* scr = (LAS float*)(lds + RING_OFF + wave * 16384);
#define TRM(SRC, Kk, LDW, NVALID, NPAD, DST, LDT, ROWMAP, DCOL) { constexpr int nblk = (NPAD) / 32; constexpr int cnt = ((Kk) / 64) * nblk; \
        if (r < cnt) { const int kb = r / nblk, nb = r % nblk, n0 = 32 * nb; tr_item(SRC, LDW, NVALID, (bf16*)(ws + (DST)), LDT, 64 * kb, n0, (ROWMAP), (DCOL), scr, lane); continue; } r -= cnt; }
#define TRM8(SRC, Kk, LDW, NN, DST, LDT, ROWMAP, SC) { constexpr int nblk = (NN) / 32; constexpr int cnt = ((Kk) / 64) * nblk; \
        if (r < cnt) { const int kb = r / nblk, nb = r % nblk, n0 = 32 * nb; tr_item8(SRC, LDW, (unsigned char*)(ws + (DST)), LDT, 64 * kb, n0, (ROWMAP), SC, scr, lane); continue; } r -= cnt; }
    long long* const vec = (long long*)(ws + WS_CTL + CTL_VEC);
#define TRML(SRC, Kk, LDW, NVALID, NPAD, DST, LDT, ROWMAP, GAIN, BVEC, VG, VB) { constexpr int nblk = (NPAD) / 32; constexpr int cnt = ((Kk) / 64) * nblk; \
        if (r < cnt) { const int kb = r / nblk, nb = r % nblk, n0 = 32 * nb; tr_item_ln(SRC, LDW, NVALID, (bf16*)(ws + (DST)), LDT, 64 * kb, n0, (ROWMAP), GAIN, BVEC, vec + (VG), vec + (VB), scr, lane); continue; } r -= cnt; }
#define TRML8(SRC, Kk, LDW, NN, DST, LDT, ROWMAP, SC, GAIN, BVEC, VG, VB) { constexpr int nblk = (NN) / 32; constexpr int cnt = ((Kk) / 64) * nblk; \
        if (r < cnt) { const int kb = r / nblk, nb = r % nblk, n0 = 32 * nb; tr_item8_ln(SRC, LDW, (unsigned char*)(ws + (DST)), LDT, 64 * kb, n0, (ROWMAP), SC, GAIN, BVEC, vec + (VG), vec + (VB), scr, lane); continue; } r -= cnt; }
    constexpr int N_TR = 2 * (32 * 176) + 88 * 64 + 32 * 184 + 2 * (32 * 64) + 256 + 2 * (16 * 64) + 32 * 64 + 32 * 16 + 32 * 32 + 8 * 64 + 2 * (32 * 176) + 88 * 64;
    for (int it = gw; it < N_TR; it += NGW) {
        int r = it;
        TRM8(in[2], 2048, 5632, 5632, WS_W_GU1, 2048, 256 * (n0 >> 7) + (n0 & 127), FP8_WGUS)
        TRM8(in[3], 2048, 5632, 5632, WS_W_GU1, 2048, 256 * (n0 >> 7) + 128 + (n0 & 127), FP8_WGUS)
        TRM8(in[4], 5632, 2048, 2048, WS_W_D1, 5632, n0, FP8_WDS)
        TRML(in[5], 2048, 5712, 5712, 5888, WS_W_IN, 2048, n0, in[22], in[23], V_GW_IN, V_BW_IN)
        TRML8(in[11], 2048, 2048, 2048, WS_W_G, 2048, 256 * (n0 >> 7) + (n0 & 127), FP8_WGS, in[22], in[23], V_GW_G, V_BW_G)
        TRML8(in[11] + (size_t)2048 * 2048, 2048, 2048, 2048, WS_W_G, 2048, 256 * (n0 >> 7) + 128 + (n0 & 127), FP8_WGS, in[22], in[23], V_GW_G, V_BW_G)
        if (r < 256) { const int h = r >> 5, rr = r & 31, kb = rr >> 2, nb = rr & 3;
            tr_item(in[10] + (size_t)h * 512 * 128, 128, 128, (bf16*)(ws + WS_W_UVP), 1024, 64 * kb, 32 * nb, (h >> 1) * 256 + (h & 1) * 128 + 32 * nb, (h & 1) * 512, scr, lane); continue; } r -= 256;
        TRM(in[13], 1024, 2048, 2048, 2048, WS_W_A, 1024, n0, 0)
        TRM(in[14], 1024, 2048, 2048, 2048, WS_W_B, 1024, n0, 0)
        TRM8(in[15], 2048, 2048, 2048, WS_W_MO, 2048, n0, FP8_WMOS)
        TRML(in[16], 2048, 512, 512, 512, WS_W_MQ, 2048, n0, in[22] + D, in[23] + D, V_GW_MQ, V_BW_MQ)
        TRM(in[17], 2048, 1024, 1024, 1024, WS_W_MKV, 2048, n0, 0)
        TRM(in[18], 512, 2048, 2048, 2048, WS_W_MOUT, 512, n0, 0)
        TRML8(in[19], 2048, 5632, 5632, WS_W_GU2, 2048, 256 * (n0 >> 7) + (n0 & 127), FP8_WGUS, in[22] + 2 * D, in[23] + 2 * D, V_GW_GU2, V_BW_GU2)
        TRML8(in[20], 2048, 5632, 5632, WS_W_GU2, 2048, 256 * (n0 >> 7) + 128 + (n0 & 127), FP8_WGUS, in[22] + 2 * D, in[23] + 2 * D, V_GW_GU2, V_BW_GU2)
        TRM8(in[21], 5632, 2048, 2048, WS_W_D2, 5632, n0, FP8_WDS)
    }
#undef TRM
#undef TRM8
#undef TRML
#undef TRML8
    for (int rw = gw; rw < 1024; rw += NGW) { const int e = (rw >> 7) & 1; *((GAS v4u*)((bf16*)(ws + WS_W_UVP) + (size_t)rw * 1024 + (1 - e) * 512) + lane) = (v4u){0u, 0u, 0u, 0u}; }
    for (int it = gw; it < (M * D) / 512; it += NGW) cvt_item8(in[0], (unsigned char*)(ws + WS_X8), it, lane, FP8_XS);
    for (int it = gw; it < (BATCH * MEMT * D) / 512; it += NGW) cvt_item(in[1], (bf16*)(ws + WS_MEM16), it, lane);
    for (int it = gw; it < (8 * 512 * 128) / 512; it += NGW) cvt_item(in[9], (bf16*)(ws + WS_W_UK), it, lane);
}

__device__ __forceinline__ void ln_phase(float* zx, bf16* x16, unsigned char* x8, const float* g, const float* b, int gw, int NGW, int lane) {
    f32x4 gv[8], bv[8];
#pragma unroll
    for (int j = 0; j < 8; ++j) { gv[j] = *((const GAS f32x4*)g + lane + 64 * j); bv[j] = *((const GAS f32x4*)b + lane + 64 * j); }
    for (int m = gw; m < M; m += NGW) {
        GAS f32x4* xr = (GAS f32x4*)(zx + (size_t)m * D) + lane;
        f32x4 v[8]; float s = 0.f;
#pragma unroll
        for (int j = 0; j < 8; ++j) { v[j] = xr[64 * j]; s += (v[j].x + v[j].y) + (v[j].z + v[j].w); }
        const float mean = wave_sum(s) * (1.f / D); float s2 = 0.f;
#pragma unroll
        for (int j = 0; j < 8; ++j) { v[j] = v[j] - mean; s2 += (v[j].x * v[j].x + v[j].y * v[j].y) + (v[j].z * v[j].z + v[j].w * v[j].w); }
        const float rstd = 1.f / sqrtf(wave_sum(s2) * (1.f / D) + LN_EPS);
#pragma unroll
        for (int j = 0; j < 8; ++j) { v[j] = v[j] * rstd * gv[j] + bv[j]; xr[64 * j] = v[j]; }
        if (x16) { GAS v2u* o8 = (GAS v2u*)(x16 + (size_t)m * D) + lane;
#pragma unroll
            for (int j = 0; j < 8; ++j) o8[64 * j] = (v2u){pk2(v[j].x, v[j].y), pk2(v[j].z, v[j].w)}; }
        if (x8) { GAS unsigned* o4 = (GAS unsigned*)(x8 + (size_t)m * D) + lane;
#pragma unroll
            for (int j = 0; j < 8; ++j) { const f32x4 q = v[j] * FP8_XS; int w = 0; w = __builtin_amdgcn_cvt_pk_fp8_f32(fminf(fmaxf(q.x, -448.f), 448.f), fminf(fmaxf(q.y, -448.f), 448.f), w, false);
                w = __builtin_amdgcn_cvt_pk_fp8_f32(fminf(fmaxf(q.z, -448.f), 448.f), fminf(fmaxf(q.w, -448.f), 448.f), w, true); o4[64 * j] = (unsigned)w; } }
    }
}
__device__ __forceinline__ void ln_final_phase(const bf16* z16, float* outp, const float* g, const float* b, int gw, int NGW, int lane) {
    for (int m0 = gw; m0 < M; m0 += 2 * NGW) {
        const int m1 = m0 + NGW; const bool two = m1 < M;
        v4u w[2][4];
#pragma unroll
        for (int j = 0; j < 4; ++j) { w[0][j] = __builtin_nontemporal_load((const GAS v4u*)(z16 + (size_t)m0 * D) + lane + 64 * j); w[1][j] = two ? __builtin_nontemporal_load((const GAS v4u*)(z16 + (size_t)m1 * D) + lane + 64 * j) : (v4u){0u, 0u, 0u, 0u}; }
#pragma unroll
        for (int rr = 0; rr < 2; ++rr) { if (rr == 1 && !two) break;
            const int m = rr ? m1 : m0;
            float v[32]; float s = 0.f;
#pragma unroll
            for (int j = 0; j < 4; ++j) { const v4u x = w[rr][j]; v[8 * j + 0] = blo(x.x); v[8 * j + 1] = bhi(x.x); v[8 * j + 2] = blo(x.y); v[8 * j + 3] = bhi(x.y); v[8 * j + 4] = blo(x.z); v[8 * j + 5] = bhi(x.z); v[8 * j + 6] = blo(x.w); v[8 * j + 7] = bhi(x.w); }
#pragma unroll
            for (int e = 0; e < 32; ++e) s += v[e];
            const float mean = wave_sum(s) * (1.f / D); float s2 = 0.f;
#pragma unroll
            for (int e = 0; e < 32; ++e) { v[e] -= mean; s2 += v[e] * v[e]; }
            const float rstd = 1.f / sqrtf(wave_sum(s2) * (1.f / D) + LN_EPS);
#pragma unroll
            for (int j = 0; j < 4; ++j) { const int c0 = 512 * j + 8 * lane;
                const f32x4 g0 = *(const GAS f32x4*)(g + c0), g1 = *(const GAS f32x4*)(g + c0 + 4), b0 = *(const GAS f32x4*)(b + c0), b1 = *(const GAS f32x4*)(b + c0 + 4);
                GAS f32x4* o = (GAS f32x4*)(outp + (size_t)m * D + c0);
                __builtin_nontemporal_store((f32x4){v[8 * j + 0], v[8 * j + 1], v[8 * j + 2], v[8 * j + 3]} * rstd * g0 + b0, o); __builtin_nontemporal_store((f32x4){v[8 * j + 4], v[8 * j + 5], v[8 * j + 6], v[8 * j + 7]} * rstd * g1 + b1, o + 1); } }
    }
}
__device__ __forceinline__ void crms_phase(const bf16* bc, unsigned char* c8, const float* kvg, float cs, int gw, int NGW, int lane) {
    float gg[8];
#pragma unroll
    for (int j = 0; j < 8; ++j) gg[j] = kvg[8 * lane + j] * cs;
    for (int m = gw; m < M; m += NGW) {
        const v4u w = *((const GAS v4u*)(bc + (size_t)m * 512) + lane);
        float x[8] = {blo(w.x), bhi(w.x), blo(w.y), bhi(w.y), blo(w.z), bhi(w.z), blo(w.w), bhi(w.w)}; float s = 0.f;
#pragma unroll
        for (int j = 0; j < 8; ++j) s += x[j] * x[j];
        const float r = 1.f / sqrtf(wave_sum(s) * (1.f / 512.f) + LN_EPS);
#pragma unroll
        for (int j = 0; j < 8; ++j) x[j] = fminf(fmaxf(x[j] * r * gg[j], -448.f), 448.f);
        *((GAS v2u*)(c8 + (size_t)m * 512) + lane) = (v2u){pg8::pk4_fp8(x[0], x[1], x[2], x[3]), pg8::pk4_fp8(x[4], x[5], x[6], x[7])};
    }
}
typedef short v4i16_t __attribute__((ext_vector_type(4)));
__device__ __forceinline__ v4i16_t lds_tr16(const LAS unsigned char* p) { return __builtin_amdgcn_ds_read_tr16_b64_v4i16((LAS v4i16_t*)p); }
__device__ __forceinline__ unsigned cvtpk(float lo, float hi) { typedef float f2 __attribute__((ext_vector_type(2))); typedef __bf16 b2 __attribute__((ext_vector_type(2))); f2 v = {lo, hi}; b2 b = __builtin_convertvector(v, b2); return __builtin_bit_cast(unsigned, b); }
__device__ __forceinline__ float xhalf_f(float v) { return __shfl_xor(v, 32); }
constexpr float LOG2E = 1.4426950408889634f;
constexpr float QSCALE = 0.125f * LOG2E;

__device__ __forceinline__ void diff_attn_mfma(LAS unsigned char* lds, const bf16* AQ, const bf16* AK, const bf16* AV, bf16* YA, const float* dlam, const float* subg, unsigned* dq, const unsigned* kmax, const int wave) {
    const int lane = lane_fresh(), r32 = lane & 31, hi = lane >> 5;
    const int comp = wave >> 2, wq = wave & 3;
    const unsigned ksrc = (unsigned)(lane * 1024 + (2 * wave) * 8);
    const unsigned vsrc0 = (unsigned)((16 * ((2 * wave) & 3) + (lane >> 2)) * 1024 + ((2 * wave) >> 2) * 32 + (lane & 3) * 8);
    const unsigned vsrc1 = (unsigned)((16 * ((2 * wave + 1) & 3) + (lane >> 2)) * 1024 + ((2 * wave + 1) >> 2) * 32 + (lane & 3) * 8);
    const unsigned kdst = (unsigned)(2 * wave) * 1024u, vdst0 = 16384u + (unsigned)(((2 * wave) >> 2) * 4096 + ((2 * wave) & 3) * 1024), vdst1 = 16384u + (unsigned)(((2 * wave + 1) >> 2) * 4096 + ((2 * wave + 1) & 3) * 1024);
    const unsigned lds0 = (unsigned)(uintptr_t)lds;
#define DA_STAGE(bo, to) do { \
        glds16(Kg + (to) + ksrc, (unsigned)__builtin_amdgcn_readfirstlane((int)(lds0 + (bo) + kdst))); \
        glds16(Kg + (to) + ksrc + 8, (unsigned)__builtin_amdgcn_readfirstlane((int)(lds0 + (bo) + kdst + 1024))); \
        glds16(Vg + (to) + vsrc0, (unsigned)__builtin_amdgcn_readfirstlane((int)(lds0 + (bo) + vdst0))); \
        glds16(Vg + (to) + vsrc1, (unsigned)__builtin_amdgcn_readfirstlane((int)(lds0 + (bo) + vdst1))); } while (0)
#define DA_WAITBAR() asm volatile("s_waitcnt vmcnt(0) lgkmcnt(0)\n\ts_barrier" ::: "memory")
    const unsigned koff = (unsigned)(((comp * 8 + hi) * 64 + r32) * 16);
    const unsigned voff = (unsigned)(16384 + (4 * hi + ((lane & 15) >> 2)) * 64 + ((lane >> 4) & 1) * 32 + (lane & 3) * 8);
    LAS unsigned* xq = (LAS unsigned*)(lds + 100352);
    for (;;) {
        if (wave == 0 && lane == 0) xq[0] = __hip_atomic_fetch_add(dq, 1u, __ATOMIC_RELAXED, __HIP_MEMORY_SCOPE_AGENT);
        asm volatile("s_waitcnt vmcnt(0) lgkmcnt(0)\n\ts_barrier" ::: "memory");
        const int j = (int)xq[0];
        if (j >= 1024) break;
        const int ub = 31 - (j >> 5), bh = j & 31;
        const int b = bh >> 3, h = 7 - (bh & 7);
        const float sl2 = LOG2E / (float)(2 << h);
        const size_t rowbase = (size_t)b * SEQ; const int q0 = ub * 128;
        const int qpos = q0 + wq * 32 + r32;
        const int nt = 2 * ub + 2;
        const int myt = 2 * ub + 1 + (wq >> 1);
        const bf16* Kg = AK + rowbase * 1024 + h * 128; const bf16* Vg = AV + rowbase * 1024 + h * 128;
        bf16x8 qr[4];
#pragma unroll
        for (int s = 0; s < 4; ++s) qr[s] = *(const GAS bf16x8*)(AQ + (rowbase + qpos) * 1024 + h * 128 + comp * 64 + s * 16 + hi * 8);
        f32x16 o[4];
#pragma unroll
        for (int blk = 0; blk < 4; ++blk)
#pragma unroll
            for (int r = 0; r < 16; ++r) o[blk][r] = 0.f;
        float mrun = -INFINITY, lrun = 0.f;
        { float qn2 = 0.f;
#pragma unroll
          for (int s = 0; s < 4; ++s) { const v4u w = __builtin_bit_cast(v4u, qr[s]); const float e0 = blo(w.x), e1 = bhi(w.x), e2 = blo(w.y), e3 = bhi(w.y), e4 = blo(w.z), e5 = bhi(w.z), e6 = blo(w.w), e7 = bhi(w.w);
              qn2 += ((e0 * e0 + e1 * e1) + (e2 * e2 + e3 * e3)) + ((e4 * e4 + e5 * e5) + (e6 * e6 + e7 * e7)); }
          qn2 += xhalf_f(qn2);
#pragma unroll
          for (int o_ = 1; o_ < 32; o_ <<= 1) qn2 = fmaxf(qn2, __shfl_xor(qn2, o_));
          const float kb = __uint_as_float(__hip_atomic_load(kmax + (b * 8 + h) * 2 + comp, __ATOMIC_RELAXED, __HIP_MEMORY_SCOPE_AGENT));
          if (lane == 0) xq[8 + wave] = __float_as_uint(sqrtf(qn2) * kb * 8.1f); }
        DA_STAGE(0u, (size_t)(nt - 1) * 64 * 1024);
        DA_WAITBAR();
        int kt_lo = 0;
        { float sb = 0.f;
#pragma unroll
          for (int w_ = 0; w_ < 8; ++w_) sb = fmaxf(sb, __uint_as_float(xq[8 + w_]));
          const float xcut = (float)(q0 - 63) - (40.f + 2.f * sb) / sl2;
          kt_lo = xcut > 0.f ? (int)__builtin_ceilf(xcut * (1.f / 64.f)) : 0; kt_lo = __builtin_amdgcn_readfirstlane(kt_lo); }
        for (int st = 0; st < nt - kt_lo; ++st) {
            const int kt = nt - 1 - st;
            const unsigned bufo = (unsigned)(st & 1) * 32768u;
            if (kt > kt_lo) DA_STAGE(32768u - bufo, (size_t)(kt - 1) * 64 * 1024);
            if (kt < myt) {
                const LAS unsigned char* Kb = lds + bufo + koff;
                f32x16 p0, p1;
#pragma unroll
                for (int r = 0; r < 16; ++r) { p0[r] = 0.f; p1[r] = 0.f; }
                { bf16x8 kf[4];
#pragma unroll
                  for (int s = 0; s < 4; ++s) kf[s] = *(const LAS bf16x8*)(Kb + s * 2048);
#pragma unroll
                  for (int s = 0; s < 4; ++s) p0 = __builtin_amdgcn_mfma_f32_32x32x16_bf16(kf[s], qr[s], p0, 0, 0, 0); }
                { bf16x8 kf[4];
#pragma unroll
                  for (int s = 0; s < 4; ++s) kf[s] = *(const LAS bf16x8*)(Kb + s * 2048 + 512);
#pragma unroll
                  for (int s = 0; s < 4; ++s) p1 = __builtin_amdgcn_mfma_f32_32x32x16_bf16(kf[s], qr[s], p1, 0, 0, 0); }
                const float qth = (float)(qpos - kt * 64 - 4 * hi);
                float rm = -INFINITY;
#pragma unroll
                for (int r = 0; r < 16; ++r) { const float kr = (float)((r & 3) + 8 * (r >> 2)); const float v0 = qth - kr, v1 = qth - (kr + 32.f);
                    p0[r] = p0[r] - sl2 * fabsf(v0); p1[r] = p1[r] - sl2 * fabsf(v1); rm = fmaxf(rm, fmaxf(p0[r], p1[r])); }
                rm = fmaxf(rm, xhalf_f(rm));
                if (__any(rm > mrun)) { const float mn = fmaxf(mrun, rm), f = __builtin_amdgcn_exp2f(mrun - mn); mrun = mn; lrun *= f;
#pragma unroll
                    for (int blk = 0; blk < 4; ++blk)
#pragma unroll
                        for (int r = 0; r < 16; ++r) o[blk][r] *= f; }
                float ls = 0.f;
#pragma unroll
                for (int r = 0; r < 16; ++r) { p0[r] = __builtin_amdgcn_exp2f(p0[r] - mrun); p1[r] = __builtin_amdgcn_exp2f(p1[r] - mrun); ls += p0[r] + p1[r]; }
                lrun += ls;
                bf16x8 pw[4];
#pragma unroll
                for (int s = 0; s < 2; ++s) {
                    v4u a = {cvtpk(p0[8 * s + 0], p0[8 * s + 1]), cvtpk(p0[8 * s + 2], p0[8 * s + 3]), cvtpk(p0[8 * s + 4], p0[8 * s + 5]), cvtpk(p0[8 * s + 6], p0[8 * s + 7])};
                    v4u c = {cvtpk(p1[8 * s + 0], p1[8 * s + 1]), cvtpk(p1[8 * s + 2], p1[8 * s + 3]), cvtpk(p1[8 * s + 4], p1[8 * s + 5]), cvtpk(p1[8 * s + 6], p1[8 * s + 7])};
                    pw[s] = __builtin_bit_cast(bf16x8, a); pw[2 + s] = __builtin_bit_cast(bf16x8, c); }
                const LAS unsigned char* Vb = lds + bufo + voff;
#pragma unroll
                for (int blk = 0; blk < 4; ++blk) {
#pragma unroll
                    for (int s = 0; s < 4; ++s) {
                        const v4i16_t lo = lds_tr16(Vb + blk * 4096 + s * 1024), hh = lds_tr16(Vb + blk * 4096 + s * 1024 + 512);
                        const bf16x8 vf = {lo[0], lo[1], lo[2], lo[3], hh[0], hh[1], hh[2], hh[3]};
                        o[blk] = __builtin_amdgcn_mfma_f32_32x32x16_bf16(vf, pw[s], o[blk], 0, 0, 0);
                    }
                }
            }
            DA_WAITBAR();
        }
        lrun += xhalf_f(lrun);
        const float inv = 1.f / lrun;
        LAS float* Y1 = (LAS float*)(lds) + wq * 4096;
        if (comp == 1) {
            float lam; { float a = dlam[lane] * dlam[64 + lane], bq_ = dlam[128 + lane] * dlam[192 + lane]; a = wave_sum(a); bq_ = wave_sum(bq_); lam = __expf(a) - __expf(bq_) + LAMBDA_INIT; }
            const float sc = inv * lam;
#pragma unroll
            for (int blk = 0; blk < 4; ++blk)
#pragma unroll
                for (int r = 0; r < 16; ++r) Y1[(32 * blk + (r & 3) + 8 * (r >> 2) + 4 * hi) * 32 + r32] = o[blk][r] * sc; }
        __syncthreads();
        if (comp == 0) {
            float ss = 0.f;
#pragma unroll
            for (int blk = 0; blk < 4; ++blk)
#pragma unroll
                for (int r = 0; r < 16; ++r) { const float a = o[blk][r] * inv - Y1[(32 * blk + (r & 3) + 8 * (r >> 2) + 4 * hi) * 32 + r32]; o[blk][r] = a; ss += a * a; }
            ss += xhalf_f(ss);
            const float rr = (1.0f - LAMBDA_INIT) / sqrtf(ss * (1.f / 128.f) + LN_EPS);
            LAS unsigned* stg = (LAS unsigned*)(lds + 65536) + wq * (32 * 65);
#pragma unroll
            for (int blk = 0; blk < 4; ++blk) {
#pragma unroll
                for (int r = 0; r < 16; r += 2) { const int e = 32 * blk + (r & 3) + 8 * (r >> 2) + 4 * hi;
                    stg[r32 * 65 + (e >> 1)] = cvtpk(o[blk][r] * rr * subg[e], o[blk][r + 1] * rr * subg[e + 1]); }
                asm volatile("" ::: "memory"); }
            LDS_WAIT(); asm volatile("" ::: "memory");
            bf16* orow = YA + (rowbase + q0 + wq * 32) * 1024 + h * 128;
#pragma unroll 4
            for (int row = 0; row < 32; ++row) *((GAS unsigned*)(orow + (size_t)row * 1024) + lane) = stg[row * 65 + lane];
        }
        __syncthreads();
    }
#undef DA_STAGE
#undef DA_WAITBAR
}

__device__ __forceinline__ unsigned okey(float f) { const unsigned u = __float_as_uint(f); return (u & 0x80000000u) ? ~u : (u | 0x80000000u); }
__device__ __forceinline__ void indexer_topk(LAS unsigned char* lds, const bf16* IQ, const bf16* IKW, unsigned short* IDX, int vcu, int G, const int wave) {
    const int lane = lane_fresh(), r32 = lane & 31, hi = lane >> 5;
    const unsigned lds0 = (unsigned)(uintptr_t)lds;
    const unsigned boff = (unsigned)((hi * 256 + r32) * 16);
    for (int j = vcu; j < 1024; j += G) {
        const int w = j & 255, i = j >> 8, bq = w >> 4, s16 = w & 15;
        const int chunk = (i == 0) ? s16 : (i == 1) ? 31 - s16 : (i == 2) ? 32 + s16 : 63 - s16;
        const int b = bq >> 2, gq = bq & 3;
        const int t0 = b * SEQ + chunk * 64 + gq * 16 + 2 * wave;
        const int ngroups = 2 * (chunk + 1);
        const int ntiles = (ngroups + 7) >> 3;
        const bf16* Kg = IKW + (size_t)b * SEQ * 256;
#define IX_STAGE(tile, bo) do { int tl_ = (tile); asm volatile("" : "+s"(tl_)); _Pragma("unroll") for (int i_ = 0; i_ < 4; ++i_) { const int q_ = 4 * wave + i_; \
            glds16s(Kg + (size_t)(tl_ * 256 + 64 * (q_ & 3)) * 256 + (q_ >> 2) * 8, (unsigned)lane * 512u, (unsigned)__builtin_amdgcn_readfirstlane((int)(lds0 + (bo) + ((q_ >> 2) * 256 + 64 * (q_ & 3)) * 16))); } } while (0)
        asm volatile("s_barrier" ::: "memory");
        IX_STAGE(0, 0u);
        bf16x8 a[4];
#pragma unroll
        for (int ks = 0; ks < 4; ++ks) a[ks] = *(const GAS bf16x8*)(IQ + (size_t)(t0 + (r32 >> 4)) * 1024 + (r32 & 15) * 64 + ks * 16 + 8 * hi);
        float wv[16];
        { const bf16* iwp = IKW + (size_t)t0 * 256 + 64 + 4 * hi;
          const v2u w00 = *(const GAS v2u*)(iwp), w01 = *(const GAS v2u*)(iwp + 8), w10 = *(const GAS v2u*)(iwp + 256), w11 = *(const GAS v2u*)(iwp + 256 + 8);
          wv[0] = blo(w00.x); wv[1] = bhi(w00.x); wv[2] = blo(w00.y); wv[3] = bhi(w00.y); wv[4] = blo(w01.x); wv[5] = bhi(w01.x); wv[6] = blo(w01.y); wv[7] = bhi(w01.y);
          wv[8] = blo(w10.x); wv[9] = bhi(w10.x); wv[10] = blo(w10.y); wv[11] = bhi(w10.y); wv[12] = blo(w11.x); wv[13] = bhi(w11.x); wv[14] = blo(w11.y); wv[15] = bhi(w11.y); }
        unsigned key[128];
#pragma unroll 128
        for (int g = 0; g < 128; ++g) {
            if (g < ngroups) {
                const unsigned bufo = (unsigned)((g >> 3) & 1) * 32768u;
                if ((g & 7) == 0) {
                    asm volatile("s_waitcnt vmcnt(0)\n\ts_barrier" ::: "memory");
                    if ((g >> 3) + 1 < ntiles) IX_STAGE((g >> 3) + 1, 32768u - bufo);
                }
                bf16x8 bk[4];
#pragma unroll
                for (int ks = 0; ks < 4; ++ks) bk[ks] = *(const LAS bf16x8*)(lds + bufo + boff + (g & 7) * 512 + ks * 8192);
                f32x16 acc = {0.f, 0.f, 0.f, 0.f, 0.f, 0.f, 0.f, 0.f, 0.f, 0.f, 0.f, 0.f, 0.f, 0.f, 0.f, 0.f};
#pragma unroll
                for (int ks = 0; ks < 4; ++ks) acc = __builtin_amdgcn_mfma_f32_32x32x16_bf16(a[ks], bk[ks], acc, 0, 0, 0);
                float s0 = 0.f, s1 = 0.f;
#pragma unroll
                for (int r = 0; r < 8; ++r) { s0 += wv[r] * fmaxf(acc[r], 0.f); s1 += wv[8 + r] * fmaxf(acc[8 + r], 0.f); }
                { const auto rr = __builtin_amdgcn_permlane32_swap(__float_as_uint(s0), __float_as_uint(s1), false, false);
                  key[g] = okey(__uint_as_float(rr[0]) + __uint_as_float(rr[1])); }
            } else key[g] = 0u;
        }
        unsigned T = 0u;
        if (chunk >= 4) {
            bool done = false;
#pragma nounroll
            for (int bit = 31; bit >= 0; --bit) {
                if (__all(done ? 1 : 0)) break;
                const unsigned trial = T | (1u << bit);
                int cnt = 0;
#pragma unroll
                for (int tl = 0; tl < 16; ++tl) { if (tl < ntiles) {
#pragma unroll
                    for (int gg = 0; gg < 8; ++gg) cnt += (key[tl * 8 + gg] >= trial) ? 1 : 0; } }
                cnt = half_sum_i32(cnt);
                if (!done && cnt >= 256) { T = trial; if (cnt == 256) done = true; }
            }
        }
        int base = 0;
        unsigned short* ip = IDX + (size_t)(t0 + hi) * 256;
#pragma unroll
        for (int g = 0; g < 128; ++g) {
            if (g < ngroups) {
                const bool sel = key[g] >= T;
                const unsigned long long mk = __ballot(sel ? 1 : 0);
                const unsigned mh = hi ? (unsigned)(mk >> 32) : (unsigned)mk;
                const int pos = base + __popc(mh & ((1u << r32) - 1u));
                if (sel && pos < 256) ip[pos] = (unsigned short)(32 * g + r32);
                base += __popc(mh);
            }
        }
    }
#undef IX_STAGE
    asm volatile("s_waitcnt vmcnt(0) lgkmcnt(0)\n\ts_barrier" ::: "memory");
}

constexpr int DSA_PAIRB = 1040;
constexpr int DSA_WAVEB = 16 * DSA_PAIRB + 512;
constexpr int DSA_LDS_END = 8 * DSA_WAVEB;
constexpr float DSA_CS = 64.f, DSA_QS = 64.f, DSA_PS = 256.f;
typedef int v2i_t __attribute__((ext_vector_type(2)));
__device__ __forceinline__ void dsa_mfma(LAS unsigned char* lds, const bf16* QL, bf16* OL, const int omask, const unsigned char* C8, const unsigned short* IDX, int vcu, int G, const int wave) {
    const int lane = lane_fresh(), h16 = lane & 15, g = lane >> 4;
    LAS unsigned char* wl = lds + wave * DSA_WAVEB;
    const unsigned wl0 = (unsigned)(uintptr_t)wl;
    LAS unsigned short* idxs = (LAS unsigned short*)(wl + 16 * DSA_PAIRB);
    const float sc2 = 0.08838834764831845f * LOG2E / (DSA_QS * DSA_CS);
    const float sl2 = (h16 < 8) ? LOG2E / (float)(2 << (h16 & 7)) : 0.f;
    const int ntok = (G == 256) ? 8 : (M - (vcu * 8 + wave) + G * 8 - 1) / (G * 8);
#define DSA_TOK(i) ((G == 256) ? ((vcu >> 6) * SEQ + (vcu & 63) + 64 * (wave + 8 * (i))) : (vcu * 8 + wave + G * 8 * (i)))
    const unsigned qk_off = (unsigned)((h16 >> 1) * DSA_PAIRB + (h16 & 1) * 512 + 32 * g);
    const int trow = (h16 >> 1) < 4 ? 4 * g + (h16 >> 1) : 16 + 4 * g + ((h16 >> 1) - 4);
    const unsigned pv_off = (unsigned)((trow >> 1) * DSA_PAIRB + (trow & 1) * 512 + 8 * (h16 & 1));
    for (int it = 0; it < ntok; ++it) {
        const int t = DSA_TOK(it); const int tpos = t & (SEQ - 1);
        const int n = (tpos >> 6) >= 3 ? 256 : 64 * ((tpos >> 6) + 1); const int nst = n >> 5;
        const unsigned char* Cb = C8 + (size_t)(t >> 12) * SEQ * 512;
        int ln = lane; asm volatile("" : "+v"(ln));
        const int h16b = ln & 15, gb = ln >> 4;
        { const v2u iv = __builtin_nontemporal_load((const GAS v2u*)(IDX + (size_t)t * 256) + ln); *((LAS v2u*)idxs + ln) = iv; }
        pg8::v8i_t qf[4];
        { const bf16* qp = QL + (size_t)t * 4096 + (h16b & 7) * 512 + 32 * gb;
#pragma unroll
          for (int s = 0; s < 4; ++s) { unsigned w8[8];
#pragma unroll
              for (int c = 0; c < 4; ++c) { const v4u w = __builtin_nontemporal_load((const GAS v4u*)(qp + 128 * s + 8 * c));
                  w8[2 * c] = pg8::pk4_fp8(fminf(fmaxf(blo(w.x) * DSA_QS, -448.f), 448.f), fminf(fmaxf(bhi(w.x) * DSA_QS, -448.f), 448.f), fminf(fmaxf(blo(w.y) * DSA_QS, -448.f), 448.f), fminf(fmaxf(bhi(w.y) * DSA_QS, -448.f), 448.f));
                  w8[2 * c + 1] = pg8::pk4_fp8(fminf(fmaxf(blo(w.z) * DSA_QS, -448.f), 448.f), fminf(fmaxf(bhi(w.z) * DSA_QS, -448.f), 448.f), fminf(fmaxf(blo(w.w) * DSA_QS, -448.f), 448.f), fminf(fmaxf(bhi(w.w) * DSA_QS, -448.f), 448.f)); }
              qf[s] = (pg8::v8i_t){(int)w8[0], (int)w8[1], (int)w8[2], (int)w8[3], (int)w8[4], (int)w8[5], (int)w8[6], (int)w8[7]}; } }
        f32x4 o[32];
#pragma unroll
        for (int blk = 0; blk < 32; ++blk) o[blk] = (f32x4){0.f, 0.f, 0.f, 0.f};
        float mrun = -INFINITY, lrun = 0.f;
        asm volatile("s_waitcnt vmcnt(0) lgkmcnt(0)" ::: "memory");
        for (int st = 0; st < nst; ++st) {
#pragma unroll
            for (int i = 0; i < 16; ++i) { const unsigned srow = idxs[st * 32 + 2 * i + (lane >> 5)];
                glds16s(Cb, srow * 512u + (unsigned)(lane & 31) * 16u, (unsigned)__builtin_amdgcn_readfirstlane((int)(wl0 + i * DSA_PAIRB))); }
            asm volatile("s_waitcnt vmcnt(0)" ::: "memory");
            f32x4 a0 = {0.f, 0.f, 0.f, 0.f}, a1 = {0.f, 0.f, 0.f, 0.f};
#pragma unroll
            for (int s = 0; s < 4; ++s) {
                const pg8::v4i_t x0 = *(const LAS pg8::v4i_t*)(wl + qk_off + 128 * s), x1 = *(const LAS pg8::v4i_t*)(wl + qk_off + 128 * s + 16);
                const pg8::v4i_t y0 = *(const LAS pg8::v4i_t*)(wl + qk_off + 8 * DSA_PAIRB + 128 * s), y1 = *(const LAS pg8::v4i_t*)(wl + qk_off + 8 * DSA_PAIRB + 128 * s + 16);
                a0 = __builtin_amdgcn_mfma_scale_f32_16x16x128_f8f6f4(__builtin_shufflevector(x0, x1, 0, 1, 2, 3, 4, 5, 6, 7), qf[s], a0, 0, 0, 0, 0x7f7f7f7f, 0, 0x7f7f7f7f);
                a1 = __builtin_amdgcn_mfma_scale_f32_16x16x128_f8f6f4(__builtin_shufflevector(y0, y1, 0, 1, 2, 3, 4, 5, 6, 7), qf[s], a1, 0, 0, 0, 0x7f7f7f7f, 0, 0x7f7f7f7f); }
            const v2u i0 = *(const LAS v2u*)(idxs + st * 32 + 4 * g), i1 = *(const LAS v2u*)(idxs + st * 32 + 16 + 4 * g);
            const int sidx[8] = {(int)(i0.x & 0xffffu), (int)(i0.x >> 16), (int)(i0.y & 0xffffu), (int)(i0.y >> 16), (int)(i1.x & 0xffffu), (int)(i1.x >> 16), (int)(i1.y & 0xffffu), (int)(i1.y >> 16)};
            float lg[8];
#pragma unroll
            for (int r = 0; r < 8; ++r) { const int d = tpos - sidx[r]; lg[r] = (r < 4 ? a0[r & 3] : a1[r & 3]) * sc2 - sl2 * (float)(d < 0 ? -d : d); }
            float rm = fmaxf(fmaxf(fmaxf(lg[0], lg[1]), fmaxf(lg[2], lg[3])), fmaxf(fmaxf(lg[4], lg[5]), fmaxf(lg[6], lg[7])));
            rm = fmaxf(rm, __shfl_xor(rm, 16)); rm = fmaxf(rm, __shfl_xor(rm, 32));
            const float mn = fmaxf(mrun, rm), f = __builtin_amdgcn_exp2f(mrun - mn); mrun = mn;
#pragma unroll
            for (int r = 0; r < 8; ++r) lg[r] = __builtin_amdgcn_exp2f(lg[r] - mn) * DSA_PS;
            const unsigned pw0 = pg8::pk4_fp8(lg[0], lg[1], lg[2], lg[3]), pw1 = pg8::pk4_fp8(lg[4], lg[5], lg[6], lg[7]);
            { const float ps = ((__builtin_amdgcn_cvt_f32_fp8((int)pw0, 0) + __builtin_amdgcn_cvt_f32_fp8((int)pw0, 1)) + (__builtin_amdgcn_cvt_f32_fp8((int)pw0, 2) + __builtin_amdgcn_cvt_f32_fp8((int)pw0, 3)))
                           + ((__builtin_amdgcn_cvt_f32_fp8((int)pw1, 0) + __builtin_amdgcn_cvt_f32_fp8((int)pw1, 1)) + (__builtin_amdgcn_cvt_f32_fp8((int)pw1, 2) + __builtin_amdgcn_cvt_f32_fp8((int)pw1, 3)));
              lrun = lrun * f + ps; }
            const long pw = (long)(((unsigned long)pw1 << 32) | (unsigned long)pw0);
#pragma unroll
            for (int blk = 0; blk < 32; ++blk) {
                const v2i_t av = __builtin_amdgcn_ds_read_tr8_b64_v2i32((LAS v2i_t*)(wl + pv_off + 16 * blk));
                const long al = (long)(((unsigned long)(unsigned)av.y << 32) | (unsigned long)(unsigned)av.x);
                o[blk] = __builtin_amdgcn_mfma_f32_16x16x32_fp8_fp8(al, pw, o[blk] * f, 0, 0, 0);
                if ((blk & 3) == 3) __builtin_amdgcn_sched_barrier(0);
            }
        }
        float lt = lrun; lt += __shfl_xor(lt, 16); lt += __shfl_xor(lt, 32);
        const float inv = 1.f / (lt * DSA_CS);
        if (h16 < 8) {
#pragma unroll
            for (int blk = 0; blk < 32; ++blk) { const f32x4 v = o[blk] * inv;
                __builtin_nontemporal_store((v2u){cvtpk(v.x, v.y), cvtpk(v.z, v.w)}, (GAS v2u*)(OL + (size_t)(t & omask) * 4096 + h16b * 512 + 16 * blk + 4 * gb)); } }
    }
    asm volatile("s_waitcnt vmcnt(0) lgkmcnt(0)" ::: "memory");
    __syncthreads();
#undef DSA_TOK
}
static_assert(DSA_LDS_END <= RING_BYTES, "DSA LDS map");

__device__ __forceinline__ void memattn_mfma(LAS unsigned char* lds, const bf16* QM, const bf16* KV, bf16* OM, int vcu, int G, const int wave) {
    const int lane = lane_fresh(), r32 = lane & 31, hi = lane >> 5;
    const unsigned voff = (unsigned)(65536 + (4 * hi + ((lane & 15) >> 2)) * 64 + ((lane >> 4) & 1) * 32 + (lane & 3) * 8);
    for (int j = vcu; j < 256; j += G) {
        const int bh = j >> 4, qb = j & 15, b = bh >> 2, h = bh & 3;
        const bf16* Kg = KV + (size_t)b * MEMT * 1024 + h * 128; const bf16* Vg = Kg + 512;
#pragma unroll
        for (int i = 0; i < 8; ++i) { const int q = 8 * wave + i;
            glds16(Kg + (size_t)(64 * (q & 3) + lane) * 1024 + (q >> 2) * 8, (unsigned)__builtin_amdgcn_readfirstlane((int)((unsigned)(uintptr_t)lds + ((q >> 2) * 256 + 64 * (q & 3)) * 16)));
            glds16(Vg + (size_t)(16 * (q & 15) + (lane >> 2)) * 1024 + (q >> 4) * 32 + (lane & 3) * 8, (unsigned)__builtin_amdgcn_readfirstlane((int)((unsigned)(uintptr_t)lds + 65536 + (q >> 4) * 16384 + (q & 15) * 1024))); }
        const size_t qrow = (size_t)b * SEQ + qb * 256 + wave * 32 + r32;
        bf16x8 qr[8];
#pragma unroll
        for (int s = 0; s < 8; ++s) qr[s] = *(const GAS bf16x8*)(QM + qrow * 512 + h * 128 + s * 16 + hi * 8);
        f32x16 o[4];
#pragma unroll
        for (int blk = 0; blk < 4; ++blk)
#pragma unroll
            for (int r = 0; r < 16; ++r) o[blk][r] = 0.f;
        float mrun = -INFINITY, lrun = 0.f;
        asm volatile("s_waitcnt vmcnt(0) lgkmcnt(0)\n\ts_barrier" ::: "memory");
        for (int kt = 0; kt < 4; ++kt) {
            const LAS unsigned char* Kb = lds + (unsigned)((hi * 256 + 64 * kt + r32) * 16);
            f32x16 p0, p1;
#pragma unroll
            for (int r = 0; r < 16; ++r) { p0[r] = 0.f; p1[r] = 0.f; }
#pragma unroll
            for (int s = 0; s < 8; ++s) { const bf16x8 k0 = *(const LAS bf16x8*)(Kb + s * 8192), k1 = *(const LAS bf16x8*)(Kb + s * 8192 + 512);
                p0 = __builtin_amdgcn_mfma_f32_32x32x16_bf16(k0, qr[s], p0, 0, 0, 0); p1 = __builtin_amdgcn_mfma_f32_32x32x16_bf16(k1, qr[s], p1, 0, 0, 0); }
            float rm = -INFINITY;
#pragma unroll
            for (int r = 0; r < 16; ++r) rm = fmaxf(rm, fmaxf(p0[r], p1[r]));
            rm = fmaxf(rm, xhalf_f(rm));
            if (__any(rm > mrun)) { const float mn = fmaxf(mrun, rm), f = __builtin_amdgcn_exp2f(mrun - mn); mrun = mn; lrun *= f;
#pragma unroll
                for (int blk = 0; blk < 4; ++blk)
#pragma unroll
                    for (int r = 0; r < 16; ++r) o[blk][r] *= f; }
            float ls = 0.f;
#pragma unroll
            for (int r = 0; r < 16; ++r) { p0[r] = __builtin_amdgcn_exp2f(p0[r] - mrun); p1[r] = __builtin_amdgcn_exp2f(p1[r] - mrun); ls += p0[r] + p1[r]; }
            lrun += ls;
            bf16x8 pw[4];
#pragma unroll
            for (int s = 0; s < 2; ++s) {
                v4u a = {cvtpk(p0[8 * s + 0], p0[8 * s + 1]), cvtpk(p0[8 * s + 2], p0[8 * s + 3]), cvtpk(p0[8 * s + 4], p0[8 * s + 5]), cvtpk(p0[8 * s + 6], p0[8 * s + 7])};
                v4u c = {cvtpk(p1[8 * s + 0], p1[8 * s + 1]), cvtpk(p1[8 * s + 2], p1[8 * s + 3]), cvtpk(p1[8 * s + 4], p1[8 * s + 5]), cvtpk(p1[8 * s + 6], p1[8 * s + 7])};
                pw[s] = __builtin_bit_cast(bf16x8, a); pw[2 + s] = __builtin_bit_cast(bf16x8, c); }
            const LAS unsigned char* Vb = lds + voff + kt * 4096;
#pragma unroll
            for (int blk = 0; blk < 4; ++blk) {
#pragma unroll
                for (int s = 0; s < 4; ++s) {
                    const v4i16_t lo = lds_tr16(Vb + blk * 16384 + s * 1024), hh = lds_tr16(Vb + blk * 16384 + s * 1024 + 512);
                    const bf16x8 vf = {lo[0], lo[1], lo[2], lo[3], hh[0], hh[1], hh[2], hh[3]};
                    o[blk] = __builtin_amdgcn_mfma_f32_32x32x16_bf16(vf, pw[s], o[blk], 0, 0, 0);
                }
            }
        }
        __syncthreads();
        lrun += xhalf_f(lrun);
        const float inv = 1.f / lrun;
        LAS unsigned* stg = (LAS unsigned*)(lds) + wave * (32 * 65);
#pragma unroll
        for (int blk = 0; blk < 4; ++blk)
#pragma unroll
            for (int r = 0; r < 16; r += 2) { const int e = 32 * blk + (r & 3) + 8 * (r >> 2) + 4 * hi;
                stg[r32 * 65 + (e >> 1)] = cvtpk(o[blk][r] * inv, o[blk][r + 1] * inv); }
        LDS_WAIT(); asm volatile("" ::: "memory");
        bf16* orow = OM + ((size_t)b * SEQ + qb * 256 + wave * 32) * 512 + h * 128;
#pragma unroll 4
        for (int row = 0; row < 32; ++row) *((GAS unsigned*)(orow + (size_t)row * 512) + lane) = stg[row * 65 + lane];
        __syncthreads();
    }
}

constexpr int N_PHASES = 21;
struct Args { const float* in[24]; float* out; unsigned char* ws; int ph_lo, ph_hi; };
__global__ void __launch_bounds__(NWAVES * 64, 2) mk_fwd(Args args) {
    extern __shared__ __attribute__((aligned(16))) unsigned char lds_raw[];
    LAS unsigned char* lds = (LAS unsigned char*)lds_raw;
    volatile LAS unsigned* MISC = (volatile LAS unsigned*)(lds + MISC_OFF);
    const int tid = threadIdx.x, wave = __builtin_amdgcn_readfirstlane(tid >> 6);
#define lane lane_fresh()
    const int G = gridDim.x, bx = blockIdx.x;
    const int vcu = (G % 8 == 0) ? (bx % 8) * (G / 8) + bx / 8 : bx;
    const int gw = vcu * NWAVES + wave, NGW = G * NWAVES;
    unsigned char* ws = args.ws;
    gu32* ctl = (gu32*)(ws + WS_CTL);
    for (int u = tid; u < (LDS_BYTES - LDSCTL_OFF) / 4; u += NWAVES * 64) ((LAS unsigned*)(lds + LDSCTL_OFF))[u] = 0u;
    __syncthreads();
    const bool one = (args.ph_hi - args.ph_lo) > 1;
    XcdBarrier bar; bar.bar = (unsigned*)(ctl + CW_BAR); bar.x = 0; bar.st = nullptr;
    if (one) bar = xcd_barrier_post((unsigned*)(ctl + CW_BAR), MISC + 8, tid == 0);
    const int lo = args.ph_lo, hi = args.ph_hi;
#ifndef PH_MASK
#define PH_MASK 0xFFFFFFFFu
#endif
#define IN(k) ((((PH_MASK) >> (k)) & 1u) && lo <= (k) && (k) < hi)
#define SEAM(k) do { if (IN(k) && IN((k) + 1)) xcd_barrier(bar, wave); } while (0)
    bf16* const X16 = (bf16*)(ws + WS_X16); bf16* const HB = (bf16*)(ws + WS_H);
    long long* const ST0 = (long long*)(ws + WS_CTL + CTL_STATS); long long* const ST1 = (long long*)(ws + WS_CTL + CTL_STATS + CTL_STATS_STRIDE); long long* const ST2 = (long long*)(ws + WS_CTL + CTL_STATS + 2 * CTL_STATS_STRIDE);
    const float* const VEC = (const float*)(ws + WS_CTL + CTL_VECF);
    float* const out = args.out;
    const float* const ln_g = args.in[22]; const float* const ln_b = args.in[23];
    using namespace pg8;

#ifdef PROBE_P0
    if (IN(0)) { p0_prologue(args.in, ws, lds, gw, NGW, wave, lane); }
#endif
    if (IN(0)) { p0_prologue(args.in, ws, lds, gw, NGW, wave, lane); }
    SEAM(0);
    if (IN(1)) { { const long long* vi = (const long long*)(ws + WS_CTL + CTL_VEC); float* vf = (float*)(ws + WS_CTL + CTL_VECF); for (int i = gw * 64 + lane; i < V_END; i += NGW * 64) vf[i] = (float)vi[i] * (1.0f / 16777216.f); }
        Gemm g{(const bf16*)(ws + WS_X8), (const bf16*)(ws + WS_W_GU1), D / 2, D / 2, D / 2, 0, 0}; StaticOrder S; S.init(M, 2 * FF, G, bx); EpiSwiGLU8 E{(unsigned char*)HB, FF, 1.0f / (FP8_XS * FP8_WGUS), FP8_HS, LnFold{nullptr, nullptr, nullptr}};
        gemm_phase<EpiSwiGLU8, StaticOrder, true, true>(lds + RING_OFF, g, S, E, wave); }
    SEAM(1);
    if (IN(2)) { Gemm g{HB, (const bf16*)(ws + WS_W_D1), FF / 2, FF / 2, FF / 2, 0, 0}; StaticOrder S; S.init(M, D, G, bx); EpiRes E{args.in[0], nullptr, D, ALPHA, 0.5f / (FP8_HS * FP8_WDS), nullptr, nullptr, nullptr, ST0, X16, (unsigned char*)(ws + WS_X8M), FP8_XS};
        gemm_phase<EpiRes, StaticOrder, true, true>(lds + RING_OFF, g, S, E, wave); }
    SEAM(2);
    if (IN(4)) {
        { Gemm g{X16, (const bf16*)(ws + WS_W_IN), D, D, D, 0, 0}; StaticOrder S; S.init(M, N_IN, G, bx);
          EpiInProj E{(bf16*)(ws + WS_AQ), (bf16*)(ws + WS_AK), (bf16*)(ws + WS_AV), (bf16*)(ws + WS_BQ), (bf16*)(ws + WS_BC), (bf16*)(ws + WS_IQ), (bf16*)(ws + WS_IKW), QSCALE, LnFold{ST0, VEC + V_GW_IN, VEC + V_BW_IN}, (unsigned*)(ctl + CW_KMAX)};
          gemm_phase<EpiInProj, StaticOrder, true>(lds + RING_OFF, g, S, E, wave); }
        { Gemm g{(const bf16*)(ws + WS_MEM16), (const bf16*)(ws + WS_W_MKV), D, D, D, 0, 0}; StaticOrder S; S.init(BATCH * MEMT, 1024, G, bx >= G - 16 ? bx - (G - 16) : (1 << 20)); EpiBf16 E{(bf16*)(ws + WS_KVMEM), 1024};
          gemm_phase<EpiBf16, StaticOrder, true>(lds + RING_OFF, g, S, E, wave); }
    }
    SEAM(4);
    if (IN(5)) {
        { Gemm g{(const bf16*)(ws + WS_BQ), (const bf16*)(ws + WS_W_UK), 1024, 128, 128, 1, 128}; StaticOrder S; S.init(M, 4096, G, bx); EpiBf16 E{(bf16*)(ws + WS_QLAT), 4096};
          gemm_phase<EpiBf16, StaticOrder, true>(lds + RING_OFF, g, S, E, wave); }
        crms_phase((const bf16*)(ws + WS_BC), (unsigned char*)(ws + WS_C8), args.in[8], DSA_CS, gw, NGW, lane);
    }
    if (IN(7)) indexer_topk(lds, (const bf16*)(ws + WS_IQ), (const bf16*)(ws + WS_IKW), (unsigned short*)(ws + WS_IDX), vcu, G, wave);
    if (IN(7)) diff_attn_mfma(lds, (const bf16*)(ws + WS_AQ), (const bf16*)(ws + WS_AK), (const bf16*)(ws + WS_AV), (bf16*)(ws + WS_AQ), args.in[6], args.in[7], (unsigned*)(ctl + CW_DQ), (const unsigned*)(ctl + CW_KMAX), wave);
    SEAM(7);
    if (IN(8)) dsa_mfma(lds, (const bf16*)(ws + WS_QLAT), (bf16*)(ws + WS_QLAT), 0x7fffffff, (const unsigned char*)(ws + WS_C8), (const unsigned short*)(ws + WS_IDX), vcu, G, wave);
    SEAM(8);
    if (IN(9)) { Gemm g{(const bf16*)(ws + WS_QLAT), (const bf16*)(ws + WS_W_UVP), 4096, 1024, 1024, 0, 1024}; StaticOrder S; S.init(M, 1024, G, bx); EpiBf16 E{(bf16*)(ws + WS_YB), 1024};
        gemm_phase<EpiBf16, StaticOrder, true>(lds + RING_OFF, g, S, E, wave); }
    SEAM(9);
    if (IN(10)) {
        { Gemm g{(const bf16*)(ws + WS_AQ), (const bf16*)(ws + WS_W_A), 1024, 1024, 1024, 0, 0}; StaticOrder S; S.init(M, D, G, bx); EpiBf16 E{(bf16*)(ws + WS_TA), D}; gemm_phase<EpiBf16, StaticOrder, true>(lds + RING_OFF, g, S, E, wave); }
        { Gemm g{(const bf16*)(ws + WS_YB), (const bf16*)(ws + WS_W_B), 1024, 1024, 1024, 0, 0}; StaticOrder S; S.init(M, D, G, bx); EpiBf16 E{(bf16*)(ws + WS_TB), D}; gemm_phase<EpiBf16, StaticOrder, true>(lds + RING_OFF, g, S, E, wave); }
    }
    SEAM(10);
    if (IN(11)) { Gemm g{(const bf16*)(ws + WS_X8M), (const bf16*)(ws + WS_W_G), D / 2, D / 2, D / 2, 0, 0}; StaticOrder S; S.init(M, 2 * D, G, bx);
        EpiGateMerge8 E{(const bf16*)(ws + WS_TA), (const bf16*)(ws + WS_TB), (unsigned char*)(ws + WS_MRG8), D, args.in[12], args.in[12] + D, 1.0f / (FP8_XS * FP8_WGS), FP8_MS, LnFold{ST0, VEC + V_GW_G, VEC + V_BW_G}};
        gemm_phase<EpiGateMerge8, StaticOrder, true, true>(lds + RING_OFF, g, S, E, wave); }
    SEAM(11);
    if (IN(12)) { Gemm g{(const bf16*)(ws + WS_MRG8), (const bf16*)(ws + WS_W_MO), D / 2, D / 2, D / 2, 0, 0}; StaticOrder S; S.init(M, D, G, bx); EpiRes E{nullptr, X16, D, ALPHA, 1.0f / (FP8_MS * FP8_WMOS), ST0, ln_g, ln_b, ST1, X16, nullptr, 0.f};
        gemm_phase<EpiRes, StaticOrder, true, true>(lds + RING_OFF, g, S, E, wave); }
    SEAM(12);
    if (IN(14)) { Gemm g{X16, (const bf16*)(ws + WS_W_MQ), D, D, D, 0, 0}; StaticOrder S; S.init(M, 512, G, bx); EpiBf16 E{(bf16*)(ws + WS_QM), 512, 0.08838834764831845f * LOG2E, LnFold{ST1, VEC + V_GW_MQ, VEC + V_BW_MQ}}; gemm_phase<EpiBf16, StaticOrder, true>(lds + RING_OFF, g, S, E, wave); }
    SEAM(14);
    if (IN(15)) memattn_mfma(lds, (const bf16*)(ws + WS_QM), (const bf16*)(ws + WS_KVMEM), (bf16*)(ws + WS_OM), vcu, G, wave);
    SEAM(15);
    if (IN(16)) { Gemm g{(const bf16*)(ws + WS_OM), (const bf16*)(ws + WS_W_MOUT), 512, 512, 512, 0, 0}; StaticOrder S; S.init(M, D, G, bx); EpiRes E{nullptr, X16, D, ALPHA, 1.0f, ST1, ln_g + D, ln_b + D, ST2, X16, (unsigned char*)(ws + WS_X8), FP8_XS};
        gemm_phase<EpiRes, StaticOrder, true>(lds + RING_OFF, g, S, E, wave); }
    SEAM(16);
    if (IN(18)) { Gemm g{(const bf16*)(ws + WS_X8), (const bf16*)(ws + WS_W_GU2), D / 2, D / 2, D / 2, 0, 0}; StaticOrder S; S.init(M, 2 * FF, G, bx); EpiSwiGLU8 E{(unsigned char*)HB, FF, 1.0f / (FP8_XS * FP8_WGUS), FP8_HS, LnFold{ST2, VEC + V_GW_GU2, VEC + V_BW_GU2}};
        gemm_phase<EpiSwiGLU8, StaticOrder, true, true>(lds + RING_OFF, g, S, E, wave); }
    SEAM(18);
    if (IN(19)) { Gemm g{HB, (const bf16*)(ws + WS_W_D2), FF / 2, FF / 2, FF / 2, 0, 0}; StaticOrder S; S.init(M, D, G, bx); EpiRes E{nullptr, X16, D, ALPHA, 0.5f / (FP8_HS * FP8_WDS), ST2, ln_g + 2 * D, ln_b + 2 * D, nullptr, X16, nullptr, 0.f};
        gemm_phase<EpiRes, StaticOrder, true, true>(lds + RING_OFF, g, S, E, wave); }
    SEAM(19);
    if (IN(20)) ln_final_phase(X16, out, ln_g + 3 * D, ln_b + 3 * D, gw, NGW, lane);
#undef IN
#undef SEAM
#undef lane
}

extern "C" void kernel_launch(void* const* d_in, const int* in_sizes, int n_in, void* d_out, int out_size, void* d_ws, size_t ws_size, hipStream_t stream) {
    static int grid = 0;
    if (grid == 0) {
        if (n_in != 24 || in_sizes[0] != M * D || out_size != M * D || ws_size < WS_END) { fprintf(stderr, "kernel_launch: unexpected shapes (n_in %d, in0 %d, out %d, ws %zu); nothing launched\n", n_in, n_in > 0 ? in_sizes[0] : -1, out_size, ws_size); grid = -1; return; }
        int dev = 0, cus = 0, per_cu = 0;
        if (hipGetDevice(&dev) != hipSuccess || hipDeviceGetAttribute(&cus, hipDeviceAttributeMultiprocessorCount, dev) != hipSuccess) { grid = -1; return; }
        if (hipFuncSetAttribute((const void*)mk_fwd, hipFuncAttributeMaxDynamicSharedMemorySize, LDS_BYTES) != hipSuccess) { fprintf(stderr, "kernel_launch: hipFuncSetAttribute failed\n"); grid = -1; return; }
        if (hipOccupancyMaxActiveBlocksPerMultiprocessor(&per_cu, (const void*)mk_fwd, NWAVES * 64, LDS_BYTES) != hipSuccess || per_cu < 1)
            fprintf(stderr, "kernel_launch: note: the occupancy query reports %d workgroups per CU\n", per_cu);
        (void)hipGetLastError();
        grid = cus;
    }
    if (grid < 0) return;
    if (hipMemsetAsync((char*)d_ws + WS_CTL, 0, CTL_ZERO_BYTES, stream) != hipSuccess) return;
    Args a{};
    for (int i = 0; i < 24; ++i) a.in[i] = (const float*)d_in[i];
    a.out = (float*)d_out; a.ws = (unsigned char*)d_ws;
#if MK_ONE_LAUNCH
    a.ph_lo = 0; a.ph_hi = N_PHASES;
    hipLaunchKernelGGL(mk_fwd, dim3(grid), dim3(NWAVES * 64), LDS_BYTES, stream, a);
#else
    for (int p = 0; p < N_PHASES; ++p) { a.ph_lo = p; a.ph_hi = p + 1; hipLaunchKernelGGL(mk_fwd, dim3(grid), dim3(NWAVES * 64), LDS_BYTES, stream, a); }
#endif
}
```

```cpp
#include <hip/hip_runtime.h>
#include <cstdio>
#include <cstdint>

#ifndef MK_ONE_LAUNCH
#define MK_ONE_LAUNCH 1
#endif

__device__ __forceinline__ int lane_fresh() { int l = (int)__builtin_amdgcn_mbcnt_hi(~0u, __builtin_amdgcn_mbcnt_lo(~0u, 0u)); asm volatile("" : "+v"(l)); return l; }
__device__ __forceinline__ void glds16(const void* gsrc, unsigned lds_dst) { unsigned keep;
    asm volatile("s_mov_b32 %0, m0\n\ts_mov_b32 m0, %2\n\ts_nop 0\n\tglobal_load_lds_dwordx4 %1, off\n\ts_mov_b32 m0, %0" : "=&s"(keep) : "v"(gsrc), "s"(lds_dst) : "memory"); }
__device__ __forceinline__ void glds16s(const void* sbase, unsigned voff, unsigned lds_dst) { unsigned keep;
    asm volatile("s_mov_b32 %0, m0\n\ts_mov_b32 m0, %3\n\ts_nop 0\n\tglobal_load_lds_dwordx4 %1, %2\n\ts_mov_b32 m0, %0" : "=&s"(keep) : "v"(voff), "s"(sbase), "s"(lds_dst) : "memory"); }
namespace pg8 {
#define PG8_LAS __attribute__((address_space(3)))
typedef unsigned short bf16_t;
typedef short bf16x8 __attribute__((ext_vector_type(8)));
typedef float f32x4 __attribute__((ext_vector_type(4)));
typedef unsigned u32x4 __attribute__((ext_vector_type(4)));
constexpr int BM = 256, BK = 64, HALF = 128, HTB = HALF * BK * 2  , STAGE_BYTES = 8 * HTB, NXCD = 8, WGM = 8;

__host__ __device__ __forceinline__ int lds_byte(int r, int c) { const int st = (r >> 4) * 2 + (c >> 5), rr = r & 15, cc = c & 31, ob = rr * 64 + cc * 2; return st * 1024 + (ob ^ (((ob >> 9) & 1) << 5)); }
__host__ __device__ __forceinline__ void stage_rc(int b, int& R, int& C) { const int st = b / 1024, sb = b % 1024, swz = sb ^ (((sb >> 9) & 1) << 5); R = (st >> 1) * 16 + swz / 64; C = (st & 1) * 32 + (swz % 64) / 2; }
__host__ __device__ __forceinline__ int perm32(int rho) { const int n = rho >> 4, i = rho & 15; return 8 * (i >> 2) + 4 * n + (i & 3); }

struct Unit { int pm, pn; };
struct Gemm { const bf16_t* A; const bf16_t* Bt; int lda, ldb, K, a_shift, a_mul; };

struct StaticOrder {
    int nM, nN, nwg, G, c;
    __host__ __device__ void init(int M, int N, int G_, int c_) { nM = M / BM; nN = N / BM; nwg = nM * nN; G = G_; c = c_; }
    __host__ __device__ bool next(int i, Unit& u) const {
        const long L = (long)i * G + c; if (L >= nwg) return false;
        int wgid = (int)L; { const int q = nwg / NXCD, r = nwg % NXCD, xcd = wgid % NXCD, off = wgid / NXCD; wgid = (xcd < r ? xcd * (q + 1) : r * (q + 1) + (xcd - r) * q) + off; }
        const int nig = WGM * nN, gid = wgid / nig, fm = gid * WGM, gsz = (nM - fm) < WGM ? (nM - fm) : WGM;
        u.pm = fm + ((wgid % nig) % gsz); u.pn = (wgid % nig) / gsz; return true;
    }
    __device__ __forceinline__ void a_ready(const Unit&) const {}
    __device__ __forceinline__ void done(const Unit&) const {}
};

__device__ __forceinline__ unsigned cvt_pk_bf16(float lo, float hi) { unsigned r; asm volatile("v_cvt_pk_bf16_f32 %0, %1, %2" : "=v"(r) : "v"(lo), "v"(hi)); return r; }
__device__ __forceinline__ float bflo(unsigned w) { return __uint_as_float(w << 16); }
__device__ __forceinline__ float bfhi(unsigned w) { return __uint_as_float(w & 0xffff0000u); }
__device__ __forceinline__ float sigmoidf_fast(float x) { return __builtin_amdgcn_rcpf(1.0f + __builtin_amdgcn_exp2f(-1.4426950408889634f * x)); }

struct LnFold {
    const long long* stats; const float* gW; const float* bW;
    __device__ __forceinline__ void row(int r, float& mean, float& rstd) const { const long long s0 = stats[2 * (size_t)r], s1 = stats[2 * (size_t)r + 1];
        mean = (float)s0 * (1.0f / (1048576.f * 2048.0f)); rstd = __builtin_amdgcn_rsqf((float)s1 * (1.0f / (65536.f * 2048.0f)) - mean * mean + 1e-5f); }
    __device__ __forceinline__ f32x4 vec4(const float* v, int i) const { return *(const f32x4*)(v + i); }
    __device__ __forceinline__ void rows8(int row0, float (&mean)[8], float (&rstd)[8]) const {
#pragma unroll
        for (int hf = 0; hf < 2; ++hf) { long long s0[4], s1[4];
#pragma unroll
            for (int q = 0; q < 4; ++q) { const size_t r = (size_t)(row0 + hf * 128 + q * 16); s0[q] = stats[2 * r]; s1[q] = stats[2 * r + 1]; }
#pragma unroll
            for (int q = 0; q < 4; ++q) { const float mu = (float)s0[q] * (1.0f / (1048576.f * 2048.0f)); mean[4 * hf + q] = mu; rstd[4 * hf + q] = __builtin_amdgcn_rsqf((float)s1[q] * (1.0f / (65536.f * 2048.0f)) - mu * mu + 1e-5f); }
            asm volatile("" : "+v"(mean[4 * hf]), "+v"(mean[4 * hf + 1]), "+v"(mean[4 * hf + 2]), "+v"(mean[4 * hf + 3]), "+v"(rstd[4 * hf]), "+v"(rstd[4 * hf + 1]), "+v"(rstd[4 * hf + 2]), "+v"(rstd[4 * hf + 3]) :: "memory"); }
    }
};
struct EpiBf16 {
    static constexpr bool PERM = true, AFTER_DRAIN = false;
    bf16_t* O; int ldc; float sc = 1.0f; LnFold lf = {nullptr, nullptr, nullptr};
    __device__ __forceinline__ void operator()(const f32x4 (&acc)[2][2][4][2], const Unit& u, int wr, int wc, int fr, int fq) const {
        const int row0 = u.pm * BM + wr * 64 + fr, col0 = u.pn * BM + wc * 32 + 8 * fq;
        f32x4 gw[2][2], bw[2][2];
#pragma unroll
        for (int bj = 0; bj < 2; ++bj)
#pragma unroll
            for (int n = 0; n < 2; ++n) { gw[bj][n] = (f32x4){0.f, 0.f, 0.f, 0.f}; bw[bj][n] = (f32x4){0.f, 0.f, 0.f, 0.f}; if (lf.stats) { gw[bj][n] = lf.vec4(lf.gW, col0 + bj * HALF + 4 * n); bw[bj][n] = lf.vec4(lf.bW, col0 + bj * HALF + 4 * n); } }
        float mean8[8], rstd8[8];
#pragma unroll
        for (int q = 0; q < 8; ++q) { mean8[q] = 0.f; rstd8[q] = 1.f; }
        if (lf.stats) lf.rows8(row0, mean8, rstd8);
#pragma unroll
        for (int ai = 0; ai < 2; ++ai)
#pragma unroll
            for (int m = 0; m < 4; ++m) { bf16_t* rowp = O + (size_t)(row0 + ai * HALF + m * 16) * ldc + col0;
                const float mean = mean8[ai * 4 + m], rstd = rstd8[ai * 4 + m];
#pragma unroll
                for (int bj = 0; bj < 2; ++bj) { const f32x4 v0 = ((acc[ai][bj][m][0] - gw[bj][0] * mean) * rstd + bw[bj][0]) * sc, v1 = ((acc[ai][bj][m][1] - gw[bj][1] * mean) * rstd + bw[bj][1]) * sc;
                    u32x4 w; w.x = cvt_pk_bf16(v0[0], v0[1]); w.y = cvt_pk_bf16(v0[2], v0[3]); w.z = cvt_pk_bf16(v1[0], v1[1]); w.w = cvt_pk_bf16(v1[2], v1[3]);
                    *(u32x4*)(rowp + bj * HALF) = w; } }
    }
};
struct EpiInProj {
    static constexpr bool PERM = true, AFTER_DRAIN = false;
    bf16_t *aq, *ak, *av, *bq, *bc, *iq, *ikw; float qscale; LnFold lf; unsigned* kmax;
    __device__ __forceinline__ void operator()(const f32x4 (&acc)[2][2][4][2], const Unit& u, int wr, int wc, int fr, int fq) const {
        bf16_t* base; int ldc, colt; const int pn = u.pn;
        if (pn < 4) { base = aq; ldc = 1024; colt = pn * 256; }
        else if (pn < 8) { base = ak; ldc = 1024; colt = (pn - 4) * 256; }
        else if (pn < 12) { base = av; ldc = 1024; colt = (pn - 8) * 256; }
        else if (pn < 16) { base = bq; ldc = 1024; colt = (pn - 12) * 256; }
        else if (pn < 18) { base = bc; ldc = 512; colt = (pn - 16) * 256; }
        else if (pn < 22) { base = iq; ldc = 1024; colt = (pn - 18) * 256; }
        else { base = ikw; ldc = 256; colt = 0; }
        const float sc = (pn < 4) ? qscale : 1.0f; float kam[2] = {0.f, 0.f};
        const int row0 = u.pm * BM + wr * 64 + fr, col0 = colt + wc * 32 + 8 * fq, cidx = pn * BM + wc * 32 + 8 * fq;
        f32x4 gw[2][2], bw[2][2];
#pragma unroll
        for (int bj = 0; bj < 2; ++bj)
#pragma unroll
            for (int n = 0; n < 2; ++n) { gw[bj][n] = lf.vec4(lf.gW, cidx + bj * HALF + 4 * n); bw[bj][n] = lf.vec4(lf.bW, cidx + bj * HALF + 4 * n); }
        float mean8[8], rstd8[8]; lf.rows8(row0, mean8, rstd8);
#pragma unroll
        for (int ai = 0; ai < 2; ++ai)
#pragma unroll
            for (int m = 0; m < 4; ++m) { bf16_t* rowp = base + (size_t)(row0 + ai * HALF + m * 16) * ldc + col0;
                const float mean = mean8[ai * 4 + m], rstd = rstd8[ai * 4 + m];
#pragma unroll
                for (int bj = 0; bj < 2; ++bj) { const f32x4 v0 = ((acc[ai][bj][m][0] - gw[bj][0] * mean) * rstd + bw[bj][0]) * sc, v1 = ((acc[ai][bj][m][1] - gw[bj][1] * mean) * rstd + bw[bj][1]) * sc;
                    kam[bj] = fmaxf(kam[bj], fmaxf(fmaxf(fmaxf(fabsf(v0[0]), fabsf(v0[1])), fmaxf(fabsf(v0[2]), fabsf(v0[3]))), fmaxf(fmaxf(fabsf(v1[0]), fabsf(v1[1])), fmaxf(fabsf(v1[2]), fabsf(v1[3])))));
                    u32x4 w; w.x = cvt_pk_bf16(v0[0], v0[1]); w.y = cvt_pk_bf16(v0[2], v0[3]); w.z = cvt_pk_bf16(v1[0], v1[1]); w.w = cvt_pk_bf16(v1[2], v1[3]);
                    *(u32x4*)(rowp + bj * HALF) = w; } }
        if (pn >= 4 && pn < 8) {
#pragma unroll
            for (int bj = 0; bj < 2; ++bj) { float v = kam[bj];
#pragma unroll
                for (int o = 1; o < 64; o <<= 1) v = fmaxf(v, __shfl_xor(v, o));
                if ((fr | fq) == 0) (void)__hip_atomic_fetch_max(kmax + ((u.pm >> 4) * 8 + 2 * (pn - 4) + bj) * 2 + (wc >> 1), __float_as_uint(v), __ATOMIC_RELAXED, __HIP_MEMORY_SCOPE_AGENT); } }
    }
};
struct EpiSwiGLU {
    static constexpr bool PERM = true, AFTER_DRAIN = false;
    bf16_t* O; int ldc;
    __device__ __forceinline__ void operator()(const f32x4 (&acc)[2][2][4][2], const Unit& u, int wr, int wc, int fr, int fq) const {
        const int row0 = u.pm * BM + wr * 64 + fr, col0 = u.pn * HALF + wc * 32 + 8 * fq;
#pragma unroll
        for (int ai = 0; ai < 2; ++ai)
#pragma unroll
            for (int m = 0; m < 4; ++m) { bf16_t* rowp = O + (size_t)(row0 + ai * HALF + m * 16) * ldc + col0;
                float h[8];
#pragma unroll
                for (int n = 0; n < 2; ++n)
#pragma unroll
                    for (int j = 0; j < 4; ++j) { const float g = acc[ai][0][m][n][j], up = acc[ai][1][m][n][j]; h[4 * n + j] = g * sigmoidf_fast(g) * up; }
                u32x4 w; w.x = cvt_pk_bf16(h[0], h[1]); w.y = cvt_pk_bf16(h[2], h[3]); w.z = cvt_pk_bf16(h[4], h[5]); w.w = cvt_pk_bf16(h[6], h[7]);
                *(u32x4*)rowp = w; }
    }
};
__device__ __forceinline__ unsigned pk4_fp8(float a, float b, float c, float d) { int w = 0; w = __builtin_amdgcn_cvt_pk_fp8_f32(a, b, w, false); w = __builtin_amdgcn_cvt_pk_fp8_f32(c, d, w, true); return (unsigned)w; }
struct EpiSwiGLU8 {
    static constexpr bool PERM = true, AFTER_DRAIN = false;
    unsigned char* O; int ldc; float ascale, hs; LnFold lf;
    __device__ __forceinline__ void operator()(const f32x4 (&acc)[2][2][4][2], const Unit& u, int wr, int wc, int fr, int fq) const {
        const int row0 = u.pm * BM + wr * 64 + fr, col0 = u.pn * HALF + wc * 32 + 8 * fq, cidx = u.pn * BM + wc * 32 + 8 * fq;
        typedef unsigned u32x2 __attribute__((ext_vector_type(2)));
        f32x4 gw[2][2], bw[2][2];
#pragma unroll
        for (int bj = 0; bj < 2; ++bj)
#pragma unroll
            for (int n = 0; n < 2; ++n) { gw[bj][n] = (f32x4){0.f, 0.f, 0.f, 0.f}; bw[bj][n] = (f32x4){0.f, 0.f, 0.f, 0.f}; if (lf.stats) { gw[bj][n] = lf.vec4(lf.gW, cidx + bj * HALF + 4 * n); bw[bj][n] = lf.vec4(lf.bW, cidx + bj * HALF + 4 * n); } }
        float mean8[8], rstd8[8];
#pragma unroll
        for (int q = 0; q < 8; ++q) { mean8[q] = 0.f; rstd8[q] = 1.f; }
        if (lf.stats) lf.rows8(row0, mean8, rstd8);
#pragma unroll
        for (int ai = 0; ai < 2; ++ai)
#pragma unroll
            for (int m = 0; m < 4; ++m) { unsigned char* rowp = O + (size_t)(row0 + ai * HALF + m * 16) * ldc + col0;
                float h[8]; const float mean = mean8[ai * 4 + m], rstd = rstd8[ai * 4 + m];
#pragma unroll
                for (int n = 0; n < 2; ++n)
#pragma unroll
                    for (int j = 0; j < 4; ++j) { const float g = (acc[ai][0][m][n][j] * ascale - gw[0][n][j] * mean) * rstd + bw[0][n][j], up = (acc[ai][1][m][n][j] * ascale - gw[1][n][j] * mean) * rstd + bw[1][n][j];
                        h[4 * n + j] = fminf(fmaxf(g * sigmoidf_fast(g) * up * hs, -448.f), 448.f); }
                *(u32x2*)rowp = (u32x2){pk4_fp8(h[0], h[1], h[2], h[3]), pk4_fp8(h[4], h[5], h[6], h[7])}; }
    }
};
struct EpiGateMerge {
    static constexpr bool PERM = true, AFTER_DRAIN = false;
    const bf16_t* ta; const bf16_t* tb; bf16_t* O; int ldc; const float* b0; const float* b1;
    __device__ __forceinline__ void operator()(const f32x4 (&acc)[2][2][4][2], const Unit& u, int wr, int wc, int fr, int fq) const {
        const int row0 = u.pm * BM + wr * 64 + fr, col0 = u.pn * HALF + wc * 32 + 8 * fq;
        float bb0[8], bb1[8];
#pragma unroll
        for (int j = 0; j < 8; ++j) { bb0[j] = b0[col0 + j]; bb1[j] = b1[col0 + j]; }
#pragma unroll
        for (int ai = 0; ai < 2; ++ai)
#pragma unroll
            for (int m = 0; m < 4; ++m) { const size_t off = (size_t)(row0 + ai * HALF + m * 16) * ldc + col0;
                const u32x4 a = *(const u32x4*)(ta + off), b = *(const u32x4*)(tb + off);
                const float av[8] = {bflo(a.x), bfhi(a.x), bflo(a.y), bfhi(a.y), bflo(a.z), bfhi(a.z), bflo(a.w), bfhi(a.w)};
                const float bv[8] = {bflo(b.x), bfhi(b.x), bflo(b.y), bfhi(b.y), bflo(b.z), bfhi(b.z), bflo(b.w), bfhi(b.w)};
                float h[8];
#pragma unroll
                for (int n = 0; n < 2; ++n)
#pragma unroll
                    for (int j = 0; j < 4; ++j) { const int e = 4 * n + j; h[e] = sigmoidf_fast(acc[ai][0][m][n][j] + bb0[e]) * av[e] + sigmoidf_fast(acc[ai][1][m][n][j] + bb1[e]) * bv[e]; }
                u32x4 w; w.x = cvt_pk_bf16(h[0], h[1]); w.y = cvt_pk_bf16(h[2], h[3]); w.z = cvt_pk_bf16(h[4], h[5]); w.w = cvt_pk_bf16(h[6], h[7]);
                *(u32x4*)(O + off) = w; }
    }
};
struct EpiGateMerge8 {
    static constexpr bool PERM = true, AFTER_DRAIN = false;
    const bf16_t* ta; const bf16_t* tb; unsigned char* O; int ldc; const float* b0; const float* b1; float ascale, ms; LnFold lf;
    __device__ __forceinline__ void operator()(const f32x4 (&acc)[2][2][4][2], const Unit& u, int wr, int wc, int fr, int fq) const {
        const int row0 = u.pm * BM + wr * 64 + fr, col0 = u.pn * HALF + wc * 32 + 8 * fq, cidx = u.pn * BM + wc * 32 + 8 * fq;
        typedef unsigned u32x2 __attribute__((ext_vector_type(2)));
        float mean8[8], rstd8[8]; lf.rows8(row0, mean8, rstd8);
        float bb0[8], bb1[8], gw0[8], gw1[8];
#pragma unroll
        for (int j = 0; j < 8; ++j) { bb0[j] = b0[col0 + j] + lf.bW[cidx + j]; bb1[j] = b1[col0 + j] + lf.bW[cidx + HALF + j]; gw0[j] = lf.gW[cidx + j]; gw1[j] = lf.gW[cidx + HALF + j]; }
#pragma unroll
        for (int am = 0; am < 8; am += 2) {
            u32x4 pa[2], pb[2];
#pragma unroll
            for (int e2 = 0; e2 < 2; ++e2) { const size_t off = (size_t)(row0 + ((am + e2) >> 2) * HALF + ((am + e2) & 3) * 16) * ldc + col0; pa[e2] = *(const u32x4*)(ta + off); pb[e2] = *(const u32x4*)(tb + off); }
#pragma unroll
            for (int e2 = 0; e2 < 2; ++e2) { const int ai = (am + e2) >> 2, m = (am + e2) & 3; const size_t off = (size_t)(row0 + ai * HALF + m * 16) * ldc + col0;
                const u32x4 a = pa[e2], b = pb[e2];
                const float av[8] = {bflo(a.x), bfhi(a.x), bflo(a.y), bfhi(a.y), bflo(a.z), bfhi(a.z), bflo(a.w), bfhi(a.w)};
                const float bv[8] = {bflo(b.x), bfhi(b.x), bflo(b.y), bfhi(b.y), bflo(b.z), bfhi(b.z), bflo(b.w), bfhi(b.w)};
                float h[8]; const float mean = mean8[ai * 4 + m], rstd = rstd8[ai * 4 + m];
#pragma unroll
                for (int n = 0; n < 2; ++n)
#pragma unroll
                    for (int j = 0; j < 4; ++j) { const int e = 4 * n + j; const float v = sigmoidf_fast((acc[ai][0][m][n][j] * ascale - gw0[e] * mean) * rstd + bb0[e]) * av[e] + sigmoidf_fast((acc[ai][1][m][n][j] * ascale - gw1[e] * mean) * rstd + bb1[e]) * bv[e];
                        h[e] = fminf(fmaxf(v * ms, -448.f), 448.f); }
                *(u32x2*)(O + off) = (u32x2){pk4_fp8(h[0], h[1], h[2], h[3]), pk4_fp8(h[4], h[5], h[6], h[7])}; }
            asm volatile("" ::: "memory"); }
    }
};
template <bool RES32, int NB = 2> struct EpiRes {
    static constexpr bool PERM = true, AFTER_DRAIN = false;
    const float* res32; const bf16_t* res16; int ldc; float alpha, s;
    const long long* rstats; const float* rg; const float* rb; long long* ostats; bf16_t* o16; unsigned char* o8; float o8s;
    __device__ __forceinline__ void operator()(const f32x4 (&acc)[2][2][4][2], const Unit& u, int wr, int wc, int fr, int fq) const {
        const int col0 = u.pn * BM + wc * 32 + 8 * fq;
        typedef unsigned u32x2 __attribute__((ext_vector_type(2)));
        float al = alpha, sa = s; asm volatile("" : "+v"(al), "+v"(sa));
        const int rowb = u.pm * BM + wr * 64 + fr;
        float mean8[8], rstd8[8];
#pragma unroll
        for (int q = 0; q < 8; ++q) { mean8[q] = 0.f; rstd8[q] = 1.f; }
        if (rstats) { LnFold lf{rstats, nullptr, nullptr}; lf.rows8(rowb, mean8, rstd8); }
        asm volatile("" : "+v"(mean8[0]), "+v"(mean8[1]), "+v"(mean8[2]), "+v"(mean8[3]), "+v"(mean8[4]), "+v"(mean8[5]), "+v"(mean8[6]), "+v"(mean8[7]), "+v"(rstd8[0]), "+v"(rstd8[1]), "+v"(rstd8[2]), "+v"(rstd8[3]), "+v"(rstd8[4]), "+v"(rstd8[5]), "+v"(rstd8[6]), "+v"(rstd8[7]) :: "memory");
        f32x4 gv[2][2], bv[2][2];
#pragma unroll
        for (int bj = 0; bj < 2; ++bj)
#pragma unroll
            for (int n = 0; n < 2; ++n) { gv[bj][n] = (f32x4){1.f, 1.f, 1.f, 1.f}; bv[bj][n] = (f32x4){0.f, 0.f, 0.f, 0.f};
                if (rstats) { gv[bj][n] = *(const f32x4*)(rg + col0 + bj * HALF + 4 * n); bv[bj][n] = *(const f32x4*)(rb + col0 + bj * HALF + 4 * n); }
                gv[bj][n] = gv[bj][n] * al; bv[bj][n] = bv[bj][n] * al; }
#pragma unroll
        for (int am = 0; am < 8; am += NB) {
            f32x4 rr[RES32 ? NB : 1][2][2]; u32x4 rw[NB][2];
#pragma unroll
            for (int e2 = 0; e2 < NB; ++e2) { const size_t off = (size_t)(rowb + ((am + e2) >> 2) * HALF + ((am + e2) & 3) * 16) * ldc + col0;
#pragma unroll
                for (int bj = 0; bj < 2; ++bj) {
                    if constexpr (RES32) { rr[e2][bj][0] = *(const f32x4*)(res32 + off + bj * HALF); rr[e2][bj][1] = *(const f32x4*)(res32 + off + bj * HALF + 4); }
                    else rw[e2][bj] = *(const u32x4*)(res16 + off + bj * HALF); } }
#pragma unroll
            for (int e2 = 0; e2 < NB; ++e2) { const int ai = (am + e2) >> 2, m = (am + e2) & 3; const int row = rowb + ai * HALF + m * 16; const size_t off = (size_t)row * ldc + col0;
                const float mean = mean8[am + e2], rstd = rstd8[am + e2];
                float ps = 0.f, pq = 0.f;
#pragma unroll
                for (int bj = 0; bj < 2; ++bj) {
                    f32x4 r0, r1;
                    if constexpr (RES32) { r0 = rr[e2][bj][0]; r1 = rr[e2][bj][1]; } else { const u32x4 w = rw[e2][bj]; r0 = (f32x4){bflo(w.x), bfhi(w.x), bflo(w.y), bfhi(w.y)}; r1 = (f32x4){bflo(w.z), bfhi(w.z), bflo(w.w), bfhi(w.w)}; }
                    const f32x4 z0 = (r0 - mean) * rstd * gv[bj][0] + bv[bj][0] + acc[ai][bj][m][0] * sa, z1 = (r1 - mean) * rstd * gv[bj][1] + bv[bj][1] + acc[ai][bj][m][1] * sa;
                    u32x4 w16; w16.x = cvt_pk_bf16(z0[0], z0[1]); w16.y = cvt_pk_bf16(z0[2], z0[3]); w16.z = cvt_pk_bf16(z1[0], z1[1]); w16.w = cvt_pk_bf16(z1[2], z1[3]);
                    *(u32x4*)(o16 + off + bj * HALF) = w16;
                    const float q0 = bflo(w16.x), q1 = bfhi(w16.x), q2 = bflo(w16.y), q3 = bfhi(w16.y), q4 = bflo(w16.z), q5 = bfhi(w16.z), q6 = bflo(w16.w), q7 = bfhi(w16.w);
                    ps += ((q0 + q1) + (q2 + q3)) + ((q4 + q5) + (q6 + q7)); pq += ((q0 * q0 + q1 * q1) + (q2 * q2 + q3 * q3)) + ((q4 * q4 + q5 * q5) + (q6 * q6 + q7 * q7));
                    if (o8) *(u32x2*)(o8 + off + bj * HALF) = (u32x2){pk4_fp8(fminf(fmaxf(q0 * o8s, -448.f), 448.f), fminf(fmaxf(q1 * o8s, -448.f), 448.f), fminf(fmaxf(q2 * o8s, -448.f), 448.f), fminf(fmaxf(q3 * o8s, -448.f), 448.f)),
                                                                      pk4_fp8(fminf(fmaxf(q4 * o8s, -448.f), 448.f), fminf(fmaxf(q5 * o8s, -448.f), 448.f), fminf(fmaxf(q6 * o8s, -448.f), 448.f), fminf(fmaxf(q7 * o8s, -448.f), 448.f))}; }
                if (ostats) { ps += __shfl_xor(ps, 16); ps += __shfl_xor(ps, 32); pq += __shfl_xor(pq, 16); pq += __shfl_xor(pq, 32);
                    if (fq == 0) { (void)__hip_atomic_fetch_add(ostats + 2 * (size_t)row, (long long)__builtin_rintf(ps * 1048576.f), __ATOMIC_RELAXED, __HIP_MEMORY_SCOPE_AGENT); (void)__hip_atomic_fetch_add(ostats + 2 * (size_t)row + 1, (long long)__builtin_rintf(pq * 65536.f), __ATOMIC_RELAXED, __HIP_MEMORY_SCOPE_AGENT); } } }
            asm volatile("" ::: "memory"); }
    }
};

typedef int v8i_t __attribute__((ext_vector_type(8)));
typedef int v4i_t __attribute__((ext_vector_type(4)));
template <class Epi, class Sched, bool ALIGN_EPI, bool FP8 = false>
__device__ __forceinline__ void gemm_phase(PG8_LAS unsigned char* lds, const Gemm g, const Sched& S, const Epi& E, const int wid) {
    const int lane = lane_fresh(), tid = wid * 64 + lane, wr = wid >> 2, wc = wid & 3, fr = lane & 15, fq = lane >> 4;
    const int K = g.K, nt = K / BK;
    unsigned voffA[2], voffB[2];
#pragma unroll
    for (int i = 0; i < 2; ++i) { int R, C; stage_rc(tid * 16 + i * 8192, R, C); const int Rb = Epi::PERM ? ((R & ~31) + perm32(R & 31)) : R;
        voffA[i] = (unsigned)(R * g.lda + C) * 2u; voffB[i] = (unsigned)(Rb * g.ldb + C) * 2u; }
    const size_t kstep = (size_t)(BK * 2);
    const size_t hstepA = (size_t)HALF * g.lda * 2, hstepB = (size_t)HALF * g.ldb * 2;
    const size_t tstepA = 2 * hstepA, tstepB = 2 * hstepB;
    const unsigned ldsw = (unsigned)wid * 1024u;
    const int aoff = lds_byte(wr * 64 + fr, fq * 8), boff = lds_byte(wc * 32 + fr, fq * 8);
#define PG8_UA(u) ((const char*)g.A + (size_t)(u).pm * tstepA + (size_t)(((u).pn >> g.a_shift) * g.a_mul) * 2)
#define PG8_UB(u) ((const char*)g.Bt + (size_t)(u).pn * tstepB)
#define PG8_SA(b, h) (((b) * 2 + (h)) * HTB)
#define PG8_SB(b, h) ((4 + (b) * 2 + (h)) * HTB)
#define PG8_STAGE(bufoff, gbase, voff) do { _Pragma("unroll") for (int _i = 0; _i < 2; ++_i) \
        __builtin_amdgcn_global_load_lds((const unsigned*)((const char*)(gbase) + (voff)[_i]), (PG8_LAS unsigned*)(lds + (bufoff) + ldsw + _i * 8192), 16, 0, 0); } while (0)
#define PG8_LD8(p_) __builtin_shufflevector(*(const PG8_LAS v4i_t*)(p_), *(const PG8_LAS v4i_t*)((p_) + 1024), 0, 1, 2, 3, 4, 5, 6, 7)
#define PG8_LDA(dst, b, h) do { _Pragma("unroll") for (int m = 0; m < 4; ++m) { if constexpr (FP8) dst##8[m] = PG8_LD8(lds + PG8_SA(b, h) + aoff + m * 2048); else { _Pragma("unroll") for (int k = 0; k < 2; ++k) dst[m][k] = *(const PG8_LAS bf16x8*)(lds + PG8_SA(b, h) + aoff + m * 2048 + k * 1024); } } } while (0)
#define PG8_LDB(dst, b, h) do { _Pragma("unroll") for (int n = 0; n < 2; ++n) { if constexpr (FP8) dst##8[n] = PG8_LD8(lds + PG8_SB(b, h) + boff + n * 2048); else { _Pragma("unroll") for (int k = 0; k < 2; ++k) dst[n][k] = *(const PG8_LAS bf16x8*)(lds + PG8_SB(b, h) + boff + n * 2048 + k * 1024); } } } while (0)
#define PG8_MMA(ai, bj, At, Bt) do { __builtin_amdgcn_s_setprio(1); _Pragma("unroll") for (int m = 0; m < 4; ++m) _Pragma("unroll") for (int n = 0; n < 2; ++n) { \
        if constexpr (FP8) asm volatile("v_mfma_scale_f32_16x16x128_f8f6f4 %0, %1, %2, %0, %3, %3 op_sel_hi:[0,0,0]" : "+v"(acc[ai][bj][m][n]) : "v"(Bt##8[n]), "v"(At##8[m]), "v"(one_scale)); \
        else { _Pragma("unroll") for (int k = 0; k < 2; ++k) acc[ai][bj][m][n] = __builtin_amdgcn_mfma_f32_16x16x32_bf16(Bt[n][k], At[m][k], acc[ai][bj][m][n], 0, 0, 0); } } \
        __builtin_amdgcn_s_setprio(0); } while (0)
#define PG8_WAIT_V(n) asm volatile("s_waitcnt vmcnt(" #n ")" ::: "memory")
#define PG8_WAIT_L(n) asm volatile("s_waitcnt lgkmcnt(" #n ")" ::: "memory")
#define PG8_BAR __builtin_amdgcn_s_barrier()
#define PG8_SCHED __builtin_amdgcn_sched_barrier(0)
    Unit cur, nxt; int ui = 0;
    if (!S.next(0, cur)) return;
    f32x4 acc[2][2][4][2];
#pragma unroll
    for (int a = 0; a < 2; ++a)
#pragma unroll
        for (int b = 0; b < 2; ++b)
#pragma unroll
            for (int m = 0; m < 4; ++m)
#pragma unroll
                for (int n = 0; n < 2; ++n) acc[a][b][m][n] = (f32x4){0.f, 0.f, 0.f, 0.f};
    bf16x8 At[4][2], B0[2][2], B1[2][2]; v8i_t At8[4], B08[2], B18[2];
    int one_scale = 0x7f7f7f7f; asm volatile("" : "+v"(one_scale));
    const char* cA = PG8_UA(cur); const char* cB = PG8_UB(cur);
    S.a_ready(cur);
    PG8_STAGE(PG8_SB(0, 0), cB, voffB); PG8_STAGE(PG8_SB(0, 1), cB + hstepB, voffB); PG8_STAGE(PG8_SA(0, 0), cA, voffA); PG8_STAGE(PG8_SA(0, 1), cA + hstepA, voffA);
    if (wr == 1) PG8_BAR;
    PG8_WAIT_V(2); PG8_BAR;
    PG8_STAGE(PG8_SB(1, 0), cB + kstep, voffB); PG8_STAGE(PG8_SA(1, 0), cA + kstep, voffA); PG8_STAGE(PG8_SB(1, 1), cB + hstepB + kstep, voffB);
    PG8_WAIT_V(6); PG8_BAR;
    for (;;) {
        const bool has_next = S.next(ui + 1, nxt);
        const char* nA = has_next ? PG8_UA(nxt) : cA; const char* nB = has_next ? PG8_UB(nxt) : cB;
        for (int t = 0; t < nt; t += 2) {
            const bool last = (t == nt - 2);
            const char* a1 = cA + (size_t)(t + 1) * kstep;
            const char* a2 = last ? nA : cA + (size_t)(t + 2) * kstep; const char* b2 = last ? nB : cB + (size_t)(t + 2) * kstep;
            const char* a3 = a2 + kstep; const char* b3 = b2 + kstep;
            if (last && has_next) S.a_ready(nxt);
            PG8_LDB(B0, 0, 0); PG8_LDB(B1, 0, 1); PG8_SCHED; PG8_LDA(At, 0, 0); PG8_STAGE(PG8_SA(1, 1), a1 + hstepA, voffA);
            PG8_WAIT_V(8); PG8_WAIT_L(0); PG8_BAR; PG8_MMA(0, 0, At, B0); PG8_MMA(0, 1, At, B1); PG8_BAR; PG8_SCHED;
            PG8_LDA(At, 0, 1); PG8_STAGE(PG8_SB(0, 0), b2, voffB); PG8_STAGE(PG8_SB(0, 1), b2 + hstepB, voffB); PG8_STAGE(PG8_SA(0, 0), a2, voffA);
            PG8_WAIT_V(8); PG8_WAIT_L(0); PG8_BAR; PG8_MMA(1, 0, At, B0); PG8_MMA(1, 1, At, B1); PG8_BAR; PG8_SCHED;
            PG8_LDB(B0, 1, 0); PG8_LDB(B1, 1, 1); PG8_SCHED; PG8_LDA(At, 1, 0); PG8_STAGE(PG8_SA(0, 1), a2 + hstepA, voffA);
            PG8_WAIT_V(8); PG8_WAIT_L(0); PG8_BAR; PG8_MMA(0, 0, At, B0); PG8_MMA(0, 1, At, B1); PG8_BAR; PG8_SCHED;
            PG8_LDA(At, 1, 1); PG8_STAGE(PG8_SB(1, 0), b3, voffB); PG8_STAGE(PG8_SB(1, 1), b3 + hstepB, voffB); PG8_STAGE(PG8_SA(1, 0), a3, voffA);
            PG8_WAIT_V(8); PG8_WAIT_L(0); PG8_BAR; PG8_MMA(1, 0, At, B0); PG8_MMA(1, 1, At, B1); PG8_BAR; PG8_SCHED;
        }
        if constexpr (ALIGN_EPI) { if (wr == 0) PG8_BAR; }
        if constexpr (FP8) asm volatile("s_nop 15\n\ts_nop 7" ::: "memory");
        { const int le = lane_fresh(); E(acc, cur, wr, wc, le & 15, le >> 4); } S.done(cur);
        if (!has_next) break;
#pragma unroll
        for (int a = 0; a < 2; ++a)
#pragma unroll
            for (int b = 0; b < 2; ++b)
#pragma unroll
                for (int m = 0; m < 4; ++m)
#pragma unroll
                    for (int n = 0; n < 2; ++n) acc[a][b][m][n] = (f32x4){0.f, 0.f, 0.f, 0.f};
        cur = nxt; cA = nA; cB = nB; ++ui;
        if constexpr (ALIGN_EPI) { if (wr == 1) PG8_BAR; }
    }
    PG8_WAIT_V(0);
    if constexpr (!ALIGN_EPI) { if (wr == 0) PG8_BAR; }
    PG8_BAR;
#undef PG8_UA
#undef PG8_UB
#undef PG8_SA
#undef PG8_SB
#undef PG8_STAGE
#undef PG8_LDA
#undef PG8_LDB
#undef PG8_MMA
#undef PG8_LD8
#undef PG8_WAIT_V
#undef PG8_WAIT_L
#undef PG8_BAR
#undef PG8_SCHED
}
}

constexpr int NWAVES = 8;
constexpr int BATCH = 4, SEQ = 4096, D = 2048, FF = 5632, M = BATCH * SEQ;
constexpr int N_IN = 5888;
constexpr int MEMT = 256;
constexpr float LN_EPS = 1e-5f;
constexpr float ALPHA = 1.189207115002721f;
constexpr float LAMBDA_INIT = 0.2f;

constexpr size_t MiB = 1u << 20;
constexpr size_t WS_CTL = 0, CTL_ZERO_BYTES = 2 * MiB;
constexpr size_t WS_W_IN = 2 * MiB;
constexpr size_t WS_W_G = 25 * MiB;
constexpr size_t WS_W_UK = 41 * MiB;
constexpr size_t WS_W_UVP = 42 * MiB;
constexpr size_t WS_W_A = 44 * MiB;
constexpr size_t WS_W_B = 48 * MiB;
constexpr size_t WS_W_MO = 52 * MiB;
constexpr size_t WS_W_MQ = 60 * MiB;
constexpr size_t WS_W_MKV = 62 * MiB;
constexpr size_t WS_W_MOUT = 66 * MiB;
constexpr size_t WS_MEM16 = 68 * MiB;
constexpr size_t WS_KVMEM = 72 * MiB;
constexpr size_t WS_W_GU2 = 74 * MiB;
constexpr size_t WS_W_D2 = 96 * MiB;
constexpr size_t WS_X8M = 107 * MiB;
constexpr size_t WS_X16 = 140 * MiB;
constexpr size_t WS_MIX = 204 * MiB;
constexpr size_t WS_W_GU1 = 204 * MiB;
constexpr size_t WS_W_D1 = 248 * MiB;
constexpr size_t WS_H = 270 * MiB;
constexpr size_t WS_AQ = WS_MIX + 0 * MiB, WS_AK = WS_MIX + 32 * MiB, WS_AV = WS_MIX + 64 * MiB, WS_BQ = WS_MIX + 96 * MiB;
constexpr size_t WS_BC = WS_MIX + 128 * MiB;
constexpr size_t WS_IQ = WS_MIX + 144 * MiB;
constexpr size_t WS_IKW = WS_MIX + 176 * MiB;
constexpr size_t WS_QLAT = WS_MIX + 184 * MiB;
constexpr size_t WS_IDX = WS_MIX + 312 * MiB;
constexpr size_t WS_YB = WS_BQ;
constexpr size_t WS_TA = WS_QLAT, WS_TB = WS_QLAT + 64 * MiB;
constexpr size_t WS_QM = WS_AQ, WS_OM = WS_AQ + 16 * MiB;
constexpr size_t WS_X8 = WS_H + 96 * MiB;
constexpr size_t WS_C8 = WS_W_IN;
constexpr size_t WS_MRG8 = WS_AV;
constexpr float FP8_WGS = 1024.f, FP8_MS = 32.f, FP8_WMOS = 2048.f;
constexpr float FP8_XS = 32.f, FP8_WGUS = 1024.f, FP8_HS = 8.f, FP8_WDS = 4096.f;
constexpr size_t WS_END = WS_MIX + 320 * MiB;
static_assert(WS_H + (size_t)M * FF * 2 <= WS_END && WS_QLAT + (size_t)M * 4096 * 2 <= WS_END, "d_ws map");
constexpr int CW_BAR = 4096;
constexpr int CW_DQ = 8192;
constexpr int CW_KMAX = 8256;
constexpr size_t CTL_STATS = 65536, CTL_STATS_STRIDE = (size_t)M * 2 * 8;
constexpr size_t CTL_VEC = CTL_STATS + 3 * CTL_STATS_STRIDE;
constexpr int V_GW_IN = 0, V_BW_IN = 5888, V_GW_G = 11776, V_BW_G = 15872, V_GW_MQ = 19968, V_BW_MQ = 20480, V_GW_GU2 = 20992, V_BW_GU2 = 32256, V_END = 43520;
constexpr size_t CTL_VECF = CTL_VEC + (size_t)V_END * 8;
static_assert(CTL_VECF + (size_t)V_END * 4 <= CTL_ZERO_BYTES, "control region");
constexpr float FX_S = 1048576.f, FX_Q = 65536.f, FX_V = 16777216.f;

constexpr int RING_OFF = 0, RING_BYTES = 153600;
constexpr int LDSCTL_OFF = RING_BYTES, MISC_OFF = LDSCTL_OFF + 320;
constexpr int LDS_BYTES = 154624;
static_assert(MISC_OFF + 128 <= LDS_BYTES, "LDS map");

#define GAS __attribute__((address_space(1)))
#define LAS __attribute__((address_space(3)))
typedef unsigned short bf16;
typedef unsigned v4u __attribute__((ext_vector_type(4)));
typedef unsigned v2u __attribute__((ext_vector_type(2)));
typedef float f32x4 __attribute__((ext_vector_type(4)));
typedef float f32x16 __attribute__((ext_vector_type(16)));
typedef short bf16x8 __attribute__((ext_vector_type(8)));
typedef GAS unsigned gu32;
#define RLX_AGENT __ATOMIC_RELAXED, __HIP_MEMORY_SCOPE_AGENT
#define LDS_WAIT() asm volatile("s_waitcnt lgkmcnt(0)" ::: "memory")
#define VM_WAIT() asm volatile("s_waitcnt vmcnt(0)" ::: "memory")
__device__ __forceinline__ unsigned f2bf(float f) { unsigned u = __builtin_bit_cast(unsigned, f); return (u + 0x7fffu + ((u >> 16) & 1u)) >> 16; }
__device__ __forceinline__ unsigned pk2(float lo, float hi) { return f2bf(lo) | (f2bf(hi) << 16); }
__device__ __forceinline__ float bf2f(unsigned short v) { return __uint_as_float((unsigned)v << 16); }
__device__ __forceinline__ float blo(unsigned w) { return __uint_as_float(w << 16); }
__device__ __forceinline__ float bhi(unsigned w) { return __uint_as_float(w & 0xffff0000u); }
__device__ __forceinline__ float wave_sum(float v) {
    v += __builtin_bit_cast(float, __builtin_amdgcn_update_dpp(0, __builtin_bit_cast(int, v), 0xB1, 0xf, 0xf, true));
    v += __builtin_bit_cast(float, __builtin_amdgcn_update_dpp(0, __builtin_bit_cast(int, v), 0x4E, 0xf, 0xf, true));
    v += __builtin_bit_cast(float, __builtin_amdgcn_update_dpp(0, __builtin_bit_cast(int, v), 0x141, 0xf, 0xf, true));
    v += __builtin_bit_cast(float, __builtin_amdgcn_update_dpp(0, __builtin_bit_cast(int, v), 0x140, 0xf, 0xf, true));
    { const auto rr = __builtin_amdgcn_permlane16_swap(__float_as_uint(v), __float_as_uint(v), false, false); v = __uint_as_float(rr[0]) + __uint_as_float(rr[1]); }
    { const auto rr = __builtin_amdgcn_permlane32_swap(__float_as_uint(v), __float_as_uint(v), false, false); v = __uint_as_float(rr[0]) + __uint_as_float(rr[1]); }
    return v;
}

__device__ __forceinline__ float xhalf_add(float a) { const auto rr = __builtin_amdgcn_permlane32_swap(__float_as_uint(a), __float_as_uint(a), false, false); return __uint_as_float(rr[0]) + __uint_as_float(rr[1]); }
__device__ __forceinline__ float xhalf_max(float a) { const auto rr = __builtin_amdgcn_permlane32_swap(__float_as_uint(a), __float_as_uint(a), false, false); return fmaxf(__uint_as_float(rr[0]), __uint_as_float(rr[1])); }
__device__ __forceinline__ int half_sum_i32(int v) {
    v += __builtin_amdgcn_update_dpp(0, v, 0xB1, 0xf, 0xf, true);
    v += __builtin_amdgcn_update_dpp(0, v, 0x4E, 0xf, 0xf, true);
    v += __builtin_amdgcn_update_dpp(0, v, 0x141, 0xf, 0xf, true);
    v += __builtin_amdgcn_update_dpp(0, v, 0x140, 0xf, 0xf, true);
    const auto rr = __builtin_amdgcn_permlane16_swap((unsigned)v, (unsigned)v, false, false); return (int)rr[0] + (int)rr[1];
}
#define XB_TMO      128
#define XB_XCNT(j)  (256  + 64 * (j))
#define XB_XSUB(j)  (1280 + 64 * (j))
#define XB_XGEN(j)  (2304 + 64 * (j))
#define XB_TOP      3328
#define XB_TOPGEN   3392
#define XCD_BAR_WORDS 3456
#define XB_SPIN_CAP (1u << 18)

__device__ __forceinline__ unsigned xb_ld(unsigned* p)              { return __hip_atomic_load(p, __ATOMIC_RELAXED, __HIP_MEMORY_SCOPE_AGENT); }
__device__ __forceinline__ unsigned xb_add(unsigned* p, unsigned v) { return __hip_atomic_fetch_add(p, v, __ATOMIC_RELAXED, __HIP_MEMORY_SCOPE_AGENT); }
__device__ __forceinline__ unsigned xb_xcc_id() { return (unsigned)__builtin_amdgcn_s_getreg((3 << 11) | 20) & 0xFu; }
#define XB_SPIN(cond, bar) do { unsigned _sp = 0; while (cond) { __builtin_amdgcn_s_sleep(1); \
    if ((++_sp & 255u) == 0u) { if (xb_ld(&(bar)[XB_TMO])) break; if (_sp > XB_SPIN_CAP) { atomicAdd(&(bar)[XB_TMO], 1u); break; } } } } while (0)

struct XcdBarrier {
    unsigned* bar; unsigned x;
    volatile LAS unsigned* st;
};

__device__ __forceinline__ XcdBarrier xcd_barrier_post(unsigned* bar, volatile LAS unsigned* st, bool t0) {
    XcdBarrier b; b.bar = bar; b.x = xb_xcc_id(); b.st = st;
    if (t0) st[2] = xb_add(&bar[XB_XCNT(b.x)], 1u);
    return b;
}
__device__ __forceinline__ void xcd_barrier_complete(unsigned* bar, unsigned x, unsigned& nloc, unsigned& nx) {
    const unsigned G = gridDim.x * gridDim.y * gridDim.z;
    unsigned sum, cnt, mine, sp = 0u;
    for (;;) {
        sum = 0u; cnt = 0u; mine = 0u;
#pragma unroll
        for (unsigned j = 0; j < 16; ++j) { const unsigned c = xb_ld(&bar[XB_XCNT(j)]); sum += c; cnt += (c > 0u) ? 1u : 0u; mine = (j == x) ? c : mine; }
        if (sum == G) break;
        __builtin_amdgcn_s_sleep(1);
        if ((++sp & 255u) == 0u) { if (xb_ld(&bar[XB_TMO])) break; if (sp > XB_SPIN_CAP) { atomicAdd(&bar[XB_TMO], 1u); break; } }
    }
    nloc = mine > 0u ? mine : 1u; nx = cnt > 0u ? cnt : 1u;
}

__device__ __forceinline__ void xcd_barrier(const XcdBarrier& b, const int wave) {
    asm volatile("s_waitcnt vmcnt(0)" ::: "memory");
    __syncthreads();
    if (wave == 0 && lane_fresh() == 0) {
        unsigned* bar = b.bar;
        __builtin_amdgcn_s_waitcnt(0);
        unsigned nloc = b.st[0], nx = b.st[1];
        if (nloc == 0u) { xcd_barrier_complete(bar, b.x, nloc, nx); b.st[0] = nloc; b.st[1] = nx; }
        const unsigned old = xb_add(&bar[XB_XSUB(b.x)], 1u);
        const unsigned gen = old / nloc;
        if (old + 1u == (gen + 1u) * nloc) {
            __builtin_amdgcn_fence(__ATOMIC_RELEASE, "agent");
            asm volatile("s_waitcnt vmcnt(0)" ::: "memory");
            const unsigned og = xb_add(&bar[XB_TOP], 1u);
            const unsigned tg = og / nx;
            if (og + 1u == (tg + 1u) * nx) xb_add(&bar[XB_TOPGEN], 1u);
            else XB_SPIN(xb_ld(&bar[XB_TOPGEN]) == tg, bar);
            __builtin_amdgcn_fence(__ATOMIC_ACQUIRE, "agent");
            xb_add(&bar[XB_XGEN(b.x)], 1u);
            asm volatile("s_waitcnt vmcnt(0)" ::: "memory");
        } else {
            XB_SPIN(xb_ld(&bar[XB_XGEN(b.x)]) == gen, bar);
            __builtin_amdgcn_fence(__ATOMIC_ACQUIRE, "agent");
            asm volatile("s_waitcnt vmcnt(0)" ::: "memory");
        }
    }
    __syncthreads();
}

__device__ __forceinline__ void tr_item(const float* W, int ldw, int nvalid, bf16* WT, int ldt, int k0, int n0, int drow0, int dcol0, LAS float* scr, int lane) {
    { const int n4 = 4 * (lane & 7), kr = lane >> 3; const bool ok = n0 + n4 < nvalid;
#pragma unroll
      for (int i = 0; i < 8; ++i) { const int kk = 8 * i + kr; const f32x4 v = ok ? *(const GAS f32x4*)(W + (size_t)(k0 + kk) * ldw + n0 + n4) : (f32x4){0.f, 0.f, 0.f, 0.f};
          LAS float* d = scr + kk * 33 + n4; d[0] = v.x; d[1] = v.y; d[2] = v.z; d[3] = v.w; } }
    LDS_WAIT(); asm volatile("" ::: "memory");
    const int c = lane & 7;
#pragma unroll
    for (int j = 0; j < 4; ++j) { const int nn = (lane >> 3) + 8 * j; const LAS float* s = scr + (8 * c) * 33 + nn;
        v4u o; o.x = pk2(s[0 * 33], s[1 * 33]); o.y = pk2(s[2 * 33], s[3 * 33]); o.z = pk2(s[4 * 33], s[5 * 33]); o.w = pk2(s[6 * 33], s[7 * 33]);
        *(GAS v4u*)(WT + (size_t)(drow0 + nn) * ldt + dcol0 + k0 + 8 * c) = o; }
    LDS_WAIT(); asm volatile("" ::: "memory");
}
__device__ __forceinline__ void tr_item8(const float* W, int ldw, unsigned char* WT, int ldt, int k0, int n0, int drow0, float sc, LAS float* scr, int lane) {
    { const int n4 = 4 * (lane & 7), kr = lane >> 3;
#pragma unroll
      for (int i = 0; i < 8; ++i) { const int kk = 8 * i + kr; const f32x4 v = *(const GAS f32x4*)(W + (size_t)(k0 + kk) * ldw + n0 + n4);
          LAS float* d = scr + kk * 33 + n4; d[0] = v.x; d[1] = v.y; d[2] = v.z; d[3] = v.w; } }
    LDS_WAIT(); asm volatile("" ::: "memory");
    const int nn = lane >> 1, hf = lane & 1; const LAS float* sp = scr + (32 * hf) * 33 + nn;
    unsigned o[8];
#pragma unroll
    for (int q = 0; q < 8; ++q) { const float a = fminf(fmaxf(sp[(4 * q + 0) * 33] * sc, -448.f), 448.f), b = fminf(fmaxf(sp[(4 * q + 1) * 33] * sc, -448.f), 448.f), c = fminf(fmaxf(sp[(4 * q + 2) * 33] * sc, -448.f), 448.f), d = fminf(fmaxf(sp[(4 * q + 3) * 33] * sc, -448.f), 448.f);
        int w = 0; w = __builtin_amdgcn_cvt_pk_fp8_f32(a, b, w, false); w = __builtin_amdgcn_cvt_pk_fp8_f32(c, d, w, true); o[q] = (unsigned)w; }
    GAS v4u* dst = (GAS v4u*)(WT + (size_t)(drow0 + nn) * ldt + k0 + 32 * hf);
    dst[0] = (v4u){o[0], o[1], o[2], o[3]}; dst[1] = (v4u){o[4], o[5], o[6], o[7]};
    LDS_WAIT(); asm volatile("" ::: "memory");
}
__device__ __forceinline__ void tr_item_ln(const float* W, int ldw, int nvalid, bf16* WT, int ldt, int k0, int n0, int drow0, const float* gain, const float* bvec, long long* gW, long long* bW, LAS float* scr, int lane) {
    { const int n4 = 4 * (lane & 7), kr = lane >> 3; const bool ok = n0 + n4 < nvalid;
#pragma unroll
      for (int i = 0; i < 8; ++i) { const int kk = 8 * i + kr; const f32x4 v = ok ? *(const GAS f32x4*)(W + (size_t)(k0 + kk) * ldw + n0 + n4) : (f32x4){0.f, 0.f, 0.f, 0.f};
          LAS float* d = scr + kk * 33 + n4; d[0] = v.x; d[1] = v.y; d[2] = v.z; d[3] = v.w; } }
    LDS_WAIT(); asm volatile("" ::: "memory");
    const int c = lane & 7;
    const f32x4 g0 = *(const GAS f32x4*)(gain + k0 + 8 * c), g1 = *(const GAS f32x4*)(gain + k0 + 8 * c + 4), b0 = *(const GAS f32x4*)(bvec + k0 + 8 * c), b1 = *(const GAS f32x4*)(bvec + k0 + 8 * c + 4);
    const float gk[8] = {g0.x, g0.y, g0.z, g0.w, g1.x, g1.y, g1.z, g1.w}, bk[8] = {b0.x, b0.y, b0.z, b0.w, b1.x, b1.y, b1.z, b1.w};
#pragma unroll
    for (int j = 0; j < 4; ++j) { const int nn = (lane >> 3) + 8 * j; const LAS float* sp = scr + (8 * c) * 33 + nn;
        float v[8], bs = 0.f;
#pragma unroll
        for (int i = 0; i < 8; ++i) { const float raw = sp[i * 33]; v[i] = raw * gk[i]; bs += raw * bk[i]; }
        v4u o; o.x = pk2(v[0], v[1]); o.y = pk2(v[2], v[3]); o.z = pk2(v[4], v[5]); o.w = pk2(v[6], v[7]);
        float gs = ((blo(o.x) + bhi(o.x)) + (blo(o.y) + bhi(o.y))) + ((blo(o.z) + bhi(o.z)) + (blo(o.w) + bhi(o.w)));
        *(GAS v4u*)(WT + (size_t)(drow0 + nn) * ldt + k0 + 8 * c) = o;
        gs += __shfl_xor(gs, 1); gs += __shfl_xor(gs, 2); gs += __shfl_xor(gs, 4); bs += __shfl_xor(bs, 1); bs += __shfl_xor(bs, 2); bs += __shfl_xor(bs, 4);
        if (c == 0) { (void)__hip_atomic_fetch_add(gW + drow0 + nn, (long long)__builtin_rintf(gs * FX_V), __ATOMIC_RELAXED, __HIP_MEMORY_SCOPE_AGENT); (void)__hip_atomic_fetch_add(bW + drow0 + nn, (long long)__builtin_rintf(bs * FX_V), __ATOMIC_RELAXED, __HIP_MEMORY_SCOPE_AGENT); } }
    LDS_WAIT(); asm volatile("" ::: "memory");
}
__device__ __forceinline__ void tr_item8_ln(const float* W, int ldw, unsigned char* WT, int ldt, int k0, int n0, int drow0, float sc, const float* gain, const float* bvec, long long* gW, long long* bW, LAS float* scr, int lane) {
    { const int n4 = 4 * (lane & 7), kr = lane >> 3;
#pragma unroll
      for (int i = 0; i < 8; ++i) { const int kk = 8 * i + kr; const f32x4 v = *(const GAS f32x4*)(W + (size_t)(k0 + kk) * ldw + n0 + n4);
          LAS float* d = scr + kk * 33 + n4; d[0] = v.x; d[1] = v.y; d[2] = v.z; d[3] = v.w; } }
    LDS_WAIT(); asm volatile("" ::: "memory");
    const int nn = lane >> 1, hf = lane & 1; const LAS float* sp = scr + (32 * hf) * 33 + nn;
    unsigned o[8]; float gs = 0.f, bs = 0.f;
#pragma unroll
    for (int q = 0; q < 8; ++q) { const f32x4 g4 = *(const GAS f32x4*)(gain + k0 + 32 * hf + 4 * q), b4 = *(const GAS f32x4*)(bvec + k0 + 32 * hf + 4 * q);
        const float r0 = sp[(4 * q + 0) * 33], r1 = sp[(4 * q + 1) * 33], r2 = sp[(4 * q + 2) * 33], r3 = sp[(4 * q + 3) * 33];
        bs += (r0 * b4.x + r1 * b4.y) + (r2 * b4.z + r3 * b4.w);
        const float a = fminf(fmaxf(r0 * g4.x * sc, -448.f), 448.f), b = fminf(fmaxf(r1 * g4.y * sc, -448.f), 448.f), c = fminf(fmaxf(r2 * g4.z * sc, -448.f), 448.f), d = fminf(fmaxf(r3 * g4.w * sc, -448.f), 448.f);
        int w = 0; w = __builtin_amdgcn_cvt_pk_fp8_f32(a, b, w, false); w = __builtin_amdgcn_cvt_pk_fp8_f32(c, d, w, true); o[q] = (unsigned)w;
        gs += (__builtin_amdgcn_cvt_f32_fp8(w, 0) + __builtin_amdgcn_cvt_f32_fp8(w, 1)) + (__builtin_amdgcn_cvt_f32_fp8(w, 2) + __builtin_amdgcn_cvt_f32_fp8(w, 3)); }
    GAS v4u* dst = (GAS v4u*)(WT + (size_t)(drow0 + nn) * ldt + k0 + 32 * hf);
    dst[0] = (v4u){o[0], o[1], o[2], o[3]}; dst[1] = (v4u){o[4], o[5], o[6], o[7]};
    gs += __shfl_xor(gs, 1); bs += __shfl_xor(bs, 1);
    if (hf == 0) { (void)__hip_atomic_fetch_add(gW + drow0 + nn, (long long)__builtin_rintf(gs / sc * FX_V), __ATOMIC_RELAXED, __HIP_MEMORY_SCOPE_AGENT); (void)__hip_atomic_fetch_add(bW + drow0 + nn, (long long)__builtin_rintf(bs * FX_V), __ATOMIC_RELAXED, __HIP_MEMORY_SCOPE_AGENT); }
    LDS_WAIT(); asm volatile("" ::: "memory");
}
__device__ __forceinline__ void cvt_item8(const float* src, unsigned char* dst, int item, int lane, float sc) {
    const GAS f32x4* sp = (const GAS f32x4*)(src + (size_t)item * 512) + 2 * lane; f32x4 a = sp[0] * sc, b = sp[1] * sc;
    int w0 = 0, w1 = 0; w0 = __builtin_amdgcn_cvt_pk_fp8_f32(fminf(fmaxf(a.x, -448.f), 448.f), fminf(fmaxf(a.y, -448.f), 448.f), w0, false); w0 = __builtin_amdgcn_cvt_pk_fp8_f32(fminf(fmaxf(a.z, -448.f), 448.f), fminf(fmaxf(a.w, -448.f), 448.f), w0, true);
    w1 = __builtin_amdgcn_cvt_pk_fp8_f32(fminf(fmaxf(b.x, -448.f), 448.f), fminf(fmaxf(b.y, -448.f), 448.f), w1, false); w1 = __builtin_amdgcn_cvt_pk_fp8_f32(fminf(fmaxf(b.z, -448.f), 448.f), fminf(fmaxf(b.w, -448.f), 448.f), w1, true);
    *((GAS v2u*)(dst + (size_t)item * 512) + lane) = (v2u){(unsigned)w0, (unsigned)w1};
}
__device__ __forceinline__ void cvt_item(const float* src, bf16* dst, int item, int lane) {
    const GAS f32x4* s = (const GAS f32x4*)(src + (size_t)item * 512) + 2 * lane; const f32x4 a = s[0], b = s[1];
    v4u o; o.x = pk2(a.x, a.y); o.y = pk2(a.z, a.w); o.z = pk2(b.x, b.y); o.w = pk2(b.z, b.w);
    *((GAS v4u*)(dst + (size_t)item * 512) + lane) = o;
}
__device__ __forceinline__ void p0_prologue(const float* const (&in)[24], unsigned char* ws, LAS unsigned char* lds, int gw, int NGW, int wave, int lane) {
    LAS float* scr = (LAS float*)(lds + RING_OFF + wave * 16384);
#define TRM(SRC, Kk, LDW, NVALID, NPAD, DST, LDT, ROWMAP, DCOL) { constexpr int nblk = (NPAD) / 32; constexpr int cnt = ((Kk) / 64) * nblk; \
        if (r < cnt) { const int kb = r / nblk, nb = r % nblk, n0 = 32 * nb; tr_item(SRC, LDW, NVALID, (bf16*)(ws + (DST)), LDT, 64 * kb, n0, (ROWMAP), (DCOL), scr, lane); continue; } r -= cnt; }
#define TRM8(SRC, Kk, LDW, NN, DST, LDT, ROWMAP, SC) { constexpr int nblk = (NN) / 32; constexpr int cnt = ((Kk) / 64) * nblk; \
        if (r < cnt) { const int kb = r / nblk, nb = r % nblk, n0 = 32 * nb; tr_item8(SRC, LDW, (unsigned char*)(ws + (DST)), LDT, 64 * kb, n0, (ROWMAP), SC, scr, lane); continue; } r -= cnt; }
    long long* const vec = (long long*)(ws + WS_CTL + CTL_VEC);
#define TRML(SRC, Kk, LDW, NVALID, NPAD, DST, LDT, ROWMAP, GAIN, BVEC, VG, VB) { constexpr int nblk = (NPAD) / 32; constexpr int cnt = ((Kk) / 64) * nblk; \
        if (r < cnt) { const int kb = r / nblk, nb = r % nblk, n0 = 32 * nb; tr_item_ln(SRC, LDW, NVALID, (bf16*)(ws + (DST)), LDT, 64 * kb, n0, (ROWMAP), GAIN, BVEC, vec + (VG), vec + (VB), scr, lane); continue; } r -= cnt; }
#define TRML8(SRC, Kk, LDW, NN, DST, LDT, ROWMAP, SC, GAIN, BVEC, VG, VB) { constexpr int nblk = (NN) / 32; constexpr int cnt = ((Kk) / 64) * nblk; \
        if (r < cnt) { const int kb = r / nblk, nb = r % nblk, n0 = 32 * nb; tr_item8_ln(SRC, LDW, (unsigned char*)(ws + (DST)), LDT, 64 * kb, n0, (ROWMAP), SC, GAIN, BVEC, vec + (VG), vec + (VB), scr, lane); continue; } r -= cnt; }
    constexpr int N_TR = 2 * (32 * 176) + 88 * 64 + 32 * 184 + 2 * (32 * 64) + 256 + 2 * (16 * 64) + 32 * 64 + 32 * 16 + 32 * 32 + 8 * 64 + 2 * (32 * 176) + 88 * 64;
    for (int it = gw; it < N_TR; it += NGW) {
        int r = it;
        TRM8(in[2], 2048, 5632, 5632, WS_W_GU1, 2048, 256 * (n0 >> 7) + (n0 & 127), FP8_WGUS)
        TRM8(in[3], 2048, 5632, 5632, WS_W_GU1, 2048, 256 * (n0 >> 7) + 128 + (n0 & 127), FP8_WGUS)
        TRM8(in[4], 5632, 2048, 2048, WS_W_D1, 5632, n0, FP8_WDS)
        TRML(in[5], 2048, 5712, 5712, 5888, WS_W_IN, 2048, n0, in[22], in[23], V_GW_IN, V_BW_IN)
        TRML8(in[11], 2048, 2048, 2048, WS_W_G, 2048, 256 * (n0 >> 7) + (n0 & 127), FP8_WGS, in[22], in[23], V_GW_G, V_BW_G)
        TRML8(in[11] + (size_t)2048 * 2048, 2048, 2048, 2048, WS_W_G, 2048, 256 * (n0 >> 7) + 128 + (n0 & 127), FP8_WGS, in[22], in[23], V_GW_G, V_BW_G)
        if (r < 256) { const int h = r >> 5, rr = r & 31, kb = rr >> 2, nb = rr & 3;
            tr_item(in[10] + (size_t)h * 512 * 128, 128, 128, (bf16*)(ws + WS_W_UVP), 1024, 64 * kb, 32 * nb, (h >> 1) * 256 + (h & 1) * 128 + 32 * nb, (h & 1) * 512, scr, lane); continue; } r -= 256;
        TRM(in[13], 1024, 2048, 2048, 2048, WS_W_A, 1024, n0, 0)
        TRM(in[14], 1024, 2048, 2048, 2048, WS_W_B, 1024, n0, 0)
        TRM8(in[15], 2048, 2048, 2048, WS_W_MO, 2048, n0, FP8_WMOS)
        TRML(in[16], 2048, 512, 512, 512, WS_W_MQ, 2048, n0, in[22] + D, in[23] + D, V_GW_MQ, V_BW_MQ)
        TRM(in[17], 2048, 1024, 1024, 1024, WS_W_MKV, 2048, n0, 0)
        TRM(in[18], 512, 2048, 2048, 2048, WS_W_MOUT, 512, n0, 0)
        TRML8(in[19], 2048, 5632, 5632, WS_W_GU2, 2048, 256 * (n0 >> 7) + (n0 & 127), FP8_WGUS, in[22] + 2 * D, in[23] + 2 * D, V_GW_GU2, V_BW_GU2)
        TRML8(in[20], 2048, 5632, 5632, WS_W_GU2, 2048, 256 * (n0 >> 7) + 128 + (n0 & 127), FP8_WGUS, in[22] + 2 * D, in[23] + 2 * D, V_GW_GU2, V_BW_GU2)
        TRM8(in[21], 5632, 2048, 2048, WS_W_D2, 5632, n0, FP8_WDS)
    }
#undef TRM
#undef TRM8
#undef TRML
#undef TRML8
    for (int rw = gw; rw < 1024; rw += NGW) { const int e = (rw >> 7) & 1; *((GAS v4u*)((bf16*)(ws + WS_W_UVP) + (size_t)rw * 1024 + (1 - e) * 512) + lane) = (v4u){0u, 0u, 0u, 0u}; }
    for (int it = gw; it < (M * D) / 512; it += NGW) cvt_item8(in[0], (unsigned char*)(ws + WS_X8), it, lane, FP8_XS);
    for (int it = gw; it < (BATCH * MEMT * D) / 512; it += NGW) cvt_item(in[1], (bf16*)(ws + WS_MEM16), it, lane);
    for (int it = gw; it < (8 * 512 * 128) / 512; it += NGW) cvt_item(in[9], (bf16*)(ws + WS_W_UK), it, lane);
}

__device__ __forceinline__ void ln_phase(float* zx, bf16* x16, unsigned char* x8, const float* g, const float* b, int gw, int NGW, int lane) {
    f32x4 gv[8], bv[8];
#pragma unroll
    for (int j = 0; j < 8; ++j) { gv[j] = *((const GAS f32x4*)g + lane + 64 * j); bv[j] = *((const GAS f32x4*)b + lane + 64 * j); }
    for (int m = gw; m < M; m += NGW) {
        GAS f32x4* xr = (GAS f32x4*)(zx + (size_t)m * D) + lane;
        f32x4 v[8]; float s = 0.f;
#pragma unroll
        for (int j = 0; j < 8; ++j) { v[j] = xr[64 * j]; s += (v[j].x + v[j].y) + (v[j].z + v[j].w); }
        const float mean = wave_sum(s) * (1.f / D); float s2 = 0.f;
#pragma unroll
        for (int j = 0; j < 8; ++j) { v[j] = v[j] - mean; s2 += (v[j].x * v[j].x + v[j].y * v[j].y) + (v[j].z * v[j].z + v[j].w * v[j].w); }
        const float rstd = 1.f / sqrtf(wave_sum(s2) * (1.f / D) + LN_EPS);
#pragma unroll
        for (int j = 0; j < 8; ++j) { v[j] = v[j] * rstd * gv[j] + bv[j]; xr[64 * j] = v[j]; }
        if (x16) { GAS v2u* o8 = (GAS v2u*)(x16 + (size_t)m * D) + lane;
#pragma unroll
            for (int j = 0; j < 8; ++j) o8[64 * j] = (v2u){pk2(v[j].x, v[j].y), pk2(v[j].z, v[j].w)}; }
        if (x8) { GAS unsigned* o4 = (GAS unsigned*)(x8 + (size_t)m * D) + lane;
#pragma unroll
            for (int j = 0; j < 8; ++j) { const f32x4 q = v[j] * FP8_XS; int w = 0; w = __builtin_amdgcn_cvt_pk_fp8_f32(fminf(fmaxf(q.x, -448.f), 448.f), fminf(fmaxf(q.y, -448.f), 448.f), w, false);
                w = __builtin_amdgcn_cvt_pk_fp8_f32(fminf(fmaxf(q.z, -448.f), 448.f), fminf(fmaxf(q.w, -448.f), 448.f), w, true); o4[64 * j] = (unsigned)w; } }
    }
}
__device__ __forceinline__ void ln_final_phase(const bf16* z16, float* outp, const float* g, const float* b, int gw, int NGW, int lane) {
    for (int m0 = gw; m0 < M; m0 += 2 * NGW) {
        const int m1 = m0 + NGW; const bool two = m1 < M;
        v4u w[2][4];
#pragma unroll
        for (int j = 0; j < 4; ++j) { w[0][j] = __builtin_nontemporal_load((const GAS v4u*)(z16 + (size_t)m0 * D) + lane + 64 * j); w[1][j] = two ? __builtin_nontemporal_load((const GAS v4u*)(z16 + (size_t)m1 * D) + lane + 64 * j) : (v4u){0u, 0u, 0u, 0u}; }
#pragma unroll
        for (int rr = 0; rr < 2; ++rr) { if (rr == 1 && !two) break;
            const int m = rr ? m1 : m0;
            float v[32]; float s = 0.f;
#pragma unroll
            for (int j = 0; j < 4; ++j) { const v4u x = w[rr][j]; v[8 * j + 0] = blo(x.x); v[8 * j + 1] = bhi(x.x); v[8 * j + 2] = blo(x.y); v[8 * j + 3] = bhi(x.y); v[8 * j + 4] = blo(x.z); v[8 * j + 5] = bhi(x.z); v[8 * j + 6] = blo(x.w); v[8 * j + 7] = bhi(x.w); }
#pragma unroll
            for (int e = 0; e < 32; ++e) s += v[e];
            const float mean = wave_sum(s) * (1.f / D); float s2 = 0.f;
#pragma unroll
            for (int e = 0; e < 32; ++e) { v[e] -= mean; s2 += v[e] * v[e]; }
            const float rstd = 1.f / sqrtf(wave_sum(s2) * (1.f / D) + LN_EPS);
#pragma unroll
            for (int j = 0; j < 4; ++j) { const int c0 = 512 * j + 8 * lane;
                const f32x4 g0 = *(const GAS f32x4*)(g + c0), g1 = *(const GAS f32x4*)(g + c0 + 4), b0 = *(const GAS f32x4*)(b + c0), b1 = *(const GAS f32x4*)(b + c0 + 4);
                GAS f32x4* o = (GAS f32x4*)(outp + (size_t)m * D + c0);
                __builtin_nontemporal_store((f32x4){v[8 * j + 0], v[8 * j + 1], v[8 * j + 2], v[8 * j + 3]} * rstd * g0 + b0, o); __builtin_nontemporal_store((f32x4){v[8 * j + 4], v[8 * j + 5], v[8 * j + 6], v[8 * j + 7]} * rstd * g1 + b1, o + 1); } }
    }
}
__device__ __forceinline__ void crms_phase(const bf16* bc, unsigned char* c8, const float* kvg, float cs, int gw, int NGW, int lane) {
    float gg[8];
#pragma unroll
    for (int j = 0; j < 8; ++j) gg[j] = kvg[8 * lane + j] * cs;
    for (int m = gw; m < M; m += NGW) {
        const v4u w = *((const GAS v4u*)(bc + (size_t)m * 512) + lane);
        float x[8] = {blo(w.x), bhi(w.x), blo(w.y), bhi(w.y), blo(w.z), bhi(w.z), blo(w.w), bhi(w.w)}; float s = 0.f;
#pragma unroll
        for (int j = 0; j < 8; ++j) s += x[j] * x[j];
        const float r = 1.f / sqrtf(wave_sum(s) * (1.f / 512.f) + LN_EPS);
#pragma unroll
        for (int j = 0; j < 8; ++j) x[j] = fminf(fmaxf(x[j] * r * gg[j], -448.f), 448.f);
        *((GAS v2u*)(c8 + (size_t)m * 512) + lane) = (v2u){pg8::pk4_fp8(x[0], x[1], x[2], x[3]), pg8::pk4_fp8(x[4], x[5], x[6], x[7])};
    }
}
typedef short v4i16_t __attribute__((ext_vector_type(4)));
__device__ __forceinline__ v4i16_t lds_tr16(const LAS unsigned char* p) { return __builtin_amdgcn_ds_read_tr16_b64_v4i16((LAS v4i16_t*)p); }
__device__ __forceinline__ unsigned cvtpk(float lo, float hi) { typedef float f2 __attribute__((ext_vector_type(2))); typedef __bf16 b2 __attribute__((ext_vector_type(2))); f2 v = {lo, hi}; b2 b = __builtin_convertvector(v, b2); return __builtin_bit_cast(unsigned, b); }
__device__ __forceinline__ float xhalf_f(float v) { return __shfl_xor(v, 32); }
constexpr float LOG2E = 1.4426950408889634f;
constexpr float QSCALE = 0.125f * LOG2E;

__device__ __forceinline__ void diff_attn_mfma(LAS unsigned char* lds, const bf16* AQ, const bf16* AK, const bf16* AV, bf16* YA, const float* dlam, const float* subg, unsigned* dq, const unsigned* kmax, const int wave) {
    const int lane = lane_fresh(), r32 = lane & 31, hi = lane >> 5;
    const int comp = wave >> 2, wq = wave & 3;
    const unsigned ksrc = (unsigned)(lane * 1024 + (2 * wave) * 8);
    const unsigned vsrc0 = (unsigned)((16 * ((2 * wave) & 3) + (lane >> 2)) * 1024 + ((2 * wave) >> 2) * 32 + (lane & 3) * 8);
    const unsigned vsrc1 = (unsigned)((16 * ((2 * wave + 1) & 3) + (lane >> 2)) * 1024 + ((2 * wave + 1) >> 2) * 32 + (lane & 3) * 8);
    const unsigned kdst = (unsigned)(2 * wave) * 1024u, vdst0 = 16384u + (unsigned)(((2 * wave) >> 2) * 4096 + ((2 * wave) & 3) * 1024), vdst1 = 16384u + (unsigned)(((2 * wave + 1) >> 2) * 4096 + ((2 * wave + 1) & 3) * 1024);
    const unsigned lds0 = (unsigned)(uintptr_t)lds;
#define DA_STAGE(bo, to) do { \
        glds16(Kg + (to) + ksrc, (unsigned)__builtin_amdgcn_readfirstlane((int)(lds0 + (bo) + kdst))); \
        glds16(Kg + (to) + ksrc + 8, (unsigned)__builtin_amdgcn_readfirstlane((int)(lds0 + (bo) + kdst + 1024))); \
        glds16(Vg + (to) + vsrc0, (unsigned)__builtin_amdgcn_readfirstlane((int)(lds0 + (bo) + vdst0))); \
        glds16(Vg + (to) + vsrc1, (unsigned)__builtin_amdgcn_readfirstlane((int)(lds0 + (bo) + vdst1))); } while (0)
#define DA_WAITBAR() asm volatile("s_waitcnt vmcnt(0) lgkmcnt(0)\n\ts_barrier" ::: "memory")
    const unsigned koff = (unsigned)(((comp * 8 + hi) * 64 + r32) * 16);
    const unsigned voff = (unsigned)(16384 + (4 * hi + ((lane & 15) >> 2)) * 64 + ((lane >> 4) & 1) * 32 + (lane & 3) * 8);
    LAS unsigned* xq = (LAS unsigned*)(lds + 100352);
    for (;;) {
        if (wave == 0 && lane == 0) xq[0] = __hip_atomic_fetch_add(dq, 1u, __ATOMIC_RELAXED, __HIP_MEMORY_SCOPE_AGENT);
        asm volatile("s_waitcnt vmcnt(0) lgkmcnt(0)\n\ts_barrier" ::: "memory");
        const int j = (int)xq[0];
        if (j >= 1024) break;
        const int ub = 31 - (j >> 5), bh = j & 31;
        const int b = bh >> 3, h = 7 - (bh & 7);
        const float sl2 = LOG2E / (float)(2 << h);
        const size_t rowbase = (size_t)b * SEQ; const int q0 = ub * 128;
        const int qpos = q0 + wq * 32 + r32;
        const int nt = 2 * ub + 2;
        const int myt = 2 * ub + 1 + (wq >> 1);
        const bf16* Kg = AK + rowbase * 1024 + h * 128; const bf16* Vg = AV + rowbase * 1024 + h * 128;
        bf16x8 qr[4];
#pragma unroll
        for (int s = 0; s < 4; ++s) qr[s] = *(const GAS bf16x8*)(AQ + (rowbase + qpos) * 1024 + h * 128 + comp * 64 + s * 16 + hi * 8);
        f32x16 o[4];
#pragma unroll
        for (int blk = 0; blk < 4; ++blk)
#pragma unroll
            for (int r = 0; r < 16; ++r) o[blk][r] = 0.f;
        float mrun = -INFINITY, lrun = 0.f;
        { float qn2 = 0.f;
#pragma unroll
          for (int s = 0; s < 4; ++s) { const v4u w = __builtin_bit_cast(v4u, qr[s]); const float e0 = blo(w.x), e1 = bhi(w.x), e2 = blo(w.y), e3 = bhi(w.y), e4 = blo(w.z), e5 = bhi(w.z), e6 = blo(w.w), e7 = bhi(w.w);
              qn2 += ((e0 * e0 + e1 * e1) + (e2 * e2 + e3 * e3)) + ((e4 * e4 + e5 * e5) + (e6 * e6 + e7 * e7)); }
          qn2 += xhalf_f(qn2);
#pragma unroll
          for (int o_ = 1; o_ < 32; o_ <<= 1) qn2 = fmaxf(qn2, __shfl_xor(qn2, o_));
          const float kb = __uint_as_float(__hip_atomic_load(kmax + (b * 8 + h) * 2 + comp, __ATOMIC_RELAXED, __HIP_MEMORY_SCOPE_AGENT));
          if (lane == 0) xq[8 + wave] = __float_as_uint(sqrtf(qn2) * kb * 8.1f); }
        DA_STAGE(0u, (size_t)(nt - 1) * 64 * 1024);
        DA_WAITBAR();
        int kt_lo = 0;
        { float sb = 0.f;
#pragma unroll
          for (int w_ = 0; w_ < 8; ++w_) sb = fmaxf(sb, __uint_as_float(xq[8 + w_]));
          const float xcut = (float)(q0 - 63) - (40.f + 2.f * sb) / sl2;
          kt_lo = xcut > 0.f ? (int)__builtin_ceilf(xcut * (1.f / 64.f)) : 0; kt_lo = __builtin_amdgcn_readfirstlane(kt_lo); }
        for (int st = 0; st < nt - kt_lo; ++st) {
            const int kt = nt - 1 - st;
            const unsigned bufo = (unsigned)(st & 1) * 32768u;
            if (kt > kt_lo) DA_STAGE(32768u - bufo, (size_t)(kt - 1) * 64 * 1024);
            if (kt < myt) {
                const LAS unsigned char* Kb = lds + bufo + koff;
                f32x16 p0, p1;
#pragma unroll
                for (int r = 0; r < 16; ++r) { p0[r] = 0.f; p1[r] = 0.f; }
                { bf16x8 kf[4];
#pragma unroll
                  for (int s = 0; s < 4; ++s) kf[s] = *(const LAS bf16x8*)(Kb + s * 2048);
#pragma unroll
                  for (int s = 0; s < 4; ++s) p0 = __builtin_amdgcn_mfma_f32_32x32x16_bf16(kf[s], qr[s], p0, 0, 0, 0); }
                { bf16x8 kf[4];
#pragma unroll
                  for (int s = 0; s < 4; ++s) kf[s] = *(const LAS bf16x8*)(Kb + s * 2048 + 512);
#pragma unroll
                  for (int s = 0; s < 4; ++s) p1 = __builtin_amdgcn_mfma_f32_32x32x16_bf16(kf[s], qr[s], p1, 0, 0, 0); }
                const float qth = (float)(qpos - kt * 64 - 4 * hi);
                float rm = -INFINITY;
#pragma unroll
                for (int r = 0; r < 16; ++r) { const float kr = (float)((r & 3) + 8 * (r >> 2)); const float v0 = qth - kr, v1 = qth - (kr + 32.f);
                    p0[r] = p0[r] - sl2 * fabsf(v0); p1[r] = p1[r] - sl2 * fabsf(v1); rm = fmaxf(rm, fmaxf(p0[r], p1[r])); }
                rm = fmaxf(rm, xhalf_f(rm));
                if (__any(rm > mrun)) { const float mn = fmaxf(mrun, rm), f = __builtin_amdgcn_exp2f(mrun - mn); mrun = mn; lrun *= f;
#pragma unroll
                    for (int blk = 0; blk < 4; ++blk)
#pragma unroll
                        for (int r = 0; r < 16; ++r) o[blk][r] *= f; }
                float ls = 0.f;
#pragma unroll
                for (int r = 0; r < 16; ++r) { p0[r] = __builtin_amdgcn_exp2f(p0[r] - mrun); p1[r] = __builtin_amdgcn_exp2f(p1[r] - mrun); ls += p0[r] + p1[r]; }
                lrun += ls;
                bf16x8 pw[4];
#pragma unroll
                for (int s = 0; s < 2; ++s) {
                    v4u a = {cvtpk(p0[8 * s + 0], p0[8 * s + 1]), cvtpk(p0[8 * s + 2], p0[8 * s + 3]), cvtpk(p0[8 * s + 4], p0[8 * s + 5]), cvtpk(p0[8 * s + 6], p0[8 * s + 7])};
                    v4u c = {cvtpk(p1[8 * s + 0], p1[8 * s + 1]), cvtpk(p1[8 * s + 2], p1[8 * s + 3]), cvtpk(p1[8 * s + 4], p1[8 * s + 5]), cvtpk(p1[8 * s + 6], p1[8 * s + 7])};
                    pw[s] = __builtin_bit_cast(bf16x8, a); pw[2 + s] = __builtin_bit_cast(bf16x8, c); }
                const LAS unsigned char* Vb = lds + bufo + voff;
#pragma unroll
                for (int blk = 0; blk < 4; ++blk) {
#pragma unroll
                    for (int s = 0; s < 4; ++s) {
                        const v4i16_t lo = lds_tr16(Vb + blk * 4096 + s * 1024), hh = lds_tr16(Vb + blk * 4096 + s * 1024 + 512);
                        const bf16x8 vf = {lo[0], lo[1], lo[2], lo[3], hh[0], hh[1], hh[2], hh[3]};
                        o[blk] = __builtin_amdgcn_mfma_f32_32x32x16_bf16(vf, pw[s], o[blk], 0, 0, 0);
                    }
                }
            }
            DA_WAITBAR();
        }
        lrun += xhalf_f(lrun);
        const float inv = 1.f / lrun;
        LAS float* Y1 = (LAS float*)(lds) + wq * 4096;
        if (comp == 1) {
            float lam; { float a = dlam[lane] * dlam[64 + lane], bq_ = dlam[128 + lane] * dlam[192 + lane]; a = wave_sum(a); bq_ = wave_sum(bq_); lam = __expf(a) - __expf(bq_) + LAMBDA_INIT; }
            const float sc = inv * lam;
#pragma unroll
            for (int blk = 0; blk < 4; ++blk)
#pragma unroll
                for (int r = 0; r < 16; ++r) Y1[(32 * blk + (r & 3) + 8 * (r >> 2) + 4 * hi) * 32 + r32] = o[blk][r] * sc; }
        __syncthreads();
        if (comp == 0) {
            float ss = 0.f;
#pragma unroll
            for (int blk = 0; blk < 4; ++blk)
#pragma unroll
                for (int r = 0; r < 16; ++r) { const float a = o[blk][r] * inv - Y1[(32 * blk + (r & 3) + 8 * (r >> 2) + 4 * hi) * 32 + r32]; o[blk][r] = a; ss += a * a; }
            ss += xhalf_f(ss);
            const float rr = (1.0f - LAMBDA_INIT) / sqrtf(ss * (1.f / 128.f) + LN_EPS);
            LAS unsigned* stg = (LAS unsigned*)(lds + 65536) + wq * (32 * 65);
#pragma unroll
            for (int blk = 0; blk < 4; ++blk) {
#pragma unroll
                for (int r = 0; r < 16; r += 2) { const int e = 32 * blk + (r & 3) + 8 * (r >> 2) + 4 * hi;
                    stg[r32 * 65 + (e >> 1)] = cvtpk(o[blk][r] * rr * subg[e], o[blk][r + 1] * rr * subg[e + 1]); }
                asm volatile("" ::: "memory"); }
            LDS_WAIT(); asm volatile("" ::: "memory");
            bf16* orow = YA + (rowbase + q0 + wq * 32) * 1024 + h * 128;
#pragma unroll 4
            for (int row = 0; row < 32; ++row) *((GAS unsigned*)(orow + (size_t)row * 1024) + lane) = stg[row * 65 + lane];
        }
        __syncthreads();
    }
#undef DA_STAGE
#undef DA_WAITBAR
}

__device__ __forceinline__ unsigned okey(float f) { const unsigned u = __float_as_uint(f); return (u & 0x80000000u) ? ~u : (u | 0x80000000u); }
__device__ __forceinline__ void indexer_topk(LAS unsigned char* lds, const bf16* IQ, const bf16* IKW, unsigned short* IDX, int vcu, int G, const int wave) {
    const int lane = lane_fresh(), r32 = lane & 31, hi = lane >> 5;
    const unsigned lds0 = (unsigned)(uintptr_t)lds;
    const unsigned boff = (unsigned)((hi * 256 + r32) * 16);
    for (int j = vcu; j < 1024; j += G) {
        const int w = j & 255, i = j >> 8, bq = w >> 4, s16 = w & 15;
        const int chunk = (i == 0) ? s16 : (i == 1) ? 31 - s16 : (i == 2) ? 32 + s16 : 63 - s16;
        const int b = bq >> 2, gq = bq & 3;
        const int t0 = b * SEQ + chunk * 64 + gq * 16 + 2 * wave;
        const int ngroups = 2 * (chunk + 1);
        const int ntiles = (ngroups + 7) >> 3;
        const bf16* Kg = IKW + (size_t)b * SEQ * 256;
#define IX_STAGE(tile, bo) do { int tl_ = (tile); asm volatile("" : "+s"(tl_)); _Pragma("unroll") for (int i_ = 0; i_ < 4; ++i_) { const int q_ = 4 * wave + i_; \
            glds16s(Kg + (size_t)(tl_ * 256 + 64 * (q_ & 3)) * 256 + (q_ >> 2) * 8, (unsigned)lane * 512u, (unsigned)__builtin_amdgcn_readfirstlane((int)(lds0 + (bo) + ((q_ >> 2) * 256 + 64 * (q_ & 3)) * 16))); } } while (0)
        asm volatile("s_barrier" ::: "memory");
        IX_STAGE(0, 0u);
        bf16x8 a[4];
#pragma unroll
        for (int ks = 0; ks < 4; ++ks) a[ks] = *(const GAS bf16x8*)(IQ + (size_t)(t0 + (r32 >> 4)) * 1024 + (r32 & 15) * 64 + ks * 16 + 8 * hi);
        float wv[16];
        { const bf16* iwp = IKW + (size_t)t0 * 256 + 64 + 4 * hi;
          const v2u w00 = *(const GAS v2u*)(iwp), w01 = *(const GAS v2u*)(iwp + 8), w10 = *(const GAS v2u*)(iwp + 256), w11 = *(const GAS v2u*)(iwp + 256 + 8);
          wv[0] = blo(w00.x); wv[1] = bhi(w00.x); wv[2] = blo(w00.y); wv[3] = bhi(w00.y); wv[4] = blo(w01.x); wv[5] = bhi(w01.x); wv[6] = blo(w01.y); wv[7] = bhi(w01.y);
          wv[8] = blo(w10.x); wv[9] = bhi(w10.x); wv[10] = blo(w10.y); wv[11] = bhi(w10.y); wv[12] = blo(w11.x); wv[13] = bhi(w11.x); wv[14] = blo(w11.y); wv[15] = bhi(w11.y); }
        unsigned key[128];
#pragma unroll 128
        for (int g = 0; g < 128; ++g) {
            if (g < ngroups) {
                const unsigned bufo = (unsigned)((g >> 3) & 1) * 32768u;
                if ((g & 7) == 0) {
                    asm volatile("s_waitcnt vmcnt(0)\n\ts_barrier" ::: "memory");
                    if ((g >> 3) + 1 < ntiles) IX_STAGE((g >> 3) + 1, 32768u - bufo);
                }
                bf16x8 bk[4];
#pragma unroll
                for (int ks = 0; ks < 4; ++ks) bk[ks] = *(const LAS bf16x8*)(lds + bufo + boff + (g & 7) * 512 + ks * 8192);
                f32x16 acc = {0.f, 0.f, 0.f, 0.f, 0.f, 0.f, 0.f, 0.f, 0.f, 0.f, 0.f, 0.f, 0.f, 0.f, 0.f, 0.f};
#pragma unroll
                for (int ks = 0; ks < 4; ++ks) acc = __builtin_amdgcn_mfma_f32_32x32x16_bf16(a[ks], bk[ks], acc, 0, 0, 0);
                float s0 = 0.f, s1 = 0.f;
#pragma unroll
                for (int r = 0; r < 8; ++r) { s0 += wv[r] * fmaxf(acc[r], 0.f); s1 += wv[8 + r] * fmaxf(acc[8 + r], 0.f); }
                { const auto rr = __builtin_amdgcn_permlane32_swap(__float_as_uint(s0), __float_as_uint(s1), false, false);
                  key[g] = okey(__uint_as_float(rr[0]) + __uint_as_float(rr[1])); }
            } else key[g] = 0u;
        }
        unsigned T = 0u;
        if (chunk >= 4) {
            bool done = false;
#pragma nounroll
            for (int bit = 31; bit >= 0; --bit) {
                if (__all(done ? 1 : 0)) break;
                const unsigned trial = T | (1u << bit);
                int cnt = 0;
#pragma unroll
                for (int tl = 0; tl < 16; ++tl) { if (tl < ntiles) {
#pragma unroll
                    for (int gg = 0; gg < 8; ++gg) cnt += (key[tl * 8 + gg] >= trial) ? 1 : 0; } }
                cnt = half_sum_i32(cnt);
                if (!done && cnt >= 256) { T = trial; if (cnt == 256) done = true; }
            }
        }
        int base = 0;
        unsigned short* ip = IDX + (size_t)(t0 + hi) * 256;
#pragma unroll
        for (int g = 0; g < 128; ++g) {
            if (g < ngroups) {
                const bool sel = key[g] >= T;
                const unsigned long long mk = __ballot(sel ? 1 : 0);
                const unsigned mh = hi ? (unsigned)(mk >> 32) : (unsigned)mk;
                const int pos = base + __popc(mh & ((1u << r32) - 1u));
                if (sel && pos < 256) ip[pos] = (unsigned short)(32 * g + r32);
                base += __popc(mh);
            }
        }
    }
#undef IX_STAGE
    asm volatile("s_waitcnt vmcnt(0) lgkmcnt(0)\n\ts_barrier" ::: "memory");
}

constexpr int DSA_PAIRB = 1040;
constexpr int DSA_WAVEB = 16 * DSA_PAIRB + 512;
constexpr int DSA_LDS_END = 8 * DSA_WAVEB;
constexpr float DSA_CS = 64.f, DSA_QS = 64.f, DSA_PS = 256.f;
typedef int v2i_t __attribute__((ext_vector_type(2)));
__device__ __forceinline__ void dsa_mfma(LAS unsigned char* lds, const bf16* QL, bf16* OL, const int omask, const unsigned char* C8, const unsigned short* IDX, int vcu, int G, const int wave) {
    const int lane = lane_fresh(), h16 = lane & 15, g = lane >> 4;
    LAS unsigned char* wl = lds + wave * DSA_WAVEB;
    const unsigned wl0 = (unsigned)(uintptr_t)wl;
    LAS unsigned short* idxs = (LAS unsigned short*)(wl + 16 * DSA_PAIRB);
    const float sc2 = 0.08838834764831845f * LOG2E / (DSA_QS * DSA_CS);
    const float sl2 = (h16 < 8) ? LOG2E / (float)(2 << (h16 & 7)) : 0.f;
    const int ntok = (G == 256) ? 8 : (M - (vcu * 8 + wave) + G * 8 - 1) / (G * 8);
#define DSA_TOK(i) ((G == 256) ? ((vcu >> 6) * SEQ + (vcu & 63) + 64 * (wave + 8 * (i))) : (vcu * 8 + wave + G * 8 * (i)))
    const unsigned qk_off = (unsigned)((h16 >> 1) * DSA_PAIRB + (h16 & 1) * 512 + 32 * g);
    const int trow = (h16 >> 1) < 4 ? 4 * g + (h16 >> 1) : 16 + 4 * g + ((h16 >> 1) - 4);
    const unsigned pv_off = (unsigned)((trow >> 1) * DSA_PAIRB + (trow & 1) * 512 + 8 * (h16 & 1));
    for (int it = 0; it < ntok; ++it) {
        const int t = DSA_TOK(it); const int tpos = t & (SEQ - 1);
        const int n = (tpos >> 6) >= 3 ? 256 : 64 * ((tpos >> 6) + 1); const int nst = n >> 5;
        const unsigned char* Cb = C8 + (size_t)(t >> 12) * SEQ * 512;
        int ln = lane; asm volatile("" : "+v"(ln));
        const int h16b = ln & 15, gb = ln >> 4;
        { const v2u iv = __builtin_nontemporal_load((const GAS v2u*)(IDX + (size_t)t * 256) + ln); *((LAS v2u*)idxs + ln) = iv; }
        pg8::v8i_t qf[4];
        { const bf16* qp = QL + (size_t)t * 4096 + (h16b & 7) * 512 + 32 * gb;
#pragma unroll
          for (int s = 0; s < 4; ++s) { unsigned w8[8];
#pragma unroll
              for (int c = 0; c < 4; ++c) { const v4u w = __builtin_nontemporal_load((const GAS v4u*)(qp + 128 * s + 8 * c));
                  w8[2 * c] = pg8::pk4_fp8(fminf(fmaxf(blo(w.x) * DSA_QS, -448.f), 448.f), fminf(fmaxf(bhi(w.x) * DSA_QS, -448.f), 448.f), fminf(fmaxf(blo(w.y) * DSA_QS, -448.f), 448.f), fminf(fmaxf(bhi(w.y) * DSA_QS, -448.f), 448.f));
                  w8[2 * c + 1] = pg8::pk4_fp8(fminf(fmaxf(blo(w.z) * DSA_QS, -448.f), 448.f), fminf(fmaxf(bhi(w.z) * DSA_QS, -448.f), 448.f), fminf(fmaxf(blo(w.w) * DSA_QS, -448.f), 448.f), fminf(fmaxf(bhi(w.w) * DSA_QS, -448.f), 448.f)); }
              qf[s] = (pg8::v8i_t){(int)w8[0], (int)w8[1], (int)w8[2], (int)w8[3], (int)w8[4], (int)w8[5], (int)w8[6], (int)w8[7]}; } }
        f32x4 o[32];
#pragma unroll
        for (int blk = 0; blk < 32; ++blk) o[blk] = (f32x4){0.f, 0.f, 0.f, 0.f};
        float mrun = -INFINITY, lrun = 0.f;
        asm volatile("s_waitcnt vmcnt(0) lgkmcnt(0)" ::: "memory");
        for (int st = 0; st < nst; ++st) {
#pragma unroll
            for (int i = 0; i < 16; ++i) { const unsigned srow = idxs[st * 32 + 2 * i + (lane >> 5)];
                glds16s(Cb, srow * 512u + (unsigned)(lane & 31) * 16u, (unsigned)__builtin_amdgcn_readfirstlane((int)(wl0 + i * DSA_PAIRB))); }
            asm volatile("s_waitcnt vmcnt(0)" ::: "memory");
            f32x4 a0 = {0.f, 0.f, 0.f, 0.f}, a1 = {0.f, 0.f, 0.f, 0.f};
#pragma unroll
            for (int s = 0; s < 4; ++s) {
                const pg8::v4i_t x0 = *(const LAS pg8::v4i_t*)(wl + qk_off + 128 * s), x1 = *(const LAS pg8::v4i_t*)(wl + qk_off + 128 * s + 16);
                const pg8::v4i_t y0 = *(const LAS pg8::v4i_t*)(wl + qk_off + 8 * DSA_PAIRB + 128 * s), y1 = *(const LAS pg8::v4i_t*)(wl + qk_off + 8 * DSA_PAIRB + 128 * s + 16);
                a0 = __builtin_amdgcn_mfma_scale_f32_16x16x128_f8f6f4(__builtin_shufflevector(x0, x1, 0, 1, 2, 3, 4, 5, 6, 7), qf[s], a0, 0, 0, 0, 0x7f7f7f7f, 0, 0x7f7f7f7f);
                a1 = __builtin_amdgcn_mfma_scale_f32_16x16x128_f8f6f4(__builtin_shufflevector(y0, y1, 0, 1, 2, 3, 4, 5, 6, 7), qf[s], a1, 0, 0, 0, 0x7f7f7f7f, 0, 0x7f7f7f7f); }
            const v2u i0 = *(const LAS v2u*)(idxs + st * 32 + 4 * g), i1 = *(const LAS v2u*)(idxs + st * 32 + 16 + 4 * g);
            const int sidx[8] = {(int)(i0.x & 0xffffu), (int)(i0.x >> 16), (int)(i0.y & 0xffffu), (int)(i0.y >> 16), (int)(i1.x & 0xffffu), (int)(i1.x >> 16), (int)(i1.y & 0xffffu), (int)(i1.y >> 16)};
            float lg[8];
#pragma unroll
            for (int r = 0; r < 8; ++r) { const int d = tpos - sidx[r]; lg[r] = (r < 4 ? a0[r & 3] : a1[r & 3]) * sc2 - sl2 * (float)(d < 0 ? -d : d); }
            float rm = fmaxf(fmaxf(fmaxf(lg[0], lg[1]), fmaxf(lg[2], lg[3])), fmaxf(fmaxf(lg[4], lg[5]), fmaxf(lg[6], lg[7])));
            rm = fmaxf(rm, __shfl_xor(rm, 16)); rm = fmaxf(rm, __shfl_xor(rm, 32));
            const float mn = fmaxf(mrun, rm), f = __builtin_amdgcn_exp2f(mrun - mn); mrun = mn;
#pragma unroll
            for (int r = 0; r < 8; ++r) lg[r] = __builtin_amdgcn_exp2f(lg[r] - mn) * DSA_PS;
            const unsigned pw0 = pg8::pk4_fp8(lg[0], lg[1], lg[2], lg[3]), pw1 = pg8::pk4_fp8(lg[4], lg[5], lg[6], lg[7]);
            { const float ps = ((__builtin_amdgcn_cvt_f32_fp8((int)pw0, 0) + __builtin_amdgcn_cvt_f32_fp8((int)pw0, 1)) + (__builtin_amdgcn_cvt_f32_fp8((int)pw0, 2) + __builtin_amdgcn_cvt_f32_fp8((int)pw0, 3)))
                           + ((__builtin_amdgcn_cvt_f32_fp8((int)pw1, 0) + __builtin_amdgcn_cvt_f32_fp8((int)pw1, 1)) + (__builtin_amdgcn_cvt_f32_fp8((int)pw1, 2) + __builtin_amdgcn_cvt_f32_fp8((int)pw1, 3)));
              lrun = lrun * f + ps; }
            const long pw = (long)(((unsigned long)pw1 << 32) | (unsigned long)pw0);
#pragma unroll
            for (int blk = 0; blk < 32; ++blk) {
                const v2i_t av = __builtin_amdgcn_ds_read_tr8_b64_v2i32((LAS v2i_t*)(wl + pv_off + 16 * blk));
                const long al = (long)(((unsigned long)(unsigned)av.y << 32) | (unsigned long)(unsigned)av.x);
                o[blk] = __builtin_amdgcn_mfma_f32_16x16x32_fp8_fp8(al, pw, o[blk] * f, 0, 0, 0);
                if ((blk & 3) == 3) __builtin_amdgcn_sched_barrier(0);
            }
        }
        float lt = lrun; lt += __shfl_xor(lt, 16); lt += __shfl_xor(lt, 32);
        const float inv = 1.f / (lt * DSA_CS);
        if (h16 < 8) {
#pragma unroll
            for (int blk = 0; blk < 32; ++blk) { const f32x4 v = o[blk] * inv;
                __builtin_nontemporal_store((v2u){cvtpk(v.x, v.y), cvtpk(v.z, v.w)}, (GAS v2u*)(OL + (size_t)(t & omask) * 4096 + h16b * 512 + 16 * blk + 4 * gb)); } }
    }
    asm volatile("s_waitcnt vmcnt(0) lgkmcnt(0)" ::: "memory");
    __syncthreads();
#undef DSA_TOK
}
static_assert(DSA_LDS_END <= RING_BYTES, "DSA LDS map");

__device__ __forceinline__ void memattn_mfma(LAS unsigned char* lds, const bf16* QM, const bf16* KV, bf16* OM, int vcu, int G, const int wave) {
    const int lane = lane_fresh(), r32 = lane & 31, hi = lane >> 5;
    const unsigned voff = (unsigned)(65536 + (4 * hi + ((lane & 15) >> 2)) * 64 + ((lane >> 4) & 1) * 32 + (lane & 3) * 8);
    for (int j = vcu; j < 256; j += G) {
        const int bh = j >> 4, qb = j & 15, b = bh >> 2, h = bh & 3;
        const bf16* Kg = KV + (size_t)b * MEMT * 1024 + h * 128; const bf16* Vg = Kg + 512;
#pragma unroll
        for (int i = 0; i < 8; ++i) { const int q = 8 * wave + i;
            glds16(Kg + (size_t)(64 * (q & 3) + lane) * 1024 + (q >> 2) * 8, (unsigned)__builtin_amdgcn_readfirstlane((int)((unsigned)(uintptr_t)lds + ((q >> 2) * 256 + 64 * (q & 3)) * 16)));
            glds16(Vg + (size_t)(16 * (q & 15) + (lane >> 2)) * 1024 + (q >> 4) * 32 + (lane & 3) * 8, (unsigned)__builtin_amdgcn_readfirstlane((int)((unsigned)(uintptr_t)lds + 65536 + (q >> 4) * 16384 + (q & 15) * 1024))); }
        const size_t qrow = (size_t)b * SEQ + qb * 256 + wave * 32 + r32;
        bf16x8 qr[8];
#pragma unroll
        for (int s = 0; s < 8; ++s) qr[s] = *(const GAS bf16x8*)(QM + qrow * 512 + h * 128 + s * 16 + hi * 8);
        f32x16 o[4];
#pragma unroll
        for (int blk = 0; blk < 4; ++blk)
#pragma unroll
            for (int r = 0; r < 16; ++r) o[blk][r] = 0.f;
        float mrun = -INFINITY, lrun = 0.f;
        asm volatile("s_waitcnt vmcnt(0) lgkmcnt(0)\n\ts_barrier" ::: "memory");
        for (int kt = 0; kt < 4; ++kt) {
            const LAS unsigned char* Kb = lds + (unsigned)((hi * 256 + 64 * kt + r32) * 16);
            f32x16 p0, p1;
#pragma unroll
            for (int r = 0; r < 16; ++r) { p0[r] = 0.f; p1[r] = 0.f; }
#pragma unroll
            for (int s = 0; s < 8; ++s) { const bf16x8 k0 = *(const LAS bf16x8*)(Kb + s * 8192), k1 = *(const LAS bf16x8*)(Kb + s * 8192 + 512);
                p0 = __builtin_amdgcn_mfma_f32_32x32x16_bf16(k0, qr[s], p0, 0, 0, 0); p1 = __builtin_amdgcn_mfma_f32_32x32x16_bf16(k1, qr[s], p1, 0, 0, 0); }
            float rm = -INFINITY;
#pragma unroll
            for (int r = 0; r < 16; ++r) rm = fmaxf(rm, fmaxf(p0[r], p1[r]));
            rm = fmaxf(rm, xhalf_f(rm));
            if (__any(rm > mrun)) { const float mn = fmaxf(mrun, rm), f = __builtin_amdgcn_exp2f(mrun - mn); mrun = mn; lrun *= f;
#pragma unroll
                for (int blk = 0; blk < 4; ++blk)
#pragma unroll
                    for (int r = 0; r < 16; ++r) o[blk][r] *= f; }
            float ls = 0.f;
#pragma unroll
            for (int r = 0; r < 16; ++r) { p0[r] = __builtin_amdgcn_exp2f(p0[r] - mrun); p1[r] = __builtin_amdgcn_exp2f(p1[r] - mrun); ls += p0[r] + p1[r]; }
            lrun += ls;
            bf16x8 pw[4];
#pragma unroll
            for (int s = 0; s < 2; ++s) {
                v4u a = {cvtpk(p0[8 * s + 0], p0[8 * s + 1]), cvtpk(p0[8 * s + 2], p0[8 * s + 3]), cvtpk(p0[8 * s + 4], p0[8 * s + 5]), cvtpk(p0[8 * s + 6], p0[8 * s + 7])};
                v4u c = {cvtpk(p1[8 * s + 0], p1[8 * s + 1]), cvtpk(p1[8 * s + 2], p1[8 * s + 3]), cvtpk(p1[8 * s + 4], p1[8 * s + 5]), cvtpk(p1[8 * s + 6], p1[8 * s + 7])};
                pw[s] = __builtin_bit_cast(bf16x8, a); pw[2 + s] = __builtin_bit_cast(bf16x8, c); }
            const LAS unsigned char* Vb = lds + voff + kt * 4096;
#pragma unroll
            for (int blk = 0; blk < 4; ++blk) {
#pragma unroll
                for (int s = 0; s < 4; ++s) {
                    const v4i16_t lo = lds_tr16(Vb + blk * 16384 + s * 1024), hh = lds_tr16(Vb + blk * 16384 + s * 1024 + 512);
                    const bf16x8 vf = {lo[0], lo[1], lo[2], lo[3], hh[0], hh[1], hh[2], hh[3]};
                    o[blk] = __builtin_amdgcn_mfma_f32_32x32x16_bf16(vf, pw[s], o[blk], 0, 0, 0);
                }
            }
        }
        __syncthreads();
        lrun += xhalf_f(lrun);
        const float inv = 1.f / lrun;
        LAS unsigned* stg = (LAS unsigned*)(lds) + wave * (32 * 65);
#pragma unroll
        for (int blk = 0; blk < 4; ++blk)
#pragma unroll
            for (int r = 0; r < 16; r += 2) { const int e = 32 * blk + (r & 3) + 8 * (r >> 2) + 4 * hi;
                stg[r32 * 65 + (e >> 1)] = cvtpk(o[blk][r] * inv, o[blk][r + 1] * inv); }
        LDS_WAIT(); asm volatile("" ::: "memory");
        bf16* orow = OM + ((size_t)b * SEQ + qb * 256 + wave * 32) * 512 + h * 128;
#pragma unroll 4
        for (int row = 0; row < 32; ++row) *((GAS unsigned*)(orow + (size_t)row * 512) + lane) = stg[row * 65 + lane];
        __syncthreads();
    }
}

constexpr int N_PHASES = 21;
struct Args { const float* in[24]; float* out; unsigned char* ws; int ph_lo, ph_hi; };
__global__ void __launch_bounds__(NWAVES * 64, 2) mk_fwd(Args args) {
    extern __shared__ __attribute__((aligned(16))) unsigned char lds_raw[];
    LAS unsigned char* lds = (LAS unsigned char*)lds_raw;
    volatile LAS unsigned* MISC = (volatile LAS unsigned*)(lds + MISC_OFF);
    const int tid = threadIdx.x, wave = __builtin_amdgcn_readfirstlane(tid >> 6);
#define lane lane_fresh()
    const int G = gridDim.x; int bx = blockIdx.x;
    int vcu = (G % 8 == 0) ? (bx % 8) * (G / 8) + bx / 8 : bx;
    int gw = vcu * NWAVES + wave; const int NGW = G * NWAVES;
    unsigned char* ws = args.ws;
    gu32* ctl = (gu32*)(ws + WS_CTL);
    for (int u = tid; u < (LDS_BYTES - LDSCTL_OFF) / 4; u += NWAVES * 64) ((LAS unsigned*)(lds + LDSCTL_OFF))[u] = 0u;
    __syncthreads();
    const bool one = (args.ph_hi - args.ph_lo) > 1;
    XcdBarrier bar; bar.bar = (unsigned*)(ctl + CW_BAR); bar.x = 0; bar.st = nullptr;
    if (one) bar = xcd_barrier_post((unsigned*)(ctl + CW_BAR), MISC + 8, tid == 0);
    const int lo = args.ph_lo, hi = args.ph_hi;
#ifndef PH_MASK
#define PH_MASK 0xFFFFFFFFu
#endif
#define IN(k) ((((PH_MASK) >> (k)) & 1u) && lo <= (k) && (k) < hi)
#define SEAM(k) do { if (IN(k) && IN((k) + 1)) xcd_barrier(bar, wave); } while (0)
    bf16* const X16 = (bf16*)(ws + WS_X16); bf16* const HB = (bf16*)(ws + WS_H);
    long long* const ST0 = (long long*)(ws + WS_CTL + CTL_STATS); long long* const ST1 = (long long*)(ws + WS_CTL + CTL_STATS + CTL_STATS_STRIDE); long long* const ST2 = (long long*)(ws + WS_CTL + CTL_STATS + 2 * CTL_STATS_STRIDE);
    const float* const VEC = (const float*)(ws + WS_CTL + CTL_VECF);
    float* const out = args.out;
    const float* const ln_g = args.in[22]; const float* const ln_b = args.in[23];
    using namespace pg8;

#ifdef PROBE_P0
    if (IN(0)) { p0_prologue(args.in, ws, lds, gw, NGW, wave, lane); }
#endif
    if (IN(0)) { p0_prologue(args.in, ws, lds, gw, NGW, wave, lane); }
    SEAM(0);
    if (one && IN(0) && (G % 8) == 0) {
        unsigned* xb = (unsigned*)(ctl + CW_BAR); bool even = true;
#pragma unroll
        for (int jx = 0; jx < 16; ++jx) { const unsigned c = xb_ld(&xb[XB_XCNT(jx)]); even = even && (jx < 8 ? c == (unsigned)(G / 8) : c == 0u); }
        const int rank = (int)MISC[10], xcc = (int)xb_xcc_id();
        if (__builtin_amdgcn_readfirstlane(even ? 1 : 0)) { vcu = __builtin_amdgcn_readfirstlane(xcc * (G / 8) + rank); bx = __builtin_amdgcn_readfirstlane(rank * 8 + xcc); gw = vcu * NWAVES + wave; }
    }
    if (IN(1)) { { const long long* vi = (const long long*)(ws + WS_CTL + CTL_VEC); float* vf = (float*)(ws + WS_CTL + CTL_VECF); for (int i = gw * 64 + lane; i < V_END; i += NGW * 64) vf[i] = (float)vi[i] * (1.0f / 16777216.f); }
        Gemm g{(const bf16*)(ws + WS_X8), (const bf16*)(ws + WS_W_GU1), D / 2, D / 2, D / 2, 0, 0}; StaticOrder S; S.init(M, 2 * FF, G, bx); EpiSwiGLU8 E{(unsigned char*)HB, FF, 1.0f / (FP8_XS * FP8_WGUS), FP8_HS, LnFold{nullptr, nullptr, nullptr}};
        gemm_phase<EpiSwiGLU8, StaticOrder, true, true>(lds + RING_OFF, g, S, E, wave); }
    SEAM(1);
    if (IN(2)) { Gemm g{HB, (const bf16*)(ws + WS_W_D1), FF / 2, FF / 2, FF / 2, 0, 0}; StaticOrder S; S.init(M, D, G, bx); EpiRes<true> E{args.in[0], nullptr, D, ALPHA, 0.5f / (FP8_HS * FP8_WDS), nullptr, nullptr, nullptr, ST0, X16, (unsigned char*)(ws + WS_X8M), FP8_XS};
        gemm_phase<EpiRes<true>, StaticOrder, true, true>(lds + RING_OFF, g, S, E, wave); }
    SEAM(2);
    if (IN(4)) {
        { Gemm g{X16, (const bf16*)(ws + WS_W_IN), D, D, D, 0, 0}; StaticOrder S; S.init(M, N_IN, G, bx);
          EpiInProj E{(bf16*)(ws + WS_AQ), (bf16*)(ws + WS_AK), (bf16*)(ws + WS_AV), (bf16*)(ws + WS_BQ), (bf16*)(ws + WS_BC), (bf16*)(ws + WS_IQ), (bf16*)(ws + WS_IKW), QSCALE, LnFold{ST0, VEC + V_GW_IN, VEC + V_BW_IN}, (unsigned*)(ctl + CW_KMAX)};
          gemm_phase<EpiInProj, StaticOrder, true>(lds + RING_OFF, g, S, E, wave); }
        { Gemm g{(const bf16*)(ws + WS_MEM16), (const bf16*)(ws + WS_W_MKV), D, D, D, 0, 0}; StaticOrder S; S.init(BATCH * MEMT, 1024, G, bx >= G - 16 ? bx - (G - 16) : (1 << 20)); EpiBf16 E{(bf16*)(ws + WS_KVMEM), 1024};
          gemm_phase<EpiBf16, StaticOrder, true>(lds + RING_OFF, g, S, E, wave); }
    }
    SEAM(4);
    if (IN(5)) {
        { Gemm g{(const bf16*)(ws + WS_BQ), (const bf16*)(ws + WS_W_UK), 1024, 128, 128, 1, 128}; StaticOrder S; S.init(M, 4096, G, bx); EpiBf16 E{(bf16*)(ws + WS_QLAT), 4096};
          gemm_phase<EpiBf16, StaticOrder, true>(lds + RING_OFF, g, S, E, wave); }
        crms_phase((const bf16*)(ws + WS_BC), (unsigned char*)(ws + WS_C8), args.in[8], DSA_CS, gw, NGW, lane);
    }
    if (IN(7)) indexer_topk(lds, (const bf16*)(ws + WS_IQ), (const bf16*)(ws + WS_IKW), (unsigned short*)(ws + WS_IDX), vcu, G, wave);
    if (IN(7)) diff_attn_mfma(lds, (const bf16*)(ws + WS_AQ), (const bf16*)(ws + WS_AK), (const bf16*)(ws + WS_AV), (bf16*)(ws + WS_AQ), args.in[6], args.in[7], (unsigned*)(ctl + CW_DQ), (const unsigned*)(ctl + CW_KMAX), wave);
    SEAM(7);
    if (IN(8)) dsa_mfma(lds, (const bf16*)(ws + WS_QLAT), (bf16*)(ws + WS_QLAT), 0x7fffffff, (const unsigned char*)(ws + WS_C8), (const unsigned short*)(ws + WS_IDX), vcu, G, wave);
    SEAM(8);
    if (IN(9)) { Gemm g{(const bf16*)(ws + WS_QLAT), (const bf16*)(ws + WS_W_UVP), 4096, 1024, 1024, 0, 1024}; StaticOrder S; S.init(M, 1024, G, bx); EpiBf16 E{(bf16*)(ws + WS_YB), 1024};
        gemm_phase<EpiBf16, StaticOrder, true>(lds + RING_OFF, g, S, E, wave); }
    SEAM(9);
    if (IN(10)) {
        { Gemm g{(const bf16*)(ws + WS_AQ), (const bf16*)(ws + WS_W_A), 1024, 1024, 1024, 0, 0}; StaticOrder S; S.init(M, D, G, bx); EpiBf16 E{(bf16*)(ws + WS_TA), D}; gemm_phase<EpiBf16, StaticOrder, true>(lds + RING_OFF, g, S, E, wave); }
        { Gemm g{(const bf16*)(ws + WS_YB), (const bf16*)(ws + WS_W_B), 1024, 1024, 1024, 0, 0}; StaticOrder S; S.init(M, D, G, bx); EpiBf16 E{(bf16*)(ws + WS_TB), D}; gemm_phase<EpiBf16, StaticOrder, true>(lds + RING_OFF, g, S, E, wave); }
    }
    SEAM(10);
    if (IN(11)) { Gemm g{(const bf16*)(ws + WS_X8M), (const bf16*)(ws + WS_W_G), D / 2, D / 2, D / 2, 0, 0}; StaticOrder S; S.init(M, 2 * D, G, bx);
        EpiGateMerge8 E{(const bf16*)(ws + WS_TA), (const bf16*)(ws + WS_TB), (unsigned char*)(ws + WS_MRG8), D, args.in[12], args.in[12] + D, 1.0f / (FP8_XS * FP8_WGS), FP8_MS, LnFold{ST0, VEC + V_GW_G, VEC + V_BW_G}};
        gemm_phase<EpiGateMerge8, StaticOrder, true, true>(lds + RING_OFF, g, S, E, wave); }
    SEAM(11);
    if (IN(12)) { Gemm g{(const bf16*)(ws + WS_MRG8), (const bf16*)(ws + WS_W_MO), D / 2, D / 2, D / 2, 0, 0}; StaticOrder S; S.init(M, D, G, bx); EpiRes<false, 1> E{nullptr, X16, D, ALPHA, 1.0f / (FP8_MS * FP8_WMOS), ST0, ln_g, ln_b, ST1, X16, nullptr, 0.f};
        gemm_phase<EpiRes<false, 1>, StaticOrder, true, true>(lds + RING_OFF, g, S, E, wave); }
    SEAM(12);
    if (IN(14)) { Gemm g{X16, (const bf16*)(ws + WS_W_MQ), D, D, D, 0, 0}; StaticOrder S; S.init(M, 512, G, bx); EpiBf16 E{(bf16*)(ws + WS_QM), 512, 0.08838834764831845f * LOG2E, LnFold{ST1, VEC + V_GW_MQ, VEC + V_BW_MQ}}; gemm_phase<EpiBf16, StaticOrder, true>(lds + RING_OFF, g, S, E, wave); }
    SEAM(14);
    if (IN(15)) memattn_mfma(lds, (const bf16*)(ws + WS_QM), (const bf16*)(ws + WS_KVMEM), (bf16*)(ws + WS_OM), vcu, G, wave);
    SEAM(15);
    if (IN(16)) { Gemm g{(const bf16*)(ws + WS_OM), (const bf16*)(ws + WS_W_MOUT), 512, 512, 512, 0, 0}; StaticOrder S; S.init(M, D, G, bx); EpiRes<false> E{nullptr, X16, D, ALPHA, 1.0f, ST1, ln_g + D, ln_b + D, ST2, X16, (unsigned char*)(ws + WS_X8), FP8_XS};
        gemm_phase<EpiRes<false>, StaticOrder, true>(lds + RING_OFF, g, S, E, wave); }
    SEAM(16);
    if (IN(18)) { Gemm g{(const bf16*)(ws + WS_X8), (const bf16*)(ws + WS_W_GU2), D / 2, D / 2, D / 2, 0, 0}; StaticOrder S; S.init(M, 2 * FF, G, bx); EpiSwiGLU8 E{(unsigned char*)HB, FF, 1.0f / (FP8_XS * FP8_WGUS), FP8_HS, LnFold{ST2, VEC + V_GW_GU2, VEC + V_BW_GU2}};
        gemm_phase<EpiSwiGLU8, StaticOrder, true, true>(lds + RING_OFF, g, S, E, wave); }
    SEAM(18);
    if (IN(19)) { Gemm g{HB, (const bf16*)(ws + WS_W_D2), FF / 2, FF / 2, FF / 2, 0, 0}; StaticOrder S; S.init(M, D, G, bx); EpiRes<false> E{nullptr, X16, D, ALPHA, 0.5f / (FP8_HS * FP8_WDS), ST2, ln_g + 2 * D, ln_b + 2 * D, nullptr, X16, nullptr, 0.f};
        gemm_phase<EpiRes<false>, StaticOrder, true, true>(lds + RING_OFF, g, S, E, wave); }
    SEAM(19);
    if (IN(20)) ln_final_phase(X16, out, ln_g + 3 * D, ln_b + 3 * D, gw, NGW, lane);
#undef IN
#undef SEAM
#undef lane
}

extern "C" void kernel_launch(void* const* d_in, const int* in_sizes, int n_in, void* d_out, int out_size, void* d_ws, size_t ws_size, hipStream_t stream) {
    static int grid = 0;
    if (grid == 0) {
        if (n_in != 24 || in_sizes[0] != M * D || out_size != M * D || ws_size < WS_END) { fprintf(stderr, "kernel_launch: unexpected shapes (n_in %d, in0 %d, out %d, ws %zu); nothing launched\n", n_in, n_in > 0 ? in_sizes[0] : -1, out_size, ws_size); grid = -1; return; }
        int dev = 0, cus = 0, per_cu = 0;
        if (hipGetDevice(&dev) != hipSuccess || hipDeviceGetAttribute(&cus, hipDeviceAttributeMultiprocessorCount, dev) != hipSuccess) { grid = -1; return; }
        if (hipFuncSetAttribute((const void*)mk_fwd, hipFuncAttributeMaxDynamicSharedMemorySize, LDS_BYTES) != hipSuccess) { fprintf(stderr, "kernel_launch: hipFuncSetAttribute failed\n"); grid = -1; return; }
        if (hipOccupancyMaxActiveBlocksPerMultiprocessor(&per_cu, (const void*)mk_fwd, NWAVES * 64, LDS_BYTES) != hipSuccess || per_cu < 1)
            fprintf(stderr, "kernel_launch: note: the occupancy query reports %d workgroups per CU\n", per_cu);
        (void)hipGetLastError();
        grid = cus;
    }
    if (grid < 0) return;
    if (hipMemsetAsync((char*)d_ws + WS_CTL, 0, CTL_ZERO_BYTES, stream) != hipSuccess) return;
    Args a{};
    for (int i = 0; i < 24; ++i) a.in[i] = (const float*)d_in[i];
    a.out = (float*)d_out; a.ws = (unsigned char*)d_ws;
#if MK_ONE_LAUNCH
    a.ph_lo = 0; a.ph_hi = N_PHASES;
    hipLaunchKernelGGL(mk_fwd, dim3(grid), dim3(NWAVES * 64), LDS_BYTES, stream, a);
#else
    for (int p = 0; p < N_PHASES; ++p) { a.ph_lo = p; a.ph_hi = p + 1; hipLaunchKernelGGL(mk_fwd, dim3(grid), dim3(NWAVES * 64), LDS_BYTES, stream, a); }
#endif
}
```

```cpp
#include <hip/hip_runtime.h>
#include <cstdio>
#include <cstdint>

#ifndef MK_ONE_LAUNCH
#define MK_ONE_LAUNCH 1
#endif

__device__ __forceinline__ int lane_fresh() { int l = (int)__builtin_amdgcn_mbcnt_hi(~0u, __builtin_amdgcn_mbcnt_lo(~0u, 0u)); asm volatile("" : "+v"(l)); return l; }
__device__ __forceinline__ void glds16(const void* gsrc, unsigned lds_dst) { unsigned keep;
    asm volatile("s_mov_b32 %0, m0\n\ts_mov_b32 m0, %2\n\ts_nop 0\n\tglobal_load_lds_dwordx4 %1, off\n\ts_mov_b32 m0, %0" : "=&s"(keep) : "v"(gsrc), "s"(lds_dst) : "memory"); }
__device__ __forceinline__ void glds16s(const void* sbase, unsigned voff, unsigned lds_dst) { unsigned keep;
    asm volatile("s_mov_b32 %0, m0\n\ts_mov_b32 m0, %3\n\ts_nop 0\n\tglobal_load_lds_dwordx4 %1, %2\n\ts_mov_b32 m0, %0" : "=&s"(keep) : "v"(voff), "s"(sbase), "s"(lds_dst) : "memory"); }
namespace pg8 {
#define PG8_LAS __attribute__((address_space(3)))
typedef unsigned short bf16_t;
typedef short bf16x8 __attribute__((ext_vector_type(8)));
typedef float f32x4 __attribute__((ext_vector_type(4)));
typedef unsigned u32x4 __attribute__((ext_vector_type(4)));
constexpr int BM = 256, BK = 64, HALF = 128, HTB = HALF * BK * 2  , STAGE_BYTES = 8 * HTB, NXCD = 8, WGM = 8;

__host__ __device__ __forceinline__ int lds_byte(int r, int c) { const int st = (r >> 4) * 2 + (c >> 5), rr = r & 15, cc = c & 31, ob = rr * 64 + cc * 2; return st * 1024 + (ob ^ (((ob >> 9) & 1) << 5)); }
__host__ __device__ __forceinline__ void stage_rc(int b, int& R, int& C) { const int st = b / 1024, sb = b % 1024, swz = sb ^ (((sb >> 9) & 1) << 5); R = (st >> 1) * 16 + swz / 64; C = (st & 1) * 32 + (swz % 64) / 2; }
__host__ __device__ __forceinline__ int perm32(int rho) { const int n = rho >> 4, i = rho & 15; return 8 * (i >> 2) + 4 * n + (i & 3); }

struct Unit { int pm, pn; };
struct Gemm { const bf16_t* A; const bf16_t* Bt; int lda, ldb, K, a_shift, a_mul; };

struct StaticOrder {
    int nM, nN, nwg, G, c;
    __host__ __device__ void init(int M, int N, int G_, int c_) { nM = M / BM; nN = N / BM; nwg = nM * nN; G = G_; c = c_; }
    __host__ __device__ bool next(int i, Unit& u) const {
        const long L = (long)i * G + c; if (L >= nwg) return false;
        int wgid = (int)L; { const int q = nwg / NXCD, r = nwg % NXCD, xcd = wgid % NXCD, off = wgid / NXCD; wgid = (xcd < r ? xcd * (q + 1) : r * (q + 1) + (xcd - r) * q) + off; }
        const int nig = WGM * nN, gid = wgid / nig, fm = gid * WGM, gsz = (nM - fm) < WGM ? (nM - fm) : WGM;
        u.pm = fm + ((wgid % nig) % gsz); u.pn = (wgid % nig) / gsz; return true;
    }
    __device__ __forceinline__ void a_ready(const Unit&) const {}
    __device__ __forceinline__ void done(const Unit&) const {}
};

__device__ __forceinline__ unsigned cvt_pk_bf16(float lo, float hi) { unsigned r; asm volatile("v_cvt_pk_bf16_f32 %0, %1, %2" : "=v"(r) : "v"(lo), "v"(hi)); return r; }
__device__ __forceinline__ float bflo(unsigned w) { return __uint_as_float(w << 16); }
__device__ __forceinline__ float bfhi(unsigned w) { return __uint_as_float(w & 0xffff0000u); }
__device__ __forceinline__ float sigmoidf_fast(float x) { return __builtin_amdgcn_rcpf(1.0f + __builtin_amdgcn_exp2f(-1.4426950408889634f * x)); }

struct LnFold {
    const long long* stats; const float* gW; const float* bW;
    __device__ __forceinline__ void row(int r, float& mean, float& rstd) const { const long long s0 = stats[2 * (size_t)r], s1 = stats[2 * (size_t)r + 1];
        mean = (float)s0 * (1.0f / (1048576.f * 2048.0f)); rstd = __builtin_amdgcn_rsqf((float)s1 * (1.0f / (65536.f * 2048.0f)) - mean * mean + 1e-5f); }
    __device__ __forceinline__ f32x4 vec4(const float* v, int i) const { return *(const f32x4*)(v + i); }
    __device__ __forceinline__ void rows8(int row0, float (&mean)[8], float (&rstd)[8]) const {
#pragma unroll
        for (int hf = 0; hf < 2; ++hf) { long long s0[4], s1[4];
#pragma unroll
            for (int q = 0; q < 4; ++q) { const size_t r = (size_t)(row0 + hf * 128 + q * 16); s0[q] = stats[2 * r]; s1[q] = stats[2 * r + 1]; }
#pragma unroll
            for (int q = 0; q < 4; ++q) { const float mu = (float)s0[q] * (1.0f / (1048576.f * 2048.0f)); mean[4 * hf + q] = mu; rstd[4 * hf + q] = __builtin_amdgcn_rsqf((float)s1[q] * (1.0f / (65536.f * 2048.0f)) - mu * mu + 1e-5f); }
            asm volatile("" : "+v"(mean[4 * hf]), "+v"(mean[4 * hf + 1]), "+v"(mean[4 * hf + 2]), "+v"(mean[4 * hf + 3]), "+v"(rstd[4 * hf]), "+v"(rstd[4 * hf + 1]), "+v"(rstd[4 * hf + 2]), "+v"(rstd[4 * hf + 3]) :: "memory"); }
    }
};
struct EpiBf16 {
    static constexpr bool PERM = true, AFTER_DRAIN = false;
    bf16_t* O; int ldc; float sc = 1.0f; LnFold lf = {nullptr, nullptr, nullptr};
    __device__ __forceinline__ void operator()(const f32x4 (&acc)[2][2][4][2], const Unit& u, int wr, int wc, int fr, int fq) const {
        const int row0 = u.pm * BM + wr * 64 + fr, col0 = u.pn * BM + wc * 32 + 8 * fq;
        f32x4 gw[2][2], bw[2][2];
#pragma unroll
        for (int bj = 0; bj < 2; ++bj)
#pragma unroll
            for (int n = 0; n < 2; ++n) { gw[bj][n] = (f32x4){0.f, 0.f, 0.f, 0.f}; bw[bj][n] = (f32x4){0.f, 0.f, 0.f, 0.f}; if (lf.stats) { gw[bj][n] = lf.vec4(lf.gW, col0 + bj * HALF + 4 * n); bw[bj][n] = lf.vec4(lf.bW, col0 + bj * HALF + 4 * n); } }
        float mean8[8], rstd8[8];
#pragma unroll
        for (int q = 0; q < 8; ++q) { mean8[q] = 0.f; rstd8[q] = 1.f; }
        if (lf.stats) lf.rows8(row0, mean8, rstd8);
#pragma unroll
        for (int ai = 0; ai < 2; ++ai)
#pragma unroll
            for (int m = 0; m < 4; ++m) { bf16_t* rowp = O + (size_t)(row0 + ai * HALF + m * 16) * ldc + col0;
                const float mean = mean8[ai * 4 + m], rstd = rstd8[ai * 4 + m];
#pragma unroll
                for (int bj = 0; bj < 2; ++bj) { const f32x4 v0 = ((acc[ai][bj][m][0] - gw[bj][0] * mean) * rstd + bw[bj][0]) * sc, v1 = ((acc[ai][bj][m][1] - gw[bj][1] * mean) * rstd + bw[bj][1]) * sc;
                    u32x4 w; w.x = cvt_pk_bf16(v0[0], v0[1]); w.y = cvt_pk_bf16(v0[2], v0[3]); w.z = cvt_pk_bf16(v1[0], v1[1]); w.w = cvt_pk_bf16(v1[2], v1[3]);
                    *(u32x4*)(rowp + bj * HALF) = w; } }
    }
};
struct EpiInProj {
    static constexpr bool PERM = true, AFTER_DRAIN = false;
    bf16_t *aq, *ak, *av, *bq, *bc, *iq, *ikw; float qscale; LnFold lf; unsigned* kmax;
    __device__ __forceinline__ void operator()(const f32x4 (&acc)[2][2][4][2], const Unit& u, int wr, int wc, int fr, int fq) const {
        bf16_t* base; int ldc, colt; const int pn = u.pn;
        if (pn < 4) { base = aq; ldc = 1024; colt = pn * 256; }
        else if (pn < 8) { base = ak; ldc = 1024; colt = (pn - 4) * 256; }
        else if (pn < 12) { base = av; ldc = 1024; colt = (pn - 8) * 256; }
        else if (pn < 16) { base = bq; ldc = 1024; colt = (pn - 12) * 256; }
        else if (pn < 18) { base = bc; ldc = 512; colt = (pn - 16) * 256; }
        else if (pn < 22) { base = iq; ldc = 1024; colt = (pn - 18) * 256; }
        else { base = ikw; ldc = 256; colt = 0; }
        const float sc = (pn < 4) ? qscale : 1.0f; float kam[2] = {0.f, 0.f};
        const int row0 = u.pm * BM + wr * 64 + fr, col0 = colt + wc * 32 + 8 * fq, cidx = pn * BM + wc * 32 + 8 * fq;
        f32x4 gw[2][2], bw[2][2];
#pragma unroll
        for (int bj = 0; bj < 2; ++bj)
#pragma unroll
            for (int n = 0; n < 2; ++n) { gw[bj][n] = lf.vec4(lf.gW, cidx + bj * HALF + 4 * n); bw[bj][n] = lf.vec4(lf.bW, cidx + bj * HALF + 4 * n); }
        float mean8[8], rstd8[8]; lf.rows8(row0, mean8, rstd8);
#pragma unroll
        for (int ai = 0; ai < 2; ++ai)
#pragma unroll
            for (int m = 0; m < 4; ++m) { bf16_t* rowp = base + (size_t)(row0 + ai * HALF + m * 16) * ldc + col0;
                const float mean = mean8[ai * 4 + m], rstd = rstd8[ai * 4 + m];
#pragma unroll
                for (int bj = 0; bj < 2; ++bj) { const f32x4 v0 = ((acc[ai][bj][m][0] - gw[bj][0] * mean) * rstd + bw[bj][0]) * sc, v1 = ((acc[ai][bj][m][1] - gw[bj][1] * mean) * rstd + bw[bj][1]) * sc;
                    kam[bj] = fmaxf(kam[bj], fmaxf(fmaxf(fmaxf(fabsf(v0[0]), fabsf(v0[1])), fmaxf(fabsf(v0[2]), fabsf(v0[3]))), fmaxf(fmaxf(fabsf(v1[0]), fabsf(v1[1])), fmaxf(fabsf(v1[2]), fabsf(v1[3])))));
                    u32x4 w; w.x = cvt_pk_bf16(v0[0], v0[1]); w.y = cvt_pk_bf16(v0[2], v0[3]); w.z = cvt_pk_bf16(v1[0], v1[1]); w.w = cvt_pk_bf16(v1[2], v1[3]);
                    *(u32x4*)(rowp + bj * HALF) = w; } }
        if (pn >= 4 && pn < 8) {
#pragma unroll
            for (int bj = 0; bj < 2; ++bj) { float v = kam[bj];
#pragma unroll
                for (int o = 1; o < 64; o <<= 1) v = fmaxf(v, __shfl_xor(v, o));
                if ((fr | fq) == 0) (void)__hip_atomic_fetch_max(kmax + ((u.pm >> 4) * 8 + 2 * (pn - 4) + bj) * 2 + (wc >> 1), __float_as_uint(v), __ATOMIC_RELAXED, __HIP_MEMORY_SCOPE_AGENT); } }
    }
};
struct EpiSwiGLU {
    static constexpr bool PERM = true, AFTER_DRAIN = false;
    bf16_t* O; int ldc;
    __device__ __forceinline__ void operator()(const f32x4 (&acc)[2][2][4][2], const Unit& u, int wr, int wc, int fr, int fq) const {
        const int row0 = u.pm * BM + wr * 64 + fr, col0 = u.pn * HALF + wc * 32 + 8 * fq;
#pragma unroll
        for (int ai = 0; ai < 2; ++ai)
#pragma unroll
            for (int m = 0; m < 4; ++m) { bf16_t* rowp = O + (size_t)(row0 + ai * HALF + m * 16) * ldc + col0;
                float h[8];
#pragma unroll
                for (int n = 0; n < 2; ++n)
#pragma unroll
                    for (int j = 0; j < 4; ++j) { const float g = acc[ai][0][m][n][j], up = acc[ai][1][m][n][j]; h[4 * n + j] = g * sigmoidf_fast(g) * up; }
                u32x4 w; w.x = cvt_pk_bf16(h[0], h[1]); w.y = cvt_pk_bf16(h[2], h[3]); w.z = cvt_pk_bf16(h[4], h[5]); w.w = cvt_pk_bf16(h[6], h[7]);
                *(u32x4*)rowp = w; }
    }
};
__device__ __forceinline__ unsigned pk4_fp8(float a, float b, float c, float d) { int w = 0; w = __builtin_amdgcn_cvt_pk_fp8_f32(a, b, w, false); w = __builtin_amdgcn_cvt_pk_fp8_f32(c, d, w, true); return (unsigned)w; }
struct EpiSwiGLU8 {
    static constexpr bool PERM = true, AFTER_DRAIN = false;
    unsigned char* O; int ldc; float ascale, hs; LnFold lf;
    __device__ __forceinline__ void operator()(const f32x4 (&acc)[2][2][4][2], const Unit& u, int wr, int wc, int fr, int fq) const {
        const int row0 = u.pm * BM + wr * 64 + fr, col0 = u.pn * HALF + wc * 32 + 8 * fq, cidx = u.pn * BM + wc * 32 + 8 * fq;
        typedef unsigned u32x2 __attribute__((ext_vector_type(2)));
        f32x4 gw[2][2], bw[2][2];
#pragma unroll
        for (int bj = 0; bj < 2; ++bj)
#pragma unroll
            for (int n = 0; n < 2; ++n) { gw[bj][n] = (f32x4){0.f, 0.f, 0.f, 0.f}; bw[bj][n] = (f32x4){0.f, 0.f, 0.f, 0.f}; if (lf.stats) { gw[bj][n] = lf.vec4(lf.gW, cidx + bj * HALF + 4 * n); bw[bj][n] = lf.vec4(lf.bW, cidx + bj * HALF + 4 * n); } }
        float mean8[8], rstd8[8];
#pragma unroll
        for (int q = 0; q < 8; ++q) { mean8[q] = 0.f; rstd8[q] = 1.f; }
        if (lf.stats) lf.rows8(row0, mean8, rstd8);
#pragma unroll
        for (int ai = 0; ai < 2; ++ai)
#pragma unroll
            for (int m = 0; m < 4; ++m) { unsigned char* rowp = O + (size_t)(row0 + ai * HALF + m * 16) * ldc + col0;
                float h[8]; const float mean = mean8[ai * 4 + m], rstd = rstd8[ai * 4 + m];
#pragma unroll
                for (int n = 0; n < 2; ++n)
#pragma unroll
                    for (int j = 0; j < 4; ++j) { const float g = (acc[ai][0][m][n][j] * ascale - gw[0][n][j] * mean) * rstd + bw[0][n][j], up = (acc[ai][1][m][n][j] * ascale - gw[1][n][j] * mean) * rstd + bw[1][n][j];
                        h[4 * n + j] = fminf(fmaxf(g * sigmoidf_fast(g) * up * hs, -448.f), 448.f); }
                *(u32x2*)rowp = (u32x2){pk4_fp8(h[0], h[1], h[2], h[3]), pk4_fp8(h[4], h[5], h[6], h[7])}; }
    }
};
struct EpiGateMerge {
    static constexpr bool PERM = true, AFTER_DRAIN = false;
    const bf16_t* ta; const bf16_t* tb; bf16_t* O; int ldc; const float* b0; const float* b1;
    __device__ __forceinline__ void operator()(const f32x4 (&acc)[2][2][4][2], const Unit& u, int wr, int wc, int fr, int fq) const {
        const int row0 = u.pm * BM + wr * 64 + fr, col0 = u.pn * HALF + wc * 32 + 8 * fq;
        float bb0[8], bb1[8];
#pragma unroll
        for (int j = 0; j < 8; ++j) { bb0[j] = b0[col0 + j]; bb1[j] = b1[col0 + j]; }
#pragma unroll
        for (int ai = 0; ai < 2; ++ai)
#pragma unroll
            for (int m = 0; m < 4; ++m) { const size_t off = (size_t)(row0 + ai * HALF + m * 16) * ldc + col0;
                const u32x4 a = *(const u32x4*)(ta + off), b = *(const u32x4*)(tb + off);
                const float av[8] = {bflo(a.x), bfhi(a.x), bflo(a.y), bfhi(a.y), bflo(a.z), bfhi(a.z), bflo(a.w), bfhi(a.w)};
                const float bv[8] = {bflo(b.x), bfhi(b.x), bflo(b.y), bfhi(b.y), bflo(b.z), bfhi(b.z), bflo(b.w), bfhi(b.w)};
                float h[8];
#pragma unroll
                for (int n = 0; n < 2; ++n)
#pragma unroll
                    for (int j = 0; j < 4; ++j) { const int e = 4 * n + j; h[e] = sigmoidf_fast(acc[ai][0][m][n][j] + bb0[e]) * av[e] + sigmoidf_fast(acc[ai][1][m][n][j] + bb1[e]) * bv[e]; }
                u32x4 w; w.x = cvt_pk_bf16(h[0], h[1]); w.y = cvt_pk_bf16(h[2], h[3]); w.z = cvt_pk_bf16(h[4], h[5]); w.w = cvt_pk_bf16(h[6], h[7]);
                *(u32x4*)(O + off) = w; }
    }
};
struct EpiGateMerge8 {
    static constexpr bool PERM = true, AFTER_DRAIN = false;
    const bf16_t* ta; const bf16_t* tb; unsigned char* O; int ldc; const float* b0; const float* b1; float ascale, ms; LnFold lf;
    __device__ __forceinline__ void operator()(const f32x4 (&acc)[2][2][4][2], const Unit& u, int wr, int wc, int fr, int fq) const {
        const int row0 = u.pm * BM + wr * 64 + fr, col0 = u.pn * HALF + wc * 32 + 8 * fq, cidx = u.pn * BM + wc * 32 + 8 * fq;
        typedef unsigned u32x2 __attribute__((ext_vector_type(2)));
        float mean8[8], rstd8[8]; lf.rows8(row0, mean8, rstd8);
        float bb0[8], bb1[8], gw0[8], gw1[8];
#pragma unroll
        for (int j = 0; j < 8; ++j) { bb0[j] = b0[col0 + j] + lf.bW[cidx + j]; bb1[j] = b1[col0 + j] + lf.bW[cidx + HALF + j]; gw0[j] = lf.gW[cidx + j]; gw1[j] = lf.gW[cidx + HALF + j]; }
#pragma unroll
        for (int am = 0; am < 8; am += 2) {
            u32x4 pa[2], pb[2];
#pragma unroll
            for (int e2 = 0; e2 < 2; ++e2) { const size_t off = (size_t)(row0 + ((am + e2) >> 2) * HALF + ((am + e2) & 3) * 16) * ldc + col0; pa[e2] = *(const u32x4*)(ta + off); pb[e2] = *(const u32x4*)(tb + off); }
#pragma unroll
            for (int e2 = 0; e2 < 2; ++e2) { const int ai = (am + e2) >> 2, m = (am + e2) & 3; const size_t off = (size_t)(row0 + ai * HALF + m * 16) * ldc + col0;
                const u32x4 a = pa[e2], b = pb[e2];
                const float av[8] = {bflo(a.x), bfhi(a.x), bflo(a.y), bfhi(a.y), bflo(a.z), bfhi(a.z), bflo(a.w), bfhi(a.w)};
                const float bv[8] = {bflo(b.x), bfhi(b.x), bflo(b.y), bfhi(b.y), bflo(b.z), bfhi(b.z), bflo(b.w), bfhi(b.w)};
                float h[8]; const float mean = mean8[ai * 4 + m], rstd = rstd8[ai * 4 + m];
#pragma unroll
                for (int n = 0; n < 2; ++n)
#pragma unroll
                    for (int j = 0; j < 4; ++j) { const int e = 4 * n + j; const float v = sigmoidf_fast((acc[ai][0][m][n][j] * ascale - gw0[e] * mean) * rstd + bb0[e]) * av[e] + sigmoidf_fast((acc[ai][1][m][n][j] * ascale - gw1[e] * mean) * rstd + bb1[e]) * bv[e];
                        h[e] = fminf(fmaxf(v * ms, -448.f), 448.f); }
                *(u32x2*)(O + off) = (u32x2){pk4_fp8(h[0], h[1], h[2], h[3]), pk4_fp8(h[4], h[5], h[6], h[7])}; }
            asm volatile("" ::: "memory"); }
    }
};
template <bool RES32, int NB = 2> struct EpiRes {
    static constexpr bool PERM = true, AFTER_DRAIN = false;
    const float* res32; const bf16_t* res16; int ldc; float alpha, s;
    const long long* rstats; const float* rg; const float* rb; long long* ostats; bf16_t* o16; unsigned char* o8; float o8s;
    __device__ __forceinline__ void operator()(const f32x4 (&acc)[2][2][4][2], const Unit& u, int wr, int wc, int fr, int fq) const {
        const int col0 = u.pn * BM + wc * 32 + 8 * fq;
        typedef unsigned u32x2 __attribute__((ext_vector_type(2)));
        float al = alpha, sa = s; asm volatile("" : "+v"(al), "+v"(sa));
        const int rowb = u.pm * BM + wr * 64 + fr;
        float mean8[8], rstd8[8];
#pragma unroll
        for (int q = 0; q < 8; ++q) { mean8[q] = 0.f; rstd8[q] = 1.f; }
        if (rstats) { LnFold lf{rstats, nullptr, nullptr}; lf.rows8(rowb, mean8, rstd8); }
        asm volatile("" : "+v"(mean8[0]), "+v"(mean8[1]), "+v"(mean8[2]), "+v"(mean8[3]), "+v"(mean8[4]), "+v"(mean8[5]), "+v"(mean8[6]), "+v"(mean8[7]), "+v"(rstd8[0]), "+v"(rstd8[1]), "+v"(rstd8[2]), "+v"(rstd8[3]), "+v"(rstd8[4]), "+v"(rstd8[5]), "+v"(rstd8[6]), "+v"(rstd8[7]) :: "memory");
        f32x4 gv[2][2], bv[2][2];
#pragma unroll
        for (int bj = 0; bj < 2; ++bj)
#pragma unroll
            for (int n = 0; n < 2; ++n) { gv[bj][n] = (f32x4){1.f, 1.f, 1.f, 1.f}; bv[bj][n] = (f32x4){0.f, 0.f, 0.f, 0.f};
                if (rstats) { gv[bj][n] = *(const f32x4*)(rg + col0 + bj * HALF + 4 * n); bv[bj][n] = *(const f32x4*)(rb + col0 + bj * HALF + 4 * n); }
                gv[bj][n] = gv[bj][n] * al; bv[bj][n] = bv[bj][n] * al; }
#pragma unroll
        for (int am = 0; am < 8; am += NB) {
            f32x4 rr[RES32 ? NB : 1][2][2]; u32x4 rw[NB][2];
#pragma unroll
            for (int e2 = 0; e2 < NB; ++e2) { const size_t off = (size_t)(rowb + ((am + e2) >> 2) * HALF + ((am + e2) & 3) * 16) * ldc + col0;
#pragma unroll
                for (int bj = 0; bj < 2; ++bj) {
                    if constexpr (RES32) { rr[e2][bj][0] = *(const f32x4*)(res32 + off + bj * HALF); rr[e2][bj][1] = *(const f32x4*)(res32 + off + bj * HALF + 4); }
                    else rw[e2][bj] = *(const u32x4*)(res16 + off + bj * HALF); } }
#pragma unroll
            for (int e2 = 0; e2 < NB; ++e2) { const int ai = (am + e2) >> 2, m = (am + e2) & 3; const int row = rowb + ai * HALF + m * 16; const size_t off = (size_t)row * ldc + col0;
                const float mean = mean8[am + e2], rstd = rstd8[am + e2];
                float ps = 0.f, pq = 0.f;
#pragma unroll
                for (int bj = 0; bj < 2; ++bj) {
                    f32x4 r0, r1;
                    if constexpr (RES32) { r0 = rr[e2][bj][0]; r1 = rr[e2][bj][1]; } else { const u32x4 w = rw[e2][bj]; r0 = (f32x4){bflo(w.x), bfhi(w.x), bflo(w.y), bfhi(w.y)}; r1 = (f32x4){bflo(w.z), bfhi(w.z), bflo(w.w), bfhi(w.w)}; }
                    const f32x4 z0 = (r0 - mean) * rstd * gv[bj][0] + bv[bj][0] + acc[ai][bj][m][0] * sa, z1 = (r1 - mean) * rstd * gv[bj][1] + bv[bj][1] + acc[ai][bj][m][1] * sa;
                    u32x4 w16; w16.x = cvt_pk_bf16(z0[0], z0[1]); w16.y = cvt_pk_bf16(z0[2], z0[3]); w16.z = cvt_pk_bf16(z1[0], z1[1]); w16.w = cvt_pk_bf16(z1[2], z1[3]);
                    *(u32x4*)(o16 + off + bj * HALF) = w16;
                    const float q0 = bflo(w16.x), q1 = bfhi(w16.x), q2 = bflo(w16.y), q3 = bfhi(w16.y), q4 = bflo(w16.z), q5 = bfhi(w16.z), q6 = bflo(w16.w), q7 = bfhi(w16.w);
                    ps += ((q0 + q1) + (q2 + q3)) + ((q4 + q5) + (q6 + q7)); pq += ((q0 * q0 + q1 * q1) + (q2 * q2 + q3 * q3)) + ((q4 * q4 + q5 * q5) + (q6 * q6 + q7 * q7));
                    if (o8) *(u32x2*)(o8 + off + bj * HALF) = (u32x2){pk4_fp8(fminf(fmaxf(q0 * o8s, -448.f), 448.f), fminf(fmaxf(q1 * o8s, -448.f), 448.f), fminf(fmaxf(q2 * o8s, -448.f), 448.f), fminf(fmaxf(q3 * o8s, -448.f), 448.f)),
                                                                      pk4_fp8(fminf(fmaxf(q4 * o8s, -448.f), 448.f), fminf(fmaxf(q5 * o8s, -448.f), 448.f), fminf(fmaxf(q6 * o8s, -448.f), 448.f), fminf(fmaxf(q7 * o8s, -448.f), 448.f))}; }
                if (ostats) { ps += __shfl_xor(ps, 16); ps += __shfl_xor(ps, 32); pq += __shfl_xor(pq, 16); pq += __shfl_xor(pq, 32);
                    if (fq == 0) { (void)__hip_atomic_fetch_add(ostats + 2 * (size_t)row, (long long)__builtin_rintf(ps * 1048576.f), __ATOMIC_RELAXED, __HIP_MEMORY_SCOPE_AGENT); (void)__hip_atomic_fetch_add(ostats + 2 * (size_t)row + 1, (long long)__builtin_rintf(pq * 65536.f), __ATOMIC_RELAXED, __HIP_MEMORY_SCOPE_AGENT); } } }
            asm volatile("" ::: "memory"); }
    }
};

typedef int v8i_t __attribute__((ext_vector_type(8)));
typedef int v4i_t __attribute__((ext_vector_type(4)));
template <class Epi, class Sched, bool ALIGN_EPI, bool FP8 = false>
__device__ __forceinline__ void gemm_phase(PG8_LAS unsigned char* lds, const Gemm g, const Sched& S, const Epi& E, const int wid) {
    const int lane = lane_fresh(), tid = wid * 64 + lane, wr = wid >> 2, wc = wid & 3, fr = lane & 15, fq = lane >> 4;
    const int K = g.K, nt = K / BK;
    unsigned voffA[2], voffB[2];
#pragma unroll
    for (int i = 0; i < 2; ++i) { int R, C; stage_rc(tid * 16 + i * 8192, R, C); const int Rb = Epi::PERM ? ((R & ~31) + perm32(R & 31)) : R;
        voffA[i] = (unsigned)(R * g.lda + C) * 2u; voffB[i] = (unsigned)(Rb * g.ldb + C) * 2u; }
    const size_t kstep = (size_t)(BK * 2);
    const size_t hstepA = (size_t)HALF * g.lda * 2, hstepB = (size_t)HALF * g.ldb * 2;
    const size_t tstepA = 2 * hstepA, tstepB = 2 * hstepB;
    const unsigned ldsw = (unsigned)wid * 1024u;
    int aoff = lds_byte(wr * 64 + fr, fq * 8), boff = lds_byte(wc * 32 + fr, fq * 8);
    asm volatile("" : "+v"(voffA[0]), "+v"(voffA[1]), "+v"(voffB[0]), "+v"(voffB[1]), "+v"(aoff), "+v"(boff));
#define PG8_UA(u) ((const char*)g.A + (size_t)(u).pm * tstepA + (size_t)(((u).pn >> g.a_shift) * g.a_mul) * 2)
#define PG8_UB(u) ((const char*)g.Bt + (size_t)(u).pn * tstepB)
#define PG8_SA(b, h) (((b) * 2 + (h)) * HTB)
#define PG8_SB(b, h) ((4 + (b) * 2 + (h)) * HTB)
#define PG8_STAGE(bufoff, gbase, voff) do { _Pragma("unroll") for (int _i = 0; _i < 2; ++_i) \
        __builtin_amdgcn_global_load_lds((const unsigned*)((const char*)(gbase) + (voff)[_i]), (PG8_LAS unsigned*)(lds + (bufoff) + ldsw + _i * 8192), 16, 0, 0); } while (0)
#define PG8_LD8(p_) __builtin_shufflevector(*(const PG8_LAS v4i_t*)(p_), *(const PG8_LAS v4i_t*)((p_) + 1024), 0, 1, 2, 3, 4, 5, 6, 7)
#define PG8_LDA(dst, b, h) do { _Pragma("unroll") for (int m = 0; m < 4; ++m) { if constexpr (FP8) dst##8[m] = PG8_LD8(lds + PG8_SA(b, h) + aoff + m * 2048); else { _Pragma("unroll") for (int k = 0; k < 2; ++k) dst[m][k] = *(const PG8_LAS bf16x8*)(lds + PG8_SA(b, h) + aoff + m * 2048 + k * 1024); } } } while (0)
#define PG8_LDB(dst, b, h) do { _Pragma("unroll") for (int n = 0; n < 2; ++n) { if constexpr (FP8) dst##8[n] = PG8_LD8(lds + PG8_SB(b, h) + boff + n * 2048); else { _Pragma("unroll") for (int k = 0; k < 2; ++k) dst[n][k] = *(const PG8_LAS bf16x8*)(lds + PG8_SB(b, h) + boff + n * 2048 + k * 1024); } } } while (0)
#define PG8_MMA(ai, bj, At, Bt) do { __builtin_amdgcn_s_setprio(1); _Pragma("unroll") for (int m = 0; m < 4; ++m) _Pragma("unroll") for (int n = 0; n < 2; ++n) { \
        if constexpr (FP8) asm volatile("v_mfma_scale_f32_16x16x128_f8f6f4 %0, %1, %2, %0, %3, %3 op_sel_hi:[0,0,0]" : "+v"(acc[ai][bj][m][n]) : "v"(Bt##8[n]), "v"(At##8[m]), "v"(one_scale)); \
        else { _Pragma("unroll") for (int k = 0; k < 2; ++k) acc[ai][bj][m][n] = __builtin_amdgcn_mfma_f32_16x16x32_bf16(Bt[n][k], At[m][k], acc[ai][bj][m][n], 0, 0, 0); } } \
        __builtin_amdgcn_s_setprio(0); } while (0)
#define PG8_WAIT_V(n) asm volatile("s_waitcnt vmcnt(" #n ")" ::: "memory")
#define PG8_WAIT_L(n) asm volatile("s_waitcnt lgkmcnt(" #n ")" ::: "memory")
#define PG8_BAR __builtin_amdgcn_s_barrier()
#define PG8_SCHED __builtin_amdgcn_sched_barrier(0)
    Unit cur, nxt; int ui = 0;
    if (!S.next(0, cur)) return;
    f32x4 acc[2][2][4][2];
#pragma unroll
    for (int a = 0; a < 2; ++a)
#pragma unroll
        for (int b = 0; b < 2; ++b)
#pragma unroll
            for (int m = 0; m < 4; ++m)
#pragma unroll
                for (int n = 0; n < 2; ++n) acc[a][b][m][n] = (f32x4){0.f, 0.f, 0.f, 0.f};
    bf16x8 At[4][2], B0[2][2], B1[2][2]; v8i_t At8[4], B08[2], B18[2];
    int one_scale = 0x7f7f7f7f; asm volatile("" : "+v"(one_scale));
    const char* cA = PG8_UA(cur); const char* cB = PG8_UB(cur);
    S.a_ready(cur);
    PG8_STAGE(PG8_SB(0, 0), cB, voffB); PG8_STAGE(PG8_SB(0, 1), cB + hstepB, voffB); PG8_STAGE(PG8_SA(0, 0), cA, voffA); PG8_STAGE(PG8_SA(0, 1), cA + hstepA, voffA);
    if (wr == 1) PG8_BAR;
    PG8_WAIT_V(2); PG8_BAR;
    PG8_STAGE(PG8_SB(1, 0), cB + kstep, voffB); PG8_STAGE(PG8_SA(1, 0), cA + kstep, voffA); PG8_STAGE(PG8_SB(1, 1), cB + hstepB + kstep, voffB);
    PG8_WAIT_V(6); PG8_BAR;
    for (;;) {
        const bool has_next = S.next(ui + 1, nxt);
        const char* nA = has_next ? PG8_UA(nxt) : cA; const char* nB = has_next ? PG8_UB(nxt) : cB;
        for (int t = 0; t < nt; t += 2) {
            const bool last = (t == nt - 2);
            const char* a1 = cA + (size_t)(t + 1) * kstep;
            const char* a2 = last ? nA : cA + (size_t)(t + 2) * kstep; const char* b2 = last ? nB : cB + (size_t)(t + 2) * kstep;
            const char* a3 = a2 + kstep; const char* b3 = b2 + kstep;
            if (last && has_next) S.a_ready(nxt);
            PG8_LDB(B0, 0, 0); PG8_LDB(B1, 0, 1); PG8_SCHED; PG8_LDA(At, 0, 0); PG8_STAGE(PG8_SA(1, 1), a1 + hstepA, voffA);
            PG8_WAIT_V(8); PG8_WAIT_L(0); PG8_BAR; PG8_MMA(0, 0, At, B0); PG8_MMA(0, 1, At, B1); PG8_BAR; PG8_SCHED;
            PG8_LDA(At, 0, 1); PG8_STAGE(PG8_SB(0, 0), b2, voffB); PG8_STAGE(PG8_SB(0, 1), b2 + hstepB, voffB); PG8_STAGE(PG8_SA(0, 0), a2, voffA);
            PG8_WAIT_V(8); PG8_WAIT_L(0); PG8_BAR; PG8_MMA(1, 0, At, B0); PG8_MMA(1, 1, At, B1); PG8_BAR; PG8_SCHED;
            PG8_LDB(B0, 1, 0); PG8_LDB(B1, 1, 1); PG8_SCHED; PG8_LDA(At, 1, 0); PG8_STAGE(PG8_SA(0, 1), a2 + hstepA, voffA);
            PG8_WAIT_V(8); PG8_WAIT_L(0); PG8_BAR; PG8_MMA(0, 0, At, B0); PG8_MMA(0, 1, At, B1); PG8_BAR; PG8_SCHED;
            PG8_LDA(At, 1, 1); PG8_STAGE(PG8_SB(1, 0), b3, voffB); PG8_STAGE(PG8_SB(1, 1), b3 + hstepB, voffB); PG8_STAGE(PG8_SA(1, 0), a3, voffA);
            PG8_WAIT_V(8); PG8_WAIT_L(0); PG8_BAR; PG8_MMA(1, 0, At, B0); PG8_MMA(1, 1, At, B1); PG8_BAR; PG8_SCHED;
        }
        if constexpr (ALIGN_EPI) { if (wr == 0) PG8_BAR; }
        if constexpr (FP8) asm volatile("s_nop 15\n\ts_nop 7" ::: "memory");
        { const int le = lane_fresh(); E(acc, cur, wr, wc, le & 15, le >> 4); } S.done(cur);
        if (!has_next) break;
#pragma unroll
        for (int a = 0; a < 2; ++a)
#pragma unroll
            for (int b = 0; b < 2; ++b)
#pragma unroll
                for (int m = 0; m < 4; ++m)
#pragma unroll
                    for (int n = 0; n < 2; ++n) acc[a][b][m][n] = (f32x4){0.f, 0.f, 0.f, 0.f};
        cur = nxt; cA = nA; cB = nB; ++ui;
        if constexpr (ALIGN_EPI) { if (wr == 1) PG8_BAR; }
    }
    PG8_WAIT_V(0);
    if constexpr (!ALIGN_EPI) { if (wr == 0) PG8_BAR; }
    PG8_BAR;
#undef PG8_UA
#undef PG8_UB
#undef PG8_SA
#undef PG8_SB
#undef PG8_STAGE
#undef PG8_LDA
#undef PG8_LDB
#undef PG8_MMA
#undef PG8_LD8
#undef PG8_WAIT_V
#undef PG8_WAIT_L
#undef PG8_BAR
#undef PG8_SCHED
}
}

constexpr int NWAVES = 8;
constexpr int BATCH = 4, SEQ = 4096, D = 2048, FF = 5632, M = BATCH * SEQ;
constexpr int N_IN = 5888;
constexpr int MEMT = 256;
constexpr float LN_EPS = 1e-5f;
constexpr float ALPHA = 1.189207115002721f;
constexpr float LAMBDA_INIT = 0.2f;

constexpr size_t MiB = 1u << 20;
constexpr size_t WS_CTL = 0, CTL_ZERO_BYTES = 2 * MiB;
constexpr size_t WS_W_IN = 2 * MiB;
constexpr size_t WS_W_G = 25 * MiB;
constexpr size_t WS_W_UK = 41 * MiB;
constexpr size_t WS_W_UVP = 42 * MiB;
constexpr size_t WS_W_A = 44 * MiB;
constexpr size_t WS_W_B = 48 * MiB;
constexpr size_t WS_W_MO = 52 * MiB;
constexpr size_t WS_W_MQ = 60 * MiB;
constexpr size_t WS_W_MKV = 62 * MiB;
constexpr size_t WS_W_MOUT = 66 * MiB;
constexpr size_t WS_MEM16 = 68 * MiB;
constexpr size_t WS_KVMEM = 72 * MiB;
constexpr size_t WS_W_GU2 = 74 * MiB;
constexpr size_t WS_W_D2 = 96 * MiB;
constexpr size_t WS_X8M = 107 * MiB;
constexpr size_t WS_X16 = 140 * MiB;
constexpr size_t WS_MIX = 204 * MiB;
constexpr size_t WS_W_GU1 = 204 * MiB;
constexpr size_t WS_W_D1 = 248 * MiB;
constexpr size_t WS_H = 270 * MiB;
constexpr size_t WS_AQ = WS_MIX + 0 * MiB, WS_AK = WS_MIX + 32 * MiB, WS_AV = WS_MIX + 64 * MiB, WS_BQ = WS_MIX + 96 * MiB;
constexpr size_t WS_BC = WS_MIX + 128 * MiB;
constexpr size_t WS_IQ = WS_MIX + 144 * MiB;
constexpr size_t WS_IKW = WS_MIX + 176 * MiB;
constexpr size_t WS_QLAT = WS_MIX + 184 * MiB;
constexpr size_t WS_IDX = WS_MIX + 312 * MiB;
constexpr size_t WS_YB = WS_BQ;
constexpr size_t WS_TA = WS_QLAT, WS_TB = WS_QLAT + 64 * MiB;
constexpr size_t WS_QM = WS_AQ, WS_OM = WS_AQ + 16 * MiB;
constexpr size_t WS_X8 = WS_H + 96 * MiB;
constexpr size_t WS_C8 = WS_W_IN;
constexpr size_t WS_MRG8 = WS_AV;
constexpr float FP8_WGS = 1024.f, FP8_MS = 32.f, FP8_WMOS = 2048.f;
constexpr float FP8_XS = 32.f, FP8_WGUS = 1024.f, FP8_HS = 8.f, FP8_WDS = 4096.f;
constexpr size_t WS_END = WS_MIX + 320 * MiB;
static_assert(WS_H + (size_t)M * FF * 2 <= WS_END && WS_QLAT + (size_t)M * 4096 * 2 <= WS_END, "d_ws map");
constexpr int CW_BAR = 4096;
constexpr int CW_DQ = 8192;
constexpr int CW_KMAX = 8256;
constexpr size_t CTL_STATS = 65536, CTL_STATS_STRIDE = (size_t)M * 2 * 8;
constexpr size_t CTL_VEC = CTL_STATS + 3 * CTL_STATS_STRIDE;
constexpr int V_GW_IN = 0, V_BW_IN = 5888, V_GW_G = 11776, V_BW_G = 15872, V_GW_MQ = 19968, V_BW_MQ = 20480, V_GW_GU2 = 20992, V_BW_GU2 = 32256, V_END = 43520;
constexpr size_t CTL_VECF = CTL_VEC + (size_t)V_END * 8;
static_assert(CTL_VECF + (size_t)V_END * 4 <= CTL_ZERO_BYTES, "control region");
constexpr float FX_S = 1048576.f, FX_Q = 65536.f, FX_V = 16777216.f;

constexpr int RING_OFF = 0, RING_BYTES = 153600;
constexpr int LDSCTL_OFF = RING_BYTES, MISC_OFF = LDSCTL_OFF + 320;
constexpr int LDS_BYTES = 154624;
static_assert(MISC_OFF + 128 <= LDS_BYTES, "LDS map");

#define GAS __attribute__((address_space(1)))
#define LAS __attribute__((address_space(3)))
typedef unsigned short bf16;
typedef unsigned v4u __attribute__((ext_vector_type(4)));
typedef unsigned v2u __attribute__((ext_vector_type(2)));
typedef float f32x4 __attribute__((ext_vector_type(4)));
typedef float f32x16 __attribute__((ext_vector_type(16)));
typedef short bf16x8 __attribute__((ext_vector_type(8)));
typedef GAS unsigned gu32;
#define RLX_AGENT __ATOMIC_RELAXED, __HIP_MEMORY_SCOPE_AGENT
#define LDS_WAIT() asm volatile("s_waitcnt lgkmcnt(0)" ::: "memory")
#define VM_WAIT() asm volatile("s_waitcnt vmcnt(0)" ::: "memory")
__device__ __forceinline__ unsigned f2bf(float f) { unsigned u = __builtin_bit_cast(unsigned, f); return (u + 0x7fffu + ((u >> 16) & 1u)) >> 16; }
__device__ __forceinline__ unsigned pk2(float lo, float hi) { return f2bf(lo) | (f2bf(hi) << 16); }
__device__ __forceinline__ float bf2f(unsigned short v) { return __uint_as_float((unsigned)v << 16); }
__device__ __forceinline__ float blo(unsigned w) { return __uint_as_float(w << 16); }
__device__ __forceinline__ float bhi(unsigned w) { return __uint_as_float(w & 0xffff0000u); }
__device__ __forceinline__ float wave_sum(float v) {
    v += __builtin_bit_cast(float, __builtin_amdgcn_update_dpp(0, __builtin_bit_cast(int, v), 0xB1, 0xf, 0xf, true));
    v += __builtin_bit_cast(float, __builtin_amdgcn_update_dpp(0, __builtin_bit_cast(int, v), 0x4E, 0xf, 0xf, true));
    v += __builtin_bit_cast(float, __builtin_amdgcn_update_dpp(0, __builtin_bit_cast(int, v), 0x141, 0xf, 0xf, true));
    v += __builtin_bit_cast(float, __builtin_amdgcn_update_dpp(0, __builtin_bit_cast(int, v), 0x140, 0xf, 0xf, true));
    { const auto rr = __builtin_amdgcn_permlane16_swap(__float_as_uint(v), __float_as_uint(v), false, false); v = __uint_as_float(rr[0]) + __uint_as_float(rr[1]); }
    { const auto rr = __builtin_amdgcn_permlane32_swap(__float_as_uint(v), __float_as_uint(v), false, false); v = __uint_as_float(rr[0]) + __uint_as_float(rr[1]); }
    return v;
}

__device__ __forceinline__ float xhalf_add(float a) { const auto rr = __builtin_amdgcn_permlane32_swap(__float_as_uint(a), __float_as_uint(a), false, false); return __uint_as_float(rr[0]) + __uint_as_float(rr[1]); }
__device__ __forceinline__ float xhalf_max(float a) { const auto rr = __builtin_amdgcn_permlane32_swap(__float_as_uint(a), __float_as_uint(a), false, false); return fmaxf(__uint_as_float(rr[0]), __uint_as_float(rr[1])); }
__device__ __forceinline__ int half_sum_i32(int v) {
    v += __builtin_amdgcn_update_dpp(0, v, 0xB1, 0xf, 0xf, true);
    v += __builtin_amdgcn_update_dpp(0, v, 0x4E, 0xf, 0xf, true);
    v += __builtin_amdgcn_update_dpp(0, v, 0x141, 0xf, 0xf, true);
    v += __builtin_amdgcn_update_dpp(0, v, 0x140, 0xf, 0xf, true);
    const auto rr = __builtin_amdgcn_permlane16_swap((unsigned)v, (unsigned)v, false, false); return (int)rr[0] + (int)rr[1];
}
#define XB_TMO      128
#define XB_XCNT(j)  (256  + 64 * (j))
#define XB_XSUB(j)  (1280 + 64 * (j))
#define XB_XGEN(j)  (2304 + 64 * (j))
#define XB_TOP      3328
#define XB_TOPGEN   3392
#define XCD_BAR_WORDS 3456
#define XB_SPIN_CAP (1u << 18)

__device__ __forceinline__ unsigned xb_ld(unsigned* p)              { return __hip_atomic_load(p, __ATOMIC_RELAXED, __HIP_MEMORY_SCOPE_AGENT); }
__device__ __forceinline__ unsigned xb_add(unsigned* p, unsigned v) { return __hip_atomic_fetch_add(p, v, __ATOMIC_RELAXED, __HIP_MEMORY_SCOPE_AGENT); }
__device__ __forceinline__ unsigned xb_xcc_id() { return (unsigned)__builtin_amdgcn_s_getreg((3 << 11) | 20) & 0xFu; }
#define XB_SPIN(cond, bar) do { unsigned _sp = 0; while (cond) { __builtin_amdgcn_s_sleep(1); \
    if ((++_sp & 255u) == 0u) { if (xb_ld(&(bar)[XB_TMO])) break; if (_sp > XB_SPIN_CAP) { atomicAdd(&(bar)[XB_TMO], 1u); break; } } } } while (0)

struct XcdBarrier {
    unsigned* bar; unsigned x;
    volatile LAS unsigned* st;
};

__device__ __forceinline__ XcdBarrier xcd_barrier_post(unsigned* bar, volatile LAS unsigned* st, bool t0) {
    XcdBarrier b; b.bar = bar; b.x = xb_xcc_id(); b.st = st;
    if (t0) st[2] = xb_add(&bar[XB_XCNT(b.x)], 1u);
    return b;
}
__device__ __forceinline__ void xcd_barrier_complete(unsigned* bar, unsigned x, unsigned& nloc, unsigned& nx) {
    const unsigned G = gridDim.x * gridDim.y * gridDim.z;
    unsigned sum, cnt, mine, sp = 0u;
    for (;;) {
        sum = 0u; cnt = 0u; mine = 0u;
#pragma unroll
        for (unsigned j = 0; j < 16; ++j) { const unsigned c = xb_ld(&bar[XB_XCNT(j)]); sum += c; cnt += (c > 0u) ? 1u : 0u; mine = (j == x) ? c : mine; }
        if (sum == G) break;
        __builtin_amdgcn_s_sleep(1);
        if ((++sp & 255u) == 0u) { if (xb_ld(&bar[XB_TMO])) break; if (sp > XB_SPIN_CAP) { atomicAdd(&bar[XB_TMO], 1u); break; } }
    }
    nloc = mine > 0u ? mine : 1u; nx = cnt > 0u ? cnt : 1u;
}

__device__ __forceinline__ void xcd_barrier(const XcdBarrier& b, const int wave) {
    asm volatile("s_waitcnt vmcnt(0)" ::: "memory");
    __syncthreads();
    if (wave == 0 && lane_fresh() == 0) {
        unsigned* bar = b.bar;
        __builtin_amdgcn_s_waitcnt(0);
        unsigned nloc = b.st[0], nx = b.st[1];
        if (nloc == 0u) { xcd_barrier_complete(bar, b.x, nloc, nx); b.st[0] = nloc; b.st[1] = nx; }
        const unsigned old = xb_add(&bar[XB_XSUB(b.x)], 1u);
        const unsigned gen = old / nloc;
        if (old + 1u == (gen + 1u) * nloc) {
            __builtin_amdgcn_fence(__ATOMIC_RELEASE, "agent");
            asm volatile("s_waitcnt vmcnt(0)" ::: "memory");
            const unsigned og = xb_add(&bar[XB_TOP], 1u);
            const unsigned tg = og / nx;
            if (og + 1u == (tg + 1u) * nx) xb_add(&bar[XB_TOPGEN], 1u);
            else XB_SPIN(xb_ld(&bar[XB_TOPGEN]) == tg, bar);
            __builtin_amdgcn_fence(__ATOMIC_ACQUIRE, "agent");
            xb_add(&bar[XB_XGEN(b.x)], 1u);
            asm volatile("s_waitcnt vmcnt(0)" ::: "memory");
        } else {
            XB_SPIN(xb_ld(&bar[XB_XGEN(b.x)]) == gen, bar);
            __builtin_amdgcn_fence(__ATOMIC_ACQUIRE, "agent");
            asm volatile("s_waitcnt vmcnt(0)" ::: "memory");
        }
    }
    __syncthreads();
}

__device__ __forceinline__ void tr_item(const float* W, int ldw, int nvalid, bf16* WT, int ldt, int k0, int n0, int drow0, int dcol0, LAS float* scr, int lane) {
    { const int n4 = 4 * (lane & 7), kr = lane >> 3; const bool ok = n0 + n4 < nvalid;
#pragma unroll
      for (int i = 0; i < 8; ++i) { const int kk = 8 * i + kr; const f32x4 v = ok ? *(const GAS f32x4*)(W + (size_t)(k0 + kk) * ldw + n0 + n4) : (f32x4){0.f, 0.f, 0.f, 0.f};
          LAS float* d = scr + kk * 33 + n4; d[0] = v.x; d[1] = v.y; d[2] = v.z; d[3] = v.w; } }
    LDS_WAIT(); asm volatile("" ::: "memory");
    const int c = lane & 7;
#pragma unroll
    for (int j = 0; j < 4; ++j) { const int nn = (lane >> 3) + 8 * j; const LAS float* s = scr + (8 * c) * 33 + nn;
        v4u o; o.x = pk2(s[0 * 33], s[1 * 33]); o.y = pk2(s[2 * 33], s[3 * 33]); o.z = pk2(s[4 * 33], s[5 * 33]); o.w = pk2(s[6 * 33], s[7 * 33]);
        *(GAS v4u*)(WT + (size_t)(drow0 + nn) * ldt + dcol0 + k0 + 8 * c) = o; }
    LDS_WAIT(); asm volatile("" ::: "memory");
}
__device__ __forceinline__ void tr_item8(const float* W, int ldw, unsigned char* WT, int ldt, int k0, int n0, int drow0, float sc, LAS float* scr, int lane) {
    { const int n4 = 4 * (lane & 7), kr = lane >> 3;
#pragma unroll
      for (int i = 0; i < 8; ++i) { const int kk = 8 * i + kr; const f32x4 v = *(const GAS f32x4*)(W + (size_t)(k0 + kk) * ldw + n0 + n4);
          LAS float* d = scr + kk * 33 + n4; d[0] = v.x; d[1] = v.y; d[2] = v.z; d[3] = v.w; } }
    LDS_WAIT(); asm volatile("" ::: "memory");
    const int nn = lane >> 1, hf = lane & 1; const LAS float* sp = scr + (32 * hf) * 33 + nn;
    unsigned o[8];
#pragma unroll
    for (int q = 0; q < 8; ++q) { const float a = fminf(fmaxf(sp[(4 * q + 0) * 33] * sc, -448.f), 448.f), b = fminf(fmaxf(sp[(4 * q + 1) * 33] * sc, -448.f), 448.f), c = fminf(fmaxf(sp[(4 * q + 2) * 33] * sc, -448.f), 448.f), d = fminf(fmaxf(sp[(4 * q + 3) * 33] * sc, -448.f), 448.f);
        int w = 0; w = __builtin_amdgcn_cvt_pk_fp8_f32(a, b, w, false); w = __builtin_amdgcn_cvt_pk_fp8_f32(c, d, w, true); o[q] = (unsigned)w; }
    GAS v4u* dst = (GAS v4u*)(WT + (size_t)(drow0 + nn) * ldt + k0 + 32 * hf);
    dst[0] = (v4u){o[0], o[1], o[2], o[3]}; dst[1] = (v4u){o[4], o[5], o[6], o[7]};
    LDS_WAIT(); asm volatile("" ::: "memory");
}
__device__ __forceinline__ void tr_item_ln(const float* W, int ldw, int nvalid, bf16* WT, int ldt, int k0, int n0, int drow0, const float* gain, const float* bvec, long long* gW, long long* bW, LAS float* scr, int lane) {
    { const int n4 = 4 * (lane & 7), kr = lane >> 3; const bool ok = n0 + n4 < nvalid;
#pragma unroll
      for (int i = 0; i < 8; ++i) { const int kk = 8 * i + kr; const f32x4 v = ok ? *(const GAS f32x4*)(W + (size_t)(k0 + kk) * ldw + n0 + n4) : (f32x4){0.f, 0.f, 0.f, 0.f};
          LAS float* d = scr + kk * 33 + n4; d[0] = v.x; d[1] = v.y; d[2] = v.z; d[3] = v.w; } }
    LDS_WAIT(); asm volatile("" ::: "memory");
    const int c = lane & 7;
    const f32x4 g0 = *(const GAS f32x4*)(gain + k0 + 8 * c), g1 = *(const GAS f32x4*)(gain + k0 + 8 * c + 4), b0 = *(const GAS f32x4*)(bvec + k0 + 8 * c), b1 = *(const GAS f32x4*)(bvec + k0 + 8 * c + 4);
    const float gk[8] = {g0.x, g0.y, g0.z, g0.w, g1.x, g1.y, g1.z, g1.w}, bk[8] = {b0.x, b0.y, b0.z, b0.w, b1.x, b1.y, b1.z, b1.w};
#pragma unroll
    for (int j = 0; j < 4; ++j) { const int nn = (lane >> 3) + 8 * j; const LAS float* sp = scr + (8 * c) * 33 + nn;
        float v[8], bs = 0.f;
#pragma unroll
        for (int i = 0; i < 8; ++i) { const float raw = sp[i * 33]; v[i] = raw * gk[i]; bs += raw * bk[i]; }
        v4u o; o.x = pk2(v[0], v[1]); o.y = pk2(v[2], v[3]); o.z = pk2(v[4], v[5]); o.w = pk2(v[6], v[7]);
        float gs = ((blo(o.x) + bhi(o.x)) + (blo(o.y) + bhi(o.y))) + ((blo(o.z) + bhi(o.z)) + (blo(o.w) + bhi(o.w)));
        *(GAS v4u*)(WT + (size_t)(drow0 + nn) * ldt + k0 + 8 * c) = o;
        gs += __shfl_xor(gs, 1); gs += __shfl_xor(gs, 2); gs += __shfl_xor(gs, 4); bs += __shfl_xor(bs, 1); bs += __shfl_xor(bs, 2); bs += __shfl_xor(bs, 4);
        if (c == 0) { (void)__hip_atomic_fetch_add(gW + drow0 + nn, (long long)__builtin_rintf(gs * FX_V), __ATOMIC_RELAXED, __HIP_MEMORY_SCOPE_AGENT); (void)__hip_atomic_fetch_add(bW + drow0 + nn, (long long)__builtin_rintf(bs * FX_V), __ATOMIC_RELAXED, __HIP_MEMORY_SCOPE_AGENT); } }
    LDS_WAIT(); asm volatile("" ::: "memory");
}
__device__ __forceinline__ void tr_item8_ln(const float* W, int ldw, unsigned char* WT, int ldt, int k0, int n0, int drow0, float sc, const float* gain, const float* bvec, long long* gW, long long* bW, LAS float* scr, int lane) {
    { const int n4 = 4 * (lane & 7), kr = lane >> 3;
#pragma unroll
      for (int i = 0; i < 8; ++i) { const int kk = 8 * i + kr; const f32x4 v = *(const GAS f32x4*)(W + (size_t)(k0 + kk) * ldw + n0 + n4);
          LAS float* d = scr + kk * 33 + n4; d[0] = v.x; d[1] = v.y; d[2] = v.z; d[3] = v.w; } }
    LDS_WAIT(); asm volatile("" ::: "memory");
    const int nn = lane >> 1, hf = lane & 1; const LAS float* sp = scr + (32 * hf) * 33 + nn;
    unsigned o[8]; float gs = 0.f, bs = 0.f;
#pragma unroll
    for (int q = 0; q < 8; ++q) { const f32x4 g4 = *(const GAS f32x4*)(gain + k0 + 32 * hf + 4 * q), b4 = *(const GAS f32x4*)(bvec + k0 + 32 * hf + 4 * q);
        const float r0 = sp[(4 * q + 0) * 33], r1 = sp[(4 * q + 1) * 33], r2 = sp[(4 * q + 2) * 33], r3 = sp[(4 * q + 3) * 33];
        bs += (r0 * b4.x + r1 * b4.y) + (r2 * b4.z + r3 * b4.w);
        const float a = fminf(fmaxf(r0 * g4.x * sc, -448.f), 448.f), b = fminf(fmaxf(r1 * g4.y * sc, -448.f), 448.f), c = fminf(fmaxf(r2 * g4.z * sc, -448.f), 448.f), d = fminf(fmaxf(r3 * g4.w * sc, -448.f), 448.f);
        int w = 0; w = __builtin_amdgcn_cvt_pk_fp8_f32(a, b, w, false); w = __builtin_amdgcn_cvt_pk_fp8_f32(c, d, w, true); o[q] = (unsigned)w;
        gs += (__builtin_amdgcn_cvt_f32_fp8(w, 0) + __builtin_amdgcn_cvt_f32_fp8(w, 1)) + (__builtin_amdgcn_cvt_f32_fp8(w, 2) + __builtin_amdgcn_cvt_f32_fp8(w, 3)); }
    GAS v4u* dst = (GAS v4u*)(WT + (size_t)(drow0 + nn) * ldt + k0 + 32 * hf);
    dst[0] = (v4u){o[0], o[1], o[2], o[3]}; dst[1] = (v4u){o[4], o[5], o[6], o[7]};
    gs += __shfl_xor(gs, 1); bs += __shfl_xor(bs, 1);
    if (hf == 0) { (void)__hip_atomic_fetch_add(gW + drow0 + nn, (long long)__builtin_rintf(gs / sc * FX_V), __ATOMIC_RELAXED, __HIP_MEMORY_SCOPE_AGENT); (void)__hip_atomic_fetch_add(bW + drow0 + nn, (long long)__builtin_rintf(bs * FX_V), __ATOMIC_RELAXED, __HIP_MEMORY_SCOPE_AGENT); }
    LDS_WAIT(); asm volatile("" ::: "memory");
}
__device__ __forceinline__ void cvt_item8(const float* src, unsigned char* dst, int item, int lane, float sc) {
    const GAS f32x4* sp = (const GAS f32x4*)(src + (size_t)item * 512) + 2 * lane; f32x4 a = sp[0] * sc, b = sp[1] * sc;
    int w0 = 0, w1 = 0; w0 = __builtin_amdgcn_cvt_pk_fp8_f32(fminf(fmaxf(a.x, -448.f), 448.f), fminf(fmaxf(a.y, -448.f), 448.f), w0, false); w0 = __builtin_amdgcn_cvt_pk_fp8_f32(fminf(fmaxf(a.z, -448.f), 448.f), fminf(fmaxf(a.w, -448.f), 448.f), w0, true);
    w1 = __builtin_amdgcn_cvt_pk_fp8_f32(fminf(fmaxf(b.x, -448.f), 448.f), fminf(fmaxf(b.y, -448.f), 448.f), w1, false); w1 = __builtin_amdgcn_cvt_pk_fp8_f32(fminf(fmaxf(b.z, -448.f), 448.f), fminf(fmaxf(b.w, -448.f), 448.f), w1, true);
    *((GAS v2u*)(dst + (size_t)item * 512) + lane) = (v2u){(unsigned)w0, (unsigned)w1};
}
__device__ __forceinline__ void cvt_item(const float* src, bf16* dst, int item, int lane) {
    const GAS f32x4* s = (const GAS f32x4*)(src + (size_t)item * 512) + 2 * lane; const f32x4 a = s[0], b = s[1];
    v4u o; o.x = pk2(a.x, a.y); o.y = pk2(a.z, a.w); o.z = pk2(b.x, b.y); o.w = pk2(b.z, b.w);
    *((GAS v4u*)(dst + (size_t)item * 512) + lane) = o;
}
__device__ __forceinline__ void p0_prologue(const float* const (&in)[24], unsigned char* ws, LAS unsigned char* lds, int gw, int NGW, int wave, int lane) {
    LAS float* scr = (LAS float*)(lds + RING_OFF + wave * 16384);
#define TRM(SRC, Kk, LDW, NVALID, NPAD, DST, LDT, ROWMAP, DCOL) { constexpr int nblk = (NPAD) / 32; constexpr int cnt = ((Kk) / 64) * nblk; \
        if (r < cnt) { const int kb = r / nblk, nb = r % nblk, n0 = 32 * nb; tr_item(SRC, LDW, NVALID, (bf16*)(ws + (DST)), LDT, 64 * kb, n0, (ROWMAP), (DCOL), scr, lane); continue; } r -= cnt; }
#define TRM8(SRC, Kk, LDW, NN, DST, LDT, ROWMAP, SC) { constexpr int nblk = (NN) / 32; constexpr int cnt = ((Kk) / 64) * nblk; \
        if (r < cnt) { const int kb = r / nblk, nb = r % nblk, n0 = 32 * nb; tr_item8(SRC, LDW, (unsigned char*)(ws + (DST)), LDT, 64 * kb, n0, (ROWMAP), SC, scr, lane); continue; } r -= cnt; }
    long long* const vec = (long long*)(ws + WS_CTL + CTL_VEC);
#define TRML(SRC, Kk, LDW, NVALID, NPAD, DST, LDT, ROWMAP, GAIN, BVEC, VG, VB) { constexpr int nblk = (NPAD) / 32; constexpr int cnt = ((Kk) / 64) * nblk; \
        if (r < cnt) { const int kb = r / nblk, nb = r % nblk, n0 = 32 * nb; tr_item_ln(SRC, LDW, NVALID, (bf16*)(ws + (DST)), LDT, 64 * kb, n0, (ROWMAP), GAIN, BVEC, vec + (VG), vec + (VB), scr, lane); continue; } r -= cnt; }
#define TRML8(SRC, Kk, LDW, NN, DST, LDT, ROWMAP, SC, GAIN, BVEC, VG, VB) { constexpr int nblk = (NN) / 32; constexpr int cnt = ((Kk) / 64) * nblk; \
        if (r < cnt) { const int kb = r / nblk, nb = r % nblk, n0 = 32 * nb; tr_item8_ln(SRC, LDW, (unsigned char*)(ws + (DST)), LDT, 64 * kb, n0, (ROWMAP), SC, GAIN, BVEC, vec + (VG), vec + (VB), scr, lane); continue; } r -= cnt; }
    constexpr int N_TR = 2 * (32 * 176) + 88 * 64 + 32 * 184 + 2 * (32 * 64) + 256 + 2 * (16 * 64) + 32 * 64 + 32 * 16 + 32 * 32 + 8 * 64 + 2 * (32 * 176) + 88 * 64;
    for (int it = gw; it < N_TR; it += NGW) {
        int r = it;
        TRM8(in[2], 2048, 5632, 5632, WS_W_GU1, 2048, 256 * (n0 >> 7) + (n0 & 127), FP8_WGUS)
        TRM8(in[3], 2048, 5632, 5632, WS_W_GU1, 2048, 256 * (n0 >> 7) + 128 + (n0 & 127), FP8_WGUS)
        TRM8(in[4], 5632, 2048, 2048, WS_W_D1, 5632, n0, FP8_WDS)
        TRML(in[5], 2048, 5712, 5712, 5888, WS_W_IN, 2048, n0, in[22], in[23], V_GW_IN, V_BW_IN)
        TRML8(in[11], 2048, 2048, 2048, WS_W_G, 2048, 256 * (n0 >> 7) + (n0 & 127), FP8_WGS, in[22], in[23], V_GW_G, V_BW_G)
        TRML8(in[11] + (size_t)2048 * 2048, 2048, 2048, 2048, WS_W_G, 2048, 256 * (n0 >> 7) + 128 + (n0 & 127), FP8_WGS, in[22], in[23], V_GW_G, V_BW_G)
        if (r < 256) { const int h = r >> 5, rr = r & 31, kb = rr >> 2, nb = rr & 3;
            tr_item(in[10] + (size_t)h * 512 * 128, 128, 128, (bf16*)(ws + WS_W_UVP), 1024, 64 * kb, 32 * nb, (h >> 1) * 256 + (h & 1) * 128 + 32 * nb, (h & 1) * 512, scr, lane); continue; } r -= 256;
        TRM(in[13], 1024, 2048, 2048, 2048, WS_W_A, 1024, n0, 0)
        TRM(in[14], 1024, 2048, 2048, 2048, WS_W_B, 1024, n0, 0)
        TRM8(in[15], 2048, 2048, 2048, WS_W_MO, 2048, n0, FP8_WMOS)
        TRML(in[16], 2048, 512, 512, 512, WS_W_MQ, 2048, n0, in[22] + D, in[23] + D, V_GW_MQ, V_BW_MQ)
        TRM(in[17], 2048, 1024, 1024, 1024, WS_W_MKV, 2048, n0, 0)
        TRM(in[18], 512, 2048, 2048, 2048, WS_W_MOUT, 512, n0, 0)
        TRML8(in[19], 2048, 5632, 5632, WS_W_GU2, 2048, 256 * (n0 >> 7) + (n0 & 127), FP8_WGUS, in[22] + 2 * D, in[23] + 2 * D, V_GW_GU2, V_BW_GU2)
        TRML8(in[20], 2048, 5632, 5632, WS_W_GU2, 2048, 256 * (n0 >> 7) + 128 + (n0 & 127), FP8_WGUS, in[22] + 2 * D, in[23] + 2 * D, V_GW_GU2, V_BW_GU2)
        TRM8(in[21], 5632, 2048, 2048, WS_W_D2, 5632, n0, FP8_WDS)
    }
#undef TRM
#undef TRM8
#undef TRML
#undef TRML8
    for (int rw = gw; rw < 1024; rw += NGW) { const int e = (rw >> 7) & 1; *((GAS v4u*)((bf16*)(ws + WS_W_UVP) + (size_t)rw * 1024 + (1 - e) * 512) + lane) = (v4u){0u, 0u, 0u, 0u}; }
    for (int it = gw; it < (M * D) / 512; it += NGW) cvt_item8(in[0], (unsigned char*)(ws + WS_X8), it, lane, FP8_XS);
    for (int it = gw; it < (BATCH * MEMT * D) / 512; it += NGW) cvt_item(in[1], (bf16*)(ws + WS_MEM16), it, lane);
    for (int it = gw; it < (8 * 512 * 128) / 512; it += NGW) cvt_item(in[9], (bf16*)(ws + WS_W_UK), it, lane);
}

__device__ __forceinline__ void ln_phase(float* zx, bf16* x16, unsigned char* x8, const float* g, const float* b, int gw, int NGW, int lane) {
    f32x4 gv[8], bv[8];
#pragma unroll
    for (int j = 0; j < 8; ++j) { gv[j] = *((const GAS f32x4*)g + lane + 64 * j); bv[j] = *((const GAS f32x4*)b + lane + 64 * j); }
    for (int m = gw; m < M; m += NGW) {
        GAS f32x4* xr = (GAS f32x4*)(zx + (size_t)m * D) + lane;
        f32x4 v[8]; float s = 0.f;
#pragma unroll
        for (int j = 0; j < 8; ++j) { v[j] = xr[64 * j]; s += (v[j].x + v[j].y) + (v[j].z + v[j].w); }
        const float mean = wave_sum(s) * (1.f / D); float s2 = 0.f;
#pragma unroll
        for (int j = 0; j < 8; ++j) { v[j] = v[j] - mean; s2 += (v[j].x * v[j].x + v[j].y * v[j].y) + (v[j].z * v[j].z + v[j].w * v[j].w); }
        const float rstd = 1.f / sqrtf(wave_sum(s2) * (1.f / D) + LN_EPS);
#pragma unroll
        for (int j = 0; j < 8; ++j) { v[j] = v[j] * rstd * gv[j] + bv[j]; xr[64 * j] = v[j]; }
        if (x16) { GAS v2u* o8 = (GAS v2u*)(x16 + (size_t)m * D) + lane;
#pragma unroll
            for (int j = 0; j < 8; ++j) o8[64 * j] = (v2u){pk2(v[j].x, v[j].y), pk2(v[j].z, v[j].w)}; }
        if (x8) { GAS unsigned* o4 = (GAS unsigned*)(x8 + (size_t)m * D) + lane;
#pragma unroll
            for (int j = 0; j < 8; ++j) { const f32x4 q = v[j] * FP8_XS; int w = 0; w = __builtin_amdgcn_cvt_pk_fp8_f32(fminf(fmaxf(q.x, -448.f), 448.f), fminf(fmaxf(q.y, -448.f), 448.f), w, false);
                w = __builtin_amdgcn_cvt_pk_fp8_f32(fminf(fmaxf(q.z, -448.f), 448.f), fminf(fmaxf(q.w, -448.f), 448.f), w, true); o4[64 * j] = (unsigned)w; } }
    }
}
__device__ __forceinline__ void ln_final_phase(const bf16* z16, float* outp, const float* g, const float* b, int gw, int NGW, int lane) {
    for (int m0 = gw; m0 < M; m0 += 2 * NGW) {
        const int m1 = m0 + NGW; const bool two = m1 < M;
        v4u w[2][4];
#pragma unroll
        for (int j = 0; j < 4; ++j) { w[0][j] = __builtin_nontemporal_load((const GAS v4u*)(z16 + (size_t)m0 * D) + lane + 64 * j); w[1][j] = two ? __builtin_nontemporal_load((const GAS v4u*)(z16 + (size_t)m1 * D) + lane + 64 * j) : (v4u){0u, 0u, 0u, 0u}; }
#pragma unroll
        for (int rr = 0; rr < 2; ++rr) { if (rr == 1 && !two) break;
            const int m = rr ? m1 : m0;
            float v[32]; float s = 0.f;
#pragma unroll
            for (int j = 0; j < 4; ++j) { const v4u x = w[rr][j]; v[8 * j + 0] = blo(x.x); v[8 * j + 1] = bhi(x.x); v[8 * j + 2] = blo(x.y); v[8 * j + 3] = bhi(x.y); v[8 * j + 4] = blo(x.z); v[8 * j + 5] = bhi(x.z); v[8 * j + 6] = blo(x.w); v[8 * j + 7] = bhi(x.w); }
#pragma unroll
            for (int e = 0; e < 32; ++e) s += v[e];
            const float mean = wave_sum(s) * (1.f / D); float s2 = 0.f;
#pragma unroll
            for (int e = 0; e < 32; ++e) { v[e] -= mean; s2 += v[e] * v[e]; }
            const float rstd = 1.f / sqrtf(wave_sum(s2) * (1.f / D) + LN_EPS);
#pragma unroll
            for (int j = 0; j < 4; ++j) { const int c0 = 512 * j + 8 * lane;
                const f32x4 g0 = *(const GAS f32x4*)(g + c0), g1 = *(const GAS f32x4*)(g + c0 + 4), b0 = *(const GAS f32x4*)(b + c0), b1 = *(const GAS f32x4*)(b + c0 + 4);
                GAS f32x4* o = (GAS f32x4*)(outp + (size_t)m * D + c0);
                __builtin_nontemporal_store((f32x4){v[8 * j + 0], v[8 * j + 1], v[8 * j + 2], v[8 * j + 3]} * rstd * g0 + b0, o); __builtin_nontemporal_store((f32x4){v[8 * j + 4], v[8 * j + 5], v[8 * j + 6], v[8 * j + 7]} * rstd * g1 + b1, o + 1); } }
    }
}
__device__ __forceinline__ void crms_phase(const bf16* bc, unsigned char* c8, const float* kvg, float cs, int gw, int NGW, int lane) {
    float gg[8];
#pragma unroll
    for (int j = 0; j < 8; ++j) gg[j] = kvg[8 * lane + j] * cs;
    for (int m = gw; m < M; m += NGW) {
        const v4u w = *((const GAS v4u*)(bc + (size_t)m * 512) + lane);
        float x[8] = {blo(w.x), bhi(w.x), blo(w.y), bhi(w.y), blo(w.z), bhi(w.z), blo(w.w), bhi(w.w)}; float s = 0.f;
#pragma unroll
        for (int j = 0; j < 8; ++j) s += x[j] * x[j];
        const float r = 1.f / sqrtf(wave_sum(s) * (1.f / 512.f) + LN_EPS);
#pragma unroll
        for (int j = 0; j < 8; ++j) x[j] = fminf(fmaxf(x[j] * r * gg[j], -448.f), 448.f);
        *((GAS v2u*)(c8 + (size_t)m * 512) + lane) = (v2u){pg8::pk4_fp8(x[0], x[1], x[2], x[3]), pg8::pk4_fp8(x[4], x[5], x[6], x[7])};
    }
}
typedef short v4i16_t __attribute__((ext_vector_type(4)));
__device__ __forceinline__ v4i16_t lds_tr16(const LAS unsigned char* p) { return __builtin_amdgcn_ds_read_tr16_b64_v4i16((LAS v4i16_t*)p); }
__device__ __forceinline__ unsigned cvtpk(float lo, float hi) { typedef float f2 __attribute__((ext_vector_type(2))); typedef __bf16 b2 __attribute__((ext_vector_type(2))); f2 v = {lo, hi}; b2 b = __builtin_convertvector(v, b2); return __builtin_bit_cast(unsigned, b); }
__device__ __forceinline__ float xhalf_f(float v) { return __shfl_xor(v, 32); }
constexpr float LOG2E = 1.4426950408889634f;
constexpr float QSCALE = 0.125f * LOG2E;

__device__ __forceinline__ void diff_attn_mfma(LAS unsigned char* lds, const bf16* AQ, const bf16* AK, const bf16* AV, bf16* YA, const float* dlam, const float* subg, unsigned* dq, const unsigned* kmax, const int wave) {
    const int lane = lane_fresh(), r32 = lane & 31, hi = lane >> 5;
    const int comp = wave >> 2, wq = wave & 3;
    const unsigned ksrc = (unsigned)(lane * 1024 + (2 * wave) * 8);
    const unsigned vsrc0 = (unsigned)((16 * ((2 * wave) & 3) + (lane >> 2)) * 1024 + ((2 * wave) >> 2) * 32 + (lane & 3) * 8);
    const unsigned vsrc1 = (unsigned)((16 * ((2 * wave + 1) & 3) + (lane >> 2)) * 1024 + ((2 * wave + 1) >> 2) * 32 + (lane & 3) * 8);
    const unsigned kdst = (unsigned)(2 * wave) * 1024u, vdst0 = 16384u + (unsigned)(((2 * wave) >> 2) * 4096 + ((2 * wave) & 3) * 1024), vdst1 = 16384u + (unsigned)(((2 * wave + 1) >> 2) * 4096 + ((2 * wave + 1) & 3) * 1024);
    const unsigned lds0 = (unsigned)(uintptr_t)lds;
#define DA_STAGE(bo, to) do { \
        glds16(Kg + (to) + ksrc, (unsigned)__builtin_amdgcn_readfirstlane((int)(lds0 + (bo) + kdst))); \
        glds16(Kg + (to) + ksrc + 8, (unsigned)__builtin_amdgcn_readfirstlane((int)(lds0 + (bo) + kdst + 1024))); \
        glds16(Vg + (to) + vsrc0, (unsigned)__builtin_amdgcn_readfirstlane((int)(lds0 + (bo) + vdst0))); \
        glds16(Vg + (to) + vsrc1, (unsigned)__builtin_amdgcn_readfirstlane((int)(lds0 + (bo) + vdst1))); } while (0)
#define DA_WAITBAR() asm volatile("s_waitcnt vmcnt(0) lgkmcnt(0)\n\ts_barrier" ::: "memory")
    const unsigned koff = (unsigned)(((comp * 8 + hi) * 64 + r32) * 16);
    const unsigned voff = (unsigned)(16384 + (4 * hi + ((lane & 15) >> 2)) * 64 + ((lane >> 4) & 1) * 32 + (lane & 3) * 8);
    LAS unsigned* xq = (LAS unsigned*)(lds + 100352);
    for (;;) {
        if (wave == 0 && lane == 0) xq[0] = __hip_atomic_fetch_add(dq, 1u, __ATOMIC_RELAXED, __HIP_MEMORY_SCOPE_AGENT);
        asm volatile("s_waitcnt vmcnt(0) lgkmcnt(0)\n\ts_barrier" ::: "memory");
        const int j = (int)xq[0];
        if (j >= 1024) break;
        const int ub = 31 - (j >> 5), bh = j & 31;
        const int b = bh >> 3, h = 7 - (bh & 7);
        const float sl2 = LOG2E / (float)(2 << h);
        const size_t rowbase = (size_t)b * SEQ; const int q0 = ub * 128;
        const int qpos = q0 + wq * 32 + r32;
        const int nt = 2 * ub + 2;
        const int myt = 2 * ub + 1 + (wq >> 1);
        const bf16* Kg = AK + rowbase * 1024 + h * 128; const bf16* Vg = AV + rowbase * 1024 + h * 128;
        bf16x8 qr[4];
#pragma unroll
        for (int s = 0; s < 4; ++s) qr[s] = *(const GAS bf16x8*)(AQ + (rowbase + qpos) * 1024 + h * 128 + comp * 64 + s * 16 + hi * 8);
        f32x16 o[4];
#pragma unroll
        for (int blk = 0; blk < 4; ++blk)
#pragma unroll
            for (int r = 0; r < 16; ++r) o[blk][r] = 0.f;
        float mrun = -INFINITY, lrun = 0.f;
        { float qn2 = 0.f;
#pragma unroll
          for (int s = 0; s < 4; ++s) { const v4u w = __builtin_bit_cast(v4u, qr[s]); const float e0 = blo(w.x), e1 = bhi(w.x), e2 = blo(w.y), e3 = bhi(w.y), e4 = blo(w.z), e5 = bhi(w.z), e6 = blo(w.w), e7 = bhi(w.w);
              qn2 += ((e0 * e0 + e1 * e1) + (e2 * e2 + e3 * e3)) + ((e4 * e4 + e5 * e5) + (e6 * e6 + e7 * e7)); }
          qn2 += xhalf_f(qn2);
#pragma unroll
          for (int o_ = 1; o_ < 32; o_ <<= 1) qn2 = fmaxf(qn2, __shfl_xor(qn2, o_));
          const float kb = __uint_as_float(__hip_atomic_load(kmax + (b * 8 + h) * 2 + comp, __ATOMIC_RELAXED, __HIP_MEMORY_SCOPE_AGENT));
          if (lane == 0) xq[8 + wave] = __float_as_uint(sqrtf(qn2) * kb * 8.1f); }
        DA_STAGE(0u, (size_t)(nt - 1) * 64 * 1024);
        DA_WAITBAR();
        int kt_lo = 0;
        { float sb = 0.f;
#pragma unroll
          for (int w_ = 0; w_ < 8; ++w_) sb = fmaxf(sb, __uint_as_float(xq[8 + w_]));
          const float xcut = (float)(q0 - 63) - (40.f + 2.f * sb) / sl2;
          kt_lo = xcut > 0.f ? (int)__builtin_ceilf(xcut * (1.f / 64.f)) : 0; kt_lo = __builtin_amdgcn_readfirstlane(kt_lo); }
        for (int st = 0; st < nt - kt_lo; ++st) {
            const int kt = nt - 1 - st;
            const unsigned bufo = (unsigned)(st & 1) * 32768u;
            if (kt > kt_lo) DA_STAGE(32768u - bufo, (size_t)(kt - 1) * 64 * 1024);
            if (kt < myt) {
                const LAS unsigned char* Kb = lds + bufo + koff;
                f32x16 p0, p1;
#pragma unroll
                for (int r = 0; r < 16; ++r) { p0[r] = 0.f; p1[r] = 0.f; }
                { bf16x8 kf[4];
#pragma unroll
                  for (int s = 0; s < 4; ++s) kf[s] = *(const LAS bf16x8*)(Kb + s * 2048);
#pragma unroll
                  for (int s = 0; s < 4; ++s) p0 = __builtin_amdgcn_mfma_f32_32x32x16_bf16(kf[s], qr[s], p0, 0, 0, 0); }
                { bf16x8 kf[4];
#pragma unroll
                  for (int s = 0; s < 4; ++s) kf[s] = *(const LAS bf16x8*)(Kb + s * 2048 + 512);
#pragma unroll
                  for (int s = 0; s < 4; ++s) p1 = __builtin_amdgcn_mfma_f32_32x32x16_bf16(kf[s], qr[s], p1, 0, 0, 0); }
                const float qth = (float)(qpos - kt * 64 - 4 * hi);
                float rm = -INFINITY;
#pragma unroll
                for (int r = 0; r < 16; ++r) { const float kr = (float)((r & 3) + 8 * (r >> 2)); const float v0 = qth - kr, v1 = qth - (kr + 32.f);
                    p0[r] = p0[r] - sl2 * fabsf(v0); p1[r] = p1[r] - sl2 * fabsf(v1); rm = fmaxf(rm, fmaxf(p0[r], p1[r])); }
                rm = fmaxf(rm, xhalf_f(rm));
                if (__any(rm > mrun)) { const float mn = fmaxf(mrun, rm), f = __builtin_amdgcn_exp2f(mrun - mn); mrun = mn; lrun *= f;
#pragma unroll
                    for (int blk = 0; blk < 4; ++blk)
#pragma unroll
                        for (int r = 0; r < 16; ++r) o[blk][r] *= f; }
                float ls = 0.f;
#pragma unroll
                for (int r = 0; r < 16; ++r) { p0[r] = __builtin_amdgcn_exp2f(p0[r] - mrun); p1[r] = __builtin_amdgcn_exp2f(p1[r] - mrun); ls += p0[r] + p1[r]; }
                lrun += ls;
                bf16x8 pw[4];
#pragma unroll
                for (int s = 0; s < 2; ++s) {
                    v4u a = {cvtpk(p0[8 * s + 0], p0[8 * s + 1]), cvtpk(p0[8 * s + 2], p0[8 * s + 3]), cvtpk(p0[8 * s + 4], p0[8 * s + 5]), cvtpk(p0[8 * s + 6], p0[8 * s + 7])};
                    v4u c = {cvtpk(p1[8 * s + 0], p1[8 * s + 1]), cvtpk(p1[8 * s + 2], p1[8 * s + 3]), cvtpk(p1[8 * s + 4], p1[8 * s + 5]), cvtpk(p1[8 * s + 6], p1[8 * s + 7])};
                    pw[s] = __builtin_bit_cast(bf16x8, a); pw[2 + s] = __builtin_bit_cast(bf16x8, c); }
                const LAS unsigned char* Vb = lds + bufo + voff;
#pragma unroll
                for (int blk = 0; blk < 4; ++blk) {
#pragma unroll
                    for (int s = 0; s < 4; ++s) {
                        const v4i16_t lo = lds_tr16(Vb + blk * 4096 + s * 1024), hh = lds_tr16(Vb + blk * 4096 + s * 1024 + 512);
                        const bf16x8 vf = {lo[0], lo[1], lo[2], lo[3], hh[0], hh[1], hh[2], hh[3]};
                        o[blk] = __builtin_amdgcn_mfma_f32_32x32x16_bf16(vf, pw[s], o[blk], 0, 0, 0);
                    }
                }
            }
            DA_WAITBAR();
        }
        lrun += xhalf_f(lrun);
        const float inv = 1.f / lrun;
        LAS float* Y1 = (LAS float*)(lds) + wq * 4096;
        if (comp == 1) {
            float lam; { float a = dlam[lane] * dlam[64 + lane], bq_ = dlam[128 + lane] * dlam[192 + lane]; a = wave_sum(a); bq_ = wave_sum(bq_); lam = __expf(a) - __expf(bq_) + LAMBDA_INIT; }
            const float sc = inv * lam;
#pragma unroll
            for (int blk = 0; blk < 4; ++blk)
#pragma unroll
                for (int r = 0; r < 16; ++r) Y1[(32 * blk + (r & 3) + 8 * (r >> 2) + 4 * hi) * 32 + r32] = o[blk][r] * sc; }
        __syncthreads();
        if (comp == 0) {
            float ss = 0.f;
#pragma unroll
            for (int blk = 0; blk < 4; ++blk)
#pragma unroll
                for (int r = 0; r < 16; ++r) { const float a = o[blk][r] * inv - Y1[(32 * blk + (r & 3) + 8 * (r >> 2) + 4 * hi) * 32 + r32]; o[blk][r] = a; ss += a * a; }
            ss += xhalf_f(ss);
            const float rr = (1.0f - LAMBDA_INIT) / sqrtf(ss * (1.f / 128.f) + LN_EPS);
            LAS unsigned* stg = (LAS unsigned*)(lds + 65536) + wq * (32 * 65);
#pragma unroll
            for (int blk = 0; blk < 4; ++blk) {
#pragma unroll
                for (int r = 0; r < 16; r += 2) { const int e = 32 * blk + (r & 3) + 8 * (r >> 2) + 4 * hi;
                    stg[r32 * 65 + (e >> 1)] = cvtpk(o[blk][r] * rr * subg[e], o[blk][r + 1] * rr * subg[e + 1]); }
                asm volatile("" ::: "memory"); }
            LDS_WAIT(); asm volatile("" ::: "memory");
            bf16* orow = YA + (rowbase + q0 + wq * 32) * 1024 + h * 128;
#pragma unroll 4
            for (int row = 0; row < 32; ++row) *((GAS unsigned*)(orow + (size_t)row * 1024) + lane) = stg[row * 65 + lane];
        }
        __syncthreads();
    }
#undef DA_STAGE
#undef DA_WAITBAR
}

__device__ __forceinline__ unsigned okey(float f) { const unsigned u = __float_as_uint(f); return (u & 0x80000000u) ? ~u : (u | 0x80000000u); }
__device__ __forceinline__ void indexer_topk(LAS unsigned char* lds, const bf16* IQ, const bf16* IKW, unsigned short* IDX, int vcu, int G, const int wave) {
    const int lane = lane_fresh(), r32 = lane & 31, hi = lane >> 5;
    const unsigned lds0 = (unsigned)(uintptr_t)lds;
    const unsigned boff = (unsigned)((hi * 256 + r32) * 16);
    for (int j = vcu; j < 1024; j += G) {
        const int w = j & 255, i = j >> 8, bq = w >> 4, s16 = w & 15;
        const int chunk = (i == 0) ? s16 : (i == 1) ? 31 - s16 : (i == 2) ? 32 + s16 : 63 - s16;
        const int b = bq >> 2, gq = bq & 3;
        const int t0 = b * SEQ + chunk * 64 + gq * 16 + 2 * wave;
        const int ngroups = 2 * (chunk + 1);
        const int ntiles = (ngroups + 7) >> 3;
        const bf16* Kg = IKW + (size_t)b * SEQ * 256;
#define IX_STAGE(tile, bo) do { int tl_ = (tile); asm volatile("" : "+s"(tl_)); _Pragma("unroll") for (int i_ = 0; i_ < 4; ++i_) { const int q_ = 4 * wave + i_; \
            glds16s(Kg + (size_t)(tl_ * 256 + 64 * (q_ & 3)) * 256 + (q_ >> 2) * 8, (unsigned)lane * 512u, (unsigned)__builtin_amdgcn_readfirstlane((int)(lds0 + (bo) + ((q_ >> 2) * 256 + 64 * (q_ & 3)) * 16))); } } while (0)
        asm volatile("s_barrier" ::: "memory");
        IX_STAGE(0, 0u);
        bf16x8 a[4];
#pragma unroll
        for (int ks = 0; ks < 4; ++ks) a[ks] = *(const GAS bf16x8*)(IQ + (size_t)(t0 + (r32 >> 4)) * 1024 + (r32 & 15) * 64 + ks * 16 + 8 * hi);
        float wv[16];
        { const bf16* iwp = IKW + (size_t)t0 * 256 + 64 + 4 * hi;
          const v2u w00 = *(const GAS v2u*)(iwp), w01 = *(const GAS v2u*)(iwp + 8), w10 = *(const GAS v2u*)(iwp + 256), w11 = *(const GAS v2u*)(iwp + 256 + 8);
          wv[0] = blo(w00.x); wv[1] = bhi(w00.x); wv[2] = blo(w00.y); wv[3] = bhi(w00.y); wv[4] = blo(w01.x); wv[5] = bhi(w01.x); wv[6] = blo(w01.y); wv[7] = bhi(w01.y);
          wv[8] = blo(w10.x); wv[9] = bhi(w10.x); wv[10] = blo(w10.y); wv[11] = bhi(w10.y); wv[12] = blo(w11.x); wv[13] = bhi(w11.x); wv[14] = blo(w11.y); wv[15] = bhi(w11.y); }
        unsigned key[128];
#pragma unroll 128
        for (int g = 0; g < 128; ++g) {
            if (g < ngroups) {
                const unsigned bufo = (unsigned)((g >> 3) & 1) * 32768u;
                if ((g & 7) == 0) {
                    asm volatile("s_waitcnt vmcnt(0)\n\ts_barrier" ::: "memory");
                    if ((g >> 3) + 1 < ntiles) IX_STAGE((g >> 3) + 1, 32768u - bufo);
                }
                bf16x8 bk[4];
#pragma unroll
                for (int ks = 0; ks < 4; ++ks) bk[ks] = *(const LAS bf16x8*)(lds + bufo + boff + (g & 7) * 512 + ks * 8192);
                f32x16 acc = {0.f, 0.f, 0.f, 0.f, 0.f, 0.f, 0.f, 0.f, 0.f, 0.f, 0.f, 0.f, 0.f, 0.f, 0.f, 0.f};
#pragma unroll
                for (int ks = 0; ks < 4; ++ks) acc = __builtin_amdgcn_mfma_f32_32x32x16_bf16(a[ks], bk[ks], acc, 0, 0, 0);
                float s0 = 0.f, s1 = 0.f;
#pragma unroll
                for (int r = 0; r < 8; ++r) { s0 += wv[r] * fmaxf(acc[r], 0.f); s1 += wv[8 + r] * fmaxf(acc[8 + r], 0.f); }
                { const auto rr = __builtin_amdgcn_permlane32_swap(__float_as_uint(s0), __float_as_uint(s1), false, false);
                  key[g] = okey(__uint_as_float(rr[0]) + __uint_as_float(rr[1])); }
            } else key[g] = 0u;
        }
        unsigned selw[4];
        { unsigned vm[4];
#pragma unroll
          for (int w_ = 0; w_ < 4; ++w_) { const int n_ = ngroups - 32 * w_; vm[w_] = n_ >= 32 ? 0xffffffffu : (n_ <= 0 ? 0u : ((1u << (n_ & 31)) - 1u)); }
          if (chunk >= 4) {
#pragma unroll
              for (int w_ = 0; w_ < 4; ++w_) { if (32 * w_ < ngroups) {
#pragma unroll
                  for (int i_ = 0; i_ < 16; ++i_) { const unsigned x = key[32 * w_ + i_], y = key[32 * w_ + i_ + 16]; key[32 * w_ + i_] = (x & 0x0000ffffu) | (y << 16); key[32 * w_ + i_ + 16] = (x >> 16) | (y & 0xffff0000u); }
#pragma unroll
                  for (int i_ = 0; i_ < 32; ++i_) { if (!(i_ & 8)) { const unsigned x = key[32 * w_ + i_], y = key[32 * w_ + i_ + 8]; key[32 * w_ + i_] = (x & 0x00ff00ffu) | ((y << 8) & 0xff00ff00u); key[32 * w_ + i_ + 8] = ((x >> 8) & 0x00ff00ffu) | (y & 0xff00ff00u); } }
#pragma unroll
                  for (int i_ = 0; i_ < 32; ++i_) { if (!(i_ & 4)) { const unsigned x = key[32 * w_ + i_], y = key[32 * w_ + i_ + 4]; key[32 * w_ + i_] = (x & 0x0f0f0f0fu) | ((y << 4) & 0xf0f0f0f0u); key[32 * w_ + i_ + 4] = ((x >> 4) & 0x0f0f0f0fu) | (y & 0xf0f0f0f0u); } }
#pragma unroll
                  for (int i_ = 0; i_ < 32; ++i_) { if (!(i_ & 2)) { const unsigned x = key[32 * w_ + i_], y = key[32 * w_ + i_ + 2]; key[32 * w_ + i_] = (x & 0x33333333u) | ((y << 2) & 0xccccccccu); key[32 * w_ + i_ + 2] = ((x >> 2) & 0x33333333u) | (y & 0xccccccccu); } }
#pragma unroll
                  for (int i_ = 0; i_ < 32; ++i_) { if (!(i_ & 1)) { const unsigned x = key[32 * w_ + i_], y = key[32 * w_ + i_ + 1]; key[32 * w_ + i_] = (x & 0x55555555u) | ((y << 1) & 0xaaaaaaaau); key[32 * w_ + i_ + 1] = ((x >> 1) & 0x55555555u) | (y & 0xaaaaaaaau); } }
              } }
              unsigned cand[4] = {vm[0], vm[1], vm[2], vm[3]}, abv[4] = {0u, 0u, 0u, 0u}; int nab = 0; bool done = false;
#pragma unroll 32
              for (int bit = 31; bit >= 0; --bit) {
                  if (__all(done ? 1 : 0)) break;
                  const unsigned o0 = cand[0] & key[bit], o1 = cand[1] & key[32 + bit], o2 = cand[2] & key[64 + bit], o3 = cand[3] & key[96 + bit];
                  const int c = half_sum_i32(__popc(o0) + __popc(o1) + __popc(o2) + __popc(o3));
                  const bool take = nab + c >= 256;
                  done = done || (take && nab + c == 256);
                  const unsigned ntm = take ? 0u : 0xffffffffu;
                  nab += c & (int)ntm;
                  abv[0] |= o0 & ntm; abv[1] |= o1 & ntm; abv[2] |= o2 & ntm; abv[3] |= o3 & ntm;
                  cand[0] = o0 ^ (cand[0] & ntm); cand[1] = o1 ^ (cand[1] & ntm); cand[2] = o2 ^ (cand[2] & ntm); cand[3] = o3 ^ (cand[3] & ntm);
              }
#pragma unroll
              for (int w_ = 0; w_ < 4; ++w_) selw[w_] = abv[w_] | cand[w_];
          } else {
#pragma unroll
              for (int w_ = 0; w_ < 4; ++w_) selw[w_] = vm[w_];
          } }
        int base = 0;
        unsigned short* ip = IDX + (size_t)(t0 + hi) * 256;
#pragma unroll
        for (int g = 0; g < 128; ++g) {
            if (g < ngroups) {
                const bool sel = ((selw[g >> 5] >> (g & 31)) & 1u) != 0u;
                const unsigned long long mk = __ballot(sel ? 1 : 0);
                const unsigned mh = hi ? (unsigned)(mk >> 32) : (unsigned)mk;
                const int pos = base + __popc(mh & ((1u << r32) - 1u));
                if (sel && pos < 256) ip[pos] = (unsigned short)(32 * g + r32);
                base += __popc(mh);
            }
        }
    }
#undef IX_STAGE
    asm volatile("s_waitcnt vmcnt(0) lgkmcnt(0)\n\ts_barrier" ::: "memory");
}

constexpr int DSA_PAIRB = 1040;
constexpr int DSA_WAVEB = 16 * DSA_PAIRB + 512;
constexpr int DSA_LDS_END = 8 * DSA_WAVEB;
constexpr float DSA_CS = 64.f, DSA_QS = 64.f, DSA_PS = 256.f;
typedef int v2i_t __attribute__((ext_vector_type(2)));
__device__ __forceinline__ void dsa_mfma(LAS unsigned char* lds, const bf16* QL, bf16* OL, const int omask, const unsigned char* C8, const unsigned short* IDX, int vcu, int G, const int wave) {
    const int lane = lane_fresh(), h16 = lane & 15, g = lane >> 4;
    LAS unsigned char* wl = lds + wave * DSA_WAVEB;
    const unsigned wl0 = (unsigned)(uintptr_t)wl;
    LAS unsigned short* idxs = (LAS unsigned short*)(wl + 16 * DSA_PAIRB);
    const float sc2 = 0.08838834764831845f * LOG2E / (DSA_QS * DSA_CS);
    const float sl2 = (h16 < 8) ? LOG2E / (float)(2 << (h16 & 7)) : 0.f;
    const int ntok = (G == 256) ? 8 : (M - (vcu * 8 + wave) + G * 8 - 1) / (G * 8);
#define DSA_TOK(i) ((G == 256) ? ((vcu >> 6) * SEQ + (vcu & 63) + 64 * (wave + 8 * (i))) : (vcu * 8 + wave + G * 8 * (i)))
    const unsigned qk_off = (unsigned)((h16 >> 1) * DSA_PAIRB + (h16 & 1) * 512 + 32 * g);
    const int trow = (h16 >> 1) < 4 ? 4 * g + (h16 >> 1) : 16 + 4 * g + ((h16 >> 1) - 4);
    const unsigned pv_off = (unsigned)((trow >> 1) * DSA_PAIRB + (trow & 1) * 512 + 8 * (h16 & 1));
    for (int it = 0; it < ntok; ++it) {
        const int t = DSA_TOK(it); const int tpos = t & (SEQ - 1);
        const int n = (tpos >> 6) >= 3 ? 256 : 64 * ((tpos >> 6) + 1); const int nst = n >> 5;
        const unsigned char* Cb = C8 + (size_t)(t >> 12) * SEQ * 512;
        int ln = lane; asm volatile("" : "+v"(ln));
        const int h16b = ln & 15, gb = ln >> 4;
        { const v2u iv = __builtin_nontemporal_load((const GAS v2u*)(IDX + (size_t)t * 256) + ln); *((LAS v2u*)idxs + ln) = iv; }
        pg8::v8i_t qf[4];
        { const bf16* qp = QL + (size_t)t * 4096 + (h16b & 7) * 512 + 32 * gb;
#pragma unroll
          for (int s = 0; s < 4; ++s) { unsigned w8[8];
#pragma unroll
              for (int c = 0; c < 4; ++c) { const v4u w = __builtin_nontemporal_load((const GAS v4u*)(qp + 128 * s + 8 * c));
                  w8[2 * c] = pg8::pk4_fp8(fminf(fmaxf(blo(w.x) * DSA_QS, -448.f), 448.f), fminf(fmaxf(bhi(w.x) * DSA_QS, -448.f), 448.f), fminf(fmaxf(blo(w.y) * DSA_QS, -448.f), 448.f), fminf(fmaxf(bhi(w.y) * DSA_QS, -448.f), 448.f));
                  w8[2 * c + 1] = pg8::pk4_fp8(fminf(fmaxf(blo(w.z) * DSA_QS, -448.f), 448.f), fminf(fmaxf(bhi(w.z) * DSA_QS, -448.f), 448.f), fminf(fmaxf(blo(w.w) * DSA_QS, -448.f), 448.f), fminf(fmaxf(bhi(w.w) * DSA_QS, -448.f), 448.f)); }
              qf[s] = (pg8::v8i_t){(int)w8[0], (int)w8[1], (int)w8[2], (int)w8[3], (int)w8[4], (int)w8[5], (int)w8[6], (int)w8[7]}; } }
        f32x4 o[32];
#pragma unroll
        for (int blk = 0; blk < 32; ++blk) o[blk] = (f32x4){0.f, 0.f, 0.f, 0.f};
        float mrun = -INFINITY, lrun = 0.f;
        asm volatile("s_waitcnt vmcnt(0) lgkmcnt(0)" ::: "memory");
        for (int st = 0; st < nst; ++st) {
#pragma unroll
            for (int i = 0; i < 16; ++i) { const unsigned srow = idxs[st * 32 + 2 * i + (lane >> 5)];
                glds16s(Cb, srow * 512u + (unsigned)(lane & 31) * 16u, (unsigned)__builtin_amdgcn_readfirstlane((int)(wl0 + i * DSA_PAIRB))); }
            asm volatile("s_waitcnt vmcnt(0)" ::: "memory");
            f32x4 a0 = {0.f, 0.f, 0.f, 0.f}, a1 = {0.f, 0.f, 0.f, 0.f};
#pragma unroll
            for (int s = 0; s < 4; ++s) {
                const pg8::v4i_t x0 = *(const LAS pg8::v4i_t*)(wl + qk_off + 128 * s), x1 = *(const LAS pg8::v4i_t*)(wl + qk_off + 128 * s + 16);
                const pg8::v4i_t y0 = *(const LAS pg8::v4i_t*)(wl + qk_off + 8 * DSA_PAIRB + 128 * s), y1 = *(const LAS pg8::v4i_t*)(wl + qk_off + 8 * DSA_PAIRB + 128 * s + 16);
                a0 = __builtin_amdgcn_mfma_scale_f32_16x16x128_f8f6f4(__builtin_shufflevector(x0, x1, 0, 1, 2, 3, 4, 5, 6, 7), qf[s], a0, 0, 0, 0, 0x7f7f7f7f, 0, 0x7f7f7f7f);
                a1 = __builtin_amdgcn_mfma_scale_f32_16x16x128_f8f6f4(__builtin_shufflevector(y0, y1, 0, 1, 2, 3, 4, 5, 6, 7), qf[s], a1, 0, 0, 0, 0x7f7f7f7f, 0, 0x7f7f7f7f); }
            const v2u i0 = *(const LAS v2u*)(idxs + st * 32 + 4 * g), i1 = *(const LAS v2u*)(idxs + st * 32 + 16 + 4 * g);
            const int sidx[8] = {(int)(i0.x & 0xffffu), (int)(i0.x >> 16), (int)(i0.y & 0xffffu), (int)(i0.y >> 16), (int)(i1.x & 0xffffu), (int)(i1.x >> 16), (int)(i1.y & 0xffffu), (int)(i1.y >> 16)};
            float lg[8];
#pragma unroll
            for (int r = 0; r < 8; ++r) { const int d = tpos - sidx[r]; lg[r] = (r < 4 ? a0[r & 3] : a1[r & 3]) * sc2 - sl2 * (float)(d < 0 ? -d : d); }
            float rm = fmaxf(fmaxf(fmaxf(lg[0], lg[1]), fmaxf(lg[2], lg[3])), fmaxf(fmaxf(lg[4], lg[5]), fmaxf(lg[6], lg[7])));
            rm = fmaxf(rm, __shfl_xor(rm, 16)); rm = fmaxf(rm, __shfl_xor(rm, 32));
            const float mn = fmaxf(mrun, rm), f = __builtin_amdgcn_exp2f(mrun - mn); mrun = mn;
#pragma unroll
            for (int r = 0; r < 8; ++r) lg[r] = __builtin_amdgcn_exp2f(lg[r] - mn) * DSA_PS;
            const unsigned pw0 = pg8::pk4_fp8(lg[0], lg[1], lg[2], lg[3]), pw1 = pg8::pk4_fp8(lg[4], lg[5], lg[6], lg[7]);
            { const float ps = ((__builtin_amdgcn_cvt_f32_fp8((int)pw0, 0) + __builtin_amdgcn_cvt_f32_fp8((int)pw0, 1)) + (__builtin_amdgcn_cvt_f32_fp8((int)pw0, 2) + __builtin_amdgcn_cvt_f32_fp8((int)pw0, 3)))
                           + ((__builtin_amdgcn_cvt_f32_fp8((int)pw1, 0) + __builtin_amdgcn_cvt_f32_fp8((int)pw1, 1)) + (__builtin_amdgcn_cvt_f32_fp8((int)pw1, 2) + __builtin_amdgcn_cvt_f32_fp8((int)pw1, 3)));
              lrun = lrun * f + ps; }
            const long pw = (long)(((unsigned long)pw1 << 32) | (unsigned long)pw0);
#pragma unroll
            for (int blk = 0; blk < 32; ++blk) {
                const v2i_t av = __builtin_amdgcn_ds_read_tr8_b64_v2i32((LAS v2i_t*)(wl + pv_off + 16 * blk));
                const long al = (long)(((unsigned long)(unsigned)av.y << 32) | (unsigned long)(unsigned)av.x);
                o[blk] = __builtin_amdgcn_mfma_f32_16x16x32_fp8_fp8(al, pw, o[blk] * f, 0, 0, 0);
                if ((blk & 3) == 3) __builtin_amdgcn_sched_barrier(0);
            }
        }
        float lt = lrun; lt += __shfl_xor(lt, 16); lt += __shfl_xor(lt, 32);
        const float inv = 1.f / (lt * DSA_CS);
        if (h16 < 8) {
#pragma unroll
            for (int blk = 0; blk < 32; ++blk) { const f32x4 v = o[blk] * inv;
                __builtin_nontemporal_store((v2u){cvtpk(v.x, v.y), cvtpk(v.z, v.w)}, (GAS v2u*)(OL + (size_t)(t & omask) * 4096 + h16b * 512 + 16 * blk + 4 * gb)); } }
    }
    asm volatile("s_waitcnt vmcnt(0) lgkmcnt(0)" ::: "memory");
    __syncthreads();
#undef DSA_TOK
}
static_assert(DSA_LDS_END <= RING_BYTES, "DSA LDS map");

__device__ __forceinline__ void memattn_mfma(LAS unsigned char* lds, const bf16* QM, const bf16* KV, bf16* OM, int vcu, int G, const int wave) {
    const int lane = lane_fresh(), r32 = lane & 31, hi = lane >> 5;
    const unsigned voff = (unsigned)(65536 + (4 * hi + ((lane & 15) >> 2)) * 64 + ((lane >> 4) & 1) * 32 + (lane & 3) * 8);
    for (int j = vcu; j < 256; j += G) {
        const int bh = j >> 4, qb = j & 15, b = bh >> 2, h = bh & 3;
        const bf16* Kg = KV + (size_t)b * MEMT * 1024 + h * 128; const bf16* Vg = Kg + 512;
#pragma unroll
        for (int i = 0; i < 8; ++i) { const int q = 8 * wave + i;
            glds16(Kg + (size_t)(64 * (q & 3) + lane) * 1024 + (q >> 2) * 8, (unsigned)__builtin_amdgcn_readfirstlane((int)((unsigned)(uintptr_t)lds + ((q >> 2) * 256 + 64 * (q & 3)) * 16)));
            glds16(Vg + (size_t)(16 * (q & 15) + (lane >> 2)) * 1024 + (q >> 4) * 32 + (lane & 3) * 8, (unsigned)__builtin_amdgcn_readfirstlane((int)((unsigned)(uintptr_t)lds + 65536 + (q >> 4) * 16384 + (q & 15) * 1024))); }
        const size_t qrow = (size_t)b * SEQ + qb * 256 + wave * 32 + r32;
        bf16x8 qr[8];
#pragma unroll
        for (int s = 0; s < 8; ++s) qr[s] = *(const GAS bf16x8*)(QM + qrow * 512 + h * 128 + s * 16 + hi * 8);
        f32x16 o[4];
#pragma unroll
        for (int blk = 0; blk < 4; ++blk)
#pragma unroll
            for (int r = 0; r < 16; ++r) o[blk][r] = 0.f;
        float mrun = -INFINITY, lrun = 0.f;
        asm volatile("s_waitcnt vmcnt(0) lgkmcnt(0)\n\ts_barrier" ::: "memory");
        for (int kt = 0; kt < 4; ++kt) {
            const LAS unsigned char* Kb = lds + (unsigned)((hi * 256 + 64 * kt + r32) * 16);
            f32x16 p0, p1;
#pragma unroll
            for (int r = 0; r < 16; ++r) { p0[r] = 0.f; p1[r] = 0.f; }
#pragma unroll
            for (int s = 0; s < 8; ++s) { const bf16x8 k0 = *(const LAS bf16x8*)(Kb + s * 8192), k1 = *(const LAS bf16x8*)(Kb + s * 8192 + 512);
                p0 = __builtin_amdgcn_mfma_f32_32x32x16_bf16(k0, qr[s], p0, 0, 0, 0); p1 = __builtin_amdgcn_mfma_f32_32x32x16_bf16(k1, qr[s], p1, 0, 0, 0); }
            float rm = -INFINITY;
#pragma unroll
            for (int r = 0; r < 16; ++r) rm = fmaxf(rm, fmaxf(p0[r], p1[r]));
            rm = fmaxf(rm, xhalf_f(rm));
            if (__any(rm > mrun)) { const float mn = fmaxf(mrun, rm), f = __builtin_amdgcn_exp2f(mrun - mn); mrun = mn; lrun *= f;
#pragma unroll
                for (int blk = 0; blk < 4; ++blk)
#pragma unroll
                    for (int r = 0; r < 16; ++r) o[blk][r] *= f; }
            float ls = 0.f;
#pragma unroll
            for (int r = 0; r < 16; ++r) { p0[r] = __builtin_amdgcn_exp2f(p0[r] - mrun); p1[r] = __builtin_amdgcn_exp2f(p1[r] - mrun); ls += p0[r] + p1[r]; }
            lrun += ls;
            bf16x8 pw[4];
#pragma unroll
            for (int s = 0; s < 2; ++s) {
                v4u a = {cvtpk(p0[8 * s + 0], p0[8 * s + 1]), cvtpk(p0[8 * s + 2], p0[8 * s + 3]), cvtpk(p0[8 * s + 4], p0[8 * s + 5]), cvtpk(p0[8 * s + 6], p0[8 * s + 7])};
                v4u c = {cvtpk(p1[8 * s + 0], p1[8 * s + 1]), cvtpk(p1[8 * s + 2], p1[8 * s + 3]), cvtpk(p1[8 * s + 4], p1[8 * s + 5]), cvtpk(p1[8 * s + 6], p1[8 * s + 7])};
                pw[s] = __builtin_bit_cast(bf16x8, a); pw[2 + s] = __builtin_bit_cast(bf16x8, c); }
            const LAS unsigned char* Vb = lds + voff + kt * 4096;
#pragma unroll
            for (int blk = 0; blk < 4; ++blk) {
#pragma unroll
                for (int s = 0; s < 4; ++s) {
                    const v4i16_t lo = lds_tr16(Vb + blk * 16384 + s * 1024), hh = lds_tr16(Vb + blk * 16384 + s * 1024 + 512);
                    const bf16x8 vf = {lo[0], lo[1], lo[2], lo[3], hh[0], hh[1], hh[2], hh[3]};
                    o[blk] = __builtin_amdgcn_mfma_f32_32x32x16_bf16(vf, pw[s], o[blk], 0, 0, 0);
                }
            }
        }
        __syncthreads();
        lrun += xhalf_f(lrun);
        const float inv = 1.f / lrun;
        LAS unsigned* stg = (LAS unsigned*)(lds) + wave * (32 * 65);
#pragma unroll
        for (int blk = 0; blk < 4; ++blk)
#pragma unroll
            for (int r = 0; r < 16; r += 2) { const int e = 32 * blk + (r & 3) + 8 * (r >> 2) + 4 * hi;
                stg[r32 * 65 + (e >> 1)] = cvtpk(o[blk][r] * inv, o[blk][r + 1] * inv); }
        LDS_WAIT(); asm volatile("" ::: "memory");
        bf16* orow = OM + ((size_t)b * SEQ + qb * 256 + wave * 32) * 512 + h * 128;
#pragma unroll 4
        for (int row = 0; row < 32; ++row) *((GAS unsigned*)(orow + (size_t)row * 512) + lane) = stg[row * 65 + lane];
        __syncthreads();
    }
}

constexpr int N_PHASES = 21;
struct Args { const float* in[24]; float* out; unsigned char* ws; int ph_lo, ph_hi; };
__global__ void __launch_bounds__(NWAVES * 64, 2) mk_fwd(Args args) {
    extern __shared__ __attribute__((aligned(16))) unsigned char lds_raw[];
    LAS unsigned char* lds = (LAS unsigned char*)lds_raw;
    volatile LAS unsigned* MISC = (volatile LAS unsigned*)(lds + MISC_OFF);
    const int tid = threadIdx.x, wave = __builtin_amdgcn_readfirstlane(tid >> 6);
#define lane lane_fresh()
    const int G = gridDim.x; int bx = blockIdx.x;
    int vcu = (G % 8 == 0) ? (bx % 8) * (G / 8) + bx / 8 : bx;
    int gw = vcu * NWAVES + wave; const int NGW = G * NWAVES;
    unsigned char* ws = args.ws;
    gu32* ctl = (gu32*)(ws + WS_CTL);
    for (int u = tid; u < (LDS_BYTES - LDSCTL_OFF) / 4; u += NWAVES * 64) ((LAS unsigned*)(lds + LDSCTL_OFF))[u] = 0u;
    __syncthreads();
    const bool one = (args.ph_hi - args.ph_lo) > 1;
    XcdBarrier bar; bar.bar = (unsigned*)(ctl + CW_BAR); bar.x = 0; bar.st = nullptr;
    if (one) bar = xcd_barrier_post((unsigned*)(ctl + CW_BAR), MISC + 8, tid == 0);
    const int lo = args.ph_lo, hi = args.ph_hi;
#ifndef PH_MASK
#define PH_MASK 0xFFFFFFFFu
#endif
#define IN(k) ((((PH_MASK) >> (k)) & 1u) && lo <= (k) && (k) < hi)
#define SEAM(k) do { if (IN(k) && IN((k) + 1)) xcd_barrier(bar, wave); } while (0)
    bf16* const X16 = (bf16*)(ws + WS_X16); bf16* const HB = (bf16*)(ws + WS_H);
    long long* const ST0 = (long long*)(ws + WS_CTL + CTL_STATS); long long* const ST1 = (long long*)(ws + WS_CTL + CTL_STATS + CTL_STATS_STRIDE); long long* const ST2 = (long long*)(ws + WS_CTL + CTL_STATS + 2 * CTL_STATS_STRIDE);
    const float* const VEC = (const float*)(ws + WS_CTL + CTL_VECF);
    float* const out = args.out;
    const float* const ln_g = args.in[22]; const float* const ln_b = args.in[23];
    using namespace pg8;

#ifdef PROBE_P0
    if (IN(0)) { p0_prologue(args.in, ws, lds, gw, NGW, wave, lane); }
#endif
    if (IN(0)) { p0_prologue(args.in, ws, lds, gw, NGW, wave, lane); }
    SEAM(0);
    if (one && IN(0) && (G % 8) == 0) {
        unsigned* xb = (unsigned*)(ctl + CW_BAR); bool even = true;
#pragma unroll
        for (int jx = 0; jx < 16; ++jx) { const unsigned c = xb_ld(&xb[XB_XCNT(jx)]); even = even && (jx < 8 ? c == (unsigned)(G / 8) : c == 0u); }
        const int rank = (int)MISC[10], xcc = (int)xb_xcc_id();
        if (__builtin_amdgcn_readfirstlane(even ? 1 : 0)) { vcu = __builtin_amdgcn_readfirstlane(xcc * (G / 8) + rank); bx = __builtin_amdgcn_readfirstlane(rank * 8 + xcc); gw = vcu * NWAVES + wave; }
    }
    if (IN(1)) { { const long long* vi = (const long long*)(ws + WS_CTL + CTL_VEC); float* vf = (float*)(ws + WS_CTL + CTL_VECF); for (int i = gw * 64 + lane; i < V_END; i += NGW * 64) vf[i] = (float)vi[i] * (1.0f / 16777216.f); }
        Gemm g{(const bf16*)(ws + WS_X8), (const bf16*)(ws + WS_W_GU1), D / 2, D / 2, D / 2, 0, 0}; StaticOrder S; S.init(M, 2 * FF, G, bx); EpiSwiGLU8 E{(unsigned char*)HB, FF, 1.0f / (FP8_XS * FP8_WGUS), FP8_HS, LnFold{nullptr, nullptr, nullptr}};
        gemm_phase<EpiSwiGLU8, StaticOrder, true, true>(lds + RING_OFF, g, S, E, wave); }
    SEAM(1);
    if (IN(2)) { Gemm g{HB, (const bf16*)(ws + WS_W_D1), FF / 2, FF / 2, FF / 2, 0, 0}; StaticOrder S; S.init(M, D, G, bx); EpiRes<true> E{args.in[0], nullptr, D, ALPHA, 0.5f / (FP8_HS * FP8_WDS), nullptr, nullptr, nullptr, ST0, X16, (unsigned char*)(ws + WS_X8M), FP8_XS};
        gemm_phase<EpiRes<true>, StaticOrder, true, true>(lds + RING_OFF, g, S, E, wave); }
    SEAM(2);
    if (IN(4)) {
        { Gemm g{X16, (const bf16*)(ws + WS_W_IN), D, D, D, 0, 0}; StaticOrder S; S.init(M, N_IN, G, bx);
          EpiInProj E{(bf16*)(ws + WS_AQ), (bf16*)(ws + WS_AK), (bf16*)(ws + WS_AV), (bf16*)(ws + WS_BQ), (bf16*)(ws + WS_BC), (bf16*)(ws + WS_IQ), (bf16*)(ws + WS_IKW), QSCALE, LnFold{ST0, VEC + V_GW_IN, VEC + V_BW_IN}, (unsigned*)(ctl + CW_KMAX)};
          gemm_phase<EpiInProj, StaticOrder, true>(lds + RING_OFF, g, S, E, wave); }
        { Gemm g{(const bf16*)(ws + WS_MEM16), (const bf16*)(ws + WS_W_MKV), D, D, D, 0, 0}; StaticOrder S; S.init(BATCH * MEMT, 1024, G, bx >= G - 16 ? bx - (G - 16) : (1 << 20)); EpiBf16 E{(bf16*)(ws + WS_KVMEM), 1024};
          gemm_phase<EpiBf16, StaticOrder, true>(lds + RING_OFF, g, S, E, wave); }
    }
    SEAM(4);
    if (IN(5)) {
        { Gemm g{(const bf16*)(ws + WS_BQ), (const bf16*)(ws + WS_W_UK), 1024, 128, 128, 1, 128}; StaticOrder S; S.init(M, 4096, G, bx); EpiBf16 E{(bf16*)(ws + WS_QLAT), 4096};
          gemm_phase<EpiBf16, StaticOrder, true>(lds + RING_OFF, g, S, E, wave); }
        crms_phase((const bf16*)(ws + WS_BC), (unsigned char*)(ws + WS_C8), args.in[8], DSA_CS, gw, NGW, lane);
    }
    if (IN(7)) indexer_topk(lds, (const bf16*)(ws + WS_IQ), (const bf16*)(ws + WS_IKW), (unsigned short*)(ws + WS_IDX), vcu, G, wave);
    if (IN(7)) diff_attn_mfma(lds, (const bf16*)(ws + WS_AQ), (const bf16*)(ws + WS_AK), (const bf16*)(ws + WS_AV), (bf16*)(ws + WS_AQ), args.in[6], args.in[7], (unsigned*)(ctl + CW_DQ), (const unsigned*)(ctl + CW_KMAX), wave);
    SEAM(7);
    if (IN(8)) dsa_mfma(lds, (const bf16*)(ws + WS_QLAT), (bf16*)(ws + WS_QLAT), 0x7fffffff, (const unsigned char*)(ws + WS_C8), (const unsigned short*)(ws + WS_IDX), vcu, G, wave);
    SEAM(8);
    if (IN(9)) { Gemm g{(const bf16*)(ws + WS_QLAT), (const bf16*)(ws + WS_W_UVP), 4096, 1024, 1024, 0, 1024}; StaticOrder S; S.init(M, 1024, G, bx); EpiBf16 E{(bf16*)(ws + WS_YB), 1024};
        gemm_phase<EpiBf16, StaticOrder, true>(lds + RING_OFF, g, S, E, wave); }
    SEAM(9);
    if (IN(10)) {
        { Gemm g{(const bf16*)(ws + WS_AQ), (const bf16*)(ws + WS_W_A), 1024, 1024, 1024, 0, 0}; StaticOrder S; S.init(M, D, G, bx); EpiBf16 E{(bf16*)(ws + WS_TA), D}; gemm_phase<EpiBf16, StaticOrder, true>(lds + RING_OFF, g, S, E, wave); }
        { Gemm g{(const bf16*)(ws + WS_YB), (const bf16*)(ws + WS_W_B), 1024, 1024, 1024, 0, 0}; StaticOrder S; S.init(M, D, G, bx); EpiBf16 E{(bf16*)(ws + WS_TB), D}; gemm_phase<EpiBf16, StaticOrder, true>(lds + RING_OFF, g, S, E, wave); }
    }
    SEAM(10);
    if (IN(11)) { Gemm g{(const bf16*)(ws + WS_X8M), (const bf16*)(ws + WS_W_G), D / 2, D / 2, D / 2, 0, 0}; StaticOrder S; S.init(M, 2 * D, G, bx);
        EpiGateMerge8 E{(const bf16*)(ws + WS_TA), (const bf16*)(ws + WS_TB), (unsigned char*)(ws + WS_MRG8), D, args.in[12], args.in[12] + D, 1.0f / (FP8_XS * FP8_WGS), FP8_MS, LnFold{ST0, VEC + V_GW_G, VEC + V_BW_G}};
        gemm_phase<EpiGateMerge8, StaticOrder, true, true>(lds + RING_OFF, g, S, E, wave); }
    SEAM(11);
    if (IN(12)) { Gemm g{(const bf16*)(ws + WS_MRG8), (const bf16*)(ws + WS_W_MO), D / 2, D / 2, D / 2, 0, 0}; StaticOrder S; S.init(M, D, G, bx); EpiRes<false, 1> E{nullptr, X16, D, ALPHA, 1.0f / (FP8_MS * FP8_WMOS), ST0, ln_g, ln_b, ST1, X16, nullptr, 0.f};
        gemm_phase<EpiRes<false, 1>, StaticOrder, true, true>(lds + RING_OFF, g, S, E, wave); }
    SEAM(12);
    if (IN(14)) { Gemm g{X16, (const bf16*)(ws + WS_W_MQ), D, D, D, 0, 0}; StaticOrder S; S.init(M, 512, G, bx); EpiBf16 E{(bf16*)(ws + WS_QM), 512, 0.08838834764831845f * LOG2E, LnFold{ST1, VEC + V_GW_MQ, VEC + V_BW_MQ}}; gemm_phase<EpiBf16, StaticOrder, true>(lds + RING_OFF, g, S, E, wave); }
    SEAM(14);
    if (IN(15)) memattn_mfma(lds, (const bf16*)(ws + WS_QM), (const bf16*)(ws + WS_KVMEM), (bf16*)(ws + WS_OM), vcu, G, wave);
    SEAM(15);
    if (IN(16)) { Gemm g{(const bf16*)(ws + WS_OM), (const bf16*)(ws + WS_W_MOUT), 512, 512, 512, 0, 0}; StaticOrder S; S.init(M, D, G, bx); EpiRes<false> E{nullptr, X16, D, ALPHA, 1.0f, ST1, ln_g + D, ln_b + D, ST2, X16, (unsigned char*)(ws + WS_X8), FP8_XS};
        gemm_phase<EpiRes<false>, StaticOrder, true>(lds + RING_OFF, g, S, E, wave); }
    SEAM(16);
    if (IN(18)) { Gemm g{(const bf16*)(ws + WS_X8), (const bf16*)(ws + WS_W_GU2), D / 2, D / 2, D / 2, 0, 0}; StaticOrder S; S.init(M, 2 * FF, G, bx); EpiSwiGLU8 E{(unsigned char*)HB, FF, 1.0f / (FP8_XS * FP8_WGUS), FP8_HS, LnFold{ST2, VEC + V_GW_GU2, VEC + V_BW_GU2}};
        gemm_phase<EpiSwiGLU8, StaticOrder, true, true>(lds + RING_OFF, g, S, E, wave); }
    SEAM(18);
    if (IN(19)) { Gemm g{HB, (const bf16*)(ws + WS_W_D2), FF / 2, FF / 2, FF / 2, 0, 0}; StaticOrder S; S.init(M, D, G, bx); EpiRes<false> E{nullptr, X16, D, ALPHA, 0.5f / (FP8_HS * FP8_WDS), ST2, ln_g + 2 * D, ln_b + 2 * D, nullptr, X16, nullptr, 0.f};
        gemm_phase<EpiRes<false>, StaticOrder, true, true>(lds + RING_OFF, g, S, E, wave); }
    SEAM(19);
    if (IN(20)) ln_final_phase(X16, out, ln_g + 3 * D, ln_b + 3 * D, gw, NGW, lane);
#undef IN
#undef SEAM
#undef lane
}

extern "C" void kernel_launch(void* const* d_in, const int* in_sizes, int n_in, void* d_out, int out_size, void* d_ws, size_t ws_size, hipStream_t stream) {
    static int grid = 0;
    if (grid == 0) {
        if (n_in != 24 || in_sizes[0] != M * D || out_size != M * D || ws_size < WS_END) { fprintf(stderr, "kernel_launch: unexpected shapes (n_in %d, in0 %d, out %d, ws %zu); nothing launched\n", n_in, n_in > 0 ? in_sizes[0] : -1, out_size, ws_size); grid = -1; return; }
        int dev = 0, cus = 0, per_cu = 0;
        if (hipGetDevice(&dev) != hipSuccess || hipDeviceGetAttribute(&cus, hipDeviceAttributeMultiprocessorCount, dev) != hipSuccess) { grid = -1; return; }
        if (hipFuncSetAttribute((const void*)mk_fwd, hipFuncAttributeMaxDynamicSharedMemorySize, LDS_BYTES) != hipSuccess) { fprintf(stderr, "kernel_launch: hipFuncSetAttribute failed\n"); grid = -1; return; }
        if (hipOccupancyMaxActiveBlocksPerMultiprocessor(&per_cu, (const void*)mk_fwd, NWAVES * 64, LDS_BYTES) != hipSuccess || per_cu < 1)
            fprintf(stderr, "kernel_launch: note: the occupancy query reports %d workgroups per CU\n", per_cu);
        (void)hipGetLastError();
        grid = cus;
    }
    if (grid < 0) return;
    if (hipMemsetAsync((char*)d_ws + WS_CTL, 0, CTL_ZERO_BYTES, stream) != hipSuccess) return;
    Args a{};
    for (int i = 0; i < 24; ++i) a.in[i] = (const float*)d_in[i];
    a.out = (float*)d_out; a.ws = (unsigned char*)d_ws;
#if MK_ONE_LAUNCH
    a.ph_lo = 0; a.ph_hi = N_PHASES;
    hipLaunchKernelGGL(mk_fwd, dim3(grid), dim3(NWAVES * 64), LDS_BYTES, stream, a);
#else
    for (int p = 0; p < N_PHASES; ++p) { a.ph_lo = p; a.ph_hi = p + 1; hipLaunchKernelGGL(mk_fwd, dim3(grid), dim3(NWAVES * 64), LDS_BYTES, stream, a); }
#endif
}
```

```cpp
#include <hip/hip_runtime.h>
#include <cstdio>
#include <cstdint>

#ifndef MK_ONE_LAUNCH
#define MK_ONE_LAUNCH 1
#endif

__device__ __forceinline__ int lane_fresh() { int l = (int)__builtin_amdgcn_mbcnt_hi(~0u, __builtin_amdgcn_mbcnt_lo(~0u, 0u)); asm volatile("" : "+v"(l)); return l; }
__device__ __forceinline__ void glds16(const void* gsrc, unsigned lds_dst) { unsigned keep;
    asm volatile("s_mov_b32 %0, m0\n\ts_mov_b32 m0, %2\n\ts_nop 0\n\tglobal_load_lds_dwordx4 %1, off\n\ts_mov_b32 m0, %0" : "=&s"(keep) : "v"(gsrc), "s"(lds_dst) : "memory"); }
__device__ __forceinline__ void glds16s(const void* sbase, unsigned voff, unsigned lds_dst) { unsigned keep;
    asm volatile("s_mov_b32 %0, m0\n\ts_mov_b32 m0, %3\n\ts_nop 0\n\tglobal_load_lds_dwordx4 %1, %2\n\ts_mov_b32 m0, %0" : "=&s"(keep) : "v"(voff), "s"(sbase), "s"(lds_dst) : "memory"); }
namespace pg8 {
#define PG8_LAS __attribute__((address_space(3)))
typedef unsigned short bf16_t;
typedef short bf16x8 __attribute__((ext_vector_type(8)));
typedef float f32x4 __attribute__((ext_vector_type(4)));
typedef unsigned u32x4 __attribute__((ext_vector_type(4)));
constexpr int BM = 256, BK = 64, HALF = 128, HTB = HALF * BK * 2  , STAGE_BYTES = 8 * HTB, NXCD = 8, WGM = 8;

__host__ __device__ __forceinline__ int lds_byte(int r, int c) { const int st = (r >> 4) * 2 + (c >> 5), rr = r & 15, cc = c & 31, ob = rr * 64 + cc * 2; return st * 1024 + (ob ^ (((ob >> 9) & 1) << 5)); }
__host__ __device__ __forceinline__ void stage_rc(int b, int& R, int& C) { const int st = b / 1024, sb = b % 1024, swz = sb ^ (((sb >> 9) & 1) << 5); R = (st >> 1) * 16 + swz / 64; C = (st & 1) * 32 + (swz % 64) / 2; }
__host__ __device__ __forceinline__ int perm32(int rho) { const int n = rho >> 4, i = rho & 15; return 8 * (i >> 2) + 4 * n + (i & 3); }

struct Unit { int pm, pn; };
struct Gemm { const bf16_t* A; const bf16_t* Bt; int lda, ldb, K, a_shift, a_mul; };

struct StaticOrder {
    int nM, nN, nwg, G, c;
    __host__ __device__ void init(int M, int N, int G_, int c_) { nM = M / BM; nN = N / BM; nwg = nM * nN; G = G_; c = c_; }
    __host__ __device__ bool next(int i, Unit& u) const {
        const long L = (long)i * G + c; if (L >= nwg) return false;
        int wgid = (int)L; { const int q = nwg / NXCD, r = nwg % NXCD, xcd = wgid % NXCD, off = wgid / NXCD; wgid = (xcd < r ? xcd * (q + 1) : r * (q + 1) + (xcd - r) * q) + off; }
        const int nig = WGM * nN, gid = wgid / nig, fm = gid * WGM, gsz = (nM - fm) < WGM ? (nM - fm) : WGM;
        u.pm = fm + ((wgid % nig) % gsz); u.pn = (wgid % nig) / gsz; return true;
    }
    __device__ __forceinline__ void a_ready(const Unit&) const {}
    __device__ __forceinline__ void done(const Unit&) const {}
};

__device__ __forceinline__ unsigned cvt_pk_bf16(float lo, float hi) { unsigned r; asm volatile("v_cvt_pk_bf16_f32 %0, %1, %2" : "=v"(r) : "v"(lo), "v"(hi)); return r; }
__device__ __forceinline__ float bflo(unsigned w) { return __uint_as_float(w << 16); }
__device__ __forceinline__ float bfhi(unsigned w) { return __uint_as_float(w & 0xffff0000u); }
__device__ __forceinline__ float sigmoidf_fast(float x) { return __builtin_amdgcn_rcpf(1.0f + __builtin_amdgcn_exp2f(-1.4426950408889634f * x)); }

struct LnFold {
    const long long* stats; const float* gW; const float* bW;
    __device__ __forceinline__ void row(int r, float& mean, float& rstd) const { const long long s0 = stats[2 * (size_t)r], s1 = stats[2 * (size_t)r + 1];
        mean = (float)s0 * (1.0f / (1048576.f * 2048.0f)); rstd = __builtin_amdgcn_rsqf((float)s1 * (1.0f / (65536.f * 2048.0f)) - mean * mean + 1e-5f); }
    __device__ __forceinline__ f32x4 vec4(const float* v, int i) const { return *(const f32x4*)(v + i); }
    __device__ __forceinline__ void rows8(int row0, float (&mean)[8], float (&rstd)[8]) const {
#pragma unroll
        for (int hf = 0; hf < 2; ++hf) { long long s0[4], s1[4];
#pragma unroll
            for (int q = 0; q < 4; ++q) { const size_t r = (size_t)(row0 + hf * 128 + q * 16); s0[q] = stats[2 * r]; s1[q] = stats[2 * r + 1]; }
#pragma unroll
            for (int q = 0; q < 4; ++q) { const float mu = (float)s0[q] * (1.0f / (1048576.f * 2048.0f)); mean[4 * hf + q] = mu; rstd[4 * hf + q] = __builtin_amdgcn_rsqf((float)s1[q] * (1.0f / (65536.f * 2048.0f)) - mu * mu + 1e-5f); }
            asm volatile("" : "+v"(mean[4 * hf]), "+v"(mean[4 * hf + 1]), "+v"(mean[4 * hf + 2]), "+v"(mean[4 * hf + 3]), "+v"(rstd[4 * hf]), "+v"(rstd[4 * hf + 1]), "+v"(rstd[4 * hf + 2]), "+v"(rstd[4 * hf + 3]) :: "memory"); }
    }
};
struct EpiBf16 {
    static constexpr bool PERM = true, AFTER_DRAIN = false;
    bf16_t* O; int ldc; float sc = 1.0f; LnFold lf = {nullptr, nullptr, nullptr};
    __device__ __forceinline__ void operator()(const f32x4 (&acc)[2][2][4][2], const Unit& u, int wr, int wc, int fr, int fq) const {
        const int row0 = u.pm * BM + wr * 64 + fr, col0 = u.pn * BM + wc * 32 + 8 * fq;
        f32x4 gw[2][2], bw[2][2];
#pragma unroll
        for (int bj = 0; bj < 2; ++bj)
#pragma unroll
            for (int n = 0; n < 2; ++n) { gw[bj][n] = (f32x4){0.f, 0.f, 0.f, 0.f}; bw[bj][n] = (f32x4){0.f, 0.f, 0.f, 0.f}; if (lf.stats) { gw[bj][n] = lf.vec4(lf.gW, col0 + bj * HALF + 4 * n); bw[bj][n] = lf.vec4(lf.bW, col0 + bj * HALF + 4 * n); } }
        float mean8[8], rstd8[8];
#pragma unroll
        for (int q = 0; q < 8; ++q) { mean8[q] = 0.f; rstd8[q] = 1.f; }
        if (lf.stats) lf.rows8(row0, mean8, rstd8);
#pragma unroll
        for (int ai = 0; ai < 2; ++ai)
#pragma unroll
            for (int m = 0; m < 4; ++m) { bf16_t* rowp = O + (size_t)(row0 + ai * HALF + m * 16) * ldc + col0;
                const float mean = mean8[ai * 4 + m], rstd = rstd8[ai * 4 + m];
#pragma unroll
                for (int bj = 0; bj < 2; ++bj) { const f32x4 v0 = ((acc[ai][bj][m][0] - gw[bj][0] * mean) * rstd + bw[bj][0]) * sc, v1 = ((acc[ai][bj][m][1] - gw[bj][1] * mean) * rstd + bw[bj][1]) * sc;
                    u32x4 w; w.x = cvt_pk_bf16(v0[0], v0[1]); w.y = cvt_pk_bf16(v0[2], v0[3]); w.z = cvt_pk_bf16(v1[0], v1[1]); w.w = cvt_pk_bf16(v1[2], v1[3]);
                    *(u32x4*)(rowp + bj * HALF) = w; } }
    }
};
struct EpiInProj {
    static constexpr bool PERM = true, AFTER_DRAIN = false;
    bf16_t *aq, *ak, *av, *bq, *bc, *iq, *ikw; float qscale; LnFold lf; unsigned* kmax;
    __device__ __forceinline__ void operator()(const f32x4 (&acc)[2][2][4][2], const Unit& u, int wr, int wc, int fr, int fq) const {
        bf16_t* base; int ldc, colt; const int pn = u.pn;
        if (pn < 4) { base = aq; ldc = 1024; colt = pn * 256; }
        else if (pn < 8) { base = ak; ldc = 1024; colt = (pn - 4) * 256; }
        else if (pn < 12) { base = av; ldc = 1024; colt = (pn - 8) * 256; }
        else if (pn < 16) { base = bq; ldc = 1024; colt = (pn - 12) * 256; }
        else if (pn < 18) { base = bc; ldc = 512; colt = (pn - 16) * 256; }
        else if (pn < 22) { base = iq; ldc = 1024; colt = (pn - 18) * 256; }
        else { base = ikw; ldc = 256; colt = 0; }
        const float sc = (pn < 4) ? qscale : 1.0f; float kam[2] = {0.f, 0.f};
        const int row0 = u.pm * BM + wr * 64 + fr, col0 = colt + wc * 32 + 8 * fq, cidx = pn * BM + wc * 32 + 8 * fq;
        f32x4 gw[2][2], bw[2][2];
#pragma unroll
        for (int bj = 0; bj < 2; ++bj)
#pragma unroll
            for (int n = 0; n < 2; ++n) { gw[bj][n] = lf.vec4(lf.gW, cidx + bj * HALF + 4 * n); bw[bj][n] = lf.vec4(lf.bW, cidx + bj * HALF + 4 * n); }
        float mean8[8], rstd8[8]; lf.rows8(row0, mean8, rstd8);
#pragma unroll
        for (int ai = 0; ai < 2; ++ai)
#pragma unroll
            for (int m = 0; m < 4; ++m) { bf16_t* rowp = base + (size_t)(row0 + ai * HALF + m * 16) * ldc + col0;
                const float mean = mean8[ai * 4 + m], rstd = rstd8[ai * 4 + m];
#pragma unroll
                for (int bj = 0; bj < 2; ++bj) { const f32x4 v0 = ((acc[ai][bj][m][0] - gw[bj][0] * mean) * rstd + bw[bj][0]) * sc, v1 = ((acc[ai][bj][m][1] - gw[bj][1] * mean) * rstd + bw[bj][1]) * sc;
                    kam[bj] = fmaxf(kam[bj], fmaxf(fmaxf(fmaxf(fabsf(v0[0]), fabsf(v0[1])), fmaxf(fabsf(v0[2]), fabsf(v0[3]))), fmaxf(fmaxf(fabsf(v1[0]), fabsf(v1[1])), fmaxf(fabsf(v1[2]), fabsf(v1[3])))));
                    u32x4 w; w.x = cvt_pk_bf16(v0[0], v0[1]); w.y = cvt_pk_bf16(v0[2], v0[3]); w.z = cvt_pk_bf16(v1[0], v1[1]); w.w = cvt_pk_bf16(v1[2], v1[3]);
                    *(u32x4*)(rowp + bj * HALF) = w; } }
        if (pn >= 4 && pn < 8) {
#pragma unroll
            for (int bj = 0; bj < 2; ++bj) { float v = kam[bj];
#pragma unroll
                for (int o = 1; o < 64; o <<= 1) v = fmaxf(v, __shfl_xor(v, o));
                if ((fr | fq) == 0) (void)__hip_atomic_fetch_max(kmax + ((u.pm >> 4) * 8 + 2 * (pn - 4) + bj) * 2 + (wc >> 1), __float_as_uint(v), __ATOMIC_RELAXED, __HIP_MEMORY_SCOPE_AGENT); } }
    }
};
struct EpiSwiGLU {
    static constexpr bool PERM = true, AFTER_DRAIN = false;
    bf16_t* O; int ldc;
    __device__ __forceinline__ void operator()(const f32x4 (&acc)[2][2][4][2], const Unit& u, int wr, int wc, int fr, int fq) const {
        const int row0 = u.pm * BM + wr * 64 + fr, col0 = u.pn * HALF + wc * 32 + 8 * fq;
#pragma unroll
        for (int ai = 0; ai < 2; ++ai)
#pragma unroll
            for (int m = 0; m < 4; ++m) { bf16_t* rowp = O + (size_t)(row0 + ai * HALF + m * 16) * ldc + col0;
                float h[8];
#pragma unroll
                for (int n = 0; n < 2; ++n)
#pragma unroll
                    for (int j = 0; j < 4; ++j) { const float g = acc[ai][0][m][n][j], up = acc[ai][1][m][n][j]; h[4 * n + j] = g * sigmoidf_fast(g) * up; }
                u32x4 w; w.x = cvt_pk_bf16(h[0], h[1]); w.y = cvt_pk_bf16(h[2], h[3]); w.z = cvt_pk_bf16(h[4], h[5]); w.w = cvt_pk_bf16(h[6], h[7]);
                *(u32x4*)rowp = w; }
    }
};
__device__ __forceinline__ unsigned pk4_fp8(float a, float b, float c, float d) { int w = 0; w = __builtin_amdgcn_cvt_pk_fp8_f32(a, b, w, false); w = __builtin_amdgcn_cvt_pk_fp8_f32(c, d, w, true); return (unsigned)w; }
struct EpiSwiGLU8 {
    static constexpr bool PERM = true, AFTER_DRAIN = false;
    unsigned char* O; int ldc; float ascale, hs; LnFold lf;
    __device__ __forceinline__ void operator()(const f32x4 (&acc)[2][2][4][2], const Unit& u, int wr, int wc, int fr, int fq) const {
        const int row0 = u.pm * BM + wr * 64 + fr, col0 = u.pn * HALF + wc * 32 + 8 * fq, cidx = u.pn * BM + wc * 32 + 8 * fq;
        typedef unsigned u32x2 __attribute__((ext_vector_type(2)));
        f32x4 gw[2][2], bw[2][2];
#pragma unroll
        for (int bj = 0; bj < 2; ++bj)
#pragma unroll
            for (int n = 0; n < 2; ++n) { gw[bj][n] = (f32x4){0.f, 0.f, 0.f, 0.f}; bw[bj][n] = (f32x4){0.f, 0.f, 0.f, 0.f}; if (lf.stats) { gw[bj][n] = lf.vec4(lf.gW, cidx + bj * HALF + 4 * n); bw[bj][n] = lf.vec4(lf.bW, cidx + bj * HALF + 4 * n); } }
        float mean8[8], rstd8[8];
#pragma unroll
        for (int q = 0; q < 8; ++q) { mean8[q] = 0.f; rstd8[q] = 1.f; }
        if (lf.stats) lf.rows8(row0, mean8, rstd8);
#pragma unroll
        for (int ai = 0; ai < 2; ++ai)
#pragma unroll
            for (int m = 0; m < 4; ++m) { unsigned char* rowp = O + (size_t)(row0 + ai * HALF + m * 16) * ldc + col0;
                float h[8]; const float mean = mean8[ai * 4 + m], rstd = rstd8[ai * 4 + m];
#pragma unroll
                for (int n = 0; n < 2; ++n)
#pragma unroll
                    for (int j = 0; j < 4; ++j) { const float g = (acc[ai][0][m][n][j] * ascale - gw[0][n][j] * mean) * rstd + bw[0][n][j], up = (acc[ai][1][m][n][j] * ascale - gw[1][n][j] * mean) * rstd + bw[1][n][j];
                        h[4 * n + j] = fminf(fmaxf(g * sigmoidf_fast(g) * up * hs, -448.f), 448.f); }
                *(u32x2*)rowp = (u32x2){pk4_fp8(h[0], h[1], h[2], h[3]), pk4_fp8(h[4], h[5], h[6], h[7])}; }
    }
};
struct EpiGateMerge {
    static constexpr bool PERM = true, AFTER_DRAIN = false;
    const bf16_t* ta; const bf16_t* tb; bf16_t* O; int ldc; const float* b0; const float* b1;
    __device__ __forceinline__ void operator()(const f32x4 (&acc)[2][2][4][2], const Unit& u, int wr, int wc, int fr, int fq) const {
        const int row0 = u.pm * BM + wr * 64 + fr, col0 = u.pn * HALF + wc * 32 + 8 * fq;
        float bb0[8], bb1[8];
#pragma unroll
        for (int j = 0; j < 8; ++j) { bb0[j] = b0[col0 + j]; bb1[j] = b1[col0 + j]; }
#pragma unroll
        for (int ai = 0; ai < 2; ++ai)
#pragma unroll
            for (int m = 0; m < 4; ++m) { const size_t off = (size_t)(row0 + ai * HALF + m * 16) * ldc + col0;
                const u32x4 a = *(const u32x4*)(ta + off), b = *(const u32x4*)(tb + off);
                const float av[8] = {bflo(a.x), bfhi(a.x), bflo(a.y), bfhi(a.y), bflo(a.z), bfhi(a.z), bflo(a.w), bfhi(a.w)};
                const float bv[8] = {bflo(b.x), bfhi(b.x), bflo(b.y), bfhi(b.y), bflo(b.z), bfhi(b.z), bflo(b.w), bfhi(b.w)};
                float h[8];
#pragma unroll
                for (int n = 0; n < 2; ++n)
#pragma unroll
                    for (int j = 0; j < 4; ++j) { const int e = 4 * n + j; h[e] = sigmoidf_fast(acc[ai][0][m][n][j] + bb0[e]) * av[e] + sigmoidf_fast(acc[ai][1][m][n][j] + bb1[e]) * bv[e]; }
                u32x4 w; w.x = cvt_pk_bf16(h[0], h[1]); w.y = cvt_pk_bf16(h[2], h[3]); w.z = cvt_pk_bf16(h[4], h[5]); w.w = cvt_pk_bf16(h[6], h[7]);
                *(u32x4*)(O + off) = w; }
    }
};
struct EpiGateMerge8 {
    static constexpr bool PERM = true, AFTER_DRAIN = false;
    const bf16_t* ta; const bf16_t* tb; unsigned char* O; int ldc; const float* b0; const float* b1; float ascale, ms; LnFold lf;
    __device__ __forceinline__ void operator()(const f32x4 (&acc)[2][2][4][2], const Unit& u, int wr, int wc, int fr, int fq) const {
        const int row0 = u.pm * BM + wr * 64 + fr, col0 = u.pn * HALF + wc * 32 + 8 * fq, cidx = u.pn * BM + wc * 32 + 8 * fq;
        typedef unsigned u32x2 __attribute__((ext_vector_type(2)));
        float mean8[8], rstd8[8]; lf.rows8(row0, mean8, rstd8);
        float bb0[8], bb1[8], gw0[8], gw1[8];
#pragma unroll
        for (int j = 0; j < 8; ++j) { bb0[j] = b0[col0 + j] + lf.bW[cidx + j]; bb1[j] = b1[col0 + j] + lf.bW[cidx + HALF + j]; gw0[j] = lf.gW[cidx + j]; gw1[j] = lf.gW[cidx + HALF + j]; }
#pragma unroll
        for (int am = 0; am < 8; am += 2) {
            u32x4 pa[2], pb[2];
#pragma unroll
            for (int e2 = 0; e2 < 2; ++e2) { const size_t off = (size_t)(row0 + ((am + e2) >> 2) * HALF + ((am + e2) & 3) * 16) * ldc + col0; pa[e2] = *(const u32x4*)(ta + off); pb[e2] = *(const u32x4*)(tb + off); }
#pragma unroll
            for (int e2 = 0; e2 < 2; ++e2) { const int ai = (am + e2) >> 2, m = (am + e2) & 3; const size_t off = (size_t)(row0 + ai * HALF + m * 16) * ldc + col0;
                const u32x4 a = pa[e2], b = pb[e2];
                const float av[8] = {bflo(a.x), bfhi(a.x), bflo(a.y), bfhi(a.y), bflo(a.z), bfhi(a.z), bflo(a.w), bfhi(a.w)};
                const float bv[8] = {bflo(b.x), bfhi(b.x), bflo(b.y), bfhi(b.y), bflo(b.z), bfhi(b.z), bflo(b.w), bfhi(b.w)};
                float h[8]; const float mean = mean8[ai * 4 + m], rstd = rstd8[ai * 4 + m];
#pragma unroll
                for (int n = 0; n < 2; ++n)
#pragma unroll
                    for (int j = 0; j < 4; ++j) { const int e = 4 * n + j; const float v = sigmoidf_fast((acc[ai][0][m][n][j] * ascale - gw0[e] * mean) * rstd + bb0[e]) * av[e] + sigmoidf_fast((acc[ai][1][m][n][j] * ascale - gw1[e] * mean) * rstd + bb1[e]) * bv[e];
                        h[e] = fminf(fmaxf(v * ms, -448.f), 448.f); }
                *(u32x2*)(O + off) = (u32x2){pk4_fp8(h[0], h[1], h[2], h[3]), pk4_fp8(h[4], h[5], h[6], h[7])}; }
            asm volatile("" ::: "memory"); }
    }
};
template <bool RES32, int NB = 2> struct EpiRes {
    static constexpr bool PERM = true, AFTER_DRAIN = false;
    const float* res32; const bf16_t* res16; int ldc; float alpha, s;
    const long long* rstats; const float* rg; const float* rb; long long* ostats; bf16_t* o16; unsigned char* o8; float o8s;
    __device__ __forceinline__ void operator()(const f32x4 (&acc)[2][2][4][2], const Unit& u, int wr, int wc, int fr, int fq) const {
        const int col0 = u.pn * BM + wc * 32 + 8 * fq;
        typedef unsigned u32x2 __attribute__((ext_vector_type(2)));
        float al = alpha, sa = s; asm volatile("" : "+v"(al), "+v"(sa));
        const int rowb = u.pm * BM + wr * 64 + fr;
        float mean8[8], rstd8[8];
#pragma unroll
        for (int q = 0; q < 8; ++q) { mean8[q] = 0.f; rstd8[q] = 1.f; }
        if (rstats) { LnFold lf{rstats, nullptr, nullptr}; lf.rows8(rowb, mean8, rstd8); }
        asm volatile("" : "+v"(mean8[0]), "+v"(mean8[1]), "+v"(mean8[2]), "+v"(mean8[3]), "+v"(mean8[4]), "+v"(mean8[5]), "+v"(mean8[6]), "+v"(mean8[7]), "+v"(rstd8[0]), "+v"(rstd8[1]), "+v"(rstd8[2]), "+v"(rstd8[3]), "+v"(rstd8[4]), "+v"(rstd8[5]), "+v"(rstd8[6]), "+v"(rstd8[7]) :: "memory");
        f32x4 gv[2][2], bv[2][2];
#pragma unroll
        for (int bj = 0; bj < 2; ++bj)
#pragma unroll
            for (int n = 0; n < 2; ++n) { gv[bj][n] = (f32x4){1.f, 1.f, 1.f, 1.f}; bv[bj][n] = (f32x4){0.f, 0.f, 0.f, 0.f};
                if (rstats) { gv[bj][n] = *(const f32x4*)(rg + col0 + bj * HALF + 4 * n); bv[bj][n] = *(const f32x4*)(rb + col0 + bj * HALF + 4 * n); }
                gv[bj][n] = gv[bj][n] * al; bv[bj][n] = bv[bj][n] * al; }
#pragma unroll
        for (int am = 0; am < 8; am += NB) {
            f32x4 rr[RES32 ? NB : 1][2][2]; u32x4 rw[NB][2];
#pragma unroll
            for (int e2 = 0; e2 < NB; ++e2) { const size_t off = (size_t)(rowb + ((am + e2) >> 2) * HALF + ((am + e2) & 3) * 16) * ldc + col0;
#pragma unroll
                for (int bj = 0; bj < 2; ++bj) {
                    if constexpr (RES32) { rr[e2][bj][0] = *(const f32x4*)(res32 + off + bj * HALF); rr[e2][bj][1] = *(const f32x4*)(res32 + off + bj * HALF + 4); }
                    else rw[e2][bj] = *(const u32x4*)(res16 + off + bj * HALF); } }
#pragma unroll
            for (int e2 = 0; e2 < NB; ++e2) { const int ai = (am + e2) >> 2, m = (am + e2) & 3; const int row = rowb + ai * HALF + m * 16; const size_t off = (size_t)row * ldc + col0;
                const float mean = mean8[am + e2], rstd = rstd8[am + e2];
                float ps = 0.f, pq = 0.f;
#pragma unroll
                for (int bj = 0; bj < 2; ++bj) {
                    f32x4 r0, r1;
                    if constexpr (RES32) { r0 = rr[e2][bj][0]; r1 = rr[e2][bj][1]; } else { const u32x4 w = rw[e2][bj]; r0 = (f32x4){bflo(w.x), bfhi(w.x), bflo(w.y), bfhi(w.y)}; r1 = (f32x4){bflo(w.z), bfhi(w.z), bflo(w.w), bfhi(w.w)}; }
                    const f32x4 z0 = (r0 - mean) * rstd * gv[bj][0] + bv[bj][0] + acc[ai][bj][m][0] * sa, z1 = (r1 - mean) * rstd * gv[bj][1] + bv[bj][1] + acc[ai][bj][m][1] * sa;
                    u32x4 w16; w16.x = cvt_pk_bf16(z0[0], z0[1]); w16.y = cvt_pk_bf16(z0[2], z0[3]); w16.z = cvt_pk_bf16(z1[0], z1[1]); w16.w = cvt_pk_bf16(z1[2], z1[3]);
                    *(u32x4*)(o16 + off + bj * HALF) = w16;
                    const float q0 = bflo(w16.x), q1 = bfhi(w16.x), q2 = bflo(w16.y), q3 = bfhi(w16.y), q4 = bflo(w16.z), q5 = bfhi(w16.z), q6 = bflo(w16.w), q7 = bfhi(w16.w);
                    ps += ((q0 + q1) + (q2 + q3)) + ((q4 + q5) + (q6 + q7)); pq += ((q0 * q0 + q1 * q1) + (q2 * q2 + q3 * q3)) + ((q4 * q4 + q5 * q5) + (q6 * q6 + q7 * q7));
                    if (o8) *(u32x2*)(o8 + off + bj * HALF) = (u32x2){pk4_fp8(fminf(fmaxf(q0 * o8s, -448.f), 448.f), fminf(fmaxf(q1 * o8s, -448.f), 448.f), fminf(fmaxf(q2 * o8s, -448.f), 448.f), fminf(fmaxf(q3 * o8s, -448.f), 448.f)),
                                                                      pk4_fp8(fminf(fmaxf(q4 * o8s, -448.f), 448.f), fminf(fmaxf(q5 * o8s, -448.f), 448.f), fminf(fmaxf(q6 * o8s, -448.f), 448.f), fminf(fmaxf(q7 * o8s, -448.f), 448.f))}; }
                if (ostats) { ps += __shfl_xor(ps, 16); ps += __shfl_xor(ps, 32); pq += __shfl_xor(pq, 16); pq += __shfl_xor(pq, 32);
                    if (fq == 0) { (void)__hip_atomic_fetch_add(ostats + 2 * (size_t)row, (long long)__builtin_rintf(ps * 1048576.f), __ATOMIC_RELAXED, __HIP_MEMORY_SCOPE_AGENT); (void)__hip_atomic_fetch_add(ostats + 2 * (size_t)row + 1, (long long)__builtin_rintf(pq * 65536.f), __ATOMIC_RELAXED, __HIP_MEMORY_SCOPE_AGENT); } } }
            asm volatile("" ::: "memory"); }
    }
};

typedef int v8i_t __attribute__((ext_vector_type(8)));
typedef int v4i_t __attribute__((ext_vector_type(4)));
template <class Epi, class Sched, bool ALIGN_EPI, bool FP8 = false>
__device__ __forceinline__ void gemm_phase(PG8_LAS unsigned char* lds, const Gemm g, const Sched& S, const Epi& E, const int wid) {
    const int lane = lane_fresh(), tid = wid * 64 + lane, wr = wid >> 2, wc = wid & 3, fr = lane & 15, fq = lane >> 4;
    const int K = g.K, nt = K / BK;
    unsigned voffA[2], voffB[2];
#pragma unroll
    for (int i = 0; i < 2; ++i) { int R, C; stage_rc(tid * 16 + i * 8192, R, C); const int Rb = Epi::PERM ? ((R & ~31) + perm32(R & 31)) : R;
        voffA[i] = (unsigned)(R * g.lda + C) * 2u; voffB[i] = (unsigned)(Rb * g.ldb + C) * 2u; }
    const size_t kstep = (size_t)(BK * 2);
    const size_t hstepA = (size_t)HALF * g.lda * 2, hstepB = (size_t)HALF * g.ldb * 2;
    const size_t tstepA = 2 * hstepA, tstepB = 2 * hstepB;
    const unsigned ldsw = (unsigned)wid * 1024u;
    int aoff = lds_byte(wr * 64 + fr, fq * 8), boff = lds_byte(wc * 32 + fr, fq * 8);
    asm volatile("" : "+v"(voffA[0]), "+v"(voffA[1]), "+v"(voffB[0]), "+v"(voffB[1]), "+v"(aoff), "+v"(boff));
#define PG8_UA(u) ((const char*)g.A + (size_t)(u).pm * tstepA + (size_t)(((u).pn >> g.a_shift) * g.a_mul) * 2)
#define PG8_UB(u) ((const char*)g.Bt + (size_t)(u).pn * tstepB)
#define PG8_SA(b, h) (((b) * 2 + (h)) * HTB)
#define PG8_SB(b, h) ((4 + (b) * 2 + (h)) * HTB)
#define PG8_STAGE(bufoff, gbase, voff) do { _Pragma("unroll") for (int _i = 0; _i < 2; ++_i) \
        __builtin_amdgcn_global_load_lds((const unsigned*)((const char*)(gbase) + (voff)[_i]), (PG8_LAS unsigned*)(lds + (bufoff) + ldsw + _i * 8192), 16, 0, 0); } while (0)
#define PG8_LD8(p_) __builtin_shufflevector(*(const PG8_LAS v4i_t*)(p_), *(const PG8_LAS v4i_t*)((p_) + 1024), 0, 1, 2, 3, 4, 5, 6, 7)
#define PG8_LDA(dst, b, h) do { _Pragma("unroll") for (int m = 0; m < 4; ++m) { if constexpr (FP8) dst##8[m] = PG8_LD8(lds + PG8_SA(b, h) + aoff + m * 2048); else { _Pragma("unroll") for (int k = 0; k < 2; ++k) dst[m][k] = *(const PG8_LAS bf16x8*)(lds + PG8_SA(b, h) + aoff + m * 2048 + k * 1024); } } } while (0)
#define PG8_LDB(dst, b, h) do { _Pragma("unroll") for (int n = 0; n < 2; ++n) { if constexpr (FP8) dst##8[n] = PG8_LD8(lds + PG8_SB(b, h) + boff + n * 2048); else { _Pragma("unroll") for (int k = 0; k < 2; ++k) dst[n][k] = *(const PG8_LAS bf16x8*)(lds + PG8_SB(b, h) + boff + n * 2048 + k * 1024); } } } while (0)
#define PG8_MMA(ai, bj, At, Bt) do { __builtin_amdgcn_s_setprio(1); _Pragma("unroll") for (int m = 0; m < 4; ++m) _Pragma("unroll") for (int n = 0; n < 2; ++n) { \
        if constexpr (FP8) asm volatile("v_mfma_scale_f32_16x16x128_f8f6f4 %0, %1, %2, %0, %3, %3 op_sel_hi:[0,0,0]" : "+v"(acc[ai][bj][m][n]) : "v"(Bt##8[n]), "v"(At##8[m]), "v"(one_scale)); \
        else { _Pragma("unroll") for (int k = 0; k < 2; ++k) acc[ai][bj][m][n] = __builtin_amdgcn_mfma_f32_16x16x32_bf16(Bt[n][k], At[m][k], acc[ai][bj][m][n], 0, 0, 0); } } \
        __builtin_amdgcn_s_setprio(0); } while (0)
#define PG8_WAIT_V(n) asm volatile("s_waitcnt vmcnt(" #n ")" ::: "memory")
#define PG8_WAIT_L(n) asm volatile("s_waitcnt lgkmcnt(" #n ")" ::: "memory")
#define PG8_BAR __builtin_amdgcn_s_barrier()
#define PG8_SCHED __builtin_amdgcn_sched_barrier(0)
    Unit cur, nxt; int ui = 0;
    if (!S.next(0, cur)) return;
    f32x4 acc[2][2][4][2];
#pragma unroll
    for (int a = 0; a < 2; ++a)
#pragma unroll
        for (int b = 0; b < 2; ++b)
#pragma unroll
            for (int m = 0; m < 4; ++m)
#pragma unroll
                for (int n = 0; n < 2; ++n) acc[a][b][m][n] = (f32x4){0.f, 0.f, 0.f, 0.f};
    bf16x8 At[4][2], B0[2][2], B1[2][2]; v8i_t At8[4], B08[2], B18[2];
    int one_scale = 0x7f7f7f7f; asm volatile("" : "+v"(one_scale));
    const char* cA = PG8_UA(cur); const char* cB = PG8_UB(cur);
    S.a_ready(cur);
    PG8_STAGE(PG8_SB(0, 0), cB, voffB); PG8_STAGE(PG8_SB(0, 1), cB + hstepB, voffB); PG8_STAGE(PG8_SA(0, 0), cA, voffA); PG8_STAGE(PG8_SA(0, 1), cA + hstepA, voffA);
    if (wr == 1) PG8_BAR;
    PG8_WAIT_V(2); PG8_BAR;
    PG8_STAGE(PG8_SB(1, 0), cB + kstep, voffB); PG8_STAGE(PG8_SA(1, 0), cA + kstep, voffA); PG8_STAGE(PG8_SB(1, 1), cB + hstepB + kstep, voffB);
    PG8_WAIT_V(6); PG8_BAR;
    for (;;) {
        const bool has_next = S.next(ui + 1, nxt);
        const char* nA = has_next ? PG8_UA(nxt) : cA; const char* nB = has_next ? PG8_UB(nxt) : cB;
        for (int t = 0; t < nt; t += 2) {
            const bool last = (t == nt - 2);
            const char* a1 = cA + (size_t)(t + 1) * kstep;
            const char* a2 = last ? nA : cA + (size_t)(t + 2) * kstep; const char* b2 = last ? nB : cB + (size_t)(t + 2) * kstep;
            const char* a3 = a2 + kstep; const char* b3 = b2 + kstep;
            if (last && has_next) S.a_ready(nxt);
            PG8_LDB(B0, 0, 0); PG8_LDB(B1, 0, 1); PG8_SCHED; PG8_LDA(At, 0, 0); PG8_STAGE(PG8_SA(1, 1), a1 + hstepA, voffA);
            PG8_WAIT_V(8); PG8_WAIT_L(0); PG8_BAR; PG8_MMA(0, 0, At, B0); PG8_MMA(0, 1, At, B1); PG8_BAR; PG8_SCHED;
            PG8_LDA(At, 0, 1); PG8_STAGE(PG8_SB(0, 0), b2, voffB); PG8_STAGE(PG8_SB(0, 1), b2 + hstepB, voffB); PG8_STAGE(PG8_SA(0, 0), a2, voffA);
            PG8_WAIT_V(8); PG8_WAIT_L(0); PG8_BAR; PG8_MMA(1, 0, At, B0); PG8_MMA(1, 1, At, B1); PG8_BAR; PG8_SCHED;
            PG8_LDB(B0, 1, 0); PG8_LDB(B1, 1, 1); PG8_SCHED; PG8_LDA(At, 1, 0); PG8_STAGE(PG8_SA(0, 1), a2 + hstepA, voffA);
            PG8_WAIT_V(8); PG8_WAIT_L(0); PG8_BAR; PG8_MMA(0, 0, At, B0); PG8_MMA(0, 1, At, B1); PG8_BAR; PG8_SCHED;
            PG8_LDA(At, 1, 1); PG8_STAGE(PG8_SB(1, 0), b3, voffB); PG8_STAGE(PG8_SB(1, 1), b3 + hstepB, voffB); PG8_STAGE(PG8_SA(1, 0), a3, voffA);
            PG8_WAIT_V(8); PG8_WAIT_L(0); PG8_BAR; PG8_MMA(1, 0, At, B0); PG8_MMA(1, 1, At, B1); PG8_BAR; PG8_SCHED;
        }
        if constexpr (ALIGN_EPI) { if (wr == 0) PG8_BAR; }
        if constexpr (FP8) asm volatile("s_nop 15\n\ts_nop 7" ::: "memory");
        { const int le = lane_fresh(); E(acc, cur, wr, wc, le & 15, le >> 4); } S.done(cur);
        if (!has_next) break;
#pragma unroll
        for (int a = 0; a < 2; ++a)
#pragma unroll
            for (int b = 0; b < 2; ++b)
#pragma unroll
                for (int m = 0; m < 4; ++m)
#pragma unroll
                    for (int n = 0; n < 2; ++n) acc[a][b][m][n] = (f32x4){0.f, 0.f, 0.f, 0.f};
        cur = nxt; cA = nA; cB = nB; ++ui;
        if constexpr (ALIGN_EPI) { if (wr == 1) PG8_BAR; }
    }
    PG8_WAIT_V(0);
    if constexpr (!ALIGN_EPI) { if (wr == 0) PG8_BAR; }
    PG8_BAR;
#undef PG8_UA
#undef PG8_UB
#undef PG8_SA
#undef PG8_SB
#undef PG8_STAGE
#undef PG8_LDA
#undef PG8_LDB
#undef PG8_MMA
#undef PG8_LD8
#undef PG8_WAIT_V
#undef PG8_WAIT_L
#undef PG8_BAR
#undef PG8_SCHED
}
}

constexpr int NWAVES = 8;
constexpr int BATCH = 4, SEQ = 4096, D = 2048, FF = 5632, M = BATCH * SEQ;
constexpr int N_IN = 5888;
constexpr int MEMT = 256;
constexpr float LN_EPS = 1e-5f;
constexpr float ALPHA = 1.189207115002721f;
constexpr float LAMBDA_INIT = 0.2f;

constexpr size_t MiB = 1u << 20;
constexpr size_t WS_CTL = 0, CTL_ZERO_BYTES = 2 * MiB;
constexpr size_t WS_W_IN = 2 * MiB;
constexpr size_t WS_W_G = 25 * MiB;
constexpr size_t WS_W_UK = 41 * MiB;
constexpr size_t WS_W_UVP = 42 * MiB;
constexpr size_t WS_W_A = 44 * MiB;
constexpr size_t WS_W_B = 48 * MiB;
constexpr size_t WS_W_MO = 52 * MiB;
constexpr size_t WS_W_MQ = 60 * MiB;
constexpr size_t WS_W_MKV = 62 * MiB;
constexpr size_t WS_W_MOUT = 66 * MiB;
constexpr size_t WS_MEM16 = 68 * MiB;
constexpr size_t WS_KVMEM = 72 * MiB;
constexpr size_t WS_W_GU2 = 74 * MiB;
constexpr size_t WS_W_D2 = 96 * MiB;
constexpr size_t WS_X8M = 107 * MiB;
constexpr size_t WS_X16 = 140 * MiB;
constexpr size_t WS_MIX = 204 * MiB;
constexpr size_t WS_W_GU1 = 204 * MiB;
constexpr size_t WS_W_D1 = 248 * MiB;
constexpr size_t WS_H = 270 * MiB;
constexpr size_t WS_AQ = WS_MIX + 0 * MiB, WS_AK = WS_MIX + 32 * MiB, WS_AV = WS_MIX + 64 * MiB, WS_BQ = WS_MIX + 96 * MiB;
constexpr size_t WS_BC = WS_MIX + 128 * MiB;
constexpr size_t WS_IQ = WS_MIX + 144 * MiB;
constexpr size_t WS_IKW = WS_MIX + 176 * MiB;
constexpr size_t WS_QLAT = WS_MIX + 184 * MiB;
constexpr size_t WS_IDX = WS_MIX + 312 * MiB;
constexpr size_t WS_YB = WS_BQ;
constexpr size_t WS_TA = WS_QLAT, WS_TB = WS_QLAT + 64 * MiB;
constexpr size_t WS_QM = WS_AQ, WS_OM = WS_AQ + 16 * MiB;
constexpr size_t WS_X8 = WS_H + 96 * MiB;
constexpr size_t WS_C8 = WS_W_IN;
constexpr size_t WS_MRG8 = WS_AV;
constexpr float FP8_WGS = 1024.f, FP8_MS = 32.f, FP8_WMOS = 2048.f;
constexpr float FP8_XS = 32.f, FP8_WGUS = 1024.f, FP8_HS = 8.f, FP8_WDS = 4096.f;
constexpr size_t WS_END = WS_MIX + 320 * MiB;
static_assert(WS_H + (size_t)M * FF * 2 <= WS_END && WS_QLAT + (size_t)M * 4096 * 2 <= WS_END, "d_ws map");
constexpr int CW_BAR = 4096;
constexpr int CW_DQ = 8192;
constexpr int CW_KMAX = 8256;
constexpr size_t CTL_STATS = 65536, CTL_STATS_STRIDE = (size_t)M * 2 * 8;
constexpr size_t CTL_VEC = CTL_STATS + 3 * CTL_STATS_STRIDE;
constexpr int V_GW_IN = 0, V_BW_IN = 5888, V_GW_G = 11776, V_BW_G = 15872, V_GW_MQ = 19968, V_BW_MQ = 20480, V_GW_GU2 = 20992, V_BW_GU2 = 32256, V_END = 43520;
constexpr size_t CTL_VECF = CTL_VEC + (size_t)V_END * 8;
static_assert(CTL_VECF + (size_t)V_END * 4 <= CTL_ZERO_BYTES, "control region");
constexpr float FX_S = 1048576.f, FX_Q = 65536.f, FX_V = 16777216.f;

constexpr int RING_OFF = 0, RING_BYTES = 153600;
constexpr int LDSCTL_OFF = RING_BYTES, MISC_OFF = LDSCTL_OFF + 320;
constexpr int LDS_BYTES = 154624;
static_assert(MISC_OFF + 128 <= LDS_BYTES, "LDS map");

#define GAS __attribute__((address_space(1)))
#define LAS __attribute__((address_space(3)))
typedef unsigned short bf16;
typedef unsigned v4u __attribute__((ext_vector_type(4)));
typedef unsigned v2u __attribute__((ext_vector_type(2)));
typedef float f32x4 __attribute__((ext_vector_type(4)));
typedef float f32x16 __attribute__((ext_vector_type(16)));
typedef short bf16x8 __attribute__((ext_vector_type(8)));
typedef GAS unsigned gu32;
#define RLX_AGENT __ATOMIC_RELAXED, __HIP_MEMORY_SCOPE_AGENT
#define LDS_WAIT() asm volatile("s_waitcnt lgkmcnt(0)" ::: "memory")
#define VM_WAIT() asm volatile("s_waitcnt vmcnt(0)" ::: "memory")
__device__ __forceinline__ unsigned f2bf(float f) { unsigned u = __builtin_bit_cast(unsigned, f); return (u + 0x7fffu + ((u >> 16) & 1u)) >> 16; }
__device__ __forceinline__ unsigned pk2(float lo, float hi) { return f2bf(lo) | (f2bf(hi) << 16); }
__device__ __forceinline__ float bf2f(unsigned short v) { return __uint_as_float((unsigned)v << 16); }
__device__ __forceinline__ float blo(unsigned w) { return __uint_as_float(w << 16); }
__device__ __forceinline__ float bhi(unsigned w) { return __uint_as_float(w & 0xffff0000u); }
__device__ __forceinline__ float wave_sum(float v) {
    v += __builtin_bit_cast(float, __builtin_amdgcn_update_dpp(0, __builtin_bit_cast(int, v), 0xB1, 0xf, 0xf, true));
    v += __builtin_bit_cast(float, __builtin_amdgcn_update_dpp(0, __builtin_bit_cast(int, v), 0x4E, 0xf, 0xf, true));
    v += __builtin_bit_cast(float, __builtin_amdgcn_update_dpp(0, __builtin_bit_cast(int, v), 0x141, 0xf, 0xf, true));
    v += __builtin_bit_cast(float, __builtin_amdgcn_update_dpp(0, __builtin_bit_cast(int, v), 0x140, 0xf, 0xf, true));
    { const auto rr = __builtin_amdgcn_permlane16_swap(__float_as_uint(v), __float_as_uint(v), false, false); v = __uint_as_float(rr[0]) + __uint_as_float(rr[1]); }
    { const auto rr = __builtin_amdgcn_permlane32_swap(__float_as_uint(v), __float_as_uint(v), false, false); v = __uint_as_float(rr[0]) + __uint_as_float(rr[1]); }
    return v;
}

__device__ __forceinline__ float xhalf_add(float a) { const auto rr = __builtin_amdgcn_permlane32_swap(__float_as_uint(a), __float_as_uint(a), false, false); return __uint_as_float(rr[0]) + __uint_as_float(rr[1]); }
__device__ __forceinline__ float xhalf_max(float a) { const auto rr = __builtin_amdgcn_permlane32_swap(__float_as_uint(a), __float_as_uint(a), false, false); return fmaxf(__uint_as_float(rr[0]), __uint_as_float(rr[1])); }
__device__ __forceinline__ int half_sum_i32(int v) {
    v += __builtin_amdgcn_update_dpp(0, v, 0xB1, 0xf, 0xf, true);
    v += __builtin_amdgcn_update_dpp(0, v, 0x4E, 0xf, 0xf, true);
    v += __builtin_amdgcn_update_dpp(0, v, 0x141, 0xf, 0xf, true);
    v += __builtin_amdgcn_update_dpp(0, v, 0x140, 0xf, 0xf, true);
    const auto rr = __builtin_amdgcn_permlane16_swap((unsigned)v, (unsigned)v, false, false); return (int)rr[0] + (int)rr[1];
}
#define XB_TMO      128
#define XB_XCNT(j)  (256  + 64 * (j))
#define XB_XSUB(j)  (1280 + 64 * (j))
#define XB_XGEN(j)  (2304 + 64 * (j))
#define XB_TOP      3328
#define XB_TOPGEN   3392
#define XCD_BAR_WORDS 3456
#define XB_SPIN_CAP (1u << 18)

__device__ __forceinline__ unsigned xb_ld(unsigned* p)              { return __hip_atomic_load(p, __ATOMIC_RELAXED, __HIP_MEMORY_SCOPE_AGENT); }
__device__ __forceinline__ unsigned xb_add(unsigned* p, unsigned v) { return __hip_atomic_fetch_add(p, v, __ATOMIC_RELAXED, __HIP_MEMORY_SCOPE_AGENT); }
__device__ __forceinline__ unsigned xb_xcc_id() { return (unsigned)__builtin_amdgcn_s_getreg((3 << 11) | 20) & 0xFu; }
#define XB_SPIN(cond, bar) do { unsigned _sp = 0; while (cond) { __builtin_amdgcn_s_sleep(1); \
    if ((++_sp & 255u) == 0u) { if (xb_ld(&(bar)[XB_TMO])) break; if (_sp > XB_SPIN_CAP) { atomicAdd(&(bar)[XB_TMO], 1u); break; } } } } while (0)

struct XcdBarrier {
    unsigned* bar; unsigned x;
    volatile LAS unsigned* st;
};

__device__ __forceinline__ XcdBarrier xcd_barrier_post(unsigned* bar, volatile LAS unsigned* st, bool t0) {
    XcdBarrier b; b.bar = bar; b.x = xb_xcc_id(); b.st = st;
    if (t0) st[2] = xb_add(&bar[XB_XCNT(b.x)], 1u);
    return b;
}
__device__ __forceinline__ void xcd_barrier_complete(unsigned* bar, unsigned x, unsigned& nloc, unsigned& nx) {
    const unsigned G = gridDim.x * gridDim.y * gridDim.z;
    unsigned sum, cnt, mine, sp = 0u;
    for (;;) {
        sum = 0u; cnt = 0u; mine = 0u;
#pragma unroll
        for (unsigned j = 0; j < 16; ++j) { const unsigned c = xb_ld(&bar[XB_XCNT(j)]); sum += c; cnt += (c > 0u) ? 1u : 0u; mine = (j == x) ? c : mine; }
        if (sum == G) break;
        __builtin_amdgcn_s_sleep(1);
        if ((++sp & 255u) == 0u) { if (xb_ld(&bar[XB_TMO])) break; if (sp > XB_SPIN_CAP) { atomicAdd(&bar[XB_TMO], 1u); break; } }
    }
    nloc = mine > 0u ? mine : 1u; nx = cnt > 0u ? cnt : 1u;
}

__device__ __forceinline__ void xcd_barrier(const XcdBarrier& b, const int wave) {
    asm volatile("s_waitcnt vmcnt(0)" ::: "memory");
    __syncthreads();
    if (wave == 0 && lane_fresh() == 0) {
        unsigned* bar = b.bar;
        __builtin_amdgcn_s_waitcnt(0);
        unsigned nloc = b.st[0], nx = b.st[1];
        if (nloc == 0u) { xcd_barrier_complete(bar, b.x, nloc, nx); b.st[0] = nloc; b.st[1] = nx; }
        const unsigned old = xb_add(&bar[XB_XSUB(b.x)], 1u);
        const unsigned gen = old / nloc;
        if (old + 1u == (gen + 1u) * nloc) {
            __builtin_amdgcn_fence(__ATOMIC_RELEASE, "agent");
            asm volatile("s_waitcnt vmcnt(0)" ::: "memory");
            const unsigned og = xb_add(&bar[XB_TOP], 1u);
            const unsigned tg = og / nx;
            if (og + 1u == (tg + 1u) * nx) xb_add(&bar[XB_TOPGEN], 1u);
            else XB_SPIN(xb_ld(&bar[XB_TOPGEN]) == tg, bar);
            __builtin_amdgcn_fence(__ATOMIC_ACQUIRE, "agent");
            xb_add(&bar[XB_XGEN(b.x)], 1u);
            asm volatile("s_waitcnt vmcnt(0)" ::: "memory");
        } else {
            XB_SPIN(xb_ld(&bar[XB_XGEN(b.x)]) == gen, bar);
            __builtin_amdgcn_fence(__ATOMIC_ACQUIRE, "agent");
            asm volatile("s_waitcnt vmcnt(0)" ::: "memory");
        }
    }
    __syncthreads();
}

__device__ __forceinline__ void tr_item(const float* W, int ldw, int nvalid, bf16* WT, int ldt, int k0, int n0, int drow0, int dcol0, LAS float* scr, int lane) {
    { const int n4 = 4 * (lane & 7), kr = lane >> 3; const bool ok = n0 + n4 < nvalid;
#pragma unroll
      for (int i = 0; i < 8; ++i) { const int kk = 8 * i + kr; const f32x4 v = ok ? *(const GAS f32x4*)(W + (size_t)(k0 + kk) * ldw + n0 + n4) : (f32x4){0.f, 0.f, 0.f, 0.f};
          LAS float* d = scr + kk * 33 + n4; d[0] = v.x; d[1] = v.y; d[2] = v.z; d[3] = v.w; } }
    LDS_WAIT(); asm volatile("" ::: "memory");
    const int c = lane & 7;
#pragma unroll
    for (int j = 0; j < 4; ++j) { const int nn = (lane >> 3) + 8 * j; const LAS float* s = scr + (8 * c) * 33 + nn;
        v4u o; o.x = pk2(s[0 * 33], s[1 * 33]); o.y = pk2(s[2 * 33], s[3 * 33]); o.z = pk2(s[4 * 33], s[5 * 33]); o.w = pk2(s[6 * 33], s[7 * 33]);
        *(GAS v4u*)(WT + (size_t)(drow0 + nn) * ldt + dcol0 + k0 + 8 * c) = o; }
    LDS_WAIT(); asm volatile("" ::: "memory");
}
__device__ __forceinline__ void tr_item8(const float* W, int ldw, unsigned char* WT, int ldt, int k0, int n0, int drow0, float sc, LAS float* scr, int lane) {
    { const int n4 = 4 * (lane & 7), kr = lane >> 3;
#pragma unroll
      for (int i = 0; i < 8; ++i) { const int kk = 8 * i + kr; const f32x4 v = *(const GAS f32x4*)(W + (size_t)(k0 + kk) * ldw + n0 + n4);
          LAS float* d = scr + kk * 33 + n4; d[0] = v.x; d[1] = v.y; d[2] = v.z; d[3] = v.w; } }
    LDS_WAIT(); asm volatile("" ::: "memory");
    const int nn = lane >> 1, hf = lane & 1; const LAS float* sp = scr + (32 * hf) * 33 + nn;
    unsigned o[8];
#pragma unroll
    for (int q = 0; q < 8; ++q) { const float a = fminf(fmaxf(sp[(4 * q + 0) * 33] * sc, -448.f), 448.f), b = fminf(fmaxf(sp[(4 * q + 1) * 33] * sc, -448.f), 448.f), c = fminf(fmaxf(sp[(4 * q + 2) * 33] * sc, -448.f), 448.f), d = fminf(fmaxf(sp[(4 * q + 3) * 33] * sc, -448.f), 448.f);
        int w = 0; w = __builtin_amdgcn_cvt_pk_fp8_f32(a, b, w, false); w = __builtin_amdgcn_cvt_pk_fp8_f32(c, d, w, true); o[q] = (unsigned)w; }
    GAS v4u* dst = (GAS v4u*)(WT + (size_t)(drow0 + nn) * ldt + k0 + 32 * hf);
    dst[0] = (v4u){o[0], o[1], o[2], o[3]}; dst[1] = (v4u){o[4], o[5], o[6], o[7]};
    LDS_WAIT(); asm volatile("" ::: "memory");
}
__device__ __forceinline__ void tr_item_ln(const float* W, int ldw, int nvalid, bf16* WT, int ldt, int k0, int n0, int drow0, const float* gain, const float* bvec, long long* gW, long long* bW, LAS float* scr, int lane) {
    { const int n4 = 4 * (lane & 7), kr = lane >> 3; const bool ok = n0 + n4 < nvalid;
#pragma unroll
      for (int i = 0; i < 8; ++i) { const int kk = 8 * i + kr; const f32x4 v = ok ? *(const GAS f32x4*)(W + (size_t)(k0 + kk) * ldw + n0 + n4) : (f32x4){0.f, 0.f, 0.f, 0.f};
          LAS float* d = scr + kk * 33 + n4; d[0] = v.x; d[1] = v.y; d[2] = v.z; d[3] = v.w; } }
    LDS_WAIT(); asm volatile("" ::: "memory");
    const int c = lane & 7;
    const f32x4 g0 = *(const GAS f32x4*)(gain + k0 + 8 * c), g1 = *(const GAS f32x4*)(gain + k0 + 8 * c + 4), b0 = *(const GAS f32x4*)(bvec + k0 + 8 * c), b1 = *(const GAS f32x4*)(bvec + k0 + 8 * c + 4);
    const float gk[8] = {g0.x, g0.y, g0.z, g0.w, g1.x, g1.y, g1.z, g1.w}, bk[8] = {b0.x, b0.y, b0.z, b0.w, b1.x, b1.y, b1.z, b1.w};
#pragma unroll
    for (int j = 0; j < 4; ++j) { const int nn = (lane >> 3) + 8 * j; const LAS float* sp = scr + (8 * c) * 33 + nn;
        float v[8], bs = 0.f;
#pragma unroll
        for (int i = 0; i < 8; ++i) { const float raw = sp[i * 33]; v[i] = raw * gk[i]; bs += raw * bk[i]; }
        v4u o; o.x = pk2(v[0], v[1]); o.y = pk2(v[2], v[3]); o.z = pk2(v[4], v[5]); o.w = pk2(v[6], v[7]);
        float gs = ((blo(o.x) + bhi(o.x)) + (blo(o.y) + bhi(o.y))) + ((blo(o.z) + bhi(o.z)) + (blo(o.w) + bhi(o.w)));
        *(GAS v4u*)(WT + (size_t)(drow0 + nn) * ldt + k0 + 8 * c) = o;
        gs += __shfl_xor(gs, 1); gs += __shfl_xor(gs, 2); gs += __shfl_xor(gs, 4); bs += __shfl_xor(bs, 1); bs += __shfl_xor(bs, 2); bs += __shfl_xor(bs, 4);
        if (c == 0) { (void)__hip_atomic_fetch_add(gW + drow0 + nn, (long long)__builtin_rintf(gs * FX_V), __ATOMIC_RELAXED, __HIP_MEMORY_SCOPE_AGENT); (void)__hip_atomic_fetch_add(bW + drow0 + nn, (long long)__builtin_rintf(bs * FX_V), __ATOMIC_RELAXED, __HIP_MEMORY_SCOPE_AGENT); } }
    LDS_WAIT(); asm volatile("" ::: "memory");
}
__device__ __forceinline__ void tr_item8_ln(const float* W, int ldw, unsigned char* WT, int ldt, int k0, int n0, int drow0, float sc, const float* gain, const float* bvec, long long* gW, long long* bW, LAS float* scr, int lane) {
    { const int n4 = 4 * (lane & 7), kr = lane >> 3;
#pragma unroll
      for (int i = 0; i < 8; ++i) { const int kk = 8 * i + kr; const f32x4 v = *(const GAS f32x4*)(W + (size_t)(k0 + kk) * ldw + n0 + n4);
          LAS float* d = scr + kk * 33 + n4; d[0] = v.x; d[1] = v.y; d[2] = v.z; d[3] = v.w; } }
    LDS_WAIT(); asm volatile("" ::: "memory");
    const int nn = lane >> 1, hf = lane & 1; const LAS float* sp = scr + (32 * hf) * 33 + nn;
    unsigned o[8]; float gs = 0.f, bs = 0.f;
#pragma unroll
    for (int q = 0; q < 8; ++q) { const f32x4 g4 = *(const GAS f32x4*)(gain + k0 + 32 * hf + 4 * q), b4 = *(const GAS f32x4*)(bvec + k0 + 32 * hf + 4 * q);
        const float r0 = sp[(4 * q + 0) * 33], r1 = sp[(4 * q + 1) * 33], r2 = sp[(4 * q + 2) * 33], r3 = sp[(4 * q + 3) * 33];
        bs += (r0 * b4.x + r1 * b4.y) + (r2 * b4.z + r3 * b4.w);
        const float a = fminf(fmaxf(r0 * g4.x * sc, -448.f), 448.f), b = fminf(fmaxf(r1 * g4.y * sc, -448.f), 448.f), c = fminf(fmaxf(r2 * g4.z * sc, -448.f), 448.f), d = fminf(fmaxf(r3 * g4.w * sc, -448.f), 448.f);
        int w = 0; w = __builtin_amdgcn_cvt_pk_fp8_f32(a, b, w, false); w = __builtin_amdgcn_cvt_pk_fp8_f32(c, d, w, true); o[q] = (unsigned)w;
        gs += (__builtin_amdgcn_cvt_f32_fp8(w, 0) + __builtin_amdgcn_cvt_f32_fp8(w, 1)) + (__builtin_amdgcn_cvt_f32_fp8(w, 2) + __builtin_amdgcn_cvt_f32_fp8(w, 3)); }
    GAS v4u* dst = (GAS v4u*)(WT + (size_t)(drow0 + nn) * ldt + k0 + 32 * hf);
    dst[0] = (v4u){o[0], o[1], o[2], o[3]}; dst[1] = (v4u){o[4], o[5], o[6], o[7]};
    gs += __shfl_xor(gs, 1); bs += __shfl_xor(bs, 1);
    if (hf == 0) { (void)__hip_atomic_fetch_add(gW + drow0 + nn, (long long)__builtin_rintf(gs / sc * FX_V), __ATOMIC_RELAXED, __HIP_MEMORY_SCOPE_AGENT); (void)__hip_atomic_fetch_add(bW + drow0 + nn, (long long)__builtin_rintf(bs * FX_V), __ATOMIC_RELAXED, __HIP_MEMORY_SCOPE_AGENT); }
    LDS_WAIT(); asm volatile("" ::: "memory");
}
__device__ __forceinline__ void cvt_item8(const float* src, unsigned char* dst, int item, int lane, float sc) {
    const GAS f32x4* sp = (const GAS f32x4*)(src + (size_t)item * 512) + 2 * lane; f32x4 a = sp[0] * sc, b = sp[1] * sc;
    int w0 = 0, w1 = 0; w0 = __builtin_amdgcn_cvt_pk_fp8_f32(fminf(fmaxf(a.x, -448.f), 448.f), fminf(fmaxf(a.y, -448.f), 448.f), w0, false); w0 = __builtin_amdgcn_cvt_pk_fp8_f32(fminf(fmaxf(a.z, -448.f), 448.f), fminf(fmaxf(a.w, -448.f), 448.f), w0, true);
    w1 = __builtin_amdgcn_cvt_pk_fp8_f32(fminf(fmaxf(b.x, -448.f), 448.f), fminf(fmaxf(b.y, -448.f), 448.f), w1, false); w1 = __builtin_amdgcn_cvt_pk_fp8_f32(fminf(fmaxf(b.z, -448.f), 448.f), fminf(fmaxf(b.w, -448.f), 448.f), w1, true);
    *((GAS v2u*)(dst + (size_t)item * 512) + lane) = (v2u){(unsigned)w0, (unsigned)w1};
}
__device__ __forceinline__ void cvt_item(const float* src, bf16* dst, int item, int lane) {
    const GAS f32x4* s = (const GAS f32x4*)(src + (size_t)item * 512) + 2 * lane; const f32x4 a = s[0], b = s[1];
    v4u o; o.x = pk2(a.x, a.y); o.y = pk2(a.z, a.w); o.z = pk2(b.x, b.y); o.w = pk2(b.z, b.w);
    *((GAS v4u*)(dst + (size_t)item * 512) + lane) = o;
}
__device__ __forceinline__ void p0_prologue(const float* const (&in)[24], unsigned char* ws, LAS unsigned char* lds, int gw, int NGW, int wave, int lane) {
    LAS float* scr = (LAS float*)(lds + RING_OFF + wave * 16384);
#define TRM(SRC, Kk, LDW, NVALID, NPAD, DST, LDT, ROWMAP, DCOL) { constexpr int nblk = (NPAD) / 32; constexpr int cnt = ((Kk) / 64) * nblk; \
        if (r < cnt) { const int kb = r / nblk, nb = r % nblk, n0 = 32 * nb; tr_item(SRC, LDW, NVALID, (bf16*)(ws + (DST)), LDT, 64 * kb, n0, (ROWMAP), (DCOL), scr, lane); continue; } r -= cnt; }
#define TRM8(SRC, Kk, LDW, NN, DST, LDT, ROWMAP, SC) { constexpr int nblk = (NN) / 32; constexpr int cnt = ((Kk) / 64) * nblk; \
        if (r < cnt) { const int kb = r / nblk, nb = r % nblk, n0 = 32 * nb; tr_item8(SRC, LDW, (unsigned char*)(ws + (DST)), LDT, 64 * kb, n0, (ROWMAP), SC, scr, lane); continue; } r -= cnt; }
    long long* const vec = (long long*)(ws + WS_CTL + CTL_VEC);
#define TRML(SRC, Kk, LDW, NVALID, NPAD, DST, LDT, ROWMAP, GAIN, BVEC, VG, VB) { constexpr int nblk = (NPAD) / 32; constexpr int cnt = ((Kk) / 64) * nblk; \
        if (r < cnt) { const int kb = r / nblk, nb = r % nblk, n0 = 32 * nb; tr_item_ln(SRC, LDW, NVALID, (bf16*)(ws + (DST)), LDT, 64 * kb, n0, (ROWMAP), GAIN, BVEC, vec + (VG), vec + (VB), scr, lane); continue; } r -= cnt; }
#define TRML8(SRC, Kk, LDW, NN, DST, LDT, ROWMAP, SC, GAIN, BVEC, VG, VB) { constexpr int nblk = (NN) / 32; constexpr int cnt = ((Kk) / 64) * nblk; \
        if (r < cnt) { const int kb = r / nblk, nb = r % nblk, n0 = 32 * nb; tr_item8_ln(SRC, LDW, (unsigned char*)(ws + (DST)), LDT, 64 * kb, n0, (ROWMAP), SC, GAIN, BVEC, vec + (VG), vec + (VB), scr, lane); continue; } r -= cnt; }
    constexpr int N_TR = 2 * (32 * 176) + 88 * 64 + 32 * 184 + 2 * (32 * 64) + 256 + 2 * (16 * 64) + 32 * 64 + 32 * 16 + 32 * 32 + 8 * 64 + 2 * (32 * 176) + 88 * 64;
    for (int it = gw; it < N_TR; it += NGW) {
        int r = it;
        TRM8(in[2], 2048, 5632, 5632, WS_W_GU1, 2048, 256 * (n0 >> 7) + (n0 & 127), FP8_WGUS)
        TRM8(in[3], 2048, 5632, 5632, WS_W_GU1, 2048, 256 * (n0 >> 7) + 128 + (n0 & 127), FP8_WGUS)
        TRM8(in[4], 5632, 2048, 2048, WS_W_D1, 5632, n0, FP8_WDS)
        TRML(in[5], 2048, 5712, 5712, 5888, WS_W_IN, 2048, n0, in[22], in[23], V_GW_IN, V_BW_IN)
        TRML8(in[11], 2048, 2048, 2048, WS_W_G, 2048, 256 * (n0 >> 7) + (n0 & 127), FP8_WGS, in[22], in[23], V_GW_G, V_BW_G)
        TRML8(in[11] + (size_t)2048 * 2048, 2048, 2048, 2048, WS_W_G, 2048, 256 * (n0 >> 7) + 128 + (n0 & 127), FP8_WGS, in[22], in[23], V_GW_G, V_BW_G)
        if (r < 256) { const int h = r >> 5, rr = r & 31, kb = rr >> 2, nb = rr & 3;
            tr_item(in[10] + (size_t)h * 512 * 128, 128, 128, (bf16*)(ws + WS_W_UVP), 1024, 64 * kb, 32 * nb, (h >> 1) * 256 + (h & 1) * 128 + 32 * nb, (h & 1) * 512, scr, lane); continue; } r -= 256;
        TRM(in[13], 1024, 2048, 2048, 2048, WS_W_A, 1024, n0, 0)
        TRM(in[14], 1024, 2048, 2048, 2048, WS_W_B, 1024, n0, 0)
        TRM8(in[15], 2048, 2048, 2048, WS_W_MO, 2048, n0, FP8_WMOS)
        TRML(in[16], 2048, 512, 512, 512, WS_W_MQ, 2048, n0, in[22] + D, in[23] + D, V_GW_MQ, V_BW_MQ)
        TRM(in[17], 2048, 1024, 1024, 1024, WS_W_MKV, 2048, n0, 0)
        TRM(in[18], 512, 2048, 2048, 2048, WS_W_MOUT, 512, n0, 0)
        TRML8(in[19], 2048, 5632, 5632, WS_W_GU2, 2048, 256 * (n0 >> 7) + (n0 & 127), FP8_WGUS, in[22] + 2 * D, in[23] + 2 * D, V_GW_GU2, V_BW_GU2)
        TRML8(in[20], 2048, 5632, 5632, WS_W_GU2, 2048, 256 * (n0 >> 7) + 128 + (n0 & 127), FP8_WGUS, in[22] + 2 * D, in[23] + 2 * D, V_GW_GU2, V_BW_GU2)
        TRM8(in[21], 5632, 2048, 2048, WS_W_D2, 5632, n0, FP8_WDS)
    }
#undef TRM
#undef TRM8
#undef TRML
#undef TRML8
    for (int rw = gw; rw < 1024; rw += NGW) { const int e = (rw >> 7) & 1; *((GAS v4u*)((bf16*)(ws + WS_W_UVP) + (size_t)rw * 1024 + (1 - e) * 512) + lane) = (v4u){0u, 0u, 0u, 0u}; }
    for (int it = gw; it < (M * D) / 512; it += NGW) cvt_item8(in[0], (unsigned char*)(ws + WS_X8), it, lane, FP8_XS);
    for (int it = gw; it < (BATCH * MEMT * D) / 512; it += NGW) cvt_item(in[1], (bf16*)(ws + WS_MEM16), it, lane);
    for (int it = gw; it < (8 * 512 * 128) / 512; it += NGW) cvt_item(in[9], (bf16*)(ws + WS_W_UK), it, lane);
}

__device__ __forceinline__ void ln_phase(float* zx, bf16* x16, unsigned char* x8, const float* g, const float* b, int gw, int NGW, int lane) {
    f32x4 gv[8], bv[8];
#pragma unroll
    for (int j = 0; j < 8; ++j) { gv[j] = *((const GAS f32x4*)g + lane + 64 * j); bv[j] = *((const GAS f32x4*)b + lane + 64 * j); }
    for (int m = gw; m < M; m += NGW) {
        GAS f32x4* xr = (GAS f32x4*)(zx + (size_t)m * D) + lane;
        f32x4 v[8]; float s = 0.f;
#pragma unroll
        for (int j = 0; j < 8; ++j) { v[j] = xr[64 * j]; s += (v[j].x + v[j].y) + (v[j].z + v[j].w); }
        const float mean = wave_sum(s) * (1.f / D); float s2 = 0.f;
#pragma unroll
        for (int j = 0; j < 8; ++j) { v[j] = v[j] - mean; s2 += (v[j].x * v[j].x + v[j].y * v[j].y) + (v[j].z * v[j].z + v[j].w * v[j].w); }
        const float rstd = 1.f / sqrtf(wave_sum(s2) * (1.f / D) + LN_EPS);
#pragma unroll
        for (int j = 0; j < 8; ++j) { v[j] = v[j] * rstd * gv[j] + bv[j]; xr[64 * j] = v[j]; }
        if (x16) { GAS v2u* o8 = (GAS v2u*)(x16 + (size_t)m * D) + lane;
#pragma unroll
            for (int j = 0; j < 8; ++j) o8[64 * j] = (v2u){pk2(v[j].x, v[j].y), pk2(v[j].z, v[j].w)}; }
        if (x8) { GAS unsigned* o4 = (GAS unsigned*)(x8 + (size_t)m * D) + lane;
#pragma unroll
            for (int j = 0; j < 8; ++j) { const f32x4 q = v[j] * FP8_XS; int w = 0; w = __builtin_amdgcn_cvt_pk_fp8_f32(fminf(fmaxf(q.x, -448.f), 448.f), fminf(fmaxf(q.y, -448.f), 448.f), w, false);
                w = __builtin_amdgcn_cvt_pk_fp8_f32(fminf(fmaxf(q.z, -448.f), 448.f), fminf(fmaxf(q.w, -448.f), 448.f), w, true); o4[64 * j] = (unsigned)w; } }
    }
}
__device__ __forceinline__ void ln_final_phase(const bf16* z16, float* outp, const float* g, const float* b, int gw, int NGW, int lane) {
    for (int m0 = gw; m0 < M; m0 += 2 * NGW) {
        const int m1 = m0 + NGW; const bool two = m1 < M;
        v4u w[2][4];
#pragma unroll
        for (int j = 0; j < 4; ++j) { w[0][j] = __builtin_nontemporal_load((const GAS v4u*)(z16 + (size_t)m0 * D) + lane + 64 * j); w[1][j] = two ? __builtin_nontemporal_load((const GAS v4u*)(z16 + (size_t)m1 * D) + lane + 64 * j) : (v4u){0u, 0u, 0u, 0u}; }
#pragma unroll
        for (int rr = 0; rr < 2; ++rr) { if (rr == 1 && !two) break;
            const int m = rr ? m1 : m0;
            float v[32]; float s = 0.f;
#pragma unroll
            for (int j = 0; j < 4; ++j) { const v4u x = w[rr][j]; v[8 * j + 0] = blo(x.x); v[8 * j + 1] = bhi(x.x); v[8 * j + 2] = blo(x.y); v[8 * j + 3] = bhi(x.y); v[8 * j + 4] = blo(x.z); v[8 * j + 5] = bhi(x.z); v[8 * j + 6] = blo(x.w); v[8 * j + 7] = bhi(x.w); }
#pragma unroll
            for (int e = 0; e < 32; ++e) s += v[e];
            const float mean = wave_sum(s) * (1.f / D); float s2 = 0.f;
#pragma unroll
            for (int e = 0; e < 32; ++e) { v[e] -= mean; s2 += v[e] * v[e]; }
            const float rstd = 1.f / sqrtf(wave_sum(s2) * (1.f / D) + LN_EPS);
#pragma unroll
            for (int j = 0; j < 4; ++j) { const int c0 = 512 * j + 8 * lane;
                const f32x4 g0 = *(const GAS f32x4*)(g + c0), g1 = *(const GAS f32x4*)(g + c0 + 4), b0 = *(const GAS f32x4*)(b + c0), b1 = *(const GAS f32x4*)(b + c0 + 4);
                GAS f32x4* o = (GAS f32x4*)(outp + (size_t)m * D + c0);
                __builtin_nontemporal_store((f32x4){v[8 * j + 0], v[8 * j + 1], v[8 * j + 2], v[8 * j + 3]} * rstd * g0 + b0, o); __builtin_nontemporal_store((f32x4){v[8 * j + 4], v[8 * j + 5], v[8 * j + 6], v[8 * j + 7]} * rstd * g1 + b1, o + 1); } }
    }
}
__device__ __forceinline__ void crms_phase(const bf16* bc, unsigned char* c8, const float* kvg, float cs, int gw, int NGW, int lane) {
    float gg[8];
#pragma unroll
    for (int j = 0; j < 8; ++j) gg[j] = kvg[8 * lane + j] * cs;
    for (int m = gw; m < M; m += NGW) {
        const v4u w = *((const GAS v4u*)(bc + (size_t)m * 512) + lane);
        float x[8] = {blo(w.x), bhi(w.x), blo(w.y), bhi(w.y), blo(w.z), bhi(w.z), blo(w.w), bhi(w.w)}; float s = 0.f;
#pragma unroll
        for (int j = 0; j < 8; ++j) s += x[j] * x[j];
        const float r = 1.f / sqrtf(wave_sum(s) * (1.f / 512.f) + LN_EPS);
#pragma unroll
        for (int j = 0; j < 8; ++j) x[j] = fminf(fmaxf(x[j] * r * gg[j], -448.f), 448.f);
        *((GAS v2u*)(c8 + (size_t)m * 512) + lane) = (v2u){pg8::pk4_fp8(x[0], x[1], x[2], x[3]), pg8::pk4_fp8(x[4], x[5], x[6], x[7])};
    }
}
typedef short v4i16_t __attribute__((ext_vector_type(4)));
__device__ __forceinline__ v4i16_t lds_tr16(const LAS unsigned char* p) { return __builtin_amdgcn_ds_read_tr16_b64_v4i16((LAS v4i16_t*)p); }
__device__ __forceinline__ unsigned cvtpk(float lo, float hi) { typedef float f2 __attribute__((ext_vector_type(2))); typedef __bf16 b2 __attribute__((ext_vector_type(2))); f2 v = {lo, hi}; b2 b = __builtin_convertvector(v, b2); return __builtin_bit_cast(unsigned, b); }
__device__ __forceinline__ float xhalf_f(float v) { return __shfl_xor(v, 32); }
constexpr float LOG2E = 1.4426950408889634f;
constexpr float QSCALE = 0.125f * LOG2E;

__device__ __forceinline__ void diff_attn_mfma(LAS unsigned char* lds, const bf16* AQ, const bf16* AK, const bf16* AV, bf16* YA, const float* dlam, const float* subg, unsigned* dq, const unsigned* kmax, const int wave) {
    const int lane = lane_fresh(), r32 = lane & 31, hi = lane >> 5;
    const int comp = wave >> 2, wq = wave & 3;
    const unsigned ksrc = (unsigned)(lane * 1024 + (2 * wave) * 8);
    const unsigned vsrc0 = (unsigned)((16 * ((2 * wave) & 3) + (lane >> 2)) * 1024 + ((2 * wave) >> 2) * 32 + (lane & 3) * 8);
    const unsigned vsrc1 = (unsigned)((16 * ((2 * wave + 1) & 3) + (lane >> 2)) * 1024 + ((2 * wave + 1) >> 2) * 32 + (lane & 3) * 8);
    const unsigned kdst = (unsigned)(2 * wave) * 1024u, vdst0 = 16384u + (unsigned)(((2 * wave) >> 2) * 4096 + ((2 * wave) & 3) * 1024), vdst1 = 16384u + (unsigned)(((2 * wave + 1) >> 2) * 4096 + ((2 * wave + 1) & 3) * 1024);
    const unsigned lds0 = (unsigned)(uintptr_t)lds;
#define DA_STAGE(bo, to) do { \
        glds16(Kg + (to) + ksrc, (unsigned)__builtin_amdgcn_readfirstlane((int)(lds0 + (bo) + kdst))); \
        glds16(Kg + (to) + ksrc + 8, (unsigned)__builtin_amdgcn_readfirstlane((int)(lds0 + (bo) + kdst + 1024))); \
        glds16(Vg + (to) + vsrc0, (unsigned)__builtin_amdgcn_readfirstlane((int)(lds0 + (bo) + vdst0))); \
        glds16(Vg + (to) + vsrc1, (unsigned)__builtin_amdgcn_readfirstlane((int)(lds0 + (bo) + vdst1))); } while (0)
#define DA_WAITBAR() asm volatile("s_waitcnt vmcnt(0) lgkmcnt(0)\n\ts_barrier" ::: "memory")
    const unsigned koff = (unsigned)(((comp * 8 + hi) * 64 + r32) * 16);
    const unsigned voff = (unsigned)(16384 + (4 * hi + ((lane & 15) >> 2)) * 64 + ((lane >> 4) & 1) * 32 + (lane & 3) * 8);
    LAS unsigned* xq = (LAS unsigned*)(lds + 100352);
    for (;;) {
        if (wave == 0 && lane == 0) xq[0] = __hip_atomic_fetch_add(dq, 1u, __ATOMIC_RELAXED, __HIP_MEMORY_SCOPE_AGENT);
        asm volatile("s_waitcnt vmcnt(0) lgkmcnt(0)\n\ts_barrier" ::: "memory");
        const int j = (int)xq[0];
        if (j >= 1024) break;
        const int ub = 31 - (j >> 5), bh = j & 31;
        const int b = bh >> 3, h = 7 - (bh & 7);
        const float sl2 = LOG2E / (float)(2 << h);
        const size_t rowbase = (size_t)b * SEQ; const int q0 = ub * 128;
        const int qpos = q0 + wq * 32 + r32;
        const int nt = 2 * ub + 2;
        const int myt = 2 * ub + 1 + (wq >> 1);
        const bf16* Kg = AK + rowbase * 1024 + h * 128; const bf16* Vg = AV + rowbase * 1024 + h * 128;
        bf16x8 qr[4];
#pragma unroll
        for (int s = 0; s < 4; ++s) qr[s] = *(const GAS bf16x8*)(AQ + (rowbase + qpos) * 1024 + h * 128 + comp * 64 + s * 16 + hi * 8);
        f32x16 o[4];
#pragma unroll
        for (int blk = 0; blk < 4; ++blk)
#pragma unroll
            for (int r = 0; r < 16; ++r) o[blk][r] = 0.f;
        float mrun = -INFINITY, lrun = 0.f;
        { float qn2 = 0.f;
#pragma unroll
          for (int s = 0; s < 4; ++s) { const v4u w = __builtin_bit_cast(v4u, qr[s]); const float e0 = blo(w.x), e1 = bhi(w.x), e2 = blo(w.y), e3 = bhi(w.y), e4 = blo(w.z), e5 = bhi(w.z), e6 = blo(w.w), e7 = bhi(w.w);
              qn2 += ((e0 * e0 + e1 * e1) + (e2 * e2 + e3 * e3)) + ((e4 * e4 + e5 * e5) + (e6 * e6 + e7 * e7)); }
          qn2 += xhalf_f(qn2);
#pragma unroll
          for (int o_ = 1; o_ < 32; o_ <<= 1) qn2 = fmaxf(qn2, __shfl_xor(qn2, o_));
          const float kb = __uint_as_float(__hip_atomic_load(kmax + (b * 8 + h) * 2 + comp, __ATOMIC_RELAXED, __HIP_MEMORY_SCOPE_AGENT));
          if (lane == 0) xq[8 + wave] = __float_as_uint(sqrtf(qn2) * kb * 8.1f); }
        DA_STAGE(0u, (size_t)(nt - 1) * 64 * 1024);
        DA_WAITBAR();
        int kt_lo = 0;
        { float sb = 0.f;
#pragma unroll
          for (int w_ = 0; w_ < 8; ++w_) sb = fmaxf(sb, __uint_as_float(xq[8 + w_]));
          const float xcut = (float)(q0 - 63) - (40.f + 2.f * sb) / sl2;
          kt_lo = xcut > 0.f ? (int)__builtin_ceilf(xcut * (1.f / 64.f)) : 0; kt_lo = __builtin_amdgcn_readfirstlane(kt_lo); }
        for (int st = 0; st < nt - kt_lo; ++st) {
            const int kt = nt - 1 - st;
            const unsigned bufo = (unsigned)(st & 1) * 32768u;
            if (kt > kt_lo) DA_STAGE(32768u - bufo, (size_t)(kt - 1) * 64 * 1024);
            if (kt < myt) {
                const LAS unsigned char* Kb = lds + bufo + koff;
                f32x16 p0, p1;
#pragma unroll
                for (int r = 0; r < 16; ++r) { p0[r] = 0.f; p1[r] = 0.f; }
                { bf16x8 kf[4];
#pragma unroll
                  for (int s = 0; s < 4; ++s) kf[s] = *(const LAS bf16x8*)(Kb + s * 2048);
#pragma unroll
                  for (int s = 0; s < 4; ++s) p0 = __builtin_amdgcn_mfma_f32_32x32x16_bf16(kf[s], qr[s], p0, 0, 0, 0); }
                { bf16x8 kf[4];
#pragma unroll
                  for (int s = 0; s < 4; ++s) kf[s] = *(const LAS bf16x8*)(Kb + s * 2048 + 512);
#pragma unroll
                  for (int s = 0; s < 4; ++s) p1 = __builtin_amdgcn_mfma_f32_32x32x16_bf16(kf[s], qr[s], p1, 0, 0, 0); }
                const float qth = (float)(qpos - kt * 64 - 4 * hi);
                float rm = -INFINITY;
#pragma unroll
                for (int r = 0; r < 16; ++r) { const float kr = (float)((r & 3) + 8 * (r >> 2)); const float v0 = qth - kr, v1 = qth - (kr + 32.f);
                    p0[r] = p0[r] - sl2 * fabsf(v0); p1[r] = p1[r] - sl2 * fabsf(v1); rm = fmaxf(rm, fmaxf(p0[r], p1[r])); }
                rm = fmaxf(rm, xhalf_f(rm));
                if (__any(rm > mrun)) { const float mn = fmaxf(mrun, rm), f = __builtin_amdgcn_exp2f(mrun - mn); mrun = mn; lrun *= f;
#pragma unroll
                    for (int blk = 0; blk < 4; ++blk)
#pragma unroll
                        for (int r = 0; r < 16; ++r) o[blk][r] *= f; }
                float ls = 0.f;
#pragma unroll
                for (int r = 0; r < 16; ++r) { p0[r] = __builtin_amdgcn_exp2f(p0[r] - mrun); p1[r] = __builtin_amdgcn_exp2f(p1[r] - mrun); ls += p0[r] + p1[r]; }
                lrun += ls;
                bf16x8 pw[4];
#pragma unroll
                for (int s = 0; s < 2; ++s) {
                    v4u a = {cvtpk(p0[8 * s + 0], p0[8 * s + 1]), cvtpk(p0[8 * s + 2], p0[8 * s + 3]), cvtpk(p0[8 * s + 4], p0[8 * s + 5]), cvtpk(p0[8 * s + 6], p0[8 * s + 7])};
                    v4u c = {cvtpk(p1[8 * s + 0], p1[8 * s + 1]), cvtpk(p1[8 * s + 2], p1[8 * s + 3]), cvtpk(p1[8 * s + 4], p1[8 * s + 5]), cvtpk(p1[8 * s + 6], p1[8 * s + 7])};
                    pw[s] = __builtin_bit_cast(bf16x8, a); pw[2 + s] = __builtin_bit_cast(bf16x8, c); }
                const LAS unsigned char* Vb = lds + bufo + voff;
#pragma unroll
                for (int blk = 0; blk < 4; ++blk) {
#pragma unroll
                    for (int s = 0; s < 4; ++s) {
                        const v4i16_t lo = lds_tr16(Vb + blk * 4096 + s * 1024), hh = lds_tr16(Vb + blk * 4096 + s * 1024 + 512);
                        const bf16x8 vf = {lo[0], lo[1], lo[2], lo[3], hh[0], hh[1], hh[2], hh[3]};
                        o[blk] = __builtin_amdgcn_mfma_f32_32x32x16_bf16(vf, pw[s], o[blk], 0, 0, 0);
                    }
                }
            }
            DA_WAITBAR();
        }
        lrun += xhalf_f(lrun);
        const float inv = 1.f / lrun;
        LAS float* Y1 = (LAS float*)(lds) + wq * 4096;
        if (comp == 1) {
            float lam; { float a = dlam[lane] * dlam[64 + lane], bq_ = dlam[128 + lane] * dlam[192 + lane]; a = wave_sum(a); bq_ = wave_sum(bq_); lam = __expf(a) - __expf(bq_) + LAMBDA_INIT; }
            const float sc = inv * lam;
#pragma unroll
            for (int blk = 0; blk < 4; ++blk)
#pragma unroll
                for (int r = 0; r < 16; ++r) Y1[(32 * blk + (r & 3) + 8 * (r >> 2) + 4 * hi) * 32 + r32] = o[blk][r] * sc; }
        __syncthreads();
        if (comp == 0) {
            float ss = 0.f;
#pragma unroll
            for (int blk = 0; blk < 4; ++blk)
#pragma unroll
                for (int r = 0; r < 16; ++r) { const float a = o[blk][r] * inv - Y1[(32 * blk + (r & 3) + 8 * (r >> 2) + 4 * hi) * 32 + r32]; o[blk][r] = a; ss += a * a; }
            ss += xhalf_f(ss);
            const float rr = (1.0f - LAMBDA_INIT) / sqrtf(ss * (1.f / 128.f) + LN_EPS);
            LAS unsigned* stg = (LAS unsigned*)(lds + 65536) + wq * (32 * 65);
#pragma unroll
            for (int blk = 0; blk < 4; ++blk) {
#pragma unroll
                for (int r = 0; r < 16; r += 2) { const int e = 32 * blk + (r & 3) + 8 * (r >> 2) + 4 * hi;
                    stg[r32 * 65 + (e >> 1)] = cvtpk(o[blk][r] * rr * subg[e], o[blk][r + 1] * rr * subg[e + 1]); }
                asm volatile("" ::: "memory"); }
            LDS_WAIT(); asm volatile("" ::: "memory");
            bf16* orow = YA + (rowbase + q0 + wq * 32) * 1024 + h * 128;
#pragma unroll 4
            for (int row = 0; row < 32; ++row) *((GAS unsigned*)(orow + (size_t)row * 1024) + lane) = stg[row * 65 + lane];
        }
        __syncthreads();
    }
#undef DA_STAGE
#undef DA_WAITBAR
}

__device__ __forceinline__ unsigned okey(float f) { const unsigned u = __float_as_uint(f); return (u & 0x80000000u) ? ~u : (u | 0x80000000u); }
__device__ __forceinline__ void indexer_topk(LAS unsigned char* lds, const bf16* IQ, const bf16* IKW, unsigned short* IDX, int vcu, int G, const int wave) {
    const int lane = lane_fresh(), r32 = lane & 31, hi = lane >> 5;
    const unsigned lds0 = (unsigned)(uintptr_t)lds;
    const unsigned boff = (unsigned)((hi * 256 + r32) * 16);
    for (int j = vcu; j < 1024; j += G) {
        const int w = j & 255, i = j >> 8, bq = w >> 4, s16 = w & 15;
        const int chunk = (i == 0) ? s16 : (i == 1) ? 31 - s16 : (i == 2) ? 32 + s16 : 63 - s16;
        const int b = bq >> 2, gq = bq & 3;
        const int t0 = b * SEQ + chunk * 64 + gq * 16 + 2 * wave;
        const int ngroups = 2 * (chunk + 1);
        const int ntiles = (ngroups + 7) >> 3;
        const bf16* Kg = IKW + (size_t)b * SEQ * 256;
#define IX_STAGE(tile, bo) do { int tl_ = (tile); asm volatile("" : "+s"(tl_)); _Pragma("unroll") for (int i_ = 0; i_ < 4; ++i_) { const int q_ = 4 * wave + i_; \
            glds16s(Kg + (size_t)(tl_ * 256 + 64 * (q_ & 3)) * 256 + (q_ >> 2) * 8, (unsigned)lane * 512u, (unsigned)__builtin_amdgcn_readfirstlane((int)(lds0 + (bo) + ((q_ >> 2) * 256 + 64 * (q_ & 3)) * 16))); } } while (0)
        asm volatile("s_barrier" ::: "memory");
        IX_STAGE(0, 0u);
        bf16x8 a[4];
#pragma unroll
        for (int ks = 0; ks < 4; ++ks) a[ks] = *(const GAS bf16x8*)(IQ + (size_t)(t0 + (r32 >> 4)) * 1024 + (r32 & 15) * 64 + ks * 16 + 8 * hi);
        float wv[16];
        { const bf16* iwp = IKW + (size_t)t0 * 256 + 64 + 4 * hi;
          const v2u w00 = *(const GAS v2u*)(iwp), w01 = *(const GAS v2u*)(iwp + 8), w10 = *(const GAS v2u*)(iwp + 256), w11 = *(const GAS v2u*)(iwp + 256 + 8);
          wv[0] = blo(w00.x); wv[1] = bhi(w00.x); wv[2] = blo(w00.y); wv[3] = bhi(w00.y); wv[4] = blo(w01.x); wv[5] = bhi(w01.x); wv[6] = blo(w01.y); wv[7] = bhi(w01.y);
          wv[8] = blo(w10.x); wv[9] = bhi(w10.x); wv[10] = blo(w10.y); wv[11] = bhi(w10.y); wv[12] = blo(w11.x); wv[13] = bhi(w11.x); wv[14] = blo(w11.y); wv[15] = bhi(w11.y); }
        typedef float f2_t __attribute__((ext_vector_type(2)));
        f2_t w2[8];
#pragma unroll
        for (int r = 0; r < 8; ++r) w2[r] = (f2_t){wv[2 * r], wv[2 * r + 1]};
#define IX_SCORE(acc_, dst_) do { f2_t s0_ = {0.f, 0.f}, s1_ = {0.f, 0.f}; \
            _Pragma("unroll") for (int r = 0; r < 4; ++r) { \
                const f2_t x0_ = {__int_as_float(max(__float_as_int(acc_[2 * r]), 0)), __int_as_float(max(__float_as_int(acc_[2 * r + 1]), 0))}; \
                const f2_t x1_ = {__int_as_float(max(__float_as_int(acc_[8 + 2 * r]), 0)), __int_as_float(max(__float_as_int(acc_[8 + 2 * r + 1]), 0))}; \
                s0_ = __builtin_elementwise_fma(x0_, w2[r], s0_); s1_ = __builtin_elementwise_fma(x1_, w2[4 + r], s1_); } \
            const auto rr_ = __builtin_amdgcn_permlane32_swap(__float_as_uint(s0_.x + s0_.y), __float_as_uint(s1_.x + s1_.y), false, false); \
            const unsigned u_ = __float_as_uint(__uint_as_float(rr_[0]) + __uint_as_float(rr_[1])); \
            dst_ = u_ ^ ((unsigned)((int)u_ >> 31) | 0x80000000u); } while (0)
        unsigned key[128];
#pragma unroll 64
        for (int g = 0; g < 128; g += 2) {
            if (g < ngroups) {
                const unsigned bufo = (unsigned)((g >> 3) & 1) * 32768u;
                if ((g & 7) == 0) {
                    asm volatile("s_waitcnt vmcnt(0)\n\ts_barrier" ::: "memory");
                    if ((g >> 3) + 1 < ntiles) IX_STAGE((g >> 3) + 1, 32768u - bufo);
                }
                bf16x8 bk0[4], bk1[4];
#pragma unroll
                for (int ks = 0; ks < 4; ++ks) { bk0[ks] = *(const LAS bf16x8*)(lds + bufo + boff + (g & 7) * 512 + ks * 8192); bk1[ks] = *(const LAS bf16x8*)(lds + bufo + boff + ((g + 1) & 7) * 512 + ks * 8192); }
                f32x16 acc0 = {0.f, 0.f, 0.f, 0.f, 0.f, 0.f, 0.f, 0.f, 0.f, 0.f, 0.f, 0.f, 0.f, 0.f, 0.f, 0.f}, acc1 = acc0;
#pragma unroll
                for (int ks = 0; ks < 4; ++ks) acc0 = __builtin_amdgcn_mfma_f32_32x32x16_bf16(a[ks], bk0[ks], acc0, 0, 0, 0);
#pragma unroll
                for (int ks = 0; ks < 4; ++ks) acc1 = __builtin_amdgcn_mfma_f32_32x32x16_bf16(a[ks], bk1[ks], acc1, 0, 0, 0);
                IX_SCORE(acc0, key[g]); IX_SCORE(acc1, key[g + 1]);
            } else { key[g] = 0u; key[g + 1] = 0u; }
        }
#undef IX_SCORE
        unsigned selw[4];
        { unsigned vm[4];
#pragma unroll
          for (int w_ = 0; w_ < 4; ++w_) { const int n_ = ngroups - 32 * w_; vm[w_] = n_ >= 32 ? 0xffffffffu : (n_ <= 0 ? 0u : ((1u << (n_ & 31)) - 1u)); }
          if (chunk >= 4) {
#pragma unroll
              for (int w_ = 0; w_ < 4; ++w_) { if (32 * w_ < ngroups) {
#pragma unroll
                  for (int i_ = 0; i_ < 16; ++i_) { const unsigned x = key[32 * w_ + i_], y = key[32 * w_ + i_ + 16]; key[32 * w_ + i_] = (x & 0x0000ffffu) | (y << 16); key[32 * w_ + i_ + 16] = (x >> 16) | (y & 0xffff0000u); }
#pragma unroll
                  for (int i_ = 0; i_ < 32; ++i_) { if (!(i_ & 8)) { const unsigned x = key[32 * w_ + i_], y = key[32 * w_ + i_ + 8]; key[32 * w_ + i_] = (x & 0x00ff00ffu) | ((y << 8) & 0xff00ff00u); key[32 * w_ + i_ + 8] = ((x >> 8) & 0x00ff00ffu) | (y & 0xff00ff00u); } }
#pragma unroll
                  for (int i_ = 0; i_ < 32; ++i_) { if (!(i_ & 4)) { const unsigned x = key[32 * w_ + i_], y = key[32 * w_ + i_ + 4]; key[32 * w_ + i_] = (x & 0x0f0f0f0fu) | ((y << 4) & 0xf0f0f0f0u); key[32 * w_ + i_ + 4] = ((x >> 4) & 0x0f0f0f0fu) | (y & 0xf0f0f0f0u); } }
#pragma unroll
                  for (int i_ = 0; i_ < 32; ++i_) { if (!(i_ & 2)) { const unsigned x = key[32 * w_ + i_], y = key[32 * w_ + i_ + 2]; key[32 * w_ + i_] = (x & 0x33333333u) | ((y << 2) & 0xccccccccu); key[32 * w_ + i_ + 2] = ((x >> 2) & 0x33333333u) | (y & 0xccccccccu); } }
#pragma unroll
                  for (int i_ = 0; i_ < 32; ++i_) { if (!(i_ & 1)) { const unsigned x = key[32 * w_ + i_], y = key[32 * w_ + i_ + 1]; key[32 * w_ + i_] = (x & 0x55555555u) | ((y << 1) & 0xaaaaaaaau); key[32 * w_ + i_ + 1] = ((x >> 1) & 0x55555555u) | (y & 0xaaaaaaaau); } }
              } }
              unsigned cand[4] = {vm[0], vm[1], vm[2], vm[3]}, abv[4] = {0u, 0u, 0u, 0u}; int nab = 0; bool done = false;
#pragma unroll 32
              for (int bit = 31; bit >= 0; --bit) {
                  if (__all(done ? 1 : 0)) break;
                  const unsigned o0 = cand[0] & key[bit], o1 = cand[1] & key[32 + bit], o2 = cand[2] & key[64 + bit], o3 = cand[3] & key[96 + bit];
                  const int c = half_sum_i32(__popc(o0) + __popc(o1) + __popc(o2) + __popc(o3));
                  const bool take = nab + c >= 256;
                  done = done || (take && nab + c == 256);
                  const unsigned ntm = take ? 0u : 0xffffffffu;
                  nab += c & (int)ntm;
                  abv[0] |= o0 & ntm; abv[1] |= o1 & ntm; abv[2] |= o2 & ntm; abv[3] |= o3 & ntm;
                  cand[0] = o0 ^ (cand[0] & ntm); cand[1] = o1 ^ (cand[1] & ntm); cand[2] = o2 ^ (cand[2] & ntm); cand[3] = o3 ^ (cand[3] & ntm);
              }
#pragma unroll
              for (int w_ = 0; w_ < 4; ++w_) selw[w_] = abv[w_] | cand[w_];
          } else {
#pragma unroll
              for (int w_ = 0; w_ < 4; ++w_) selw[w_] = vm[w_];
          } }
        int base = 0;
        unsigned short* ip = IDX + (size_t)(t0 + hi) * 256;
#pragma unroll
        for (int g = 0; g < 128; ++g) {
            if (g < ngroups) {
                const bool sel = ((selw[g >> 5] >> (g & 31)) & 1u) != 0u;
                const unsigned long long mk = __ballot(sel ? 1 : 0);
                const unsigned mh = hi ? (unsigned)(mk >> 32) : (unsigned)mk;
                const int pos = base + __popc(mh & ((1u << r32) - 1u));
                if (sel && pos < 256) ip[pos] = (unsigned short)(32 * g + r32);
                base += __popc(mh);
            }
        }
    }
#undef IX_STAGE
    asm volatile("s_waitcnt vmcnt(0) lgkmcnt(0)\n\ts_barrier" ::: "memory");
}

constexpr int DSA_PAIRB = 1040;
constexpr int DSA_WAVEB = 16 * DSA_PAIRB + 512;
constexpr int DSA_LDS_END = 8 * DSA_WAVEB;
constexpr float DSA_CS = 64.f, DSA_QS = 64.f, DSA_PS = 256.f;
typedef int v2i_t __attribute__((ext_vector_type(2)));
__device__ __forceinline__ void dsa_mfma(LAS unsigned char* lds, const bf16* QL, bf16* OL, const int omask, const unsigned char* C8, const unsigned short* IDX, int vcu, int G, const int wave) {
    const int lane = lane_fresh(), h16 = lane & 15, g = lane >> 4;
    LAS unsigned char* wl = lds + wave * DSA_WAVEB;
    const unsigned wl0 = (unsigned)(uintptr_t)wl;
    LAS unsigned short* idxs = (LAS unsigned short*)(wl + 16 * DSA_PAIRB);
    const float sc2 = 0.08838834764831845f * LOG2E / (DSA_QS * DSA_CS);
    const float sl2 = (h16 < 8) ? LOG2E / (float)(2 << (h16 & 7)) : 0.f;
    const int ntok = (G == 256) ? 8 : (M - (vcu * 8 + wave) + G * 8 - 1) / (G * 8);
#define DSA_TOK(i) ((G == 256) ? ((vcu >> 6) * SEQ + (vcu & 63) + 64 * (wave + 8 * (i))) : (vcu * 8 + wave + G * 8 * (i)))
    const unsigned qk_off = (unsigned)((h16 >> 1) * DSA_PAIRB + (h16 & 1) * 512 + 32 * g);
    const int trow = (h16 >> 1) < 4 ? 4 * g + (h16 >> 1) : 16 + 4 * g + ((h16 >> 1) - 4);
    const unsigned pv_off = (unsigned)((trow >> 1) * DSA_PAIRB + (trow & 1) * 512 + 8 * (h16 & 1));
    for (int it = 0; it < ntok; ++it) {
        const int t = DSA_TOK(it); const int tpos = t & (SEQ - 1);
        const int n = (tpos >> 6) >= 3 ? 256 : 64 * ((tpos >> 6) + 1); const int nst = n >> 5;
        const unsigned char* Cb = C8 + (size_t)(t >> 12) * SEQ * 512;
        int ln = lane; asm volatile("" : "+v"(ln));
        const int h16b = ln & 15, gb = ln >> 4;
        { const v2u iv = __builtin_nontemporal_load((const GAS v2u*)(IDX + (size_t)t * 256) + ln); *((LAS v2u*)idxs + ln) = iv; }
        pg8::v8i_t qf[4];
        { const bf16* qp = QL + (size_t)t * 4096 + (h16b & 7) * 512 + 32 * gb;
#pragma unroll
          for (int s = 0; s < 4; ++s) { unsigned w8[8];
#pragma unroll
              for (int c = 0; c < 4; ++c) { const v4u w = __builtin_nontemporal_load((const GAS v4u*)(qp + 128 * s + 8 * c));
                  w8[2 * c] = pg8::pk4_fp8(fminf(fmaxf(blo(w.x) * DSA_QS, -448.f), 448.f), fminf(fmaxf(bhi(w.x) * DSA_QS, -448.f), 448.f), fminf(fmaxf(blo(w.y) * DSA_QS, -448.f), 448.f), fminf(fmaxf(bhi(w.y) * DSA_QS, -448.f), 448.f));
                  w8[2 * c + 1] = pg8::pk4_fp8(fminf(fmaxf(blo(w.z) * DSA_QS, -448.f), 448.f), fminf(fmaxf(bhi(w.z) * DSA_QS, -448.f), 448.f), fminf(fmaxf(blo(w.w) * DSA_QS, -448.f), 448.f), fminf(fmaxf(bhi(w.w) * DSA_QS, -448.f), 448.f)); }
              qf[s] = (pg8::v8i_t){(int)w8[0], (int)w8[1], (int)w8[2], (int)w8[3], (int)w8[4], (int)w8[5], (int)w8[6], (int)w8[7]}; } }
        f32x4 o[32];
#pragma unroll
        for (int blk = 0; blk < 32; ++blk) o[blk] = (f32x4){0.f, 0.f, 0.f, 0.f};
        float mrun = -INFINITY, lrun = 0.f;
        asm volatile("s_waitcnt vmcnt(0) lgkmcnt(0)" ::: "memory");
        for (int st = 0; st < nst; ++st) {
#pragma unroll
            for (int i = 0; i < 16; ++i) { const unsigned srow = idxs[st * 32 + 2 * i + (lane >> 5)];
                glds16s(Cb, srow * 512u + (unsigned)(lane & 31) * 16u, (unsigned)__builtin_amdgcn_readfirstlane((int)(wl0 + i * DSA_PAIRB))); }
            asm volatile("s_waitcnt vmcnt(0)" ::: "memory");
            f32x4 a0 = {0.f, 0.f, 0.f, 0.f}, a1 = {0.f, 0.f, 0.f, 0.f};
#pragma unroll
            for (int s = 0; s < 4; ++s) {
                const pg8::v4i_t x0 = *(const LAS pg8::v4i_t*)(wl + qk_off + 128 * s), x1 = *(const LAS pg8::v4i_t*)(wl + qk_off + 128 * s + 16);
                const pg8::v4i_t y0 = *(const LAS pg8::v4i_t*)(wl + qk_off + 8 * DSA_PAIRB + 128 * s), y1 = *(const LAS pg8::v4i_t*)(wl + qk_off + 8 * DSA_PAIRB + 128 * s + 16);
                a0 = __builtin_amdgcn_mfma_scale_f32_16x16x128_f8f6f4(__builtin_shufflevector(x0, x1, 0, 1, 2, 3, 4, 5, 6, 7), qf[s], a0, 0, 0, 0, 0x7f7f7f7f, 0, 0x7f7f7f7f);
                a1 = __builtin_amdgcn_mfma_scale_f32_16x16x128_f8f6f4(__builtin_shufflevector(y0, y1, 0, 1, 2, 3, 4, 5, 6, 7), qf[s], a1, 0, 0, 0, 0x7f7f7f7f, 0, 0x7f7f7f7f); }
            const v2u i0 = *(const LAS v2u*)(idxs + st * 32 + 4 * g), i1 = *(const LAS v2u*)(idxs + st * 32 + 16 + 4 * g);
            const int sidx[8] = {(int)(i0.x & 0xffffu), (int)(i0.x >> 16), (int)(i0.y & 0xffffu), (int)(i0.y >> 16), (int)(i1.x & 0xffffu), (int)(i1.x >> 16), (int)(i1.y & 0xffffu), (int)(i1.y >> 16)};
            float lg[8];
#pragma unroll
            for (int r = 0; r < 8; ++r) { const int d = tpos - sidx[r]; lg[r] = (r < 4 ? a0[r & 3] : a1[r & 3]) * sc2 - sl2 * (float)(d < 0 ? -d : d); }
            float rm = fmaxf(fmaxf(fmaxf(lg[0], lg[1]), fmaxf(lg[2], lg[3])), fmaxf(fmaxf(lg[4], lg[5]), fmaxf(lg[6], lg[7])));
            rm = fmaxf(rm, __shfl_xor(rm, 16)); rm = fmaxf(rm, __shfl_xor(rm, 32));
            const float mn = fmaxf(mrun, rm), f = __builtin_amdgcn_exp2f(mrun - mn); mrun = mn;
#pragma unroll
            for (int r = 0; r < 8; ++r) lg[r] = __builtin_amdgcn_exp2f(lg[r] - mn) * DSA_PS;
            const unsigned pw0 = pg8::pk4_fp8(lg[0], lg[1], lg[2], lg[3]), pw1 = pg8::pk4_fp8(lg[4], lg[5], lg[6], lg[7]);
            { const float ps = ((__builtin_amdgcn_cvt_f32_fp8((int)pw0, 0) + __builtin_amdgcn_cvt_f32_fp8((int)pw0, 1)) + (__builtin_amdgcn_cvt_f32_fp8((int)pw0, 2) + __builtin_amdgcn_cvt_f32_fp8((int)pw0, 3)))
                           + ((__builtin_amdgcn_cvt_f32_fp8((int)pw1, 0) + __builtin_amdgcn_cvt_f32_fp8((int)pw1, 1)) + (__builtin_amdgcn_cvt_f32_fp8((int)pw1, 2) + __builtin_amdgcn_cvt_f32_fp8((int)pw1, 3)));
              lrun = lrun * f + ps; }
            const long pw = (long)(((unsigned long)pw1 << 32) | (unsigned long)pw0);
#pragma unroll
            for (int blk = 0; blk < 32; ++blk) {
                const v2i_t av = __builtin_amdgcn_ds_read_tr8_b64_v2i32((LAS v2i_t*)(wl + pv_off + 16 * blk));
                const long al = (long)(((unsigned long)(unsigned)av.y << 32) | (unsigned long)(unsigned)av.x);
                o[blk] = __builtin_amdgcn_mfma_f32_16x16x32_fp8_fp8(al, pw, o[blk] * f, 0, 0, 0);
                if ((blk & 3) == 3) __builtin_amdgcn_sched_barrier(0);
            }
        }
        float lt = lrun; lt += __shfl_xor(lt, 16); lt += __shfl_xor(lt, 32);
        const float inv = 1.f / (lt * DSA_CS);
        if (h16 < 8) {
#pragma unroll
            for (int blk = 0; blk < 32; ++blk) { const f32x4 v = o[blk] * inv;
                __builtin_nontemporal_store((v2u){cvtpk(v.x, v.y), cvtpk(v.z, v.w)}, (GAS v2u*)(OL + (size_t)(t & omask) * 4096 + h16b * 512 + 16 * blk + 4 * gb)); } }
    }
    asm volatile("s_waitcnt vmcnt(0) lgkmcnt(0)" ::: "memory");
    __syncthreads();
#undef DSA_TOK
}
static_assert(DSA_LDS_END <= RING_BYTES, "DSA LDS map");

__device__ __forceinline__ void memattn_mfma(LAS unsigned char* lds, const bf16* QM, const bf16* KV, bf16* OM, int vcu, int G, const int wave) {
    const int lane = lane_fresh(), r32 = lane & 31, hi = lane >> 5;
    const unsigned voff = (unsigned)(65536 + (4 * hi + ((lane & 15) >> 2)) * 64 + ((lane >> 4) & 1) * 32 + (lane & 3) * 8);
    for (int j = vcu; j < 256; j += G) {
        const int bh = j >> 4, qb = j & 15, b = bh >> 2, h = bh & 3;
        const bf16* Kg = KV + (size_t)b * MEMT * 1024 + h * 128; const bf16* Vg = Kg + 512;
#pragma unroll
        for (int i = 0; i < 8; ++i) { const int q = 8 * wave + i;
            glds16(Kg + (size_t)(64 * (q & 3) + lane) * 1024 + (q >> 2) * 8, (unsigned)__builtin_amdgcn_readfirstlane((int)((unsigned)(uintptr_t)lds + ((q >> 2) * 256 + 64 * (q & 3)) * 16)));
            glds16(Vg + (size_t)(16 * (q & 15) + (lane >> 2)) * 1024 + (q >> 4) * 32 + (lane & 3) * 8, (unsigned)__builtin_amdgcn_readfirstlane((int)((unsigned)(uintptr_t)lds + 65536 + (q >> 4) * 16384 + (q & 15) * 1024))); }
        const size_t qrow = (size_t)b * SEQ + qb * 256 + wave * 32 + r32;
        bf16x8 qr[8];
#pragma unroll
        for (int s = 0; s < 8; ++s) qr[s] = *(const GAS bf16x8*)(QM + qrow * 512 + h * 128 + s * 16 + hi * 8);
        f32x16 o[4];
#pragma unroll
        for (int blk = 0; blk < 4; ++blk)
#pragma unroll
            for (int r = 0; r < 16; ++r) o[blk][r] = 0.f;
        float mrun = -INFINITY, lrun = 0.f;
        asm volatile("s_waitcnt vmcnt(0) lgkmcnt(0)\n\ts_barrier" ::: "memory");
        for (int kt = 0; kt < 4; ++kt) {
            const LAS unsigned char* Kb = lds + (unsigned)((hi * 256 + 64 * kt + r32) * 16);
            f32x16 p0, p1;
#pragma unroll
            for (int r = 0; r < 16; ++r) { p0[r] = 0.f; p1[r] = 0.f; }
#pragma unroll
            for (int s = 0; s < 8; ++s) { const bf16x8 k0 = *(const LAS bf16x8*)(Kb + s * 8192), k1 = *(const LAS bf16x8*)(Kb + s * 8192 + 512);
                p0 = __builtin_amdgcn_mfma_f32_32x32x16_bf16(k0, qr[s], p0, 0, 0, 0); p1 = __builtin_amdgcn_mfma_f32_32x32x16_bf16(k1, qr[s], p1, 0, 0, 0); }
            float rm = -INFINITY;
#pragma unroll
            for (int r = 0; r < 16; ++r) rm = fmaxf(rm, fmaxf(p0[r], p1[r]));
            rm = fmaxf(rm, xhalf_f(rm));
            if (__any(rm > mrun)) { const float mn = fmaxf(mrun, rm), f = __builtin_amdgcn_exp2f(mrun - mn); mrun = mn; lrun *= f;
#pragma unroll
                for (int blk = 0; blk < 4; ++blk)
#pragma unroll
                    for (int r = 0; r < 16; ++r) o[blk][r] *= f; }
            float ls = 0.f;
#pragma unroll
            for (int r = 0; r < 16; ++r) { p0[r] = __builtin_amdgcn_exp2f(p0[r] - mrun); p1[r] = __builtin_amdgcn_exp2f(p1[r] - mrun); ls += p0[r] + p1[r]; }
            lrun += ls;
            bf16x8 pw[4];
#pragma unroll
            for (int s = 0; s < 2; ++s) {
                v4u a = {cvtpk(p0[8 * s + 0], p0[8 * s + 1]), cvtpk(p0[8 * s + 2], p0[8 * s + 3]), cvtpk(p0[8 * s + 4], p0[8 * s + 5]), cvtpk(p0[8 * s + 6], p0[8 * s + 7])};
                v4u c = {cvtpk(p1[8 * s + 0], p1[8 * s + 1]), cvtpk(p1[8 * s + 2], p1[8 * s + 3]), cvtpk(p1[8 * s + 4], p1[8 * s + 5]), cvtpk(p1[8 * s + 6], p1[8 * s + 7])};
                pw[s] = __builtin_bit_cast(bf16x8, a); pw[2 + s] = __builtin_bit_cast(bf16x8, c); }
            const LAS unsigned char* Vb = lds + voff + kt * 4096;
#pragma unroll
            for (int blk = 0; blk < 4; ++blk) {
#pragma unroll
                for (int s = 0; s < 4; ++s) {
                    const v4i16_t lo = lds_tr16(Vb + blk * 16384 + s * 1024), hh = lds_tr16(Vb + blk * 16384 + s * 1024 + 512);
                    const bf16x8 vf = {lo[0], lo[1], lo[2], lo[3], hh[0], hh[1], hh[2], hh[3]};
                    o[blk] = __builtin_amdgcn_mfma_f32_32x32x16_bf16(vf, pw[s], o[blk], 0, 0, 0);
                }
            }
        }
        __syncthreads();
        lrun += xhalf_f(lrun);
        const float inv = 1.f / lrun;
        LAS unsigned* stg = (LAS unsigned*)(lds) + wave * (32 * 65);
#pragma unroll
        for (int blk = 0; blk < 4; ++blk)
#pragma unroll
            for (int r = 0; r < 16; r += 2) { const int e = 32 * blk + (r & 3) + 8 * (r >> 2) + 4 * hi;
                stg[r32 * 65 + (e >> 1)] = cvtpk(o[blk][r] * inv, o[blk][r + 1] * inv); }
        LDS_WAIT(); asm volatile("" ::: "memory");
        bf16* orow = OM + ((size_t)b * SEQ + qb * 256 + wave * 32) * 512 + h * 128;
#pragma unroll 4
        for (int row = 0; row < 32; ++row) *((GAS unsigned*)(orow + (size_t)row * 512) + lane) = stg[row * 65 + lane];
        __syncthreads();
    }
}

constexpr int N_PHASES = 21;
struct Args { const float* in[24]; float* out; unsigned char* ws; int ph_lo, ph_hi; };
__global__ void __launch_bounds__(NWAVES * 64, 2) mk_fwd(Args args) {
    extern __shared__ __attribute__((aligned(16))) unsigned char lds_raw[];
    LAS unsigned char* lds = (LAS unsigned char*)lds_raw;
    volatile LAS unsigned* MISC = (volatile LAS unsigned*)(lds + MISC_OFF);
    const int tid = threadIdx.x, wave = __builtin_amdgcn_readfirstlane(tid >> 6);
#define lane lane_fresh()
    const int G = gridDim.x; int bx = blockIdx.x;
    int vcu = (G % 8 == 0) ? (bx % 8) * (G / 8) + bx / 8 : bx;
    int gw = vcu * NWAVES + wave; const int NGW = G * NWAVES;
    unsigned char* ws = args.ws;
    gu32* ctl = (gu32*)(ws + WS_CTL);
    for (int u = tid; u < (LDS_BYTES - LDSCTL_OFF) / 4; u += NWAVES * 64) ((LAS unsigned*)(lds + LDSCTL_OFF))[u] = 0u;
    __syncthreads();
    const bool one = (args.ph_hi - args.ph_lo) > 1;
    XcdBarrier bar; bar.bar = (unsigned*)(ctl + CW_BAR); bar.x = 0; bar.st = nullptr;
    if (one) bar = xcd_barrier_post((unsigned*)(ctl + CW_BAR), MISC + 8, tid == 0);
    const int lo = args.ph_lo, hi = args.ph_hi;
#ifndef PH_MASK
#define PH_MASK 0xFFFFFFFFu
#endif
#define IN(k) ((((PH_MASK) >> (k)) & 1u) && lo <= (k) && (k) < hi)
#define SEAM(k) do { if (IN(k) && IN((k) + 1)) xcd_barrier(bar, wave); } while (0)
    bf16* const X16 = (bf16*)(ws + WS_X16); bf16* const HB = (bf16*)(ws + WS_H);
    long long* const ST0 = (long long*)(ws + WS_CTL + CTL_STATS); long long* const ST1 = (long long*)(ws + WS_CTL + CTL_STATS + CTL_STATS_STRIDE); long long* const ST2 = (long long*)(ws + WS_CTL + CTL_STATS + 2 * CTL_STATS_STRIDE);
    const float* const VEC = (const float*)(ws + WS_CTL + CTL_VECF);
    float* const out = args.out;
    const float* const ln_g = args.in[22]; const float* const ln_b = args.in[23];
    using namespace pg8;

#ifdef PROBE_P0
    if (IN(0)) { p0_prologue(args.in, ws, lds, gw, NGW, wave, lane); }
#endif
    if (IN(0)) { p0_prologue(args.in, ws, lds, gw, NGW, wave, lane); }
    SEAM(0);
    if (one && IN(0) && (G % 8) == 0) {
        unsigned* xb = (unsigned*)(ctl + CW_BAR); bool even = true;
#pragma unroll
        for (int jx = 0; jx < 16; ++jx) { const unsigned c = xb_ld(&xb[XB_XCNT(jx)]); even = even && (jx < 8 ? c == (unsigned)(G / 8) : c == 0u); }
        const int rank = (int)MISC[10], xcc = (int)xb_xcc_id();
        if (__builtin_amdgcn_readfirstlane(even ? 1 : 0)) { vcu = __builtin_amdgcn_readfirstlane(xcc * (G / 8) + rank); bx = __builtin_amdgcn_readfirstlane(rank * 8 + xcc); gw = vcu * NWAVES + wave; }
    }
    if (IN(1)) { { const long long* vi = (const long long*)(ws + WS_CTL + CTL_VEC); float* vf = (float*)(ws + WS_CTL + CTL_VECF); for (int i = gw * 64 + lane; i < V_END; i += NGW * 64) vf[i] = (float)vi[i] * (1.0f / 16777216.f); }
        Gemm g{(const bf16*)(ws + WS_X8), (const bf16*)(ws + WS_W_GU1), D / 2, D / 2, D / 2, 0, 0}; StaticOrder S; S.init(M, 2 * FF, G, bx); EpiSwiGLU8 E{(unsigned char*)HB, FF, 1.0f / (FP8_XS * FP8_WGUS), FP8_HS, LnFold{nullptr, nullptr, nullptr}};
        gemm_phase<EpiSwiGLU8, StaticOrder, true, true>(lds + RING_OFF, g, S, E, wave); }
    SEAM(1);
    if (IN(2)) { Gemm g{HB, (const bf16*)(ws + WS_W_D1), FF / 2, FF / 2, FF / 2, 0, 0}; StaticOrder S; S.init(M, D, G, bx); EpiRes<true> E{args.in[0], nullptr, D, ALPHA, 0.5f / (FP8_HS * FP8_WDS), nullptr, nullptr, nullptr, ST0, X16, (unsigned char*)(ws + WS_X8M), FP8_XS};
        gemm_phase<EpiRes<true>, StaticOrder, true, true>(lds + RING_OFF, g, S, E, wave); }
    SEAM(2);
    if (IN(4)) {
        { Gemm g{X16, (const bf16*)(ws + WS_W_IN), D, D, D, 0, 0}; StaticOrder S; S.init(M, N_IN, G, bx);
          EpiInProj E{(bf16*)(ws + WS_AQ), (bf16*)(ws + WS_AK), (bf16*)(ws + WS_AV), (bf16*)(ws + WS_BQ), (bf16*)(ws + WS_BC), (bf16*)(ws + WS_IQ), (bf16*)(ws + WS_IKW), QSCALE, LnFold{ST0, VEC + V_GW_IN, VEC + V_BW_IN}, (unsigned*)(ctl + CW_KMAX)};
          gemm_phase<EpiInProj, StaticOrder, true>(lds + RING_OFF, g, S, E, wave); }
        { Gemm g{(const bf16*)(ws + WS_MEM16), (const bf16*)(ws + WS_W_MKV), D, D, D, 0, 0}; StaticOrder S; S.init(BATCH * MEMT, 1024, G, bx >= G - 16 ? bx - (G - 16) : (1 << 20)); EpiBf16 E{(bf16*)(ws + WS_KVMEM), 1024};
          gemm_phase<EpiBf16, StaticOrder, true>(lds + RING_OFF, g, S, E, wave); }
    }
    SEAM(4);
    if (IN(5)) {
        { Gemm g{(const bf16*)(ws + WS_BQ), (const bf16*)(ws + WS_W_UK), 1024, 128, 128, 1, 128}; StaticOrder S; S.init(M, 4096, G, bx); EpiBf16 E{(bf16*)(ws + WS_QLAT), 4096};
          gemm_phase<EpiBf16, StaticOrder, true>(lds + RING_OFF, g, S, E, wave); }
        crms_phase((const bf16*)(ws + WS_BC), (unsigned char*)(ws + WS_C8), args.in[8], DSA_CS, gw, NGW, lane);
    }
    if (IN(7)) indexer_topk(lds, (const bf16*)(ws + WS_IQ), (const bf16*)(ws + WS_IKW), (unsigned short*)(ws + WS_IDX), vcu, G, wave);
    if (IN(7)) diff_attn_mfma(lds, (const bf16*)(ws + WS_AQ), (const bf16*)(ws + WS_AK), (const bf16*)(ws + WS_AV), (bf16*)(ws + WS_AQ), args.in[6], args.in[7], (unsigned*)(ctl + CW_DQ), (const unsigned*)(ctl + CW_KMAX), wave);
    SEAM(7);
    if (IN(8)) dsa_mfma(lds, (const bf16*)(ws + WS_QLAT), (bf16*)(ws + WS_QLAT), 0x7fffffff, (const unsigned char*)(ws + WS_C8), (const unsigned short*)(ws + WS_IDX), vcu, G, wave);
    SEAM(8);
    if (IN(9)) { Gemm g{(const bf16*)(ws + WS_QLAT), (const bf16*)(ws + WS_W_UVP), 4096, 1024, 1024, 0, 1024}; StaticOrder S; S.init(M, 1024, G, bx); EpiBf16 E{(bf16*)(ws + WS_YB), 1024};
        gemm_phase<EpiBf16, StaticOrder, true>(lds + RING_OFF, g, S, E, wave); }
    SEAM(9);
    if (IN(10)) {
        { Gemm g{(const bf16*)(ws + WS_AQ), (const bf16*)(ws + WS_W_A), 1024, 1024, 1024, 0, 0}; StaticOrder S; S.init(M, D, G, bx); EpiBf16 E{(bf16*)(ws + WS_TA), D}; gemm_phase<EpiBf16, StaticOrder, true>(lds + RING_OFF, g, S, E, wave); }
        { Gemm g{(const bf16*)(ws + WS_YB), (const bf16*)(ws + WS_W_B), 1024, 1024, 1024, 0, 0}; StaticOrder S; S.init(M, D, G, bx); EpiBf16 E{(bf16*)(ws + WS_TB), D}; gemm_phase<EpiBf16, StaticOrder, true>(lds + RING_OFF, g, S, E, wave); }
    }
    SEAM(10);
    if (IN(11)) { Gemm g{(const bf16*)(ws + WS_X8M), (const bf16*)(ws + WS_W_G), D / 2, D / 2, D / 2, 0, 0}; StaticOrder S; S.init(M, 2 * D, G, bx);
        EpiGateMerge8 E{(const bf16*)(ws + WS_TA), (const bf16*)(ws + WS_TB), (unsigned char*)(ws + WS_MRG8), D, args.in[12], args.in[12] + D, 1.0f / (FP8_XS * FP8_WGS), FP8_MS, LnFold{ST0, VEC + V_GW_G, VEC + V_BW_G}};
        gemm_phase<EpiGateMerge8, StaticOrder, true, true>(lds + RING_OFF, g, S, E, wave); }
    SEAM(11);
    if (IN(12)) { Gemm g{(const bf16*)(ws + WS_MRG8), (const bf16*)(ws + WS_W_MO), D / 2, D / 2, D / 2, 0, 0}; StaticOrder S; S.init(M, D, G, bx); EpiRes<false, 1> E{nullptr, X16, D, ALPHA, 1.0f / (FP8_MS * FP8_WMOS), ST0, ln_g, ln_b, ST1, X16, nullptr, 0.f};
        gemm_phase<EpiRes<false, 1>, StaticOrder, true, true>(lds + RING_OFF, g, S, E, wave); }
    SEAM(12);
    if (IN(14)) { Gemm g{X16, (const bf16*)(ws + WS_W_MQ), D, D, D, 0, 0}; StaticOrder S; S.init(M, 512, G, bx); EpiBf16 E{(bf16*)(ws + WS_QM), 512, 0.08838834764831845f * LOG2E, LnFold{ST1, VEC + V_GW_MQ, VEC + V_BW_MQ}}; gemm_phase<EpiBf16, StaticOrder, true>(lds + RING_OFF, g, S, E, wave); }
    SEAM(14);
    if (IN(15)) memattn_mfma(lds, (const bf16*)(ws + WS_QM), (const bf16*)(ws + WS_KVMEM), (bf16*)(ws + WS_OM), vcu, G, wave);
    SEAM(15);
    if (IN(16)) { Gemm g{(const bf16*)(ws + WS_OM), (const bf16*)(ws + WS_W_MOUT), 512, 512, 512, 0, 0}; StaticOrder S; S.init(M, D, G, bx); EpiRes<false> E{nullptr, X16, D, ALPHA, 1.0f, ST1, ln_g + D, ln_b + D, ST2, X16, (unsigned char*)(ws + WS_X8), FP8_XS};
        gemm_phase<EpiRes<false>, StaticOrder, true>(lds + RING_OFF, g, S, E, wave); }
    SEAM(16);
    if (IN(18)) { Gemm g{(const bf16*)(ws + WS_X8), (const bf16*)(ws + WS_W_GU2), D / 2, D / 2, D / 2, 0, 0}; StaticOrder S; S.init(M, 2 * FF, G, bx); EpiSwiGLU8 E{(unsigned char*)HB, FF, 1.0f / (FP8_XS * FP8_WGUS), FP8_HS, LnFold{ST2, VEC + V_GW_GU2, VEC + V_BW_GU2}};
        gemm_phase<EpiSwiGLU8, StaticOrder, true, true>(lds + RING_OFF, g, S, E, wave); }
    SEAM(18);
    if (IN(19)) { Gemm g{HB, (const bf16*)(ws + WS_W_D2), FF / 2, FF / 2, FF / 2, 0, 0}; StaticOrder S; S.init(M, D, G, bx); EpiRes<false> E{nullptr, X16, D, ALPHA, 0.5f / (FP8_HS * FP8_WDS), ST2, ln_g + 2 * D, ln_b + 2 * D, nullptr, X16, nullptr, 0.f};
        gemm_phase<EpiRes<false>, StaticOrder, true, true>(lds + RING_OFF, g, S, E, wave); }
    SEAM(19);
    if (IN(20)) ln_final_phase(X16, out, ln_g + 3 * D, ln_b + 3 * D, gw, NGW, lane);
#undef IN
#undef SEAM
#undef lane
}

extern "C" void kernel_launch(void* const* d_in, const int* in_sizes, int n_in, void* d_out, int out_size, void* d_ws, size_t ws_size, hipStream_t stream) {
    static int grid = 0;
    if (grid == 0) {
        if (n_in != 24 || in_sizes[0] != M * D || out_size != M * D || ws_size < WS_END) { fprintf(stderr, "kernel_launch: unexpected shapes (n_in %d, in0 %d, out %d, ws %zu); nothing launched\n", n_in, n_in > 0 ? in_sizes[0] : -1, out_size, ws_size); grid = -1; return; }
        int dev = 0, cus = 0, per_cu = 0;
        if (hipGetDevice(&dev) != hipSuccess || hipDeviceGetAttribute(&cus, hipDeviceAttributeMultiprocessorCount, dev) != hipSuccess) { grid = -1; return; }
        if (hipFuncSetAttribute((const void*)mk_fwd, hipFuncAttributeMaxDynamicSharedMemorySize, LDS_BYTES) != hipSuccess) { fprintf(stderr, "kernel_launch: hipFuncSetAttribute failed\n"); grid = -1; return; }
        if (hipOccupancyMaxActiveBlocksPerMultiprocessor(&per_cu, (const void*)mk_fwd, NWAVES * 64, LDS_BYTES) != hipSuccess || per_cu < 1)
            fprintf(stderr, "kernel_launch: note: the occupancy query reports %d workgroups per CU\n", per_cu);
        (void)hipGetLastError();
        grid = cus;
    }
    if (grid < 0) return;
    if (hipMemsetAsync((char*)d_ws + WS_CTL, 0, CTL_ZERO_BYTES, stream) != hipSuccess) return;
    Args a{};
    for (int i = 0; i < 24; ++i) a.in[i] = (const float*)d_in[i];
    a.out = (float*)d_out; a.ws = (unsigned char*)d_ws;
#if MK_ONE_LAUNCH
    a.ph_lo = 0; a.ph_hi = N_PHASES;
    hipLaunchKernelGGL(mk_fwd, dim3(grid), dim3(NWAVES * 64), LDS_BYTES, stream, a);
#else
    for (int p = 0; p < N_PHASES; ++p) { a.ph_lo = p; a.ph_hi = p + 1; hipLaunchKernelGGL(mk_fwd, dim3(grid), dim3(NWAVES * 64), LDS_BYTES, stream, a); }
#endif
}
```

```cpp
#include <hip/hip_runtime.h>
#include <cstdio>
#include <cstdint>

#ifndef MK_ONE_LAUNCH
#define MK_ONE_LAUNCH 1
#endif

__device__ __forceinline__ int lane_fresh() { int l = (int)__builtin_amdgcn_mbcnt_hi(~0u, __builtin_amdgcn_mbcnt_lo(~0u, 0u)); asm volatile("" : "+v"(l)); return l; }
__device__ __forceinline__ void glds16(const void* gsrc, unsigned lds_dst) { unsigned keep;
    asm volatile("s_mov_b32 %0, m0\n\ts_mov_b32 m0, %2\n\ts_nop 0\n\tglobal_load_lds_dwordx4 %1, off\n\ts_mov_b32 m0, %0" : "=&s"(keep) : "v"(gsrc), "s"(lds_dst) : "memory"); }
__device__ __forceinline__ void glds16s(const void* sbase, unsigned voff, unsigned lds_dst) { unsigned keep;
    asm volatile("s_mov_b32 %0, m0\n\ts_mov_b32 m0, %3\n\ts_nop 0\n\tglobal_load_lds_dwordx4 %1, %2\n\ts_mov_b32 m0, %0" : "=&s"(keep) : "v"(voff), "s"(sbase), "s"(lds_dst) : "memory"); }
namespace pg8 {
#define PG8_LAS __attribute__((address_space(3)))
typedef unsigned short bf16_t;
typedef short bf16x8 __attribute__((ext_vector_type(8)));
typedef float f32x4 __attribute__((ext_vector_type(4)));
typedef unsigned u32x4 __attribute__((ext_vector_type(4)));
constexpr int BM = 256, BK = 64, HALF = 128, HTB = HALF * BK * 2  , STAGE_BYTES = 8 * HTB, NXCD = 8, WGM = 8;

__host__ __device__ __forceinline__ int lds_byte(int r, int c) { const int st = (r >> 4) * 2 + (c >> 5), rr = r & 15, cc = c & 31, ob = rr * 64 + cc * 2; return st * 1024 + (ob ^ (((ob >> 9) & 1) << 5)); }
__host__ __device__ __forceinline__ void stage_rc(int b, int& R, int& C) { const int st = b / 1024, sb = b % 1024, swz = sb ^ (((sb >> 9) & 1) << 5); R = (st >> 1) * 16 + swz / 64; C = (st & 1) * 32 + (swz % 64) / 2; }
__host__ __device__ __forceinline__ int perm32(int rho) { const int n = rho >> 4, i = rho & 15; return 8 * (i >> 2) + 4 * n + (i & 3); }

struct Unit { int pm, pn; };
struct Gemm { const bf16_t* A; const bf16_t* Bt; int lda, ldb, K, a_shift, a_mul; };

struct StaticOrder {
    int nM, nN, nwg, G, c;
    __host__ __device__ void init(int M, int N, int G_, int c_) { nM = M / BM; nN = N / BM; nwg = nM * nN; G = G_; c = c_; }
    __host__ __device__ bool next(int i, Unit& u) const {
        const long L = (long)i * G + c; if (L >= nwg) return false;
        int wgid = (int)L; { const int q = nwg / NXCD, r = nwg % NXCD, xcd = wgid % NXCD, off = wgid / NXCD; wgid = (xcd < r ? xcd * (q + 1) : r * (q + 1) + (xcd - r) * q) + off; }
        const int nig = WGM * nN, gid = wgid / nig, fm = gid * WGM, gsz = (nM - fm) < WGM ? (nM - fm) : WGM;
        u.pm = fm + ((wgid % nig) % gsz); u.pn = (wgid % nig) / gsz; return true;
    }
    __device__ __forceinline__ void a_ready(const Unit&) const {}
    __device__ __forceinline__ void done(const Unit&) const {}
};

__device__ __forceinline__ unsigned cvt_pk_bf16(float lo, float hi) { unsigned r; asm volatile("v_cvt_pk_bf16_f32 %0, %1, %2" : "=v"(r) : "v"(lo), "v"(hi)); return r; }
__device__ __forceinline__ float bflo(unsigned w) { return __uint_as_float(w << 16); }
__device__ __forceinline__ float bfhi(unsigned w) { return __uint_as_float(w & 0xffff0000u); }
__device__ __forceinline__ float sigmoidf_fast(float x) { return __builtin_amdgcn_rcpf(1.0f + __builtin_amdgcn_exp2f(-1.4426950408889634f * x)); }

struct LnFold {
    const long long* stats; const float* gW; const float* bW;
    __device__ __forceinline__ void row(int r, float& mean, float& rstd) const { const long long s0 = stats[2 * (size_t)r], s1 = stats[2 * (size_t)r + 1];
        mean = (float)s0 * (1.0f / (1048576.f * 2048.0f)); rstd = __builtin_amdgcn_rsqf((float)s1 * (1.0f / (65536.f * 2048.0f)) - mean * mean + 1e-5f); }
    __device__ __forceinline__ f32x4 vec4(const float* v, int i) const { return *(const f32x4*)(v + i); }
    __device__ __forceinline__ void rows8(int row0, float (&mean)[8], float (&rstd)[8]) const {
#pragma unroll
        for (int hf = 0; hf < 2; ++hf) { long long s0[4], s1[4];
#pragma unroll
            for (int q = 0; q < 4; ++q) { const size_t r = (size_t)(row0 + hf * 128 + q * 16); s0[q] = stats[2 * r]; s1[q] = stats[2 * r + 1]; }
#pragma unroll
            for (int q = 0; q < 4; ++q) { const float mu = (float)s0[q] * (1.0f / (1048576.f * 2048.0f)); mean[4 * hf + q] = mu; rstd[4 * hf + q] = __builtin_amdgcn_rsqf((float)s1[q] * (1.0f / (65536.f * 2048.0f)) - mu * mu + 1e-5f); }
            asm volatile("" : "+v"(mean[4 * hf]), "+v"(mean[4 * hf + 1]), "+v"(mean[4 * hf + 2]), "+v"(mean[4 * hf + 3]), "+v"(rstd[4 * hf]), "+v"(rstd[4 * hf + 1]), "+v"(rstd[4 * hf + 2]), "+v"(rstd[4 * hf + 3]) :: "memory"); }
    }
};
struct EpiBf16 {
    static constexpr bool PERM = true, AFTER_DRAIN = false;
    bf16_t* O; int ldc; float sc = 1.0f; LnFold lf = {nullptr, nullptr, nullptr};
    __device__ __forceinline__ void operator()(const f32x4 (&acc)[2][2][4][2], const Unit& u, int wr, int wc, int fr, int fq) const {
        const int row0 = u.pm * BM + wr * 64 + fr, col0 = u.pn * BM + wc * 32 + 8 * fq;
        f32x4 gw[2][2], bw[2][2];
#pragma unroll
        for (int bj = 0; bj < 2; ++bj)
#pragma unroll
            for (int n = 0; n < 2; ++n) { gw[bj][n] = (f32x4){0.f, 0.f, 0.f, 0.f}; bw[bj][n] = (f32x4){0.f, 0.f, 0.f, 0.f}; if (lf.stats) { gw[bj][n] = lf.vec4(lf.gW, col0 + bj * HALF + 4 * n); bw[bj][n] = lf.vec4(lf.bW, col0 + bj * HALF + 4 * n); } }
        float mean8[8], rstd8[8];
#pragma unroll
        for (int q = 0; q < 8; ++q) { mean8[q] = 0.f; rstd8[q] = 1.f; }
        if (lf.stats) lf.rows8(row0, mean8, rstd8);
#pragma unroll
        for (int ai = 0; ai < 2; ++ai)
#pragma unroll
            for (int m = 0; m < 4; ++m) { bf16_t* rowp = O + (size_t)(row0 + ai * HALF + m * 16) * ldc + col0;
                const float mean = mean8[ai * 4 + m], rstd = rstd8[ai * 4 + m];
#pragma unroll
                for (int bj = 0; bj < 2; ++bj) { const f32x4 v0 = ((acc[ai][bj][m][0] - gw[bj][0] * mean) * rstd + bw[bj][0]) * sc, v1 = ((acc[ai][bj][m][1] - gw[bj][1] * mean) * rstd + bw[bj][1]) * sc;
                    u32x4 w; w.x = cvt_pk_bf16(v0[0], v0[1]); w.y = cvt_pk_bf16(v0[2], v0[3]); w.z = cvt_pk_bf16(v1[0], v1[1]); w.w = cvt_pk_bf16(v1[2], v1[3]);
                    *(u32x4*)(rowp + bj * HALF) = w; } }
    }
};
struct EpiInProj {
    static constexpr bool PERM = true, AFTER_DRAIN = false;
    bf16_t *aq, *ak, *av, *bq, *bc, *iq, *ikw; float qscale; LnFold lf; unsigned* kmax;
    __device__ __forceinline__ void operator()(const f32x4 (&acc)[2][2][4][2], const Unit& u, int wr, int wc, int fr, int fq) const {
        bf16_t* base; int ldc, colt; const int pn = u.pn;
        if (pn < 4) { base = aq; ldc = 1024; colt = pn * 256; }
        else if (pn < 8) { base = ak; ldc = 1024; colt = (pn - 4) * 256; }
        else if (pn < 12) { base = av; ldc = 1024; colt = (pn - 8) * 256; }
        else if (pn < 16) { base = bq; ldc = 1024; colt = (pn - 12) * 256; }
        else if (pn < 18) { base = bc; ldc = 512; colt = (pn - 16) * 256; }
        else if (pn < 22) { base = iq; ldc = 1024; colt = (pn - 18) * 256; }
        else { base = ikw; ldc = 256; colt = 0; }
        const float sc = (pn < 4) ? qscale : 1.0f; float kam[2] = {0.f, 0.f};
        const int row0 = u.pm * BM + wr * 64 + fr, col0 = colt + wc * 32 + 8 * fq, cidx = pn * BM + wc * 32 + 8 * fq;
        f32x4 gw[2][2], bw[2][2];
#pragma unroll
        for (int bj = 0; bj < 2; ++bj)
#pragma unroll
            for (int n = 0; n < 2; ++n) { gw[bj][n] = lf.vec4(lf.gW, cidx + bj * HALF + 4 * n); bw[bj][n] = lf.vec4(lf.bW, cidx + bj * HALF + 4 * n); }
        float mean8[8], rstd8[8]; lf.rows8(row0, mean8, rstd8);
#pragma unroll
        for (int ai = 0; ai < 2; ++ai)
#pragma unroll
            for (int m = 0; m < 4; ++m) { bf16_t* rowp = base + (size_t)(row0 + ai * HALF + m * 16) * ldc + col0;
                const float mean = mean8[ai * 4 + m], rstd = rstd8[ai * 4 + m];
#pragma unroll
                for (int bj = 0; bj < 2; ++bj) { const f32x4 v0 = ((acc[ai][bj][m][0] - gw[bj][0] * mean) * rstd + bw[bj][0]) * sc, v1 = ((acc[ai][bj][m][1] - gw[bj][1] * mean) * rstd + bw[bj][1]) * sc;
                    kam[bj] = fmaxf(kam[bj], fmaxf(fmaxf(fmaxf(fabsf(v0[0]), fabsf(v0[1])), fmaxf(fabsf(v0[2]), fabsf(v0[3]))), fmaxf(fmaxf(fabsf(v1[0]), fabsf(v1[1])), fmaxf(fabsf(v1[2]), fabsf(v1[3])))));
                    u32x4 w; w.x = cvt_pk_bf16(v0[0], v0[1]); w.y = cvt_pk_bf16(v0[2], v0[3]); w.z = cvt_pk_bf16(v1[0], v1[1]); w.w = cvt_pk_bf16(v1[2], v1[3]);
                    *(u32x4*)(rowp + bj * HALF) = w; } }
        if (pn >= 4 && pn < 8) {
#pragma unroll
            for (int bj = 0; bj < 2; ++bj) { float v = kam[bj];
#pragma unroll
                for (int o = 1; o < 64; o <<= 1) v = fmaxf(v, __shfl_xor(v, o));
                if ((fr | fq) == 0) (void)__hip_atomic_fetch_max(kmax + ((u.pm >> 4) * 8 + 2 * (pn - 4) + bj) * 2 + (wc >> 1), __float_as_uint(v), __ATOMIC_RELAXED, __HIP_MEMORY_SCOPE_AGENT); } }
    }
};
struct EpiSwiGLU {
    static constexpr bool PERM = true, AFTER_DRAIN = false;
    bf16_t* O; int ldc;
    __device__ __forceinline__ void operator()(const f32x4 (&acc)[2][2][4][2], const Unit& u, int wr, int wc, int fr, int fq) const {
        const int row0 = u.pm * BM + wr * 64 + fr, col0 = u.pn * HALF + wc * 32 + 8 * fq;
#pragma unroll
        for (int ai = 0; ai < 2; ++ai)
#pragma unroll
            for (int m = 0; m < 4; ++m) { bf16_t* rowp = O + (size_t)(row0 + ai * HALF + m * 16) * ldc + col0;
                float h[8];
#pragma unroll
                for (int n = 0; n < 2; ++n)
#pragma unroll
                    for (int j = 0; j < 4; ++j) { const float g = acc[ai][0][m][n][j], up = acc[ai][1][m][n][j]; h[4 * n + j] = g * sigmoidf_fast(g) * up; }
                u32x4 w; w.x = cvt_pk_bf16(h[0], h[1]); w.y = cvt_pk_bf16(h[2], h[3]); w.z = cvt_pk_bf16(h[4], h[5]); w.w = cvt_pk_bf16(h[6], h[7]);
                *(u32x4*)rowp = w; }
    }
};
__device__ __forceinline__ unsigned pk4_fp8(float a, float b, float c, float d) { int w = 0; w = __builtin_amdgcn_cvt_pk_fp8_f32(a, b, w, false); w = __builtin_amdgcn_cvt_pk_fp8_f32(c, d, w, true); return (unsigned)w; }
struct EpiFp8 {
    static constexpr bool PERM = true, AFTER_DRAIN = false;
    unsigned char* O; int ldc; float sc;
    __device__ __forceinline__ void operator()(const f32x4 (&acc)[2][2][4][2], const Unit& u, int wr, int wc, int fr, int fq) const {
        typedef unsigned u32x2 __attribute__((ext_vector_type(2)));
        const int row0 = u.pm * BM + wr * 64 + fr, col0 = u.pn * BM + wc * 32 + 8 * fq;
#pragma unroll
        for (int ai = 0; ai < 2; ++ai)
#pragma unroll
            for (int m = 0; m < 4; ++m) { unsigned char* rowp = O + (size_t)(row0 + ai * HALF + m * 16) * ldc + col0;
#pragma unroll
                for (int bj = 0; bj < 2; ++bj) { const f32x4 v0 = acc[ai][bj][m][0] * sc, v1 = acc[ai][bj][m][1] * sc;
                    *(u32x2*)(rowp + bj * HALF) = (u32x2){pk4_fp8(fminf(fmaxf(v0[0], -448.f), 448.f), fminf(fmaxf(v0[1], -448.f), 448.f), fminf(fmaxf(v0[2], -448.f), 448.f), fminf(fmaxf(v0[3], -448.f), 448.f)),
                                                          pk4_fp8(fminf(fmaxf(v1[0], -448.f), 448.f), fminf(fmaxf(v1[1], -448.f), 448.f), fminf(fmaxf(v1[2], -448.f), 448.f), fminf(fmaxf(v1[3], -448.f), 448.f))}; } }
    }
};
struct EpiSwiGLU8 {
    static constexpr bool PERM = true, AFTER_DRAIN = false;
    unsigned char* O; int ldc; float ascale, hs; LnFold lf;
    __device__ __forceinline__ void operator()(const f32x4 (&acc)[2][2][4][2], const Unit& u, int wr, int wc, int fr, int fq) const {
        const int row0 = u.pm * BM + wr * 64 + fr, col0 = u.pn * HALF + wc * 32 + 8 * fq, cidx = u.pn * BM + wc * 32 + 8 * fq;
        typedef unsigned u32x2 __attribute__((ext_vector_type(2)));
        f32x4 gw[2][2], bw[2][2];
#pragma unroll
        for (int bj = 0; bj < 2; ++bj)
#pragma unroll
            for (int n = 0; n < 2; ++n) { gw[bj][n] = (f32x4){0.f, 0.f, 0.f, 0.f}; bw[bj][n] = (f32x4){0.f, 0.f, 0.f, 0.f}; if (lf.stats) { gw[bj][n] = lf.vec4(lf.gW, cidx + bj * HALF + 4 * n); bw[bj][n] = lf.vec4(lf.bW, cidx + bj * HALF + 4 * n); } }
        float mean8[8], rstd8[8];
#pragma unroll
        for (int q = 0; q < 8; ++q) { mean8[q] = 0.f; rstd8[q] = 1.f; }
        if (lf.stats) lf.rows8(row0, mean8, rstd8);
#pragma unroll
        for (int ai = 0; ai < 2; ++ai)
#pragma unroll
            for (int m = 0; m < 4; ++m) { unsigned char* rowp = O + (size_t)(row0 + ai * HALF + m * 16) * ldc + col0;
                float h[8]; const float mean = mean8[ai * 4 + m], rstd = rstd8[ai * 4 + m];
#pragma unroll
                for (int n = 0; n < 2; ++n)
#pragma unroll
                    for (int j = 0; j < 4; ++j) { const float g = (acc[ai][0][m][n][j] * ascale - gw[0][n][j] * mean) * rstd + bw[0][n][j], up = (acc[ai][1][m][n][j] * ascale - gw[1][n][j] * mean) * rstd + bw[1][n][j];
                        h[4 * n + j] = fminf(fmaxf(g * sigmoidf_fast(g) * up * hs, -448.f), 448.f); }
                *(u32x2*)rowp = (u32x2){pk4_fp8(h[0], h[1], h[2], h[3]), pk4_fp8(h[4], h[5], h[6], h[7])}; }
    }
};
struct EpiGateMerge {
    static constexpr bool PERM = true, AFTER_DRAIN = false;
    const bf16_t* ta; const bf16_t* tb; bf16_t* O; int ldc; const float* b0; const float* b1;
    __device__ __forceinline__ void operator()(const f32x4 (&acc)[2][2][4][2], const Unit& u, int wr, int wc, int fr, int fq) const {
        const int row0 = u.pm * BM + wr * 64 + fr, col0 = u.pn * HALF + wc * 32 + 8 * fq;
        float bb0[8], bb1[8];
#pragma unroll
        for (int j = 0; j < 8; ++j) { bb0[j] = b0[col0 + j]; bb1[j] = b1[col0 + j]; }
#pragma unroll
        for (int ai = 0; ai < 2; ++ai)
#pragma unroll
            for (int m = 0; m < 4; ++m) { const size_t off = (size_t)(row0 + ai * HALF + m * 16) * ldc + col0;
                const u32x4 a = *(const u32x4*)(ta + off), b = *(const u32x4*)(tb + off);
                const float av[8] = {bflo(a.x), bfhi(a.x), bflo(a.y), bfhi(a.y), bflo(a.z), bfhi(a.z), bflo(a.w), bfhi(a.w)};
                const float bv[8] = {bflo(b.x), bfhi(b.x), bflo(b.y), bfhi(b.y), bflo(b.z), bfhi(b.z), bflo(b.w), bfhi(b.w)};
                float h[8];
#pragma unroll
                for (int n = 0; n < 2; ++n)
#pragma unroll
                    for (int j = 0; j < 4; ++j) { const int e = 4 * n + j; h[e] = sigmoidf_fast(acc[ai][0][m][n][j] + bb0[e]) * av[e] + sigmoidf_fast(acc[ai][1][m][n][j] + bb1[e]) * bv[e]; }
                u32x4 w; w.x = cvt_pk_bf16(h[0], h[1]); w.y = cvt_pk_bf16(h[2], h[3]); w.z = cvt_pk_bf16(h[4], h[5]); w.w = cvt_pk_bf16(h[6], h[7]);
                *(u32x4*)(O + off) = w; }
    }
};
struct EpiGateMerge8 {
    static constexpr bool PERM = true, AFTER_DRAIN = false;
    const bf16_t* ta; const bf16_t* tb; unsigned char* O; int ldc; const float* b0; const float* b1; float ascale, ms; LnFold lf;
    __device__ __forceinline__ void operator()(const f32x4 (&acc)[2][2][4][2], const Unit& u, int wr, int wc, int fr, int fq) const {
        const int row0 = u.pm * BM + wr * 64 + fr, col0 = u.pn * HALF + wc * 32 + 8 * fq, cidx = u.pn * BM + wc * 32 + 8 * fq;
        typedef unsigned u32x2 __attribute__((ext_vector_type(2)));
        float mean8[8], rstd8[8]; lf.rows8(row0, mean8, rstd8);
        float bb0[8], bb1[8], gw0[8], gw1[8];
#pragma unroll
        for (int j = 0; j < 8; ++j) { bb0[j] = b0[col0 + j] + lf.bW[cidx + j]; bb1[j] = b1[col0 + j] + lf.bW[cidx + HALF + j]; gw0[j] = lf.gW[cidx + j]; gw1[j] = lf.gW[cidx + HALF + j]; }
#pragma unroll
        for (int am = 0; am < 8; am += 2) {
            u32x4 pa[2], pb[2];
#pragma unroll
            for (int e2 = 0; e2 < 2; ++e2) { const size_t off = (size_t)(row0 + ((am + e2) >> 2) * HALF + ((am + e2) & 3) * 16) * ldc + col0; pa[e2] = *(const u32x4*)(ta + off); pb[e2] = *(const u32x4*)(tb + off); }
#pragma unroll
            for (int e2 = 0; e2 < 2; ++e2) { const int ai = (am + e2) >> 2, m = (am + e2) & 3; const size_t off = (size_t)(row0 + ai * HALF + m * 16) * ldc + col0;
                const u32x4 a = pa[e2], b = pb[e2];
                const float av[8] = {bflo(a.x), bfhi(a.x), bflo(a.y), bfhi(a.y), bflo(a.z), bfhi(a.z), bflo(a.w), bfhi(a.w)};
                const float bv[8] = {bflo(b.x), bfhi(b.x), bflo(b.y), bfhi(b.y), bflo(b.z), bfhi(b.z), bflo(b.w), bfhi(b.w)};
                float h[8]; const float mean = mean8[ai * 4 + m], rstd = rstd8[ai * 4 + m];
#pragma unroll
                for (int n = 0; n < 2; ++n)
#pragma unroll
                    for (int j = 0; j < 4; ++j) { const int e = 4 * n + j; const float v = sigmoidf_fast((acc[ai][0][m][n][j] * ascale - gw0[e] * mean) * rstd + bb0[e]) * av[e] + sigmoidf_fast((acc[ai][1][m][n][j] * ascale - gw1[e] * mean) * rstd + bb1[e]) * bv[e];
                        h[e] = fminf(fmaxf(v * ms, -448.f), 448.f); }
                *(u32x2*)(O + off) = (u32x2){pk4_fp8(h[0], h[1], h[2], h[3]), pk4_fp8(h[4], h[5], h[6], h[7])}; }
            asm volatile("" ::: "memory"); }
    }
};
template <bool RES32, int NB = 2> struct EpiRes {
    static constexpr bool PERM = true, AFTER_DRAIN = false;
    const float* res32; const bf16_t* res16; int ldc; float alpha, s;
    const long long* rstats; const float* rg; const float* rb; long long* ostats; bf16_t* o16; unsigned char* o8; float o8s;
    __device__ __forceinline__ void operator()(const f32x4 (&acc)[2][2][4][2], const Unit& u, int wr, int wc, int fr, int fq) const {
        const int col0 = u.pn * BM + wc * 32 + 8 * fq;
        typedef unsigned u32x2 __attribute__((ext_vector_type(2)));
        float al = alpha, sa = s; asm volatile("" : "+v"(al), "+v"(sa));
        const int rowb = u.pm * BM + wr * 64 + fr;
        float mean8[8], rstd8[8];
#pragma unroll
        for (int q = 0; q < 8; ++q) { mean8[q] = 0.f; rstd8[q] = 1.f; }
        if (rstats) { LnFold lf{rstats, nullptr, nullptr}; lf.rows8(rowb, mean8, rstd8); }
        asm volatile("" : "+v"(mean8[0]), "+v"(mean8[1]), "+v"(mean8[2]), "+v"(mean8[3]), "+v"(mean8[4]), "+v"(mean8[5]), "+v"(mean8[6]), "+v"(mean8[7]), "+v"(rstd8[0]), "+v"(rstd8[1]), "+v"(rstd8[2]), "+v"(rstd8[3]), "+v"(rstd8[4]), "+v"(rstd8[5]), "+v"(rstd8[6]), "+v"(rstd8[7]) :: "memory");
        f32x4 gv[2][2], bv[2][2];
#pragma unroll
        for (int bj = 0; bj < 2; ++bj)
#pragma unroll
            for (int n = 0; n < 2; ++n) { gv[bj][n] = (f32x4){1.f, 1.f, 1.f, 1.f}; bv[bj][n] = (f32x4){0.f, 0.f, 0.f, 0.f};
                if (rstats) { gv[bj][n] = *(const f32x4*)(rg + col0 + bj * HALF + 4 * n); bv[bj][n] = *(const f32x4*)(rb + col0 + bj * HALF + 4 * n); }
                gv[bj][n] = gv[bj][n] * al; bv[bj][n] = bv[bj][n] * al; }
#pragma unroll
        for (int am = 0; am < 8; am += NB) {
            f32x4 rr[RES32 ? NB : 1][2][2]; u32x4 rw[NB][2];
#pragma unroll
            for (int e2 = 0; e2 < NB; ++e2) { const size_t off = (size_t)(rowb + ((am + e2) >> 2) * HALF + ((am + e2) & 3) * 16) * ldc + col0;
#pragma unroll
                for (int bj = 0; bj < 2; ++bj) {
                    if constexpr (RES32) { rr[e2][bj][0] = *(const f32x4*)(res32 + off + bj * HALF); rr[e2][bj][1] = *(const f32x4*)(res32 + off + bj * HALF + 4); }
                    else rw[e2][bj] = *(const u32x4*)(res16 + off + bj * HALF); } }
#pragma unroll
            for (int e2 = 0; e2 < NB; ++e2) { const int ai = (am + e2) >> 2, m = (am + e2) & 3; const int row = rowb + ai * HALF + m * 16; const size_t off = (size_t)row * ldc + col0;
                const float mean = mean8[am + e2], rstd = rstd8[am + e2];
                float ps = 0.f, pq = 0.f;
#pragma unroll
                for (int bj = 0; bj < 2; ++bj) {
                    f32x4 r0, r1;
                    if constexpr (RES32) { r0 = rr[e2][bj][0]; r1 = rr[e2][bj][1]; } else { const u32x4 w = rw[e2][bj]; r0 = (f32x4){bflo(w.x), bfhi(w.x), bflo(w.y), bfhi(w.y)}; r1 = (f32x4){bflo(w.z), bfhi(w.z), bflo(w.w), bfhi(w.w)}; }
                    const f32x4 z0 = (r0 - mean) * rstd * gv[bj][0] + bv[bj][0] + acc[ai][bj][m][0] * sa, z1 = (r1 - mean) * rstd * gv[bj][1] + bv[bj][1] + acc[ai][bj][m][1] * sa;
                    u32x4 w16; w16.x = cvt_pk_bf16(z0[0], z0[1]); w16.y = cvt_pk_bf16(z0[2], z0[3]); w16.z = cvt_pk_bf16(z1[0], z1[1]); w16.w = cvt_pk_bf16(z1[2], z1[3]);
                    *(u32x4*)(o16 + off + bj * HALF) = w16;
                    const float q0 = bflo(w16.x), q1 = bfhi(w16.x), q2 = bflo(w16.y), q3 = bfhi(w16.y), q4 = bflo(w16.z), q5 = bfhi(w16.z), q6 = bflo(w16.w), q7 = bfhi(w16.w);
                    ps += ((q0 + q1) + (q2 + q3)) + ((q4 + q5) + (q6 + q7)); pq += ((q0 * q0 + q1 * q1) + (q2 * q2 + q3 * q3)) + ((q4 * q4 + q5 * q5) + (q6 * q6 + q7 * q7));
                    if (o8) *(u32x2*)(o8 + off + bj * HALF) = (u32x2){pk4_fp8(fminf(fmaxf(q0 * o8s, -448.f), 448.f), fminf(fmaxf(q1 * o8s, -448.f), 448.f), fminf(fmaxf(q2 * o8s, -448.f), 448.f), fminf(fmaxf(q3 * o8s, -448.f), 448.f)),
                                                                      pk4_fp8(fminf(fmaxf(q4 * o8s, -448.f), 448.f), fminf(fmaxf(q5 * o8s, -448.f), 448.f), fminf(fmaxf(q6 * o8s, -448.f), 448.f), fminf(fmaxf(q7 * o8s, -448.f), 448.f))}; }
                if (ostats) { ps += __shfl_xor(ps, 16); ps += __shfl_xor(ps, 32); pq += __shfl_xor(pq, 16); pq += __shfl_xor(pq, 32);
                    if (fq == 0) { (void)__hip_atomic_fetch_add(ostats + 2 * (size_t)row, (long long)__builtin_rintf(ps * 1048576.f), __ATOMIC_RELAXED, __HIP_MEMORY_SCOPE_AGENT); (void)__hip_atomic_fetch_add(ostats + 2 * (size_t)row + 1, (long long)__builtin_rintf(pq * 65536.f), __ATOMIC_RELAXED, __HIP_MEMORY_SCOPE_AGENT); } } }
            asm volatile("" ::: "memory"); }
    }
};

typedef int v8i_t __attribute__((ext_vector_type(8)));
typedef int v4i_t __attribute__((ext_vector_type(4)));
template <class Epi, class Sched, bool ALIGN_EPI, bool FP8 = false>
__device__ __forceinline__ void gemm_phase(PG8_LAS unsigned char* lds, const Gemm g, const Sched& S, const Epi& E, const int wid) {
    const int lane = lane_fresh(), tid = wid * 64 + lane, wr = wid >> 2, wc = wid & 3, fr = lane & 15, fq = lane >> 4;
    const int K = g.K, nt = K / BK;
    unsigned voffA[2], voffB[2];
#pragma unroll
    for (int i = 0; i < 2; ++i) { int R, C; stage_rc(tid * 16 + i * 8192, R, C); const int Rb = Epi::PERM ? ((R & ~31) + perm32(R & 31)) : R;
        voffA[i] = (unsigned)(R * g.lda + C) * 2u; voffB[i] = (unsigned)(Rb * g.ldb + C) * 2u; }
    const size_t kstep = (size_t)(BK * 2);
    const size_t hstepA = (size_t)HALF * g.lda * 2, hstepB = (size_t)HALF * g.ldb * 2;
    const size_t tstepA = 2 * hstepA, tstepB = 2 * hstepB;
    const unsigned ldsw = (unsigned)wid * 1024u;
    int aoff = lds_byte(wr * 64 + fr, fq * 8), boff = lds_byte(wc * 32 + fr, fq * 8);
    asm volatile("" : "+v"(voffA[0]), "+v"(voffA[1]), "+v"(voffB[0]), "+v"(voffB[1]), "+v"(aoff), "+v"(boff));
#define PG8_UA(u) ((const char*)g.A + (size_t)(u).pm * tstepA + (size_t)(((u).pn >> g.a_shift) * g.a_mul) * 2)
#define PG8_UB(u) ((const char*)g.Bt + (size_t)(u).pn * tstepB)
#define PG8_SA(b, h) (((b) * 2 + (h)) * HTB)
#define PG8_SB(b, h) ((4 + (b) * 2 + (h)) * HTB)
#define PG8_STAGE(bufoff, gbase, voff) do { _Pragma("unroll") for (int _i = 0; _i < 2; ++_i) \
        __builtin_amdgcn_global_load_lds((const unsigned*)((const char*)(gbase) + (voff)[_i]), (PG8_LAS unsigned*)(lds + (bufoff) + ldsw + _i * 8192), 16, 0, 0); } while (0)
#define PG8_LD8(p_) __builtin_shufflevector(*(const PG8_LAS v4i_t*)(p_), *(const PG8_LAS v4i_t*)((p_) + 1024), 0, 1, 2, 3, 4, 5, 6, 7)
#define PG8_LDA(dst, b, h) do { _Pragma("unroll") for (int m = 0; m < 4; ++m) { if constexpr (FP8) dst##8[m] = PG8_LD8(lds + PG8_SA(b, h) + aoff + m * 2048); else { _Pragma("unroll") for (int k = 0; k < 2; ++k) dst[m][k] = *(const PG8_LAS bf16x8*)(lds + PG8_SA(b, h) + aoff + m * 2048 + k * 1024); } } } while (0)
#define PG8_LDB(dst, b, h) do { _Pragma("unroll") for (int n = 0; n < 2; ++n) { if constexpr (FP8) dst##8[n] = PG8_LD8(lds + PG8_SB(b, h) + boff + n * 2048); else { _Pragma("unroll") for (int k = 0; k < 2; ++k) dst[n][k] = *(const PG8_LAS bf16x8*)(lds + PG8_SB(b, h) + boff + n * 2048 + k * 1024); } } } while (0)
#define PG8_MMA(ai, bj, At, Bt) do { __builtin_amdgcn_s_setprio(1); _Pragma("unroll") for (int m = 0; m < 4; ++m) _Pragma("unroll") for (int n = 0; n < 2; ++n) { \
        if constexpr (FP8) asm volatile("v_mfma_scale_f32_16x16x128_f8f6f4 %0, %1, %2, %0, %3, %3 op_sel_hi:[0,0,0]" : "+v"(acc[ai][bj][m][n]) : "v"(Bt##8[n]), "v"(At##8[m]), "v"(one_scale)); \
        else { _Pragma("unroll") for (int k = 0; k < 2; ++k) acc[ai][bj][m][n] = __builtin_amdgcn_mfma_f32_16x16x32_bf16(Bt[n][k], At[m][k], acc[ai][bj][m][n], 0, 0, 0); } } \
        __builtin_amdgcn_s_setprio(0); } while (0)
#define PG8_WAIT_V(n) asm volatile("s_waitcnt vmcnt(" #n ")" ::: "memory")
#define PG8_WAIT_L(n) asm volatile("s_waitcnt lgkmcnt(" #n ")" ::: "memory")
#define PG8_BAR __builtin_amdgcn_s_barrier()
#define PG8_SCHED __builtin_amdgcn_sched_barrier(0)
    Unit cur, nxt; int ui = 0;
    if (!S.next(0, cur)) return;
    f32x4 acc[2][2][4][2];
#pragma unroll
    for (int a = 0; a < 2; ++a)
#pragma unroll
        for (int b = 0; b < 2; ++b)
#pragma unroll
            for (int m = 0; m < 4; ++m)
#pragma unroll
                for (int n = 0; n < 2; ++n) acc[a][b][m][n] = (f32x4){0.f, 0.f, 0.f, 0.f};
    bf16x8 At[4][2], B0[2][2], B1[2][2]; v8i_t At8[4], B08[2], B18[2];
    int one_scale = 0x7f7f7f7f; asm volatile("" : "+v"(one_scale));
    const char* cA = PG8_UA(cur); const char* cB = PG8_UB(cur);
    S.a_ready(cur);
    PG8_STAGE(PG8_SB(0, 0), cB, voffB); PG8_STAGE(PG8_SB(0, 1), cB + hstepB, voffB); PG8_STAGE(PG8_SA(0, 0), cA, voffA); PG8_STAGE(PG8_SA(0, 1), cA + hstepA, voffA);
    if (wr == 1) PG8_BAR;
    PG8_WAIT_V(2); PG8_BAR;
    PG8_STAGE(PG8_SB(1, 0), cB + kstep, voffB); PG8_STAGE(PG8_SA(1, 0), cA + kstep, voffA); PG8_STAGE(PG8_SB(1, 1), cB + hstepB + kstep, voffB);
    PG8_WAIT_V(6); PG8_BAR;
    for (;;) {
        const bool has_next = S.next(ui + 1, nxt);
        const char* nA = has_next ? PG8_UA(nxt) : cA; const char* nB = has_next ? PG8_UB(nxt) : cB;
        for (int t = 0; t < nt; t += 2) {
            const bool last = (t == nt - 2);
            const char* a1 = cA + (size_t)(t + 1) * kstep;
            const char* a2 = last ? nA : cA + (size_t)(t + 2) * kstep; const char* b2 = last ? nB : cB + (size_t)(t + 2) * kstep;
            const char* a3 = a2 + kstep; const char* b3 = b2 + kstep;
            if (last && has_next) S.a_ready(nxt);
            PG8_LDB(B0, 0, 0); PG8_LDB(B1, 0, 1); PG8_SCHED; PG8_LDA(At, 0, 0); PG8_STAGE(PG8_SA(1, 1), a1 + hstepA, voffA);
            PG8_WAIT_V(8); PG8_WAIT_L(0); PG8_BAR; PG8_MMA(0, 0, At, B0); PG8_MMA(0, 1, At, B1); PG8_BAR; PG8_SCHED;
            PG8_LDA(At, 0, 1); PG8_STAGE(PG8_SB(0, 0), b2, voffB); PG8_STAGE(PG8_SB(0, 1), b2 + hstepB, voffB); PG8_STAGE(PG8_SA(0, 0), a2, voffA);
            PG8_WAIT_V(8); PG8_WAIT_L(0); PG8_BAR; PG8_MMA(1, 0, At, B0); PG8_MMA(1, 1, At, B1); PG8_BAR; PG8_SCHED;
            PG8_LDB(B0, 1, 0); PG8_LDB(B1, 1, 1); PG8_SCHED; PG8_LDA(At, 1, 0); PG8_STAGE(PG8_SA(0, 1), a2 + hstepA, voffA);
            PG8_WAIT_V(8); PG8_WAIT_L(0); PG8_BAR; PG8_MMA(0, 0, At, B0); PG8_MMA(0, 1, At, B1); PG8_BAR; PG8_SCHED;
            PG8_LDA(At, 1, 1); PG8_STAGE(PG8_SB(1, 0), b3, voffB); PG8_STAGE(PG8_SB(1, 1), b3 + hstepB, voffB); PG8_STAGE(PG8_SA(1, 0), a3, voffA);
            PG8_WAIT_V(8); PG8_WAIT_L(0); PG8_BAR; PG8_MMA(1, 0, At, B0); PG8_MMA(1, 1, At, B1); PG8_BAR; PG8_SCHED;
        }
        if constexpr (ALIGN_EPI) { if (wr == 0) PG8_BAR; }
        if constexpr (FP8) asm volatile("s_nop 15\n\ts_nop 7" ::: "memory");
        { const int le = lane_fresh(); E(acc, cur, wr, wc, le & 15, le >> 4); } S.done(cur);
        if (!has_next) break;
#pragma unroll
        for (int a = 0; a < 2; ++a)
#pragma unroll
            for (int b = 0; b < 2; ++b)
#pragma unroll
                for (int m = 0; m < 4; ++m)
#pragma unroll
                    for (int n = 0; n < 2; ++n) acc[a][b][m][n] = (f32x4){0.f, 0.f, 0.f, 0.f};
        cur = nxt; cA = nA; cB = nB; ++ui;
        if constexpr (ALIGN_EPI) { if (wr == 1) PG8_BAR; }
    }
    PG8_WAIT_V(0);
    if constexpr (!ALIGN_EPI) { if (wr == 0) PG8_BAR; }
    PG8_BAR;
#undef PG8_UA
#undef PG8_UB
#undef PG8_SA
#undef PG8_SB
#undef PG8_STAGE
#undef PG8_LDA
#undef PG8_LDB
#undef PG8_MMA
#undef PG8_LD8
#undef PG8_WAIT_V
#undef PG8_WAIT_L
#undef PG8_BAR
#undef PG8_SCHED
}
}

constexpr int NWAVES = 8;
constexpr int BATCH = 4, SEQ = 4096, D = 2048, FF = 5632, M = BATCH * SEQ;
constexpr int N_IN = 5888;
constexpr int MEMT = 256;
constexpr float LN_EPS = 1e-5f;
constexpr float ALPHA = 1.189207115002721f;
constexpr float LAMBDA_INIT = 0.2f;

constexpr size_t MiB = 1u << 20;
constexpr size_t WS_CTL = 0, CTL_ZERO_BYTES = 2 * MiB;
constexpr size_t WS_W_IN = 2 * MiB;
constexpr size_t WS_W_G = 25 * MiB;
constexpr size_t WS_W_UK = 41 * MiB;
constexpr size_t WS_W_UVP = 42 * MiB;
constexpr size_t WS_W_A = 44 * MiB;
constexpr size_t WS_W_B = 48 * MiB;
constexpr size_t WS_W_MO = 52 * MiB;
constexpr size_t WS_W_MQ = 60 * MiB;
constexpr size_t WS_W_MKV = 62 * MiB;
constexpr size_t WS_W_MOUT = 66 * MiB;
constexpr size_t WS_MEM16 = 68 * MiB;
constexpr size_t WS_KVMEM = 72 * MiB;
constexpr size_t WS_W_GU2 = 74 * MiB;
constexpr size_t WS_W_D2 = 96 * MiB;
constexpr size_t WS_X8M = 107 * MiB;
constexpr size_t WS_X16 = 140 * MiB;
constexpr size_t WS_MIX = 204 * MiB;
constexpr size_t WS_W_GU1 = 204 * MiB;
constexpr size_t WS_W_D1 = 248 * MiB;
constexpr size_t WS_H = 270 * MiB;
constexpr size_t WS_AQ = WS_MIX + 0 * MiB, WS_AK = WS_MIX + 32 * MiB, WS_AV = WS_MIX + 64 * MiB, WS_BQ = WS_MIX + 96 * MiB;
constexpr size_t WS_BC = WS_MIX + 128 * MiB;
constexpr size_t WS_IQ = WS_MIX + 144 * MiB;
constexpr size_t WS_IKW = WS_MIX + 176 * MiB;
constexpr size_t WS_QLAT = WS_MIX + 184 * MiB;
constexpr size_t WS_IDX = WS_MIX + 312 * MiB;
constexpr size_t WS_YB = WS_BQ;
constexpr size_t WS_TA = WS_QLAT, WS_TB = WS_QLAT + 64 * MiB;
constexpr size_t WS_QM = WS_AQ, WS_OM = WS_AQ + 16 * MiB;
constexpr size_t WS_X8 = WS_H + 96 * MiB;
constexpr size_t WS_C8 = WS_W_IN;
constexpr size_t WS_MRG8 = WS_AV;
constexpr float FP8_WGS = 1024.f, FP8_MS = 32.f, FP8_WMOS = 2048.f;
constexpr float FP8_XS = 32.f, FP8_WGUS = 1024.f, FP8_HS = 8.f, FP8_WDS = 4096.f;
constexpr size_t WS_END = WS_MIX + 320 * MiB;
static_assert(WS_H + (size_t)M * FF * 2 <= WS_END && WS_QLAT + (size_t)M * 4096 * 2 <= WS_END, "d_ws map");
constexpr int CW_BAR = 4096;
constexpr int CW_DQ = 8192;
constexpr int CW_KMAX = 8256;
constexpr size_t CTL_STATS = 65536, CTL_STATS_STRIDE = (size_t)M * 2 * 8;
constexpr size_t CTL_VEC = CTL_STATS + 3 * CTL_STATS_STRIDE;
constexpr int V_GW_IN = 0, V_BW_IN = 5888, V_GW_G = 11776, V_BW_G = 15872, V_GW_MQ = 19968, V_BW_MQ = 20480, V_GW_GU2 = 20992, V_BW_GU2 = 32256, V_END = 43520;
constexpr size_t CTL_VECF = CTL_VEC + (size_t)V_END * 8;
static_assert(CTL_VECF + (size_t)V_END * 4 <= CTL_ZERO_BYTES, "control region");
constexpr float FX_S = 1048576.f, FX_Q = 65536.f, FX_V = 16777216.f;

constexpr int RING_OFF = 0, RING_BYTES = 153600;
constexpr int LDSCTL_OFF = RING_BYTES, MISC_OFF = LDSCTL_OFF + 320;
constexpr int LDS_BYTES = 154624;
static_assert(MISC_OFF + 128 <= LDS_BYTES, "LDS map");

#define GAS __attribute__((address_space(1)))
#define LAS __attribute__((address_space(3)))
typedef unsigned short bf16;
typedef unsigned v4u __attribute__((ext_vector_type(4)));
typedef unsigned v2u __attribute__((ext_vector_type(2)));
typedef float f32x4 __attribute__((ext_vector_type(4)));
typedef float f32x16 __attribute__((ext_vector_type(16)));
typedef short bf16x8 __attribute__((ext_vector_type(8)));
typedef GAS unsigned gu32;
#define RLX_AGENT __ATOMIC_RELAXED, __HIP_MEMORY_SCOPE_AGENT
#define LDS_WAIT() asm volatile("s_waitcnt lgkmcnt(0)" ::: "memory")
#define VM_WAIT() asm volatile("s_waitcnt vmcnt(0)" ::: "memory")
__device__ __forceinline__ unsigned f2bf(float f) { unsigned u = __builtin_bit_cast(unsigned, f); return (u + 0x7fffu + ((u >> 16) & 1u)) >> 16; }
__device__ __forceinline__ unsigned pk2(float lo, float hi) { return f2bf(lo) | (f2bf(hi) << 16); }
__device__ __forceinline__ float bf2f(unsigned short v) { return __uint_as_float((unsigned)v << 16); }
__device__ __forceinline__ float blo(unsigned w) { return __uint_as_float(w << 16); }
__device__ __forceinline__ float bhi(unsigned w) { return __uint_as_float(w & 0xffff0000u); }
__device__ __forceinline__ float wave_sum(float v) {
    v += __builtin_bit_cast(float, __builtin_amdgcn_update_dpp(0, __builtin_bit_cast(int, v), 0xB1, 0xf, 0xf, true));
    v += __builtin_bit_cast(float, __builtin_amdgcn_update_dpp(0, __builtin_bit_cast(int, v), 0x4E, 0xf, 0xf, true));
    v += __builtin_bit_cast(float, __builtin_amdgcn_update_dpp(0, __builtin_bit_cast(int, v), 0x141, 0xf, 0xf, true));
    v += __builtin_bit_cast(float, __builtin_amdgcn_update_dpp(0, __builtin_bit_cast(int, v), 0x140, 0xf, 0xf, true));
    { const auto rr = __builtin_amdgcn_permlane16_swap(__float_as_uint(v), __float_as_uint(v), false, false); v = __uint_as_float(rr[0]) + __uint_as_float(rr[1]); }
    { const auto rr = __builtin_amdgcn_permlane32_swap(__float_as_uint(v), __float_as_uint(v), false, false); v = __uint_as_float(rr[0]) + __uint_as_float(rr[1]); }
    return v;
}

__device__ __forceinline__ float xhalf_add(float a) { const auto rr = __builtin_amdgcn_permlane32_swap(__float_as_uint(a), __float_as_uint(a), false, false); return __uint_as_float(rr[0]) + __uint_as_float(rr[1]); }
__device__ __forceinline__ float xhalf_max(float a) { const auto rr = __builtin_amdgcn_permlane32_swap(__float_as_uint(a), __float_as_uint(a), false, false); return fmaxf(__uint_as_float(rr[0]), __uint_as_float(rr[1])); }
__device__ __forceinline__ int half_sum_i32(int v) {
    v += __builtin_amdgcn_update_dpp(0, v, 0xB1, 0xf, 0xf, true);
    v += __builtin_amdgcn_update_dpp(0, v, 0x4E, 0xf, 0xf, true);
    v += __builtin_amdgcn_update_dpp(0, v, 0x141, 0xf, 0xf, true);
    v += __builtin_amdgcn_update_dpp(0, v, 0x140, 0xf, 0xf, true);
    const auto rr = __builtin_amdgcn_permlane16_swap((unsigned)v, (unsigned)v, false, false); return (int)rr[0] + (int)rr[1];
}
#define XB_TMO      128
#define XB_XCNT(j)  (256  + 64 * (j))
#define XB_XSUB(j)  (1280 + 64 * (j))
#define XB_XGEN(j)  (2304 + 64 * (j))
#define XB_TOP      3328
#define XB_TOPGEN   3392
#define XCD_BAR_WORDS 3456
#define XB_SPIN_CAP (1u << 18)

__device__ __forceinline__ unsigned xb_ld(unsigned* p)              { return __hip_atomic_load(p, __ATOMIC_RELAXED, __HIP_MEMORY_SCOPE_AGENT); }
__device__ __forceinline__ unsigned xb_add(unsigned* p, unsigned v) { return __hip_atomic_fetch_add(p, v, __ATOMIC_RELAXED, __HIP_MEMORY_SCOPE_AGENT); }
__device__ __forceinline__ unsigned xb_xcc_id() { return (unsigned)__builtin_amdgcn_s_getreg((3 << 11) | 20) & 0xFu; }
#define XB_SPIN(cond, bar) do { unsigned _sp = 0; while (cond) { __builtin_amdgcn_s_sleep(1); \
    if ((++_sp & 255u) == 0u) { if (xb_ld(&(bar)[XB_TMO])) break; if (_sp > XB_SPIN_CAP) { atomicAdd(&(bar)[XB_TMO], 1u); break; } } } } while (0)

struct XcdBarrier {
    unsigned* bar; unsigned x;
    volatile LAS unsigned* st;
};

__device__ __forceinline__ XcdBarrier xcd_barrier_post(unsigned* bar, volatile LAS unsigned* st, bool t0) {
    XcdBarrier b; b.bar = bar; b.x = xb_xcc_id(); b.st = st;
    if (t0) st[2] = xb_add(&bar[XB_XCNT(b.x)], 1u);
    return b;
}
__device__ __forceinline__ void xcd_barrier_complete(unsigned* bar, unsigned x, unsigned& nloc, unsigned& nx) {
    const unsigned G = gridDim.x * gridDim.y * gridDim.z;
    unsigned sum, cnt, mine, sp = 0u;
    for (;;) {
        sum = 0u; cnt = 0u; mine = 0u;
#pragma unroll
        for (unsigned j = 0; j < 16; ++j) { const unsigned c = xb_ld(&bar[XB_XCNT(j)]); sum += c; cnt += (c > 0u) ? 1u : 0u; mine = (j == x) ? c : mine; }
        if (sum == G) break;
        __builtin_amdgcn_s_sleep(1);
        if ((++sp & 255u) == 0u) { if (xb_ld(&bar[XB_TMO])) break; if (sp > XB_SPIN_CAP) { atomicAdd(&bar[XB_TMO], 1u); break; } }
    }
    nloc = mine > 0u ? mine : 1u; nx = cnt > 0u ? cnt : 1u;
}

__device__ __forceinline__ void xcd_barrier(const XcdBarrier& b, const int wave) {
    asm volatile("s_waitcnt vmcnt(0)" ::: "memory");
    __syncthreads();
    if (wave == 0 && lane_fresh() == 0) {
        unsigned* bar = b.bar;
        __builtin_amdgcn_s_waitcnt(0);
        unsigned nloc = b.st[0], nx = b.st[1];
        if (nloc == 0u) { xcd_barrier_complete(bar, b.x, nloc, nx); b.st[0] = nloc; b.st[1] = nx; }
        const unsigned old = xb_add(&bar[XB_XSUB(b.x)], 1u);
        const unsigned gen = old / nloc;
        if (old + 1u == (gen + 1u) * nloc) {
            __builtin_amdgcn_fence(__ATOMIC_RELEASE, "agent");
            asm volatile("s_waitcnt vmcnt(0)" ::: "memory");
            const unsigned og = xb_add(&bar[XB_TOP], 1u);
            const unsigned tg = og / nx;
            if (og + 1u == (tg + 1u) * nx) xb_add(&bar[XB_TOPGEN], 1u);
            else XB_SPIN(xb_ld(&bar[XB_TOPGEN]) == tg, bar);
            __builtin_amdgcn_fence(__ATOMIC_ACQUIRE, "agent");
            xb_add(&bar[XB_XGEN(b.x)], 1u);
            asm volatile("s_waitcnt vmcnt(0)" ::: "memory");
        } else {
            XB_SPIN(xb_ld(&bar[XB_XGEN(b.x)]) == gen, bar);
            __builtin_amdgcn_fence(__ATOMIC_ACQUIRE, "agent");
            asm volatile("s_waitcnt vmcnt(0)" ::: "memory");
        }
    }
    __syncthreads();
}

__device__ __forceinline__ void tr_item(const float* W, int ldw, int nvalid, bf16* WT, int ldt, int k0, int n0, int drow0, int dcol0, LAS float* scr, int lane) {
    { const int n4 = 4 * (lane & 7), kr = lane >> 3; const bool ok = n0 + n4 < nvalid;
#pragma unroll
      for (int i = 0; i < 8; ++i) { const int kk = 8 * i + kr; const f32x4 v = ok ? *(const GAS f32x4*)(W + (size_t)(k0 + kk) * ldw + n0 + n4) : (f32x4){0.f, 0.f, 0.f, 0.f};
          LAS float* d = scr + kk * 33 + n4; d[0] = v.x; d[1] = v.y; d[2] = v.z; d[3] = v.w; } }
    LDS_WAIT(); asm volatile("" ::: "memory");
    const int c = lane & 7;
#pragma unroll
    for (int j = 0; j < 4; ++j) { const int nn = (lane >> 3) + 8 * j; const LAS float* s = scr + (8 * c) * 33 + nn;
        v4u o; o.x = pk2(s[0 * 33], s[1 * 33]); o.y = pk2(s[2 * 33], s[3 * 33]); o.z = pk2(s[4 * 33], s[5 * 33]); o.w = pk2(s[6 * 33], s[7 * 33]);
        *(GAS v4u*)(WT + (size_t)(drow0 + nn) * ldt + dcol0 + k0 + 8 * c) = o; }
    LDS_WAIT(); asm volatile("" ::: "memory");
}
__device__ __forceinline__ void tr_item8(const float* W, int ldw, unsigned char* WT, int ldt, int k0, int n0, int drow0, float sc, LAS float* scr, int lane) {
    { const int n4 = 4 * (lane & 7), kr = lane >> 3;
#pragma unroll
      for (int i = 0; i < 8; ++i) { const int kk = 8 * i + kr; const f32x4 v = *(const GAS f32x4*)(W + (size_t)(k0 + kk) * ldw + n0 + n4);
          LAS float* d = scr + kk * 33 + n4; d[0] = v.x; d[1] = v.y; d[2] = v.z; d[3] = v.w; } }
    LDS_WAIT(); asm volatile("" ::: "memory");
    const int nn = lane >> 1, hf = lane & 1; const LAS float* sp = scr + (32 * hf) * 33 + nn;
    unsigned o[8];
#pragma unroll
    for (int q = 0; q < 8; ++q) { const float a = fminf(fmaxf(sp[(4 * q + 0) * 33] * sc, -448.f), 448.f), b = fminf(fmaxf(sp[(4 * q + 1) * 33] * sc, -448.f), 448.f), c = fminf(fmaxf(sp[(4 * q + 2) * 33] * sc, -448.f), 448.f), d = fminf(fmaxf(sp[(4 * q + 3) * 33] * sc, -448.f), 448.f);
        int w = 0; w = __builtin_amdgcn_cvt_pk_fp8_f32(a, b, w, false); w = __builtin_amdgcn_cvt_pk_fp8_f32(c, d, w, true); o[q] = (unsigned)w; }
    GAS v4u* dst = (GAS v4u*)(WT + (size_t)(drow0 + nn) * ldt + k0 + 32 * hf);
    dst[0] = (v4u){o[0], o[1], o[2], o[3]}; dst[1] = (v4u){o[4], o[5], o[6], o[7]};
    LDS_WAIT(); asm volatile("" ::: "memory");
}
__device__ __forceinline__ void tr_item_ln(const float* W, int ldw, int nvalid, bf16* WT, int ldt, int k0, int n0, int drow0, const float* gain, const float* bvec, long long* gW, long long* bW, LAS float* scr, int lane) {
    { const int n4 = 4 * (lane & 7), kr = lane >> 3; const bool ok = n0 + n4 < nvalid;
#pragma unroll
      for (int i = 0; i < 8; ++i) { const int kk = 8 * i + kr; const f32x4 v = ok ? *(const GAS f32x4*)(W + (size_t)(k0 + kk) * ldw + n0 + n4) : (f32x4){0.f, 0.f, 0.f, 0.f};
          LAS float* d = scr + kk * 33 + n4; d[0] = v.x; d[1] = v.y; d[2] = v.z; d[3] = v.w; } }
    LDS_WAIT(); asm volatile("" ::: "memory");
    const int c = lane & 7;
    const f32x4 g0 = *(const GAS f32x4*)(gain + k0 + 8 * c), g1 = *(const GAS f32x4*)(gain + k0 + 8 * c + 4), b0 = *(const GAS f32x4*)(bvec + k0 + 8 * c), b1 = *(const GAS f32x4*)(bvec + k0 + 8 * c + 4);
    const float gk[8] = {g0.x, g0.y, g0.z, g0.w, g1.x, g1.y, g1.z, g1.w}, bk[8] = {b0.x, b0.y, b0.z, b0.w, b1.x, b1.y, b1.z, b1.w};
#pragma unroll
    for (int j = 0; j < 4; ++j) { const int nn = (lane >> 3) + 8 * j; const LAS float* sp = scr + (8 * c) * 33 + nn;
        float v[8], bs = 0.f;
#pragma unroll
        for (int i = 0; i < 8; ++i) { const float raw = sp[i * 33]; v[i] = raw * gk[i]; bs += raw * bk[i]; }
        v4u o; o.x = pk2(v[0], v[1]); o.y = pk2(v[2], v[3]); o.z = pk2(v[4], v[5]); o.w = pk2(v[6], v[7]);
        float gs = ((blo(o.x) + bhi(o.x)) + (blo(o.y) + bhi(o.y))) + ((blo(o.z) + bhi(o.z)) + (blo(o.w) + bhi(o.w)));
        *(GAS v4u*)(WT + (size_t)(drow0 + nn) * ldt + k0 + 8 * c) = o;
        gs += __shfl_xor(gs, 1); gs += __shfl_xor(gs, 2); gs += __shfl_xor(gs, 4); bs += __shfl_xor(bs, 1); bs += __shfl_xor(bs, 2); bs += __shfl_xor(bs, 4);
        if (c == 0) { (void)__hip_atomic_fetch_add(gW + drow0 + nn, (long long)__builtin_rintf(gs * FX_V), __ATOMIC_RELAXED, __HIP_MEMORY_SCOPE_AGENT); (void)__hip_atomic_fetch_add(bW + drow0 + nn, (long long)__builtin_rintf(bs * FX_V), __ATOMIC_RELAXED, __HIP_MEMORY_SCOPE_AGENT); } }
    LDS_WAIT(); asm volatile("" ::: "memory");
}
__device__ __forceinline__ void tr_item8_ln(const float* W, int ldw, unsigned char* WT, int ldt, int k0, int n0, int drow0, float sc, const float* gain, const float* bvec, long long* gW, long long* bW, LAS float* scr, int lane) {
    { const int n4 = 4 * (lane & 7), kr = lane >> 3;
#pragma unroll
      for (int i = 0; i < 8; ++i) { const int kk = 8 * i + kr; const f32x4 v = *(const GAS f32x4*)(W + (size_t)(k0 + kk) * ldw + n0 + n4);
          LAS float* d = scr + kk * 33 + n4; d[0] = v.x; d[1] = v.y; d[2] = v.z; d[3] = v.w; } }
    LDS_WAIT(); asm volatile("" ::: "memory");
    const int nn = lane >> 1, hf = lane & 1; const LAS float* sp = scr + (32 * hf) * 33 + nn;
    unsigned o[8]; float gs = 0.f, bs = 0.f;
#pragma unroll
    for (int q = 0; q < 8; ++q) { const f32x4 g4 = *(const GAS f32x4*)(gain + k0 + 32 * hf + 4 * q), b4 = *(const GAS f32x4*)(bvec + k0 + 32 * hf + 4 * q);
        const float r0 = sp[(4 * q + 0) * 33], r1 = sp[(4 * q + 1) * 33], r2 = sp[(4 * q + 2) * 33], r3 = sp[(4 * q + 3) * 33];
        bs += (r0 * b4.x + r1 * b4.y) + (r2 * b4.z + r3 * b4.w);
        const float a = fminf(fmaxf(r0 * g4.x * sc, -448.f), 448.f), b = fminf(fmaxf(r1 * g4.y * sc, -448.f), 448.f), c = fminf(fmaxf(r2 * g4.z * sc, -448.f), 448.f), d = fminf(fmaxf(r3 * g4.w * sc, -448.f), 448.f);
        int w = 0; w = __builtin_amdgcn_cvt_pk_fp8_f32(a, b, w, false); w = __builtin_amdgcn_cvt_pk_fp8_f32(c, d, w, true); o[q] = (unsigned)w;
        gs += (__builtin_amdgcn_cvt_f32_fp8(w, 0) + __builtin_amdgcn_cvt_f32_fp8(w, 1)) + (__builtin_amdgcn_cvt_f32_fp8(w, 2) + __builtin_amdgcn_cvt_f32_fp8(w, 3)); }
    GAS v4u* dst = (GAS v4u*)(WT + (size_t)(drow0 + nn) * ldt + k0 + 32 * hf);
    dst[0] = (v4u){o[0], o[1], o[2], o[3]}; dst[1] = (v4u){o[4], o[5], o[6], o[7]};
    gs += __shfl_xor(gs, 1); bs += __shfl_xor(bs, 1);
    if (hf == 0) { (void)__hip_atomic_fetch_add(gW + drow0 + nn, (long long)__builtin_rintf(gs / sc * FX_V), __ATOMIC_RELAXED, __HIP_MEMORY_SCOPE_AGENT); (void)__hip_atomic_fetch_add(bW + drow0 + nn, (long long)__builtin_rintf(bs * FX_V), __ATOMIC_RELAXED, __HIP_MEMORY_SCOPE_AGENT); }
    LDS_WAIT(); asm volatile("" ::: "memory");
}
__device__ __forceinline__ void cvt_item8(const float* src, unsigned char* dst, int item, int lane, float sc) {
    const GAS f32x4* sp = (const GAS f32x4*)(src + (size_t)item * 512) + 2 * lane; f32x4 a = sp[0] * sc, b = sp[1] * sc;
    int w0 = 0, w1 = 0; w0 = __builtin_amdgcn_cvt_pk_fp8_f32(fminf(fmaxf(a.x, -448.f), 448.f), fminf(fmaxf(a.y, -448.f), 448.f), w0, false); w0 = __builtin_amdgcn_cvt_pk_fp8_f32(fminf(fmaxf(a.z, -448.f), 448.f), fminf(fmaxf(a.w, -448.f), 448.f), w0, true);
    w1 = __builtin_amdgcn_cvt_pk_fp8_f32(fminf(fmaxf(b.x, -448.f), 448.f), fminf(fmaxf(b.y, -448.f), 448.f), w1, false); w1 = __builtin_amdgcn_cvt_pk_fp8_f32(fminf(fmaxf(b.z, -448.f), 448.f), fminf(fmaxf(b.w, -448.f), 448.f), w1, true);
    *((GAS v2u*)(dst + (size_t)item * 512) + lane) = (v2u){(unsigned)w0, (unsigned)w1};
}
__device__ __forceinline__ void cvt_item(const float* src, bf16* dst, int item, int lane) {
    const GAS f32x4* s = (const GAS f32x4*)(src + (size_t)item * 512) + 2 * lane; const f32x4 a = s[0], b = s[1];
    v4u o; o.x = pk2(a.x, a.y); o.y = pk2(a.z, a.w); o.z = pk2(b.x, b.y); o.w = pk2(b.z, b.w);
    *((GAS v4u*)(dst + (size_t)item * 512) + lane) = o;
}
__device__ __forceinline__ void p0_prologue(const float* const (&in)[24], unsigned char* ws, LAS unsigned char* lds, int gw, int NGW, int wave, int lane) {
    LAS float* scr = (LAS float*)(lds + RING_OFF + wave * 16384);
#define TRM(SRC, Kk, LDW, NVALID, NPAD, DST, LDT, ROWMAP, DCOL) { constexpr int nblk = (NPAD) / 32; constexpr int cnt = ((Kk) / 64) * nblk; \
        if (r < cnt) { const int kb = r / nblk, nb = r % nblk, n0 = 32 * nb; tr_item(SRC, LDW, NVALID, (bf16*)(ws + (DST)), LDT, 64 * kb, n0, (ROWMAP), (DCOL), scr, lane); continue; } r -= cnt; }
#define TRM8(SRC, Kk, LDW, NN, DST, LDT, ROWMAP, SC) { constexpr int nblk = (NN) / 32; constexpr int cnt = ((Kk) / 64) * nblk; \
        if (r < cnt) { const int kb = r / nblk, nb = r % nblk, n0 = 32 * nb; tr_item8(SRC, LDW, (unsigned char*)(ws + (DST)), LDT, 64 * kb, n0, (ROWMAP), SC, scr, lane); continue; } r -= cnt; }
    long long* const vec = (long long*)(ws + WS_CTL + CTL_VEC);
#define TRML(SRC, Kk, LDW, NVALID, NPAD, DST, LDT, ROWMAP, GAIN, BVEC, VG, VB) { constexpr int nblk = (NPAD) / 32; constexpr int cnt = ((Kk) / 64) * nblk; \
        if (r < cnt) { const int kb = r / nblk, nb = r % nblk, n0 = 32 * nb; tr_item_ln(SRC, LDW, NVALID, (bf16*)(ws + (DST)), LDT, 64 * kb, n0, (ROWMAP), GAIN, BVEC, vec + (VG), vec + (VB), scr, lane); continue; } r -= cnt; }
#define TRML8(SRC, Kk, LDW, NN, DST, LDT, ROWMAP, SC, GAIN, BVEC, VG, VB) { constexpr int nblk = (NN) / 32; constexpr int cnt = ((Kk) / 64) * nblk; \
        if (r < cnt) { const int kb = r / nblk, nb = r % nblk, n0 = 32 * nb; tr_item8_ln(SRC, LDW, (unsigned char*)(ws + (DST)), LDT, 64 * kb, n0, (ROWMAP), SC, GAIN, BVEC, vec + (VG), vec + (VB), scr, lane); continue; } r -= cnt; }
    constexpr int N_TR = 2 * (32 * 176) + 88 * 64 + 32 * 184 + 2 * (32 * 64) + 256 + 2 * (16 * 64) + 32 * 64 + 32 * 16 + 32 * 32 + 8 * 64 + 2 * (32 * 176) + 88 * 64;
    for (int it = gw; it < N_TR; it += NGW) {
        int r = it;
        TRM8(in[2], 2048, 5632, 5632, WS_W_GU1, 2048, 256 * (n0 >> 7) + (n0 & 127), FP8_WGUS)
        TRM8(in[3], 2048, 5632, 5632, WS_W_GU1, 2048, 256 * (n0 >> 7) + 128 + (n0 & 127), FP8_WGUS)
        TRM8(in[4], 5632, 2048, 2048, WS_W_D1, 5632, n0, FP8_WDS)
        TRML(in[5], 2048, 5712, 5712, 5888, WS_W_IN, 2048, n0, in[22], in[23], V_GW_IN, V_BW_IN)
        TRML8(in[11], 2048, 2048, 2048, WS_W_G, 2048, 256 * (n0 >> 7) + (n0 & 127), FP8_WGS, in[22], in[23], V_GW_G, V_BW_G)
        TRML8(in[11] + (size_t)2048 * 2048, 2048, 2048, 2048, WS_W_G, 2048, 256 * (n0 >> 7) + 128 + (n0 & 127), FP8_WGS, in[22], in[23], V_GW_G, V_BW_G)
        if (r < 256) { const int h = r >> 5, rr = r & 31, kb = rr >> 2, nb = rr & 3;
            tr_item(in[10] + (size_t)h * 512 * 128, 128, 128, (bf16*)(ws + WS_W_UVP), 1024, 64 * kb, 32 * nb, (h >> 1) * 256 + (h & 1) * 128 + 32 * nb, (h & 1) * 512, scr, lane); continue; } r -= 256;
        TRM(in[13], 1024, 2048, 2048, 2048, WS_W_A, 1024, n0, 0)
        TRM(in[14], 1024, 2048, 2048, 2048, WS_W_B, 1024, n0, 0)
        TRM8(in[15], 2048, 2048, 2048, WS_W_MO, 2048, n0, FP8_WMOS)
        TRML(in[16], 2048, 512, 512, 512, WS_W_MQ, 2048, n0, in[22] + D, in[23] + D, V_GW_MQ, V_BW_MQ)
        TRM(in[17], 2048, 1024, 1024, 1024, WS_W_MKV, 2048, n0, 0)
        TRM(in[18], 512, 2048, 2048, 2048, WS_W_MOUT, 512, n0, 0)
        TRML8(in[19], 2048, 5632, 5632, WS_W_GU2, 2048, 256 * (n0 >> 7) + (n0 & 127), FP8_WGUS, in[22] + 2 * D, in[23] + 2 * D, V_GW_GU2, V_BW_GU2)
        TRML8(in[20], 2048, 5632, 5632, WS_W_GU2, 2048, 256 * (n0 >> 7) + 128 + (n0 & 127), FP8_WGUS, in[22] + 2 * D, in[23] + 2 * D, V_GW_GU2, V_BW_GU2)
        TRM8(in[21], 5632, 2048, 2048, WS_W_D2, 5632, n0, FP8_WDS)
    }
#undef TRM
#undef TRM8
#undef TRML
#undef TRML8
    for (int rw = gw; rw < 1024; rw += NGW) { const int e = (rw >> 7) & 1; *((GAS v4u*)((bf16*)(ws + WS_W_UVP) + (size_t)rw * 1024 + (1 - e) * 512) + lane) = (v4u){0u, 0u, 0u, 0u}; }
    for (int it = gw; it < (M * D) / 512; it += NGW) cvt_item8(in[0], (unsigned char*)(ws + WS_X8), it, lane, FP8_XS);
    for (int it = gw; it < (BATCH * MEMT * D) / 512; it += NGW) cvt_item(in[1], (bf16*)(ws + WS_MEM16), it, lane);
    for (int it = gw; it < (8 * 512 * 128) / 512; it += NGW) cvt_item(in[9], (bf16*)(ws + WS_W_UK), it, lane);
}

__device__ __forceinline__ void ln_phase(float* zx, bf16* x16, unsigned char* x8, const float* g, const float* b, int gw, int NGW, int lane) {
    f32x4 gv[8], bv[8];
#pragma unroll
    for (int j = 0; j < 8; ++j) { gv[j] = *((const GAS f32x4*)g + lane + 64 * j); bv[j] = *((const GAS f32x4*)b + lane + 64 * j); }
    for (int m = gw; m < M; m += NGW) {
        GAS f32x4* xr = (GAS f32x4*)(zx + (size_t)m * D) + lane;
        f32x4 v[8]; float s = 0.f;
#pragma unroll
        for (int j = 0; j < 8; ++j) { v[j] = xr[64 * j]; s += (v[j].x + v[j].y) + (v[j].z + v[j].w); }
        const float mean = wave_sum(s) * (1.f / D); float s2 = 0.f;
#pragma unroll
        for (int j = 0; j < 8; ++j) { v[j] = v[j] - mean; s2 += (v[j].x * v[j].x + v[j].y * v[j].y) + (v[j].z * v[j].z + v[j].w * v[j].w); }
        const float rstd = 1.f / sqrtf(wave_sum(s2) * (1.f / D) + LN_EPS);
#pragma unroll
        for (int j = 0; j < 8; ++j) { v[j] = v[j] * rstd * gv[j] + bv[j]; xr[64 * j] = v[j]; }
        if (x16) { GAS v2u* o8 = (GAS v2u*)(x16 + (size_t)m * D) + lane;
#pragma unroll
            for (int j = 0; j < 8; ++j) o8[64 * j] = (v2u){pk2(v[j].x, v[j].y), pk2(v[j].z, v[j].w)}; }
        if (x8) { GAS unsigned* o4 = (GAS unsigned*)(x8 + (size_t)m * D) + lane;
#pragma unroll
            for (int j = 0; j < 8; ++j) { const f32x4 q = v[j] * FP8_XS; int w = 0; w = __builtin_amdgcn_cvt_pk_fp8_f32(fminf(fmaxf(q.x, -448.f), 448.f), fminf(fmaxf(q.y, -448.f), 448.f), w, false);
                w = __builtin_amdgcn_cvt_pk_fp8_f32(fminf(fmaxf(q.z, -448.f), 448.f), fminf(fmaxf(q.w, -448.f), 448.f), w, true); o4[64 * j] = (unsigned)w; } }
    }
}
__device__ __forceinline__ void ln_final_phase(const bf16* z16, float* outp, const float* g, const float* b, int gw, int NGW, int lane) {
    for (int m0 = gw; m0 < M; m0 += 2 * NGW) {
        const int m1 = m0 + NGW; const bool two = m1 < M;
        v4u w[2][4];
#pragma unroll
        for (int j = 0; j < 4; ++j) { w[0][j] = __builtin_nontemporal_load((const GAS v4u*)(z16 + (size_t)m0 * D) + lane + 64 * j); w[1][j] = two ? __builtin_nontemporal_load((const GAS v4u*)(z16 + (size_t)m1 * D) + lane + 64 * j) : (v4u){0u, 0u, 0u, 0u}; }
#pragma unroll
        for (int rr = 0; rr < 2; ++rr) { if (rr == 1 && !two) break;
            const int m = rr ? m1 : m0;
            float v[32]; float s = 0.f;
#pragma unroll
            for (int j = 0; j < 4; ++j) { const v4u x = w[rr][j]; v[8 * j + 0] = blo(x.x); v[8 * j + 1] = bhi(x.x); v[8 * j + 2] = blo(x.y); v[8 * j + 3] = bhi(x.y); v[8 * j + 4] = blo(x.z); v[8 * j + 5] = bhi(x.z); v[8 * j + 6] = blo(x.w); v[8 * j + 7] = bhi(x.w); }
#pragma unroll
            for (int e = 0; e < 32; ++e) s += v[e];
            const float mean = wave_sum(s) * (1.f / D); float s2 = 0.f;
#pragma unroll
            for (int e = 0; e < 32; ++e) { v[e] -= mean; s2 += v[e] * v[e]; }
            const float rstd = 1.f / sqrtf(wave_sum(s2) * (1.f / D) + LN_EPS);
#pragma unroll
            for (int j = 0; j < 4; ++j) { const int c0 = 512 * j + 8 * lane;
                const f32x4 g0 = *(const GAS f32x4*)(g + c0), g1 = *(const GAS f32x4*)(g + c0 + 4), b0 = *(const GAS f32x4*)(b + c0), b1 = *(const GAS f32x4*)(b + c0 + 4);
                GAS f32x4* o = (GAS f32x4*)(outp + (size_t)m * D + c0);
                __builtin_nontemporal_store((f32x4){v[8 * j + 0], v[8 * j + 1], v[8 * j + 2], v[8 * j + 3]} * rstd * g0 + b0, o); __builtin_nontemporal_store((f32x4){v[8 * j + 4], v[8 * j + 5], v[8 * j + 6], v[8 * j + 7]} * rstd * g1 + b1, o + 1); } }
    }
}
__device__ __forceinline__ void crms_phase(const bf16* bc, unsigned char* c8, const float* kvg, float cs, int gw, int NGW, int lane) {
    float gg[8];
#pragma unroll
    for (int j = 0; j < 8; ++j) gg[j] = kvg[8 * lane + j] * cs;
    for (int m = gw; m < M; m += NGW) {
        const v4u w = *((const GAS v4u*)(bc + (size_t)m * 512) + lane);
        float x[8] = {blo(w.x), bhi(w.x), blo(w.y), bhi(w.y), blo(w.z), bhi(w.z), blo(w.w), bhi(w.w)}; float s = 0.f;
#pragma unroll
        for (int j = 0; j < 8; ++j) s += x[j] * x[j];
        const float r = 1.f / sqrtf(wave_sum(s) * (1.f / 512.f) + LN_EPS);
#pragma unroll
        for (int j = 0; j < 8; ++j) x[j] = fminf(fmaxf(x[j] * r * gg[j], -448.f), 448.f);
        *((GAS v2u*)(c8 + (size_t)m * 512) + lane) = (v2u){pg8::pk4_fp8(x[0], x[1], x[2], x[3]), pg8::pk4_fp8(x[4], x[5], x[6], x[7])};
    }
}
typedef short v4i16_t __attribute__((ext_vector_type(4)));
__device__ __forceinline__ v4i16_t lds_tr16(const LAS unsigned char* p) { return __builtin_amdgcn_ds_read_tr16_b64_v4i16((LAS v4i16_t*)p); }
__device__ __forceinline__ unsigned cvtpk(float lo, float hi) { typedef float f2 __attribute__((ext_vector_type(2))); typedef __bf16 b2 __attribute__((ext_vector_type(2))); f2 v = {lo, hi}; b2 b = __builtin_convertvector(v, b2); return __builtin_bit_cast(unsigned, b); }
__device__ __forceinline__ float xhalf_f(float v) { return __shfl_xor(v, 32); }
constexpr float LOG2E = 1.4426950408889634f;
constexpr float QSCALE = 0.125f * LOG2E;

__device__ __forceinline__ void diff_attn_mfma(LAS unsigned char* lds, const bf16* AQ, const bf16* AK, const bf16* AV, bf16* YA, const float* dlam, const float* subg, unsigned* dq, const unsigned* kmax, const int wave) {
    const int lane = lane_fresh(), r32 = lane & 31, hi = lane >> 5;
    const int comp = wave >> 2, wq = wave & 3;
    const unsigned ksrc = (unsigned)(lane * 1024 + (2 * wave) * 8);
    const unsigned vsrc0 = (unsigned)((16 * ((2 * wave) & 3) + (lane >> 2)) * 1024 + ((2 * wave) >> 2) * 32 + (lane & 3) * 8);
    const unsigned vsrc1 = (unsigned)((16 * ((2 * wave + 1) & 3) + (lane >> 2)) * 1024 + ((2 * wave + 1) >> 2) * 32 + (lane & 3) * 8);
    const unsigned kdst = (unsigned)(2 * wave) * 1024u, vdst0 = 16384u + (unsigned)(((2 * wave) >> 2) * 4096 + ((2 * wave) & 3) * 1024), vdst1 = 16384u + (unsigned)(((2 * wave + 1) >> 2) * 4096 + ((2 * wave + 1) & 3) * 1024);
    const unsigned lds0 = (unsigned)(uintptr_t)lds;
#define DA_STAGE(bo, to) do { \
        glds16(Kg + (to) + ksrc, (unsigned)__builtin_amdgcn_readfirstlane((int)(lds0 + (bo) + kdst))); \
        glds16(Kg + (to) + ksrc + 8, (unsigned)__builtin_amdgcn_readfirstlane((int)(lds0 + (bo) + kdst + 1024))); \
        glds16(Vg + (to) + vsrc0, (unsigned)__builtin_amdgcn_readfirstlane((int)(lds0 + (bo) + vdst0))); \
        glds16(Vg + (to) + vsrc1, (unsigned)__builtin_amdgcn_readfirstlane((int)(lds0 + (bo) + vdst1))); } while (0)
#define DA_WAITBAR() asm volatile("s_waitcnt vmcnt(0) lgkmcnt(0)\n\ts_barrier" ::: "memory")
    const unsigned koff = (unsigned)(((comp * 8 + hi) * 64 + r32) * 16);
    const unsigned voff = (unsigned)(16384 + (4 * hi + ((lane & 15) >> 2)) * 64 + ((lane >> 4) & 1) * 32 + (lane & 3) * 8);
    LAS unsigned* xq = (LAS unsigned*)(lds + 100352);
    for (;;) {
        if (wave == 0 && lane == 0) xq[0] = __hip_atomic_fetch_add(dq, 1u, __ATOMIC_RELAXED, __HIP_MEMORY_SCOPE_AGENT);
        asm volatile("s_waitcnt vmcnt(0) lgkmcnt(0)\n\ts_barrier" ::: "memory");
        const int j = (int)xq[0];
        if (j >= 1024) break;
        const int ub = 31 - (j >> 5), bh = j & 31;
        const int b = bh >> 3, h = 7 - (bh & 7);
        const float sl2 = LOG2E / (float)(2 << h);
        const size_t rowbase = (size_t)b * SEQ; const int q0 = ub * 128;
        const int qpos = q0 + wq * 32 + r32;
        const int nt = 2 * ub + 2;
        const int myt = 2 * ub + 1 + (wq >> 1);
        const bf16* Kg = AK + rowbase * 1024 + h * 128; const bf16* Vg = AV + rowbase * 1024 + h * 128;
        bf16x8 qr[4];
#pragma unroll
        for (int s = 0; s < 4; ++s) qr[s] = *(const GAS bf16x8*)(AQ + (rowbase + qpos) * 1024 + h * 128 + comp * 64 + s * 16 + hi * 8);
        f32x16 o[4];
#pragma unroll
        for (int blk = 0; blk < 4; ++blk)
#pragma unroll
            for (int r = 0; r < 16; ++r) o[blk][r] = 0.f;
        float mrun = -INFINITY, lrun = 0.f;
        { float qn2 = 0.f;
#pragma unroll
          for (int s = 0; s < 4; ++s) { const v4u w = __builtin_bit_cast(v4u, qr[s]); const float e0 = blo(w.x), e1 = bhi(w.x), e2 = blo(w.y), e3 = bhi(w.y), e4 = blo(w.z), e5 = bhi(w.z), e6 = blo(w.w), e7 = bhi(w.w);
              qn2 += ((e0 * e0 + e1 * e1) + (e2 * e2 + e3 * e3)) + ((e4 * e4 + e5 * e5) + (e6 * e6 + e7 * e7)); }
          qn2 += xhalf_f(qn2);
#pragma unroll
          for (int o_ = 1; o_ < 32; o_ <<= 1) qn2 = fmaxf(qn2, __shfl_xor(qn2, o_));
          const float kb = __uint_as_float(__hip_atomic_load(kmax + (b * 8 + h) * 2 + comp, __ATOMIC_RELAXED, __HIP_MEMORY_SCOPE_AGENT));
          if (lane == 0) xq[8 + wave] = __float_as_uint(sqrtf(qn2) * kb * 8.1f); }
        DA_STAGE(0u, (size_t)(nt - 1) * 64 * 1024);
        DA_WAITBAR();
        int kt_lo = 0;
        { float sb = 0.f;
#pragma unroll
          for (int w_ = 0; w_ < 8; ++w_) sb = fmaxf(sb, __uint_as_float(xq[8 + w_]));
          const float xcut = (float)(q0 - 63) - (40.f + 2.f * sb) / sl2;
          kt_lo = xcut > 0.f ? (int)__builtin_ceilf(xcut * (1.f / 64.f)) : 0; kt_lo = __builtin_amdgcn_readfirstlane(kt_lo); }
        for (int st = 0; st < nt - kt_lo; ++st) {
            const int kt = nt - 1 - st;
            const unsigned bufo = (unsigned)(st & 1) * 32768u;
            if (kt > kt_lo) DA_STAGE(32768u - bufo, (size_t)(kt - 1) * 64 * 1024);
            if (kt < myt) {
                const LAS unsigned char* Kb = lds + bufo + koff;
                f32x16 p0, p1;
#pragma unroll
                for (int r = 0; r < 16; ++r) { p0[r] = 0.f; p1[r] = 0.f; }
                { bf16x8 kf[4];
#pragma unroll
                  for (int s = 0; s < 4; ++s) kf[s] = *(const LAS bf16x8*)(Kb + s * 2048);
#pragma unroll
                  for (int s = 0; s < 4; ++s) p0 = __builtin_amdgcn_mfma_f32_32x32x16_bf16(kf[s], qr[s], p0, 0, 0, 0); }
                { bf16x8 kf[4];
#pragma unroll
                  for (int s = 0; s < 4; ++s) kf[s] = *(const LAS bf16x8*)(Kb + s * 2048 + 512);
#pragma unroll
                  for (int s = 0; s < 4; ++s) p1 = __builtin_amdgcn_mfma_f32_32x32x16_bf16(kf[s], qr[s], p1, 0, 0, 0); }
                const float qth = (float)(qpos - kt * 64 - 4 * hi);
                float rm = -INFINITY;
#pragma unroll
                for (int r = 0; r < 16; ++r) { const float kr = (float)((r & 3) + 8 * (r >> 2)); const float v0 = qth - kr, v1 = qth - (kr + 32.f);
                    p0[r] = p0[r] - sl2 * fabsf(v0); p1[r] = p1[r] - sl2 * fabsf(v1); rm = fmaxf(rm, fmaxf(p0[r], p1[r])); }
                rm = fmaxf(rm, xhalf_f(rm));
                if (__any(rm > mrun)) { const float mn = fmaxf(mrun, rm), f = __builtin_amdgcn_exp2f(mrun - mn); mrun = mn; lrun *= f;
#pragma unroll
                    for (int blk = 0; blk < 4; ++blk)
#pragma unroll
                        for (int r = 0; r < 16; ++r) o[blk][r] *= f; }
                float ls = 0.f;
#pragma unroll
                for (int r = 0; r < 16; ++r) { p0[r] = __builtin_amdgcn_exp2f(p0[r] - mrun); p1[r] = __builtin_amdgcn_exp2f(p1[r] - mrun); ls += p0[r] + p1[r]; }
                lrun += ls;
                bf16x8 pw[4];
#pragma unroll
                for (int s = 0; s < 2; ++s) {
                    v4u a = {cvtpk(p0[8 * s + 0], p0[8 * s + 1]), cvtpk(p0[8 * s + 2], p0[8 * s + 3]), cvtpk(p0[8 * s + 4], p0[8 * s + 5]), cvtpk(p0[8 * s + 6], p0[8 * s + 7])};
                    v4u c = {cvtpk(p1[8 * s + 0], p1[8 * s + 1]), cvtpk(p1[8 * s + 2], p1[8 * s + 3]), cvtpk(p1[8 * s + 4], p1[8 * s + 5]), cvtpk(p1[8 * s + 6], p1[8 * s + 7])};
                    pw[s] = __builtin_bit_cast(bf16x8, a); pw[2 + s] = __builtin_bit_cast(bf16x8, c); }
                const LAS unsigned char* Vb = lds + bufo + voff;
#pragma unroll
                for (int blk = 0; blk < 4; ++blk) {
#pragma unroll
                    for (int s = 0; s < 4; ++s) {
                        const v4i16_t lo = lds_tr16(Vb + blk * 4096 + s * 1024), hh = lds_tr16(Vb + blk * 4096 + s * 1024 + 512);
                        const bf16x8 vf = {lo[0], lo[1], lo[2], lo[3], hh[0], hh[1], hh[2], hh[3]};
                        o[blk] = __builtin_amdgcn_mfma_f32_32x32x16_bf16(vf, pw[s], o[blk], 0, 0, 0);
                    }
                }
            }
            DA_WAITBAR();
        }
        lrun += xhalf_f(lrun);
        const float inv = 1.f / lrun;
        LAS float* Y1 = (LAS float*)(lds) + wq * 4096;
        if (comp == 1) {
            float lam; { float a = dlam[lane] * dlam[64 + lane], bq_ = dlam[128 + lane] * dlam[192 + lane]; a = wave_sum(a); bq_ = wave_sum(bq_); lam = __expf(a) - __expf(bq_) + LAMBDA_INIT; }
            const float sc = inv * lam;
#pragma unroll
            for (int blk = 0; blk < 4; ++blk)
#pragma unroll
                for (int r = 0; r < 16; ++r) Y1[(32 * blk + (r & 3) + 8 * (r >> 2) + 4 * hi) * 32 + r32] = o[blk][r] * sc; }
        __syncthreads();
        if (comp == 0) {
            float ss = 0.f;
#pragma unroll
            for (int blk = 0; blk < 4; ++blk)
#pragma unroll
                for (int r = 0; r < 16; ++r) { const float a = o[blk][r] * inv - Y1[(32 * blk + (r & 3) + 8 * (r >> 2) + 4 * hi) * 32 + r32]; o[blk][r] = a; ss += a * a; }
            ss += xhalf_f(ss);
            const float rr = (1.0f - LAMBDA_INIT) / sqrtf(ss * (1.f / 128.f) + LN_EPS);
            LAS unsigned* stg = (LAS unsigned*)(lds + 65536) + wq * (32 * 65);
#pragma unroll
            for (int blk = 0; blk < 4; ++blk) {
#pragma unroll
                for (int r = 0; r < 16; r += 2) { const int e = 32 * blk + (r & 3) + 8 * (r >> 2) + 4 * hi;
                    stg[r32 * 65 + (e >> 1)] = cvtpk(o[blk][r] * rr * subg[e], o[blk][r + 1] * rr * subg[e + 1]); }
                asm volatile("" ::: "memory"); }
            LDS_WAIT(); asm volatile("" ::: "memory");
            bf16* orow = YA + (rowbase + q0 + wq * 32) * 1024 + h * 128;
#pragma unroll 4
            for (int row = 0; row < 32; ++row) *((GAS unsigned*)(orow + (size_t)row * 1024) + lane) = stg[row * 65 + lane];
        }
        __syncthreads();
    }
#undef DA_STAGE
#undef DA_WAITBAR
}

__device__ __forceinline__ unsigned okey(float f) { const unsigned u = __float_as_uint(f); return (u & 0x80000000u) ? ~u : (u | 0x80000000u); }
__device__ __forceinline__ void indexer_topk(LAS unsigned char* lds, const bf16* IQ, const bf16* IKW, unsigned short* IDX, int vcu, int G, const int wave) {
    const int lane = lane_fresh(), r32 = lane & 31, hi = lane >> 5;
    const unsigned lds0 = (unsigned)(uintptr_t)lds;
    const unsigned boff = (unsigned)((hi * 256 + r32) * 16);
    for (int j = vcu; j < 1024; j += G) {
        const int w = j & 255, i = j >> 8, bq = w >> 4, s16 = w & 15;
        const int chunk = (i == 0) ? s16 : (i == 1) ? 31 - s16 : (i == 2) ? 32 + s16 : 63 - s16;
        const int b = bq >> 2, gq = bq & 3;
        const int t0 = b * SEQ + chunk * 64 + gq * 16 + 2 * wave;
        const int ngroups = 2 * (chunk + 1);
        const int ntiles = (ngroups + 7) >> 3;
        const bf16* Kg = IKW + (size_t)b * SEQ * 256;
#define IX_STAGE(tile, bo) do { int tl_ = (tile); asm volatile("" : "+s"(tl_)); _Pragma("unroll") for (int i_ = 0; i_ < 4; ++i_) { const int q_ = 4 * wave + i_; \
            glds16s(Kg + (size_t)(tl_ * 256 + 64 * (q_ & 3)) * 256 + (q_ >> 2) * 8, (unsigned)lane * 512u, (unsigned)__builtin_amdgcn_readfirstlane((int)(lds0 + (bo) + ((q_ >> 2) * 256 + 64 * (q_ & 3)) * 16))); } } while (0)
        asm volatile("s_barrier" ::: "memory");
        IX_STAGE(0, 0u);
        bf16x8 a[4];
#pragma unroll
        for (int ks = 0; ks < 4; ++ks) a[ks] = *(const GAS bf16x8*)(IQ + (size_t)(t0 + (r32 >> 4)) * 1024 + (r32 & 15) * 64 + ks * 16 + 8 * hi);
        float wv[16];
        { const bf16* iwp = IKW + (size_t)t0 * 256 + 64 + 4 * hi;
          const v2u w00 = *(const GAS v2u*)(iwp), w01 = *(const GAS v2u*)(iwp + 8), w10 = *(const GAS v2u*)(iwp + 256), w11 = *(const GAS v2u*)(iwp + 256 + 8);
          wv[0] = blo(w00.x); wv[1] = bhi(w00.x); wv[2] = blo(w00.y); wv[3] = bhi(w00.y); wv[4] = blo(w01.x); wv[5] = bhi(w01.x); wv[6] = blo(w01.y); wv[7] = bhi(w01.y);
          wv[8] = blo(w10.x); wv[9] = bhi(w10.x); wv[10] = blo(w10.y); wv[11] = bhi(w10.y); wv[12] = blo(w11.x); wv[13] = bhi(w11.x); wv[14] = blo(w11.y); wv[15] = bhi(w11.y); }
        typedef float f2_t __attribute__((ext_vector_type(2)));
        f2_t w2[8];
#pragma unroll
        for (int r = 0; r < 8; ++r) w2[r] = (f2_t){wv[2 * r], wv[2 * r + 1]};
#define IX_SCORE(acc_, dst_) do { f2_t s0_ = {0.f, 0.f}, s1_ = {0.f, 0.f}; \
            _Pragma("unroll") for (int r = 0; r < 4; ++r) { \
                const f2_t x0_ = {__int_as_float(max(__float_as_int(acc_[2 * r]), 0)), __int_as_float(max(__float_as_int(acc_[2 * r + 1]), 0))}; \
                const f2_t x1_ = {__int_as_float(max(__float_as_int(acc_[8 + 2 * r]), 0)), __int_as_float(max(__float_as_int(acc_[8 + 2 * r + 1]), 0))}; \
                s0_ = __builtin_elementwise_fma(x0_, w2[r], s0_); s1_ = __builtin_elementwise_fma(x1_, w2[4 + r], s1_); } \
            const auto rr_ = __builtin_amdgcn_permlane32_swap(__float_as_uint(s0_.x + s0_.y), __float_as_uint(s1_.x + s1_.y), false, false); \
            const unsigned u_ = __float_as_uint(__uint_as_float(rr_[0]) + __uint_as_float(rr_[1])); \
            dst_ = u_ ^ ((unsigned)((int)u_ >> 31) | 0x80000000u); } while (0)
        unsigned key[128];
#pragma unroll 64
        for (int g = 0; g < 128; g += 2) {
            if (g < ngroups) {
                const unsigned bufo = (unsigned)((g >> 3) & 1) * 32768u;
                if ((g & 7) == 0) {
                    asm volatile("s_waitcnt vmcnt(0)\n\ts_barrier" ::: "memory");
                    if ((g >> 3) + 1 < ntiles) IX_STAGE((g >> 3) + 1, 32768u - bufo);
                }
                bf16x8 bk0[4], bk1[4];
#pragma unroll
                for (int ks = 0; ks < 4; ++ks) { bk0[ks] = *(const LAS bf16x8*)(lds + bufo + boff + (g & 7) * 512 + ks * 8192); bk1[ks] = *(const LAS bf16x8*)(lds + bufo + boff + ((g + 1) & 7) * 512 + ks * 8192); }
                f32x16 acc0 = {0.f, 0.f, 0.f, 0.f, 0.f, 0.f, 0.f, 0.f, 0.f, 0.f, 0.f, 0.f, 0.f, 0.f, 0.f, 0.f}, acc1 = acc0;
#pragma unroll
                for (int ks = 0; ks < 4; ++ks) acc0 = __builtin_amdgcn_mfma_f32_32x32x16_bf16(a[ks], bk0[ks], acc0, 0, 0, 0);
#pragma unroll
                for (int ks = 0; ks < 4; ++ks) acc1 = __builtin_amdgcn_mfma_f32_32x32x16_bf16(a[ks], bk1[ks], acc1, 0, 0, 0);
                IX_SCORE(acc0, key[g]); IX_SCORE(acc1, key[g + 1]);
            } else { key[g] = 0u; key[g + 1] = 0u; }
        }
#undef IX_SCORE
        unsigned selw[4];
        { unsigned vm[4];
#pragma unroll
          for (int w_ = 0; w_ < 4; ++w_) { const int n_ = ngroups - 32 * w_; vm[w_] = n_ >= 32 ? 0xffffffffu : (n_ <= 0 ? 0u : ((1u << (n_ & 31)) - 1u)); }
          if (chunk >= 4) {
#pragma unroll
              for (int w_ = 0; w_ < 4; ++w_) { if (32 * w_ < ngroups) {
#pragma unroll
                  for (int i_ = 0; i_ < 16; ++i_) { const unsigned x = key[32 * w_ + i_], y = key[32 * w_ + i_ + 16]; key[32 * w_ + i_] = (x & 0x0000ffffu) | (y << 16); key[32 * w_ + i_ + 16] = (x >> 16) | (y & 0xffff0000u); }
#pragma unroll
                  for (int i_ = 0; i_ < 32; ++i_) { if (!(i_ & 8)) { const unsigned x = key[32 * w_ + i_], y = key[32 * w_ + i_ + 8]; key[32 * w_ + i_] = (x & 0x00ff00ffu) | ((y << 8) & 0xff00ff00u); key[32 * w_ + i_ + 8] = ((x >> 8) & 0x00ff00ffu) | (y & 0xff00ff00u); } }
#pragma unroll
                  for (int i_ = 0; i_ < 32; ++i_) { if (!(i_ & 4)) { const unsigned x = key[32 * w_ + i_], y = key[32 * w_ + i_ + 4]; key[32 * w_ + i_] = (x & 0x0f0f0f0fu) | ((y << 4) & 0xf0f0f0f0u); key[32 * w_ + i_ + 4] = ((x >> 4) & 0x0f0f0f0fu) | (y & 0xf0f0f0f0u); } }
#pragma unroll
                  for (int i_ = 0; i_ < 32; ++i_) { if (!(i_ & 2)) { const unsigned x = key[32 * w_ + i_], y = key[32 * w_ + i_ + 2]; key[32 * w_ + i_] = (x & 0x33333333u) | ((y << 2) & 0xccccccccu); key[32 * w_ + i_ + 2] = ((x >> 2) & 0x33333333u) | (y & 0xccccccccu); } }
#pragma unroll
                  for (int i_ = 0; i_ < 32; ++i_) { if (!(i_ & 1)) { const unsigned x = key[32 * w_ + i_], y = key[32 * w_ + i_ + 1]; key[32 * w_ + i_] = (x & 0x55555555u) | ((y << 1) & 0xaaaaaaaau); key[32 * w_ + i_ + 1] = ((x >> 1) & 0x55555555u) | (y & 0xaaaaaaaau); } }
              } }
              unsigned cand[4] = {vm[0], vm[1], vm[2], vm[3]}, abv[4] = {0u, 0u, 0u, 0u}; int nab = 0; bool done = false;
#pragma unroll 32
              for (int bit = 31; bit >= 0; --bit) {
                  if (__all(done ? 1 : 0)) break;
                  const unsigned o0 = cand[0] & key[bit], o1 = cand[1] & key[32 + bit], o2 = cand[2] & key[64 + bit], o3 = cand[3] & key[96 + bit];
                  const int c = half_sum_i32(__popc(o0) + __popc(o1) + __popc(o2) + __popc(o3));
                  const bool take = nab + c >= 256;
                  done = done || (take && nab + c == 256);
                  const unsigned ntm = take ? 0u : 0xffffffffu;
                  nab += c & (int)ntm;
                  abv[0] |= o0 & ntm; abv[1] |= o1 & ntm; abv[2] |= o2 & ntm; abv[3] |= o3 & ntm;
                  cand[0] = o0 ^ (cand[0] & ntm); cand[1] = o1 ^ (cand[1] & ntm); cand[2] = o2 ^ (cand[2] & ntm); cand[3] = o3 ^ (cand[3] & ntm);
              }
#pragma unroll
              for (int w_ = 0; w_ < 4; ++w_) selw[w_] = abv[w_] | cand[w_];
          } else {
#pragma unroll
              for (int w_ = 0; w_ < 4; ++w_) selw[w_] = vm[w_];
          } }
        int base = 0;
        unsigned short* ip = IDX + (size_t)(t0 + hi) * 256;
#pragma unroll
        for (int g = 0; g < 128; ++g) {
            if (g < ngroups) {
                const bool sel = ((selw[g >> 5] >> (g & 31)) & 1u) != 0u;
                const unsigned long long mk = __ballot(sel ? 1 : 0);
                const unsigned mh = hi ? (unsigned)(mk >> 32) : (unsigned)mk;
                const int pos = base + __popc(mh & ((1u << r32) - 1u));
                if (sel && pos < 256) ip[pos] = (unsigned short)(32 * g + r32);
                base += __popc(mh);
            }
        }
    }
#undef IX_STAGE
    asm volatile("s_waitcnt vmcnt(0) lgkmcnt(0)\n\ts_barrier" ::: "memory");
}

constexpr int DSA_PAIRB = 1040;
constexpr int DSA_WAVEB = 16 * DSA_PAIRB + 512;
constexpr int DSA_LDS_END = 8 * DSA_WAVEB;
constexpr float DSA_CS = 64.f, DSA_QS = 64.f, DSA_PS = 256.f;
typedef int v2i_t __attribute__((ext_vector_type(2)));
__device__ __forceinline__ void dsa_mfma(LAS unsigned char* lds, const bf16* QL, bf16* OL, const int omask, const unsigned char* C8, const unsigned short* IDX, int vcu, int G, const int wave) {
    const int lane = lane_fresh(), h16 = lane & 15, g = lane >> 4;
    LAS unsigned char* wl = lds + wave * DSA_WAVEB;
    const unsigned wl0 = (unsigned)(uintptr_t)wl;
    LAS unsigned short* idxs = (LAS unsigned short*)(wl + 16 * DSA_PAIRB);
    const float sc2 = 0.08838834764831845f * LOG2E / (DSA_QS * DSA_CS);
    const float sl2 = (h16 < 8) ? LOG2E / (float)(2 << (h16 & 7)) : 0.f;
    const int ntok = (G == 256) ? 8 : (M - (vcu * 8 + wave) + G * 8 - 1) / (G * 8);
#define DSA_TOK(i) ((G == 256) ? ((vcu >> 6) * SEQ + (vcu & 63) + 64 * (wave + 8 * (i))) : (vcu * 8 + wave + G * 8 * (i)))
    const unsigned qk_off = (unsigned)((h16 >> 1) * DSA_PAIRB + (h16 & 1) * 512 + 32 * g);
    const int trow = (h16 >> 1) < 4 ? 4 * g + (h16 >> 1) : 16 + 4 * g + ((h16 >> 1) - 4);
    const unsigned pv_off = (unsigned)((trow >> 1) * DSA_PAIRB + (trow & 1) * 512 + 8 * (h16 & 1));
    for (int it = 0; it < ntok; ++it) {
        const int t = DSA_TOK(it); const int tpos = t & (SEQ - 1);
        const int n = (tpos >> 6) >= 3 ? 256 : 64 * ((tpos >> 6) + 1); const int nst = n >> 5;
        const unsigned char* Cb = C8 + (size_t)(t >> 12) * SEQ * 512;
        int ln = lane; asm volatile("" : "+v"(ln));
        const int h16b = ln & 15, gb = ln >> 4;
        { const v2u iv = __builtin_nontemporal_load((const GAS v2u*)(IDX + (size_t)t * 256) + ln); *((LAS v2u*)idxs + ln) = iv; }
        pg8::v8i_t qf[4];
        { const unsigned char* qp = (const unsigned char*)QL + (size_t)t * 8192 + (h16b & 7) * 512 + 32 * gb;
#pragma unroll
          for (int s = 0; s < 4; ++s) { const v4u lo = __builtin_nontemporal_load((const GAS v4u*)(qp + 128 * s)), hi = __builtin_nontemporal_load((const GAS v4u*)(qp + 128 * s + 16));
              qf[s] = (pg8::v8i_t){(int)lo.x, (int)lo.y, (int)lo.z, (int)lo.w, (int)hi.x, (int)hi.y, (int)hi.z, (int)hi.w}; } }
        f32x4 o[32];
#pragma unroll
        for (int blk = 0; blk < 32; ++blk) o[blk] = (f32x4){0.f, 0.f, 0.f, 0.f};
        float mrun = -INFINITY, lrun = 0.f;
        asm volatile("s_waitcnt lgkmcnt(0)" ::: "memory");
        for (int st = 0; st < nst; ++st) {
            { const LAS v4u* ip4 = (const LAS v4u*)(idxs + st * 32);
              const v4u q0 = ip4[0], q1 = ip4[1], q2 = ip4[2], q3 = ip4[3];
              const unsigned iw[16] = {q0.x, q0.y, q0.z, q0.w, q1.x, q1.y, q1.z, q1.w, q2.x, q2.y, q2.z, q2.w, q3.x, q3.y, q3.z, q3.w};
              const unsigned sh = (unsigned)(ln >> 5) * 16u, lo16 = (unsigned)(ln & 31) * 16u;
#pragma unroll
              for (int i = 0; i < 16; ++i) { const unsigned srow = (iw[i] >> sh) & 0xffffu;
                  glds16s(Cb, srow * 512u + lo16, (unsigned)__builtin_amdgcn_readfirstlane((int)(wl0 + i * DSA_PAIRB))); } }
            asm volatile("s_waitcnt vmcnt(0)" ::: "memory");
            f32x4 a0 = {0.f, 0.f, 0.f, 0.f}, a1 = {0.f, 0.f, 0.f, 0.f};
#pragma unroll
            for (int s = 0; s < 4; ++s) {
                const pg8::v4i_t x0 = *(const LAS pg8::v4i_t*)(wl + qk_off + 128 * s), x1 = *(const LAS pg8::v4i_t*)(wl + qk_off + 128 * s + 16);
                const pg8::v4i_t y0 = *(const LAS pg8::v4i_t*)(wl + qk_off + 8 * DSA_PAIRB + 128 * s), y1 = *(const LAS pg8::v4i_t*)(wl + qk_off + 8 * DSA_PAIRB + 128 * s + 16);
                a0 = __builtin_amdgcn_mfma_scale_f32_16x16x128_f8f6f4(__builtin_shufflevector(x0, x1, 0, 1, 2, 3, 4, 5, 6, 7), qf[s], a0, 0, 0, 0, 0x7f7f7f7f, 0, 0x7f7f7f7f);
                a1 = __builtin_amdgcn_mfma_scale_f32_16x16x128_f8f6f4(__builtin_shufflevector(y0, y1, 0, 1, 2, 3, 4, 5, 6, 7), qf[s], a1, 0, 0, 0, 0x7f7f7f7f, 0, 0x7f7f7f7f); }
            const v2u i0 = *(const LAS v2u*)(idxs + st * 32 + 4 * g), i1 = *(const LAS v2u*)(idxs + st * 32 + 16 + 4 * g);
            const int sidx[8] = {(int)(i0.x & 0xffffu), (int)(i0.x >> 16), (int)(i0.y & 0xffffu), (int)(i0.y >> 16), (int)(i1.x & 0xffffu), (int)(i1.x >> 16), (int)(i1.y & 0xffffu), (int)(i1.y >> 16)};
            float lg[8];
#pragma unroll
            for (int r = 0; r < 8; ++r) { const int d = tpos - sidx[r]; lg[r] = (r < 4 ? a0[r & 3] : a1[r & 3]) * sc2 - sl2 * (float)(d < 0 ? -d : d); }
            float rm = fmaxf(fmaxf(fmaxf(lg[0], lg[1]), fmaxf(lg[2], lg[3])), fmaxf(fmaxf(lg[4], lg[5]), fmaxf(lg[6], lg[7])));
            { const auto r1 = __builtin_amdgcn_permlane16_swap(__float_as_uint(rm), __float_as_uint(rm), false, false); rm = fmaxf(__uint_as_float(r1[0]), __uint_as_float(r1[1])); }
            rm = xhalf_max(rm);
            const float mn = fmaxf(mrun, rm), f = __builtin_amdgcn_exp2f(mrun - mn); mrun = mn;
#pragma unroll
            for (int r = 0; r < 8; ++r) lg[r] = __builtin_amdgcn_exp2f(lg[r] - mn) * DSA_PS;
            const unsigned pw0 = pg8::pk4_fp8(lg[0], lg[1], lg[2], lg[3]), pw1 = pg8::pk4_fp8(lg[4], lg[5], lg[6], lg[7]);
            { const float ps = ((__builtin_amdgcn_cvt_f32_fp8((int)pw0, 0) + __builtin_amdgcn_cvt_f32_fp8((int)pw0, 1)) + (__builtin_amdgcn_cvt_f32_fp8((int)pw0, 2) + __builtin_amdgcn_cvt_f32_fp8((int)pw0, 3)))
                           + ((__builtin_amdgcn_cvt_f32_fp8((int)pw1, 0) + __builtin_amdgcn_cvt_f32_fp8((int)pw1, 1)) + (__builtin_amdgcn_cvt_f32_fp8((int)pw1, 2) + __builtin_amdgcn_cvt_f32_fp8((int)pw1, 3)));
              lrun = lrun * f + ps; }
            const long pw = (long)(((unsigned long)pw1 << 32) | (unsigned long)pw0);
#pragma unroll
            for (int blk = 0; blk < 32; ++blk) {
                const v2i_t av = __builtin_amdgcn_ds_read_tr8_b64_v2i32((LAS v2i_t*)(wl + pv_off + 16 * blk));
                const long al = (long)(((unsigned long)(unsigned)av.y << 32) | (unsigned long)(unsigned)av.x);
                o[blk] = __builtin_amdgcn_mfma_f32_16x16x32_fp8_fp8(al, pw, o[blk] * f, 0, 0, 0);
                if ((blk & 3) == 3) __builtin_amdgcn_sched_barrier(0);
            }
        }
        float lt = lrun; lt += __shfl_xor(lt, 16); lt += __shfl_xor(lt, 32);
        const float inv = 1.f / (lt * DSA_CS);
        if (h16 < 8) {
#pragma unroll
            for (int blk = 0; blk < 32; ++blk) { const f32x4 v = o[blk] * inv;
                __builtin_nontemporal_store((v2u){cvtpk(v.x, v.y), cvtpk(v.z, v.w)}, (GAS v2u*)(OL + (size_t)(t & omask) * 4096 + h16b * 512 + 16 * blk + 4 * gb)); } }
    }
    asm volatile("s_waitcnt vmcnt(0) lgkmcnt(0)" ::: "memory");
    __syncthreads();
#undef DSA_TOK
}
static_assert(DSA_LDS_END <= RING_BYTES, "DSA LDS map");

__device__ __forceinline__ void memattn_mfma(LAS unsigned char* lds, const bf16* QM, const bf16* KV, bf16* OM, int vcu, int G, const int wave) {
    const int lane = lane_fresh(), r32 = lane & 31, hi = lane >> 5;
    const unsigned voff = (unsigned)(65536 + (4 * hi + ((lane & 15) >> 2)) * 64 + ((lane >> 4) & 1) * 32 + (lane & 3) * 8);
    for (int j = vcu; j < 256; j += G) {
        const int bh = j >> 4, qb = j & 15, b = bh >> 2, h = bh & 3;
        const bf16* Kg = KV + (size_t)b * MEMT * 1024 + h * 128; const bf16* Vg = Kg + 512;
#pragma unroll
        for (int i = 0; i < 8; ++i) { const int q = 8 * wave + i;
            glds16(Kg + (size_t)(64 * (q & 3) + lane) * 1024 + (q >> 2) * 8, (unsigned)__builtin_amdgcn_readfirstlane((int)((unsigned)(uintptr_t)lds + ((q >> 2) * 256 + 64 * (q & 3)) * 16)));
            glds16(Vg + (size_t)(16 * (q & 15) + (lane >> 2)) * 1024 + (q >> 4) * 32 + (lane & 3) * 8, (unsigned)__builtin_amdgcn_readfirstlane((int)((unsigned)(uintptr_t)lds + 65536 + (q >> 4) * 16384 + (q & 15) * 1024))); }
        const size_t qrow = (size_t)b * SEQ + qb * 256 + wave * 32 + r32;
        bf16x8 qr[8];
#pragma unroll
        for (int s = 0; s < 8; ++s) qr[s] = *(const GAS bf16x8*)(QM + qrow * 512 + h * 128 + s * 16 + hi * 8);
        f32x16 o[4];
#pragma unroll
        for (int blk = 0; blk < 4; ++blk)
#pragma unroll
            for (int r = 0; r < 16; ++r) o[blk][r] = 0.f;
        float mrun = -INFINITY, lrun = 0.f;
        asm volatile("s_waitcnt vmcnt(0) lgkmcnt(0)\n\ts_barrier" ::: "memory");
        for (int kt = 0; kt < 4; ++kt) {
            const LAS unsigned char* Kb = lds + (unsigned)((hi * 256 + 64 * kt + r32) * 16);
            f32x16 p0, p1;
#pragma unroll
            for (int r = 0; r < 16; ++r) { p0[r] = 0.f; p1[r] = 0.f; }
#pragma unroll
            for (int s = 0; s < 8; ++s) { const bf16x8 k0 = *(const LAS bf16x8*)(Kb + s * 8192), k1 = *(const LAS bf16x8*)(Kb + s * 8192 + 512);
                p0 = __builtin_amdgcn_mfma_f32_32x32x16_bf16(k0, qr[s], p0, 0, 0, 0); p1 = __builtin_amdgcn_mfma_f32_32x32x16_bf16(k1, qr[s], p1, 0, 0, 0); }
            float rm = -INFINITY;
#pragma unroll
            for (int r = 0; r < 16; ++r) rm = fmaxf(rm, fmaxf(p0[r], p1[r]));
            rm = fmaxf(rm, xhalf_f(rm));
            if (__any(rm > mrun)) { const float mn = fmaxf(mrun, rm), f = __builtin_amdgcn_exp2f(mrun - mn); mrun = mn; lrun *= f;
#pragma unroll
                for (int blk = 0; blk < 4; ++blk)
#pragma unroll
                    for (int r = 0; r < 16; ++r) o[blk][r] *= f; }
            float ls = 0.f;
#pragma unroll
            for (int r = 0; r < 16; ++r) { p0[r] = __builtin_amdgcn_exp2f(p0[r] - mrun); p1[r] = __builtin_amdgcn_exp2f(p1[r] - mrun); ls += p0[r] + p1[r]; }
            lrun += ls;
            bf16x8 pw[4];
#pragma unroll
            for (int s = 0; s < 2; ++s) {
                v4u a = {cvtpk(p0[8 * s + 0], p0[8 * s + 1]), cvtpk(p0[8 * s + 2], p0[8 * s + 3]), cvtpk(p0[8 * s + 4], p0[8 * s + 5]), cvtpk(p0[8 * s + 6], p0[8 * s + 7])};
                v4u c = {cvtpk(p1[8 * s + 0], p1[8 * s + 1]), cvtpk(p1[8 * s + 2], p1[8 * s + 3]), cvtpk(p1[8 * s + 4], p1[8 * s + 5]), cvtpk(p1[8 * s + 6], p1[8 * s + 7])};
                pw[s] = __builtin_bit_cast(bf16x8, a); pw[2 + s] = __builtin_bit_cast(bf16x8, c); }
            const LAS unsigned char* Vb = lds + voff + kt * 4096;
#pragma unroll
            for (int blk = 0; blk < 4; ++blk) {
#pragma unroll
                for (int s = 0; s < 4; ++s) {
                    const v4i16_t lo = lds_tr16(Vb + blk * 16384 + s * 1024), hh = lds_tr16(Vb + blk * 16384 + s * 1024 + 512);
                    const bf16x8 vf = {lo[0], lo[1], lo[2], lo[3], hh[0], hh[1], hh[2], hh[3]};
                    o[blk] = __builtin_amdgcn_mfma_f32_32x32x16_bf16(vf, pw[s], o[blk], 0, 0, 0);
                }
            }
        }
        __syncthreads();
        lrun += xhalf_f(lrun);
        const float inv = 1.f / lrun;
        LAS unsigned* stg = (LAS unsigned*)(lds) + wave * (32 * 65);
#pragma unroll
        for (int blk = 0; blk < 4; ++blk)
#pragma unroll
            for (int r = 0; r < 16; r += 2) { const int e = 32 * blk + (r & 3) + 8 * (r >> 2) + 4 * hi;
                stg[r32 * 65 + (e >> 1)] = cvtpk(o[blk][r] * inv, o[blk][r + 1] * inv); }
        LDS_WAIT(); asm volatile("" ::: "memory");
        bf16* orow = OM + ((size_t)b * SEQ + qb * 256 + wave * 32) * 512 + h * 128;
#pragma unroll 4
        for (int row = 0; row < 32; ++row) *((GAS unsigned*)(orow + (size_t)row * 512) + lane) = stg[row * 65 + lane];
        __syncthreads();
    }
}

constexpr int N_PHASES = 21;
struct Args { const float* in[24]; float* out; unsigned char* ws; int ph_lo, ph_hi; };
__global__ void __launch_bounds__(NWAVES * 64, 2) mk_fwd(Args args) {
    extern __shared__ __attribute__((aligned(16))) unsigned char lds_raw[];
    LAS unsigned char* lds = (LAS unsigned char*)lds_raw;
    volatile LAS unsigned* MISC = (volatile LAS unsigned*)(lds + MISC_OFF);
    const int tid = threadIdx.x, wave = __builtin_amdgcn_readfirstlane(tid >> 6);
#define lane lane_fresh()
    const int G = gridDim.x; int bx = blockIdx.x;
    int vcu = (G % 8 == 0) ? (bx % 8) * (G / 8) + bx / 8 : bx;
    int gw = vcu * NWAVES + wave; const int NGW = G * NWAVES;
    unsigned char* ws = args.ws;
    gu32* ctl = (gu32*)(ws + WS_CTL);
    for (int u = tid; u < (LDS_BYTES - LDSCTL_OFF) / 4; u += NWAVES * 64) ((LAS unsigned*)(lds + LDSCTL_OFF))[u] = 0u;
    __syncthreads();
    const bool one = (args.ph_hi - args.ph_lo) > 1;
    XcdBarrier bar; bar.bar = (unsigned*)(ctl + CW_BAR); bar.x = 0; bar.st = nullptr;
    if (one) bar = xcd_barrier_post((unsigned*)(ctl + CW_BAR), MISC + 8, tid == 0);
    const int lo = args.ph_lo, hi = args.ph_hi;
#ifndef PH_MASK
#define PH_MASK 0xFFFFFFFFu
#endif
#define IN(k) ((((PH_MASK) >> (k)) & 1u) && lo <= (k) && (k) < hi)
#define SEAM(k) do { if (IN(k) && IN((k) + 1)) xcd_barrier(bar, wave); } while (0)
    bf16* const X16 = (bf16*)(ws + WS_X16); bf16* const HB = (bf16*)(ws + WS_H);
    long long* const ST0 = (long long*)(ws + WS_CTL + CTL_STATS); long long* const ST1 = (long long*)(ws + WS_CTL + CTL_STATS + CTL_STATS_STRIDE); long long* const ST2 = (long long*)(ws + WS_CTL + CTL_STATS + 2 * CTL_STATS_STRIDE);
    const float* const VEC = (const float*)(ws + WS_CTL + CTL_VECF);
    float* const out = args.out;
    const float* const ln_g = args.in[22]; const float* const ln_b = args.in[23];
    using namespace pg8;

#ifdef PROBE_P0
    if (IN(0)) { p0_prologue(args.in, ws, lds, gw, NGW, wave, lane); }
#endif
    if (IN(0)) { p0_prologue(args.in, ws, lds, gw, NGW, wave, lane); }
    SEAM(0);
    if (one && IN(0) && (G % 8) == 0) {
        unsigned* xb = (unsigned*)(ctl + CW_BAR); bool even = true;
#pragma unroll
        for (int jx = 0; jx < 16; ++jx) { const unsigned c = xb_ld(&xb[XB_XCNT(jx)]); even = even && (jx < 8 ? c == (unsigned)(G / 8) : c == 0u); }
        const int rank = (int)MISC[10], xcc = (int)xb_xcc_id();
        if (__builtin_amdgcn_readfirstlane(even ? 1 : 0)) { vcu = __builtin_amdgcn_readfirstlane(xcc * (G / 8) + rank); bx = __builtin_amdgcn_readfirstlane(rank * 8 + xcc); gw = vcu * NWAVES + wave; }
    }
    if (IN(1)) { { const long long* vi = (const long long*)(ws + WS_CTL + CTL_VEC); float* vf = (float*)(ws + WS_CTL + CTL_VECF); for (int i = gw * 64 + lane; i < V_END; i += NGW * 64) vf[i] = (float)vi[i] * (1.0f / 16777216.f); }
        Gemm g{(const bf16*)(ws + WS_X8), (const bf16*)(ws + WS_W_GU1), D / 2, D / 2, D / 2, 0, 0}; StaticOrder S; S.init(M, 2 * FF, G, bx); EpiSwiGLU8 E{(unsigned char*)HB, FF, 1.0f / (FP8_XS * FP8_WGUS), FP8_HS, LnFold{nullptr, nullptr, nullptr}};
        gemm_phase<EpiSwiGLU8, StaticOrder, true, true>(lds + RING_OFF, g, S, E, wave); }
    SEAM(1);
    if (IN(2)) { Gemm g{HB, (const bf16*)(ws + WS_W_D1), FF / 2, FF / 2, FF / 2, 0, 0}; StaticOrder S; S.init(M, D, G, bx); EpiRes<true> E{args.in[0], nullptr, D, ALPHA, 0.5f / (FP8_HS * FP8_WDS), nullptr, nullptr, nullptr, ST0, X16, (unsigned char*)(ws + WS_X8M), FP8_XS};
        gemm_phase<EpiRes<true>, StaticOrder, true, true>(lds + RING_OFF, g, S, E, wave); }
    SEAM(2);
    if (IN(4)) {
        { Gemm g{X16, (const bf16*)(ws + WS_W_IN), D, D, D, 0, 0}; StaticOrder S; S.init(M, N_IN, G, bx);
          EpiInProj E{(bf16*)(ws + WS_AQ), (bf16*)(ws + WS_AK), (bf16*)(ws + WS_AV), (bf16*)(ws + WS_BQ), (bf16*)(ws + WS_BC), (bf16*)(ws + WS_IQ), (bf16*)(ws + WS_IKW), QSCALE, LnFold{ST0, VEC + V_GW_IN, VEC + V_BW_IN}, (unsigned*)(ctl + CW_KMAX)};
          gemm_phase<EpiInProj, StaticOrder, true>(lds + RING_OFF, g, S, E, wave); }
        { Gemm g{(const bf16*)(ws + WS_MEM16), (const bf16*)(ws + WS_W_MKV), D, D, D, 0, 0}; StaticOrder S; S.init(BATCH * MEMT, 1024, G, bx >= G - 16 ? bx - (G - 16) : (1 << 20)); EpiBf16 E{(bf16*)(ws + WS_KVMEM), 1024};
          gemm_phase<EpiBf16, StaticOrder, true>(lds + RING_OFF, g, S, E, wave); }
    }
    SEAM(4);
    if (IN(5)) {
        { Gemm g{(const bf16*)(ws + WS_BQ), (const bf16*)(ws + WS_W_UK), 1024, 128, 128, 1, 128}; StaticOrder S; S.init(M, 4096, G, bx); EpiFp8 E{(unsigned char*)(ws + WS_QLAT), 8192, DSA_QS};
          gemm_phase<EpiFp8, StaticOrder, true>(lds + RING_OFF, g, S, E, wave); }
        crms_phase((const bf16*)(ws + WS_BC), (unsigned char*)(ws + WS_C8), args.in[8], DSA_CS, gw, NGW, lane);
    }
    if (IN(7)) indexer_topk(lds, (const bf16*)(ws + WS_IQ), (const bf16*)(ws + WS_IKW), (unsigned short*)(ws + WS_IDX), vcu, G, wave);
    if (IN(7)) diff_attn_mfma(lds, (const bf16*)(ws + WS_AQ), (const bf16*)(ws + WS_AK), (const bf16*)(ws + WS_AV), (bf16*)(ws + WS_AQ), args.in[6], args.in[7], (unsigned*)(ctl + CW_DQ), (const unsigned*)(ctl + CW_KMAX), wave);
    SEAM(7);
    if (IN(8)) dsa_mfma(lds, (const bf16*)(ws + WS_QLAT), (bf16*)(ws + WS_QLAT), 0x7fffffff, (const unsigned char*)(ws + WS_C8), (const unsigned short*)(ws + WS_IDX), vcu, G, wave);
    SEAM(8);
    if (IN(9)) { Gemm g{(const bf16*)(ws + WS_QLAT), (const bf16*)(ws + WS_W_UVP), 4096, 1024, 1024, 0, 1024}; StaticOrder S; S.init(M, 1024, G, bx); EpiBf16 E{(bf16*)(ws + WS_YB), 1024};
        gemm_phase<EpiBf16, StaticOrder, true>(lds + RING_OFF, g, S, E, wave); }
    SEAM(9);
    if (IN(10)) {
        { Gemm g{(const bf16*)(ws + WS_AQ), (const bf16*)(ws + WS_W_A), 1024, 1024, 1024, 0, 0}; StaticOrder S; S.init(M, D, G, bx); EpiBf16 E{(bf16*)(ws + WS_TA), D}; gemm_phase<EpiBf16, StaticOrder, true>(lds + RING_OFF, g, S, E, wave); }
        { Gemm g{(const bf16*)(ws + WS_YB), (const bf16*)(ws + WS_W_B), 1024, 1024, 1024, 0, 0}; StaticOrder S; S.init(M, D, G, bx); EpiBf16 E{(bf16*)(ws + WS_TB), D}; gemm_phase<EpiBf16, StaticOrder, true>(lds + RING_OFF, g, S, E, wave); }
    }
    SEAM(10);
    if (IN(11)) { Gemm g{(const bf16*)(ws + WS_X8M), (const bf16*)(ws + WS_W_G), D / 2, D / 2, D / 2, 0, 0}; StaticOrder S; S.init(M, 2 * D, G, bx);
        EpiGateMerge8 E{(const bf16*)(ws + WS_TA), (const bf16*)(ws + WS_TB), (unsigned char*)(ws + WS_MRG8), D, args.in[12], args.in[12] + D, 1.0f / (FP8_XS * FP8_WGS), FP8_MS, LnFold{ST0, VEC + V_GW_G, VEC + V_BW_G}};
        gemm_phase<EpiGateMerge8, StaticOrder, true, true>(lds + RING_OFF, g, S, E, wave); }
    SEAM(11);
    if (IN(12)) { Gemm g{(const bf16*)(ws + WS_MRG8), (const bf16*)(ws + WS_W_MO), D / 2, D / 2, D / 2, 0, 0}; StaticOrder S; S.init(M, D, G, bx); EpiRes<false, 1> E{nullptr, X16, D, ALPHA, 1.0f / (FP8_MS * FP8_WMOS), ST0, ln_g, ln_b, ST1, X16, nullptr, 0.f};
        gemm_phase<EpiRes<false, 1>, StaticOrder, true, true>(lds + RING_OFF, g, S, E, wave); }
    SEAM(12);
    if (IN(14)) { Gemm g{X16, (const bf16*)(ws + WS_W_MQ), D, D, D, 0, 0}; StaticOrder S; S.init(M, 512, G, bx); EpiBf16 E{(bf16*)(ws + WS_QM), 512, 0.08838834764831845f * LOG2E, LnFold{ST1, VEC + V_GW_MQ, VEC + V_BW_MQ}}; gemm_phase<EpiBf16, StaticOrder, true>(lds + RING_OFF, g, S, E, wave); }
    SEAM(14);
    if (IN(15)) memattn_mfma(lds, (const bf16*)(ws + WS_QM), (const bf16*)(ws + WS_KVMEM), (bf16*)(ws + WS_OM), vcu, G, wave);
    SEAM(15);
    if (IN(16)) { Gemm g{(const bf16*)(ws + WS_OM), (const bf16*)(ws + WS_W_MOUT), 512, 512, 512, 0, 0}; StaticOrder S; S.init(M, D, G, bx); EpiRes<false> E{nullptr, X16, D, ALPHA, 1.0f, ST1, ln_g + D, ln_b + D, ST2, X16, (unsigned char*)(ws + WS_X8), FP8_XS};
        gemm_phase<EpiRes<false>, StaticOrder, true>(lds + RING_OFF, g, S, E, wave); }
    SEAM(16);
    if (IN(18)) { Gemm g{(const bf16*)(ws + WS_X8), (const bf16*)(ws + WS_W_GU2), D / 2, D / 2, D / 2, 0, 0}; StaticOrder S; S.init(M, 2 * FF, G, bx); EpiSwiGLU8 E{(unsigned char*)HB, FF, 1.0f / (FP8_XS * FP8_WGUS), FP8_HS, LnFold{ST2, VEC + V_GW_GU2, VEC + V_BW_GU2}};
        gemm_phase<EpiSwiGLU8, StaticOrder, true, true>(lds + RING_OFF, g, S, E, wave); }
    SEAM(18);
    if (IN(19)) { Gemm g{HB, (const bf16*)(ws + WS_W_D2), FF / 2, FF / 2, FF / 2, 0, 0}; StaticOrder S; S.init(M, D, G, bx); EpiRes<false> E{nullptr, X16, D, ALPHA, 0.5f / (FP8_HS * FP8_WDS), ST2, ln_g + 2 * D, ln_b + 2 * D, nullptr, X16, nullptr, 0.f};
        gemm_phase<EpiRes<false>, StaticOrder, true, true>(lds + RING_OFF, g, S, E, wave); }
    SEAM(19);
    if (IN(20)) ln_final_phase(X16, out, ln_g + 3 * D, ln_b + 3 * D, gw, NGW, lane);
#undef IN
#undef SEAM
#undef lane
}

extern "C" void kernel_launch(void* const* d_in, const int* in_sizes, int n_in, void* d_out, int out_size, void* d_ws, size_t ws_size, hipStream_t stream) {
    static int grid = 0;
    if (grid == 0) {
        if (n_in != 24 || in_sizes[0] != M * D || out_size != M * D || ws_size < WS_END) { fprintf(stderr, "kernel_launch: unexpected shapes (n_in %d, in0 %d, out %d, ws %zu); nothing launched\n", n_in, n_in > 0 ? in_sizes[0] : -1, out_size, ws_size); grid = -1; return; }
        int dev = 0, cus = 0, per_cu = 0;
        if (hipGetDevice(&dev) != hipSuccess || hipDeviceGetAttribute(&cus, hipDeviceAttributeMultiprocessorCount, dev) != hipSuccess) { grid = -1; return; }
        if (hipFuncSetAttribute((const void*)mk_fwd, hipFuncAttributeMaxDynamicSharedMemorySize, LDS_BYTES) != hipSuccess) { fprintf(stderr, "kernel_launch: hipFuncSetAttribute failed\n"); grid = -1; return; }
        if (hipOccupancyMaxActiveBlocksPerMultiprocessor(&per_cu, (const void*)mk_fwd, NWAVES * 64, LDS_BYTES) != hipSuccess || per_cu < 1)
            fprintf(stderr, "kernel_launch: note: the occupancy query reports %d workgroups per CU\n", per_cu);
        (void)hipGetLastError();
        grid = cus;
    }
    if (grid < 0) return;
    if (hipMemsetAsync((char*)d_ws + WS_CTL, 0, CTL_ZERO_BYTES, stream) != hipSuccess) return;
    Args a{};
    for (int i = 0; i < 24; ++i) a.in[i] = (const float*)d_in[i];
    a.out = (float*)d_out; a.ws = (unsigned char*)d_ws;
#if MK_ONE_LAUNCH
    a.ph_lo = 0; a.ph_hi = N_PHASES;
    hipLaunchKernelGGL(mk_fwd, dim3(grid), dim3(NWAVES * 64), LDS_BYTES, stream, a);
#else
    for (int p = 0; p < N_PHASES; ++p) { a.ph_lo = p; a.ph_hi = p + 1; hipLaunchKernelGGL(mk_fwd, dim3(grid), dim3(NWAVES * 64), LDS_BYTES, stream, a); }
#endif
}
```

```cpp
#include <hip/hip_runtime.h>
#include <cstdio>
#include <cstdint>

#ifndef MK_ONE_LAUNCH
#define MK_ONE_LAUNCH 1
#endif

__device__ __forceinline__ int lane_fresh() { int l = (int)__builtin_amdgcn_mbcnt_hi(~0u, __builtin_amdgcn_mbcnt_lo(~0u, 0u)); asm volatile("" : "+v"(l)); return l; }
__device__ __forceinline__ void glds16(const void* gsrc, unsigned lds_dst) { unsigned keep;
    asm volatile("s_mov_b32 %0, m0\n\ts_mov_b32 m0, %2\n\ts_nop 0\n\tglobal_load_lds_dwordx4 %1, off\n\ts_mov_b32 m0, %0" : "=&s"(keep) : "v"(gsrc), "s"(lds_dst) : "memory"); }
__device__ __forceinline__ void glds16s(const void* sbase, unsigned voff, unsigned lds_dst) { unsigned keep;
    asm volatile("s_mov_b32 %0, m0\n\ts_mov_b32 m0, %3\n\ts_nop 0\n\tglobal_load_lds_dwordx4 %1, %2\n\ts_mov_b32 m0, %0" : "=&s"(keep) : "v"(voff), "s"(sbase), "s"(lds_dst) : "memory"); }
__device__ __forceinline__ void glds16s_x16(const void* sbase, const unsigned (&v)[16], unsigned lds_dst0) { unsigned keep;
    asm volatile("s_mov_b32 %0, m0\n\ts_mov_b32 m0, %18\n\ts_nop 0\n\t"
        "global_load_lds_dwordx4 %1, %17\n\ts_add_u32 m0, m0, 1040\n\ts_nop 0\n\t"
        "global_load_lds_dwordx4 %2, %17\n\ts_add_u32 m0, m0, 1040\n\ts_nop 0\n\t"
        "global_load_lds_dwordx4 %3, %17\n\ts_add_u32 m0, m0, 1040\n\ts_nop 0\n\t"
        "global_load_lds_dwordx4 %4, %17\n\ts_add_u32 m0, m0, 1040\n\ts_nop 0\n\t"
        "global_load_lds_dwordx4 %5, %17\n\ts_add_u32 m0, m0, 1040\n\ts_nop 0\n\t"
        "global_load_lds_dwordx4 %6, %17\n\ts_add_u32 m0, m0, 1040\n\ts_nop 0\n\t"
        "global_load_lds_dwordx4 %7, %17\n\ts_add_u32 m0, m0, 1040\n\ts_nop 0\n\t"
        "global_load_lds_dwordx4 %8, %17\n\ts_add_u32 m0, m0, 1040\n\ts_nop 0\n\t"
        "global_load_lds_dwordx4 %9, %17\n\ts_add_u32 m0, m0, 1040\n\ts_nop 0\n\t"
        "global_load_lds_dwordx4 %10, %17\n\ts_add_u32 m0, m0, 1040\n\ts_nop 0\n\t"
        "global_load_lds_dwordx4 %11, %17\n\ts_add_u32 m0, m0, 1040\n\ts_nop 0\n\t"
        "global_load_lds_dwordx4 %12, %17\n\ts_add_u32 m0, m0, 1040\n\ts_nop 0\n\t"
        "global_load_lds_dwordx4 %13, %17\n\ts_add_u32 m0, m0, 1040\n\ts_nop 0\n\t"
        "global_load_lds_dwordx4 %14, %17\n\ts_add_u32 m0, m0, 1040\n\ts_nop 0\n\t"
        "global_load_lds_dwordx4 %15, %17\n\ts_add_u32 m0, m0, 1040\n\ts_nop 0\n\t"
        "global_load_lds_dwordx4 %16, %17\n\ts_mov_b32 m0, %0"
        : "=&s"(keep) : "v"(v[0]), "v"(v[1]), "v"(v[2]), "v"(v[3]), "v"(v[4]), "v"(v[5]), "v"(v[6]), "v"(v[7]), "v"(v[8]), "v"(v[9]), "v"(v[10]), "v"(v[11]), "v"(v[12]), "v"(v[13]), "v"(v[14]), "v"(v[15]), "s"(sbase), "s"(lds_dst0) : "memory", "scc"); }
namespace pg8 {
#define PG8_LAS __attribute__((address_space(3)))
typedef unsigned short bf16_t;
typedef short bf16x8 __attribute__((ext_vector_type(8)));
typedef float f32x4 __attribute__((ext_vector_type(4)));
typedef unsigned u32x4 __attribute__((ext_vector_type(4)));
constexpr int BM = 256, BK = 64, HALF = 128, HTB = HALF * BK * 2  , STAGE_BYTES = 8 * HTB, NXCD = 8, WGM = 8;

__host__ __device__ __forceinline__ int lds_byte(int r, int c) { const int st = (r >> 4) * 2 + (c >> 5), rr = r & 15, cc = c & 31, ob = rr * 64 + cc * 2; return st * 1024 + (ob ^ (((ob >> 9) & 1) << 5)); }
__host__ __device__ __forceinline__ void stage_rc(int b, int& R, int& C) { const int st = b / 1024, sb = b % 1024, swz = sb ^ (((sb >> 9) & 1) << 5); R = (st >> 1) * 16 + swz / 64; C = (st & 1) * 32 + (swz % 64) / 2; }
__host__ __device__ __forceinline__ int perm32(int rho) { const int n = rho >> 4, i = rho & 15; return 8 * (i >> 2) + 4 * n + (i & 3); }

struct Unit { int pm, pn; };
struct Gemm { const bf16_t* A; const bf16_t* Bt; int lda, ldb, K, a_shift, a_mul; };

struct StaticOrder {
    int nM, nN, nwg, G, c;
    __host__ __device__ void init(int M, int N, int G_, int c_) { nM = M / BM; nN = N / BM; nwg = nM * nN; G = G_; c = c_; }
    __host__ __device__ bool next(int i, Unit& u) const {
        const long L = (long)i * G + c; if (L >= nwg) return false;
        int wgid = (int)L; { const int q = nwg / NXCD, r = nwg % NXCD, xcd = wgid % NXCD, off = wgid / NXCD; wgid = (xcd < r ? xcd * (q + 1) : r * (q + 1) + (xcd - r) * q) + off; }
        const int nig = WGM * nN, gid = wgid / nig, fm = gid * WGM, gsz = (nM - fm) < WGM ? (nM - fm) : WGM;
        u.pm = fm + ((wgid % nig) % gsz); u.pn = (wgid % nig) / gsz; return true;
    }
    __device__ __forceinline__ void a_ready(const Unit&) const {}
    __device__ __forceinline__ void done(const Unit&) const {}
};

__device__ __forceinline__ unsigned cvt_pk_bf16(float lo, float hi) { unsigned r; asm volatile("v_cvt_pk_bf16_f32 %0, %1, %2" : "=v"(r) : "v"(lo), "v"(hi)); return r; }
__device__ __forceinline__ float bflo(unsigned w) { return __uint_as_float(w << 16); }
__device__ __forceinline__ float bfhi(unsigned w) { return __uint_as_float(w & 0xffff0000u); }
__device__ __forceinline__ float sigmoidf_fast(float x) { return __builtin_amdgcn_rcpf(1.0f + __builtin_amdgcn_exp2f(-1.4426950408889634f * x)); }

struct LnFold {
    const long long* stats; const float* gW; const float* bW;
    __device__ __forceinline__ void row(int r, float& mean, float& rstd) const { const long long s0 = stats[2 * (size_t)r], s1 = stats[2 * (size_t)r + 1];
        mean = (float)s0 * (1.0f / (1048576.f * 2048.0f)); rstd = __builtin_amdgcn_rsqf((float)s1 * (1.0f / (65536.f * 2048.0f)) - mean * mean + 1e-5f); }
    __device__ __forceinline__ f32x4 vec4(const float* v, int i) const { return *(const f32x4*)(v + i); }
    __device__ __forceinline__ void rows8(int row0, float (&mean)[8], float (&rstd)[8]) const {
#pragma unroll
        for (int hf = 0; hf < 2; ++hf) { long long s0[4], s1[4];
#pragma unroll
            for (int q = 0; q < 4; ++q) { const size_t r = (size_t)(row0 + hf * 128 + q * 16); s0[q] = stats[2 * r]; s1[q] = stats[2 * r + 1]; }
#pragma unroll
            for (int q = 0; q < 4; ++q) { const float mu = (float)s0[q] * (1.0f / (1048576.f * 2048.0f)); mean[4 * hf + q] = mu; rstd[4 * hf + q] = __builtin_amdgcn_rsqf((float)s1[q] * (1.0f / (65536.f * 2048.0f)) - mu * mu + 1e-5f); }
            asm volatile("" : "+v"(mean[4 * hf]), "+v"(mean[4 * hf + 1]), "+v"(mean[4 * hf + 2]), "+v"(mean[4 * hf + 3]), "+v"(rstd[4 * hf]), "+v"(rstd[4 * hf + 1]), "+v"(rstd[4 * hf + 2]), "+v"(rstd[4 * hf + 3]) :: "memory"); }
    }
};
struct EpiBf16 {
    static constexpr bool PERM = true, AFTER_DRAIN = false;
    bf16_t* O; int ldc; float sc = 1.0f; LnFold lf = {nullptr, nullptr, nullptr};
    __device__ __forceinline__ void operator()(const f32x4 (&acc)[2][2][4][2], const Unit& u, int wr, int wc, int fr, int fq) const {
        const int row0 = u.pm * BM + wr * 64 + fr, col0 = u.pn * BM + wc * 32 + 8 * fq;
        f32x4 gw[2][2], bw[2][2];
#pragma unroll
        for (int bj = 0; bj < 2; ++bj)
#pragma unroll
            for (int n = 0; n < 2; ++n) { gw[bj][n] = (f32x4){0.f, 0.f, 0.f, 0.f}; bw[bj][n] = (f32x4){0.f, 0.f, 0.f, 0.f}; if (lf.stats) { gw[bj][n] = lf.vec4(lf.gW, col0 + bj * HALF + 4 * n); bw[bj][n] = lf.vec4(lf.bW, col0 + bj * HALF + 4 * n); } }
        float mean8[8], rstd8[8];
#pragma unroll
        for (int q = 0; q < 8; ++q) { mean8[q] = 0.f; rstd8[q] = 1.f; }
        if (lf.stats) lf.rows8(row0, mean8, rstd8);
#pragma unroll
        for (int ai = 0; ai < 2; ++ai)
#pragma unroll
            for (int m = 0; m < 4; ++m) { bf16_t* rowp = O + (size_t)(row0 + ai * HALF + m * 16) * ldc + col0;
                const float mean = mean8[ai * 4 + m], rstd = rstd8[ai * 4 + m];
#pragma unroll
                for (int bj = 0; bj < 2; ++bj) { const f32x4 v0 = ((acc[ai][bj][m][0] - gw[bj][0] * mean) * rstd + bw[bj][0]) * sc, v1 = ((acc[ai][bj][m][1] - gw[bj][1] * mean) * rstd + bw[bj][1]) * sc;
                    u32x4 w; w.x = cvt_pk_bf16(v0[0], v0[1]); w.y = cvt_pk_bf16(v0[2], v0[3]); w.z = cvt_pk_bf16(v1[0], v1[1]); w.w = cvt_pk_bf16(v1[2], v1[3]);
                    *(u32x4*)(rowp + bj * HALF) = w; } }
    }
};
struct EpiInProj {
    static constexpr bool PERM = true, AFTER_DRAIN = false;
    bf16_t *aq, *ak, *av, *bq, *bc, *iq, *ikw; float qscale; LnFold lf; unsigned* kmax; int pn0; float ascale;
    __device__ __forceinline__ void operator()(const f32x4 (&acc)[2][2][4][2], const Unit& u, int wr, int wc, int fr, int fq) const {
        bf16_t* base; int ldc, colt; const int pn = u.pn + pn0;
        if (pn < 4) { base = aq; ldc = 1024; colt = pn * 256; }
        else if (pn < 8) { base = ak; ldc = 1024; colt = (pn - 4) * 256; }
        else if (pn < 12) { base = av; ldc = 1024; colt = (pn - 8) * 256; }
        else if (pn < 16) { base = bq; ldc = 1024; colt = (pn - 12) * 256; }
        else if (pn < 18) { base = bc; ldc = 512; colt = (pn - 16) * 256; }
        else if (pn < 22) { base = iq; ldc = 1024; colt = (pn - 18) * 256; }
        else { base = ikw; ldc = 256; colt = 0; }
        const float sc = (pn < 4) ? qscale : 1.0f; float kam[2] = {0.f, 0.f};
        const int row0 = u.pm * BM + wr * 64 + fr, col0 = colt + wc * 32 + 8 * fq, cidx = pn * BM + wc * 32 + 8 * fq;
        f32x4 gw[2][2], bw[2][2];
#pragma unroll
        for (int bj = 0; bj < 2; ++bj)
#pragma unroll
            for (int n = 0; n < 2; ++n) { gw[bj][n] = lf.vec4(lf.gW, cidx + bj * HALF + 4 * n); bw[bj][n] = lf.vec4(lf.bW, cidx + bj * HALF + 4 * n); }
        float mean8[8], rstd8[8]; lf.rows8(row0, mean8, rstd8);
#pragma unroll
        for (int ai = 0; ai < 2; ++ai)
#pragma unroll
            for (int m = 0; m < 4; ++m) { bf16_t* rowp = base + (size_t)(row0 + ai * HALF + m * 16) * ldc + col0;
                const float mean = mean8[ai * 4 + m], rstd = rstd8[ai * 4 + m];
#pragma unroll
                for (int bj = 0; bj < 2; ++bj) { const f32x4 v0 = ((acc[ai][bj][m][0] * ascale - gw[bj][0] * mean) * rstd + bw[bj][0]) * sc, v1 = ((acc[ai][bj][m][1] * ascale - gw[bj][1] * mean) * rstd + bw[bj][1]) * sc;
                    kam[bj] = fmaxf(kam[bj], fmaxf(fmaxf(fmaxf(fabsf(v0[0]), fabsf(v0[1])), fmaxf(fabsf(v0[2]), fabsf(v0[3]))), fmaxf(fmaxf(fabsf(v1[0]), fabsf(v1[1])), fmaxf(fabsf(v1[2]), fabsf(v1[3])))));
                    u32x4 w; w.x = cvt_pk_bf16(v0[0], v0[1]); w.y = cvt_pk_bf16(v0[2], v0[3]); w.z = cvt_pk_bf16(v1[0], v1[1]); w.w = cvt_pk_bf16(v1[2], v1[3]);
                    *(u32x4*)(rowp + bj * HALF) = w; } }
        if (pn >= 4 && pn < 8) {
#pragma unroll
            for (int bj = 0; bj < 2; ++bj) { float v = kam[bj];
#pragma unroll
                for (int o = 1; o < 64; o <<= 1) v = fmaxf(v, __shfl_xor(v, o));
                if ((fr | fq) == 0) (void)__hip_atomic_fetch_max(kmax + ((u.pm >> 4) * 8 + 2 * (pn - 4) + bj) * 2 + (wc >> 1), __float_as_uint(v), __ATOMIC_RELAXED, __HIP_MEMORY_SCOPE_AGENT); } }
    }
};
struct EpiSwiGLU {
    static constexpr bool PERM = true, AFTER_DRAIN = false;
    bf16_t* O; int ldc;
    __device__ __forceinline__ void operator()(const f32x4 (&acc)[2][2][4][2], const Unit& u, int wr, int wc, int fr, int fq) const {
        const int row0 = u.pm * BM + wr * 64 + fr, col0 = u.pn * HALF + wc * 32 + 8 * fq;
#pragma unroll
        for (int ai = 0; ai < 2; ++ai)
#pragma unroll
            for (int m = 0; m < 4; ++m) { bf16_t* rowp = O + (size_t)(row0 + ai * HALF + m * 16) * ldc + col0;
                float h[8];
#pragma unroll
                for (int n = 0; n < 2; ++n)
#pragma unroll
                    for (int j = 0; j < 4; ++j) { const float g = acc[ai][0][m][n][j], up = acc[ai][1][m][n][j]; h[4 * n + j] = g * sigmoidf_fast(g) * up; }
                u32x4 w; w.x = cvt_pk_bf16(h[0], h[1]); w.y = cvt_pk_bf16(h[2], h[3]); w.z = cvt_pk_bf16(h[4], h[5]); w.w = cvt_pk_bf16(h[6], h[7]);
                *(u32x4*)rowp = w; }
    }
};
__device__ __forceinline__ unsigned pk4_fp8(float a, float b, float c, float d) { int w = 0; w = __builtin_amdgcn_cvt_pk_fp8_f32(a, b, w, false); w = __builtin_amdgcn_cvt_pk_fp8_f32(c, d, w, true); return (unsigned)w; }
struct EpiFp8 {
    static constexpr bool PERM = true, AFTER_DRAIN = false;
    unsigned char* O; int ldc; float sc;
    __device__ __forceinline__ void operator()(const f32x4 (&acc)[2][2][4][2], const Unit& u, int wr, int wc, int fr, int fq) const {
        typedef unsigned u32x2 __attribute__((ext_vector_type(2)));
        const int row0 = u.pm * BM + wr * 64 + fr, col0 = u.pn * BM + wc * 32 + 8 * fq;
#pragma unroll
        for (int ai = 0; ai < 2; ++ai)
#pragma unroll
            for (int m = 0; m < 4; ++m) { unsigned char* rowp = O + (size_t)(row0 + ai * HALF + m * 16) * ldc + col0;
#pragma unroll
                for (int bj = 0; bj < 2; ++bj) { const f32x4 v0 = acc[ai][bj][m][0] * sc, v1 = acc[ai][bj][m][1] * sc;
                    *(u32x2*)(rowp + bj * HALF) = (u32x2){pk4_fp8(fminf(fmaxf(v0[0], -448.f), 448.f), fminf(fmaxf(v0[1], -448.f), 448.f), fminf(fmaxf(v0[2], -448.f), 448.f), fminf(fmaxf(v0[3], -448.f), 448.f)),
                                                          pk4_fp8(fminf(fmaxf(v1[0], -448.f), 448.f), fminf(fmaxf(v1[1], -448.f), 448.f), fminf(fmaxf(v1[2], -448.f), 448.f), fminf(fmaxf(v1[3], -448.f), 448.f))}; } }
    }
};
struct EpiSwiGLU8 {
    static constexpr bool PERM = true, AFTER_DRAIN = false;
    unsigned char* O; int ldc; float ascale, hs; LnFold lf;
    __device__ __forceinline__ void operator()(const f32x4 (&acc)[2][2][4][2], const Unit& u, int wr, int wc, int fr, int fq) const {
        const int row0 = u.pm * BM + wr * 64 + fr, col0 = u.pn * HALF + wc * 32 + 8 * fq, cidx = u.pn * BM + wc * 32 + 8 * fq;
        typedef unsigned u32x2 __attribute__((ext_vector_type(2)));
        f32x4 gw[2][2], bw[2][2];
#pragma unroll
        for (int bj = 0; bj < 2; ++bj)
#pragma unroll
            for (int n = 0; n < 2; ++n) { gw[bj][n] = (f32x4){0.f, 0.f, 0.f, 0.f}; bw[bj][n] = (f32x4){0.f, 0.f, 0.f, 0.f}; if (lf.stats) { gw[bj][n] = lf.vec4(lf.gW, cidx + bj * HALF + 4 * n); bw[bj][n] = lf.vec4(lf.bW, cidx + bj * HALF + 4 * n); } }
        float mean8[8], rstd8[8];
#pragma unroll
        for (int q = 0; q < 8; ++q) { mean8[q] = 0.f; rstd8[q] = 1.f; }
        if (lf.stats) lf.rows8(row0, mean8, rstd8);
#pragma unroll
        for (int ai = 0; ai < 2; ++ai)
#pragma unroll
            for (int m = 0; m < 4; ++m) { unsigned char* rowp = O + (size_t)(row0 + ai * HALF + m * 16) * ldc + col0;
                float h[8]; const float mean = mean8[ai * 4 + m], rstd = rstd8[ai * 4 + m];
#pragma unroll
                for (int n = 0; n < 2; ++n)
#pragma unroll
                    for (int j = 0; j < 4; ++j) { const float g = (acc[ai][0][m][n][j] * ascale - gw[0][n][j] * mean) * rstd + bw[0][n][j], up = (acc[ai][1][m][n][j] * ascale - gw[1][n][j] * mean) * rstd + bw[1][n][j];
                        h[4 * n + j] = fminf(fmaxf(g * sigmoidf_fast(g) * up * hs, -448.f), 448.f); }
                *(u32x2*)rowp = (u32x2){pk4_fp8(h[0], h[1], h[2], h[3]), pk4_fp8(h[4], h[5], h[6], h[7])}; }
    }
};
struct EpiGateMerge {
    static constexpr bool PERM = true, AFTER_DRAIN = false;
    const bf16_t* ta; const bf16_t* tb; bf16_t* O; int ldc; const float* b0; const float* b1;
    __device__ __forceinline__ void operator()(const f32x4 (&acc)[2][2][4][2], const Unit& u, int wr, int wc, int fr, int fq) const {
        const int row0 = u.pm * BM + wr * 64 + fr, col0 = u.pn * HALF + wc * 32 + 8 * fq;
        float bb0[8], bb1[8];
#pragma unroll
        for (int j = 0; j < 8; ++j) { bb0[j] = b0[col0 + j]; bb1[j] = b1[col0 + j]; }
#pragma unroll
        for (int ai = 0; ai < 2; ++ai)
#pragma unroll
            for (int m = 0; m < 4; ++m) { const size_t off = (size_t)(row0 + ai * HALF + m * 16) * ldc + col0;
                const u32x4 a = *(const u32x4*)(ta + off), b = *(const u32x4*)(tb + off);
                const float av[8] = {bflo(a.x), bfhi(a.x), bflo(a.y), bfhi(a.y), bflo(a.z), bfhi(a.z), bflo(a.w), bfhi(a.w)};
                const float bv[8] = {bflo(b.x), bfhi(b.x), bflo(b.y), bfhi(b.y), bflo(b.z), bfhi(b.z), bflo(b.w), bfhi(b.w)};
                float h[8];
#pragma unroll
                for (int n = 0; n < 2; ++n)
#pragma unroll
                    for (int j = 0; j < 4; ++j) { const int e = 4 * n + j; h[e] = sigmoidf_fast(acc[ai][0][m][n][j] + bb0[e]) * av[e] + sigmoidf_fast(acc[ai][1][m][n][j] + bb1[e]) * bv[e]; }
                u32x4 w; w.x = cvt_pk_bf16(h[0], h[1]); w.y = cvt_pk_bf16(h[2], h[3]); w.z = cvt_pk_bf16(h[4], h[5]); w.w = cvt_pk_bf16(h[6], h[7]);
                *(u32x4*)(O + off) = w; }
    }
};
struct EpiGateMerge8 {
    static constexpr bool PERM = true, AFTER_DRAIN = false;
    const bf16_t* ta; const bf16_t* tb; unsigned char* O; int ldc; const float* b0; const float* b1; float ascale, ms; LnFold lf;
    __device__ __forceinline__ void operator()(const f32x4 (&acc)[2][2][4][2], const Unit& u, int wr, int wc, int fr, int fq) const {
        const int row0 = u.pm * BM + wr * 64 + fr, col0 = u.pn * HALF + wc * 32 + 8 * fq, cidx = u.pn * BM + wc * 32 + 8 * fq;
        typedef unsigned u32x2 __attribute__((ext_vector_type(2)));
        float mean8[8], rstd8[8]; lf.rows8(row0, mean8, rstd8);
        float bb0[8], bb1[8], gw0[8], gw1[8];
#pragma unroll
        for (int j = 0; j < 8; ++j) { bb0[j] = b0[col0 + j] + lf.bW[cidx + j]; bb1[j] = b1[col0 + j] + lf.bW[cidx + HALF + j]; gw0[j] = lf.gW[cidx + j]; gw1[j] = lf.gW[cidx + HALF + j]; }
#pragma unroll
        for (int am = 0; am < 8; am += 2) {
            u32x4 pa[2], pb[2];
#pragma unroll
            for (int e2 = 0; e2 < 2; ++e2) { const size_t off = (size_t)(row0 + ((am + e2) >> 2) * HALF + ((am + e2) & 3) * 16) * ldc + col0; pa[e2] = *(const u32x4*)(ta + off); pb[e2] = *(const u32x4*)(tb + off); }
#pragma unroll
            for (int e2 = 0; e2 < 2; ++e2) { const int ai = (am + e2) >> 2, m = (am + e2) & 3; const size_t off = (size_t)(row0 + ai * HALF + m * 16) * ldc + col0;
                const u32x4 a = pa[e2], b = pb[e2];
                const float av[8] = {bflo(a.x), bfhi(a.x), bflo(a.y), bfhi(a.y), bflo(a.z), bfhi(a.z), bflo(a.w), bfhi(a.w)};
                const float bv[8] = {bflo(b.x), bfhi(b.x), bflo(b.y), bfhi(b.y), bflo(b.z), bfhi(b.z), bflo(b.w), bfhi(b.w)};
                float h[8]; const float mean = mean8[ai * 4 + m], rstd = rstd8[ai * 4 + m];
#pragma unroll
                for (int n = 0; n < 2; ++n)
#pragma unroll
                    for (int j = 0; j < 4; ++j) { const int e = 4 * n + j; const float v = sigmoidf_fast((acc[ai][0][m][n][j] * ascale - gw0[e] * mean) * rstd + bb0[e]) * av[e] + sigmoidf_fast((acc[ai][1][m][n][j] * ascale - gw1[e] * mean) * rstd + bb1[e]) * bv[e];
                        h[e] = fminf(fmaxf(v * ms, -448.f), 448.f); }
                *(u32x2*)(O + off) = (u32x2){pk4_fp8(h[0], h[1], h[2], h[3]), pk4_fp8(h[4], h[5], h[6], h[7])}; }
            asm volatile("" ::: "memory"); }
    }
};
template <bool RES32, int NB = 2> struct EpiRes {
    static constexpr bool PERM = true, AFTER_DRAIN = false;
    const float* res32; const bf16_t* res16; int ldc; float alpha, s;
    const long long* rstats; const float* rg; const float* rb; long long* ostats; bf16_t* o16; unsigned char* o8; float o8s;
    __device__ __forceinline__ void operator()(const f32x4 (&acc)[2][2][4][2], const Unit& u, int wr, int wc, int fr, int fq) const {
        const int col0 = u.pn * BM + wc * 32 + 8 * fq;
        typedef unsigned u32x2 __attribute__((ext_vector_type(2)));
        float al = alpha, sa = s; asm volatile("" : "+v"(al), "+v"(sa));
        const int rowb = u.pm * BM + wr * 64 + fr;
        float mean8[8], rstd8[8];
#pragma unroll
        for (int q = 0; q < 8; ++q) { mean8[q] = 0.f; rstd8[q] = 1.f; }
        if (rstats) { LnFold lf{rstats, nullptr, nullptr}; lf.rows8(rowb, mean8, rstd8); }
        asm volatile("" : "+v"(mean8[0]), "+v"(mean8[1]), "+v"(mean8[2]), "+v"(mean8[3]), "+v"(mean8[4]), "+v"(mean8[5]), "+v"(mean8[6]), "+v"(mean8[7]), "+v"(rstd8[0]), "+v"(rstd8[1]), "+v"(rstd8[2]), "+v"(rstd8[3]), "+v"(rstd8[4]), "+v"(rstd8[5]), "+v"(rstd8[6]), "+v"(rstd8[7]) :: "memory");
        f32x4 gv[2][2], bv[2][2];
#pragma unroll
        for (int bj = 0; bj < 2; ++bj)
#pragma unroll
            for (int n = 0; n < 2; ++n) { gv[bj][n] = (f32x4){1.f, 1.f, 1.f, 1.f}; bv[bj][n] = (f32x4){0.f, 0.f, 0.f, 0.f};
                if (rstats) { gv[bj][n] = *(const f32x4*)(rg + col0 + bj * HALF + 4 * n); bv[bj][n] = *(const f32x4*)(rb + col0 + bj * HALF + 4 * n); }
                gv[bj][n] = gv[bj][n] * al; bv[bj][n] = bv[bj][n] * al; }
#pragma unroll
        for (int am = 0; am < 8; am += NB) {
            f32x4 rr[RES32 ? NB : 1][2][2]; u32x4 rw[NB][2];
#pragma unroll
            for (int e2 = 0; e2 < NB; ++e2) { const size_t off = (size_t)(rowb + ((am + e2) >> 2) * HALF + ((am + e2) & 3) * 16) * ldc + col0;
#pragma unroll
                for (int bj = 0; bj < 2; ++bj) {
                    if constexpr (RES32) { rr[e2][bj][0] = *(const f32x4*)(res32 + off + bj * HALF); rr[e2][bj][1] = *(const f32x4*)(res32 + off + bj * HALF + 4); }
                    else rw[e2][bj] = *(const u32x4*)(res16 + off + bj * HALF); } }
#pragma unroll
            for (int e2 = 0; e2 < NB; ++e2) { const int ai = (am + e2) >> 2, m = (am + e2) & 3; const int row = rowb + ai * HALF + m * 16; const size_t off = (size_t)row * ldc + col0;
                const float mean = mean8[am + e2], rstd = rstd8[am + e2];
                float ps = 0.f, pq = 0.f;
#pragma unroll
                for (int bj = 0; bj < 2; ++bj) {
                    f32x4 r0, r1;
                    if constexpr (RES32) { r0 = rr[e2][bj][0]; r1 = rr[e2][bj][1]; } else { const u32x4 w = rw[e2][bj]; r0 = (f32x4){bflo(w.x), bfhi(w.x), bflo(w.y), bfhi(w.y)}; r1 = (f32x4){bflo(w.z), bfhi(w.z), bflo(w.w), bfhi(w.w)}; }
                    const f32x4 z0 = (r0 - mean) * rstd * gv[bj][0] + bv[bj][0] + acc[ai][bj][m][0] * sa, z1 = (r1 - mean) * rstd * gv[bj][1] + bv[bj][1] + acc[ai][bj][m][1] * sa;
                    u32x4 w16; w16.x = cvt_pk_bf16(z0[0], z0[1]); w16.y = cvt_pk_bf16(z0[2], z0[3]); w16.z = cvt_pk_bf16(z1[0], z1[1]); w16.w = cvt_pk_bf16(z1[2], z1[3]);
                    *(u32x4*)(o16 + off + bj * HALF) = w16;
                    const float q0 = bflo(w16.x), q1 = bfhi(w16.x), q2 = bflo(w16.y), q3 = bfhi(w16.y), q4 = bflo(w16.z), q5 = bfhi(w16.z), q6 = bflo(w16.w), q7 = bfhi(w16.w);
                    ps += ((q0 + q1) + (q2 + q3)) + ((q4 + q5) + (q6 + q7)); pq += ((q0 * q0 + q1 * q1) + (q2 * q2 + q3 * q3)) + ((q4 * q4 + q5 * q5) + (q6 * q6 + q7 * q7));
                    if (o8) *(u32x2*)(o8 + off + bj * HALF) = (u32x2){pk4_fp8(fminf(fmaxf(q0 * o8s, -448.f), 448.f), fminf(fmaxf(q1 * o8s, -448.f), 448.f), fminf(fmaxf(q2 * o8s, -448.f), 448.f), fminf(fmaxf(q3 * o8s, -448.f), 448.f)),
                                                                      pk4_fp8(fminf(fmaxf(q4 * o8s, -448.f), 448.f), fminf(fmaxf(q5 * o8s, -448.f), 448.f), fminf(fmaxf(q6 * o8s, -448.f), 448.f), fminf(fmaxf(q7 * o8s, -448.f), 448.f))}; }
                if (ostats) { ps += __shfl_xor(ps, 16); ps += __shfl_xor(ps, 32); pq += __shfl_xor(pq, 16); pq += __shfl_xor(pq, 32);
                    if (fq == 0) { (void)__hip_atomic_fetch_add(ostats + 2 * (size_t)row, (long long)__builtin_rintf(ps * 1048576.f), __ATOMIC_RELAXED, __HIP_MEMORY_SCOPE_AGENT); (void)__hip_atomic_fetch_add(ostats + 2 * (size_t)row + 1, (long long)__builtin_rintf(pq * 65536.f), __ATOMIC_RELAXED, __HIP_MEMORY_SCOPE_AGENT); } } }
            asm volatile("" ::: "memory"); }
    }
};

typedef int v8i_t __attribute__((ext_vector_type(8)));
typedef int v4i_t __attribute__((ext_vector_type(4)));
template <class Epi, class Sched, bool ALIGN_EPI, bool FP8 = false>
__device__ __forceinline__ void gemm_phase(PG8_LAS unsigned char* lds, const Gemm g, const Sched& S, const Epi& E, const int wid) {
    const int lane = lane_fresh(), tid = wid * 64 + lane, wr = wid >> 2, wc = wid & 3, fr = lane & 15, fq = lane >> 4;
    const int K = g.K, nt = K / BK;
    unsigned voffA[2], voffB[2];
#pragma unroll
    for (int i = 0; i < 2; ++i) { int R, C; stage_rc(tid * 16 + i * 8192, R, C); const int Rb = Epi::PERM ? ((R & ~31) + perm32(R & 31)) : R;
        voffA[i] = (unsigned)(R * g.lda + C) * 2u; voffB[i] = (unsigned)(Rb * g.ldb + C) * 2u; }
    const size_t kstep = (size_t)(BK * 2);
    const size_t hstepA = (size_t)HALF * g.lda * 2, hstepB = (size_t)HALF * g.ldb * 2;
    const size_t tstepA = 2 * hstepA, tstepB = 2 * hstepB;
    const unsigned ldsw = (unsigned)wid * 1024u;
    int aoff = lds_byte(wr * 64 + fr, fq * 8), boff = lds_byte(wc * 32 + fr, fq * 8);
    asm volatile("" : "+v"(voffA[0]), "+v"(voffA[1]), "+v"(voffB[0]), "+v"(voffB[1]), "+v"(aoff), "+v"(boff));
#define PG8_UA(u) ((const char*)g.A + (size_t)(u).pm * tstepA + (size_t)(((u).pn >> g.a_shift) * g.a_mul) * 2)
#define PG8_UB(u) ((const char*)g.Bt + (size_t)(u).pn * tstepB)
#define PG8_SA(b, h) (((b) * 2 + (h)) * HTB)
#define PG8_SB(b, h) ((4 + (b) * 2 + (h)) * HTB)
#define PG8_STAGE(bufoff, gbase, voff) do { _Pragma("unroll") for (int _i = 0; _i < 2; ++_i) \
        __builtin_amdgcn_global_load_lds((const unsigned*)((const char*)(gbase) + (voff)[_i]), (PG8_LAS unsigned*)(lds + (bufoff) + ldsw + _i * 8192), 16, 0, 0); } while (0)
#define PG8_LD8(p_) __builtin_shufflevector(*(const PG8_LAS v4i_t*)(p_), *(const PG8_LAS v4i_t*)((p_) + 1024), 0, 1, 2, 3, 4, 5, 6, 7)
#define PG8_LDA(dst, b, h) do { _Pragma("unroll") for (int m = 0; m < 4; ++m) { if constexpr (FP8) dst##8[m] = PG8_LD8(lds + PG8_SA(b, h) + aoff + m * 2048); else { _Pragma("unroll") for (int k = 0; k < 2; ++k) dst[m][k] = *(const PG8_LAS bf16x8*)(lds + PG8_SA(b, h) + aoff + m * 2048 + k * 1024); } } } while (0)
#define PG8_LDB(dst, b, h) do { _Pragma("unroll") for (int n = 0; n < 2; ++n) { if constexpr (FP8) dst##8[n] = PG8_LD8(lds + PG8_SB(b, h) + boff + n * 2048); else { _Pragma("unroll") for (int k = 0; k < 2; ++k) dst[n][k] = *(const PG8_LAS bf16x8*)(lds + PG8_SB(b, h) + boff + n * 2048 + k * 1024); } } } while (0)
#define PG8_MMA(ai, bj, At, Bt) do { __builtin_amdgcn_s_setprio(1); _Pragma("unroll") for (int m = 0; m < 4; ++m) _Pragma("unroll") for (int n = 0; n < 2; ++n) { \
        if constexpr (FP8) asm volatile("v_mfma_scale_f32_16x16x128_f8f6f4 %0, %1, %2, %0, %3, %3 op_sel_hi:[0,0,0]" : "+v"(acc[ai][bj][m][n]) : "v"(Bt##8[n]), "v"(At##8[m]), "v"(one_scale)); \
        else { _Pragma("unroll") for (int k = 0; k < 2; ++k) acc[ai][bj][m][n] = __builtin_amdgcn_mfma_f32_16x16x32_bf16(Bt[n][k], At[m][k], acc[ai][bj][m][n], 0, 0, 0); } } \
        __builtin_amdgcn_s_setprio(0); } while (0)
#define PG8_WAIT_V(n) asm volatile("s_waitcnt vmcnt(" #n ")" ::: "memory")
#define PG8_WAIT_L(n) asm volatile("s_waitcnt lgkmcnt(" #n ")" ::: "memory")
#define PG8_BAR __builtin_amdgcn_s_barrier()
#define PG8_SCHED __builtin_amdgcn_sched_barrier(0)
    Unit cur, nxt; int ui = 0;
    if (!S.next(0, cur)) return;
    f32x4 acc[2][2][4][2];
#pragma unroll
    for (int a = 0; a < 2; ++a)
#pragma unroll
        for (int b = 0; b < 2; ++b)
#pragma unroll
            for (int m = 0; m < 4; ++m)
#pragma unroll
                for (int n = 0; n < 2; ++n) acc[a][b][m][n] = (f32x4){0.f, 0.f, 0.f, 0.f};
    bf16x8 At[4][2], B0[2][2], B1[2][2]; v8i_t At8[4], B08[2], B18[2];
    int one_scale = 0x7f7f7f7f; asm volatile("" : "+v"(one_scale));
    const char* cA = PG8_UA(cur); const char* cB = PG8_UB(cur);
    S.a_ready(cur);
    PG8_STAGE(PG8_SB(0, 0), cB, voffB); PG8_STAGE(PG8_SB(0, 1), cB + hstepB, voffB); PG8_STAGE(PG8_SA(0, 0), cA, voffA); PG8_STAGE(PG8_SA(0, 1), cA + hstepA, voffA);
    if (wr == 1) PG8_BAR;
    PG8_WAIT_V(2); PG8_BAR;
    PG8_STAGE(PG8_SB(1, 0), cB + kstep, voffB); PG8_STAGE(PG8_SA(1, 0), cA + kstep, voffA); PG8_STAGE(PG8_SB(1, 1), cB + hstepB + kstep, voffB);
    PG8_WAIT_V(6); PG8_BAR;
    for (;;) {
        const bool has_next = S.next(ui + 1, nxt);
        const char* nA = has_next ? PG8_UA(nxt) : cA; const char* nB = has_next ? PG8_UB(nxt) : cB;
        for (int t = 0; t < nt; t += 2) {
            const bool last = (t == nt - 2);
            const char* a1 = cA + (size_t)(t + 1) * kstep;
            const char* a2 = last ? nA : cA + (size_t)(t + 2) * kstep; const char* b2 = last ? nB : cB + (size_t)(t + 2) * kstep;
            const char* a3 = a2 + kstep; const char* b3 = b2 + kstep;
            if (last && has_next) S.a_ready(nxt);
            PG8_LDB(B0, 0, 0); PG8_LDB(B1, 0, 1); PG8_SCHED; PG8_LDA(At, 0, 0); PG8_STAGE(PG8_SA(1, 1), a1 + hstepA, voffA);
            PG8_WAIT_V(8); PG8_WAIT_L(0); PG8_BAR; PG8_MMA(0, 0, At, B0); PG8_MMA(0, 1, At, B1); PG8_BAR; PG8_SCHED;
            PG8_LDA(At, 0, 1); PG8_STAGE(PG8_SB(0, 0), b2, voffB); PG8_STAGE(PG8_SB(0, 1), b2 + hstepB, voffB); PG8_STAGE(PG8_SA(0, 0), a2, voffA);
            PG8_WAIT_V(8); PG8_WAIT_L(0); PG8_BAR; PG8_MMA(1, 0, At, B0); PG8_MMA(1, 1, At, B1); PG8_BAR; PG8_SCHED;
            PG8_LDB(B0, 1, 0); PG8_LDB(B1, 1, 1); PG8_SCHED; PG8_LDA(At, 1, 0); PG8_STAGE(PG8_SA(0, 1), a2 + hstepA, voffA);
            PG8_WAIT_V(8); PG8_WAIT_L(0); PG8_BAR; PG8_MMA(0, 0, At, B0); PG8_MMA(0, 1, At, B1); PG8_BAR; PG8_SCHED;
            PG8_LDA(At, 1, 1); PG8_STAGE(PG8_SB(1, 0), b3, voffB); PG8_STAGE(PG8_SB(1, 1), b3 + hstepB, voffB); PG8_STAGE(PG8_SA(1, 0), a3, voffA);
            PG8_WAIT_V(8); PG8_WAIT_L(0); PG8_BAR; PG8_MMA(1, 0, At, B0); PG8_MMA(1, 1, At, B1); PG8_BAR; PG8_SCHED;
        }
        if constexpr (ALIGN_EPI) { if (wr == 0) PG8_BAR; }
        if constexpr (FP8) asm volatile("s_nop 15\n\ts_nop 7" ::: "memory");
        { const int le = lane_fresh(); E(acc, cur, wr, wc, le & 15, le >> 4); } S.done(cur);
        if (!has_next) break;
#pragma unroll
        for (int a = 0; a < 2; ++a)
#pragma unroll
            for (int b = 0; b < 2; ++b)
#pragma unroll
                for (int m = 0; m < 4; ++m)
#pragma unroll
                    for (int n = 0; n < 2; ++n) acc[a][b][m][n] = (f32x4){0.f, 0.f, 0.f, 0.f};
        cur = nxt; cA = nA; cB = nB; ++ui;
        if constexpr (ALIGN_EPI) { if (wr == 1) PG8_BAR; }
    }
    PG8_WAIT_V(0);
    if constexpr (!ALIGN_EPI) { if (wr == 0) PG8_BAR; }
    PG8_BAR;
#undef PG8_UA
#undef PG8_UB
#undef PG8_SA
#undef PG8_SB
#undef PG8_STAGE
#undef PG8_LDA
#undef PG8_LDB
#undef PG8_MMA
#undef PG8_LD8
#undef PG8_WAIT_V
#undef PG8_WAIT_L
#undef PG8_BAR
#undef PG8_SCHED
}
}

constexpr int NWAVES = 8;
constexpr int BATCH = 4, SEQ = 4096, D = 2048, FF = 5632, M = BATCH * SEQ;
constexpr int N_IN = 5888;
constexpr int MEMT = 256;
constexpr float LN_EPS = 1e-5f;
constexpr float ALPHA = 1.189207115002721f;
constexpr float LAMBDA_INIT = 0.2f;

constexpr size_t MiB = 1u << 20;
constexpr size_t WS_CTL = 0, CTL_ZERO_BYTES = 2 * MiB;
constexpr size_t WS_W_IN = 2 * MiB;
constexpr size_t WS_W_IN8 = WS_W_IN, WS_W_INB = WS_W_IN + 9 * MiB; constexpr int N_IN8 = 4608, N_INB = 1280;
constexpr size_t WS_W_G = 25 * MiB;
constexpr size_t WS_W_UK = 41 * MiB;
constexpr size_t WS_W_UVP = 42 * MiB;
constexpr size_t WS_W_A = 44 * MiB;
constexpr size_t WS_W_B = 48 * MiB;
constexpr size_t WS_W_MO = 52 * MiB;
constexpr size_t WS_W_MQ = 60 * MiB;
constexpr size_t WS_W_MKV = 62 * MiB;
constexpr size_t WS_W_MOUT = 66 * MiB;
constexpr size_t WS_MEM16 = 68 * MiB;
constexpr size_t WS_KVMEM = 72 * MiB;
constexpr size_t WS_W_GU2 = 74 * MiB;
constexpr size_t WS_W_D2 = 96 * MiB;
constexpr size_t WS_X8M = 107 * MiB;
constexpr size_t WS_X16 = 140 * MiB;
constexpr size_t WS_MIX = 204 * MiB;
constexpr size_t WS_W_GU1 = 204 * MiB;
constexpr size_t WS_W_D1 = 248 * MiB;
constexpr size_t WS_H = 270 * MiB;
constexpr size_t WS_AQ = WS_MIX + 0 * MiB, WS_AK = WS_MIX + 32 * MiB, WS_AV = WS_MIX + 64 * MiB, WS_BQ = WS_MIX + 96 * MiB;
constexpr size_t WS_BC = WS_MIX + 128 * MiB;
constexpr size_t WS_IQ = WS_MIX + 144 * MiB;
constexpr size_t WS_IKW = WS_MIX + 176 * MiB;
constexpr size_t WS_QLAT = WS_MIX + 184 * MiB;
constexpr size_t WS_IDX = WS_MIX + 312 * MiB;
constexpr size_t WS_YB = WS_BQ;
constexpr size_t WS_TA = WS_QLAT, WS_TB = WS_QLAT + 64 * MiB;
constexpr size_t WS_QM = WS_AQ, WS_OM = WS_AQ + 16 * MiB;
constexpr size_t WS_X8 = WS_H + 96 * MiB;
constexpr size_t WS_C8 = WS_W_IN;
constexpr size_t WS_MRG8 = WS_AV;
constexpr float FP8_WGS = 1024.f, FP8_MS = 32.f, FP8_WMOS = 2048.f;
constexpr float FP8_XS = 32.f, FP8_WGUS = 1024.f, FP8_HS = 8.f, FP8_WDS = 4096.f;
constexpr size_t WS_END = WS_MIX + 320 * MiB;
static_assert(WS_H + (size_t)M * FF * 2 <= WS_END && WS_QLAT + (size_t)M * 4096 * 2 <= WS_END, "d_ws map");
constexpr int CW_BAR = 4096;
constexpr int CW_DQ = 8192;
constexpr int CW_KMAX = 8256;
constexpr size_t CTL_STATS = 65536, CTL_STATS_STRIDE = (size_t)M * 2 * 8;
constexpr size_t CTL_VEC = CTL_STATS + 3 * CTL_STATS_STRIDE;
constexpr int V_GW_IN = 0, V_BW_IN = 5888, V_GW_G = 11776, V_BW_G = 15872, V_GW_MQ = 19968, V_BW_MQ = 20480, V_GW_GU2 = 20992, V_BW_GU2 = 32256, V_END = 43520;
constexpr size_t CTL_VECF = CTL_VEC + (size_t)V_END * 8;
static_assert(CTL_VECF + (size_t)V_END * 4 <= CTL_ZERO_BYTES, "control region");
constexpr float FX_S = 1048576.f, FX_Q = 65536.f, FX_V = 16777216.f;

constexpr int RING_OFF = 0, RING_BYTES = 153600;
constexpr int LDSCTL_OFF = RING_BYTES, MISC_OFF = LDSCTL_OFF + 320;
constexpr int LDS_BYTES = 154624;
static_assert(MISC_OFF + 128 <= LDS_BYTES, "LDS map");

#define GAS __attribute__((address_space(1)))
#define LAS __attribute__((address_space(3)))
typedef unsigned short bf16;
typedef unsigned v4u __attribute__((ext_vector_type(4)));
typedef unsigned v2u __attribute__((ext_vector_type(2)));
typedef float f32x4 __attribute__((ext_vector_type(4)));
typedef float f32x16 __attribute__((ext_vector_type(16)));
typedef short bf16x8 __attribute__((ext_vector_type(8)));
typedef GAS unsigned gu32;
#define RLX_AGENT __ATOMIC_RELAXED, __HIP_MEMORY_SCOPE_AGENT
#define LDS_WAIT() asm volatile("s_waitcnt lgkmcnt(0)" ::: "memory")
#define VM_WAIT() asm volatile("s_waitcnt vmcnt(0)" ::: "memory")
__device__ __forceinline__ unsigned f2bf(float f) { unsigned u = __builtin_bit_cast(unsigned, f); return (u + 0x7fffu + ((u >> 16) & 1u)) >> 16; }
__device__ __forceinline__ unsigned pk2(float lo, float hi) { return f2bf(lo) | (f2bf(hi) << 16); }
__device__ __forceinline__ float bf2f(unsigned short v) { return __uint_as_float((unsigned)v << 16); }
__device__ __forceinline__ float blo(unsigned w) { return __uint_as_float(w << 16); }
__device__ __forceinline__ float bhi(unsigned w) { return __uint_as_float(w & 0xffff0000u); }
__device__ __forceinline__ float wave_sum(float v) {
    v += __builtin_bit_cast(float, __builtin_amdgcn_update_dpp(0, __builtin_bit_cast(int, v), 0xB1, 0xf, 0xf, true));
    v += __builtin_bit_cast(float, __builtin_amdgcn_update_dpp(0, __builtin_bit_cast(int, v), 0x4E, 0xf, 0xf, true));
    v += __builtin_bit_cast(float, __builtin_amdgcn_update_dpp(0, __builtin_bit_cast(int, v), 0x141, 0xf, 0xf, true));
    v += __builtin_bit_cast(float, __builtin_amdgcn_update_dpp(0, __builtin_bit_cast(int, v), 0x140, 0xf, 0xf, true));
    { const auto rr = __builtin_amdgcn_permlane16_swap(__float_as_uint(v), __float_as_uint(v), false, false); v = __uint_as_float(rr[0]) + __uint_as_float(rr[1]); }
    { const auto rr = __builtin_amdgcn_permlane32_swap(__float_as_uint(v), __float_as_uint(v), false, false); v = __uint_as_float(rr[0]) + __uint_as_float(rr[1]); }
    return v;
}

__device__ __forceinline__ float xhalf_add(float a) { const auto rr = __builtin_amdgcn_permlane32_swap(__float_as_uint(a), __float_as_uint(a), false, false); return __uint_as_float(rr[0]) + __uint_as_float(rr[1]); }
__device__ __forceinline__ float xhalf_max(float a) { const auto rr = __builtin_amdgcn_permlane32_swap(__float_as_uint(a), __float_as_uint(a), false, false); return fmaxf(__uint_as_float(rr[0]), __uint_as_float(rr[1])); }
__device__ __forceinline__ int half_sum_i32(int v) {
    v += __builtin_amdgcn_update_dpp(0, v, 0xB1, 0xf, 0xf, true);
    v += __builtin_amdgcn_update_dpp(0, v, 0x4E, 0xf, 0xf, true);
    v += __builtin_amdgcn_update_dpp(0, v, 0x141, 0xf, 0xf, true);
    v += __builtin_amdgcn_update_dpp(0, v, 0x140, 0xf, 0xf, true);
    const auto rr = __builtin_amdgcn_permlane16_swap((unsigned)v, (unsigned)v, false, false); return (int)rr[0] + (int)rr[1];
}
#define XB_TMO      128
#define XB_XCNT(j)  (256  + 64 * (j))
#define XB_XSUB(j)  (1280 + 64 * (j))
#define XB_XGEN(j)  (2304 + 64 * (j))
#define XB_TOP      3328
#define XB_TOPGEN   3392
#define XCD_BAR_WORDS 3456
#define XB_SPIN_CAP (1u << 18)

__device__ __forceinline__ unsigned xb_ld(unsigned* p)              { return __hip_atomic_load(p, __ATOMIC_RELAXED, __HIP_MEMORY_SCOPE_AGENT); }
__device__ __forceinline__ unsigned xb_add(unsigned* p, unsigned v) { return __hip_atomic_fetch_add(p, v, __ATOMIC_RELAXED, __HIP_MEMORY_SCOPE_AGENT); }
__device__ __forceinline__ unsigned xb_xcc_id() { return (unsigned)__builtin_amdgcn_s_getreg((3 << 11) | 20) & 0xFu; }
#define XB_SPIN(cond, bar) do { unsigned _sp = 0; while (cond) { __builtin_amdgcn_s_sleep(1); \
    if ((++_sp & 255u) == 0u) { if (xb_ld(&(bar)[XB_TMO])) break; if (_sp > XB_SPIN_CAP) { atomicAdd(&(bar)[XB_TMO], 1u); break; } } } } while (0)

struct XcdBarrier {
    unsigned* bar; unsigned x;
    volatile LAS unsigned* st;
};

__device__ __forceinline__ XcdBarrier xcd_barrier_post(unsigned* bar, volatile LAS unsigned* st, bool t0) {
    XcdBarrier b; b.bar = bar; b.x = xb_xcc_id(); b.st = st;
    if (t0) st[2] = xb_add(&bar[XB_XCNT(b.x)], 1u);
    return b;
}
__device__ __forceinline__ void xcd_barrier_complete(unsigned* bar, unsigned x, unsigned& nloc, unsigned& nx) {
    const unsigned G = gridDim.x * gridDim.y * gridDim.z;
    unsigned sum, cnt, mine, sp = 0u;
    for (;;) {
        sum = 0u; cnt = 0u; mine = 0u;
#pragma unroll
        for (unsigned j = 0; j < 16; ++j) { const unsigned c = xb_ld(&bar[XB_XCNT(j)]); sum += c; cnt += (c > 0u) ? 1u : 0u; mine = (j == x) ? c : mine; }
        if (sum == G) break;
        __builtin_amdgcn_s_sleep(1);
        if ((++sp & 255u) == 0u) { if (xb_ld(&bar[XB_TMO])) break; if (sp > XB_SPIN_CAP) { atomicAdd(&bar[XB_TMO], 1u); break; } }
    }
    nloc = mine > 0u ? mine : 1u; nx = cnt > 0u ? cnt : 1u;
}

__device__ __forceinline__ void xcd_barrier(const XcdBarrier& b, const int wave) {
    asm volatile("s_waitcnt vmcnt(0)" ::: "memory");
    __syncthreads();
    if (wave == 0 && lane_fresh() == 0) {
        unsigned* bar = b.bar;
        __builtin_amdgcn_s_waitcnt(0);
        unsigned nloc = b.st[0], nx = b.st[1];
        if (nloc == 0u) { xcd_barrier_complete(bar, b.x, nloc, nx); b.st[0] = nloc; b.st[1] = nx; }
        const unsigned old = xb_add(&bar[XB_XSUB(b.x)], 1u);
        const unsigned gen = old / nloc;
        if (old + 1u == (gen + 1u) * nloc) {
            __builtin_amdgcn_fence(__ATOMIC_RELEASE, "agent");
            asm volatile("s_waitcnt vmcnt(0)" ::: "memory");
            const unsigned og = xb_add(&bar[XB_TOP], 1u);
            const unsigned tg = og / nx;
            if (og + 1u == (tg + 1u) * nx) xb_add(&bar[XB_TOPGEN], 1u);
            else XB_SPIN(xb_ld(&bar[XB_TOPGEN]) == tg, bar);
            __builtin_amdgcn_fence(__ATOMIC_ACQUIRE, "agent");
            xb_add(&bar[XB_XGEN(b.x)], 1u);
            asm volatile("s_waitcnt vmcnt(0)" ::: "memory");
        } else {
            XB_SPIN(xb_ld(&bar[XB_XGEN(b.x)]) == gen, bar);
            __builtin_amdgcn_fence(__ATOMIC_ACQUIRE, "agent");
            asm volatile("s_waitcnt vmcnt(0)" ::: "memory");
        }
    }
    __syncthreads();
}

__device__ __forceinline__ void tr_item(const float* W, int ldw, int nvalid, bf16* WT, int ldt, int k0, int n0, int drow0, int dcol0, LAS float* scr, int lane) {
    { const int n4 = 4 * (lane & 7), kr = lane >> 3; const bool ok = n0 + n4 < nvalid;
#pragma unroll
      for (int i = 0; i < 8; ++i) { const int kk = 8 * i + kr; const f32x4 v = ok ? *(const GAS f32x4*)(W + (size_t)(k0 + kk) * ldw + n0 + n4) : (f32x4){0.f, 0.f, 0.f, 0.f};
          LAS float* d = scr + kk * 33 + n4; d[0] = v.x; d[1] = v.y; d[2] = v.z; d[3] = v.w; } }
    LDS_WAIT(); asm volatile("" ::: "memory");
    const int c = lane & 7;
#pragma unroll
    for (int j = 0; j < 4; ++j) { const int nn = (lane >> 3) + 8 * j; const LAS float* s = scr + (8 * c) * 33 + nn;
        v4u o; o.x = pk2(s[0 * 33], s[1 * 33]); o.y = pk2(s[2 * 33], s[3 * 33]); o.z = pk2(s[4 * 33], s[5 * 33]); o.w = pk2(s[6 * 33], s[7 * 33]);
        *(GAS v4u*)(WT + (size_t)(drow0 + nn) * ldt + dcol0 + k0 + 8 * c) = o; }
    LDS_WAIT(); asm volatile("" ::: "memory");
}
__device__ __forceinline__ void tr_item8(const float* W, int ldw, unsigned char* WT, int ldt, int k0, int n0, int drow0, float sc, LAS float* scr, int lane) {
    { const int n4 = 4 * (lane & 7), kr = lane >> 3;
#pragma unroll
      for (int i = 0; i < 8; ++i) { const int kk = 8 * i + kr; const f32x4 v = *(const GAS f32x4*)(W + (size_t)(k0 + kk) * ldw + n0 + n4);
          LAS float* d = scr + kk * 33 + n4; d[0] = v.x; d[1] = v.y; d[2] = v.z; d[3] = v.w; } }
    LDS_WAIT(); asm volatile("" ::: "memory");
    const int nn = lane >> 1, hf = lane & 1; const LAS float* sp = scr + (32 * hf) * 33 + nn;
    unsigned o[8];
#pragma unroll
    for (int q = 0; q < 8; ++q) { const float a = fminf(fmaxf(sp[(4 * q + 0) * 33] * sc, -448.f), 448.f), b = fminf(fmaxf(sp[(4 * q + 1) * 33] * sc, -448.f), 448.f), c = fminf(fmaxf(sp[(4 * q + 2) * 33] * sc, -448.f), 448.f), d = fminf(fmaxf(sp[(4 * q + 3) * 33] * sc, -448.f), 448.f);
        int w = 0; w = __builtin_amdgcn_cvt_pk_fp8_f32(a, b, w, false); w = __builtin_amdgcn_cvt_pk_fp8_f32(c, d, w, true); o[q] = (unsigned)w; }
    GAS v4u* dst = (GAS v4u*)(WT + (size_t)(drow0 + nn) * ldt + k0 + 32 * hf);
    dst[0] = (v4u){o[0], o[1], o[2], o[3]}; dst[1] = (v4u){o[4], o[5], o[6], o[7]};
    LDS_WAIT(); asm volatile("" ::: "memory");
}
__device__ __forceinline__ void tr_item_ln(const float* W, int ldw, int nvalid, bf16* WT, int ldt, int k0, int n0, int drow0, const float* gain, const float* bvec, long long* gW, long long* bW, LAS float* scr, int lane) {
    { const int n4 = 4 * (lane & 7), kr = lane >> 3; const bool ok = n0 + n4 < nvalid;
#pragma unroll
      for (int i = 0; i < 8; ++i) { const int kk = 8 * i + kr; const f32x4 v = ok ? *(const GAS f32x4*)(W + (size_t)(k0 + kk) * ldw + n0 + n4) : (f32x4){0.f, 0.f, 0.f, 0.f};
          LAS float* d = scr + kk * 33 + n4; d[0] = v.x; d[1] = v.y; d[2] = v.z; d[3] = v.w; } }
    LDS_WAIT(); asm volatile("" ::: "memory");
    const int c = lane & 7;
    const f32x4 g0 = *(const GAS f32x4*)(gain + k0 + 8 * c), g1 = *(const GAS f32x4*)(gain + k0 + 8 * c + 4), b0 = *(const GAS f32x4*)(bvec + k0 + 8 * c), b1 = *(const GAS f32x4*)(bvec + k0 + 8 * c + 4);
    const float gk[8] = {g0.x, g0.y, g0.z, g0.w, g1.x, g1.y, g1.z, g1.w}, bk[8] = {b0.x, b0.y, b0.z, b0.w, b1.x, b1.y, b1.z, b1.w};
#pragma unroll
    for (int j = 0; j < 4; ++j) { const int nn = (lane >> 3) + 8 * j; const LAS float* sp = scr + (8 * c) * 33 + nn;
        float v[8], bs = 0.f;
#pragma unroll
        for (int i = 0; i < 8; ++i) { const float raw = sp[i * 33]; v[i] = raw * gk[i]; bs += raw * bk[i]; }
        v4u o; o.x = pk2(v[0], v[1]); o.y = pk2(v[2], v[3]); o.z = pk2(v[4], v[5]); o.w = pk2(v[6], v[7]);
        float gs = ((blo(o.x) + bhi(o.x)) + (blo(o.y) + bhi(o.y))) + ((blo(o.z) + bhi(o.z)) + (blo(o.w) + bhi(o.w)));
        *(GAS v4u*)(WT + (size_t)(drow0 + nn) * ldt + k0 + 8 * c) = o;
        gs += __shfl_xor(gs, 1); gs += __shfl_xor(gs, 2); gs += __shfl_xor(gs, 4); bs += __shfl_xor(bs, 1); bs += __shfl_xor(bs, 2); bs += __shfl_xor(bs, 4);
        if (c == 0) { (void)__hip_atomic_fetch_add(gW + drow0 + nn, (long long)__builtin_rintf(gs * FX_V), __ATOMIC_RELAXED, __HIP_MEMORY_SCOPE_AGENT); (void)__hip_atomic_fetch_add(bW + drow0 + nn, (long long)__builtin_rintf(bs * FX_V), __ATOMIC_RELAXED, __HIP_MEMORY_SCOPE_AGENT); } }
    LDS_WAIT(); asm volatile("" ::: "memory");
}
__device__ __forceinline__ void tr_item8_ln(const float* W, int ldw, unsigned char* WT, int ldt, int k0, int n0, int drow0, float sc, const float* gain, const float* bvec, long long* gW, long long* bW, LAS float* scr, int lane) {
    { const int n4 = 4 * (lane & 7), kr = lane >> 3;
#pragma unroll
      for (int i = 0; i < 8; ++i) { const int kk = 8 * i + kr; const f32x4 v = *(const GAS f32x4*)(W + (size_t)(k0 + kk) * ldw + n0 + n4);
          LAS float* d = scr + kk * 33 + n4; d[0] = v.x; d[1] = v.y; d[2] = v.z; d[3] = v.w; } }
    LDS_WAIT(); asm volatile("" ::: "memory");
    const int nn = lane >> 1, hf = lane & 1; const LAS float* sp = scr + (32 * hf) * 33 + nn;
    unsigned o[8]; float gs = 0.f, bs = 0.f;
#pragma unroll
    for (int q = 0; q < 8; ++q) { const f32x4 g4 = *(const GAS f32x4*)(gain + k0 + 32 * hf + 4 * q), b4 = *(const GAS f32x4*)(bvec + k0 + 32 * hf + 4 * q);
        const float r0 = sp[(4 * q + 0) * 33], r1 = sp[(4 * q + 1) * 33], r2 = sp[(4 * q + 2) * 33], r3 = sp[(4 * q + 3) * 33];
        bs += (r0 * b4.x + r1 * b4.y) + (r2 * b4.z + r3 * b4.w);
        const float a = fminf(fmaxf(r0 * g4.x * sc, -448.f), 448.f), b = fminf(fmaxf(r1 * g4.y * sc, -448.f), 448.f), c = fminf(fmaxf(r2 * g4.z * sc, -448.f), 448.f), d = fminf(fmaxf(r3 * g4.w * sc, -448.f), 448.f);
        int w = 0; w = __builtin_amdgcn_cvt_pk_fp8_f32(a, b, w, false); w = __builtin_amdgcn_cvt_pk_fp8_f32(c, d, w, true); o[q] = (unsigned)w;
        gs += (__builtin_amdgcn_cvt_f32_fp8(w, 0) + __builtin_amdgcn_cvt_f32_fp8(w, 1)) + (__builtin_amdgcn_cvt_f32_fp8(w, 2) + __builtin_amdgcn_cvt_f32_fp8(w, 3)); }
    GAS v4u* dst = (GAS v4u*)(WT + (size_t)(drow0 + nn) * ldt + k0 + 32 * hf);
    dst[0] = (v4u){o[0], o[1], o[2], o[3]}; dst[1] = (v4u){o[4], o[5], o[6], o[7]};
    gs += __shfl_xor(gs, 1); bs += __shfl_xor(bs, 1);
    if (hf == 0) { (void)__hip_atomic_fetch_add(gW + drow0 + nn, (long long)__builtin_rintf(gs / sc * FX_V), __ATOMIC_RELAXED, __HIP_MEMORY_SCOPE_AGENT); (void)__hip_atomic_fetch_add(bW + drow0 + nn, (long long)__builtin_rintf(bs * FX_V), __ATOMIC_RELAXED, __HIP_MEMORY_SCOPE_AGENT); }
    LDS_WAIT(); asm volatile("" ::: "memory");
}
__device__ __forceinline__ void cvt_item8(const float* src, unsigned char* dst, int item, int lane, float sc) {
    const GAS f32x4* sp = (const GAS f32x4*)(src + (size_t)item * 512) + 2 * lane; f32x4 a = sp[0] * sc, b = sp[1] * sc;
    int w0 = 0, w1 = 0; w0 = __builtin_amdgcn_cvt_pk_fp8_f32(fminf(fmaxf(a.x, -448.f), 448.f), fminf(fmaxf(a.y, -448.f), 448.f), w0, false); w0 = __builtin_amdgcn_cvt_pk_fp8_f32(fminf(fmaxf(a.z, -448.f), 448.f), fminf(fmaxf(a.w, -448.f), 448.f), w0, true);
    w1 = __builtin_amdgcn_cvt_pk_fp8_f32(fminf(fmaxf(b.x, -448.f), 448.f), fminf(fmaxf(b.y, -448.f), 448.f), w1, false); w1 = __builtin_amdgcn_cvt_pk_fp8_f32(fminf(fmaxf(b.z, -448.f), 448.f), fminf(fmaxf(b.w, -448.f), 448.f), w1, true);
    *((GAS v2u*)(dst + (size_t)item * 512) + lane) = (v2u){(unsigned)w0, (unsigned)w1};
}
__device__ __forceinline__ void cvt_item(const float* src, bf16* dst, int item, int lane) {
    const GAS f32x4* s = (const GAS f32x4*)(src + (size_t)item * 512) + 2 * lane; const f32x4 a = s[0], b = s[1];
    v4u o; o.x = pk2(a.x, a.y); o.y = pk2(a.z, a.w); o.z = pk2(b.x, b.y); o.w = pk2(b.z, b.w);
    *((GAS v4u*)(dst + (size_t)item * 512) + lane) = o;
}
__device__ __forceinline__ void p0_prologue(const float* const (&in)[24], unsigned char* ws, LAS unsigned char* lds, int gw, int NGW, int wave, int lane) {
    LAS float* scr = (LAS float*)(lds + RING_OFF + wave * 16384);
#define TRM(SRC, Kk, LDW, NVALID, NPAD, DST, LDT, ROWMAP, DCOL) { constexpr int nblk = (NPAD) / 32; constexpr int cnt = ((Kk) / 64) * nblk; \
        if (r < cnt) { const int kb = r / nblk, nb = r % nblk, n0 = 32 * nb; tr_item(SRC, LDW, NVALID, (bf16*)(ws + (DST)), LDT, 64 * kb, n0, (ROWMAP), (DCOL), scr, lane); continue; } r -= cnt; }
#define TRM8(SRC, Kk, LDW, NN, DST, LDT, ROWMAP, SC) { constexpr int nblk = (NN) / 32; constexpr int cnt = ((Kk) / 64) * nblk; \
        if (r < cnt) { const int kb = r / nblk, nb = r % nblk, n0 = 32 * nb; tr_item8(SRC, LDW, (unsigned char*)(ws + (DST)), LDT, 64 * kb, n0, (ROWMAP), SC, scr, lane); continue; } r -= cnt; }
    long long* const vec = (long long*)(ws + WS_CTL + CTL_VEC);
#define TRML(SRC, Kk, LDW, NVALID, NPAD, DST, LDT, ROWMAP, GAIN, BVEC, VG, VB) { constexpr int nblk = (NPAD) / 32; constexpr int cnt = ((Kk) / 64) * nblk; \
        if (r < cnt) { const int kb = r / nblk, nb = r % nblk, n0 = 32 * nb; tr_item_ln(SRC, LDW, NVALID, (bf16*)(ws + (DST)), LDT, 64 * kb, n0, (ROWMAP), GAIN, BVEC, vec + (VG), vec + (VB), scr, lane); continue; } r -= cnt; }
#define TRML8(SRC, Kk, LDW, NN, DST, LDT, ROWMAP, SC, GAIN, BVEC, VG, VB) { constexpr int nblk = (NN) / 32; constexpr int cnt = ((Kk) / 64) * nblk; \
        if (r < cnt) { const int kb = r / nblk, nb = r % nblk, n0 = 32 * nb; tr_item8_ln(SRC, LDW, (unsigned char*)(ws + (DST)), LDT, 64 * kb, n0, (ROWMAP), SC, GAIN, BVEC, vec + (VG), vec + (VB), scr, lane); continue; } r -= cnt; }
    constexpr int N_TR = 2 * (32 * 176) + 88 * 64 + 32 * 184 + 2 * (32 * 64) + 256 + 2 * (16 * 64) + 32 * 64 + 32 * 16 + 32 * 32 + 8 * 64 + 2 * (32 * 176) + 88 * 64;
    for (int it = gw; it < N_TR; it += NGW) {
        int r = it;
        TRM8(in[2], 2048, 5632, 5632, WS_W_GU1, 2048, 256 * (n0 >> 7) + (n0 & 127), FP8_WGUS)
        TRM8(in[3], 2048, 5632, 5632, WS_W_GU1, 2048, 256 * (n0 >> 7) + 128 + (n0 & 127), FP8_WGUS)
        TRM8(in[4], 5632, 2048, 2048, WS_W_D1, 5632, n0, FP8_WDS)
        TRML8(in[5], 2048, 5712, 4608, WS_W_IN8, 2048, n0, FP8_WGS, in[22], in[23], V_GW_IN, V_BW_IN)
        TRML(in[5] + 4608, 2048, 5712, 1104, 1280, WS_W_INB, 2048, n0, in[22], in[23], V_GW_IN + 4608, V_BW_IN + 4608)
        TRML8(in[11], 2048, 2048, 2048, WS_W_G, 2048, 256 * (n0 >> 7) + (n0 & 127), FP8_WGS, in[22], in[23], V_GW_G, V_BW_G)
        TRML8(in[11] + (size_t)2048 * 2048, 2048, 2048, 2048, WS_W_G, 2048, 256 * (n0 >> 7) + 128 + (n0 & 127), FP8_WGS, in[22], in[23], V_GW_G, V_BW_G)
        if (r < 256) { const int h = r >> 5, rr = r & 31, kb = rr >> 2, nb = rr & 3;
            tr_item(in[10] + (size_t)h * 512 * 128, 128, 128, (bf16*)(ws + WS_W_UVP), 1024, 64 * kb, 32 * nb, (h >> 1) * 256 + (h & 1) * 128 + 32 * nb, (h & 1) * 512, scr, lane); continue; } r -= 256;
        TRM(in[13], 1024, 2048, 2048, 2048, WS_W_A, 1024, n0, 0)
        TRM(in[14], 1024, 2048, 2048, 2048, WS_W_B, 1024, n0, 0)
        TRM8(in[15], 2048, 2048, 2048, WS_W_MO, 2048, n0, FP8_WMOS)
        TRML(in[16], 2048, 512, 512, 512, WS_W_MQ, 2048, n0, in[22] + D, in[23] + D, V_GW_MQ, V_BW_MQ)
        TRM(in[17], 2048, 1024, 1024, 1024, WS_W_MKV, 2048, n0, 0)
        TRM(in[18], 512, 2048, 2048, 2048, WS_W_MOUT, 512, n0, 0)
        TRML8(in[19], 2048, 5632, 5632, WS_W_GU2, 2048, 256 * (n0 >> 7) + (n0 & 127), FP8_WGUS, in[22] + 2 * D, in[23] + 2 * D, V_GW_GU2, V_BW_GU2)
        TRML8(in[20], 2048, 5632, 5632, WS_W_GU2, 2048, 256 * (n0 >> 7) + 128 + (n0 & 127), FP8_WGUS, in[22] + 2 * D, in[23] + 2 * D, V_GW_GU2, V_BW_GU2)
        TRM8(in[21], 5632, 2048, 2048, WS_W_D2, 5632, n0, FP8_WDS)
    }
#undef TRM
#undef TRM8
#undef TRML
#undef TRML8
    for (int rw = gw; rw < 1024; rw += NGW) { const int e = (rw >> 7) & 1; *((GAS v4u*)((bf16*)(ws + WS_W_UVP) + (size_t)rw * 1024 + (1 - e) * 512) + lane) = (v4u){0u, 0u, 0u, 0u}; }
    for (int it = gw; it < (M * D) / 512; it += NGW) cvt_item8(in[0], (unsigned char*)(ws + WS_X8), it, lane, FP8_XS);
    for (int it = gw; it < (BATCH * MEMT * D) / 512; it += NGW) cvt_item(in[1], (bf16*)(ws + WS_MEM16), it, lane);
    for (int it = gw; it < (8 * 512 * 128) / 512; it += NGW) cvt_item(in[9], (bf16*)(ws + WS_W_UK), it, lane);
}

__device__ __forceinline__ void ln_phase(float* zx, bf16* x16, unsigned char* x8, const float* g, const float* b, int gw, int NGW, int lane) {
    f32x4 gv[8], bv[8];
#pragma unroll
    for (int j = 0; j < 8; ++j) { gv[j] = *((const GAS f32x4*)g + lane + 64 * j); bv[j] = *((const GAS f32x4*)b + lane + 64 * j); }
    for (int m = gw; m < M; m += NGW) {
        GAS f32x4* xr = (GAS f32x4*)(zx + (size_t)m * D) + lane;
        f32x4 v[8]; float s = 0.f;
#pragma unroll
        for (int j = 0; j < 8; ++j) { v[j] = xr[64 * j]; s += (v[j].x + v[j].y) + (v[j].z + v[j].w); }
        const float mean = wave_sum(s) * (1.f / D); float s2 = 0.f;
#pragma unroll
        for (int j = 0; j < 8; ++j) { v[j] = v[j] - mean; s2 += (v[j].x * v[j].x + v[j].y * v[j].y) + (v[j].z * v[j].z + v[j].w * v[j].w); }
        const float rstd = 1.f / sqrtf(wave_sum(s2) * (1.f / D) + LN_EPS);
#pragma unroll
        for (int j = 0; j < 8; ++j) { v[j] = v[j] * rstd * gv[j] + bv[j]; xr[64 * j] = v[j]; }
        if (x16) { GAS v2u* o8 = (GAS v2u*)(x16 + (size_t)m * D) + lane;
#pragma unroll
            for (int j = 0; j < 8; ++j) o8[64 * j] = (v2u){pk2(v[j].x, v[j].y), pk2(v[j].z, v[j].w)}; }
        if (x8) { GAS unsigned* o4 = (GAS unsigned*)(x8 + (size_t)m * D) + lane;
#pragma unroll
            for (int j = 0; j < 8; ++j) { const f32x4 q = v[j] * FP8_XS; int w = 0; w = __builtin_amdgcn_cvt_pk_fp8_f32(fminf(fmaxf(q.x, -448.f), 448.f), fminf(fmaxf(q.y, -448.f), 448.f), w, false);
                w = __builtin_amdgcn_cvt_pk_fp8_f32(fminf(fmaxf(q.z, -448.f), 448.f), fminf(fmaxf(q.w, -448.f), 448.f), w, true); o4[64 * j] = (unsigned)w; } }
    }
}
__device__ __forceinline__ void ln_final_phase(const bf16* z16, float* outp, const float* g, const float* b, int gw, int NGW, int lane) {
    for (int m0 = gw; m0 < M; m0 += 2 * NGW) {
        const int m1 = m0 + NGW; const bool two = m1 < M;
        v4u w[2][4];
#pragma unroll
        for (int j = 0; j < 4; ++j) { w[0][j] = __builtin_nontemporal_load((const GAS v4u*)(z16 + (size_t)m0 * D) + lane + 64 * j); w[1][j] = two ? __builtin_nontemporal_load((const GAS v4u*)(z16 + (size_t)m1 * D) + lane + 64 * j) : (v4u){0u, 0u, 0u, 0u}; }
#pragma unroll
        for (int rr = 0; rr < 2; ++rr) { if (rr == 1 && !two) break;
            const int m = rr ? m1 : m0;
            float v[32]; float s = 0.f;
#pragma unroll
            for (int j = 0; j < 4; ++j) { const v4u x = w[rr][j]; v[8 * j + 0] = blo(x.x); v[8 * j + 1] = bhi(x.x); v[8 * j + 2] = blo(x.y); v[8 * j + 3] = bhi(x.y); v[8 * j + 4] = blo(x.z); v[8 * j + 5] = bhi(x.z); v[8 * j + 6] = blo(x.w); v[8 * j + 7] = bhi(x.w); }
#pragma unroll
            for (int e = 0; e < 32; ++e) s += v[e];
            const float mean = wave_sum(s) * (1.f / D); float s2 = 0.f;
#pragma unroll
            for (int e = 0; e < 32; ++e) { v[e] -= mean; s2 += v[e] * v[e]; }
            const float rstd = 1.f / sqrtf(wave_sum(s2) * (1.f / D) + LN_EPS);
#pragma unroll
            for (int j = 0; j < 4; ++j) { const int c0 = 512 * j + 8 * lane;
                const f32x4 g0 = *(const GAS f32x4*)(g + c0), g1 = *(const GAS f32x4*)(g + c0 + 4), b0 = *(const GAS f32x4*)(b + c0), b1 = *(const GAS f32x4*)(b + c0 + 4);
                GAS f32x4* o = (GAS f32x4*)(outp + (size_t)m * D + c0);
                __builtin_nontemporal_store((f32x4){v[8 * j + 0], v[8 * j + 1], v[8 * j + 2], v[8 * j + 3]} * rstd * g0 + b0, o); __builtin_nontemporal_store((f32x4){v[8 * j + 4], v[8 * j + 5], v[8 * j + 6], v[8 * j + 7]} * rstd * g1 + b1, o + 1); } }
    }
}
__device__ __forceinline__ void crms_phase(const bf16* bc, unsigned char* c8, const float* kvg, float cs, int gw, int NGW, int lane) {
    float gg[8];
#pragma unroll
    for (int j = 0; j < 8; ++j) gg[j] = kvg[8 * lane + j] * cs;
    for (int m = gw; m < M; m += NGW) {
        const v4u w = *((const GAS v4u*)(bc + (size_t)m * 512) + lane);
        float x[8] = {blo(w.x), bhi(w.x), blo(w.y), bhi(w.y), blo(w.z), bhi(w.z), blo(w.w), bhi(w.w)}; float s = 0.f;
#pragma unroll
        for (int j = 0; j < 8; ++j) s += x[j] * x[j];
        const float r = 1.f / sqrtf(wave_sum(s) * (1.f / 512.f) + LN_EPS);
#pragma unroll
        for (int j = 0; j < 8; ++j) x[j] = fminf(fmaxf(x[j] * r * gg[j], -448.f), 448.f);
        *((GAS v2u*)(c8 + (size_t)m * 512) + lane) = (v2u){pg8::pk4_fp8(x[0], x[1], x[2], x[3]), pg8::pk4_fp8(x[4], x[5], x[6], x[7])};
    }
}
typedef short v4i16_t __attribute__((ext_vector_type(4)));
__device__ __forceinline__ v4i16_t lds_tr16(const LAS unsigned char* p) { return __builtin_amdgcn_ds_read_tr16_b64_v4i16((LAS v4i16_t*)p); }
__device__ __forceinline__ unsigned cvtpk(float lo, float hi) { typedef float f2 __attribute__((ext_vector_type(2))); typedef __bf16 b2 __attribute__((ext_vector_type(2))); f2 v = {lo, hi}; b2 b = __builtin_convertvector(v, b2); return __builtin_bit_cast(unsigned, b); }
__device__ __forceinline__ float xhalf_f(float v) { return __shfl_xor(v, 32); }
constexpr float LOG2E = 1.4426950408889634f;
constexpr float QSCALE = 0.125f * LOG2E;

__device__ __forceinline__ void diff_attn_mfma(LAS unsigned char* lds, const bf16* AQ, const bf16* AK, const bf16* AV, bf16* YA, const float* dlam, const float* subg, unsigned* dq, const unsigned* kmax, const int wave) {
    const int lane = lane_fresh(), r32 = lane & 31, hi = lane >> 5;
    const int comp = wave >> 2, wq = wave & 3;
    const unsigned ksrc = (unsigned)(lane * 1024 + (2 * wave) * 8);
    const unsigned vsrc0 = (unsigned)((16 * ((2 * wave) & 3) + (lane >> 2)) * 1024 + ((2 * wave) >> 2) * 32 + (lane & 3) * 8);
    const unsigned vsrc1 = (unsigned)((16 * ((2 * wave + 1) & 3) + (lane >> 2)) * 1024 + ((2 * wave + 1) >> 2) * 32 + (lane & 3) * 8);
    const unsigned kdst = (unsigned)(2 * wave) * 1024u, vdst0 = 16384u + (unsigned)(((2 * wave) >> 2) * 4096 + ((2 * wave) & 3) * 1024), vdst1 = 16384u + (unsigned)(((2 * wave + 1) >> 2) * 4096 + ((2 * wave + 1) & 3) * 1024);
    const unsigned lds0 = (unsigned)(uintptr_t)lds;
#define DA_STAGE(bo, to) do { \
        glds16(Kg + (to) + ksrc, (unsigned)__builtin_amdgcn_readfirstlane((int)(lds0 + (bo) + kdst))); \
        glds16(Kg + (to) + ksrc + 8, (unsigned)__builtin_amdgcn_readfirstlane((int)(lds0 + (bo) + kdst + 1024))); \
        glds16(Vg + (to) + vsrc0, (unsigned)__builtin_amdgcn_readfirstlane((int)(lds0 + (bo) + vdst0))); \
        glds16(Vg + (to) + vsrc1, (unsigned)__builtin_amdgcn_readfirstlane((int)(lds0 + (bo) + vdst1))); } while (0)
#define DA_WAITBAR() asm volatile("s_waitcnt vmcnt(0) lgkmcnt(0)\n\ts_barrier" ::: "memory")
    const unsigned koff = (unsigned)(((comp * 8 + hi) * 64 + r32) * 16);
    const unsigned voff = (unsigned)(16384 + (4 * hi + ((lane & 15) >> 2)) * 64 + ((lane >> 4) & 1) * 32 + (lane & 3) * 8);
    LAS unsigned* xq = (LAS unsigned*)(lds + 100352);
    for (;;) {
        if (wave == 0 && lane == 0) xq[0] = __hip_atomic_fetch_add(dq, 1u, __ATOMIC_RELAXED, __HIP_MEMORY_SCOPE_AGENT);
        asm volatile("s_waitcnt vmcnt(0) lgkmcnt(0)\n\ts_barrier" ::: "memory");
        const int j = (int)xq[0];
        if (j >= 1024) break;
        const int ub = 31 - (j >> 5), bh = j & 31;
        const int b = bh >> 3, h = 7 - (bh & 7);
        const float sl2 = LOG2E / (float)(2 << h);
        const size_t rowbase = (size_t)b * SEQ; const int q0 = ub * 128;
        const int qpos = q0 + wq * 32 + r32;
        const int nt = 2 * ub + 2;
        const int myt = 2 * ub + 1 + (wq >> 1);
        const bf16* Kg = AK + rowbase * 1024 + h * 128; const bf16* Vg = AV + rowbase * 1024 + h * 128;
        bf16x8 qr[4];
#pragma unroll
        for (int s = 0; s < 4; ++s) qr[s] = *(const GAS bf16x8*)(AQ + (rowbase + qpos) * 1024 + h * 128 + comp * 64 + s * 16 + hi * 8);
        f32x16 o[4];
#pragma unroll
        for (int blk = 0; blk < 4; ++blk)
#pragma unroll
            for (int r = 0; r < 16; ++r) o[blk][r] = 0.f;
        float mrun = -INFINITY, lrun = 0.f;
        { float qn2 = 0.f;
#pragma unroll
          for (int s = 0; s < 4; ++s) { const v4u w = __builtin_bit_cast(v4u, qr[s]); const float e0 = blo(w.x), e1 = bhi(w.x), e2 = blo(w.y), e3 = bhi(w.y), e4 = blo(w.z), e5 = bhi(w.z), e6 = blo(w.w), e7 = bhi(w.w);
              qn2 += ((e0 * e0 + e1 * e1) + (e2 * e2 + e3 * e3)) + ((e4 * e4 + e5 * e5) + (e6 * e6 + e7 * e7)); }
          qn2 += xhalf_f(qn2);
#pragma unroll
          for (int o_ = 1; o_ < 32; o_ <<= 1) qn2 = fmaxf(qn2, __shfl_xor(qn2, o_));
          const float kb = __uint_as_float(__hip_atomic_load(kmax + (b * 8 + h) * 2 + comp, __ATOMIC_RELAXED, __HIP_MEMORY_SCOPE_AGENT));
          if (lane == 0) xq[8 + wave] = __float_as_uint(sqrtf(qn2) * kb * 8.1f); }
        DA_STAGE(0u, (size_t)(nt - 1) * 64 * 1024);
        DA_WAITBAR();
        int kt_lo = 0;
        { float sb = 0.f;
#pragma unroll
          for (int w_ = 0; w_ < 8; ++w_) sb = fmaxf(sb, __uint_as_float(xq[8 + w_]));
          const float xcut = (float)(q0 - 63) - (40.f + 2.f * sb) / sl2;
          kt_lo = xcut > 0.f ? (int)__builtin_ceilf(xcut * (1.f / 64.f)) : 0; kt_lo = __builtin_amdgcn_readfirstlane(kt_lo); }
        for (int st = 0; st < nt - kt_lo; ++st) {
            const int kt = nt - 1 - st;
            const unsigned bufo = (unsigned)(st & 1) * 32768u;
            if (kt > kt_lo) DA_STAGE(32768u - bufo, (size_t)(kt - 1) * 64 * 1024);
            if (kt < myt) {
                const LAS unsigned char* Kb = lds + bufo + koff;
                f32x16 p0, p1;
#pragma unroll
                for (int r = 0; r < 16; ++r) { p0[r] = 0.f; p1[r] = 0.f; }
                { bf16x8 kf[4];
#pragma unroll
                  for (int s = 0; s < 4; ++s) kf[s] = *(const LAS bf16x8*)(Kb + s * 2048);
#pragma unroll
                  for (int s = 0; s < 4; ++s) p0 = __builtin_amdgcn_mfma_f32_32x32x16_bf16(kf[s], qr[s], p0, 0, 0, 0); }
                { bf16x8 kf[4];
#pragma unroll
                  for (int s = 0; s < 4; ++s) kf[s] = *(const LAS bf16x8*)(Kb + s * 2048 + 512);
#pragma unroll
                  for (int s = 0; s < 4; ++s) p1 = __builtin_amdgcn_mfma_f32_32x32x16_bf16(kf[s], qr[s], p1, 0, 0, 0); }
                const float qth = (float)(qpos - kt * 64 - 4 * hi);
                float rm = -INFINITY;
#pragma unroll
                for (int r = 0; r < 16; ++r) { const float kr = (float)((r & 3) + 8 * (r >> 2)); const float v0 = qth - kr, v1 = qth - (kr + 32.f);
                    p0[r] = p0[r] - sl2 * fabsf(v0); p1[r] = p1[r] - sl2 * fabsf(v1); rm = fmaxf(rm, fmaxf(p0[r], p1[r])); }
                rm = fmaxf(rm, xhalf_f(rm));
                if (__any(rm > mrun)) { const float mn = fmaxf(mrun, rm), f = __builtin_amdgcn_exp2f(mrun - mn); mrun = mn; lrun *= f;
#pragma unroll
                    for (int blk = 0; blk < 4; ++blk)
#pragma unroll
                        for (int r = 0; r < 16; ++r) o[blk][r] *= f; }
                float ls = 0.f;
#pragma unroll
                for (int r = 0; r < 16; ++r) { p0[r] = __builtin_amdgcn_exp2f(p0[r] - mrun); p1[r] = __builtin_amdgcn_exp2f(p1[r] - mrun); ls += p0[r] + p1[r]; }
                lrun += ls;
                bf16x8 pw[4];
#pragma unroll
                for (int s = 0; s < 2; ++s) {
                    v4u a = {cvtpk(p0[8 * s + 0], p0[8 * s + 1]), cvtpk(p0[8 * s + 2], p0[8 * s + 3]), cvtpk(p0[8 * s + 4], p0[8 * s + 5]), cvtpk(p0[8 * s + 6], p0[8 * s + 7])};
                    v4u c = {cvtpk(p1[8 * s + 0], p1[8 * s + 1]), cvtpk(p1[8 * s + 2], p1[8 * s + 3]), cvtpk(p1[8 * s + 4], p1[8 * s + 5]), cvtpk(p1[8 * s + 6], p1[8 * s + 7])};
                    pw[s] = __builtin_bit_cast(bf16x8, a); pw[2 + s] = __builtin_bit_cast(bf16x8, c); }
                const LAS unsigned char* Vb = lds + bufo + voff;
#pragma unroll
                for (int blk = 0; blk < 4; ++blk) {
#pragma unroll
                    for (int s = 0; s < 4; ++s) {
                        const v4i16_t lo = lds_tr16(Vb + blk * 4096 + s * 1024), hh = lds_tr16(Vb + blk * 4096 + s * 1024 + 512);
                        const bf16x8 vf = {lo[0], lo[1], lo[2], lo[3], hh[0], hh[1], hh[2], hh[3]};
                        o[blk] = __builtin_amdgcn_mfma_f32_32x32x16_bf16(vf, pw[s], o[blk], 0, 0, 0);
                    }
                }
            }
            DA_WAITBAR();
        }
        lrun += xhalf_f(lrun);
        const float inv = 1.f / lrun;
        LAS float* Y1 = (LAS float*)(lds) + wq * 4096;
        if (comp == 1) {
            float lam; { float a = dlam[lane] * dlam[64 + lane], bq_ = dlam[128 + lane] * dlam[192 + lane]; a = wave_sum(a); bq_ = wave_sum(bq_); lam = __expf(a) - __expf(bq_) + LAMBDA_INIT; }
            const float sc = inv * lam;
#pragma unroll
            for (int blk = 0; blk < 4; ++blk)
#pragma unroll
                for (int r = 0; r < 16; ++r) Y1[(32 * blk + (r & 3) + 8 * (r >> 2) + 4 * hi) * 32 + r32] = o[blk][r] * sc; }
        __syncthreads();
        if (comp == 0) {
            float ss = 0.f;
#pragma unroll
            for (int blk = 0; blk < 4; ++blk)
#pragma unroll
                for (int r = 0; r < 16; ++r) { const float a = o[blk][r] * inv - Y1[(32 * blk + (r & 3) + 8 * (r >> 2) + 4 * hi) * 32 + r32]; o[blk][r] = a; ss += a * a; }
            ss += xhalf_f(ss);
            const float rr = (1.0f - LAMBDA_INIT) / sqrtf(ss * (1.f / 128.f) + LN_EPS);
            LAS unsigned* stg = (LAS unsigned*)(lds + 65536) + wq * (32 * 65);
#pragma unroll
            for (int blk = 0; blk < 4; ++blk) {
#pragma unroll
                for (int r = 0; r < 16; r += 2) { const int e = 32 * blk + (r & 3) + 8 * (r >> 2) + 4 * hi;
                    stg[r32 * 65 + (e >> 1)] = cvtpk(o[blk][r] * rr * subg[e], o[blk][r + 1] * rr * subg[e + 1]); }
                asm volatile("" ::: "memory"); }
            LDS_WAIT(); asm volatile("" ::: "memory");
            bf16* orow = YA + (rowbase + q0 + wq * 32) * 1024 + h * 128;
#pragma unroll 4
            for (int row = 0; row < 32; ++row) *((GAS unsigned*)(orow + (size_t)row * 1024) + lane) = stg[row * 65 + lane];
        }
        __syncthreads();
    }
#undef DA_STAGE
#undef DA_WAITBAR
}

__device__ __forceinline__ unsigned okey(float f) { const unsigned u = __float_as_uint(f); return (u & 0x80000000u) ? ~u : (u | 0x80000000u); }
__device__ __forceinline__ void indexer_topk(LAS unsigned char* lds, const bf16* IQ, const bf16* IKW, unsigned short* IDX, int vcu, int G, const int wave) {
    const int lane = lane_fresh(), r32 = lane & 31, hi = lane >> 5;
    const unsigned lds0 = (unsigned)(uintptr_t)lds;
    const unsigned boff = (unsigned)((hi * 256 + r32) * 16);
    for (int j = vcu; j < 1024; j += G) {
        const int w = j & 255, i = j >> 8, bq = w >> 4, s16 = w & 15;
        const int chunk = (i == 0) ? s16 : (i == 1) ? 31 - s16 : (i == 2) ? 32 + s16 : 63 - s16;
        const int b = bq >> 2, gq = bq & 3;
        const int t0 = b * SEQ + chunk * 64 + gq * 16 + 2 * wave;
        const int ngroups = 2 * (chunk + 1);
        const int ntiles = (ngroups + 7) >> 3;
        const bf16* Kg = IKW + (size_t)b * SEQ * 256;
#define IX_STAGE(tile, bo) do { int tl_ = (tile); asm volatile("" : "+s"(tl_)); _Pragma("unroll") for (int i_ = 0; i_ < 4; ++i_) { const int q_ = 4 * wave + i_; \
            glds16s(Kg + (size_t)(tl_ * 256 + 64 * (q_ & 3)) * 256 + (q_ >> 2) * 8, (unsigned)lane * 512u, (unsigned)__builtin_amdgcn_readfirstlane((int)(lds0 + (bo) + ((q_ >> 2) * 256 + 64 * (q_ & 3)) * 16))); } } while (0)
        asm volatile("s_barrier" ::: "memory");
        IX_STAGE(0, 0u);
        bf16x8 a[4];
#pragma unroll
        for (int ks = 0; ks < 4; ++ks) a[ks] = *(const GAS bf16x8*)(IQ + (size_t)(t0 + (r32 >> 4)) * 1024 + (r32 & 15) * 64 + ks * 16 + 8 * hi);
        float wv[16];
        { const bf16* iwp = IKW + (size_t)t0 * 256 + 64 + 4 * hi;
          const v2u w00 = *(const GAS v2u*)(iwp), w01 = *(const GAS v2u*)(iwp + 8), w10 = *(const GAS v2u*)(iwp + 256), w11 = *(const GAS v2u*)(iwp + 256 + 8);
          wv[0] = blo(w00.x); wv[1] = bhi(w00.x); wv[2] = blo(w00.y); wv[3] = bhi(w00.y); wv[4] = blo(w01.x); wv[5] = bhi(w01.x); wv[6] = blo(w01.y); wv[7] = bhi(w01.y);
          wv[8] = blo(w10.x); wv[9] = bhi(w10.x); wv[10] = blo(w10.y); wv[11] = bhi(w10.y); wv[12] = blo(w11.x); wv[13] = bhi(w11.x); wv[14] = blo(w11.y); wv[15] = bhi(w11.y); }
        typedef float f2_t __attribute__((ext_vector_type(2)));
        f2_t w2[8];
#pragma unroll
        for (int r = 0; r < 8; ++r) w2[r] = (f2_t){wv[2 * r], wv[2 * r + 1]};
#define IX_SCORE(acc_, dst_) do { f2_t s0_ = {0.f, 0.f}, s1_ = {0.f, 0.f}; \
            _Pragma("unroll") for (int r = 0; r < 4; ++r) { \
                const f2_t x0_ = {__int_as_float(max(__float_as_int(acc_[2 * r]), 0)), __int_as_float(max(__float_as_int(acc_[2 * r + 1]), 0))}; \
                const f2_t x1_ = {__int_as_float(max(__float_as_int(acc_[8 + 2 * r]), 0)), __int_as_float(max(__float_as_int(acc_[8 + 2 * r + 1]), 0))}; \
                s0_ = __builtin_elementwise_fma(x0_, w2[r], s0_); s1_ = __builtin_elementwise_fma(x1_, w2[4 + r], s1_); } \
            const auto rr_ = __builtin_amdgcn_permlane32_swap(__float_as_uint(s0_.x + s0_.y), __float_as_uint(s1_.x + s1_.y), false, false); \
            const unsigned u_ = __float_as_uint(__uint_as_float(rr_[0]) + __uint_as_float(rr_[1])); \
            dst_ = u_ ^ ((unsigned)((int)u_ >> 31) | 0x80000000u); } while (0)
        unsigned key[128];
#pragma unroll 64
        for (int g = 0; g < 128; g += 2) {
            if (g < ngroups) {
                const unsigned bufo = (unsigned)((g >> 3) & 1) * 32768u;
                if ((g & 7) == 0) {
                    asm volatile("s_waitcnt vmcnt(0)\n\ts_barrier" ::: "memory");
                    if ((g >> 3) + 1 < ntiles) IX_STAGE((g >> 3) + 1, 32768u - bufo);
                }
                bf16x8 bk0[4], bk1[4];
#pragma unroll
                for (int ks = 0; ks < 4; ++ks) { bk0[ks] = *(const LAS bf16x8*)(lds + bufo + boff + (g & 7) * 512 + ks * 8192); bk1[ks] = *(const LAS bf16x8*)(lds + bufo + boff + ((g + 1) & 7) * 512 + ks * 8192); }
                f32x16 acc0 = {0.f, 0.f, 0.f, 0.f, 0.f, 0.f, 0.f, 0.f, 0.f, 0.f, 0.f, 0.f, 0.f, 0.f, 0.f, 0.f}, acc1 = acc0;
#pragma unroll
                for (int ks = 0; ks < 4; ++ks) acc0 = __builtin_amdgcn_mfma_f32_32x32x16_bf16(a[ks], bk0[ks], acc0, 0, 0, 0);
#pragma unroll
                for (int ks = 0; ks < 4; ++ks) acc1 = __builtin_amdgcn_mfma_f32_32x32x16_bf16(a[ks], bk1[ks], acc1, 0, 0, 0);
                IX_SCORE(acc0, key[g]); IX_SCORE(acc1, key[g + 1]);
            } else { key[g] = 0u; key[g + 1] = 0u; }
        }
#undef IX_SCORE
        unsigned selw[4];
        { unsigned vm[4];
#pragma unroll
          for (int w_ = 0; w_ < 4; ++w_) { const int n_ = ngroups - 32 * w_; vm[w_] = n_ >= 32 ? 0xffffffffu : (n_ <= 0 ? 0u : ((1u << (n_ & 31)) - 1u)); }
          if (chunk >= 4) {
#pragma unroll
              for (int w_ = 0; w_ < 4; ++w_) { if (32 * w_ < ngroups) {
#pragma unroll
                  for (int i_ = 0; i_ < 16; ++i_) { const unsigned x = key[32 * w_ + i_], y = key[32 * w_ + i_ + 16]; key[32 * w_ + i_] = (x & 0x0000ffffu) | (y << 16); key[32 * w_ + i_ + 16] = (x >> 16) | (y & 0xffff0000u); }
#pragma unroll
                  for (int i_ = 0; i_ < 32; ++i_) { if (!(i_ & 8)) { const unsigned x = key[32 * w_ + i_], y = key[32 * w_ + i_ + 8]; key[32 * w_ + i_] = (x & 0x00ff00ffu) | ((y << 8) & 0xff00ff00u); key[32 * w_ + i_ + 8] = ((x >> 8) & 0x00ff00ffu) | (y & 0xff00ff00u); } }
#pragma unroll
                  for (int i_ = 0; i_ < 32; ++i_) { if (!(i_ & 4)) { const unsigned x = key[32 * w_ + i_], y = key[32 * w_ + i_ + 4]; key[32 * w_ + i_] = (x & 0x0f0f0f0fu) | ((y << 4) & 0xf0f0f0f0u); key[32 * w_ + i_ + 4] = ((x >> 4) & 0x0f0f0f0fu) | (y & 0xf0f0f0f0u); } }
#pragma unroll
                  for (int i_ = 0; i_ < 32; ++i_) { if (!(i_ & 2)) { const unsigned x = key[32 * w_ + i_], y = key[32 * w_ + i_ + 2]; key[32 * w_ + i_] = (x & 0x33333333u) | ((y << 2) & 0xccccccccu); key[32 * w_ + i_ + 2] = ((x >> 2) & 0x33333333u) | (y & 0xccccccccu); } }
#pragma unroll
                  for (int i_ = 0; i_ < 32; ++i_) { if (!(i_ & 1)) { const unsigned x = key[32 * w_ + i_], y = key[32 * w_ + i_ + 1]; key[32 * w_ + i_] = (x & 0x55555555u) | ((y << 1) & 0xaaaaaaaau); key[32 * w_ + i_ + 1] = ((x >> 1) & 0x55555555u) | (y & 0xaaaaaaaau); } }
              } }
              unsigned cand[4] = {vm[0], vm[1], vm[2], vm[3]}, abv[4] = {0u, 0u, 0u, 0u}; int nab = 0; bool done = false;
#pragma unroll 32
              for (int bit = 31; bit >= 0; --bit) {
                  if (__all(done ? 1 : 0)) break;
                  const unsigned o0 = cand[0] & key[bit], o1 = cand[1] & key[32 + bit], o2 = cand[2] & key[64 + bit], o3 = cand[3] & key[96 + bit];
                  const int c = half_sum_i32(__popc(o0) + __popc(o1) + __popc(o2) + __popc(o3));
                  const bool take = nab + c >= 256;
                  done = done || (take && nab + c == 256);
                  const unsigned ntm = take ? 0u : 0xffffffffu;
                  nab += c & (int)ntm;
                  abv[0] |= o0 & ntm; abv[1] |= o1 & ntm; abv[2] |= o2 & ntm; abv[3] |= o3 & ntm;
                  cand[0] = o0 ^ (cand[0] & ntm); cand[1] = o1 ^ (cand[1] & ntm); cand[2] = o2 ^ (cand[2] & ntm); cand[3] = o3 ^ (cand[3] & ntm);
              }
#pragma unroll
              for (int w_ = 0; w_ < 4; ++w_) selw[w_] = abv[w_] | cand[w_];
          } else {
#pragma unroll
              for (int w_ = 0; w_ < 4; ++w_) selw[w_] = vm[w_];
          } }
        int base = 0;
        unsigned short* ip = IDX + (size_t)(t0 + hi) * 256;
#pragma unroll
        for (int g = 0; g < 128; ++g) {
            if (g < ngroups) {
                const bool sel = ((selw[g >> 5] >> (g & 31)) & 1u) != 0u;
                const unsigned long long mk = __ballot(sel ? 1 : 0);
                const unsigned mh = hi ? (unsigned)(mk >> 32) : (unsigned)mk;
                const int pos = base + __popc(mh & ((1u << r32) - 1u));
                if (sel && pos < 256) ip[pos] = (unsigned short)(32 * g + r32);
                base += __popc(mh);
            }
        }
    }
#undef IX_STAGE
    asm volatile("s_waitcnt vmcnt(0) lgkmcnt(0)\n\ts_barrier" ::: "memory");
}

constexpr int DSA_PAIRB = 1040;
constexpr int DSA_WAVEB = 16 * DSA_PAIRB + 512;
constexpr int DSA_LDS_END = 8 * DSA_WAVEB;
constexpr float DSA_CS = 64.f, DSA_QS = 64.f, DSA_PS = 256.f;
typedef int v2i_t __attribute__((ext_vector_type(2)));
__device__ __forceinline__ void dsa_mfma(LAS unsigned char* lds, const bf16* QL, bf16* OL, const int omask, const unsigned char* C8, const unsigned short* IDX, int vcu, int G, const int wave) {
    const int lane = lane_fresh(), h16 = lane & 15, g = lane >> 4;
    LAS unsigned char* wl = lds + wave * DSA_WAVEB;
    const unsigned wl0 = (unsigned)(uintptr_t)wl;
    LAS unsigned short* idxs = (LAS unsigned short*)(wl + 16 * DSA_PAIRB);
    const float sc2 = 0.08838834764831845f * LOG2E / (DSA_QS * DSA_CS);
    const float sl2 = (h16 < 8) ? LOG2E / (float)(2 << (h16 & 7)) : 0.f;
    const int ntok = (G == 256) ? 8 : (M - (vcu * 8 + wave) + G * 8 - 1) / (G * 8);
#define DSA_TOK(i) ((G == 256) ? ((vcu >> 6) * SEQ + (vcu & 63) + 64 * (wave + 8 * (i))) : (vcu * 8 + wave + G * 8 * (i)))
    const unsigned qk_off = (unsigned)((h16 >> 1) * DSA_PAIRB + (h16 & 1) * 512 + 32 * g);
    const int trow = (h16 >> 1) < 4 ? 4 * g + (h16 >> 1) : 16 + 4 * g + ((h16 >> 1) - 4);
    const unsigned pv_off = (unsigned)((trow >> 1) * DSA_PAIRB + (trow & 1) * 512 + 8 * (h16 & 1));
    for (int it = 0; it < ntok; ++it) {
        const int t = DSA_TOK(it); const int tpos = t & (SEQ - 1);
        const int n = (tpos >> 6) >= 3 ? 256 : 64 * ((tpos >> 6) + 1); const int nst = n >> 5;
        const unsigned char* Cb = C8 + (size_t)(t >> 12) * SEQ * 512;
        int ln = lane; asm volatile("" : "+v"(ln));
        const int h16b = ln & 15, gb = ln >> 4;
        { const v2u iv = __builtin_nontemporal_load((const GAS v2u*)(IDX + (size_t)t * 256) + ln); *((LAS v2u*)idxs + ln) = iv; }
        pg8::v8i_t qf[4];
        { const unsigned char* qp = (const unsigned char*)QL + (size_t)t * 8192 + (h16b & 7) * 512 + 32 * gb;
#pragma unroll
          for (int s = 0; s < 4; ++s) { const v4u lo = __builtin_nontemporal_load((const GAS v4u*)(qp + 128 * s)), hi = __builtin_nontemporal_load((const GAS v4u*)(qp + 128 * s + 16));
              qf[s] = (pg8::v8i_t){(int)lo.x, (int)lo.y, (int)lo.z, (int)lo.w, (int)hi.x, (int)hi.y, (int)hi.z, (int)hi.w}; } }
        f32x4 o[32];
#pragma unroll
        for (int blk = 0; blk < 32; ++blk) o[blk] = (f32x4){0.f, 0.f, 0.f, 0.f};
        float mrun = -INFINITY, lrun = 0.f;
        asm volatile("s_waitcnt lgkmcnt(0)" ::: "memory");
        for (int k = 0; k < nst; ++k) { const int st = nst - 1 - k;
            { const LAS v4u* ip4 = (const LAS v4u*)(idxs + st * 32);
              const v4u q0 = ip4[0], q1 = ip4[1], q2 = ip4[2], q3 = ip4[3];
              const unsigned iw[16] = {q0.x, q0.y, q0.z, q0.w, q1.x, q1.y, q1.z, q1.w, q2.x, q2.y, q2.z, q2.w, q3.x, q3.y, q3.z, q3.w};
              const unsigned sh = (unsigned)(ln >> 5) * 16u, lo16 = (unsigned)(ln & 31) * 16u;
              unsigned vo[16];
#pragma unroll
              for (int i = 0; i < 16; ++i) vo[i] = ((iw[i] >> sh) & 0xffffu) * 512u + lo16;
              glds16s_x16(Cb, vo, (unsigned)__builtin_amdgcn_readfirstlane((int)wl0)); }
            asm volatile("s_waitcnt vmcnt(0)" ::: "memory");
            f32x4 a0 = {0.f, 0.f, 0.f, 0.f}, a1 = {0.f, 0.f, 0.f, 0.f};
#pragma unroll
            for (int s = 0; s < 4; ++s) {
                const pg8::v4i_t x0 = *(const LAS pg8::v4i_t*)(wl + qk_off + 128 * s), x1 = *(const LAS pg8::v4i_t*)(wl + qk_off + 128 * s + 16);
                const pg8::v4i_t y0 = *(const LAS pg8::v4i_t*)(wl + qk_off + 8 * DSA_PAIRB + 128 * s), y1 = *(const LAS pg8::v4i_t*)(wl + qk_off + 8 * DSA_PAIRB + 128 * s + 16);
                a0 = __builtin_amdgcn_mfma_scale_f32_16x16x128_f8f6f4(__builtin_shufflevector(x0, x1, 0, 1, 2, 3, 4, 5, 6, 7), qf[s], a0, 0, 0, 0, 0x7f7f7f7f, 0, 0x7f7f7f7f);
                a1 = __builtin_amdgcn_mfma_scale_f32_16x16x128_f8f6f4(__builtin_shufflevector(y0, y1, 0, 1, 2, 3, 4, 5, 6, 7), qf[s], a1, 0, 0, 0, 0x7f7f7f7f, 0, 0x7f7f7f7f); }
            const v2u i0 = *(const LAS v2u*)(idxs + st * 32 + 4 * g), i1 = *(const LAS v2u*)(idxs + st * 32 + 16 + 4 * g);
            const int sidx[8] = {(int)(i0.x & 0xffffu), (int)(i0.x >> 16), (int)(i0.y & 0xffffu), (int)(i0.y >> 16), (int)(i1.x & 0xffffu), (int)(i1.x >> 16), (int)(i1.y & 0xffffu), (int)(i1.y >> 16)};
            float lg[8];
#pragma unroll
            for (int r = 0; r < 8; ++r) { const int d = tpos - sidx[r]; lg[r] = (r < 4 ? a0[r & 3] : a1[r & 3]) * sc2 - sl2 * (float)(d < 0 ? -d : d); }
            float rm = fmaxf(fmaxf(fmaxf(lg[0], lg[1]), fmaxf(lg[2], lg[3])), fmaxf(fmaxf(lg[4], lg[5]), fmaxf(lg[6], lg[7])));
            { const auto r1 = __builtin_amdgcn_permlane16_swap(__float_as_uint(rm), __float_as_uint(rm), false, false); rm = fmaxf(__uint_as_float(r1[0]), __uint_as_float(r1[1])); }
            rm = xhalf_max(rm);
            const float mn = fmaxf(mrun, rm), f = __builtin_amdgcn_exp2f(mrun - mn); mrun = mn;
#pragma unroll
            for (int r = 0; r < 8; ++r) lg[r] = __builtin_amdgcn_exp2f(lg[r] - mn) * DSA_PS;
            const unsigned pw0 = pg8::pk4_fp8(lg[0], lg[1], lg[2], lg[3]), pw1 = pg8::pk4_fp8(lg[4], lg[5], lg[6], lg[7]);
            { const float ps = ((__builtin_amdgcn_cvt_f32_fp8((int)pw0, 0) + __builtin_amdgcn_cvt_f32_fp8((int)pw0, 1)) + (__builtin_amdgcn_cvt_f32_fp8((int)pw0, 2) + __builtin_amdgcn_cvt_f32_fp8((int)pw0, 3)))
                           + ((__builtin_amdgcn_cvt_f32_fp8((int)pw1, 0) + __builtin_amdgcn_cvt_f32_fp8((int)pw1, 1)) + (__builtin_amdgcn_cvt_f32_fp8((int)pw1, 2) + __builtin_amdgcn_cvt_f32_fp8((int)pw1, 3)));
              lrun = lrun * f + ps; }
            const long pw = (long)(((unsigned long)pw1 << 32) | (unsigned long)pw0);
            if (__any(f != 1.f)) {
#pragma unroll
                for (int blk = 0; blk < 32; ++blk) o[blk] = o[blk] * f; }
            { v2i_t av[2][4];
#pragma unroll
              for (int i = 0; i < 4; ++i) av[0][i] = __builtin_amdgcn_ds_read_tr8_b64_v2i32((LAS v2i_t*)(wl + pv_off + 16 * i));
#pragma unroll
              for (int grp = 0; grp < 8; ++grp) {
                  if (grp < 7) {
#pragma unroll
                      for (int i = 0; i < 4; ++i) av[(grp + 1) & 1][i] = __builtin_amdgcn_ds_read_tr8_b64_v2i32((LAS v2i_t*)(wl + pv_off + 16 * (4 * grp + 4 + i))); }
                  __builtin_amdgcn_sched_barrier(0);
#pragma unroll
                  for (int i = 0; i < 4; ++i) { const v2i_t a_ = av[grp & 1][i];
                      const long al = (long)(((unsigned long)(unsigned)a_.y << 32) | (unsigned long)(unsigned)a_.x);
                      o[4 * grp + i] = __builtin_amdgcn_mfma_f32_16x16x32_fp8_fp8(al, pw, o[4 * grp + i], 0, 0, 0); }
                  __builtin_amdgcn_sched_barrier(0);
              } }
        }
        float lt = lrun; lt += __shfl_xor(lt, 16); lt += __shfl_xor(lt, 32);
        const float inv = 1.f / (lt * DSA_CS);
        if (h16 < 8) {
#pragma unroll
            for (int blk = 0; blk < 32; ++blk) { const f32x4 v = o[blk] * inv;
                __builtin_nontemporal_store((v2u){cvtpk(v.x, v.y), cvtpk(v.z, v.w)}, (GAS v2u*)(OL + (size_t)(t & omask) * 4096 + h16b * 512 + 16 * blk + 4 * gb)); } }
    }
    asm volatile("s_waitcnt vmcnt(0) lgkmcnt(0)" ::: "memory");
    __syncthreads();
#undef DSA_TOK
}
static_assert(DSA_LDS_END <= RING_BYTES, "DSA LDS map");

__device__ __forceinline__ void memattn_mfma(LAS unsigned char* lds, const bf16* QM, const bf16* KV, bf16* OM, int vcu, int G, const int wave) {
    const int lane = lane_fresh(), r32 = lane & 31, hi = lane >> 5;
    const unsigned voff = (unsigned)(65536 + (4 * hi + ((lane & 15) >> 2)) * 64 + ((lane >> 4) & 1) * 32 + (lane & 3) * 8);
    for (int j = vcu; j < 256; j += G) {
        const int bh = j >> 4, qb = j & 15, b = bh >> 2, h = bh & 3;
        const bf16* Kg = KV + (size_t)b * MEMT * 1024 + h * 128; const bf16* Vg = Kg + 512;
#pragma unroll
        for (int i = 0; i < 8; ++i) { const int q = 8 * wave + i;
            glds16(Kg + (size_t)(64 * (q & 3) + lane) * 1024 + (q >> 2) * 8, (unsigned)__builtin_amdgcn_readfirstlane((int)((unsigned)(uintptr_t)lds + ((q >> 2) * 256 + 64 * (q & 3)) * 16)));
            glds16(Vg + (size_t)(16 * (q & 15) + (lane >> 2)) * 1024 + (q >> 4) * 32 + (lane & 3) * 8, (unsigned)__builtin_amdgcn_readfirstlane((int)((unsigned)(uintptr_t)lds + 65536 + (q >> 4) * 16384 + (q & 15) * 1024))); }
        const size_t qrow = (size_t)b * SEQ + qb * 256 + wave * 32 + r32;
        bf16x8 qr[8];
#pragma unroll
        for (int s = 0; s < 8; ++s) qr[s] = *(const GAS bf16x8*)(QM + qrow * 512 + h * 128 + s * 16 + hi * 8);
        f32x16 o[4];
#pragma unroll
        for (int blk = 0; blk < 4; ++blk)
#pragma unroll
            for (int r = 0; r < 16; ++r) o[blk][r] = 0.f;
        float mrun = -INFINITY, lrun = 0.f;
        asm volatile("s_waitcnt vmcnt(0) lgkmcnt(0)\n\ts_barrier" ::: "memory");
        for (int kt = 0; kt < 4; ++kt) {
            const LAS unsigned char* Kb = lds + (unsigned)((hi * 256 + 64 * kt + r32) * 16);
            f32x16 p0, p1;
#pragma unroll
            for (int r = 0; r < 16; ++r) { p0[r] = 0.f; p1[r] = 0.f; }
#pragma unroll
            for (int s = 0; s < 8; ++s) { const bf16x8 k0 = *(const LAS bf16x8*)(Kb + s * 8192), k1 = *(const LAS bf16x8*)(Kb + s * 8192 + 512);
                p0 = __builtin_amdgcn_mfma_f32_32x32x16_bf16(k0, qr[s], p0, 0, 0, 0); p1 = __builtin_amdgcn_mfma_f32_32x32x16_bf16(k1, qr[s], p1, 0, 0, 0); }
            float rm = -INFINITY;
#pragma unroll
            for (int r = 0; r < 16; ++r) rm = fmaxf(rm, fmaxf(p0[r], p1[r]));
            rm = fmaxf(rm, xhalf_f(rm));
            if (__any(rm > mrun)) { const float mn = fmaxf(mrun, rm), f = __builtin_amdgcn_exp2f(mrun - mn); mrun = mn; lrun *= f;
#pragma unroll
                for (int blk = 0; blk < 4; ++blk)
#pragma unroll
                    for (int r = 0; r < 16; ++r) o[blk][r] *= f; }
            float ls = 0.f;
#pragma unroll
            for (int r = 0; r < 16; ++r) { p0[r] = __builtin_amdgcn_exp2f(p0[r] - mrun); p1[r] = __builtin_amdgcn_exp2f(p1[r] - mrun); ls += p0[r] + p1[r]; }
            lrun += ls;
            bf16x8 pw[4];
#pragma unroll
            for (int s = 0; s < 2; ++s) {
                v4u a = {cvtpk(p0[8 * s + 0], p0[8 * s + 1]), cvtpk(p0[8 * s + 2], p0[8 * s + 3]), cvtpk(p0[8 * s + 4], p0[8 * s + 5]), cvtpk(p0[8 * s + 6], p0[8 * s + 7])};
                v4u c = {cvtpk(p1[8 * s + 0], p1[8 * s + 1]), cvtpk(p1[8 * s + 2], p1[8 * s + 3]), cvtpk(p1[8 * s + 4], p1[8 * s + 5]), cvtpk(p1[8 * s + 6], p1[8 * s + 7])};
                pw[s] = __builtin_bit_cast(bf16x8, a); pw[2 + s] = __builtin_bit_cast(bf16x8, c); }
            const LAS unsigned char* Vb = lds + voff + kt * 4096;
#pragma unroll
            for (int blk = 0; blk < 4; ++blk) {
#pragma unroll
                for (int s = 0; s < 4; ++s) {
                    const v4i16_t lo = lds_tr16(Vb + blk * 16384 + s * 1024), hh = lds_tr16(Vb + blk * 16384 + s * 1024 + 512);
                    const bf16x8 vf = {lo[0], lo[1], lo[2], lo[3], hh[0], hh[1], hh[2], hh[3]};
                    o[blk] = __builtin_amdgcn_mfma_f32_32x32x16_bf16(vf, pw[s], o[blk], 0, 0, 0);
                }
            }
        }
        __syncthreads();
        lrun += xhalf_f(lrun);
        const float inv = 1.f / lrun;
        LAS unsigned* stg = (LAS unsigned*)(lds) + wave * (32 * 65);
#pragma unroll
        for (int blk = 0; blk < 4; ++blk)
#pragma unroll
            for (int r = 0; r < 16; r += 2) { const int e = 32 * blk + (r & 3) + 8 * (r >> 2) + 4 * hi;
                stg[r32 * 65 + (e >> 1)] = cvtpk(o[blk][r] * inv, o[blk][r + 1] * inv); }
        LDS_WAIT(); asm volatile("" ::: "memory");
        bf16* orow = OM + ((size_t)b * SEQ + qb * 256 + wave * 32) * 512 + h * 128;
#pragma unroll 4
        for (int row = 0; row < 32; ++row) *((GAS unsigned*)(orow + (size_t)row * 512) + lane) = stg[row * 65 + lane];
        __syncthreads();
    }
}

constexpr int N_PHASES = 21;
struct Args { const float* in[24]; float* out; unsigned char* ws; int ph_lo, ph_hi; };
__global__ void __launch_bounds__(NWAVES * 64, 2) mk_fwd(Args args) {
    extern __shared__ __attribute__((aligned(16))) unsigned char lds_raw[];
    LAS unsigned char* lds = (LAS unsigned char*)lds_raw;
    volatile LAS unsigned* MISC = (volatile LAS unsigned*)(lds + MISC_OFF);
    const int tid = threadIdx.x, wave = __builtin_amdgcn_readfirstlane(tid >> 6);
#define lane lane_fresh()
    const int G = gridDim.x; int bx = blockIdx.x;
    int vcu = (G % 8 == 0) ? (bx % 8) * (G / 8) + bx / 8 : bx;
    int gw = vcu * NWAVES + wave; const int NGW = G * NWAVES;
    unsigned char* ws = args.ws;
    gu32* ctl = (gu32*)(ws + WS_CTL);
    for (int u = tid; u < (LDS_BYTES - LDSCTL_OFF) / 4; u += NWAVES * 64) ((LAS unsigned*)(lds + LDSCTL_OFF))[u] = 0u;
    __syncthreads();
    const bool one = (args.ph_hi - args.ph_lo) > 1;
    XcdBarrier bar; bar.bar = (unsigned*)(ctl + CW_BAR); bar.x = 0; bar.st = nullptr;
    if (one) bar = xcd_barrier_post((unsigned*)(ctl + CW_BAR), MISC + 8, tid == 0);
    const int lo = args.ph_lo, hi = args.ph_hi;
#ifndef PH_MASK
#define PH_MASK 0xFFFFFFFFu
#endif
#define IN(k) ((((PH_MASK) >> (k)) & 1u) && lo <= (k) && (k) < hi)
#define SEAM(k) do { if (IN(k) && IN((k) + 1)) xcd_barrier(bar, wave); } while (0)
    bf16* const X16 = (bf16*)(ws + WS_X16); bf16* const HB = (bf16*)(ws + WS_H);
    long long* const ST0 = (long long*)(ws + WS_CTL + CTL_STATS); long long* const ST1 = (long long*)(ws + WS_CTL + CTL_STATS + CTL_STATS_STRIDE); long long* const ST2 = (long long*)(ws + WS_CTL + CTL_STATS + 2 * CTL_STATS_STRIDE);
    const float* const VEC = (const float*)(ws + WS_CTL + CTL_VECF);
    float* const out = args.out;
    const float* const ln_g = args.in[22]; const float* const ln_b = args.in[23];
    using namespace pg8;

#ifdef PROBE_P0
    if (IN(0)) { p0_prologue(args.in, ws, lds, gw, NGW, wave, lane); }
#endif
    if (IN(0)) { p0_prologue(args.in, ws, lds, gw, NGW, wave, lane); }
    SEAM(0);
    if (one && IN(0) && (G % 8) == 0) {
        unsigned* xb = (unsigned*)(ctl + CW_BAR); bool even = true;
#pragma unroll
        for (int jx = 0; jx < 16; ++jx) { const unsigned c = xb_ld(&xb[XB_XCNT(jx)]); even = even && (jx < 8 ? c == (unsigned)(G / 8) : c == 0u); }
        const int rank = (int)MISC[10], xcc = (int)xb_xcc_id();
        if (__builtin_amdgcn_readfirstlane(even ? 1 : 0)) { vcu = __builtin_amdgcn_readfirstlane(xcc * (G / 8) + rank); bx = __builtin_amdgcn_readfirstlane(rank * 8 + xcc); gw = vcu * NWAVES + wave; }
    }
    if (IN(1)) { { const long long* vi = (const long long*)(ws + WS_CTL + CTL_VEC); float* vf = (float*)(ws + WS_CTL + CTL_VECF); for (int i = gw * 64 + lane; i < V_END; i += NGW * 64) vf[i] = (float)vi[i] * (1.0f / 16777216.f); }
        Gemm g{(const bf16*)(ws + WS_X8), (const bf16*)(ws + WS_W_GU1), D / 2, D / 2, D / 2, 0, 0}; StaticOrder S; S.init(M, 2 * FF, G, bx); EpiSwiGLU8 E{(unsigned char*)HB, FF, 1.0f / (FP8_XS * FP8_WGUS), FP8_HS, LnFold{nullptr, nullptr, nullptr}};
        gemm_phase<EpiSwiGLU8, StaticOrder, true, true>(lds + RING_OFF, g, S, E, wave); }
    SEAM(1);
    if (IN(2)) { Gemm g{HB, (const bf16*)(ws + WS_W_D1), FF / 2, FF / 2, FF / 2, 0, 0}; StaticOrder S; S.init(M, D, G, bx); EpiRes<true> E{args.in[0], nullptr, D, ALPHA, 0.5f / (FP8_HS * FP8_WDS), nullptr, nullptr, nullptr, ST0, X16, (unsigned char*)(ws + WS_X8M), FP8_XS};
        gemm_phase<EpiRes<true>, StaticOrder, true, true>(lds + RING_OFF, g, S, E, wave); }
    SEAM(2);
    if (IN(4)) {
        { Gemm g{(const bf16*)(ws + WS_X8M), (const bf16*)(ws + WS_W_IN8), D / 2, D / 2, D / 2, 0, 0}; StaticOrder S; S.init(M, N_IN8, G, bx);
          EpiInProj E{(bf16*)(ws + WS_AQ), (bf16*)(ws + WS_AK), (bf16*)(ws + WS_AV), (bf16*)(ws + WS_BQ), (bf16*)(ws + WS_BC), (bf16*)(ws + WS_IQ), (bf16*)(ws + WS_IKW), QSCALE, LnFold{ST0, VEC + V_GW_IN, VEC + V_BW_IN}, (unsigned*)(ctl + CW_KMAX), 0, 1.0f / (FP8_XS * FP8_WGS)};
          gemm_phase<EpiInProj, StaticOrder, true, true>(lds + RING_OFF, g, S, E, wave); }
        { Gemm g{X16, (const bf16*)(ws + WS_W_INB), D, D, D, 0, 0}; StaticOrder S; S.init(M, N_INB, G, (G % 16 == 0) ? (bx + G / 2) % G : bx);
          EpiInProj E{(bf16*)(ws + WS_AQ), (bf16*)(ws + WS_AK), (bf16*)(ws + WS_AV), (bf16*)(ws + WS_BQ), (bf16*)(ws + WS_BC), (bf16*)(ws + WS_IQ), (bf16*)(ws + WS_IKW), QSCALE, LnFold{ST0, VEC + V_GW_IN, VEC + V_BW_IN}, (unsigned*)(ctl + CW_KMAX), N_IN8 / 256, 1.0f};
          gemm_phase<EpiInProj, StaticOrder, true>(lds + RING_OFF, g, S, E, wave); }
        { Gemm g{(const bf16*)(ws + WS_MEM16), (const bf16*)(ws + WS_W_MKV), D, D, D, 0, 0}; StaticOrder S; S.init(BATCH * MEMT, 1024, G, bx >= G - 16 ? bx - (G - 16) : (1 << 20)); EpiBf16 E{(bf16*)(ws + WS_KVMEM), 1024};
          gemm_phase<EpiBf16, StaticOrder, true>(lds + RING_OFF, g, S, E, wave); }
    }
    SEAM(4);
    if (IN(5)) {
        { Gemm g{(const bf16*)(ws + WS_BQ), (const bf16*)(ws + WS_W_UK), 1024, 128, 128, 1, 128}; StaticOrder S; S.init(M, 4096, G, bx); EpiFp8 E{(unsigned char*)(ws + WS_QLAT), 8192, DSA_QS};
          gemm_phase<EpiFp8, StaticOrder, true>(lds + RING_OFF, g, S, E, wave); }
        crms_phase((const bf16*)(ws + WS_BC), (unsigned char*)(ws + WS_C8), args.in[8], DSA_CS, gw, NGW, lane);
    }
    if (IN(7)) indexer_topk(lds, (const bf16*)(ws + WS_IQ), (const bf16*)(ws + WS_IKW), (unsigned short*)(ws + WS_IDX), vcu, G, wave);
    if (IN(7)) diff_attn_mfma(lds, (const bf16*)(ws + WS_AQ), (const bf16*)(ws + WS_AK), (const bf16*)(ws + WS_AV), (bf16*)(ws + WS_AQ), args.in[6], args.in[7], (unsigned*)(ctl + CW_DQ), (const unsigned*)(ctl + CW_KMAX), wave);
    SEAM(7);
    if (IN(8)) dsa_mfma(lds, (const bf16*)(ws + WS_QLAT), (bf16*)(ws + WS_QLAT), 0x7fffffff, (const unsigned char*)(ws + WS_C8), (const unsigned short*)(ws + WS_IDX), vcu, G, wave);
    SEAM(8);
    if (IN(9)) { Gemm g{(const bf16*)(ws + WS_QLAT), (const bf16*)(ws + WS_W_UVP), 4096, 1024, 1024, 0, 1024}; StaticOrder S; S.init(M, 1024, G, bx); EpiBf16 E{(bf16*)(ws + WS_YB), 1024};
        gemm_phase<EpiBf16, StaticOrder, true>(lds + RING_OFF, g, S, E, wave); }
    SEAM(9);
    if (IN(10)) {
        { Gemm g{(const bf16*)(ws + WS_AQ), (const bf16*)(ws + WS_W_A), 1024, 1024, 1024, 0, 0}; StaticOrder S; S.init(M, D, G, bx); EpiBf16 E{(bf16*)(ws + WS_TA), D}; gemm_phase<EpiBf16, StaticOrder, true>(lds + RING_OFF, g, S, E, wave); }
        { Gemm g{(const bf16*)(ws + WS_YB), (const bf16*)(ws + WS_W_B), 1024, 1024, 1024, 0, 0}; StaticOrder S; S.init(M, D, G, bx); EpiBf16 E{(bf16*)(ws + WS_TB), D}; gemm_phase<EpiBf16, StaticOrder, true>(lds + RING_OFF, g, S, E, wave); }
    }
    SEAM(10);
    if (IN(11)) { Gemm g{(const bf16*)(ws + WS_X8M), (const bf16*)(ws + WS_W_G), D / 2, D / 2, D / 2, 0, 0}; StaticOrder S; S.init(M, 2 * D, G, bx);
        EpiGateMerge8 E{(const bf16*)(ws + WS_TA), (const bf16*)(ws + WS_TB), (unsigned char*)(ws + WS_MRG8), D, args.in[12], args.in[12] + D, 1.0f / (FP8_XS * FP8_WGS), FP8_MS, LnFold{ST0, VEC + V_GW_G, VEC + V_BW_G}};
        gemm_phase<EpiGateMerge8, StaticOrder, true, true>(lds + RING_OFF, g, S, E, wave); }
    SEAM(11);
    if (IN(12)) { Gemm g{(const bf16*)(ws + WS_MRG8), (const bf16*)(ws + WS_W_MO), D / 2, D / 2, D / 2, 0, 0}; StaticOrder S; S.init(M, D, G, bx); EpiRes<false, 1> E{nullptr, X16, D, ALPHA, 1.0f / (FP8_MS * FP8_WMOS), ST0, ln_g, ln_b, ST1, X16, nullptr, 0.f};
        gemm_phase<EpiRes<false, 1>, StaticOrder, true, true>(lds + RING_OFF, g, S, E, wave); }
    SEAM(12);
    if (IN(14)) { Gemm g{X16, (const bf16*)(ws + WS_W_MQ), D, D, D, 0, 0}; StaticOrder S; S.init(M, 512, G, bx); EpiBf16 E{(bf16*)(ws + WS_QM), 512, 0.08838834764831845f * LOG2E, LnFold{ST1, VEC + V_GW_MQ, VEC + V_BW_MQ}}; gemm_phase<EpiBf16, StaticOrder, true>(lds + RING_OFF, g, S, E, wave); }
    SEAM(14);
    if (IN(15)) memattn_mfma(lds, (const bf16*)(ws + WS_QM), (const bf16*)(ws + WS_KVMEM), (bf16*)(ws + WS_OM), vcu, G, wave);
    SEAM(15);
    if (IN(16)) { Gemm g{(const bf16*)(ws + WS_OM), (const bf16*)(ws + WS_W_MOUT), 512, 512, 512, 0, 0}; StaticOrder S; S.init(M, D, G, bx); EpiRes<false> E{nullptr, X16, D, ALPHA, 1.0f, ST1, ln_g + D, ln_b + D, ST2, X16, (unsigned char*)(ws + WS_X8), FP8_XS};
        gemm_phase<EpiRes<false>, StaticOrder, true>(lds + RING_OFF, g, S, E, wave); }
    SEAM(16);
    if (IN(18)) { Gemm g{(const bf16*)(ws + WS_X8), (const bf16*)(ws + WS_W_GU2), D / 2, D / 2, D / 2, 0, 0}; StaticOrder S; S.init(M, 2 * FF, G, bx); EpiSwiGLU8 E{(unsigned char*)HB, FF, 1.0f / (FP8_XS * FP8_WGUS), FP8_HS, LnFold{ST2, VEC + V_GW_GU2, VEC + V_BW_GU2}};
        gemm_phase<EpiSwiGLU8, StaticOrder, true, true>(lds + RING_OFF, g, S, E, wave); }
    SEAM(18);
    if (IN(19)) { Gemm g{HB, (const bf16*)(ws + WS_W_D2), FF / 2, FF / 2, FF / 2, 0, 0}; StaticOrder S; S.init(M, D, G, bx); EpiRes<false> E{nullptr, X16, D, ALPHA, 0.5f / (FP8_HS * FP8_WDS), ST2, ln_g + 2 * D, ln_b + 2 * D, nullptr, X16, nullptr, 0.f};
        gemm_phase<EpiRes<false>, StaticOrder, true, true>(lds + RING_OFF, g, S, E, wave); }
    SEAM(19);
    if (IN(20)) ln_final_phase(X16, out, ln_g + 3 * D, ln_b + 3 * D, gw, NGW, lane);
#undef IN
#undef SEAM
#undef lane
}

extern "C" void kernel_launch(void* const* d_in, const int* in_sizes, int n_in, void* d_out, int out_size, void* d_ws, size_t ws_size, hipStream_t stream) {
    static int grid = 0;
    if (grid == 0) {
        if (n_in != 24 || in_sizes[0] != M * D || out_size != M * D || ws_size < WS_END) { fprintf(stderr, "kernel_launch: unexpected shapes (n_in %d, in0 %d, out %d, ws %zu); nothing launched\n", n_in, n_in > 0 ? in_sizes[0] : -1, out_size, ws_size); grid = -1; return; }
        int dev = 0, cus = 0, per_cu = 0;
        if (hipGetDevice(&dev) != hipSuccess || hipDeviceGetAttribute(&cus, hipDeviceAttributeMultiprocessorCount, dev) != hipSuccess) { grid = -1; return; }
        if (hipFuncSetAttribute((const void*)mk_fwd, hipFuncAttributeMaxDynamicSharedMemorySize, LDS_BYTES) != hipSuccess) { fprintf(stderr, "kernel_launch: hipFuncSetAttribute failed\n"); grid = -1; return; }
        if (hipOccupancyMaxActiveBlocksPerMultiprocessor(&per_cu, (const void*)mk_fwd, NWAVES * 64, LDS_BYTES) != hipSuccess || per_cu < 1)
            fprintf(stderr, "kernel_launch: note: the occupancy query reports %d workgroups per CU\n", per_cu);
        (void)hipGetLastError();
        grid = cus;
    }
    if (grid < 0) return;
    if (hipMemsetAsync((char*)d_ws + WS_CTL, 0, CTL_ZERO_BYTES, stream) != hipSuccess) return;
    Args a{};
    for (int i = 0; i < 24; ++i) a.in[i] = (const float*)d_in[i];
    a.out = (float*)d_out; a.ws = (unsigned char*)d_ws;
#if MK_ONE_LAUNCH
    a.ph_lo = 0; a.ph_hi = N_PHASES;
    hipLaunchKernelGGL(mk_fwd, dim3(grid), dim3(NWAVES * 64), LDS_BYTES, stream, a);
#else
    for (int p = 0; p < N_PHASES; ++p) { a.ph_lo = p; a.ph_hi = p + 1; hipLaunchKernelGGL(mk_fwd, dim3(grid), dim3(NWAVES * 64), LDS_BYTES, stream, a); }
#endif
}
```

```cpp
#include <hip/hip_runtime.h>
#include <cstdio>
#include <cstdint>

#ifndef MK_ONE_LAUNCH
#define MK_ONE_LAUNCH 1
#endif

__device__ __forceinline__ int lane_fresh() { int l = (int)__builtin_amdgcn_mbcnt_hi(~0u, __builtin_amdgcn_mbcnt_lo(~0u, 0u)); asm volatile("" : "+v"(l)); return l; }
__device__ __forceinline__ void glds16(const void* gsrc, unsigned lds_dst) { unsigned keep;
    asm volatile("s_mov_b32 %0, m0\n\ts_mov_b32 m0, %2\n\ts_nop 0\n\tglobal_load_lds_dwordx4 %1, off\n\ts_mov_b32 m0, %0" : "=&s"(keep) : "v"(gsrc), "s"(lds_dst) : "memory"); }
__device__ __forceinline__ void glds16s(const void* sbase, unsigned voff, unsigned lds_dst) { unsigned keep;
    asm volatile("s_mov_b32 %0, m0\n\ts_mov_b32 m0, %3\n\ts_nop 0\n\tglobal_load_lds_dwordx4 %1, %2\n\ts_mov_b32 m0, %0" : "=&s"(keep) : "v"(voff), "s"(sbase), "s"(lds_dst) : "memory"); }
__device__ __forceinline__ void glds16s_x16(const void* sbase, const unsigned (&v)[16], unsigned lds_dst0) { unsigned keep;
    asm volatile("s_mov_b32 %0, m0\n\ts_mov_b32 m0, %18\n\ts_nop 0\n\t"
        "global_load_lds_dwordx4 %1, %17\n\ts_add_u32 m0, m0, 1040\n\ts_nop 0\n\t"
        "global_load_lds_dwordx4 %2, %17\n\ts_add_u32 m0, m0, 1040\n\ts_nop 0\n\t"
        "global_load_lds_dwordx4 %3, %17\n\ts_add_u32 m0, m0, 1040\n\ts_nop 0\n\t"
        "global_load_lds_dwordx4 %4, %17\n\ts_add_u32 m0, m0, 1040\n\ts_nop 0\n\t"
        "global_load_lds_dwordx4 %5, %17\n\ts_add_u32 m0, m0, 1040\n\ts_nop 0\n\t"
        "global_load_lds_dwordx4 %6, %17\n\ts_add_u32 m0, m0, 1040\n\ts_nop 0\n\t"
        "global_load_lds_dwordx4 %7, %17\n\ts_add_u32 m0, m0, 1040\n\ts_nop 0\n\t"
        "global_load_lds_dwordx4 %8, %17\n\ts_add_u32 m0, m0, 1040\n\ts_nop 0\n\t"
        "global_load_lds_dwordx4 %9, %17\n\ts_add_u32 m0, m0, 1040\n\ts_nop 0\n\t"
        "global_load_lds_dwordx4 %10, %17\n\ts_add_u32 m0, m0, 1040\n\ts_nop 0\n\t"
        "global_load_lds_dwordx4 %11, %17\n\ts_add_u32 m0, m0, 1040\n\ts_nop 0\n\t"
        "global_load_lds_dwordx4 %12, %17\n\ts_add_u32 m0, m0, 1040\n\ts_nop 0\n\t"
        "global_load_lds_dwordx4 %13, %17\n\ts_add_u32 m0, m0, 1040\n\ts_nop 0\n\t"
        "global_load_lds_dwordx4 %14, %17\n\ts_add_u32 m0, m0, 1040\n\ts_nop 0\n\t"
        "global_load_lds_dwordx4 %15, %17\n\ts_add_u32 m0, m0, 1040\n\ts_nop 0\n\t"
        "global_load_lds_dwordx4 %16, %17\n\ts_mov_b32 m0, %0"
        : "=&s"(keep) : "v"(v[0]), "v"(v[1]), "v"(v[2]), "v"(v[3]), "v"(v[4]), "v"(v[5]), "v"(v[6]), "v"(v[7]), "v"(v[8]), "v"(v[9]), "v"(v[10]), "v"(v[11]), "v"(v[12]), "v"(v[13]), "v"(v[14]), "v"(v[15]), "s"(sbase), "s"(lds_dst0) : "memory", "scc"); }
namespace pg8 {
#define PG8_LAS __attribute__((address_space(3)))
typedef unsigned short bf16_t;
typedef short bf16x8 __attribute__((ext_vector_type(8)));
typedef float f32x4 __attribute__((ext_vector_type(4)));
typedef unsigned u32x4 __attribute__((ext_vector_type(4)));
constexpr int BM = 256, BK = 64, HALF = 128, HTB = HALF * BK * 2  , STAGE_BYTES = 8 * HTB, NXCD = 8, WGM = 8;

__host__ __device__ __forceinline__ int lds_byte(int r, int c) { const int st = (r >> 4) * 2 + (c >> 5), rr = r & 15, cc = c & 31, ob = rr * 64 + cc * 2; return st * 1024 + (ob ^ (((ob >> 9) & 1) << 5)); }
__host__ __device__ __forceinline__ void stage_rc(int b, int& R, int& C) { const int st = b / 1024, sb = b % 1024, swz = sb ^ (((sb >> 9) & 1) << 5); R = (st >> 1) * 16 + swz / 64; C = (st & 1) * 32 + (swz % 64) / 2; }
__host__ __device__ __forceinline__ int perm32(int rho) { const int n = rho >> 4, i = rho & 15; return 8 * (i >> 2) + 4 * n + (i & 3); }

struct Unit { int pm, pn; };
struct Gemm { const bf16_t* A; const bf16_t* Bt; int lda, ldb, K, a_shift, a_mul; };

struct StaticOrder {
    int nM, nN, nwg, G, c;
    __host__ __device__ void init(int M, int N, int G_, int c_) { nM = M / BM; nN = N / BM; nwg = nM * nN; G = G_; c = c_; }
    __host__ __device__ bool next(int i, Unit& u) const {
        const long L = (long)i * G + c; if (L >= nwg) return false;
        int wgid = (int)L; { const int q = nwg / NXCD, r = nwg % NXCD, xcd = wgid % NXCD, off = wgid / NXCD; wgid = (xcd < r ? xcd * (q + 1) : r * (q + 1) + (xcd - r) * q) + off; }
        const int nig = WGM * nN, gid = wgid / nig, fm = gid * WGM, gsz = (nM - fm) < WGM ? (nM - fm) : WGM;
        u.pm = fm + ((wgid % nig) % gsz); u.pn = (wgid % nig) / gsz; return true;
    }
    __device__ __forceinline__ void a_ready(const Unit&) const {}
    __device__ __forceinline__ void done(const Unit&) const {}
};

__device__ __forceinline__ unsigned cvt_pk_bf16(float lo, float hi) { unsigned r; asm volatile("v_cvt_pk_bf16_f32 %0, %1, %2" : "=v"(r) : "v"(lo), "v"(hi)); return r; }
__device__ __forceinline__ float bflo(unsigned w) { return __uint_as_float(w << 16); }
__device__ __forceinline__ float bfhi(unsigned w) { return __uint_as_float(w & 0xffff0000u); }
__device__ __forceinline__ float sigmoidf_fast(float x) { return __builtin_amdgcn_rcpf(1.0f + __builtin_amdgcn_exp2f(-1.4426950408889634f * x)); }

struct LnFold {
    const long long* stats; const float* gW; const float* bW;
    __device__ __forceinline__ void row(int r, float& mean, float& rstd) const { const long long s0 = stats[2 * (size_t)r], s1 = stats[2 * (size_t)r + 1];
        mean = (float)s0 * (1.0f / (1048576.f * 2048.0f)); rstd = __builtin_amdgcn_rsqf((float)s1 * (1.0f / (65536.f * 2048.0f)) - mean * mean + 1e-5f); }
    __device__ __forceinline__ f32x4 vec4(const float* v, int i) const { return *(const f32x4*)(v + i); }
    __device__ __forceinline__ void rows8(int row0, float (&mean)[8], float (&rstd)[8]) const {
#pragma unroll
        for (int hf = 0; hf < 2; ++hf) { long long s0[4], s1[4];
#pragma unroll
            for (int q = 0; q < 4; ++q) { const size_t r = (size_t)(row0 + hf * 128 + q * 16); s0[q] = stats[2 * r]; s1[q] = stats[2 * r + 1]; }
#pragma unroll
            for (int q = 0; q < 4; ++q) { const float mu = (float)s0[q] * (1.0f / (1048576.f * 2048.0f)); mean[4 * hf + q] = mu; rstd[4 * hf + q] = __builtin_amdgcn_rsqf((float)s1[q] * (1.0f / (65536.f * 2048.0f)) - mu * mu + 1e-5f); }
            asm volatile("" : "+v"(mean[4 * hf]), "+v"(mean[4 * hf + 1]), "+v"(mean[4 * hf + 2]), "+v"(mean[4 * hf + 3]), "+v"(rstd[4 * hf]), "+v"(rstd[4 * hf + 1]), "+v"(rstd[4 * hf + 2]), "+v"(rstd[4 * hf + 3]) :: "memory"); }
    }
};
struct EpiBf16 {
    static constexpr bool PERM = true, AFTER_DRAIN = false;
    bf16_t* O; int ldc; float sc = 1.0f; LnFold lf = {nullptr, nullptr, nullptr};
    __device__ __forceinline__ void operator()(const f32x4 (&acc)[2][2][4][2], const Unit& u, int wr, int wc, int fr, int fq) const {
        const int row0 = u.pm * BM + wr * 64 + fr, col0 = u.pn * BM + wc * 32 + 8 * fq;
        f32x4 gw[2][2], bw[2][2];
#pragma unroll
        for (int bj = 0; bj < 2; ++bj)
#pragma unroll
            for (int n = 0; n < 2; ++n) { gw[bj][n] = (f32x4){0.f, 0.f, 0.f, 0.f}; bw[bj][n] = (f32x4){0.f, 0.f, 0.f, 0.f}; if (lf.stats) { gw[bj][n] = lf.vec4(lf.gW, col0 + bj * HALF + 4 * n); bw[bj][n] = lf.vec4(lf.bW, col0 + bj * HALF + 4 * n); } }
        float mean8[8], rstd8[8];
#pragma unroll
        for (int q = 0; q < 8; ++q) { mean8[q] = 0.f; rstd8[q] = 1.f; }
        if (lf.stats) lf.rows8(row0, mean8, rstd8);
#pragma unroll
        for (int ai = 0; ai < 2; ++ai)
#pragma unroll
            for (int m = 0; m < 4; ++m) { bf16_t* rowp = O + (size_t)(row0 + ai * HALF + m * 16) * ldc + col0;
                const float mean = mean8[ai * 4 + m], rstd = rstd8[ai * 4 + m];
#pragma unroll
                for (int bj = 0; bj < 2; ++bj) { const f32x4 v0 = ((acc[ai][bj][m][0] - gw[bj][0] * mean) * rstd + bw[bj][0]) * sc, v1 = ((acc[ai][bj][m][1] - gw[bj][1] * mean) * rstd + bw[bj][1]) * sc;
                    u32x4 w; w.x = cvt_pk_bf16(v0[0], v0[1]); w.y = cvt_pk_bf16(v0[2], v0[3]); w.z = cvt_pk_bf16(v1[0], v1[1]); w.w = cvt_pk_bf16(v1[2], v1[3]);
                    *(u32x4*)(rowp + bj * HALF) = w; } }
    }
};
struct EpiInProj {
    static constexpr bool PERM = true, AFTER_DRAIN = false;
    bf16_t *aq, *ak, *av, *bq, *bc, *iq, *ikw; float qscale; LnFold lf; unsigned* kmax; int pn0; float ascale;
    __device__ __forceinline__ void operator()(const f32x4 (&acc)[2][2][4][2], const Unit& u, int wr, int wc, int fr, int fq) const {
        bf16_t* base; int ldc, colt; const int pn = u.pn + pn0;
        if (pn < 4) { base = aq; ldc = 1024; colt = pn * 256; }
        else if (pn < 8) { base = ak; ldc = 1024; colt = (pn - 4) * 256; }
        else if (pn < 12) { base = av; ldc = 1024; colt = (pn - 8) * 256; }
        else if (pn < 16) { base = bq; ldc = 1024; colt = (pn - 12) * 256; }
        else if (pn < 18) { base = bc; ldc = 512; colt = (pn - 16) * 256; }
        else if (pn < 22) { base = iq; ldc = 1024; colt = (pn - 18) * 256; }
        else { base = ikw; ldc = 256; colt = 0; }
        const float sc = (pn < 4) ? qscale : 1.0f; float kam[2] = {0.f, 0.f};
        const int row0 = u.pm * BM + wr * 64 + fr, col0 = colt + wc * 32 + 8 * fq, cidx = pn * BM + wc * 32 + 8 * fq;
        f32x4 gw[2][2], bw[2][2];
#pragma unroll
        for (int bj = 0; bj < 2; ++bj)
#pragma unroll
            for (int n = 0; n < 2; ++n) { gw[bj][n] = lf.vec4(lf.gW, cidx + bj * HALF + 4 * n); bw[bj][n] = lf.vec4(lf.bW, cidx + bj * HALF + 4 * n); }
        float mean8[8], rstd8[8]; lf.rows8(row0, mean8, rstd8);
#pragma unroll
        for (int ai = 0; ai < 2; ++ai)
#pragma unroll
            for (int m = 0; m < 4; ++m) { bf16_t* rowp = base + (size_t)(row0 + ai * HALF + m * 16) * ldc + col0;
                const float mean = mean8[ai * 4 + m], rstd = rstd8[ai * 4 + m];
#pragma unroll
                for (int bj = 0; bj < 2; ++bj) { const f32x4 v0 = ((acc[ai][bj][m][0] * ascale - gw[bj][0] * mean) * rstd + bw[bj][0]) * sc, v1 = ((acc[ai][bj][m][1] * ascale - gw[bj][1] * mean) * rstd + bw[bj][1]) * sc;
                    kam[bj] = fmaxf(kam[bj], fmaxf(fmaxf(fmaxf(fabsf(v0[0]), fabsf(v0[1])), fmaxf(fabsf(v0[2]), fabsf(v0[3]))), fmaxf(fmaxf(fabsf(v1[0]), fabsf(v1[1])), fmaxf(fabsf(v1[2]), fabsf(v1[3])))));
                    u32x4 w; w.x = cvt_pk_bf16(v0[0], v0[1]); w.y = cvt_pk_bf16(v0[2], v0[3]); w.z = cvt_pk_bf16(v1[0], v1[1]); w.w = cvt_pk_bf16(v1[2], v1[3]);
                    *(u32x4*)(rowp + bj * HALF) = w; } }
        if (pn >= 4 && pn < 8) {
#pragma unroll
            for (int bj = 0; bj < 2; ++bj) { float v = kam[bj];
#pragma unroll
                for (int o = 1; o < 64; o <<= 1) v = fmaxf(v, __shfl_xor(v, o));
                if ((fr | fq) == 0) (void)__hip_atomic_fetch_max(kmax + ((u.pm >> 4) * 8 + 2 * (pn - 4) + bj) * 2 + (wc >> 1), __float_as_uint(v), __ATOMIC_RELAXED, __HIP_MEMORY_SCOPE_AGENT); } }
    }
};
struct EpiSwiGLU {
    static constexpr bool PERM = true, AFTER_DRAIN = false;
    bf16_t* O; int ldc;
    __device__ __forceinline__ void operator()(const f32x4 (&acc)[2][2][4][2], const Unit& u, int wr, int wc, int fr, int fq) const {
        const int row0 = u.pm * BM + wr * 64 + fr, col0 = u.pn * HALF + wc * 32 + 8 * fq;
#pragma unroll
        for (int ai = 0; ai < 2; ++ai)
#pragma unroll
            for (int m = 0; m < 4; ++m) { bf16_t* rowp = O + (size_t)(row0 + ai * HALF + m * 16) * ldc + col0;
                float h[8];
#pragma unroll
                for (int n = 0; n < 2; ++n)
#pragma unroll
                    for (int j = 0; j < 4; ++j) { const float g = acc[ai][0][m][n][j], up = acc[ai][1][m][n][j]; h[4 * n + j] = g * sigmoidf_fast(g) * up; }
                u32x4 w; w.x = cvt_pk_bf16(h[0], h[1]); w.y = cvt_pk_bf16(h[2], h[3]); w.z = cvt_pk_bf16(h[4], h[5]); w.w = cvt_pk_bf16(h[6], h[7]);
                *(u32x4*)rowp = w; }
    }
};
__device__ __forceinline__ unsigned pk4_fp8(float a, float b, float c, float d) { int w = 0; w = __builtin_amdgcn_cvt_pk_fp8_f32(a, b, w, false); w = __builtin_amdgcn_cvt_pk_fp8_f32(c, d, w, true); return (unsigned)w; }
struct EpiFp8 {
    static constexpr bool PERM = true, AFTER_DRAIN = false;
    unsigned char* O; int ldc; float sc;
    __device__ __forceinline__ void operator()(const f32x4 (&acc)[2][2][4][2], const Unit& u, int wr, int wc, int fr, int fq) const {
        typedef unsigned u32x2 __attribute__((ext_vector_type(2)));
        const int row0 = u.pm * BM + wr * 64 + fr, col0 = u.pn * BM + wc * 32 + 8 * fq;
#pragma unroll
        for (int ai = 0; ai < 2; ++ai)
#pragma unroll
            for (int m = 0; m < 4; ++m) { unsigned char* rowp = O + (size_t)(row0 + ai * HALF + m * 16) * ldc + col0;
#pragma unroll
                for (int bj = 0; bj < 2; ++bj) { const f32x4 v0 = acc[ai][bj][m][0] * sc, v1 = acc[ai][bj][m][1] * sc;
                    *(u32x2*)(rowp + bj * HALF) = (u32x2){pk4_fp8(fminf(fmaxf(v0[0], -448.f), 448.f), fminf(fmaxf(v0[1], -448.f), 448.f), fminf(fmaxf(v0[2], -448.f), 448.f), fminf(fmaxf(v0[3], -448.f), 448.f)),
                                                          pk4_fp8(fminf(fmaxf(v1[0], -448.f), 448.f), fminf(fmaxf(v1[1], -448.f), 448.f), fminf(fmaxf(v1[2], -448.f), 448.f), fminf(fmaxf(v1[3], -448.f), 448.f))}; } }
    }
};
struct EpiSwiGLU8 {
    static constexpr bool PERM = true, AFTER_DRAIN = false;
    unsigned char* O; int ldc; float ascale, hs; LnFold lf;
    __device__ __forceinline__ void operator()(const f32x4 (&acc)[2][2][4][2], const Unit& u, int wr, int wc, int fr, int fq) const {
        const int row0 = u.pm * BM + wr * 64 + fr, col0 = u.pn * HALF + wc * 32 + 8 * fq, cidx = u.pn * BM + wc * 32 + 8 * fq;
        typedef unsigned u32x2 __attribute__((ext_vector_type(2)));
        f32x4 gw[2][2], bw[2][2];
#pragma unroll
        for (int bj = 0; bj < 2; ++bj)
#pragma unroll
            for (int n = 0; n < 2; ++n) { gw[bj][n] = (f32x4){0.f, 0.f, 0.f, 0.f}; bw[bj][n] = (f32x4){0.f, 0.f, 0.f, 0.f}; if (lf.stats) { gw[bj][n] = lf.vec4(lf.gW, cidx + bj * HALF + 4 * n); bw[bj][n] = lf.vec4(lf.bW, cidx + bj * HALF + 4 * n); } }
        float mean8[8], rstd8[8];
#pragma unroll
        for (int q = 0; q < 8; ++q) { mean8[q] = 0.f; rstd8[q] = 1.f; }
        if (lf.stats) lf.rows8(row0, mean8, rstd8);
#pragma unroll
        for (int ai = 0; ai < 2; ++ai)
#pragma unroll
            for (int m = 0; m < 4; ++m) { unsigned char* rowp = O + (size_t)(row0 + ai * HALF + m * 16) * ldc + col0;
                float h[8]; const float mean = mean8[ai * 4 + m], rstd = rstd8[ai * 4 + m];
#pragma unroll
                for (int n = 0; n < 2; ++n)
#pragma unroll
                    for (int j = 0; j < 4; ++j) { const float g = (acc[ai][0][m][n][j] * ascale - gw[0][n][j] * mean) * rstd + bw[0][n][j], up = (acc[ai][1][m][n][j] * ascale - gw[1][n][j] * mean) * rstd + bw[1][n][j];
                        h[4 * n + j] = fminf(fmaxf(g * sigmoidf_fast(g) * up * hs, -448.f), 448.f); }
                *(u32x2*)rowp = (u32x2){pk4_fp8(h[0], h[1], h[2], h[3]), pk4_fp8(h[4], h[5], h[6], h[7])}; }
    }
};
struct EpiGateMerge {
    static constexpr bool PERM = true, AFTER_DRAIN = false;
    const bf16_t* ta; const bf16_t* tb; bf16_t* O; int ldc; const float* b0; const float* b1;
    __device__ __forceinline__ void operator()(const f32x4 (&acc)[2][2][4][2], const Unit& u, int wr, int wc, int fr, int fq) const {
        const int row0 = u.pm * BM + wr * 64 + fr, col0 = u.pn * HALF + wc * 32 + 8 * fq;
        float bb0[8], bb1[8];
#pragma unroll
        for (int j = 0; j < 8; ++j) { bb0[j] = b0[col0 + j]; bb1[j] = b1[col0 + j]; }
#pragma unroll
        for (int ai = 0; ai < 2; ++ai)
#pragma unroll
            for (int m = 0; m < 4; ++m) { const size_t off = (size_t)(row0 + ai * HALF + m * 16) * ldc + col0;
                const u32x4 a = *(const u32x4*)(ta + off), b = *(const u32x4*)(tb + off);
                const float av[8] = {bflo(a.x), bfhi(a.x), bflo(a.y), bfhi(a.y), bflo(a.z), bfhi(a.z), bflo(a.w), bfhi(a.w)};
                const float bv[8] = {bflo(b.x), bfhi(b.x), bflo(b.y), bfhi(b.y), bflo(b.z), bfhi(b.z), bflo(b.w), bfhi(b.w)};
                float h[8];
#pragma unroll
                for (int n = 0; n < 2; ++n)
#pragma unroll
                    for (int j = 0; j < 4; ++j) { const int e = 4 * n + j; h[e] = sigmoidf_fast(acc[ai][0][m][n][j] + bb0[e]) * av[e] + sigmoidf_fast(acc[ai][1][m][n][j] + bb1[e]) * bv[e]; }
                u32x4 w; w.x = cvt_pk_bf16(h[0], h[1]); w.y = cvt_pk_bf16(h[2], h[3]); w.z = cvt_pk_bf16(h[4], h[5]); w.w = cvt_pk_bf16(h[6], h[7]);
                *(u32x4*)(O + off) = w; }
    }
};
struct EpiGateMerge8 {
    static constexpr bool PERM = true, AFTER_DRAIN = false;
    const bf16_t* ta; const bf16_t* tb; unsigned char* O; int ldc; const float* b0; const float* b1; float ascale, ms; LnFold lf;
    __device__ __forceinline__ void operator()(const f32x4 (&acc)[2][2][4][2], const Unit& u, int wr, int wc, int fr, int fq) const {
        const int row0 = u.pm * BM + wr * 64 + fr, col0 = u.pn * HALF + wc * 32 + 8 * fq, cidx = u.pn * BM + wc * 32 + 8 * fq;
        typedef unsigned u32x2 __attribute__((ext_vector_type(2)));
        float mean8[8], rstd8[8]; lf.rows8(row0, mean8, rstd8);
        float bb0[8], bb1[8], gw0[8], gw1[8];
#pragma unroll
        for (int j = 0; j < 8; ++j) { bb0[j] = b0[col0 + j] + lf.bW[cidx + j]; bb1[j] = b1[col0 + j] + lf.bW[cidx + HALF + j]; gw0[j] = lf.gW[cidx + j]; gw1[j] = lf.gW[cidx + HALF + j]; }
#pragma unroll
        for (int am = 0; am < 8; am += 2) {
            u32x4 pa[2], pb[2];
#pragma unroll
            for (int e2 = 0; e2 < 2; ++e2) { const size_t off = (size_t)(row0 + ((am + e2) >> 2) * HALF + ((am + e2) & 3) * 16) * ldc + col0; pa[e2] = *(const u32x4*)(ta + off); pb[e2] = *(const u32x4*)(tb + off); }
#pragma unroll
            for (int e2 = 0; e2 < 2; ++e2) { const int ai = (am + e2) >> 2, m = (am + e2) & 3; const size_t off = (size_t)(row0 + ai * HALF + m * 16) * ldc + col0;
                const u32x4 a = pa[e2], b = pb[e2];
                const float av[8] = {bflo(a.x), bfhi(a.x), bflo(a.y), bfhi(a.y), bflo(a.z), bfhi(a.z), bflo(a.w), bfhi(a.w)};
                const float bv[8] = {bflo(b.x), bfhi(b.x), bflo(b.y), bfhi(b.y), bflo(b.z), bfhi(b.z), bflo(b.w), bfhi(b.w)};
                float h[8]; const float mean = mean8[ai * 4 + m], rstd = rstd8[ai * 4 + m];
#pragma unroll
                for (int n = 0; n < 2; ++n)
#pragma unroll
                    for (int j = 0; j < 4; ++j) { const int e = 4 * n + j; const float v = sigmoidf_fast((acc[ai][0][m][n][j] * ascale - gw0[e] * mean) * rstd + bb0[e]) * av[e] + sigmoidf_fast((acc[ai][1][m][n][j] * ascale - gw1[e] * mean) * rstd + bb1[e]) * bv[e];
                        h[e] = fminf(fmaxf(v * ms, -448.f), 448.f); }
                *(u32x2*)(O + off) = (u32x2){pk4_fp8(h[0], h[1], h[2], h[3]), pk4_fp8(h[4], h[5], h[6], h[7])}; }
            asm volatile("" ::: "memory"); }
    }
};
template <bool RES32, int NB = 2> struct EpiRes {
    static constexpr bool PERM = true, AFTER_DRAIN = false;
    const float* res32; const bf16_t* res16; int ldc; float alpha, s;
    const long long* rstats; const float* rg; const float* rb; long long* ostats; bf16_t* o16; unsigned char* o8; float o8s;
    __device__ __forceinline__ void operator()(const f32x4 (&acc)[2][2][4][2], const Unit& u, int wr, int wc, int fr, int fq) const {
        const int col0 = u.pn * BM + wc * 32 + 8 * fq;
        typedef unsigned u32x2 __attribute__((ext_vector_type(2)));
        float al = alpha, sa = s; asm volatile("" : "+v"(al), "+v"(sa));
        const int rowb = u.pm * BM + wr * 64 + fr;
        float mean8[8], rstd8[8];
#pragma unroll
        for (int q = 0; q < 8; ++q) { mean8[q] = 0.f; rstd8[q] = 1.f; }
        if (rstats) { LnFold lf{rstats, nullptr, nullptr}; lf.rows8(rowb, mean8, rstd8); }
        asm volatile("" : "+v"(mean8[0]), "+v"(mean8[1]), "+v"(mean8[2]), "+v"(mean8[3]), "+v"(mean8[4]), "+v"(mean8[5]), "+v"(mean8[6]), "+v"(mean8[7]), "+v"(rstd8[0]), "+v"(rstd8[1]), "+v"(rstd8[2]), "+v"(rstd8[3]), "+v"(rstd8[4]), "+v"(rstd8[5]), "+v"(rstd8[6]), "+v"(rstd8[7]) :: "memory");
        f32x4 gv[2][2], bv[2][2];
#pragma unroll
        for (int bj = 0; bj < 2; ++bj)
#pragma unroll
            for (int n = 0; n < 2; ++n) { gv[bj][n] = (f32x4){1.f, 1.f, 1.f, 1.f}; bv[bj][n] = (f32x4){0.f, 0.f, 0.f, 0.f};
                if (rstats) { gv[bj][n] = *(const f32x4*)(rg + col0 + bj * HALF + 4 * n); bv[bj][n] = *(const f32x4*)(rb + col0 + bj * HALF + 4 * n); }
                gv[bj][n] = gv[bj][n] * al; bv[bj][n] = bv[bj][n] * al; }
#pragma unroll
        for (int am = 0; am < 8; am += NB) {
            f32x4 rr[RES32 ? NB : 1][2][2]; u32x4 rw[NB][2];
#pragma unroll
            for (int e2 = 0; e2 < NB; ++e2) { const size_t off = (size_t)(rowb + ((am + e2) >> 2) * HALF + ((am + e2) & 3) * 16) * ldc + col0;
#pragma unroll
                for (int bj = 0; bj < 2; ++bj) {
                    if constexpr (RES32) { rr[e2][bj][0] = *(const f32x4*)(res32 + off + bj * HALF); rr[e2][bj][1] = *(const f32x4*)(res32 + off + bj * HALF + 4); }
                    else rw[e2][bj] = *(const u32x4*)(res16 + off + bj * HALF); } }
#pragma unroll
            for (int e2 = 0; e2 < NB; ++e2) { const int ai = (am + e2) >> 2, m = (am + e2) & 3; const int row = rowb + ai * HALF + m * 16; const size_t off = (size_t)row * ldc + col0;
                const float mean = mean8[am + e2], rstd = rstd8[am + e2];
                float ps = 0.f, pq = 0.f;
#pragma unroll
                for (int bj = 0; bj < 2; ++bj) {
                    f32x4 r0, r1;
                    if constexpr (RES32) { r0 = rr[e2][bj][0]; r1 = rr[e2][bj][1]; } else { const u32x4 w = rw[e2][bj]; r0 = (f32x4){bflo(w.x), bfhi(w.x), bflo(w.y), bfhi(w.y)}; r1 = (f32x4){bflo(w.z), bfhi(w.z), bflo(w.w), bfhi(w.w)}; }
                    const f32x4 z0 = (r0 - mean) * rstd * gv[bj][0] + bv[bj][0] + acc[ai][bj][m][0] * sa, z1 = (r1 - mean) * rstd * gv[bj][1] + bv[bj][1] + acc[ai][bj][m][1] * sa;
                    u32x4 w16; w16.x = cvt_pk_bf16(z0[0], z0[1]); w16.y = cvt_pk_bf16(z0[2], z0[3]); w16.z = cvt_pk_bf16(z1[0], z1[1]); w16.w = cvt_pk_bf16(z1[2], z1[3]);
                    *(u32x4*)(o16 + off + bj * HALF) = w16;
                    const float q0 = bflo(w16.x), q1 = bfhi(w16.x), q2 = bflo(w16.y), q3 = bfhi(w16.y), q4 = bflo(w16.z), q5 = bfhi(w16.z), q6 = bflo(w16.w), q7 = bfhi(w16.w);
                    ps += ((q0 + q1) + (q2 + q3)) + ((q4 + q5) + (q6 + q7)); pq += ((q0 * q0 + q1 * q1) + (q2 * q2 + q3 * q3)) + ((q4 * q4 + q5 * q5) + (q6 * q6 + q7 * q7));
                    if (o8) *(u32x2*)(o8 + off + bj * HALF) = (u32x2){pk4_fp8(fminf(fmaxf(q0 * o8s, -448.f), 448.f), fminf(fmaxf(q1 * o8s, -448.f), 448.f), fminf(fmaxf(q2 * o8s, -448.f), 448.f), fminf(fmaxf(q3 * o8s, -448.f), 448.f)),
                                                                      pk4_fp8(fminf(fmaxf(q4 * o8s, -448.f), 448.f), fminf(fmaxf(q5 * o8s, -448.f), 448.f), fminf(fmaxf(q6 * o8s, -448.f), 448.f), fminf(fmaxf(q7 * o8s, -448.f), 448.f))}; }
                if (ostats) { ps += __shfl_xor(ps, 16); ps += __shfl_xor(ps, 32); pq += __shfl_xor(pq, 16); pq += __shfl_xor(pq, 32);
                    if (fq == 0) { (void)__hip_atomic_fetch_add(ostats + 2 * (size_t)row, (long long)__builtin_rintf(ps * 1048576.f), __ATOMIC_RELAXED, __HIP_MEMORY_SCOPE_AGENT); (void)__hip_atomic_fetch_add(ostats + 2 * (size_t)row + 1, (long long)__builtin_rintf(pq * 65536.f), __ATOMIC_RELAXED, __HIP_MEMORY_SCOPE_AGENT); } } }
            asm volatile("" ::: "memory"); }
    }
};

typedef int v8i_t __attribute__((ext_vector_type(8)));
typedef int v4i_t __attribute__((ext_vector_type(4)));
template <class Epi, class Sched, bool ALIGN_EPI, bool FP8 = false>
__device__ __forceinline__ void gemm_phase(PG8_LAS unsigned char* lds, const Gemm g, const Sched& S, const Epi& E, const int wid) {
    const int lane = lane_fresh(), tid = wid * 64 + lane, wr = wid >> 2, wc = wid & 3, fr = lane & 15, fq = lane >> 4;
    const int K = g.K, nt = K / BK;
    unsigned voffA[2], voffB[2];
#pragma unroll
    for (int i = 0; i < 2; ++i) { int R, C; stage_rc(tid * 16 + i * 8192, R, C); const int Rb = Epi::PERM ? ((R & ~31) + perm32(R & 31)) : R;
        voffA[i] = (unsigned)(R * g.lda + C) * 2u; voffB[i] = (unsigned)(Rb * g.ldb + C) * 2u; }
    const size_t kstep = (size_t)(BK * 2);
    const size_t hstepA = (size_t)HALF * g.lda * 2, hstepB = (size_t)HALF * g.ldb * 2;
    const size_t tstepA = 2 * hstepA, tstepB = 2 * hstepB;
    const unsigned ldsw = (unsigned)wid * 1024u;
    int aoff = lds_byte(wr * 64 + fr, fq * 8), boff = lds_byte(wc * 32 + fr, fq * 8);
    asm volatile("" : "+v"(voffA[0]), "+v"(voffA[1]), "+v"(voffB[0]), "+v"(voffB[1]), "+v"(aoff), "+v"(boff));
#define PG8_UA(u) ((const char*)g.A + (size_t)(u).pm * tstepA + (size_t)(((u).pn >> g.a_shift) * g.a_mul) * 2)
#define PG8_UB(u) ((const char*)g.Bt + (size_t)(u).pn * tstepB)
#define PG8_SA(b, h) (((b) * 2 + (h)) * HTB)
#define PG8_SB(b, h) ((4 + (b) * 2 + (h)) * HTB)
#define PG8_STAGE(bufoff, gbase, voff) do { _Pragma("unroll") for (int _i = 0; _i < 2; ++_i) \
        __builtin_amdgcn_global_load_lds((const unsigned*)((const char*)(gbase) + (voff)[_i]), (PG8_LAS unsigned*)(lds + (bufoff) + ldsw + _i * 8192), 16, 0, 0); } while (0)
#define PG8_LD8(p_) __builtin_shufflevector(*(const PG8_LAS v4i_t*)(p_), *(const PG8_LAS v4i_t*)((p_) + 1024), 0, 1, 2, 3, 4, 5, 6, 7)
#define PG8_LDA(dst, b, h) do { _Pragma("unroll") for (int m = 0; m < 4; ++m) { if constexpr (FP8) dst##8[m] = PG8_LD8(lds + PG8_SA(b, h) + aoff + m * 2048); else { _Pragma("unroll") for (int k = 0; k < 2; ++k) dst[m][k] = *(const PG8_LAS bf16x8*)(lds + PG8_SA(b, h) + aoff + m * 2048 + k * 1024); } } } while (0)
#define PG8_LDB(dst, b, h) do { _Pragma("unroll") for (int n = 0; n < 2; ++n) { if constexpr (FP8) dst##8[n] = PG8_LD8(lds + PG8_SB(b, h) + boff + n * 2048); else { _Pragma("unroll") for (int k = 0; k < 2; ++k) dst[n][k] = *(const PG8_LAS bf16x8*)(lds + PG8_SB(b, h) + boff + n * 2048 + k * 1024); } } } while (0)
#define PG8_MMA(ai, bj, At, Bt) do { __builtin_amdgcn_s_setprio(1); _Pragma("unroll") for (int m = 0; m < 4; ++m) _Pragma("unroll") for (int n = 0; n < 2; ++n) { \
        if constexpr (FP8) asm volatile("v_mfma_scale_f32_16x16x128_f8f6f4 %0, %1, %2, %0, %3, %3 op_sel_hi:[0,0,0]" : "+v"(acc[ai][bj][m][n]) : "v"(Bt##8[n]), "v"(At##8[m]), "v"(one_scale)); \
        else { _Pragma("unroll") for (int k = 0; k < 2; ++k) acc[ai][bj][m][n] = __builtin_amdgcn_mfma_f32_16x16x32_bf16(Bt[n][k], At[m][k], acc[ai][bj][m][n], 0, 0, 0); } } \
        __builtin_amdgcn_s_setprio(0); } while (0)
#define PG8_WAIT_V(n) asm volatile("s_waitcnt vmcnt(" #n ")" ::: "memory")
#define PG8_WAIT_L(n) asm volatile("s_waitcnt lgkmcnt(" #n ")" ::: "memory")
#define PG8_BAR __builtin_amdgcn_s_barrier()
#define PG8_SCHED __builtin_amdgcn_sched_barrier(0)
    Unit cur, nxt; int ui = 0;
    if (!S.next(0, cur)) return;
    f32x4 acc[2][2][4][2];
#pragma unroll
    for (int a = 0; a < 2; ++a)
#pragma unroll
        for (int b = 0; b < 2; ++b)
#pragma unroll
            for (int m = 0; m < 4; ++m)
#pragma unroll
                for (int n = 0; n < 2; ++n) acc[a][b][m][n] = (f32x4){0.f, 0.f, 0.f, 0.f};
    bf16x8 At[4][2], B0[2][2], B1[2][2]; v8i_t At8[4], B08[2], B18[2];
    int one_scale = 0x7f7f7f7f; asm volatile("" : "+v"(one_scale));
    const char* cA = PG8_UA(cur); const char* cB = PG8_UB(cur);
    S.a_ready(cur);
    PG8_STAGE(PG8_SB(0, 0), cB, voffB); PG8_STAGE(PG8_SB(0, 1), cB + hstepB, voffB); PG8_STAGE(PG8_SA(0, 0), cA, voffA); PG8_STAGE(PG8_SA(0, 1), cA + hstepA, voffA);
    if (wr == 1) PG8_BAR;
    PG8_WAIT_V(2); PG8_BAR;
    PG8_STAGE(PG8_SB(1, 0), cB + kstep, voffB); PG8_STAGE(PG8_SA(1, 0), cA + kstep, voffA); PG8_STAGE(PG8_SB(1, 1), cB + hstepB + kstep, voffB);
    PG8_WAIT_V(6); PG8_BAR;
    for (;;) {
        const bool has_next = S.next(ui + 1, nxt);
        const char* nA = has_next ? PG8_UA(nxt) : cA; const char* nB = has_next ? PG8_UB(nxt) : cB;
        for (int t = 0; t < nt; t += 2) {
            const bool last = (t == nt - 2);
            const char* a1 = cA + (size_t)(t + 1) * kstep;
            const char* a2 = last ? nA : cA + (size_t)(t + 2) * kstep; const char* b2 = last ? nB : cB + (size_t)(t + 2) * kstep;
            const char* a3 = a2 + kstep; const char* b3 = b2 + kstep;
            if (last && has_next) S.a_ready(nxt);
            PG8_LDB(B0, 0, 0); PG8_LDB(B1, 0, 1); PG8_SCHED; PG8_LDA(At, 0, 0); PG8_STAGE(PG8_SA(1, 1), a1 + hstepA, voffA);
            PG8_WAIT_V(8); PG8_WAIT_L(0); PG8_BAR; PG8_MMA(0, 0, At, B0); PG8_MMA(0, 1, At, B1); PG8_BAR; PG8_SCHED;
            PG8_LDA(At, 0, 1); PG8_STAGE(PG8_SB(0, 0), b2, voffB); PG8_STAGE(PG8_SB(0, 1), b2 + hstepB, voffB); PG8_STAGE(PG8_SA(0, 0), a2, voffA);
            PG8_WAIT_V(8); PG8_WAIT_L(0); PG8_BAR; PG8_MMA(1, 0, At, B0); PG8_MMA(1, 1, At, B1); PG8_BAR; PG8_SCHED;
            PG8_LDB(B0, 1, 0); PG8_LDB(B1, 1, 1); PG8_SCHED; PG8_LDA(At, 1, 0); PG8_STAGE(PG8_SA(0, 1), a2 + hstepA, voffA);
            PG8_WAIT_V(8); PG8_WAIT_L(0); PG8_BAR; PG8_MMA(0, 0, At, B0); PG8_MMA(0, 1, At, B1); PG8_BAR; PG8_SCHED;
            PG8_LDA(At, 1, 1); PG8_STAGE(PG8_SB(1, 0), b3, voffB); PG8_STAGE(PG8_SB(1, 1), b3 + hstepB, voffB); PG8_STAGE(PG8_SA(1, 0), a3, voffA);
            PG8_WAIT_V(8); PG8_WAIT_L(0); PG8_BAR; PG8_MMA(1, 0, At, B0); PG8_MMA(1, 1, At, B1); PG8_BAR; PG8_SCHED;
        }
        if constexpr (ALIGN_EPI) { if (wr == 0) PG8_BAR; }
        if constexpr (FP8) asm volatile("s_nop 15\n\ts_nop 7" ::: "memory");
        { const int le = lane_fresh(); E(acc, cur, wr, wc, le & 15, le >> 4); } S.done(cur);
        if (!has_next) break;
#pragma unroll
        for (int a = 0; a < 2; ++a)
#pragma unroll
            for (int b = 0; b < 2; ++b)
#pragma unroll
                for (int m = 0; m < 4; ++m)
#pragma unroll
                    for (int n = 0; n < 2; ++n) acc[a][b][m][n] = (f32x4){0.f, 0.f, 0.f, 0.f};
        cur = nxt; cA = nA; cB = nB; ++ui;
        if constexpr (ALIGN_EPI) { if (wr == 1) PG8_BAR; }
    }
    PG8_WAIT_V(0);
    if constexpr (!ALIGN_EPI) { if (wr == 0) PG8_BAR; }
    PG8_BAR;
#undef PG8_UA
#undef PG8_UB
#undef PG8_SA
#undef PG8_SB
#undef PG8_STAGE
#undef PG8_LDA
#undef PG8_LDB
#undef PG8_MMA
#undef PG8_LD8
#undef PG8_WAIT_V
#undef PG8_WAIT_L
#undef PG8_BAR
#undef PG8_SCHED
}
}

constexpr int NWAVES = 8;
constexpr int BATCH = 4, SEQ = 4096, D = 2048, FF = 5632, M = BATCH * SEQ;
constexpr int N_IN = 5888;
constexpr int MEMT = 256;
constexpr float LN_EPS = 1e-5f;
constexpr float ALPHA = 1.189207115002721f;
constexpr float LAMBDA_INIT = 0.2f;

constexpr size_t MiB = 1u << 20;
constexpr size_t WS_CTL = 0, CTL_ZERO_BYTES = 2 * MiB;
constexpr size_t WS_W_IN = 2 * MiB;
constexpr size_t WS_W_IN8 = WS_W_IN, WS_W_INB = WS_W_IN + 9 * MiB; constexpr int N_IN8 = 4608, N_INB = 1280;
constexpr size_t WS_W_G = 25 * MiB;
constexpr size_t WS_W_UK = 41 * MiB;
constexpr size_t WS_W_UVP = 42 * MiB;
constexpr size_t WS_W_A = 44 * MiB;
constexpr size_t WS_W_B = 48 * MiB;
constexpr size_t WS_W_MO = 52 * MiB;
constexpr size_t WS_W_MQ = 60 * MiB;
constexpr size_t WS_W_MKV = 62 * MiB;
constexpr size_t WS_W_MOUT = 66 * MiB;
constexpr size_t WS_MEM16 = 68 * MiB;
constexpr size_t WS_KVMEM = 72 * MiB;
constexpr size_t WS_W_GU2 = 74 * MiB;
constexpr size_t WS_W_D2 = 96 * MiB;
constexpr size_t WS_X8M = 107 * MiB;
constexpr size_t WS_X16 = 140 * MiB;
constexpr size_t WS_MIX = 204 * MiB;
constexpr size_t WS_W_GU1 = 204 * MiB;
constexpr size_t WS_W_D1 = 248 * MiB;
constexpr size_t WS_H = 270 * MiB;
constexpr size_t WS_AQ = WS_MIX + 0 * MiB, WS_AK = WS_MIX + 32 * MiB, WS_AV = WS_MIX + 64 * MiB, WS_BQ = WS_MIX + 96 * MiB;
constexpr size_t WS_BC = WS_MIX + 128 * MiB;
constexpr size_t WS_IQ = WS_MIX + 144 * MiB;
constexpr size_t WS_IKW = WS_MIX + 176 * MiB;
constexpr size_t WS_QLAT = WS_MIX + 184 * MiB;
constexpr size_t WS_IDX = WS_MIX + 312 * MiB;
constexpr size_t WS_YB = WS_BQ;
constexpr size_t WS_TA = WS_QLAT, WS_TB = WS_QLAT + 64 * MiB;
constexpr size_t WS_QM = WS_AQ, WS_OM = WS_AQ + 16 * MiB;
constexpr size_t WS_X8 = WS_H + 96 * MiB;
constexpr size_t WS_C8 = WS_W_IN;
constexpr size_t WS_MRG8 = WS_AV;
constexpr float FP8_WGS = 1024.f, FP8_MS = 32.f, FP8_WMOS = 2048.f;
constexpr float FP8_XS = 32.f, FP8_WGUS = 1024.f, FP8_HS = 8.f, FP8_WDS = 4096.f;
constexpr size_t WS_END = WS_MIX + 320 * MiB;
static_assert(WS_H + (size_t)M * FF * 2 <= WS_END && WS_QLAT + (size_t)M * 4096 * 2 <= WS_END, "d_ws map");
constexpr int CW_BAR = 4096;
constexpr int CW_DQ = 8192;
constexpr int CW_KMAX = 8256;
constexpr size_t CTL_STATS = 65536, CTL_STATS_STRIDE = (size_t)M * 2 * 8;
constexpr size_t CTL_VEC = CTL_STATS + 3 * CTL_STATS_STRIDE;
constexpr int V_GW_IN = 0, V_BW_IN = 5888, V_GW_G = 11776, V_BW_G = 15872, V_GW_MQ = 19968, V_BW_MQ = 20480, V_GW_GU2 = 20992, V_BW_GU2 = 32256, V_END = 43520;
constexpr size_t CTL_VECF = CTL_VEC + (size_t)V_END * 8;
static_assert(CTL_VECF + (size_t)V_END * 4 <= CTL_ZERO_BYTES, "control region");
constexpr float FX_S = 1048576.f, FX_Q = 65536.f, FX_V = 16777216.f;

constexpr int RING_OFF = 0, RING_BYTES = 153600;
constexpr int LDSCTL_OFF = RING_BYTES, MISC_OFF = LDSCTL_OFF + 320;
constexpr int LDS_BYTES = 154624;
static_assert(MISC_OFF + 128 <= LDS_BYTES, "LDS map");

#define GAS __attribute__((address_space(1)))
#define LAS __attribute__((address_space(3)))
typedef unsigned short bf16;
typedef unsigned v4u __attribute__((ext_vector_type(4)));
typedef unsigned v2u __attribute__((ext_vector_type(2)));
typedef float f32x4 __attribute__((ext_vector_type(4)));
typedef float f32x16 __attribute__((ext_vector_type(16)));
typedef short bf16x8 __attribute__((ext_vector_type(8)));
typedef GAS unsigned gu32;
#define RLX_AGENT __ATOMIC_RELAXED, __HIP_MEMORY_SCOPE_AGENT
#define LDS_WAIT() asm volatile("s_waitcnt lgkmcnt(0)" ::: "memory")
#define VM_WAIT() asm volatile("s_waitcnt vmcnt(0)" ::: "memory")
__device__ __forceinline__ unsigned f2bf(float f) { unsigned u = __builtin_bit_cast(unsigned, f); return (u + 0x7fffu + ((u >> 16) & 1u)) >> 16; }
__device__ __forceinline__ unsigned pk2(float lo, float hi) { return f2bf(lo) | (f2bf(hi) << 16); }
__device__ __forceinline__ float bf2f(unsigned short v) { return __uint_as_float((unsigned)v << 16); }
__device__ __forceinline__ float blo(unsigned w) { return __uint_as_float(w << 16); }
__device__ __forceinline__ float bhi(unsigned w) { return __uint_as_float(w & 0xffff0000u); }
__device__ __forceinline__ float wave_sum(float v) {
    v += __builtin_bit_cast(float, __builtin_amdgcn_update_dpp(0, __builtin_bit_cast(int, v), 0xB1, 0xf, 0xf, true));
    v += __builtin_bit_cast(float, __builtin_amdgcn_update_dpp(0, __builtin_bit_cast(int, v), 0x4E, 0xf, 0xf, true));
    v += __builtin_bit_cast(float, __builtin_amdgcn_update_dpp(0, __builtin_bit_cast(int, v), 0x141, 0xf, 0xf, true));
    v += __builtin_bit_cast(float, __builtin_amdgcn_update_dpp(0, __builtin_bit_cast(int, v), 0x140, 0xf, 0xf, true));
    { const auto rr = __builtin_amdgcn_permlane16_swap(__float_as_uint(v), __float_as_uint(v), false, false); v = __uint_as_float(rr[0]) + __uint_as_float(rr[1]); }
    { const auto rr = __builtin_amdgcn_permlane32_swap(__float_as_uint(v), __float_as_uint(v), false, false); v = __uint_as_float(rr[0]) + __uint_as_float(rr[1]); }
    return v;
}

__device__ __forceinline__ float xhalf_add(float a) { const auto rr = __builtin_amdgcn_permlane32_swap(__float_as_uint(a), __float_as_uint(a), false, false); return __uint_as_float(rr[0]) + __uint_as_float(rr[1]); }
__device__ __forceinline__ float xhalf_max(float a) { const auto rr = __builtin_amdgcn_permlane32_swap(__float_as_uint(a), __float_as_uint(a), false, false); return fmaxf(__uint_as_float(rr[0]), __uint_as_float(rr[1])); }
__device__ __forceinline__ int half_sum_i32(int v) {
    v += __builtin_amdgcn_update_dpp(0, v, 0xB1, 0xf, 0xf, true);
    v += __builtin_amdgcn_update_dpp(0, v, 0x4E, 0xf, 0xf, true);
    v += __builtin_amdgcn_update_dpp(0, v, 0x141, 0xf, 0xf, true);
    v += __builtin_amdgcn_update_dpp(0, v, 0x140, 0xf, 0xf, true);
    const auto rr = __builtin_amdgcn_permlane16_swap((unsigned)v, (unsigned)v, false, false); return (int)rr[0] + (int)rr[1];
}
#define XB_TMO      128
#define XB_XCNT(j)  (256  + 64 * (j))
#define XB_XSUB(j)  (1280 + 64 * (j))
#define XB_XGEN(j)  (2304 + 64 * (j))
#define XB_TOP      3328
#define XB_TOPGEN   3392
#define XCD_BAR_WORDS 3456
#define XB_SPIN_CAP (1u << 18)

__device__ __forceinline__ unsigned xb_ld(unsigned* p)              { return __hip_atomic_load(p, __ATOMIC_RELAXED, __HIP_MEMORY_SCOPE_AGENT); }
__device__ __forceinline__ unsigned xb_add(unsigned* p, unsigned v) { return __hip_atomic_fetch_add(p, v, __ATOMIC_RELAXED, __HIP_MEMORY_SCOPE_AGENT); }
__device__ __forceinline__ unsigned xb_xcc_id() { return (unsigned)__builtin_amdgcn_s_getreg((3 << 11) | 20) & 0xFu; }
#define XB_SPIN(cond, bar) do { unsigned _sp = 0; while (cond) { __builtin_amdgcn_s_sleep(1); \
    if ((++_sp & 255u) == 0u) { if (xb_ld(&(bar)[XB_TMO])) break; if (_sp > XB_SPIN_CAP) { atomicAdd(&(bar)[XB_TMO], 1u); break; } } } } while (0)

struct XcdBarrier {
    unsigned* bar; unsigned x;
    volatile LAS unsigned* st;
};

__device__ __forceinline__ XcdBarrier xcd_barrier_post(unsigned* bar, volatile LAS unsigned* st, bool t0) {
    XcdBarrier b; b.bar = bar; b.x = xb_xcc_id(); b.st = st;
    if (t0) st[2] = xb_add(&bar[XB_XCNT(b.x)], 1u);
    return b;
}
__device__ __forceinline__ void xcd_barrier_complete(unsigned* bar, unsigned x, unsigned& nloc, unsigned& nx) {
    const unsigned G = gridDim.x * gridDim.y * gridDim.z;
    unsigned sum, cnt, mine, sp = 0u;
    for (;;) {
        sum = 0u; cnt = 0u; mine = 0u;
#pragma unroll
        for (unsigned j = 0; j < 16; ++j) { const unsigned c = xb_ld(&bar[XB_XCNT(j)]); sum += c; cnt += (c > 0u) ? 1u : 0u; mine = (j == x) ? c : mine; }
        if (sum == G) break;
        __builtin_amdgcn_s_sleep(1);
        if ((++sp & 255u) == 0u) { if (xb_ld(&bar[XB_TMO])) break; if (sp > XB_SPIN_CAP) { atomicAdd(&bar[XB_TMO], 1u); break; } }
    }
    nloc = mine > 0u ? mine : 1u; nx = cnt > 0u ? cnt : 1u;
}

__device__ __forceinline__ void xcd_barrier(const XcdBarrier& b, const int wave) {
    asm volatile("s_waitcnt vmcnt(0)" ::: "memory");
    __syncthreads();
    if (wave == 0 && lane_fresh() == 0) {
        unsigned* bar = b.bar;
        __builtin_amdgcn_s_waitcnt(0);
        unsigned nloc = b.st[0], nx = b.st[1];
        if (nloc == 0u) { xcd_barrier_complete(bar, b.x, nloc, nx); b.st[0] = nloc; b.st[1] = nx; }
        const unsigned old = xb_add(&bar[XB_XSUB(b.x)], 1u);
        const unsigned gen = old / nloc;
        if (old + 1u == (gen + 1u) * nloc) {
            __builtin_amdgcn_fence(__ATOMIC_RELEASE, "agent");
            asm volatile("s_waitcnt vmcnt(0)" ::: "memory");
            const unsigned og = xb_add(&bar[XB_TOP], 1u);
            const unsigned tg = og / nx;
            if (og + 1u == (tg + 1u) * nx) xb_add(&bar[XB_TOPGEN], 1u);
            else XB_SPIN(xb_ld(&bar[XB_TOPGEN]) == tg, bar);
            __builtin_amdgcn_fence(__ATOMIC_ACQUIRE, "agent");
            xb_add(&bar[XB_XGEN(b.x)], 1u);
            asm volatile("s_waitcnt vmcnt(0)" ::: "memory");
        } else {
            XB_SPIN(xb_ld(&bar[XB_XGEN(b.x)]) == gen, bar);
            __builtin_amdgcn_fence(__ATOMIC_ACQUIRE, "agent");
            asm volatile("s_waitcnt vmcnt(0)" ::: "memory");
        }
    }
    __syncthreads();
}

__device__ __forceinline__ void tr_item(const float* W, int ldw, int nvalid, bf16* WT, int ldt, int k0, int n0, int drow0, int dcol0, LAS float* scr, int lane) {
    { const int n4 = 4 * (lane & 7), kr = lane >> 3; const bool ok = n0 + n4 < nvalid;
#pragma unroll
      for (int i = 0; i < 8; ++i) { const int kk = 8 * i + kr; const f32x4 v = ok ? *(const GAS f32x4*)(W + (size_t)(k0 + kk) * ldw + n0 + n4) : (f32x4){0.f, 0.f, 0.f, 0.f};
          LAS float* d = scr + kk * 33 + n4; d[0] = v.x; d[1] = v.y; d[2] = v.z; d[3] = v.w; } }
    LDS_WAIT(); asm volatile("" ::: "memory");
    const int c = lane & 7;
#pragma unroll
    for (int j = 0; j < 4; ++j) { const int nn = (lane >> 3) + 8 * j; const LAS float* s = scr + (8 * c) * 33 + nn;
        v4u o; o.x = pk2(s[0 * 33], s[1 * 33]); o.y = pk2(s[2 * 33], s[3 * 33]); o.z = pk2(s[4 * 33], s[5 * 33]); o.w = pk2(s[6 * 33], s[7 * 33]);
        *(GAS v4u*)(WT + (size_t)(drow0 + nn) * ldt + dcol0 + k0 + 8 * c) = o; }
    LDS_WAIT(); asm volatile("" ::: "memory");
}
__device__ __forceinline__ void tr_item8(const float* W, int ldw, unsigned char* WT, int ldt, int k0, int n0, int drow0, float sc, LAS float* scr, int lane) {
    { const int n4 = 4 * (lane & 7), kr = lane >> 3;
#pragma unroll
      for (int i = 0; i < 8; ++i) { const int kk = 8 * i + kr; const f32x4 v = *(const GAS f32x4*)(W + (size_t)(k0 + kk) * ldw + n0 + n4);
          LAS float* d = scr + kk * 33 + n4; d[0] = v.x; d[1] = v.y; d[2] = v.z; d[3] = v.w; } }
    LDS_WAIT(); asm volatile("" ::: "memory");
    const int nn = lane >> 1, hf = lane & 1; const LAS float* sp = scr + (32 * hf) * 33 + nn;
    unsigned o[8];
#pragma unroll
    for (int q = 0; q < 8; ++q) { const float a = fminf(fmaxf(sp[(4 * q + 0) * 33] * sc, -448.f), 448.f), b = fminf(fmaxf(sp[(4 * q + 1) * 33] * sc, -448.f), 448.f), c = fminf(fmaxf(sp[(4 * q + 2) * 33] * sc, -448.f), 448.f), d = fminf(fmaxf(sp[(4 * q + 3) * 33] * sc, -448.f), 448.f);
        int w = 0; w = __builtin_amdgcn_cvt_pk_fp8_f32(a, b, w, false); w = __builtin_amdgcn_cvt_pk_fp8_f32(c, d, w, true); o[q] = (unsigned)w; }
    GAS v4u* dst = (GAS v4u*)(WT + (size_t)(drow0 + nn) * ldt + k0 + 32 * hf);
    dst[0] = (v4u){o[0], o[1], o[2], o[3]}; dst[1] = (v4u){o[4], o[5], o[6], o[7]};
    LDS_WAIT(); asm volatile("" ::: "memory");
}
__device__ __forceinline__ void tr_item_ln(const float* W, int ldw, int nvalid, bf16* WT, int ldt, int k0, int n0, int drow0, const float* gain, const float* bvec, long long* gW, long long* bW, LAS float* scr, int lane) {
    { const int n4 = 4 * (lane & 7), kr = lane >> 3; const bool ok = n0 + n4 < nvalid;
#pragma unroll
      for (int i = 0; i < 8; ++i) { const int kk = 8 * i + kr; const f32x4 v = ok ? *(const GAS f32x4*)(W + (size_t)(k0 + kk) * ldw + n0 + n4) : (f32x4){0.f, 0.f, 0.f, 0.f};
          LAS float* d = scr + kk * 33 + n4; d[0] = v.x; d[1] = v.y; d[2] = v.z; d[3] = v.w; } }
    LDS_WAIT(); asm volatile("" ::: "memory");
    const int c = lane & 7;
    const f32x4 g0 = *(const GAS f32x4*)(gain + k0 + 8 * c), g1 = *(const GAS f32x4*)(gain + k0 + 8 * c + 4), b0 = *(const GAS f32x4*)(bvec + k0 + 8 * c), b1 = *(const GAS f32x4*)(bvec + k0 + 8 * c + 4);
    const float gk[8] = {g0.x, g0.y, g0.z, g0.w, g1.x, g1.y, g1.z, g1.w}, bk[8] = {b0.x, b0.y, b0.z, b0.w, b1.x, b1.y, b1.z, b1.w};
#pragma unroll
    for (int j = 0; j < 4; ++j) { const int nn = (lane >> 3) + 8 * j; const LAS float* sp = scr + (8 * c) * 33 + nn;
        float v[8], bs = 0.f;
#pragma unroll
        for (int i = 0; i < 8; ++i) { const float raw = sp[i * 33]; v[i] = raw * gk[i]; bs += raw * bk[i]; }
        v4u o; o.x = pk2(v[0], v[1]); o.y = pk2(v[2], v[3]); o.z = pk2(v[4], v[5]); o.w = pk2(v[6], v[7]);
        float gs = ((blo(o.x) + bhi(o.x)) + (blo(o.y) + bhi(o.y))) + ((blo(o.z) + bhi(o.z)) + (blo(o.w) + bhi(o.w)));
        *(GAS v4u*)(WT + (size_t)(drow0 + nn) * ldt + k0 + 8 * c) = o;
        gs += __shfl_xor(gs, 1); gs += __shfl_xor(gs, 2); gs += __shfl_xor(gs, 4); bs += __shfl_xor(bs, 1); bs += __shfl_xor(bs, 2); bs += __shfl_xor(bs, 4);
        if (c == 0) { (void)__hip_atomic_fetch_add(gW + drow0 + nn, (long long)__builtin_rintf(gs * FX_V), __ATOMIC_RELAXED, __HIP_MEMORY_SCOPE_AGENT); (void)__hip_atomic_fetch_add(bW + drow0 + nn, (long long)__builtin_rintf(bs * FX_V), __ATOMIC_RELAXED, __HIP_MEMORY_SCOPE_AGENT); } }
    LDS_WAIT(); asm volatile("" ::: "memory");
}
__device__ __forceinline__ void tr_item8_ln(const float* W, int ldw, unsigned char* WT, int ldt, int k0, int n0, int drow0, float sc, const float* gain, const float* bvec, long long* gW, long long* bW, LAS float* scr, int lane) {
    { const int n4 = 4 * (lane & 7), kr = lane >> 3;
#pragma unroll
      for (int i = 0; i < 8; ++i) { const int kk = 8 * i + kr; const f32x4 v = *(const GAS f32x4*)(W + (size_t)(k0 + kk) * ldw + n0 + n4);
          LAS float* d = scr + kk * 33 + n4; d[0] = v.x; d[1] = v.y; d[2] = v.z; d[3] = v.w; } }
    LDS_WAIT(); asm volatile("" ::: "memory");
    const int nn = lane >> 1, hf = lane & 1; const LAS float* sp = scr + (32 * hf) * 33 + nn;
    unsigned o[8]; float gs = 0.f, bs = 0.f;
#pragma unroll
    for (int q = 0; q < 8; ++q) { const f32x4 g4 = *(const GAS f32x4*)(gain + k0 + 32 * hf + 4 * q), b4 = *(const GAS f32x4*)(bvec + k0 + 32 * hf + 4 * q);
        const float r0 = sp[(4 * q + 0) * 33], r1 = sp[(4 * q + 1) * 33], r2 = sp[(4 * q + 2) * 33], r3 = sp[(4 * q + 3) * 33];
        bs += (r0 * b4.x + r1 * b4.y) + (r2 * b4.z + r3 * b4.w);
        const float a = fminf(fmaxf(r0 * g4.x * sc, -448.f), 448.f), b = fminf(fmaxf(r1 * g4.y * sc, -448.f), 448.f), c = fminf(fmaxf(r2 * g4.z * sc, -448.f), 448.f), d = fminf(fmaxf(r3 * g4.w * sc, -448.f), 448.f);
        int w = 0; w = __builtin_amdgcn_cvt_pk_fp8_f32(a, b, w, false); w = __builtin_amdgcn_cvt_pk_fp8_f32(c, d, w, true); o[q] = (unsigned)w;
        gs += (__builtin_amdgcn_cvt_f32_fp8(w, 0) + __builtin_amdgcn_cvt_f32_fp8(w, 1)) + (__builtin_amdgcn_cvt_f32_fp8(w, 2) + __builtin_amdgcn_cvt_f32_fp8(w, 3)); }
    GAS v4u* dst = (GAS v4u*)(WT + (size_t)(drow0 + nn) * ldt + k0 + 32 * hf);
    dst[0] = (v4u){o[0], o[1], o[2], o[3]}; dst[1] = (v4u){o[4], o[5], o[6], o[7]};
    gs += __shfl_xor(gs, 1); bs += __shfl_xor(bs, 1);
    if (hf == 0) { (void)__hip_atomic_fetch_add(gW + drow0 + nn, (long long)__builtin_rintf(gs / sc * FX_V), __ATOMIC_RELAXED, __HIP_MEMORY_SCOPE_AGENT); (void)__hip_atomic_fetch_add(bW + drow0 + nn, (long long)__builtin_rintf(bs * FX_V), __ATOMIC_RELAXED, __HIP_MEMORY_SCOPE_AGENT); }
    LDS_WAIT(); asm volatile("" ::: "memory");
}
__device__ __forceinline__ void cvt_item8(const float* src, unsigned char* dst, int item, int lane, float sc) {
    const GAS f32x4* sp = (const GAS f32x4*)(src + (size_t)item * 512) + 2 * lane; f32x4 a = sp[0] * sc, b = sp[1] * sc;
    int w0 = 0, w1 = 0; w0 = __builtin_amdgcn_cvt_pk_fp8_f32(fminf(fmaxf(a.x, -448.f), 448.f), fminf(fmaxf(a.y, -448.f), 448.f), w0, false); w0 = __builtin_amdgcn_cvt_pk_fp8_f32(fminf(fmaxf(a.z, -448.f), 448.f), fminf(fmaxf(a.w, -448.f), 448.f), w0, true);
    w1 = __builtin_amdgcn_cvt_pk_fp8_f32(fminf(fmaxf(b.x, -448.f), 448.f), fminf(fmaxf(b.y, -448.f), 448.f), w1, false); w1 = __builtin_amdgcn_cvt_pk_fp8_f32(fminf(fmaxf(b.z, -448.f), 448.f), fminf(fmaxf(b.w, -448.f), 448.f), w1, true);
    *((GAS v2u*)(dst + (size_t)item * 512) + lane) = (v2u){(unsigned)w0, (unsigned)w1};
}
__device__ __forceinline__ void cvt_item(const float* src, bf16* dst, int item, int lane) {
    const GAS f32x4* s = (const GAS f32x4*)(src + (size_t)item * 512) + 2 * lane; const f32x4 a = s[0], b = s[1];
    v4u o; o.x = pk2(a.x, a.y); o.y = pk2(a.z, a.w); o.z = pk2(b.x, b.y); o.w = pk2(b.z, b.w);
    *((GAS v4u*)(dst + (size_t)item * 512) + lane) = o;
}
__device__ __forceinline__ void p0_prologue(const float* const (&in)[24], unsigned char* ws, LAS unsigned char* lds, int gw, int NGW, int wave, int lane) {
    LAS float* scr = (LAS float*)(lds + RING_OFF + wave * 16384);
#define TRM(SRC, Kk, LDW, NVALID, NPAD, DST, LDT, ROWMAP, DCOL) { constexpr int nblk = (NPAD) / 32; constexpr int cnt = ((Kk) / 64) * nblk; \
        if (r < cnt) { const int kb = r / nblk, nb = r % nblk, n0 = 32 * nb; tr_item(SRC, LDW, NVALID, (bf16*)(ws + (DST)), LDT, 64 * kb, n0, (ROWMAP), (DCOL), scr, lane); continue; } r -= cnt; }
#define TRM8(SRC, Kk, LDW, NN, DST, LDT, ROWMAP, SC) { constexpr int nblk = (NN) / 32; constexpr int cnt = ((Kk) / 64) * nblk; \
        if (r < cnt) { const int kb = r / nblk, nb = r % nblk, n0 = 32 * nb; tr_item8(SRC, LDW, (unsigned char*)(ws + (DST)), LDT, 64 * kb, n0, (ROWMAP), SC, scr, lane); continue; } r -= cnt; }
    long long* const vec = (long long*)(ws + WS_CTL + CTL_VEC);
#define TRML(SRC, Kk, LDW, NVALID, NPAD, DST, LDT, ROWMAP, GAIN, BVEC, VG, VB) { constexpr int nblk = (NPAD) / 32; constexpr int cnt = ((Kk) / 64) * nblk; \
        if (r < cnt) { const int kb = r / nblk, nb = r % nblk, n0 = 32 * nb; tr_item_ln(SRC, LDW, NVALID, (bf16*)(ws + (DST)), LDT, 64 * kb, n0, (ROWMAP), GAIN, BVEC, vec + (VG), vec + (VB), scr, lane); continue; } r -= cnt; }
#define TRML8(SRC, Kk, LDW, NN, DST, LDT, ROWMAP, SC, GAIN, BVEC, VG, VB) { constexpr int nblk = (NN) / 32; constexpr int cnt = ((Kk) / 64) * nblk; \
        if (r < cnt) { const int kb = r / nblk, nb = r % nblk, n0 = 32 * nb; tr_item8_ln(SRC, LDW, (unsigned char*)(ws + (DST)), LDT, 64 * kb, n0, (ROWMAP), SC, GAIN, BVEC, vec + (VG), vec + (VB), scr, lane); continue; } r -= cnt; }
    constexpr int N_TR = 2 * (32 * 176) + 88 * 64 + 32 * 184 + 2 * (32 * 64) + 256 + 2 * (16 * 64) + 32 * 64 + 32 * 16 + 32 * 32 + 8 * 64 + 2 * (32 * 176) + 88 * 64;
    for (int it = gw; it < N_TR; it += NGW) {
        int r = it;
        TRM8(in[2], 2048, 5632, 5632, WS_W_GU1, 2048, 256 * (n0 >> 7) + (n0 & 127), FP8_WGUS)
        TRM8(in[3], 2048, 5632, 5632, WS_W_GU1, 2048, 256 * (n0 >> 7) + 128 + (n0 & 127), FP8_WGUS)
        TRM8(in[4], 5632, 2048, 2048, WS_W_D1, 5632, n0, FP8_WDS)
        TRML8(in[5], 2048, 5712, 4608, WS_W_IN8, 2048, n0, FP8_WGS, in[22], in[23], V_GW_IN, V_BW_IN)
        TRML(in[5] + 4608, 2048, 5712, 1104, 1280, WS_W_INB, 2048, n0, in[22], in[23], V_GW_IN + 4608, V_BW_IN + 4608)
        TRML8(in[11], 2048, 2048, 2048, WS_W_G, 2048, 256 * (n0 >> 7) + (n0 & 127), FP8_WGS, in[22], in[23], V_GW_G, V_BW_G)
        TRML8(in[11] + (size_t)2048 * 2048, 2048, 2048, 2048, WS_W_G, 2048, 256 * (n0 >> 7) + 128 + (n0 & 127), FP8_WGS, in[22], in[23], V_GW_G, V_BW_G)
        if (r < 256) { const int h = r >> 5, rr = r & 31, kb = rr >> 2, nb = rr & 3;
            tr_item(in[10] + (size_t)h * 512 * 128, 128, 128, (bf16*)(ws + WS_W_UVP), 1024, 64 * kb, 32 * nb, (h >> 1) * 256 + (h & 1) * 128 + 32 * nb, (h & 1) * 512, scr, lane); continue; } r -= 256;
        TRM(in[13], 1024, 2048, 2048, 2048, WS_W_A, 1024, n0, 0)
        TRM(in[14], 1024, 2048, 2048, 2048, WS_W_B, 1024, n0, 0)
        TRM8(in[15], 2048, 2048, 2048, WS_W_MO, 2048, n0, FP8_WMOS)
        TRML(in[16], 2048, 512, 512, 512, WS_W_MQ, 2048, n0, in[22] + D, in[23] + D, V_GW_MQ, V_BW_MQ)
        TRM(in[17], 2048, 1024, 1024, 1024, WS_W_MKV, 2048, n0, 0)
        TRM(in[18], 512, 2048, 2048, 2048, WS_W_MOUT, 512, n0, 0)
        TRML8(in[19], 2048, 5632, 5632, WS_W_GU2, 2048, 256 * (n0 >> 7) + (n0 & 127), FP8_WGUS, in[22] + 2 * D, in[23] + 2 * D, V_GW_GU2, V_BW_GU2)
        TRML8(in[20], 2048, 5632, 5632, WS_W_GU2, 2048, 256 * (n0 >> 7) + 128 + (n0 & 127), FP8_WGUS, in[22] + 2 * D, in[23] + 2 * D, V_GW_GU2, V_BW_GU2)
        TRM8(in[21], 5632, 2048, 2048, WS_W_D2, 5632, n0, FP8_WDS)
    }
#undef TRM
#undef TRM8
#undef TRML
#undef TRML8
    for (int rw = gw; rw < 1024; rw += NGW) { const int e = (rw >> 7) & 1; *((GAS v4u*)((bf16*)(ws + WS_W_UVP) + (size_t)rw * 1024 + (1 - e) * 512) + lane) = (v4u){0u, 0u, 0u, 0u}; }
    for (int it = gw; it < (M * D) / 512; it += NGW) cvt_item8(in[0], (unsigned char*)(ws + WS_X8), it, lane, FP8_XS);
    for (int it = gw; it < (BATCH * MEMT * D) / 512; it += NGW) cvt_item(in[1], (bf16*)(ws + WS_MEM16), it, lane);
    for (int it = gw; it < (8 * 512 * 128) / 512; it += NGW) cvt_item(in[9], (bf16*)(ws + WS_W_UK), it, lane);
}

__device__ __forceinline__ void ln_phase(float* zx, bf16* x16, unsigned char* x8, const float* g, const float* b, int gw, int NGW, int lane) {
    f32x4 gv[8], bv[8];
#pragma unroll
    for (int j = 0; j < 8; ++j) { gv[j] = *((const GAS f32x4*)g + lane + 64 * j); bv[j] = *((const GAS f32x4*)b + lane + 64 * j); }
    for (int m = gw; m < M; m += NGW) {
        GAS f32x4* xr = (GAS f32x4*)(zx + (size_t)m * D) + lane;
        f32x4 v[8]; float s = 0.f;
#pragma unroll
        for (int j = 0; j < 8; ++j) { v[j] = xr[64 * j]; s += (v[j].x + v[j].y) + (v[j].z + v[j].w); }
        const float mean = wave_sum(s) * (1.f / D); float s2 = 0.f;
#pragma unroll
        for (int j = 0; j < 8; ++j) { v[j] = v[j] - mean; s2 += (v[j].x * v[j].x + v[j].y * v[j].y) + (v[j].z * v[j].z + v[j].w * v[j].w); }
        const float rstd = 1.f / sqrtf(wave_sum(s2) * (1.f / D) + LN_EPS);
#pragma unroll
        for (int j = 0; j < 8; ++j) { v[j] = v[j] * rstd * gv[j] + bv[j]; xr[64 * j] = v[j]; }
        if (x16) { GAS v2u* o8 = (GAS v2u*)(x16 + (size_t)m * D) + lane;
#pragma unroll
            for (int j = 0; j < 8; ++j) o8[64 * j] = (v2u){pk2(v[j].x, v[j].y), pk2(v[j].z, v[j].w)}; }
        if (x8) { GAS unsigned* o4 = (GAS unsigned*)(x8 + (size_t)m * D) + lane;
#pragma unroll
            for (int j = 0; j < 8; ++j) { const f32x4 q = v[j] * FP8_XS; int w = 0; w = __builtin_amdgcn_cvt_pk_fp8_f32(fminf(fmaxf(q.x, -448.f), 448.f), fminf(fmaxf(q.y, -448.f), 448.f), w, false);
                w = __builtin_amdgcn_cvt_pk_fp8_f32(fminf(fmaxf(q.z, -448.f), 448.f), fminf(fmaxf(q.w, -448.f), 448.f), w, true); o4[64 * j] = (unsigned)w; } }
    }
}
__device__ __forceinline__ void ln_final_phase(const bf16* z16, float* outp, const float* g, const float* b, int gw, int NGW, int lane) {
    for (int m0 = gw; m0 < M; m0 += 2 * NGW) {
        const int m1 = m0 + NGW; const bool two = m1 < M;
        v4u w[2][4];
#pragma unroll
        for (int j = 0; j < 4; ++j) { w[0][j] = __builtin_nontemporal_load((const GAS v4u*)(z16 + (size_t)m0 * D) + lane + 64 * j); w[1][j] = two ? __builtin_nontemporal_load((const GAS v4u*)(z16 + (size_t)m1 * D) + lane + 64 * j) : (v4u){0u, 0u, 0u, 0u}; }
#pragma unroll
        for (int rr = 0; rr < 2; ++rr) { if (rr == 1 && !two) break;
            const int m = rr ? m1 : m0;
            float v[32]; float s = 0.f;
#pragma unroll
            for (int j = 0; j < 4; ++j) { const v4u x = w[rr][j]; v[8 * j + 0] = blo(x.x); v[8 * j + 1] = bhi(x.x); v[8 * j + 2] = blo(x.y); v[8 * j + 3] = bhi(x.y); v[8 * j + 4] = blo(x.z); v[8 * j + 5] = bhi(x.z); v[8 * j + 6] = blo(x.w); v[8 * j + 7] = bhi(x.w); }
#pragma unroll
            for (int e = 0; e < 32; ++e) s += v[e];
            const float mean = wave_sum(s) * (1.f / D); float s2 = 0.f;
#pragma unroll
            for (int e = 0; e < 32; ++e) { v[e] -= mean; s2 += v[e] * v[e]; }
            const float rstd = 1.f / sqrtf(wave_sum(s2) * (1.f / D) + LN_EPS);
#pragma unroll
            for (int j = 0; j < 4; ++j) { const int c0 = 512 * j + 8 * lane;
                const f32x4 g0 = *(const GAS f32x4*)(g + c0), g1 = *(const GAS f32x4*)(g + c0 + 4), b0 = *(const GAS f32x4*)(b + c0), b1 = *(const GAS f32x4*)(b + c0 + 4);
                GAS f32x4* o = (GAS f32x4*)(outp + (size_t)m * D + c0);
                __builtin_nontemporal_store((f32x4){v[8 * j + 0], v[8 * j + 1], v[8 * j + 2], v[8 * j + 3]} * rstd * g0 + b0, o); __builtin_nontemporal_store((f32x4){v[8 * j + 4], v[8 * j + 5], v[8 * j + 6], v[8 * j + 7]} * rstd * g1 + b1, o + 1); } }
    }
}
__device__ __forceinline__ void crms_phase(const bf16* bc, unsigned char* c8, const float* kvg, float cs, int gw, int NGW, int lane) {
    float gg[8];
#pragma unroll
    for (int j = 0; j < 8; ++j) gg[j] = kvg[8 * lane + j] * cs;
    for (int m = gw; m < M; m += NGW) {
        const v4u w = *((const GAS v4u*)(bc + (size_t)m * 512) + lane);
        float x[8] = {blo(w.x), bhi(w.x), blo(w.y), bhi(w.y), blo(w.z), bhi(w.z), blo(w.w), bhi(w.w)}; float s = 0.f;
#pragma unroll
        for (int j = 0; j < 8; ++j) s += x[j] * x[j];
        const float r = 1.f / sqrtf(wave_sum(s) * (1.f / 512.f) + LN_EPS);
#pragma unroll
        for (int j = 0; j < 8; ++j) x[j] = fminf(fmaxf(x[j] * r * gg[j], -448.f), 448.f);
        *((GAS v2u*)(c8 + (size_t)m * 512) + lane) = (v2u){pg8::pk4_fp8(x[0], x[1], x[2], x[3]), pg8::pk4_fp8(x[4], x[5], x[6], x[7])};
    }
}
typedef short v4i16_t __attribute__((ext_vector_type(4)));
__device__ __forceinline__ v4i16_t lds_tr16(const LAS unsigned char* p) { return __builtin_amdgcn_ds_read_tr16_b64_v4i16((LAS v4i16_t*)p); }
__device__ __forceinline__ unsigned cvtpk(float lo, float hi) { typedef float f2 __attribute__((ext_vector_type(2))); typedef __bf16 b2 __attribute__((ext_vector_type(2))); f2 v = {lo, hi}; b2 b = __builtin_convertvector(v, b2); return __builtin_bit_cast(unsigned, b); }
__device__ __forceinline__ float xhalf_f(float v) { return __shfl_xor(v, 32); }
constexpr float LOG2E = 1.4426950408889634f;
constexpr float QSCALE = 0.125f * LOG2E;

__device__ __forceinline__ void diff_attn_mfma(LAS unsigned char* lds, const bf16* AQ, const bf16* AK, const bf16* AV, bf16* YA, const float* dlam, const float* subg, unsigned* dq, const unsigned* kmax, const int wave) {
    const int lane = lane_fresh(), r32 = lane & 31, hi = lane >> 5;
    const int comp = wave >> 2, wq = wave & 3;
    const unsigned ksrc = (unsigned)(lane * 1024 + (2 * wave) * 8);
    const unsigned vsrc0 = (unsigned)((16 * ((2 * wave) & 3) + (lane >> 2)) * 1024 + ((2 * wave) >> 2) * 32 + (lane & 3) * 8);
    const unsigned vsrc1 = (unsigned)((16 * ((2 * wave + 1) & 3) + (lane >> 2)) * 1024 + ((2 * wave + 1) >> 2) * 32 + (lane & 3) * 8);
    const unsigned kdst = (unsigned)(2 * wave) * 1024u, vdst0 = 16384u + (unsigned)(((2 * wave) >> 2) * 4096 + ((2 * wave) & 3) * 1024), vdst1 = 16384u + (unsigned)(((2 * wave + 1) >> 2) * 4096 + ((2 * wave + 1) & 3) * 1024);
    const unsigned lds0 = (unsigned)(uintptr_t)lds;
#define DA_STAGE(bo, to) do { \
        glds16(Kg + (to) + ksrc, (unsigned)__builtin_amdgcn_readfirstlane((int)(lds0 + (bo) + kdst))); \
        glds16(Kg + (to) + ksrc + 8, (unsigned)__builtin_amdgcn_readfirstlane((int)(lds0 + (bo) + kdst + 1024))); \
        glds16(Vg + (to) + vsrc0, (unsigned)__builtin_amdgcn_readfirstlane((int)(lds0 + (bo) + vdst0))); \
        glds16(Vg + (to) + vsrc1, (unsigned)__builtin_amdgcn_readfirstlane((int)(lds0 + (bo) + vdst1))); } while (0)
#define DA_WAITBAR() asm volatile("s_waitcnt vmcnt(0) lgkmcnt(0)\n\ts_barrier" ::: "memory")
    const unsigned koff = (unsigned)(((comp * 8 + hi) * 64 + r32) * 16);
    const unsigned voff = (unsigned)(16384 + (4 * hi + ((lane & 15) >> 2)) * 64 + ((lane >> 4) & 1) * 32 + (lane & 3) * 8);
    LAS unsigned* xq = (LAS unsigned*)(lds + 100352);
    for (;;) {
        if (wave == 0 && lane == 0) xq[0] = __hip_atomic_fetch_add(dq, 1u, __ATOMIC_RELAXED, __HIP_MEMORY_SCOPE_AGENT);
        asm volatile("s_waitcnt vmcnt(0) lgkmcnt(0)\n\ts_barrier" ::: "memory");
        const int j = (int)xq[0];
        if (j >= 1024) break;
        const int ub = 31 - (j >> 5), bh = j & 31;
        const int b = bh >> 3, h = 7 - (bh & 7);
        const float sl2 = LOG2E / (float)(2 << h);
        const size_t rowbase = (size_t)b * SEQ; const int q0 = ub * 128;
        const int qpos = q0 + wq * 32 + r32;
        const int nt = 2 * ub + 2;
        const int myt = 2 * ub + 1 + (wq >> 1);
        const bf16* Kg = AK + rowbase * 1024 + h * 128; const bf16* Vg = AV + rowbase * 1024 + h * 128;
        bf16x8 qr[4];
#pragma unroll
        for (int s = 0; s < 4; ++s) qr[s] = *(const GAS bf16x8*)(AQ + (rowbase + qpos) * 1024 + h * 128 + comp * 64 + s * 16 + hi * 8);
        f32x16 o[4];
#pragma unroll
        for (int blk = 0; blk < 4; ++blk)
#pragma unroll
            for (int r = 0; r < 16; ++r) o[blk][r] = 0.f;
        float mrun = -INFINITY;
        f32x16 ol;
#pragma unroll
        for (int r = 0; r < 16; ++r) ol[r] = 0.f;
        const bf16x8 vones = {(short)0x3F80, (short)0x3F80, (short)0x3F80, (short)0x3F80, (short)0x3F80, (short)0x3F80, (short)0x3F80, (short)0x3F80};
        { float qn2 = 0.f;
#pragma unroll
          for (int s = 0; s < 4; ++s) { const v4u w = __builtin_bit_cast(v4u, qr[s]); const float e0 = blo(w.x), e1 = bhi(w.x), e2 = blo(w.y), e3 = bhi(w.y), e4 = blo(w.z), e5 = bhi(w.z), e6 = blo(w.w), e7 = bhi(w.w);
              qn2 += ((e0 * e0 + e1 * e1) + (e2 * e2 + e3 * e3)) + ((e4 * e4 + e5 * e5) + (e6 * e6 + e7 * e7)); }
          qn2 += xhalf_f(qn2);
#pragma unroll
          for (int o_ = 1; o_ < 32; o_ <<= 1) qn2 = fmaxf(qn2, __shfl_xor(qn2, o_));
          const float kb = __uint_as_float(__hip_atomic_load(kmax + (b * 8 + h) * 2 + comp, __ATOMIC_RELAXED, __HIP_MEMORY_SCOPE_AGENT));
          if (lane == 0) xq[8 + wave] = __float_as_uint(sqrtf(qn2) * kb * 8.1f); }
        DA_STAGE(0u, (size_t)(nt - 1) * 64 * 1024);
        DA_WAITBAR();
        int kt_lo = 0;
        { float sb = 0.f;
#pragma unroll
          for (int w_ = 0; w_ < 8; ++w_) sb = fmaxf(sb, __uint_as_float(xq[8 + w_]));
          const float xcut = (float)(q0 - 63) - (40.f + 2.f * sb) / sl2;
          kt_lo = xcut > 0.f ? (int)__builtin_ceilf(xcut * (1.f / 64.f)) : 0; kt_lo = __builtin_amdgcn_readfirstlane(kt_lo); }
        for (int st = 0; st < nt - kt_lo; ++st) {
            const int kt = nt - 1 - st;
            const unsigned bufo = (unsigned)(st & 1) * 32768u;
            if (kt > kt_lo) DA_STAGE(32768u - bufo, (size_t)(kt - 1) * 64 * 1024);
            if (kt < myt) {
                const LAS unsigned char* Kb = lds + bufo + koff;
                f32x16 p0, p1;
#pragma unroll
                for (int r = 0; r < 16; ++r) { p0[r] = 0.f; p1[r] = 0.f; }
                { bf16x8 kf0[4], kf1[4];
#pragma unroll
                  for (int s = 0; s < 4; ++s) { kf0[s] = *(const LAS bf16x8*)(Kb + s * 2048); kf1[s] = *(const LAS bf16x8*)(Kb + s * 2048 + 512); }
#pragma unroll
                  for (int s = 0; s < 4; ++s) { p0 = __builtin_amdgcn_mfma_f32_32x32x16_bf16(kf0[s], qr[s], p0, 0, 0, 0); p1 = __builtin_amdgcn_mfma_f32_32x32x16_bf16(kf1[s], qr[s], p1, 0, 0, 0); } }
                const float qth = (float)(qpos - kt * 64 - 4 * hi);
                float rm = -INFINITY;
#pragma unroll
                for (int r = 0; r < 16; ++r) { const float kr = (float)((r & 3) + 8 * (r >> 2)); const float v0 = qth - kr, v1 = qth - (kr + 32.f);
                    p0[r] = p0[r] - sl2 * fabsf(v0); p1[r] = p1[r] - sl2 * fabsf(v1); rm = fmaxf(rm, fmaxf(p0[r], p1[r])); }
                rm = fmaxf(rm, xhalf_f(rm));
                if (__any(rm > mrun)) { const float mn = fmaxf(mrun, rm), f = __builtin_amdgcn_exp2f(mrun - mn); mrun = mn;
#pragma unroll
                    for (int r = 0; r < 16; ++r) ol[r] *= f;
#pragma unroll
                    for (int blk = 0; blk < 4; ++blk)
#pragma unroll
                        for (int r = 0; r < 16; ++r) o[blk][r] *= f; }
#pragma unroll
                for (int r = 0; r < 16; ++r) { p0[r] = __builtin_amdgcn_exp2f(p0[r] - mrun); p1[r] = __builtin_amdgcn_exp2f(p1[r] - mrun); }
                bf16x8 pw[4];
#pragma unroll
                for (int s = 0; s < 2; ++s) {
                    v4u a = {cvtpk(p0[8 * s + 0], p0[8 * s + 1]), cvtpk(p0[8 * s + 2], p0[8 * s + 3]), cvtpk(p0[8 * s + 4], p0[8 * s + 5]), cvtpk(p0[8 * s + 6], p0[8 * s + 7])};
                    v4u c = {cvtpk(p1[8 * s + 0], p1[8 * s + 1]), cvtpk(p1[8 * s + 2], p1[8 * s + 3]), cvtpk(p1[8 * s + 4], p1[8 * s + 5]), cvtpk(p1[8 * s + 6], p1[8 * s + 7])};
                    pw[s] = __builtin_bit_cast(bf16x8, a); pw[2 + s] = __builtin_bit_cast(bf16x8, c); }
#pragma unroll
                for (int s = 0; s < 4; ++s) ol = __builtin_amdgcn_mfma_f32_32x32x16_bf16(vones, pw[s], ol, 0, 0, 0);
                const LAS unsigned char* Vb = lds + bufo + voff;
                { v4i16_t va[2][4][2];
#pragma unroll
                  for (int s = 0; s < 4; ++s) { va[0][s][0] = lds_tr16(Vb + s * 1024); va[0][s][1] = lds_tr16(Vb + s * 1024 + 512); }
#pragma unroll
                  for (int blk = 0; blk < 4; ++blk) {
                      if (blk < 3) {
#pragma unroll
                          for (int s = 0; s < 4; ++s) { va[(blk + 1) & 1][s][0] = lds_tr16(Vb + (blk + 1) * 4096 + s * 1024); va[(blk + 1) & 1][s][1] = lds_tr16(Vb + (blk + 1) * 4096 + s * 1024 + 512); } }
                      __builtin_amdgcn_sched_barrier(0);
#pragma unroll
                      for (int s = 0; s < 4; ++s) { const v4i16_t lo = va[blk & 1][s][0], hh = va[blk & 1][s][1];
                          const bf16x8 vf = {lo[0], lo[1], lo[2], lo[3], hh[0], hh[1], hh[2], hh[3]};
                          o[blk] = __builtin_amdgcn_mfma_f32_32x32x16_bf16(vf, pw[s], o[blk], 0, 0, 0); }
                      __builtin_amdgcn_sched_barrier(0);
                  } }
            }
            DA_WAITBAR();
        }
        const float inv = 1.f / ol[0];
        LAS float* Y1 = (LAS float*)(lds) + wq * 4096;
        if (comp == 1) {
            float lam; { float a = dlam[lane] * dlam[64 + lane], bq_ = dlam[128 + lane] * dlam[192 + lane]; a = wave_sum(a); bq_ = wave_sum(bq_); lam = __expf(a) - __expf(bq_) + LAMBDA_INIT; }
            const float sc = inv * lam;
#pragma unroll
            for (int blk = 0; blk < 4; ++blk)
#pragma unroll
                for (int r = 0; r < 16; ++r) Y1[(32 * blk + (r & 3) + 8 * (r >> 2) + 4 * hi) * 32 + r32] = o[blk][r] * sc; }
        __syncthreads();
        if (comp == 0) {
            float ss = 0.f;
#pragma unroll
            for (int blk = 0; blk < 4; ++blk)
#pragma unroll
                for (int r = 0; r < 16; ++r) { const float a = o[blk][r] * inv - Y1[(32 * blk + (r & 3) + 8 * (r >> 2) + 4 * hi) * 32 + r32]; o[blk][r] = a; ss += a * a; }
            ss += xhalf_f(ss);
            const float rr = (1.0f - LAMBDA_INIT) / sqrtf(ss * (1.f / 128.f) + LN_EPS);
            LAS unsigned* stg = (LAS unsigned*)(lds + 65536) + wq * (32 * 65);
#pragma unroll
            for (int blk = 0; blk < 4; ++blk) {
#pragma unroll
                for (int r = 0; r < 16; r += 2) { const int e = 32 * blk + (r & 3) + 8 * (r >> 2) + 4 * hi;
                    stg[r32 * 65 + (e >> 1)] = cvtpk(o[blk][r] * rr * subg[e], o[blk][r + 1] * rr * subg[e + 1]); }
                asm volatile("" ::: "memory"); }
            LDS_WAIT(); asm volatile("" ::: "memory");
            bf16* orow = YA + (rowbase + q0 + wq * 32) * 1024 + h * 128;
#pragma unroll 4
            for (int row = 0; row < 32; ++row) *((GAS unsigned*)(orow + (size_t)row * 1024) + lane) = stg[row * 65 + lane];
        }
        __syncthreads();
    }
#undef DA_STAGE
#undef DA_WAITBAR
}

__device__ __forceinline__ unsigned okey(float f) { const unsigned u = __float_as_uint(f); return (u & 0x80000000u) ? ~u : (u | 0x80000000u); }
__device__ __forceinline__ void indexer_topk(LAS unsigned char* lds, const bf16* IQ, const bf16* IKW, unsigned short* IDX, int vcu, int G, const int wave) {
    const int lane = lane_fresh(), r32 = lane & 31, hi = lane >> 5;
    const unsigned lds0 = (unsigned)(uintptr_t)lds;
    const unsigned boff = (unsigned)((hi * 256 + r32) * 16);
    for (int j = vcu; j < 1024; j += G) {
        const int w = j & 255, i = j >> 8, bq = w >> 4, s16 = w & 15;
        const int chunk = (i == 0) ? s16 : (i == 1) ? 31 - s16 : (i == 2) ? 32 + s16 : 63 - s16;
        const int b = bq >> 2, gq = bq & 3;
        const int t0 = b * SEQ + chunk * 64 + gq * 16 + 2 * wave;
        const int ngroups = 2 * (chunk + 1);
        const int ntiles = (ngroups + 7) >> 3;
        const bf16* Kg = IKW + (size_t)b * SEQ * 256;
#define IX_STAGE(tile, bo) do { int tl_ = (tile); asm volatile("" : "+s"(tl_)); _Pragma("unroll") for (int i_ = 0; i_ < 4; ++i_) { const int q_ = 4 * wave + i_; \
            glds16s(Kg + (size_t)(tl_ * 256 + 64 * (q_ & 3)) * 256 + (q_ >> 2) * 8, (unsigned)lane * 512u, (unsigned)__builtin_amdgcn_readfirstlane((int)(lds0 + (bo) + ((q_ >> 2) * 256 + 64 * (q_ & 3)) * 16))); } } while (0)
        asm volatile("s_barrier" ::: "memory");
        IX_STAGE(0, 0u);
        bf16x8 a[4];
#pragma unroll
        for (int ks = 0; ks < 4; ++ks) a[ks] = *(const GAS bf16x8*)(IQ + (size_t)(t0 + (r32 >> 4)) * 1024 + (r32 & 15) * 64 + ks * 16 + 8 * hi);
        float wv[16];
        { const bf16* iwp = IKW + (size_t)t0 * 256 + 64 + 4 * hi;
          const v2u w00 = *(const GAS v2u*)(iwp), w01 = *(const GAS v2u*)(iwp + 8), w10 = *(const GAS v2u*)(iwp + 256), w11 = *(const GAS v2u*)(iwp + 256 + 8);
          wv[0] = blo(w00.x); wv[1] = bhi(w00.x); wv[2] = blo(w00.y); wv[3] = bhi(w00.y); wv[4] = blo(w01.x); wv[5] = bhi(w01.x); wv[6] = blo(w01.y); wv[7] = bhi(w01.y);
          wv[8] = blo(w10.x); wv[9] = bhi(w10.x); wv[10] = blo(w10.y); wv[11] = bhi(w10.y); wv[12] = blo(w11.x); wv[13] = bhi(w11.x); wv[14] = blo(w11.y); wv[15] = bhi(w11.y); }
        typedef float f2_t __attribute__((ext_vector_type(2)));
        f2_t w2[8];
#pragma unroll
        for (int r = 0; r < 8; ++r) w2[r] = (f2_t){wv[2 * r], wv[2 * r + 1]};
#define IX_SCORE(acc_, dst_) do { f2_t s0_ = {0.f, 0.f}, s1_ = {0.f, 0.f}; \
            _Pragma("unroll") for (int r = 0; r < 4; ++r) { \
                const f2_t x0_ = {__int_as_float(max(__float_as_int(acc_[2 * r]), 0)), __int_as_float(max(__float_as_int(acc_[2 * r + 1]), 0))}; \
                const f2_t x1_ = {__int_as_float(max(__float_as_int(acc_[8 + 2 * r]), 0)), __int_as_float(max(__float_as_int(acc_[8 + 2 * r + 1]), 0))}; \
                s0_ = __builtin_elementwise_fma(x0_, w2[r], s0_); s1_ = __builtin_elementwise_fma(x1_, w2[4 + r], s1_); } \
            const auto rr_ = __builtin_amdgcn_permlane32_swap(__float_as_uint(s0_.x + s0_.y), __float_as_uint(s1_.x + s1_.y), false, false); \
            const unsigned u_ = __float_as_uint(__uint_as_float(rr_[0]) + __uint_as_float(rr_[1])); \
            dst_ = u_ ^ ((unsigned)((int)u_ >> 31) | 0x80000000u); } while (0)
        unsigned key[128];
#pragma unroll 64
        for (int g = 0; g < 128; g += 2) {
            if (g < ngroups) {
                const unsigned bufo = (unsigned)((g >> 3) & 1) * 32768u;
                if ((g & 7) == 0) {
                    asm volatile("s_waitcnt vmcnt(0)\n\ts_barrier" ::: "memory");
                    if ((g >> 3) + 1 < ntiles) IX_STAGE((g >> 3) + 1, 32768u - bufo);
                }
                bf16x8 bk0[4], bk1[4];
#pragma unroll
                for (int ks = 0; ks < 4; ++ks) { bk0[ks] = *(const LAS bf16x8*)(lds + bufo + boff + (g & 7) * 512 + ks * 8192); bk1[ks] = *(const LAS bf16x8*)(lds + bufo + boff + ((g + 1) & 7) * 512 + ks * 8192); }
                f32x16 acc0 = {0.f, 0.f, 0.f, 0.f, 0.f, 0.f, 0.f, 0.f, 0.f, 0.f, 0.f, 0.f, 0.f, 0.f, 0.f, 0.f}, acc1 = acc0;
#pragma unroll
                for (int ks = 0; ks < 4; ++ks) acc0 = __builtin_amdgcn_mfma_f32_32x32x16_bf16(a[ks], bk0[ks], acc0, 0, 0, 0);
#pragma unroll
                for (int ks = 0; ks < 4; ++ks) acc1 = __builtin_amdgcn_mfma_f32_32x32x16_bf16(a[ks], bk1[ks], acc1, 0, 0, 0);
                IX_SCORE(acc0, key[g]); IX_SCORE(acc1, key[g + 1]);
            } else { key[g] = 0u; key[g + 1] = 0u; }
        }
#undef IX_SCORE
        unsigned selw[4];
        { unsigned vm[4];
#pragma unroll
          for (int w_ = 0; w_ < 4; ++w_) { const int n_ = ngroups - 32 * w_; vm[w_] = n_ >= 32 ? 0xffffffffu : (n_ <= 0 ? 0u : ((1u << (n_ & 31)) - 1u)); }
          if (chunk >= 4) {
#pragma unroll
              for (int w_ = 0; w_ < 4; ++w_) { if (32 * w_ < ngroups) {
#pragma unroll
                  for (int i_ = 0; i_ < 16; ++i_) { const unsigned x = key[32 * w_ + i_], y = key[32 * w_ + i_ + 16]; key[32 * w_ + i_] = (x & 0x0000ffffu) | (y << 16); key[32 * w_ + i_ + 16] = (x >> 16) | (y & 0xffff0000u); }
#pragma unroll
                  for (int i_ = 0; i_ < 32; ++i_) { if (!(i_ & 8)) { const unsigned x = key[32 * w_ + i_], y = key[32 * w_ + i_ + 8]; key[32 * w_ + i_] = (x & 0x00ff00ffu) | ((y << 8) & 0xff00ff00u); key[32 * w_ + i_ + 8] = ((x >> 8) & 0x00ff00ffu) | (y & 0xff00ff00u); } }
#pragma unroll
                  for (int i_ = 0; i_ < 32; ++i_) { if (!(i_ & 4)) { const unsigned x = key[32 * w_ + i_], y = key[32 * w_ + i_ + 4]; key[32 * w_ + i_] = (x & 0x0f0f0f0fu) | ((y << 4) & 0xf0f0f0f0u); key[32 * w_ + i_ + 4] = ((x >> 4) & 0x0f0f0f0fu) | (y & 0xf0f0f0f0u); } }
#pragma unroll
                  for (int i_ = 0; i_ < 32; ++i_) { if (!(i_ & 2)) { const unsigned x = key[32 * w_ + i_], y = key[32 * w_ + i_ + 2]; key[32 * w_ + i_] = (x & 0x33333333u) | ((y << 2) & 0xccccccccu); key[32 * w_ + i_ + 2] = ((x >> 2) & 0x33333333u) | (y & 0xccccccccu); } }
#pragma unroll
                  for (int i_ = 0; i_ < 32; ++i_) { if (!(i_ & 1)) { const unsigned x = key[32 * w_ + i_], y = key[32 * w_ + i_ + 1]; key[32 * w_ + i_] = (x & 0x55555555u) | ((y << 1) & 0xaaaaaaaau); key[32 * w_ + i_ + 1] = ((x >> 1) & 0x55555555u) | (y & 0xaaaaaaaau); } }
              } }
              unsigned cand[4] = {vm[0], vm[1], vm[2], vm[3]}, abv[4] = {0u, 0u, 0u, 0u}; int nab = 0; bool done = false;
#pragma unroll 32
              for (int bit = 31; bit >= 0; --bit) {
                  if (__all(done ? 1 : 0)) break;
                  const unsigned o0 = cand[0] & key[bit], o1 = cand[1] & key[32 + bit], o2 = cand[2] & key[64 + bit], o3 = cand[3] & key[96 + bit];
                  const int c = half_sum_i32(__popc(o0) + __popc(o1) + __popc(o2) + __popc(o3));
                  const bool take = nab + c >= 256;
                  done = done || (take && nab + c == 256);
                  const unsigned ntm = take ? 0u : 0xffffffffu;
                  nab += c & (int)ntm;
                  abv[0] |= o0 & ntm; abv[1] |= o1 & ntm; abv[2] |= o2 & ntm; abv[3] |= o3 & ntm;
                  cand[0] = o0 ^ (cand[0] & ntm); cand[1] = o1 ^ (cand[1] & ntm); cand[2] = o2 ^ (cand[2] & ntm); cand[3] = o3 ^ (cand[3] & ntm);
              }
#pragma unroll
              for (int w_ = 0; w_ < 4; ++w_) selw[w_] = abv[w_] | cand[w_];
          } else {
#pragma unroll
              for (int w_ = 0; w_ < 4; ++w_) selw[w_] = vm[w_];
          } }
        int base = 0;
        unsigned short* ip = IDX + (size_t)(t0 + hi) * 256;
#pragma unroll
        for (int g = 0; g < 128; ++g) {
            if (g < ngroups) {
                const bool sel = ((selw[g >> 5] >> (g & 31)) & 1u) != 0u;
                const unsigned long long mk = __ballot(sel ? 1 : 0);
                const unsigned mh = hi ? (unsigned)(mk >> 32) : (unsigned)mk;
                const int pos = base + __popc(mh & ((1u << r32) - 1u));
                if (sel && pos < 256) ip[pos] = (unsigned short)(32 * g + r32);
                base += __popc(mh);
            }
        }
    }
#undef IX_STAGE
    asm volatile("s_waitcnt vmcnt(0) lgkmcnt(0)\n\ts_barrier" ::: "memory");
}

constexpr int DSA_PAIRB = 1040;
constexpr int DSA_WAVEB = 16 * DSA_PAIRB + 512;
constexpr int DSA_LDS_END = 8 * DSA_WAVEB;
constexpr float DSA_CS = 64.f, DSA_QS = 64.f, DSA_PS = 256.f;
typedef int v2i_t __attribute__((ext_vector_type(2)));
__device__ __forceinline__ void dsa_mfma(LAS unsigned char* lds, const bf16* QL, bf16* OL, const int omask, const unsigned char* C8, const unsigned short* IDX, int vcu, int G, const int wave) {
    const int lane = lane_fresh(), h16 = lane & 15, g = lane >> 4;
    LAS unsigned char* wl = lds + wave * DSA_WAVEB;
    const unsigned wl0 = (unsigned)(uintptr_t)wl;
    LAS unsigned short* idxs = (LAS unsigned short*)(wl + 16 * DSA_PAIRB);
    const float sc2 = 0.08838834764831845f * LOG2E / (DSA_QS * DSA_CS);
    const float sl2 = (h16 < 8) ? LOG2E / (float)(2 << (h16 & 7)) : 0.f;
    const int ntok = (G == 256) ? 8 : (M - (vcu * 8 + wave) + G * 8 - 1) / (G * 8);
#define DSA_TOK(i) ((G == 256) ? ((vcu >> 6) * SEQ + (vcu & 63) + 64 * (wave + 8 * (i))) : (vcu * 8 + wave + G * 8 * (i)))
    const unsigned qk_off = (unsigned)((h16 >> 1) * DSA_PAIRB + (h16 & 1) * 512 + 32 * g);
    const int trow = (h16 >> 1) < 4 ? 4 * g + (h16 >> 1) : 16 + 4 * g + ((h16 >> 1) - 4);
    const unsigned pv_off = (unsigned)((trow >> 1) * DSA_PAIRB + (trow & 1) * 512 + 8 * (h16 & 1));
    for (int it = 0; it < ntok; ++it) {
        const int t = DSA_TOK(it); const int tpos = t & (SEQ - 1);
        const int n = (tpos >> 6) >= 3 ? 256 : 64 * ((tpos >> 6) + 1); const int nst = n >> 5;
        const unsigned char* Cb = C8 + (size_t)(t >> 12) * SEQ * 512;
        int ln = lane; asm volatile("" : "+v"(ln));
        const int h16b = ln & 15, gb = ln >> 4;
        { const v2u iv = __builtin_nontemporal_load((const GAS v2u*)(IDX + (size_t)t * 256) + ln); *((LAS v2u*)idxs + ln) = iv; }
        pg8::v8i_t qf[4];
        { const unsigned char* qp = (const unsigned char*)QL + (size_t)t * 8192 + (h16b & 7) * 512 + 32 * gb;
#pragma unroll
          for (int s = 0; s < 4; ++s) { const v4u lo = __builtin_nontemporal_load((const GAS v4u*)(qp + 128 * s)), hi = __builtin_nontemporal_load((const GAS v4u*)(qp + 128 * s + 16));
              qf[s] = (pg8::v8i_t){(int)lo.x, (int)lo.y, (int)lo.z, (int)lo.w, (int)hi.x, (int)hi.y, (int)hi.z, (int)hi.w}; } }
        f32x4 o[32];
#pragma unroll
        for (int blk = 0; blk < 32; ++blk) o[blk] = (f32x4){0.f, 0.f, 0.f, 0.f};
        float mrun = -INFINITY, lrun = 0.f;
        asm volatile("s_waitcnt lgkmcnt(0)" ::: "memory");
        for (int k = 0; k < nst; ++k) { const int st = nst - 1 - k;
            { const LAS v4u* ip4 = (const LAS v4u*)(idxs + st * 32);
              const v4u q0 = ip4[0], q1 = ip4[1], q2 = ip4[2], q3 = ip4[3];
              const unsigned iw[16] = {q0.x, q0.y, q0.z, q0.w, q1.x, q1.y, q1.z, q1.w, q2.x, q2.y, q2.z, q2.w, q3.x, q3.y, q3.z, q3.w};
              const unsigned sh = (unsigned)(ln >> 5) * 16u, lo16 = (unsigned)(ln & 31) * 16u;
              unsigned vo[16];
#pragma unroll
              for (int i = 0; i < 16; ++i) vo[i] = ((iw[i] >> sh) & 0xffffu) * 512u + lo16;
              glds16s_x16(Cb, vo, (unsigned)__builtin_amdgcn_readfirstlane((int)wl0)); }
            asm volatile("s_waitcnt vmcnt(0)" ::: "memory");
            f32x4 a0 = {0.f, 0.f, 0.f, 0.f}, a1 = {0.f, 0.f, 0.f, 0.f};
#pragma unroll
            for (int s = 0; s < 4; ++s) {
                const pg8::v4i_t x0 = *(const LAS pg8::v4i_t*)(wl + qk_off + 128 * s), x1 = *(const LAS pg8::v4i_t*)(wl + qk_off + 128 * s + 16);
                const pg8::v4i_t y0 = *(const LAS pg8::v4i_t*)(wl + qk_off + 8 * DSA_PAIRB + 128 * s), y1 = *(const LAS pg8::v4i_t*)(wl + qk_off + 8 * DSA_PAIRB + 128 * s + 16);
                a0 = __builtin_amdgcn_mfma_scale_f32_16x16x128_f8f6f4(__builtin_shufflevector(x0, x1, 0, 1, 2, 3, 4, 5, 6, 7), qf[s], a0, 0, 0, 0, 0x7f7f7f7f, 0, 0x7f7f7f7f);
                a1 = __builtin_amdgcn_mfma_scale_f32_16x16x128_f8f6f4(__builtin_shufflevector(y0, y1, 0, 1, 2, 3, 4, 5, 6, 7), qf[s], a1, 0, 0, 0, 0x7f7f7f7f, 0, 0x7f7f7f7f); }
            const v2u i0 = *(const LAS v2u*)(idxs + st * 32 + 4 * g), i1 = *(const LAS v2u*)(idxs + st * 32 + 16 + 4 * g);
            const int sidx[8] = {(int)(i0.x & 0xffffu), (int)(i0.x >> 16), (int)(i0.y & 0xffffu), (int)(i0.y >> 16), (int)(i1.x & 0xffffu), (int)(i1.x >> 16), (int)(i1.y & 0xffffu), (int)(i1.y >> 16)};
            float lg[8];
#pragma unroll
            for (int r = 0; r < 8; ++r) { const int d = tpos - sidx[r]; lg[r] = (r < 4 ? a0[r & 3] : a1[r & 3]) * sc2 - sl2 * (float)(d < 0 ? -d : d); }
            float rm = fmaxf(fmaxf(fmaxf(lg[0], lg[1]), fmaxf(lg[2], lg[3])), fmaxf(fmaxf(lg[4], lg[5]), fmaxf(lg[6], lg[7])));
            { const auto r1 = __builtin_amdgcn_permlane16_swap(__float_as_uint(rm), __float_as_uint(rm), false, false); rm = fmaxf(__uint_as_float(r1[0]), __uint_as_float(r1[1])); }
            rm = xhalf_max(rm);
            const float mn = fmaxf(mrun, rm), f = __builtin_amdgcn_exp2f(mrun - mn); mrun = mn;
#pragma unroll
            for (int r = 0; r < 8; ++r) lg[r] = __builtin_amdgcn_exp2f(lg[r] - mn) * DSA_PS;
            const unsigned pw0 = pg8::pk4_fp8(lg[0], lg[1], lg[2], lg[3]), pw1 = pg8::pk4_fp8(lg[4], lg[5], lg[6], lg[7]);
            { const float ps = ((__builtin_amdgcn_cvt_f32_fp8((int)pw0, 0) + __builtin_amdgcn_cvt_f32_fp8((int)pw0, 1)) + (__builtin_amdgcn_cvt_f32_fp8((int)pw0, 2) + __builtin_amdgcn_cvt_f32_fp8((int)pw0, 3)))
                           + ((__builtin_amdgcn_cvt_f32_fp8((int)pw1, 0) + __builtin_amdgcn_cvt_f32_fp8((int)pw1, 1)) + (__builtin_amdgcn_cvt_f32_fp8((int)pw1, 2) + __builtin_amdgcn_cvt_f32_fp8((int)pw1, 3)));
              lrun = lrun * f + ps; }
            const long pw = (long)(((unsigned long)pw1 << 32) | (unsigned long)pw0);
            if (__any(f != 1.f)) {
#pragma unroll
                for (int blk = 0; blk < 32; ++blk) o[blk] = o[blk] * f; }
            { v2i_t av[2][4];
#pragma unroll
              for (int i = 0; i < 4; ++i) av[0][i] = __builtin_amdgcn_ds_read_tr8_b64_v2i32((LAS v2i_t*)(wl + pv_off + 16 * i));
#pragma unroll
              for (int grp = 0; grp < 8; ++grp) {
                  if (grp < 7) {
#pragma unroll
                      for (int i = 0; i < 4; ++i) av[(grp + 1) & 1][i] = __builtin_amdgcn_ds_read_tr8_b64_v2i32((LAS v2i_t*)(wl + pv_off + 16 * (4 * grp + 4 + i))); }
                  __builtin_amdgcn_sched_barrier(0);
#pragma unroll
                  for (int i = 0; i < 4; ++i) { const v2i_t a_ = av[grp & 1][i];
                      const long al = (long)(((unsigned long)(unsigned)a_.y << 32) | (unsigned long)(unsigned)a_.x);
                      o[4 * grp + i] = __builtin_amdgcn_mfma_f32_16x16x32_fp8_fp8(al, pw, o[4 * grp + i], 0, 0, 0); }
                  __builtin_amdgcn_sched_barrier(0);
              } }
        }
        float lt = lrun; lt += __shfl_xor(lt, 16); lt += __shfl_xor(lt, 32);
        const float inv = 1.f / (lt * DSA_CS);
        if (h16 < 8) {
#pragma unroll
            for (int blk = 0; blk < 32; ++blk) { const f32x4 v = o[blk] * inv;
                __builtin_nontemporal_store((v2u){cvtpk(v.x, v.y), cvtpk(v.z, v.w)}, (GAS v2u*)(OL + (size_t)(t & omask) * 4096 + h16b * 512 + 16 * blk + 4 * gb)); } }
    }
    asm volatile("s_waitcnt vmcnt(0) lgkmcnt(0)" ::: "memory");
    __syncthreads();
#undef DSA_TOK
}
static_assert(DSA_LDS_END <= RING_BYTES, "DSA LDS map");

__device__ __forceinline__ void memattn_mfma(LAS unsigned char* lds, const bf16* QM, const bf16* KV, bf16* OM, int vcu, int G, const int wave) {
    const int lane = lane_fresh(), r32 = lane & 31, hi = lane >> 5;
    const unsigned voff = (unsigned)(65536 + (4 * hi + ((lane & 15) >> 2)) * 64 + ((lane >> 4) & 1) * 32 + (lane & 3) * 8);
    for (int j = vcu; j < 256; j += G) {
        const int bh = j >> 4, qb = j & 15, b = bh >> 2, h = bh & 3;
        const bf16* Kg = KV + (size_t)b * MEMT * 1024 + h * 128; const bf16* Vg = Kg + 512;
#pragma unroll
        for (int i = 0; i < 8; ++i) { const int q = 8 * wave + i;
            glds16(Kg + (size_t)(64 * (q & 3) + lane) * 1024 + (q >> 2) * 8, (unsigned)__builtin_amdgcn_readfirstlane((int)((unsigned)(uintptr_t)lds + ((q >> 2) * 256 + 64 * (q & 3)) * 16)));
            glds16(Vg + (size_t)(16 * (q & 15) + (lane >> 2)) * 1024 + (q >> 4) * 32 + (lane & 3) * 8, (unsigned)__builtin_amdgcn_readfirstlane((int)((unsigned)(uintptr_t)lds + 65536 + (q >> 4) * 16384 + (q & 15) * 1024))); }
        const size_t qrow = (size_t)b * SEQ + qb * 256 + wave * 32 + r32;
        bf16x8 qr[8];
#pragma unroll
        for (int s = 0; s < 8; ++s) qr[s] = *(const GAS bf16x8*)(QM + qrow * 512 + h * 128 + s * 16 + hi * 8);
        f32x16 o[4];
#pragma unroll
        for (int blk = 0; blk < 4; ++blk)
#pragma unroll
            for (int r = 0; r < 16; ++r) o[blk][r] = 0.f;
        float mrun = -INFINITY, lrun = 0.f;
        asm volatile("s_waitcnt vmcnt(0) lgkmcnt(0)\n\ts_barrier" ::: "memory");
        for (int kt = 0; kt < 4; ++kt) {
            const LAS unsigned char* Kb = lds + (unsigned)((hi * 256 + 64 * kt + r32) * 16);
            f32x16 p0, p1;
#pragma unroll
            for (int r = 0; r < 16; ++r) { p0[r] = 0.f; p1[r] = 0.f; }
#pragma unroll
            for (int s = 0; s < 8; ++s) { const bf16x8 k0 = *(const LAS bf16x8*)(Kb + s * 8192), k1 = *(const LAS bf16x8*)(Kb + s * 8192 + 512);
                p0 = __builtin_amdgcn_mfma_f32_32x32x16_bf16(k0, qr[s], p0, 0, 0, 0); p1 = __builtin_amdgcn_mfma_f32_32x32x16_bf16(k1, qr[s], p1, 0, 0, 0); }
            float rm = -INFINITY;
#pragma unroll
            for (int r = 0; r < 16; ++r) rm = fmaxf(rm, fmaxf(p0[r], p1[r]));
            rm = fmaxf(rm, xhalf_f(rm));
            if (__any(rm > mrun)) { const float mn = fmaxf(mrun, rm), f = __builtin_amdgcn_exp2f(mrun - mn); mrun = mn; lrun *= f;
#pragma unroll
                for (int blk = 0; blk < 4; ++blk)
#pragma unroll
                    for (int r = 0; r < 16; ++r) o[blk][r] *= f; }
            float ls = 0.f;
#pragma unroll
            for (int r = 0; r < 16; ++r) { p0[r] = __builtin_amdgcn_exp2f(p0[r] - mrun); p1[r] = __builtin_amdgcn_exp2f(p1[r] - mrun); ls += p0[r] + p1[r]; }
            lrun += ls;
            bf16x8 pw[4];
#pragma unroll
            for (int s = 0; s < 2; ++s) {
                v4u a = {cvtpk(p0[8 * s + 0], p0[8 * s + 1]), cvtpk(p0[8 * s + 2], p0[8 * s + 3]), cvtpk(p0[8 * s + 4], p0[8 * s + 5]), cvtpk(p0[8 * s + 6], p0[8 * s + 7])};
                v4u c = {cvtpk(p1[8 * s + 0], p1[8 * s + 1]), cvtpk(p1[8 * s + 2], p1[8 * s + 3]), cvtpk(p1[8 * s + 4], p1[8 * s + 5]), cvtpk(p1[8 * s + 6], p1[8 * s + 7])};
                pw[s] = __builtin_bit_cast(bf16x8, a); pw[2 + s] = __builtin_bit_cast(bf16x8, c); }
            const LAS unsigned char* Vb = lds + voff + kt * 4096;
#pragma unroll
            for (int blk = 0; blk < 4; ++blk) {
#pragma unroll
                for (int s = 0; s < 4; ++s) {
                    const v4i16_t lo = lds_tr16(Vb + blk * 16384 + s * 1024), hh = lds_tr16(Vb + blk * 16384 + s * 1024 + 512);
                    const bf16x8 vf = {lo[0], lo[1], lo[2], lo[3], hh[0], hh[1], hh[2], hh[3]};
                    o[blk] = __builtin_amdgcn_mfma_f32_32x32x16_bf16(vf, pw[s], o[blk], 0, 0, 0);
                }
            }
        }
        __syncthreads();
        lrun += xhalf_f(lrun);
        const float inv = 1.f / lrun;
        LAS unsigned* stg = (LAS unsigned*)(lds) + wave * (32 * 65);
#pragma unroll
        for (int blk = 0; blk < 4; ++blk)
#pragma unroll
            for (int r = 0; r < 16; r += 2) { const int e = 32 * blk + (r & 3) + 8 * (r >> 2) + 4 * hi;
                stg[r32 * 65 + (e >> 1)] = cvtpk(o[blk][r] * inv, o[blk][r + 1] * inv); }
        LDS_WAIT(); asm volatile("" ::: "memory");
        bf16* orow = OM + ((size_t)b * SEQ + qb * 256 + wave * 32) * 512 + h * 128;
#pragma unroll 4
        for (int row = 0; row < 32; ++row) *((GAS unsigned*)(orow + (size_t)row * 512) + lane) = stg[row * 65 + lane];
        __syncthreads();
    }
}

constexpr int N_PHASES = 21;
struct Args { const float* in[24]; float* out; unsigned char* ws; int ph_lo, ph_hi; };
__global__ void __launch_bounds__(NWAVES * 64, 2) mk_fwd(Args args) {
    extern __shared__ __attribute__((aligned(16))) unsigned char lds_raw[];
    LAS unsigned char* lds = (LAS unsigned char*)lds_raw;
    volatile LAS unsigned* MISC = (volatile LAS unsigned*)(lds + MISC_OFF);
    const int tid = threadIdx.x, wave = __builtin_amdgcn_readfirstlane(tid >> 6);
#define lane lane_fresh()
    const int G = gridDim.x; int bx = blockIdx.x;
    int vcu = (G % 8 == 0) ? (bx % 8) * (G / 8) + bx / 8 : bx;
    int gw = vcu * NWAVES + wave; const int NGW = G * NWAVES;
    unsigned char* ws = args.ws;
    gu32* ctl = (gu32*)(ws + WS_CTL);
    for (int u = tid; u < (LDS_BYTES - LDSCTL_OFF) / 4; u += NWAVES * 64) ((LAS unsigned*)(lds + LDSCTL_OFF))[u] = 0u;
    __syncthreads();
    const bool one = (args.ph_hi - args.ph_lo) > 1;
    XcdBarrier bar; bar.bar = (unsigned*)(ctl + CW_BAR); bar.x = 0; bar.st = nullptr;
    if (one) bar = xcd_barrier_post((unsigned*)(ctl + CW_BAR), MISC + 8, tid == 0);
    const int lo = args.ph_lo, hi = args.ph_hi;
#ifndef PH_MASK
#define PH_MASK 0xFFFFFFFFu
#endif
#define IN(k) ((((PH_MASK) >> (k)) & 1u) && lo <= (k) && (k) < hi)
#define SEAM(k) do { if (IN(k) && IN((k) + 1)) xcd_barrier(bar, wave); } while (0)
    bf16* const X16 = (bf16*)(ws + WS_X16); bf16* const HB = (bf16*)(ws + WS_H);
    long long* const ST0 = (long long*)(ws + WS_CTL + CTL_STATS); long long* const ST1 = (long long*)(ws + WS_CTL + CTL_STATS + CTL_STATS_STRIDE); long long* const ST2 = (long long*)(ws + WS_CTL + CTL_STATS + 2 * CTL_STATS_STRIDE);
    const float* const VEC = (const float*)(ws + WS_CTL + CTL_VECF);
    float* const out = args.out;
    const float* const ln_g = args.in[22]; const float* const ln_b = args.in[23];
    using namespace pg8;

#ifdef PROBE_P0
    if (IN(0)) { p0_prologue(args.in, ws, lds, gw, NGW, wave, lane); }
#endif
    if (IN(0)) { p0_prologue(args.in, ws, lds, gw, NGW, wave, lane); }
    SEAM(0);
    if (one && IN(0) && (G % 8) == 0) {
        unsigned* xb = (unsigned*)(ctl + CW_BAR); bool even = true;
#pragma unroll
        for (int jx = 0; jx < 16; ++jx) { const unsigned c = xb_ld(&xb[XB_XCNT(jx)]); even = even && (jx < 8 ? c == (unsigned)(G / 8) : c == 0u); }
        const int rank = (int)MISC[10], xcc = (int)xb_xcc_id();
        if (__builtin_amdgcn_readfirstlane(even ? 1 : 0)) { vcu = __builtin_amdgcn_readfirstlane(xcc * (G / 8) + rank); bx = __builtin_amdgcn_readfirstlane(rank * 8 + xcc); gw = vcu * NWAVES + wave; }
    }
    if (IN(1)) { { const long long* vi = (const long long*)(ws + WS_CTL + CTL_VEC); float* vf = (float*)(ws + WS_CTL + CTL_VECF); for (int i = gw * 64 + lane; i < V_END; i += NGW * 64) vf[i] = (float)vi[i] * (1.0f / 16777216.f); }
        Gemm g{(const bf16*)(ws + WS_X8), (const bf16*)(ws + WS_W_GU1), D / 2, D / 2, D / 2, 0, 0}; StaticOrder S; S.init(M, 2 * FF, G, bx); EpiSwiGLU8 E{(unsigned char*)HB, FF, 1.0f / (FP8_XS * FP8_WGUS), FP8_HS, LnFold{nullptr, nullptr, nullptr}};
        gemm_phase<EpiSwiGLU8, StaticOrder, true, true>(lds + RING_OFF, g, S, E, wave); }
    SEAM(1);
    if (IN(2)) { Gemm g{HB, (const bf16*)(ws + WS_W_D1), FF / 2, FF / 2, FF / 2, 0, 0}; StaticOrder S; S.init(M, D, G, bx); EpiRes<true> E{args.in[0], nullptr, D, ALPHA, 0.5f / (FP8_HS * FP8_WDS), nullptr, nullptr, nullptr, ST0, X16, (unsigned char*)(ws + WS_X8M), FP8_XS};
        gemm_phase<EpiRes<true>, StaticOrder, true, true>(lds + RING_OFF, g, S, E, wave); }
    SEAM(2);
    if (IN(4)) {
        { Gemm g{(const bf16*)(ws + WS_X8M), (const bf16*)(ws + WS_W_IN8), D / 2, D / 2, D / 2, 0, 0}; StaticOrder S; S.init(M, N_IN8, G, bx);
          EpiInProj E{(bf16*)(ws + WS_AQ), (bf16*)(ws + WS_AK), (bf16*)(ws + WS_AV), (bf16*)(ws + WS_BQ), (bf16*)(ws + WS_BC), (bf16*)(ws + WS_IQ), (bf16*)(ws + WS_IKW), QSCALE, LnFold{ST0, VEC + V_GW_IN, VEC + V_BW_IN}, (unsigned*)(ctl + CW_KMAX), 0, 1.0f / (FP8_XS * FP8_WGS)};
          gemm_phase<EpiInProj, StaticOrder, true, true>(lds + RING_OFF, g, S, E, wave); }
        { Gemm g{X16, (const bf16*)(ws + WS_W_INB), D, D, D, 0, 0}; StaticOrder S; S.init(M, N_INB, G, (G % 16 == 0) ? (bx + G / 2) % G : bx);
          EpiInProj E{(bf16*)(ws + WS_AQ), (bf16*)(ws + WS_AK), (bf16*)(ws + WS_AV), (bf16*)(ws + WS_BQ), (bf16*)(ws + WS_BC), (bf16*)(ws + WS_IQ), (bf16*)(ws + WS_IKW), QSCALE, LnFold{ST0, VEC + V_GW_IN, VEC + V_BW_IN}, (unsigned*)(ctl + CW_KMAX), N_IN8 / 256, 1.0f};
          gemm_phase<EpiInProj, StaticOrder, true>(lds + RING_OFF, g, S, E, wave); }
        { Gemm g{(const bf16*)(ws + WS_MEM16), (const bf16*)(ws + WS_W_MKV), D, D, D, 0, 0}; StaticOrder S; S.init(BATCH * MEMT, 1024, G, bx >= G - 16 ? bx - (G - 16) : (1 << 20)); EpiBf16 E{(bf16*)(ws + WS_KVMEM), 1024};
          gemm_phase<EpiBf16, StaticOrder, true>(lds + RING_OFF, g, S, E, wave); }
    }
    SEAM(4);
    if (IN(5)) {
        { Gemm g{(const bf16*)(ws + WS_BQ), (const bf16*)(ws + WS_W_UK), 1024, 128, 128, 1, 128}; StaticOrder S; S.init(M, 4096, G, bx); EpiFp8 E{(unsigned char*)(ws + WS_QLAT), 8192, DSA_QS};
          gemm_phase<EpiFp8, StaticOrder, true>(lds + RING_OFF, g, S, E, wave); }
        crms_phase((const bf16*)(ws + WS_BC), (unsigned char*)(ws + WS_C8), args.in[8], DSA_CS, gw, NGW, lane);
    }
    if (IN(7)) indexer_topk(lds, (const bf16*)(ws + WS_IQ), (const bf16*)(ws + WS_IKW), (unsigned short*)(ws + WS_IDX), vcu, G, wave);
    if (IN(7)) diff_attn_mfma(lds, (const bf16*)(ws + WS_AQ), (const bf16*)(ws + WS_AK), (const bf16*)(ws + WS_AV), (bf16*)(ws + WS_AQ), args.in[6], args.in[7], (unsigned*)(ctl + CW_DQ), (const unsigned*)(ctl + CW_KMAX), wave);
    SEAM(7);
    if (IN(8)) dsa_mfma(lds, (const bf16*)(ws + WS_QLAT), (bf16*)(ws + WS_QLAT), 0x7fffffff, (const unsigned char*)(ws + WS_C8), (const unsigned short*)(ws + WS_IDX), vcu, G, wave);
    SEAM(8);
    if (IN(9)) { Gemm g{(const bf16*)(ws + WS_QLAT), (const bf16*)(ws + WS_W_UVP), 4096, 1024, 1024, 0, 1024}; StaticOrder S; S.init(M, 1024, G, bx); EpiBf16 E{(bf16*)(ws + WS_YB), 1024};
        gemm_phase<EpiBf16, StaticOrder, true>(lds + RING_OFF, g, S, E, wave); }
    SEAM(9);
    if (IN(10)) {
        { Gemm g{(const bf16*)(ws + WS_AQ), (const bf16*)(ws + WS_W_A), 1024, 1024, 1024, 0, 0}; StaticOrder S; S.init(M, D, G, bx); EpiBf16 E{(bf16*)(ws + WS_TA), D}; gemm_phase<EpiBf16, StaticOrder, true>(lds + RING_OFF, g, S, E, wave); }
        { Gemm g{(const bf16*)(ws + WS_YB), (const bf16*)(ws + WS_W_B), 1024, 1024, 1024, 0, 0}; StaticOrder S; S.init(M, D, G, bx); EpiBf16 E{(bf16*)(ws + WS_TB), D}; gemm_phase<EpiBf16, StaticOrder, true>(lds + RING_OFF, g, S, E, wave); }
    }
    SEAM(10);
    if (IN(11)) { Gemm g{(const bf16*)(ws + WS_X8M), (const bf16*)(ws + WS_W_G), D / 2, D / 2, D / 2, 0, 0}; StaticOrder S; S.init(M, 2 * D, G, bx);
        EpiGateMerge8 E{(const bf16*)(ws + WS_TA), (const bf16*)(ws + WS_TB), (unsigned char*)(ws + WS_MRG8), D, args.in[12], args.in[12] + D, 1.0f / (FP8_XS * FP8_WGS), FP8_MS, LnFold{ST0, VEC + V_GW_G, VEC + V_BW_G}};
        gemm_phase<EpiGateMerge8, StaticOrder, true, true>(lds + RING_OFF, g, S, E, wave); }
    SEAM(11);
    if (IN(12)) { Gemm g{(const bf16*)(ws + WS_MRG8), (const bf16*)(ws + WS_W_MO), D / 2, D / 2, D / 2, 0, 0}; StaticOrder S; S.init(M, D, G, bx); EpiRes<false, 1> E{nullptr, X16, D, ALPHA, 1.0f / (FP8_MS * FP8_WMOS), ST0, ln_g, ln_b, ST1, X16, nullptr, 0.f};
        gemm_phase<EpiRes<false, 1>, StaticOrder, true, true>(lds + RING_OFF, g, S, E, wave); }
    SEAM(12);
    if (IN(14)) { Gemm g{X16, (const bf16*)(ws + WS_W_MQ), D, D, D, 0, 0}; StaticOrder S; S.init(M, 512, G, bx); EpiBf16 E{(bf16*)(ws + WS_QM), 512, 0.08838834764831845f * LOG2E, LnFold{ST1, VEC + V_GW_MQ, VEC + V_BW_MQ}}; gemm_phase<EpiBf16, StaticOrder, true>(lds + RING_OFF, g, S, E, wave); }
    SEAM(14);
    if (IN(15)) memattn_mfma(lds, (const bf16*)(ws + WS_QM), (const bf16*)(ws + WS_KVMEM), (bf16*)(ws + WS_OM), vcu, G, wave);
    SEAM(15);
    if (IN(16)) { Gemm g{(const bf16*)(ws + WS_OM), (const bf16*)(ws + WS_W_MOUT), 512, 512, 512, 0, 0}; StaticOrder S; S.init(M, D, G, bx); EpiRes<false> E{nullptr, X16, D, ALPHA, 1.0f, ST1, ln_g + D, ln_b + D, ST2, X16, (unsigned char*)(ws + WS_X8), FP8_XS};
        gemm_phase<EpiRes<false>, StaticOrder, true>(lds + RING_OFF, g, S, E, wave); }
    SEAM(16);
    if (IN(18)) { Gemm g{(const bf16*)(ws + WS_X8), (const bf16*)(ws + WS_W_GU2), D / 2, D / 2, D / 2, 0, 0}; StaticOrder S; S.init(M, 2 * FF, G, bx); EpiSwiGLU8 E{(unsigned char*)HB, FF, 1.0f / (FP8_XS * FP8_WGUS), FP8_HS, LnFold{ST2, VEC + V_GW_GU2, VEC + V_BW_GU2}};
        gemm_phase<EpiSwiGLU8, StaticOrder, true, true>(lds + RING_OFF, g, S, E, wave); }
    SEAM(18);
    if (IN(19)) { Gemm g{HB, (const bf16*)(ws + WS_W_D2), FF / 2, FF / 2, FF / 2, 0, 0}; StaticOrder S; S.init(M, D, G, bx); EpiRes<false> E{nullptr, X16, D, ALPHA, 0.5f / (FP8_HS * FP8_WDS), ST2, ln_g + 2 * D, ln_b + 2 * D, nullptr, X16, nullptr, 0.f};
        gemm_phase<EpiRes<false>, StaticOrder, true, true>(lds + RING_OFF, g, S, E, wave); }
    SEAM(19);
    if (IN(20)) ln_final_phase(X16, out, ln_g + 3 * D, ln_b + 3 * D, gw, NGW, lane);
#undef IN
#undef SEAM
#undef lane
}

extern "C" void kernel_launch(void* const* d_in, const int* in_sizes, int n_in, void* d_out, int out_size, void* d_ws, size_t ws_size, hipStream_t stream) {
    static int grid = 0;
    if (grid == 0) {
        if (n_in != 24 || in_sizes[0] != M * D || out_size != M * D || ws_size < WS_END) { fprintf(stderr, "kernel_launch: unexpected shapes (n_in %d, in0 %d, out %d, ws %zu); nothing launched\n", n_in, n_in > 0 ? in_sizes[0] : -1, out_size, ws_size); grid = -1; return; }
        int dev = 0, cus = 0, per_cu = 0;
        if (hipGetDevice(&dev) != hipSuccess || hipDeviceGetAttribute(&cus, hipDeviceAttributeMultiprocessorCount, dev) != hipSuccess) { grid = -1; return; }
        if (hipFuncSetAttribute((const void*)mk_fwd, hipFuncAttributeMaxDynamicSharedMemorySize, LDS_BYTES) != hipSuccess) { fprintf(stderr, "kernel_launch: hipFuncSetAttribute failed\n"); grid = -1; return; }
        if (hipOccupancyMaxActiveBlocksPerMultiprocessor(&per_cu, (const void*)mk_fwd, NWAVES * 64, LDS_BYTES) != hipSuccess || per_cu < 1)
            fprintf(stderr, "kernel_launch: note: the occupancy query reports %d workgroups per CU\n", per_cu);
        (void)hipGetLastError();
        grid = cus;
    }
    if (grid < 0) return;
    if (hipMemsetAsync((char*)d_ws + WS_CTL, 0, CTL_ZERO_BYTES, stream) != hipSuccess) return;
    Args a{};
    for (int i = 0; i < 24; ++i) a.in[i] = (const float*)d_in[i];
    a.out = (float*)d_out; a.ws = (unsigned char*)d_ws;
#if MK_ONE_LAUNCH
    a.ph_lo = 0; a.ph_hi = N_PHASES;
    hipLaunchKernelGGL(mk_fwd, dim3(grid), dim3(NWAVES * 64), LDS_BYTES, stream, a);
#else
    for (int p = 0; p < N_PHASES; ++p) { a.ph_lo = p; a.ph_hi = p + 1; hipLaunchKernelGGL(mk_fwd, dim3(grid), dim3(NWAVES * 64), LDS_BYTES, stream, a); }
#endif
}
```

```cpp
#include <hip/hip_runtime.h>
#include <cstdio>
#include <cstdint>

#ifndef MK_ONE_LAUNCH
#define MK_ONE_LAUNCH 1
#endif

__device__ __forceinline__ int lane_fresh() { int l = (int)__builtin_amdgcn_mbcnt_hi(~0u, __builtin_amdgcn_mbcnt_lo(~0u, 0u)); asm volatile("" : "+v"(l)); return l; }
__device__ __forceinline__ void glds16(const void* gsrc, unsigned lds_dst) { unsigned keep;
    asm volatile("s_mov_b32 %0, m0\n\ts_mov_b32 m0, %2\n\ts_nop 0\n\tglobal_load_lds_dwordx4 %1, off\n\ts_mov_b32 m0, %0" : "=&s"(keep) : "v"(gsrc), "s"(lds_dst) : "memory"); }
__device__ __forceinline__ void glds16s(const void* sbase, unsigned voff, unsigned lds_dst) { unsigned keep;
    asm volatile("s_mov_b32 %0, m0\n\ts_mov_b32 m0, %3\n\ts_nop 0\n\tglobal_load_lds_dwordx4 %1, %2\n\ts_mov_b32 m0, %0" : "=&s"(keep) : "v"(voff), "s"(sbase), "s"(lds_dst) : "memory"); }
__device__ __forceinline__ void glds16s_x16(const void* sbase, const unsigned (&v)[16], unsigned lds_dst0) { unsigned keep;
    asm volatile("s_mov_b32 %0, m0\n\ts_mov_b32 m0, %18\n\ts_nop 0\n\t"
        "global_load_lds_dwordx4 %1, %17\n\ts_add_u32 m0, m0, 1040\n\ts_nop 0\n\t"
        "global_load_lds_dwordx4 %2, %17\n\ts_add_u32 m0, m0, 1040\n\ts_nop 0\n\t"
        "global_load_lds_dwordx4 %3, %17\n\ts_add_u32 m0, m0, 1040\n\ts_nop 0\n\t"
        "global_load_lds_dwordx4 %4, %17\n\ts_add_u32 m0, m0, 1040\n\ts_nop 0\n\t"
        "global_load_lds_dwordx4 %5, %17\n\ts_add_u32 m0, m0, 1040\n\ts_nop 0\n\t"
        "global_load_lds_dwordx4 %6, %17\n\ts_add_u32 m0, m0, 1040\n\ts_nop 0\n\t"
        "global_load_lds_dwordx4 %7, %17\n\ts_add_u32 m0, m0, 1040\n\ts_nop 0\n\t"
        "global_load_lds_dwordx4 %8, %17\n\ts_add_u32 m0, m0, 1040\n\ts_nop 0\n\t"
        "global_load_lds_dwordx4 %9, %17\n\ts_add_u32 m0, m0, 1040\n\ts_nop 0\n\t"
        "global_load_lds_dwordx4 %10, %17\n\ts_add_u32 m0, m0, 1040\n\ts_nop 0\n\t"
        "global_load_lds_dwordx4 %11, %17\n\ts_add_u32 m0, m0, 1040\n\ts_nop 0\n\t"
        "global_load_lds_dwordx4 %12, %17\n\ts_add_u32 m0, m0, 1040\n\ts_nop 0\n\t"
        "global_load_lds_dwordx4 %13, %17\n\ts_add_u32 m0, m0, 1040\n\ts_nop 0\n\t"
        "global_load_lds_dwordx4 %14, %17\n\ts_add_u32 m0, m0, 1040\n\ts_nop 0\n\t"
        "global_load_lds_dwordx4 %15, %17\n\ts_add_u32 m0, m0, 1040\n\ts_nop 0\n\t"
        "global_load_lds_dwordx4 %16, %17\n\ts_mov_b32 m0, %0"
        : "=&s"(keep) : "v"(v[0]), "v"(v[1]), "v"(v[2]), "v"(v[3]), "v"(v[4]), "v"(v[5]), "v"(v[6]), "v"(v[7]), "v"(v[8]), "v"(v[9]), "v"(v[10]), "v"(v[11]), "v"(v[12]), "v"(v[13]), "v"(v[14]), "v"(v[15]), "s"(sbase), "s"(lds_dst0) : "memory", "scc"); }
namespace pg8 {
#define PG8_LAS __attribute__((address_space(3)))
typedef unsigned short bf16_t;
typedef short bf16x8 __attribute__((ext_vector_type(8)));
typedef float f32x4 __attribute__((ext_vector_type(4)));
typedef unsigned u32x4 __attribute__((ext_vector_type(4)));
constexpr int BM = 256, BK = 64, HALF = 128, HTB = HALF * BK * 2  , STAGE_BYTES = 8 * HTB, NXCD = 8, WGM = 8;

__host__ __device__ __forceinline__ int lds_byte(int r, int c) { const int st = (r >> 4) * 2 + (c >> 5), rr = r & 15, cc = c & 31, ob = rr * 64 + cc * 2; return st * 1024 + (ob ^ (((ob >> 9) & 1) << 5)); }
__host__ __device__ __forceinline__ void stage_rc(int b, int& R, int& C) { const int st = b / 1024, sb = b % 1024, swz = sb ^ (((sb >> 9) & 1) << 5); R = (st >> 1) * 16 + swz / 64; C = (st & 1) * 32 + (swz % 64) / 2; }
__host__ __device__ __forceinline__ int perm32(int rho) { const int n = rho >> 4, i = rho & 15; return 8 * (i >> 2) + 4 * n + (i & 3); }

struct Unit { int pm, pn; };
struct Gemm { const bf16_t* A; const bf16_t* Bt; int lda, ldb, K, a_shift, a_mul; int b_wrap, b_kmul; };

struct StaticOrder {
    int nM, nN, nwg, G, c;
    __host__ __device__ void init(int M, int N, int G_, int c_) { nM = M / BM; nN = N / BM; nwg = nM * nN; G = G_; c = c_; }
    __host__ __device__ bool next(int i, Unit& u) const {
        const long L = (long)i * G + c; if (L >= nwg) return false;
        int wgid = (int)L; { const int q = nwg / NXCD, r = nwg % NXCD, xcd = wgid % NXCD, off = wgid / NXCD; wgid = (xcd < r ? xcd * (q + 1) : r * (q + 1) + (xcd - r) * q) + off; }
        const int nig = WGM * nN, gid = wgid / nig, fm = gid * WGM, gsz = (nM - fm) < WGM ? (nM - fm) : WGM;
        u.pm = fm + ((wgid % nig) % gsz); u.pn = (wgid % nig) / gsz; return true;
    }
    __device__ __forceinline__ void a_ready(const Unit&) const {}
    __device__ __forceinline__ void done(const Unit&) const {}
};

__device__ __forceinline__ unsigned cvt_pk_bf16(float lo, float hi) { unsigned r; asm volatile("v_cvt_pk_bf16_f32 %0, %1, %2" : "=v"(r) : "v"(lo), "v"(hi)); return r; }
__device__ __forceinline__ float bflo(unsigned w) { return __uint_as_float(w << 16); }
__device__ __forceinline__ float bfhi(unsigned w) { return __uint_as_float(w & 0xffff0000u); }
__device__ __forceinline__ float sigmoidf_fast(float x) { return __builtin_amdgcn_rcpf(1.0f + __builtin_amdgcn_exp2f(-1.4426950408889634f * x)); }

struct LnFold {
    const long long* stats; const float* gW; const float* bW;
    __device__ __forceinline__ void row(int r, float& mean, float& rstd) const { const long long s0 = stats[2 * (size_t)r], s1 = stats[2 * (size_t)r + 1];
        mean = (float)s0 * (1.0f / (1048576.f * 2048.0f)); rstd = __builtin_amdgcn_rsqf((float)s1 * (1.0f / (65536.f * 2048.0f)) - mean * mean + 1e-5f); }
    __device__ __forceinline__ f32x4 vec4(const float* v, int i) const { return *(const f32x4*)(v + i); }
    __device__ __forceinline__ void rows8(int row0, float (&mean)[8], float (&rstd)[8]) const {
#pragma unroll
        for (int hf = 0; hf < 2; ++hf) { long long s0[4], s1[4];
#pragma unroll
            for (int q = 0; q < 4; ++q) { const size_t r = (size_t)(row0 + hf * 128 + q * 16); s0[q] = stats[2 * r]; s1[q] = stats[2 * r + 1]; }
#pragma unroll
            for (int q = 0; q < 4; ++q) { const float mu = (float)s0[q] * (1.0f / (1048576.f * 2048.0f)); mean[4 * hf + q] = mu; rstd[4 * hf + q] = __builtin_amdgcn_rsqf((float)s1[q] * (1.0f / (65536.f * 2048.0f)) - mu * mu + 1e-5f); }
            asm volatile("" : "+v"(mean[4 * hf]), "+v"(mean[4 * hf + 1]), "+v"(mean[4 * hf + 2]), "+v"(mean[4 * hf + 3]), "+v"(rstd[4 * hf]), "+v"(rstd[4 * hf + 1]), "+v"(rstd[4 * hf + 2]), "+v"(rstd[4 * hf + 3]) :: "memory"); }
    }
};
struct EpiBf16 {
    static constexpr bool PERM = true, AFTER_DRAIN = false;
    bf16_t* O; int ldc; float sc = 1.0f; LnFold lf = {nullptr, nullptr, nullptr};
    __device__ __forceinline__ void operator()(const f32x4 (&acc)[2][2][4][2], const Unit& u, int wr, int wc, int fr, int fq) const {
        const int row0 = u.pm * BM + wr * 64 + fr, col0 = u.pn * BM + wc * 32 + 8 * fq;
        f32x4 gw[2][2], bw[2][2];
#pragma unroll
        for (int bj = 0; bj < 2; ++bj)
#pragma unroll
            for (int n = 0; n < 2; ++n) { gw[bj][n] = (f32x4){0.f, 0.f, 0.f, 0.f}; bw[bj][n] = (f32x4){0.f, 0.f, 0.f, 0.f}; if (lf.stats) { gw[bj][n] = lf.vec4(lf.gW, col0 + bj * HALF + 4 * n); bw[bj][n] = lf.vec4(lf.bW, col0 + bj * HALF + 4 * n); } }
        float mean8[8], rstd8[8];
#pragma unroll
        for (int q = 0; q < 8; ++q) { mean8[q] = 0.f; rstd8[q] = 1.f; }
        if (lf.stats) lf.rows8(row0, mean8, rstd8);
#pragma unroll
        for (int ai = 0; ai < 2; ++ai)
#pragma unroll
            for (int m = 0; m < 4; ++m) { bf16_t* rowp = O + (size_t)(row0 + ai * HALF + m * 16) * ldc + col0;
                const float mean = mean8[ai * 4 + m], rstd = rstd8[ai * 4 + m];
#pragma unroll
                for (int bj = 0; bj < 2; ++bj) { const f32x4 v0 = ((acc[ai][bj][m][0] - gw[bj][0] * mean) * rstd + bw[bj][0]) * sc, v1 = ((acc[ai][bj][m][1] - gw[bj][1] * mean) * rstd + bw[bj][1]) * sc;
                    u32x4 w; w.x = cvt_pk_bf16(v0[0], v0[1]); w.y = cvt_pk_bf16(v0[2], v0[3]); w.z = cvt_pk_bf16(v1[0], v1[1]); w.w = cvt_pk_bf16(v1[2], v1[3]);
                    *(u32x4*)(rowp + bj * HALF) = w; } }
    }
};
struct EpiBf16S {
    static constexpr bool PERM = true, AFTER_DRAIN = false;
    bf16_t* O; size_t pstride; float sc; LnFold lf;
    __device__ __forceinline__ void operator()(const f32x4 (&acc)[2][2][4][2], const Unit& u, int wr, int wc, int fr, int fq) const {
        const int part = u.pn >> 1, row0 = u.pm * BM + wr * 64 + fr, col0 = (u.pn & 1) * BM + wc * 32 + 8 * fq;
        const float fs = part ? 0.f : 1.f;
        f32x4 gw[2][2], bw[2][2];
#pragma unroll
        for (int bj = 0; bj < 2; ++bj)
#pragma unroll
            for (int n = 0; n < 2; ++n) { gw[bj][n] = lf.vec4(lf.gW, col0 + bj * HALF + 4 * n) * fs; bw[bj][n] = lf.vec4(lf.bW, col0 + bj * HALF + 4 * n) * fs; }
        float mean8[8], rstd8[8]; lf.rows8(row0, mean8, rstd8);
        bf16_t* Op = O + (size_t)part * pstride;
#pragma unroll
        for (int ai = 0; ai < 2; ++ai)
#pragma unroll
            for (int m = 0; m < 4; ++m) { bf16_t* rowp = Op + (size_t)(row0 + ai * HALF + m * 16) * 512 + col0;
                const float mean = mean8[ai * 4 + m], rstd = rstd8[ai * 4 + m];
#pragma unroll
                for (int bj = 0; bj < 2; ++bj) { const f32x4 v0 = ((acc[ai][bj][m][0] - gw[bj][0] * mean) * rstd + bw[bj][0]) * sc, v1 = ((acc[ai][bj][m][1] - gw[bj][1] * mean) * rstd + bw[bj][1]) * sc;
                    u32x4 w; w.x = cvt_pk_bf16(v0[0], v0[1]); w.y = cvt_pk_bf16(v0[2], v0[3]); w.z = cvt_pk_bf16(v1[0], v1[1]); w.w = cvt_pk_bf16(v1[2], v1[3]);
                    *(u32x4*)(rowp + bj * HALF) = w; } }
    }
};
struct EpiInProj {
    static constexpr bool PERM = true, AFTER_DRAIN = false;
    bf16_t *aq, *ak, *av, *bq, *bc, *iq, *ikw; float qscale; LnFold lf; unsigned* kmax; int pn0; float ascale;
    __device__ __forceinline__ void operator()(const f32x4 (&acc)[2][2][4][2], const Unit& u, int wr, int wc, int fr, int fq) const {
        bf16_t* base; int ldc, colt; const int pn = u.pn + pn0;
        if (pn < 4) { base = aq; ldc = 1024; colt = pn * 256; }
        else if (pn < 8) { base = ak; ldc = 1024; colt = (pn - 4) * 256; }
        else if (pn < 12) { base = av; ldc = 1024; colt = (pn - 8) * 256; }
        else if (pn < 16) { base = bq; ldc = 1024; colt = (pn - 12) * 256; }
        else if (pn < 18) { base = bc; ldc = 512; colt = (pn - 16) * 256; }
        else if (pn < 22) { base = iq; ldc = 1024; colt = (pn - 18) * 256; }
        else { base = ikw; ldc = 256; colt = 0; }
        const float sc = (pn < 4) ? qscale : 1.0f; float kam[2] = {0.f, 0.f};
        const int row0 = u.pm * BM + wr * 64 + fr, col0 = colt + wc * 32 + 8 * fq, cidx = pn * BM + wc * 32 + 8 * fq;
        f32x4 gw[2][2], bw[2][2];
#pragma unroll
        for (int bj = 0; bj < 2; ++bj)
#pragma unroll
            for (int n = 0; n < 2; ++n) { gw[bj][n] = lf.vec4(lf.gW, cidx + bj * HALF + 4 * n); bw[bj][n] = lf.vec4(lf.bW, cidx + bj * HALF + 4 * n); }
        float mean8[8], rstd8[8]; lf.rows8(row0, mean8, rstd8);
#pragma unroll
        for (int ai = 0; ai < 2; ++ai)
#pragma unroll
            for (int m = 0; m < 4; ++m) { bf16_t* rowp = base + (size_t)(row0 + ai * HALF + m * 16) * ldc + col0;
                const float mean = mean8[ai * 4 + m], rstd = rstd8[ai * 4 + m];
#pragma unroll
                for (int bj = 0; bj < 2; ++bj) { const f32x4 v0 = ((acc[ai][bj][m][0] * ascale - gw[bj][0] * mean) * rstd + bw[bj][0]) * sc, v1 = ((acc[ai][bj][m][1] * ascale - gw[bj][1] * mean) * rstd + bw[bj][1]) * sc;
                    if (pn >= 4 && pn < 8) {
                        float sq = ((v0[0] * v0[0] + v0[1] * v0[1]) + (v0[2] * v0[2] + v0[3] * v0[3])) + ((v1[0] * v1[0] + v1[1] * v1[1]) + (v1[2] * v1[2] + v1[3] * v1[3]));
                        { const auto r1 = __builtin_amdgcn_permlane16_swap(__float_as_uint(sq), __float_as_uint(sq), false, false); sq = __uint_as_float(r1[0]) + __uint_as_float(r1[1]); }
                        { const auto r2 = __builtin_amdgcn_permlane32_swap(__float_as_uint(sq), __float_as_uint(sq), false, false); sq = __uint_as_float(r2[0]) + __uint_as_float(r2[1]); }
                        kam[bj] = fmaxf(kam[bj], sq); }
                    u32x4 w; w.x = cvt_pk_bf16(v0[0], v0[1]); w.y = cvt_pk_bf16(v0[2], v0[3]); w.z = cvt_pk_bf16(v1[0], v1[1]); w.w = cvt_pk_bf16(v1[2], v1[3]);
                    *(u32x4*)(rowp + bj * HALF) = w; } }
        if (pn >= 4 && pn < 8) {
#pragma unroll
            for (int bj = 0; bj < 2; ++bj) { float v = kam[bj];
#pragma unroll
                for (int o = 1; o < 64; o <<= 1) v = fmaxf(v, __shfl_xor(v, o));
                if ((fr | fq) == 0) (void)__hip_atomic_fetch_max(kmax + (((u.pm >> 4) * 8 + 2 * (pn - 4) + bj) * 2 + (wc >> 1)) * 2 + (wc & 1), __float_as_uint(v), __ATOMIC_RELAXED, __HIP_MEMORY_SCOPE_AGENT); } }
    }
};
struct EpiSwiGLU {
    static constexpr bool PERM = true, AFTER_DRAIN = false;
    bf16_t* O; int ldc;
    __device__ __forceinline__ void operator()(const f32x4 (&acc)[2][2][4][2], const Unit& u, int wr, int wc, int fr, int fq) const {
        const int row0 = u.pm * BM + wr * 64 + fr, col0 = u.pn * HALF + wc * 32 + 8 * fq;
#pragma unroll
        for (int ai = 0; ai < 2; ++ai)
#pragma unroll
            for (int m = 0; m < 4; ++m) { bf16_t* rowp = O + (size_t)(row0 + ai * HALF + m * 16) * ldc + col0;
                float h[8];
#pragma unroll
                for (int n = 0; n < 2; ++n)
#pragma unroll
                    for (int j = 0; j < 4; ++j) { const float g = acc[ai][0][m][n][j], up = acc[ai][1][m][n][j]; h[4 * n + j] = g * sigmoidf_fast(g) * up; }
                u32x4 w; w.x = cvt_pk_bf16(h[0], h[1]); w.y = cvt_pk_bf16(h[2], h[3]); w.z = cvt_pk_bf16(h[4], h[5]); w.w = cvt_pk_bf16(h[6], h[7]);
                *(u32x4*)rowp = w; }
    }
};
__device__ __forceinline__ unsigned pk4_fp8(float a, float b, float c, float d) { int w = 0; w = __builtin_amdgcn_cvt_pk_fp8_f32(a, b, w, false); w = __builtin_amdgcn_cvt_pk_fp8_f32(c, d, w, true); return (unsigned)w; }
struct EpiFp8 {
    static constexpr bool PERM = true, AFTER_DRAIN = false;
    unsigned char* O; int ldc; float sc;
    __device__ __forceinline__ void operator()(const f32x4 (&acc)[2][2][4][2], const Unit& u, int wr, int wc, int fr, int fq) const {
        typedef unsigned u32x2 __attribute__((ext_vector_type(2)));
        const int row0 = u.pm * BM + wr * 64 + fr, col0 = u.pn * BM + wc * 32 + 8 * fq;
#pragma unroll
        for (int ai = 0; ai < 2; ++ai)
#pragma unroll
            for (int m = 0; m < 4; ++m) { unsigned char* rowp = O + (size_t)(row0 + ai * HALF + m * 16) * ldc + col0;
#pragma unroll
                for (int bj = 0; bj < 2; ++bj) { const f32x4 v0 = acc[ai][bj][m][0] * sc, v1 = acc[ai][bj][m][1] * sc;
                    *(u32x2*)(rowp + bj * HALF) = (u32x2){pk4_fp8(fminf(fmaxf(v0[0], -448.f), 448.f), fminf(fmaxf(v0[1], -448.f), 448.f), fminf(fmaxf(v0[2], -448.f), 448.f), fminf(fmaxf(v0[3], -448.f), 448.f)),
                                                          pk4_fp8(fminf(fmaxf(v1[0], -448.f), 448.f), fminf(fmaxf(v1[1], -448.f), 448.f), fminf(fmaxf(v1[2], -448.f), 448.f), fminf(fmaxf(v1[3], -448.f), 448.f))}; } }
    }
};
struct EpiSwiGLU8 {
    static constexpr bool PERM = true, AFTER_DRAIN = false;
    unsigned char* O; int ldc; float ascale, hs; LnFold lf;
    __device__ __forceinline__ void operator()(const f32x4 (&acc)[2][2][4][2], const Unit& u, int wr, int wc, int fr, int fq) const {
        const int row0 = u.pm * BM + wr * 64 + fr, col0 = u.pn * HALF + wc * 32 + 8 * fq, cidx = u.pn * BM + wc * 32 + 8 * fq;
        typedef unsigned u32x2 __attribute__((ext_vector_type(2)));
        f32x4 gw[2][2], bw[2][2];
#pragma unroll
        for (int bj = 0; bj < 2; ++bj)
#pragma unroll
            for (int n = 0; n < 2; ++n) { gw[bj][n] = (f32x4){0.f, 0.f, 0.f, 0.f}; bw[bj][n] = (f32x4){0.f, 0.f, 0.f, 0.f}; if (lf.stats) { gw[bj][n] = lf.vec4(lf.gW, cidx + bj * HALF + 4 * n); bw[bj][n] = lf.vec4(lf.bW, cidx + bj * HALF + 4 * n); } }
        float mean8[8], rstd8[8];
#pragma unroll
        for (int q = 0; q < 8; ++q) { mean8[q] = 0.f; rstd8[q] = 1.f; }
        if (lf.stats) lf.rows8(row0, mean8, rstd8);
#pragma unroll
        for (int ai = 0; ai < 2; ++ai)
#pragma unroll
            for (int m = 0; m < 4; ++m) { unsigned char* rowp = O + (size_t)(row0 + ai * HALF + m * 16) * ldc + col0;
                float h[8]; const float mean = mean8[ai * 4 + m], rstd = rstd8[ai * 4 + m];
#pragma unroll
                for (int n = 0; n < 2; ++n)
#pragma unroll
                    for (int j = 0; j < 4; ++j) { const float g = (acc[ai][0][m][n][j] * ascale - gw[0][n][j] * mean) * rstd + bw[0][n][j], up = (acc[ai][1][m][n][j] * ascale - gw[1][n][j] * mean) * rstd + bw[1][n][j];
                        h[4 * n + j] = fminf(fmaxf(g * sigmoidf_fast(g) * up * hs, -448.f), 448.f); }
                *(u32x2*)rowp = (u32x2){pk4_fp8(h[0], h[1], h[2], h[3]), pk4_fp8(h[4], h[5], h[6], h[7])}; }
    }
};
struct EpiGateMerge {
    static constexpr bool PERM = true, AFTER_DRAIN = false;
    const bf16_t* ta; const bf16_t* tb; bf16_t* O; int ldc; const float* b0; const float* b1;
    __device__ __forceinline__ void operator()(const f32x4 (&acc)[2][2][4][2], const Unit& u, int wr, int wc, int fr, int fq) const {
        const int row0 = u.pm * BM + wr * 64 + fr, col0 = u.pn * HALF + wc * 32 + 8 * fq;
        float bb0[8], bb1[8];
#pragma unroll
        for (int j = 0; j < 8; ++j) { bb0[j] = b0[col0 + j]; bb1[j] = b1[col0 + j]; }
#pragma unroll
        for (int ai = 0; ai < 2; ++ai)
#pragma unroll
            for (int m = 0; m < 4; ++m) { const size_t off = (size_t)(row0 + ai * HALF + m * 16) * ldc + col0;
                const u32x4 a = *(const u32x4*)(ta + off), b = *(const u32x4*)(tb + off);
                const float av[8] = {bflo(a.x), bfhi(a.x), bflo(a.y), bfhi(a.y), bflo(a.z), bfhi(a.z), bflo(a.w), bfhi(a.w)};
                const float bv[8] = {bflo(b.x), bfhi(b.x), bflo(b.y), bfhi(b.y), bflo(b.z), bfhi(b.z), bflo(b.w), bfhi(b.w)};
                float h[8];
#pragma unroll
                for (int n = 0; n < 2; ++n)
#pragma unroll
                    for (int j = 0; j < 4; ++j) { const int e = 4 * n + j; h[e] = sigmoidf_fast(acc[ai][0][m][n][j] + bb0[e]) * av[e] + sigmoidf_fast(acc[ai][1][m][n][j] + bb1[e]) * bv[e]; }
                u32x4 w; w.x = cvt_pk_bf16(h[0], h[1]); w.y = cvt_pk_bf16(h[2], h[3]); w.z = cvt_pk_bf16(h[4], h[5]); w.w = cvt_pk_bf16(h[6], h[7]);
                *(u32x4*)(O + off) = w; }
    }
};
struct EpiGateMerge8 {
    static constexpr bool PERM = true, AFTER_DRAIN = false;
    const bf16_t* ta; const bf16_t* tb; unsigned char* O; int ldc; const float* b0; const float* b1; float ascale, ms; LnFold lf;
    __device__ __forceinline__ void operator()(const f32x4 (&acc)[2][2][4][2], const Unit& u, int wr, int wc, int fr, int fq) const {
        const int row0 = u.pm * BM + wr * 64 + fr, col0 = u.pn * HALF + wc * 32 + 8 * fq, cidx = u.pn * BM + wc * 32 + 8 * fq;
        typedef unsigned u32x2 __attribute__((ext_vector_type(2)));
        float mean8[8], rstd8[8]; lf.rows8(row0, mean8, rstd8);
        float bb0[8], bb1[8], gw0[8], gw1[8];
#pragma unroll
        for (int j = 0; j < 8; ++j) { bb0[j] = b0[col0 + j] + lf.bW[cidx + j]; bb1[j] = b1[col0 + j] + lf.bW[cidx + HALF + j]; gw0[j] = lf.gW[cidx + j]; gw1[j] = lf.gW[cidx + HALF + j]; }
#pragma unroll
        for (int am = 0; am < 8; am += 2) {
            u32x4 pa[2], pb[2];
#pragma unroll
            for (int e2 = 0; e2 < 2; ++e2) { const size_t off = (size_t)(row0 + ((am + e2) >> 2) * HALF + ((am + e2) & 3) * 16) * ldc + col0; pa[e2] = *(const u32x4*)(ta + off); pb[e2] = *(const u32x4*)(tb + off); }
#pragma unroll
            for (int e2 = 0; e2 < 2; ++e2) { const int ai = (am + e2) >> 2, m = (am + e2) & 3; const size_t off = (size_t)(row0 + ai * HALF + m * 16) * ldc + col0;
                const u32x4 a = pa[e2], b = pb[e2];
                const float av[8] = {bflo(a.x), bfhi(a.x), bflo(a.y), bfhi(a.y), bflo(a.z), bfhi(a.z), bflo(a.w), bfhi(a.w)};
                const float bv[8] = {bflo(b.x), bfhi(b.x), bflo(b.y), bfhi(b.y), bflo(b.z), bfhi(b.z), bflo(b.w), bfhi(b.w)};
                float h[8]; const float mean = mean8[ai * 4 + m], rstd = rstd8[ai * 4 + m];
#pragma unroll
                for (int n = 0; n < 2; ++n)
#pragma unroll
                    for (int j = 0; j < 4; ++j) { const int e = 4 * n + j; const float v = sigmoidf_fast((acc[ai][0][m][n][j] * ascale - gw0[e] * mean) * rstd + bb0[e]) * av[e] + sigmoidf_fast((acc[ai][1][m][n][j] * ascale - gw1[e] * mean) * rstd + bb1[e]) * bv[e];
                        h[e] = fminf(fmaxf(v * ms, -448.f), 448.f); }
                *(u32x2*)(O + off) = (u32x2){pk4_fp8(h[0], h[1], h[2], h[3]), pk4_fp8(h[4], h[5], h[6], h[7])}; }
            asm volatile("" ::: "memory"); }
    }
};
template <bool RES32, int NB = 2> struct EpiRes {
    static constexpr bool PERM = true, AFTER_DRAIN = false;
    const float* res32; const bf16_t* res16; int ldc; float alpha, s;
    const long long* rstats; const float* rg; const float* rb; long long* ostats; bf16_t* o16; unsigned char* o8; float o8s;
    __device__ __forceinline__ void operator()(const f32x4 (&acc)[2][2][4][2], const Unit& u, int wr, int wc, int fr, int fq) const {
        const int col0 = u.pn * BM + wc * 32 + 8 * fq;
        typedef unsigned u32x2 __attribute__((ext_vector_type(2)));
        float al = alpha, sa = s; asm volatile("" : "+v"(al), "+v"(sa));
        const int rowb = u.pm * BM + wr * 64 + fr;
        float mean8[8], rstd8[8];
#pragma unroll
        for (int q = 0; q < 8; ++q) { mean8[q] = 0.f; rstd8[q] = 1.f; }
        if (rstats) { LnFold lf{rstats, nullptr, nullptr}; lf.rows8(rowb, mean8, rstd8); }
        asm volatile("" : "+v"(mean8[0]), "+v"(mean8[1]), "+v"(mean8[2]), "+v"(mean8[3]), "+v"(mean8[4]), "+v"(mean8[5]), "+v"(mean8[6]), "+v"(mean8[7]), "+v"(rstd8[0]), "+v"(rstd8[1]), "+v"(rstd8[2]), "+v"(rstd8[3]), "+v"(rstd8[4]), "+v"(rstd8[5]), "+v"(rstd8[6]), "+v"(rstd8[7]) :: "memory");
        f32x4 gv[2][2], bv[2][2];
#pragma unroll
        for (int bj = 0; bj < 2; ++bj)
#pragma unroll
            for (int n = 0; n < 2; ++n) { gv[bj][n] = (f32x4){1.f, 1.f, 1.f, 1.f}; bv[bj][n] = (f32x4){0.f, 0.f, 0.f, 0.f};
                if (rstats) { gv[bj][n] = *(const f32x4*)(rg + col0 + bj * HALF + 4 * n); bv[bj][n] = *(const f32x4*)(rb + col0 + bj * HALF + 4 * n); }
                gv[bj][n] = gv[bj][n] * al; bv[bj][n] = bv[bj][n] * al; }
#pragma unroll
        for (int am = 0; am < 8; am += NB) {
            f32x4 rr[RES32 ? NB : 1][2][2]; u32x4 rw[NB][2];
#pragma unroll
            for (int e2 = 0; e2 < NB; ++e2) { const size_t off = (size_t)(rowb + ((am + e2) >> 2) * HALF + ((am + e2) & 3) * 16) * ldc + col0;
#pragma unroll
                for (int bj = 0; bj < 2; ++bj) {
                    if constexpr (RES32) { rr[e2][bj][0] = *(const f32x4*)(res32 + off + bj * HALF); rr[e2][bj][1] = *(const f32x4*)(res32 + off + bj * HALF + 4); }
                    else rw[e2][bj] = *(const u32x4*)(res16 + off + bj * HALF); } }
#pragma unroll
            for (int e2 = 0; e2 < NB; ++e2) { const int ai = (am + e2) >> 2, m = (am + e2) & 3; const int row = rowb + ai * HALF + m * 16; const size_t off = (size_t)row * ldc + col0;
                const float mean = mean8[am + e2], rstd = rstd8[am + e2];
                float ps = 0.f, pq = 0.f;
#pragma unroll
                for (int bj = 0; bj < 2; ++bj) {
                    f32x4 r0, r1;
                    if constexpr (RES32) { r0 = rr[e2][bj][0]; r1 = rr[e2][bj][1]; } else { const u32x4 w = rw[e2][bj]; r0 = (f32x4){bflo(w.x), bfhi(w.x), bflo(w.y), bfhi(w.y)}; r1 = (f32x4){bflo(w.z), bfhi(w.z), bflo(w.w), bfhi(w.w)}; }
                    const f32x4 z0 = (r0 - mean) * rstd * gv[bj][0] + bv[bj][0] + acc[ai][bj][m][0] * sa, z1 = (r1 - mean) * rstd * gv[bj][1] + bv[bj][1] + acc[ai][bj][m][1] * sa;
                    u32x4 w16; w16.x = cvt_pk_bf16(z0[0], z0[1]); w16.y = cvt_pk_bf16(z0[2], z0[3]); w16.z = cvt_pk_bf16(z1[0], z1[1]); w16.w = cvt_pk_bf16(z1[2], z1[3]);
                    *(u32x4*)(o16 + off + bj * HALF) = w16;
                    const float q0 = bflo(w16.x), q1 = bfhi(w16.x), q2 = bflo(w16.y), q3 = bfhi(w16.y), q4 = bflo(w16.z), q5 = bfhi(w16.z), q6 = bflo(w16.w), q7 = bfhi(w16.w);
                    ps += ((q0 + q1) + (q2 + q3)) + ((q4 + q5) + (q6 + q7)); pq += ((q0 * q0 + q1 * q1) + (q2 * q2 + q3 * q3)) + ((q4 * q4 + q5 * q5) + (q6 * q6 + q7 * q7));
                    if (o8) *(u32x2*)(o8 + off + bj * HALF) = (u32x2){pk4_fp8(fminf(fmaxf(q0 * o8s, -448.f), 448.f), fminf(fmaxf(q1 * o8s, -448.f), 448.f), fminf(fmaxf(q2 * o8s, -448.f), 448.f), fminf(fmaxf(q3 * o8s, -448.f), 448.f)),
                                                                      pk4_fp8(fminf(fmaxf(q4 * o8s, -448.f), 448.f), fminf(fmaxf(q5 * o8s, -448.f), 448.f), fminf(fmaxf(q6 * o8s, -448.f), 448.f), fminf(fmaxf(q7 * o8s, -448.f), 448.f))}; }
                if (ostats) { ps += __shfl_xor(ps, 16); ps += __shfl_xor(ps, 32); pq += __shfl_xor(pq, 16); pq += __shfl_xor(pq, 32);
                    if (fq == 0) { (void)__hip_atomic_fetch_add(ostats + 2 * (size_t)row, (long long)__builtin_rintf(ps * 1048576.f), __ATOMIC_RELAXED, __HIP_MEMORY_SCOPE_AGENT); (void)__hip_atomic_fetch_add(ostats + 2 * (size_t)row + 1, (long long)__builtin_rintf(pq * 65536.f), __ATOMIC_RELAXED, __HIP_MEMORY_SCOPE_AGENT); } } }
            asm volatile("" ::: "memory"); }
    }
};

typedef int v8i_t __attribute__((ext_vector_type(8)));
typedef int v4i_t __attribute__((ext_vector_type(4)));
template <class Epi, class Sched, bool ALIGN_EPI, bool FP8 = false>
__device__ __forceinline__ void gemm_phase(PG8_LAS unsigned char* lds, const Gemm g, const Sched& S, const Epi& E, const int wid) {
    const int lane = lane_fresh(), tid = wid * 64 + lane, wr = wid >> 2, wc = wid & 3, fr = lane & 15, fq = lane >> 4;
    const int K = g.K, nt = K / BK;
    unsigned voffA[2], voffB[2];
#pragma unroll
    for (int i = 0; i < 2; ++i) { int R, C; stage_rc(tid * 16 + i * 8192, R, C); const int Rb = Epi::PERM ? ((R & ~31) + perm32(R & 31)) : R;
        voffA[i] = (unsigned)(R * g.lda + C) * 2u; voffB[i] = (unsigned)(Rb * g.ldb + C) * 2u; }
    const size_t kstep = (size_t)(BK * 2);
    const size_t hstepA = (size_t)HALF * g.lda * 2, hstepB = (size_t)HALF * g.ldb * 2;
    const size_t tstepA = 2 * hstepA, tstepB = 2 * hstepB;
    const unsigned ldsw = (unsigned)wid * 1024u;
    int aoff = lds_byte(wr * 64 + fr, fq * 8), boff = lds_byte(wc * 32 + fr, fq * 8);
    asm volatile("" : "+v"(voffA[0]), "+v"(voffA[1]), "+v"(voffB[0]), "+v"(voffB[1]), "+v"(aoff), "+v"(boff));
#define PG8_UA(u) ((const char*)g.A + (size_t)(u).pm * tstepA + (size_t)(((u).pn >> g.a_shift) * g.a_mul) * 2)
#define PG8_UB(u) ((const char*)g.Bt + (size_t)(g.b_wrap ? ((u).pn & (g.b_wrap - 1)) : (u).pn) * tstepB + (size_t)(((u).pn >> g.a_shift) * g.b_kmul) * 2)
#define PG8_SA(b, h) (((b) * 2 + (h)) * HTB)
#define PG8_SB(b, h) ((4 + (b) * 2 + (h)) * HTB)
#define PG8_STAGE(bufoff, gbase, voff) do { _Pragma("unroll") for (int _i = 0; _i < 2; ++_i) \
        __builtin_amdgcn_global_load_lds((const unsigned*)((const char*)(gbase) + (voff)[_i]), (PG8_LAS unsigned*)(lds + (bufoff) + ldsw + _i * 8192), 16, 0, 0); } while (0)
#define PG8_LD8(p_) __builtin_shufflevector(*(const PG8_LAS v4i_t*)(p_), *(const PG8_LAS v4i_t*)((p_) + 1024), 0, 1, 2, 3, 4, 5, 6, 7)
#define PG8_LDA(dst, b, h) do { _Pragma("unroll") for (int m = 0; m < 4; ++m) { if constexpr (FP8) dst##8[m] = PG8_LD8(lds + PG8_SA(b, h) + aoff + m * 2048); else { _Pragma("unroll") for (int k = 0; k < 2; ++k) dst[m][k] = *(const PG8_LAS bf16x8*)(lds + PG8_SA(b, h) + aoff + m * 2048 + k * 1024); } } } while (0)
#define PG8_LDB(dst, b, h) do { _Pragma("unroll") for (int n = 0; n < 2; ++n) { if constexpr (FP8) dst##8[n] = PG8_LD8(lds + PG8_SB(b, h) + boff + n * 2048); else { _Pragma("unroll") for (int k = 0; k < 2; ++k) dst[n][k] = *(const PG8_LAS bf16x8*)(lds + PG8_SB(b, h) + boff + n * 2048 + k * 1024); } } } while (0)
#define PG8_MMA(ai, bj, At, Bt) do { __builtin_amdgcn_s_setprio(1); _Pragma("unroll") for (int m = 0; m < 4; ++m) _Pragma("unroll") for (int n = 0; n < 2; ++n) { \
        if constexpr (FP8) asm volatile("v_mfma_scale_f32_16x16x128_f8f6f4 %0, %1, %2, %0, %3, %3 op_sel_hi:[0,0,0]" : "+v"(acc[ai][bj][m][n]) : "v"(Bt##8[n]), "v"(At##8[m]), "v"(one_scale)); \
        else { _Pragma("unroll") for (int k = 0; k < 2; ++k) acc[ai][bj][m][n] = __builtin_amdgcn_mfma_f32_16x16x32_bf16(Bt[n][k], At[m][k], acc[ai][bj][m][n], 0, 0, 0); } } \
        __builtin_amdgcn_s_setprio(0); } while (0)
#define PG8_WAIT_V(n) asm volatile("s_waitcnt vmcnt(" #n ")" ::: "memory")
#define PG8_WAIT_L(n) asm volatile("s_waitcnt lgkmcnt(" #n ")" ::: "memory")
#define PG8_BAR __builtin_amdgcn_s_barrier()
#define PG8_SCHED __builtin_amdgcn_sched_barrier(0)
    Unit cur, nxt; int ui = 0;
    if (!S.next(0, cur)) return;
    f32x4 acc[2][2][4][2];
#pragma unroll
    for (int a = 0; a < 2; ++a)
#pragma unroll
        for (int b = 0; b < 2; ++b)
#pragma unroll
            for (int m = 0; m < 4; ++m)
#pragma unroll
                for (int n = 0; n < 2; ++n) acc[a][b][m][n] = (f32x4){0.f, 0.f, 0.f, 0.f};
    bf16x8 At[4][2], B0[2][2], B1[2][2]; v8i_t At8[4], B08[2], B18[2];
    int one_scale = 0x7f7f7f7f; asm volatile("" : "+v"(one_scale));
    const char* cA = PG8_UA(cur); const char* cB = PG8_UB(cur);
    S.a_ready(cur);
    PG8_STAGE(PG8_SB(0, 0), cB, voffB); PG8_STAGE(PG8_SB(0, 1), cB + hstepB, voffB); PG8_STAGE(PG8_SA(0, 0), cA, voffA); PG8_STAGE(PG8_SA(0, 1), cA + hstepA, voffA);
    if (wr == 1) PG8_BAR;
    PG8_WAIT_V(2); PG8_BAR;
    PG8_STAGE(PG8_SB(1, 0), cB + kstep, voffB); PG8_STAGE(PG8_SA(1, 0), cA + kstep, voffA); PG8_STAGE(PG8_SB(1, 1), cB + hstepB + kstep, voffB);
    PG8_WAIT_V(6); PG8_BAR;
    for (;;) {
        const bool has_next = S.next(ui + 1, nxt);
        const char* nA = has_next ? PG8_UA(nxt) : cA; const char* nB = has_next ? PG8_UB(nxt) : cB;
        for (int t = 0; t < nt; t += 2) {
            const bool last = (t == nt - 2);
            const char* a1 = cA + (size_t)(t + 1) * kstep;
            const char* a2 = last ? nA : cA + (size_t)(t + 2) * kstep; const char* b2 = last ? nB : cB + (size_t)(t + 2) * kstep;
            const char* a3 = a2 + kstep; const char* b3 = b2 + kstep;
            if (last && has_next) S.a_ready(nxt);
            PG8_LDB(B0, 0, 0); PG8_LDB(B1, 0, 1); PG8_SCHED; PG8_LDA(At, 0, 0); PG8_STAGE(PG8_SA(1, 1), a1 + hstepA, voffA);
            PG8_WAIT_V(8); PG8_WAIT_L(0); PG8_BAR; PG8_MMA(0, 0, At, B0); PG8_MMA(0, 1, At, B1); PG8_BAR; PG8_SCHED;
            PG8_LDA(At, 0, 1); PG8_STAGE(PG8_SB(0, 0), b2, voffB); PG8_STAGE(PG8_SB(0, 1), b2 + hstepB, voffB); PG8_STAGE(PG8_SA(0, 0), a2, voffA);
            PG8_WAIT_V(8); PG8_WAIT_L(0); PG8_BAR; PG8_MMA(1, 0, At, B0); PG8_MMA(1, 1, At, B1); PG8_BAR; PG8_SCHED;
            PG8_LDB(B0, 1, 0); PG8_LDB(B1, 1, 1); PG8_SCHED; PG8_LDA(At, 1, 0); PG8_STAGE(PG8_SA(0, 1), a2 + hstepA, voffA);
            PG8_WAIT_V(8); PG8_WAIT_L(0); PG8_BAR; PG8_MMA(0, 0, At, B0); PG8_MMA(0, 1, At, B1); PG8_BAR; PG8_SCHED;
            PG8_LDA(At, 1, 1); PG8_STAGE(PG8_SB(1, 0), b3, voffB); PG8_STAGE(PG8_SB(1, 1), b3 + hstepB, voffB); PG8_STAGE(PG8_SA(1, 0), a3, voffA);
            PG8_WAIT_V(8); PG8_WAIT_L(0); PG8_BAR; PG8_MMA(1, 0, At, B0); PG8_MMA(1, 1, At, B1); PG8_BAR; PG8_SCHED;
        }
        if constexpr (ALIGN_EPI) { if (wr == 0) PG8_BAR; }
        if constexpr (FP8) asm volatile("s_nop 15\n\ts_nop 7" ::: "memory");
        { const int le = lane_fresh(); E(acc, cur, wr, wc, le & 15, le >> 4); } S.done(cur);
        if (!has_next) break;
#pragma unroll
        for (int a = 0; a < 2; ++a)
#pragma unroll
            for (int b = 0; b < 2; ++b)
#pragma unroll
                for (int m = 0; m < 4; ++m)
#pragma unroll
                    for (int n = 0; n < 2; ++n) acc[a][b][m][n] = (f32x4){0.f, 0.f, 0.f, 0.f};
        cur = nxt; cA = nA; cB = nB; ++ui;
        if constexpr (ALIGN_EPI) { if (wr == 1) PG8_BAR; }
    }
    PG8_WAIT_V(0);
    if constexpr (!ALIGN_EPI) { if (wr == 0) PG8_BAR; }
    PG8_BAR;
#undef PG8_UA
#undef PG8_UB
#undef PG8_SA
#undef PG8_SB
#undef PG8_STAGE
#undef PG8_LDA
#undef PG8_LDB
#undef PG8_MMA
#undef PG8_LD8
#undef PG8_WAIT_V
#undef PG8_WAIT_L
#undef PG8_BAR
#undef PG8_SCHED
}
}

constexpr int NWAVES = 8;
constexpr int BATCH = 4, SEQ = 4096, D = 2048, FF = 5632, M = BATCH * SEQ;
constexpr int N_IN = 5888;
constexpr int MEMT = 256;
constexpr float LN_EPS = 1e-5f;
constexpr float ALPHA = 1.189207115002721f;
constexpr float LAMBDA_INIT = 0.2f;

constexpr size_t MiB = 1u << 20;
constexpr size_t WS_CTL = 0, CTL_ZERO_BYTES = 2 * MiB;
constexpr size_t WS_W_IN = 2 * MiB;
constexpr size_t WS_W_IN8 = WS_W_IN, WS_W_INB = WS_W_IN + 9 * MiB; constexpr int N_IN8 = 4608, N_INB = 1280;
constexpr size_t WS_W_G = 25 * MiB;
constexpr size_t WS_W_UK = 41 * MiB;
constexpr size_t WS_W_UVP = 42 * MiB;
constexpr size_t WS_W_A = 44 * MiB;
constexpr size_t WS_W_B = 48 * MiB;
constexpr size_t WS_W_MO = 52 * MiB;
constexpr size_t WS_W_MQ = 60 * MiB;
constexpr size_t WS_W_MKV = 62 * MiB;
constexpr size_t WS_W_MOUT = 66 * MiB;
constexpr size_t WS_MEM16 = 68 * MiB;
constexpr size_t WS_KVMEM = 72 * MiB;
constexpr size_t WS_W_GU2 = 74 * MiB;
constexpr size_t WS_W_D2 = 96 * MiB;
constexpr size_t WS_X8M = 107 * MiB;
constexpr size_t WS_X16 = 140 * MiB;
constexpr size_t WS_MIX = 204 * MiB;
constexpr size_t WS_W_GU1 = 204 * MiB;
constexpr size_t WS_W_D1 = 248 * MiB;
constexpr size_t WS_H = 270 * MiB;
constexpr size_t WS_AQ = WS_MIX + 0 * MiB, WS_AK = WS_MIX + 32 * MiB, WS_AV = WS_MIX + 64 * MiB, WS_BQ = WS_MIX + 96 * MiB;
constexpr size_t WS_BC = WS_MIX + 128 * MiB;
constexpr size_t WS_IQ = WS_MIX + 144 * MiB;
constexpr size_t WS_IKW = WS_MIX + 176 * MiB;
constexpr size_t WS_QLAT = WS_MIX + 184 * MiB;
constexpr size_t WS_IDX = WS_MIX + 312 * MiB;
constexpr size_t WS_YB = WS_BQ;
constexpr size_t WS_TA = WS_QLAT, WS_TB = WS_QLAT + 64 * MiB;
constexpr size_t WS_QM = WS_AQ, WS_OM = WS_AK;
constexpr size_t WS_X8 = WS_H + 96 * MiB;
constexpr size_t WS_YA8 = WS_W_IN;
constexpr size_t WS_C8 = WS_W_G + 8 * MiB;
constexpr size_t WS_MRG8 = WS_AV;
constexpr float FP8_OMS = 64.f, FP8_WMOUTS = 1024.f;
constexpr float FP8_WUVS = 1024.f;
constexpr float FP8_WGS = 1024.f, FP8_MS = 32.f, FP8_WMOS = 2048.f, FP8_YS = 64.f, FP8_WBS = 1024.f, FP8_YAS = 64.f, FP8_WAS = 1024.f;
constexpr float FP8_XS = 32.f, FP8_WGUS = 1024.f, FP8_HS = 8.f, FP8_WDS = 4096.f;
constexpr size_t WS_END = WS_MIX + 320 * MiB;
static_assert(WS_H + (size_t)M * FF * 2 <= WS_END && WS_QLAT + (size_t)M * 4096 * 2 <= WS_END, "d_ws map");
constexpr int CW_BAR = 4096;
constexpr int CW_DQ = 8192;
constexpr int CW_KMAX = 8256;
constexpr size_t CTL_STATS = 65536, CTL_STATS_STRIDE = (size_t)M * 2 * 8;
constexpr size_t CTL_VEC = CTL_STATS + 3 * CTL_STATS_STRIDE;
constexpr int V_GW_IN = 0, V_BW_IN = 5888, V_GW_G = 11776, V_BW_G = 15872, V_GW_MQ = 19968, V_BW_MQ = 20480, V_GW_GU2 = 20992, V_BW_GU2 = 32256, V_END = 43520;
constexpr size_t CTL_VECF = CTL_VEC + (size_t)V_END * 8;
static_assert(CTL_VECF + (size_t)V_END * 4 <= CTL_ZERO_BYTES, "control region");
constexpr float FX_S = 1048576.f, FX_Q = 65536.f, FX_V = 16777216.f;

constexpr int RING_OFF = 0, RING_BYTES = 153600;
constexpr int LDSCTL_OFF = RING_BYTES, MISC_OFF = LDSCTL_OFF + 320;
constexpr int LDS_BYTES = 154624;
static_assert(MISC_OFF + 128 <= LDS_BYTES, "LDS map");

#define GAS __attribute__((address_space(1)))
#define LAS __attribute__((address_space(3)))
typedef unsigned short bf16;
typedef unsigned v4u __attribute__((ext_vector_type(4)));
typedef unsigned v2u __attribute__((ext_vector_type(2)));
typedef float f32x4 __attribute__((ext_vector_type(4)));
typedef float f32x16 __attribute__((ext_vector_type(16)));
typedef short bf16x8 __attribute__((ext_vector_type(8)));
typedef GAS unsigned gu32;
#define RLX_AGENT __ATOMIC_RELAXED, __HIP_MEMORY_SCOPE_AGENT
#define LDS_WAIT() asm volatile("s_waitcnt lgkmcnt(0)" ::: "memory")
#define VM_WAIT() asm volatile("s_waitcnt vmcnt(0)" ::: "memory")
__device__ __forceinline__ unsigned f2bf(float f) { unsigned u = __builtin_bit_cast(unsigned, f); return (u + 0x7fffu + ((u >> 16) & 1u)) >> 16; }
__device__ __forceinline__ unsigned pk2(float lo, float hi) { return f2bf(lo) | (f2bf(hi) << 16); }
__device__ __forceinline__ float bf2f(unsigned short v) { return __uint_as_float((unsigned)v << 16); }
__device__ __forceinline__ float blo(unsigned w) { return __uint_as_float(w << 16); }
__device__ __forceinline__ float bhi(unsigned w) { return __uint_as_float(w & 0xffff0000u); }
__device__ __forceinline__ float wave_sum(float v) {
    v += __builtin_bit_cast(float, __builtin_amdgcn_update_dpp(0, __builtin_bit_cast(int, v), 0xB1, 0xf, 0xf, true));
    v += __builtin_bit_cast(float, __builtin_amdgcn_update_dpp(0, __builtin_bit_cast(int, v), 0x4E, 0xf, 0xf, true));
    v += __builtin_bit_cast(float, __builtin_amdgcn_update_dpp(0, __builtin_bit_cast(int, v), 0x141, 0xf, 0xf, true));
    v += __builtin_bit_cast(float, __builtin_amdgcn_update_dpp(0, __builtin_bit_cast(int, v), 0x140, 0xf, 0xf, true));
    { const auto rr = __builtin_amdgcn_permlane16_swap(__float_as_uint(v), __float_as_uint(v), false, false); v = __uint_as_float(rr[0]) + __uint_as_float(rr[1]); }
    { const auto rr = __builtin_amdgcn_permlane32_swap(__float_as_uint(v), __float_as_uint(v), false, false); v = __uint_as_float(rr[0]) + __uint_as_float(rr[1]); }
    return v;
}

__device__ __forceinline__ float xhalf_add(float a) { const auto rr = __builtin_amdgcn_permlane32_swap(__float_as_uint(a), __float_as_uint(a), false, false); return __uint_as_float(rr[0]) + __uint_as_float(rr[1]); }
__device__ __forceinline__ float xhalf_max(float a) { const auto rr = __builtin_amdgcn_permlane32_swap(__float_as_uint(a), __float_as_uint(a), false, false); return fmaxf(__uint_as_float(rr[0]), __uint_as_float(rr[1])); }
__device__ __forceinline__ int half_sum_i32(int v) {
    v += __builtin_amdgcn_update_dpp(0, v, 0xB1, 0xf, 0xf, true);
    v += __builtin_amdgcn_update_dpp(0, v, 0x4E, 0xf, 0xf, true);
    v += __builtin_amdgcn_update_dpp(0, v, 0x141, 0xf, 0xf, true);
    v += __builtin_amdgcn_update_dpp(0, v, 0x140, 0xf, 0xf, true);
    const auto rr = __builtin_amdgcn_permlane16_swap((unsigned)v, (unsigned)v, false, false); return (int)rr[0] + (int)rr[1];
}
#define XB_TMO      128
#define XB_XCNT(j)  (256  + 64 * (j))
#define XB_XSUB(j)  (1280 + 64 * (j))
#define XB_XGEN(j)  (2304 + 64 * (j))
#define XB_TOP      3328
#define XB_TOPGEN   3392
#define XCD_BAR_WORDS 3456
#define XB_SPIN_CAP (1u << 18)

__device__ __forceinline__ unsigned xb_ld(unsigned* p)              { return __hip_atomic_load(p, __ATOMIC_RELAXED, __HIP_MEMORY_SCOPE_AGENT); }
__device__ __forceinline__ unsigned xb_add(unsigned* p, unsigned v) { return __hip_atomic_fetch_add(p, v, __ATOMIC_RELAXED, __HIP_MEMORY_SCOPE_AGENT); }
__device__ __forceinline__ unsigned xb_add_l2(unsigned* p, unsigned v) { unsigned r; asm volatile("global_atomic_add %0, %1, %2, off sc0\n\ts_waitcnt vmcnt(0)" : "=&v"(r) : "v"(p), "v"(v) : "memory"); return r; }
__device__ __forceinline__ void xb_add_l2_nr(unsigned* p, unsigned v) { asm volatile("global_atomic_add %0, %1, off" :: "v"(p), "v"(v) : "memory"); }
__device__ __forceinline__ unsigned xb_ld_l2(unsigned* p) { return xb_add_l2(p, 0u); }
__device__ __forceinline__ unsigned xb_xcc_id() { return (unsigned)__builtin_amdgcn_s_getreg((3 << 11) | 20) & 0xFu; }
#define XB_SPIN(cond, bar) do { unsigned _sp = 0; while (cond) { __builtin_amdgcn_s_sleep(1); \
    if ((++_sp & 255u) == 0u) { if (xb_ld(&(bar)[XB_TMO])) break; if (_sp > XB_SPIN_CAP) { atomicAdd(&(bar)[XB_TMO], 1u); break; } } } } while (0)

struct XcdBarrier {
    unsigned* bar; unsigned x;
    volatile LAS unsigned* st;
};

__device__ __forceinline__ XcdBarrier xcd_barrier_post(unsigned* bar, volatile LAS unsigned* st, bool t0) {
    XcdBarrier b; b.bar = bar; b.x = xb_xcc_id(); b.st = st;
    if (t0) st[2] = xb_add(&bar[XB_XCNT(b.x)], 1u);
    return b;
}
__device__ __forceinline__ void xcd_barrier_complete(unsigned* bar, unsigned x, unsigned& nloc, unsigned& nx) {
    const unsigned G = gridDim.x * gridDim.y * gridDim.z;
    unsigned sum, cnt, mine, sp = 0u;
    for (;;) {
        sum = 0u; cnt = 0u; mine = 0u;
#pragma unroll
        for (unsigned j = 0; j < 16; ++j) { const unsigned c = xb_ld(&bar[XB_XCNT(j)]); sum += c; cnt += (c > 0u) ? 1u : 0u; mine = (j == x) ? c : mine; }
        if (sum == G) break;
        __builtin_amdgcn_s_sleep(1);
        if ((++sp & 255u) == 0u) { if (xb_ld(&bar[XB_TMO])) break; if (sp > XB_SPIN_CAP) { atomicAdd(&bar[XB_TMO], 1u); break; } }
    }
    nloc = mine > 0u ? mine : 1u; nx = cnt > 0u ? cnt : 1u;
}

__device__ __forceinline__ void xcd_barrier(const XcdBarrier& b, const int wave) {
    asm volatile("s_waitcnt vmcnt(0)" ::: "memory");
    __syncthreads();
    if (wave == 0 && lane_fresh() == 0) {
        unsigned* bar = b.bar;
        __builtin_amdgcn_s_waitcnt(0);
        unsigned nloc = b.st[0], nx = b.st[1];
        if (nloc == 0u) { xcd_barrier_complete(bar, b.x, nloc, nx); b.st[0] = nloc; b.st[1] = nx; }
        const unsigned old = xb_add_l2(&bar[XB_XSUB(b.x)], 1u);
        const unsigned gen = old / nloc;
        if (old + 1u == (gen + 1u) * nloc) {
            __builtin_amdgcn_fence(__ATOMIC_RELEASE, "agent");
            asm volatile("s_waitcnt vmcnt(0)" ::: "memory");
            const unsigned og = xb_add(&bar[XB_TOP], 1u);
            const unsigned tg = og / nx;
            if (og + 1u == (tg + 1u) * nx) xb_add(&bar[XB_TOPGEN], 1u);
            else XB_SPIN(xb_ld(&bar[XB_TOPGEN]) == tg, bar);
            __builtin_amdgcn_fence(__ATOMIC_ACQUIRE, "agent");
            xb_add_l2_nr(&bar[XB_XGEN(b.x)], 1u);
            asm volatile("s_waitcnt vmcnt(0)" ::: "memory");
        } else {
            XB_SPIN(xb_ld_l2(&bar[XB_XGEN(b.x)]) == gen, bar);
            __builtin_amdgcn_fence(__ATOMIC_ACQUIRE, "agent");
            asm volatile("s_waitcnt vmcnt(0)" ::: "memory");
        }
    }
    __syncthreads();
}

__device__ __forceinline__ void tr_load(const float* W, int ldw, int nvalid, int k0, int n0, const float* G, const float* B, int lane, f32x4 (&pv)[8], f32x4& gbv, int& okf) {
    gbv = *(const GAS f32x4*)((lane < 16 ? G + 4 * lane : (lane < 32 ? B + 4 * (lane - 16) : G)) + k0);
    const int n4 = 4 * (lane & 7), kr = lane >> 3; const bool ok = n0 + n4 < nvalid;
    const float* base = W + (size_t)(k0 + kr) * ldw + (ok ? n0 + n4 : 0);
#pragma unroll
    for (int i = 0; i < 8; ++i) pv[i] = __builtin_nontemporal_load((const GAS f32x4*)(base + (size_t)(8 * i) * ldw));
    okf = ok ? 1 : 0;
}
__device__ __forceinline__ void tr_stage(LAS float* scr, int lane, const f32x4 (&pv)[8], const f32x4& gbv, const int okf) {
    const int n4 = 4 * (lane & 7), kr = lane >> 3; const float m = okf ? 1.f : 0.f;
#pragma unroll
    for (int i = 0; i < 8; ++i) { const int kk = 8 * i + kr; const f32x4 v = pv[i]; LAS float* d = scr + kk * 33 + n4; d[0] = okf ? v.x : 0.f; d[1] = okf ? v.y : 0.f; d[2] = okf ? v.z : 0.f; d[3] = okf ? v.w : 0.f; }
    (void)m;
    if (lane < 32) *(LAS f32x4*)(scr + 64 * 33 + 4 * lane) = gbv;
    LDS_WAIT(); asm volatile("" ::: "memory");
}
__device__ __forceinline__ void tr_item(const float* W, int ldw, int nvalid, bf16* WT, int ldt, int k0, int n0, int drow0, int dcol0, LAS float* scr, int lane) {
    const int c = lane & 7;
#pragma unroll
    for (int j = 0; j < 4; ++j) { const int nn = (lane >> 3) + 8 * j; const LAS float* s = scr + (8 * c) * 33 + nn;
        v4u o; o.x = pk2(s[0 * 33], s[1 * 33]); o.y = pk2(s[2 * 33], s[3 * 33]); o.z = pk2(s[4 * 33], s[5 * 33]); o.w = pk2(s[6 * 33], s[7 * 33]);
        *(GAS v4u*)(WT + (size_t)(drow0 + nn) * ldt + dcol0 + k0 + 8 * c) = o; }
    LDS_WAIT(); asm volatile("" ::: "memory");
}
__device__ __forceinline__ void tr_item8(const float* W, int ldw, unsigned char* WT, int ldt, int k0, int n0, int drow0, float sc, LAS float* scr, int lane, int dcol0 = 0) {
    const int nn = lane >> 1, hf = lane & 1; const LAS float* sp = scr + (32 * hf) * 33 + nn;
    unsigned o[8];
#pragma unroll
    for (int q = 0; q < 8; ++q) { const float a = fminf(fmaxf(sp[(4 * q + 0) * 33] * sc, -448.f), 448.f), b = fminf(fmaxf(sp[(4 * q + 1) * 33] * sc, -448.f), 448.f), c = fminf(fmaxf(sp[(4 * q + 2) * 33] * sc, -448.f), 448.f), d = fminf(fmaxf(sp[(4 * q + 3) * 33] * sc, -448.f), 448.f);
        int w = 0; w = __builtin_amdgcn_cvt_pk_fp8_f32(a, b, w, false); w = __builtin_amdgcn_cvt_pk_fp8_f32(c, d, w, true); o[q] = (unsigned)w; }
    GAS v4u* dst = (GAS v4u*)(WT + (size_t)(drow0 + nn) * ldt + dcol0 + k0 + 32 * hf);
    dst[0] = (v4u){o[0], o[1], o[2], o[3]}; dst[1] = (v4u){o[4], o[5], o[6], o[7]};
    LDS_WAIT(); asm volatile("" ::: "memory");
}
__device__ __forceinline__ void tr_item_ln(const float* W, int ldw, int nvalid, bf16* WT, int ldt, int k0, int n0, int drow0, const float* gain, const float* bvec, long long* gW, long long* bW, LAS float* scr, int lane) {
    const int c = lane & 7;
    const LAS float* sgb = scr + 64 * 33;
    const f32x4 g0 = *(const LAS f32x4*)(sgb + 8 * c), g1 = *(const LAS f32x4*)(sgb + 8 * c + 4), b0 = *(const LAS f32x4*)(sgb + 64 + 8 * c), b1 = *(const LAS f32x4*)(sgb + 64 + 8 * c + 4);
    const float gk[8] = {g0.x, g0.y, g0.z, g0.w, g1.x, g1.y, g1.z, g1.w}, bk[8] = {b0.x, b0.y, b0.z, b0.w, b1.x, b1.y, b1.z, b1.w};
#pragma unroll
    for (int j = 0; j < 4; ++j) { const int nn = (lane >> 3) + 8 * j; const LAS float* sp = scr + (8 * c) * 33 + nn;
        float v[8], bs = 0.f;
#pragma unroll
        for (int i = 0; i < 8; ++i) { const float raw = sp[i * 33]; v[i] = raw * gk[i]; bs += raw * bk[i]; }
        v4u o; o.x = pk2(v[0], v[1]); o.y = pk2(v[2], v[3]); o.z = pk2(v[4], v[5]); o.w = pk2(v[6], v[7]);
        float gs = ((blo(o.x) + bhi(o.x)) + (blo(o.y) + bhi(o.y))) + ((blo(o.z) + bhi(o.z)) + (blo(o.w) + bhi(o.w)));
        *(GAS v4u*)(WT + (size_t)(drow0 + nn) * ldt + k0 + 8 * c) = o;
        gs += __shfl_xor(gs, 1); gs += __shfl_xor(gs, 2); gs += __shfl_xor(gs, 4); bs += __shfl_xor(bs, 1); bs += __shfl_xor(bs, 2); bs += __shfl_xor(bs, 4);
        if (c == 0) { (void)__hip_atomic_fetch_add(gW + drow0 + nn, (long long)__builtin_rintf(gs * FX_V), __ATOMIC_RELAXED, __HIP_MEMORY_SCOPE_AGENT); (void)__hip_atomic_fetch_add(bW + drow0 + nn, (long long)__builtin_rintf(bs * FX_V), __ATOMIC_RELAXED, __HIP_MEMORY_SCOPE_AGENT); } }
    LDS_WAIT(); asm volatile("" ::: "memory");
}
__device__ __forceinline__ void tr_item8_ln(const float* W, int ldw, unsigned char* WT, int ldt, int k0, int n0, int drow0, float sc, const float* gain, const float* bvec, long long* gW, long long* bW, LAS float* scr, int lane) {
    const int nn = lane >> 1, hf = lane & 1; const LAS float* sp = scr + (32 * hf) * 33 + nn;
    unsigned o[8]; float gs = 0.f, bs = 0.f;
#pragma unroll
    for (int q = 0; q < 8; ++q) { const f32x4 g4 = *(const LAS f32x4*)(scr + 64 * 33 + 32 * hf + 4 * q), b4 = *(const LAS f32x4*)(scr + 64 * 33 + 64 + 32 * hf + 4 * q);
        const float r0 = sp[(4 * q + 0) * 33], r1 = sp[(4 * q + 1) * 33], r2 = sp[(4 * q + 2) * 33], r3 = sp[(4 * q + 3) * 33];
        bs += (r0 * b4.x + r1 * b4.y) + (r2 * b4.z + r3 * b4.w);
        const float a = fminf(fmaxf(r0 * g4.x * sc, -448.f), 448.f), b = fminf(fmaxf(r1 * g4.y * sc, -448.f), 448.f), c = fminf(fmaxf(r2 * g4.z * sc, -448.f), 448.f), d = fminf(fmaxf(r3 * g4.w * sc, -448.f), 448.f);
        int w = 0; w = __builtin_amdgcn_cvt_pk_fp8_f32(a, b, w, false); w = __builtin_amdgcn_cvt_pk_fp8_f32(c, d, w, true); o[q] = (unsigned)w;
        gs += (__builtin_amdgcn_cvt_f32_fp8(w, 0) + __builtin_amdgcn_cvt_f32_fp8(w, 1)) + (__builtin_amdgcn_cvt_f32_fp8(w, 2) + __builtin_amdgcn_cvt_f32_fp8(w, 3)); }
    GAS v4u* dst = (GAS v4u*)(WT + (size_t)(drow0 + nn) * ldt + k0 + 32 * hf);
    dst[0] = (v4u){o[0], o[1], o[2], o[3]}; dst[1] = (v4u){o[4], o[5], o[6], o[7]};
    gs += __shfl_xor(gs, 1); bs += __shfl_xor(bs, 1);
    if (hf == 0) { (void)__hip_atomic_fetch_add(gW + drow0 + nn, (long long)__builtin_rintf(gs / sc * FX_V), __ATOMIC_RELAXED, __HIP_MEMORY_SCOPE_AGENT); (void)__hip_atomic_fetch_add(bW + drow0 + nn, (long long)__builtin_rintf(bs * FX_V), __ATOMIC_RELAXED, __HIP_MEMORY_SCOPE_AGENT); }
    LDS_WAIT(); asm volatile("" ::: "memory");
}
__device__ __forceinline__ void cvt_item8(const float* src, unsigned char* dst, int item, int lane, float sc) {
    const GAS f32x4* sp = (const GAS f32x4*)(src + (size_t)item * 512) + 2 * lane; f32x4 a = sp[0] * sc, b = sp[1] * sc;
    int w0 = 0, w1 = 0; w0 = __builtin_amdgcn_cvt_pk_fp8_f32(fminf(fmaxf(a.x, -448.f), 448.f), fminf(fmaxf(a.y, -448.f), 448.f), w0, false); w0 = __builtin_amdgcn_cvt_pk_fp8_f32(fminf(fmaxf(a.z, -448.f), 448.f), fminf(fmaxf(a.w, -448.f), 448.f), w0, true);
    w1 = __builtin_amdgcn_cvt_pk_fp8_f32(fminf(fmaxf(b.x, -448.f), 448.f), fminf(fmaxf(b.y, -448.f), 448.f), w1, false); w1 = __builtin_amdgcn_cvt_pk_fp8_f32(fminf(fmaxf(b.z, -448.f), 448.f), fminf(fmaxf(b.w, -448.f), 448.f), w1, true);
    *((GAS v2u*)(dst + (size_t)item * 512) + lane) = (v2u){(unsigned)w0, (unsigned)w1};
}
__device__ __forceinline__ void cvt_item(const float* src, bf16* dst, int item, int lane) {
    const GAS f32x4* s = (const GAS f32x4*)(src + (size_t)item * 512) + 2 * lane; const f32x4 a = s[0], b = s[1];
    v4u o; o.x = pk2(a.x, a.y); o.y = pk2(a.z, a.w); o.z = pk2(b.x, b.y); o.w = pk2(b.z, b.w);
    *((GAS v4u*)(dst + (size_t)item * 512) + lane) = o;
}
__device__ __forceinline__ void p0_prologue(const float* const (&in)[24], unsigned char* ws, LAS unsigned char* lds, int gw, int NGW, int wave, int lane) {
    LAS float* scr = (LAS float*)(lds + RING_OFF + wave * 16384);
    long long* const vec = (long long*)(ws + WS_CTL + CTL_VEC);
#define P0_LIST(E16, E8, EL16, EL8, EUV) \
        E8(in[2], 2048, 5632, 5632, WS_W_GU1, 2048, 256 * (n0 >> 7) + (n0 & 127), FP8_WGUS)             \
        E8(in[3], 2048, 5632, 5632, WS_W_GU1, 2048, 256 * (n0 >> 7) + 128 + (n0 & 127), FP8_WGUS)       \
        E8(in[4], 5632, 2048, 2048, WS_W_D1, 5632, n0, FP8_WDS)                                        \
        EL8(in[5], 2048, 5712, 4608, WS_W_IN8, 2048, n0, FP8_WGS, in[22], in[23], V_GW_IN, V_BW_IN)     \
        EL16(in[5] + 4608, 2048, 5712, 1104, 1280, WS_W_INB, 2048, n0, in[22], in[23], V_GW_IN + 4608, V_BW_IN + 4608)     \
        EL8(in[11], 2048, 2048, 2048, WS_W_G, 2048, 256 * (n0 >> 7) + (n0 & 127), FP8_WGS, in[22], in[23], V_GW_G, V_BW_G)               \
        EL8(in[11] + (size_t)2048 * 2048, 2048, 2048, 2048, WS_W_G, 2048, 256 * (n0 >> 7) + 128 + (n0 & 127), FP8_WGS, in[22], in[23], V_GW_G, V_BW_G)     \
        EUV \
        E8(in[13], 1024, 2048, 2048, WS_W_A, 1024, n0, FP8_WAS)                                         \
        E8(in[14], 1024, 2048, 2048, WS_W_B, 1024, n0, FP8_WBS)                                         \
        E8(in[15], 2048, 2048, 2048, WS_W_MO, 2048, n0, FP8_WMOS) \
        EL16(in[16], 2048, 512, 512, 512, WS_W_MQ, 2048, n0, in[22] + D, in[23] + D, V_GW_MQ, V_BW_MQ)                     \
        E16(in[17], 2048, 1024, 1024, 1024, WS_W_MKV, 2048, n0, 0) \
        E8(in[18], 512, 2048, 2048, WS_W_MOUT, 512, n0, FP8_WMOUTS)                                     \
        EL8(in[19], 2048, 5632, 5632, WS_W_GU2, 2048, 256 * (n0 >> 7) + (n0 & 127), FP8_WGUS, in[22] + 2 * D, in[23] + 2 * D, V_GW_GU2, V_BW_GU2)            \
        EL8(in[20], 2048, 5632, 5632, WS_W_GU2, 2048, 256 * (n0 >> 7) + 128 + (n0 & 127), FP8_WGUS, in[22] + 2 * D, in[23] + 2 * D, V_GW_GU2, V_BW_GU2)      \
        E8(in[21], 5632, 2048, 2048, WS_W_D2, 5632, n0, FP8_WDS)
#define TRM(SRC, Kk, LDW, NVALID, NPAD, DST, LDT, ROWMAP, DCOL) { constexpr int nblk = (NPAD) / 32; constexpr int cnt = ((Kk) / 64) * nblk; \
        if (r < cnt) { const int kb = r / nblk, nb = r % nblk, n0 = 32 * nb; tr_item(SRC, LDW, NVALID, (bf16*)(ws + (DST)), LDT, 64 * kb, n0, (ROWMAP), (DCOL), scr, lane); break; } r -= cnt; }
#define TRM8(SRC, Kk, LDW, NN, DST, LDT, ROWMAP, SC) { constexpr int nblk = (NN) / 32; constexpr int cnt = ((Kk) / 64) * nblk; \
        if (r < cnt) { const int kb = r / nblk, nb = r % nblk, n0 = 32 * nb; tr_item8(SRC, LDW, (unsigned char*)(ws + (DST)), LDT, 64 * kb, n0, (ROWMAP), SC, scr, lane); break; } r -= cnt; }
#define TRML(SRC, Kk, LDW, NVALID, NPAD, DST, LDT, ROWMAP, GAIN, BVEC, VG, VB) { constexpr int nblk = (NPAD) / 32; constexpr int cnt = ((Kk) / 64) * nblk; \
        if (r < cnt) { const int kb = r / nblk, nb = r % nblk, n0 = 32 * nb; tr_item_ln(SRC, LDW, NVALID, (bf16*)(ws + (DST)), LDT, 64 * kb, n0, (ROWMAP), GAIN, BVEC, vec + (VG), vec + (VB), scr, lane); break; } r -= cnt; }
#define TRML8(SRC, Kk, LDW, NN, DST, LDT, ROWMAP, SC, GAIN, BVEC, VG, VB) { constexpr int nblk = (NN) / 32; constexpr int cnt = ((Kk) / 64) * nblk; \
        if (r < cnt) { const int kb = r / nblk, nb = r % nblk, n0 = 32 * nb; tr_item8_ln(SRC, LDW, (unsigned char*)(ws + (DST)), LDT, 64 * kb, n0, (ROWMAP), SC, GAIN, BVEC, vec + (VG), vec + (VB), scr, lane); break; } r -= cnt; }
#define TRUV { if (r < 256) { const int h = r >> 5, rr = r & 31, kb = rr >> 2, nb = rr & 3;                     \
            tr_item8(in[10] + (size_t)h * 512 * 128, 128, (unsigned char*)(ws + WS_W_UVP), 1024, 64 * kb, 32 * nb, (h >> 1) * 256 + (h & 1) * 128 + 32 * nb, FP8_WUVS, scr, lane, (h & 1) * 512); break; } r -= 256; }
#define LDM(SRC, Kk, LDW, NVALID, NPAD, DST, LDT, ROWMAP, DCOL) { constexpr int nblk = (NPAD) / 32; constexpr int cnt = ((Kk) / 64) * nblk; if (r < cnt) { W_ = SRC; ldw_ = LDW; nv_ = NVALID; k0_ = 64 * (r / nblk); n0_ = 32 * (r % nblk); break; } r -= cnt; }
#define LDM8(SRC, Kk, LDW, NN, DST, LDT, ROWMAP, SC) { constexpr int nblk = (NN) / 32; constexpr int cnt = ((Kk) / 64) * nblk; if (r < cnt) { W_ = SRC; ldw_ = LDW; nv_ = NN; k0_ = 64 * (r / nblk); n0_ = 32 * (r % nblk); break; } r -= cnt; }
#define LDML(SRC, Kk, LDW, NVALID, NPAD, DST, LDT, ROWMAP, GAIN, BVEC, VG, VB) { constexpr int nblk = (NPAD) / 32; constexpr int cnt = ((Kk) / 64) * nblk; if (r < cnt) { W_ = SRC; ldw_ = LDW; nv_ = NVALID; k0_ = 64 * (r / nblk); n0_ = 32 * (r % nblk); G_ = GAIN; B_ = BVEC; break; } r -= cnt; }
#define LDML8(SRC, Kk, LDW, NN, DST, LDT, ROWMAP, SC, GAIN, BVEC, VG, VB) { constexpr int nblk = (NN) / 32; constexpr int cnt = ((Kk) / 64) * nblk; if (r < cnt) { W_ = SRC; ldw_ = LDW; nv_ = NN; k0_ = 64 * (r / nblk); n0_ = 32 * (r % nblk); G_ = GAIN; B_ = BVEC; break; } r -= cnt; }
#define LDUV { if (r < 256) { const int h = r >> 5, rr = r & 31; W_ = in[10] + (size_t)h * 512 * 128; ldw_ = 128; nv_ = 128; k0_ = 64 * (rr >> 2); n0_ = 32 * (rr & 3); break; } r -= 256; }
#define P0_LOAD(IT, PV, GB, OK) do { const float* W_ = in[2]; const float* G_ = in[22]; const float* B_ = in[22]; int ldw_ = 5632, nv_ = 5632, k0_ = 0, n0_ = 0; do { int r = (IT); P0_LIST(LDM, LDM8, LDML, LDML8, LDUV) } while (0); \
        tr_load(W_, ldw_, nv_, k0_, n0_, G_, B_, lane, PV, GB, OK); } while (0)
#define P0_PROC(IT, PV, GB, OK) do { tr_stage(scr, lane, PV, GB, OK); int r = (IT); P0_LIST(TRM, TRM8, TRML, TRML8, TRUV) } while (0)
    constexpr int N_TR = 2 * (32 * 176) + 88 * 64 + 32 * 184 + 2 * (32 * 64) + 256 + 2 * (16 * 64) + 32 * 64 + 32 * 16 + 32 * 32 + 8 * 64 + 2 * (32 * 176) + 88 * 64;
    { f32x4 va[8], vb[8], vc[8], ga, gb, gc; int oa = 1, ob = 1, oc = 1;
#define P0_CL(i_) ((i_) < N_TR ? (i_) : N_TR - 1)
      P0_LOAD(P0_CL(gw), va, ga, oa);
      P0_LOAD(P0_CL(gw + NGW), vb, gb, ob);
      for (int it = gw; it < N_TR; it += 3 * NGW) {
          P0_LOAD(P0_CL(it + 2 * NGW), vc, gc, oc);
          P0_PROC(it, va, ga, oa);
          P0_LOAD(P0_CL(it + 3 * NGW), va, ga, oa);
          if (it + NGW < N_TR) P0_PROC(it + NGW, vb, gb, ob);
          P0_LOAD(P0_CL(it + 4 * NGW), vb, gb, ob);
          if (it + 2 * NGW < N_TR) P0_PROC(it + 2 * NGW, vc, gc, oc);
      }
#undef P0_CL
    }
#undef P0_LOAD
#undef P0_PROC
#undef P0_LIST
#undef TRM
#undef TRM8
#undef TRML
#undef TRML8
#undef TRUV
#undef LDM
#undef LDM8
#undef LDML
#undef LDML8
#undef LDUV
    for (int rw = gw; rw < 1024; rw += NGW) { const int e = (rw >> 7) & 1; *((GAS v2u*)((unsigned char*)(ws + WS_W_UVP) + (size_t)rw * 1024 + (1 - e) * 512) + lane) = (v2u){0u, 0u}; }
    for (int it = 4 * gw; it < (M * D) / 512; it += 4 * NGW) {
        const GAS f32x4* sp = (const GAS f32x4*)(in[0] + (size_t)it * 512) + 2 * lane; f32x4 q[8];
#pragma unroll
        for (int j = 0; j < 4; ++j) { q[2 * j] = __builtin_nontemporal_load(sp + 128 * j); q[2 * j + 1] = __builtin_nontemporal_load(sp + 128 * j + 1); }
#pragma unroll
        for (int j = 0; j < 4; ++j) { const f32x4 a = q[2 * j] * FP8_XS, b = q[2 * j + 1] * FP8_XS; int w0 = 0, w1 = 0;
            w0 = __builtin_amdgcn_cvt_pk_fp8_f32(fminf(fmaxf(a.x, -448.f), 448.f), fminf(fmaxf(a.y, -448.f), 448.f), w0, false); w0 = __builtin_amdgcn_cvt_pk_fp8_f32(fminf(fmaxf(a.z, -448.f), 448.f), fminf(fmaxf(a.w, -448.f), 448.f), w0, true);
            w1 = __builtin_amdgcn_cvt_pk_fp8_f32(fminf(fmaxf(b.x, -448.f), 448.f), fminf(fmaxf(b.y, -448.f), 448.f), w1, false); w1 = __builtin_amdgcn_cvt_pk_fp8_f32(fminf(fmaxf(b.z, -448.f), 448.f), fminf(fmaxf(b.w, -448.f), 448.f), w1, true);
            *((GAS v2u*)((unsigned char*)(ws + WS_X8) + (size_t)(it + j) * 512) + lane) = (v2u){(unsigned)w0, (unsigned)w1}; } }
    for (int it = gw; it < (BATCH * MEMT * D) / 512; it += NGW) cvt_item(in[1], (bf16*)(ws + WS_MEM16), it, lane);
    for (int it = gw; it < (8 * 512 * 128) / 512; it += NGW) cvt_item(in[9], (bf16*)(ws + WS_W_UK), it, lane);
}

__device__ __forceinline__ void ln_phase(float* zx, bf16* x16, unsigned char* x8, const float* g, const float* b, int gw, int NGW, int lane) {
    f32x4 gv[8], bv[8];
#pragma unroll
    for (int j = 0; j < 8; ++j) { gv[j] = *((const GAS f32x4*)g + lane + 64 * j); bv[j] = *((const GAS f32x4*)b + lane + 64 * j); }
    for (int m = gw; m < M; m += NGW) {
        GAS f32x4* xr = (GAS f32x4*)(zx + (size_t)m * D) + lane;
        f32x4 v[8]; float s = 0.f;
#pragma unroll
        for (int j = 0; j < 8; ++j) { v[j] = xr[64 * j]; s += (v[j].x + v[j].y) + (v[j].z + v[j].w); }
        const float mean = wave_sum(s) * (1.f / D); float s2 = 0.f;
#pragma unroll
        for (int j = 0; j < 8; ++j) { v[j] = v[j] - mean; s2 += (v[j].x * v[j].x + v[j].y * v[j].y) + (v[j].z * v[j].z + v[j].w * v[j].w); }
        const float rstd = 1.f / sqrtf(wave_sum(s2) * (1.f / D) + LN_EPS);
#pragma unroll
        for (int j = 0; j < 8; ++j) { v[j] = v[j] * rstd * gv[j] + bv[j]; xr[64 * j] = v[j]; }
        if (x16) { GAS v2u* o8 = (GAS v2u*)(x16 + (size_t)m * D) + lane;
#pragma unroll
            for (int j = 0; j < 8; ++j) o8[64 * j] = (v2u){pk2(v[j].x, v[j].y), pk2(v[j].z, v[j].w)}; }
        if (x8) { GAS unsigned* o4 = (GAS unsigned*)(x8 + (size_t)m * D) + lane;
#pragma unroll
            for (int j = 0; j < 8; ++j) { const f32x4 q = v[j] * FP8_XS; int w = 0; w = __builtin_amdgcn_cvt_pk_fp8_f32(fminf(fmaxf(q.x, -448.f), 448.f), fminf(fmaxf(q.y, -448.f), 448.f), w, false);
                w = __builtin_amdgcn_cvt_pk_fp8_f32(fminf(fmaxf(q.z, -448.f), 448.f), fminf(fmaxf(q.w, -448.f), 448.f), w, true); o4[64 * j] = (unsigned)w; } }
    }
}
__device__ __forceinline__ void ln_final_phase(const bf16* z16, float* outp, const float* g, const float* b, int gw, int NGW, int lane) {
    for (int m0 = gw; m0 < M; m0 += 2 * NGW) {
        const int m1 = m0 + NGW; const bool two = m1 < M;
        v4u w[2][4];
#pragma unroll
        for (int j = 0; j < 4; ++j) { w[0][j] = __builtin_nontemporal_load((const GAS v4u*)(z16 + (size_t)m0 * D) + lane + 64 * j); w[1][j] = two ? __builtin_nontemporal_load((const GAS v4u*)(z16 + (size_t)m1 * D) + lane + 64 * j) : (v4u){0u, 0u, 0u, 0u}; }
#pragma unroll
        for (int rr = 0; rr < 2; ++rr) { if (rr == 1 && !two) break;
            const int m = rr ? m1 : m0;
            float v[32]; float s = 0.f;
#pragma unroll
            for (int j = 0; j < 4; ++j) { const v4u x = w[rr][j]; v[8 * j + 0] = blo(x.x); v[8 * j + 1] = bhi(x.x); v[8 * j + 2] = blo(x.y); v[8 * j + 3] = bhi(x.y); v[8 * j + 4] = blo(x.z); v[8 * j + 5] = bhi(x.z); v[8 * j + 6] = blo(x.w); v[8 * j + 7] = bhi(x.w); }
#pragma unroll
            for (int e = 0; e < 32; ++e) s += v[e];
            const float mean = wave_sum(s) * (1.f / D); float s2 = 0.f;
#pragma unroll
            for (int e = 0; e < 32; ++e) { v[e] -= mean; s2 += v[e] * v[e]; }
            const float rstd = 1.f / sqrtf(wave_sum(s2) * (1.f / D) + LN_EPS);
#pragma unroll
            for (int j = 0; j < 4; ++j) { const int c0 = 512 * j + 8 * lane;
                const f32x4 g0 = *(const GAS f32x4*)(g + c0), g1 = *(const GAS f32x4*)(g + c0 + 4), b0 = *(const GAS f32x4*)(b + c0), b1 = *(const GAS f32x4*)(b + c0 + 4);
                GAS f32x4* o = (GAS f32x4*)(outp + (size_t)m * D + c0);
                __builtin_nontemporal_store((f32x4){v[8 * j + 0], v[8 * j + 1], v[8 * j + 2], v[8 * j + 3]} * rstd * g0 + b0, o); __builtin_nontemporal_store((f32x4){v[8 * j + 4], v[8 * j + 5], v[8 * j + 6], v[8 * j + 7]} * rstd * g1 + b1, o + 1); } }
    }
}
__device__ __forceinline__ void crms_phase(const bf16* bc, unsigned char* c8, const float* kvg, float cs, int gw, int NGW, int lane) {
    float gg[8];
#pragma unroll
    for (int j = 0; j < 8; ++j) gg[j] = kvg[8 * lane + j] * cs;
    for (int m0 = gw; m0 < M; m0 += 8 * NGW) {
        v4u w8[8];
#pragma unroll
        for (int r = 0; r < 8; ++r) { const int m = m0 + r * NGW < M ? m0 + r * NGW : M - 1; w8[r] = *((const GAS v4u*)(bc + (size_t)m * 512) + lane); }
#pragma unroll
        for (int r = 0; r < 8; ++r) { const int m = m0 + r * NGW; if (m < M) { const v4u w = w8[r];
            float x[8] = {blo(w.x), bhi(w.x), blo(w.y), bhi(w.y), blo(w.z), bhi(w.z), blo(w.w), bhi(w.w)}; float s = 0.f;
#pragma unroll
            for (int j = 0; j < 8; ++j) s += x[j] * x[j];
            const float rr = 1.f / sqrtf(wave_sum(s) * (1.f / 512.f) + LN_EPS);
#pragma unroll
            for (int j = 0; j < 8; ++j) x[j] = fminf(fmaxf(x[j] * rr * gg[j], -448.f), 448.f);
            *((GAS v2u*)(c8 + (size_t)m * 512) + lane) = (v2u){pg8::pk4_fp8(x[0], x[1], x[2], x[3]), pg8::pk4_fp8(x[4], x[5], x[6], x[7])}; } }
    }
}
typedef short v4i16_t __attribute__((ext_vector_type(4)));
__device__ __forceinline__ v4i16_t lds_tr16(const LAS unsigned char* p) { return __builtin_amdgcn_ds_read_tr16_b64_v4i16((LAS v4i16_t*)p); }
__device__ __forceinline__ unsigned cvtpk(float lo, float hi) { typedef float f2 __attribute__((ext_vector_type(2))); typedef __bf16 b2 __attribute__((ext_vector_type(2))); f2 v = {lo, hi}; b2 b = __builtin_convertvector(v, b2); return __builtin_bit_cast(unsigned, b); }
__device__ __forceinline__ float xhalf_f(float v) { return __shfl_xor(v, 32); }
constexpr float LOG2E = 1.4426950408889634f;
constexpr float QSCALE = 0.125f * LOG2E;

__device__ __forceinline__ void diff_attn_mfma(LAS unsigned char* lds, const bf16* AQ, const bf16* AK, const bf16* AV, bf16* YA, const float* dlam, const float* subg, unsigned* dq, const unsigned* kmax, const int wave) {
    const int lane = lane_fresh(), r32 = lane & 31, hi = lane >> 5;
    const int comp = wave >> 2, wq = wave & 3;
    const unsigned ksrc = (unsigned)(lane * 1024 + (2 * wave) * 8);
    const unsigned vsrc0 = (unsigned)((16 * ((2 * wave) & 3) + (lane >> 2)) * 1024 + ((2 * wave) >> 2) * 32 + (lane & 3) * 8);
    const unsigned vsrc1 = (unsigned)((16 * ((2 * wave + 1) & 3) + (lane >> 2)) * 1024 + ((2 * wave + 1) >> 2) * 32 + (lane & 3) * 8);
    const unsigned kdst = (unsigned)(2 * wave) * 1024u, vdst0 = 16384u + (unsigned)(((2 * wave) >> 2) * 4096 + ((2 * wave) & 3) * 1024), vdst1 = 16384u + (unsigned)(((2 * wave + 1) >> 2) * 4096 + ((2 * wave + 1) & 3) * 1024);
    const unsigned lds0 = (unsigned)(uintptr_t)lds;
#define DA_STAGE(bo, to) do { \
        glds16(Kg + (to) + ksrc, (unsigned)__builtin_amdgcn_readfirstlane((int)(lds0 + (bo) + kdst))); \
        glds16(Kg + (to) + ksrc + 8, (unsigned)__builtin_amdgcn_readfirstlane((int)(lds0 + (bo) + kdst + 1024))); \
        glds16(Vg + (to) + vsrc0, (unsigned)__builtin_amdgcn_readfirstlane((int)(lds0 + (bo) + vdst0))); \
        glds16(Vg + (to) + vsrc1, (unsigned)__builtin_amdgcn_readfirstlane((int)(lds0 + (bo) + vdst1))); } while (0)
#define DA_WAITBAR() asm volatile("s_waitcnt vmcnt(0) lgkmcnt(0)\n\ts_barrier" ::: "memory")
    const unsigned koff = (unsigned)(((comp * 8 + hi) * 64 + r32) * 16);
    const unsigned voff = (unsigned)(16384 + (4 * hi + ((lane & 15) >> 2)) * 64 + ((lane >> 4) & 1) * 32 + (lane & 3) * 8);
    LAS unsigned* xq = (LAS unsigned*)(lds + 100352);
    for (;;) {
        if (wave == 0 && lane == 0) xq[0] = __hip_atomic_fetch_add(dq, 1u, __ATOMIC_RELAXED, __HIP_MEMORY_SCOPE_AGENT);
        asm volatile("s_waitcnt vmcnt(0) lgkmcnt(0)\n\ts_barrier" ::: "memory");
        const int j = (int)xq[0];
        if (j >= 1024) break;
        const int ub = 31 - (j >> 5), bh = j & 31;
        const int b = bh >> 3, h = 7 - (bh & 7);
        const float sl2 = LOG2E / (float)(2 << h);
        const size_t rowbase = (size_t)b * SEQ; const int q0 = ub * 128;
        const int qpos = q0 + wq * 32 + r32;
        const int nt = 2 * ub + 2;
        const int myt = 2 * ub + 1 + (wq >> 1);
        const bf16* Kg = AK + rowbase * 1024 + h * 128; const bf16* Vg = AV + rowbase * 1024 + h * 128;
        bf16x8 qr[4];
#pragma unroll
        for (int s = 0; s < 4; ++s) qr[s] = *(const GAS bf16x8*)(AQ + (rowbase + qpos) * 1024 + h * 128 + comp * 64 + s * 16 + hi * 8);
        f32x16 o[4];
#pragma unroll
        for (int blk = 0; blk < 4; ++blk)
#pragma unroll
            for (int r = 0; r < 16; ++r) o[blk][r] = 0.f;
        float mrun = -INFINITY;
        f32x16 ol;
#pragma unroll
        for (int r = 0; r < 16; ++r) ol[r] = 0.f;
        const bf16x8 vones = {(short)0x3F80, (short)0x3F80, (short)0x3F80, (short)0x3F80, (short)0x3F80, (short)0x3F80, (short)0x3F80, (short)0x3F80};
        float sbr;
        { float qn2 = 0.f;
#pragma unroll
          for (int s = 0; s < 4; ++s) { const v4u w = __builtin_bit_cast(v4u, qr[s]); const float e0 = blo(w.x), e1 = bhi(w.x), e2 = blo(w.y), e3 = bhi(w.y), e4 = blo(w.z), e5 = bhi(w.z), e6 = blo(w.w), e7 = bhi(w.w);
              qn2 += ((e0 * e0 + e1 * e1) + (e2 * e2 + e3 * e3)) + ((e4 * e4 + e5 * e5) + (e6 * e6 + e7 * e7)); }
          qn2 += xhalf_f(qn2);
          const float qn2row = qn2;
#pragma unroll
          for (int o_ = 1; o_ < 32; o_ <<= 1) qn2 = fmaxf(qn2, __shfl_xor(qn2, o_));
          const unsigned* kp = kmax + ((b * 8 + h) * 2 + comp) * 2;
          const float k2 = __uint_as_float(__hip_atomic_load(kp, __ATOMIC_RELAXED, __HIP_MEMORY_SCOPE_AGENT)) + __uint_as_float(__hip_atomic_load(kp + 1, __ATOMIC_RELAXED, __HIP_MEMORY_SCOPE_AGENT));
          sbr = sqrtf(qn2row * k2) * 1.02f;
          if (lane == 0) xq[8 + wave] = __float_as_uint(sqrtf(qn2 * k2) * 1.02f); }
        DA_STAGE(0u, (size_t)(nt - 1) * 64 * 1024);
        DA_WAITBAR();
        int kt_lo = 0;
        { float sb = 0.f;
#pragma unroll
          for (int w_ = 0; w_ < 8; ++w_) sb = fmaxf(sb, __uint_as_float(xq[8 + w_]));
          const float xcut = (float)(q0 - 63) - (40.f + 2.f * sb) / sl2;
          kt_lo = xcut > 0.f ? (int)__builtin_ceilf(xcut * (1.f / 64.f)) : 0; kt_lo = __builtin_amdgcn_readfirstlane(kt_lo); }
        for (int st = 0; st < nt - kt_lo; ++st) {
            const int kt = nt - 1 - st;
            const unsigned bufo = (unsigned)(st & 1) * 32768u;
            if (kt > kt_lo) DA_STAGE(32768u - bufo, (size_t)(kt - 1) * 64 * 1024);
            if (kt < myt) {
                const LAS unsigned char* Kb = lds + bufo + koff;
                f32x16 p0, p1;
#pragma unroll
                for (int r = 0; r < 16; ++r) { p0[r] = 0.f; p1[r] = 0.f; }
                { bf16x8 kf0[4], kf1[4];
#pragma unroll
                  for (int s = 0; s < 4; ++s) { kf0[s] = *(const LAS bf16x8*)(Kb + s * 2048); kf1[s] = *(const LAS bf16x8*)(Kb + s * 2048 + 512); }
#pragma unroll
                  for (int s = 0; s < 4; ++s) { p0 = __builtin_amdgcn_mfma_f32_32x32x16_bf16(kf0[s], qr[s], p0, 0, 0, 0); p1 = __builtin_amdgcn_mfma_f32_32x32x16_bf16(kf1[s], qr[s], p1, 0, 0, 0); } }
                const float qth = (float)(qpos - kt * 64 - 4 * hi);
                float rm = -INFINITY;
#pragma unroll
                for (int r = 0; r < 16; ++r) { const float kr = (float)((r & 3) + 8 * (r >> 2)); const float v0 = qth - kr, v1 = qth - (kr + 32.f);
                    p0[r] = p0[r] - sl2 * fabsf(v0); p1[r] = p1[r] - sl2 * fabsf(v1); rm = fmaxf(rm, fmaxf(p0[r], p1[r])); }
                rm = fmaxf(rm, xhalf_f(rm));
                if (!__all(rm < mrun - 40.f ? 1 : 0)) {
                if (__any(rm > mrun)) { const float mn = fmaxf(mrun, rm), f = __builtin_amdgcn_exp2f(mrun - mn); mrun = mn;
#pragma unroll
                    for (int r = 0; r < 16; ++r) ol[r] *= f;
#pragma unroll
                    for (int blk = 0; blk < 4; ++blk)
#pragma unroll
                        for (int r = 0; r < 16; ++r) o[blk][r] *= f; }
#pragma unroll
                for (int r = 0; r < 16; ++r) { p0[r] = __builtin_amdgcn_exp2f(p0[r] - mrun); p1[r] = __builtin_amdgcn_exp2f(p1[r] - mrun); }
                bf16x8 pw[4];
#pragma unroll
                for (int s = 0; s < 2; ++s) {
                    v4u a = {cvtpk(p0[8 * s + 0], p0[8 * s + 1]), cvtpk(p0[8 * s + 2], p0[8 * s + 3]), cvtpk(p0[8 * s + 4], p0[8 * s + 5]), cvtpk(p0[8 * s + 6], p0[8 * s + 7])};
                    v4u c = {cvtpk(p1[8 * s + 0], p1[8 * s + 1]), cvtpk(p1[8 * s + 2], p1[8 * s + 3]), cvtpk(p1[8 * s + 4], p1[8 * s + 5]), cvtpk(p1[8 * s + 6], p1[8 * s + 7])};
                    pw[s] = __builtin_bit_cast(bf16x8, a); pw[2 + s] = __builtin_bit_cast(bf16x8, c); }
#pragma unroll
                for (int s = 0; s < 4; ++s) ol = __builtin_amdgcn_mfma_f32_32x32x16_bf16(vones, pw[s], ol, 0, 0, 0);
                const LAS unsigned char* Vb = lds + bufo + voff;
                { v4i16_t va[2][4][2];
#pragma unroll
                  for (int s = 0; s < 4; ++s) { va[0][s][0] = lds_tr16(Vb + s * 1024); va[0][s][1] = lds_tr16(Vb + s * 1024 + 512); }
#pragma unroll
                  for (int blk = 0; blk < 4; ++blk) {
                      if (blk < 3) {
#pragma unroll
                          for (int s = 0; s < 4; ++s) { va[(blk + 1) & 1][s][0] = lds_tr16(Vb + (blk + 1) * 4096 + s * 1024); va[(blk + 1) & 1][s][1] = lds_tr16(Vb + (blk + 1) * 4096 + s * 1024 + 512); } }
                      __builtin_amdgcn_sched_barrier(0);
#pragma unroll
                      for (int s = 0; s < 4; ++s) { const v4i16_t lo = va[blk & 1][s][0], hh = va[blk & 1][s][1];
                          const bf16x8 vf = {lo[0], lo[1], lo[2], lo[3], hh[0], hh[1], hh[2], hh[3]};
                          o[blk] = __builtin_amdgcn_mfma_f32_32x32x16_bf16(vf, pw[s], o[blk], 0, 0, 0); }
                      __builtin_amdgcn_sched_barrier(0);
                  } }
                }
            }
            { const int ktn = kt - 1;
              const bool negl = (ktn < 2 * ub) && (sbr - sl2 * (float)(qpos - (64 * ktn + 63)) < mrun - 40.f);
              const unsigned okw = __all(negl ? 1 : 0) ? 1u : 0u;
              if (lane == 0) xq[16 + (st & 1) * 8 + wave] = okw; }
            DA_WAITBAR();
            { const v4u f0 = *(const LAS v4u*)(xq + 16 + (st & 1) * 8), f1 = *(const LAS v4u*)(xq + 20 + (st & 1) * 8);
              if (__builtin_amdgcn_readfirstlane((int)(f0.x & f0.y & f0.z & f0.w & f1.x & f1.y & f1.z & f1.w))) break; }
        }
        const float inv = 1.f / ol[0];
        LAS float* Y1 = (LAS float*)(lds) + wq * 4096;
        if (comp == 1) {
            float lam; { float a = dlam[lane] * dlam[64 + lane], bq_ = dlam[128 + lane] * dlam[192 + lane]; a = wave_sum(a); bq_ = wave_sum(bq_); lam = __expf(a) - __expf(bq_) + LAMBDA_INIT; }
            const float sc = inv * lam;
#pragma unroll
            for (int blk = 0; blk < 4; ++blk)
#pragma unroll
                for (int r = 0; r < 16; ++r) Y1[(32 * blk + (r & 3) + 8 * (r >> 2) + 4 * hi) * 32 + r32] = o[blk][r] * sc; }
        __syncthreads();
        if (comp == 0) {
            float ss = 0.f;
#pragma unroll
            for (int blk = 0; blk < 4; ++blk)
#pragma unroll
                for (int r = 0; r < 16; ++r) { const float a = o[blk][r] * inv - Y1[(32 * blk + (r & 3) + 8 * (r >> 2) + 4 * hi) * 32 + r32]; o[blk][r] = a; ss += a * a; }
            ss += xhalf_f(ss);
            const float rr = (1.0f - LAMBDA_INIT) / sqrtf(ss * (1.f / 128.f) + LN_EPS);
            LAS unsigned* stg = (LAS unsigned*)(lds + 65536) + wq * (32 * 33);
            const float rs = rr * FP8_YAS;
#pragma unroll
            for (int blk = 0; blk < 4; ++blk) {
#pragma unroll
                for (int r = 0; r < 16; r += 4) { const int e = 32 * blk + 8 * (r >> 2) + 4 * hi;
                    stg[r32 * 33 + (e >> 2)] = pg8::pk4_fp8(fminf(fmaxf(o[blk][r] * rs * subg[e], -448.f), 448.f), fminf(fmaxf(o[blk][r + 1] * rs * subg[e + 1], -448.f), 448.f),
                                                           fminf(fmaxf(o[blk][r + 2] * rs * subg[e + 2], -448.f), 448.f), fminf(fmaxf(o[blk][r + 3] * rs * subg[e + 3], -448.f), 448.f)); }
                asm volatile("" ::: "memory"); }
            LDS_WAIT(); asm volatile("" ::: "memory");
            unsigned char* orow = (unsigned char*)YA + (rowbase + q0 + wq * 32) * 1024 + h * 128;
#pragma unroll 4
            for (int row = 0; row < 32; row += 2) *((GAS unsigned*)(orow + (size_t)(row + hi) * 1024) + r32) = stg[(row + hi) * 33 + r32];
        }
        __syncthreads();
    }
#undef DA_STAGE
#undef DA_WAITBAR
}

__device__ __forceinline__ unsigned okey(float f) { const unsigned u = __float_as_uint(f); return (u & 0x80000000u) ? ~u : (u | 0x80000000u); }
__device__ __forceinline__ void indexer_topk(LAS unsigned char* lds, const bf16* IQ, const bf16* IKW, unsigned short* IDX, int vcu, int G, const int wave) {
    const int lane = lane_fresh(), r32 = lane & 31, hi = lane >> 5;
    const unsigned lds0 = (unsigned)(uintptr_t)lds;
    const unsigned boff = (unsigned)((hi * 256 + r32) * 16);
#define IX_STAGE0(JJ) do { const bf16* Kg0_ = IKW + (size_t)((((JJ) & 255) >> 4) >> 2) * SEQ * 256; _Pragma("unroll") for (int i_ = 0; i_ < 4; ++i_) { const int q_ = 4 * wave + i_; \
            glds16s(Kg0_ + (size_t)(64 * (q_ & 3)) * 256 + (q_ >> 2) * 8, (unsigned)lane * 512u, (unsigned)__builtin_amdgcn_readfirstlane((int)(lds0 + ((q_ >> 2) * 256 + 64 * (q_ & 3)) * 16))); } } while (0)
    if (vcu < 1024) IX_STAGE0(vcu);
    for (int j = vcu; j < 1024; j += G) {
        const int w = j & 255, i = j >> 8, bq = w >> 4, s16 = w & 15;
        const int chunk = (i == 0) ? s16 : (i == 1) ? 31 - s16 : (i == 2) ? 32 + s16 : 63 - s16;
        const int b = bq >> 2, gq = bq & 3;
        const int t0 = b * SEQ + chunk * 64 + gq * 16 + 2 * wave;
        const int ngroups = 2 * (chunk + 1);
        const int ntiles = (ngroups + 7) >> 3;
        const bf16* Kg = IKW + (size_t)b * SEQ * 256;
#define IX_STAGE(tile, bo) do { int tl_ = (tile); asm volatile("" : "+s"(tl_)); _Pragma("unroll") for (int i_ = 0; i_ < 4; ++i_) { const int q_ = 4 * wave + i_; \
            glds16s(Kg + (size_t)(tl_ * 256 + 64 * (q_ & 3)) * 256 + (q_ >> 2) * 8, (unsigned)lane * 512u, (unsigned)__builtin_amdgcn_readfirstlane((int)(lds0 + (bo) + ((q_ >> 2) * 256 + 64 * (q_ & 3)) * 16))); } } while (0)
        unsigned pf = 0u;
        if (j + G < 1024) { const int jn = j + G, wn = jn & 255, in_ = jn >> 8, bqn = wn >> 4, sn = wn & 15;
            const int chn = (in_ == 0) ? sn : (in_ == 1) ? 31 - sn : (in_ == 2) ? 32 + sn : 63 - sn;
            const int tn0 = (bqn >> 2) * SEQ + chn * 64 + (bqn & 3) * 16 + 2 * wave;
            const bf16* pa = (lane < 32) ? IQ + (size_t)tn0 * 1024 + lane * 64 : IKW + (size_t)(tn0 + (lane & 1)) * 256 + 64;
            asm volatile("global_load_dword %0, %1, off" : "=&v"(pf) : "v"(pa) : "memory"); }
        bf16x8 a[4];
#pragma unroll
        for (int ks = 0; ks < 4; ++ks) a[ks] = *(const GAS bf16x8*)(IQ + (size_t)(t0 + (r32 >> 4)) * 1024 + (r32 & 15) * 64 + ks * 16 + 8 * hi);
        float wv[16];
        { const bf16* iwp = IKW + (size_t)t0 * 256 + 64 + 4 * hi;
          const v2u w00 = *(const GAS v2u*)(iwp), w01 = *(const GAS v2u*)(iwp + 8), w10 = *(const GAS v2u*)(iwp + 256), w11 = *(const GAS v2u*)(iwp + 256 + 8);
          wv[0] = blo(w00.x); wv[1] = bhi(w00.x); wv[2] = blo(w00.y); wv[3] = bhi(w00.y); wv[4] = blo(w01.x); wv[5] = bhi(w01.x); wv[6] = blo(w01.y); wv[7] = bhi(w01.y);
          wv[8] = blo(w10.x); wv[9] = bhi(w10.x); wv[10] = blo(w10.y); wv[11] = bhi(w10.y); wv[12] = blo(w11.x); wv[13] = bhi(w11.x); wv[14] = blo(w11.y); wv[15] = bhi(w11.y); }
        typedef float f2_t __attribute__((ext_vector_type(2)));
        f2_t w2[8];
#pragma unroll
        for (int r = 0; r < 8; ++r) w2[r] = (f2_t){wv[2 * r], wv[2 * r + 1]};
#define IX_SCORE(acc_, dst_) do { f2_t s0_ = {0.f, 0.f}, s1_ = {0.f, 0.f}; \
            _Pragma("unroll") for (int r = 0; r < 4; ++r) { \
                const f2_t x0_ = {__int_as_float(max(__float_as_int(acc_[2 * r]), 0)), __int_as_float(max(__float_as_int(acc_[2 * r + 1]), 0))}; \
                const f2_t x1_ = {__int_as_float(max(__float_as_int(acc_[8 + 2 * r]), 0)), __int_as_float(max(__float_as_int(acc_[8 + 2 * r + 1]), 0))}; \
                s0_ = __builtin_elementwise_fma(x0_, w2[r], s0_); s1_ = __builtin_elementwise_fma(x1_, w2[4 + r], s1_); } \
            const auto rr_ = __builtin_amdgcn_permlane32_swap(__float_as_uint(s0_.x + s0_.y), __float_as_uint(s1_.x + s1_.y), false, false); \
            const unsigned u_ = __float_as_uint(__uint_as_float(rr_[0]) + __uint_as_float(rr_[1])); \
            dst_ = u_ ^ ((unsigned)((int)u_ >> 31) | 0x80000000u); } while (0)
        unsigned key[128];
#pragma unroll 64
        for (int g = 0; g < 128; g += 2) {
            if (g < ngroups) {
                const unsigned bufo = (unsigned)((g >> 3) & 1) * 32768u;
                if ((g & 7) == 0) {
                    asm volatile("s_waitcnt vmcnt(0)\n\ts_barrier" ::: "memory");
                    if (g == 0) asm volatile("" :: "v"(pf));
                    if ((g >> 3) + 1 < ntiles) IX_STAGE((g >> 3) + 1, 32768u - bufo);
                }
                bf16x8 bk0[4], bk1[4];
#pragma unroll
                for (int ks = 0; ks < 4; ++ks) { bk0[ks] = *(const LAS bf16x8*)(lds + bufo + boff + (g & 7) * 512 + ks * 8192); bk1[ks] = *(const LAS bf16x8*)(lds + bufo + boff + ((g + 1) & 7) * 512 + ks * 8192); }
                f32x16 acc0 = {0.f, 0.f, 0.f, 0.f, 0.f, 0.f, 0.f, 0.f, 0.f, 0.f, 0.f, 0.f, 0.f, 0.f, 0.f, 0.f}, acc1 = acc0;
#pragma unroll
                for (int ks = 0; ks < 4; ++ks) acc0 = __builtin_amdgcn_mfma_f32_32x32x16_bf16(a[ks], bk0[ks], acc0, 0, 0, 0);
#pragma unroll
                for (int ks = 0; ks < 4; ++ks) acc1 = __builtin_amdgcn_mfma_f32_32x32x16_bf16(a[ks], bk1[ks], acc1, 0, 0, 0);
                IX_SCORE(acc0, key[g]); IX_SCORE(acc1, key[g + 1]);
            } else { key[g] = 0u; key[g + 1] = 0u; }
        }
#undef IX_SCORE
        asm volatile("s_waitcnt lgkmcnt(0)\n\ts_barrier" ::: "memory");
        if (j + G < 1024) IX_STAGE0(j + G);
        unsigned selw[4];
        { unsigned vm[4];
#pragma unroll
          for (int w_ = 0; w_ < 4; ++w_) { const int n_ = ngroups - 32 * w_; vm[w_] = n_ >= 32 ? 0xffffffffu : (n_ <= 0 ? 0u : ((1u << (n_ & 31)) - 1u)); }
          if (chunk >= 4) {
#pragma unroll
              for (int w_ = 0; w_ < 4; ++w_) { if (32 * w_ < ngroups) {
#pragma unroll
                  for (int i_ = 0; i_ < 16; ++i_) { const unsigned x = key[32 * w_ + i_], y = key[32 * w_ + i_ + 16]; key[32 * w_ + i_] = (x & 0x0000ffffu) | (y << 16); key[32 * w_ + i_ + 16] = (x >> 16) | (y & 0xffff0000u); }
#pragma unroll
                  for (int i_ = 0; i_ < 32; ++i_) { if (!(i_ & 8)) { const unsigned x = key[32 * w_ + i_], y = key[32 * w_ + i_ + 8]; key[32 * w_ + i_] = (x & 0x00ff00ffu) | ((y << 8) & 0xff00ff00u); key[32 * w_ + i_ + 8] = ((x >> 8) & 0x00ff00ffu) | (y & 0xff00ff00u); } }
#pragma unroll
                  for (int i_ = 0; i_ < 32; ++i_) { if (!(i_ & 4)) { const unsigned x = key[32 * w_ + i_], y = key[32 * w_ + i_ + 4]; key[32 * w_ + i_] = (x & 0x0f0f0f0fu) | ((y << 4) & 0xf0f0f0f0u); key[32 * w_ + i_ + 4] = ((x >> 4) & 0x0f0f0f0fu) | (y & 0xf0f0f0f0u); } }
#pragma unroll
                  for (int i_ = 0; i_ < 32; ++i_) { if (!(i_ & 2)) { const unsigned x = key[32 * w_ + i_], y = key[32 * w_ + i_ + 2]; key[32 * w_ + i_] = (x & 0x33333333u) | ((y << 2) & 0xccccccccu); key[32 * w_ + i_ + 2] = ((x >> 2) & 0x33333333u) | (y & 0xccccccccu); } }
#pragma unroll
                  for (int i_ = 0; i_ < 32; ++i_) { if (!(i_ & 1)) { const unsigned x = key[32 * w_ + i_], y = key[32 * w_ + i_ + 1]; key[32 * w_ + i_] = (x & 0x55555555u) | ((y << 1) & 0xaaaaaaaau); key[32 * w_ + i_ + 1] = ((x >> 1) & 0x55555555u) | (y & 0xaaaaaaaau); } }
              } }
              unsigned cand[4] = {vm[0], vm[1], vm[2], vm[3]}, abv[4] = {0u, 0u, 0u, 0u}; int nab = 0; bool done = false;
#pragma unroll 32
              for (int bit = 31; bit >= 0; --bit) {
                  if (__all(done ? 1 : 0)) break;
                  const unsigned o0 = cand[0] & key[bit], o1 = cand[1] & key[32 + bit], o2 = cand[2] & key[64 + bit], o3 = cand[3] & key[96 + bit];
                  const int c = half_sum_i32(__popc(o0) + __popc(o1) + __popc(o2) + __popc(o3));
                  const bool take = nab + c >= 256;
                  done = done || (take && nab + c == 256);
                  const unsigned ntm = take ? 0u : 0xffffffffu;
                  nab += c & (int)ntm;
                  abv[0] |= o0 & ntm; abv[1] |= o1 & ntm; abv[2] |= o2 & ntm; abv[3] |= o3 & ntm;
                  cand[0] = o0 ^ (cand[0] & ntm); cand[1] = o1 ^ (cand[1] & ntm); cand[2] = o2 ^ (cand[2] & ntm); cand[3] = o3 ^ (cand[3] & ntm);
              }
#pragma unroll
              for (int w_ = 0; w_ < 4; ++w_) selw[w_] = abv[w_] | cand[w_];
          } else {
#pragma unroll
              for (int w_ = 0; w_ < 4; ++w_) selw[w_] = vm[w_];
          } }
        int base = 0;
        LAS unsigned short* ip = (LAS unsigned short*)(lds + 65536 + wave * 1024) + hi * 256;
#pragma unroll
        for (int g = 0; g < 128; ++g) {
            if (g < ngroups) {
                const bool sel = ((selw[g >> 5] >> (g & 31)) & 1u) != 0u;
                const unsigned long long mk = __ballot(sel ? 1 : 0);
                const unsigned mh = hi ? (unsigned)(mk >> 32) : (unsigned)mk;
                const int pos = base + __popc(mh & ((1u << r32) - 1u));
                if (sel && pos < 256) ip[pos] = (unsigned short)(32 * g + r32);
                base += __popc(mh);
            }
        }
        asm volatile("s_waitcnt lgkmcnt(0)" ::: "memory");
        { const v4u row = *(const LAS v4u*)(lds + 65536 + wave * 1024 + lane * 16);
          *(GAS v4u*)(IDX + (size_t)(t0 + hi) * 256 + r32 * 8) = row; }
        asm volatile("s_waitcnt lgkmcnt(0)" ::: "memory");
    }
#undef IX_STAGE
#undef IX_STAGE0
    asm volatile("s_waitcnt vmcnt(0) lgkmcnt(0)\n\ts_barrier" ::: "memory");
}

constexpr int DSA_PAIRB = 1040;
constexpr int DSA_WAVEB = 16 * DSA_PAIRB + 2048;
constexpr int DSA_LDS_END = 8 * DSA_WAVEB;
constexpr float DSA_CS = 64.f, DSA_QS = 64.f, DSA_PS = 256.f, DSA_OS = 64.f;
typedef int v2i_t __attribute__((ext_vector_type(2)));
__device__ __forceinline__ void dsa_mfma(LAS unsigned char* lds, const bf16* QL, bf16* OL, const int omask, const unsigned char* C8, const unsigned short* IDX, int vcu, int G, const int wave) {
    const int lane = lane_fresh(), h16 = lane & 15, g = lane >> 4;
    LAS unsigned char* wl = lds + wave * DSA_WAVEB;
    const unsigned wl0 = (unsigned)(uintptr_t)wl;
    const unsigned ib0 = (unsigned)(uintptr_t)(wl + 16 * DSA_PAIRB);
    const float sc2 = 0.08838834764831845f * LOG2E / (DSA_QS * DSA_CS);
    const float sl2 = (h16 < 8) ? LOG2E / (float)(2 << (h16 & 7)) : 0.f;
    const int ntok = (G == 256) ? 8 : (M - (vcu * 8 + wave) + G * 8 - 1) / (G * 8);
#define DSA_TOK(i) ((G == 256) ? ((vcu >> 6) * SEQ + (vcu & 63) + 64 * (wave + 8 * (i))) : (vcu * 8 + wave + G * 8 * (i)))
    const unsigned qk_off = (unsigned)((h16 >> 1) * DSA_PAIRB + (h16 & 1) * 512 + 32 * g);
    const int trow = (h16 >> 1) < 4 ? 4 * g + (h16 >> 1) : 16 + 4 * g + ((h16 >> 1) - 4);
    const unsigned pv_off = (unsigned)((trow >> 1) * DSA_PAIRB + (trow & 1) * 512 + 8 * (h16 & 1));
    glds16(IDX + (size_t)DSA_TOK(0) * 256 + (lane & 31) * 8 + (lane >> 5) * 256, (unsigned)__builtin_amdgcn_readfirstlane((int)ib0));
    for (int it = 0; it < ntok; ++it) {
        LAS unsigned short* idxs = (LAS unsigned short*)(wl + 16 * DSA_PAIRB + (it & 1) * 1024);
        const int t = DSA_TOK(it); const int tpos = t & (SEQ - 1);
        const int n = (tpos >> 6) >= 3 ? 256 : 64 * ((tpos >> 6) + 1); const int nst = n >> 5;
        const unsigned char* Cb = C8 + (size_t)(t >> 12) * SEQ * 512;
        int ln = lane; asm volatile("" : "+v"(ln));
        const int h16b = ln & 15, gb = ln >> 4;
        if (it + 1 < ntok) glds16(IDX + (size_t)DSA_TOK(it + 1) * 256 + (ln & 31) * 8 + (ln >> 5) * 256, (unsigned)__builtin_amdgcn_readfirstlane((int)(ib0 + ((it + 1) & 1) * 1024)));
        pg8::v8i_t qf[4];
        { const unsigned char* qp = (const unsigned char*)QL + (size_t)t * 8192 + (h16b & 7) * 512 + 32 * gb;
#pragma unroll
          for (int s = 0; s < 4; ++s) { const v4u lo = __builtin_nontemporal_load((const GAS v4u*)(qp + 128 * s)), hi = __builtin_nontemporal_load((const GAS v4u*)(qp + 128 * s + 16));
              qf[s] = (pg8::v8i_t){(int)lo.x, (int)lo.y, (int)lo.z, (int)lo.w, (int)hi.x, (int)hi.y, (int)hi.z, (int)hi.w}; } }
        unsigned pf = 0u;
        if (it + 1 < ntok) { const int tn = DSA_TOK(it + 1);
            const unsigned char* pa = (const unsigned char*)QL + (size_t)tn * 8192 + (ln & 31) * 128;
            asm volatile("global_load_dword %0, %1, off" : "=&v"(pf) : "v"(pa) : "memory"); }
        f32x4 o[32];
#pragma unroll
        for (int blk = 0; blk < 32; ++blk) o[blk] = (f32x4){0.f, 0.f, 0.f, 0.f};
        float mrun = -INFINITY, lrun = 0.f;
        asm volatile("s_waitcnt lgkmcnt(0)" ::: "memory");
#define DSA_GATHER(IDXS_, CB_, ST_) do { const LAS v4u* ip4 = (const LAS v4u*)((IDXS_) + (ST_) * 32); \
              const v4u q0 = ip4[0], q1 = ip4[1], q2 = ip4[2], q3 = ip4[3]; \
              const unsigned iw[16] = {q0.x, q0.y, q0.z, q0.w, q1.x, q1.y, q1.z, q1.w, q2.x, q2.y, q2.z, q2.w, q3.x, q3.y, q3.z, q3.w}; \
              const unsigned sh = (unsigned)(ln >> 5) * 16u, lo16 = (unsigned)(ln & 31) * 16u; \
              unsigned vo[16]; \
              _Pragma("unroll") for (int i = 0; i < 16; ++i) vo[i] = ((iw[i] >> sh) & 0xffffu) * 512u + lo16; \
              glds16s_x16((CB_), vo, (unsigned)__builtin_amdgcn_readfirstlane((int)wl0)); } while (0)
        if (it == 0) { asm volatile("s_waitcnt vmcnt(0)" ::: "memory"); DSA_GATHER(idxs, Cb, nst - 1); }
        asm volatile("s_waitcnt vmcnt(16)" : "+v"(qf[0]), "+v"(qf[1]), "+v"(qf[2]), "+v"(qf[3]) :: "memory");
        asm volatile("" :: "v"(pf));
        for (int k = 0; k < nst; ++k) { const int st = nst - 1 - k;
            asm volatile("s_waitcnt vmcnt(8)" ::: "memory");
            f32x4 a0 = {0.f, 0.f, 0.f, 0.f}, a1 = {0.f, 0.f, 0.f, 0.f};
#pragma unroll
            for (int s = 0; s < 4; ++s) {
                const pg8::v4i_t x0 = *(const LAS pg8::v4i_t*)(wl + qk_off + 128 * s), x1 = *(const LAS pg8::v4i_t*)(wl + qk_off + 128 * s + 16);
                a0 = __builtin_amdgcn_mfma_scale_f32_16x16x128_f8f6f4(__builtin_shufflevector(x0, x1, 0, 1, 2, 3, 4, 5, 6, 7), qf[s], a0, 0, 0, 0, 0x7f7f7f7f, 0, 0x7f7f7f7f); }
            asm volatile("s_waitcnt vmcnt(0)" ::: "memory");
#pragma unroll
            for (int s = 0; s < 4; ++s) {
                const pg8::v4i_t y0 = *(const LAS pg8::v4i_t*)(wl + qk_off + 8 * DSA_PAIRB + 128 * s), y1 = *(const LAS pg8::v4i_t*)(wl + qk_off + 8 * DSA_PAIRB + 128 * s + 16);
                a1 = __builtin_amdgcn_mfma_scale_f32_16x16x128_f8f6f4(__builtin_shufflevector(y0, y1, 0, 1, 2, 3, 4, 5, 6, 7), qf[s], a1, 0, 0, 0, 0x7f7f7f7f, 0, 0x7f7f7f7f); }
            const v2u i0 = *(const LAS v2u*)(idxs + st * 32 + 4 * g), i1 = *(const LAS v2u*)(idxs + st * 32 + 16 + 4 * g);
            const int sidx[8] = {(int)(i0.x & 0xffffu), (int)(i0.x >> 16), (int)(i0.y & 0xffffu), (int)(i0.y >> 16), (int)(i1.x & 0xffffu), (int)(i1.x >> 16), (int)(i1.y & 0xffffu), (int)(i1.y >> 16)};
            float lg[8];
#pragma unroll
            for (int r = 0; r < 8; ++r) { const int d = tpos - sidx[r]; lg[r] = (r < 4 ? a0[r & 3] : a1[r & 3]) * sc2 - sl2 * (float)(d < 0 ? -d : d); }
            float rm = fmaxf(fmaxf(fmaxf(lg[0], lg[1]), fmaxf(lg[2], lg[3])), fmaxf(fmaxf(lg[4], lg[5]), fmaxf(lg[6], lg[7])));
            { const auto r1 = __builtin_amdgcn_permlane16_swap(__float_as_uint(rm), __float_as_uint(rm), false, false); rm = fmaxf(__uint_as_float(r1[0]), __uint_as_float(r1[1])); }
            rm = xhalf_max(rm);
            const float mn = fmaxf(mrun, rm), f = __builtin_amdgcn_exp2f(mrun - mn); mrun = mn;
#pragma unroll
            for (int r = 0; r < 8; ++r) lg[r] = __builtin_amdgcn_exp2f(lg[r] - mn) * DSA_PS;
            const unsigned pw0 = pg8::pk4_fp8(lg[0], lg[1], lg[2], lg[3]), pw1 = pg8::pk4_fp8(lg[4], lg[5], lg[6], lg[7]);
            { const float ps = ((__builtin_amdgcn_cvt_f32_fp8((int)pw0, 0) + __builtin_amdgcn_cvt_f32_fp8((int)pw0, 1)) + (__builtin_amdgcn_cvt_f32_fp8((int)pw0, 2) + __builtin_amdgcn_cvt_f32_fp8((int)pw0, 3)))
                           + ((__builtin_amdgcn_cvt_f32_fp8((int)pw1, 0) + __builtin_amdgcn_cvt_f32_fp8((int)pw1, 1)) + (__builtin_amdgcn_cvt_f32_fp8((int)pw1, 2) + __builtin_amdgcn_cvt_f32_fp8((int)pw1, 3)));
              lrun = lrun * f + ps; }
            const long pw = (long)(((unsigned long)pw1 << 32) | (unsigned long)pw0);
            if (__any(f != 1.f)) {
#pragma unroll
                for (int blk = 0; blk < 32; ++blk) o[blk] = o[blk] * f; }
            { v2i_t av[2][4];
#pragma unroll
              for (int i = 0; i < 4; ++i) av[0][i] = __builtin_amdgcn_ds_read_tr8_b64_v2i32((LAS v2i_t*)(wl + pv_off + 16 * i));
#pragma unroll
              for (int grp = 0; grp < 8; ++grp) {
                  if (grp < 7) {
#pragma unroll
                      for (int i = 0; i < 4; ++i) av[(grp + 1) & 1][i] = __builtin_amdgcn_ds_read_tr8_b64_v2i32((LAS v2i_t*)(wl + pv_off + 16 * (4 * grp + 4 + i))); }
                  __builtin_amdgcn_sched_barrier(0);
#pragma unroll
                  for (int i = 0; i < 4; ++i) { const v2i_t a_ = av[grp & 1][i];
                      const long al = (long)(((unsigned long)(unsigned)a_.y << 32) | (unsigned long)(unsigned)a_.x);
                      o[4 * grp + i] = __builtin_amdgcn_mfma_f32_16x16x32_fp8_fp8(al, pw, o[4 * grp + i], 0, 0, 0); }
                  __builtin_amdgcn_sched_barrier(0);
              } }
            asm volatile("s_waitcnt lgkmcnt(0)" ::: "memory");
            if (k + 1 < nst) DSA_GATHER(idxs, Cb, st - 1);
            else if (it + 1 < ntok) { const int tn = DSA_TOK(it + 1), tpn = tn & (SEQ - 1); const int nn = (tpn >> 6) >= 3 ? 256 : 64 * ((tpn >> 6) + 1);
                DSA_GATHER((LAS unsigned short*)(wl + 16 * DSA_PAIRB + ((it + 1) & 1) * 1024), C8 + (size_t)(tn >> 12) * SEQ * 512, (nn >> 5) - 1); }
        }
#undef DSA_GATHER
        float lt = lrun; lt += __shfl_xor(lt, 16); lt += __shfl_xor(lt, 32);
        const float inv = 1.f / (lt * DSA_CS);
        if (h16 < 8) {
#pragma unroll
            for (int blk = 0; blk < 32; ++blk) { const f32x4 v = o[blk] * (inv * DSA_OS);
                __builtin_nontemporal_store(pg8::pk4_fp8(fminf(fmaxf(v.x, -448.f), 448.f), fminf(fmaxf(v.y, -448.f), 448.f), fminf(fmaxf(v.z, -448.f), 448.f), fminf(fmaxf(v.w, -448.f), 448.f)),
                                            (GAS unsigned*)((unsigned char*)OL + (size_t)(t & omask) * 8192 + h16b * 512 + 16 * blk + 4 * gb)); } }
    }
    asm volatile("s_waitcnt vmcnt(0) lgkmcnt(0)" ::: "memory");
    __syncthreads();
#undef DSA_TOK
}
static_assert(DSA_LDS_END <= RING_BYTES, "DSA LDS map");

__device__ __forceinline__ void memattn_mfma(LAS unsigned char* lds, const bf16* QM, const bf16* KV, bf16* OM, int vcu, int G, const int wave) {
    const int lane = lane_fresh(), r32 = lane & 31, hi = lane >> 5;
    const unsigned voff = (unsigned)(65536 + (4 * hi + ((lane & 15) >> 2)) * 64 + ((lane >> 4) & 1) * 32 + (lane & 3) * 8);
    for (int j = vcu; j < 256; j += G) {
        const int bh = j >> 4, qb = j & 15, b = bh >> 2, h = bh & 3;
        const bf16* Kg = KV + (size_t)b * MEMT * 1024 + h * 128; const bf16* Vg = Kg + 512;
#pragma unroll
        for (int i = 0; i < 8; ++i) { const int q = 8 * wave + i;
            glds16(Kg + (size_t)(64 * (q & 3) + lane) * 1024 + (q >> 2) * 8, (unsigned)__builtin_amdgcn_readfirstlane((int)((unsigned)(uintptr_t)lds + ((q >> 2) * 256 + 64 * (q & 3)) * 16)));
            glds16(Vg + (size_t)(16 * (q & 15) + (lane >> 2)) * 1024 + (q >> 4) * 32 + (lane & 3) * 8, (unsigned)__builtin_amdgcn_readfirstlane((int)((unsigned)(uintptr_t)lds + 65536 + (q >> 4) * 16384 + (q & 15) * 1024))); }
        const size_t qrow = (size_t)b * SEQ + qb * 256 + wave * 32 + r32;
        bf16x8 qr[8];
#pragma unroll
        for (int s = 0; s < 8; ++s) { const v4u qa = *(const GAS v4u*)(QM + qrow * 512 + h * 128 + s * 16 + hi * 8), qb_ = *(const GAS v4u*)(QM + (size_t)M * 512 + qrow * 512 + h * 128 + s * 16 + hi * 8);
            const v4u qs = {cvtpk(blo(qa.x) + blo(qb_.x), bhi(qa.x) + bhi(qb_.x)), cvtpk(blo(qa.y) + blo(qb_.y), bhi(qa.y) + bhi(qb_.y)), cvtpk(blo(qa.z) + blo(qb_.z), bhi(qa.z) + bhi(qb_.z)), cvtpk(blo(qa.w) + blo(qb_.w), bhi(qa.w) + bhi(qb_.w))};
            qr[s] = __builtin_bit_cast(bf16x8, qs); }
        f32x16 o[4];
#pragma unroll
        for (int blk = 0; blk < 4; ++blk)
#pragma unroll
            for (int r = 0; r < 16; ++r) o[blk][r] = 0.f;
        float mrun = -INFINITY, lrun = 0.f;
        asm volatile("s_waitcnt vmcnt(0) lgkmcnt(0)\n\ts_barrier" ::: "memory");
        for (int kt = 0; kt < 4; ++kt) {
            const LAS unsigned char* Kb = lds + (unsigned)((hi * 256 + 64 * kt + r32) * 16);
            f32x16 p0, p1;
#pragma unroll
            for (int r = 0; r < 16; ++r) { p0[r] = 0.f; p1[r] = 0.f; }
#pragma unroll
            for (int s = 0; s < 8; ++s) { const bf16x8 k0 = *(const LAS bf16x8*)(Kb + s * 8192), k1 = *(const LAS bf16x8*)(Kb + s * 8192 + 512);
                p0 = __builtin_amdgcn_mfma_f32_32x32x16_bf16(k0, qr[s], p0, 0, 0, 0); p1 = __builtin_amdgcn_mfma_f32_32x32x16_bf16(k1, qr[s], p1, 0, 0, 0); }
            float rm = -INFINITY;
#pragma unroll
            for (int r = 0; r < 16; ++r) rm = fmaxf(rm, fmaxf(p0[r], p1[r]));
            rm = fmaxf(rm, xhalf_f(rm));
            if (__any(rm > mrun)) { const float mn = fmaxf(mrun, rm), f = __builtin_amdgcn_exp2f(mrun - mn); mrun = mn; lrun *= f;
#pragma unroll
                for (int blk = 0; blk < 4; ++blk)
#pragma unroll
                    for (int r = 0; r < 16; ++r) o[blk][r] *= f; }
            float ls = 0.f;
#pragma unroll
            for (int r = 0; r < 16; ++r) { p0[r] = __builtin_amdgcn_exp2f(p0[r] - mrun); p1[r] = __builtin_amdgcn_exp2f(p1[r] - mrun); ls += p0[r] + p1[r]; }
            lrun += ls;
            bf16x8 pw[4];
#pragma unroll
            for (int s = 0; s < 2; ++s) {
                v4u a = {cvtpk(p0[8 * s + 0], p0[8 * s + 1]), cvtpk(p0[8 * s + 2], p0[8 * s + 3]), cvtpk(p0[8 * s + 4], p0[8 * s + 5]), cvtpk(p0[8 * s + 6], p0[8 * s + 7])};
                v4u c = {cvtpk(p1[8 * s + 0], p1[8 * s + 1]), cvtpk(p1[8 * s + 2], p1[8 * s + 3]), cvtpk(p1[8 * s + 4], p1[8 * s + 5]), cvtpk(p1[8 * s + 6], p1[8 * s + 7])};
                pw[s] = __builtin_bit_cast(bf16x8, a); pw[2 + s] = __builtin_bit_cast(bf16x8, c); }
            const LAS unsigned char* Vb = lds + voff + kt * 4096;
#pragma unroll
            for (int blk = 0; blk < 4; ++blk) {
#pragma unroll
                for (int s = 0; s < 4; ++s) {
                    const v4i16_t lo = lds_tr16(Vb + blk * 16384 + s * 1024), hh = lds_tr16(Vb + blk * 16384 + s * 1024 + 512);
                    const bf16x8 vf = {lo[0], lo[1], lo[2], lo[3], hh[0], hh[1], hh[2], hh[3]};
                    o[blk] = __builtin_amdgcn_mfma_f32_32x32x16_bf16(vf, pw[s], o[blk], 0, 0, 0);
                }
            }
        }
        __syncthreads();
        lrun += xhalf_f(lrun);
        const float inv = 1.f / lrun;
        LAS unsigned* stg = (LAS unsigned*)(lds) + wave * (32 * 33);
        const float is = inv * FP8_OMS;
#pragma unroll
        for (int blk = 0; blk < 4; ++blk)
#pragma unroll
            for (int r = 0; r < 16; r += 4) { const int e = 32 * blk + 8 * (r >> 2) + 4 * hi;
                stg[r32 * 33 + (e >> 2)] = pg8::pk4_fp8(fminf(fmaxf(o[blk][r] * is, -448.f), 448.f), fminf(fmaxf(o[blk][r + 1] * is, -448.f), 448.f), fminf(fmaxf(o[blk][r + 2] * is, -448.f), 448.f), fminf(fmaxf(o[blk][r + 3] * is, -448.f), 448.f)); }
        LDS_WAIT(); asm volatile("" ::: "memory");
        unsigned char* orow = (unsigned char*)OM + ((size_t)b * SEQ + qb * 256 + wave * 32) * 512 + h * 128;
#pragma unroll 4
        for (int row = 0; row < 32; row += 2) *((GAS unsigned*)(orow + (size_t)(row + hi) * 512) + r32) = stg[(row + hi) * 33 + r32];
        __syncthreads();
    }
}

constexpr int N_PHASES = 21;
struct Args { const float* in[24]; float* out; unsigned char* ws; int ph_lo, ph_hi; };
__global__ void __launch_bounds__(NWAVES * 64, 2) mk_fwd(Args args) {
    extern __shared__ __attribute__((aligned(16))) unsigned char lds_raw[];
    LAS unsigned char* lds = (LAS unsigned char*)lds_raw;
    volatile LAS unsigned* MISC = (volatile LAS unsigned*)(lds + MISC_OFF);
    const int tid = threadIdx.x, wave = __builtin_amdgcn_readfirstlane(tid >> 6);
#define lane lane_fresh()
    const int G = gridDim.x; int bx = blockIdx.x;
    int vcu = (G % 8 == 0) ? (bx % 8) * (G / 8) + bx / 8 : bx;
    int gw = vcu * NWAVES + wave; const int NGW = G * NWAVES;
    unsigned char* ws = args.ws;
    gu32* ctl = (gu32*)(ws + WS_CTL);
    for (int u = tid; u < (LDS_BYTES - LDSCTL_OFF) / 4; u += NWAVES * 64) ((LAS unsigned*)(lds + LDSCTL_OFF))[u] = 0u;
    __syncthreads();
    const bool one = (args.ph_hi - args.ph_lo) > 1;
    XcdBarrier bar; bar.bar = (unsigned*)(ctl + CW_BAR); bar.x = 0; bar.st = nullptr;
    if (one) bar = xcd_barrier_post((unsigned*)(ctl + CW_BAR), MISC + 8, tid == 0);
    const int lo = args.ph_lo, hi = args.ph_hi;
#ifndef PH_MASK
#define PH_MASK 0xFFFFFFFFu
#endif
#define IN(k) ((((PH_MASK) >> (k)) & 1u) && lo <= (k) && (k) < hi)
#define SEAM(k) do { if (IN(k) && IN((k) + 1)) xcd_barrier(bar, wave); } while (0)
    bf16* const X16 = (bf16*)(ws + WS_X16); bf16* const HB = (bf16*)(ws + WS_H);
    long long* const ST0 = (long long*)(ws + WS_CTL + CTL_STATS); long long* const ST1 = (long long*)(ws + WS_CTL + CTL_STATS + CTL_STATS_STRIDE); long long* const ST2 = (long long*)(ws + WS_CTL + CTL_STATS + 2 * CTL_STATS_STRIDE);
    const float* const VEC = (const float*)(ws + WS_CTL + CTL_VECF);
    float* const out = args.out;
    const float* const ln_g = args.in[22]; const float* const ln_b = args.in[23];
    using namespace pg8;

#ifdef PROBE_P0
    if (IN(0)) { p0_prologue(args.in, ws, lds, gw, NGW, wave, lane); }
#endif
    if (IN(0)) { p0_prologue(args.in, ws, lds, gw, NGW, wave, lane); }
    SEAM(0);
    if (one && IN(0) && (G % 8) == 0) {
        unsigned* xb = (unsigned*)(ctl + CW_BAR); bool even = true;
#pragma unroll
        for (int jx = 0; jx < 16; ++jx) { const unsigned c = xb_ld(&xb[XB_XCNT(jx)]); even = even && (jx < 8 ? c == (unsigned)(G / 8) : c == 0u); }
        const int rank = (int)MISC[10], xcc = (int)xb_xcc_id();
        if (__builtin_amdgcn_readfirstlane(even ? 1 : 0)) { vcu = __builtin_amdgcn_readfirstlane(xcc * (G / 8) + rank); bx = __builtin_amdgcn_readfirstlane(rank * 8 + xcc); gw = vcu * NWAVES + wave; }
    }
    if (IN(1)) { { const long long* vi = (const long long*)(ws + WS_CTL + CTL_VEC); float* vf = (float*)(ws + WS_CTL + CTL_VECF); for (int i = gw * 64 + lane; i < V_END; i += NGW * 64) vf[i] = (float)vi[i] * (1.0f / 16777216.f); }
        Gemm g{(const bf16*)(ws + WS_X8), (const bf16*)(ws + WS_W_GU1), D / 2, D / 2, D / 2, 0, 0}; StaticOrder S; S.init(M, 2 * FF, G, bx); EpiSwiGLU8 E{(unsigned char*)HB, FF, 1.0f / (FP8_XS * FP8_WGUS), FP8_HS, LnFold{nullptr, nullptr, nullptr}};
        gemm_phase<EpiSwiGLU8, StaticOrder, true, true>(lds + RING_OFF, g, S, E, wave); }
    SEAM(1);
    if (IN(2)) { Gemm g{HB, (const bf16*)(ws + WS_W_D1), FF / 2, FF / 2, FF / 2, 0, 0}; StaticOrder S; S.init(M, D, G, bx); EpiRes<true> E{args.in[0], nullptr, D, ALPHA, 0.5f / (FP8_HS * FP8_WDS), nullptr, nullptr, nullptr, ST0, X16, (unsigned char*)(ws + WS_X8M), FP8_XS};
        gemm_phase<EpiRes<true>, StaticOrder, true, true>(lds + RING_OFF, g, S, E, wave); }
    SEAM(2);
    if (IN(4)) {
        const bool sp4 = (G == 256);
        { Gemm g{(const bf16*)(ws + WS_X8M), (const bf16*)(ws + WS_W_IN8), D / 2, D / 2, D / 2, 0, 0}; StaticOrder S; S.init(M, N_IN8, sp4 ? 168 : G, sp4 ? (bx < 168 ? bx : (1 << 20)) : bx);
          EpiInProj E{(bf16*)(ws + WS_AQ), (bf16*)(ws + WS_AK), (bf16*)(ws + WS_AV), (bf16*)(ws + WS_BQ), (bf16*)(ws + WS_BC), (bf16*)(ws + WS_IQ), (bf16*)(ws + WS_IKW), QSCALE, LnFold{ST0, VEC + V_GW_IN, VEC + V_BW_IN}, (unsigned*)(ctl + CW_KMAX), 0, 1.0f / (FP8_XS * FP8_WGS)};
          gemm_phase<EpiInProj, StaticOrder, true, true>(lds + RING_OFF, g, S, E, wave); }
        { Gemm g{X16, (const bf16*)(ws + WS_W_INB), D, D, D, 0, 0}; StaticOrder S; S.init(M, N_INB, sp4 ? 88 : G, sp4 ? (bx >= 168 ? bx - 168 : (1 << 20)) : ((G % 16 == 0) ? (bx + G / 2) % G : bx));
          EpiInProj E{(bf16*)(ws + WS_AQ), (bf16*)(ws + WS_AK), (bf16*)(ws + WS_AV), (bf16*)(ws + WS_BQ), (bf16*)(ws + WS_BC), (bf16*)(ws + WS_IQ), (bf16*)(ws + WS_IKW), QSCALE, LnFold{ST0, VEC + V_GW_IN, VEC + V_BW_IN}, (unsigned*)(ctl + CW_KMAX), N_IN8 / 256, 1.0f};
          gemm_phase<EpiInProj, StaticOrder, true>(lds + RING_OFF, g, S, E, wave); }
        { Gemm g{(const bf16*)(ws + WS_MEM16), (const bf16*)(ws + WS_W_MKV), D, D, D, 0, 0}; StaticOrder S; S.init(BATCH * MEMT, 1024, sp4 ? 16 : G, sp4 ? ((bx >= 224 && bx < 240) ? bx - 224 : (1 << 20)) : (bx >= G - 16 ? bx - (G - 16) : (1 << 20))); EpiBf16 E{(bf16*)(ws + WS_KVMEM), 1024};
          gemm_phase<EpiBf16, StaticOrder, true>(lds + RING_OFF, g, S, E, wave); }
    }
    SEAM(4);
    if (IN(5)) {
        { Gemm g{(const bf16*)(ws + WS_BQ), (const bf16*)(ws + WS_W_UK), 1024, 128, 128, 1, 128}; StaticOrder S; S.init(M, 4096, G, bx); EpiFp8 E{(unsigned char*)(ws + WS_QLAT), 8192, DSA_QS};
          gemm_phase<EpiFp8, StaticOrder, true>(lds + RING_OFF, g, S, E, wave); }
        crms_phase((const bf16*)(ws + WS_BC), (unsigned char*)(ws + WS_C8), args.in[8], DSA_CS, gw, NGW, lane);
    }
    if (IN(7)) indexer_topk(lds, (const bf16*)(ws + WS_IQ), (const bf16*)(ws + WS_IKW), (unsigned short*)(ws + WS_IDX), vcu, G, wave);
    if (IN(7)) diff_attn_mfma(lds, (const bf16*)(ws + WS_AQ), (const bf16*)(ws + WS_AK), (const bf16*)(ws + WS_AV), (bf16*)(ws + WS_YA8), args.in[6], args.in[7], (unsigned*)(ctl + CW_DQ), (const unsigned*)(ctl + CW_KMAX), wave);
    SEAM(7);
    if (IN(8)) dsa_mfma(lds, (const bf16*)(ws + WS_QLAT), (bf16*)(ws + WS_QLAT), 0x7fffffff, (const unsigned char*)(ws + WS_C8), (const unsigned short*)(ws + WS_IDX), vcu, G, wave);
    SEAM(8);
    if (IN(9)) { Gemm g{(const bf16*)(ws + WS_QLAT), (const bf16*)(ws + WS_W_UVP), 4096, 512, 512, 0, 512}; StaticOrder S; S.init(M, 1024, G, bx); EpiFp8 E{(unsigned char*)(ws + WS_YB), 1024, FP8_YS / (DSA_OS * FP8_WUVS)};
        gemm_phase<EpiFp8, StaticOrder, true, true>(lds + RING_OFF, g, S, E, wave); }
    SEAM(9);
    if (IN(10)) {
        { Gemm g{(const bf16*)(ws + WS_YA8), (const bf16*)(ws + WS_W_A), 512, 512, 512, 0, 0}; StaticOrder S; S.init(M, D, G, bx); EpiBf16 E{(bf16*)(ws + WS_TA), D, 1.0f / (FP8_YAS * FP8_WAS)}; gemm_phase<EpiBf16, StaticOrder, true, true>(lds + RING_OFF, g, S, E, wave); }
        { Gemm g{(const bf16*)(ws + WS_YB), (const bf16*)(ws + WS_W_B), 512, 512, 512, 0, 0}; StaticOrder S; S.init(M, D, G, bx); EpiBf16 E{(bf16*)(ws + WS_TB), D, 1.0f / (FP8_YS * FP8_WBS)}; gemm_phase<EpiBf16, StaticOrder, true, true>(lds + RING_OFF, g, S, E, wave); }
    }
    SEAM(10);
    if (IN(11)) { Gemm g{(const bf16*)(ws + WS_X8M), (const bf16*)(ws + WS_W_G), D / 2, D / 2, D / 2, 0, 0}; StaticOrder S; S.init(M, 2 * D, G, bx);
        EpiGateMerge8 E{(const bf16*)(ws + WS_TA), (const bf16*)(ws + WS_TB), (unsigned char*)(ws + WS_MRG8), D, args.in[12], args.in[12] + D, 1.0f / (FP8_XS * FP8_WGS), FP8_MS, LnFold{ST0, VEC + V_GW_G, VEC + V_BW_G}};
        gemm_phase<EpiGateMerge8, StaticOrder, true, true>(lds + RING_OFF, g, S, E, wave); }
    SEAM(11);
    if (IN(12)) { Gemm g{(const bf16*)(ws + WS_MRG8), (const bf16*)(ws + WS_W_MO), D / 2, D / 2, D / 2, 0, 0}; StaticOrder S; S.init(M, D, G, bx); EpiRes<false, 1> E{nullptr, X16, D, ALPHA, 1.0f / (FP8_MS * FP8_WMOS), ST0, ln_g, ln_b, ST1, X16, nullptr, 0.f};
        gemm_phase<EpiRes<false, 1>, StaticOrder, true, true>(lds + RING_OFF, g, S, E, wave); }
    SEAM(12);
    if (IN(14)) { Gemm g{X16, (const bf16*)(ws + WS_W_MQ), D, D, D / 2, 1, D / 2, 2, D / 2}; StaticOrder S; S.init(M, 1024, G, bx);
        EpiBf16S E{(bf16*)(ws + WS_QM), (size_t)M * 512, 0.08838834764831845f * LOG2E, LnFold{ST1, VEC + V_GW_MQ, VEC + V_BW_MQ}}; gemm_phase<EpiBf16S, StaticOrder, true>(lds + RING_OFF, g, S, E, wave); }
    SEAM(14);
    if (IN(15)) memattn_mfma(lds, (const bf16*)(ws + WS_QM), (const bf16*)(ws + WS_KVMEM), (bf16*)(ws + WS_OM), vcu, G, wave);
    SEAM(15);
    if (IN(16)) { Gemm g{(const bf16*)(ws + WS_OM), (const bf16*)(ws + WS_W_MOUT), 256, 256, 256, 0, 0}; StaticOrder S; S.init(M, D, G, bx); EpiRes<false> E{nullptr, X16, D, ALPHA, 1.0f / (FP8_OMS * FP8_WMOUTS), ST1, ln_g + D, ln_b + D, ST2, X16, (unsigned char*)(ws + WS_X8), FP8_XS};
        gemm_phase<EpiRes<false>, StaticOrder, true, true>(lds + RING_OFF, g, S, E, wave); }
    SEAM(16);
    if (IN(18)) { Gemm g{(const bf16*)(ws + WS_X8), (const bf16*)(ws + WS_W_GU2), D / 2, D / 2, D / 2, 0, 0}; StaticOrder S; S.init(M, 2 * FF, G, bx); EpiSwiGLU8 E{(unsigned char*)HB, FF, 1.0f / (FP8_XS * FP8_WGUS), FP8_HS, LnFold{ST2, VEC + V_GW_GU2, VEC + V_BW_GU2}};
        gemm_phase<EpiSwiGLU8, StaticOrder, true, true>(lds + RING_OFF, g, S, E, wave); }
    SEAM(18);
    if (IN(19)) { Gemm g{HB, (const bf16*)(ws + WS_W_D2), FF / 2, FF / 2, FF / 2, 0, 0}; StaticOrder S; S.init(M, D, G, bx); EpiRes<false> E{nullptr, X16, D, ALPHA, 0.5f / (FP8_HS * FP8_WDS), ST2, ln_g + 2 * D, ln_b + 2 * D, nullptr, X16, nullptr, 0.f};
        gemm_phase<EpiRes<false>, StaticOrder, true, true>(lds + RING_OFF, g, S, E, wave); }
    SEAM(19);
    if (IN(20)) ln_final_phase(X16, out, ln_g + 3 * D, ln_b + 3 * D, gw, NGW, lane);
#undef IN
#undef SEAM
#undef lane
}

extern "C" void kernel_launch(void* const* d_in, const int* in_sizes, int n_in, void* d_out, int out_size, void* d_ws, size_t ws_size, hipStream_t stream) {
    static int grid = 0;
    if (grid == 0) {
        if (n_in != 24 || in_sizes[0] != M * D || out_size != M * D || ws_size < WS_END) { fprintf(stderr, "kernel_launch: unexpected shapes (n_in %d, in0 %d, out %d, ws %zu); nothing launched\n", n_in, n_in > 0 ? in_sizes[0] : -1, out_size, ws_size); grid = -1; return; }
        int dev = 0, cus = 0, per_cu = 0;
        if (hipGetDevice(&dev) != hipSuccess || hipDeviceGetAttribute(&cus, hipDeviceAttributeMultiprocessorCount, dev) != hipSuccess) { grid = -1; return; }
        if (hipFuncSetAttribute((const void*)mk_fwd, hipFuncAttributeMaxDynamicSharedMemorySize, LDS_BYTES) != hipSuccess) { fprintf(stderr, "kernel_launch: hipFuncSetAttribute failed\n"); grid = -1; return; }
        if (hipOccupancyMaxActiveBlocksPerMultiprocessor(&per_cu, (const void*)mk_fwd, NWAVES * 64, LDS_BYTES) != hipSuccess || per_cu < 1)
            fprintf(stderr, "kernel_launch: note: the occupancy query reports %d workgroups per CU\n", per_cu);
        (void)hipGetLastError();
        grid = cus;
    }
    if (grid < 0) return;
    if (hipMemsetAsync((char*)d_ws + WS_CTL, 0, CTL_ZERO_BYTES, stream) != hipSuccess) return;
    Args a{};
    for (int i = 0; i < 24; ++i) a.in[i] = (const float*)d_in[i];
    a.out = (float*)d_out; a.ws = (unsigned char*)d_ws;
#if MK_ONE_LAUNCH
    a.ph_lo = 0; a.ph_hi = N_PHASES;
    hipLaunchKernelGGL(mk_fwd, dim3(grid), dim3(NWAVES * 64), LDS_BYTES, stream, a);
#else
    for (int p = 0; p < N_PHASES; ++p) { a.ph_lo = p; a.ph_hi = p + 1; hipLaunchKernelGGL(mk_fwd, dim3(grid), dim3(NWAVES * 64), LDS_BYTES, stream, a); }
#endif
}
```

```cpp
#include <hip/hip_runtime.h>
#include <cstdio>
#include <cstdint>

#ifndef MK_ONE_LAUNCH
#define MK_ONE_LAUNCH 1
#endif

__device__ __forceinline__ int lane_fresh() { int l = (int)__builtin_amdgcn_mbcnt_hi(~0u, __builtin_amdgcn_mbcnt_lo(~0u, 0u)); asm volatile("" : "+v"(l)); return l; }
__device__ __forceinline__ void glds16(const void* gsrc, unsigned lds_dst) { unsigned keep;
    asm volatile("s_mov_b32 %0, m0\n\ts_mov_b32 m0, %2\n\ts_nop 0\n\tglobal_load_lds_dwordx4 %1, off\n\ts_mov_b32 m0, %0" : "=&s"(keep) : "v"(gsrc), "s"(lds_dst) : "memory"); }
__device__ __forceinline__ void glds16s(const void* sbase, unsigned voff, unsigned lds_dst) { unsigned keep;
    asm volatile("s_mov_b32 %0, m0\n\ts_mov_b32 m0, %3\n\ts_nop 0\n\tglobal_load_lds_dwordx4 %1, %2\n\ts_mov_b32 m0, %0" : "=&s"(keep) : "v"(voff), "s"(sbase), "s"(lds_dst) : "memory"); }
__device__ __forceinline__ void glds16s_x16(const void* sbase, const unsigned (&v)[16], unsigned lds_dst0) { unsigned keep;
    asm volatile("s_mov_b32 %0, m0\n\ts_mov_b32 m0, %18\n\ts_nop 0\n\t"
        "global_load_lds_dwordx4 %1, %17\n\ts_add_u32 m0, m0, 1040\n\ts_nop 0\n\t"
        "global_load_lds_dwordx4 %2, %17\n\ts_add_u32 m0, m0, 1040\n\ts_nop 0\n\t"
        "global_load_lds_dwordx4 %3, %17\n\ts_add_u32 m0, m0, 1040\n\ts_nop 0\n\t"
        "global_load_lds_dwordx4 %4, %17\n\ts_add_u32 m0, m0, 1040\n\ts_nop 0\n\t"
        "global_load_lds_dwordx4 %5, %17\n\ts_add_u32 m0, m0, 1040\n\ts_nop 0\n\t"
        "global_load_lds_dwordx4 %6, %17\n\ts_add_u32 m0, m0, 1040\n\ts_nop 0\n\t"
        "global_load_lds_dwordx4 %7, %17\n\ts_add_u32 m0, m0, 1040\n\ts_nop 0\n\t"
        "global_load_lds_dwordx4 %8, %17\n\ts_add_u32 m0, m0, 1040\n\ts_nop 0\n\t"
        "global_load_lds_dwordx4 %9, %17\n\ts_add_u32 m0, m0, 1040\n\ts_nop 0\n\t"
        "global_load_lds_dwordx4 %10, %17\n\ts_add_u32 m0, m0, 1040\n\ts_nop 0\n\t"
        "global_load_lds_dwordx4 %11, %17\n\ts_add_u32 m0, m0, 1040\n\ts_nop 0\n\t"
        "global_load_lds_dwordx4 %12, %17\n\ts_add_u32 m0, m0, 1040\n\ts_nop 0\n\t"
        "global_load_lds_dwordx4 %13, %17\n\ts_add_u32 m0, m0, 1040\n\ts_nop 0\n\t"
        "global_load_lds_dwordx4 %14, %17\n\ts_add_u32 m0, m0, 1040\n\ts_nop 0\n\t"
        "global_load_lds_dwordx4 %15, %17\n\ts_add_u32 m0, m0, 1040\n\ts_nop 0\n\t"
        "global_load_lds_dwordx4 %16, %17\n\ts_mov_b32 m0, %0"
        : "=&s"(keep) : "v"(v[0]), "v"(v[1]), "v"(v[2]), "v"(v[3]), "v"(v[4]), "v"(v[5]), "v"(v[6]), "v"(v[7]), "v"(v[8]), "v"(v[9]), "v"(v[10]), "v"(v[11]), "v"(v[12]), "v"(v[13]), "v"(v[14]), "v"(v[15]), "s"(sbase), "s"(lds_dst0) : "memory", "scc"); }
namespace pg8 {
#define PG8_LAS __attribute__((address_space(3)))
typedef unsigned short bf16_t;
typedef short bf16x8 __attribute__((ext_vector_type(8)));
typedef float f32x4 __attribute__((ext_vector_type(4)));
typedef unsigned u32x4 __attribute__((ext_vector_type(4)));
constexpr int BM = 256, BK = 64, HALF = 128, HTB = HALF * BK * 2  , STAGE_BYTES = 8 * HTB, NXCD = 8, WGM = 8;

__host__ __device__ __forceinline__ int lds_byte(int r, int c) { const int st = (r >> 4) * 2 + (c >> 5), rr = r & 15, cc = c & 31, ob = rr * 64 + cc * 2; return st * 1024 + (ob ^ (((ob >> 9) & 1) << 5)); }
__host__ __device__ __forceinline__ void stage_rc(int b, int& R, int& C) { const int st = b / 1024, sb = b % 1024, swz = sb ^ (((sb >> 9) & 1) << 5); R = (st >> 1) * 16 + swz / 64; C = (st & 1) * 32 + (swz % 64) / 2; }
__host__ __device__ __forceinline__ int perm32(int rho) { const int n = rho >> 4, i = rho & 15; return 8 * (i >> 2) + 4 * n + (i & 3); }

struct Unit { int pm, pn; };
struct Gemm { const bf16_t* A; const bf16_t* Bt; int lda, ldb, K, a_shift, a_mul; int b_wrap, b_kmul; };

struct StaticOrder {
    int nM, nN, nwg, G, c;
    __host__ __device__ void init(int M, int N, int G_, int c_) { nM = M / BM; nN = N / BM; nwg = nM * nN; G = G_; c = c_; }
    __host__ __device__ bool next(int i, Unit& u) const {
        const long L = (long)i * G + c; if (L >= nwg) return false;
        int wgid = (int)L; { const int q = nwg / NXCD, r = nwg % NXCD, xcd = wgid % NXCD, off = wgid / NXCD; wgid = (xcd < r ? xcd * (q + 1) : r * (q + 1) + (xcd - r) * q) + off; }
        const int nig = WGM * nN, gid = wgid / nig, fm = gid * WGM, gsz = (nM - fm) < WGM ? (nM - fm) : WGM;
        u.pm = fm + ((wgid % nig) % gsz); u.pn = (wgid % nig) / gsz; return true;
    }
    __device__ __forceinline__ void a_ready(const Unit&) const {}
    __device__ __forceinline__ void done(const Unit&) const {}
};

__device__ __forceinline__ unsigned cvt_pk_bf16(float lo, float hi) { unsigned r; asm volatile("v_cvt_pk_bf16_f32 %0, %1, %2" : "=v"(r) : "v"(lo), "v"(hi)); return r; }
__device__ __forceinline__ float bflo(unsigned w) { return __uint_as_float(w << 16); }
__device__ __forceinline__ float bfhi(unsigned w) { return __uint_as_float(w & 0xffff0000u); }
__device__ __forceinline__ float sigmoidf_fast(float x) { return __builtin_amdgcn_rcpf(1.0f + __builtin_amdgcn_exp2f(-1.4426950408889634f * x)); }

struct LnFold {
    const long long* stats; const float* gW; const float* bW;
    __device__ __forceinline__ void row(int r, float& mean, float& rstd) const { const long long s0 = stats[2 * (size_t)r], s1 = stats[2 * (size_t)r + 1];
        mean = (float)s0 * (1.0f / (1048576.f * 2048.0f)); rstd = __builtin_amdgcn_rsqf((float)s1 * (1.0f / (65536.f * 2048.0f)) - mean * mean + 1e-5f); }
    __device__ __forceinline__ f32x4 vec4(const float* v, int i) const { return *(const f32x4*)(v + i); }
    __device__ __forceinline__ void rows8(int row0, float (&mean)[8], float (&rstd)[8]) const {
#pragma unroll
        for (int hf = 0; hf < 2; ++hf) { long long s0[4], s1[4];
#pragma unroll
            for (int q = 0; q < 4; ++q) { const size_t r = (size_t)(row0 + hf * 128 + q * 16); s0[q] = stats[2 * r]; s1[q] = stats[2 * r + 1]; }
#pragma unroll
            for (int q = 0; q < 4; ++q) { const float mu = (float)s0[q] * (1.0f / (1048576.f * 2048.0f)); mean[4 * hf + q] = mu; rstd[4 * hf + q] = __builtin_amdgcn_rsqf((float)s1[q] * (1.0f / (65536.f * 2048.0f)) - mu * mu + 1e-5f); }
            asm volatile("" : "+v"(mean[4 * hf]), "+v"(mean[4 * hf + 1]), "+v"(mean[4 * hf + 2]), "+v"(mean[4 * hf + 3]), "+v"(rstd[4 * hf]), "+v"(rstd[4 * hf + 1]), "+v"(rstd[4 * hf + 2]), "+v"(rstd[4 * hf + 3]) :: "memory"); }
    }
};
struct EpiBf16 {
    static constexpr bool PERM = true, AFTER_DRAIN = false;
    bf16_t* O; int ldc; float sc = 1.0f; LnFold lf = {nullptr, nullptr, nullptr};
    __device__ __forceinline__ void operator()(const f32x4 (&acc)[2][2][4][2], const Unit& u, int wr, int wc, int fr, int fq) const {
        const int row0 = u.pm * BM + wr * 64 + fr, col0 = u.pn * BM + wc * 32 + 8 * fq;
        f32x4 gw[2][2], bw[2][2];
#pragma unroll
        for (int bj = 0; bj < 2; ++bj)
#pragma unroll
            for (int n = 0; n < 2; ++n) { gw[bj][n] = (f32x4){0.f, 0.f, 0.f, 0.f}; bw[bj][n] = (f32x4){0.f, 0.f, 0.f, 0.f}; if (lf.stats) { gw[bj][n] = lf.vec4(lf.gW, col0 + bj * HALF + 4 * n); bw[bj][n] = lf.vec4(lf.bW, col0 + bj * HALF + 4 * n); } }
        float mean8[8], rstd8[8];
#pragma unroll
        for (int q = 0; q < 8; ++q) { mean8[q] = 0.f; rstd8[q] = 1.f; }
        if (lf.stats) lf.rows8(row0, mean8, rstd8);
#pragma unroll
        for (int ai = 0; ai < 2; ++ai)
#pragma unroll
            for (int m = 0; m < 4; ++m) { bf16_t* rowp = O + (size_t)(row0 + ai * HALF + m * 16) * ldc + col0;
                const float mean = mean8[ai * 4 + m], rstd = rstd8[ai * 4 + m];
#pragma unroll
                for (int bj = 0; bj < 2; ++bj) { const f32x4 v0 = ((acc[ai][bj][m][0] - gw[bj][0] * mean) * rstd + bw[bj][0]) * sc, v1 = ((acc[ai][bj][m][1] - gw[bj][1] * mean) * rstd + bw[bj][1]) * sc;
                    u32x4 w; w.x = cvt_pk_bf16(v0[0], v0[1]); w.y = cvt_pk_bf16(v0[2], v0[3]); w.z = cvt_pk_bf16(v1[0], v1[1]); w.w = cvt_pk_bf16(v1[2], v1[3]);
                    *(u32x4*)(rowp + bj * HALF) = w; } }
    }
};
struct EpiBf16S {
    static constexpr bool PERM = true, AFTER_DRAIN = false;
    bf16_t* O; size_t pstride; float sc; LnFold lf;
    __device__ __forceinline__ void operator()(const f32x4 (&acc)[2][2][4][2], const Unit& u, int wr, int wc, int fr, int fq) const {
        const int part = u.pn >> 1, row0 = u.pm * BM + wr * 64 + fr, col0 = (u.pn & 1) * BM + wc * 32 + 8 * fq;
        const float fs = part ? 0.f : 1.f;
        f32x4 gw[2][2], bw[2][2];
#pragma unroll
        for (int bj = 0; bj < 2; ++bj)
#pragma unroll
            for (int n = 0; n < 2; ++n) { gw[bj][n] = lf.vec4(lf.gW, col0 + bj * HALF + 4 * n) * fs; bw[bj][n] = lf.vec4(lf.bW, col0 + bj * HALF + 4 * n) * fs; }
        float mean8[8], rstd8[8]; lf.rows8(row0, mean8, rstd8);
        bf16_t* Op = O + (size_t)part * pstride;
#pragma unroll
        for (int ai = 0; ai < 2; ++ai)
#pragma unroll
            for (int m = 0; m < 4; ++m) { bf16_t* rowp = Op + (size_t)(row0 + ai * HALF + m * 16) * 512 + col0;
                const float mean = mean8[ai * 4 + m], rstd = rstd8[ai * 4 + m];
#pragma unroll
                for (int bj = 0; bj < 2; ++bj) { const f32x4 v0 = ((acc[ai][bj][m][0] - gw[bj][0] * mean) * rstd + bw[bj][0]) * sc, v1 = ((acc[ai][bj][m][1] - gw[bj][1] * mean) * rstd + bw[bj][1]) * sc;
                    u32x4 w; w.x = cvt_pk_bf16(v0[0], v0[1]); w.y = cvt_pk_bf16(v0[2], v0[3]); w.z = cvt_pk_bf16(v1[0], v1[1]); w.w = cvt_pk_bf16(v1[2], v1[3]);
                    *(u32x4*)(rowp + bj * HALF) = w; } }
    }
};
struct EpiInProj {
    static constexpr bool PERM = true, AFTER_DRAIN = false;
    bf16_t *aq, *ak, *av, *bq, *bc, *iq, *ikw; float qscale; LnFold lf; unsigned* kmax; int pn0; float ascale;
    __device__ __forceinline__ void operator()(const f32x4 (&acc)[2][2][4][2], const Unit& u, int wr, int wc, int fr, int fq) const {
        bf16_t* base; int ldc, colt; const int pn = u.pn + pn0;
        if (pn < 4) { base = aq; ldc = 1024; colt = pn * 256; }
        else if (pn < 8) { base = ak; ldc = 1024; colt = (pn - 4) * 256; }
        else if (pn < 12) { base = av; ldc = 1024; colt = (pn - 8) * 256; }
        else if (pn < 16) { base = bq; ldc = 1024; colt = (pn - 12) * 256; }
        else if (pn < 18) { base = bc; ldc = 512; colt = (pn - 16) * 256; }
        else if (pn < 22) { base = iq; ldc = 1024; colt = (pn - 18) * 256; }
        else { base = ikw; ldc = 256; colt = 0; }
        const float sc = (pn < 4) ? qscale : 1.0f; float kam[2] = {0.f, 0.f};
        const int row0 = u.pm * BM + wr * 64 + fr, col0 = colt + wc * 32 + 8 * fq, cidx = pn * BM + wc * 32 + 8 * fq;
        f32x4 gw[2][2], bw[2][2];
#pragma unroll
        for (int bj = 0; bj < 2; ++bj)
#pragma unroll
            for (int n = 0; n < 2; ++n) { gw[bj][n] = lf.vec4(lf.gW, cidx + bj * HALF + 4 * n); bw[bj][n] = lf.vec4(lf.bW, cidx + bj * HALF + 4 * n); }
        float mean8[8], rstd8[8]; lf.rows8(row0, mean8, rstd8);
#pragma unroll
        for (int ai = 0; ai < 2; ++ai)
#pragma unroll
            for (int m = 0; m < 4; ++m) { bf16_t* rowp = base + (size_t)(row0 + ai * HALF + m * 16) * ldc + col0;
                const float Ar = rstd8[ai * 4 + m] * ascale * sc, Br = -mean8[ai * 4 + m] * rstd8[ai * 4 + m] * sc;
#pragma unroll
                for (int bj = 0; bj < 2; ++bj) { const f32x4 v0 = acc[ai][bj][m][0] * Ar + (gw[bj][0] * Br + bw[bj][0] * sc), v1 = acc[ai][bj][m][1] * Ar + (gw[bj][1] * Br + bw[bj][1] * sc);
                    if (pn >= 4 && pn < 8) {
                        float sq = ((v0[0] * v0[0] + v0[1] * v0[1]) + (v0[2] * v0[2] + v0[3] * v0[3])) + ((v1[0] * v1[0] + v1[1] * v1[1]) + (v1[2] * v1[2] + v1[3] * v1[3]));
                        { const auto r1 = __builtin_amdgcn_permlane16_swap(__float_as_uint(sq), __float_as_uint(sq), false, false); sq = __uint_as_float(r1[0]) + __uint_as_float(r1[1]); }
                        { const auto r2 = __builtin_amdgcn_permlane32_swap(__float_as_uint(sq), __float_as_uint(sq), false, false); sq = __uint_as_float(r2[0]) + __uint_as_float(r2[1]); }
                        kam[bj] = fmaxf(kam[bj], sq); }
                    u32x4 w; w.x = cvt_pk_bf16(v0[0], v0[1]); w.y = cvt_pk_bf16(v0[2], v0[3]); w.z = cvt_pk_bf16(v1[0], v1[1]); w.w = cvt_pk_bf16(v1[2], v1[3]);
                    *(u32x4*)(rowp + bj * HALF) = w; } }
        if (pn >= 4 && pn < 8) {
#pragma unroll
            for (int bj = 0; bj < 2; ++bj) { float v = kam[bj];
#pragma unroll
                for (int o = 1; o < 64; o <<= 1) v = fmaxf(v, __shfl_xor(v, o));
                if ((fr | fq) == 0) (void)__hip_atomic_fetch_max(kmax + (((u.pm >> 4) * 8 + 2 * (pn - 4) + bj) * 2 + (wc >> 1)) * 2 + (wc & 1), __float_as_uint(v), __ATOMIC_RELAXED, __HIP_MEMORY_SCOPE_AGENT); } }
    }
};
struct EpiSwiGLU {
    static constexpr bool PERM = true, AFTER_DRAIN = false;
    bf16_t* O; int ldc;
    __device__ __forceinline__ void operator()(const f32x4 (&acc)[2][2][4][2], const Unit& u, int wr, int wc, int fr, int fq) const {
        const int row0 = u.pm * BM + wr * 64 + fr, col0 = u.pn * HALF + wc * 32 + 8 * fq;
#pragma unroll
        for (int ai = 0; ai < 2; ++ai)
#pragma unroll
            for (int m = 0; m < 4; ++m) { bf16_t* rowp = O + (size_t)(row0 + ai * HALF + m * 16) * ldc + col0;
                float h[8];
#pragma unroll
                for (int n = 0; n < 2; ++n)
#pragma unroll
                    for (int j = 0; j < 4; ++j) { const float g = acc[ai][0][m][n][j], up = acc[ai][1][m][n][j]; h[4 * n + j] = g * sigmoidf_fast(g) * up; }
                u32x4 w; w.x = cvt_pk_bf16(h[0], h[1]); w.y = cvt_pk_bf16(h[2], h[3]); w.z = cvt_pk_bf16(h[4], h[5]); w.w = cvt_pk_bf16(h[6], h[7]);
                *(u32x4*)rowp = w; }
    }
};
__device__ __forceinline__ unsigned pk4_fp8(float a, float b, float c, float d) { int w = 0; w = __builtin_amdgcn_cvt_pk_fp8_f32(a, b, w, false); w = __builtin_amdgcn_cvt_pk_fp8_f32(c, d, w, true); return (unsigned)w; }
struct EpiFp8 {
    static constexpr bool PERM = true, AFTER_DRAIN = false;
    unsigned char* O; int ldc; float sc;
    __device__ __forceinline__ void operator()(const f32x4 (&acc)[2][2][4][2], const Unit& u, int wr, int wc, int fr, int fq) const {
        typedef unsigned u32x2 __attribute__((ext_vector_type(2)));
        const int row0 = u.pm * BM + wr * 64 + fr, col0 = u.pn * BM + wc * 32 + 8 * fq;
#pragma unroll
        for (int ai = 0; ai < 2; ++ai)
#pragma unroll
            for (int m = 0; m < 4; ++m) { unsigned char* rowp = O + (size_t)(row0 + ai * HALF + m * 16) * ldc + col0;
#pragma unroll
                for (int bj = 0; bj < 2; ++bj) { const f32x4 v0 = acc[ai][bj][m][0] * sc, v1 = acc[ai][bj][m][1] * sc;
                    *(u32x2*)(rowp + bj * HALF) = (u32x2){pk4_fp8(fminf(fmaxf(v0[0], -448.f), 448.f), fminf(fmaxf(v0[1], -448.f), 448.f), fminf(fmaxf(v0[2], -448.f), 448.f), fminf(fmaxf(v0[3], -448.f), 448.f)),
                                                          pk4_fp8(fminf(fmaxf(v1[0], -448.f), 448.f), fminf(fmaxf(v1[1], -448.f), 448.f), fminf(fmaxf(v1[2], -448.f), 448.f), fminf(fmaxf(v1[3], -448.f), 448.f))}; } }
    }
};
struct EpiSwiGLU8 {
    static constexpr bool PERM = true, AFTER_DRAIN = false;
    unsigned char* O; int ldc; float ascale, hs; LnFold lf;
    __device__ __forceinline__ void operator()(const f32x4 (&acc)[2][2][4][2], const Unit& u, int wr, int wc, int fr, int fq) const {
        const int row0 = u.pm * BM + wr * 64 + fr, col0 = u.pn * HALF + wc * 32 + 8 * fq, cidx = u.pn * BM + wc * 32 + 8 * fq;
        typedef unsigned u32x2 __attribute__((ext_vector_type(2)));
        f32x4 gw[2][2], bw[2][2];
#pragma unroll
        for (int bj = 0; bj < 2; ++bj)
#pragma unroll
            for (int n = 0; n < 2; ++n) { gw[bj][n] = (f32x4){0.f, 0.f, 0.f, 0.f}; bw[bj][n] = (f32x4){0.f, 0.f, 0.f, 0.f}; if (lf.stats) { gw[bj][n] = lf.vec4(lf.gW, cidx + bj * HALF + 4 * n); bw[bj][n] = lf.vec4(lf.bW, cidx + bj * HALF + 4 * n); } }
        float mean8[8], rstd8[8];
#pragma unroll
        for (int q = 0; q < 8; ++q) { mean8[q] = 0.f; rstd8[q] = 1.f; }
        if (lf.stats) lf.rows8(row0, mean8, rstd8);
#pragma unroll
        for (int ai = 0; ai < 2; ++ai)
#pragma unroll
            for (int m = 0; m < 4; ++m) { unsigned char* rowp = O + (size_t)(row0 + ai * HALF + m * 16) * ldc + col0;
                float h[8]; const float Ar = rstd8[ai * 4 + m] * ascale, Br = -mean8[ai * 4 + m] * rstd8[ai * 4 + m];
#pragma unroll
                for (int n = 0; n < 2; ++n)
#pragma unroll
                    for (int j = 0; j < 4; ++j) { const float g = acc[ai][0][m][n][j] * Ar + (gw[0][n][j] * Br + bw[0][n][j]), up = acc[ai][1][m][n][j] * Ar + (gw[1][n][j] * Br + bw[1][n][j]);
                        h[4 * n + j] = fminf(fmaxf(g * sigmoidf_fast(g) * up * hs, -448.f), 448.f); }
                *(u32x2*)rowp = (u32x2){pk4_fp8(h[0], h[1], h[2], h[3]), pk4_fp8(h[4], h[5], h[6], h[7])}; }
    }
};
struct EpiGateMerge {
    static constexpr bool PERM = true, AFTER_DRAIN = false;
    const bf16_t* ta; const bf16_t* tb; bf16_t* O; int ldc; const float* b0; const float* b1;
    __device__ __forceinline__ void operator()(const f32x4 (&acc)[2][2][4][2], const Unit& u, int wr, int wc, int fr, int fq) const {
        const int row0 = u.pm * BM + wr * 64 + fr, col0 = u.pn * HALF + wc * 32 + 8 * fq;
        float bb0[8], bb1[8];
#pragma unroll
        for (int j = 0; j < 8; ++j) { bb0[j] = b0[col0 + j]; bb1[j] = b1[col0 + j]; }
#pragma unroll
        for (int ai = 0; ai < 2; ++ai)
#pragma unroll
            for (int m = 0; m < 4; ++m) { const size_t off = (size_t)(row0 + ai * HALF + m * 16) * ldc + col0;
                const u32x4 a = *(const u32x4*)(ta + off), b = *(const u32x4*)(tb + off);
                const float av[8] = {bflo(a.x), bfhi(a.x), bflo(a.y), bfhi(a.y), bflo(a.z), bfhi(a.z), bflo(a.w), bfhi(a.w)};
                const float bv[8] = {bflo(b.x), bfhi(b.x), bflo(b.y), bfhi(b.y), bflo(b.z), bfhi(b.z), bflo(b.w), bfhi(b.w)};
                float h[8];
#pragma unroll
                for (int n = 0; n < 2; ++n)
#pragma unroll
                    for (int j = 0; j < 4; ++j) { const int e = 4 * n + j; h[e] = sigmoidf_fast(acc[ai][0][m][n][j] + bb0[e]) * av[e] + sigmoidf_fast(acc[ai][1][m][n][j] + bb1[e]) * bv[e]; }
                u32x4 w; w.x = cvt_pk_bf16(h[0], h[1]); w.y = cvt_pk_bf16(h[2], h[3]); w.z = cvt_pk_bf16(h[4], h[5]); w.w = cvt_pk_bf16(h[6], h[7]);
                *(u32x4*)(O + off) = w; }
    }
};
struct EpiGateMerge8 {
    static constexpr bool PERM = true, AFTER_DRAIN = false;
    const bf16_t* ta; const bf16_t* tb; unsigned char* O; int ldc; const float* b0; const float* b1; float ascale, ms; LnFold lf;
    __device__ __forceinline__ void operator()(const f32x4 (&acc)[2][2][4][2], const Unit& u, int wr, int wc, int fr, int fq) const {
        const int row0 = u.pm * BM + wr * 64 + fr, col0 = u.pn * HALF + wc * 32 + 8 * fq, cidx = u.pn * BM + wc * 32 + 8 * fq;
        typedef unsigned u32x2 __attribute__((ext_vector_type(2)));
        float mean8[8], rstd8[8]; lf.rows8(row0, mean8, rstd8);
        float bb0[8], bb1[8], gw0[8], gw1[8];
#pragma unroll
        for (int j = 0; j < 8; ++j) { bb0[j] = b0[col0 + j] + lf.bW[cidx + j]; bb1[j] = b1[col0 + j] + lf.bW[cidx + HALF + j]; gw0[j] = lf.gW[cidx + j]; gw1[j] = lf.gW[cidx + HALF + j]; }
#pragma unroll
        for (int am = 0; am < 8; am += 2) {
            u32x4 pa[2], pb[2];
#pragma unroll
            for (int e2 = 0; e2 < 2; ++e2) { const size_t off = (size_t)(row0 + ((am + e2) >> 2) * HALF + ((am + e2) & 3) * 16) * ldc + col0; pa[e2] = *(const u32x4*)(ta + off); pb[e2] = *(const u32x4*)(tb + off); }
#pragma unroll
            for (int e2 = 0; e2 < 2; ++e2) { const int ai = (am + e2) >> 2, m = (am + e2) & 3; const size_t off = (size_t)(row0 + ai * HALF + m * 16) * ldc + col0;
                const u32x4 a = pa[e2], b = pb[e2];
                const float av[8] = {bflo(a.x), bfhi(a.x), bflo(a.y), bfhi(a.y), bflo(a.z), bfhi(a.z), bflo(a.w), bfhi(a.w)};
                const float bv[8] = {bflo(b.x), bfhi(b.x), bflo(b.y), bfhi(b.y), bflo(b.z), bfhi(b.z), bflo(b.w), bfhi(b.w)};
                float h[8]; const float Ar = rstd8[ai * 4 + m] * ascale, Br = -mean8[ai * 4 + m] * rstd8[ai * 4 + m];
#pragma unroll
                for (int n = 0; n < 2; ++n)
#pragma unroll
                    for (int j = 0; j < 4; ++j) { const int e = 4 * n + j; const float v = sigmoidf_fast(acc[ai][0][m][n][j] * Ar + (gw0[e] * Br + bb0[e])) * av[e] + sigmoidf_fast(acc[ai][1][m][n][j] * Ar + (gw1[e] * Br + bb1[e])) * bv[e];
                        h[e] = fminf(fmaxf(v * ms, -448.f), 448.f); }
                *(u32x2*)(O + off) = (u32x2){pk4_fp8(h[0], h[1], h[2], h[3]), pk4_fp8(h[4], h[5], h[6], h[7])}; }
            asm volatile("" ::: "memory"); }
    }
};
template <bool RES32, int NB = 2> struct EpiRes {
    static constexpr bool PERM = true, AFTER_DRAIN = false;
    const float* res32; const bf16_t* res16; int ldc; float alpha, s;
    const long long* rstats; const float* rg; const float* rb; long long* ostats; bf16_t* o16; unsigned char* o8; float o8s;
    __device__ __forceinline__ void operator()(const f32x4 (&acc)[2][2][4][2], const Unit& u, int wr, int wc, int fr, int fq) const {
        const int col0 = u.pn * BM + wc * 32 + 8 * fq;
        typedef unsigned u32x2 __attribute__((ext_vector_type(2)));
        float al = alpha, sa = s; asm volatile("" : "+v"(al), "+v"(sa));
        const int rowb = u.pm * BM + wr * 64 + fr;
        float mean8[8], rstd8[8];
#pragma unroll
        for (int q = 0; q < 8; ++q) { mean8[q] = 0.f; rstd8[q] = 1.f; }
        if (rstats) { LnFold lf{rstats, nullptr, nullptr}; lf.rows8(rowb, mean8, rstd8); }
        asm volatile("" : "+v"(mean8[0]), "+v"(mean8[1]), "+v"(mean8[2]), "+v"(mean8[3]), "+v"(mean8[4]), "+v"(mean8[5]), "+v"(mean8[6]), "+v"(mean8[7]), "+v"(rstd8[0]), "+v"(rstd8[1]), "+v"(rstd8[2]), "+v"(rstd8[3]), "+v"(rstd8[4]), "+v"(rstd8[5]), "+v"(rstd8[6]), "+v"(rstd8[7]) :: "memory");
        f32x4 gv[2][2], bv[2][2];
#pragma unroll
        for (int bj = 0; bj < 2; ++bj)
#pragma unroll
            for (int n = 0; n < 2; ++n) { gv[bj][n] = (f32x4){1.f, 1.f, 1.f, 1.f}; bv[bj][n] = (f32x4){0.f, 0.f, 0.f, 0.f};
                if (rstats) { gv[bj][n] = *(const f32x4*)(rg + col0 + bj * HALF + 4 * n); bv[bj][n] = *(const f32x4*)(rb + col0 + bj * HALF + 4 * n); }
                gv[bj][n] = gv[bj][n] * al; bv[bj][n] = bv[bj][n] * al; }
#pragma unroll
        for (int am = 0; am < 8; am += NB) {
            f32x4 rr[RES32 ? NB : 1][2][2]; u32x4 rw[NB][2];
#pragma unroll
            for (int e2 = 0; e2 < NB; ++e2) { const size_t off = (size_t)(rowb + ((am + e2) >> 2) * HALF + ((am + e2) & 3) * 16) * ldc + col0;
#pragma unroll
                for (int bj = 0; bj < 2; ++bj) {
                    if constexpr (RES32) { rr[e2][bj][0] = *(const f32x4*)(res32 + off + bj * HALF); rr[e2][bj][1] = *(const f32x4*)(res32 + off + bj * HALF + 4); }
                    else rw[e2][bj] = *(const u32x4*)(res16 + off + bj * HALF); } }
#pragma unroll
            for (int e2 = 0; e2 < NB; ++e2) { const int ai = (am + e2) >> 2, m = (am + e2) & 3; const int row = rowb + ai * HALF + m * 16; const size_t off = (size_t)row * ldc + col0;
                const float mean = mean8[am + e2], rstd = rstd8[am + e2];
                float ps = 0.f, pq = 0.f;
#pragma unroll
                for (int bj = 0; bj < 2; ++bj) {
                    f32x4 r0, r1;
                    if constexpr (RES32) { r0 = rr[e2][bj][0]; r1 = rr[e2][bj][1]; } else { const u32x4 w = rw[e2][bj]; r0 = (f32x4){bflo(w.x), bfhi(w.x), bflo(w.y), bfhi(w.y)}; r1 = (f32x4){bflo(w.z), bfhi(w.z), bflo(w.w), bfhi(w.w)}; }
                    const f32x4 z0 = (r0 - mean) * rstd * gv[bj][0] + bv[bj][0] + acc[ai][bj][m][0] * sa, z1 = (r1 - mean) * rstd * gv[bj][1] + bv[bj][1] + acc[ai][bj][m][1] * sa;
                    u32x4 w16; w16.x = cvt_pk_bf16(z0[0], z0[1]); w16.y = cvt_pk_bf16(z0[2], z0[3]); w16.z = cvt_pk_bf16(z1[0], z1[1]); w16.w = cvt_pk_bf16(z1[2], z1[3]);
                    *(u32x4*)(o16 + off + bj * HALF) = w16;
                    const float q0 = bflo(w16.x), q1 = bfhi(w16.x), q2 = bflo(w16.y), q3 = bfhi(w16.y), q4 = bflo(w16.z), q5 = bfhi(w16.z), q6 = bflo(w16.w), q7 = bfhi(w16.w);
                    ps += ((q0 + q1) + (q2 + q3)) + ((q4 + q5) + (q6 + q7)); pq += ((q0 * q0 + q1 * q1) + (q2 * q2 + q3 * q3)) + ((q4 * q4 + q5 * q5) + (q6 * q6 + q7 * q7));
                    if (o8) *(u32x2*)(o8 + off + bj * HALF) = (u32x2){pk4_fp8(fminf(fmaxf(q0 * o8s, -448.f), 448.f), fminf(fmaxf(q1 * o8s, -448.f), 448.f), fminf(fmaxf(q2 * o8s, -448.f), 448.f), fminf(fmaxf(q3 * o8s, -448.f), 448.f)),
                                                                      pk4_fp8(fminf(fmaxf(q4 * o8s, -448.f), 448.f), fminf(fmaxf(q5 * o8s, -448.f), 448.f), fminf(fmaxf(q6 * o8s, -448.f), 448.f), fminf(fmaxf(q7 * o8s, -448.f), 448.f))}; }
                if (ostats) { ps += __shfl_xor(ps, 16); ps += __shfl_xor(ps, 32); pq += __shfl_xor(pq, 16); pq += __shfl_xor(pq, 32);
                    if (fq == 0) { (void)__hip_atomic_fetch_add(ostats + 2 * (size_t)row, (long long)__builtin_rintf(ps * 1048576.f), __ATOMIC_RELAXED, __HIP_MEMORY_SCOPE_AGENT); (void)__hip_atomic_fetch_add(ostats + 2 * (size_t)row + 1, (long long)__builtin_rintf(pq * 65536.f), __ATOMIC_RELAXED, __HIP_MEMORY_SCOPE_AGENT); } } }
            asm volatile("" ::: "memory"); }
    }
};

typedef int v8i_t __attribute__((ext_vector_type(8)));
typedef int v4i_t __attribute__((ext_vector_type(4)));
template <class Epi, class Sched, bool ALIGN_EPI, bool FP8 = false, bool BDIAG = false>
__device__ __forceinline__ void gemm_phase(PG8_LAS unsigned char* lds, const Gemm g, const Sched& S, const Epi& E, const int wid) {
    const int lane = lane_fresh(), tid = wid * 64 + lane, wr = wid >> 2, wc = wid & 3, fr = lane & 15, fq = lane >> 4;
    const int K = g.K, nt = K / BK;
    unsigned voffA[2], voffB[2];
#pragma unroll
    for (int i = 0; i < 2; ++i) { int R, C; stage_rc(tid * 16 + i * 8192, R, C); const int Rb = Epi::PERM ? ((R & ~31) + perm32(R & 31)) : R;
        voffA[i] = (unsigned)(R * g.lda + C) * 2u; voffB[i] = (unsigned)(Rb * g.ldb + C) * 2u; }
    const size_t kstep = (size_t)(BK * 2);
    const size_t hstepA = (size_t)HALF * g.lda * 2, hstepB = (size_t)HALF * g.ldb * 2;
    const size_t tstepA = 2 * hstepA, tstepB = 2 * hstepB;
    const unsigned ldsw = (unsigned)wid * 1024u;
    int aoff = lds_byte(wr * 64 + fr, fq * 8), boff = lds_byte(wc * 32 + fr, fq * 8);
    asm volatile("" : "+v"(voffA[0]), "+v"(voffA[1]), "+v"(voffB[0]), "+v"(voffB[1]), "+v"(aoff), "+v"(boff));
#define PG8_UA(u) ((const char*)g.A + (size_t)(u).pm * tstepA + (size_t)(((u).pn >> g.a_shift) * g.a_mul) * 2)
#define PG8_UB(u) ((const char*)g.Bt + (size_t)(g.b_wrap ? ((u).pn & (g.b_wrap - 1)) : (u).pn) * tstepB + (size_t)(((u).pn >> g.a_shift) * g.b_kmul) * 2)
#define PG8_SA(b, h) (((b) * 2 + (h)) * HTB)
#define PG8_SB(b, h) ((4 + (b) * 2 + (h)) * HTB)
#define PG8_STAGE(bufoff, gbase, voff) do { _Pragma("unroll") for (int _i = 0; _i < 2; ++_i) \
        __builtin_amdgcn_global_load_lds((const unsigned*)((const char*)(gbase) + (voff)[_i]), (PG8_LAS unsigned*)(lds + (bufoff) + ldsw + _i * 8192), 16, 0, 0); } while (0)
#define PG8_LD8(p_) __builtin_shufflevector(*(const PG8_LAS v4i_t*)(p_), *(const PG8_LAS v4i_t*)((p_) + 1024), 0, 1, 2, 3, 4, 5, 6, 7)
#define PG8_LDA(dst, b, h) do { _Pragma("unroll") for (int m = 0; m < 4; ++m) { if constexpr (FP8) dst##8[m] = PG8_LD8(lds + PG8_SA(b, h) + aoff + m * 2048); else { _Pragma("unroll") for (int k = 0; k < 2; ++k) dst[m][k] = *(const PG8_LAS bf16x8*)(lds + PG8_SA(b, h) + aoff + m * 2048 + k * 1024); } } } while (0)
#define PG8_LDB(dst, b, h) do { _Pragma("unroll") for (int n = 0; n < 2; ++n) { if constexpr (FP8) dst##8[n] = PG8_LD8(lds + PG8_SB(b, h) + boff + n * 2048); else { _Pragma("unroll") for (int k = 0; k < 2; ++k) dst[n][k] = *(const PG8_LAS bf16x8*)(lds + PG8_SB(b, h) + boff + n * 2048 + k * 1024); } } } while (0)
#define PG8_MMA(ai, bj, At, Bt) do { __builtin_amdgcn_s_setprio(1); _Pragma("unroll") for (int m = 0; m < 4; ++m) _Pragma("unroll") for (int n = 0; n < 2; ++n) { \
        if constexpr (FP8) asm volatile("v_mfma_scale_f32_16x16x128_f8f6f4 %0, %1, %2, %0, %3, %3 op_sel_hi:[0,0,0]" : "+v"(acc[ai][bj][m][n]) : "v"(Bt##8[n]), "v"(At##8[m]), "v"(one_scale)); \
        else { _Pragma("unroll") for (int k = 0; k < 2; ++k) acc[ai][bj][m][n] = __builtin_amdgcn_mfma_f32_16x16x32_bf16(Bt[n][k], At[m][k], acc[ai][bj][m][n], 0, 0, 0); } } \
        __builtin_amdgcn_s_setprio(0); } while (0)
#define PG8_WAIT_V(n) asm volatile("s_waitcnt vmcnt(" #n ")" ::: "memory")
#define PG8_WAIT_L(n) asm volatile("s_waitcnt lgkmcnt(" #n ")" ::: "memory")
#define PG8_BAR __builtin_amdgcn_s_barrier()
#define PG8_SCHED __builtin_amdgcn_sched_barrier(0)
    Unit cur, nxt; int ui = 0;
    if (!S.next(0, cur)) return;
    f32x4 acc[2][2][4][2];
#pragma unroll
    for (int a = 0; a < 2; ++a)
#pragma unroll
        for (int b = 0; b < 2; ++b)
#pragma unroll
            for (int m = 0; m < 4; ++m)
#pragma unroll
                for (int n = 0; n < 2; ++n) acc[a][b][m][n] = (f32x4){0.f, 0.f, 0.f, 0.f};
    bf16x8 At[4][2], B0[2][2], B1[2][2]; v8i_t At8[4], B08[2], B18[2];
    int one_scale = 0x7f7f7f7f; asm volatile("" : "+v"(one_scale));
    const char* cA = PG8_UA(cur); const char* cB = PG8_UB(cur);
    S.a_ready(cur);
    PG8_STAGE(PG8_SB(0, 0), cB, voffB); PG8_STAGE(PG8_SB(0, 1), cB + hstepB, voffB); PG8_STAGE(PG8_SA(0, 0), cA, voffA); PG8_STAGE(PG8_SA(0, 1), cA + hstepA, voffA);
    if (wr == 1) PG8_BAR;
    PG8_WAIT_V(2); PG8_BAR;
    PG8_STAGE(PG8_SB(1, 0), cB + kstep, voffB); PG8_STAGE(PG8_SA(1, 0), cA + kstep, voffA); PG8_STAGE(PG8_SB(1, 1), cB + hstepB + kstep, voffB);
    PG8_WAIT_V(6); PG8_BAR;
    for (;;) {
        const bool has_next = S.next(ui + 1, nxt);
        const char* nA = has_next ? PG8_UA(nxt) : cA; const char* nB = has_next ? PG8_UB(nxt) : cB;
        for (int t = 0; t < nt; t += 2) {
            const bool last = (t == nt - 2); const bool kh0 = 2 * t < nt; (void)kh0;
            const char* a1 = cA + (size_t)(t + 1) * kstep;
            const char* a2 = last ? nA : cA + (size_t)(t + 2) * kstep; const char* b2 = last ? nB : cB + (size_t)(t + 2) * kstep;
            const char* a3 = a2 + kstep; const char* b3 = b2 + kstep;
            if (last && has_next) S.a_ready(nxt);
            PG8_LDB(B0, 0, 0); PG8_LDB(B1, 0, 1); PG8_SCHED; PG8_LDA(At, 0, 0); PG8_STAGE(PG8_SA(1, 1), a1 + hstepA, voffA);
            PG8_WAIT_V(8); PG8_WAIT_L(0); PG8_BAR; if (!BDIAG || kh0) PG8_MMA(0, 0, At, B0); if (!BDIAG || !kh0) PG8_MMA(0, 1, At, B1); PG8_BAR; PG8_SCHED;
            PG8_LDA(At, 0, 1); PG8_STAGE(PG8_SB(0, 0), b2, voffB); PG8_STAGE(PG8_SB(0, 1), b2 + hstepB, voffB); PG8_STAGE(PG8_SA(0, 0), a2, voffA);
            PG8_WAIT_V(8); PG8_WAIT_L(0); PG8_BAR; if (!BDIAG || kh0) PG8_MMA(1, 0, At, B0); if (!BDIAG || !kh0) PG8_MMA(1, 1, At, B1); PG8_BAR; PG8_SCHED;
            PG8_LDB(B0, 1, 0); PG8_LDB(B1, 1, 1); PG8_SCHED; PG8_LDA(At, 1, 0); PG8_STAGE(PG8_SA(0, 1), a2 + hstepA, voffA);
            PG8_WAIT_V(8); PG8_WAIT_L(0); PG8_BAR; if (!BDIAG || kh0) PG8_MMA(0, 0, At, B0); if (!BDIAG || !kh0) PG8_MMA(0, 1, At, B1); PG8_BAR; PG8_SCHED;
            PG8_LDA(At, 1, 1); PG8_STAGE(PG8_SB(1, 0), b3, voffB); PG8_STAGE(PG8_SB(1, 1), b3 + hstepB, voffB); PG8_STAGE(PG8_SA(1, 0), a3, voffA);
            PG8_WAIT_V(8); PG8_WAIT_L(0); PG8_BAR; if (!BDIAG || kh0) PG8_MMA(1, 0, At, B0); if (!BDIAG || !kh0) PG8_MMA(1, 1, At, B1); PG8_BAR; PG8_SCHED;
        }
        if constexpr (ALIGN_EPI) { if (wr == 0) PG8_BAR; }
        if constexpr (FP8) asm volatile("s_nop 15\n\ts_nop 7" ::: "memory");
        { const int le = lane_fresh(); E(acc, cur, wr, wc, le & 15, le >> 4); } S.done(cur);
        if (!has_next) break;
#pragma unroll
        for (int a = 0; a < 2; ++a)
#pragma unroll
            for (int b = 0; b < 2; ++b)
#pragma unroll
                for (int m = 0; m < 4; ++m)
#pragma unroll
                    for (int n = 0; n < 2; ++n) acc[a][b][m][n] = (f32x4){0.f, 0.f, 0.f, 0.f};
        cur = nxt; cA = nA; cB = nB; ++ui;
        if constexpr (ALIGN_EPI) { if (wr == 1) PG8_BAR; }
    }
    PG8_WAIT_V(0);
    if constexpr (!ALIGN_EPI) { if (wr == 0) PG8_BAR; }
    PG8_BAR;
#undef PG8_UA
#undef PG8_UB
#undef PG8_SA
#undef PG8_SB
#undef PG8_STAGE
#undef PG8_LDA
#undef PG8_LDB
#undef PG8_MMA
#undef PG8_LD8
#undef PG8_WAIT_V
#undef PG8_WAIT_L
#undef PG8_BAR
#undef PG8_SCHED
}
}

constexpr int NWAVES = 8;
constexpr int BATCH = 4, SEQ = 4096, D = 2048, FF = 5632, M = BATCH * SEQ;
constexpr int N_IN = 5888;
constexpr int MEMT = 256;
constexpr float LN_EPS = 1e-5f;
constexpr float ALPHA = 1.189207115002721f;
constexpr float LAMBDA_INIT = 0.2f;

constexpr size_t MiB = 1u << 20;
constexpr size_t WS_CTL = 0, CTL_ZERO_BYTES = 2 * MiB;
constexpr size_t WS_W_IN = 2 * MiB;
constexpr size_t WS_W_IN8 = WS_W_IN, WS_W_INB = WS_W_IN + 9 * MiB; constexpr int N_IN8 = 4608, N_INB = 1280;
constexpr size_t WS_W_G = 25 * MiB;
constexpr size_t WS_W_UK = 41 * MiB;
constexpr size_t WS_W_UVP = 42 * MiB;
constexpr size_t WS_W_A = 44 * MiB;
constexpr size_t WS_W_B = 48 * MiB;
constexpr size_t WS_W_MO = 52 * MiB;
constexpr size_t WS_W_MQ = 60 * MiB;
constexpr size_t WS_W_MKV = 62 * MiB;
constexpr size_t WS_W_MOUT = 66 * MiB;
constexpr size_t WS_MEM16 = 68 * MiB;
constexpr size_t WS_KVMEM = 72 * MiB;
constexpr size_t WS_W_GU2 = 74 * MiB;
constexpr size_t WS_W_D2 = 96 * MiB;
constexpr size_t WS_X8M = 107 * MiB;
constexpr size_t WS_X16 = 140 * MiB;
constexpr size_t WS_MIX = 204 * MiB;
constexpr size_t WS_W_GU1 = 204 * MiB;
constexpr size_t WS_W_D1 = 248 * MiB;
constexpr size_t WS_H = 270 * MiB;
constexpr size_t WS_AQ = WS_MIX + 0 * MiB, WS_AK = WS_MIX + 32 * MiB, WS_AV = WS_MIX + 64 * MiB, WS_BQ = WS_MIX + 96 * MiB;
constexpr size_t WS_BC = WS_MIX + 128 * MiB;
constexpr size_t WS_IQ = WS_MIX + 144 * MiB;
constexpr size_t WS_IKW = WS_MIX + 176 * MiB;
constexpr size_t WS_QLAT = WS_MIX + 184 * MiB;
constexpr size_t WS_IDX = WS_MIX + 312 * MiB;
constexpr size_t WS_YB = WS_BQ;
constexpr size_t WS_TA = WS_QLAT, WS_TB = WS_QLAT + 64 * MiB;
constexpr size_t WS_QM = WS_AQ, WS_OM = WS_AK;
constexpr size_t WS_X8 = WS_H + 96 * MiB;
constexpr size_t WS_YA8 = WS_W_IN;
constexpr size_t WS_C8 = WS_W_G + 8 * MiB;
constexpr size_t WS_MRG8 = WS_AV;
constexpr float FP8_OMS = 64.f, FP8_WMOUTS = 1024.f;
constexpr float FP8_WUVS = 1024.f;
constexpr float FP8_WGS = 1024.f, FP8_MS = 32.f, FP8_WMOS = 2048.f, FP8_YS = 64.f, FP8_WBS = 1024.f, FP8_YAS = 64.f, FP8_WAS = 1024.f;
constexpr float FP8_XS = 32.f, FP8_WGUS = 1024.f, FP8_HS = 8.f, FP8_WDS = 4096.f;
constexpr size_t WS_END = WS_MIX + 320 * MiB;
static_assert(WS_H + (size_t)M * FF * 2 <= WS_END && WS_QLAT + (size_t)M * 4096 * 2 <= WS_END, "d_ws map");
constexpr int CW_BAR = 4096;
constexpr int CW_DQ = 8192;
constexpr int CW_KMAX = 8256;
constexpr size_t CTL_STATS = 65536, CTL_STATS_STRIDE = (size_t)M * 2 * 8;
constexpr size_t CTL_VEC = CTL_STATS + 3 * CTL_STATS_STRIDE;
constexpr int V_GW_IN = 0, V_BW_IN = 5888, V_GW_G = 11776, V_BW_G = 15872, V_GW_MQ = 19968, V_BW_MQ = 20480, V_GW_GU2 = 20992, V_BW_GU2 = 32256, V_END = 43520;
constexpr size_t CTL_VECF = CTL_VEC + (size_t)V_END * 8;
static_assert(CTL_VECF + (size_t)V_END * 4 <= CTL_ZERO_BYTES, "control region");
constexpr float FX_S = 1048576.f, FX_Q = 65536.f, FX_V = 16777216.f;

constexpr int RING_OFF = 0, RING_BYTES = 153600;
constexpr int LDSCTL_OFF = RING_BYTES, MISC_OFF = LDSCTL_OFF + 320;
constexpr int LDS_BYTES = 154624;
static_assert(MISC_OFF + 128 <= LDS_BYTES, "LDS map");

#define GAS __attribute__((address_space(1)))
#define LAS __attribute__((address_space(3)))
typedef unsigned short bf16;
typedef unsigned v4u __attribute__((ext_vector_type(4)));
typedef unsigned v2u __attribute__((ext_vector_type(2)));
typedef float f32x4 __attribute__((ext_vector_type(4)));
typedef float f32x16 __attribute__((ext_vector_type(16)));
typedef short bf16x8 __attribute__((ext_vector_type(8)));
typedef GAS unsigned gu32;
#define RLX_AGENT __ATOMIC_RELAXED, __HIP_MEMORY_SCOPE_AGENT
#define LDS_WAIT() asm volatile("s_waitcnt lgkmcnt(0)" ::: "memory")
#define VM_WAIT() asm volatile("s_waitcnt vmcnt(0)" ::: "memory")
__device__ __forceinline__ unsigned f2bf(float f) { unsigned u = __builtin_bit_cast(unsigned, f); return (u + 0x7fffu + ((u >> 16) & 1u)) >> 16; }
__device__ __forceinline__ unsigned pk2(float lo, float hi) { return f2bf(lo) | (f2bf(hi) << 16); }
__device__ __forceinline__ float bf2f(unsigned short v) { return __uint_as_float((unsigned)v << 16); }
__device__ __forceinline__ float blo(unsigned w) { return __uint_as_float(w << 16); }
__device__ __forceinline__ float bhi(unsigned w) { return __uint_as_float(w & 0xffff0000u); }
__device__ __forceinline__ float wave_sum(float v) {
    v += __builtin_bit_cast(float, __builtin_amdgcn_update_dpp(0, __builtin_bit_cast(int, v), 0xB1, 0xf, 0xf, true));
    v += __builtin_bit_cast(float, __builtin_amdgcn_update_dpp(0, __builtin_bit_cast(int, v), 0x4E, 0xf, 0xf, true));
    v += __builtin_bit_cast(float, __builtin_amdgcn_update_dpp(0, __builtin_bit_cast(int, v), 0x141, 0xf, 0xf, true));
    v += __builtin_bit_cast(float, __builtin_amdgcn_update_dpp(0, __builtin_bit_cast(int, v), 0x140, 0xf, 0xf, true));
    { const auto rr = __builtin_amdgcn_permlane16_swap(__float_as_uint(v), __float_as_uint(v), false, false); v = __uint_as_float(rr[0]) + __uint_as_float(rr[1]); }
    { const auto rr = __builtin_amdgcn_permlane32_swap(__float_as_uint(v), __float_as_uint(v), false, false); v = __uint_as_float(rr[0]) + __uint_as_float(rr[1]); }
    return v;
}

__device__ __forceinline__ float xhalf_add(float a) { const auto rr = __builtin_amdgcn_permlane32_swap(__float_as_uint(a), __float_as_uint(a), false, false); return __uint_as_float(rr[0]) + __uint_as_float(rr[1]); }
__device__ __forceinline__ float xhalf_max(float a) { const auto rr = __builtin_amdgcn_permlane32_swap(__float_as_uint(a), __float_as_uint(a), false, false); return fmaxf(__uint_as_float(rr[0]), __uint_as_float(rr[1])); }
__device__ __forceinline__ int half_sum_i32(int v) {
    v += __builtin_amdgcn_update_dpp(0, v, 0xB1, 0xf, 0xf, true);
    v += __builtin_amdgcn_update_dpp(0, v, 0x4E, 0xf, 0xf, true);
    v += __builtin_amdgcn_update_dpp(0, v, 0x141, 0xf, 0xf, true);
    v += __builtin_amdgcn_update_dpp(0, v, 0x140, 0xf, 0xf, true);
    const auto rr = __builtin_amdgcn_permlane16_swap((unsigned)v, (unsigned)v, false, false); return (int)rr[0] + (int)rr[1];
}
#define XB_TMO      128
#define XB_XCNT(j)  (256  + 64 * (j))
#define XB_XSUB(j)  (1280 + 64 * (j))
#define XB_XGEN(j)  (2304 + 64 * (j))
#define XB_TOP      3328
#define XB_TOPGEN   3392
#define XCD_BAR_WORDS 3456
#define XB_SPIN_CAP (1u << 18)

__device__ __forceinline__ unsigned xb_ld(unsigned* p)              { return __hip_atomic_load(p, __ATOMIC_RELAXED, __HIP_MEMORY_SCOPE_AGENT); }
__device__ __forceinline__ unsigned xb_add(unsigned* p, unsigned v) { return __hip_atomic_fetch_add(p, v, __ATOMIC_RELAXED, __HIP_MEMORY_SCOPE_AGENT); }
__device__ __forceinline__ unsigned xb_add_l2(unsigned* p, unsigned v) { unsigned r; asm volatile("global_atomic_add %0, %1, %2, off sc0\n\ts_waitcnt vmcnt(0)" : "=&v"(r) : "v"(p), "v"(v) : "memory"); return r; }
__device__ __forceinline__ void xb_add_l2_nr(unsigned* p, unsigned v) { asm volatile("global_atomic_add %0, %1, off" :: "v"(p), "v"(v) : "memory"); }
__device__ __forceinline__ unsigned xb_ld_l2(unsigned* p) { return xb_add_l2(p, 0u); }
__device__ __forceinline__ unsigned xb_xcc_id() { return (unsigned)__builtin_amdgcn_s_getreg((3 << 11) | 20) & 0xFu; }
#define XB_SPIN(cond, bar) do { unsigned _sp = 0; while (cond) { __builtin_amdgcn_s_sleep(1); \
    if ((++_sp & 255u) == 0u) { if (xb_ld(&(bar)[XB_TMO])) break; if (_sp > XB_SPIN_CAP) { atomicAdd(&(bar)[XB_TMO], 1u); break; } } } } while (0)

struct XcdBarrier {
    unsigned* bar; unsigned x;
    volatile LAS unsigned* st;
};

__device__ __forceinline__ XcdBarrier xcd_barrier_post(unsigned* bar, volatile LAS unsigned* st, bool t0) {
    XcdBarrier b; b.bar = bar; b.x = xb_xcc_id(); b.st = st;
    if (t0) st[2] = xb_add(&bar[XB_XCNT(b.x)], 1u);
    return b;
}
__device__ __forceinline__ void xcd_barrier_complete(unsigned* bar, unsigned x, unsigned& nloc, unsigned& nx) {
    const unsigned G = gridDim.x * gridDim.y * gridDim.z;
    unsigned sum, cnt, mine, sp = 0u;
    for (;;) {
        sum = 0u; cnt = 0u; mine = 0u;
#pragma unroll
        for (unsigned j = 0; j < 16; ++j) { const unsigned c = xb_ld(&bar[XB_XCNT(j)]); sum += c; cnt += (c > 0u) ? 1u : 0u; mine = (j == x) ? c : mine; }
        if (sum == G) break;
        __builtin_amdgcn_s_sleep(1);
        if ((++sp & 255u) == 0u) { if (xb_ld(&bar[XB_TMO])) break; if (sp > XB_SPIN_CAP) { atomicAdd(&bar[XB_TMO], 1u); break; } }
    }
    nloc = mine > 0u ? mine : 1u; nx = cnt > 0u ? cnt : 1u;
}

__device__ __forceinline__ void xcd_barrier(const XcdBarrier& b, const int wave) {
    asm volatile("s_waitcnt vmcnt(0)" ::: "memory");
    __syncthreads();
    if (wave == 0 && lane_fresh() == 0) {
        unsigned* bar = b.bar;
        __builtin_amdgcn_s_waitcnt(0);
        unsigned nloc = b.st[0], nx = b.st[1];
        if (nloc == 0u) { xcd_barrier_complete(bar, b.x, nloc, nx); b.st[0] = nloc; b.st[1] = nx; }
        const unsigned old = xb_add_l2(&bar[XB_XSUB(b.x)], 1u);
        const unsigned gen = old / nloc;
        if (old + 1u == (gen + 1u) * nloc) {
            __builtin_amdgcn_fence(__ATOMIC_RELEASE, "agent");
            asm volatile("s_waitcnt vmcnt(0)" ::: "memory");
            const unsigned og = xb_add(&bar[XB_TOP], 1u);
            const unsigned tg = og / nx;
            if (og + 1u == (tg + 1u) * nx) xb_add(&bar[XB_TOPGEN], 1u);
            else XB_SPIN(xb_ld(&bar[XB_TOPGEN]) == tg, bar);
            __builtin_amdgcn_fence(__ATOMIC_ACQUIRE, "agent");
            xb_add_l2_nr(&bar[XB_XGEN(b.x)], 1u);
            asm volatile("s_waitcnt vmcnt(0)" ::: "memory");
        } else {
            XB_SPIN(xb_ld_l2(&bar[XB_XGEN(b.x)]) == gen, bar);
            __builtin_amdgcn_fence(__ATOMIC_ACQUIRE, "agent");
            asm volatile("s_waitcnt vmcnt(0)" ::: "memory");
        }
    }
    __syncthreads();
}

__device__ __forceinline__ void tr_load(const float* W, int ldw, int nvalid, int k0, int n0, const float* G, const float* B, int lane, f32x4 (&pv)[8], f32x4& gbv, int& okf) {
    gbv = *(const GAS f32x4*)((lane < 16 ? G + 4 * lane : (lane < 32 ? B + 4 * (lane - 16) : G)) + k0);
    const int n4 = 4 * (lane & 7), kr = lane >> 3; const bool ok = n0 + n4 < nvalid;
    const float* base = W + (size_t)(k0 + kr) * ldw + (ok ? n0 + n4 : 0);
#pragma unroll
    for (int i = 0; i < 8; ++i) pv[i] = __builtin_nontemporal_load((const GAS f32x4*)(base + (size_t)(8 * i) * ldw));
    okf = ok ? 1 : 0;
}
__device__ __forceinline__ void tr_stage(LAS float* scr, int lane, const f32x4 (&pv)[8], const f32x4& gbv, const int okf) {
    const int n4 = 4 * (lane & 7), kr = lane >> 3; const float m = okf ? 1.f : 0.f;
#pragma unroll
    for (int i = 0; i < 8; ++i) { const int kk = 8 * i + kr; const f32x4 v = pv[i]; LAS float* d = scr + kk * 33 + n4; d[0] = okf ? v.x : 0.f; d[1] = okf ? v.y : 0.f; d[2] = okf ? v.z : 0.f; d[3] = okf ? v.w : 0.f; }
    (void)m;
    if (lane < 32) *(LAS f32x4*)(scr + 64 * 33 + 4 * lane) = gbv;
    LDS_WAIT(); asm volatile("" ::: "memory");
}
__device__ __forceinline__ void tr_item(const float* W, int ldw, int nvalid, bf16* WT, int ldt, int k0, int n0, int drow0, int dcol0, LAS float* scr, int lane) {
    const int c = lane & 7;
#pragma unroll
    for (int j = 0; j < 4; ++j) { const int nn = (lane >> 3) + 8 * j; const LAS float* s = scr + (8 * c) * 33 + nn;
        v4u o; o.x = pk2(s[0 * 33], s[1 * 33]); o.y = pk2(s[2 * 33], s[3 * 33]); o.z = pk2(s[4 * 33], s[5 * 33]); o.w = pk2(s[6 * 33], s[7 * 33]);
        *(GAS v4u*)(WT + (size_t)(drow0 + nn) * ldt + dcol0 + k0 + 8 * c) = o; }
    LDS_WAIT(); asm volatile("" ::: "memory");
}
__device__ __forceinline__ void tr_item8(const float* W, int ldw, unsigned char* WT, int ldt, int k0, int n0, int drow0, float sc, LAS float* scr, int lane, int dcol0 = 0) {
    const int nn = lane >> 1, hf = lane & 1; const LAS float* sp = scr + (32 * hf) * 33 + nn;
    unsigned o[8];
#pragma unroll
    for (int q = 0; q < 8; ++q) { const float a = fminf(fmaxf(sp[(4 * q + 0) * 33] * sc, -448.f), 448.f), b = fminf(fmaxf(sp[(4 * q + 1) * 33] * sc, -448.f), 448.f), c = fminf(fmaxf(sp[(4 * q + 2) * 33] * sc, -448.f), 448.f), d = fminf(fmaxf(sp[(4 * q + 3) * 33] * sc, -448.f), 448.f);
        int w = 0; w = __builtin_amdgcn_cvt_pk_fp8_f32(a, b, w, false); w = __builtin_amdgcn_cvt_pk_fp8_f32(c, d, w, true); o[q] = (unsigned)w; }
    GAS v4u* dst = (GAS v4u*)(WT + (size_t)(drow0 + nn) * ldt + dcol0 + k0 + 32 * hf);
    dst[0] = (v4u){o[0], o[1], o[2], o[3]}; dst[1] = (v4u){o[4], o[5], o[6], o[7]};
    LDS_WAIT(); asm volatile("" ::: "memory");
}
__device__ __forceinline__ void tr_item_ln(const float* W, int ldw, int nvalid, bf16* WT, int ldt, int k0, int n0, int drow0, const float* gain, const float* bvec, long long* gW, long long* bW, LAS float* scr, int lane) {
    const int c = lane & 7;
    const LAS float* sgb = scr + 64 * 33;
    const f32x4 g0 = *(const LAS f32x4*)(sgb + 8 * c), g1 = *(const LAS f32x4*)(sgb + 8 * c + 4), b0 = *(const LAS f32x4*)(sgb + 64 + 8 * c), b1 = *(const LAS f32x4*)(sgb + 64 + 8 * c + 4);
    const float gk[8] = {g0.x, g0.y, g0.z, g0.w, g1.x, g1.y, g1.z, g1.w}, bk[8] = {b0.x, b0.y, b0.z, b0.w, b1.x, b1.y, b1.z, b1.w};
#pragma unroll
    for (int j = 0; j < 4; ++j) { const int nn = (lane >> 3) + 8 * j; const LAS float* sp = scr + (8 * c) * 33 + nn;
        float v[8], bs = 0.f;
#pragma unroll
        for (int i = 0; i < 8; ++i) { const float raw = sp[i * 33]; v[i] = raw * gk[i]; bs += raw * bk[i]; }
        v4u o; o.x = pk2(v[0], v[1]); o.y = pk2(v[2], v[3]); o.z = pk2(v[4], v[5]); o.w = pk2(v[6], v[7]);
        float gs = ((blo(o.x) + bhi(o.x)) + (blo(o.y) + bhi(o.y))) + ((blo(o.z) + bhi(o.z)) + (blo(o.w) + bhi(o.w)));
        *(GAS v4u*)(WT + (size_t)(drow0 + nn) * ldt + k0 + 8 * c) = o;
        gs += __shfl_xor(gs, 1); gs += __shfl_xor(gs, 2); gs += __shfl_xor(gs, 4); bs += __shfl_xor(bs, 1); bs += __shfl_xor(bs, 2); bs += __shfl_xor(bs, 4);
        if (c == 0) { (void)__hip_atomic_fetch_add(gW + drow0 + nn, (long long)__builtin_rintf(gs * FX_V), __ATOMIC_RELAXED, __HIP_MEMORY_SCOPE_AGENT); (void)__hip_atomic_fetch_add(bW + drow0 + nn, (long long)__builtin_rintf(bs * FX_V), __ATOMIC_RELAXED, __HIP_MEMORY_SCOPE_AGENT); } }
    LDS_WAIT(); asm volatile("" ::: "memory");
}
__device__ __forceinline__ void tr_item8_ln(const float* W, int ldw, unsigned char* WT, int ldt, int k0, int n0, int drow0, float sc, const float* gain, const float* bvec, long long* gW, long long* bW, LAS float* scr, int lane) {
    const int nn = lane >> 1, hf = lane & 1; const LAS float* sp = scr + (32 * hf) * 33 + nn;
    unsigned o[8]; float gs = 0.f, bs = 0.f;
#pragma unroll
    for (int q = 0; q < 8; ++q) { const f32x4 g4 = *(const LAS f32x4*)(scr + 64 * 33 + 32 * hf + 4 * q), b4 = *(const LAS f32x4*)(scr + 64 * 33 + 64 + 32 * hf + 4 * q);
        const float r0 = sp[(4 * q + 0) * 33], r1 = sp[(4 * q + 1) * 33], r2 = sp[(4 * q + 2) * 33], r3 = sp[(4 * q + 3) * 33];
        bs += (r0 * b4.x + r1 * b4.y) + (r2 * b4.z + r3 * b4.w);
        const float a = fminf(fmaxf(r0 * g4.x * sc, -448.f), 448.f), b = fminf(fmaxf(r1 * g4.y * sc, -448.f), 448.f), c = fminf(fmaxf(r2 * g4.z * sc, -448.f), 448.f), d = fminf(fmaxf(r3 * g4.w * sc, -448.f), 448.f);
        int w = 0; w = __builtin_amdgcn_cvt_pk_fp8_f32(a, b, w, false); w = __builtin_amdgcn_cvt_pk_fp8_f32(c, d, w, true); o[q] = (unsigned)w;
        gs += (__builtin_amdgcn_cvt_f32_fp8(w, 0) + __builtin_amdgcn_cvt_f32_fp8(w, 1)) + (__builtin_amdgcn_cvt_f32_fp8(w, 2) + __builtin_amdgcn_cvt_f32_fp8(w, 3)); }
    GAS v4u* dst = (GAS v4u*)(WT + (size_t)(drow0 + nn) * ldt + k0 + 32 * hf);
    dst[0] = (v4u){o[0], o[1], o[2], o[3]}; dst[1] = (v4u){o[4], o[5], o[6], o[7]};
    gs += __shfl_xor(gs, 1); bs += __shfl_xor(bs, 1);
    if (hf == 0) { (void)__hip_atomic_fetch_add(gW + drow0 + nn, (long long)__builtin_rintf(gs / sc * FX_V), __ATOMIC_RELAXED, __HIP_MEMORY_SCOPE_AGENT); (void)__hip_atomic_fetch_add(bW + drow0 + nn, (long long)__builtin_rintf(bs * FX_V), __ATOMIC_RELAXED, __HIP_MEMORY_SCOPE_AGENT); }
    LDS_WAIT(); asm volatile("" ::: "memory");
}
__device__ __forceinline__ void cvt_item8(const float* src, unsigned char* dst, int item, int lane, float sc) {
    const GAS f32x4* sp = (const GAS f32x4*)(src + (size_t)item * 512) + 2 * lane; f32x4 a = sp[0] * sc, b = sp[1] * sc;
    int w0 = 0, w1 = 0; w0 = __builtin_amdgcn_cvt_pk_fp8_f32(fminf(fmaxf(a.x, -448.f), 448.f), fminf(fmaxf(a.y, -448.f), 448.f), w0, false); w0 = __builtin_amdgcn_cvt_pk_fp8_f32(fminf(fmaxf(a.z, -448.f), 448.f), fminf(fmaxf(a.w, -448.f), 448.f), w0, true);
    w1 = __builtin_amdgcn_cvt_pk_fp8_f32(fminf(fmaxf(b.x, -448.f), 448.f), fminf(fmaxf(b.y, -448.f), 448.f), w1, false); w1 = __builtin_amdgcn_cvt_pk_fp8_f32(fminf(fmaxf(b.z, -448.f), 448.f), fminf(fmaxf(b.w, -448.f), 448.f), w1, true);
    *((GAS v2u*)(dst + (size_t)item * 512) + lane) = (v2u){(unsigned)w0, (unsigned)w1};
}
__device__ __forceinline__ void cvt_item(const float* src, bf16* dst, int item, int lane) {
    const GAS f32x4* s = (const GAS f32x4*)(src + (size_t)item * 512) + 2 * lane; const f32x4 a = s[0], b = s[1];
    v4u o; o.x = pk2(a.x, a.y); o.y = pk2(a.z, a.w); o.z = pk2(b.x, b.y); o.w = pk2(b.z, b.w);
    *((GAS v4u*)(dst + (size_t)item * 512) + lane) = o;
}
__device__ __forceinline__ void p0_prologue(const float* const (&in)[24], unsigned char* ws, LAS unsigned char* lds, int gw, int NGW, int wave, int lane) {
    LAS float* scr = (LAS float*)(lds + RING_OFF + wave * 16384);
    long long* const vec = (long long*)(ws + WS_CTL + CTL_VEC);
#define P0_LIST(E16, E8, EL16, EL8, EUV) \
        E8(in[2], 2048, 5632, 5632, WS_W_GU1, 2048, 256 * (n0 >> 7) + (n0 & 127), FP8_WGUS)             \
        E8(in[3], 2048, 5632, 5632, WS_W_GU1, 2048, 256 * (n0 >> 7) + 128 + (n0 & 127), FP8_WGUS)       \
        E8(in[4], 5632, 2048, 2048, WS_W_D1, 5632, n0, FP8_WDS)                                        \
        EL8(in[5], 2048, 5712, 4608, WS_W_IN8, 2048, n0, FP8_WGS, in[22], in[23], V_GW_IN, V_BW_IN)     \
        EL16(in[5] + 4608, 2048, 5712, 1104, 1280, WS_W_INB, 2048, n0, in[22], in[23], V_GW_IN + 4608, V_BW_IN + 4608)     \
        EL8(in[11], 2048, 2048, 2048, WS_W_G, 2048, 256 * (n0 >> 7) + (n0 & 127), FP8_WGS, in[22], in[23], V_GW_G, V_BW_G)               \
        EL8(in[11] + (size_t)2048 * 2048, 2048, 2048, 2048, WS_W_G, 2048, 256 * (n0 >> 7) + 128 + (n0 & 127), FP8_WGS, in[22], in[23], V_GW_G, V_BW_G)     \
        EUV \
        E8(in[13], 1024, 2048, 2048, WS_W_A, 1024, n0, FP8_WAS)                                         \
        E8(in[14], 1024, 2048, 2048, WS_W_B, 1024, n0, FP8_WBS)                                         \
        E8(in[15], 2048, 2048, 2048, WS_W_MO, 2048, n0, FP8_WMOS) \
        EL16(in[16], 2048, 512, 512, 512, WS_W_MQ, 2048, n0, in[22] + D, in[23] + D, V_GW_MQ, V_BW_MQ)                     \
        E16(in[17], 2048, 1024, 1024, 1024, WS_W_MKV, 2048, n0, 0) \
        E8(in[18], 512, 2048, 2048, WS_W_MOUT, 512, n0, FP8_WMOUTS)                                     \
        EL8(in[19], 2048, 5632, 5632, WS_W_GU2, 2048, 256 * (n0 >> 7) + (n0 & 127), FP8_WGUS, in[22] + 2 * D, in[23] + 2 * D, V_GW_GU2, V_BW_GU2)            \
        EL8(in[20], 2048, 5632, 5632, WS_W_GU2, 2048, 256 * (n0 >> 7) + 128 + (n0 & 127), FP8_WGUS, in[22] + 2 * D, in[23] + 2 * D, V_GW_GU2, V_BW_GU2)      \
        E8(in[21], 5632, 2048, 2048, WS_W_D2, 5632, n0, FP8_WDS)
#define TRM(SRC, Kk, LDW, NVALID, NPAD, DST, LDT, ROWMAP, DCOL) { constexpr int nblk = (NPAD) / 32; constexpr int cnt = ((Kk) / 64) * nblk; \
        if (r < cnt) { const int kb = r / nblk, nb = r % nblk, n0 = 32 * nb; tr_item(SRC, LDW, NVALID, (bf16*)(ws + (DST)), LDT, 64 * kb, n0, (ROWMAP), (DCOL), scr, lane); break; } r -= cnt; }
#define TRM8(SRC, Kk, LDW, NN, DST, LDT, ROWMAP, SC) { constexpr int nblk = (NN) / 32; constexpr int cnt = ((Kk) / 64) * nblk; \
        if (r < cnt) { const int kb = r / nblk, nb = r % nblk, n0 = 32 * nb; tr_item8(SRC, LDW, (unsigned char*)(ws + (DST)), LDT, 64 * kb, n0, (ROWMAP), SC, scr, lane); break; } r -= cnt; }
#define TRML(SRC, Kk, LDW, NVALID, NPAD, DST, LDT, ROWMAP, GAIN, BVEC, VG, VB) { constexpr int nblk = (NPAD) / 32; constexpr int cnt = ((Kk) / 64) * nblk; \
        if (r < cnt) { const int kb = r / nblk, nb = r % nblk, n0 = 32 * nb; tr_item_ln(SRC, LDW, NVALID, (bf16*)(ws + (DST)), LDT, 64 * kb, n0, (ROWMAP), GAIN, BVEC, vec + (VG), vec + (VB), scr, lane); break; } r -= cnt; }
#define TRML8(SRC, Kk, LDW, NN, DST, LDT, ROWMAP, SC, GAIN, BVEC, VG, VB) { constexpr int nblk = (NN) / 32; constexpr int cnt = ((Kk) / 64) * nblk; \
        if (r < cnt) { const int kb = r / nblk, nb = r % nblk, n0 = 32 * nb; tr_item8_ln(SRC, LDW, (unsigned char*)(ws + (DST)), LDT, 64 * kb, n0, (ROWMAP), SC, GAIN, BVEC, vec + (VG), vec + (VB), scr, lane); break; } r -= cnt; }
#define TRUV { if (r < 256) { const int h = r >> 5, rr = r & 31, kb = rr >> 2, nb = rr & 3;                     \
            tr_item8(in[10] + (size_t)h * 512 * 128, 128, (unsigned char*)(ws + WS_W_UVP), 1024, 64 * kb, 32 * nb, (h >> 1) * 256 + (h & 1) * 128 + 32 * nb, FP8_WUVS, scr, lane, (h & 1) * 512); break; } r -= 256; }
#define LDM(SRC, Kk, LDW, NVALID, NPAD, DST, LDT, ROWMAP, DCOL) { constexpr int nblk = (NPAD) / 32; constexpr int cnt = ((Kk) / 64) * nblk; if (r < cnt) { W_ = SRC; ldw_ = LDW; nv_ = NVALID; k0_ = 64 * (r / nblk); n0_ = 32 * (r % nblk); break; } r -= cnt; }
#define LDM8(SRC, Kk, LDW, NN, DST, LDT, ROWMAP, SC) { constexpr int nblk = (NN) / 32; constexpr int cnt = ((Kk) / 64) * nblk; if (r < cnt) { W_ = SRC; ldw_ = LDW; nv_ = NN; k0_ = 64 * (r / nblk); n0_ = 32 * (r % nblk); break; } r -= cnt; }
#define LDML(SRC, Kk, LDW, NVALID, NPAD, DST, LDT, ROWMAP, GAIN, BVEC, VG, VB) { constexpr int nblk = (NPAD) / 32; constexpr int cnt = ((Kk) / 64) * nblk; if (r < cnt) { W_ = SRC; ldw_ = LDW; nv_ = NVALID; k0_ = 64 * (r / nblk); n0_ = 32 * (r % nblk); G_ = GAIN; B_ = BVEC; break; } r -= cnt; }
#define LDML8(SRC, Kk, LDW, NN, DST, LDT, ROWMAP, SC, GAIN, BVEC, VG, VB) { constexpr int nblk = (NN) / 32; constexpr int cnt = ((Kk) / 64) * nblk; if (r < cnt) { W_ = SRC; ldw_ = LDW; nv_ = NN; k0_ = 64 * (r / nblk); n0_ = 32 * (r % nblk); G_ = GAIN; B_ = BVEC; break; } r -= cnt; }
#define LDUV { if (r < 256) { const int h = r >> 5, rr = r & 31; W_ = in[10] + (size_t)h * 512 * 128; ldw_ = 128; nv_ = 128; k0_ = 64 * (rr >> 2); n0_ = 32 * (rr & 3); break; } r -= 256; }
#define P0_LOAD(IT, PV, GB, OK) do { const float* W_ = in[2]; const float* G_ = in[22]; const float* B_ = in[22]; int ldw_ = 5632, nv_ = 5632, k0_ = 0, n0_ = 0; do { int r = (IT); P0_LIST(LDM, LDM8, LDML, LDML8, LDUV) } while (0); \
        tr_load(W_, ldw_, nv_, k0_, n0_, G_, B_, lane, PV, GB, OK); } while (0)
#define P0_PROC(IT, PV, GB, OK) do { tr_stage(scr, lane, PV, GB, OK); int r = (IT); P0_LIST(TRM, TRM8, TRML, TRML8, TRUV) } while (0)
    constexpr int N_TR = 2 * (32 * 176) + 88 * 64 + 32 * 184 + 2 * (32 * 64) + 256 + 2 * (16 * 64) + 32 * 64 + 32 * 16 + 32 * 32 + 8 * 64 + 2 * (32 * 176) + 88 * 64;
    { f32x4 va[8], vb[8], vc[8], ga, gb, gc; int oa = 1, ob = 1, oc = 1;
#define P0_CL(i_) ((i_) < N_TR ? (i_) : N_TR - 1)
      P0_LOAD(P0_CL(gw), va, ga, oa);
      P0_LOAD(P0_CL(gw + NGW), vb, gb, ob);
      for (int it = gw; it < N_TR; it += 3 * NGW) {
          P0_LOAD(P0_CL(it + 2 * NGW), vc, gc, oc);
          P0_PROC(it, va, ga, oa);
          P0_LOAD(P0_CL(it + 3 * NGW), va, ga, oa);
          if (it + NGW < N_TR) P0_PROC(it + NGW, vb, gb, ob);
          P0_LOAD(P0_CL(it + 4 * NGW), vb, gb, ob);
          if (it + 2 * NGW < N_TR) P0_PROC(it + 2 * NGW, vc, gc, oc);
      }
#undef P0_CL
    }
#undef P0_LOAD
#undef P0_PROC
#undef P0_LIST
#undef TRM
#undef TRM8
#undef TRML
#undef TRML8
#undef TRUV
#undef LDM
#undef LDM8
#undef LDML
#undef LDML8
#undef LDUV
    for (int rw = gw; rw < 1024; rw += NGW) { const int e = (rw >> 7) & 1; *((GAS v2u*)((unsigned char*)(ws + WS_W_UVP) + (size_t)rw * 1024 + (1 - e) * 512) + lane) = (v2u){0u, 0u}; }
    for (int it = 4 * gw; it < (M * D) / 512; it += 4 * NGW) {
        const GAS f32x4* sp = (const GAS f32x4*)(in[0] + (size_t)it * 512) + 2 * lane; f32x4 q[8];
#pragma unroll
        for (int j = 0; j < 4; ++j) { q[2 * j] = __builtin_nontemporal_load(sp + 128 * j); q[2 * j + 1] = __builtin_nontemporal_load(sp + 128 * j + 1); }
#pragma unroll
        for (int j = 0; j < 4; ++j) { const f32x4 a = q[2 * j] * FP8_XS, b = q[2 * j + 1] * FP8_XS; int w0 = 0, w1 = 0;
            w0 = __builtin_amdgcn_cvt_pk_fp8_f32(fminf(fmaxf(a.x, -448.f), 448.f), fminf(fmaxf(a.y, -448.f), 448.f), w0, false); w0 = __builtin_amdgcn_cvt_pk_fp8_f32(fminf(fmaxf(a.z, -448.f), 448.f), fminf(fmaxf(a.w, -448.f), 448.f), w0, true);
            w1 = __builtin_amdgcn_cvt_pk_fp8_f32(fminf(fmaxf(b.x, -448.f), 448.f), fminf(fmaxf(b.y, -448.f), 448.f), w1, false); w1 = __builtin_amdgcn_cvt_pk_fp8_f32(fminf(fmaxf(b.z, -448.f), 448.f), fminf(fmaxf(b.w, -448.f), 448.f), w1, true);
            *((GAS v2u*)((unsigned char*)(ws + WS_X8) + (size_t)(it + j) * 512) + lane) = (v2u){(unsigned)w0, (unsigned)w1}; } }
    for (int it = gw; it < (BATCH * MEMT * D) / 512; it += NGW) cvt_item(in[1], (bf16*)(ws + WS_MEM16), it, lane);
    for (int it = gw; it < (8 * 512 * 128) / 512; it += NGW) cvt_item(in[9], (bf16*)(ws + WS_W_UK), it, lane);
}

__device__ __forceinline__ void ln_phase(float* zx, bf16* x16, unsigned char* x8, const float* g, const float* b, int gw, int NGW, int lane) {
    f32x4 gv[8], bv[8];
#pragma unroll
    for (int j = 0; j < 8; ++j) { gv[j] = *((const GAS f32x4*)g + lane + 64 * j); bv[j] = *((const GAS f32x4*)b + lane + 64 * j); }
    for (int m = gw; m < M; m += NGW) {
        GAS f32x4* xr = (GAS f32x4*)(zx + (size_t)m * D) + lane;
        f32x4 v[8]; float s = 0.f;
#pragma unroll
        for (int j = 0; j < 8; ++j) { v[j] = xr[64 * j]; s += (v[j].x + v[j].y) + (v[j].z + v[j].w); }
        const float mean = wave_sum(s) * (1.f / D); float s2 = 0.f;
#pragma unroll
        for (int j = 0; j < 8; ++j) { v[j] = v[j] - mean; s2 += (v[j].x * v[j].x + v[j].y * v[j].y) + (v[j].z * v[j].z + v[j].w * v[j].w); }
        const float rstd = 1.f / sqrtf(wave_sum(s2) * (1.f / D) + LN_EPS);
#pragma unroll
        for (int j = 0; j < 8; ++j) { v[j] = v[j] * rstd * gv[j] + bv[j]; xr[64 * j] = v[j]; }
        if (x16) { GAS v2u* o8 = (GAS v2u*)(x16 + (size_t)m * D) + lane;
#pragma unroll
            for (int j = 0; j < 8; ++j) o8[64 * j] = (v2u){pk2(v[j].x, v[j].y), pk2(v[j].z, v[j].w)}; }
        if (x8) { GAS unsigned* o4 = (GAS unsigned*)(x8 + (size_t)m * D) + lane;
#pragma unroll
            for (int j = 0; j < 8; ++j) { const f32x4 q = v[j] * FP8_XS; int w = 0; w = __builtin_amdgcn_cvt_pk_fp8_f32(fminf(fmaxf(q.x, -448.f), 448.f), fminf(fmaxf(q.y, -448.f), 448.f), w, false);
                w = __builtin_amdgcn_cvt_pk_fp8_f32(fminf(fmaxf(q.z, -448.f), 448.f), fminf(fmaxf(q.w, -448.f), 448.f), w, true); o4[64 * j] = (unsigned)w; } }
    }
}
__device__ __forceinline__ void ln_final_phase(const bf16* z16, float* outp, const float* g, const float* b, int gw, int NGW, int lane) {
    for (int m0 = gw; m0 < M; m0 += 2 * NGW) {
        const int m1 = m0 + NGW; const bool two = m1 < M;
        v4u w[2][4];
#pragma unroll
        for (int j = 0; j < 4; ++j) { w[0][j] = __builtin_nontemporal_load((const GAS v4u*)(z16 + (size_t)m0 * D) + lane + 64 * j); w[1][j] = two ? __builtin_nontemporal_load((const GAS v4u*)(z16 + (size_t)m1 * D) + lane + 64 * j) : (v4u){0u, 0u, 0u, 0u}; }
#pragma unroll
        for (int rr = 0; rr < 2; ++rr) { if (rr == 1 && !two) break;
            const int m = rr ? m1 : m0;
            float v[32]; float s = 0.f;
#pragma unroll
            for (int j = 0; j < 4; ++j) { const v4u x = w[rr][j]; v[8 * j + 0] = blo(x.x); v[8 * j + 1] = bhi(x.x); v[8 * j + 2] = blo(x.y); v[8 * j + 3] = bhi(x.y); v[8 * j + 4] = blo(x.z); v[8 * j + 5] = bhi(x.z); v[8 * j + 6] = blo(x.w); v[8 * j + 7] = bhi(x.w); }
#pragma unroll
            for (int e = 0; e < 32; ++e) s += v[e];
            const float mean = wave_sum(s) * (1.f / D); float s2 = 0.f;
#pragma unroll
            for (int e = 0; e < 32; ++e) { v[e] -= mean; s2 += v[e] * v[e]; }
            const float rstd = 1.f / sqrtf(wave_sum(s2) * (1.f / D) + LN_EPS);
#pragma unroll
            for (int j = 0; j < 4; ++j) { const int c0 = 512 * j + 8 * lane;
                const f32x4 g0 = *(const GAS f32x4*)(g + c0), g1 = *(const GAS f32x4*)(g + c0 + 4), b0 = *(const GAS f32x4*)(b + c0), b1 = *(const GAS f32x4*)(b + c0 + 4);
                GAS f32x4* o = (GAS f32x4*)(outp + (size_t)m * D + c0);
                __builtin_nontemporal_store((f32x4){v[8 * j + 0], v[8 * j + 1], v[8 * j + 2], v[8 * j + 3]} * rstd * g0 + b0, o); __builtin_nontemporal_store((f32x4){v[8 * j + 4], v[8 * j + 5], v[8 * j + 6], v[8 * j + 7]} * rstd * g1 + b1, o + 1); } }
    }
}
__device__ __forceinline__ void crms_phase(const bf16* bc, unsigned char* c8, const float* kvg, float cs, int gw, int NGW, int lane) {
    float gg[8];
#pragma unroll
    for (int j = 0; j < 8; ++j) gg[j] = kvg[8 * lane + j] * cs;
    for (int m0 = gw; m0 < M; m0 += 8 * NGW) {
        v4u w8[8];
#pragma unroll
        for (int r = 0; r < 8; ++r) { const int m = m0 + r * NGW < M ? m0 + r * NGW : M - 1; w8[r] = *((const GAS v4u*)(bc + (size_t)m * 512) + lane); }
#pragma unroll
        for (int r = 0; r < 8; ++r) { const int m = m0 + r * NGW; if (m < M) { const v4u w = w8[r];
            float x[8] = {blo(w.x), bhi(w.x), blo(w.y), bhi(w.y), blo(w.z), bhi(w.z), blo(w.w), bhi(w.w)}; float s = 0.f;
#pragma unroll
            for (int j = 0; j < 8; ++j) s += x[j] * x[j];
            const float rr = 1.f / sqrtf(wave_sum(s) * (1.f / 512.f) + LN_EPS);
#pragma unroll
            for (int j = 0; j < 8; ++j) x[j] = fminf(fmaxf(x[j] * rr * gg[j], -448.f), 448.f);
            *((GAS v2u*)(c8 + (size_t)m * 512) + lane) = (v2u){pg8::pk4_fp8(x[0], x[1], x[2], x[3]), pg8::pk4_fp8(x[4], x[5], x[6], x[7])}; } }
    }
}
typedef short v4i16_t __attribute__((ext_vector_type(4)));
__device__ __forceinline__ v4i16_t lds_tr16(const LAS unsigned char* p) { return __builtin_amdgcn_ds_read_tr16_b64_v4i16((LAS v4i16_t*)p); }
__device__ __forceinline__ unsigned cvtpk(float lo, float hi) { typedef float f2 __attribute__((ext_vector_type(2))); typedef __bf16 b2 __attribute__((ext_vector_type(2))); f2 v = {lo, hi}; b2 b = __builtin_convertvector(v, b2); return __builtin_bit_cast(unsigned, b); }
__device__ __forceinline__ float xhalf_f(float v) { return __shfl_xor(v, 32); }
constexpr float LOG2E = 1.4426950408889634f;
constexpr float QSCALE = 0.125f * LOG2E;

__device__ __forceinline__ void diff_attn_mfma(LAS unsigned char* lds, const bf16* AQ, const bf16* AK, const bf16* AV, bf16* YA, const float* dlam, const float* subg, unsigned* dq, const unsigned* kmax, const int wave) {
    const int lane = lane_fresh(), r32 = lane & 31, hi = lane >> 5;
    const int comp = wave >> 2, wq = wave & 3;
    const unsigned ksrc = (unsigned)(lane * 1024 + (2 * wave) * 8);
    const unsigned vsrc0 = (unsigned)((16 * ((2 * wave) & 3) + (lane >> 2)) * 1024 + ((2 * wave) >> 2) * 32 + (lane & 3) * 8);
    const unsigned vsrc1 = (unsigned)((16 * ((2 * wave + 1) & 3) + (lane >> 2)) * 1024 + ((2 * wave + 1) >> 2) * 32 + (lane & 3) * 8);
    const unsigned kdst = (unsigned)(2 * wave) * 1024u, vdst0 = 16384u + (unsigned)(((2 * wave) >> 2) * 4096 + ((2 * wave) & 3) * 1024), vdst1 = 16384u + (unsigned)(((2 * wave + 1) >> 2) * 4096 + ((2 * wave + 1) & 3) * 1024);
    const unsigned lds0 = (unsigned)(uintptr_t)lds;
#define DA_STAGE(bo, to) do { \
        glds16(Kg + (to) + ksrc, (unsigned)__builtin_amdgcn_readfirstlane((int)(lds0 + (bo) + kdst))); \
        glds16(Kg + (to) + ksrc + 8, (unsigned)__builtin_amdgcn_readfirstlane((int)(lds0 + (bo) + kdst + 1024))); \
        glds16(Vg + (to) + vsrc0, (unsigned)__builtin_amdgcn_readfirstlane((int)(lds0 + (bo) + vdst0))); \
        glds16(Vg + (to) + vsrc1, (unsigned)__builtin_amdgcn_readfirstlane((int)(lds0 + (bo) + vdst1))); } while (0)
#define DA_WAITBAR() asm volatile("s_waitcnt vmcnt(0) lgkmcnt(0)\n\ts_barrier" ::: "memory")
    const unsigned koff = (unsigned)(((comp * 8 + hi) * 64 + r32) * 16);
    const unsigned voff = (unsigned)(16384 + (4 * hi + ((lane & 15) >> 2)) * 64 + ((lane >> 4) & 1) * 32 + (lane & 3) * 8);
    LAS unsigned* xq = (LAS unsigned*)(lds + 100352);
    for (;;) {
        if (wave == 0 && lane == 0) xq[0] = __hip_atomic_fetch_add(dq, 1u, __ATOMIC_RELAXED, __HIP_MEMORY_SCOPE_AGENT);
        asm volatile("s_waitcnt vmcnt(0) lgkmcnt(0)\n\ts_barrier" ::: "memory");
        const int j = (int)xq[0];
        if (j >= 1024) break;
        const int ub = 31 - (j >> 5), bh = j & 31;
        const int b = bh >> 3, h = 7 - (bh & 7);
        const float sl2 = LOG2E / (float)(2 << h);
        const size_t rowbase = (size_t)b * SEQ; const int q0 = ub * 128;
        const int qpos = q0 + wq * 32 + r32;
        const int nt = 2 * ub + 2;
        const int myt = 2 * ub + 1 + (wq >> 1);
        const bf16* Kg = AK + rowbase * 1024 + h * 128; const bf16* Vg = AV + rowbase * 1024 + h * 128;
        bf16x8 qr[4];
#pragma unroll
        for (int s = 0; s < 4; ++s) qr[s] = *(const GAS bf16x8*)(AQ + (rowbase + qpos) * 1024 + h * 128 + comp * 64 + s * 16 + hi * 8);
        f32x16 o[4];
#pragma unroll
        for (int blk = 0; blk < 4; ++blk)
#pragma unroll
            for (int r = 0; r < 16; ++r) o[blk][r] = 0.f;
        float mrun = -INFINITY;
        f32x16 ol;
#pragma unroll
        for (int r = 0; r < 16; ++r) ol[r] = 0.f;
        const bf16x8 vones = {(short)0x3F80, (short)0x3F80, (short)0x3F80, (short)0x3F80, (short)0x3F80, (short)0x3F80, (short)0x3F80, (short)0x3F80};
        float sbr;
        { float qn2 = 0.f;
#pragma unroll
          for (int s = 0; s < 4; ++s) { const v4u w = __builtin_bit_cast(v4u, qr[s]); const float e0 = blo(w.x), e1 = bhi(w.x), e2 = blo(w.y), e3 = bhi(w.y), e4 = blo(w.z), e5 = bhi(w.z), e6 = blo(w.w), e7 = bhi(w.w);
              qn2 += ((e0 * e0 + e1 * e1) + (e2 * e2 + e3 * e3)) + ((e4 * e4 + e5 * e5) + (e6 * e6 + e7 * e7)); }
          qn2 += xhalf_f(qn2);
          const float qn2row = qn2;
#pragma unroll
          for (int o_ = 1; o_ < 32; o_ <<= 1) qn2 = fmaxf(qn2, __shfl_xor(qn2, o_));
          const unsigned* kp = kmax + ((b * 8 + h) * 2 + comp) * 2;
          const float k2 = __uint_as_float(__hip_atomic_load(kp, __ATOMIC_RELAXED, __HIP_MEMORY_SCOPE_AGENT)) + __uint_as_float(__hip_atomic_load(kp + 1, __ATOMIC_RELAXED, __HIP_MEMORY_SCOPE_AGENT));
          sbr = sqrtf(qn2row * k2) * 1.02f;
          if (lane == 0) xq[8 + wave] = __float_as_uint(sqrtf(qn2 * k2) * 1.02f); }
        DA_STAGE(0u, (size_t)(nt - 1) * 64 * 1024);
        DA_WAITBAR();
        int kt_lo = 0;
        { float sb = 0.f;
#pragma unroll
          for (int w_ = 0; w_ < 8; ++w_) sb = fmaxf(sb, __uint_as_float(xq[8 + w_]));
          const float xcut = (float)(q0 - 63) - (40.f + 2.f * sb) / sl2;
          kt_lo = xcut > 0.f ? (int)__builtin_ceilf(xcut * (1.f / 64.f)) : 0; kt_lo = __builtin_amdgcn_readfirstlane(kt_lo); }
        for (int st = 0; st < nt - kt_lo; ++st) {
            const int kt = nt - 1 - st;
            const unsigned bufo = (unsigned)(st & 1) * 32768u;
            if (kt > kt_lo) DA_STAGE(32768u - bufo, (size_t)(kt - 1) * 64 * 1024);
            if (kt < myt) {
                const LAS unsigned char* Kb = lds + bufo + koff;
                f32x16 p0, p1;
#pragma unroll
                for (int r = 0; r < 16; ++r) { p0[r] = 0.f; p1[r] = 0.f; }
                { bf16x8 kf0[4], kf1[4];
#pragma unroll
                  for (int s = 0; s < 4; ++s) { kf0[s] = *(const LAS bf16x8*)(Kb + s * 2048); kf1[s] = *(const LAS bf16x8*)(Kb + s * 2048 + 512); }
#pragma unroll
                  for (int s = 0; s < 4; ++s) { p0 = __builtin_amdgcn_mfma_f32_32x32x16_bf16(kf0[s], qr[s], p0, 0, 0, 0); p1 = __builtin_amdgcn_mfma_f32_32x32x16_bf16(kf1[s], qr[s], p1, 0, 0, 0); } }
                const float qth = (float)(qpos - kt * 64 - 4 * hi);
                float rm = -INFINITY;
#pragma unroll
                for (int r = 0; r < 16; ++r) { const float kr = (float)((r & 3) + 8 * (r >> 2)); const float v0 = qth - kr, v1 = qth - (kr + 32.f);
                    p0[r] = p0[r] - sl2 * fabsf(v0); p1[r] = p1[r] - sl2 * fabsf(v1); rm = fmaxf(rm, fmaxf(p0[r], p1[r])); }
                rm = fmaxf(rm, xhalf_f(rm));
                if (!__all(rm < mrun - 40.f ? 1 : 0)) {
                if (__any(rm > mrun)) { const float mn = fmaxf(mrun, rm), f = __builtin_amdgcn_exp2f(mrun - mn); mrun = mn;
#pragma unroll
                    for (int r = 0; r < 16; ++r) ol[r] *= f;
#pragma unroll
                    for (int blk = 0; blk < 4; ++blk)
#pragma unroll
                        for (int r = 0; r < 16; ++r) o[blk][r] *= f; }
#pragma unroll
                for (int r = 0; r < 16; ++r) { p0[r] = __builtin_amdgcn_exp2f(p0[r] - mrun); p1[r] = __builtin_amdgcn_exp2f(p1[r] - mrun); }
                bf16x8 pw[4];
#pragma unroll
                for (int s = 0; s < 2; ++s) {
                    v4u a = {cvtpk(p0[8 * s + 0], p0[8 * s + 1]), cvtpk(p0[8 * s + 2], p0[8 * s + 3]), cvtpk(p0[8 * s + 4], p0[8 * s + 5]), cvtpk(p0[8 * s + 6], p0[8 * s + 7])};
                    v4u c = {cvtpk(p1[8 * s + 0], p1[8 * s + 1]), cvtpk(p1[8 * s + 2], p1[8 * s + 3]), cvtpk(p1[8 * s + 4], p1[8 * s + 5]), cvtpk(p1[8 * s + 6], p1[8 * s + 7])};
                    pw[s] = __builtin_bit_cast(bf16x8, a); pw[2 + s] = __builtin_bit_cast(bf16x8, c); }
#pragma unroll
                for (int s = 0; s < 4; ++s) ol = __builtin_amdgcn_mfma_f32_32x32x16_bf16(vones, pw[s], ol, 0, 0, 0);
                const LAS unsigned char* Vb = lds + bufo + voff;
                { v4i16_t va[2][4][2];
#pragma unroll
                  for (int s = 0; s < 4; ++s) { va[0][s][0] = lds_tr16(Vb + s * 1024); va[0][s][1] = lds_tr16(Vb + s * 1024 + 512); }
#pragma unroll
                  for (int blk = 0; blk < 4; ++blk) {
                      if (blk < 3) {
#pragma unroll
                          for (int s = 0; s < 4; ++s) { va[(blk + 1) & 1][s][0] = lds_tr16(Vb + (blk + 1) * 4096 + s * 1024); va[(blk + 1) & 1][s][1] = lds_tr16(Vb + (blk + 1) * 4096 + s * 1024 + 512); } }
                      __builtin_amdgcn_sched_barrier(0);
#pragma unroll
                      for (int s = 0; s < 4; ++s) { const v4i16_t lo = va[blk & 1][s][0], hh = va[blk & 1][s][1];
                          const bf16x8 vf = {lo[0], lo[1], lo[2], lo[3], hh[0], hh[1], hh[2], hh[3]};
                          o[blk] = __builtin_amdgcn_mfma_f32_32x32x16_bf16(vf, pw[s], o[blk], 0, 0, 0); }
                      __builtin_amdgcn_sched_barrier(0);
                  } }
                }
            }
            { const int ktn = kt - 1;
              const bool negl = (ktn < 2 * ub) && (sbr - sl2 * (float)(qpos - (64 * ktn + 63)) < mrun - 40.f);
              const unsigned okw = __all(negl ? 1 : 0) ? 1u : 0u;
              if (lane == 0) xq[16 + (st & 1) * 8 + wave] = okw; }
            DA_WAITBAR();
            { const v4u f0 = *(const LAS v4u*)(xq + 16 + (st & 1) * 8), f1 = *(const LAS v4u*)(xq + 20 + (st & 1) * 8);
              if (__builtin_amdgcn_readfirstlane((int)(f0.x & f0.y & f0.z & f0.w & f1.x & f1.y & f1.z & f1.w))) break; }
        }
        const float inv = 1.f / ol[0];
        LAS float* Y1 = (LAS float*)(lds) + wq * 4096;
        if (comp == 1) {
            float lam; { float a = dlam[lane] * dlam[64 + lane], bq_ = dlam[128 + lane] * dlam[192 + lane]; a = wave_sum(a); bq_ = wave_sum(bq_); lam = __expf(a) - __expf(bq_) + LAMBDA_INIT; }
            const float sc = inv * lam;
#pragma unroll
            for (int blk = 0; blk < 4; ++blk)
#pragma unroll
                for (int r = 0; r < 16; ++r) Y1[(32 * blk + (r & 3) + 8 * (r >> 2) + 4 * hi) * 32 + r32] = o[blk][r] * sc; }
        __syncthreads();
        if (comp == 0) {
            float ss = 0.f;
#pragma unroll
            for (int blk = 0; blk < 4; ++blk)
#pragma unroll
                for (int r = 0; r < 16; ++r) { const float a = o[blk][r] * inv - Y1[(32 * blk + (r & 3) + 8 * (r >> 2) + 4 * hi) * 32 + r32]; o[blk][r] = a; ss += a * a; }
            ss += xhalf_f(ss);
            const float rr = (1.0f - LAMBDA_INIT) / sqrtf(ss * (1.f / 128.f) + LN_EPS);
            LAS unsigned* stg = (LAS unsigned*)(lds + 65536) + wq * (32 * 33);
            const float rs = rr * FP8_YAS;
#pragma unroll
            for (int blk = 0; blk < 4; ++blk) {
#pragma unroll
                for (int r = 0; r < 16; r += 4) { const int e = 32 * blk + 8 * (r >> 2) + 4 * hi;
                    stg[r32 * 33 + (e >> 2)] = pg8::pk4_fp8(fminf(fmaxf(o[blk][r] * rs * subg[e], -448.f), 448.f), fminf(fmaxf(o[blk][r + 1] * rs * subg[e + 1], -448.f), 448.f),
                                                           fminf(fmaxf(o[blk][r + 2] * rs * subg[e + 2], -448.f), 448.f), fminf(fmaxf(o[blk][r + 3] * rs * subg[e + 3], -448.f), 448.f)); }
                asm volatile("" ::: "memory"); }
            LDS_WAIT(); asm volatile("" ::: "memory");
            unsigned char* orow = (unsigned char*)YA + (rowbase + q0 + wq * 32) * 1024 + h * 128;
#pragma unroll 4
            for (int row = 0; row < 32; row += 2) *((GAS unsigned*)(orow + (size_t)(row + hi) * 1024) + r32) = stg[(row + hi) * 33 + r32];
        }
        __syncthreads();
    }
#undef DA_STAGE
#undef DA_WAITBAR
}

__device__ __forceinline__ unsigned okey(float f) { const unsigned u = __float_as_uint(f); return (u & 0x80000000u) ? ~u : (u | 0x80000000u); }
__device__ __forceinline__ void indexer_topk(LAS unsigned char* lds, const bf16* IQ, const bf16* IKW, unsigned short* IDX, int vcu, int G, const int wave) {
    const int lane = lane_fresh(), r32 = lane & 31, hi = lane >> 5;
    const unsigned lds0 = (unsigned)(uintptr_t)lds;
    const unsigned boff = (unsigned)((hi * 256 + r32) * 16);
#define IX_STAGE0(JJ) do { const bf16* Kg0_ = IKW + (size_t)((((JJ) & 255) >> 4) >> 2) * SEQ * 256; _Pragma("unroll") for (int i_ = 0; i_ < 4; ++i_) { const int q_ = 4 * wave + i_; \
            glds16s(Kg0_ + (size_t)(64 * (q_ & 3)) * 256 + (q_ >> 2) * 8, (unsigned)lane * 512u, (unsigned)__builtin_amdgcn_readfirstlane((int)(lds0 + ((q_ >> 2) * 256 + 64 * (q_ & 3)) * 16))); } } while (0)
    if (vcu < 1024) IX_STAGE0(vcu);
    for (int j = vcu; j < 1024; j += G) {
        const int w = j & 255, i = j >> 8, bq = w >> 4, s16 = w & 15;
        const int chunk = (i == 0) ? s16 : (i == 1) ? 31 - s16 : (i == 2) ? 32 + s16 : 63 - s16;
        const int b = bq >> 2, gq = bq & 3;
        const int t0 = b * SEQ + chunk * 64 + gq * 16 + 2 * wave;
        const int ngroups = 2 * (chunk + 1);
        const int ntiles = (ngroups + 7) >> 3;
        const bf16* Kg = IKW + (size_t)b * SEQ * 256;
#define IX_STAGE(tile, bo) do { int tl_ = (tile); asm volatile("" : "+s"(tl_)); _Pragma("unroll") for (int i_ = 0; i_ < 4; ++i_) { const int q_ = 4 * wave + i_; \
            glds16s(Kg + (size_t)(tl_ * 256 + 64 * (q_ & 3)) * 256 + (q_ >> 2) * 8, (unsigned)lane * 512u, (unsigned)__builtin_amdgcn_readfirstlane((int)(lds0 + (bo) + ((q_ >> 2) * 256 + 64 * (q_ & 3)) * 16))); } } while (0)
        unsigned pf = 0u;
        if (j + G < 1024) { const int jn = j + G, wn = jn & 255, in_ = jn >> 8, bqn = wn >> 4, sn = wn & 15;
            const int chn = (in_ == 0) ? sn : (in_ == 1) ? 31 - sn : (in_ == 2) ? 32 + sn : 63 - sn;
            const int tn0 = (bqn >> 2) * SEQ + chn * 64 + (bqn & 3) * 16 + 2 * wave;
            const bf16* pa = (lane < 32) ? IQ + (size_t)tn0 * 1024 + lane * 64 : IKW + (size_t)(tn0 + (lane & 1)) * 256 + 64;
            asm volatile("global_load_dword %0, %1, off" : "=&v"(pf) : "v"(pa) : "memory"); }
        bf16x8 a[4];
#pragma unroll
        for (int ks = 0; ks < 4; ++ks) a[ks] = *(const GAS bf16x8*)(IQ + (size_t)(t0 + (r32 >> 4)) * 1024 + (r32 & 15) * 64 + ks * 16 + 8 * hi);
        float wv[16];
        { const bf16* iwp = IKW + (size_t)t0 * 256 + 64 + 4 * hi;
          const v2u w00 = *(const GAS v2u*)(iwp), w01 = *(const GAS v2u*)(iwp + 8), w10 = *(const GAS v2u*)(iwp + 256), w11 = *(const GAS v2u*)(iwp + 256 + 8);
          wv[0] = blo(w00.x); wv[1] = bhi(w00.x); wv[2] = blo(w00.y); wv[3] = bhi(w00.y); wv[4] = blo(w01.x); wv[5] = bhi(w01.x); wv[6] = blo(w01.y); wv[7] = bhi(w01.y);
          wv[8] = blo(w10.x); wv[9] = bhi(w10.x); wv[10] = blo(w10.y); wv[11] = bhi(w10.y); wv[12] = blo(w11.x); wv[13] = bhi(w11.x); wv[14] = blo(w11.y); wv[15] = bhi(w11.y); }
        typedef float f2_t __attribute__((ext_vector_type(2)));
        f2_t w2[8];
#pragma unroll
        for (int r = 0; r < 8; ++r) w2[r] = (f2_t){wv[2 * r], wv[2 * r + 1]};
#define IX_SCORE(acc_, dst_) do { f2_t s0_ = {0.f, 0.f}, s1_ = {0.f, 0.f}; \
            _Pragma("unroll") for (int r = 0; r < 4; ++r) { \
                const f2_t x0_ = {__int_as_float(max(__float_as_int(acc_[2 * r]), 0)), __int_as_float(max(__float_as_int(acc_[2 * r + 1]), 0))}; \
                const f2_t x1_ = {__int_as_float(max(__float_as_int(acc_[8 + 2 * r]), 0)), __int_as_float(max(__float_as_int(acc_[8 + 2 * r + 1]), 0))}; \
                s0_ = __builtin_elementwise_fma(x0_, w2[r], s0_); s1_ = __builtin_elementwise_fma(x1_, w2[4 + r], s1_); } \
            const auto rr_ = __builtin_amdgcn_permlane32_swap(__float_as_uint(s0_.x + s0_.y), __float_as_uint(s1_.x + s1_.y), false, false); \
            const unsigned u_ = __float_as_uint(__uint_as_float(rr_[0]) + __uint_as_float(rr_[1])); \
            dst_ = u_ ^ ((unsigned)((int)u_ >> 31) | 0x80000000u); } while (0)
        unsigned key[128];
#pragma unroll 64
        for (int g = 0; g < 128; g += 2) {
            if (g < ngroups) {
                const unsigned bufo = (unsigned)((g >> 3) & 1) * 32768u;
                if ((g & 7) == 0) {
                    asm volatile("s_waitcnt vmcnt(0)\n\ts_barrier" ::: "memory");
                    if (g == 0) asm volatile("" :: "v"(pf));
                    if ((g >> 3) + 1 < ntiles) IX_STAGE((g >> 3) + 1, 32768u - bufo);
                }
                bf16x8 bk0[4], bk1[4];
#pragma unroll
                for (int ks = 0; ks < 4; ++ks) { bk0[ks] = *(const LAS bf16x8*)(lds + bufo + boff + (g & 7) * 512 + ks * 8192); bk1[ks] = *(const LAS bf16x8*)(lds + bufo + boff + ((g + 1) & 7) * 512 + ks * 8192); }
                f32x16 acc0 = {0.f, 0.f, 0.f, 0.f, 0.f, 0.f, 0.f, 0.f, 0.f, 0.f, 0.f, 0.f, 0.f, 0.f, 0.f, 0.f}, acc1 = acc0;
#pragma unroll
                for (int ks = 0; ks < 4; ++ks) acc0 = __builtin_amdgcn_mfma_f32_32x32x16_bf16(a[ks], bk0[ks], acc0, 0, 0, 0);
#pragma unroll
                for (int ks = 0; ks < 4; ++ks) acc1 = __builtin_amdgcn_mfma_f32_32x32x16_bf16(a[ks], bk1[ks], acc1, 0, 0, 0);
                IX_SCORE(acc0, key[g]); IX_SCORE(acc1, key[g + 1]);
            } else { key[g] = 0u; key[g + 1] = 0u; }
        }
#undef IX_SCORE
        asm volatile("s_waitcnt lgkmcnt(0)\n\ts_barrier" ::: "memory");
        if (j + G < 1024) IX_STAGE0(j + G);
        unsigned selw[4];
        { unsigned vm[4];
#pragma unroll
          for (int w_ = 0; w_ < 4; ++w_) { const int n_ = ngroups - 32 * w_; vm[w_] = n_ >= 32 ? 0xffffffffu : (n_ <= 0 ? 0u : ((1u << (n_ & 31)) - 1u)); }
          if (chunk >= 4) {
#pragma unroll
              for (int w_ = 0; w_ < 4; ++w_) { if (32 * w_ < ngroups) {
#pragma unroll
                  for (int i_ = 0; i_ < 16; ++i_) { const unsigned x = key[32 * w_ + i_], y = key[32 * w_ + i_ + 16]; key[32 * w_ + i_] = (x & 0x0000ffffu) | (y << 16); key[32 * w_ + i_ + 16] = (x >> 16) | (y & 0xffff0000u); }
#pragma unroll
                  for (int i_ = 0; i_ < 32; ++i_) { if (!(i_ & 8)) { const unsigned x = key[32 * w_ + i_], y = key[32 * w_ + i_ + 8]; key[32 * w_ + i_] = (x & 0x00ff00ffu) | ((y << 8) & 0xff00ff00u); key[32 * w_ + i_ + 8] = ((x >> 8) & 0x00ff00ffu) | (y & 0xff00ff00u); } }
#pragma unroll
                  for (int i_ = 0; i_ < 32; ++i_) { if (!(i_ & 4)) { const unsigned x = key[32 * w_ + i_], y = key[32 * w_ + i_ + 4]; key[32 * w_ + i_] = (x & 0x0f0f0f0fu) | ((y << 4) & 0xf0f0f0f0u); key[32 * w_ + i_ + 4] = ((x >> 4) & 0x0f0f0f0fu) | (y & 0xf0f0f0f0u); } }
#pragma unroll
                  for (int i_ = 0; i_ < 32; ++i_) { if (!(i_ & 2)) { const unsigned x = key[32 * w_ + i_], y = key[32 * w_ + i_ + 2]; key[32 * w_ + i_] = (x & 0x33333333u) | ((y << 2) & 0xccccccccu); key[32 * w_ + i_ + 2] = ((x >> 2) & 0x33333333u) | (y & 0xccccccccu); } }
#pragma unroll
                  for (int i_ = 0; i_ < 32; ++i_) { if (!(i_ & 1)) { const unsigned x = key[32 * w_ + i_], y = key[32 * w_ + i_ + 1]; key[32 * w_ + i_] = (x & 0x55555555u) | ((y << 1) & 0xaaaaaaaau); key[32 * w_ + i_ + 1] = ((x >> 1) & 0x55555555u) | (y & 0xaaaaaaaau); } }
              } }
              unsigned cand[4] = {vm[0], vm[1], vm[2], vm[3]}, abv[4] = {0u, 0u, 0u, 0u}; int nab = 0; bool done = false;
#pragma unroll 32
              for (int bit = 31; bit >= 0; --bit) {
                  if (__all(done ? 1 : 0)) break;
                  const unsigned o0 = cand[0] & key[bit], o1 = cand[1] & key[32 + bit], o2 = cand[2] & key[64 + bit], o3 = cand[3] & key[96 + bit];
                  const int c = half_sum_i32(__popc(o0) + __popc(o1) + __popc(o2) + __popc(o3));
                  const bool take = nab + c >= 256;
                  done = done || (take && nab + c == 256);
                  const unsigned ntm = take ? 0u : 0xffffffffu;
                  nab += c & (int)ntm;
                  abv[0] |= o0 & ntm; abv[1] |= o1 & ntm; abv[2] |= o2 & ntm; abv[3] |= o3 & ntm;
                  cand[0] = o0 ^ (cand[0] & ntm); cand[1] = o1 ^ (cand[1] & ntm); cand[2] = o2 ^ (cand[2] & ntm); cand[3] = o3 ^ (cand[3] & ntm);
              }
#pragma unroll
              for (int w_ = 0; w_ < 4; ++w_) selw[w_] = abv[w_] | cand[w_];
          } else {
#pragma unroll
              for (int w_ = 0; w_ < 4; ++w_) selw[w_] = vm[w_];
          } }
        int base = 0;
        LAS unsigned short* ip = (LAS unsigned short*)(lds + 65536 + wave * 1024) + hi * 256;
#pragma unroll
        for (int g = 0; g < 128; ++g) {
            if (g < ngroups) {
                const bool sel = ((selw[g >> 5] >> (g & 31)) & 1u) != 0u;
                const unsigned long long mk = __ballot(sel ? 1 : 0);
                const unsigned mh = hi ? (unsigned)(mk >> 32) : (unsigned)mk;
                const int pos = base + __popc(mh & ((1u << r32) - 1u));
                if (sel && pos < 256) ip[pos] = (unsigned short)(32 * g + r32);
                base += __popc(mh);
            }
        }
        asm volatile("s_waitcnt lgkmcnt(0)" ::: "memory");
        { const v4u row = *(const LAS v4u*)(lds + 65536 + wave * 1024 + lane * 16);
          *(GAS v4u*)(IDX + (size_t)(t0 + hi) * 256 + r32 * 8) = row; }
        asm volatile("s_waitcnt lgkmcnt(0)" ::: "memory");
    }
#undef IX_STAGE
#undef IX_STAGE0
    asm volatile("s_waitcnt vmcnt(0) lgkmcnt(0)\n\ts_barrier" ::: "memory");
}

constexpr int DSA_PAIRB = 1040;
constexpr int DSA_WAVEB = 16 * DSA_PAIRB + 2048;
constexpr int DSA_LDS_END = 8 * DSA_WAVEB;
constexpr float DSA_CS = 64.f, DSA_QS = 64.f, DSA_PS = 256.f, DSA_OS = 64.f;
typedef int v2i_t __attribute__((ext_vector_type(2)));
__device__ __forceinline__ void dsa_mfma(LAS unsigned char* lds, const bf16* QL, bf16* OL, const int omask, const unsigned char* C8, const unsigned short* IDX, int vcu, int G, const int wave) {
    const int lane = lane_fresh(), h16 = lane & 15, g = lane >> 4;
    LAS unsigned char* wl = lds + wave * DSA_WAVEB;
    const unsigned wl0 = (unsigned)(uintptr_t)wl;
    const unsigned ib0 = (unsigned)(uintptr_t)(wl + 16 * DSA_PAIRB);
    const float sc2 = 0.08838834764831845f * LOG2E / (DSA_QS * DSA_CS);
    const float sl2 = (h16 < 8) ? LOG2E / (float)(2 << (h16 & 7)) : 0.f;
    const int ntok = (G == 256) ? 8 : (M - (vcu * 8 + wave) + G * 8 - 1) / (G * 8);
#define DSA_TOK(i) ((G == 256) ? ((vcu >> 6) * SEQ + (vcu & 63) + 64 * (wave + 8 * (i))) : (vcu * 8 + wave + G * 8 * (i)))
    const unsigned qk_off = (unsigned)((h16 >> 1) * DSA_PAIRB + (h16 & 1) * 512 + 32 * g);
    const int trow = (h16 >> 1) < 4 ? 4 * g + (h16 >> 1) : 16 + 4 * g + ((h16 >> 1) - 4);
    const unsigned pv_off = (unsigned)((trow >> 1) * DSA_PAIRB + (trow & 1) * 512 + 8 * (h16 & 1));
    glds16(IDX + (size_t)DSA_TOK(0) * 256 + (lane & 31) * 8 + (lane >> 5) * 256, (unsigned)__builtin_amdgcn_readfirstlane((int)ib0));
    for (int it = 0; it < ntok; ++it) {
        LAS unsigned short* idxs = (LAS unsigned short*)(wl + 16 * DSA_PAIRB + (it & 1) * 1024);
        const int t = DSA_TOK(it); const int tpos = t & (SEQ - 1);
        const int n = (tpos >> 6) >= 3 ? 256 : 64 * ((tpos >> 6) + 1); const int nst = n >> 5;
        const unsigned char* Cb = C8 + (size_t)(t >> 12) * SEQ * 512;
        int ln = lane; asm volatile("" : "+v"(ln));
        const int h16b = ln & 15, gb = ln >> 4;
        if (it + 1 < ntok) glds16(IDX + (size_t)DSA_TOK(it + 1) * 256 + (ln & 31) * 8 + (ln >> 5) * 256, (unsigned)__builtin_amdgcn_readfirstlane((int)(ib0 + ((it + 1) & 1) * 1024)));
        pg8::v8i_t qf[4];
        { const unsigned char* qp = (const unsigned char*)QL + (size_t)t * 8192 + (h16b & 7) * 512 + 32 * gb;
#pragma unroll
          for (int s = 0; s < 4; ++s) { const v4u lo = __builtin_nontemporal_load((const GAS v4u*)(qp + 128 * s)), hi = __builtin_nontemporal_load((const GAS v4u*)(qp + 128 * s + 16));
              qf[s] = (pg8::v8i_t){(int)lo.x, (int)lo.y, (int)lo.z, (int)lo.w, (int)hi.x, (int)hi.y, (int)hi.z, (int)hi.w}; } }
        unsigned pf = 0u;
        if (it + 1 < ntok) { const int tn = DSA_TOK(it + 1);
            const unsigned char* pa = (const unsigned char*)QL + (size_t)tn * 8192 + (ln & 31) * 128;
            asm volatile("global_load_dword %0, %1, off" : "=&v"(pf) : "v"(pa) : "memory"); }
        f32x4 o[32];
#pragma unroll
        for (int blk = 0; blk < 32; ++blk) o[blk] = (f32x4){0.f, 0.f, 0.f, 0.f};
        float mrun = -INFINITY, lrun = 0.f;
        asm volatile("s_waitcnt lgkmcnt(0)" ::: "memory");
#define DSA_GATHER(IDXS_, CB_, ST_) do { const LAS v4u* ip4 = (const LAS v4u*)((IDXS_) + (ST_) * 32); \
              const v4u q0 = ip4[0], q1 = ip4[1], q2 = ip4[2], q3 = ip4[3]; \
              const unsigned iw[16] = {q0.x, q0.y, q0.z, q0.w, q1.x, q1.y, q1.z, q1.w, q2.x, q2.y, q2.z, q2.w, q3.x, q3.y, q3.z, q3.w}; \
              const unsigned sh = (unsigned)(ln >> 5) * 16u, lo16 = (unsigned)(ln & 31) * 16u; \
              unsigned vo[16]; \
              _Pragma("unroll") for (int i = 0; i < 16; ++i) vo[i] = ((iw[i] >> sh) & 0xffffu) * 512u + lo16; \
              glds16s_x16((CB_), vo, (unsigned)__builtin_amdgcn_readfirstlane((int)wl0)); } while (0)
        if (it == 0) { asm volatile("s_waitcnt vmcnt(0)" ::: "memory"); DSA_GATHER(idxs, Cb, nst - 1); }
        asm volatile("s_waitcnt vmcnt(16)" : "+v"(qf[0]), "+v"(qf[1]), "+v"(qf[2]), "+v"(qf[3]) :: "memory");
        asm volatile("" :: "v"(pf));
        for (int k = 0; k < nst; ++k) { const int st = nst - 1 - k;
            asm volatile("s_waitcnt vmcnt(8)" ::: "memory");
            f32x4 a0 = {0.f, 0.f, 0.f, 0.f}, a1 = {0.f, 0.f, 0.f, 0.f};
#pragma unroll
            for (int s = 0; s < 4; ++s) {
                const pg8::v4i_t x0 = *(const LAS pg8::v4i_t*)(wl + qk_off + 128 * s), x1 = *(const LAS pg8::v4i_t*)(wl + qk_off + 128 * s + 16);
                a0 = __builtin_amdgcn_mfma_scale_f32_16x16x128_f8f6f4(__builtin_shufflevector(x0, x1, 0, 1, 2, 3, 4, 5, 6, 7), qf[s], a0, 0, 0, 0, 0x7f7f7f7f, 0, 0x7f7f7f7f); }
            asm volatile("s_waitcnt vmcnt(0)" ::: "memory");
#pragma unroll
            for (int s = 0; s < 4; ++s) {
                const pg8::v4i_t y0 = *(const LAS pg8::v4i_t*)(wl + qk_off + 8 * DSA_PAIRB + 128 * s), y1 = *(const LAS pg8::v4i_t*)(wl + qk_off + 8 * DSA_PAIRB + 128 * s + 16);
                a1 = __builtin_amdgcn_mfma_scale_f32_16x16x128_f8f6f4(__builtin_shufflevector(y0, y1, 0, 1, 2, 3, 4, 5, 6, 7), qf[s], a1, 0, 0, 0, 0x7f7f7f7f, 0, 0x7f7f7f7f); }
            const v2u i0 = *(const LAS v2u*)(idxs + st * 32 + 4 * g), i1 = *(const LAS v2u*)(idxs + st * 32 + 16 + 4 * g);
            const int sidx[8] = {(int)(i0.x & 0xffffu), (int)(i0.x >> 16), (int)(i0.y & 0xffffu), (int)(i0.y >> 16), (int)(i1.x & 0xffffu), (int)(i1.x >> 16), (int)(i1.y & 0xffffu), (int)(i1.y >> 16)};
            float lg[8];
#pragma unroll
            for (int r = 0; r < 8; ++r) { const int d = tpos - sidx[r]; lg[r] = (r < 4 ? a0[r & 3] : a1[r & 3]) * sc2 - sl2 * (float)(d < 0 ? -d : d); }
            float rm = fmaxf(fmaxf(fmaxf(lg[0], lg[1]), fmaxf(lg[2], lg[3])), fmaxf(fmaxf(lg[4], lg[5]), fmaxf(lg[6], lg[7])));
            { const auto r1 = __builtin_amdgcn_permlane16_swap(__float_as_uint(rm), __float_as_uint(rm), false, false); rm = fmaxf(__uint_as_float(r1[0]), __uint_as_float(r1[1])); }
            rm = xhalf_max(rm);
            const float mn = fmaxf(mrun, rm), f = __builtin_amdgcn_exp2f(mrun - mn); mrun = mn;
#pragma unroll
            for (int r = 0; r < 8; ++r) lg[r] = __builtin_amdgcn_exp2f(lg[r] - mn) * DSA_PS;
            const unsigned pw0 = pg8::pk4_fp8(lg[0], lg[1], lg[2], lg[3]), pw1 = pg8::pk4_fp8(lg[4], lg[5], lg[6], lg[7]);
            { const float ps = ((__builtin_amdgcn_cvt_f32_fp8((int)pw0, 0) + __builtin_amdgcn_cvt_f32_fp8((int)pw0, 1)) + (__builtin_amdgcn_cvt_f32_fp8((int)pw0, 2) + __builtin_amdgcn_cvt_f32_fp8((int)pw0, 3)))
                           + ((__builtin_amdgcn_cvt_f32_fp8((int)pw1, 0) + __builtin_amdgcn_cvt_f32_fp8((int)pw1, 1)) + (__builtin_amdgcn_cvt_f32_fp8((int)pw1, 2) + __builtin_amdgcn_cvt_f32_fp8((int)pw1, 3)));
              lrun = lrun * f + ps; }
            const long pw = (long)(((unsigned long)pw1 << 32) | (unsigned long)pw0);
            if (__any(f != 1.f)) {
#pragma unroll
                for (int blk = 0; blk < 32; ++blk) o[blk] = o[blk] * f; }
            { v2i_t av[2][4];
#pragma unroll
              for (int i = 0; i < 4; ++i) av[0][i] = __builtin_amdgcn_ds_read_tr8_b64_v2i32((LAS v2i_t*)(wl + pv_off + 16 * i));
#pragma unroll
              for (int grp = 0; grp < 8; ++grp) {
                  if (grp < 7) {
#pragma unroll
                      for (int i = 0; i < 4; ++i) av[(grp + 1) & 1][i] = __builtin_amdgcn_ds_read_tr8_b64_v2i32((LAS v2i_t*)(wl + pv_off + 16 * (4 * grp + 4 + i))); }
                  __builtin_amdgcn_sched_barrier(0);
#pragma unroll
                  for (int i = 0; i < 4; ++i) { const v2i_t a_ = av[grp & 1][i];
                      const long al = (long)(((unsigned long)(unsigned)a_.y << 32) | (unsigned long)(unsigned)a_.x);
                      o[4 * grp + i] = __builtin_amdgcn_mfma_f32_16x16x32_fp8_fp8(al, pw, o[4 * grp + i], 0, 0, 0); }
                  __builtin_amdgcn_sched_barrier(0);
              } }
            asm volatile("s_waitcnt lgkmcnt(0)" ::: "memory");
            if (k + 1 < nst) DSA_GATHER(idxs, Cb, st - 1);
            else if (it + 1 < ntok) { const int tn = DSA_TOK(it + 1), tpn = tn & (SEQ - 1); const int nn = (tpn >> 6) >= 3 ? 256 : 64 * ((tpn >> 6) + 1);
                DSA_GATHER((LAS unsigned short*)(wl + 16 * DSA_PAIRB + ((it + 1) & 1) * 1024), C8 + (size_t)(tn >> 12) * SEQ * 512, (nn >> 5) - 1); }
        }
#undef DSA_GATHER
        float lt = lrun; lt += __shfl_xor(lt, 16); lt += __shfl_xor(lt, 32);
        const float inv = 1.f / (lt * DSA_CS);
        if (h16 < 8) {
#pragma unroll
            for (int blk = 0; blk < 32; ++blk) { const f32x4 v = o[blk] * (inv * DSA_OS);
                __builtin_nontemporal_store(pg8::pk4_fp8(fminf(fmaxf(v.x, -448.f), 448.f), fminf(fmaxf(v.y, -448.f), 448.f), fminf(fmaxf(v.z, -448.f), 448.f), fminf(fmaxf(v.w, -448.f), 448.f)),
                                            (GAS unsigned*)((unsigned char*)OL + (size_t)(t & omask) * 8192 + h16b * 512 + 16 * blk + 4 * gb)); } }
    }
    asm volatile("s_waitcnt vmcnt(0) lgkmcnt(0)" ::: "memory");
    __syncthreads();
#undef DSA_TOK
}
static_assert(DSA_LDS_END <= RING_BYTES, "DSA LDS map");

__device__ __forceinline__ void memattn_mfma(LAS unsigned char* lds, const bf16* QM, const bf16* KV, bf16* OM, int vcu, int G, const int wave) {
    const int lane = lane_fresh(), r32 = lane & 31, hi = lane >> 5;
    const unsigned voff = (unsigned)(65536 + (4 * hi + ((lane & 15) >> 2)) * 64 + ((lane >> 4) & 1) * 32 + (lane & 3) * 8);
    for (int j = vcu; j < 256; j += G) {
        const int bh = j >> 4, qb = j & 15, b = bh >> 2, h = bh & 3;
        const bf16* Kg = KV + (size_t)b * MEMT * 1024 + h * 128; const bf16* Vg = Kg + 512;
#pragma unroll
        for (int i = 0; i < 8; ++i) { const int q = 8 * wave + i;
            glds16(Kg + (size_t)(64 * (q & 3) + lane) * 1024 + (q >> 2) * 8, (unsigned)__builtin_amdgcn_readfirstlane((int)((unsigned)(uintptr_t)lds + ((q >> 2) * 256 + 64 * (q & 3)) * 16)));
            glds16(Vg + (size_t)(16 * (q & 15) + (lane >> 2)) * 1024 + (q >> 4) * 32 + (lane & 3) * 8, (unsigned)__builtin_amdgcn_readfirstlane((int)((unsigned)(uintptr_t)lds + 65536 + (q >> 4) * 16384 + (q & 15) * 1024))); }
        const size_t qrow = (size_t)b * SEQ + qb * 256 + wave * 32 + r32;
        bf16x8 qr[8];
#pragma unroll
        for (int s = 0; s < 8; ++s) { const v4u qa = *(const GAS v4u*)(QM + qrow * 512 + h * 128 + s * 16 + hi * 8), qb_ = *(const GAS v4u*)(QM + (size_t)M * 512 + qrow * 512 + h * 128 + s * 16 + hi * 8);
            const v4u qs = {cvtpk(blo(qa.x) + blo(qb_.x), bhi(qa.x) + bhi(qb_.x)), cvtpk(blo(qa.y) + blo(qb_.y), bhi(qa.y) + bhi(qb_.y)), cvtpk(blo(qa.z) + blo(qb_.z), bhi(qa.z) + bhi(qb_.z)), cvtpk(blo(qa.w) + blo(qb_.w), bhi(qa.w) + bhi(qb_.w))};
            qr[s] = __builtin_bit_cast(bf16x8, qs); }
        f32x16 o[4];
#pragma unroll
        for (int blk = 0; blk < 4; ++blk)
#pragma unroll
            for (int r = 0; r < 16; ++r) o[blk][r] = 0.f;
        float mrun = -INFINITY, lrun = 0.f;
        asm volatile("s_waitcnt vmcnt(0) lgkmcnt(0)\n\ts_barrier" ::: "memory");
        for (int kt = 0; kt < 4; ++kt) {
            const LAS unsigned char* Kb = lds + (unsigned)((hi * 256 + 64 * kt + r32) * 16);
            f32x16 p0, p1;
#pragma unroll
            for (int r = 0; r < 16; ++r) { p0[r] = 0.f; p1[r] = 0.f; }
#pragma unroll
            for (int s = 0; s < 8; ++s) { const bf16x8 k0 = *(const LAS bf16x8*)(Kb + s * 8192), k1 = *(const LAS bf16x8*)(Kb + s * 8192 + 512);
                p0 = __builtin_amdgcn_mfma_f32_32x32x16_bf16(k0, qr[s], p0, 0, 0, 0); p1 = __builtin_amdgcn_mfma_f32_32x32x16_bf16(k1, qr[s], p1, 0, 0, 0); }
            float rm = -INFINITY;
#pragma unroll
            for (int r = 0; r < 16; ++r) rm = fmaxf(rm, fmaxf(p0[r], p1[r]));
            rm = fmaxf(rm, xhalf_f(rm));
            if (__any(rm > mrun)) { const float mn = fmaxf(mrun, rm), f = __builtin_amdgcn_exp2f(mrun - mn); mrun = mn; lrun *= f;
#pragma unroll
                for (int blk = 0; blk < 4; ++blk)
#pragma unroll
                    for (int r = 0; r < 16; ++r) o[blk][r] *= f; }
            float ls = 0.f;
#pragma unroll
            for (int r = 0; r < 16; ++r) { p0[r] = __builtin_amdgcn_exp2f(p0[r] - mrun); p1[r] = __builtin_amdgcn_exp2f(p1[r] - mrun); ls += p0[r] + p1[r]; }
            lrun += ls;
            bf16x8 pw[4];
#pragma unroll
            for (int s = 0; s < 2; ++s) {
                v4u a = {cvtpk(p0[8 * s + 0], p0[8 * s + 1]), cvtpk(p0[8 * s + 2], p0[8 * s + 3]), cvtpk(p0[8 * s + 4], p0[8 * s + 5]), cvtpk(p0[8 * s + 6], p0[8 * s + 7])};
                v4u c = {cvtpk(p1[8 * s + 0], p1[8 * s + 1]), cvtpk(p1[8 * s + 2], p1[8 * s + 3]), cvtpk(p1[8 * s + 4], p1[8 * s + 5]), cvtpk(p1[8 * s + 6], p1[8 * s + 7])};
                pw[s] = __builtin_bit_cast(bf16x8, a); pw[2 + s] = __builtin_bit_cast(bf16x8, c); }
            const LAS unsigned char* Vb = lds + voff + kt * 4096;
#pragma unroll
            for (int blk = 0; blk < 4; ++blk) {
#pragma unroll
                for (int s = 0; s < 4; ++s) {
                    const v4i16_t lo = lds_tr16(Vb + blk * 16384 + s * 1024), hh = lds_tr16(Vb + blk * 16384 + s * 1024 + 512);
                    const bf16x8 vf = {lo[0], lo[1], lo[2], lo[3], hh[0], hh[1], hh[2], hh[3]};
                    o[blk] = __builtin_amdgcn_mfma_f32_32x32x16_bf16(vf, pw[s], o[blk], 0, 0, 0);
                }
            }
        }
        __syncthreads();
        lrun += xhalf_f(lrun);
        const float inv = 1.f / lrun;
        LAS unsigned* stg = (LAS unsigned*)(lds) + wave * (32 * 33);
        const float is = inv * FP8_OMS;
#pragma unroll
        for (int blk = 0; blk < 4; ++blk)
#pragma unroll
            for (int r = 0; r < 16; r += 4) { const int e = 32 * blk + 8 * (r >> 2) + 4 * hi;
                stg[r32 * 33 + (e >> 2)] = pg8::pk4_fp8(fminf(fmaxf(o[blk][r] * is, -448.f), 448.f), fminf(fmaxf(o[blk][r + 1] * is, -448.f), 448.f), fminf(fmaxf(o[blk][r + 2] * is, -448.f), 448.f), fminf(fmaxf(o[blk][r + 3] * is, -448.f), 448.f)); }
        LDS_WAIT(); asm volatile("" ::: "memory");
        unsigned char* orow = (unsigned char*)OM + ((size_t)b * SEQ + qb * 256 + wave * 32) * 512 + h * 128;
#pragma unroll 4
        for (int row = 0; row < 32; row += 2) *((GAS unsigned*)(orow + (size_t)(row + hi) * 512) + r32) = stg[(row + hi) * 33 + r32];
        __syncthreads();
    }
}

constexpr int N_PHASES = 21;
struct Args { const float* in[24]; float* out; unsigned char* ws; int ph_lo, ph_hi; };
__global__ void __launch_bounds__(NWAVES * 64, 2) mk_fwd(Args args) {
    extern __shared__ __attribute__((aligned(16))) unsigned char lds_raw[];
    LAS unsigned char* lds = (LAS unsigned char*)lds_raw;
    volatile LAS unsigned* MISC = (volatile LAS unsigned*)(lds + MISC_OFF);
    const int tid = threadIdx.x, wave = __builtin_amdgcn_readfirstlane(tid >> 6);
#define lane lane_fresh()
    const int G = gridDim.x; int bx = blockIdx.x;
    int vcu = (G % 8 == 0) ? (bx % 8) * (G / 8) + bx / 8 : bx;
    int gw = vcu * NWAVES + wave; const int NGW = G * NWAVES;
    unsigned char* ws = args.ws;
    gu32* ctl = (gu32*)(ws + WS_CTL);
    for (int u = tid; u < (LDS_BYTES - LDSCTL_OFF) / 4; u += NWAVES * 64) ((LAS unsigned*)(lds + LDSCTL_OFF))[u] = 0u;
    __syncthreads();
    const bool one = (args.ph_hi - args.ph_lo) > 1;
    XcdBarrier bar; bar.bar = (unsigned*)(ctl + CW_BAR); bar.x = 0; bar.st = nullptr;
    if (one) bar = xcd_barrier_post((unsigned*)(ctl + CW_BAR), MISC + 8, tid == 0);
    const int lo = args.ph_lo, hi = args.ph_hi;
#ifndef PH_MASK
#define PH_MASK 0xFFFFFFFFu
#endif
#define IN(k) ((((PH_MASK) >> (k)) & 1u) && lo <= (k) && (k) < hi)
#define SEAM(k) do { if (IN(k) && IN((k) + 1)) xcd_barrier(bar, wave); } while (0)
    bf16* const X16 = (bf16*)(ws + WS_X16); bf16* const HB = (bf16*)(ws + WS_H);
    long long* const ST0 = (long long*)(ws + WS_CTL + CTL_STATS); long long* const ST1 = (long long*)(ws + WS_CTL + CTL_STATS + CTL_STATS_STRIDE); long long* const ST2 = (long long*)(ws + WS_CTL + CTL_STATS + 2 * CTL_STATS_STRIDE);
    const float* const VEC = (const float*)(ws + WS_CTL + CTL_VECF);
    float* const out = args.out;
    const float* const ln_g = args.in[22]; const float* const ln_b = args.in[23];
    using namespace pg8;

#ifdef PROBE_P0
    if (IN(0)) { p0_prologue(args.in, ws, lds, gw, NGW, wave, lane); }
#endif
    if (IN(0)) { p0_prologue(args.in, ws, lds, gw, NGW, wave, lane); }
    SEAM(0);
    if (one && IN(0) && (G % 8) == 0) {
        unsigned* xb = (unsigned*)(ctl + CW_BAR); bool even = true;
#pragma unroll
        for (int jx = 0; jx < 16; ++jx) { const unsigned c = xb_ld(&xb[XB_XCNT(jx)]); even = even && (jx < 8 ? c == (unsigned)(G / 8) : c == 0u); }
        const int rank = (int)MISC[10], xcc = (int)xb_xcc_id();
        if (__builtin_amdgcn_readfirstlane(even ? 1 : 0)) { vcu = __builtin_amdgcn_readfirstlane(xcc * (G / 8) + rank); bx = __builtin_amdgcn_readfirstlane(rank * 8 + xcc); gw = vcu * NWAVES + wave; }
    }
    if (IN(1)) { { const long long* vi = (const long long*)(ws + WS_CTL + CTL_VEC); float* vf = (float*)(ws + WS_CTL + CTL_VECF); for (int i = gw * 64 + lane; i < V_END; i += NGW * 64) vf[i] = (float)vi[i] * (1.0f / 16777216.f); }
        Gemm g{(const bf16*)(ws + WS_X8), (const bf16*)(ws + WS_W_GU1), D / 2, D / 2, D / 2, 0, 0}; StaticOrder S; S.init(M, 2 * FF, G, bx); EpiSwiGLU8 E{(unsigned char*)HB, FF, 1.0f / (FP8_XS * FP8_WGUS), FP8_HS, LnFold{nullptr, nullptr, nullptr}};
        gemm_phase<EpiSwiGLU8, StaticOrder, true, true>(lds + RING_OFF, g, S, E, wave); }
    SEAM(1);
    if (IN(2)) { Gemm g{HB, (const bf16*)(ws + WS_W_D1), FF / 2, FF / 2, FF / 2, 0, 0}; StaticOrder S; S.init(M, D, G, bx); EpiRes<true> E{args.in[0], nullptr, D, ALPHA, 0.5f / (FP8_HS * FP8_WDS), nullptr, nullptr, nullptr, ST0, X16, (unsigned char*)(ws + WS_X8M), FP8_XS};
        gemm_phase<EpiRes<true>, StaticOrder, true, true>(lds + RING_OFF, g, S, E, wave); }
    SEAM(2);
    if (IN(4)) {
        const bool sp4 = (G == 256);
        { Gemm g{(const bf16*)(ws + WS_X8M), (const bf16*)(ws + WS_W_IN8), D / 2, D / 2, D / 2, 0, 0}; StaticOrder S; S.init(M, N_IN8, sp4 ? 168 : G, sp4 ? (bx < 168 ? bx : (1 << 20)) : bx);
          EpiInProj E{(bf16*)(ws + WS_AQ), (bf16*)(ws + WS_AK), (bf16*)(ws + WS_AV), (bf16*)(ws + WS_BQ), (bf16*)(ws + WS_BC), (bf16*)(ws + WS_IQ), (bf16*)(ws + WS_IKW), QSCALE, LnFold{ST0, VEC + V_GW_IN, VEC + V_BW_IN}, (unsigned*)(ctl + CW_KMAX), 0, 1.0f / (FP8_XS * FP8_WGS)};
          gemm_phase<EpiInProj, StaticOrder, true, true>(lds + RING_OFF, g, S, E, wave); }
        { Gemm g{X16, (const bf16*)(ws + WS_W_INB), D, D, D, 0, 0}; StaticOrder S; S.init(M, N_INB, sp4 ? 88 : G, sp4 ? (bx >= 168 ? bx - 168 : (1 << 20)) : ((G % 16 == 0) ? (bx + G / 2) % G : bx));
          EpiInProj E{(bf16*)(ws + WS_AQ), (bf16*)(ws + WS_AK), (bf16*)(ws + WS_AV), (bf16*)(ws + WS_BQ), (bf16*)(ws + WS_BC), (bf16*)(ws + WS_IQ), (bf16*)(ws + WS_IKW), QSCALE, LnFold{ST0, VEC + V_GW_IN, VEC + V_BW_IN}, (unsigned*)(ctl + CW_KMAX), N_IN8 / 256, 1.0f};
          gemm_phase<EpiInProj, StaticOrder, true>(lds + RING_OFF, g, S, E, wave); }
        { Gemm g{(const bf16*)(ws + WS_MEM16), (const bf16*)(ws + WS_W_MKV), D, D, D, 0, 0}; StaticOrder S; S.init(BATCH * MEMT, 1024, sp4 ? 16 : G, sp4 ? ((bx >= 224 && bx < 240) ? bx - 224 : (1 << 20)) : (bx >= G - 16 ? bx - (G - 16) : (1 << 20))); EpiBf16 E{(bf16*)(ws + WS_KVMEM), 1024};
          gemm_phase<EpiBf16, StaticOrder, true>(lds + RING_OFF, g, S, E, wave); }
    }
    SEAM(4);
    if (IN(5)) {
        { Gemm g{(const bf16*)(ws + WS_BQ), (const bf16*)(ws + WS_W_UK), 1024, 128, 128, 1, 128}; StaticOrder S; S.init(M, 4096, G, bx); EpiFp8 E{(unsigned char*)(ws + WS_QLAT), 8192, DSA_QS};
          gemm_phase<EpiFp8, StaticOrder, true>(lds + RING_OFF, g, S, E, wave); }
        crms_phase((const bf16*)(ws + WS_BC), (unsigned char*)(ws + WS_C8), args.in[8], DSA_CS, gw, NGW, lane);
    }
    if (IN(7)) indexer_topk(lds, (const bf16*)(ws + WS_IQ), (const bf16*)(ws + WS_IKW), (unsigned short*)(ws + WS_IDX), vcu, G, wave);
    if (IN(7)) diff_attn_mfma(lds, (const bf16*)(ws + WS_AQ), (const bf16*)(ws + WS_AK), (const bf16*)(ws + WS_AV), (bf16*)(ws + WS_YA8), args.in[6], args.in[7], (unsigned*)(ctl + CW_DQ), (const unsigned*)(ctl + CW_KMAX), wave);
    SEAM(7);
    if (IN(8)) dsa_mfma(lds, (const bf16*)(ws + WS_QLAT), (bf16*)(ws + WS_QLAT), 0x7fffffff, (const unsigned char*)(ws + WS_C8), (const unsigned short*)(ws + WS_IDX), vcu, G, wave);
    SEAM(8);
    if (IN(9)) { Gemm g{(const bf16*)(ws + WS_QLAT), (const bf16*)(ws + WS_W_UVP), 4096, 512, 512, 0, 512}; StaticOrder S; S.init(M, 1024, G, bx); EpiFp8 E{(unsigned char*)(ws + WS_YB), 1024, FP8_YS / (DSA_OS * FP8_WUVS)};
        gemm_phase<EpiFp8, StaticOrder, true, true, true>(lds + RING_OFF, g, S, E, wave); }
    SEAM(9);
    if (IN(10)) {
        { Gemm g{(const bf16*)(ws + WS_YA8), (const bf16*)(ws + WS_W_A), 512, 512, 512, 0, 0}; StaticOrder S; S.init(M, D, G, bx); EpiBf16 E{(bf16*)(ws + WS_TA), D, 1.0f / (FP8_YAS * FP8_WAS)}; gemm_phase<EpiBf16, StaticOrder, true, true>(lds + RING_OFF, g, S, E, wave); }
        { Gemm g{(const bf16*)(ws + WS_YB), (const bf16*)(ws + WS_W_B), 512, 512, 512, 0, 0}; StaticOrder S; S.init(M, D, G, bx); EpiBf16 E{(bf16*)(ws + WS_TB), D, 1.0f / (FP8_YS * FP8_WBS)}; gemm_phase<EpiBf16, StaticOrder, true, true>(lds + RING_OFF, g, S, E, wave); }
    }
    SEAM(10);
    if (IN(11)) { Gemm g{(const bf16*)(ws + WS_X8M), (const bf16*)(ws + WS_W_G), D / 2, D / 2, D / 2, 0, 0}; StaticOrder S; S.init(M, 2 * D, G, bx);
        EpiGateMerge8 E{(const bf16*)(ws + WS_TA), (const bf16*)(ws + WS_TB), (unsigned char*)(ws + WS_MRG8), D, args.in[12], args.in[12] + D, 1.0f / (FP8_XS * FP8_WGS), FP8_MS, LnFold{ST0, VEC + V_GW_G, VEC + V_BW_G}};
        gemm_phase<EpiGateMerge8, StaticOrder, true, true>(lds + RING_OFF, g, S, E, wave); }
    SEAM(11);
    if (IN(12)) { Gemm g{(const bf16*)(ws + WS_MRG8), (const bf16*)(ws + WS_W_MO), D / 2, D / 2, D / 2, 0, 0}; StaticOrder S; S.init(M, D, G, bx); EpiRes<false, 1> E{nullptr, X16, D, ALPHA, 1.0f / (FP8_MS * FP8_WMOS), ST0, ln_g, ln_b, ST1, X16, nullptr, 0.f};
        gemm_phase<EpiRes<false, 1>, StaticOrder, true, true>(lds + RING_OFF, g, S, E, wave); }
    SEAM(12);
    if (IN(14)) { Gemm g{X16, (const bf16*)(ws + WS_W_MQ), D, D, D / 2, 1, D / 2, 2, D / 2}; StaticOrder S; S.init(M, 1024, G, bx);
        EpiBf16S E{(bf16*)(ws + WS_QM), (size_t)M * 512, 0.08838834764831845f * LOG2E, LnFold{ST1, VEC + V_GW_MQ, VEC + V_BW_MQ}}; gemm_phase<EpiBf16S, StaticOrder, true>(lds + RING_OFF, g, S, E, wave); }
    SEAM(14);
    if (IN(15)) memattn_mfma(lds, (const bf16*)(ws + WS_QM), (const bf16*)(ws + WS_KVMEM), (bf16*)(ws + WS_OM), vcu, G, wave);
    SEAM(15);
    if (IN(16)) { Gemm g{(const bf16*)(ws + WS_OM), (const bf16*)(ws + WS_W_MOUT), 256, 256, 256, 0, 0}; StaticOrder S; S.init(M, D, G, bx); EpiRes<false> E{nullptr, X16, D, ALPHA, 1.0f / (FP8_OMS * FP8_WMOUTS), ST1, ln_g + D, ln_b + D, ST2, X16, (unsigned char*)(ws + WS_X8), FP8_XS};
        gemm_phase<EpiRes<false>, StaticOrder, true, true>(lds + RING_OFF, g, S, E, wave); }
    SEAM(16);
    if (IN(18)) { Gemm g{(const bf16*)(ws + WS_X8), (const bf16*)(ws + WS_W_GU2), D / 2, D / 2, D / 2, 0, 0}; StaticOrder S; S.init(M, 2 * FF, G, bx); EpiSwiGLU8 E{(unsigned char*)HB, FF, 1.0f / (FP8_XS * FP8_WGUS), FP8_HS, LnFold{ST2, VEC + V_GW_GU2, VEC + V_BW_GU2}};
        gemm_phase<EpiSwiGLU8, StaticOrder, true, true>(lds + RING_OFF, g, S, E, wave); }
    SEAM(18);
    if (IN(19)) { Gemm g{HB, (const bf16*)(ws + WS_W_D2), FF / 2, FF / 2, FF / 2, 0, 0}; StaticOrder S; S.init(M, D, G, bx); EpiRes<false> E{nullptr, X16, D, ALPHA, 0.5f / (FP8_HS * FP8_WDS), ST2, ln_g + 2 * D, ln_b + 2 * D, nullptr, X16, nullptr, 0.f};
        gemm_phase<EpiRes<false>, StaticOrder, true, true>(lds + RING_OFF, g, S, E, wave); }
    SEAM(19);
    if (IN(20)) ln_final_phase(X16, out, ln_g + 3 * D, ln_b + 3 * D, gw, NGW, lane);
#undef IN
#undef SEAM
#undef lane
}

extern "C" void kernel_launch(void* const* d_in, const int* in_sizes, int n_in, void* d_out, int out_size, void* d_ws, size_t ws_size, hipStream_t stream) {
    static int grid = 0;
    if (grid == 0) {
        if (n_in != 24 || in_sizes[0] != M * D || out_size != M * D || ws_size < WS_END) { fprintf(stderr, "kernel_launch: unexpected shapes (n_in %d, in0 %d, out %d, ws %zu); nothing launched\n", n_in, n_in > 0 ? in_sizes[0] : -1, out_size, ws_size); grid = -1; return; }
        int dev = 0, cus = 0, per_cu = 0;
        if (hipGetDevice(&dev) != hipSuccess || hipDeviceGetAttribute(&cus, hipDeviceAttributeMultiprocessorCount, dev) != hipSuccess) { grid = -1; return; }
        if (hipFuncSetAttribute((const void*)mk_fwd, hipFuncAttributeMaxDynamicSharedMemorySize, LDS_BYTES) != hipSuccess) { fprintf(stderr, "kernel_launch: hipFuncSetAttribute failed\n"); grid = -1; return; }
        if (hipOccupancyMaxActiveBlocksPerMultiprocessor(&per_cu, (const void*)mk_fwd, NWAVES * 64, LDS_BYTES) != hipSuccess || per_cu < 1)
            fprintf(stderr, "kernel_launch: note: the occupancy query reports %d workgroups per CU\n", per_cu);
        (void)hipGetLastError();
        grid = cus;
    }
    if (grid < 0) return;
    if (hipMemsetAsync((char*)d_ws + WS_CTL, 0, CTL_ZERO_BYTES, stream) != hipSuccess) return;
    Args a{};
    for (int i = 0; i < 24; ++i) a.in[i] = (const float*)d_in[i];
    a.out = (float*)d_out; a.ws = (unsigned char*)d_ws;
#if MK_ONE_LAUNCH
    a.ph_lo = 0; a.ph_hi = N_PHASES;
    hipLaunchKernelGGL(mk_fwd, dim3(grid), dim3(NWAVES * 64), LDS_BYTES, stream, a);
#else
    for (int p = 0; p < N_PHASES; ++p) { a.ph_lo = p; a.ph_hi = p + 1; hipLaunchKernelGGL(mk_fwd, dim3(grid), dim3(NWAVES * 64), LDS_BYTES, stream, a); }
#endif
}
```

```cpp
#include <hip/hip_runtime.h>
#include <cstdio>
#include <cstdint>

#ifndef MK_ONE_LAUNCH
#define MK_ONE_LAUNCH 1
#endif

__device__ __forceinline__ int lane_fresh() { int l = (int)__builtin_amdgcn_mbcnt_hi(~0u, __builtin_amdgcn_mbcnt_lo(~0u, 0u)); asm volatile("" : "+v"(l)); return l; }
__device__ __forceinline__ void glds16(const void* gsrc, unsigned lds_dst) { unsigned keep;
    asm volatile("s_mov_b32 %0, m0\n\ts_mov_b32 m0, %2\n\ts_nop 0\n\tglobal_load_lds_dwordx4 %1, off\n\ts_mov_b32 m0, %0" : "=&s"(keep) : "v"(gsrc), "s"(lds_dst) : "memory"); }
__device__ __forceinline__ void glds16s(const void* sbase, unsigned voff, unsigned lds_dst) { unsigned keep;
    asm volatile("s_mov_b32 %0, m0\n\ts_mov_b32 m0, %3\n\ts_nop 0\n\tglobal_load_lds_dwordx4 %1, %2\n\ts_mov_b32 m0, %0" : "=&s"(keep) : "v"(voff), "s"(sbase), "s"(lds_dst) : "memory"); }
__device__ __forceinline__ void glds16s_x16(const void* sbase, const unsigned (&v)[16], unsigned lds_dst0) { unsigned keep;
    asm volatile("s_mov_b32 %0, m0\n\ts_mov_b32 m0, %18\n\ts_nop 0\n\t"
        "global_load_lds_dwordx4 %1, %17\n\ts_add_u32 m0, m0, 1040\n\ts_nop 0\n\t"
        "global_load_lds_dwordx4 %2, %17\n\ts_add_u32 m0, m0, 1040\n\ts_nop 0\n\t"
        "global_load_lds_dwordx4 %3, %17\n\ts_add_u32 m0, m0, 1040\n\ts_nop 0\n\t"
        "global_load_lds_dwordx4 %4, %17\n\ts_add_u32 m0, m0, 1040\n\ts_nop 0\n\t"
        "global_load_lds_dwordx4 %5, %17\n\ts_add_u32 m0, m0, 1040\n\ts_nop 0\n\t"
        "global_load_lds_dwordx4 %6, %17\n\ts_add_u32 m0, m0, 1040\n\ts_nop 0\n\t"
        "global_load_lds_dwordx4 %7, %17\n\ts_add_u32 m0, m0, 1040\n\ts_nop 0\n\t"
        "global_load_lds_dwordx4 %8, %17\n\ts_add_u32 m0, m0, 1040\n\ts_nop 0\n\t"
        "global_load_lds_dwordx4 %9, %17\n\ts_add_u32 m0, m0, 1040\n\ts_nop 0\n\t"
        "global_load_lds_dwordx4 %10, %17\n\ts_add_u32 m0, m0, 1040\n\ts_nop 0\n\t"
        "global_load_lds_dwordx4 %11, %17\n\ts_add_u32 m0, m0, 1040\n\ts_nop 0\n\t"
        "global_load_lds_dwordx4 %12, %17\n\ts_add_u32 m0, m0, 1040\n\ts_nop 0\n\t"
        "global_load_lds_dwordx4 %13, %17\n\ts_add_u32 m0, m0, 1040\n\ts_nop 0\n\t"
        "global_load_lds_dwordx4 %14, %17\n\ts_add_u32 m0, m0, 1040\n\ts_nop 0\n\t"
        "global_load_lds_dwordx4 %15, %17\n\ts_add_u32 m0, m0, 1040\n\ts_nop 0\n\t"
        "global_load_lds_dwordx4 %16, %17\n\ts_mov_b32 m0, %0"
        : "=&s"(keep) : "v"(v[0]), "v"(v[1]), "v"(v[2]), "v"(v[3]), "v"(v[4]), "v"(v[5]), "v"(v[6]), "v"(v[7]), "v"(v[8]), "v"(v[9]), "v"(v[10]), "v"(v[11]), "v"(v[12]), "v"(v[13]), "v"(v[14]), "v"(v[15]), "s"(sbase), "s"(lds_dst0) : "memory", "scc"); }
namespace pg8 {
#define PG8_LAS __attribute__((address_space(3)))
typedef unsigned short bf16_t;
typedef short bf16x8 __attribute__((ext_vector_type(8)));
typedef float f32x4 __attribute__((ext_vector_type(4)));
typedef unsigned u32x4 __attribute__((ext_vector_type(4)));
constexpr int BM = 256, BK = 64, HALF = 128, HTB = HALF * BK * 2  , STAGE_BYTES = 8 * HTB, NXCD = 8, WGM = 8;

__host__ __device__ __forceinline__ int lds_byte(int r, int c) { const int st = (r >> 4) * 2 + (c >> 5), rr = r & 15, cc = c & 31, ob = rr * 64 + cc * 2; return st * 1024 + (ob ^ (((ob >> 9) & 1) << 5)); }
__host__ __device__ __forceinline__ void stage_rc(int b, int& R, int& C) { const int st = b / 1024, sb = b % 1024, swz = sb ^ (((sb >> 9) & 1) << 5); R = (st >> 1) * 16 + swz / 64; C = (st & 1) * 32 + (swz % 64) / 2; }
__host__ __device__ __forceinline__ int perm32(int rho) { const int n = rho >> 4, i = rho & 15; return 8 * (i >> 2) + 4 * n + (i & 3); }

struct Unit { int pm, pn; };
struct Gemm { const bf16_t* A; const bf16_t* Bt; int lda, ldb, K, a_shift, a_mul; int b_wrap, b_kmul; };

struct StaticOrder {
    int nM, nN, nwg, G, c;
    __host__ __device__ void init(int M, int N, int G_, int c_) { nM = M / BM; nN = N / BM; nwg = nM * nN; G = G_; c = c_; }
    __host__ __device__ bool next(int i, Unit& u) const {
        const long L = (long)i * G + c; if (L >= nwg) return false;
        int wgid = (int)L; { const int q = nwg / NXCD, r = nwg % NXCD, xcd = wgid % NXCD, off = wgid / NXCD; wgid = (xcd < r ? xcd * (q + 1) : r * (q + 1) + (xcd - r) * q) + off; }
        const int nig = WGM * nN, gid = wgid / nig, fm = gid * WGM, gsz = (nM - fm) < WGM ? (nM - fm) : WGM;
        u.pm = fm + ((wgid % nig) % gsz); u.pn = (wgid % nig) / gsz; return true;
    }
    __device__ __forceinline__ void a_ready(const Unit&) const {}
    __device__ __forceinline__ void done(const Unit&) const {}
};

__device__ __forceinline__ unsigned cvt_pk_bf16(float lo, float hi) { unsigned r; asm volatile("v_cvt_pk_bf16_f32 %0, %1, %2" : "=v"(r) : "v"(lo), "v"(hi)); return r; }
__device__ __forceinline__ float bflo(unsigned w) { return __uint_as_float(w << 16); }
__device__ __forceinline__ float bfhi(unsigned w) { return __uint_as_float(w & 0xffff0000u); }
__device__ __forceinline__ float sigmoidf_fast(float x) { return __builtin_amdgcn_rcpf(1.0f + __builtin_amdgcn_exp2f(-1.4426950408889634f * x)); }

struct LnFold {
    const long long* stats; const float* gW; const float* bW;
    __device__ __forceinline__ void row(int r, float& mean, float& rstd) const { const long long s0 = stats[2 * (size_t)r], s1 = stats[2 * (size_t)r + 1];
        mean = (float)s0 * (1.0f / (1048576.f * 2048.0f)); rstd = __builtin_amdgcn_rsqf((float)s1 * (1.0f / (65536.f * 2048.0f)) - mean * mean + 1e-5f); }
    __device__ __forceinline__ f32x4 vec4(const float* v, int i) const { return *(const f32x4*)(v + i); }
    __device__ __forceinline__ void rows8(int row0, float (&mean)[8], float (&rstd)[8]) const {
#pragma unroll
        for (int hf = 0; hf < 2; ++hf) { long long s0[4], s1[4];
#pragma unroll
            for (int q = 0; q < 4; ++q) { const size_t r = (size_t)(row0 + hf * 128 + q * 16); s0[q] = stats[2 * r]; s1[q] = stats[2 * r + 1]; }
#pragma unroll
            for (int q = 0; q < 4; ++q) { const float mu = (float)s0[q] * (1.0f / (1048576.f * 2048.0f)); mean[4 * hf + q] = mu; rstd[4 * hf + q] = __builtin_amdgcn_rsqf((float)s1[q] * (1.0f / (65536.f * 2048.0f)) - mu * mu + 1e-5f); }
            asm volatile("" : "+v"(mean[4 * hf]), "+v"(mean[4 * hf + 1]), "+v"(mean[4 * hf + 2]), "+v"(mean[4 * hf + 3]), "+v"(rstd[4 * hf]), "+v"(rstd[4 * hf + 1]), "+v"(rstd[4 * hf + 2]), "+v"(rstd[4 * hf + 3]) :: "memory"); }
    }
};
struct EpiBf16 {
    static constexpr bool PERM = true, AFTER_DRAIN = false;
    bf16_t* O; int ldc; float sc = 1.0f; LnFold lf = {nullptr, nullptr, nullptr};
    __device__ __forceinline__ void operator()(const f32x4 (&acc)[2][2][4][2], const Unit& u, int wr, int wc, int fr, int fq) const {
        const int row0 = u.pm * BM + wr * 64 + fr, col0 = u.pn * BM + wc * 32 + 8 * fq;
        f32x4 gw[2][2], bw[2][2];
#pragma unroll
        for (int bj = 0; bj < 2; ++bj)
#pragma unroll
            for (int n = 0; n < 2; ++n) { gw[bj][n] = (f32x4){0.f, 0.f, 0.f, 0.f}; bw[bj][n] = (f32x4){0.f, 0.f, 0.f, 0.f}; if (lf.stats) { gw[bj][n] = lf.vec4(lf.gW, col0 + bj * HALF + 4 * n); bw[bj][n] = lf.vec4(lf.bW, col0 + bj * HALF + 4 * n); } }
        float mean8[8], rstd8[8];
#pragma unroll
        for (int q = 0; q < 8; ++q) { mean8[q] = 0.f; rstd8[q] = 1.f; }
        if (lf.stats) lf.rows8(row0, mean8, rstd8);
#pragma unroll
        for (int ai = 0; ai < 2; ++ai)
#pragma unroll
            for (int m = 0; m < 4; ++m) { bf16_t* rowp = O + (size_t)(row0 + ai * HALF + m * 16) * ldc + col0;
                const float mean = mean8[ai * 4 + m], rstd = rstd8[ai * 4 + m];
#pragma unroll
                for (int bj = 0; bj < 2; ++bj) { const f32x4 v0 = ((acc[ai][bj][m][0] - gw[bj][0] * mean) * rstd + bw[bj][0]) * sc, v1 = ((acc[ai][bj][m][1] - gw[bj][1] * mean) * rstd + bw[bj][1]) * sc;
                    u32x4 w; w.x = cvt_pk_bf16(v0[0], v0[1]); w.y = cvt_pk_bf16(v0[2], v0[3]); w.z = cvt_pk_bf16(v1[0], v1[1]); w.w = cvt_pk_bf16(v1[2], v1[3]);
                    *(u32x4*)(rowp + bj * HALF) = w; } }
    }
};
struct EpiBf16S {
    static constexpr bool PERM = true, AFTER_DRAIN = false;
    bf16_t* O; size_t pstride; float sc; LnFold lf;
    __device__ __forceinline__ void operator()(const f32x4 (&acc)[2][2][4][2], const Unit& u, int wr, int wc, int fr, int fq) const {
        const int part = u.pn >> 1, row0 = u.pm * BM + wr * 64 + fr, col0 = (u.pn & 1) * BM + wc * 32 + 8 * fq;
        const float fs = part ? 0.f : 1.f;
        f32x4 gw[2][2], bw[2][2];
#pragma unroll
        for (int bj = 0; bj < 2; ++bj)
#pragma unroll
            for (int n = 0; n < 2; ++n) { gw[bj][n] = lf.vec4(lf.gW, col0 + bj * HALF + 4 * n) * fs; bw[bj][n] = lf.vec4(lf.bW, col0 + bj * HALF + 4 * n) * fs; }
        float mean8[8], rstd8[8]; lf.rows8(row0, mean8, rstd8);
        bf16_t* Op = O + (size_t)part * pstride;
#pragma unroll
        for (int ai = 0; ai < 2; ++ai)
#pragma unroll
            for (int m = 0; m < 4; ++m) { bf16_t* rowp = Op + (size_t)(row0 + ai * HALF + m * 16) * 512 + col0;
                const float mean = mean8[ai * 4 + m], rstd = rstd8[ai * 4 + m];
#pragma unroll
                for (int bj = 0; bj < 2; ++bj) { const f32x4 v0 = ((acc[ai][bj][m][0] - gw[bj][0] * mean) * rstd + bw[bj][0]) * sc, v1 = ((acc[ai][bj][m][1] - gw[bj][1] * mean) * rstd + bw[bj][1]) * sc;
                    u32x4 w; w.x = cvt_pk_bf16(v0[0], v0[1]); w.y = cvt_pk_bf16(v0[2], v0[3]); w.z = cvt_pk_bf16(v1[0], v1[1]); w.w = cvt_pk_bf16(v1[2], v1[3]);
                    *(u32x4*)(rowp + bj * HALF) = w; } }
    }
};
struct EpiInProj {
    static constexpr bool PERM = true, AFTER_DRAIN = false;
    bf16_t *aq, *ak, *av, *bq, *bc, *iq, *ikw; float qscale; LnFold lf; unsigned* kmax; int pn0; float ascale;
    __device__ __forceinline__ void operator()(const f32x4 (&acc)[2][2][4][2], const Unit& u, int wr, int wc, int fr, int fq) const {
        bf16_t* base; int ldc, colt; const int pn = u.pn + pn0;
        if (pn < 4) { base = aq; ldc = 1024; colt = pn * 256; }
        else if (pn < 8) { base = ak; ldc = 1024; colt = (pn - 4) * 256; }
        else if (pn < 12) { base = av; ldc = 1024; colt = (pn - 8) * 256; }
        else if (pn < 16) { base = bq; ldc = 1024; colt = (pn - 12) * 256; }
        else if (pn < 18) { base = bc; ldc = 512; colt = (pn - 16) * 256; }
        else if (pn < 22) { base = iq; ldc = 1024; colt = (pn - 18) * 256; }
        else { base = ikw; ldc = 256; colt = 0; }
        const float sc = (pn < 4) ? qscale : 1.0f; float kam[2] = {0.f, 0.f};
        const int row0 = u.pm * BM + wr * 64 + fr, col0 = colt + wc * 32 + 8 * fq, cidx = pn * BM + wc * 32 + 8 * fq;
        f32x4 gw[2][2], bw[2][2];
#pragma unroll
        for (int bj = 0; bj < 2; ++bj)
#pragma unroll
            for (int n = 0; n < 2; ++n) { gw[bj][n] = lf.vec4(lf.gW, cidx + bj * HALF + 4 * n); bw[bj][n] = lf.vec4(lf.bW, cidx + bj * HALF + 4 * n); }
        float mean8[8], rstd8[8]; lf.rows8(row0, mean8, rstd8);
#pragma unroll
        for (int ai = 0; ai < 2; ++ai)
#pragma unroll
            for (int m = 0; m < 4; ++m) { bf16_t* rowp = base + (size_t)(row0 + ai * HALF + m * 16) * ldc + col0;
                const float Ar = rstd8[ai * 4 + m] * ascale * sc, Br = -mean8[ai * 4 + m] * rstd8[ai * 4 + m] * sc;
#pragma unroll
                for (int bj = 0; bj < 2; ++bj) { const f32x4 v0 = acc[ai][bj][m][0] * Ar + (gw[bj][0] * Br + bw[bj][0] * sc), v1 = acc[ai][bj][m][1] * Ar + (gw[bj][1] * Br + bw[bj][1] * sc);
                    if (pn >= 4 && pn < 8) {
                        float sq = ((v0[0] * v0[0] + v0[1] * v0[1]) + (v0[2] * v0[2] + v0[3] * v0[3])) + ((v1[0] * v1[0] + v1[1] * v1[1]) + (v1[2] * v1[2] + v1[3] * v1[3]));
                        { const auto r1 = __builtin_amdgcn_permlane16_swap(__float_as_uint(sq), __float_as_uint(sq), false, false); sq = __uint_as_float(r1[0]) + __uint_as_float(r1[1]); }
                        { const auto r2 = __builtin_amdgcn_permlane32_swap(__float_as_uint(sq), __float_as_uint(sq), false, false); sq = __uint_as_float(r2[0]) + __uint_as_float(r2[1]); }
                        kam[bj] = fmaxf(kam[bj], sq); }
                    u32x4 w; w.x = cvt_pk_bf16(v0[0], v0[1]); w.y = cvt_pk_bf16(v0[2], v0[3]); w.z = cvt_pk_bf16(v1[0], v1[1]); w.w = cvt_pk_bf16(v1[2], v1[3]);
                    *(u32x4*)(rowp + bj * HALF) = w; } }
        if (pn >= 4 && pn < 8) {
#pragma unroll
            for (int bj = 0; bj < 2; ++bj) { float v = kam[bj];
#pragma unroll
                for (int o = 1; o < 64; o <<= 1) v = fmaxf(v, __shfl_xor(v, o));
                if ((fr | fq) == 0) (void)__hip_atomic_fetch_max(kmax + (((u.pm >> 4) * 8 + 2 * (pn - 4) + bj) * 2 + (wc >> 1)) * 2 + (wc & 1), __float_as_uint(v), __ATOMIC_RELAXED, __HIP_MEMORY_SCOPE_AGENT); } }
    }
};
struct EpiSwiGLU {
    static constexpr bool PERM = true, AFTER_DRAIN = false;
    bf16_t* O; int ldc;
    __device__ __forceinline__ void operator()(const f32x4 (&acc)[2][2][4][2], const Unit& u, int wr, int wc, int fr, int fq) const {
        const int row0 = u.pm * BM + wr * 64 + fr, col0 = u.pn * HALF + wc * 32 + 8 * fq;
#pragma unroll
        for (int ai = 0; ai < 2; ++ai)
#pragma unroll
            for (int m = 0; m < 4; ++m) { bf16_t* rowp = O + (size_t)(row0 + ai * HALF + m * 16) * ldc + col0;
                float h[8];
#pragma unroll
                for (int n = 0; n < 2; ++n)
#pragma unroll
                    for (int j = 0; j < 4; ++j) { const float g = acc[ai][0][m][n][j], up = acc[ai][1][m][n][j]; h[4 * n + j] = g * sigmoidf_fast(g) * up; }
                u32x4 w; w.x = cvt_pk_bf16(h[0], h[1]); w.y = cvt_pk_bf16(h[2], h[3]); w.z = cvt_pk_bf16(h[4], h[5]); w.w = cvt_pk_bf16(h[6], h[7]);
                *(u32x4*)rowp = w; }
    }
};
__device__ __forceinline__ unsigned pk4_fp8(float a, float b, float c, float d) { int w = 0; w = __builtin_amdgcn_cvt_pk_fp8_f32(a, b, w, false); w = __builtin_amdgcn_cvt_pk_fp8_f32(c, d, w, true); return (unsigned)w; }
struct EpiFp8 {
    static constexpr bool PERM = true, AFTER_DRAIN = false;
    unsigned char* O; int ldc; float sc;
    __device__ __forceinline__ void operator()(const f32x4 (&acc)[2][2][4][2], const Unit& u, int wr, int wc, int fr, int fq) const {
        typedef unsigned u32x2 __attribute__((ext_vector_type(2)));
        const int row0 = u.pm * BM + wr * 64 + fr, col0 = u.pn * BM + wc * 32 + 8 * fq;
#pragma unroll
        for (int ai = 0; ai < 2; ++ai)
#pragma unroll
            for (int m = 0; m < 4; ++m) { unsigned char* rowp = O + (size_t)(row0 + ai * HALF + m * 16) * ldc + col0;
#pragma unroll
                for (int bj = 0; bj < 2; ++bj) { const f32x4 v0 = acc[ai][bj][m][0] * sc, v1 = acc[ai][bj][m][1] * sc;
                    *(u32x2*)(rowp + bj * HALF) = (u32x2){pk4_fp8(fminf(fmaxf(v0[0], -448.f), 448.f), fminf(fmaxf(v0[1], -448.f), 448.f), fminf(fmaxf(v0[2], -448.f), 448.f), fminf(fmaxf(v0[3], -448.f), 448.f)),
                                                          pk4_fp8(fminf(fmaxf(v1[0], -448.f), 448.f), fminf(fmaxf(v1[1], -448.f), 448.f), fminf(fmaxf(v1[2], -448.f), 448.f), fminf(fmaxf(v1[3], -448.f), 448.f))}; } }
    }
};
struct EpiSwiGLU8 {
    static constexpr bool PERM = true, AFTER_DRAIN = false;
    unsigned char* O; int ldc; float ascale, hs; LnFold lf;
    __device__ __forceinline__ void operator()(const f32x4 (&acc)[2][2][4][2], const Unit& u, int wr, int wc, int fr, int fq) const {
        const int row0 = u.pm * BM + wr * 64 + fr, col0 = u.pn * HALF + wc * 32 + 8 * fq, cidx = u.pn * BM + wc * 32 + 8 * fq;
        typedef unsigned u32x2 __attribute__((ext_vector_type(2)));
        f32x4 gw[2][2], bw[2][2];
#pragma unroll
        for (int bj = 0; bj < 2; ++bj)
#pragma unroll
            for (int n = 0; n < 2; ++n) { gw[bj][n] = (f32x4){0.f, 0.f, 0.f, 0.f}; bw[bj][n] = (f32x4){0.f, 0.f, 0.f, 0.f}; if (lf.stats) { gw[bj][n] = lf.vec4(lf.gW, cidx + bj * HALF + 4 * n); bw[bj][n] = lf.vec4(lf.bW, cidx + bj * HALF + 4 * n); } }
        float mean8[8], rstd8[8];
#pragma unroll
        for (int q = 0; q < 8; ++q) { mean8[q] = 0.f; rstd8[q] = 1.f; }
        if (lf.stats) lf.rows8(row0, mean8, rstd8);
#pragma unroll
        for (int ai = 0; ai < 2; ++ai)
#pragma unroll
            for (int m = 0; m < 4; ++m) { unsigned char* rowp = O + (size_t)(row0 + ai * HALF + m * 16) * ldc + col0;
                float h[8]; const float Ar = rstd8[ai * 4 + m] * ascale, Br = -mean8[ai * 4 + m] * rstd8[ai * 4 + m];
#pragma unroll
                for (int n = 0; n < 2; ++n)
#pragma unroll
                    for (int j = 0; j < 4; ++j) { const float g = acc[ai][0][m][n][j] * Ar + (gw[0][n][j] * Br + bw[0][n][j]), up = acc[ai][1][m][n][j] * Ar + (gw[1][n][j] * Br + bw[1][n][j]);
                        h[4 * n + j] = fminf(fmaxf(g * sigmoidf_fast(g) * up * hs, -448.f), 448.f); }
                *(u32x2*)rowp = (u32x2){pk4_fp8(h[0], h[1], h[2], h[3]), pk4_fp8(h[4], h[5], h[6], h[7])}; }
    }
};
struct EpiGateMerge {
    static constexpr bool PERM = true, AFTER_DRAIN = false;
    const bf16_t* ta; const bf16_t* tb; bf16_t* O; int ldc; const float* b0; const float* b1;
    __device__ __forceinline__ void operator()(const f32x4 (&acc)[2][2][4][2], const Unit& u, int wr, int wc, int fr, int fq) const {
        const int row0 = u.pm * BM + wr * 64 + fr, col0 = u.pn * HALF + wc * 32 + 8 * fq;
        float bb0[8], bb1[8];
#pragma unroll
        for (int j = 0; j < 8; ++j) { bb0[j] = b0[col0 + j]; bb1[j] = b1[col0 + j]; }
#pragma unroll
        for (int ai = 0; ai < 2; ++ai)
#pragma unroll
            for (int m = 0; m < 4; ++m) { const size_t off = (size_t)(row0 + ai * HALF + m * 16) * ldc + col0;
                const u32x4 a = *(const u32x4*)(ta + off), b = *(const u32x4*)(tb + off);
                const float av[8] = {bflo(a.x), bfhi(a.x), bflo(a.y), bfhi(a.y), bflo(a.z), bfhi(a.z), bflo(a.w), bfhi(a.w)};
                const float bv[8] = {bflo(b.x), bfhi(b.x), bflo(b.y), bfhi(b.y), bflo(b.z), bfhi(b.z), bflo(b.w), bfhi(b.w)};
                float h[8];
#pragma unroll
                for (int n = 0; n < 2; ++n)
#pragma unroll
                    for (int j = 0; j < 4; ++j) { const int e = 4 * n + j; h[e] = sigmoidf_fast(acc[ai][0][m][n][j] + bb0[e]) * av[e] + sigmoidf_fast(acc[ai][1][m][n][j] + bb1[e]) * bv[e]; }
                u32x4 w; w.x = cvt_pk_bf16(h[0], h[1]); w.y = cvt_pk_bf16(h[2], h[3]); w.z = cvt_pk_bf16(h[4], h[5]); w.w = cvt_pk_bf16(h[6], h[7]);
                *(u32x4*)(O + off) = w; }
    }
};
struct EpiGateMerge8 {
    static constexpr bool PERM = true, AFTER_DRAIN = false;
    const bf16_t* ta; const bf16_t* tb; unsigned char* O; int ldc; const float* b0; const float* b1; float ascale, ms; LnFold lf;
    __device__ __forceinline__ void operator()(const f32x4 (&acc)[2][2][4][2], const Unit& u, int wr, int wc, int fr, int fq) const {
        const int row0 = u.pm * BM + wr * 64 + fr, col0 = u.pn * HALF + wc * 32 + 8 * fq, cidx = u.pn * BM + wc * 32 + 8 * fq;
        typedef unsigned u32x2 __attribute__((ext_vector_type(2)));
        float mean8[8], rstd8[8]; lf.rows8(row0, mean8, rstd8);
        float bb0[8], bb1[8], gw0[8], gw1[8];
#pragma unroll
        for (int j = 0; j < 8; ++j) { bb0[j] = b0[col0 + j] + lf.bW[cidx + j]; bb1[j] = b1[col0 + j] + lf.bW[cidx + HALF + j]; gw0[j] = lf.gW[cidx + j]; gw1[j] = lf.gW[cidx + HALF + j]; }
#pragma unroll
        for (int am = 0; am < 8; am += 2) {
            u32x4 pa[2], pb[2];
#pragma unroll
            for (int e2 = 0; e2 < 2; ++e2) { const size_t off = (size_t)(row0 + ((am + e2) >> 2) * HALF + ((am + e2) & 3) * 16) * ldc + col0; pa[e2] = *(const u32x4*)(ta + off); pb[e2] = *(const u32x4*)(tb + off); }
#pragma unroll
            for (int e2 = 0; e2 < 2; ++e2) { const int ai = (am + e2) >> 2, m = (am + e2) & 3; const size_t off = (size_t)(row0 + ai * HALF + m * 16) * ldc + col0;
                const u32x4 a = pa[e2], b = pb[e2];
                const float av[8] = {bflo(a.x), bfhi(a.x), bflo(a.y), bfhi(a.y), bflo(a.z), bfhi(a.z), bflo(a.w), bfhi(a.w)};
                const float bv[8] = {bflo(b.x), bfhi(b.x), bflo(b.y), bfhi(b.y), bflo(b.z), bfhi(b.z), bflo(b.w), bfhi(b.w)};
                float h[8]; const float Ar = rstd8[ai * 4 + m] * ascale, Br = -mean8[ai * 4 + m] * rstd8[ai * 4 + m];
#pragma unroll
                for (int n = 0; n < 2; ++n)
#pragma unroll
                    for (int j = 0; j < 4; ++j) { const int e = 4 * n + j; const float v = sigmoidf_fast(acc[ai][0][m][n][j] * Ar + (gw0[e] * Br + bb0[e])) * av[e] + sigmoidf_fast(acc[ai][1][m][n][j] * Ar + (gw1[e] * Br + bb1[e])) * bv[e];
                        h[e] = fminf(fmaxf(v * ms, -448.f), 448.f); }
                *(u32x2*)(O + off) = (u32x2){pk4_fp8(h[0], h[1], h[2], h[3]), pk4_fp8(h[4], h[5], h[6], h[7])}; }
            asm volatile("" ::: "memory"); }
    }
};
template <bool RES32, int NB = 2> struct EpiRes {
    static constexpr bool PERM = true, AFTER_DRAIN = false;
    const float* res32; const bf16_t* res16; int ldc; float alpha, s;
    const long long* rstats; const float* rg; const float* rb; long long* ostats; bf16_t* o16; unsigned char* o8; float o8s;
    __device__ __forceinline__ void operator()(const f32x4 (&acc)[2][2][4][2], const Unit& u, int wr, int wc, int fr, int fq) const {
        const int col0 = u.pn * BM + wc * 32 + 8 * fq;
        typedef unsigned u32x2 __attribute__((ext_vector_type(2)));
        float al = alpha, sa = s; asm volatile("" : "+v"(al), "+v"(sa));
        const int rowb = u.pm * BM + wr * 64 + fr;
        float mean8[8], rstd8[8];
#pragma unroll
        for (int q = 0; q < 8; ++q) { mean8[q] = 0.f; rstd8[q] = 1.f; }
        if (rstats) { LnFold lf{rstats, nullptr, nullptr}; lf.rows8(rowb, mean8, rstd8); }
        asm volatile("" : "+v"(mean8[0]), "+v"(mean8[1]), "+v"(mean8[2]), "+v"(mean8[3]), "+v"(mean8[4]), "+v"(mean8[5]), "+v"(mean8[6]), "+v"(mean8[7]), "+v"(rstd8[0]), "+v"(rstd8[1]), "+v"(rstd8[2]), "+v"(rstd8[3]), "+v"(rstd8[4]), "+v"(rstd8[5]), "+v"(rstd8[6]), "+v"(rstd8[7]) :: "memory");
        f32x4 gv[2][2], bv[2][2];
#pragma unroll
        for (int bj = 0; bj < 2; ++bj)
#pragma unroll
            for (int n = 0; n < 2; ++n) { gv[bj][n] = (f32x4){1.f, 1.f, 1.f, 1.f}; bv[bj][n] = (f32x4){0.f, 0.f, 0.f, 0.f};
                if (rstats) { gv[bj][n] = *(const f32x4*)(rg + col0 + bj * HALF + 4 * n); bv[bj][n] = *(const f32x4*)(rb + col0 + bj * HALF + 4 * n); }
                gv[bj][n] = gv[bj][n] * al; bv[bj][n] = bv[bj][n] * al; }
#pragma unroll
        for (int am = 0; am < 8; am += NB) {
            f32x4 rr[RES32 ? NB : 1][2][2]; u32x4 rw[NB][2];
#pragma unroll
            for (int e2 = 0; e2 < NB; ++e2) { const size_t off = (size_t)(rowb + ((am + e2) >> 2) * HALF + ((am + e2) & 3) * 16) * ldc + col0;
#pragma unroll
                for (int bj = 0; bj < 2; ++bj) {
                    if constexpr (RES32) { rr[e2][bj][0] = *(const f32x4*)(res32 + off + bj * HALF); rr[e2][bj][1] = *(const f32x4*)(res32 + off + bj * HALF + 4); }
                    else rw[e2][bj] = *(const u32x4*)(res16 + off + bj * HALF); } }
#pragma unroll
            for (int e2 = 0; e2 < NB; ++e2) { const int ai = (am + e2) >> 2, m = (am + e2) & 3; const int row = rowb + ai * HALF + m * 16; const size_t off = (size_t)row * ldc + col0;
                const float mean = mean8[am + e2], rstd = rstd8[am + e2];
                float ps = 0.f, pq = 0.f;
#pragma unroll
                for (int bj = 0; bj < 2; ++bj) {
                    f32x4 r0, r1;
                    if constexpr (RES32) { r0 = rr[e2][bj][0]; r1 = rr[e2][bj][1]; } else { const u32x4 w = rw[e2][bj]; r0 = (f32x4){bflo(w.x), bfhi(w.x), bflo(w.y), bfhi(w.y)}; r1 = (f32x4){bflo(w.z), bfhi(w.z), bflo(w.w), bfhi(w.w)}; }
                    const f32x4 z0 = (r0 - mean) * rstd * gv[bj][0] + bv[bj][0] + acc[ai][bj][m][0] * sa, z1 = (r1 - mean) * rstd * gv[bj][1] + bv[bj][1] + acc[ai][bj][m][1] * sa;
                    u32x4 w16; w16.x = cvt_pk_bf16(z0[0], z0[1]); w16.y = cvt_pk_bf16(z0[2], z0[3]); w16.z = cvt_pk_bf16(z1[0], z1[1]); w16.w = cvt_pk_bf16(z1[2], z1[3]);
                    *(u32x4*)(o16 + off + bj * HALF) = w16;
                    const float q0 = bflo(w16.x), q1 = bfhi(w16.x), q2 = bflo(w16.y), q3 = bfhi(w16.y), q4 = bflo(w16.z), q5 = bfhi(w16.z), q6 = bflo(w16.w), q7 = bfhi(w16.w);
                    ps += ((q0 + q1) + (q2 + q3)) + ((q4 + q5) + (q6 + q7)); pq += ((q0 * q0 + q1 * q1) + (q2 * q2 + q3 * q3)) + ((q4 * q4 + q5 * q5) + (q6 * q6 + q7 * q7));
                    if (o8) *(u32x2*)(o8 + off + bj * HALF) = (u32x2){pk4_fp8(fminf(fmaxf(q0 * o8s, -448.f), 448.f), fminf(fmaxf(q1 * o8s, -448.f), 448.f), fminf(fmaxf(q2 * o8s, -448.f), 448.f), fminf(fmaxf(q3 * o8s, -448.f), 448.f)),
                                                                      pk4_fp8(fminf(fmaxf(q4 * o8s, -448.f), 448.f), fminf(fmaxf(q5 * o8s, -448.f), 448.f), fminf(fmaxf(q6 * o8s, -448.f), 448.f), fminf(fmaxf(q7 * o8s, -448.f), 448.f))}; }
                if (ostats) { ps += __shfl_xor(ps, 16); ps += __shfl_xor(ps, 32); pq += __shfl_xor(pq, 16); pq += __shfl_xor(pq, 32);
                    if (fq == 0) { (void)__hip_atomic_fetch_add(ostats + 2 * (size_t)row, (long long)__builtin_rintf(ps * 1048576.f), __ATOMIC_RELAXED, __HIP_MEMORY_SCOPE_AGENT); (void)__hip_atomic_fetch_add(ostats + 2 * (size_t)row + 1, (long long)__builtin_rintf(pq * 65536.f), __ATOMIC_RELAXED, __HIP_MEMORY_SCOPE_AGENT); } } }
            asm volatile("" ::: "memory"); }
    }
};

typedef int v8i_t __attribute__((ext_vector_type(8)));
typedef int v4i_t __attribute__((ext_vector_type(4)));
template <class Epi, class Sched, bool ALIGN_EPI, bool FP8 = false, bool BDIAG = false>
__device__ __forceinline__ void gemm_phase(PG8_LAS unsigned char* lds, const Gemm g, const Sched& S, const Epi& E, const int wid) {
    const int lane = lane_fresh(), tid = wid * 64 + lane, wr = wid >> 2, wc = wid & 3, fr = lane & 15, fq = lane >> 4;
    const int K = g.K, nt = K / BK;
    unsigned voffA[2], voffB[2];
#pragma unroll
    for (int i = 0; i < 2; ++i) { int R, C; stage_rc(tid * 16 + i * 8192, R, C); const int Rb = Epi::PERM ? ((R & ~31) + perm32(R & 31)) : R;
        voffA[i] = (unsigned)(R * g.lda + C) * 2u; voffB[i] = (unsigned)(Rb * g.ldb + C) * 2u; }
    const size_t kstep = (size_t)(BK * 2);
    const size_t hstepA = (size_t)HALF * g.lda * 2, hstepB = (size_t)HALF * g.ldb * 2;
    const size_t tstepA = 2 * hstepA, tstepB = 2 * hstepB;
    const unsigned ldsw = (unsigned)wid * 1024u;
    int aoff = lds_byte(wr * 64 + fr, fq * 8), boff = lds_byte(wc * 32 + fr, fq * 8);
    asm volatile("" : "+v"(voffA[0]), "+v"(voffA[1]), "+v"(voffB[0]), "+v"(voffB[1]), "+v"(aoff), "+v"(boff));
#define PG8_UA(u) ((const char*)g.A + (size_t)(u).pm * tstepA + (size_t)(((u).pn >> g.a_shift) * g.a_mul) * 2)
#define PG8_UB(u) ((const char*)g.Bt + (size_t)(g.b_wrap ? ((u).pn & (g.b_wrap - 1)) : (u).pn) * tstepB + (size_t)(((u).pn >> g.a_shift) * g.b_kmul) * 2)
#define PG8_SA(b, h) (((b) * 2 + (h)) * HTB)
#define PG8_SB(b, h) ((4 + (b) * 2 + (h)) * HTB)
#define PG8_STAGE(bufoff, gbase, voff) do { _Pragma("unroll") for (int _i = 0; _i < 2; ++_i) \
        __builtin_amdgcn_global_load_lds((const unsigned*)((const char*)(gbase) + (voff)[_i]), (PG8_LAS unsigned*)(lds + (bufoff) + ldsw + _i * 8192), 16, 0, 0); } while (0)
#define PG8_LD8(p_) __builtin_shufflevector(*(const PG8_LAS v4i_t*)(p_), *(const PG8_LAS v4i_t*)((p_) + 1024), 0, 1, 2, 3, 4, 5, 6, 7)
#define PG8_LDA(dst, b, h) do { _Pragma("unroll") for (int m = 0; m < 4; ++m) { if constexpr (FP8) dst##8[m] = PG8_LD8(lds + PG8_SA(b, h) + aoff + m * 2048); else { _Pragma("unroll") for (int k = 0; k < 2; ++k) dst[m][k] = *(const PG8_LAS bf16x8*)(lds + PG8_SA(b, h) + aoff + m * 2048 + k * 1024); } } } while (0)
#define PG8_LDB(dst, b, h) do { _Pragma("unroll") for (int n = 0; n < 2; ++n) { if constexpr (FP8) dst##8[n] = PG8_LD8(lds + PG8_SB(b, h) + boff + n * 2048); else { _Pragma("unroll") for (int k = 0; k < 2; ++k) dst[n][k] = *(const PG8_LAS bf16x8*)(lds + PG8_SB(b, h) + boff + n * 2048 + k * 1024); } } } while (0)
#define PG8_MMA(ai, bj, At, Bt) do { __builtin_amdgcn_s_setprio(1); _Pragma("unroll") for (int m = 0; m < 4; ++m) _Pragma("unroll") for (int n = 0; n < 2; ++n) { \
        if constexpr (FP8) asm volatile("v_mfma_scale_f32_16x16x128_f8f6f4 %0, %1, %2, %0, %3, %3 op_sel_hi:[0,0,0]" : "+v"(acc[ai][bj][m][n]) : "v"(Bt##8[n]), "v"(At##8[m]), "v"(one_scale)); \
        else { _Pragma("unroll") for (int k = 0; k < 2; ++k) acc[ai][bj][m][n] = __builtin_amdgcn_mfma_f32_16x16x32_bf16(Bt[n][k], At[m][k], acc[ai][bj][m][n], 0, 0, 0); } } \
        __builtin_amdgcn_s_setprio(0); } while (0)
#define PG8_WAIT_V(n) asm volatile("s_waitcnt vmcnt(" #n ")" ::: "memory")
#define PG8_WAIT_L(n) asm volatile("s_waitcnt lgkmcnt(" #n ")" ::: "memory")
#define PG8_BAR __builtin_amdgcn_s_barrier()
#define PG8_SCHED __builtin_amdgcn_sched_barrier(0)
    Unit cur, nxt; int ui = 0;
    if (!S.next(0, cur)) return;
    f32x4 acc[2][2][4][2];
#pragma unroll
    for (int a = 0; a < 2; ++a)
#pragma unroll
        for (int b = 0; b < 2; ++b)
#pragma unroll
            for (int m = 0; m < 4; ++m)
#pragma unroll
                for (int n = 0; n < 2; ++n) acc[a][b][m][n] = (f32x4){0.f, 0.f, 0.f, 0.f};
    bf16x8 At[4][2], B0[2][2], B1[2][2]; v8i_t At8[4], B08[2], B18[2];
    int one_scale = 0x7f7f7f7f; asm volatile("" : "+v"(one_scale));
    const char* cA = PG8_UA(cur); const char* cB = PG8_UB(cur);
    S.a_ready(cur);
    PG8_STAGE(PG8_SB(0, 0), cB, voffB); PG8_STAGE(PG8_SB(0, 1), cB + hstepB, voffB); PG8_STAGE(PG8_SA(0, 0), cA, voffA); PG8_STAGE(PG8_SA(0, 1), cA + hstepA, voffA);
    if (wr == 1) PG8_BAR;
    PG8_WAIT_V(2); PG8_BAR;
    PG8_STAGE(PG8_SB(1, 0), cB + kstep, voffB); PG8_STAGE(PG8_SA(1, 0), cA + kstep, voffA); PG8_STAGE(PG8_SB(1, 1), cB + hstepB + kstep, voffB);
    PG8_WAIT_V(6); PG8_BAR;
    for (;;) {
        const bool has_next = S.next(ui + 1, nxt);
        const char* nA = has_next ? PG8_UA(nxt) : cA; const char* nB = has_next ? PG8_UB(nxt) : cB;
        for (int t = 0; t < nt; t += 2) {
            const bool last = (t == nt - 2); const bool kh0 = 2 * t < nt; (void)kh0;
            const char* a1 = cA + (size_t)(t + 1) * kstep;
            const char* a2 = last ? nA : cA + (size_t)(t + 2) * kstep; const char* b2 = last ? nB : cB + (size_t)(t + 2) * kstep;
            const char* a3 = a2 + kstep; const char* b3 = b2 + kstep;
            if (last && has_next) S.a_ready(nxt);
            PG8_LDB(B0, 0, 0); PG8_LDB(B1, 0, 1); PG8_SCHED; PG8_LDA(At, 0, 0); PG8_STAGE(PG8_SA(1, 1), a1 + hstepA, voffA);
            PG8_WAIT_V(8); PG8_WAIT_L(0); PG8_BAR; if (!BDIAG || kh0) PG8_MMA(0, 0, At, B0); if (!BDIAG || !kh0) PG8_MMA(0, 1, At, B1); PG8_BAR; PG8_SCHED;
            PG8_LDA(At, 0, 1); PG8_STAGE(PG8_SB(0, 0), b2, voffB); PG8_STAGE(PG8_SB(0, 1), b2 + hstepB, voffB); PG8_STAGE(PG8_SA(0, 0), a2, voffA);
            PG8_WAIT_V(8); PG8_WAIT_L(0); PG8_BAR; if (!BDIAG || kh0) PG8_MMA(1, 0, At, B0); if (!BDIAG || !kh0) PG8_MMA(1, 1, At, B1); PG8_BAR; PG8_SCHED;
            PG8_LDB(B0, 1, 0); PG8_LDB(B1, 1, 1); PG8_SCHED; PG8_LDA(At, 1, 0); PG8_STAGE(PG8_SA(0, 1), a2 + hstepA, voffA);
            PG8_WAIT_V(8); PG8_WAIT_L(0); PG8_BAR; if (!BDIAG || kh0) PG8_MMA(0, 0, At, B0); if (!BDIAG || !kh0) PG8_MMA(0, 1, At, B1); PG8_BAR; PG8_SCHED;
            PG8_LDA(At, 1, 1); PG8_STAGE(PG8_SB(1, 0), b3, voffB); PG8_STAGE(PG8_SB(1, 1), b3 + hstepB, voffB); PG8_STAGE(PG8_SA(1, 0), a3, voffA);
            PG8_WAIT_V(8); PG8_WAIT_L(0); PG8_BAR; if (!BDIAG || kh0) PG8_MMA(1, 0, At, B0); if (!BDIAG || !kh0) PG8_MMA(1, 1, At, B1); PG8_BAR; PG8_SCHED;
        }
        if constexpr (ALIGN_EPI) { if (wr == 0) PG8_BAR; }
        if constexpr (FP8) asm volatile("s_nop 15\n\ts_nop 7" ::: "memory");
        { const int le = lane_fresh(); E(acc, cur, wr, wc, le & 15, le >> 4); } S.done(cur);
        if (!has_next) break;
#pragma unroll
        for (int a = 0; a < 2; ++a)
#pragma unroll
            for (int b = 0; b < 2; ++b)
#pragma unroll
                for (int m = 0; m < 4; ++m)
#pragma unroll
                    for (int n = 0; n < 2; ++n) acc[a][b][m][n] = (f32x4){0.f, 0.f, 0.f, 0.f};
        cur = nxt; cA = nA; cB = nB; ++ui;
        if constexpr (ALIGN_EPI) { if (wr == 1) PG8_BAR; }
    }
    PG8_WAIT_V(0);
    if constexpr (!ALIGN_EPI) { if (wr == 0) PG8_BAR; }
    PG8_BAR;
#undef PG8_UA
#undef PG8_UB
#undef PG8_SA
#undef PG8_SB
#undef PG8_STAGE
#undef PG8_LDA
#undef PG8_LDB
#undef PG8_MMA
#undef PG8_LD8
#undef PG8_WAIT_V
#undef PG8_WAIT_L
#undef PG8_BAR
#undef PG8_SCHED
}
}

constexpr int NWAVES = 8;
constexpr int BATCH = 4, SEQ = 4096, D = 2048, FF = 5632, M = BATCH * SEQ;
constexpr int N_IN = 5888;
constexpr int MEMT = 256;
constexpr float LN_EPS = 1e-5f;
constexpr float ALPHA = 1.189207115002721f;
constexpr float LAMBDA_INIT = 0.2f;

constexpr size_t MiB = 1u << 20;
constexpr size_t WS_CTL = 0, CTL_ZERO_BYTES = 2 * MiB;
constexpr size_t WS_W_IN = 2 * MiB;
constexpr size_t WS_W_IN8 = WS_W_IN, WS_W_INB = WS_W_IN + 9 * MiB; constexpr int N_IN8 = 4608, N_INB = 1280;
constexpr size_t WS_W_G = 25 * MiB;
constexpr size_t WS_W_UK = 41 * MiB;
constexpr size_t WS_W_UVP = 42 * MiB;
constexpr size_t WS_W_A = 44 * MiB;
constexpr size_t WS_W_B = 48 * MiB;
constexpr size_t WS_W_MO = 52 * MiB;
constexpr size_t WS_W_MQ = 60 * MiB;
constexpr size_t WS_W_MKV = 62 * MiB;
constexpr size_t WS_W_MOUT = 66 * MiB;
constexpr size_t WS_MEM16 = 68 * MiB;
constexpr size_t WS_KVMEM = 72 * MiB;
constexpr size_t WS_W_GU2 = 74 * MiB;
constexpr size_t WS_W_D2 = 96 * MiB;
constexpr size_t WS_X8M = 107 * MiB;
constexpr size_t WS_X16 = 140 * MiB;
constexpr size_t WS_MIX = 204 * MiB;
constexpr size_t WS_W_GU1 = 204 * MiB;
constexpr size_t WS_W_D1 = 248 * MiB;
constexpr size_t WS_H = 270 * MiB;
constexpr size_t WS_AQ = WS_MIX + 0 * MiB, WS_AK = WS_MIX + 32 * MiB, WS_AV = WS_MIX + 64 * MiB, WS_BQ = WS_MIX + 96 * MiB;
constexpr size_t WS_BC = WS_MIX + 128 * MiB;
constexpr size_t WS_IQ = WS_MIX + 144 * MiB;
constexpr size_t WS_IKW = WS_MIX + 176 * MiB;
constexpr size_t WS_QLAT = WS_MIX + 184 * MiB;
constexpr size_t WS_IDX = WS_MIX + 312 * MiB;
constexpr size_t WS_YB = WS_BQ;
constexpr size_t WS_TA = WS_QLAT, WS_TB = WS_QLAT + 64 * MiB;
constexpr size_t WS_QM = WS_AQ, WS_OM = WS_AK;
constexpr size_t WS_X8 = WS_H + 96 * MiB;
constexpr size_t WS_YA8 = WS_W_IN;
constexpr size_t WS_C8 = WS_W_G + 8 * MiB;
constexpr size_t WS_MRG8 = WS_AV;
constexpr float FP8_OMS = 64.f, FP8_WMOUTS = 1024.f;
constexpr float FP8_WUVS = 1024.f;
constexpr float FP8_WGS = 1024.f, FP8_MS = 32.f, FP8_WMOS = 2048.f, FP8_YS = 64.f, FP8_WBS = 1024.f, FP8_YAS = 64.f, FP8_WAS = 1024.f;
constexpr float FP8_XS = 32.f, FP8_WGUS = 1024.f, FP8_HS = 8.f, FP8_WDS = 4096.f;
constexpr size_t WS_END = WS_MIX + 320 * MiB;
static_assert(WS_H + (size_t)M * FF * 2 <= WS_END && WS_QLAT + (size_t)M * 4096 * 2 <= WS_END, "d_ws map");
constexpr int CW_BAR = 4096;
constexpr int CW_DQ = 8192;
constexpr int CW_KMAX = 8256;
constexpr size_t CTL_STATS = 65536, CTL_STATS_STRIDE = (size_t)M * 2 * 8;
constexpr size_t CTL_VEC = CTL_STATS + 3 * CTL_STATS_STRIDE;
constexpr int V_GW_IN = 0, V_BW_IN = 5888, V_GW_G = 11776, V_BW_G = 15872, V_GW_MQ = 19968, V_BW_MQ = 20480, V_GW_GU2 = 20992, V_BW_GU2 = 32256, V_END = 43520;
constexpr size_t CTL_VECF = CTL_VEC + (size_t)V_END * 8;
static_assert(CTL_VECF + (size_t)V_END * 4 <= CTL_ZERO_BYTES, "control region");
constexpr float FX_S = 1048576.f, FX_Q = 65536.f, FX_V = 16777216.f;

constexpr int RING_OFF = 0, RING_BYTES = 153600;
constexpr int LDSCTL_OFF = RING_BYTES, MISC_OFF = LDSCTL_OFF + 320;
constexpr int LDS_BYTES = 154624;
static_assert(MISC_OFF + 128 <= LDS_BYTES, "LDS map");

#define GAS __attribute__((address_space(1)))
#define LAS __attribute__((address_space(3)))
typedef unsigned short bf16;
typedef unsigned v4u __attribute__((ext_vector_type(4)));
typedef unsigned v2u __attribute__((ext_vector_type(2)));
typedef float f32x4 __attribute__((ext_vector_type(4)));
typedef float f32x16 __attribute__((ext_vector_type(16)));
typedef short bf16x8 __attribute__((ext_vector_type(8)));
typedef GAS unsigned gu32;
#define RLX_AGENT __ATOMIC_RELAXED, __HIP_MEMORY_SCOPE_AGENT
#define LDS_WAIT() asm volatile("s_waitcnt lgkmcnt(0)" ::: "memory")
#define VM_WAIT() asm volatile("s_waitcnt vmcnt(0)" ::: "memory")
__device__ __forceinline__ unsigned f2bf(float f) { unsigned u = __builtin_bit_cast(unsigned, f); return (u + 0x7fffu + ((u >> 16) & 1u)) >> 16; }
__device__ __forceinline__ unsigned pk2(float lo, float hi) { return f2bf(lo) | (f2bf(hi) << 16); }
__device__ __forceinline__ float bf2f(unsigned short v) { return __uint_as_float((unsigned)v << 16); }
__device__ __forceinline__ float blo(unsigned w) { return __uint_as_float(w << 16); }
__device__ __forceinline__ float bhi(unsigned w) { return __uint_as_float(w & 0xffff0000u); }
__device__ __forceinline__ float wave_sum(float v) {
    v += __builtin_bit_cast(float, __builtin_amdgcn_update_dpp(0, __builtin_bit_cast(int, v), 0xB1, 0xf, 0xf, true));
    v += __builtin_bit_cast(float, __builtin_amdgcn_update_dpp(0, __builtin_bit_cast(int, v), 0x4E, 0xf, 0xf, true));
    v += __builtin_bit_cast(float, __builtin_amdgcn_update_dpp(0, __builtin_bit_cast(int, v), 0x141, 0xf, 0xf, true));
    v += __builtin_bit_cast(float, __builtin_amdgcn_update_dpp(0, __builtin_bit_cast(int, v), 0x140, 0xf, 0xf, true));
    { const auto rr = __builtin_amdgcn_permlane16_swap(__float_as_uint(v), __float_as_uint(v), false, false); v = __uint_as_float(rr[0]) + __uint_as_float(rr[1]); }
    { const auto rr = __builtin_amdgcn_permlane32_swap(__float_as_uint(v), __float_as_uint(v), false, false); v = __uint_as_float(rr[0]) + __uint_as_float(rr[1]); }
    return v;
}

__device__ __forceinline__ float xhalf_add(float a) { const auto rr = __builtin_amdgcn_permlane32_swap(__float_as_uint(a), __float_as_uint(a), false, false); return __uint_as_float(rr[0]) + __uint_as_float(rr[1]); }
__device__ __forceinline__ float xhalf_max(float a) { const auto rr = __builtin_amdgcn_permlane32_swap(__float_as_uint(a), __float_as_uint(a), false, false); return fmaxf(__uint_as_float(rr[0]), __uint_as_float(rr[1])); }
__device__ __forceinline__ int half_sum_i32(int v) {
    v += __builtin_amdgcn_update_dpp(0, v, 0xB1, 0xf, 0xf, true);
    v += __builtin_amdgcn_update_dpp(0, v, 0x4E, 0xf, 0xf, true);
    v += __builtin_amdgcn_update_dpp(0, v, 0x141, 0xf, 0xf, true);
    v += __builtin_amdgcn_update_dpp(0, v, 0x140, 0xf, 0xf, true);
    const auto rr = __builtin_amdgcn_permlane16_swap((unsigned)v, (unsigned)v, false, false); return (int)rr[0] + (int)rr[1];
}
#define XB_TMO      128
#define XB_XCNT(j)  (256  + 64 * (j))
#define XB_XSUB(j)  (1280 + 64 * (j))
#define XB_XGEN(j)  (2304 + 64 * (j))
#define XB_TOP      3328
#define XB_TOPGEN   3392
#define XCD_BAR_WORDS 3456
#define XB_SPIN_CAP (1u << 18)

__device__ __forceinline__ unsigned xb_ld(unsigned* p)              { return __hip_atomic_load(p, __ATOMIC_RELAXED, __HIP_MEMORY_SCOPE_AGENT); }
__device__ __forceinline__ unsigned xb_add(unsigned* p, unsigned v) { return __hip_atomic_fetch_add(p, v, __ATOMIC_RELAXED, __HIP_MEMORY_SCOPE_AGENT); }
__device__ __forceinline__ unsigned xb_add_l2(unsigned* p, unsigned v) { unsigned r; asm volatile("global_atomic_add %0, %1, %2, off sc0\n\ts_waitcnt vmcnt(0)" : "=&v"(r) : "v"(p), "v"(v) : "memory"); return r; }
__device__ __forceinline__ void xb_add_l2_nr(unsigned* p, unsigned v) { asm volatile("global_atomic_add %0, %1, off" :: "v"(p), "v"(v) : "memory"); }
__device__ __forceinline__ unsigned xb_ld_l2(unsigned* p) { return xb_add_l2(p, 0u); }
__device__ __forceinline__ unsigned xb_xcc_id() { return (unsigned)__builtin_amdgcn_s_getreg((3 << 11) | 20) & 0xFu; }
#define XB_SPIN(cond, bar) do { unsigned _sp = 0; while (cond) { __builtin_amdgcn_s_sleep(1); \
    if ((++_sp & 255u) == 0u) { if (xb_ld(&(bar)[XB_TMO])) break; if (_sp > XB_SPIN_CAP) { atomicAdd(&(bar)[XB_TMO], 1u); break; } } } } while (0)

struct XcdBarrier {
    unsigned* bar; unsigned x;
    volatile LAS unsigned* st;
};

__device__ __forceinline__ XcdBarrier xcd_barrier_post(unsigned* bar, volatile LAS unsigned* st, bool t0) {
    XcdBarrier b; b.bar = bar; b.x = xb_xcc_id(); b.st = st;
    if (t0) st[2] = xb_add(&bar[XB_XCNT(b.x)], 1u);
    return b;
}
__device__ __forceinline__ void xcd_barrier_complete(unsigned* bar, unsigned x, unsigned& nloc, unsigned& nx) {
    const unsigned G = gridDim.x * gridDim.y * gridDim.z;
    unsigned sum, cnt, mine, sp = 0u;
    for (;;) {
        sum = 0u; cnt = 0u; mine = 0u;
#pragma unroll
        for (unsigned j = 0; j < 16; ++j) { const unsigned c = xb_ld(&bar[XB_XCNT(j)]); sum += c; cnt += (c > 0u) ? 1u : 0u; mine = (j == x) ? c : mine; }
        if (sum == G) break;
        __builtin_amdgcn_s_sleep(1);
        if ((++sp & 255u) == 0u) { if (xb_ld(&bar[XB_TMO])) break; if (sp > XB_SPIN_CAP) { atomicAdd(&bar[XB_TMO], 1u); break; } }
    }
    nloc = mine > 0u ? mine : 1u; nx = cnt > 0u ? cnt : 1u;
}

__device__ __forceinline__ void xcd_barrier(const XcdBarrier& b, const int wave) {
    asm volatile("s_waitcnt vmcnt(0)" ::: "memory");
    __syncthreads();
    if (wave == 0 && lane_fresh() == 0) {
        unsigned* bar = b.bar;
        __builtin_amdgcn_s_waitcnt(0);
        unsigned nloc = b.st[0], nx = b.st[1];
        if (nloc == 0u) { xcd_barrier_complete(bar, b.x, nloc, nx); b.st[0] = nloc; b.st[1] = nx; }
        const unsigned old = xb_add_l2(&bar[XB_XSUB(b.x)], 1u);
        const unsigned gen = old / nloc;
        if (old + 1u == (gen + 1u) * nloc) {
            __builtin_amdgcn_fence(__ATOMIC_RELEASE, "agent");
            asm volatile("s_waitcnt vmcnt(0)" ::: "memory");
            const unsigned og = xb_add(&bar[XB_TOP], 1u);
            const unsigned tg = og / nx;
            if (og + 1u == (tg + 1u) * nx) xb_add(&bar[XB_TOPGEN], 1u);
            else XB_SPIN(xb_ld(&bar[XB_TOPGEN]) == tg, bar);
            __builtin_amdgcn_fence(__ATOMIC_ACQUIRE, "agent");
            xb_add_l2_nr(&bar[XB_XGEN(b.x)], 1u);
            asm volatile("s_waitcnt vmcnt(0)" ::: "memory");
        } else {
            XB_SPIN(xb_ld_l2(&bar[XB_XGEN(b.x)]) == gen, bar);
            __builtin_amdgcn_fence(__ATOMIC_ACQUIRE, "agent");
            asm volatile("s_waitcnt vmcnt(0)" ::: "memory");
        }
    }
    __syncthreads();
}

__device__ __forceinline__ void tr_load(const float* W, int ldw, int nvalid, int k0, int n0, const float* G, const float* B, int lane, f32x4 (&pv)[8], f32x4& gbv, int& okf) {
    gbv = *(const GAS f32x4*)((lane < 16 ? G + 4 * lane : (lane < 32 ? B + 4 * (lane - 16) : G)) + k0);
    const int n4 = 4 * (lane & 7), kr = lane >> 3; const bool ok = n0 + n4 < nvalid;
    const float* base = W + (size_t)(k0 + kr) * ldw + (ok ? n0 + n4 : 0);
#pragma unroll
    for (int i = 0; i < 8; ++i) pv[i] = __builtin_nontemporal_load((const GAS f32x4*)(base + (size_t)(8 * i) * ldw));
    okf = ok ? 1 : 0;
}
__device__ __forceinline__ void tr_stage(LAS float* scr, int lane, const f32x4 (&pv)[8], const f32x4& gbv, const int okf) {
    const int n4 = 4 * (lane & 7), kr = lane >> 3; const float m = okf ? 1.f : 0.f;
#pragma unroll
    for (int i = 0; i < 8; ++i) { const int kk = 8 * i + kr; const f32x4 v = pv[i]; LAS float* d = scr + kk * 33 + n4; d[0] = okf ? v.x : 0.f; d[1] = okf ? v.y : 0.f; d[2] = okf ? v.z : 0.f; d[3] = okf ? v.w : 0.f; }
    (void)m;
    if (lane < 32) *(LAS f32x4*)(scr + 64 * 33 + 4 * lane) = gbv;
    LDS_WAIT(); asm volatile("" ::: "memory");
}
__device__ __forceinline__ void tr_item(const float* W, int ldw, int nvalid, bf16* WT, int ldt, int k0, int n0, int drow0, int dcol0, LAS float* scr, int lane) {
    const int c = lane & 7;
#pragma unroll
    for (int j = 0; j < 4; ++j) { const int nn = (lane >> 3) + 8 * j; const LAS float* s = scr + (8 * c) * 33 + nn;
        v4u o; o.x = pk2(s[0 * 33], s[1 * 33]); o.y = pk2(s[2 * 33], s[3 * 33]); o.z = pk2(s[4 * 33], s[5 * 33]); o.w = pk2(s[6 * 33], s[7 * 33]);
        *(GAS v4u*)(WT + (size_t)(drow0 + nn) * ldt + dcol0 + k0 + 8 * c) = o; }
    LDS_WAIT(); asm volatile("" ::: "memory");
}
__device__ __forceinline__ void tr_item8(const float* W, int ldw, unsigned char* WT, int ldt, int k0, int n0, int drow0, float sc, LAS float* scr, int lane, int dcol0 = 0) {
    const int nn = lane >> 1, hf = lane & 1; const LAS float* sp = scr + (32 * hf) * 33 + nn;
    unsigned o[8];
#pragma unroll
    for (int q = 0; q < 8; ++q) { const float a = fminf(fmaxf(sp[(4 * q + 0) * 33] * sc, -448.f), 448.f), b = fminf(fmaxf(sp[(4 * q + 1) * 33] * sc, -448.f), 448.f), c = fminf(fmaxf(sp[(4 * q + 2) * 33] * sc, -448.f), 448.f), d = fminf(fmaxf(sp[(4 * q + 3) * 33] * sc, -448.f), 448.f);
        int w = 0; w = __builtin_amdgcn_cvt_pk_fp8_f32(a, b, w, false); w = __builtin_amdgcn_cvt_pk_fp8_f32(c, d, w, true); o[q] = (unsigned)w; }
    GAS v4u* dst = (GAS v4u*)(WT + (size_t)(drow0 + nn) * ldt + dcol0 + k0 + 32 * hf);
    dst[0] = (v4u){o[0], o[1], o[2], o[3]}; dst[1] = (v4u){o[4], o[5], o[6], o[7]};
    LDS_WAIT(); asm volatile("" ::: "memory");
}
__device__ __forceinline__ void tr_item_ln(const float* W, int ldw, int nvalid, bf16* WT, int ldt, int k0, int n0, int drow0, const float* gain, const float* bvec, long long* gW, long long* bW, LAS float* scr, int lane) {
    const int c = lane & 7;
    const LAS float* sgb = scr + 64 * 33;
    const f32x4 g0 = *(const LAS f32x4*)(sgb + 8 * c), g1 = *(const LAS f32x4*)(sgb + 8 * c + 4), b0 = *(const LAS f32x4*)(sgb + 64 + 8 * c), b1 = *(const LAS f32x4*)(sgb + 64 + 8 * c + 4);
    const float gk[8] = {g0.x, g0.y, g0.z, g0.w, g1.x, g1.y, g1.z, g1.w}, bk[8] = {b0.x, b0.y, b0.z, b0.w, b1.x, b1.y, b1.z, b1.w};
#pragma unroll
    for (int j = 0; j < 4; ++j) { const int nn = (lane >> 3) + 8 * j; const LAS float* sp = scr + (8 * c) * 33 + nn;
        float v[8], bs = 0.f;
#pragma unroll
        for (int i = 0; i < 8; ++i) { const float raw = sp[i * 33]; v[i] = raw * gk[i]; bs += raw * bk[i]; }
        v4u o; o.x = pk2(v[0], v[1]); o.y = pk2(v[2], v[3]); o.z = pk2(v[4], v[5]); o.w = pk2(v[6], v[7]);
        float gs = ((blo(o.x) + bhi(o.x)) + (blo(o.y) + bhi(o.y))) + ((blo(o.z) + bhi(o.z)) + (blo(o.w) + bhi(o.w)));
        *(GAS v4u*)(WT + (size_t)(drow0 + nn) * ldt + k0 + 8 * c) = o;
        gs += __shfl_xor(gs, 1); gs += __shfl_xor(gs, 2); gs += __shfl_xor(gs, 4); bs += __shfl_xor(bs, 1); bs += __shfl_xor(bs, 2); bs += __shfl_xor(bs, 4);
        if (c == 0) { (void)__hip_atomic_fetch_add(gW + drow0 + nn, (long long)__builtin_rintf(gs * FX_V), __ATOMIC_RELAXED, __HIP_MEMORY_SCOPE_AGENT); (void)__hip_atomic_fetch_add(bW + drow0 + nn, (long long)__builtin_rintf(bs * FX_V), __ATOMIC_RELAXED, __HIP_MEMORY_SCOPE_AGENT); } }
    LDS_WAIT(); asm volatile("" ::: "memory");
}
__device__ __forceinline__ void tr_item8_ln(const float* W, int ldw, unsigned char* WT, int ldt, int k0, int n0, int drow0, float sc, const float* gain, const float* bvec, long long* gW, long long* bW, LAS float* scr, int lane) {
    const int nn = lane >> 1, hf = lane & 1; const LAS float* sp = scr + (32 * hf) * 33 + nn;
    unsigned o[8]; float gs = 0.f, bs = 0.f;
#pragma unroll
    for (int q = 0; q < 8; ++q) { const f32x4 g4 = *(const LAS f32x4*)(scr + 64 * 33 + 32 * hf + 4 * q), b4 = *(const LAS f32x4*)(scr + 64 * 33 + 64 + 32 * hf + 4 * q);
        const float r0 = sp[(4 * q + 0) * 33], r1 = sp[(4 * q + 1) * 33], r2 = sp[(4 * q + 2) * 33], r3 = sp[(4 * q + 3) * 33];
        bs += (r0 * b4.x + r1 * b4.y) + (r2 * b4.z + r3 * b4.w);
        const float a = fminf(fmaxf(r0 * g4.x * sc, -448.f), 448.f), b = fminf(fmaxf(r1 * g4.y * sc, -448.f), 448.f), c = fminf(fmaxf(r2 * g4.z * sc, -448.f), 448.f), d = fminf(fmaxf(r3 * g4.w * sc, -448.f), 448.f);
        int w = 0; w = __builtin_amdgcn_cvt_pk_fp8_f32(a, b, w, false); w = __builtin_amdgcn_cvt_pk_fp8_f32(c, d, w, true); o[q] = (unsigned)w;
        gs += (__builtin_amdgcn_cvt_f32_fp8(w, 0) + __builtin_amdgcn_cvt_f32_fp8(w, 1)) + (__builtin_amdgcn_cvt_f32_fp8(w, 2) + __builtin_amdgcn_cvt_f32_fp8(w, 3)); }
    GAS v4u* dst = (GAS v4u*)(WT + (size_t)(drow0 + nn) * ldt + k0 + 32 * hf);
    dst[0] = (v4u){o[0], o[1], o[2], o[3]}; dst[1] = (v4u){o[4], o[5], o[6], o[7]};
    gs += __shfl_xor(gs, 1); bs += __shfl_xor(bs, 1);
    if (hf == 0) { (void)__hip_atomic_fetch_add(gW + drow0 + nn, (long long)__builtin_rintf(gs / sc * FX_V), __ATOMIC_RELAXED, __HIP_MEMORY_SCOPE_AGENT); (void)__hip_atomic_fetch_add(bW + drow0 + nn, (long long)__builtin_rintf(bs * FX_V), __ATOMIC_RELAXED, __HIP_MEMORY_SCOPE_AGENT); }
    LDS_WAIT(); asm volatile("" ::: "memory");
}
__device__ __forceinline__ void cvt_item8(const float* src, unsigned char* dst, int item, int lane, float sc) {
    const GAS f32x4* sp = (const GAS f32x4*)(src + (size_t)item * 512) + 2 * lane; f32x4 a = sp[0] * sc, b = sp[1] * sc;
    int w0 = 0, w1 = 0; w0 = __builtin_amdgcn_cvt_pk_fp8_f32(fminf(fmaxf(a.x, -448.f), 448.f), fminf(fmaxf(a.y, -448.f), 448.f), w0, false); w0 = __builtin_amdgcn_cvt_pk_fp8_f32(fminf(fmaxf(a.z, -448.f), 448.f), fminf(fmaxf(a.w, -448.f), 448.f), w0, true);
    w1 = __builtin_amdgcn_cvt_pk_fp8_f32(fminf(fmaxf(b.x, -448.f), 448.f), fminf(fmaxf(b.y, -448.f), 448.f), w1, false); w1 = __builtin_amdgcn_cvt_pk_fp8_f32(fminf(fmaxf(b.z, -448.f), 448.f), fminf(fmaxf(b.w, -448.f), 448.f), w1, true);
    *((GAS v2u*)(dst + (size_t)item * 512) + lane) = (v2u){(unsigned)w0, (unsigned)w1};
}
__device__ __forceinline__ void cvt_item(const float* src, bf16* dst, int item, int lane) {
    const GAS f32x4* s = (const GAS f32x4*)(src + (size_t)item * 512) + 2 * lane; const f32x4 a = s[0], b = s[1];
    v4u o; o.x = pk2(a.x, a.y); o.y = pk2(a.z, a.w); o.z = pk2(b.x, b.y); o.w = pk2(b.z, b.w);
    *((GAS v4u*)(dst + (size_t)item * 512) + lane) = o;
}
__device__ __forceinline__ void p0_prologue(const float* const (&in)[24], unsigned char* ws, LAS unsigned char* lds, int gw, int NGW, int wave, int lane) {
    LAS float* scr = (LAS float*)(lds + RING_OFF + wave * 16384);
    long long* const vec = (long long*)(ws + WS_CTL + CTL_VEC);
#define P0_LIST(E16, E8, EL16, EL8, EUV) \
        E8(in[2], 2048, 5632, 5632, WS_W_GU1, 2048, 256 * (n0 >> 7) + (n0 & 127), FP8_WGUS)             \
        E8(in[3], 2048, 5632, 5632, WS_W_GU1, 2048, 256 * (n0 >> 7) + 128 + (n0 & 127), FP8_WGUS)       \
        E8(in[4], 5632, 2048, 2048, WS_W_D1, 5632, n0, FP8_WDS)                                        \
        EL8(in[5], 2048, 5712, 4608, WS_W_IN8, 2048, n0, FP8_WGS, in[22], in[23], V_GW_IN, V_BW_IN)     \
        EL16(in[5] + 4608, 2048, 5712, 1104, 1280, WS_W_INB, 2048, n0, in[22], in[23], V_GW_IN + 4608, V_BW_IN + 4608)     \
        EL8(in[11], 2048, 2048, 2048, WS_W_G, 2048, 256 * (n0 >> 7) + (n0 & 127), FP8_WGS, in[22], in[23], V_GW_G, V_BW_G)               \
        EL8(in[11] + (size_t)2048 * 2048, 2048, 2048, 2048, WS_W_G, 2048, 256 * (n0 >> 7) + 128 + (n0 & 127), FP8_WGS, in[22], in[23], V_GW_G, V_BW_G)     \
        EUV \
        E8(in[13], 1024, 2048, 2048, WS_W_A, 1024, n0, FP8_WAS)                                         \
        E8(in[14], 1024, 2048, 2048, WS_W_B, 1024, n0, FP8_WBS)                                         \
        E8(in[15], 2048, 2048, 2048, WS_W_MO, 2048, n0, FP8_WMOS) \
        EL16(in[16], 2048, 512, 512, 512, WS_W_MQ, 2048, n0, in[22] + D, in[23] + D, V_GW_MQ, V_BW_MQ)                     \
        E16(in[17], 2048, 1024, 1024, 1024, WS_W_MKV, 2048, n0, 0) \
        E8(in[18], 512, 2048, 2048, WS_W_MOUT, 512, n0, FP8_WMOUTS)                                     \
        EL8(in[19], 2048, 5632, 5632, WS_W_GU2, 2048, 256 * (n0 >> 7) + (n0 & 127), FP8_WGUS, in[22] + 2 * D, in[23] + 2 * D, V_GW_GU2, V_BW_GU2)            \
        EL8(in[20], 2048, 5632, 5632, WS_W_GU2, 2048, 256 * (n0 >> 7) + 128 + (n0 & 127), FP8_WGUS, in[22] + 2 * D, in[23] + 2 * D, V_GW_GU2, V_BW_GU2)      \
        E8(in[21], 5632, 2048, 2048, WS_W_D2, 5632, n0, FP8_WDS)
#define TRM(SRC, Kk, LDW, NVALID, NPAD, DST, LDT, ROWMAP, DCOL) { constexpr int nblk = (NPAD) / 32; constexpr int cnt = ((Kk) / 64) * nblk; \
        if (r < cnt) { const int kb = r / nblk, nb = r % nblk, n0 = 32 * nb; tr_item(SRC, LDW, NVALID, (bf16*)(ws + (DST)), LDT, 64 * kb, n0, (ROWMAP), (DCOL), scr, lane); break; } r -= cnt; }
#define TRM8(SRC, Kk, LDW, NN, DST, LDT, ROWMAP, SC) { constexpr int nblk = (NN) / 32; constexpr int cnt = ((Kk) / 64) * nblk; \
        if (r < cnt) { const int kb = r / nblk, nb = r % nblk, n0 = 32 * nb; tr_item8(SRC, LDW, (unsigned char*)(ws + (DST)), LDT, 64 * kb, n0, (ROWMAP), SC, scr, lane); break; } r -= cnt; }
#define TRML(SRC, Kk, LDW, NVALID, NPAD, DST, LDT, ROWMAP, GAIN, BVEC, VG, VB) { constexpr int nblk = (NPAD) / 32; constexpr int cnt = ((Kk) / 64) * nblk; \
        if (r < cnt) { const int kb = r / nblk, nb = r % nblk, n0 = 32 * nb; tr_item_ln(SRC, LDW, NVALID, (bf16*)(ws + (DST)), LDT, 64 * kb, n0, (ROWMAP), GAIN, BVEC, vec + (VG), vec + (VB), scr, lane); break; } r -= cnt; }
#define TRML8(SRC, Kk, LDW, NN, DST, LDT, ROWMAP, SC, GAIN, BVEC, VG, VB) { constexpr int nblk = (NN) / 32; constexpr int cnt = ((Kk) / 64) * nblk; \
        if (r < cnt) { const int kb = r / nblk, nb = r % nblk, n0 = 32 * nb; tr_item8_ln(SRC, LDW, (unsigned char*)(ws + (DST)), LDT, 64 * kb, n0, (ROWMAP), SC, GAIN, BVEC, vec + (VG), vec + (VB), scr, lane); break; } r -= cnt; }
#define TRUV { if (r < 256) { const int h = r >> 5, rr = r & 31, kb = rr >> 2, nb = rr & 3;                     \
            tr_item8(in[10] + (size_t)h * 512 * 128, 128, (unsigned char*)(ws + WS_W_UVP), 1024, 64 * kb, 32 * nb, (h >> 1) * 256 + (h & 1) * 128 + 32 * nb, FP8_WUVS, scr, lane, (h & 1) * 512); break; } r -= 256; }
#define LDM(SRC, Kk, LDW, NVALID, NPAD, DST, LDT, ROWMAP, DCOL) { constexpr int nblk = (NPAD) / 32; constexpr int cnt = ((Kk) / 64) * nblk; if (r < cnt) { W_ = SRC; ldw_ = LDW; nv_ = NVALID; k0_ = 64 * (r / nblk); n0_ = 32 * (r % nblk); break; } r -= cnt; }
#define LDM8(SRC, Kk, LDW, NN, DST, LDT, ROWMAP, SC) { constexpr int nblk = (NN) / 32; constexpr int cnt = ((Kk) / 64) * nblk; if (r < cnt) { W_ = SRC; ldw_ = LDW; nv_ = NN; k0_ = 64 * (r / nblk); n0_ = 32 * (r % nblk); break; } r -= cnt; }
#define LDML(SRC, Kk, LDW, NVALID, NPAD, DST, LDT, ROWMAP, GAIN, BVEC, VG, VB) { constexpr int nblk = (NPAD) / 32; constexpr int cnt = ((Kk) / 64) * nblk; if (r < cnt) { W_ = SRC; ldw_ = LDW; nv_ = NVALID; k0_ = 64 * (r / nblk); n0_ = 32 * (r % nblk); G_ = GAIN; B_ = BVEC; break; } r -= cnt; }
#define LDML8(SRC, Kk, LDW, NN, DST, LDT, ROWMAP, SC, GAIN, BVEC, VG, VB) { constexpr int nblk = (NN) / 32; constexpr int cnt = ((Kk) / 64) * nblk; if (r < cnt) { W_ = SRC; ldw_ = LDW; nv_ = NN; k0_ = 64 * (r / nblk); n0_ = 32 * (r % nblk); G_ = GAIN; B_ = BVEC; break; } r -= cnt; }
#define LDUV { if (r < 256) { const int h = r >> 5, rr = r & 31; W_ = in[10] + (size_t)h * 512 * 128; ldw_ = 128; nv_ = 128; k0_ = 64 * (rr >> 2); n0_ = 32 * (rr & 3); break; } r -= 256; }
#define P0_LOAD(IT, PV, GB, OK) do { const float* W_ = in[2]; const float* G_ = in[22]; const float* B_ = in[22]; int ldw_ = 5632, nv_ = 5632, k0_ = 0, n0_ = 0; do { int r = (IT); P0_LIST(LDM, LDM8, LDML, LDML8, LDUV) } while (0); \
        tr_load(W_, ldw_, nv_, k0_, n0_, G_, B_, lane, PV, GB, OK); } while (0)
#define P0_PROC(IT, PV, GB, OK) do { tr_stage(scr, lane, PV, GB, OK); int r = (IT); P0_LIST(TRM, TRM8, TRML, TRML8, TRUV) } while (0)
    constexpr int N_TR = 2 * (32 * 176) + 88 * 64 + 32 * 184 + 2 * (32 * 64) + 256 + 2 * (16 * 64) + 32 * 64 + 32 * 16 + 32 * 32 + 8 * 64 + 2 * (32 * 176) + 88 * 64;
    { f32x4 va[8], vb[8], vc[8], ga, gb, gc; int oa = 1, ob = 1, oc = 1;
#define P0_CL(i_) ((i_) < N_TR ? (i_) : N_TR - 1)
      P0_LOAD(P0_CL(gw), va, ga, oa);
      P0_LOAD(P0_CL(gw + NGW), vb, gb, ob);
      for (int it = gw; it < N_TR; it += 3 * NGW) {
          P0_LOAD(P0_CL(it + 2 * NGW), vc, gc, oc);
          P0_PROC(it, va, ga, oa);
          P0_LOAD(P0_CL(it + 3 * NGW), va, ga, oa);
          if (it + NGW < N_TR) P0_PROC(it + NGW, vb, gb, ob);
          P0_LOAD(P0_CL(it + 4 * NGW), vb, gb, ob);
          if (it + 2 * NGW < N_TR) P0_PROC(it + 2 * NGW, vc, gc, oc);
      }
#undef P0_CL
    }
#undef P0_LOAD
#undef P0_PROC
#undef P0_LIST
#undef TRM
#undef TRM8
#undef TRML
#undef TRML8
#undef TRUV
#undef LDM
#undef LDM8
#undef LDML
#undef LDML8
#undef LDUV
    for (int rw = gw; rw < 1024; rw += NGW) { const int e = (rw >> 7) & 1; *((GAS v2u*)((unsigned char*)(ws + WS_W_UVP) + (size_t)rw * 1024 + (1 - e) * 512) + lane) = (v2u){0u, 0u}; }
    for (int it = 4 * gw; it < (M * D) / 512; it += 4 * NGW) {
        const GAS f32x4* sp = (const GAS f32x4*)(in[0] + (size_t)it * 512) + 2 * lane; f32x4 q[8];
#pragma unroll
        for (int j = 0; j < 4; ++j) { q[2 * j] = __builtin_nontemporal_load(sp + 128 * j); q[2 * j + 1] = __builtin_nontemporal_load(sp + 128 * j + 1); }
#pragma unroll
        for (int j = 0; j < 4; ++j) { const f32x4 a = q[2 * j] * FP8_XS, b = q[2 * j + 1] * FP8_XS; int w0 = 0, w1 = 0;
            w0 = __builtin_amdgcn_cvt_pk_fp8_f32(fminf(fmaxf(a.x, -448.f), 448.f), fminf(fmaxf(a.y, -448.f), 448.f), w0, false); w0 = __builtin_amdgcn_cvt_pk_fp8_f32(fminf(fmaxf(a.z, -448.f), 448.f), fminf(fmaxf(a.w, -448.f), 448.f), w0, true);
            w1 = __builtin_amdgcn_cvt_pk_fp8_f32(fminf(fmaxf(b.x, -448.f), 448.f), fminf(fmaxf(b.y, -448.f), 448.f), w1, false); w1 = __builtin_amdgcn_cvt_pk_fp8_f32(fminf(fmaxf(b.z, -448.f), 448.f), fminf(fmaxf(b.w, -448.f), 448.f), w1, true);
            *((GAS v2u*)((unsigned char*)(ws + WS_X8) + (size_t)(it + j) * 512) + lane) = (v2u){(unsigned)w0, (unsigned)w1}; } }
    for (int it = gw; it < (BATCH * MEMT * D) / 512; it += NGW) cvt_item(in[1], (bf16*)(ws + WS_MEM16), it, lane);
    for (int it = gw; it < (8 * 512 * 128) / 512; it += NGW) cvt_item(in[9], (bf16*)(ws + WS_W_UK), it, lane);
}

__device__ __forceinline__ void ln_phase(float* zx, bf16* x16, unsigned char* x8, const float* g, const float* b, int gw, int NGW, int lane) {
    f32x4 gv[8], bv[8];
#pragma unroll
    for (int j = 0; j < 8; ++j) { gv[j] = *((const GAS f32x4*)g + lane + 64 * j); bv[j] = *((const GAS f32x4*)b + lane + 64 * j); }
    for (int m = gw; m < M; m += NGW) {
        GAS f32x4* xr = (GAS f32x4*)(zx + (size_t)m * D) + lane;
        f32x4 v[8]; float s = 0.f;
#pragma unroll
        for (int j = 0; j < 8; ++j) { v[j] = xr[64 * j]; s += (v[j].x + v[j].y) + (v[j].z + v[j].w); }
        const float mean = wave_sum(s) * (1.f / D); float s2 = 0.f;
#pragma unroll
        for (int j = 0; j < 8; ++j) { v[j] = v[j] - mean; s2 += (v[j].x * v[j].x + v[j].y * v[j].y) + (v[j].z * v[j].z + v[j].w * v[j].w); }
        const float rstd = 1.f / sqrtf(wave_sum(s2) * (1.f / D) + LN_EPS);
#pragma unroll
        for (int j = 0; j < 8; ++j) { v[j] = v[j] * rstd * gv[j] + bv[j]; xr[64 * j] = v[j]; }
        if (x16) { GAS v2u* o8 = (GAS v2u*)(x16 + (size_t)m * D) + lane;
#pragma unroll
            for (int j = 0; j < 8; ++j) o8[64 * j] = (v2u){pk2(v[j].x, v[j].y), pk2(v[j].z, v[j].w)}; }
        if (x8) { GAS unsigned* o4 = (GAS unsigned*)(x8 + (size_t)m * D) + lane;
#pragma unroll
            for (int j = 0; j < 8; ++j) { const f32x4 q = v[j] * FP8_XS; int w = 0; w = __builtin_amdgcn_cvt_pk_fp8_f32(fminf(fmaxf(q.x, -448.f), 448.f), fminf(fmaxf(q.y, -448.f), 448.f), w, false);
                w = __builtin_amdgcn_cvt_pk_fp8_f32(fminf(fmaxf(q.z, -448.f), 448.f), fminf(fmaxf(q.w, -448.f), 448.f), w, true); o4[64 * j] = (unsigned)w; } }
    }
}
__device__ __forceinline__ void ln_final_phase(const bf16* z16, float* outp, const float* g, const float* b, int gw, int NGW, int lane) {
    for (int m0 = gw; m0 < M; m0 += 2 * NGW) {
        const int m1 = m0 + NGW; const bool two = m1 < M;
        v4u w[2][4];
#pragma unroll
        for (int j = 0; j < 4; ++j) { w[0][j] = __builtin_nontemporal_load((const GAS v4u*)(z16 + (size_t)m0 * D) + lane + 64 * j); w[1][j] = two ? __builtin_nontemporal_load((const GAS v4u*)(z16 + (size_t)m1 * D) + lane + 64 * j) : (v4u){0u, 0u, 0u, 0u}; }
#pragma unroll
        for (int rr = 0; rr < 2; ++rr) { if (rr == 1 && !two) break;
            const int m = rr ? m1 : m0;
            float v[32]; float s = 0.f;
#pragma unroll
            for (int j = 0; j < 4; ++j) { const v4u x = w[rr][j]; v[8 * j + 0] = blo(x.x); v[8 * j + 1] = bhi(x.x); v[8 * j + 2] = blo(x.y); v[8 * j + 3] = bhi(x.y); v[8 * j + 4] = blo(x.z); v[8 * j + 5] = bhi(x.z); v[8 * j + 6] = blo(x.w); v[8 * j + 7] = bhi(x.w); }
#pragma unroll
            for (int e = 0; e < 32; ++e) s += v[e];
            const float mean = wave_sum(s) * (1.f / D); float s2 = 0.f;
#pragma unroll
            for (int e = 0; e < 32; ++e) { v[e] -= mean; s2 += v[e] * v[e]; }
            const float rstd = 1.f / sqrtf(wave_sum(s2) * (1.f / D) + LN_EPS);
#pragma unroll
            for (int j = 0; j < 4; ++j) { const int c0 = 512 * j + 8 * lane;
                const f32x4 g0 = *(const GAS f32x4*)(g + c0), g1 = *(const GAS f32x4*)(g + c0 + 4), b0 = *(const GAS f32x4*)(b + c0), b1 = *(const GAS f32x4*)(b + c0 + 4);
                GAS f32x4* o = (GAS f32x4*)(outp + (size_t)m * D + c0);
                __builtin_nontemporal_store((f32x4){v[8 * j + 0], v[8 * j + 1], v[8 * j + 2], v[8 * j + 3]} * rstd * g0 + b0, o); __builtin_nontemporal_store((f32x4){v[8 * j + 4], v[8 * j + 5], v[8 * j + 6], v[8 * j + 7]} * rstd * g1 + b1, o + 1); } }
    }
}
__device__ __forceinline__ void crms_phase(const bf16* bc, unsigned char* c8, const float* kvg, float cs, int gw, int NGW, int lane) {
    float gg[8];
#pragma unroll
    for (int j = 0; j < 8; ++j) gg[j] = kvg[8 * lane + j] * cs;
    for (int m0 = gw; m0 < M; m0 += 8 * NGW) {
        v4u w8[8];
#pragma unroll
        for (int r = 0; r < 8; ++r) { const int m = m0 + r * NGW < M ? m0 + r * NGW : M - 1; w8[r] = *((const GAS v4u*)(bc + (size_t)m * 512) + lane); }
#pragma unroll
        for (int r = 0; r < 8; ++r) { const int m = m0 + r * NGW; if (m < M) { const v4u w = w8[r];
            float x[8] = {blo(w.x), bhi(w.x), blo(w.y), bhi(w.y), blo(w.z), bhi(w.z), blo(w.w), bhi(w.w)}; float s = 0.f;
#pragma unroll
            for (int j = 0; j < 8; ++j) s += x[j] * x[j];
            const float rr = 1.f / sqrtf(wave_sum(s) * (1.f / 512.f) + LN_EPS);
#pragma unroll
            for (int j = 0; j < 8; ++j) x[j] = fminf(fmaxf(x[j] * rr * gg[j], -448.f), 448.f);
            *((GAS v2u*)(c8 + (size_t)m * 512) + lane) = (v2u){pg8::pk4_fp8(x[0], x[1], x[2], x[3]), pg8::pk4_fp8(x[4], x[5], x[6], x[7])}; } }
    }
}
typedef short v4i16_t __attribute__((ext_vector_type(4)));
__device__ __forceinline__ v4i16_t lds_tr16(const LAS unsigned char* p) { return __builtin_amdgcn_ds_read_tr16_b64_v4i16((LAS v4i16_t*)p); }
__device__ __forceinline__ unsigned cvtpk(float lo, float hi) { typedef float f2 __attribute__((ext_vector_type(2))); typedef __bf16 b2 __attribute__((ext_vector_type(2))); f2 v = {lo, hi}; b2 b = __builtin_convertvector(v, b2); return __builtin_bit_cast(unsigned, b); }
__device__ __forceinline__ float xhalf_f(float v) { return __shfl_xor(v, 32); }
constexpr float LOG2E = 1.4426950408889634f;
constexpr float QSCALE = 0.125f * LOG2E;

__device__ const unsigned short da_order[1024] = {
    0, 8, 16, 24, 1, 9, 17, 25, 32, 40, 48, 56, 33, 41, 49, 57, 64, 72, 80, 88, 65, 73, 81, 89, 96, 104, 112, 120, 97, 105, 113, 121,
    128, 136, 144, 152, 129, 137, 145, 153, 160, 168, 176, 184, 161, 169, 177, 185, 192, 200, 208, 216, 193, 201, 209, 217, 224, 232, 240, 248, 225, 233, 241, 249,
    256, 264, 272, 280, 257, 265, 273, 281, 288, 296, 304, 312, 289, 297, 305, 313, 320, 328, 336, 344, 321, 329, 337, 345, 352, 360, 368, 376, 353, 361, 369, 377,
    384, 392, 400, 408, 385, 393, 401, 409, 416, 424, 432, 440, 417, 425, 433, 441, 2, 10, 18, 26, 34, 42, 50, 58, 66, 74, 82, 90, 98, 106, 114, 122,
    130, 138, 146, 154, 162, 170, 178, 186, 194, 202, 210, 218, 226, 234, 242, 250, 258, 266, 274, 282, 290, 298, 306, 314, 322, 330, 338, 346, 354, 362, 370, 378,
    386, 394, 402, 410, 418, 426, 434, 442, 448, 456, 464, 472, 449, 457, 465, 473, 450, 458, 466, 474, 480, 488, 496, 504, 481, 489, 497, 505, 482, 490, 498, 506,
    512, 520, 528, 536, 513, 521, 529, 537, 514, 522, 530, 538, 544, 552, 560, 568, 545, 553, 561, 569, 546, 554, 562, 570, 576, 584, 592, 600, 577, 585, 593, 601,
    578, 586, 594, 602, 608, 616, 624, 632, 609, 617, 625, 633, 610, 618, 626, 634, 640, 648, 656, 664, 641, 649, 657, 665, 642, 650, 658, 666, 672, 680, 688, 696,
    673, 681, 689, 697, 674, 682, 690, 698, 704, 712, 720, 728, 705, 713, 721, 729, 706, 714, 722, 730, 3, 11, 19, 27, 35, 43, 51, 59, 67, 75, 83, 91,
    99, 107, 115, 123, 131, 139, 147, 155, 163, 171, 179, 187, 195, 203, 211, 219, 227, 235, 243, 251, 259, 267, 275, 283, 291, 299, 307, 315, 323, 331, 339, 347,
    355, 363, 371, 379, 387, 395, 403, 411, 419, 427, 435, 443, 451, 459, 467, 475, 483, 491, 499, 507, 515, 523, 531, 539, 547, 555, 563, 571, 579, 587, 595, 603,
    611, 619, 627, 635, 643, 651, 659, 667, 675, 683, 691, 699, 707, 715, 723, 731, 736, 744, 752, 760, 737, 745, 753, 761, 738, 746, 754, 762, 739, 747, 755, 763,
    768, 776, 784, 792, 769, 777, 785, 793, 770, 778, 786, 794, 771, 779, 787, 795, 800, 808, 816, 824, 801, 809, 817, 825, 802, 810, 818, 826, 803, 811, 819, 827,
    832, 840, 848, 856, 833, 841, 849, 857, 834, 842, 850, 858, 835, 843, 851, 859, 4, 12, 20, 28, 36, 44, 52, 60, 68, 76, 84, 92, 100, 108, 116, 124,
    132, 140, 148, 156, 164, 172, 180, 188, 196, 204, 212, 220, 228, 236, 244, 252, 260, 268, 276, 284, 292, 300, 308, 316, 324, 332, 340, 348, 356, 364, 372, 380,
    388, 396, 404, 412, 420, 428, 436, 444, 452, 460, 468, 476, 484, 492, 500, 508, 516, 524, 532, 540, 548, 556, 564, 572, 580, 588, 596, 604, 612, 620, 628, 636,
    644, 652, 660, 668, 676, 684, 692, 700, 708, 716, 724, 732, 740, 748, 756, 764, 772, 780, 788, 796, 804, 812, 820, 828, 836, 844, 852, 860, 864, 872, 880, 888,
    865, 873, 881, 889, 866, 874, 882, 890, 867, 875, 883, 891, 868, 876, 884, 892, 896, 904, 912, 920, 897, 905, 913, 921, 898, 906, 914, 922, 899, 907, 915, 923,
    900, 908, 916, 924, 5, 13, 21, 29, 37, 45, 53, 61, 69, 77, 85, 93, 101, 109, 117, 125, 133, 141, 149, 157, 165, 173, 181, 189, 197, 205, 213, 221,
    229, 237, 245, 253, 261, 269, 277, 285, 293, 301, 309, 317, 325, 333, 341, 349, 357, 365, 373, 381, 389, 397, 405, 413, 421, 429, 437, 445, 453, 461, 469, 477,
    485, 493, 501, 509, 517, 525, 533, 541, 549, 557, 565, 573, 581, 589, 597, 605, 613, 621, 629, 637, 645, 653, 661, 669, 677, 685, 693, 701, 709, 717, 725, 733,
    741, 749, 757, 765, 773, 781, 789, 797, 805, 813, 821, 829, 837, 845, 853, 861, 869, 877, 885, 893, 901, 909, 917, 925, 928, 936, 944, 952, 929, 937, 945, 953,
    930, 938, 946, 954, 931, 939, 947, 955, 932, 940, 948, 956, 933, 941, 949, 957, 6, 14, 22, 30, 38, 46, 54, 62, 70, 78, 86, 94, 102, 110, 118, 126,
    134, 142, 150, 158, 166, 174, 182, 190, 198, 206, 214, 222, 230, 238, 246, 254, 262, 270, 278, 286, 294, 302, 310, 318, 326, 334, 342, 350, 358, 366, 374, 382,
    390, 398, 406, 414, 422, 430, 438, 446, 454, 462, 470, 478, 486, 494, 502, 510, 518, 526, 534, 542, 550, 558, 566, 574, 582, 590, 598, 606, 614, 622, 630, 638,
    646, 654, 662, 670, 678, 686, 694, 702, 710, 718, 726, 734, 742, 750, 758, 766, 774, 782, 790, 798, 806, 814, 822, 830, 838, 846, 854, 862, 870, 878, 886, 894,
    902, 910, 918, 926, 934, 942, 950, 958, 7, 15, 23, 31, 39, 47, 55, 63, 71, 79, 87, 95, 103, 111, 119, 127, 135, 143, 151, 159, 167, 175, 183, 191,
    199, 207, 215, 223, 231, 239, 247, 255, 263, 271, 279, 287, 295, 303, 311, 319, 327, 335, 343, 351, 359, 367, 375, 383, 391, 399, 407, 415, 423, 431, 439, 447,
    455, 463, 471, 479, 487, 495, 503, 511, 519, 527, 535, 543, 551, 559, 567, 575, 583, 591, 599, 607, 615, 623, 631, 639, 647, 655, 663, 671, 679, 687, 695, 703,
    711, 719, 727, 735, 743, 751, 759, 767, 775, 783, 791, 799, 807, 815, 823, 831, 839, 847, 855, 863, 871, 879, 887, 895, 903, 911, 919, 927, 935, 943, 951, 959,
    960, 968, 976, 984, 961, 969, 977, 985, 962, 970, 978, 986, 963, 971, 979, 987, 964, 972, 980, 988, 965, 973, 981, 989, 966, 974, 982, 990, 967, 975, 983, 991,
    992, 1000, 1008, 1016, 993, 1001, 1009, 1017, 994, 1002, 1010, 1018, 995, 1003, 1011, 1019, 996, 1004, 1012, 1020, 997, 1005, 1013, 1021, 998, 1006, 1014, 1022, 999, 1007, 1015, 1023,
};
__device__ __forceinline__ void diff_attn_mfma(LAS unsigned char* lds, const bf16* AQ, const bf16* AK, const bf16* AV, bf16* YA, const float* dlam, const float* subg, unsigned* dq, const unsigned* kmax, const int wave) {
    const int lane = lane_fresh(), r32 = lane & 31, hi = lane >> 5;
    const int comp = wave >> 2, wq = wave & 3;
    const unsigned ksrc = (unsigned)(lane * 1024 + (2 * wave) * 8);
    const unsigned vsrc0 = (unsigned)((16 * ((2 * wave) & 3) + (lane >> 2)) * 1024 + ((2 * wave) >> 2) * 32 + (lane & 3) * 8);
    const unsigned vsrc1 = (unsigned)((16 * ((2 * wave + 1) & 3) + (lane >> 2)) * 1024 + ((2 * wave + 1) >> 2) * 32 + (lane & 3) * 8);
    const unsigned kdst = (unsigned)(2 * wave) * 1024u, vdst0 = 16384u + (unsigned)(((2 * wave) >> 2) * 4096 + ((2 * wave) & 3) * 1024), vdst1 = 16384u + (unsigned)(((2 * wave + 1) >> 2) * 4096 + ((2 * wave + 1) & 3) * 1024);
    const unsigned lds0 = (unsigned)(uintptr_t)lds;
#define DA_STAGE(bo, to) do { \
        glds16(Kg + (to) + ksrc, (unsigned)__builtin_amdgcn_readfirstlane((int)(lds0 + (bo) + kdst))); \
        glds16(Kg + (to) + ksrc + 8, (unsigned)__builtin_amdgcn_readfirstlane((int)(lds0 + (bo) + kdst + 1024))); \
        glds16(Vg + (to) + vsrc0, (unsigned)__builtin_amdgcn_readfirstlane((int)(lds0 + (bo) + vdst0))); \
        glds16(Vg + (to) + vsrc1, (unsigned)__builtin_amdgcn_readfirstlane((int)(lds0 + (bo) + vdst1))); } while (0)
#define DA_WAITBAR() asm volatile("s_waitcnt vmcnt(0) lgkmcnt(0)\n\ts_barrier" ::: "memory")
    const unsigned koff = (unsigned)(((comp * 8 + hi) * 64 + r32) * 16);
    const unsigned voff = (unsigned)(16384 + (4 * hi + ((lane & 15) >> 2)) * 64 + ((lane >> 4) & 1) * 32 + (lane & 3) * 8);
    LAS unsigned* xq = (LAS unsigned*)(lds + 100352);
    for (;;) {
        if (wave == 0 && lane == 0) { const unsigned t = __hip_atomic_fetch_add(dq, 1u, __ATOMIC_RELAXED, __HIP_MEMORY_SCOPE_AGENT); xq[0] = t < 1024u ? (unsigned)da_order[t] : 1024u; }
        asm volatile("s_waitcnt vmcnt(0) lgkmcnt(0)\n\ts_barrier" ::: "memory");
        const int j = (int)xq[0];
        if (j >= 1024) break;
        const int ub = 31 - (j >> 5), bh = j & 31;
        const int b = bh >> 3, h = 7 - (bh & 7);
        const float sl2 = LOG2E / (float)(2 << h);
        const size_t rowbase = (size_t)b * SEQ; const int q0 = ub * 128;
        const int qpos = q0 + wq * 32 + r32;
        const int nt = 2 * ub + 2;
        const int myt = 2 * ub + 1 + (wq >> 1);
        const bf16* Kg = AK + rowbase * 1024 + h * 128; const bf16* Vg = AV + rowbase * 1024 + h * 128;
        bf16x8 qr[4];
#pragma unroll
        for (int s = 0; s < 4; ++s) qr[s] = *(const GAS bf16x8*)(AQ + (rowbase + qpos) * 1024 + h * 128 + comp * 64 + s * 16 + hi * 8);
        f32x16 o[4];
#pragma unroll
        for (int blk = 0; blk < 4; ++blk)
#pragma unroll
            for (int r = 0; r < 16; ++r) o[blk][r] = 0.f;
        float mrun = -INFINITY;
        f32x16 ol;
#pragma unroll
        for (int r = 0; r < 16; ++r) ol[r] = 0.f;
        const bf16x8 vones = {(short)0x3F80, (short)0x3F80, (short)0x3F80, (short)0x3F80, (short)0x3F80, (short)0x3F80, (short)0x3F80, (short)0x3F80};
        float sbr;
        { float qn2 = 0.f;
#pragma unroll
          for (int s = 0; s < 4; ++s) { const v4u w = __builtin_bit_cast(v4u, qr[s]); const float e0 = blo(w.x), e1 = bhi(w.x), e2 = blo(w.y), e3 = bhi(w.y), e4 = blo(w.z), e5 = bhi(w.z), e6 = blo(w.w), e7 = bhi(w.w);
              qn2 += ((e0 * e0 + e1 * e1) + (e2 * e2 + e3 * e3)) + ((e4 * e4 + e5 * e5) + (e6 * e6 + e7 * e7)); }
          qn2 += xhalf_f(qn2);
          const float qn2row = qn2;
#pragma unroll
          for (int o_ = 1; o_ < 32; o_ <<= 1) qn2 = fmaxf(qn2, __shfl_xor(qn2, o_));
          const unsigned* kp = kmax + ((b * 8 + h) * 2 + comp) * 2;
          const float k2 = __uint_as_float(__hip_atomic_load(kp, __ATOMIC_RELAXED, __HIP_MEMORY_SCOPE_AGENT)) + __uint_as_float(__hip_atomic_load(kp + 1, __ATOMIC_RELAXED, __HIP_MEMORY_SCOPE_AGENT));
          sbr = sqrtf(qn2row * k2) * 1.02f;
          if (lane == 0) xq[8 + wave] = __float_as_uint(sqrtf(qn2 * k2) * 1.02f); }
        DA_STAGE(0u, (size_t)(nt - 1) * 64 * 1024);
        DA_WAITBAR();
        int kt_lo = 0;
        { float sb = 0.f;
#pragma unroll
          for (int w_ = 0; w_ < 8; ++w_) sb = fmaxf(sb, __uint_as_float(xq[8 + w_]));
          const float xcut = (float)(q0 - 63) - (40.f + 2.f * sb) / sl2;
          kt_lo = xcut > 0.f ? (int)__builtin_ceilf(xcut * (1.f / 64.f)) : 0; kt_lo = __builtin_amdgcn_readfirstlane(kt_lo); }
        for (int st = 0; st < nt - kt_lo; ++st) {
            const int kt = nt - 1 - st;
            const unsigned bufo = (unsigned)(st & 1) * 32768u;
            if (kt > kt_lo) DA_STAGE(32768u - bufo, (size_t)(kt - 1) * 64 * 1024);
            if (kt < myt) {
                const LAS unsigned char* Kb = lds + bufo + koff;
                f32x16 p0, p1;
#pragma unroll
                for (int r = 0; r < 16; ++r) { p0[r] = 0.f; p1[r] = 0.f; }
                { bf16x8 kf0[4], kf1[4];
#pragma unroll
                  for (int s = 0; s < 4; ++s) { kf0[s] = *(const LAS bf16x8*)(Kb + s * 2048); kf1[s] = *(const LAS bf16x8*)(Kb + s * 2048 + 512); }
#pragma unroll
                  for (int s = 0; s < 4; ++s) { p0 = __builtin_amdgcn_mfma_f32_32x32x16_bf16(kf0[s], qr[s], p0, 0, 0, 0); p1 = __builtin_amdgcn_mfma_f32_32x32x16_bf16(kf1[s], qr[s], p1, 0, 0, 0); } }
                const float qth = (float)(qpos - kt * 64 - 4 * hi);
                float rm = -INFINITY;
#pragma unroll
                for (int r = 0; r < 16; ++r) { const float kr = (float)((r & 3) + 8 * (r >> 2)); const float v0 = qth - kr, v1 = qth - (kr + 32.f);
                    p0[r] = p0[r] - sl2 * fabsf(v0); p1[r] = p1[r] - sl2 * fabsf(v1); rm = fmaxf(rm, fmaxf(p0[r], p1[r])); }
                rm = fmaxf(rm, xhalf_f(rm));
                if (!__all(rm < mrun - 40.f ? 1 : 0)) {
                if (__any(rm > mrun)) { const float mn = fmaxf(mrun, rm), f = __builtin_amdgcn_exp2f(mrun - mn); mrun = mn;
#pragma unroll
                    for (int r = 0; r < 16; ++r) ol[r] *= f;
#pragma unroll
                    for (int blk = 0; blk < 4; ++blk)
#pragma unroll
                        for (int r = 0; r < 16; ++r) o[blk][r] *= f; }
#pragma unroll
                for (int r = 0; r < 16; ++r) { p0[r] = __builtin_amdgcn_exp2f(p0[r] - mrun); p1[r] = __builtin_amdgcn_exp2f(p1[r] - mrun); }
                bf16x8 pw[4];
#pragma unroll
                for (int s = 0; s < 2; ++s) {
                    v4u a = {cvtpk(p0[8 * s + 0], p0[8 * s + 1]), cvtpk(p0[8 * s + 2], p0[8 * s + 3]), cvtpk(p0[8 * s + 4], p0[8 * s + 5]), cvtpk(p0[8 * s + 6], p0[8 * s + 7])};
                    v4u c = {cvtpk(p1[8 * s + 0], p1[8 * s + 1]), cvtpk(p1[8 * s + 2], p1[8 * s + 3]), cvtpk(p1[8 * s + 4], p1[8 * s + 5]), cvtpk(p1[8 * s + 6], p1[8 * s + 7])};
                    pw[s] = __builtin_bit_cast(bf16x8, a); pw[2 + s] = __builtin_bit_cast(bf16x8, c); }
#pragma unroll
                for (int s = 0; s < 4; ++s) ol = __builtin_amdgcn_mfma_f32_32x32x16_bf16(vones, pw[s], ol, 0, 0, 0);
                const LAS unsigned char* Vb = lds + bufo + voff;
                { v4i16_t va[2][4][2];
#pragma unroll
                  for (int s = 0; s < 4; ++s) { va[0][s][0] = lds_tr16(Vb + s * 1024); va[0][s][1] = lds_tr16(Vb + s * 1024 + 512); }
#pragma unroll
                  for (int blk = 0; blk < 4; ++blk) {
                      if (blk < 3) {
#pragma unroll
                          for (int s = 0; s < 4; ++s) { va[(blk + 1) & 1][s][0] = lds_tr16(Vb + (blk + 1) * 4096 + s * 1024); va[(blk + 1) & 1][s][1] = lds_tr16(Vb + (blk + 1) * 4096 + s * 1024 + 512); } }
                      __builtin_amdgcn_sched_barrier(0);
#pragma unroll
                      for (int s = 0; s < 4; ++s) { const v4i16_t lo = va[blk & 1][s][0], hh = va[blk & 1][s][1];
                          const bf16x8 vf = {lo[0], lo[1], lo[2], lo[3], hh[0], hh[1], hh[2], hh[3]};
                          o[blk] = __builtin_amdgcn_mfma_f32_32x32x16_bf16(vf, pw[s], o[blk], 0, 0, 0); }
                      __builtin_amdgcn_sched_barrier(0);
                  } }
                }
            }
            { const int ktn = kt - 1;
              const bool negl = (ktn < 2 * ub) && (sbr - sl2 * (float)(qpos - (64 * ktn + 63)) < mrun - 40.f);
              const unsigned okw = __all(negl ? 1 : 0) ? 1u : 0u;
              if (lane == 0) xq[16 + (st & 1) * 8 + wave] = okw; }
            DA_WAITBAR();
            { const v4u f0 = *(const LAS v4u*)(xq + 16 + (st & 1) * 8), f1 = *(const LAS v4u*)(xq + 20 + (st & 1) * 8);
              if (__builtin_amdgcn_readfirstlane((int)(f0.x & f0.y & f0.z & f0.w & f1.x & f1.y & f1.z & f1.w))) break; }
        }
        const float inv = 1.f / ol[0];
        LAS float* Y1 = (LAS float*)(lds) + wq * 4096;
        if (comp == 1) {
            float lam; { float a = dlam[lane] * dlam[64 + lane], bq_ = dlam[128 + lane] * dlam[192 + lane]; a = wave_sum(a); bq_ = wave_sum(bq_); lam = __expf(a) - __expf(bq_) + LAMBDA_INIT; }
            const float sc = inv * lam;
#pragma unroll
            for (int blk = 0; blk < 4; ++blk)
#pragma unroll
                for (int r = 0; r < 16; ++r) Y1[(32 * blk + (r & 3) + 8 * (r >> 2) + 4 * hi) * 32 + r32] = o[blk][r] * sc; }
        __syncthreads();
        if (comp == 0) {
            float ss = 0.f;
#pragma unroll
            for (int blk = 0; blk < 4; ++blk)
#pragma unroll
                for (int r = 0; r < 16; ++r) { const float a = o[blk][r] * inv - Y1[(32 * blk + (r & 3) + 8 * (r >> 2) + 4 * hi) * 32 + r32]; o[blk][r] = a; ss += a * a; }
            ss += xhalf_f(ss);
            const float rr = (1.0f - LAMBDA_INIT) / sqrtf(ss * (1.f / 128.f) + LN_EPS);
            LAS unsigned* stg = (LAS unsigned*)(lds + 65536) + wq * (32 * 33);
            const float rs = rr * FP8_YAS;
#pragma unroll
            for (int blk = 0; blk < 4; ++blk) {
#pragma unroll
                for (int r = 0; r < 16; r += 4) { const int e = 32 * blk + 8 * (r >> 2) + 4 * hi;
                    stg[r32 * 33 + (e >> 2)] = pg8::pk4_fp8(fminf(fmaxf(o[blk][r] * rs * subg[e], -448.f), 448.f), fminf(fmaxf(o[blk][r + 1] * rs * subg[e + 1], -448.f), 448.f),
                                                           fminf(fmaxf(o[blk][r + 2] * rs * subg[e + 2], -448.f), 448.f), fminf(fmaxf(o[blk][r + 3] * rs * subg[e + 3], -448.f), 448.f)); }
                asm volatile("" ::: "memory"); }
            LDS_WAIT(); asm volatile("" ::: "memory");
            unsigned char* orow = (unsigned char*)YA + (rowbase + q0 + wq * 32) * 1024 + h * 128;
#pragma unroll 4
            for (int row = 0; row < 32; row += 2) *((GAS unsigned*)(orow + (size_t)(row + hi) * 1024) + r32) = stg[(row + hi) * 33 + r32];
        }
        __syncthreads();
    }
#undef DA_STAGE
#undef DA_WAITBAR
}

__device__ __forceinline__ unsigned okey(float f) { const unsigned u = __float_as_uint(f); return (u & 0x80000000u) ? ~u : (u | 0x80000000u); }
__device__ __forceinline__ void indexer_topk(LAS unsigned char* lds, const bf16* IQ, const bf16* IKW, unsigned short* IDX, int vcu, int G, const int wave) {
    const int lane = lane_fresh(), r32 = lane & 31, hi = lane >> 5;
    const unsigned lds0 = (unsigned)(uintptr_t)lds;
    const unsigned boff = (unsigned)((hi * 256 + r32) * 16);
#define IX_STAGE0(JJ) do { const bf16* Kg0_ = IKW + (size_t)((((JJ) & 255) >> 4) >> 2) * SEQ * 256; _Pragma("unroll") for (int i_ = 0; i_ < 4; ++i_) { const int q_ = 4 * wave + i_; \
            glds16s(Kg0_ + (size_t)(64 * (q_ & 3)) * 256 + (q_ >> 2) * 8, (unsigned)lane * 512u, (unsigned)__builtin_amdgcn_readfirstlane((int)(lds0 + ((q_ >> 2) * 256 + 64 * (q_ & 3)) * 16))); } } while (0)
    if (vcu < 1024) IX_STAGE0(vcu);
    for (int j = vcu; j < 1024; j += G) {
        const int w = j & 255, i = j >> 8, bq = w >> 4, s16 = w & 15;
        const int chunk = (i == 0) ? s16 : (i == 1) ? 31 - s16 : (i == 2) ? 32 + s16 : 63 - s16;
        const int b = bq >> 2, gq = bq & 3;
        const int t0 = b * SEQ + chunk * 64 + gq * 16 + 2 * wave;
        const int ngroups = 2 * (chunk + 1);
        const int ntiles = (ngroups + 7) >> 3;
        const bf16* Kg = IKW + (size_t)b * SEQ * 256;
#define IX_STAGE(tile, bo) do { int tl_ = (tile); asm volatile("" : "+s"(tl_)); _Pragma("unroll") for (int i_ = 0; i_ < 4; ++i_) { const int q_ = 4 * wave + i_; \
            glds16s(Kg + (size_t)(tl_ * 256 + 64 * (q_ & 3)) * 256 + (q_ >> 2) * 8, (unsigned)lane * 512u, (unsigned)__builtin_amdgcn_readfirstlane((int)(lds0 + (bo) + ((q_ >> 2) * 256 + 64 * (q_ & 3)) * 16))); } } while (0)
        unsigned pf = 0u;
        if (j + G < 1024) { const int jn = j + G, wn = jn & 255, in_ = jn >> 8, bqn = wn >> 4, sn = wn & 15;
            const int chn = (in_ == 0) ? sn : (in_ == 1) ? 31 - sn : (in_ == 2) ? 32 + sn : 63 - sn;
            const int tn0 = (bqn >> 2) * SEQ + chn * 64 + (bqn & 3) * 16 + 2 * wave;
            const bf16* pa = (lane < 32) ? IQ + (size_t)tn0 * 1024 + lane * 64 : IKW + (size_t)(tn0 + (lane & 1)) * 256 + 64;
            asm volatile("global_load_dword %0, %1, off" : "=&v"(pf) : "v"(pa) : "memory"); }
        bf16x8 a[4];
#pragma unroll
        for (int ks = 0; ks < 4; ++ks) a[ks] = *(const GAS bf16x8*)(IQ + (size_t)(t0 + (r32 >> 4)) * 1024 + (r32 & 15) * 64 + ks * 16 + 8 * hi);
        float wv[16];
        { const bf16* iwp = IKW + (size_t)t0 * 256 + 64 + 4 * hi;
          const v2u w00 = *(const GAS v2u*)(iwp), w01 = *(const GAS v2u*)(iwp + 8), w10 = *(const GAS v2u*)(iwp + 256), w11 = *(const GAS v2u*)(iwp + 256 + 8);
          wv[0] = blo(w00.x); wv[1] = bhi(w00.x); wv[2] = blo(w00.y); wv[3] = bhi(w00.y); wv[4] = blo(w01.x); wv[5] = bhi(w01.x); wv[6] = blo(w01.y); wv[7] = bhi(w01.y);
          wv[8] = blo(w10.x); wv[9] = bhi(w10.x); wv[10] = blo(w10.y); wv[11] = bhi(w10.y); wv[12] = blo(w11.x); wv[13] = bhi(w11.x); wv[14] = blo(w11.y); wv[15] = bhi(w11.y); }
        typedef float f2_t __attribute__((ext_vector_type(2)));
        f2_t w2[8];
#pragma unroll
        for (int r = 0; r < 8; ++r) w2[r] = (f2_t){wv[2 * r], wv[2 * r + 1]};
#define IX_SCORE(acc_, dst_) do { f2_t s0_ = {0.f, 0.f}, s1_ = {0.f, 0.f}; \
            _Pragma("unroll") for (int r = 0; r < 4; ++r) { \
                const f2_t x0_ = {__int_as_float(max(__float_as_int(acc_[2 * r]), 0)), __int_as_float(max(__float_as_int(acc_[2 * r + 1]), 0))}; \
                const f2_t x1_ = {__int_as_float(max(__float_as_int(acc_[8 + 2 * r]), 0)), __int_as_float(max(__float_as_int(acc_[8 + 2 * r + 1]), 0))}; \
                s0_ = __builtin_elementwise_fma(x0_, w2[r], s0_); s1_ = __builtin_elementwise_fma(x1_, w2[4 + r], s1_); } \
            const auto rr_ = __builtin_amdgcn_permlane32_swap(__float_as_uint(s0_.x + s0_.y), __float_as_uint(s1_.x + s1_.y), false, false); \
            const unsigned u_ = __float_as_uint(__uint_as_float(rr_[0]) + __uint_as_float(rr_[1])); \
            dst_ = u_ ^ ((unsigned)((int)u_ >> 31) | 0x80000000u); } while (0)
        unsigned key[128];
#pragma unroll 64
        for (int g = 0; g < 128; g += 2) {
            if (g < ngroups) {
                const unsigned bufo = (unsigned)((g >> 3) & 1) * 32768u;
                if ((g & 7) == 0) {
                    asm volatile("s_waitcnt vmcnt(0)\n\ts_barrier" ::: "memory");
                    if (g == 0) asm volatile("" :: "v"(pf));
                    if ((g >> 3) + 1 < ntiles) IX_STAGE((g >> 3) + 1, 32768u - bufo);
                }
                bf16x8 bk0[4], bk1[4];
#pragma unroll
                for (int ks = 0; ks < 4; ++ks) { bk0[ks] = *(const LAS bf16x8*)(lds + bufo + boff + (g & 7) * 512 + ks * 8192); bk1[ks] = *(const LAS bf16x8*)(lds + bufo + boff + ((g + 1) & 7) * 512 + ks * 8192); }
                f32x16 acc0 = {0.f, 0.f, 0.f, 0.f, 0.f, 0.f, 0.f, 0.f, 0.f, 0.f, 0.f, 0.f, 0.f, 0.f, 0.f, 0.f}, acc1 = acc0;
#pragma unroll
                for (int ks = 0; ks < 4; ++ks) acc0 = __builtin_amdgcn_mfma_f32_32x32x16_bf16(a[ks], bk0[ks], acc0, 0, 0, 0);
#pragma unroll
                for (int ks = 0; ks < 4; ++ks) acc1 = __builtin_amdgcn_mfma_f32_32x32x16_bf16(a[ks], bk1[ks], acc1, 0, 0, 0);
                IX_SCORE(acc0, key[g]); IX_SCORE(acc1, key[g + 1]);
            } else { key[g] = 0u; key[g + 1] = 0u; }
        }
#undef IX_SCORE
        asm volatile("s_waitcnt lgkmcnt(0)\n\ts_barrier" ::: "memory");
        if (j + G < 1024) IX_STAGE0(j + G);
        unsigned selw[4];
        { unsigned vm[4];
#pragma unroll
          for (int w_ = 0; w_ < 4; ++w_) { const int n_ = ngroups - 32 * w_; vm[w_] = n_ >= 32 ? 0xffffffffu : (n_ <= 0 ? 0u : ((1u << (n_ & 31)) - 1u)); }
          if (chunk >= 4) {
#pragma unroll
              for (int w_ = 0; w_ < 4; ++w_) { if (32 * w_ < ngroups) {
#pragma unroll
                  for (int i_ = 0; i_ < 16; ++i_) { const unsigned x = key[32 * w_ + i_], y = key[32 * w_ + i_ + 16]; key[32 * w_ + i_] = (x & 0x0000ffffu) | (y << 16); key[32 * w_ + i_ + 16] = (x >> 16) | (y & 0xffff0000u); }
#pragma unroll
                  for (int i_ = 0; i_ < 32; ++i_) { if (!(i_ & 8)) { const unsigned x = key[32 * w_ + i_], y = key[32 * w_ + i_ + 8]; key[32 * w_ + i_] = (x & 0x00ff00ffu) | ((y << 8) & 0xff00ff00u); key[32 * w_ + i_ + 8] = ((x >> 8) & 0x00ff00ffu) | (y & 0xff00ff00u); } }
#pragma unroll
                  for (int i_ = 0; i_ < 32; ++i_) { if (!(i_ & 4)) { const unsigned x = key[32 * w_ + i_], y = key[32 * w_ + i_ + 4]; key[32 * w_ + i_] = (x & 0x0f0f0f0fu) | ((y << 4) & 0xf0f0f0f0u); key[32 * w_ + i_ + 4] = ((x >> 4) & 0x0f0f0f0fu) | (y & 0xf0f0f0f0u); } }
#pragma unroll
                  for (int i_ = 0; i_ < 32; ++i_) { if (!(i_ & 2)) { const unsigned x = key[32 * w_ + i_], y = key[32 * w_ + i_ + 2]; key[32 * w_ + i_] = (x & 0x33333333u) | ((y << 2) & 0xccccccccu); key[32 * w_ + i_ + 2] = ((x >> 2) & 0x33333333u) | (y & 0xccccccccu); } }
#pragma unroll
                  for (int i_ = 0; i_ < 32; ++i_) { if (!(i_ & 1)) { const unsigned x = key[32 * w_ + i_], y = key[32 * w_ + i_ + 1]; key[32 * w_ + i_] = (x & 0x55555555u) | ((y << 1) & 0xaaaaaaaau); key[32 * w_ + i_ + 1] = ((x >> 1) & 0x55555555u) | (y & 0xaaaaaaaau); } }
              } }
              unsigned cand[4] = {vm[0], vm[1], vm[2], vm[3]}, abv[4] = {0u, 0u, 0u, 0u}; int nab = 0; bool done = false;
#pragma unroll 32
              for (int bit = 31; bit >= 0; --bit) {
                  if (__all(done ? 1 : 0)) break;
                  const unsigned o0 = cand[0] & key[bit], o1 = cand[1] & key[32 + bit], o2 = cand[2] & key[64 + bit], o3 = cand[3] & key[96 + bit];
                  const int c = half_sum_i32(__popc(o0) + __popc(o1) + __popc(o2) + __popc(o3));
                  const bool take = nab + c >= 256;
                  done = done || (take && nab + c == 256);
                  const unsigned ntm = take ? 0u : 0xffffffffu;
                  nab += c & (int)ntm;
                  abv[0] |= o0 & ntm; abv[1] |= o1 & ntm; abv[2] |= o2 & ntm; abv[3] |= o3 & ntm;
                  cand[0] = o0 ^ (cand[0] & ntm); cand[1] = o1 ^ (cand[1] & ntm); cand[2] = o2 ^ (cand[2] & ntm); cand[3] = o3 ^ (cand[3] & ntm);
              }
#pragma unroll
              for (int w_ = 0; w_ < 4; ++w_) selw[w_] = abv[w_] | cand[w_];
          } else {
#pragma unroll
              for (int w_ = 0; w_ < 4; ++w_) selw[w_] = vm[w_];
          } }
        int base = 0;
        LAS unsigned short* ip = (LAS unsigned short*)(lds + 65536 + wave * 1024) + hi * 256;
#pragma unroll
        for (int g = 0; g < 128; ++g) {
            if (g < ngroups) {
                const bool sel = ((selw[g >> 5] >> (g & 31)) & 1u) != 0u;
                const unsigned long long mk = __ballot(sel ? 1 : 0);
                const unsigned mh = hi ? (unsigned)(mk >> 32) : (unsigned)mk;
                const int pos = base + __popc(mh & ((1u << r32) - 1u));
                if (sel && pos < 256) ip[pos] = (unsigned short)(32 * g + r32);
                base += __popc(mh);
            }
        }
        asm volatile("s_waitcnt lgkmcnt(0)" ::: "memory");
        { const v4u row = *(const LAS v4u*)(lds + 65536 + wave * 1024 + lane * 16);
          *(GAS v4u*)(IDX + (size_t)(t0 + hi) * 256 + r32 * 8) = row; }
        asm volatile("s_waitcnt lgkmcnt(0)" ::: "memory");
    }
#undef IX_STAGE
#undef IX_STAGE0
    asm volatile("s_waitcnt vmcnt(0) lgkmcnt(0)\n\ts_barrier" ::: "memory");
}

constexpr int DSA_PAIRB = 1040;
constexpr int DSA_WAVEB = 16 * DSA_PAIRB + 2048;
constexpr int DSA_LDS_END = 8 * DSA_WAVEB;
constexpr float DSA_CS = 64.f, DSA_QS = 64.f, DSA_PS = 256.f, DSA_OS = 64.f;
typedef int v2i_t __attribute__((ext_vector_type(2)));
__device__ __forceinline__ void dsa_mfma(LAS unsigned char* lds, const bf16* QL, bf16* OL, const int omask, const unsigned char* C8, const unsigned short* IDX, int vcu, int G, const int wave) {
    const int lane = lane_fresh(), h16 = lane & 15, g = lane >> 4;
    LAS unsigned char* wl = lds + wave * DSA_WAVEB;
    const unsigned wl0 = (unsigned)(uintptr_t)wl;
    const unsigned ib0 = (unsigned)(uintptr_t)(wl + 16 * DSA_PAIRB);
    const float sc2 = 0.08838834764831845f * LOG2E / (DSA_QS * DSA_CS);
    const float sl2 = (h16 < 8) ? LOG2E / (float)(2 << (h16 & 7)) : 0.f;
    const int ntok = (G == 256) ? 8 : (M - (vcu * 8 + wave) + G * 8 - 1) / (G * 8);
#define DSA_TOK(i) ((G == 256) ? ((vcu >> 6) * SEQ + (vcu & 63) + 64 * (wave + 8 * (i))) : (vcu * 8 + wave + G * 8 * (i)))
    const unsigned qk_off = (unsigned)((h16 >> 1) * DSA_PAIRB + (h16 & 1) * 512 + 32 * g);
    const int trow = (h16 >> 1) < 4 ? 4 * g + (h16 >> 1) : 16 + 4 * g + ((h16 >> 1) - 4);
    const unsigned pv_off = (unsigned)((trow >> 1) * DSA_PAIRB + (trow & 1) * 512 + 8 * (h16 & 1));
    glds16(IDX + (size_t)DSA_TOK(0) * 256 + (lane & 31) * 8 + (lane >> 5) * 256, (unsigned)__builtin_amdgcn_readfirstlane((int)ib0));
    for (int it = 0; it < ntok; ++it) {
        LAS unsigned short* idxs = (LAS unsigned short*)(wl + 16 * DSA_PAIRB + (it & 1) * 1024);
        const int t = DSA_TOK(it); const int tpos = t & (SEQ - 1);
        const int n = (tpos >> 6) >= 3 ? 256 : 64 * ((tpos >> 6) + 1); const int nst = n >> 5;
        const unsigned char* Cb = C8 + (size_t)(t >> 12) * SEQ * 512;
        int ln = lane; asm volatile("" : "+v"(ln));
        const int h16b = ln & 15, gb = ln >> 4;
        if (it + 1 < ntok) glds16(IDX + (size_t)DSA_TOK(it + 1) * 256 + (ln & 31) * 8 + (ln >> 5) * 256, (unsigned)__builtin_amdgcn_readfirstlane((int)(ib0 + ((it + 1) & 1) * 1024)));
        pg8::v8i_t qf[4];
        { const unsigned char* qp = (const unsigned char*)QL + (size_t)t * 8192 + (h16b & 7) * 512 + 32 * gb;
#pragma unroll
          for (int s = 0; s < 4; ++s) { const v4u lo = __builtin_nontemporal_load((const GAS v4u*)(qp + 128 * s)), hi = __builtin_nontemporal_load((const GAS v4u*)(qp + 128 * s + 16));
              qf[s] = (pg8::v8i_t){(int)lo.x, (int)lo.y, (int)lo.z, (int)lo.w, (int)hi.x, (int)hi.y, (int)hi.z, (int)hi.w}; } }
        unsigned pf = 0u;
        if (it + 1 < ntok) { const int tn = DSA_TOK(it + 1);
            const unsigned char* pa = (const unsigned char*)QL + (size_t)tn * 8192 + (ln & 31) * 128;
            asm volatile("global_load_dword %0, %1, off" : "=&v"(pf) : "v"(pa) : "memory"); }
        f32x4 o[32];
#pragma unroll
        for (int blk = 0; blk < 32; ++blk) o[blk] = (f32x4){0.f, 0.f, 0.f, 0.f};
        float mrun = -INFINITY, lrun = 0.f;
        asm volatile("s_waitcnt lgkmcnt(0)" ::: "memory");
#define DSA_GATHER(IDXS_, CB_, ST_) do { const LAS v4u* ip4 = (const LAS v4u*)((IDXS_) + (ST_) * 32); \
              const v4u q0 = ip4[0], q1 = ip4[1], q2 = ip4[2], q3 = ip4[3]; \
              const unsigned iw[16] = {q0.x, q0.y, q0.z, q0.w, q1.x, q1.y, q1.z, q1.w, q2.x, q2.y, q2.z, q2.w, q3.x, q3.y, q3.z, q3.w}; \
              const unsigned sh = (unsigned)(ln >> 5) * 16u, lo16 = (unsigned)(ln & 31) * 16u; \
              unsigned vo[16]; \
              _Pragma("unroll") for (int i = 0; i < 16; ++i) vo[i] = ((iw[i] >> sh) & 0xffffu) * 512u + lo16; \
              glds16s_x16((CB_), vo, (unsigned)__builtin_amdgcn_readfirstlane((int)wl0)); } while (0)
        if (it == 0) { asm volatile("s_waitcnt vmcnt(0)" ::: "memory"); DSA_GATHER(idxs, Cb, nst - 1); }
        asm volatile("s_waitcnt vmcnt(16)" : "+v"(qf[0]), "+v"(qf[1]), "+v"(qf[2]), "+v"(qf[3]) :: "memory");
        asm volatile("" :: "v"(pf));
        for (int k = 0; k < nst; ++k) { const int st = nst - 1 - k;
            asm volatile("s_waitcnt vmcnt(8)" ::: "memory");
            f32x4 a0 = {0.f, 0.f, 0.f, 0.f}, a1 = {0.f, 0.f, 0.f, 0.f};
#pragma unroll
            for (int s = 0; s < 4; ++s) {
                const pg8::v4i_t x0 = *(const LAS pg8::v4i_t*)(wl + qk_off + 128 * s), x1 = *(const LAS pg8::v4i_t*)(wl + qk_off + 128 * s + 16);
                a0 = __builtin_amdgcn_mfma_scale_f32_16x16x128_f8f6f4(__builtin_shufflevector(x0, x1, 0, 1, 2, 3, 4, 5, 6, 7), qf[s], a0, 0, 0, 0, 0x7f7f7f7f, 0, 0x7f7f7f7f); }
            asm volatile("s_waitcnt vmcnt(0)" ::: "memory");
#pragma unroll
            for (int s = 0; s < 4; ++s) {
                const pg8::v4i_t y0 = *(const LAS pg8::v4i_t*)(wl + qk_off + 8 * DSA_PAIRB + 128 * s), y1 = *(const LAS pg8::v4i_t*)(wl + qk_off + 8 * DSA_PAIRB + 128 * s + 16);
                a1 = __builtin_amdgcn_mfma_scale_f32_16x16x128_f8f6f4(__builtin_shufflevector(y0, y1, 0, 1, 2, 3, 4, 5, 6, 7), qf[s], a1, 0, 0, 0, 0x7f7f7f7f, 0, 0x7f7f7f7f); }
            const v2u i0 = *(const LAS v2u*)(idxs + st * 32 + 4 * g), i1 = *(const LAS v2u*)(idxs + st * 32 + 16 + 4 * g);
            const int sidx[8] = {(int)(i0.x & 0xffffu), (int)(i0.x >> 16), (int)(i0.y & 0xffffu), (int)(i0.y >> 16), (int)(i1.x & 0xffffu), (int)(i1.x >> 16), (int)(i1.y & 0xffffu), (int)(i1.y >> 16)};
            float lg[8];
#pragma unroll
            for (int r = 0; r < 8; ++r) { const int d = tpos - sidx[r]; lg[r] = (r < 4 ? a0[r & 3] : a1[r & 3]) * sc2 - sl2 * (float)(d < 0 ? -d : d); }
            float rm = fmaxf(fmaxf(fmaxf(lg[0], lg[1]), fmaxf(lg[2], lg[3])), fmaxf(fmaxf(lg[4], lg[5]), fmaxf(lg[6], lg[7])));
            { const auto r1 = __builtin_amdgcn_permlane16_swap(__float_as_uint(rm), __float_as_uint(rm), false, false); rm = fmaxf(__uint_as_float(r1[0]), __uint_as_float(r1[1])); }
            rm = xhalf_max(rm);
            const float mn = fmaxf(mrun, rm), f = __builtin_amdgcn_exp2f(mrun - mn); mrun = mn;
#pragma unroll
            for (int r = 0; r < 8; ++r) lg[r] = __builtin_amdgcn_exp2f(lg[r] - mn) * DSA_PS;
            const unsigned pw0 = pg8::pk4_fp8(lg[0], lg[1], lg[2], lg[3]), pw1 = pg8::pk4_fp8(lg[4], lg[5], lg[6], lg[7]);
            { const float ps = ((__builtin_amdgcn_cvt_f32_fp8((int)pw0, 0) + __builtin_amdgcn_cvt_f32_fp8((int)pw0, 1)) + (__builtin_amdgcn_cvt_f32_fp8((int)pw0, 2) + __builtin_amdgcn_cvt_f32_fp8((int)pw0, 3)))
                           + ((__builtin_amdgcn_cvt_f32_fp8((int)pw1, 0) + __builtin_amdgcn_cvt_f32_fp8((int)pw1, 1)) + (__builtin_amdgcn_cvt_f32_fp8((int)pw1, 2) + __builtin_amdgcn_cvt_f32_fp8((int)pw1, 3)));
              lrun = lrun * f + ps; }
            const long pw = (long)(((unsigned long)pw1 << 32) | (unsigned long)pw0);
            if (__any(f != 1.f)) {
#pragma unroll
                for (int blk = 0; blk < 32; ++blk) o[blk] = o[blk] * f; }
            { v2i_t av[2][4];
#pragma unroll
              for (int i = 0; i < 4; ++i) av[0][i] = __builtin_amdgcn_ds_read_tr8_b64_v2i32((LAS v2i_t*)(wl + pv_off + 16 * i));
#pragma unroll
              for (int grp = 0; grp < 8; ++grp) {
                  if (grp < 7) {
#pragma unroll
                      for (int i = 0; i < 4; ++i) av[(grp + 1) & 1][i] = __builtin_amdgcn_ds_read_tr8_b64_v2i32((LAS v2i_t*)(wl + pv_off + 16 * (4 * grp + 4 + i))); }
                  __builtin_amdgcn_sched_barrier(0);
#pragma unroll
                  for (int i = 0; i < 4; ++i) { const v2i_t a_ = av[grp & 1][i];
                      const long al = (long)(((unsigned long)(unsigned)a_.y << 32) | (unsigned long)(unsigned)a_.x);
                      o[4 * grp + i] = __builtin_amdgcn_mfma_f32_16x16x32_fp8_fp8(al, pw, o[4 * grp + i], 0, 0, 0); }
                  __builtin_amdgcn_sched_barrier(0);
              } }
            asm volatile("s_waitcnt lgkmcnt(0)" ::: "memory");
            if (k + 1 < nst) DSA_GATHER(idxs, Cb, st - 1);
            else if (it + 1 < ntok) { const int tn = DSA_TOK(it + 1), tpn = tn & (SEQ - 1); const int nn = (tpn >> 6) >= 3 ? 256 : 64 * ((tpn >> 6) + 1);
                DSA_GATHER((LAS unsigned short*)(wl + 16 * DSA_PAIRB + ((it + 1) & 1) * 1024), C8 + (size_t)(tn >> 12) * SEQ * 512, (nn >> 5) - 1); }
        }
#undef DSA_GATHER
        float lt = lrun; lt += __shfl_xor(lt, 16); lt += __shfl_xor(lt, 32);
        const float inv = 1.f / (lt * DSA_CS);
        if (h16 < 8) {
#pragma unroll
            for (int blk = 0; blk < 32; ++blk) { const f32x4 v = o[blk] * (inv * DSA_OS);
                __builtin_nontemporal_store(pg8::pk4_fp8(fminf(fmaxf(v.x, -448.f), 448.f), fminf(fmaxf(v.y, -448.f), 448.f), fminf(fmaxf(v.z, -448.f), 448.f), fminf(fmaxf(v.w, -448.f), 448.f)),
                                            (GAS unsigned*)((unsigned char*)OL + (size_t)(t & omask) * 8192 + h16b * 512 + 16 * blk + 4 * gb)); } }
    }
    asm volatile("s_waitcnt vmcnt(0) lgkmcnt(0)" ::: "memory");
    __syncthreads();
#undef DSA_TOK
}
static_assert(DSA_LDS_END <= RING_BYTES, "DSA LDS map");

__device__ __forceinline__ void memattn_mfma(LAS unsigned char* lds, const bf16* QM, const bf16* KV, bf16* OM, int vcu, int G, const int wave) {
    const int lane = lane_fresh(), r32 = lane & 31, hi = lane >> 5;
    const unsigned voff = (unsigned)(65536 + (4 * hi + ((lane & 15) >> 2)) * 64 + ((lane >> 4) & 1) * 32 + (lane & 3) * 8);
    for (int j = vcu; j < 256; j += G) {
        const int bh = j >> 4, qb = j & 15, b = bh >> 2, h = bh & 3;
        const bf16* Kg = KV + (size_t)b * MEMT * 1024 + h * 128; const bf16* Vg = Kg + 512;
#pragma unroll
        for (int i = 0; i < 8; ++i) { const int q = 8 * wave + i;
            glds16(Kg + (size_t)(64 * (q & 3) + lane) * 1024 + (q >> 2) * 8, (unsigned)__builtin_amdgcn_readfirstlane((int)((unsigned)(uintptr_t)lds + ((q >> 2) * 256 + 64 * (q & 3)) * 16)));
            glds16(Vg + (size_t)(16 * (q & 15) + (lane >> 2)) * 1024 + (q >> 4) * 32 + (lane & 3) * 8, (unsigned)__builtin_amdgcn_readfirstlane((int)((unsigned)(uintptr_t)lds + 65536 + (q >> 4) * 16384 + (q & 15) * 1024))); }
        const size_t qrow = (size_t)b * SEQ + qb * 256 + wave * 32 + r32;
        bf16x8 qr[8];
#pragma unroll
        for (int s = 0; s < 8; ++s) { const v4u qa = *(const GAS v4u*)(QM + qrow * 512 + h * 128 + s * 16 + hi * 8), qb_ = *(const GAS v4u*)(QM + (size_t)M * 512 + qrow * 512 + h * 128 + s * 16 + hi * 8);
            const v4u qs = {cvtpk(blo(qa.x) + blo(qb_.x), bhi(qa.x) + bhi(qb_.x)), cvtpk(blo(qa.y) + blo(qb_.y), bhi(qa.y) + bhi(qb_.y)), cvtpk(blo(qa.z) + blo(qb_.z), bhi(qa.z) + bhi(qb_.z)), cvtpk(blo(qa.w) + blo(qb_.w), bhi(qa.w) + bhi(qb_.w))};
            qr[s] = __builtin_bit_cast(bf16x8, qs); }
        f32x16 o[4];
#pragma unroll
        for (int blk = 0; blk < 4; ++blk)
#pragma unroll
            for (int r = 0; r < 16; ++r) o[blk][r] = 0.f;
        float mrun = -INFINITY, lrun = 0.f;
        asm volatile("s_waitcnt vmcnt(0) lgkmcnt(0)\n\ts_barrier" ::: "memory");
        for (int kt = 0; kt < 4; ++kt) {
            const LAS unsigned char* Kb = lds + (unsigned)((hi * 256 + 64 * kt + r32) * 16);
            f32x16 p0, p1;
#pragma unroll
            for (int r = 0; r < 16; ++r) { p0[r] = 0.f; p1[r] = 0.f; }
#pragma unroll
            for (int s = 0; s < 8; ++s) { const bf16x8 k0 = *(const LAS bf16x8*)(Kb + s * 8192), k1 = *(const LAS bf16x8*)(Kb + s * 8192 + 512);
                p0 = __builtin_amdgcn_mfma_f32_32x32x16_bf16(k0, qr[s], p0, 0, 0, 0); p1 = __builtin_amdgcn_mfma_f32_32x32x16_bf16(k1, qr[s], p1, 0, 0, 0); }
            float rm = -INFINITY;
#pragma unroll
            for (int r = 0; r < 16; ++r) rm = fmaxf(rm, fmaxf(p0[r], p1[r]));
            rm = fmaxf(rm, xhalf_f(rm));
            if (__any(rm > mrun)) { const float mn = fmaxf(mrun, rm), f = __builtin_amdgcn_exp2f(mrun - mn); mrun = mn; lrun *= f;
#pragma unroll
                for (int blk = 0; blk < 4; ++blk)
#pragma unroll
                    for (int r = 0; r < 16; ++r) o[blk][r] *= f; }
            float ls = 0.f;
#pragma unroll
            for (int r = 0; r < 16; ++r) { p0[r] = __builtin_amdgcn_exp2f(p0[r] - mrun); p1[r] = __builtin_amdgcn_exp2f(p1[r] - mrun); ls += p0[r] + p1[r]; }
            lrun += ls;
            bf16x8 pw[4];
#pragma unroll
            for (int s = 0; s < 2; ++s) {
                v4u a = {cvtpk(p0[8 * s + 0], p0[8 * s + 1]), cvtpk(p0[8 * s + 2], p0[8 * s + 3]), cvtpk(p0[8 * s + 4], p0[8 * s + 5]), cvtpk(p0[8 * s + 6], p0[8 * s + 7])};
                v4u c = {cvtpk(p1[8 * s + 0], p1[8 * s + 1]), cvtpk(p1[8 * s + 2], p1[8 * s + 3]), cvtpk(p1[8 * s + 4], p1[8 * s + 5]), cvtpk(p1[8 * s + 6], p1[8 * s + 7])};
                pw[s] = __builtin_bit_cast(bf16x8, a); pw[2 + s] = __builtin_bit_cast(bf16x8, c); }
            const LAS unsigned char* Vb = lds + voff + kt * 4096;
#pragma unroll
            for (int blk = 0; blk < 4; ++blk) {
#pragma unroll
                for (int s = 0; s < 4; ++s) {
                    const v4i16_t lo = lds_tr16(Vb + blk * 16384 + s * 1024), hh = lds_tr16(Vb + blk * 16384 + s * 1024 + 512);
                    const bf16x8 vf = {lo[0], lo[1], lo[2], lo[3], hh[0], hh[1], hh[2], hh[3]};
                    o[blk] = __builtin_amdgcn_mfma_f32_32x32x16_bf16(vf, pw[s], o[blk], 0, 0, 0);
                }
            }
        }
        __syncthreads();
        lrun += xhalf_f(lrun);
        const float inv = 1.f / lrun;
        LAS unsigned* stg = (LAS unsigned*)(lds) + wave * (32 * 33);
        const float is = inv * FP8_OMS;
#pragma unroll
        for (int blk = 0; blk < 4; ++blk)
#pragma unroll
            for (int r = 0; r < 16; r += 4) { const int e = 32 * blk + 8 * (r >> 2) + 4 * hi;
                stg[r32 * 33 + (e >> 2)] = pg8::pk4_fp8(fminf(fmaxf(o[blk][r] * is, -448.f), 448.f), fminf(fmaxf(o[blk][r + 1] * is, -448.f), 448.f), fminf(fmaxf(o[blk][r + 2] * is, -448.f), 448.f), fminf(fmaxf(o[blk][r + 3] * is, -448.f), 448.f)); }
        LDS_WAIT(); asm volatile("" ::: "memory");
        unsigned char* orow = (unsigned char*)OM + ((size_t)b * SEQ + qb * 256 + wave * 32) * 512 + h * 128;
#pragma unroll 4
        for (int row = 0; row < 32; row += 2) *((GAS unsigned*)(orow + (size_t)(row + hi) * 512) + r32) = stg[(row + hi) * 33 + r32];
        __syncthreads();
    }
}

constexpr int N_PHASES = 21;
struct Args { const float* in[24]; float* out; unsigned char* ws; int ph_lo, ph_hi; };
__global__ void __launch_bounds__(NWAVES * 64, 2) mk_fwd(Args args) {
    extern __shared__ __attribute__((aligned(16))) unsigned char lds_raw[];
    LAS unsigned char* lds = (LAS unsigned char*)lds_raw;
    volatile LAS unsigned* MISC = (volatile LAS unsigned*)(lds + MISC_OFF);
    const int tid = threadIdx.x, wave = __builtin_amdgcn_readfirstlane(tid >> 6);
#define lane lane_fresh()
    const int G = gridDim.x; int bx = blockIdx.x;
    int vcu = (G % 8 == 0) ? (bx % 8) * (G / 8) + bx / 8 : bx;
    int gw = vcu * NWAVES + wave; const int NGW = G * NWAVES;
    unsigned char* ws = args.ws;
    gu32* ctl = (gu32*)(ws + WS_CTL);
    for (int u = tid; u < (LDS_BYTES - LDSCTL_OFF) / 4; u += NWAVES * 64) ((LAS unsigned*)(lds + LDSCTL_OFF))[u] = 0u;
    __syncthreads();
    const bool one = (args.ph_hi - args.ph_lo) > 1;
    XcdBarrier bar; bar.bar = (unsigned*)(ctl + CW_BAR); bar.x = 0; bar.st = nullptr;
    if (one) bar = xcd_barrier_post((unsigned*)(ctl + CW_BAR), MISC + 8, tid == 0);
    const int lo = args.ph_lo, hi = args.ph_hi;
#ifndef PH_MASK
#define PH_MASK 0xFFFFFFFFu
#endif
#define IN(k) ((((PH_MASK) >> (k)) & 1u) && lo <= (k) && (k) < hi)
#define SEAM(k) do { if (IN(k) && IN((k) + 1)) xcd_barrier(bar, wave); } while (0)
    bf16* const X16 = (bf16*)(ws + WS_X16); bf16* const HB = (bf16*)(ws + WS_H);
    long long* const ST0 = (long long*)(ws + WS_CTL + CTL_STATS); long long* const ST1 = (long long*)(ws + WS_CTL + CTL_STATS + CTL_STATS_STRIDE); long long* const ST2 = (long long*)(ws + WS_CTL + CTL_STATS + 2 * CTL_STATS_STRIDE);
    const float* const VEC = (const float*)(ws + WS_CTL + CTL_VECF);
    float* const out = args.out;
    const float* const ln_g = args.in[22]; const float* const ln_b = args.in[23];
    using namespace pg8;

#ifdef PROBE_P0
    if (IN(0)) { p0_prologue(args.in, ws, lds, gw, NGW, wave, lane); }
#endif
    if (IN(0)) { p0_prologue(args.in, ws, lds, gw, NGW, wave, lane); }
    SEAM(0);
    if (one && IN(0) && (G % 8) == 0) {
        unsigned* xb = (unsigned*)(ctl + CW_BAR); bool even = true;
#pragma unroll
        for (int jx = 0; jx < 16; ++jx) { const unsigned c = xb_ld(&xb[XB_XCNT(jx)]); even = even && (jx < 8 ? c == (unsigned)(G / 8) : c == 0u); }
        const int rank = (int)MISC[10], xcc = (int)xb_xcc_id();
        if (__builtin_amdgcn_readfirstlane(even ? 1 : 0)) { vcu = __builtin_amdgcn_readfirstlane(xcc * (G / 8) + rank); bx = __builtin_amdgcn_readfirstlane(rank * 8 + xcc); gw = vcu * NWAVES + wave; }
    }
    if (IN(1)) { { const long long* vi = (const long long*)(ws + WS_CTL + CTL_VEC); float* vf = (float*)(ws + WS_CTL + CTL_VECF); for (int i = gw * 64 + lane; i < V_END; i += NGW * 64) vf[i] = (float)vi[i] * (1.0f / 16777216.f); }
        Gemm g{(const bf16*)(ws + WS_X8), (const bf16*)(ws + WS_W_GU1), D / 2, D / 2, D / 2, 0, 0}; StaticOrder S; S.init(M, 2 * FF, G, bx); EpiSwiGLU8 E{(unsigned char*)HB, FF, 1.0f / (FP8_XS * FP8_WGUS), FP8_HS, LnFold{nullptr, nullptr, nullptr}};
        gemm_phase<EpiSwiGLU8, StaticOrder, true, true>(lds + RING_OFF, g, S, E, wave); }
    SEAM(1);
    if (IN(2)) { Gemm g{HB, (const bf16*)(ws + WS_W_D1), FF / 2, FF / 2, FF / 2, 0, 0}; StaticOrder S; S.init(M, D, G, bx); EpiRes<true> E{args.in[0], nullptr, D, ALPHA, 0.5f / (FP8_HS * FP8_WDS), nullptr, nullptr, nullptr, ST0, X16, (unsigned char*)(ws + WS_X8M), FP8_XS};
        gemm_phase<EpiRes<true>, StaticOrder, true, true>(lds + RING_OFF, g, S, E, wave); }
    SEAM(2);
    if (IN(4)) {
        const bool sp4 = (G == 256);
        { Gemm g{(const bf16*)(ws + WS_X8M), (const bf16*)(ws + WS_W_IN8), D / 2, D / 2, D / 2, 0, 0}; StaticOrder S; S.init(M, N_IN8, sp4 ? 168 : G, sp4 ? (bx < 168 ? bx : (1 << 20)) : bx);
          EpiInProj E{(bf16*)(ws + WS_AQ), (bf16*)(ws + WS_AK), (bf16*)(ws + WS_AV), (bf16*)(ws + WS_BQ), (bf16*)(ws + WS_BC), (bf16*)(ws + WS_IQ), (bf16*)(ws + WS_IKW), QSCALE, LnFold{ST0, VEC + V_GW_IN, VEC + V_BW_IN}, (unsigned*)(ctl + CW_KMAX), 0, 1.0f / (FP8_XS * FP8_WGS)};
          gemm_phase<EpiInProj, StaticOrder, true, true>(lds + RING_OFF, g, S, E, wave); }
        { Gemm g{X16, (const bf16*)(ws + WS_W_INB), D, D, D, 0, 0}; StaticOrder S; S.init(M, N_INB, sp4 ? 88 : G, sp4 ? (bx >= 168 ? bx - 168 : (1 << 20)) : ((G % 16 == 0) ? (bx + G / 2) % G : bx));
          EpiInProj E{(bf16*)(ws + WS_AQ), (bf16*)(ws + WS_AK), (bf16*)(ws + WS_AV), (bf16*)(ws + WS_BQ), (bf16*)(ws + WS_BC), (bf16*)(ws + WS_IQ), (bf16*)(ws + WS_IKW), QSCALE, LnFold{ST0, VEC + V_GW_IN, VEC + V_BW_IN}, (unsigned*)(ctl + CW_KMAX), N_IN8 / 256, 1.0f};
          gemm_phase<EpiInProj, StaticOrder, true>(lds + RING_OFF, g, S, E, wave); }
        { Gemm g{(const bf16*)(ws + WS_MEM16), (const bf16*)(ws + WS_W_MKV), D, D, D, 0, 0}; StaticOrder S; S.init(BATCH * MEMT, 1024, sp4 ? 16 : G, sp4 ? ((bx >= 224 && bx < 240) ? bx - 224 : (1 << 20)) : (bx >= G - 16 ? bx - (G - 16) : (1 << 20))); EpiBf16 E{(bf16*)(ws + WS_KVMEM), 1024};
          gemm_phase<EpiBf16, StaticOrder, true>(lds + RING_OFF, g, S, E, wave); }
    }
    SEAM(4);
    if (IN(5)) {
        { Gemm g{(const bf16*)(ws + WS_BQ), (const bf16*)(ws + WS_W_UK), 1024, 128, 128, 1, 128}; StaticOrder S; S.init(M, 4096, G, bx); EpiFp8 E{(unsigned char*)(ws + WS_QLAT), 8192, DSA_QS};
          gemm_phase<EpiFp8, StaticOrder, true>(lds + RING_OFF, g, S, E, wave); }
        crms_phase((const bf16*)(ws + WS_BC), (unsigned char*)(ws + WS_C8), args.in[8], DSA_CS, gw, NGW, lane);
    }
    if (IN(7)) indexer_topk(lds, (const bf16*)(ws + WS_IQ), (const bf16*)(ws + WS_IKW), (unsigned short*)(ws + WS_IDX), vcu, G, wave);
    if (IN(7)) diff_attn_mfma(lds, (const bf16*)(ws + WS_AQ), (const bf16*)(ws + WS_AK), (const bf16*)(ws + WS_AV), (bf16*)(ws + WS_YA8), args.in[6], args.in[7], (unsigned*)(ctl + CW_DQ), (const unsigned*)(ctl + CW_KMAX), wave);
    SEAM(7);
    if (IN(8)) dsa_mfma(lds, (const bf16*)(ws + WS_QLAT), (bf16*)(ws + WS_QLAT), 0x7fffffff, (const unsigned char*)(ws + WS_C8), (const unsigned short*)(ws + WS_IDX), vcu, G, wave);
    SEAM(8);
    if (IN(9)) { Gemm g{(const bf16*)(ws + WS_QLAT), (const bf16*)(ws + WS_W_UVP), 4096, 512, 512, 0, 512}; StaticOrder S; S.init(M, 1024, G, bx); EpiFp8 E{(unsigned char*)(ws + WS_YB), 1024, FP8_YS / (DSA_OS * FP8_WUVS)};
        gemm_phase<EpiFp8, StaticOrder, true, true, true>(lds + RING_OFF, g, S, E, wave); }
    SEAM(9);
    if (IN(10)) {
        { Gemm g{(const bf16*)(ws + WS_YA8), (const bf16*)(ws + WS_W_A), 512, 512, 512, 0, 0}; StaticOrder S; S.init(M, D, G, bx); EpiBf16 E{(bf16*)(ws + WS_TA), D, 1.0f / (FP8_YAS * FP8_WAS)}; gemm_phase<EpiBf16, StaticOrder, true, true>(lds + RING_OFF, g, S, E, wave); }
        { Gemm g{(const bf16*)(ws + WS_YB), (const bf16*)(ws + WS_W_B), 512, 512, 512, 0, 0}; StaticOrder S; S.init(M, D, G, bx); EpiBf16 E{(bf16*)(ws + WS_TB), D, 1.0f / (FP8_YS * FP8_WBS)}; gemm_phase<EpiBf16, StaticOrder, true, true>(lds + RING_OFF, g, S, E, wave); }
    }
    SEAM(10);
    if (IN(11)) { Gemm g{(const bf16*)(ws + WS_X8M), (const bf16*)(ws + WS_W_G), D / 2, D / 2, D / 2, 0, 0}; StaticOrder S; S.init(M, 2 * D, G, bx);
        EpiGateMerge8 E{(const bf16*)(ws + WS_TA), (const bf16*)(ws + WS_TB), (unsigned char*)(ws + WS_MRG8), D, args.in[12], args.in[12] + D, 1.0f / (FP8_XS * FP8_WGS), FP8_MS, LnFold{ST0, VEC + V_GW_G, VEC + V_BW_G}};
        gemm_phase<EpiGateMerge8, StaticOrder, true, true>(lds + RING_OFF, g, S, E, wave); }
    SEAM(11);
    if (IN(12)) { Gemm g{(const bf16*)(ws + WS_MRG8), (const bf16*)(ws + WS_W_MO), D / 2, D / 2, D / 2, 0, 0}; StaticOrder S; S.init(M, D, G, bx); EpiRes<false, 1> E{nullptr, X16, D, ALPHA, 1.0f / (FP8_MS * FP8_WMOS), ST0, ln_g, ln_b, ST1, X16, nullptr, 0.f};
        gemm_phase<EpiRes<false, 1>, StaticOrder, true, true>(lds + RING_OFF, g, S, E, wave); }
    SEAM(12);
    if (IN(14)) { Gemm g{X16, (const bf16*)(ws + WS_W_MQ), D, D, D / 2, 1, D / 2, 2, D / 2}; StaticOrder S; S.init(M, 1024, G, bx);
        EpiBf16S E{(bf16*)(ws + WS_QM), (size_t)M * 512, 0.08838834764831845f * LOG2E, LnFold{ST1, VEC + V_GW_MQ, VEC + V_BW_MQ}}; gemm_phase<EpiBf16S, StaticOrder, true>(lds + RING_OFF, g, S, E, wave); }
    SEAM(14);
    if (IN(15)) memattn_mfma(lds, (const bf16*)(ws + WS_QM), (const bf16*)(ws + WS_KVMEM), (bf16*)(ws + WS_OM), vcu, G, wave);
    SEAM(15);
    if (IN(16)) { Gemm g{(const bf16*)(ws + WS_OM), (const bf16*)(ws + WS_W_MOUT), 256, 256, 256, 0, 0}; StaticOrder S; S.init(M, D, G, bx); EpiRes<false> E{nullptr, X16, D, ALPHA, 1.0f / (FP8_OMS * FP8_WMOUTS), ST1, ln_g + D, ln_b + D, ST2, X16, (unsigned char*)(ws + WS_X8), FP8_XS};
        gemm_phase<EpiRes<false>, StaticOrder, true, true>(lds + RING_OFF, g, S, E, wave); }
    SEAM(16);
    if (IN(18)) { Gemm g{(const bf16*)(ws + WS_X8), (const bf16*)(ws + WS_W_GU2), D / 2, D / 2, D / 2, 0, 0}; StaticOrder S; S.init(M, 2 * FF, G, bx); EpiSwiGLU8 E{(unsigned char*)HB, FF, 1.0f / (FP8_XS * FP8_WGUS), FP8_HS, LnFold{ST2, VEC + V_GW_GU2, VEC + V_BW_GU2}};
        gemm_phase<EpiSwiGLU8, StaticOrder, true, true>(lds + RING_OFF, g, S, E, wave); }
    SEAM(18);
    if (IN(19)) { Gemm g{HB, (const bf16*)(ws + WS_W_D2), FF / 2, FF / 2, FF / 2, 0, 0}; StaticOrder S; S.init(M, D, G, bx); EpiRes<false> E{nullptr, X16, D, ALPHA, 0.5f / (FP8_HS * FP8_WDS), ST2, ln_g + 2 * D, ln_b + 2 * D, nullptr, X16, nullptr, 0.f};
        gemm_phase<EpiRes<false>, StaticOrder, true, true>(lds + RING_OFF, g, S, E, wave); }
    SEAM(19);
    if (IN(20)) ln_final_phase(X16, out, ln_g + 3 * D, ln_b + 3 * D, gw, NGW, lane);
#undef IN
#undef SEAM
#undef lane
}

extern "C" void kernel_launch(void* const* d_in, const int* in_sizes, int n_in, void* d_out, int out_size, void* d_ws, size_t ws_size, hipStream_t stream) {
    static int grid = 0;
    if (grid == 0) {
        if (n_in != 24 || in_sizes[0] != M * D || out_size != M * D || ws_size < WS_END) { fprintf(stderr, "kernel_launch: unexpected shapes (n_in %d, in0 %d, out %d, ws %zu); nothing launched\n", n_in, n_in > 0 ? in_sizes[0] : -1, out_size, ws_size); grid = -1; return; }
        int dev = 0, cus = 0, per_cu = 0;
        if (hipGetDevice(&dev) != hipSuccess || hipDeviceGetAttribute(&cus, hipDeviceAttributeMultiprocessorCount, dev) != hipSuccess) { grid = -1; return; }
        if (hipFuncSetAttribute((const void*)mk_fwd, hipFuncAttributeMaxDynamicSharedMemorySize, LDS_BYTES) != hipSuccess) { fprintf(stderr, "kernel_launch: hipFuncSetAttribute failed\n"); grid = -1; return; }
        if (hipOccupancyMaxActiveBlocksPerMultiprocessor(&per_cu, (const void*)mk_fwd, NWAVES * 64, LDS_BYTES) != hipSuccess || per_cu < 1)
            fprintf(stderr, "kernel_launch: note: the occupancy query reports %d workgroups per CU\n", per_cu);
        (void)hipGetLastError();
        grid = cus;
    }
    if (grid < 0) return;
    if (hipMemsetAsync((char*)d_ws + WS_CTL, 0, CTL_ZERO_BYTES, stream) != hipSuccess) return;
    Args a{};
    for (int i = 0; i < 24; ++i) a.in[i] = (const float*)d_in[i];
    a.out = (float*)d_out; a.ws = (unsigned char*)d_ws;
#if MK_ONE_LAUNCH
    a.ph_lo = 0; a.ph_hi = N_PHASES;
    hipLaunchKernelGGL(mk_fwd, dim3(grid), dim3(NWAVES * 64), LDS_BYTES, stream, a);
#else
    for (int p = 0; p < N_PHASES; ++p) { a.ph_lo = p; a.ph_hi = p + 1; hipLaunchKernelGGL(mk_fwd, dim3(grid), dim3(NWAVES * 64), LDS_BYTES, stream, a); }
#endif
}
```
